# Optimizing an MI355X kernel written in HIP

```python
import jax, jax.numpy as jnp
from jax import lax
import numpy as np

D_MODEL = 2048
BATCH = 8
SEQ = 2048
DEPTH = 1
DEC_BATCH = 32
DEC_SEQ = 8
PAST_LEN = 16384
PAGE_SIZE = 128

N_ATT_HEADS = 12
HEAD_DIM = 128
D_ATT = N_ATT_HEADS * HEAD_DIM
ATT_SCALE = HEAD_DIM ** -0.5
PATTERNS = ((128, 1), (512, 4), (2048, 16))
MAX_WINDOW = 2048
BLOCK = 128
WIN_BUF = min(MAX_WINDOW, PAST_LEN)
D_LRU = D_MODEL - D_ATT
N_LRU_BLOCKS = 8
LRU_BLOCK = D_LRU // N_LRU_BLOCKS
CONV_WIDTH = 4
LRU_C = 8.0
D_IN = 3 * D_ATT + 2 * D_LRU
SPLITS = (D_ATT, 2 * D_ATT, 3 * D_ATT, 3 * D_ATT + D_LRU)
N_KEYS = 128
N_EXPERTS = N_KEYS * N_KEYS
PEER_HEADS = 8
D_KEY = 256
HALF_KEY = D_KEY // 2
TOPK = 16
TOKEN_BLOCK = 128
ALPHA = (2.0 * DEPTH) ** 0.25
BETA = (8.0 * DEPTH) ** -0.25
LN_EPS = 1e-5

kernel_name = 'hymba_dilated_rglru_peer_step'


def layer_norm(x, g, b):
    xf = x.astype(jnp.float32)
    mu = xf.mean(-1, keepdims=True)
    var = jnp.mean(jnp.square(xf - mu), -1, keepdims=True)
    return ((xf - mu) * lax.rsqrt(var + LN_EPS) * g + b).astype(x.dtype)


def alibi_slopes():
    return 2.0 ** (-8.0 * jnp.arange(1, N_ATT_HEADS + 1, dtype=jnp.float32) / N_ATT_HEADS)


def dilated_prompt(q, k, v, window, dil, slopes):
    B, S, H, E = q.shape
    nb = window // dil
    L = S // dil
    L_pad = -(-L // BLOCK) * BLOCK
    nc = L_pad // BLOCK

    def to_classes(t):
        t = jnp.pad(t, ((0, 0), (0, dil * L_pad - S), (0, 0), (0, 0)))
        return t.reshape(B, L_pad, dil, H, E)

    def key_blocks(t):
        t = jnp.pad(to_classes(t), ((0, 0), (BLOCK, 0), (0, 0), (0, 0), (0, 0)))
        t = t.reshape(B, nc + 1, BLOCK, dil, H, E)
        return jnp.concatenate([t[:, :-1], t[:, 1:]], axis=2)

    qc = to_classes(q).reshape(B, nc, BLOCK, dil, H, E)
    kc = key_blocks(k)
    vc = key_blocks(v)
    s = jnp.einsum('bcqrhe,bckrhe->bcrhqk', qc, kc, preferred_element_type=jnp.float32) * ATT_SCALE
    q_loc = jnp.arange(BLOCK)[:, None]
    k_loc = jnp.arange(2 * BLOCK)[None, :]
    dist = q_loc + BLOCK - k_loc
    key_idx = jnp.arange(nc)[:, None, None] * BLOCK - BLOCK + k_loc[None]
    valid = (dist >= 0) & (dist <= nb) & (key_idx >= 0)
    bias = -slopes[:, None, None] * (dil * dist).astype(jnp.float32)
    s = jnp.where(valid[None, :, None, None], s + bias, -jnp.inf)
    m = s.max(-1)
    p = jnp.exp(s - m[..., None])
    l = p.sum(-1)
    o = jnp.einsum('bcrhqk,bckrhe->bcqrhe', p, vc)
    o = o.reshape(B, L_pad * dil, H, E)[:, :S]
    m = m.transpose(0, 1, 4, 2, 3).reshape(B, L_pad * dil, H)[:, :S]
    l = l.transpose(0, 1, 4, 2, 3).reshape(B, L_pad * dil, H)[:, :S]
    return m, l, o


def dilated_sample(q, k_cat, v_cat, window, dil, slopes):
    T = q.shape[1]
    n_past = k_cat.shape[1] - T
    nb = window // dil
    dist = jnp.arange(nb + 1)
    idx = n_past + jnp.arange(T)[:, None] - dil * dist[None, :]
    valid = idx >= 0
    idx = jnp.maximum(idx, 0)
    kg = k_cat[:, idx]
    vg = v_cat[:, idx]
    s = jnp.einsum('bthe,btkhe->bhtk', q, kg, preferred_element_type=jnp.float32) * ATT_SCALE
    bias = -slopes[:, None, None] * (dil * dist).astype(jnp.float32)[None, None, :]
    s = jnp.where(valid[None, None], s + bias[None], -jnp.inf)
    m = s.max(-1)
    p = jnp.exp(s - m[..., None])
    l = p.sum(-1)
    o = jnp.einsum('bhtk,btkhe->bthe', p, vg)
    return m.transpose(0, 2, 1), l.transpose(0, 2, 1), o


def merge_patterns(parts):
    m_all = jnp.stack([pt[0] for pt in parts])
    l_all = jnp.stack([pt[1] for pt in parts])
    o_all = jnp.stack([pt[2] for pt in parts])
    w = jnp.exp(m_all - m_all.max(0))
    num = jnp.einsum('pbth,pbthe->bthe', w, o_all)
    den = jnp.einsum('pbth,pbth->bth', w, l_all)
    return num / den[..., None]


def causal_conv(x_ext, w, b):
    T = x_ext.shape[1] - (CONV_WIDTH - 1)
    return sum(x_ext[:, j:j + T] * w[j] for j in range(CONV_WIDTH)) + b


def rg_lru(xc, h0, w_a, b_a, w_x, b_x, lam):
    B, T, C = xc.shape
    xf = xc.astype(jnp.float32)
    xb = xf.reshape(B, T, N_LRU_BLOCKS, LRU_BLOCK)
    r = jax.nn.sigmoid(jnp.einsum('btnc,ncd->btnd', xb, w_a.astype(jnp.float32)).reshape(B, T, C) + b_a)
    i = jax.nn.sigmoid(jnp.einsum('btnc,ncd->btnd', xb, w_x.astype(jnp.float32)).reshape(B, T, C) + b_x)
    log_a = -LRU_C * r * jax.nn.softplus(-lam.astype(jnp.float32))
    a = jnp.exp(log_a)
    u = jnp.sqrt(-jnp.expm1(2.0 * log_a)) * (i * xf)

    def step(h, inp):
        a_t, u_t = inp
        h = a_t * h + u_t
        return h, h

    h_last, hs = lax.scan(step, h0.astype(jnp.float32), (jnp.swapaxes(a, 0, 1), jnp.swapaxes(u, 0, 1)))
    return jnp.swapaxes(hs, 0, 1), h_last


def peer(x, w_query, sub_keys, expert_u, expert_v):
    N = x.shape[0]
    n_pad = -(-N // TOKEN_BLOCK) * TOKEN_BLOCK
    xp = jnp.pad(x, ((0, n_pad - N), (0, 0))).reshape(n_pad // TOKEN_BLOCK, TOKEN_BLOCK, D_MODEL)

    def block(xb):
        q = (xb @ w_query).reshape(TOKEN_BLOCK, PEER_HEADS, 2, HALF_KEY)
        s = jnp.einsum('thpe,hpke->thpk', q, sub_keys, preferred_element_type=jnp.float32)
        sv, si = lax.top_k(s, TOPK)
        cand = sv[:, :, 0, :, None] + sv[:, :, 1, None, :]
        cand_idx = si[:, :, 0, :, None] * N_KEYS + si[:, :, 1, None, :]
        fv, fi = lax.top_k(cand.reshape(TOKEN_BLOCK, PEER_HEADS, TOPK * TOPK), TOPK)
        eidx = jnp.take_along_axis(cand_idx.reshape(TOKEN_BLOCK, PEER_HEADS, TOPK * TOPK), fi, axis=-1)
        g = jax.nn.softmax(fv, axis=-1)
        hid = jax.nn.gelu(jnp.einsum('thkd,td->thk', expert_u[eidx], xb, preferred_element_type=jnp.float32), approximate=False)
        return jnp.einsum('thk,thkd->td', (g * hid).astype(xb.dtype), expert_v[eidx])

    return lax.map(block, xp).reshape(n_pad, D_MODEL)[:N]


def trunk_layer(x, k_buf, v_buf, conv_buf, h0, w_in, conv_w, conv_b, lru_w_a, lru_b_a, lru_w_x, lru_b_x,
                lru_lambda, w_out, ln1_g, ln1_b, peer_w_query, peer_sub_keys, peer_u, peer_v, ln2_g, ln2_b):
    B, T, _ = x.shape
    proj = x @ w_in
    q, k, v, xr, gate = jnp.split(proj, SPLITS, axis=-1)
    q = q.reshape(B, T, N_ATT_HEADS, HEAD_DIM)
    k = k.reshape(B, T, N_ATT_HEADS, HEAD_DIM)
    v = v.reshape(B, T, N_ATT_HEADS, HEAD_DIM)
    slopes = alibi_slopes()
    if k_buf is None:
        parts = [dilated_prompt(q, k, v, wd, dl, slopes) for wd, dl in PATTERNS]
        keep = min(MAX_WINDOW, T)
        new_k, new_v = k[:, T - keep:], v[:, T - keep:]
        conv_buf = jnp.zeros((B, CONV_WIDTH - 1, D_LRU), xr.dtype)
        h0 = jnp.zeros((B, D_LRU), jnp.float32)
    else:
        k_cat = jnp.concatenate([k_buf.astype(k.dtype), k], axis=1)
        v_cat = jnp.concatenate([v_buf.astype(v.dtype), v], axis=1)
        parts = [dilated_sample(q, k_cat, v_cat, wd, dl, slopes) for wd, dl in PATTERNS]
        new_k, new_v = k_cat[:, T:], v_cat[:, T:]
    att = merge_patterns(parts).reshape(B, T, D_ATT).astype(x.dtype)
    x_ext = jnp.concatenate([conv_buf.astype(xr.dtype), xr], axis=1)
    xc = causal_conv(x_ext, conv_w, conv_b)
    new_conv = x_ext[:, T:]
    hs, h_last = rg_lru(xc, h0, lru_w_a, lru_b_a, lru_w_x, lru_b_x, lru_lambda)
    rec = (hs * jax.nn.gelu(gate.astype(jnp.float32), approximate=False)).astype(x.dtype)
    mix = jnp.concatenate([att, rec], axis=-1) @ w_out
    x1 = layer_norm(ALPHA * x + mix, ln1_g, ln1_b)
    ffn = peer(x1.reshape(B * T, D_MODEL), peer_w_query, peer_sub_keys, peer_u, peer_v).reshape(B, T, D_MODEL)
    y = layer_norm(ALPHA * x1 + ffn, ln2_g, ln2_b)
    return y, new_k, new_v, new_conv, h_last


def setup_inputs(seed: int = 0) -> dict:
    key = jax.random.key(seed)
    ks = jax.random.split(key, 24)
    f32 = jnp.float32

    def nrm(k, shape, scale=1.0):
        return jax.random.normal(k, shape, f32) * scale

    u = jax.random.uniform(ks[10], (DEPTH, D_LRU), f32, 0.9, 0.999)
    a0 = u ** (1.0 / LRU_C)
    lam = jnp.log(a0) - jnp.log1p(-a0)
    return {
        'x_prompt': nrm(ks[0], (BATCH, SEQ, D_MODEL)),
        'x_sample': nrm(ks[1], (DEC_BATCH, DEC_SEQ, D_MODEL)),
        'cache_k': nrm(ks[2], (DEPTH, DEC_BATCH, WIN_BUF, N_ATT_HEADS, HEAD_DIM)),
        'cache_v': nrm(ks[3], (DEPTH, DEC_BATCH, WIN_BUF, N_ATT_HEADS, HEAD_DIM)),
        'state_conv': nrm(ks[4], (DEPTH, DEC_BATCH, CONV_WIDTH - 1, D_LRU)),
        'state_h': nrm(ks[5], (DEPTH, DEC_BATCH, D_LRU), 0.5),
        'w_in': nrm(ks[6], (DEPTH, D_MODEL, D_IN), D_MODEL ** -0.5),
        'conv_w': nrm(ks[7], (DEPTH, CONV_WIDTH, D_LRU), 0.5),
        'conv_b': nrm(ks[8], (DEPTH, D_LRU), 0.01),
        'lru_w_a': nrm(ks[9], (DEPTH, N_LRU_BLOCKS, LRU_BLOCK, LRU_BLOCK), LRU_BLOCK ** -0.5),
        'lru_b_a': nrm(ks[11], (DEPTH, D_LRU), 0.01),
        'lru_w_x': nrm(ks[12], (DEPTH, N_LRU_BLOCKS, LRU_BLOCK, LRU_BLOCK), LRU_BLOCK ** -0.5),
        'lru_b_x': nrm(ks[13], (DEPTH, D_LRU), 0.01),
        'lru_lambda': lam,
        'w_out': nrm(ks[14], (DEPTH, D_MODEL, D_MODEL), BETA * D_MODEL ** -0.5),
        'ln1_g': 1.0 + nrm(ks[15], (DEPTH, D_MODEL), 0.02),
        'ln1_b': nrm(ks[16], (DEPTH, D_MODEL), 0.02),
        'peer_w_query': nrm(ks[17], (DEPTH, D_MODEL, PEER_HEADS * D_KEY), D_MODEL ** -0.5),
        'peer_sub_keys': nrm(ks[18], (DEPTH, PEER_HEADS, 2, N_KEYS, HALF_KEY), HALF_KEY ** -0.5),
        'peer_u': nrm(ks[19], (DEPTH, N_EXPERTS, D_MODEL), D_MODEL ** -0.5),
        'peer_v': nrm(ks[20], (DEPTH, N_EXPERTS, D_MODEL), BETA * PEER_HEADS ** -0.5),
        'ln2_g': 1.0 + nrm(ks[21], (DEPTH, D_MODEL), 0.02),
        'ln2_b': nrm(ks[22], (DEPTH, D_MODEL), 0.02),
    }


def reference(x_prompt, x_sample, cache_k, cache_v, state_conv, state_h, w_in, conv_w, conv_b, lru_w_a,
              lru_b_a, lru_w_x, lru_b_x, lru_lambda, w_out, ln1_g, ln1_b, peer_w_query, peer_sub_keys,
              peer_u, peer_v, ln2_g, ln2_b):
    yp, ys = x_prompt, x_sample
    kp, vp, cp, hp = [], [], [], []
    kq, vq, cq, hq = [], [], [], []
    for layer in range(DEPTH):
        wts = (w_in[layer], conv_w[layer], conv_b[layer], lru_w_a[layer], lru_b_a[layer], lru_w_x[layer],
               lru_b_x[layer], lru_lambda[layer], w_out[layer], ln1_g[layer], ln1_b[layer],
               peer_w_query[layer], peer_sub_keys[layer], peer_u[layer], peer_v[layer], ln2_g[layer], ln2_b[layer])
        yp, k1, v1, c1, h1 = trunk_layer(yp, None, None, None, None, *wts)
        ys, k2, v2, c2, h2 = trunk_layer(ys, cache_k[layer], cache_v[layer], state_conv[layer], state_h[layer], *wts)
        kp.append(k1); vp.append(v1); cp.append(c1); hp.append(h1)
        kq.append(k2); vq.append(v2); cq.append(c2); hq.append(h2)
    return (yp, ys, jnp.stack(kp), jnp.stack(vp), jnp.stack(cp), jnp.stack(hp),
            jnp.stack(kq), jnp.stack(vq), jnp.stack(cq), jnp.stack(hq))
```

```cpp
#include <hip/hip_runtime.h>
#include <cstdio>
#include <cstdint>
namespace pg8 {
#define PG8_LAS __attribute__((address_space(3)))
typedef unsigned short bf16_t;
typedef short bf16x8 __attribute__((ext_vector_type(8)));
typedef float f32x4 __attribute__((ext_vector_type(4)));
typedef unsigned u32x4 __attribute__((ext_vector_type(4)));
constexpr int BM = 256, BK = 64, HALF = 128, HTB = HALF * BK * 2  , STAGE_BYTES = 8 * HTB, NXCD = 8, WGM = 8;

__host__ __device__ __forceinline__ int lds_byte(int r, int c) { const int st = (r >> 4) * 2 + (c >> 5), rr = r & 15, cc = c & 31, ob = rr * 64 + cc * 2; return st * 1024 + (ob ^ (((ob >> 9) & 1) << 5)); }
__host__ __device__ __forceinline__ void stage_rc(int b, int& R, int& C) { const int st = b / 1024, sb = b % 1024, swz = sb ^ (((sb >> 9) & 1) << 5); R = (st >> 1) * 16 + swz / 64; C = (st & 1) * 32 + (swz % 64) / 2; }
__host__ __device__ __forceinline__ int perm32(int rho) { const int n = rho >> 4, i = rho & 15; return 8 * (i >> 2) + 4 * n + (i & 3); }

struct Unit { int pm, pn; };
struct Gemm { const bf16_t* A; const bf16_t* Bt; int M, N, K; };

struct StaticOrder {
    int nM, nN, nwg, G, c;
    __host__ __device__ void init(int M, int N, int G_, int c_) { nM = M / BM; nN = N / BM; nwg = nM * nN; G = G_; c = c_; }
    __host__ __device__ bool next(int i, Unit& u) const {
        const long L = (long)i * G + c; if (L >= nwg) return false;
        int wgid = (int)L; { const int q = nwg / NXCD, r = nwg % NXCD, xcd = wgid % NXCD, off = wgid / NXCD; wgid = (xcd < r ? xcd * (q + 1) : r * (q + 1) + (xcd - r) * q) + off; }
        const int nig = WGM * nN, gid = wgid / nig, fm = gid * WGM, gsz = (nM - fm) < WGM ? (nM - fm) : WGM;
        u.pm = fm + ((wgid % nig) % gsz); u.pn = (wgid % nig) / gsz; return true;
    }
    __device__ __forceinline__ void a_ready(const Unit&) const {}
    __device__ __forceinline__ void done(const Unit&) const {}
};
struct CountedOrder : StaticOrder {
    const unsigned* ready; unsigned need; unsigned* tmo;
    __device__ __forceinline__ void a_ready(const Unit& u) const {
        if (threadIdx.x < 64) {
            const unsigned long long t0 = __builtin_amdgcn_s_memrealtime(); unsigned polls = 0;
            while ((unsigned)__builtin_amdgcn_readfirstlane(__hip_atomic_load(ready + 64 * u.pm, __ATOMIC_RELAXED, __HIP_MEMORY_SCOPE_AGENT)) < need) {
                if ((++polls & 255u) == 0u && __builtin_amdgcn_readfirstlane(__hip_atomic_load(tmo, __ATOMIC_RELAXED, __HIP_MEMORY_SCOPE_AGENT)) != 0u) break;
                if (__builtin_amdgcn_s_memrealtime() - t0 > 2000000ull) {
                    if (threadIdx.x == 0) { unsigned expect = 0u; __hip_atomic_compare_exchange_strong(tmo + 1, &expect, 0x600u | (unsigned)(u.pm & 0xff), __ATOMIC_RELAXED, __ATOMIC_RELAXED, __HIP_MEMORY_SCOPE_AGENT); __hip_atomic_store(tmo, 1u, __ATOMIC_RELAXED, __HIP_MEMORY_SCOPE_AGENT); }
                    break; }
                __builtin_amdgcn_s_sleep(2); }
            __builtin_amdgcn_fence(__ATOMIC_ACQUIRE, "agent");
            asm volatile("s_waitcnt vmcnt(0)" ::: "memory");
        }
#if !defined(BROKEN_HOOK_NO_BARRIER)
        asm volatile("" ::: "memory"); __builtin_amdgcn_s_barrier(); asm volatile("" ::: "memory");
#endif
    }
};

__device__ __forceinline__ unsigned cvt_pk_bf16(float lo, float hi) { unsigned r; asm volatile("v_cvt_pk_bf16_f32 %0, %1, %2" : "=v"(r) : "v"(lo), "v"(hi)); return r; }
typedef float f32x2 __attribute__((ext_vector_type(2)));
__device__ __forceinline__ f32x2 gelu_pk(f32x2 v) {
    const f32x2 av = __builtin_elementwise_abs(v), d = av * 0.2316418882f + 1.0f;
    f32x2 t; t.x = __builtin_amdgcn_rcpf(d.x); t.y = __builtin_amdgcn_rcpf(d.y);
    f32x2 q = t * 0.5307027145f + (-0.7265760135f); q = q * t + 0.7107068705f; q = q * t + (-0.142248368f); q = q * t + 0.127414796f; q = q * t;
    const f32x2 s = (v * v) * (-0.72134752044f);
    f32x2 e; e.x = __builtin_amdgcn_exp2f(s.x); e.y = __builtin_amdgcn_exp2f(s.y);
    const f32x2 m = v * (q * e), r = v - m;
    f32x2 o; o.x = v.x < 0.f ? m.x : r.x; o.y = v.y < 0.f ? m.y : r.y; return o;
}

struct EpiF32 {
    static constexpr bool PERM = false, AFTER_DRAIN = false;
    float* C; int ldc; const float* bias;
    __device__ __forceinline__ void operator()(const f32x4 (&acc)[2][2][4][2], const Unit& u, int wr, int wc, int fr, int fq) const {
        const int row0 = u.pm * BM + wr * 64 + fr, col0 = u.pn * BM + wc * 32 + 4 * fq;
        f32x4 bv[2][2];
#pragma unroll
        for (int bj = 0; bj < 2; ++bj)
#pragma unroll
            for (int n = 0; n < 2; ++n) bv[bj][n] = bias ? *(const f32x4*)(bias + col0 + bj * HALF + n * 16) : (f32x4){0.f, 0.f, 0.f, 0.f};
#pragma unroll
        for (int ai = 0; ai < 2; ++ai)
#pragma unroll
            for (int m = 0; m < 4; ++m) { float* rowp = C + (size_t)(row0 + ai * HALF + m * 16) * ldc + col0;
#pragma unroll
                for (int bj = 0; bj < 2; ++bj)
#pragma unroll
                    for (int n = 0; n < 2; ++n) *(f32x4*)(rowp + bj * HALF + n * 16) = acc[ai][bj][m][n] + bv[bj][n]; }
    }
};
template <int ACT  > struct EpiBf16 {
    static constexpr bool PERM = true, AFTER_DRAIN = false;
    bf16_t* O; int ldc; const float* bias; int split_cols; size_t split_stride;
    __device__ __forceinline__ void operator()(const f32x4 (&acc)[2][2][4][2], const Unit& u, int wr, int wc, int fr, int fq) const {
        const int row0 = u.pm * BM + wr * 64 + fr; int colt = u.pn * BM; bf16_t* base = O;
        if (split_cols) { const int t = colt / split_cols; base += (size_t)t * split_stride; colt -= t * split_cols; }
        const int col0 = colt + wc * 32 + 8 * fq, bcol0 = u.pn * BM + wc * 32 + 8 * fq;
        f32x4 bv[2][2];
#pragma unroll
        for (int bj = 0; bj < 2; ++bj)
#pragma unroll
            for (int n = 0; n < 2; ++n) bv[bj][n] = bias ? *(const f32x4*)(bias + bcol0 + bj * HALF + 4 * n) : (f32x4){0.f, 0.f, 0.f, 0.f};
#pragma unroll
        for (int ai = 0; ai < 2; ++ai)
#pragma unroll
            for (int m = 0; m < 4; ++m) { bf16_t* rowp = base + (size_t)(row0 + ai * HALF + m * 16) * ldc + col0;
#pragma unroll
                for (int bj = 0; bj < 2; ++bj) { f32x4 v0 = acc[ai][bj][m][0] + bv[bj][0], v1 = acc[ai][bj][m][1] + bv[bj][1];
                    if (ACT == 1) { f32x2 a = gelu_pk((f32x2){v0[0], v0[1]}), b = gelu_pk((f32x2){v0[2], v0[3]}), c = gelu_pk((f32x2){v1[0], v1[1]}), d = gelu_pk((f32x2){v1[2], v1[3]});
                        v0 = (f32x4){a.x, a.y, b.x, b.y}; v1 = (f32x4){c.x, c.y, d.x, d.y}; }
                    if (ACT == 2) {
#pragma unroll
                        for (int j = 0; j < 4; ++j) { v0[j] = 0.5f * v0[j] * (1.0f + erff(v0[j] * 0.70710678f)); v1[j] = 0.5f * v1[j] * (1.0f + erff(v1[j] * 0.70710678f)); } }
                    u32x4 w; w.x = cvt_pk_bf16(v0[0], v0[1]); w.y = cvt_pk_bf16(v0[2], v0[3]); w.z = cvt_pk_bf16(v1[0], v1[1]); w.w = cvt_pk_bf16(v1[2], v1[3]);
                    *(u32x4*)(rowp + bj * HALF) = w; } }
    }
};

struct PanelStats {
    unsigned* xbuf;
    unsigned* cnt;
    unsigned* tmo;
    int ntn; float eps;
    unsigned code;
    __device__ __forceinline__ bool run(const f32x4 (&v)[2][2][4][2], const Unit& u, int wr, int wc, int fr, int fq, PG8_LAS unsigned char* lds, int wid, int lane) const {
        typedef float f32x2v __attribute__((ext_vector_type(2)));
        PG8_LAS f32x2v* P = (PG8_LAS f32x2v*)lds;
        PG8_LAS f32x2v* S = (PG8_LAS f32x2v*)(lds + 8192);
        PG8_LAS unsigned* flag = (PG8_LAS unsigned*)(lds + 8192 + 2048);
#pragma unroll
        for (int ai = 0; ai < 2; ++ai)
#pragma unroll
            for (int m = 0; m < 4; ++m) {
                float s = 0.f;
#pragma unroll
                for (int bj = 0; bj < 2; ++bj)
#pragma unroll
                    for (int n = 0; n < 2; ++n) { const f32x4 x = v[ai][bj][m][n]; s += (x[0] + x[1]) + (x[2] + x[3]); }
                s += __shfl_xor(s, 16); s += __shfl_xor(s, 32);
                const float mw = s * (1.0f / 64.0f); float q = 0.f;
#pragma unroll
                for (int bj = 0; bj < 2; ++bj)
#pragma unroll
                    for (int n = 0; n < 2; ++n) { const f32x4 d = v[ai][bj][m][n] - mw; q += (d[0] * d[0] + d[1] * d[1]) + (d[2] * d[2] + d[3] * d[3]); }
                q += __shfl_xor(q, 16); q += __shfl_xor(q, 32);
                if (fq == 0) P[(ai * HALF + wr * 64 + m * 16 + fr) * 4 + wc] = (f32x2v){mw, q};
            }
        asm volatile("s_waitcnt lgkmcnt(0)" ::: "memory"); __builtin_amdgcn_s_barrier(); asm volatile("" ::: "memory");
#if defined(BROKEN_NO_WAIT)
        if (blockIdx.x >= 64) { const long long t0 = clock64(); while (clock64() - t0 < 60000) __builtin_amdgcn_s_sleep(8); }
#endif
        const int row = wid * 32 + (lane & 31);
        if (lane < 32) {
            const f32x2v a = P[row * 4 + 0], b = P[row * 4 + 1], c = P[row * 4 + 2], d = P[row * 4 + 3];
            const float mt = (a.x + b.x + c.x + d.x) * 0.25f;
            const float da = a.x - mt, db = b.x - mt, dc = c.x - mt, dd = d.x - mt;
            const float m2 = (a.y + b.y) + (c.y + d.y) + 64.0f * ((da * da + db * db) + (dc * dc + dd * dd));
            unsigned long long* slot = (unsigned long long*)xbuf + ((size_t)(u.pm * BM + row) * 4 + u.pn);
            __hip_atomic_store(slot, ((unsigned long long)__float_as_uint(m2) << 32) | __float_as_uint(mt), __ATOMIC_RELAXED, __HIP_MEMORY_SCOPE_AGENT);
        }
        asm volatile("s_waitcnt vmcnt(0)" ::: "memory");
        if (lane == 0) __hip_atomic_fetch_add(cnt + 64 * u.pm, 1u, __ATOMIC_RELAXED, __HIP_MEMORY_SCOPE_AGENT);
        if (wid == 0) {
            bool dead = false; const unsigned long long t0 = __builtin_amdgcn_s_memrealtime(); const unsigned want = 8u * (unsigned)ntn;
            for (;;) {
#if defined(BROKEN_NO_WAIT)
                break;
#endif
                if ((unsigned)__builtin_amdgcn_readfirstlane(__hip_atomic_load(cnt + 64 * u.pm, __ATOMIC_RELAXED, __HIP_MEMORY_SCOPE_AGENT)) >= want) break;
                if (__builtin_amdgcn_s_memrealtime() - t0 > 2000000ull) {
                    if (lane == 0) { unsigned expect = 0u; __hip_atomic_compare_exchange_strong(tmo + 1, &expect, code | (unsigned)(u.pm & 0xff), __ATOMIC_RELAXED, __ATOMIC_RELAXED, __HIP_MEMORY_SCOPE_AGENT);
                                     __hip_atomic_store(tmo, 1u, __ATOMIC_RELAXED, __HIP_MEMORY_SCOPE_AGENT); }
                    dead = true; break; }
                __builtin_amdgcn_s_sleep(2);
            }
            __builtin_amdgcn_fence(__ATOMIC_ACQUIRE, "agent");
            if (lane == 0) flag[0] = dead ? 1u : 0u;
        }
        asm volatile("s_waitcnt vmcnt(0) lgkmcnt(0)" ::: "memory"); __builtin_amdgcn_s_barrier(); asm volatile("" ::: "memory");
        const bool bad = flag[0] != 0u;
        if (lane < 32) {
            const unsigned long long* slot = (const unsigned long long*)xbuf + (size_t)(u.pm * BM + row) * 4; float mt[4], m2[4]; float ms = 0.f;
#pragma unroll
            for (int t = 0; t < 4; ++t) { if (t < ntn) { const unsigned long long w = __hip_atomic_load(slot + t, __ATOMIC_RELAXED, __HIP_MEMORY_SCOPE_AGENT); mt[t] = __uint_as_float((unsigned)w); m2[t] = __uint_as_float((unsigned)(w >> 32)); } else { mt[t] = 0.f; m2[t] = 0.f; } ms += mt[t]; }
            const float mean = ms / (float)ntn; float q = 0.f;
#pragma unroll
            for (int t = 0; t < 4; ++t) if (t < ntn) { const float dm = mt[t] - mean; q += m2[t] + 256.0f * dm * dm; }
            S[row] = (f32x2v){mean, 1.0f / sqrtf(q / (256.0f * (float)ntn) + eps)};
        }
        asm volatile("s_waitcnt lgkmcnt(0)" ::: "memory"); __builtin_amdgcn_s_barrier(); asm volatile("" ::: "memory");
        return bad;
    }
};
struct EpiLnRes {
    static constexpr bool PERM = false, AFTER_DRAIN = true;
    const float* base; float* out; int ldc; const float* bias; PanelStats st; unsigned poison;
    __device__ __forceinline__ void refuse(size_t i0, size_t stride, int M, int N) const { const float q = __builtin_nanf(""); for (size_t i = i0; i < (size_t)M * N; i += stride) out[(i / N) * ldc + i % N] = q;
        if (i0 == 0) { unsigned expect = 0u; __hip_atomic_compare_exchange_strong(st.tmo + 1, &expect, 0x7f0u, __ATOMIC_RELAXED, __ATOMIC_RELAXED, __HIP_MEMORY_SCOPE_AGENT); __hip_atomic_store(st.tmo, 1u, __ATOMIC_RELAXED, __HIP_MEMORY_SCOPE_AGENT); } }
    __device__ __forceinline__ void fused(f32x4 (&acc)[2][2][4][2], const Unit& u, int wr, int wc, int fr, int fq, PG8_LAS unsigned char* lds, int wid, int lane) const {
        typedef float f32x2v __attribute__((ext_vector_type(2)));
        const PG8_LAS f32x2v* S = (const PG8_LAS f32x2v*)(lds + 8192);
        const int col0 = u.pn * BM + wc * 32 + 4 * fq;
#pragma unroll
        for (int bj = 0; bj < 2; ++bj)
#pragma unroll
            for (int n = 0; n < 2; ++n) { const f32x4 bv = bias ? *(const f32x4*)(bias + col0 + bj * HALF + n * 16) : (f32x4){0.f, 0.f, 0.f, 0.f};
#pragma unroll
                for (int ai = 0; ai < 2; ++ai)
#pragma unroll
                    for (int m = 0; m < 4; ++m) acc[ai][bj][m][n] += bv; }
        const bool bad = st.run(acc, u, wr, wc, fr, fq, lds, wid, lane) || poison != 0u;
        const float qnan = __builtin_nanf("");
#pragma unroll
        for (int ai = 0; ai < 2; ++ai)
#pragma unroll
            for (int m = 0; m < 4; ++m) { const int r = ai * HALF + wr * 64 + m * 16 + fr; const f32x2v sr = S[r]; const size_t off = (size_t)(u.pm * BM + r) * ldc + col0;
#pragma unroll
                for (int bj = 0; bj < 2; ++bj)
#pragma unroll
                    for (int n = 0; n < 2; ++n) { const f32x4 bs = *(const f32x4*)(base + off + bj * HALF + n * 16); f32x4 o = bs + (acc[ai][bj][m][n] - sr.x) * sr.y;
                        if (bad) o = (f32x4){qnan, qnan, qnan, qnan}; *(f32x4*)(out + off + bj * HALF + n * 16) = o; }
                asm volatile("" ::: "memory"); }
    }
};
struct EpiLnResLn {
    static constexpr bool PERM = false, AFTER_DRAIN = true;
    const float* base; float* out; bf16_t* xn; int ldc; const float* bias; PanelStats st1, st2; unsigned poison;
    __device__ __forceinline__ void refuse(size_t i0, size_t stride, int M, int N) const { const float q = __builtin_nanf(""); for (size_t i = i0; i < (size_t)M * N; i += stride) { const size_t o = (i / N) * ldc + i % N; out[o] = q; xn[o] = (bf16_t)0x7fc0u; }
        if (i0 == 0) { unsigned expect = 0u; __hip_atomic_compare_exchange_strong(st1.tmo + 1, &expect, 0x7f0u, __ATOMIC_RELAXED, __ATOMIC_RELAXED, __HIP_MEMORY_SCOPE_AGENT); __hip_atomic_store(st1.tmo, 1u, __ATOMIC_RELAXED, __HIP_MEMORY_SCOPE_AGENT); } }
    __device__ __forceinline__ void fused(f32x4 (&acc)[2][2][4][2], const Unit& u, int wr, int wc, int fr, int fq, PG8_LAS unsigned char* lds, int wid, int lane) const {
        typedef float f32x2v __attribute__((ext_vector_type(2))); typedef unsigned u32x2v __attribute__((ext_vector_type(2)));
        const PG8_LAS f32x2v* S = (const PG8_LAS f32x2v*)(lds + 8192);
        const int col0 = u.pn * BM + wc * 32 + 4 * fq;
#pragma unroll
        for (int bj = 0; bj < 2; ++bj)
#pragma unroll
            for (int n = 0; n < 2; ++n) { const f32x4 bv = bias ? *(const f32x4*)(bias + col0 + bj * HALF + n * 16) : (f32x4){0.f, 0.f, 0.f, 0.f};
#pragma unroll
                for (int ai = 0; ai < 2; ++ai)
#pragma unroll
                    for (int m = 0; m < 4; ++m) acc[ai][bj][m][n] += bv; }
        bool bad = st1.run(acc, u, wr, wc, fr, fq, lds, wid, lane) || poison != 0u;
        const float qnan = __builtin_nanf("");
#pragma unroll
        for (int ai = 0; ai < 2; ++ai)
#pragma unroll
            for (int m = 0; m < 4; ++m) { const int r = ai * HALF + wr * 64 + m * 16 + fr; const f32x2v sr = S[r]; const size_t off = (size_t)(u.pm * BM + r) * ldc + col0;
#pragma unroll
                for (int bj = 0; bj < 2; ++bj)
#pragma unroll
                    for (int n = 0; n < 2; ++n) { const f32x4 bs = *(const f32x4*)(base + off + bj * HALF + n * 16); acc[ai][bj][m][n] = bs + (acc[ai][bj][m][n] - sr.x) * sr.y; }
                asm volatile("" : "+v"(acc[ai][0][m][0]), "+v"(acc[ai][0][m][1]), "+v"(acc[ai][1][m][0]), "+v"(acc[ai][1][m][1]));
                if (m & 1) asm volatile("" ::: "memory"); }
        const bool bad1 = bad;
        bad = st2.run(acc, u, wr, wc, fr, fq, lds, wid, lane) || bad;
#pragma unroll
        for (int ai = 0; ai < 2; ++ai)
#pragma unroll
            for (int m = 0; m < 4; ++m) { const int r = ai * HALF + wr * 64 + m * 16 + fr; const f32x2v sr = S[r]; const size_t off = (size_t)(u.pm * BM + r) * ldc + col0;
#pragma unroll
                for (int bj = 0; bj < 2; ++bj)
#pragma unroll
                    for (int n = 0; n < 2; ++n) { const f32x4 x1 = acc[ai][bj][m][n]; *(f32x4*)(out + off + bj * HALF + n * 16) = bad1 ? (f32x4){qnan, qnan, qnan, qnan} : x1;
                        const f32x4 o = (x1 - sr.x) * sr.y; u32x2v w; w.x = cvt_pk_bf16(o[0], o[1]); w.y = cvt_pk_bf16(o[2], o[3]);
                        if (bad) { w.x = 0x7fc07fc0u; w.y = 0x7fc07fc0u; } *(u32x2v*)(xn + off + bj * HALF + n * 16) = w; }
                asm volatile("" ::: "memory"); }
    }
};

template <class Epi, class Sched, bool STAMP = false>
__device__ __forceinline__ void gemm_phase(PG8_LAS unsigned char* lds, const Gemm g, const Sched& S, const Epi& E, unsigned long long* stamps) {
    const int tid = threadIdx.x, wid = __builtin_amdgcn_readfirstlane(tid >> 6), lane = tid & 63, wr = wid >> 2, wc = wid & 3, fr = lane & 15, fq = lane >> 4;
    const int K = g.K, nt = K / BK;
    int ts_lo = 0, ts_hi = 0, nts = 0; const unsigned long long rt_entry = STAMP ? (unsigned long long)wall_clock64() : 0ull;
#define PG8_STAMP() do { if (STAMP && wid == 0 && nts < 64) { const unsigned long long _c = (unsigned long long)clock64(); \
        ts_lo = (lane == nts) ? (int)(unsigned)_c : ts_lo; ts_hi = (lane == nts) ? (int)(unsigned)(_c >> 32) : ts_hi; ++nts; } } while (0)
    PG8_STAMP();
    unsigned voffA[2], voffB[2];
#pragma unroll
    for (int i = 0; i < 2; ++i) { int R, C; stage_rc(tid * 16 + i * 8192, R, C); const int Rb = Epi::PERM ? ((R & ~31) + perm32(R & 31)) : R;
        voffA[i] = (unsigned)(R * K + C) * 2u; voffB[i] = (unsigned)(Rb * K + C) * 2u; }
    const size_t kstep = (size_t)(BK * 2);
    const size_t hstep = (size_t)HALF * K * 2;
    const size_t tstep = 2 * hstep;
    const unsigned ldsw = (unsigned)wid * 1024u;
    const int aoff = lds_byte(wr * 64 + fr, fq * 8), boff = lds_byte(wc * 32 + fr, fq * 8);
#define PG8_SA(b, h) (((b) * 2 + (h)) * HTB)
#define PG8_SB(b, h) ((4 + (b) * 2 + (h)) * HTB)
#define PG8_STAGE(bufoff, gbase, voff) do { _Pragma("unroll") for (int _i = 0; _i < 2; ++_i) \
        __builtin_amdgcn_global_load_lds((const unsigned*)((const char*)(gbase) + (voff)[_i]), (PG8_LAS unsigned*)(lds + (bufoff) + ldsw + _i * 8192), 16, 0, 0); } while (0)
#define PG8_LDA(dst, b, h) do { _Pragma("unroll") for (int m = 0; m < 4; ++m) _Pragma("unroll") for (int k = 0; k < 2; ++k) dst[m][k] = *(const PG8_LAS bf16x8*)(lds + PG8_SA(b, h) + aoff + m * 2048 + k * 1024); } while (0)
#define PG8_LDB(dst, b, h) do { _Pragma("unroll") for (int n = 0; n < 2; ++n) _Pragma("unroll") for (int k = 0; k < 2; ++k) dst[n][k] = *(const PG8_LAS bf16x8*)(lds + PG8_SB(b, h) + boff + n * 2048 + k * 1024); } while (0)
#define PG8_MMA(ai, bj, At, Bt) do { __builtin_amdgcn_s_setprio(1); _Pragma("unroll") for (int m = 0; m < 4; ++m) _Pragma("unroll") for (int n = 0; n < 2; ++n) _Pragma("unroll") for (int k = 0; k < 2; ++k) \
        acc[ai][bj][m][n] = __builtin_amdgcn_mfma_f32_16x16x32_bf16(Bt[n][k], At[m][k], acc[ai][bj][m][n], 0, 0, 0); __builtin_amdgcn_s_setprio(0); } while (0)
#define PG8_WAIT_V(n) asm volatile("s_waitcnt vmcnt(" #n ")" ::: "memory")
#define PG8_WAIT_L(n) asm volatile("s_waitcnt lgkmcnt(" #n ")" ::: "memory")
#define PG8_BAR __builtin_amdgcn_s_barrier()
#define PG8_SCHED __builtin_amdgcn_sched_barrier(0)
    Unit cur, nxt; int ui = 0;
    if (!S.next(0, cur)) return;
    f32x4 acc[2][2][4][2];
#pragma unroll
    for (int a = 0; a < 2; ++a)
#pragma unroll
        for (int b = 0; b < 2; ++b)
#pragma unroll
            for (int m = 0; m < 4; ++m)
#pragma unroll
                for (int n = 0; n < 2; ++n) acc[a][b][m][n] = (f32x4){0.f, 0.f, 0.f, 0.f};
    bf16x8 At[4][2], B0[2][2], B1[2][2];
    const char* cA = (const char*)g.A + (size_t)cur.pm * tstep; const char* cB = (const char*)g.Bt + (size_t)cur.pn * tstep;
    S.a_ready(cur);
    PG8_STAGE(PG8_SB(0, 0), cB, voffB); PG8_STAGE(PG8_SA(0, 0), cA, voffA); PG8_STAGE(PG8_SB(0, 1), cB + hstep, voffB); PG8_STAGE(PG8_SA(0, 1), cA + hstep, voffA);
    if (wr == 1) PG8_BAR;
    PG8_WAIT_V(4); PG8_BAR;
    PG8_STAGE(PG8_SB(1, 0), cB + kstep, voffB); PG8_STAGE(PG8_SA(1, 0), cA + kstep, voffA); PG8_STAGE(PG8_SB(1, 1), cB + hstep + kstep, voffB);
    PG8_WAIT_V(6); PG8_BAR;
    PG8_STAMP();
    for (;;) {
        const bool has_next = S.next(ui + 1, nxt);
        const char* nA = has_next ? (const char*)g.A + (size_t)nxt.pm * tstep : cA; const char* nB = has_next ? (const char*)g.Bt + (size_t)nxt.pn * tstep : cB;
        for (int t = 0; t < nt; t += 2) {
            const bool last = (t == nt - 2);
            const char* a1 = cA + (size_t)(t + 1) * kstep;
            const char* a2 = last ? nA : cA + (size_t)(t + 2) * kstep; const char* b2 = last ? nB : cB + (size_t)(t + 2) * kstep;
            const char* a3 = a2 + kstep; const char* b3 = b2 + kstep;
            if (last && has_next) S.a_ready(nxt);
            PG8_LDB(B0, 0, 0); PG8_SCHED; PG8_LDA(At, 0, 0); PG8_STAGE(PG8_SA(1, 1), a1 + hstep, voffA);
            PG8_WAIT_L(8); PG8_BAR; PG8_WAIT_L(0); PG8_MMA(0, 0, At, B0); PG8_BAR; PG8_SCHED;
            PG8_LDB(B1, 0, 1); PG8_STAGE(PG8_SB(0, 0), b2, voffB);
            PG8_BAR; PG8_WAIT_L(0); PG8_MMA(0, 1, At, B1); PG8_BAR;
            PG8_LDA(At, 0, 1); PG8_STAGE(PG8_SA(0, 0), a2, voffA);
            PG8_BAR; PG8_WAIT_L(0); PG8_MMA(1, 0, At, B0); PG8_BAR; PG8_SCHED;
            PG8_STAGE(PG8_SB(0, 1), b2 + hstep, voffB);
            PG8_WAIT_V(6); PG8_BAR; PG8_MMA(1, 1, At, B1); PG8_BAR;
            PG8_LDB(B0, 1, 0); PG8_SCHED; PG8_LDA(At, 1, 0); PG8_STAGE(PG8_SA(0, 1), a2 + hstep, voffA);
            PG8_WAIT_L(8); PG8_BAR; PG8_WAIT_L(0); PG8_MMA(0, 0, At, B0); PG8_BAR; PG8_SCHED;
            PG8_LDB(B1, 1, 1); PG8_STAGE(PG8_SB(1, 0), b3, voffB);
            PG8_BAR; PG8_WAIT_L(0); PG8_MMA(0, 1, At, B1); PG8_BAR;
            PG8_LDA(At, 1, 1); PG8_STAGE(PG8_SA(1, 0), a3, voffA);
            PG8_BAR; PG8_WAIT_L(0); PG8_MMA(1, 0, At, B0); PG8_BAR; PG8_SCHED;
            PG8_STAGE(PG8_SB(1, 1), b3 + hstep, voffB);
            PG8_WAIT_V(6); PG8_BAR; PG8_MMA(1, 1, At, B1); PG8_BAR;
        }
        PG8_STAMP();
        if constexpr (!Epi::AFTER_DRAIN) { E(acc, cur, wr, wc, fr, fq); S.done(cur); }
        PG8_STAMP();
        if (!has_next) break;
#pragma unroll
        for (int a = 0; a < 2; ++a)
#pragma unroll
            for (int b = 0; b < 2; ++b)
#pragma unroll
                for (int m = 0; m < 4; ++m)
#pragma unroll
                    for (int n = 0; n < 2; ++n) acc[a][b][m][n] = (f32x4){0.f, 0.f, 0.f, 0.f};
        cur = nxt; cA = nA; cB = nB; ++ui;
    }
    PG8_WAIT_V(0);
    if (wr == 0) PG8_BAR;
    PG8_BAR;
    if constexpr (Epi::AFTER_DRAIN) { E.fused(acc, cur, wr, wc, fr, fq, lds, wid, lane); S.done(cur); }
    PG8_STAMP();
    if (STAMP && wid == 0) { stamps[lane] = lane < nts ? (((unsigned long long)(unsigned)ts_hi << 32) | (unsigned)ts_lo) : 0ull;
        if (lane == 62) stamps[62] = rt_entry; if (lane == 63) stamps[63] = (unsigned long long)wall_clock64(); }
#undef PG8_STAMP
#undef PG8_SA
#undef PG8_SB
#undef PG8_STAGE
#undef PG8_LDA
#undef PG8_LDB
#undef PG8_MMA
#undef PG8_WAIT_V
#undef PG8_WAIT_L
#undef PG8_BAR
#undef PG8_SCHED
}
}
#define XB_TMO      128
#define XB_XCNT(j)  (256  + 64 * (j))
#define XB_XSUB(j)  (1280 + 64 * (j))
#define XB_XGEN(j)  (2304 + 64 * (j))
#define XB_TOP      3328
#define XB_TOPGEN   3392
#define XCD_BAR_WORDS 3456
#define XB_SPIN_CAP (1u << 18)
#define LAS __attribute__((address_space(3)))

__device__ __forceinline__ unsigned xb_ld(unsigned* p)              { return __hip_atomic_load(p, __ATOMIC_RELAXED, __HIP_MEMORY_SCOPE_AGENT); }
__device__ __forceinline__ unsigned xb_add(unsigned* p, unsigned v) { return __hip_atomic_fetch_add(p, v, __ATOMIC_RELAXED, __HIP_MEMORY_SCOPE_AGENT); }
__device__ __forceinline__ unsigned xb_xcc_id() { return (unsigned)__builtin_amdgcn_s_getreg((3 << 11) | 20) & 0xFu; }
#define XB_SPIN(cond, bar) do { unsigned _sp = 0; while (cond) { __builtin_amdgcn_s_sleep(1); \
    if ((++_sp & 255u) == 0u) { if (xb_ld(&(bar)[XB_TMO])) break; if (_sp > XB_SPIN_CAP) { atomicAdd(&(bar)[XB_TMO], 1u); break; } } } } while (0)

struct XcdBarrier {
    unsigned* bar; unsigned x;
    volatile LAS unsigned* st;
};

__device__ __forceinline__ XcdBarrier xcd_barrier_post(unsigned* bar, volatile LAS unsigned* st) {
    XcdBarrier b; b.bar = bar; b.x = xb_xcc_id(); b.st = st;
    if (threadIdx.x == 0) (void)xb_add(&bar[XB_XCNT(b.x)], 1u);
    return b;
}
__device__ __forceinline__ void xcd_barrier_complete(unsigned* bar, unsigned x, unsigned& nloc, unsigned& nx) {
    const unsigned G = gridDim.x * gridDim.y * gridDim.z;
    unsigned sum, cnt, mine, sp = 0u;
    for (;;) {
        sum = 0u; cnt = 0u; mine = 0u;
#pragma unroll
        for (unsigned j = 0; j < 16; ++j) { const unsigned c = xb_ld(&bar[XB_XCNT(j)]); sum += c; cnt += (c > 0u) ? 1u : 0u; mine = (j == x) ? c : mine; }
        if (sum == G) break;
        __builtin_amdgcn_s_sleep(1);
        if ((++sp & 255u) == 0u) { if (xb_ld(&bar[XB_TMO])) break; if (sp > XB_SPIN_CAP) { atomicAdd(&bar[XB_TMO], 1u); break; } }
    }
    nloc = mine > 0u ? mine : 1u; nx = cnt > 0u ? cnt : 1u;
}

__device__ __forceinline__ void xcd_barrier(const XcdBarrier& b) {
    asm volatile("s_waitcnt vmcnt(0)" ::: "memory");
    __syncthreads();
    if (threadIdx.x == 0) {
        unsigned* bar = b.bar;
        __builtin_amdgcn_s_waitcnt(0);
        unsigned nloc = b.st[0], nx = b.st[1];
        if (nloc == 0u) { xcd_barrier_complete(bar, b.x, nloc, nx); b.st[0] = nloc; b.st[1] = nx; }
        const unsigned old = xb_add(&bar[XB_XSUB(b.x)], 1u);
        const unsigned gen = old / nloc;
        if (old + 1u == (gen + 1u) * nloc) {
            __builtin_amdgcn_fence(__ATOMIC_RELEASE, "agent");
            asm volatile("s_waitcnt vmcnt(0)" ::: "memory");
            const unsigned og = xb_add(&bar[XB_TOP], 1u);
            const unsigned tg = og / nx;
            if (og + 1u == (tg + 1u) * nx) xb_add(&bar[XB_TOPGEN], 1u);
            else XB_SPIN(xb_ld(&bar[XB_TOPGEN]) == tg, bar);
            __builtin_amdgcn_fence(__ATOMIC_ACQUIRE, "agent");
            xb_add(&bar[XB_XGEN(b.x)], 1u);
            asm volatile("s_waitcnt vmcnt(0)" ::: "memory");
        } else {
            XB_SPIN(xb_ld(&bar[XB_XGEN(b.x)]) == gen, bar);
            __builtin_amdgcn_fence(__ATOMIC_ACQUIRE, "agent");
            asm volatile("s_waitcnt vmcnt(0)" ::: "memory");
        }
    }
    __syncthreads();
}


namespace mk {
typedef unsigned short bf16_t;
typedef float f32x4 __attribute__((ext_vector_type(4)));
constexpr int D = 2048, NTOK_P = 16384, NTOK_S = 256, NTOK = 16640;
constexpr int DIN = 5632, DATT = 1536, DLRU = 512, NH = 12, HD = 128;
constexpr int NEXP = 16384;
constexpr float ALPHA = 1.189207115002721f;
constexpr float LN_EPS = 1e-5f;
constexpr float ATT_SCALE = 0.08838834764831845f;
constexpr size_t O_YP = 0, O_YS = 33554432, O_KP = 34078720, O_VP = 59244544, O_CP = 84410368, O_HP = 84422656,
                 O_KS = 84426752, O_VS = 185090048, O_CS = 285753344, O_HS = 285802496, O_END = 285818880;
constexpr size_t WS_CTL = 0;
constexpr size_t WS_XB = 65536;
constexpr size_t WS_WINT = WS_XB + (size_t)NTOK * D * 2;
constexpr size_t WS_WOT = WS_WINT + (size_t)DIN * D * 2;
constexpr size_t WS_WQT = WS_WOT + (size_t)D * D * 2;
constexpr size_t WS_UB = WS_WQT + (size_t)D * D * 2;
constexpr size_t WS_VB = WS_UB + (size_t)NEXP * D * 2;
constexpr size_t WS_QF = WS_VB + (size_t)NEXP * D * 2;
constexpr size_t WS_XR = WS_QF + (size_t)NTOK * DATT * 4;
constexpr size_t WS_GATE = WS_XR + (size_t)NTOK * DLRU * 4;
constexpr size_t WS_AR = WS_GATE + (size_t)NTOK * DLRU * 4;
constexpr size_t WS_PRE1 = WS_AR + (size_t)NTOK * D * 2;
constexpr size_t WS_X1F = WS_PRE1 + (size_t)NTOK * D * 4;
constexpr size_t WS_X1B = WS_X1F + (size_t)NTOK * D * 4;
constexpr size_t WS_QP = WS_X1B + (size_t)NTOK * D * 2;
constexpr size_t WS_EIDX = WS_QP + (size_t)NTOK * D * 4;
constexpr size_t WS_GW = WS_EIDX + (size_t)NTOK * 128 * 4;
constexpr size_t WS_END = WS_GW + (size_t)NTOK * 128 * 4;

constexpr int NTHREADS = 512;
constexpr int LDS_BYTES = 147456;
constexpr int MISC_OFF = 131072;

struct Params {
    const float* x_prompt; const float* x_sample; const float* cache_k; const float* cache_v; const float* state_conv; const float* state_h;
    const float* w_in; const float* conv_w; const float* conv_b; const float* lru_w_a; const float* lru_b_a; const float* lru_w_x; const float* lru_b_x;
    const float* lru_lambda; const float* w_out; const float* ln1_g; const float* ln1_b; const float* w_query; const float* sub_keys;
    const float* peer_u; const float* peer_v; const float* ln2_g; const float* ln2_b;
    float* out; unsigned char* ws; int ph_lo, ph_hi;
};

__device__ __forceinline__ unsigned f2bf(float f) { unsigned u = __float_as_uint(f); u += 0x7fffu + ((u >> 16) & 1u); return u >> 16; }
__device__ __forceinline__ unsigned pack2(float a, float b) { return f2bf(a) | (f2bf(b) << 16); }
__device__ __forceinline__ float bflo(unsigned w) { return __uint_as_float(w << 16); }
__device__ __forceinline__ float bfhi(unsigned w) { return __uint_as_float(w & 0xffff0000u); }
__device__ __forceinline__ float wave_sum(float v) {
#pragma unroll
    for (int o = 32; o >= 1; o >>= 1) v += __shfl_xor(v, o);
    return v;
}
__device__ __forceinline__ float wave_max(float v) {
#pragma unroll
    for (int o = 32; o >= 1; o >>= 1) v = fmaxf(v, __shfl_xor(v, o));
    return v;
}
__device__ __forceinline__ float gelu_exact(float v) { return 0.5f * v * (1.0f + erff(v * 0.7071067811865476f)); }
__device__ __forceinline__ float sigmoidf(float v) { return 1.0f / (1.0f + expf(-v)); }
__device__ __forceinline__ float readlane_f(float v, int l) { return __int_as_float(__builtin_amdgcn_readlane(__float_as_int(v), l)); }

__device__ __forceinline__ void convert_flat(const float* src, bf16_t* dst, size_t n8, size_t gtid, size_t gstride) {
    for (size_t i = gtid; i < n8; i += gstride) {
        const float4 a = ((const float4*)src)[2 * i], b = ((const float4*)src)[2 * i + 1];
        uint4 w; w.x = pack2(a.x, a.y); w.y = pack2(a.z, a.w); w.z = pack2(b.x, b.y); w.w = pack2(b.z, b.w);
        ((uint4*)dst)[i] = w;
    }
}
__device__ __forceinline__ void transpose_convert(const float* src, bf16_t* dst, int K, int N, LAS float* tile) {
    const int tid = threadIdx.x, ntn = N / 64, ntiles = (K / 64) * ntn;
    for (int tl = blockIdx.x; tl < ntiles; tl += gridDim.x) {
        const int kt = tl / ntn, nt = tl - kt * ntn;
#pragma unroll
        for (int i = 0; i < 8; ++i) { const int r = (tid >> 6) + 8 * i, c = tid & 63; tile[r * 65 + c] = src[(size_t)(kt * 64 + r) * N + nt * 64 + c]; }
        __syncthreads();
#pragma unroll
        for (int i = 0; i < 4; ++i) { const int n = (tid >> 5) + 16 * i, k0 = 2 * (tid & 31);
            const unsigned v = pack2(tile[k0 * 65 + n], tile[(k0 + 1) * 65 + n]);
            *(unsigned*)(dst + (size_t)(nt * 64 + n) * K + kt * 64 + k0) = v; }
        __syncthreads();
    }
}
__device__ __forceinline__ void phase_prologue(const Params& P, LAS unsigned char* lds) {
    const size_t gtid = (size_t)blockIdx.x * NTHREADS + threadIdx.x, gstride = (size_t)gridDim.x * NTHREADS;
    unsigned char* ws = P.ws;
    convert_flat(P.x_prompt, (bf16_t*)(ws + WS_XB), (size_t)NTOK_P * D / 8, gtid, gstride);
    convert_flat(P.x_sample, (bf16_t*)(ws + WS_XB) + (size_t)NTOK_P * D, (size_t)NTOK_S * D / 8, gtid, gstride);
    convert_flat(P.peer_u, (bf16_t*)(ws + WS_UB), (size_t)NEXP * D / 8, gtid, gstride);
    convert_flat(P.peer_v, (bf16_t*)(ws + WS_VB), (size_t)NEXP * D / 8, gtid, gstride);
    transpose_convert(P.w_in, (bf16_t*)(ws + WS_WINT), D, DIN, (LAS float*)lds);
    transpose_convert(P.w_out, (bf16_t*)(ws + WS_WOT), D, D, (LAS float*)lds);
    transpose_convert(P.w_query, (bf16_t*)(ws + WS_WQT), D, D, (LAS float*)lds);
    const size_t n4b = (size_t)2040 * DATT / 4, tot = 32 * n4b;
    for (size_t i = gtid; i < 2 * tot; i += gstride) {
        const int tz = i >= tot; const size_t j = i - (tz ? tot : 0); const size_t b = j / n4b, r = j - b * n4b;
        const float4* src = (const float4*)(tz ? P.cache_v : P.cache_k) + (b * 2048 + 8) * (DATT / 4) + r;
        float4* dst = (float4*)(P.out + (tz ? O_VS : O_KS)) + b * 2048 * (DATT / 4) + r;
        *dst = *src;
    }
}

struct EpiProj {
    static constexpr bool PERM = false, AFTER_DRAIN = false;
    float* out; float* QF; float* XR; float* GATE;
    __device__ __forceinline__ void operator()(const f32x4 (&acc)[2][2][4][2], const pg8::Unit& u, int wr, int wc, int fr, int fq) const {
        const int pn = u.pn; const int coff = wc * 32 + 4 * fq;
#pragma unroll
        for (int ai = 0; ai < 2; ++ai)
#pragma unroll
            for (int m = 0; m < 4; ++m) {
                const int row = u.pm * 256 + ai * 128 + wr * 64 + m * 16 + fr;
                float* rowp;
                if (pn < 6) rowp = QF + (size_t)row * DATT + pn * 256;
                else if (pn < 18) {
                    const int isv = pn >= 12; const int c0 = (pn - (isv ? 12 : 6)) * 256;
                    if (row < NTOK_P) rowp = out + (isv ? O_VP : O_KP) + (size_t)row * DATT + c0;
                    else { const int rr = row - NTOK_P, b = rr >> 3, t = rr & 7; rowp = out + (isv ? O_VS : O_KS) + ((size_t)b * 2048 + 2040 + t) * DATT + c0; }
                } else if (pn < 20) rowp = XR + (size_t)row * DLRU + (pn - 18) * 256;
                else rowp = GATE + (size_t)row * DLRU + (pn - 20) * 256;
#pragma unroll
                for (int bj = 0; bj < 2; ++bj)
#pragma unroll
                    for (int n = 0; n < 2; ++n) *(f32x4*)(rowp + coff + bj * 128 + n * 16) = acc[ai][bj][m][n];
            }
    }
};
struct EpiOut {
    static constexpr bool PERM = false, AFTER_DRAIN = false;
    const float* xp; const float* xs; float* pre;
    __device__ __forceinline__ void operator()(const f32x4 (&acc)[2][2][4][2], const pg8::Unit& u, int wr, int wc, int fr, int fq) const {
        const int col0 = u.pn * 256 + wc * 32 + 4 * fq;
#pragma unroll
        for (int ai = 0; ai < 2; ++ai)
#pragma unroll
            for (int m = 0; m < 4; ++m) {
                const int row = u.pm * 256 + ai * 128 + wr * 64 + m * 16 + fr;
                const float* xr = (row < NTOK_P ? xp + (size_t)row * D : xs + (size_t)(row - NTOK_P) * D) + col0;
                float* pr = pre + (size_t)row * D + col0;
#pragma unroll
                for (int bj = 0; bj < 2; ++bj)
#pragma unroll
                    for (int n = 0; n < 2; ++n) { const f32x4 xv = *(const f32x4*)(xr + bj * 128 + n * 16); *(f32x4*)(pr + bj * 128 + n * 16) = xv * ALPHA + acc[ai][bj][m][n]; }
            }
    }
};
struct EpiPlain {
    static constexpr bool PERM = false, AFTER_DRAIN = false;
    float* C; int ldc;
    __device__ __forceinline__ void operator()(const f32x4 (&acc)[2][2][4][2], const pg8::Unit& u, int wr, int wc, int fr, int fq) const {
        const int col0 = u.pn * 256 + wc * 32 + 4 * fq;
#pragma unroll
        for (int ai = 0; ai < 2; ++ai)
#pragma unroll
            for (int m = 0; m < 4; ++m) {
                const int row = u.pm * 256 + ai * 128 + wr * 64 + m * 16 + fr;
                float* pr = C + (size_t)row * ldc + col0;
#pragma unroll
                for (int bj = 0; bj < 2; ++bj)
#pragma unroll
                    for (int n = 0; n < 2; ++n) *(f32x4*)(pr + bj * 128 + n * 16) = acc[ai][bj][m][n];
            }
    }
};

__device__ __forceinline__ const float* kv_row(const Params& P, bool isv, bool samp, int b, int pos, int h) {
    if (!samp) return P.out + (isv ? O_VP : O_KP) + ((size_t)(b * 2048 + pos) * DATT + h * HD);
    if (pos < 2048) return (isv ? P.cache_v : P.cache_k) + ((size_t)(b * 2048 + pos) * DATT + h * HD);
    return P.out + (isv ? O_VS : O_KS) + ((size_t)(b * 2048 + 2040 + (pos - 2048)) * DATT + h * HD);
}
__device__ __forceinline__ void attn_simple_unit(const Params& P, int row, int h, LAS float* wl, int lane) {
    const bool samp = row >= NTOK_P; int b, t;
    if (!samp) { b = row >> 11; t = row & 2047; } else { b = (row - NTOK_P) >> 3; t = (row - NTOK_P) & 7; }
    const float* qrow = (const float*)(P.ws + WS_QF) + (size_t)row * DATT + h * HD;
    wl[lane] = qrow[lane]; wl[64 + lane] = qrow[64 + lane];
    __builtin_amdgcn_wave_barrier();
    const float slope = exp2f(-8.0f * (float)(h + 1) / 12.0f);
    const int base = samp ? 2048 : 0;
    float sc[7]; float mx = -INFINITY;
#pragma unroll
    for (int r = 0; r < 7; ++r) {
        const int idx = r * 64 + lane; float s = -INFINITY;
        if (idx < 387) {
            const int pz = idx / 129, d = idx - pz * 129, dil = 1 << (2 * pz), pos = base + t - dil * d;
            if (pos >= 0) {
                const float4* kr = (const float4*)kv_row(P, false, samp, b, pos, h); float a = 0.f;
#pragma unroll 8
                for (int e4 = 0; e4 < 32; ++e4) { const float4 kv = kr[e4]; const f32x4 qv = ((LAS f32x4*)wl)[e4]; a += kv.x * qv.x + kv.y * qv.y + kv.z * qv.z + kv.w * qv.w; }
                s = a * ATT_SCALE - slope * (float)(dil * d);
            }
        }
        sc[r] = s; mx = fmaxf(mx, s);
    }
    mx = wave_max(mx);
    float l = 0.f;
#pragma unroll
    for (int r = 0; r < 7; ++r) { const float p = (sc[r] == -INFINITY) ? 0.f : expf(sc[r] - mx); wl[128 + r * 64 + lane] = p; l += p; }
    l = wave_sum(l);
    __builtin_amdgcn_wave_barrier();
    float o0 = 0.f, o1 = 0.f;
    for (int idx = 0; idx < 387; ++idx) {
        const float p = wl[128 + idx];
        if (p != 0.f) {
            const int pz = idx / 129, d = idx - pz * 129, dil = 1 << (2 * pz), pos = base + t - dil * d;
            const float2 vv = ((const float2*)kv_row(P, true, samp, b, pos, h))[lane];
            o0 += p * vv.x; o1 += p * vv.y;
        }
    }
    const float inv = 1.0f / l;
    bf16_t* ar = (bf16_t*)(P.ws + WS_AR) + (size_t)row * D + h * HD;
    *(unsigned*)(ar + 2 * lane) = pack2(o0 * inv, o1 * inv);
    __builtin_amdgcn_wave_barrier();
}

__device__ __forceinline__ void lru_simple_unit(const Params& P, int s, int n, int lane) {
    const bool samp = s >= 8; const int b = samp ? s - 8 : s; const int T = samp ? 8 : 2048; const int row0 = samp ? NTOK_P + b * 8 : b * 2048;
    const int ch = n * 64 + lane;
    float wa[64], wx[64];
#pragma unroll
    for (int c = 0; c < 64; ++c) { wa[c] = P.lru_w_a[(n * 64 + c) * 64 + lane]; wx[c] = P.lru_w_x[(n * 64 + c) * 64 + lane]; }
    const float ba = P.lru_b_a[ch], bx = P.lru_b_x[ch], lam = P.lru_lambda[ch];
    const float sp = log1pf(expf(-lam));
    const float cw0 = P.conv_w[ch], cw1 = P.conv_w[512 + ch], cw2 = P.conv_w[1024 + ch], cw3 = P.conv_w[1536 + ch], cb = P.conv_b[ch];
    float x0 = 0.f, x1 = 0.f, x2 = 0.f, h = 0.f;
    if (samp) { x0 = P.state_conv[(b * 3 + 0) * 512 + ch]; x1 = P.state_conv[(b * 3 + 1) * 512 + ch]; x2 = P.state_conv[(b * 3 + 2) * 512 + ch]; h = P.state_h[b * 512 + ch]; }
    const float* XR = (const float*)(P.ws + WS_XR); const float* GT = (const float*)(P.ws + WS_GATE);
    bf16_t* AR = (bf16_t*)(P.ws + WS_AR);
    for (int t0 = 0; t0 < T; t0 += 8) {
        float xin[8], gt[8];
#pragma unroll
        for (int i = 0; i < 8; ++i) { xin[i] = XR[(size_t)(row0 + t0 + i) * DLRU + ch]; gt[i] = GT[(size_t)(row0 + t0 + i) * DLRU + ch]; }
#pragma unroll
        for (int i = 0; i < 8; ++i) {
            const float xc = ((x0 * cw0 + x1 * cw1) + x2 * cw2) + xin[i] * cw3 + cb;
            x0 = x1; x1 = x2; x2 = xin[i];
            float ra = 0.f, ri = 0.f;
#pragma unroll
            for (int c = 0; c < 64; ++c) { const float xcc = readlane_f(xc, c); ra += xcc * wa[c]; ri += xcc * wx[c]; if ((c & 15) == 15) __builtin_amdgcn_sched_barrier(0); }
            const float r = sigmoidf(ra + ba), ig = sigmoidf(ri + bx);
            const float log_a = -8.0f * r * sp; const float a = expf(log_a);
            const float u = sqrtf(-expm1f(2.0f * log_a)) * (ig * xc);
            h = a * h + u;
            const float rec = h * gelu_exact(gt[i]);
            AR[(size_t)(row0 + t0 + i) * D + DATT + ch] = (bf16_t)f2bf(rec);
        }
    }
    P.out[(samp ? O_HS : O_HP) + (size_t)b * 512 + ch] = h;
    float* co = P.out + (samp ? O_CS : O_CP) + (size_t)b * 3 * 512 + ch;
    co[0] = x0; co[512] = x1; co[1024] = x2;
}

__device__ __forceinline__ void phase_mixers(const Params& P, LAS unsigned char* lds) {
    const int lane = threadIdx.x & 63, wave = __builtin_amdgcn_readfirstlane(threadIdx.x >> 6);
    LAS float* wl = (LAS float*)lds + wave * 576;
    if (wave == 0) { for (int u = blockIdx.x; u < 64; u += gridDim.x) lru_simple_unit(P, u >> 3, u & 7, lane); }
    if (wave == 1) { for (int u = blockIdx.x; u < 256; u += gridDim.x) lru_simple_unit(P, 8 + (u >> 3), u & 7, lane); }
    const int nunits = NTOK * NH;
    for (int u = blockIdx.x * 8 + wave; u < nunits; u += gridDim.x * 8) attn_simple_unit(P, u / NH, u % NH, wl, lane);
}

__device__ __forceinline__ void phase_ln1(const Params& P) {
    const int lane = threadIdx.x & 63, wave = threadIdx.x >> 6;
    const float* pre = (const float*)(P.ws + WS_PRE1); float* x1f = (float*)(P.ws + WS_X1F); bf16_t* x1b = (bf16_t*)(P.ws + WS_X1B);
    for (int row = blockIdx.x * 8 + wave; row < NTOK; row += gridDim.x * 8) {
        float4 v[8]; float s = 0.f;
#pragma unroll
        for (int j = 0; j < 8; ++j) { v[j] = *(const float4*)(pre + (size_t)row * D + j * 256 + lane * 4); s += (v[j].x + v[j].y) + (v[j].z + v[j].w); }
        const float mean = wave_sum(s) * (1.0f / D); float q = 0.f;
#pragma unroll
        for (int j = 0; j < 8; ++j) { const float a = v[j].x - mean, b = v[j].y - mean, c = v[j].z - mean, d = v[j].w - mean; q += (a * a + b * b) + (c * c + d * d); }
        const float rstd = rsqrtf(wave_sum(q) * (1.0f / D) + LN_EPS);
#pragma unroll
        for (int j = 0; j < 8; ++j) { const int col = j * 256 + lane * 4; const float4 g = *(const float4*)(P.ln1_g + col), bb = *(const float4*)(P.ln1_b + col);
            float4 o; o.x = (v[j].x - mean) * rstd * g.x + bb.x; o.y = (v[j].y - mean) * rstd * g.y + bb.y; o.z = (v[j].z - mean) * rstd * g.z + bb.z; o.w = (v[j].w - mean) * rstd * g.w + bb.w;
            *(float4*)(x1f + (size_t)row * D + col) = o;
            uint2 w; w.x = pack2(o.x, o.y); w.y = pack2(o.z, o.w); *(uint2*)(x1b + (size_t)row * D + col) = w; }
    }
}

__device__ __forceinline__ int mono(float v) { const int b = __float_as_int(v); return b ^ ((b >> 31) & 0x7fffffff); }
__device__ __forceinline__ float unmono(int k) { return __int_as_float(k ^ ((k >> 31) & 0x7fffffff)); }
#define MK_INSERT16(L, X) do { int _x = (X); _Pragma("unroll") for (int _j = 0; _j < 16; ++_j) { const int _hi = max(L[_j], _x); _x = min(L[_j], _x); L[_j] = _hi; } } while (0)

__device__ __forceinline__ void phase_route(const Params& P, LAS unsigned char* lds) {
    const int lane = threadIdx.x & 63, wave = __builtin_amdgcn_readfirstlane(threadIdx.x >> 6);
    LAS float* ql = (LAS float*)(lds + wave * 17408);
    LAS float* sl = ql + 2048;
    LAS int* kl = (LAS int*)(sl + 2048);
    const float* QP = (const float*)(P.ws + WS_QP);
    int* EIDX = (int*)(P.ws + WS_EIDX); float* GW = (float*)(P.ws + WS_GW);
    for (int row = blockIdx.x * 8 + wave; row < NTOK; row += gridDim.x * 8) {
#pragma unroll
        for (int j = 0; j < 8; ++j) ((LAS f32x4*)ql)[j * 64 + lane] = *(const f32x4*)(QP + (size_t)row * D + (j * 64 + lane) * 4);
        __builtin_amdgcn_wave_barrier();
#pragma unroll 1
        for (int hp = 0; hp < 16; ++hp) {
            const float4* k0 = (const float4*)(P.sub_keys + (size_t)(hp * 128 + lane) * 128); const float4* k1 = k0 + 64 * 32;
            float a0 = 0.f, a1 = 0.f;
#pragma unroll 4
            for (int e4 = 0; e4 < 32; ++e4) { const f32x4 qv = ((LAS f32x4*)ql)[hp * 32 + e4]; const float4 u0 = k0[e4], u1 = k1[e4];
                a0 += qv.x * u0.x + qv.y * u0.y + qv.z * u0.z + qv.w * u0.w; a1 += qv.x * u1.x + qv.y * u1.y + qv.z * u1.z + qv.w * u1.w; }
            sl[hp * 128 + lane] = a0; sl[hp * 128 + 64 + lane] = a1;
        }
        __builtin_amdgcn_wave_barrier();
        if (lane < 16) {
            int L[16];
#pragma unroll
            for (int j = 0; j < 16; ++j) L[j] = (int)0x80000000;
#pragma unroll 1
            for (int k = 0; k < 128; ++k) { const int key = (mono(sl[lane * 128 + k]) & ~127) | k; MK_INSERT16(L, key); }
#pragma unroll
            for (int j = 0; j < 16; ++j) kl[lane * 16 + j] = L[j];
        }
        __builtin_amdgcn_wave_barrier();
        if (lane < 8) {
            const int h = lane; int L[16];
#pragma unroll
            for (int j = 0; j < 16; ++j) L[j] = (int)0x80000000;
#pragma unroll 1
            for (int a = 0; a < 16; ++a) { const float va = unmono(kl[(2 * h) * 16 + a] & ~127);
#pragma unroll 1
                for (int b = 0; b < 16; ++b) { const float vb = unmono(kl[(2 * h + 1) * 16 + b] & ~127); const int key = (mono(va + vb) & ~255) | (a << 4) | b; MK_INSERT16(L, key); } }
            float e[16]; float sum = 0.f; const float mx = unmono(L[0] & ~255);
#pragma unroll
            for (int j = 0; j < 16; ++j) { e[j] = expf(unmono(L[j] & ~255) - mx); sum += e[j]; }
            const float inv = 1.0f / sum;
#pragma unroll
            for (int j = 0; j < 16; ++j) { const int a = (L[j] >> 4) & 15, b = L[j] & 15;
                const int i0 = kl[(2 * h) * 16 + a] & 127, i1 = kl[(2 * h + 1) * 16 + b] & 127;
                EIDX[(size_t)row * 128 + h * 16 + j] = i0 * 128 + i1; GW[(size_t)row * 128 + h * 16 + j] = e[j] * inv; }
        }
        __builtin_amdgcn_wave_barrier();
    }
}

__device__ __forceinline__ void phase_experts(const Params& P) {
    const int lane = threadIdx.x & 63, wave = threadIdx.x >> 6;
    const float* x1f = (const float*)(P.ws + WS_X1F);
    const int* EIDX = (const int*)(P.ws + WS_EIDX); const float* GW = (const float*)(P.ws + WS_GW);
    const bf16_t* UB = (const bf16_t*)(P.ws + WS_UB); const bf16_t* VB = (const bf16_t*)(P.ws + WS_VB);
    for (int row = blockIdx.x * 8 + wave; row < NTOK; row += gridDim.x * 8) {
        float x[32], acc[32];
#pragma unroll
        for (int j = 0; j < 4; ++j) { const float4 a = *(const float4*)(x1f + (size_t)row * D + j * 512 + lane * 8), b = *(const float4*)(x1f + (size_t)row * D + j * 512 + lane * 8 + 4);
            x[j * 8 + 0] = a.x; x[j * 8 + 1] = a.y; x[j * 8 + 2] = a.z; x[j * 8 + 3] = a.w; x[j * 8 + 4] = b.x; x[j * 8 + 5] = b.y; x[j * 8 + 6] = b.z; x[j * 8 + 7] = b.w; }
#pragma unroll
        for (int i = 0; i < 32; ++i) acc[i] = 0.f;
        const int e_lo = EIDX[(size_t)row * 128 + lane], e_hi = EIDX[(size_t)row * 128 + 64 + lane];
        const float g_lo = GW[(size_t)row * 128 + lane], g_hi = GW[(size_t)row * 128 + 64 + lane];
        for (int k = 0; k < 128; ++k) {
            const int e = __builtin_amdgcn_readlane(k < 64 ? e_lo : e_hi, k & 63);
            const float g = readlane_f(k < 64 ? g_lo : g_hi, k & 63);
            const uint4* ur = (const uint4*)(UB + (size_t)e * D); const uint4* vr = (const uint4*)(VB + (size_t)e * D);
            uint4 uu[4], vv[4];
#pragma unroll
            for (int j = 0; j < 4; ++j) { uu[j] = ur[j * 64 + lane]; vv[j] = vr[j * 64 + lane]; }
            float d = 0.f;
#pragma unroll
            for (int j = 0; j < 4; ++j) {
                d += x[j * 8 + 0] * bflo(uu[j].x) + x[j * 8 + 1] * bfhi(uu[j].x) + x[j * 8 + 2] * bflo(uu[j].y) + x[j * 8 + 3] * bfhi(uu[j].y)
                   + x[j * 8 + 4] * bflo(uu[j].z) + x[j * 8 + 5] * bfhi(uu[j].z) + x[j * 8 + 6] * bflo(uu[j].w) + x[j * 8 + 7] * bfhi(uu[j].w);
            }
            d = wave_sum(d);
            const float w = g * gelu_exact(d);
#pragma unroll
            for (int j = 0; j < 4; ++j) {
                acc[j * 8 + 0] += w * bflo(vv[j].x); acc[j * 8 + 1] += w * bfhi(vv[j].x); acc[j * 8 + 2] += w * bflo(vv[j].y); acc[j * 8 + 3] += w * bfhi(vv[j].y);
                acc[j * 8 + 4] += w * bflo(vv[j].z); acc[j * 8 + 5] += w * bfhi(vv[j].z); acc[j * 8 + 6] += w * bflo(vv[j].w); acc[j * 8 + 7] += w * bfhi(vv[j].w);
            }
        }
        float s = 0.f;
#pragma unroll
        for (int i = 0; i < 32; ++i) { acc[i] += ALPHA * x[i]; s += acc[i]; }
        const float mean = wave_sum(s) * (1.0f / D); float q = 0.f;
#pragma unroll
        for (int i = 0; i < 32; ++i) { const float dd = acc[i] - mean; q += dd * dd; }
        const float rstd = rsqrtf(wave_sum(q) * (1.0f / D) + LN_EPS);
        float* yo = P.out + (row < NTOK_P ? O_YP + (size_t)row * D : O_YS + (size_t)(row - NTOK_P) * D);
#pragma unroll
        for (int j = 0; j < 4; ++j) {
            const int col = j * 512 + lane * 8;
            const float4 g0 = *(const float4*)(P.ln2_g + col), g1 = *(const float4*)(P.ln2_g + col + 4), b0 = *(const float4*)(P.ln2_b + col), b1 = *(const float4*)(P.ln2_b + col + 4);
            float4 o0, o1;
            o0.x = (acc[j * 8 + 0] - mean) * rstd * g0.x + b0.x; o0.y = (acc[j * 8 + 1] - mean) * rstd * g0.y + b0.y; o0.z = (acc[j * 8 + 2] - mean) * rstd * g0.z + b0.z; o0.w = (acc[j * 8 + 3] - mean) * rstd * g0.w + b0.w;
            o1.x = (acc[j * 8 + 4] - mean) * rstd * g1.x + b1.x; o1.y = (acc[j * 8 + 5] - mean) * rstd * g1.y + b1.y; o1.z = (acc[j * 8 + 6] - mean) * rstd * g1.z + b1.z; o1.w = (acc[j * 8 + 7] - mean) * rstd * g1.w + b1.w;
            *(float4*)(yo + col) = o0; *(float4*)(yo + col + 4) = o1;
        }
    }
}

constexpr int NPHASE = 8;
__global__ void __launch_bounds__(NTHREADS, 2) fwd(Params P) {
    extern __shared__ __attribute__((aligned(16))) unsigned char lds_raw[];
    LAS unsigned char* lds = (LAS unsigned char*)lds_raw;
    volatile LAS unsigned* misc = (volatile LAS unsigned*)(lds + MISC_OFF);
    const int lo = P.ph_lo, hi = P.ph_hi;
    XcdBarrier bar; bar.bar = (unsigned*)(P.ws + WS_CTL); bar.x = 0; bar.st = nullptr;
    if (hi - lo > 1) {
        if (threadIdx.x == 0) { misc[0] = 0u; misc[1] = 0u; misc[2] = 0u; misc[3] = 0u; }
        __syncthreads();
        bar = xcd_barrier_post((unsigned*)(P.ws + WS_CTL), misc);
    }
#ifndef MK_PHASE_MASK
#define MK_PHASE_MASK 0xff
#endif
#define IN(k) (((MK_PHASE_MASK >> (k)) & 1) && lo <= (k) && (k) < hi)
#define SEAM(k) do { if (IN(k) && IN((k) + 1)) xcd_barrier(bar); } while (0)
    if (IN(0)) { phase_prologue(P, lds); }
    SEAM(0);
    if (IN(1)) {
        pg8::Gemm g{(const pg8::bf16_t*)(P.ws + WS_XB), (const pg8::bf16_t*)(P.ws + WS_WINT), NTOK, DIN, D};
        pg8::StaticOrder S; S.init(NTOK, DIN, (int)gridDim.x, (int)blockIdx.x);
        EpiProj E{P.out, (float*)(P.ws + WS_QF), (float*)(P.ws + WS_XR), (float*)(P.ws + WS_GATE)};
        pg8::gemm_phase<EpiProj, pg8::StaticOrder, false>(lds, g, S, E, nullptr);
    }
    SEAM(1);
    if (IN(2)) { phase_mixers(P, lds); }
    SEAM(2);
    if (IN(3)) {
        pg8::Gemm g{(const pg8::bf16_t*)(P.ws + WS_AR), (const pg8::bf16_t*)(P.ws + WS_WOT), NTOK, D, D};
        pg8::StaticOrder S; S.init(NTOK, D, (int)gridDim.x, (int)blockIdx.x);
        EpiOut E{P.x_prompt, P.x_sample, (float*)(P.ws + WS_PRE1)};
        pg8::gemm_phase<EpiOut, pg8::StaticOrder, false>(lds, g, S, E, nullptr);
    }
    SEAM(3);
    if (IN(4)) { phase_ln1(P); }
    SEAM(4);
    if (IN(5)) {
        pg8::Gemm g{(const pg8::bf16_t*)(P.ws + WS_X1B), (const pg8::bf16_t*)(P.ws + WS_WQT), NTOK, D, D};
        pg8::StaticOrder S; S.init(NTOK, D, (int)gridDim.x, (int)blockIdx.x);
        EpiPlain E{(float*)(P.ws + WS_QP), D};
        pg8::gemm_phase<EpiPlain, pg8::StaticOrder, false>(lds, g, S, E, nullptr);
    }
    SEAM(5);
    if (IN(6)) { phase_route(P, lds); }
    SEAM(6);
    if (IN(7)) { phase_experts(P); }
#undef IN
#undef SEAM
}
}

#ifndef MK_N_LAUNCHES
#define MK_N_LAUNCHES 8
#endif
extern "C" void kernel_launch(void* const* d_in, const int* in_sizes, int n_in, void* d_out, int out_size, void* d_ws, size_t ws_size, hipStream_t stream) {
    using namespace mk;
    static int grid = 0;
    if (grid == 0) {
        if (n_in != 23 || (size_t)out_size != O_END || ws_size < WS_END) { fprintf(stderr, "kernel_launch: unexpected shapes: n_in %d out %d ws %zu (need %zu)\n", n_in, out_size, ws_size, (size_t)WS_END); grid = -1; return; }
        int dev = 0, cus = 0, per_cu = 0;
        if (hipGetDevice(&dev) != hipSuccess || hipDeviceGetAttribute(&cus, hipDeviceAttributeMultiprocessorCount, dev) != hipSuccess) { grid = -1; return; }
        if (hipFuncSetAttribute((const void*)fwd, hipFuncAttributeMaxDynamicSharedMemorySize, LDS_BYTES) != hipSuccess) { fprintf(stderr, "kernel_launch: hipFuncSetAttribute failed\n"); grid = -1; return; }
        if (hipOccupancyMaxActiveBlocksPerMultiprocessor(&per_cu, (const void*)fwd, NTHREADS, LDS_BYTES) != hipSuccess || per_cu < 1) { fprintf(stderr, "kernel_launch: occupancy query says %d\n", per_cu); }
        (void)hipGetLastError();
        grid = cus;
    }
    if (grid < 0) return;
    (void)hipMemsetAsync((char*)d_ws + WS_CTL, 0, 65536, stream);
    Params p{};
    p.x_prompt = (const float*)d_in[0]; p.x_sample = (const float*)d_in[1]; p.cache_k = (const float*)d_in[2]; p.cache_v = (const float*)d_in[3];
    p.state_conv = (const float*)d_in[4]; p.state_h = (const float*)d_in[5]; p.w_in = (const float*)d_in[6]; p.conv_w = (const float*)d_in[7]; p.conv_b = (const float*)d_in[8];
    p.lru_w_a = (const float*)d_in[9]; p.lru_b_a = (const float*)d_in[10]; p.lru_w_x = (const float*)d_in[11]; p.lru_b_x = (const float*)d_in[12]; p.lru_lambda = (const float*)d_in[13];
    p.w_out = (const float*)d_in[14]; p.ln1_g = (const float*)d_in[15]; p.ln1_b = (const float*)d_in[16]; p.w_query = (const float*)d_in[17]; p.sub_keys = (const float*)d_in[18];
    p.peer_u = (const float*)d_in[19]; p.peer_v = (const float*)d_in[20]; p.ln2_g = (const float*)d_in[21]; p.ln2_b = (const float*)d_in[22];
    p.out = (float*)d_out; p.ws = (unsigned char*)d_ws;
#if MK_N_LAUNCHES == 1
    p.ph_lo = 0; p.ph_hi = NPHASE;
    hipLaunchKernelGGL(fwd, dim3(grid), dim3(NTHREADS), LDS_BYTES, stream, p);
#else
    for (int k = 0; k < NPHASE; ++k) { p.ph_lo = k; p.ph_hi = k + 1; hipLaunchKernelGGL(fwd, dim3(grid), dim3(NTHREADS), LDS_BYTES, stream, p); }
#endif
    const hipError_t le = hipPeekAtLastError();
    if (le != hipSuccess) fprintf(stderr, "kernel_launch: launch failed: %s\n", hipGetErrorName(le));
}
```

```cpp
#include <hip/hip_runtime.h>
#include <cstdio>
#include <cstdint>
namespace pg8 {
#define PG8_LAS __attribute__((address_space(3)))
typedef unsigned short bf16_t;
typedef short bf16x8 __attribute__((ext_vector_type(8)));
typedef float f32x4 __attribute__((ext_vector_type(4)));
typedef unsigned u32x4 __attribute__((ext_vector_type(4)));
constexpr int BM = 256, BK = 64, HALF = 128, HTB = HALF * BK * 2  , STAGE_BYTES = 8 * HTB, NXCD = 8, WGM = 8;

__host__ __device__ __forceinline__ int lds_byte(int r, int c) { const int st = (r >> 4) * 2 + (c >> 5), rr = r & 15, cc = c & 31, ob = rr * 64 + cc * 2; return st * 1024 + (ob ^ (((ob >> 9) & 1) << 5)); }
__host__ __device__ __forceinline__ void stage_rc(int b, int& R, int& C) { const int st = b / 1024, sb = b % 1024, swz = sb ^ (((sb >> 9) & 1) << 5); R = (st >> 1) * 16 + swz / 64; C = (st & 1) * 32 + (swz % 64) / 2; }
__host__ __device__ __forceinline__ int perm32(int rho) { const int n = rho >> 4, i = rho & 15; return 8 * (i >> 2) + 4 * n + (i & 3); }

struct Unit { int pm, pn; };
struct Gemm { const bf16_t* A; const bf16_t* Bt; int M, N, K; };

struct StaticOrder {
    int nM, nN, nwg, G, c;
    __host__ __device__ void init(int M, int N, int G_, int c_) { nM = M / BM; nN = N / BM; nwg = nM * nN; G = G_; c = c_; }
    __host__ __device__ bool next(int i, Unit& u) const {
        const long L = (long)i * G + c; if (L >= nwg) return false;
        int wgid = (int)L; { const int q = nwg / NXCD, r = nwg % NXCD, xcd = wgid % NXCD, off = wgid / NXCD; wgid = (xcd < r ? xcd * (q + 1) : r * (q + 1) + (xcd - r) * q) + off; }
        const int nig = WGM * nN, gid = wgid / nig, fm = gid * WGM, gsz = (nM - fm) < WGM ? (nM - fm) : WGM;
        u.pm = fm + ((wgid % nig) % gsz); u.pn = (wgid % nig) / gsz; return true;
    }
    __device__ __forceinline__ void a_ready(const Unit&) const {}
    __device__ __forceinline__ void done(const Unit&) const {}
};
struct CountedOrder : StaticOrder {
    const unsigned* ready; unsigned need; unsigned* tmo;
    __device__ __forceinline__ void a_ready(const Unit& u) const {
        if (threadIdx.x < 64) {
            const unsigned long long t0 = __builtin_amdgcn_s_memrealtime(); unsigned polls = 0;
            while ((unsigned)__builtin_amdgcn_readfirstlane(__hip_atomic_load(ready + 64 * u.pm, __ATOMIC_RELAXED, __HIP_MEMORY_SCOPE_AGENT)) < need) {
                if ((++polls & 255u) == 0u && __builtin_amdgcn_readfirstlane(__hip_atomic_load(tmo, __ATOMIC_RELAXED, __HIP_MEMORY_SCOPE_AGENT)) != 0u) break;
                if (__builtin_amdgcn_s_memrealtime() - t0 > 2000000ull) {
                    if (threadIdx.x == 0) { unsigned expect = 0u; __hip_atomic_compare_exchange_strong(tmo + 1, &expect, 0x600u | (unsigned)(u.pm & 0xff), __ATOMIC_RELAXED, __ATOMIC_RELAXED, __HIP_MEMORY_SCOPE_AGENT); __hip_atomic_store(tmo, 1u, __ATOMIC_RELAXED, __HIP_MEMORY_SCOPE_AGENT); }
                    break; }
                __builtin_amdgcn_s_sleep(2); }
            __builtin_amdgcn_fence(__ATOMIC_ACQUIRE, "agent");
            asm volatile("s_waitcnt vmcnt(0)" ::: "memory");
        }
#if !defined(BROKEN_HOOK_NO_BARRIER)
        asm volatile("" ::: "memory"); __builtin_amdgcn_s_barrier(); asm volatile("" ::: "memory");
#endif
    }
};

__device__ __forceinline__ unsigned cvt_pk_bf16(float lo, float hi) { unsigned r; asm volatile("v_cvt_pk_bf16_f32 %0, %1, %2" : "=v"(r) : "v"(lo), "v"(hi)); return r; }
typedef float f32x2 __attribute__((ext_vector_type(2)));
__device__ __forceinline__ f32x2 gelu_pk(f32x2 v) {
    const f32x2 av = __builtin_elementwise_abs(v), d = av * 0.2316418882f + 1.0f;
    f32x2 t; t.x = __builtin_amdgcn_rcpf(d.x); t.y = __builtin_amdgcn_rcpf(d.y);
    f32x2 q = t * 0.5307027145f + (-0.7265760135f); q = q * t + 0.7107068705f; q = q * t + (-0.142248368f); q = q * t + 0.127414796f; q = q * t;
    const f32x2 s = (v * v) * (-0.72134752044f);
    f32x2 e; e.x = __builtin_amdgcn_exp2f(s.x); e.y = __builtin_amdgcn_exp2f(s.y);
    const f32x2 m = v * (q * e), r = v - m;
    f32x2 o; o.x = v.x < 0.f ? m.x : r.x; o.y = v.y < 0.f ? m.y : r.y; return o;
}

struct EpiF32 {
    static constexpr bool PERM = false, AFTER_DRAIN = false;
    float* C; int ldc; const float* bias;
    __device__ __forceinline__ void operator()(const f32x4 (&acc)[2][2][4][2], const Unit& u, int wr, int wc, int fr, int fq) const {
        const int row0 = u.pm * BM + wr * 64 + fr, col0 = u.pn * BM + wc * 32 + 4 * fq;
        f32x4 bv[2][2];
#pragma unroll
        for (int bj = 0; bj < 2; ++bj)
#pragma unroll
            for (int n = 0; n < 2; ++n) bv[bj][n] = bias ? *(const f32x4*)(bias + col0 + bj * HALF + n * 16) : (f32x4){0.f, 0.f, 0.f, 0.f};
#pragma unroll
        for (int ai = 0; ai < 2; ++ai)
#pragma unroll
            for (int m = 0; m < 4; ++m) { float* rowp = C + (size_t)(row0 + ai * HALF + m * 16) * ldc + col0;
#pragma unroll
                for (int bj = 0; bj < 2; ++bj)
#pragma unroll
                    for (int n = 0; n < 2; ++n) *(f32x4*)(rowp + bj * HALF + n * 16) = acc[ai][bj][m][n] + bv[bj][n]; }
    }
};
template <int ACT  > struct EpiBf16 {
    static constexpr bool PERM = true, AFTER_DRAIN = false;
    bf16_t* O; int ldc; const float* bias; int split_cols; size_t split_stride;
    __device__ __forceinline__ void operator()(const f32x4 (&acc)[2][2][4][2], const Unit& u, int wr, int wc, int fr, int fq) const {
        const int row0 = u.pm * BM + wr * 64 + fr; int colt = u.pn * BM; bf16_t* base = O;
        if (split_cols) { const int t = colt / split_cols; base += (size_t)t * split_stride; colt -= t * split_cols; }
        const int col0 = colt + wc * 32 + 8 * fq, bcol0 = u.pn * BM + wc * 32 + 8 * fq;
        f32x4 bv[2][2];
#pragma unroll
        for (int bj = 0; bj < 2; ++bj)
#pragma unroll
            for (int n = 0; n < 2; ++n) bv[bj][n] = bias ? *(const f32x4*)(bias + bcol0 + bj * HALF + 4 * n) : (f32x4){0.f, 0.f, 0.f, 0.f};
#pragma unroll
        for (int ai = 0; ai < 2; ++ai)
#pragma unroll
            for (int m = 0; m < 4; ++m) { bf16_t* rowp = base + (size_t)(row0 + ai * HALF + m * 16) * ldc + col0;
#pragma unroll
                for (int bj = 0; bj < 2; ++bj) { f32x4 v0 = acc[ai][bj][m][0] + bv[bj][0], v1 = acc[ai][bj][m][1] + bv[bj][1];
                    if (ACT == 1) { f32x2 a = gelu_pk((f32x2){v0[0], v0[1]}), b = gelu_pk((f32x2){v0[2], v0[3]}), c = gelu_pk((f32x2){v1[0], v1[1]}), d = gelu_pk((f32x2){v1[2], v1[3]});
                        v0 = (f32x4){a.x, a.y, b.x, b.y}; v1 = (f32x4){c.x, c.y, d.x, d.y}; }
                    if (ACT == 2) {
#pragma unroll
                        for (int j = 0; j < 4; ++j) { v0[j] = 0.5f * v0[j] * (1.0f + erff(v0[j] * 0.70710678f)); v1[j] = 0.5f * v1[j] * (1.0f + erff(v1[j] * 0.70710678f)); } }
                    u32x4 w; w.x = cvt_pk_bf16(v0[0], v0[1]); w.y = cvt_pk_bf16(v0[2], v0[3]); w.z = cvt_pk_bf16(v1[0], v1[1]); w.w = cvt_pk_bf16(v1[2], v1[3]);
                    *(u32x4*)(rowp + bj * HALF) = w; } }
    }
};

struct PanelStats {
    unsigned* xbuf;
    unsigned* cnt;
    unsigned* tmo;
    int ntn; float eps;
    unsigned code;
    __device__ __forceinline__ bool run(const f32x4 (&v)[2][2][4][2], const Unit& u, int wr, int wc, int fr, int fq, PG8_LAS unsigned char* lds, int wid, int lane) const {
        typedef float f32x2v __attribute__((ext_vector_type(2)));
        PG8_LAS f32x2v* P = (PG8_LAS f32x2v*)lds;
        PG8_LAS f32x2v* S = (PG8_LAS f32x2v*)(lds + 8192);
        PG8_LAS unsigned* flag = (PG8_LAS unsigned*)(lds + 8192 + 2048);
#pragma unroll
        for (int ai = 0; ai < 2; ++ai)
#pragma unroll
            for (int m = 0; m < 4; ++m) {
                float s = 0.f;
#pragma unroll
                for (int bj = 0; bj < 2; ++bj)
#pragma unroll
                    for (int n = 0; n < 2; ++n) { const f32x4 x = v[ai][bj][m][n]; s += (x[0] + x[1]) + (x[2] + x[3]); }
                s += __shfl_xor(s, 16); s += __shfl_xor(s, 32);
                const float mw = s * (1.0f / 64.0f); float q = 0.f;
#pragma unroll
                for (int bj = 0; bj < 2; ++bj)
#pragma unroll
                    for (int n = 0; n < 2; ++n) { const f32x4 d = v[ai][bj][m][n] - mw; q += (d[0] * d[0] + d[1] * d[1]) + (d[2] * d[2] + d[3] * d[3]); }
                q += __shfl_xor(q, 16); q += __shfl_xor(q, 32);
                if (fq == 0) P[(ai * HALF + wr * 64 + m * 16 + fr) * 4 + wc] = (f32x2v){mw, q};
            }
        asm volatile("s_waitcnt lgkmcnt(0)" ::: "memory"); __builtin_amdgcn_s_barrier(); asm volatile("" ::: "memory");
#if defined(BROKEN_NO_WAIT)
        if (blockIdx.x >= 64) { const long long t0 = clock64(); while (clock64() - t0 < 60000) __builtin_amdgcn_s_sleep(8); }
#endif
        const int row = wid * 32 + (lane & 31);
        if (lane < 32) {
            const f32x2v a = P[row * 4 + 0], b = P[row * 4 + 1], c = P[row * 4 + 2], d = P[row * 4 + 3];
            const float mt = (a.x + b.x + c.x + d.x) * 0.25f;
            const float da = a.x - mt, db = b.x - mt, dc = c.x - mt, dd = d.x - mt;
            const float m2 = (a.y + b.y) + (c.y + d.y) + 64.0f * ((da * da + db * db) + (dc * dc + dd * dd));
            unsigned long long* slot = (unsigned long long*)xbuf + ((size_t)(u.pm * BM + row) * 4 + u.pn);
            __hip_atomic_store(slot, ((unsigned long long)__float_as_uint(m2) << 32) | __float_as_uint(mt), __ATOMIC_RELAXED, __HIP_MEMORY_SCOPE_AGENT);
        }
        asm volatile("s_waitcnt vmcnt(0)" ::: "memory");
        if (lane == 0) __hip_atomic_fetch_add(cnt + 64 * u.pm, 1u, __ATOMIC_RELAXED, __HIP_MEMORY_SCOPE_AGENT);
        if (wid == 0) {
            bool dead = false; const unsigned long long t0 = __builtin_amdgcn_s_memrealtime(); const unsigned want = 8u * (unsigned)ntn;
            for (;;) {
#if defined(BROKEN_NO_WAIT)
                break;
#endif
                if ((unsigned)__builtin_amdgcn_readfirstlane(__hip_atomic_load(cnt + 64 * u.pm, __ATOMIC_RELAXED, __HIP_MEMORY_SCOPE_AGENT)) >= want) break;
                if (__builtin_amdgcn_s_memrealtime() - t0 > 2000000ull) {
                    if (lane == 0) { unsigned expect = 0u; __hip_atomic_compare_exchange_strong(tmo + 1, &expect, code | (unsigned)(u.pm & 0xff), __ATOMIC_RELAXED, __ATOMIC_RELAXED, __HIP_MEMORY_SCOPE_AGENT);
                                     __hip_atomic_store(tmo, 1u, __ATOMIC_RELAXED, __HIP_MEMORY_SCOPE_AGENT); }
                    dead = true; break; }
                __builtin_amdgcn_s_sleep(2);
            }
            __builtin_amdgcn_fence(__ATOMIC_ACQUIRE, "agent");
            if (lane == 0) flag[0] = dead ? 1u : 0u;
        }
        asm volatile("s_waitcnt vmcnt(0) lgkmcnt(0)" ::: "memory"); __builtin_amdgcn_s_barrier(); asm volatile("" ::: "memory");
        const bool bad = flag[0] != 0u;
        if (lane < 32) {
            const unsigned long long* slot = (const unsigned long long*)xbuf + (size_t)(u.pm * BM + row) * 4; float mt[4], m2[4]; float ms = 0.f;
#pragma unroll
            for (int t = 0; t < 4; ++t) { if (t < ntn) { const unsigned long long w = __hip_atomic_load(slot + t, __ATOMIC_RELAXED, __HIP_MEMORY_SCOPE_AGENT); mt[t] = __uint_as_float((unsigned)w); m2[t] = __uint_as_float((unsigned)(w >> 32)); } else { mt[t] = 0.f; m2[t] = 0.f; } ms += mt[t]; }
            const float mean = ms / (float)ntn; float q = 0.f;
#pragma unroll
            for (int t = 0; t < 4; ++t) if (t < ntn) { const float dm = mt[t] - mean; q += m2[t] + 256.0f * dm * dm; }
            S[row] = (f32x2v){mean, 1.0f / sqrtf(q / (256.0f * (float)ntn) + eps)};
        }
        asm volatile("s_waitcnt lgkmcnt(0)" ::: "memory"); __builtin_amdgcn_s_barrier(); asm volatile("" ::: "memory");
        return bad;
    }
};
struct EpiLnRes {
    static constexpr bool PERM = false, AFTER_DRAIN = true;
    const float* base; float* out; int ldc; const float* bias; PanelStats st; unsigned poison;
    __device__ __forceinline__ void refuse(size_t i0, size_t stride, int M, int N) const { const float q = __builtin_nanf(""); for (size_t i = i0; i < (size_t)M * N; i += stride) out[(i / N) * ldc + i % N] = q;
        if (i0 == 0) { unsigned expect = 0u; __hip_atomic_compare_exchange_strong(st.tmo + 1, &expect, 0x7f0u, __ATOMIC_RELAXED, __ATOMIC_RELAXED, __HIP_MEMORY_SCOPE_AGENT); __hip_atomic_store(st.tmo, 1u, __ATOMIC_RELAXED, __HIP_MEMORY_SCOPE_AGENT); } }
    __device__ __forceinline__ void fused(f32x4 (&acc)[2][2][4][2], const Unit& u, int wr, int wc, int fr, int fq, PG8_LAS unsigned char* lds, int wid, int lane) const {
        typedef float f32x2v __attribute__((ext_vector_type(2)));
        const PG8_LAS f32x2v* S = (const PG8_LAS f32x2v*)(lds + 8192);
        const int col0 = u.pn * BM + wc * 32 + 4 * fq;
#pragma unroll
        for (int bj = 0; bj < 2; ++bj)
#pragma unroll
            for (int n = 0; n < 2; ++n) { const f32x4 bv = bias ? *(const f32x4*)(bias + col0 + bj * HALF + n * 16) : (f32x4){0.f, 0.f, 0.f, 0.f};
#pragma unroll
                for (int ai = 0; ai < 2; ++ai)
#pragma unroll
                    for (int m = 0; m < 4; ++m) acc[ai][bj][m][n] += bv; }
        const bool bad = st.run(acc, u, wr, wc, fr, fq, lds, wid, lane) || poison != 0u;
        const float qnan = __builtin_nanf("");
#pragma unroll
        for (int ai = 0; ai < 2; ++ai)
#pragma unroll
            for (int m = 0; m < 4; ++m) { const int r = ai * HALF + wr * 64 + m * 16 + fr; const f32x2v sr = S[r]; const size_t off = (size_t)(u.pm * BM + r) * ldc + col0;
#pragma unroll
                for (int bj = 0; bj < 2; ++bj)
#pragma unroll
                    for (int n = 0; n < 2; ++n) { const f32x4 bs = *(const f32x4*)(base + off + bj * HALF + n * 16); f32x4 o = bs + (acc[ai][bj][m][n] - sr.x) * sr.y;
                        if (bad) o = (f32x4){qnan, qnan, qnan, qnan}; *(f32x4*)(out + off + bj * HALF + n * 16) = o; }
                asm volatile("" ::: "memory"); }
    }
};
struct EpiLnResLn {
    static constexpr bool PERM = false, AFTER_DRAIN = true;
    const float* base; float* out; bf16_t* xn; int ldc; const float* bias; PanelStats st1, st2; unsigned poison;
    __device__ __forceinline__ void refuse(size_t i0, size_t stride, int M, int N) const { const float q = __builtin_nanf(""); for (size_t i = i0; i < (size_t)M * N; i += stride) { const size_t o = (i / N) * ldc + i % N; out[o] = q; xn[o] = (bf16_t)0x7fc0u; }
        if (i0 == 0) { unsigned expect = 0u; __hip_atomic_compare_exchange_strong(st1.tmo + 1, &expect, 0x7f0u, __ATOMIC_RELAXED, __ATOMIC_RELAXED, __HIP_MEMORY_SCOPE_AGENT); __hip_atomic_store(st1.tmo, 1u, __ATOMIC_RELAXED, __HIP_MEMORY_SCOPE_AGENT); } }
    __device__ __forceinline__ void fused(f32x4 (&acc)[2][2][4][2], const Unit& u, int wr, int wc, int fr, int fq, PG8_LAS unsigned char* lds, int wid, int lane) const {
        typedef float f32x2v __attribute__((ext_vector_type(2))); typedef unsigned u32x2v __attribute__((ext_vector_type(2)));
        const PG8_LAS f32x2v* S = (const PG8_LAS f32x2v*)(lds + 8192);
        const int col0 = u.pn * BM + wc * 32 + 4 * fq;
#pragma unroll
        for (int bj = 0; bj < 2; ++bj)
#pragma unroll
            for (int n = 0; n < 2; ++n) { const f32x4 bv = bias ? *(const f32x4*)(bias + col0 + bj * HALF + n * 16) : (f32x4){0.f, 0.f, 0.f, 0.f};
#pragma unroll
                for (int ai = 0; ai < 2; ++ai)
#pragma unroll
                    for (int m = 0; m < 4; ++m) acc[ai][bj][m][n] += bv; }
        bool bad = st1.run(acc, u, wr, wc, fr, fq, lds, wid, lane) || poison != 0u;
        const float qnan = __builtin_nanf("");
#pragma unroll
        for (int ai = 0; ai < 2; ++ai)
#pragma unroll
            for (int m = 0; m < 4; ++m) { const int r = ai * HALF + wr * 64 + m * 16 + fr; const f32x2v sr = S[r]; const size_t off = (size_t)(u.pm * BM + r) * ldc + col0;
#pragma unroll
                for (int bj = 0; bj < 2; ++bj)
#pragma unroll
                    for (int n = 0; n < 2; ++n) { const f32x4 bs = *(const f32x4*)(base + off + bj * HALF + n * 16); acc[ai][bj][m][n] = bs + (acc[ai][bj][m][n] - sr.x) * sr.y; }
                asm volatile("" : "+v"(acc[ai][0][m][0]), "+v"(acc[ai][0][m][1]), "+v"(acc[ai][1][m][0]), "+v"(acc[ai][1][m][1]));
                if (m & 1) asm volatile("" ::: "memory"); }
        const bool bad1 = bad;
        bad = st2.run(acc, u, wr, wc, fr, fq, lds, wid, lane) || bad;
#pragma unroll
        for (int ai = 0; ai < 2; ++ai)
#pragma unroll
            for (int m = 0; m < 4; ++m) { const int r = ai * HALF + wr * 64 + m * 16 + fr; const f32x2v sr = S[r]; const size_t off = (size_t)(u.pm * BM + r) * ldc + col0;
#pragma unroll
                for (int bj = 0; bj < 2; ++bj)
#pragma unroll
                    for (int n = 0; n < 2; ++n) { const f32x4 x1 = acc[ai][bj][m][n]; *(f32x4*)(out + off + bj * HALF + n * 16) = bad1 ? (f32x4){qnan, qnan, qnan, qnan} : x1;
                        const f32x4 o = (x1 - sr.x) * sr.y; u32x2v w; w.x = cvt_pk_bf16(o[0], o[1]); w.y = cvt_pk_bf16(o[2], o[3]);
                        if (bad) { w.x = 0x7fc07fc0u; w.y = 0x7fc07fc0u; } *(u32x2v*)(xn + off + bj * HALF + n * 16) = w; }
                asm volatile("" ::: "memory"); }
    }
};

template <class Epi, class Sched, bool STAMP = false>
__device__ __forceinline__ void gemm_phase(PG8_LAS unsigned char* lds, const Gemm g, const Sched& S, const Epi& E, unsigned long long* stamps) {
    const int tid = threadIdx.x, wid = __builtin_amdgcn_readfirstlane(tid >> 6), lane = tid & 63, wr = wid >> 2, wc = wid & 3, fr = lane & 15, fq = lane >> 4;
    const int K = g.K, nt = K / BK;
    int ts_lo = 0, ts_hi = 0, nts = 0; const unsigned long long rt_entry = STAMP ? (unsigned long long)wall_clock64() : 0ull;
#define PG8_STAMP() do { if (STAMP && wid == 0 && nts < 64) { const unsigned long long _c = (unsigned long long)clock64(); \
        ts_lo = (lane == nts) ? (int)(unsigned)_c : ts_lo; ts_hi = (lane == nts) ? (int)(unsigned)(_c >> 32) : ts_hi; ++nts; } } while (0)
    PG8_STAMP();
    unsigned voffA[2], voffB[2];
#pragma unroll
    for (int i = 0; i < 2; ++i) { int R, C; stage_rc(tid * 16 + i * 8192, R, C); const int Rb = Epi::PERM ? ((R & ~31) + perm32(R & 31)) : R;
        voffA[i] = (unsigned)(R * K + C) * 2u; voffB[i] = (unsigned)(Rb * K + C) * 2u; }
    const size_t kstep = (size_t)(BK * 2);
    const size_t hstep = (size_t)HALF * K * 2;
    const size_t tstep = 2 * hstep;
    const unsigned ldsw = (unsigned)wid * 1024u;
    const int aoff = lds_byte(wr * 64 + fr, fq * 8), boff = lds_byte(wc * 32 + fr, fq * 8);
#define PG8_SA(b, h) (((b) * 2 + (h)) * HTB)
#define PG8_SB(b, h) ((4 + (b) * 2 + (h)) * HTB)
#define PG8_STAGE(bufoff, gbase, voff) do { _Pragma("unroll") for (int _i = 0; _i < 2; ++_i) \
        __builtin_amdgcn_global_load_lds((const unsigned*)((const char*)(gbase) + (voff)[_i]), (PG8_LAS unsigned*)(lds + (bufoff) + ldsw + _i * 8192), 16, 0, 0); } while (0)
#define PG8_LDA(dst, b, h) do { _Pragma("unroll") for (int m = 0; m < 4; ++m) _Pragma("unroll") for (int k = 0; k < 2; ++k) dst[m][k] = *(const PG8_LAS bf16x8*)(lds + PG8_SA(b, h) + aoff + m * 2048 + k * 1024); } while (0)
#define PG8_LDB(dst, b, h) do { _Pragma("unroll") for (int n = 0; n < 2; ++n) _Pragma("unroll") for (int k = 0; k < 2; ++k) dst[n][k] = *(const PG8_LAS bf16x8*)(lds + PG8_SB(b, h) + boff + n * 2048 + k * 1024); } while (0)
#define PG8_MMA(ai, bj, At, Bt) do { __builtin_amdgcn_s_setprio(1); _Pragma("unroll") for (int m = 0; m < 4; ++m) _Pragma("unroll") for (int n = 0; n < 2; ++n) _Pragma("unroll") for (int k = 0; k < 2; ++k) \
        acc[ai][bj][m][n] = __builtin_amdgcn_mfma_f32_16x16x32_bf16(Bt[n][k], At[m][k], acc[ai][bj][m][n], 0, 0, 0); __builtin_amdgcn_s_setprio(0); } while (0)
#define PG8_WAIT_V(n) asm volatile("s_waitcnt vmcnt(" #n ")" ::: "memory")
#define PG8_WAIT_L(n) asm volatile("s_waitcnt lgkmcnt(" #n ")" ::: "memory")
#define PG8_BAR __builtin_amdgcn_s_barrier()
#define PG8_SCHED __builtin_amdgcn_sched_barrier(0)
    Unit cur, nxt; int ui = 0;
    if (!S.next(0, cur)) return;
    f32x4 acc[2][2][4][2];
#pragma unroll
    for (int a = 0; a < 2; ++a)
#pragma unroll
        for (int b = 0; b < 2; ++b)
#pragma unroll
            for (int m = 0; m < 4; ++m)
#pragma unroll
                for (int n = 0; n < 2; ++n) acc[a][b][m][n] = (f32x4){0.f, 0.f, 0.f, 0.f};
    bf16x8 At[4][2], B0[2][2], B1[2][2];
    const char* cA = (const char*)g.A + (size_t)cur.pm * tstep; const char* cB = (const char*)g.Bt + (size_t)cur.pn * tstep;
    S.a_ready(cur);
    PG8_STAGE(PG8_SB(0, 0), cB, voffB); PG8_STAGE(PG8_SA(0, 0), cA, voffA); PG8_STAGE(PG8_SB(0, 1), cB + hstep, voffB); PG8_STAGE(PG8_SA(0, 1), cA + hstep, voffA);
    if (wr == 1) PG8_BAR;
    PG8_WAIT_V(4); PG8_BAR;
    PG8_STAGE(PG8_SB(1, 0), cB + kstep, voffB); PG8_STAGE(PG8_SA(1, 0), cA + kstep, voffA); PG8_STAGE(PG8_SB(1, 1), cB + hstep + kstep, voffB);
    PG8_WAIT_V(6); PG8_BAR;
    PG8_STAMP();
    for (;;) {
        const bool has_next = S.next(ui + 1, nxt);
        const char* nA = has_next ? (const char*)g.A + (size_t)nxt.pm * tstep : cA; const char* nB = has_next ? (const char*)g.Bt + (size_t)nxt.pn * tstep : cB;
        for (int t = 0; t < nt; t += 2) {
            const bool last = (t == nt - 2);
            const char* a1 = cA + (size_t)(t + 1) * kstep;
            const char* a2 = last ? nA : cA + (size_t)(t + 2) * kstep; const char* b2 = last ? nB : cB + (size_t)(t + 2) * kstep;
            const char* a3 = a2 + kstep; const char* b3 = b2 + kstep;
            if (last && has_next) S.a_ready(nxt);
            PG8_LDB(B0, 0, 0); PG8_SCHED; PG8_LDA(At, 0, 0); PG8_STAGE(PG8_SA(1, 1), a1 + hstep, voffA);
            PG8_WAIT_L(8); PG8_BAR; PG8_WAIT_L(0); PG8_MMA(0, 0, At, B0); PG8_BAR; PG8_SCHED;
            PG8_LDB(B1, 0, 1); PG8_STAGE(PG8_SB(0, 0), b2, voffB);
            PG8_BAR; PG8_WAIT_L(0); PG8_MMA(0, 1, At, B1); PG8_BAR;
            PG8_LDA(At, 0, 1); PG8_STAGE(PG8_SA(0, 0), a2, voffA);
            PG8_BAR; PG8_WAIT_L(0); PG8_MMA(1, 0, At, B0); PG8_BAR; PG8_SCHED;
            PG8_STAGE(PG8_SB(0, 1), b2 + hstep, voffB);
            PG8_WAIT_V(6); PG8_BAR; PG8_MMA(1, 1, At, B1); PG8_BAR;
            PG8_LDB(B0, 1, 0); PG8_SCHED; PG8_LDA(At, 1, 0); PG8_STAGE(PG8_SA(0, 1), a2 + hstep, voffA);
            PG8_WAIT_L(8); PG8_BAR; PG8_WAIT_L(0); PG8_MMA(0, 0, At, B0); PG8_BAR; PG8_SCHED;
            PG8_LDB(B1, 1, 1); PG8_STAGE(PG8_SB(1, 0), b3, voffB);
            PG8_BAR; PG8_WAIT_L(0); PG8_MMA(0, 1, At, B1); PG8_BAR;
            PG8_LDA(At, 1, 1); PG8_STAGE(PG8_SA(1, 0), a3, voffA);
            PG8_BAR; PG8_WAIT_L(0); PG8_MMA(1, 0, At, B0); PG8_BAR; PG8_SCHED;
            PG8_STAGE(PG8_SB(1, 1), b3 + hstep, voffB);
            PG8_WAIT_V(6); PG8_BAR; PG8_MMA(1, 1, At, B1); PG8_BAR;
        }
        PG8_STAMP();
        if constexpr (!Epi::AFTER_DRAIN) { E(acc, cur, wr, wc, fr, fq); S.done(cur); }
        PG8_STAMP();
        if (!has_next) break;
#pragma unroll
        for (int a = 0; a < 2; ++a)
#pragma unroll
            for (int b = 0; b < 2; ++b)
#pragma unroll
                for (int m = 0; m < 4; ++m)
#pragma unroll
                    for (int n = 0; n < 2; ++n) acc[a][b][m][n] = (f32x4){0.f, 0.f, 0.f, 0.f};
        cur = nxt; cA = nA; cB = nB; ++ui;
    }
    PG8_WAIT_V(0);
    if (wr == 0) PG8_BAR;
    PG8_BAR;
    if constexpr (Epi::AFTER_DRAIN) { E.fused(acc, cur, wr, wc, fr, fq, lds, wid, lane); S.done(cur); }
    PG8_STAMP();
    if (STAMP && wid == 0) { stamps[lane] = lane < nts ? (((unsigned long long)(unsigned)ts_hi << 32) | (unsigned)ts_lo) : 0ull;
        if (lane == 62) stamps[62] = rt_entry; if (lane == 63) stamps[63] = (unsigned long long)wall_clock64(); }
#undef PG8_STAMP
#undef PG8_SA
#undef PG8_SB
#undef PG8_STAGE
#undef PG8_LDA
#undef PG8_LDB
#undef PG8_MMA
#undef PG8_WAIT_V
#undef PG8_WAIT_L
#undef PG8_BAR
#undef PG8_SCHED
}
}
#define XB_TMO      128
#define XB_XCNT(j)  (256  + 64 * (j))
#define XB_XSUB(j)  (1280 + 64 * (j))
#define XB_XGEN(j)  (2304 + 64 * (j))
#define XB_TOP      3328
#define XB_TOPGEN   3392
#define XCD_BAR_WORDS 3456
#define XB_SPIN_CAP (1u << 18)
#define LAS __attribute__((address_space(3)))

__device__ __forceinline__ unsigned xb_ld(unsigned* p)              { return __hip_atomic_load(p, __ATOMIC_RELAXED, __HIP_MEMORY_SCOPE_AGENT); }
__device__ __forceinline__ unsigned xb_add(unsigned* p, unsigned v) { return __hip_atomic_fetch_add(p, v, __ATOMIC_RELAXED, __HIP_MEMORY_SCOPE_AGENT); }
__device__ __forceinline__ unsigned xb_xcc_id() { return (unsigned)__builtin_amdgcn_s_getreg((3 << 11) | 20) & 0xFu; }
#define XB_SPIN(cond, bar) do { unsigned _sp = 0; while (cond) { __builtin_amdgcn_s_sleep(1); \
    if ((++_sp & 255u) == 0u) { if (xb_ld(&(bar)[XB_TMO])) break; if (_sp > XB_SPIN_CAP) { atomicAdd(&(bar)[XB_TMO], 1u); break; } } } } while (0)

struct XcdBarrier {
    unsigned* bar; unsigned x;
    volatile LAS unsigned* st;
};

__device__ __forceinline__ XcdBarrier xcd_barrier_post(unsigned* bar, volatile LAS unsigned* st) {
    XcdBarrier b; b.bar = bar; b.x = xb_xcc_id(); b.st = st;
    if (threadIdx.x == 0) (void)xb_add(&bar[XB_XCNT(b.x)], 1u);
    return b;
}
__device__ __forceinline__ void xcd_barrier_complete(unsigned* bar, unsigned x, unsigned& nloc, unsigned& nx) {
    const unsigned G = gridDim.x * gridDim.y * gridDim.z;
    unsigned sum, cnt, mine, sp = 0u;
    for (;;) {
        sum = 0u; cnt = 0u; mine = 0u;
#pragma unroll
        for (unsigned j = 0; j < 16; ++j) { const unsigned c = xb_ld(&bar[XB_XCNT(j)]); sum += c; cnt += (c > 0u) ? 1u : 0u; mine = (j == x) ? c : mine; }
        if (sum == G) break;
        __builtin_amdgcn_s_sleep(1);
        if ((++sp & 255u) == 0u) { if (xb_ld(&bar[XB_TMO])) break; if (sp > XB_SPIN_CAP) { atomicAdd(&bar[XB_TMO], 1u); break; } }
    }
    nloc = mine > 0u ? mine : 1u; nx = cnt > 0u ? cnt : 1u;
}

__device__ __forceinline__ void xcd_barrier(const XcdBarrier& b) {
    asm volatile("s_waitcnt vmcnt(0)" ::: "memory");
    __syncthreads();
    if (threadIdx.x == 0) {
        unsigned* bar = b.bar;
        __builtin_amdgcn_s_waitcnt(0);
        unsigned nloc = b.st[0], nx = b.st[1];
        if (nloc == 0u) { xcd_barrier_complete(bar, b.x, nloc, nx); b.st[0] = nloc; b.st[1] = nx; }
        const unsigned old = xb_add(&bar[XB_XSUB(b.x)], 1u);
        const unsigned gen = old / nloc;
        if (old + 1u == (gen + 1u) * nloc) {
            __builtin_amdgcn_fence(__ATOMIC_RELEASE, "agent");
            asm volatile("s_waitcnt vmcnt(0)" ::: "memory");
            const unsigned og = xb_add(&bar[XB_TOP], 1u);
            const unsigned tg = og / nx;
            if (og + 1u == (tg + 1u) * nx) xb_add(&bar[XB_TOPGEN], 1u);
            else XB_SPIN(xb_ld(&bar[XB_TOPGEN]) == tg, bar);
            __builtin_amdgcn_fence(__ATOMIC_ACQUIRE, "agent");
            xb_add(&bar[XB_XGEN(b.x)], 1u);
            asm volatile("s_waitcnt vmcnt(0)" ::: "memory");
        } else {
            XB_SPIN(xb_ld(&bar[XB_XGEN(b.x)]) == gen, bar);
            __builtin_amdgcn_fence(__ATOMIC_ACQUIRE, "agent");
            asm volatile("s_waitcnt vmcnt(0)" ::: "memory");
        }
    }
    __syncthreads();
}


namespace mk {
typedef unsigned short bf16_t;
typedef float f32x4 __attribute__((ext_vector_type(4)));
constexpr int D = 2048, NTOK_P = 16384, NTOK_S = 256, NTOK = 16640;
constexpr int DIN = 5632, DATT = 1536, DLRU = 512, NH = 12, HD = 128;
constexpr int NEXP = 16384;
constexpr float ALPHA = 1.189207115002721f;
constexpr float LN_EPS = 1e-5f;
constexpr float ATT_SCALE = 0.08838834764831845f;
constexpr size_t O_YP = 0, O_YS = 33554432, O_KP = 34078720, O_VP = 59244544, O_CP = 84410368, O_HP = 84422656,
                 O_KS = 84426752, O_VS = 185090048, O_CS = 285753344, O_HS = 285802496, O_END = 285818880;
constexpr size_t WS_CTL = 0;
constexpr size_t WS_XB = 65536;
constexpr size_t WS_WINT = WS_XB + (size_t)NTOK * D * 2;
constexpr size_t WS_WOT = WS_WINT + (size_t)DIN * D * 2;
constexpr size_t WS_WQT = WS_WOT + (size_t)D * D * 2;
constexpr size_t WS_UB = WS_WQT + (size_t)D * D * 2;
constexpr size_t WS_VB = WS_UB + (size_t)NEXP * D * 2;
constexpr size_t WS_QF = WS_VB + (size_t)NEXP * D * 2;
constexpr size_t WS_XR = WS_QF + (size_t)NTOK * DATT * 4;
constexpr size_t WS_GATE = WS_XR + (size_t)NTOK * DLRU * 4;
constexpr size_t WS_AR = WS_GATE + (size_t)NTOK * DLRU * 4;
constexpr size_t WS_PRE1 = WS_AR + (size_t)NTOK * D * 2;
constexpr size_t WS_X1F = WS_PRE1 + (size_t)NTOK * D * 4;
constexpr size_t WS_X1B = WS_X1F + (size_t)NTOK * D * 4;
constexpr size_t WS_QP = WS_X1B + (size_t)NTOK * D * 2;
constexpr size_t WS_EIDX = WS_QP + (size_t)NTOK * D * 4;
constexpr size_t WS_GW = WS_EIDX + (size_t)NTOK * 128 * 4;
constexpr size_t WS_END = WS_GW + (size_t)NTOK * 128 * 4;

constexpr int NTHREADS = 512;
constexpr int LDS_BYTES = 147456;
constexpr int MISC_OFF = 131072;

struct Params {
    const float* x_prompt; const float* x_sample; const float* cache_k; const float* cache_v; const float* state_conv; const float* state_h;
    const float* w_in; const float* conv_w; const float* conv_b; const float* lru_w_a; const float* lru_b_a; const float* lru_w_x; const float* lru_b_x;
    const float* lru_lambda; const float* w_out; const float* ln1_g; const float* ln1_b; const float* w_query; const float* sub_keys;
    const float* peer_u; const float* peer_v; const float* ln2_g; const float* ln2_b;
    float* out; unsigned char* ws; int ph_lo, ph_hi;
};

__device__ __forceinline__ unsigned f2bf(float f) { unsigned u = __float_as_uint(f); u += 0x7fffu + ((u >> 16) & 1u); return u >> 16; }
__device__ __forceinline__ unsigned pack2(float a, float b) { return f2bf(a) | (f2bf(b) << 16); }
__device__ __forceinline__ float bflo(unsigned w) { return __uint_as_float(w << 16); }
__device__ __forceinline__ float bfhi(unsigned w) { return __uint_as_float(w & 0xffff0000u); }
__device__ __forceinline__ float wave_sum(float v) {
#pragma unroll
    for (int o = 32; o >= 1; o >>= 1) v += __shfl_xor(v, o);
    return v;
}
__device__ __forceinline__ float wave_max(float v) {
#pragma unroll
    for (int o = 32; o >= 1; o >>= 1) v = fmaxf(v, __shfl_xor(v, o));
    return v;
}
__device__ __forceinline__ float gelu_exact(float v) { return 0.5f * v * (1.0f + erff(v * 0.7071067811865476f)); }
__device__ __forceinline__ float sigmoidf(float v) { return 1.0f / (1.0f + expf(-v)); }
__device__ __forceinline__ float readlane_f(float v, int l) { return __int_as_float(__builtin_amdgcn_readlane(__float_as_int(v), l)); }

__device__ __forceinline__ void convert_flat(const float* src, bf16_t* dst, size_t n8, size_t gtid, size_t gstride) {
    for (size_t i = gtid; i < n8; i += gstride) {
        const float4 a = ((const float4*)src)[2 * i], b = ((const float4*)src)[2 * i + 1];
        uint4 w; w.x = pack2(a.x, a.y); w.y = pack2(a.z, a.w); w.z = pack2(b.x, b.y); w.w = pack2(b.z, b.w);
        ((uint4*)dst)[i] = w;
    }
}
__device__ __forceinline__ void transpose_convert(const float* src, bf16_t* dst, int K, int N, LAS float* tile) {
    const int tid = threadIdx.x, ntn = N / 64, ntiles = (K / 64) * ntn;
    for (int tl = blockIdx.x; tl < ntiles; tl += gridDim.x) {
        const int kt = tl / ntn, nt = tl - kt * ntn;
#pragma unroll
        for (int i = 0; i < 8; ++i) { const int r = (tid >> 6) + 8 * i, c = tid & 63; tile[r * 65 + c] = src[(size_t)(kt * 64 + r) * N + nt * 64 + c]; }
        __syncthreads();
#pragma unroll
        for (int i = 0; i < 4; ++i) { const int n = (tid >> 5) + 16 * i, k0 = 2 * (tid & 31);
            const unsigned v = pack2(tile[k0 * 65 + n], tile[(k0 + 1) * 65 + n]);
            *(unsigned*)(dst + (size_t)(nt * 64 + n) * K + kt * 64 + k0) = v; }
        __syncthreads();
    }
}
__device__ __forceinline__ void phase_prologue(const Params& P, LAS unsigned char* lds) {
    const size_t gtid = (size_t)blockIdx.x * NTHREADS + threadIdx.x, gstride = (size_t)gridDim.x * NTHREADS;
    unsigned char* ws = P.ws;
    convert_flat(P.x_prompt, (bf16_t*)(ws + WS_XB), (size_t)NTOK_P * D / 8, gtid, gstride);
    convert_flat(P.x_sample, (bf16_t*)(ws + WS_XB) + (size_t)NTOK_P * D, (size_t)NTOK_S * D / 8, gtid, gstride);
    convert_flat(P.peer_u, (bf16_t*)(ws + WS_UB), (size_t)NEXP * D / 8, gtid, gstride);
    convert_flat(P.peer_v, (bf16_t*)(ws + WS_VB), (size_t)NEXP * D / 8, gtid, gstride);
    transpose_convert(P.w_in, (bf16_t*)(ws + WS_WINT), D, DIN, (LAS float*)lds);
    transpose_convert(P.w_out, (bf16_t*)(ws + WS_WOT), D, D, (LAS float*)lds);
    transpose_convert(P.w_query, (bf16_t*)(ws + WS_WQT), D, D, (LAS float*)lds);
    const size_t n4b = (size_t)2040 * DATT / 4, tot = 32 * n4b;
    for (size_t i = gtid; i < 2 * tot; i += gstride) {
        const int tz = i >= tot; const size_t j = i - (tz ? tot : 0); const size_t b = j / n4b, r = j - b * n4b;
        const float4* src = (const float4*)(tz ? P.cache_v : P.cache_k) + (b * 2048 + 8) * (DATT / 4) + r;
        float4* dst = (float4*)(P.out + (tz ? O_VS : O_KS)) + b * 2048 * (DATT / 4) + r;
        *dst = *src;
    }
}

struct EpiProj {
    static constexpr bool PERM = false, AFTER_DRAIN = false;
    float* out; float* QF; float* XR; float* GATE;
    __device__ __forceinline__ void operator()(const f32x4 (&acc)[2][2][4][2], const pg8::Unit& u, int wr, int wc, int fr, int fq) const {
        const int pn = u.pn; const int coff = wc * 32 + 4 * fq;
#pragma unroll
        for (int ai = 0; ai < 2; ++ai)
#pragma unroll
            for (int m = 0; m < 4; ++m) {
                const int row = u.pm * 256 + ai * 128 + wr * 64 + m * 16 + fr;
                float* rowp;
                if (pn < 6) rowp = QF + (size_t)row * DATT + pn * 256;
                else if (pn < 18) {
                    const int isv = pn >= 12; const int c0 = (pn - (isv ? 12 : 6)) * 256;
                    if (row < NTOK_P) rowp = out + (isv ? O_VP : O_KP) + (size_t)row * DATT + c0;
                    else { const int rr = row - NTOK_P, b = rr >> 3, t = rr & 7; rowp = out + (isv ? O_VS : O_KS) + ((size_t)b * 2048 + 2040 + t) * DATT + c0; }
                } else if (pn < 20) rowp = XR + (size_t)row * DLRU + (pn - 18) * 256;
                else rowp = GATE + (size_t)row * DLRU + (pn - 20) * 256;
#pragma unroll
                for (int bj = 0; bj < 2; ++bj)
#pragma unroll
                    for (int n = 0; n < 2; ++n) *(f32x4*)(rowp + coff + bj * 128 + n * 16) = acc[ai][bj][m][n];
            }
    }
};
struct EpiOut {
    static constexpr bool PERM = false, AFTER_DRAIN = false;
    const float* xp; const float* xs; float* pre;
    __device__ __forceinline__ void operator()(const f32x4 (&acc)[2][2][4][2], const pg8::Unit& u, int wr, int wc, int fr, int fq) const {
        const int col0 = u.pn * 256 + wc * 32 + 4 * fq;
#pragma unroll
        for (int ai = 0; ai < 2; ++ai)
#pragma unroll
            for (int m = 0; m < 4; ++m) {
                const int row = u.pm * 256 + ai * 128 + wr * 64 + m * 16 + fr;
                const float* xr = (row < NTOK_P ? xp + (size_t)row * D : xs + (size_t)(row - NTOK_P) * D) + col0;
                float* pr = pre + (size_t)row * D + col0;
#pragma unroll
                for (int bj = 0; bj < 2; ++bj)
#pragma unroll
                    for (int n = 0; n < 2; ++n) { const f32x4 xv = *(const f32x4*)(xr + bj * 128 + n * 16); *(f32x4*)(pr + bj * 128 + n * 16) = xv * ALPHA + acc[ai][bj][m][n]; }
            }
    }
};
struct EpiPlain {
    static constexpr bool PERM = false, AFTER_DRAIN = false;
    float* C; int ldc;
    __device__ __forceinline__ void operator()(const f32x4 (&acc)[2][2][4][2], const pg8::Unit& u, int wr, int wc, int fr, int fq) const {
        const int col0 = u.pn * 256 + wc * 32 + 4 * fq;
#pragma unroll
        for (int ai = 0; ai < 2; ++ai)
#pragma unroll
            for (int m = 0; m < 4; ++m) {
                const int row = u.pm * 256 + ai * 128 + wr * 64 + m * 16 + fr;
                float* pr = C + (size_t)row * ldc + col0;
#pragma unroll
                for (int bj = 0; bj < 2; ++bj)
#pragma unroll
                    for (int n = 0; n < 2; ++n) *(f32x4*)(pr + bj * 128 + n * 16) = acc[ai][bj][m][n];
            }
    }
};

__device__ __forceinline__ const float* kv_row(const Params& P, bool isv, bool samp, int b, int pos, int h) {
    if (!samp) return P.out + (isv ? O_VP : O_KP) + ((size_t)(b * 2048 + pos) * DATT + h * HD);
    if (pos < 2048) return (isv ? P.cache_v : P.cache_k) + ((size_t)(b * 2048 + pos) * DATT + h * HD);
    return P.out + (isv ? O_VS : O_KS) + ((size_t)(b * 2048 + 2040 + (pos - 2048)) * DATT + h * HD);
}
__device__ __forceinline__ void attn_simple_unit(const Params& P, int row, int h, LAS float* wl, int lane) {
    const bool samp = row >= NTOK_P; int b, t;
    if (!samp) { b = row >> 11; t = row & 2047; } else { b = (row - NTOK_P) >> 3; t = (row - NTOK_P) & 7; }
    const float* qrow = (const float*)(P.ws + WS_QF) + (size_t)row * DATT + h * HD;
    wl[lane] = qrow[lane]; wl[64 + lane] = qrow[64 + lane];
    __builtin_amdgcn_wave_barrier();
    const float slope = exp2f(-8.0f * (float)(h + 1) / 12.0f);
    const int base = samp ? 2048 : 0;
    float sc[7]; float mx = -INFINITY;
#pragma unroll
    for (int r = 0; r < 7; ++r) {
        const int idx = r * 64 + lane; float s = -INFINITY;
        if (idx < 387) {
            const int pz = idx / 129, d = idx - pz * 129, dil = 1 << (2 * pz), pos = base + t - dil * d;
            if (pos >= 0) {
                const float4* kr = (const float4*)kv_row(P, false, samp, b, pos, h); float a = 0.f;
#pragma unroll 8
                for (int e4 = 0; e4 < 32; ++e4) { const float4 kv = kr[e4]; const f32x4 qv = ((LAS f32x4*)wl)[e4]; a += kv.x * qv.x + kv.y * qv.y + kv.z * qv.z + kv.w * qv.w; }
                s = a * ATT_SCALE - slope * (float)(dil * d);
            }
        }
        sc[r] = s; mx = fmaxf(mx, s);
    }
    mx = wave_max(mx);
    float l = 0.f;
#pragma unroll
    for (int r = 0; r < 7; ++r) { const float p = (sc[r] == -INFINITY) ? 0.f : expf(sc[r] - mx); wl[128 + r * 64 + lane] = p; l += p; }
    l = wave_sum(l);
    __builtin_amdgcn_wave_barrier();
    float o0 = 0.f, o1 = 0.f;
    for (int idx = 0; idx < 387; ++idx) {
        const float p = wl[128 + idx];
        if (p != 0.f) {
            const int pz = idx / 129, d = idx - pz * 129, dil = 1 << (2 * pz), pos = base + t - dil * d;
            const float2 vv = ((const float2*)kv_row(P, true, samp, b, pos, h))[lane];
            o0 += p * vv.x; o1 += p * vv.y;
        }
    }
    const float inv = 1.0f / l;
    bf16_t* ar = (bf16_t*)(P.ws + WS_AR) + (size_t)row * D + h * HD;
    *(unsigned*)(ar + 2 * lane) = pack2(o0 * inv, o1 * inv);
    __builtin_amdgcn_wave_barrier();
}

__device__ __forceinline__ void lru_simple_unit(const Params& P, int s, int n, int lane) {
    const bool samp = s >= 8; const int b = samp ? s - 8 : s; const int T = samp ? 8 : 2048; const int row0 = samp ? NTOK_P + b * 8 : b * 2048;
    const int ch = n * 64 + lane;
    float wa[64], wx[64];
#pragma unroll
    for (int c = 0; c < 64; ++c) { wa[c] = P.lru_w_a[(n * 64 + c) * 64 + lane]; wx[c] = P.lru_w_x[(n * 64 + c) * 64 + lane]; }
    const float ba = P.lru_b_a[ch], bx = P.lru_b_x[ch], lam = P.lru_lambda[ch];
    const float sp = log1pf(expf(-lam));
    const float cw0 = P.conv_w[ch], cw1 = P.conv_w[512 + ch], cw2 = P.conv_w[1024 + ch], cw3 = P.conv_w[1536 + ch], cb = P.conv_b[ch];
    float x0 = 0.f, x1 = 0.f, x2 = 0.f, h = 0.f;
    if (samp) { x0 = P.state_conv[(b * 3 + 0) * 512 + ch]; x1 = P.state_conv[(b * 3 + 1) * 512 + ch]; x2 = P.state_conv[(b * 3 + 2) * 512 + ch]; h = P.state_h[b * 512 + ch]; }
    const float* XR = (const float*)(P.ws + WS_XR); const float* GT = (const float*)(P.ws + WS_GATE);
    bf16_t* AR = (bf16_t*)(P.ws + WS_AR);
    for (int t0 = 0; t0 < T; t0 += 8) {
        float xin[8], gt[8];
#pragma unroll
        for (int i = 0; i < 8; ++i) { xin[i] = XR[(size_t)(row0 + t0 + i) * DLRU + ch]; gt[i] = GT[(size_t)(row0 + t0 + i) * DLRU + ch]; }
#pragma unroll
        for (int i = 0; i < 8; ++i) {
            const float xc = ((x0 * cw0 + x1 * cw1) + x2 * cw2) + xin[i] * cw3 + cb;
            x0 = x1; x1 = x2; x2 = xin[i];
            float ra = 0.f, ri = 0.f;
#pragma unroll
            for (int c = 0; c < 64; ++c) { const float xcc = readlane_f(xc, c); ra += xcc * wa[c]; ri += xcc * wx[c]; if ((c & 15) == 15) __builtin_amdgcn_sched_barrier(0); }
            const float r = sigmoidf(ra + ba), ig = sigmoidf(ri + bx);
            const float log_a = -8.0f * r * sp; const float a = expf(log_a);
            const float u = sqrtf(-expm1f(2.0f * log_a)) * (ig * xc);
            h = a * h + u;
            const float rec = h * gelu_exact(gt[i]);
            AR[(size_t)(row0 + t0 + i) * D + DATT + ch] = (bf16_t)f2bf(rec);
        }
    }
    P.out[(samp ? O_HS : O_HP) + (size_t)b * 512 + ch] = h;
    float* co = P.out + (samp ? O_CS : O_CP) + (size_t)b * 3 * 512 + ch;
    co[0] = x0; co[512] = x1; co[1024] = x2;
}

__device__ __forceinline__ void phase_mixers(const Params& P, LAS unsigned char* lds) {
    const int lane = threadIdx.x & 63, wave = __builtin_amdgcn_readfirstlane(threadIdx.x >> 6);
    LAS float* wl = (LAS float*)lds + wave * 576;
    if (wave == 0) { for (int u = blockIdx.x; u < 64; u += gridDim.x) lru_simple_unit(P, u >> 3, u & 7, lane); }
    if (wave == 1) { for (int u = blockIdx.x; u < 256; u += gridDim.x) lru_simple_unit(P, 8 + (u >> 3), u & 7, lane); }
    const int nunits = NTOK * NH;
    for (int u = blockIdx.x * 8 + wave; u < nunits; u += gridDim.x * 8) attn_simple_unit(P, u / NH, u % NH, wl, lane);
}

__device__ __forceinline__ void phase_ln1(const Params& P) {
    const int lane = threadIdx.x & 63, wave = threadIdx.x >> 6;
    const float* pre = (const float*)(P.ws + WS_PRE1); float* x1f = (float*)(P.ws + WS_X1F); bf16_t* x1b = (bf16_t*)(P.ws + WS_X1B);
    for (int row = blockIdx.x * 8 + wave; row < NTOK; row += gridDim.x * 8) {
        float4 v[8]; float s = 0.f;
#pragma unroll
        for (int j = 0; j < 8; ++j) { v[j] = *(const float4*)(pre + (size_t)row * D + j * 256 + lane * 4); s += (v[j].x + v[j].y) + (v[j].z + v[j].w); }
        const float mean = wave_sum(s) * (1.0f / D); float q = 0.f;
#pragma unroll
        for (int j = 0; j < 8; ++j) { const float a = v[j].x - mean, b = v[j].y - mean, c = v[j].z - mean, d = v[j].w - mean; q += (a * a + b * b) + (c * c + d * d); }
        const float rstd = rsqrtf(wave_sum(q) * (1.0f / D) + LN_EPS);
#pragma unroll
        for (int j = 0; j < 8; ++j) { const int col = j * 256 + lane * 4; const float4 g = *(const float4*)(P.ln1_g + col), bb = *(const float4*)(P.ln1_b + col);
            float4 o; o.x = (v[j].x - mean) * rstd * g.x + bb.x; o.y = (v[j].y - mean) * rstd * g.y + bb.y; o.z = (v[j].z - mean) * rstd * g.z + bb.z; o.w = (v[j].w - mean) * rstd * g.w + bb.w;
            *(float4*)(x1f + (size_t)row * D + col) = o;
            uint2 w; w.x = pack2(o.x, o.y); w.y = pack2(o.z, o.w); *(uint2*)(x1b + (size_t)row * D + col) = w; }
    }
}

__device__ __forceinline__ int mono(float v) { const int b = __float_as_int(v); return b ^ ((b >> 31) & 0x7fffffff); }
__device__ __forceinline__ float unmono(int k) { return __int_as_float(k ^ ((k >> 31) & 0x7fffffff)); }
#define MK_INSERT16(L, X) do { int _x = (X); _Pragma("unroll") for (int _j = 0; _j < 16; ++_j) { const int _hi = max(L[_j], _x); _x = min(L[_j], _x); L[_j] = _hi; } } while (0)

__device__ __forceinline__ void phase_route(const Params& P, LAS unsigned char* lds) {
    const int lane = threadIdx.x & 63, wave = __builtin_amdgcn_readfirstlane(threadIdx.x >> 6);
    LAS float* ql = (LAS float*)(lds + wave * 17408);
    LAS float* sl = ql + 2048;
    LAS int* kl = (LAS int*)(sl + 2048);
    const float* QP = (const float*)(P.ws + WS_QP);
    int* EIDX = (int*)(P.ws + WS_EIDX); float* GW = (float*)(P.ws + WS_GW);
    for (int row = blockIdx.x * 8 + wave; row < NTOK; row += gridDim.x * 8) {
#pragma unroll
        for (int j = 0; j < 8; ++j) ((LAS f32x4*)ql)[j * 64 + lane] = *(const f32x4*)(QP + (size_t)row * D + (j * 64 + lane) * 4);
        __builtin_amdgcn_wave_barrier();
#pragma unroll 1
        for (int hp = 0; hp < 16; ++hp) {
            const float4* k0 = (const float4*)(P.sub_keys + (size_t)(hp * 128 + lane) * 128); const float4* k1 = k0 + 64 * 32;
            float a0 = 0.f, a1 = 0.f;
#pragma unroll 4
            for (int e4 = 0; e4 < 32; ++e4) { const f32x4 qv = ((LAS f32x4*)ql)[hp * 32 + e4]; const float4 u0 = k0[e4], u1 = k1[e4];
                a0 += qv.x * u0.x + qv.y * u0.y + qv.z * u0.z + qv.w * u0.w; a1 += qv.x * u1.x + qv.y * u1.y + qv.z * u1.z + qv.w * u1.w; }
            sl[hp * 128 + lane] = a0; sl[hp * 128 + 64 + lane] = a1;
        }
        __builtin_amdgcn_wave_barrier();
        if (lane < 16) {
            int L[16];
#pragma unroll
            for (int j = 0; j < 16; ++j) L[j] = (int)0x80000000;
#pragma unroll 1
            for (int k = 0; k < 128; ++k) { const int key = (mono(sl[lane * 128 + k]) & ~127) | k; MK_INSERT16(L, key); }
#pragma unroll
            for (int j = 0; j < 16; ++j) kl[lane * 16 + j] = L[j];
        }
        __builtin_amdgcn_wave_barrier();
        if (lane < 8) {
            const int h = lane; int L[16];
#pragma unroll
            for (int j = 0; j < 16; ++j) L[j] = (int)0x80000000;
#pragma unroll 1
            for (int a = 0; a < 16; ++a) { const float va = unmono(kl[(2 * h) * 16 + a] & ~127);
#pragma unroll 1
                for (int b = 0; b < 16; ++b) { const float vb = unmono(kl[(2 * h + 1) * 16 + b] & ~127); const int key = (mono(va + vb) & ~255) | (a << 4) | b; MK_INSERT16(L, key); } }
            float e[16]; float sum = 0.f; const float mx = unmono(L[0] & ~255);
#pragma unroll
            for (int j = 0; j < 16; ++j) { e[j] = expf(unmono(L[j] & ~255) - mx); sum += e[j]; }
            const float inv = 1.0f / sum;
#pragma unroll
            for (int j = 0; j < 16; ++j) { const int a = (L[j] >> 4) & 15, b = L[j] & 15;
                const int i0 = kl[(2 * h) * 16 + a] & 127, i1 = kl[(2 * h + 1) * 16 + b] & 127;
                EIDX[(size_t)row * 128 + h * 16 + j] = i0 * 128 + i1; GW[(size_t)row * 128 + h * 16 + j] = e[j] * inv; }
        }
        __builtin_amdgcn_wave_barrier();
    }
}

__device__ __forceinline__ void phase_experts(const Params& P) {
    const int lane = threadIdx.x & 63, wave = threadIdx.x >> 6;
    const float* x1f = (const float*)(P.ws + WS_X1F);
    const int* EIDX = (const int*)(P.ws + WS_EIDX); const float* GW = (const float*)(P.ws + WS_GW);
    const bf16_t* UB = (const bf16_t*)(P.ws + WS_UB); const bf16_t* VB = (const bf16_t*)(P.ws + WS_VB);
    for (int row = blockIdx.x * 8 + wave; row < NTOK; row += gridDim.x * 8) {
        float x[32], acc[32];
#pragma unroll
        for (int j = 0; j < 4; ++j) { const float4 a = *(const float4*)(x1f + (size_t)row * D + j * 512 + lane * 8), b = *(const float4*)(x1f + (size_t)row * D + j * 512 + lane * 8 + 4);
            x[j * 8 + 0] = a.x; x[j * 8 + 1] = a.y; x[j * 8 + 2] = a.z; x[j * 8 + 3] = a.w; x[j * 8 + 4] = b.x; x[j * 8 + 5] = b.y; x[j * 8 + 6] = b.z; x[j * 8 + 7] = b.w; }
#pragma unroll
        for (int i = 0; i < 32; ++i) acc[i] = 0.f;
        const int e_lo = EIDX[(size_t)row * 128 + lane], e_hi = EIDX[(size_t)row * 128 + 64 + lane];
        const float g_lo = GW[(size_t)row * 128 + lane], g_hi = GW[(size_t)row * 128 + 64 + lane];
        for (int k = 0; k < 128; ++k) {
            const int e = __builtin_amdgcn_readlane(k < 64 ? e_lo : e_hi, k & 63);
            const float g = readlane_f(k < 64 ? g_lo : g_hi, k & 63);
            const uint4* ur = (const uint4*)(UB + (size_t)e * D); const uint4* vr = (const uint4*)(VB + (size_t)e * D);
            uint4 uu[4], vv[4];
#pragma unroll
            for (int j = 0; j < 4; ++j) { uu[j] = ur[j * 64 + lane]; vv[j] = vr[j * 64 + lane]; }
            float d = 0.f;
#pragma unroll
            for (int j = 0; j < 4; ++j) {
                d += x[j * 8 + 0] * bflo(uu[j].x) + x[j * 8 + 1] * bfhi(uu[j].x) + x[j * 8 + 2] * bflo(uu[j].y) + x[j * 8 + 3] * bfhi(uu[j].y)
                   + x[j * 8 + 4] * bflo(uu[j].z) + x[j * 8 + 5] * bfhi(uu[j].z) + x[j * 8 + 6] * bflo(uu[j].w) + x[j * 8 + 7] * bfhi(uu[j].w);
            }
            d = wave_sum(d);
            const float w = g * gelu_exact(d);
#pragma unroll
            for (int j = 0; j < 4; ++j) {
                acc[j * 8 + 0] += w * bflo(vv[j].x); acc[j * 8 + 1] += w * bfhi(vv[j].x); acc[j * 8 + 2] += w * bflo(vv[j].y); acc[j * 8 + 3] += w * bfhi(vv[j].y);
                acc[j * 8 + 4] += w * bflo(vv[j].z); acc[j * 8 + 5] += w * bfhi(vv[j].z); acc[j * 8 + 6] += w * bflo(vv[j].w); acc[j * 8 + 7] += w * bfhi(vv[j].w);
            }
        }
        float s = 0.f;
#pragma unroll
        for (int i = 0; i < 32; ++i) { acc[i] += ALPHA * x[i]; s += acc[i]; }
        const float mean = wave_sum(s) * (1.0f / D); float q = 0.f;
#pragma unroll
        for (int i = 0; i < 32; ++i) { const float dd = acc[i] - mean; q += dd * dd; }
        const float rstd = rsqrtf(wave_sum(q) * (1.0f / D) + LN_EPS);
        float* yo = P.out + (row < NTOK_P ? O_YP + (size_t)row * D : O_YS + (size_t)(row - NTOK_P) * D);
#pragma unroll
        for (int j = 0; j < 4; ++j) {
            const int col = j * 512 + lane * 8;
            const float4 g0 = *(const float4*)(P.ln2_g + col), g1 = *(const float4*)(P.ln2_g + col + 4), b0 = *(const float4*)(P.ln2_b + col), b1 = *(const float4*)(P.ln2_b + col + 4);
            float4 o0, o1;
            o0.x = (acc[j * 8 + 0] - mean) * rstd * g0.x + b0.x; o0.y = (acc[j * 8 + 1] - mean) * rstd * g0.y + b0.y; o0.z = (acc[j * 8 + 2] - mean) * rstd * g0.z + b0.z; o0.w = (acc[j * 8 + 3] - mean) * rstd * g0.w + b0.w;
            o1.x = (acc[j * 8 + 4] - mean) * rstd * g1.x + b1.x; o1.y = (acc[j * 8 + 5] - mean) * rstd * g1.y + b1.y; o1.z = (acc[j * 8 + 6] - mean) * rstd * g1.z + b1.z; o1.w = (acc[j * 8 + 7] - mean) * rstd * g1.w + b1.w;
            *(float4*)(yo + col) = o0; *(float4*)(yo + col + 4) = o1;
        }
    }
}

constexpr int NPHASE = 8;
__global__ void __launch_bounds__(NTHREADS, 2) fwd(Params P) {
    extern __shared__ __attribute__((aligned(16))) unsigned char lds_raw[];
    LAS unsigned char* lds = (LAS unsigned char*)lds_raw;
    volatile LAS unsigned* misc = (volatile LAS unsigned*)(lds + MISC_OFF);
    const int lo = P.ph_lo, hi = P.ph_hi;
    XcdBarrier bar; bar.bar = (unsigned*)(P.ws + WS_CTL); bar.x = 0; bar.st = nullptr;
    if (hi - lo > 1) {
        if (threadIdx.x == 0) { misc[0] = 0u; misc[1] = 0u; misc[2] = 0u; misc[3] = 0u; }
        __syncthreads();
        bar = xcd_barrier_post((unsigned*)(P.ws + WS_CTL), misc);
    }
#ifndef MK_PHASE_MASK
#define MK_PHASE_MASK 0xff
#endif
#define IN(k) (((MK_PHASE_MASK >> (k)) & 1) && lo <= (k) && (k) < hi)
#define SEAM(k) do { if (IN(k) && IN((k) + 1)) xcd_barrier(bar); } while (0)
    if (IN(0)) { phase_prologue(P, lds); }
    SEAM(0);
    if (IN(1)) {
        pg8::Gemm g{(const pg8::bf16_t*)(P.ws + WS_XB), (const pg8::bf16_t*)(P.ws + WS_WINT), NTOK, DIN, D};
        pg8::StaticOrder S; S.init(NTOK, DIN, (int)gridDim.x, (int)blockIdx.x);
        EpiProj E{P.out, (float*)(P.ws + WS_QF), (float*)(P.ws + WS_XR), (float*)(P.ws + WS_GATE)};
        pg8::gemm_phase<EpiProj, pg8::StaticOrder, false>(lds, g, S, E, nullptr);
    }
    SEAM(1);
    if (IN(2)) { phase_mixers(P, lds); }
    SEAM(2);
    if (IN(3)) {
        pg8::Gemm g{(const pg8::bf16_t*)(P.ws + WS_AR), (const pg8::bf16_t*)(P.ws + WS_WOT), NTOK, D, D};
        pg8::StaticOrder S; S.init(NTOK, D, (int)gridDim.x, (int)blockIdx.x);
        EpiOut E{P.x_prompt, P.x_sample, (float*)(P.ws + WS_PRE1)};
        pg8::gemm_phase<EpiOut, pg8::StaticOrder, false>(lds, g, S, E, nullptr);
    }
    SEAM(3);
    if (IN(4)) { phase_ln1(P); }
    SEAM(4);
    if (IN(5)) {
        pg8::Gemm g{(const pg8::bf16_t*)(P.ws + WS_X1B), (const pg8::bf16_t*)(P.ws + WS_WQT), NTOK, D, D};
        pg8::StaticOrder S; S.init(NTOK, D, (int)gridDim.x, (int)blockIdx.x);
        EpiPlain E{(float*)(P.ws + WS_QP), D};
        pg8::gemm_phase<EpiPlain, pg8::StaticOrder, false>(lds, g, S, E, nullptr);
    }
    SEAM(5);
    if (IN(6)) { phase_route(P, lds); }
    SEAM(6);
    if (IN(7)) { phase_experts(P); }
#undef IN
#undef SEAM
}
}

#ifndef MK_N_LAUNCHES
#define MK_N_LAUNCHES 1
#endif
extern "C" void kernel_launch(void* const* d_in, const int* in_sizes, int n_in, void* d_out, int out_size, void* d_ws, size_t ws_size, hipStream_t stream) {
    using namespace mk;
    static int grid = 0;
    if (grid == 0) {
        if (n_in != 23 || (size_t)out_size != O_END || ws_size < WS_END) { fprintf(stderr, "kernel_launch: unexpected shapes: n_in %d out %d ws %zu (need %zu)\n", n_in, out_size, ws_size, (size_t)WS_END); grid = -1; return; }
        int dev = 0, cus = 0, per_cu = 0;
        if (hipGetDevice(&dev) != hipSuccess || hipDeviceGetAttribute(&cus, hipDeviceAttributeMultiprocessorCount, dev) != hipSuccess) { grid = -1; return; }
        if (hipFuncSetAttribute((const void*)fwd, hipFuncAttributeMaxDynamicSharedMemorySize, LDS_BYTES) != hipSuccess) { fprintf(stderr, "kernel_launch: hipFuncSetAttribute failed\n"); grid = -1; return; }
        if (hipOccupancyMaxActiveBlocksPerMultiprocessor(&per_cu, (const void*)fwd, NTHREADS, LDS_BYTES) != hipSuccess || per_cu < 1) { fprintf(stderr, "kernel_launch: occupancy query says %d\n", per_cu); }
        (void)hipGetLastError();
        grid = cus;
    }
    if (grid < 0) return;
    (void)hipMemsetAsync((char*)d_ws + WS_CTL, 0, 65536, stream);
    Params p{};
    p.x_prompt = (const float*)d_in[0]; p.x_sample = (const float*)d_in[1]; p.cache_k = (const float*)d_in[2]; p.cache_v = (const float*)d_in[3];
    p.state_conv = (const float*)d_in[4]; p.state_h = (const float*)d_in[5]; p.w_in = (const float*)d_in[6]; p.conv_w = (const float*)d_in[7]; p.conv_b = (const float*)d_in[8];
    p.lru_w_a = (const float*)d_in[9]; p.lru_b_a = (const float*)d_in[10]; p.lru_w_x = (const float*)d_in[11]; p.lru_b_x = (const float*)d_in[12]; p.lru_lambda = (const float*)d_in[13];
    p.w_out = (const float*)d_in[14]; p.ln1_g = (const float*)d_in[15]; p.ln1_b = (const float*)d_in[16]; p.w_query = (const float*)d_in[17]; p.sub_keys = (const float*)d_in[18];
    p.peer_u = (const float*)d_in[19]; p.peer_v = (const float*)d_in[20]; p.ln2_g = (const float*)d_in[21]; p.ln2_b = (const float*)d_in[22];
    p.out = (float*)d_out; p.ws = (unsigned char*)d_ws;
#if MK_N_LAUNCHES == 1
    p.ph_lo = 0; p.ph_hi = NPHASE;
    hipLaunchKernelGGL(fwd, dim3(grid), dim3(NTHREADS), LDS_BYTES, stream, p);
#else
    for (int k = 0; k < NPHASE; ++k) { p.ph_lo = k; p.ph_hi = k + 1; hipLaunchKernelGGL(fwd, dim3(grid), dim3(NTHREADS), LDS_BYTES, stream, p); }
#endif
    const hipError_t le = hipPeekAtLastError();
    if (le != hipSuccess) fprintf(stderr, "kernel_launch: launch failed: %s\n", hipGetErrorName(le));
}
```

```cpp
#include <hip/hip_runtime.h>
#include <cstdio>
#include <cstdint>
namespace pg8 {
#define PG8_LAS __attribute__((address_space(3)))
typedef unsigned short bf16_t;
typedef short bf16x8 __attribute__((ext_vector_type(8)));
typedef float f32x4 __attribute__((ext_vector_type(4)));
typedef unsigned u32x4 __attribute__((ext_vector_type(4)));
constexpr int BM = 256, BK = 64, HALF = 128, HTB = HALF * BK * 2  , STAGE_BYTES = 8 * HTB, NXCD = 8, WGM = 8;

__host__ __device__ __forceinline__ int lds_byte(int r, int c) { const int st = (r >> 4) * 2 + (c >> 5), rr = r & 15, cc = c & 31, ob = rr * 64 + cc * 2; return st * 1024 + (ob ^ (((ob >> 9) & 1) << 5)); }
__host__ __device__ __forceinline__ void stage_rc(int b, int& R, int& C) { const int st = b / 1024, sb = b % 1024, swz = sb ^ (((sb >> 9) & 1) << 5); R = (st >> 1) * 16 + swz / 64; C = (st & 1) * 32 + (swz % 64) / 2; }
__host__ __device__ __forceinline__ int perm32(int rho) { const int n = rho >> 4, i = rho & 15; return 8 * (i >> 2) + 4 * n + (i & 3); }

struct Unit { int pm, pn; };
struct Gemm { const bf16_t* A; const bf16_t* Bt; int M, N, K; };

struct StaticOrder {
    int nM, nN, nwg, G, c;
    __host__ __device__ void init(int M, int N, int G_, int c_) { nM = M / BM; nN = N / BM; nwg = nM * nN; G = G_; c = c_; }
    __host__ __device__ bool next(int i, Unit& u) const {
        const long L = (long)i * G + c; if (L >= nwg) return false;
        int wgid = (int)L; { const int q = nwg / NXCD, r = nwg % NXCD, xcd = wgid % NXCD, off = wgid / NXCD; wgid = (xcd < r ? xcd * (q + 1) : r * (q + 1) + (xcd - r) * q) + off; }
        const int nig = WGM * nN, gid = wgid / nig, fm = gid * WGM, gsz = (nM - fm) < WGM ? (nM - fm) : WGM;
        u.pm = fm + ((wgid % nig) % gsz); u.pn = (wgid % nig) / gsz; return true;
    }
    __device__ __forceinline__ void a_ready(const Unit&) const {}
    __device__ __forceinline__ void done(const Unit&) const {}
};
struct CountedOrder : StaticOrder {
    const unsigned* ready; unsigned need; unsigned* tmo;
    __device__ __forceinline__ void a_ready(const Unit& u) const {
        if (threadIdx.x < 64) {
            const unsigned long long t0 = __builtin_amdgcn_s_memrealtime(); unsigned polls = 0;
            while ((unsigned)__builtin_amdgcn_readfirstlane(__hip_atomic_load(ready + 64 * u.pm, __ATOMIC_RELAXED, __HIP_MEMORY_SCOPE_AGENT)) < need) {
                if ((++polls & 255u) == 0u && __builtin_amdgcn_readfirstlane(__hip_atomic_load(tmo, __ATOMIC_RELAXED, __HIP_MEMORY_SCOPE_AGENT)) != 0u) break;
                if (__builtin_amdgcn_s_memrealtime() - t0 > 2000000ull) {
                    if (threadIdx.x == 0) { unsigned expect = 0u; __hip_atomic_compare_exchange_strong(tmo + 1, &expect, 0x600u | (unsigned)(u.pm & 0xff), __ATOMIC_RELAXED, __ATOMIC_RELAXED, __HIP_MEMORY_SCOPE_AGENT); __hip_atomic_store(tmo, 1u, __ATOMIC_RELAXED, __HIP_MEMORY_SCOPE_AGENT); }
                    break; }
                __builtin_amdgcn_s_sleep(2); }
            __builtin_amdgcn_fence(__ATOMIC_ACQUIRE, "agent");
            asm volatile("s_waitcnt vmcnt(0)" ::: "memory");
        }
#if !defined(BROKEN_HOOK_NO_BARRIER)
        asm volatile("" ::: "memory"); __builtin_amdgcn_s_barrier(); asm volatile("" ::: "memory");
#endif
    }
};

__device__ __forceinline__ unsigned cvt_pk_bf16(float lo, float hi) { unsigned r; asm volatile("v_cvt_pk_bf16_f32 %0, %1, %2" : "=v"(r) : "v"(lo), "v"(hi)); return r; }
typedef float f32x2 __attribute__((ext_vector_type(2)));
__device__ __forceinline__ f32x2 gelu_pk(f32x2 v) {
    const f32x2 av = __builtin_elementwise_abs(v), d = av * 0.2316418882f + 1.0f;
    f32x2 t; t.x = __builtin_amdgcn_rcpf(d.x); t.y = __builtin_amdgcn_rcpf(d.y);
    f32x2 q = t * 0.5307027145f + (-0.7265760135f); q = q * t + 0.7107068705f; q = q * t + (-0.142248368f); q = q * t + 0.127414796f; q = q * t;
    const f32x2 s = (v * v) * (-0.72134752044f);
    f32x2 e; e.x = __builtin_amdgcn_exp2f(s.x); e.y = __builtin_amdgcn_exp2f(s.y);
    const f32x2 m = v * (q * e), r = v - m;
    f32x2 o; o.x = v.x < 0.f ? m.x : r.x; o.y = v.y < 0.f ? m.y : r.y; return o;
}

struct EpiF32 {
    static constexpr bool PERM = false, AFTER_DRAIN = false;
    float* C; int ldc; const float* bias;
    __device__ __forceinline__ void operator()(const f32x4 (&acc)[2][2][4][2], const Unit& u, int wr, int wc, int fr, int fq) const {
        const int row0 = u.pm * BM + wr * 64 + fr, col0 = u.pn * BM + wc * 32 + 4 * fq;
        f32x4 bv[2][2];
#pragma unroll
        for (int bj = 0; bj < 2; ++bj)
#pragma unroll
            for (int n = 0; n < 2; ++n) bv[bj][n] = bias ? *(const f32x4*)(bias + col0 + bj * HALF + n * 16) : (f32x4){0.f, 0.f, 0.f, 0.f};
#pragma unroll
        for (int ai = 0; ai < 2; ++ai)
#pragma unroll
            for (int m = 0; m < 4; ++m) { float* rowp = C + (size_t)(row0 + ai * HALF + m * 16) * ldc + col0;
#pragma unroll
                for (int bj = 0; bj < 2; ++bj)
#pragma unroll
                    for (int n = 0; n < 2; ++n) *(f32x4*)(rowp + bj * HALF + n * 16) = acc[ai][bj][m][n] + bv[bj][n]; }
    }
};
template <int ACT  > struct EpiBf16 {
    static constexpr bool PERM = true, AFTER_DRAIN = false;
    bf16_t* O; int ldc; const float* bias; int split_cols; size_t split_stride;
    __device__ __forceinline__ void operator()(const f32x4 (&acc)[2][2][4][2], const Unit& u, int wr, int wc, int fr, int fq) const {
        const int row0 = u.pm * BM + wr * 64 + fr; int colt = u.pn * BM; bf16_t* base = O;
        if (split_cols) { const int t = colt / split_cols; base += (size_t)t * split_stride; colt -= t * split_cols; }
        const int col0 = colt + wc * 32 + 8 * fq, bcol0 = u.pn * BM + wc * 32 + 8 * fq;
        f32x4 bv[2][2];
#pragma unroll
        for (int bj = 0; bj < 2; ++bj)
#pragma unroll
            for (int n = 0; n < 2; ++n) bv[bj][n] = bias ? *(const f32x4*)(bias + bcol0 + bj * HALF + 4 * n) : (f32x4){0.f, 0.f, 0.f, 0.f};
#pragma unroll
        for (int ai = 0; ai < 2; ++ai)
#pragma unroll
            for (int m = 0; m < 4; ++m) { bf16_t* rowp = base + (size_t)(row0 + ai * HALF + m * 16) * ldc + col0;
#pragma unroll
                for (int bj = 0; bj < 2; ++bj) { f32x4 v0 = acc[ai][bj][m][0] + bv[bj][0], v1 = acc[ai][bj][m][1] + bv[bj][1];
                    if (ACT == 1) { f32x2 a = gelu_pk((f32x2){v0[0], v0[1]}), b = gelu_pk((f32x2){v0[2], v0[3]}), c = gelu_pk((f32x2){v1[0], v1[1]}), d = gelu_pk((f32x2){v1[2], v1[3]});
                        v0 = (f32x4){a.x, a.y, b.x, b.y}; v1 = (f32x4){c.x, c.y, d.x, d.y}; }
                    if (ACT == 2) {
#pragma unroll
                        for (int j = 0; j < 4; ++j) { v0[j] = 0.5f * v0[j] * (1.0f + erff(v0[j] * 0.70710678f)); v1[j] = 0.5f * v1[j] * (1.0f + erff(v1[j] * 0.70710678f)); } }
                    u32x4 w; w.x = cvt_pk_bf16(v0[0], v0[1]); w.y = cvt_pk_bf16(v0[2], v0[3]); w.z = cvt_pk_bf16(v1[0], v1[1]); w.w = cvt_pk_bf16(v1[2], v1[3]);
                    *(u32x4*)(rowp + bj * HALF) = w; } }
    }
};

struct PanelStats {
    unsigned* xbuf;
    unsigned* cnt;
    unsigned* tmo;
    int ntn; float eps;
    unsigned code;
    __device__ __forceinline__ bool run(const f32x4 (&v)[2][2][4][2], const Unit& u, int wr, int wc, int fr, int fq, PG8_LAS unsigned char* lds, int wid, int lane) const {
        typedef float f32x2v __attribute__((ext_vector_type(2)));
        PG8_LAS f32x2v* P = (PG8_LAS f32x2v*)lds;
        PG8_LAS f32x2v* S = (PG8_LAS f32x2v*)(lds + 8192);
        PG8_LAS unsigned* flag = (PG8_LAS unsigned*)(lds + 8192 + 2048);
#pragma unroll
        for (int ai = 0; ai < 2; ++ai)
#pragma unroll
            for (int m = 0; m < 4; ++m) {
                float s = 0.f;
#pragma unroll
                for (int bj = 0; bj < 2; ++bj)
#pragma unroll
                    for (int n = 0; n < 2; ++n) { const f32x4 x = v[ai][bj][m][n]; s += (x[0] + x[1]) + (x[2] + x[3]); }
                s += __shfl_xor(s, 16); s += __shfl_xor(s, 32);
                const float mw = s * (1.0f / 64.0f); float q = 0.f;
#pragma unroll
                for (int bj = 0; bj < 2; ++bj)
#pragma unroll
                    for (int n = 0; n < 2; ++n) { const f32x4 d = v[ai][bj][m][n] - mw; q += (d[0] * d[0] + d[1] * d[1]) + (d[2] * d[2] + d[3] * d[3]); }
                q += __shfl_xor(q, 16); q += __shfl_xor(q, 32);
                if (fq == 0) P[(ai * HALF + wr * 64 + m * 16 + fr) * 4 + wc] = (f32x2v){mw, q};
            }
        asm volatile("s_waitcnt lgkmcnt(0)" ::: "memory"); __builtin_amdgcn_s_barrier(); asm volatile("" ::: "memory");
#if defined(BROKEN_NO_WAIT)
        if (blockIdx.x >= 64) { const long long t0 = clock64(); while (clock64() - t0 < 60000) __builtin_amdgcn_s_sleep(8); }
#endif
        const int row = wid * 32 + (lane & 31);
        if (lane < 32) {
            const f32x2v a = P[row * 4 + 0], b = P[row * 4 + 1], c = P[row * 4 + 2], d = P[row * 4 + 3];
            const float mt = (a.x + b.x + c.x + d.x) * 0.25f;
            const float da = a.x - mt, db = b.x - mt, dc = c.x - mt, dd = d.x - mt;
            const float m2 = (a.y + b.y) + (c.y + d.y) + 64.0f * ((da * da + db * db) + (dc * dc + dd * dd));
            unsigned long long* slot = (unsigned long long*)xbuf + ((size_t)(u.pm * BM + row) * 4 + u.pn);
            __hip_atomic_store(slot, ((unsigned long long)__float_as_uint(m2) << 32) | __float_as_uint(mt), __ATOMIC_RELAXED, __HIP_MEMORY_SCOPE_AGENT);
        }
        asm volatile("s_waitcnt vmcnt(0)" ::: "memory");
        if (lane == 0) __hip_atomic_fetch_add(cnt + 64 * u.pm, 1u, __ATOMIC_RELAXED, __HIP_MEMORY_SCOPE_AGENT);
        if (wid == 0) {
            bool dead = false; const unsigned long long t0 = __builtin_amdgcn_s_memrealtime(); const unsigned want = 8u * (unsigned)ntn;
            for (;;) {
#if defined(BROKEN_NO_WAIT)
                break;
#endif
                if ((unsigned)__builtin_amdgcn_readfirstlane(__hip_atomic_load(cnt + 64 * u.pm, __ATOMIC_RELAXED, __HIP_MEMORY_SCOPE_AGENT)) >= want) break;
                if (__builtin_amdgcn_s_memrealtime() - t0 > 2000000ull) {
                    if (lane == 0) { unsigned expect = 0u; __hip_atomic_compare_exchange_strong(tmo + 1, &expect, code | (unsigned)(u.pm & 0xff), __ATOMIC_RELAXED, __ATOMIC_RELAXED, __HIP_MEMORY_SCOPE_AGENT);
                                     __hip_atomic_store(tmo, 1u, __ATOMIC_RELAXED, __HIP_MEMORY_SCOPE_AGENT); }
                    dead = true; break; }
                __builtin_amdgcn_s_sleep(2);
            }
            __builtin_amdgcn_fence(__ATOMIC_ACQUIRE, "agent");
            if (lane == 0) flag[0] = dead ? 1u : 0u;
        }
        asm volatile("s_waitcnt vmcnt(0) lgkmcnt(0)" ::: "memory"); __builtin_amdgcn_s_barrier(); asm volatile("" ::: "memory");
        const bool bad = flag[0] != 0u;
        if (lane < 32) {
            const unsigned long long* slot = (const unsigned long long*)xbuf + (size_t)(u.pm * BM + row) * 4; float mt[4], m2[4]; float ms = 0.f;
#pragma unroll
            for (int t = 0; t < 4; ++t) { if (t < ntn) { const unsigned long long w = __hip_atomic_load(slot + t, __ATOMIC_RELAXED, __HIP_MEMORY_SCOPE_AGENT); mt[t] = __uint_as_float((unsigned)w); m2[t] = __uint_as_float((unsigned)(w >> 32)); } else { mt[t] = 0.f; m2[t] = 0.f; } ms += mt[t]; }
            const float mean = ms / (float)ntn; float q = 0.f;
#pragma unroll
            for (int t = 0; t < 4; ++t) if (t < ntn) { const float dm = mt[t] - mean; q += m2[t] + 256.0f * dm * dm; }
            S[row] = (f32x2v){mean, 1.0f / sqrtf(q / (256.0f * (float)ntn) + eps)};
        }
        asm volatile("s_waitcnt lgkmcnt(0)" ::: "memory"); __builtin_amdgcn_s_barrier(); asm volatile("" ::: "memory");
        return bad;
    }
};
struct EpiLnRes {
    static constexpr bool PERM = false, AFTER_DRAIN = true;
    const float* base; float* out; int ldc; const float* bias; PanelStats st; unsigned poison;
    __device__ __forceinline__ void refuse(size_t i0, size_t stride, int M, int N) const { const float q = __builtin_nanf(""); for (size_t i = i0; i < (size_t)M * N; i += stride) out[(i / N) * ldc + i % N] = q;
        if (i0 == 0) { unsigned expect = 0u; __hip_atomic_compare_exchange_strong(st.tmo + 1, &expect, 0x7f0u, __ATOMIC_RELAXED, __ATOMIC_RELAXED, __HIP_MEMORY_SCOPE_AGENT); __hip_atomic_store(st.tmo, 1u, __ATOMIC_RELAXED, __HIP_MEMORY_SCOPE_AGENT); } }
    __device__ __forceinline__ void fused(f32x4 (&acc)[2][2][4][2], const Unit& u, int wr, int wc, int fr, int fq, PG8_LAS unsigned char* lds, int wid, int lane) const {
        typedef float f32x2v __attribute__((ext_vector_type(2)));
        const PG8_LAS f32x2v* S = (const PG8_LAS f32x2v*)(lds + 8192);
        const int col0 = u.pn * BM + wc * 32 + 4 * fq;
#pragma unroll
        for (int bj = 0; bj < 2; ++bj)
#pragma unroll
            for (int n = 0; n < 2; ++n) { const f32x4 bv = bias ? *(const f32x4*)(bias + col0 + bj * HALF + n * 16) : (f32x4){0.f, 0.f, 0.f, 0.f};
#pragma unroll
                for (int ai = 0; ai < 2; ++ai)
#pragma unroll
                    for (int m = 0; m < 4; ++m) acc[ai][bj][m][n] += bv; }
        const bool bad = st.run(acc, u, wr, wc, fr, fq, lds, wid, lane) || poison != 0u;
        const float qnan = __builtin_nanf("");
#pragma unroll
        for (int ai = 0; ai < 2; ++ai)
#pragma unroll
            for (int m = 0; m < 4; ++m) { const int r = ai * HALF + wr * 64 + m * 16 + fr; const f32x2v sr = S[r]; const size_t off = (size_t)(u.pm * BM + r) * ldc + col0;
#pragma unroll
                for (int bj = 0; bj < 2; ++bj)
#pragma unroll
                    for (int n = 0; n < 2; ++n) { const f32x4 bs = *(const f32x4*)(base + off + bj * HALF + n * 16); f32x4 o = bs + (acc[ai][bj][m][n] - sr.x) * sr.y;
                        if (bad) o = (f32x4){qnan, qnan, qnan, qnan}; *(f32x4*)(out + off + bj * HALF + n * 16) = o; }
                asm volatile("" ::: "memory"); }
    }
};
struct EpiLnResLn {
    static constexpr bool PERM = false, AFTER_DRAIN = true;
    const float* base; float* out; bf16_t* xn; int ldc; const float* bias; PanelStats st1, st2; unsigned poison;
    __device__ __forceinline__ void refuse(size_t i0, size_t stride, int M, int N) const { const float q = __builtin_nanf(""); for (size_t i = i0; i < (size_t)M * N; i += stride) { const size_t o = (i / N) * ldc + i % N; out[o] = q; xn[o] = (bf16_t)0x7fc0u; }
        if (i0 == 0) { unsigned expect = 0u; __hip_atomic_compare_exchange_strong(st1.tmo + 1, &expect, 0x7f0u, __ATOMIC_RELAXED, __ATOMIC_RELAXED, __HIP_MEMORY_SCOPE_AGENT); __hip_atomic_store(st1.tmo, 1u, __ATOMIC_RELAXED, __HIP_MEMORY_SCOPE_AGENT); } }
    __device__ __forceinline__ void fused(f32x4 (&acc)[2][2][4][2], const Unit& u, int wr, int wc, int fr, int fq, PG8_LAS unsigned char* lds, int wid, int lane) const {
        typedef float f32x2v __attribute__((ext_vector_type(2))); typedef unsigned u32x2v __attribute__((ext_vector_type(2)));
        const PG8_LAS f32x2v* S = (const PG8_LAS f32x2v*)(lds + 8192);
        const int col0 = u.pn * BM + wc * 32 + 4 * fq;
#pragma unroll
        for (int bj = 0; bj < 2; ++bj)
#pragma unroll
            for (int n = 0; n < 2; ++n) { const f32x4 bv = bias ? *(const f32x4*)(bias + col0 + bj * HALF + n * 16) : (f32x4){0.f, 0.f, 0.f, 0.f};
#pragma unroll
                for (int ai = 0; ai < 2; ++ai)
#pragma unroll
                    for (int m = 0; m < 4; ++m) acc[ai][bj][m][n] += bv; }
        bool bad = st1.run(acc, u, wr, wc, fr, fq, lds, wid, lane) || poison != 0u;
        const float qnan = __builtin_nanf("");
#pragma unroll
        for (int ai = 0; ai < 2; ++ai)
#pragma unroll
            for (int m = 0; m < 4; ++m) { const int r = ai * HALF + wr * 64 + m * 16 + fr; const f32x2v sr = S[r]; const size_t off = (size_t)(u.pm * BM + r) * ldc + col0;
#pragma unroll
                for (int bj = 0; bj < 2; ++bj)
#pragma unroll
                    for (int n = 0; n < 2; ++n) { const f32x4 bs = *(const f32x4*)(base + off + bj * HALF + n * 16); acc[ai][bj][m][n] = bs + (acc[ai][bj][m][n] - sr.x) * sr.y; }
                asm volatile("" : "+v"(acc[ai][0][m][0]), "+v"(acc[ai][0][m][1]), "+v"(acc[ai][1][m][0]), "+v"(acc[ai][1][m][1]));
                if (m & 1) asm volatile("" ::: "memory"); }
        const bool bad1 = bad;
        bad = st2.run(acc, u, wr, wc, fr, fq, lds, wid, lane) || bad;
#pragma unroll
        for (int ai = 0; ai < 2; ++ai)
#pragma unroll
            for (int m = 0; m < 4; ++m) { const int r = ai * HALF + wr * 64 + m * 16 + fr; const f32x2v sr = S[r]; const size_t off = (size_t)(u.pm * BM + r) * ldc + col0;
#pragma unroll
                for (int bj = 0; bj < 2; ++bj)
#pragma unroll
                    for (int n = 0; n < 2; ++n) { const f32x4 x1 = acc[ai][bj][m][n]; *(f32x4*)(out + off + bj * HALF + n * 16) = bad1 ? (f32x4){qnan, qnan, qnan, qnan} : x1;
                        const f32x4 o = (x1 - sr.x) * sr.y; u32x2v w; w.x = cvt_pk_bf16(o[0], o[1]); w.y = cvt_pk_bf16(o[2], o[3]);
                        if (bad) { w.x = 0x7fc07fc0u; w.y = 0x7fc07fc0u; } *(u32x2v*)(xn + off + bj * HALF + n * 16) = w; }
                asm volatile("" ::: "memory"); }
    }
};

template <class Epi, class Sched, bool STAMP = false>
__device__ __forceinline__ void gemm_phase(PG8_LAS unsigned char* lds, const Gemm g, const Sched& S, const Epi& E, unsigned long long* stamps) {
    const int tid = threadIdx.x, wid = __builtin_amdgcn_readfirstlane(tid >> 6), lane = tid & 63, wr = wid >> 2, wc = wid & 3, fr = lane & 15, fq = lane >> 4;
    const int K = g.K, nt = K / BK;
    int ts_lo = 0, ts_hi = 0, nts = 0; const unsigned long long rt_entry = STAMP ? (unsigned long long)wall_clock64() : 0ull;
#define PG8_STAMP() do { if (STAMP && wid == 0 && nts < 64) { const unsigned long long _c = (unsigned long long)clock64(); \
        ts_lo = (lane == nts) ? (int)(unsigned)_c : ts_lo; ts_hi = (lane == nts) ? (int)(unsigned)(_c >> 32) : ts_hi; ++nts; } } while (0)
    PG8_STAMP();
    unsigned voffA[2], voffB[2];
#pragma unroll
    for (int i = 0; i < 2; ++i) { int R, C; stage_rc(tid * 16 + i * 8192, R, C); const int Rb = Epi::PERM ? ((R & ~31) + perm32(R & 31)) : R;
        voffA[i] = (unsigned)(R * K + C) * 2u; voffB[i] = (unsigned)(Rb * K + C) * 2u; }
    const size_t kstep = (size_t)(BK * 2);
    const size_t hstep = (size_t)HALF * K * 2;
    const size_t tstep = 2 * hstep;
    const unsigned ldsw = (unsigned)wid * 1024u;
    const int aoff = lds_byte(wr * 64 + fr, fq * 8), boff = lds_byte(wc * 32 + fr, fq * 8);
#define PG8_SA(b, h) (((b) * 2 + (h)) * HTB)
#define PG8_SB(b, h) ((4 + (b) * 2 + (h)) * HTB)
#define PG8_STAGE(bufoff, gbase, voff) do { _Pragma("unroll") for (int _i = 0; _i < 2; ++_i) \
        __builtin_amdgcn_global_load_lds((const unsigned*)((const char*)(gbase) + (voff)[_i]), (PG8_LAS unsigned*)(lds + (bufoff) + ldsw + _i * 8192), 16, 0, 0); } while (0)
#define PG8_LDA(dst, b, h) do { _Pragma("unroll") for (int m = 0; m < 4; ++m) _Pragma("unroll") for (int k = 0; k < 2; ++k) dst[m][k] = *(const PG8_LAS bf16x8*)(lds + PG8_SA(b, h) + aoff + m * 2048 + k * 1024); } while (0)
#define PG8_LDB(dst, b, h) do { _Pragma("unroll") for (int n = 0; n < 2; ++n) _Pragma("unroll") for (int k = 0; k < 2; ++k) dst[n][k] = *(const PG8_LAS bf16x8*)(lds + PG8_SB(b, h) + boff + n * 2048 + k * 1024); } while (0)
#define PG8_MMA(ai, bj, At, Bt) do { __builtin_amdgcn_s_setprio(1); _Pragma("unroll") for (int m = 0; m < 4; ++m) _Pragma("unroll") for (int n = 0; n < 2; ++n) _Pragma("unroll") for (int k = 0; k < 2; ++k) \
        acc[ai][bj][m][n] = __builtin_amdgcn_mfma_f32_16x16x32_bf16(Bt[n][k], At[m][k], acc[ai][bj][m][n], 0, 0, 0); __builtin_amdgcn_s_setprio(0); } while (0)
#define PG8_WAIT_V(n) asm volatile("s_waitcnt vmcnt(" #n ")" ::: "memory")
#define PG8_WAIT_L(n) asm volatile("s_waitcnt lgkmcnt(" #n ")" ::: "memory")
#define PG8_BAR __builtin_amdgcn_s_barrier()
#define PG8_SCHED __builtin_amdgcn_sched_barrier(0)
    Unit cur, nxt; int ui = 0;
    if (!S.next(0, cur)) return;
    f32x4 acc[2][2][4][2];
#pragma unroll
    for (int a = 0; a < 2; ++a)
#pragma unroll
        for (int b = 0; b < 2; ++b)
#pragma unroll
            for (int m = 0; m < 4; ++m)
#pragma unroll
                for (int n = 0; n < 2; ++n) acc[a][b][m][n] = (f32x4){0.f, 0.f, 0.f, 0.f};
    bf16x8 At[4][2], B0[2][2], B1[2][2];
    const char* cA = (const char*)g.A + (size_t)cur.pm * tstep; const char* cB = (const char*)g.Bt + (size_t)cur.pn * tstep;
    S.a_ready(cur);
    PG8_STAGE(PG8_SB(0, 0), cB, voffB); PG8_STAGE(PG8_SA(0, 0), cA, voffA); PG8_STAGE(PG8_SB(0, 1), cB + hstep, voffB); PG8_STAGE(PG8_SA(0, 1), cA + hstep, voffA);
    if (wr == 1) PG8_BAR;
    PG8_WAIT_V(4); PG8_BAR;
    PG8_STAGE(PG8_SB(1, 0), cB + kstep, voffB); PG8_STAGE(PG8_SA(1, 0), cA + kstep, voffA); PG8_STAGE(PG8_SB(1, 1), cB + hstep + kstep, voffB);
    PG8_WAIT_V(6); PG8_BAR;
    PG8_STAMP();
    for (;;) {
        const bool has_next = S.next(ui + 1, nxt);
        const char* nA = has_next ? (const char*)g.A + (size_t)nxt.pm * tstep : cA; const char* nB = has_next ? (const char*)g.Bt + (size_t)nxt.pn * tstep : cB;
        for (int t = 0; t < nt; t += 2) {
            const bool last = (t == nt - 2);
            const char* a1 = cA + (size_t)(t + 1) * kstep;
            const char* a2 = last ? nA : cA + (size_t)(t + 2) * kstep; const char* b2 = last ? nB : cB + (size_t)(t + 2) * kstep;
            const char* a3 = a2 + kstep; const char* b3 = b2 + kstep;
            if (last && has_next) S.a_ready(nxt);
            PG8_LDB(B0, 0, 0); PG8_SCHED; PG8_LDA(At, 0, 0); PG8_STAGE(PG8_SA(1, 1), a1 + hstep, voffA);
            PG8_WAIT_L(8); PG8_BAR; PG8_WAIT_L(0); PG8_MMA(0, 0, At, B0); PG8_BAR; PG8_SCHED;
            PG8_LDB(B1, 0, 1); PG8_STAGE(PG8_SB(0, 0), b2, voffB);
            PG8_BAR; PG8_WAIT_L(0); PG8_MMA(0, 1, At, B1); PG8_BAR;
            PG8_LDA(At, 0, 1); PG8_STAGE(PG8_SA(0, 0), a2, voffA);
            PG8_BAR; PG8_WAIT_L(0); PG8_MMA(1, 0, At, B0); PG8_BAR; PG8_SCHED;
            PG8_STAGE(PG8_SB(0, 1), b2 + hstep, voffB);
            PG8_WAIT_V(6); PG8_BAR; PG8_MMA(1, 1, At, B1); PG8_BAR;
            PG8_LDB(B0, 1, 0); PG8_SCHED; PG8_LDA(At, 1, 0); PG8_STAGE(PG8_SA(0, 1), a2 + hstep, voffA);
            PG8_WAIT_L(8); PG8_BAR; PG8_WAIT_L(0); PG8_MMA(0, 0, At, B0); PG8_BAR; PG8_SCHED;
            PG8_LDB(B1, 1, 1); PG8_STAGE(PG8_SB(1, 0), b3, voffB);
            PG8_BAR; PG8_WAIT_L(0); PG8_MMA(0, 1, At, B1); PG8_BAR;
            PG8_LDA(At, 1, 1); PG8_STAGE(PG8_SA(1, 0), a3, voffA);
            PG8_BAR; PG8_WAIT_L(0); PG8_MMA(1, 0, At, B0); PG8_BAR; PG8_SCHED;
            PG8_STAGE(PG8_SB(1, 1), b3 + hstep, voffB);
            PG8_WAIT_V(6); PG8_BAR; PG8_MMA(1, 1, At, B1); PG8_BAR;
        }
        PG8_STAMP();
        if constexpr (!Epi::AFTER_DRAIN) { E(acc, cur, wr, wc, fr, fq); S.done(cur); }
        PG8_STAMP();
        if (!has_next) break;
#pragma unroll
        for (int a = 0; a < 2; ++a)
#pragma unroll
            for (int b = 0; b < 2; ++b)
#pragma unroll
                for (int m = 0; m < 4; ++m)
#pragma unroll
                    for (int n = 0; n < 2; ++n) acc[a][b][m][n] = (f32x4){0.f, 0.f, 0.f, 0.f};
        cur = nxt; cA = nA; cB = nB; ++ui;
    }
    PG8_WAIT_V(0);
    if (wr == 0) PG8_BAR;
    PG8_BAR;
    if constexpr (Epi::AFTER_DRAIN) { E.fused(acc, cur, wr, wc, fr, fq, lds, wid, lane); S.done(cur); }
    PG8_STAMP();
    if (STAMP && wid == 0) { stamps[lane] = lane < nts ? (((unsigned long long)(unsigned)ts_hi << 32) | (unsigned)ts_lo) : 0ull;
        if (lane == 62) stamps[62] = rt_entry; if (lane == 63) stamps[63] = (unsigned long long)wall_clock64(); }
#undef PG8_STAMP
#undef PG8_SA
#undef PG8_SB
#undef PG8_STAGE
#undef PG8_LDA
#undef PG8_LDB
#undef PG8_MMA
#undef PG8_WAIT_V
#undef PG8_WAIT_L
#undef PG8_BAR
#undef PG8_SCHED
}
}
#define XB_TMO      128
#define XB_XCNT(j)  (256  + 64 * (j))
#define XB_XSUB(j)  (1280 + 64 * (j))
#define XB_XGEN(j)  (2304 + 64 * (j))
#define XB_TOP      3328
#define XB_TOPGEN   3392
#define XCD_BAR_WORDS 3456
#define XB_SPIN_CAP (1u << 18)
#define LAS __attribute__((address_space(3)))

__device__ __forceinline__ unsigned xb_ld(unsigned* p)              { return __hip_atomic_load(p, __ATOMIC_RELAXED, __HIP_MEMORY_SCOPE_AGENT); }
__device__ __forceinline__ unsigned xb_add(unsigned* p, unsigned v) { return __hip_atomic_fetch_add(p, v, __ATOMIC_RELAXED, __HIP_MEMORY_SCOPE_AGENT); }
__device__ __forceinline__ unsigned xb_xcc_id() { return (unsigned)__builtin_amdgcn_s_getreg((3 << 11) | 20) & 0xFu; }
#define XB_SPIN(cond, bar) do { unsigned _sp = 0; while (cond) { __builtin_amdgcn_s_sleep(1); \
    if ((++_sp & 255u) == 0u) { if (xb_ld(&(bar)[XB_TMO])) break; if (_sp > XB_SPIN_CAP) { atomicAdd(&(bar)[XB_TMO], 1u); break; } } } } while (0)

struct XcdBarrier {
    unsigned* bar; unsigned x;
    volatile LAS unsigned* st;
};

__device__ __forceinline__ XcdBarrier xcd_barrier_post(unsigned* bar, volatile LAS unsigned* st) {
    XcdBarrier b; b.bar = bar; b.x = xb_xcc_id(); b.st = st;
    if (threadIdx.x == 0) (void)xb_add(&bar[XB_XCNT(b.x)], 1u);
    return b;
}
__device__ __forceinline__ void xcd_barrier_complete(unsigned* bar, unsigned x, unsigned& nloc, unsigned& nx) {
    const unsigned G = gridDim.x * gridDim.y * gridDim.z;
    unsigned sum, cnt, mine, sp = 0u;
    for (;;) {
        sum = 0u; cnt = 0u; mine = 0u;
#pragma unroll
        for (unsigned j = 0; j < 16; ++j) { const unsigned c = xb_ld(&bar[XB_XCNT(j)]); sum += c; cnt += (c > 0u) ? 1u : 0u; mine = (j == x) ? c : mine; }
        if (sum == G) break;
        __builtin_amdgcn_s_sleep(1);
        if ((++sp & 255u) == 0u) { if (xb_ld(&bar[XB_TMO])) break; if (sp > XB_SPIN_CAP) { atomicAdd(&bar[XB_TMO], 1u); break; } }
    }
    nloc = mine > 0u ? mine : 1u; nx = cnt > 0u ? cnt : 1u;
}

__device__ __forceinline__ void xcd_barrier(const XcdBarrier& b) {
    asm volatile("s_waitcnt vmcnt(0)" ::: "memory");
    __syncthreads();
    if (threadIdx.x == 0) {
        unsigned* bar = b.bar;
        __builtin_amdgcn_s_waitcnt(0);
        unsigned nloc = b.st[0], nx = b.st[1];
        if (nloc == 0u) { xcd_barrier_complete(bar, b.x, nloc, nx); b.st[0] = nloc; b.st[1] = nx; }
        const unsigned old = xb_add(&bar[XB_XSUB(b.x)], 1u);
        const unsigned gen = old / nloc;
        if (old + 1u == (gen + 1u) * nloc) {
            __builtin_amdgcn_fence(__ATOMIC_RELEASE, "agent");
            asm volatile("s_waitcnt vmcnt(0)" ::: "memory");
            const unsigned og = xb_add(&bar[XB_TOP], 1u);
            const unsigned tg = og / nx;
            if (og + 1u == (tg + 1u) * nx) xb_add(&bar[XB_TOPGEN], 1u);
            else XB_SPIN(xb_ld(&bar[XB_TOPGEN]) == tg, bar);
            __builtin_amdgcn_fence(__ATOMIC_ACQUIRE, "agent");
            xb_add(&bar[XB_XGEN(b.x)], 1u);
            asm volatile("s_waitcnt vmcnt(0)" ::: "memory");
        } else {
            XB_SPIN(xb_ld(&bar[XB_XGEN(b.x)]) == gen, bar);
            __builtin_amdgcn_fence(__ATOMIC_ACQUIRE, "agent");
            asm volatile("s_waitcnt vmcnt(0)" ::: "memory");
        }
    }
    __syncthreads();
}


namespace mk {
typedef unsigned short bf16_t;
typedef float f32x4 __attribute__((ext_vector_type(4)));
typedef short bf16x8 __attribute__((ext_vector_type(8)));
typedef short s16x4 __attribute__((ext_vector_type(4)));
typedef unsigned u32x4 __attribute__((ext_vector_type(4)));
typedef unsigned u32x2 __attribute__((ext_vector_type(2)));
constexpr int D = 2048, NTOK_P = 16384, NTOK_S = 256, NTOK = 16640;
constexpr int DIN = 5632, DATT = 1536, DLRU = 512, NH = 12, HD = 128;
constexpr int NEXP = 16384;
constexpr float ALPHA = 1.189207115002721f;
constexpr float LN_EPS = 1e-5f;
constexpr float ATT_SCALE = 0.08838834764831845f;
constexpr float LOG2E = 1.4426950408889634f;
constexpr size_t O_YP = 0, O_YS = 33554432, O_KP = 34078720, O_VP = 59244544, O_CP = 84410368, O_HP = 84422656,
                 O_KS = 84426752, O_VS = 185090048, O_CS = 285753344, O_HS = 285802496, O_END = 285818880;
constexpr size_t WS_CTL = 0;
constexpr size_t WS_XB = 65536;
constexpr size_t WS_WINT = WS_XB + (size_t)NTOK * D * 2;
constexpr size_t WS_WOT = WS_WINT + (size_t)DIN * D * 2;
constexpr size_t WS_WQT = WS_WOT + (size_t)D * D * 2;
constexpr size_t WS_UB = WS_WQT + (size_t)D * D * 2;
constexpr size_t WS_VB = WS_UB + (size_t)NEXP * D * 2;
constexpr size_t WS_QF = WS_VB + (size_t)NEXP * D * 2;
constexpr size_t WS_XR = WS_QF + (size_t)NTOK * DATT * 4;
constexpr size_t WS_GATE = WS_XR + (size_t)NTOK * DLRU * 4;
constexpr size_t WS_AR = WS_GATE + (size_t)NTOK * DLRU * 4;
constexpr size_t WS_PRE1 = WS_AR + (size_t)NTOK * D * 2;
constexpr size_t WS_X1F = WS_PRE1 + (size_t)NTOK * D * 4;
constexpr size_t WS_X1B = WS_X1F + (size_t)NTOK * D * 4;
constexpr size_t WS_QP = WS_X1B + (size_t)NTOK * D * 2;
constexpr size_t WS_EIDX = WS_QP + (size_t)NTOK * D * 4;
constexpr size_t WS_GW = WS_EIDX + (size_t)NTOK * 128 * 4;
constexpr size_t WS_QB = WS_GW + (size_t)NTOK * 128 * 4;
constexpr size_t WS_KB = WS_QB + (size_t)NTOK_P * DATT * 2;
constexpr size_t WS_VB16 = WS_KB + (size_t)NTOK_P * DATT * 2;
constexpr size_t WS_PO = WS_VB16 + (size_t)NTOK_P * DATT * 2;
constexpr size_t WS_PM = WS_PO + (size_t)2 * NTOK_P * DATT * 2;
constexpr size_t WS_PL = WS_PM + (size_t)2 * NTOK_P * NH * 4;
constexpr size_t WS_R0 = WS_PL + (size_t)2 * NTOK_P * NH * 4;
constexpr size_t WS_R1 = WS_R0 + (size_t)NTOK_P * DLRU * 4;
constexpr size_t WS_HE = WS_R1 + (size_t)NTOK_P * DLRU * 4;
constexpr size_t WS_AE = WS_HE + (size_t)8 * 32 * 512 * 4;
constexpr size_t WS_END = WS_AE + (size_t)8 * 32 * 512 * 4;

constexpr int NTHREADS = 512;
constexpr int LDS_BYTES = 148480;
constexpr int MISC_OFF = 147456;

struct Params {
    const float* x_prompt; const float* x_sample; const float* cache_k; const float* cache_v; const float* state_conv; const float* state_h;
    const float* w_in; const float* conv_w; const float* conv_b; const float* lru_w_a; const float* lru_b_a; const float* lru_w_x; const float* lru_b_x;
    const float* lru_lambda; const float* w_out; const float* ln1_g; const float* ln1_b; const float* w_query; const float* sub_keys;
    const float* peer_u; const float* peer_v; const float* ln2_g; const float* ln2_b;
    float* out; unsigned char* ws; int ph_lo, ph_hi;
};

__device__ __forceinline__ unsigned f2bf(float f) { unsigned u = __float_as_uint(f); u += 0x7fffu + ((u >> 16) & 1u); return u >> 16; }
__device__ __forceinline__ unsigned pack2(float a, float b) { return f2bf(a) | (f2bf(b) << 16); }
__device__ __forceinline__ float bflo(unsigned w) { return __uint_as_float(w << 16); }
__device__ __forceinline__ float bfhi(unsigned w) { return __uint_as_float(w & 0xffff0000u); }
__device__ __forceinline__ float wave_sum(float v) {
#pragma unroll
    for (int o = 32; o >= 1; o >>= 1) v += __shfl_xor(v, o);
    return v;
}
__device__ __forceinline__ float wave_max(float v) {
#pragma unroll
    for (int o = 32; o >= 1; o >>= 1) v = fmaxf(v, __shfl_xor(v, o));
    return v;
}
__device__ __forceinline__ float gelu_exact(float v) { return 0.5f * v * (1.0f + erff(v * 0.7071067811865476f)); }
__device__ __forceinline__ float sigmoidf(float v) { return 1.0f / (1.0f + expf(-v)); }
__device__ __forceinline__ float readlane_f(float v, int l) { return __int_as_float(__builtin_amdgcn_readlane(__float_as_int(v), l)); }

__device__ __forceinline__ void convert_flat(const float* src, bf16_t* dst, size_t n8, size_t gtid, size_t gstride) {
    for (size_t i = gtid; i < n8; i += gstride) {
        const float4 a = ((const float4*)src)[2 * i], b = ((const float4*)src)[2 * i + 1];
        uint4 w; w.x = pack2(a.x, a.y); w.y = pack2(a.z, a.w); w.z = pack2(b.x, b.y); w.w = pack2(b.z, b.w);
        ((uint4*)dst)[i] = w;
    }
}
__device__ __forceinline__ void transpose_convert(const float* src, bf16_t* dst, int K, int N, LAS float* tile) {
    const int tid = threadIdx.x, ntn = N / 64, ntiles = (K / 64) * ntn;
    for (int tl = blockIdx.x; tl < ntiles; tl += gridDim.x) {
        const int kt = tl / ntn, nt = tl - kt * ntn;
#pragma unroll
        for (int i = 0; i < 8; ++i) { const int r = (tid >> 6) + 8 * i, c = tid & 63; tile[r * 65 + c] = src[(size_t)(kt * 64 + r) * N + nt * 64 + c]; }
        __syncthreads();
#pragma unroll
        for (int i = 0; i < 4; ++i) { const int n = (tid >> 5) + 16 * i, k0 = 2 * (tid & 31);
            const unsigned v = pack2(tile[k0 * 65 + n], tile[(k0 + 1) * 65 + n]);
            *(unsigned*)(dst + (size_t)(nt * 64 + n) * K + kt * 64 + k0) = v; }
        __syncthreads();
    }
}
__device__ __forceinline__ void phase_prologue(const Params& P, LAS unsigned char* lds) {
    const size_t gtid = (size_t)blockIdx.x * NTHREADS + threadIdx.x, gstride = (size_t)gridDim.x * NTHREADS;
    unsigned char* ws = P.ws;
    convert_flat(P.x_prompt, (bf16_t*)(ws + WS_XB), (size_t)NTOK_P * D / 8, gtid, gstride);
    convert_flat(P.x_sample, (bf16_t*)(ws + WS_XB) + (size_t)NTOK_P * D, (size_t)NTOK_S * D / 8, gtid, gstride);
    convert_flat(P.peer_u, (bf16_t*)(ws + WS_UB), (size_t)NEXP * D / 8, gtid, gstride);
    convert_flat(P.peer_v, (bf16_t*)(ws + WS_VB), (size_t)NEXP * D / 8, gtid, gstride);
    transpose_convert(P.w_in, (bf16_t*)(ws + WS_WINT), D, DIN, (LAS float*)lds);
    transpose_convert(P.w_out, (bf16_t*)(ws + WS_WOT), D, D, (LAS float*)lds);
    transpose_convert(P.w_query, (bf16_t*)(ws + WS_WQT), D, D, (LAS float*)lds);
    const size_t n4b = (size_t)2040 * DATT / 4, tot = 32 * n4b;
    for (size_t i = gtid; i < 2 * tot; i += gstride) {
        const int tz = i >= tot; const size_t j = i - (tz ? tot : 0); const size_t b = j / n4b, r = j - b * n4b;
        const float4* src = (const float4*)(tz ? P.cache_v : P.cache_k) + (b * 2048 + 8) * (DATT / 4) + r;
        float4* dst = (float4*)(P.out + (tz ? O_VS : O_KS)) + b * 2048 * (DATT / 4) + r;
        *dst = *src;
    }
}

struct EpiProj {
    static constexpr bool PERM = false, AFTER_DRAIN = false;
    float* out; float* QF; float* XR; float* GATE; bf16_t* QB; bf16_t* KB; bf16_t* VB16;
    __device__ __forceinline__ void operator()(const f32x4 (&acc)[2][2][4][2], const pg8::Unit& u, int wr, int wc, int fr, int fq) const {
        const int pn = u.pn; const int coff = wc * 32 + 4 * fq;
#pragma unroll
        for (int ai = 0; ai < 2; ++ai)
#pragma unroll
            for (int m = 0; m < 4; ++m) {
                const int row = u.pm * 256 + ai * 128 + wr * 64 + m * 16 + fr;
                const bool prompt = row < NTOK_P;
                float* rowp = nullptr; bf16_t* rowb = nullptr; float bsc = 1.0f;
                if (pn < 6) { if (prompt) { rowb = QB + (size_t)row * DATT + pn * 256; bsc = ATT_SCALE * LOG2E; } else rowp = QF + (size_t)row * DATT + pn * 256; }
                else if (pn < 18) {
                    const int isv = pn >= 12; const int c0 = (pn - (isv ? 12 : 6)) * 256;
                    if (prompt) { rowp = out + (isv ? O_VP : O_KP) + (size_t)row * DATT + c0; rowb = (isv ? VB16 : KB) + (size_t)row * DATT + c0; }
                    else { const int rr = row - NTOK_P, b = rr >> 3, t = rr & 7; rowp = out + (isv ? O_VS : O_KS) + ((size_t)b * 2048 + 2040 + t) * DATT + c0; }
                } else if (pn < 20) rowp = XR + (size_t)row * DLRU + (pn - 18) * 256;
                else rowp = GATE + (size_t)row * DLRU + (pn - 20) * 256;
#pragma unroll
                for (int bj = 0; bj < 2; ++bj)
#pragma unroll
                    for (int n = 0; n < 2; ++n) {
                        const f32x4 v = acc[ai][bj][m][n];
                        if (rowp) *(f32x4*)(rowp + coff + bj * 128 + n * 16) = v;
                        if (rowb) { u32x2 w; w.x = pg8::cvt_pk_bf16(v[0] * bsc, v[1] * bsc); w.y = pg8::cvt_pk_bf16(v[2] * bsc, v[3] * bsc); *(u32x2*)(rowb + coff + bj * 128 + n * 16) = w; }
                    }
            }
    }
};
struct EpiOut {
    static constexpr bool PERM = false, AFTER_DRAIN = false;
    const float* xp; const float* xs; float* pre;
    __device__ __forceinline__ void operator()(const f32x4 (&acc)[2][2][4][2], const pg8::Unit& u, int wr, int wc, int fr, int fq) const {
        const int col0 = u.pn * 256 + wc * 32 + 4 * fq;
#pragma unroll
        for (int ai = 0; ai < 2; ++ai)
#pragma unroll
            for (int m = 0; m < 4; ++m) {
                const int row = u.pm * 256 + ai * 128 + wr * 64 + m * 16 + fr;
                const float* xr = (row < NTOK_P ? xp + (size_t)row * D : xs + (size_t)(row - NTOK_P) * D) + col0;
                float* pr = pre + (size_t)row * D + col0;
#pragma unroll
                for (int bj = 0; bj < 2; ++bj)
#pragma unroll
                    for (int n = 0; n < 2; ++n) { const f32x4 xv = *(const f32x4*)(xr + bj * 128 + n * 16); *(f32x4*)(pr + bj * 128 + n * 16) = xv * ALPHA + acc[ai][bj][m][n]; }
            }
    }
};
struct EpiPlain {
    static constexpr bool PERM = false, AFTER_DRAIN = false;
    float* C; int ldc;
    __device__ __forceinline__ void operator()(const f32x4 (&acc)[2][2][4][2], const pg8::Unit& u, int wr, int wc, int fr, int fq) const {
        const int col0 = u.pn * 256 + wc * 32 + 4 * fq;
#pragma unroll
        for (int ai = 0; ai < 2; ++ai)
#pragma unroll
            for (int m = 0; m < 4; ++m) {
                const int row = u.pm * 256 + ai * 128 + wr * 64 + m * 16 + fr;
                float* pr = C + (size_t)row * ldc + col0;
#pragma unroll
                for (int bj = 0; bj < 2; ++bj)
#pragma unroll
                    for (int n = 0; n < 2; ++n) *(f32x4*)(pr + bj * 128 + n * 16) = acc[ai][bj][m][n];
            }
    }
};

__device__ __forceinline__ const float* kv_row(const Params& P, bool isv, bool samp, int b, int pos, int h) {
    if (!samp) return P.out + (isv ? O_VP : O_KP) + ((size_t)(b * 2048 + pos) * DATT + h * HD);
    if (pos < 2048) return (isv ? P.cache_v : P.cache_k) + ((size_t)(b * 2048 + pos) * DATT + h * HD);
    return P.out + (isv ? O_VS : O_KS) + ((size_t)(b * 2048 + 2040 + (pos - 2048)) * DATT + h * HD);
}
__device__ __forceinline__ void attn_simple_unit(const Params& P, int row, int h, LAS float* wl, int lane) {
    const bool samp = row >= NTOK_P; int b, t;
    if (!samp) { b = row >> 11; t = row & 2047; } else { b = (row - NTOK_P) >> 3; t = (row - NTOK_P) & 7; }
    const float* qrow = (const float*)(P.ws + WS_QF) + (size_t)row * DATT + h * HD;
    wl[lane] = qrow[lane]; wl[64 + lane] = qrow[64 + lane];
    __builtin_amdgcn_wave_barrier();
    const float slope = exp2f(-8.0f * (float)(h + 1) / 12.0f);
    const int base = samp ? 2048 : 0;
    float sc[7]; float mx = -INFINITY;
#pragma unroll
    for (int r = 0; r < 7; ++r) {
        const int idx = r * 64 + lane; float s = -INFINITY;
        if (idx < 387) {
            const int pz = idx / 129, d = idx - pz * 129, dil = 1 << (2 * pz), pos = base + t - dil * d;
            if (pos >= 0) {
                const float4* kr = (const float4*)kv_row(P, false, samp, b, pos, h); float a = 0.f;
#pragma unroll 8
                for (int e4 = 0; e4 < 32; ++e4) { const float4 kv = kr[e4]; const f32x4 qv = ((LAS f32x4*)wl)[e4]; a += kv.x * qv.x + kv.y * qv.y + kv.z * qv.z + kv.w * qv.w; }
                s = a * ATT_SCALE - slope * (float)(dil * d);
            }
        }
        sc[r] = s; mx = fmaxf(mx, s);
    }
    mx = wave_max(mx);
    float l = 0.f;
#pragma unroll
    for (int r = 0; r < 7; ++r) { const float p = (sc[r] == -INFINITY) ? 0.f : expf(sc[r] - mx); wl[128 + r * 64 + lane] = p; l += p; }
    l = wave_sum(l);
    __builtin_amdgcn_wave_barrier();
    float o0 = 0.f, o1 = 0.f;
    for (int idx = 0; idx < 387; ++idx) {
        const float p = wl[128 + idx];
        if (p != 0.f) {
            const int pz = idx / 129, d = idx - pz * 129, dil = 1 << (2 * pz), pos = base + t - dil * d;
            const float2 vv = ((const float2*)kv_row(P, true, samp, b, pos, h))[lane];
            o0 += p * vv.x; o1 += p * vv.y;
        }
    }
    const float inv = 1.0f / l;
    bf16_t* ar = (bf16_t*)(P.ws + WS_AR) + (size_t)row * D + h * HD;
    *(unsigned*)(ar + 2 * lane) = pack2(o0 * inv, o1 * inv);
    __builtin_amdgcn_wave_barrier();
}

constexpr int KVS = 288, VOFF = 73728;
template <int MODE>
__device__ __forceinline__ void attn_unit(const Params& P, int p, int b, int h, int r, int c, LAS unsigned char* lds) {
    const int tid = threadIdx.x, lane = tid & 63, w = __builtin_amdgcn_readfirstlane(tid >> 6);
    const int dil = 1 << (2 * p);
    const bf16_t* Qb = (const bf16_t*)(P.ws + WS_QB); const bf16_t* Kb = (const bf16_t*)(P.ws + WS_KB); const bf16_t* Vb = (const bf16_t*)(P.ws + WS_VB16);
    const size_t tok0 = (size_t)b * 2048;
    const int j0 = 128 * c - 128, rho0 = (c == 0) ? 128 : 0;
#pragma unroll
    for (int it = 0; it < 8; ++it) {
        const int rho = it * 32 + (tid >> 4), ch = tid & 15;
        if (rho >= rho0) {
            const size_t tok = tok0 + (size_t)((j0 + rho) * dil + r);
            const u32x4 kv = *(const u32x4*)(Kb + tok * DATT + h * HD + ch * 8);
            const u32x4 vv = *(const u32x4*)(Vb + tok * DATT + h * HD + ch * 8);
            *(LAS u32x4*)(lds + rho * KVS + ch * 16) = kv;
            *(LAS u32x4*)(lds + VOFF + rho * KVS + ch * 16) = vv;
        }
    }
    const int cq = lane & 15, g = lane >> 4;
    const int iq = 128 * c + 16 * w + cq;
    const size_t qtok = tok0 + (size_t)(iq * dil + r);
    bf16x8 qf[4];
#pragma unroll
    for (int ks = 0; ks < 4; ++ks) qf[ks] = *(const bf16x8*)(Qb + qtok * DATT + h * HD + 32 * ks + 8 * g);
    __syncthreads();
    const int ktmin = (8 - w - 8 * c) > 0 ? (8 - w - 8 * c) : 0;
    const float slope2 = exp2f(-8.0f * (float)(h + 1) / 12.0f) * LOG2E * (float)dil;
    f32x4 s[9]; float m = -INFINITY;
#pragma unroll
    for (int kt = 0; kt < 9; ++kt) {
        if (kt >= ktmin) {
            f32x4 acc = {0.f, 0.f, 0.f, 0.f};
#pragma unroll
            for (int ks = 0; ks < 4; ++ks) { const bf16x8 kf = *(const LAS bf16x8*)(lds + (16 * w + 16 * kt + cq) * KVS + (32 * ks + 8 * g) * 2); acc = __builtin_amdgcn_mfma_f32_16x16x32_bf16(kf, qf[ks], acc, 0, 0, 0); }
#pragma unroll
            for (int ii = 0; ii < 4; ++ii) { const int dist = cq + 128 - 16 * kt - 4 * g - ii; float v = acc[ii] - slope2 * (float)dist;
                if (kt == 0 && dist > 128) v = -INFINITY; if (kt == 8 && dist < 0) v = -INFINITY; acc[ii] = v; m = fmaxf(m, v); }
            s[kt] = acc;
        } else s[kt] = (f32x4){-INFINITY, -INFINITY, -INFINITY, -INFINITY};
    }
    m = fmaxf(m, __shfl_xor(m, 16)); m = fmaxf(m, __shfl_xor(m, 32));
    float l = 0.f;
#pragma unroll
    for (int kt = 0; kt < 9; ++kt)
#pragma unroll
        for (int ii = 0; ii < 4; ++ii) { const float pp = exp2f(s[kt][ii] - m); s[kt][ii] = pp; l += pp; }
    l += __shfl_xor(l, 16); l += __shfl_xor(l, 32);
    f32x4 o[8];
#pragma unroll
    for (int dt = 0; dt < 8; ++dt) o[dt] = (f32x4){0.f, 0.f, 0.f, 0.f};
#pragma unroll
    for (int kk = 0; kk < 5; ++kk) {
        const int T0 = 2 * kk, T1 = 2 * kk + 1;
        if (T1 >= ktmin || T0 == 8) {
            u32x4 pw; pw.x = pg8::cvt_pk_bf16(s[T0][0], s[T0][1]); pw.y = pg8::cvt_pk_bf16(s[T0][2], s[T0][3]);
            if (T1 <= 8) { pw.z = pg8::cvt_pk_bf16(s[T1 <= 8 ? T1 : 8][0], s[T1 <= 8 ? T1 : 8][1]); pw.w = pg8::cvt_pk_bf16(s[T1 <= 8 ? T1 : 8][2], s[T1 <= 8 ? T1 : 8][3]); } else { pw.z = 0u; pw.w = 0u; }
            const bf16x8 pf = __builtin_bit_cast(bf16x8, pw);
            const int rT0 = (T0 >= ktmin) ? T0 : 8, rT1 = (T1 <= 8 && T1 >= ktmin) ? T1 : 8;
            const int a0 = VOFF + (16 * w + 16 * rT0 + 4 * g + (cq >> 2)) * KVS + 8 * (cq & 3);
            const int a1 = VOFF + (16 * w + 16 * rT1 + 4 * g + (cq >> 2)) * KVS + 8 * (cq & 3);
#pragma unroll
            for (int dt = 0; dt < 8; ++dt) {
                const s16x4 v0 = __builtin_amdgcn_ds_read_tr16_b64_v4i16((LAS s16x4*)(lds + a0 + dt * 32));
                const s16x4 v1 = __builtin_amdgcn_ds_read_tr16_b64_v4i16((LAS s16x4*)(lds + a1 + dt * 32));
                const bf16x8 vf = {v0[0], v0[1], v0[2], v0[3], v1[0], v1[1], v1[2], v1[3]};
                o[dt] = __builtin_amdgcn_mfma_f32_16x16x32_bf16(vf, pf, o[dt], 0, 0, 0);
            }
        }
    }
    const float inv = 1.0f / l;
    if (MODE == 0) {
        bf16_t* po = (bf16_t*)(P.ws + WS_PO) + ((size_t)p * NTOK_P + qtok) * DATT + h * HD + 4 * g;
#pragma unroll
        for (int dt = 0; dt < 8; ++dt) { u32x2 wv; wv.x = pg8::cvt_pk_bf16(o[dt][0] * inv, o[dt][1] * inv); wv.y = pg8::cvt_pk_bf16(o[dt][2] * inv, o[dt][3] * inv); *(u32x2*)(po + 16 * dt) = wv; }
        if (g == 0) { ((float*)(P.ws + WS_PM))[((size_t)p * NTOK_P + qtok) * NH + h] = m; ((float*)(P.ws + WS_PL))[((size_t)p * NTOK_P + qtok) * NH + h] = l; }
    } else {
        const float* PM = (const float*)(P.ws + WS_PM); const float* PL = (const float*)(P.ws + WS_PL);
        const float m0 = PM[qtok * NH + h], l0 = PL[qtok * NH + h], m1 = PM[((size_t)NTOK_P + qtok) * NH + h], l1 = PL[((size_t)NTOK_P + qtok) * NH + h];
        const float M = fmaxf(m, fmaxf(m0, m1));
        const float w2 = exp2f(m - M), w0 = exp2f(m0 - M) * l0, w1 = exp2f(m1 - M) * l1;
        const float rden = 1.0f / (w2 * l + w0 + w1);
        const bf16_t* p0 = (const bf16_t*)(P.ws + WS_PO) + qtok * DATT + h * HD + 4 * g;
        const bf16_t* p1 = p0 + (size_t)NTOK_P * DATT;
        bf16_t* ar = (bf16_t*)(P.ws + WS_AR) + qtok * D + h * HD + 4 * g;
#pragma unroll
        for (int dt = 0; dt < 8; ++dt) {
            const u32x2 x0 = *(const u32x2*)(p0 + 16 * dt), x1 = *(const u32x2*)(p1 + 16 * dt);
            const float r0 = (w2 * o[dt][0] + w0 * bflo(x0.x) + w1 * bflo(x1.x)) * rden, r1 = (w2 * o[dt][1] + w0 * bfhi(x0.x) + w1 * bfhi(x1.x)) * rden;
            const float r2 = (w2 * o[dt][2] + w0 * bflo(x0.y) + w1 * bflo(x1.y)) * rden, r3 = (w2 * o[dt][3] + w0 * bfhi(x0.y) + w1 * bfhi(x1.y)) * rden;
            u32x2 wv; wv.x = pg8::cvt_pk_bf16(r0, r1); wv.y = pg8::cvt_pk_bf16(r2, r3); *(u32x2*)(ar + 16 * dt) = wv;
        }
    }
    __syncthreads();
}

__device__ __forceinline__ void lru_unit(const Params& P, bool samp, int b, int n, int k, int lane) {
    const int T = samp ? 8 : 64; const int row0 = samp ? NTOK_P + b * 8 : b * 2048 + k * 64; const int ch = n * 64 + lane;
    float wa[64], wx[64];
#pragma unroll
    for (int c = 0; c < 64; ++c) { wa[c] = P.lru_w_a[(n * 64 + c) * 64 + lane]; wx[c] = P.lru_w_x[(n * 64 + c) * 64 + lane]; }
    const float ba = P.lru_b_a[ch], bx = P.lru_b_x[ch], lam = P.lru_lambda[ch];
    const float sp = log1pf(expf(-lam));
    const float cw0 = P.conv_w[ch], cw1 = P.conv_w[512 + ch], cw2 = P.conv_w[1024 + ch], cw3 = P.conv_w[1536 + ch], cb = P.conv_b[ch];
    const float* XR = (const float*)(P.ws + WS_XR); const float* GT = (const float*)(P.ws + WS_GATE);
    float* R0 = (float*)(P.ws + WS_R0); float* R1 = (float*)(P.ws + WS_R1); bf16_t* AR = (bf16_t*)(P.ws + WS_AR);
    float x0 = 0.f, x1 = 0.f, x2 = 0.f, h = 0.f, A = 1.f;
    if (samp) { x0 = P.state_conv[(b * 3 + 0) * 512 + ch]; x1 = P.state_conv[(b * 3 + 1) * 512 + ch]; x2 = P.state_conv[(b * 3 + 2) * 512 + ch]; h = P.state_h[b * 512 + ch]; }
    else if (k > 0) { x0 = XR[(size_t)(row0 - 3) * DLRU + ch]; x1 = XR[(size_t)(row0 - 2) * DLRU + ch]; x2 = XR[(size_t)(row0 - 1) * DLRU + ch]; }
    for (int t0 = 0; t0 < T; t0 += 8) {
        float xin[8], gt[8];
#pragma unroll
        for (int i = 0; i < 8; ++i) { xin[i] = XR[(size_t)(row0 + t0 + i) * DLRU + ch]; gt[i] = GT[(size_t)(row0 + t0 + i) * DLRU + ch]; }
#pragma unroll
        for (int i = 0; i < 8; ++i) {
            const float xc = ((x0 * cw0 + x1 * cw1) + x2 * cw2) + xin[i] * cw3 + cb;
            x0 = x1; x1 = x2; x2 = xin[i];
            float ra = 0.f, ri = 0.f;
#pragma unroll
            for (int c = 0; c < 64; ++c) { const float xcc = readlane_f(xc, c); ra += xcc * wa[c]; ri += xcc * wx[c]; if ((c & 15) == 15) __builtin_amdgcn_sched_barrier(0); }
            const float rr = sigmoidf(ra + ba), ig = sigmoidf(ri + bx);
            const float log_a = -8.0f * rr * sp; const float a = expf(log_a);
            const float u = sqrtf(-expm1f(2.0f * log_a)) * (ig * xc);
            h = a * h + u; A = a * A;
            const float ge = gelu_exact(gt[i]);
            if (samp) AR[(size_t)(row0 + t0 + i) * D + DATT + ch] = (bf16_t)f2bf(h * ge);
            else { R0[(size_t)(row0 + t0 + i) * DLRU + ch] = h * ge; R1[(size_t)(row0 + t0 + i) * DLRU + ch] = A * ge; }
        }
    }
    if (samp) { P.out[O_HS + (size_t)b * 512 + ch] = h; float* co = P.out + O_CS + (size_t)b * 3 * 512 + ch; co[0] = x0; co[512] = x1; co[1024] = x2; }
    else {
        ((float*)(P.ws + WS_HE))[((size_t)(b * 32 + k)) * 512 + ch] = h; ((float*)(P.ws + WS_AE))[((size_t)(b * 32 + k)) * 512 + ch] = A;
        if (k == 31) { float* co = P.out + O_CP + (size_t)b * 3 * 512 + ch; co[0] = x0; co[512] = x1; co[1024] = x2; }
    }
}

__device__ __forceinline__ void phase_mix_a(const Params& P, LAS unsigned char* lds) {
    const int lane = threadIdx.x & 63, wave = __builtin_amdgcn_readfirstlane(threadIdx.x >> 6);
    const int gw = blockIdx.x * 8 + wave, nw = gridDim.x * 8;
    for (int u = gw; u < 2048 + 256; u += nw) { const bool samp = u >= 2048; const int v = samp ? u - 2048 : u; lru_unit(P, samp, samp ? (v >> 3) : (v >> 8), samp ? (v & 7) : ((v >> 5) & 7), v & 31, lane); }
    { LAS float* wl = (LAS float*)lds + wave * 576;
      for (int u = gw; u < NTOK_S * NH; u += nw) attn_simple_unit(P, NTOK_P + u / NH, u % NH, wl, lane); }
    __syncthreads();
    for (int u = blockIdx.x; u < 3072; u += gridDim.x) {
        const int p = u / 1536, rem = u - p * 1536, bh = rem >> 4, rc = rem & 15;
        const int b = bh / NH, h = bh - b * NH;
        const int r = p == 0 ? 0 : (rc >> 2), c = p == 0 ? rc : (rc & 3);
        attn_unit<0>(P, p, b, h, r, c, lds);
    }
}
__device__ __forceinline__ void phase_mix_b(const Params& P, LAS unsigned char* lds) {
    {
        const int gt = blockIdx.x * NTHREADS + threadIdx.x;
        for (int i = gt; i < 8 * 32 * 512; i += gridDim.x * NTHREADS) {
            const int ch = i & 511, k = (i >> 9) & 31, b = i >> 14;
            const float* HE = (const float*)(P.ws + WS_HE) + (size_t)b * 32 * 512 + ch; const float* AE = (const float*)(P.ws + WS_AE) + (size_t)b * 32 * 512 + ch;
            float hin = 0.f;
            for (int kk = 0; kk < k; ++kk) hin = HE[kk * 512] + AE[kk * 512] * hin;
            const float* R0 = (const float*)(P.ws + WS_R0) + (size_t)(b * 2048 + k * 64) * DLRU + ch; const float* R1 = (const float*)(P.ws + WS_R1) + (size_t)(b * 2048 + k * 64) * DLRU + ch;
            bf16_t* ar = (bf16_t*)(P.ws + WS_AR) + (size_t)(b * 2048 + k * 64) * D + DATT + ch;
#pragma unroll 8
            for (int t = 0; t < 64; ++t) ar[(size_t)t * D] = (bf16_t)f2bf(R0[(size_t)t * DLRU] + R1[(size_t)t * DLRU] * hin);
            if (k == 31) P.out[O_HP + (size_t)b * 512 + ch] = HE[31 * 512] + AE[31 * 512] * hin;
        }
    }
    for (int u = blockIdx.x; u < 1536; u += gridDim.x) {
        const int bh = u >> 4, r = u & 15; const int b = bh / NH, h = bh - b * NH;
        attn_unit<1>(P, 2, b, h, r, 0, lds);
    }
}

__device__ __forceinline__ void phase_ln1(const Params& P) {
    const int lane = threadIdx.x & 63, wave = threadIdx.x >> 6;
    const float* pre = (const float*)(P.ws + WS_PRE1); float* x1f = (float*)(P.ws + WS_X1F); bf16_t* x1b = (bf16_t*)(P.ws + WS_X1B);
    for (int row = blockIdx.x * 8 + wave; row < NTOK; row += gridDim.x * 8) {
        float4 v[8]; float s = 0.f;
#pragma unroll
        for (int j = 0; j < 8; ++j) { v[j] = *(const float4*)(pre + (size_t)row * D + j * 256 + lane * 4); s += (v[j].x + v[j].y) + (v[j].z + v[j].w); }
        const float mean = wave_sum(s) * (1.0f / D); float q = 0.f;
#pragma unroll
        for (int j = 0; j < 8; ++j) { const float a = v[j].x - mean, b = v[j].y - mean, c = v[j].z - mean, d = v[j].w - mean; q += (a * a + b * b) + (c * c + d * d); }
        const float rstd = rsqrtf(wave_sum(q) * (1.0f / D) + LN_EPS);
#pragma unroll
        for (int j = 0; j < 8; ++j) { const int col = j * 256 + lane * 4; const float4 g = *(const float4*)(P.ln1_g + col), bb = *(const float4*)(P.ln1_b + col);
            float4 o; o.x = (v[j].x - mean) * rstd * g.x + bb.x; o.y = (v[j].y - mean) * rstd * g.y + bb.y; o.z = (v[j].z - mean) * rstd * g.z + bb.z; o.w = (v[j].w - mean) * rstd * g.w + bb.w;
            *(float4*)(x1f + (size_t)row * D + col) = o;
            uint2 w; w.x = pack2(o.x, o.y); w.y = pack2(o.z, o.w); *(uint2*)(x1b + (size_t)row * D + col) = w; }
    }
}

__device__ __forceinline__ int mono(float v) { const int b = __float_as_int(v); return b ^ ((b >> 31) & 0x7fffffff); }
__device__ __forceinline__ float unmono(int k) { return __int_as_float(k ^ ((k >> 31) & 0x7fffffff)); }
#define MK_INSERT16(L, X) do { int _x = (X); _Pragma("unroll") for (int _j = 0; _j < 16; ++_j) { const int _hi = max(L[_j], _x); _x = min(L[_j], _x); L[_j] = _hi; } } while (0)

__device__ __forceinline__ void phase_route(const Params& P, LAS unsigned char* lds) {
    const int lane = threadIdx.x & 63, wave = __builtin_amdgcn_readfirstlane(threadIdx.x >> 6);
    LAS float* ql = (LAS float*)(lds + wave * 17408);
    LAS float* sl = ql + 2048;
    LAS int* kl = (LAS int*)(sl + 2048);
    const float* QP = (const float*)(P.ws + WS_QP);
    int* EIDX = (int*)(P.ws + WS_EIDX); float* GW = (float*)(P.ws + WS_GW);
    for (int row = blockIdx.x * 8 + wave; row < NTOK; row += gridDim.x * 8) {
#pragma unroll
        for (int j = 0; j < 8; ++j) ((LAS f32x4*)ql)[j * 64 + lane] = *(const f32x4*)(QP + (size_t)row * D + (j * 64 + lane) * 4);
        __builtin_amdgcn_wave_barrier();
#pragma unroll 1
        for (int hp = 0; hp < 16; ++hp) {
            const float4* k0 = (const float4*)(P.sub_keys + (size_t)(hp * 128 + lane) * 128); const float4* k1 = k0 + 64 * 32;
            float a0 = 0.f, a1 = 0.f;
#pragma unroll 4
            for (int e4 = 0; e4 < 32; ++e4) { const f32x4 qv = ((LAS f32x4*)ql)[hp * 32 + e4]; const float4 u0 = k0[e4], u1 = k1[e4];
                a0 += qv.x * u0.x + qv.y * u0.y + qv.z * u0.z + qv.w * u0.w; a1 += qv.x * u1.x + qv.y * u1.y + qv.z * u1.z + qv.w * u1.w; }
            sl[hp * 128 + lane] = a0; sl[hp * 128 + 64 + lane] = a1;
        }
        __builtin_amdgcn_wave_barrier();
        if (lane < 16) {
            int L[16];
#pragma unroll
            for (int j = 0; j < 16; ++j) L[j] = (int)0x80000000;
#pragma unroll 1
            for (int k = 0; k < 128; ++k) { const int key = (mono(sl[lane * 128 + k]) & ~127) | k; MK_INSERT16(L, key); }
#pragma unroll
            for (int j = 0; j < 16; ++j) kl[lane * 16 + j] = L[j];
        }
        __builtin_amdgcn_wave_barrier();
        if (lane < 8) {
            const int h = lane; int L[16];
#pragma unroll
            for (int j = 0; j < 16; ++j) L[j] = (int)0x80000000;
#pragma unroll 1
            for (int a = 0; a < 16; ++a) { const float va = unmono(kl[(2 * h) * 16 + a] & ~127);
#pragma unroll 1
                for (int b = 0; b < 16; ++b) { const float vb = unmono(kl[(2 * h + 1) * 16 + b] & ~127); const int key = (mono(va + vb) & ~255) | (a << 4) | b; MK_INSERT16(L, key); } }
            float e[16]; float sum = 0.f; const float mx = unmono(L[0] & ~255);
#pragma unroll
            for (int j = 0; j < 16; ++j) { e[j] = expf(unmono(L[j] & ~255) - mx); sum += e[j]; }
            const float inv = 1.0f / sum;
#pragma unroll
            for (int j = 0; j < 16; ++j) { const int a = (L[j] >> 4) & 15, b = L[j] & 15;
                const int i0 = kl[(2 * h) * 16 + a] & 127, i1 = kl[(2 * h + 1) * 16 + b] & 127;
                EIDX[(size_t)row * 128 + h * 16 + j] = i0 * 128 + i1; GW[(size_t)row * 128 + h * 16 + j] = e[j] * inv; }
        }
        __builtin_amdgcn_wave_barrier();
    }
}

__device__ __forceinline__ void phase_experts(const Params& P) {
    const int lane = threadIdx.x & 63, wave = threadIdx.x >> 6;
    const float* x1f = (const float*)(P.ws + WS_X1F);
    const int* EIDX = (const int*)(P.ws + WS_EIDX); const float* GW = (const float*)(P.ws + WS_GW);
    const bf16_t* UB = (const bf16_t*)(P.ws + WS_UB); const bf16_t* VB = (const bf16_t*)(P.ws + WS_VB);
    for (int row = blockIdx.x * 8 + wave; row < NTOK; row += gridDim.x * 8) {
        float x[32], acc[32];
#pragma unroll
        for (int j = 0; j < 4; ++j) { const float4 a = *(const float4*)(x1f + (size_t)row * D + j * 512 + lane * 8), b = *(const float4*)(x1f + (size_t)row * D + j * 512 + lane * 8 + 4);
            x[j * 8 + 0] = a.x; x[j * 8 + 1] = a.y; x[j * 8 + 2] = a.z; x[j * 8 + 3] = a.w; x[j * 8 + 4] = b.x; x[j * 8 + 5] = b.y; x[j * 8 + 6] = b.z; x[j * 8 + 7] = b.w; }
#pragma unroll
        for (int i = 0; i < 32; ++i) acc[i] = 0.f;
        const int e_lo = EIDX[(size_t)row * 128 + lane], e_hi = EIDX[(size_t)row * 128 + 64 + lane];
        const float g_lo = GW[(size_t)row * 128 + lane], g_hi = GW[(size_t)row * 128 + 64 + lane];
        for (int k = 0; k < 128; ++k) {
            const int e = __builtin_amdgcn_readlane(k < 64 ? e_lo : e_hi, k & 63);
            const float g = readlane_f(k < 64 ? g_lo : g_hi, k & 63);
            const uint4* ur = (const uint4*)(UB + (size_t)e * D); const uint4* vr = (const uint4*)(VB + (size_t)e * D);
            uint4 uu[4], vv[4];
#pragma unroll
            for (int j = 0; j < 4; ++j) { uu[j] = ur[j * 64 + lane]; vv[j] = vr[j * 64 + lane]; }
            float d = 0.f;
#pragma unroll
            for (int j = 0; j < 4; ++j) {
                d += x[j * 8 + 0] * bflo(uu[j].x) + x[j * 8 + 1] * bfhi(uu[j].x) + x[j * 8 + 2] * bflo(uu[j].y) + x[j * 8 + 3] * bfhi(uu[j].y)
                   + x[j * 8 + 4] * bflo(uu[j].z) + x[j * 8 + 5] * bfhi(uu[j].z) + x[j * 8 + 6] * bflo(uu[j].w) + x[j * 8 + 7] * bfhi(uu[j].w);
            }
            d = wave_sum(d);
            const float w = g * gelu_exact(d);
#pragma unroll
            for (int j = 0; j < 4; ++j) {
                acc[j * 8 + 0] += w * bflo(vv[j].x); acc[j * 8 + 1] += w * bfhi(vv[j].x); acc[j * 8 + 2] += w * bflo(vv[j].y); acc[j * 8 + 3] += w * bfhi(vv[j].y);
                acc[j * 8 + 4] += w * bflo(vv[j].z); acc[j * 8 + 5] += w * bfhi(vv[j].z); acc[j * 8 + 6] += w * bflo(vv[j].w); acc[j * 8 + 7] += w * bfhi(vv[j].w);
            }
        }
        float s = 0.f;
#pragma unroll
        for (int i = 0; i < 32; ++i) { acc[i] += ALPHA * x[i]; s += acc[i]; }
        const float mean = wave_sum(s) * (1.0f / D); float q = 0.f;
#pragma unroll
        for (int i = 0; i < 32; ++i) { const float dd = acc[i] - mean; q += dd * dd; }
        const float rstd = rsqrtf(wave_sum(q) * (1.0f / D) + LN_EPS);
        float* yo = P.out + (row < NTOK_P ? O_YP + (size_t)row * D : O_YS + (size_t)(row - NTOK_P) * D);
#pragma unroll
        for (int j = 0; j < 4; ++j) {
            const int col = j * 512 + lane * 8;
            const float4 g0 = *(const float4*)(P.ln2_g + col), g1 = *(const float4*)(P.ln2_g + col + 4), b0 = *(const float4*)(P.ln2_b + col), b1 = *(const float4*)(P.ln2_b + col + 4);
            float4 o0, o1;
            o0.x = (acc[j * 8 + 0] - mean) * rstd * g0.x + b0.x; o0.y = (acc[j * 8 + 1] - mean) * rstd * g0.y + b0.y; o0.z = (acc[j * 8 + 2] - mean) * rstd * g0.z + b0.z; o0.w = (acc[j * 8 + 3] - mean) * rstd * g0.w + b0.w;
            o1.x = (acc[j * 8 + 4] - mean) * rstd * g1.x + b1.x; o1.y = (acc[j * 8 + 5] - mean) * rstd * g1.y + b1.y; o1.z = (acc[j * 8 + 6] - mean) * rstd * g1.z + b1.z; o1.w = (acc[j * 8 + 7] - mean) * rstd * g1.w + b1.w;
            *(float4*)(yo + col) = o0; *(float4*)(yo + col + 4) = o1;
        }
    }
}

constexpr int NPHASE = 9;
__global__ void __launch_bounds__(NTHREADS, 2) fwd(Params P) {
    extern __shared__ __attribute__((aligned(16))) unsigned char lds_raw[];
    LAS unsigned char* lds = (LAS unsigned char*)lds_raw;
    volatile LAS unsigned* misc = (volatile LAS unsigned*)(lds + MISC_OFF);
    const int lo = P.ph_lo, hi = P.ph_hi;
    XcdBarrier bar; bar.bar = (unsigned*)(P.ws + WS_CTL); bar.x = 0; bar.st = nullptr;
    if (hi - lo > 1) {
        if (threadIdx.x == 0) { misc[0] = 0u; misc[1] = 0u; misc[2] = 0u; misc[3] = 0u; }
        __syncthreads();
        bar = xcd_barrier_post((unsigned*)(P.ws + WS_CTL), misc);
    }
#ifndef MK_PHASE_MASK
#define MK_PHASE_MASK 0x1ff
#endif
#define IN(k) (((MK_PHASE_MASK >> (k)) & 1) && lo <= (k) && (k) < hi)
#define SEAM(k) do { if (IN(k) && IN((k) + 1)) xcd_barrier(bar); } while (0)
    if (IN(0)) { phase_prologue(P, lds); }
    SEAM(0);
    if (IN(1)) {
        pg8::Gemm g{(const pg8::bf16_t*)(P.ws + WS_XB), (const pg8::bf16_t*)(P.ws + WS_WINT), NTOK, DIN, D};
        pg8::StaticOrder S; S.init(NTOK, DIN, (int)gridDim.x, (int)blockIdx.x);
        EpiProj E{P.out, (float*)(P.ws + WS_QF), (float*)(P.ws + WS_XR), (float*)(P.ws + WS_GATE), (bf16_t*)(P.ws + WS_QB), (bf16_t*)(P.ws + WS_KB), (bf16_t*)(P.ws + WS_VB16)};
        pg8::gemm_phase<EpiProj, pg8::StaticOrder, false>(lds, g, S, E, nullptr);
    }
    SEAM(1);
    if (IN(2)) { phase_mix_a(P, lds); }
    SEAM(2);
    if (IN(3)) { phase_mix_b(P, lds); }
    SEAM(3);
    if (IN(4)) {
        pg8::Gemm g{(const pg8::bf16_t*)(P.ws + WS_AR), (const pg8::bf16_t*)(P.ws + WS_WOT), NTOK, D, D};
        pg8::StaticOrder S; S.init(NTOK, D, (int)gridDim.x, (int)blockIdx.x);
        EpiOut E{P.x_prompt, P.x_sample, (float*)(P.ws + WS_PRE1)};
        pg8::gemm_phase<EpiOut, pg8::StaticOrder, false>(lds, g, S, E, nullptr);
    }
    SEAM(4);
    if (IN(5)) { phase_ln1(P); }
    SEAM(5);
    if (IN(6)) {
        pg8::Gemm g{(const pg8::bf16_t*)(P.ws + WS_X1B), (const pg8::bf16_t*)(P.ws + WS_WQT), NTOK, D, D};
        pg8::StaticOrder S; S.init(NTOK, D, (int)gridDim.x, (int)blockIdx.x);
        EpiPlain E{(float*)(P.ws + WS_QP), D};
        pg8::gemm_phase<EpiPlain, pg8::StaticOrder, false>(lds, g, S, E, nullptr);
    }
    SEAM(6);
    if (IN(7)) { phase_route(P, lds); }
    SEAM(7);
    if (IN(8)) { phase_experts(P); }
#ifdef MK_REP
    if (IN(MK_REP)) { MK_REP_CALL; }
#endif
#undef IN
#undef SEAM
}
}

#ifndef MK_N_LAUNCHES
#define MK_N_LAUNCHES 1
#endif
extern "C" void kernel_launch(void* const* d_in, const int* in_sizes, int n_in, void* d_out, int out_size, void* d_ws, size_t ws_size, hipStream_t stream) {
    using namespace mk;
    static int grid = 0;
    if (grid == 0) {
        if (n_in != 23 || (size_t)out_size != O_END || ws_size < WS_END) { fprintf(stderr, "kernel_launch: unexpected shapes: n_in %d out %d ws %zu (need %zu)\n", n_in, out_size, ws_size, (size_t)WS_END); grid = -1; return; }
        int dev = 0, cus = 0, per_cu = 0;
        if (hipGetDevice(&dev) != hipSuccess || hipDeviceGetAttribute(&cus, hipDeviceAttributeMultiprocessorCount, dev) != hipSuccess) { grid = -1; return; }
        if (hipFuncSetAttribute((const void*)fwd, hipFuncAttributeMaxDynamicSharedMemorySize, LDS_BYTES) != hipSuccess) { fprintf(stderr, "kernel_launch: hipFuncSetAttribute failed\n"); grid = -1; return; }
        if (hipOccupancyMaxActiveBlocksPerMultiprocessor(&per_cu, (const void*)fwd, NTHREADS, LDS_BYTES) != hipSuccess || per_cu < 1) { fprintf(stderr, "kernel_launch: occupancy query says %d\n", per_cu); }
        (void)hipGetLastError();
        grid = cus;
    }
    if (grid < 0) return;
    (void)hipMemsetAsync((char*)d_ws + WS_CTL, 0, 65536, stream);
    Params p{};
    p.x_prompt = (const float*)d_in[0]; p.x_sample = (const float*)d_in[1]; p.cache_k = (const float*)d_in[2]; p.cache_v = (const float*)d_in[3];
    p.state_conv = (const float*)d_in[4]; p.state_h = (const float*)d_in[5]; p.w_in = (const float*)d_in[6]; p.conv_w = (const float*)d_in[7]; p.conv_b = (const float*)d_in[8];
    p.lru_w_a = (const float*)d_in[9]; p.lru_b_a = (const float*)d_in[10]; p.lru_w_x = (const float*)d_in[11]; p.lru_b_x = (const float*)d_in[12]; p.lru_lambda = (const float*)d_in[13];
    p.w_out = (const float*)d_in[14]; p.ln1_g = (const float*)d_in[15]; p.ln1_b = (const float*)d_in[16]; p.w_query = (const float*)d_in[17]; p.sub_keys = (const float*)d_in[18];
    p.peer_u = (const float*)d_in[19]; p.peer_v = (const float*)d_in[20]; p.ln2_g = (const float*)d_in[21]; p.ln2_b = (const float*)d_in[22];
    p.out = (float*)d_out; p.ws = (unsigned char*)d_ws;
#if MK_N_LAUNCHES == 1
    p.ph_lo = 0; p.ph_hi = NPHASE;
    hipLaunchKernelGGL(fwd, dim3(grid), dim3(NTHREADS), LDS_BYTES, stream, p);
#else
    for (int k = 0; k < NPHASE; ++k) { p.ph_lo = k; p.ph_hi = k + 1; hipLaunchKernelGGL(fwd, dim3(grid), dim3(NTHREADS), LDS_BYTES, stream, p); }
#endif
    const hipError_t le = hipPeekAtLastError();
    if (le != hipSuccess) fprintf(stderr, "kernel_launch: launch failed: %s\n", hipGetErrorName(le));
}
```

```cpp
#include <hip/hip_runtime.h>
#include <cstdio>
#include <cstdint>
namespace pg8 {
#define PG8_LAS __attribute__((address_space(3)))
typedef unsigned short bf16_t;
typedef short bf16x8 __attribute__((ext_vector_type(8)));
typedef float f32x4 __attribute__((ext_vector_type(4)));
typedef unsigned u32x4 __attribute__((ext_vector_type(4)));
constexpr int BM = 256, BK = 64, HALF = 128, HTB = HALF * BK * 2  , STAGE_BYTES = 8 * HTB, NXCD = 8, WGM = 8;

__host__ __device__ __forceinline__ int lds_byte(int r, int c) { const int st = (r >> 4) * 2 + (c >> 5), rr = r & 15, cc = c & 31, ob = rr * 64 + cc * 2; return st * 1024 + (ob ^ (((ob >> 9) & 1) << 5)); }
__host__ __device__ __forceinline__ void stage_rc(int b, int& R, int& C) { const int st = b / 1024, sb = b % 1024, swz = sb ^ (((sb >> 9) & 1) << 5); R = (st >> 1) * 16 + swz / 64; C = (st & 1) * 32 + (swz % 64) / 2; }
__host__ __device__ __forceinline__ int perm32(int rho) { const int n = rho >> 4, i = rho & 15; return 8 * (i >> 2) + 4 * n + (i & 3); }

struct Unit { int pm, pn; };
struct Gemm { const bf16_t* A; const bf16_t* Bt; int M, N, K; };

struct StaticOrder {
    int nM, nN, nwg, G, c;
    __host__ __device__ void init(int M, int N, int G_, int c_) { nM = M / BM; nN = N / BM; nwg = nM * nN; G = G_; c = c_; }
    __host__ __device__ bool next(int i, Unit& u) const {
        const long L = (long)i * G + c; if (L >= nwg) return false;
        int wgid = (int)L; { const int q = nwg / NXCD, r = nwg % NXCD, xcd = wgid % NXCD, off = wgid / NXCD; wgid = (xcd < r ? xcd * (q + 1) : r * (q + 1) + (xcd - r) * q) + off; }
        const int nig = WGM * nN, gid = wgid / nig, fm = gid * WGM, gsz = (nM - fm) < WGM ? (nM - fm) : WGM;
        u.pm = fm + ((wgid % nig) % gsz); u.pn = (wgid % nig) / gsz; return true;
    }
    __device__ __forceinline__ void a_ready(const Unit&) const {}
    __device__ __forceinline__ void done(const Unit&) const {}
};
struct CountedOrder : StaticOrder {
    const unsigned* ready; unsigned need; unsigned* tmo;
    __device__ __forceinline__ void a_ready(const Unit& u) const {
        if (threadIdx.x < 64) {
            const unsigned long long t0 = __builtin_amdgcn_s_memrealtime(); unsigned polls = 0;
            while ((unsigned)__builtin_amdgcn_readfirstlane(__hip_atomic_load(ready + 64 * u.pm, __ATOMIC_RELAXED, __HIP_MEMORY_SCOPE_AGENT)) < need) {
                if ((++polls & 255u) == 0u && __builtin_amdgcn_readfirstlane(__hip_atomic_load(tmo, __ATOMIC_RELAXED, __HIP_MEMORY_SCOPE_AGENT)) != 0u) break;
                if (__builtin_amdgcn_s_memrealtime() - t0 > 2000000ull) {
                    if (threadIdx.x == 0) { unsigned expect = 0u; __hip_atomic_compare_exchange_strong(tmo + 1, &expect, 0x600u | (unsigned)(u.pm & 0xff), __ATOMIC_RELAXED, __ATOMIC_RELAXED, __HIP_MEMORY_SCOPE_AGENT); __hip_atomic_store(tmo, 1u, __ATOMIC_RELAXED, __HIP_MEMORY_SCOPE_AGENT); }
                    break; }
                __builtin_amdgcn_s_sleep(2); }
            __builtin_amdgcn_fence(__ATOMIC_ACQUIRE, "agent");
            asm volatile("s_waitcnt vmcnt(0)" ::: "memory");
        }
#if !defined(BROKEN_HOOK_NO_BARRIER)
        asm volatile("" ::: "memory"); __builtin_amdgcn_s_barrier(); asm volatile("" ::: "memory");
#endif
    }
};

__device__ __forceinline__ unsigned cvt_pk_bf16(float lo, float hi) { unsigned r; asm volatile("v_cvt_pk_bf16_f32 %0, %1, %2" : "=v"(r) : "v"(lo), "v"(hi)); return r; }
typedef float f32x2 __attribute__((ext_vector_type(2)));
__device__ __forceinline__ f32x2 gelu_pk(f32x2 v) {
    const f32x2 av = __builtin_elementwise_abs(v), d = av * 0.2316418882f + 1.0f;
    f32x2 t; t.x = __builtin_amdgcn_rcpf(d.x); t.y = __builtin_amdgcn_rcpf(d.y);
    f32x2 q = t * 0.5307027145f + (-0.7265760135f); q = q * t + 0.7107068705f; q = q * t + (-0.142248368f); q = q * t + 0.127414796f; q = q * t;
    const f32x2 s = (v * v) * (-0.72134752044f);
    f32x2 e; e.x = __builtin_amdgcn_exp2f(s.x); e.y = __builtin_amdgcn_exp2f(s.y);
    const f32x2 m = v * (q * e), r = v - m;
    f32x2 o; o.x = v.x < 0.f ? m.x : r.x; o.y = v.y < 0.f ? m.y : r.y; return o;
}

struct EpiF32 {
    static constexpr bool PERM = false, AFTER_DRAIN = false;
    float* C; int ldc; const float* bias;
    __device__ __forceinline__ void operator()(const f32x4 (&acc)[2][2][4][2], const Unit& u, int wr, int wc, int fr, int fq) const {
        const int row0 = u.pm * BM + wr * 64 + fr, col0 = u.pn * BM + wc * 32 + 4 * fq;
        f32x4 bv[2][2];
#pragma unroll
        for (int bj = 0; bj < 2; ++bj)
#pragma unroll
            for (int n = 0; n < 2; ++n) bv[bj][n] = bias ? *(const f32x4*)(bias + col0 + bj * HALF + n * 16) : (f32x4){0.f, 0.f, 0.f, 0.f};
#pragma unroll
        for (int ai = 0; ai < 2; ++ai)
#pragma unroll
            for (int m = 0; m < 4; ++m) { float* rowp = C + (size_t)(row0 + ai * HALF + m * 16) * ldc + col0;
#pragma unroll
                for (int bj = 0; bj < 2; ++bj)
#pragma unroll
                    for (int n = 0; n < 2; ++n) *(f32x4*)(rowp + bj * HALF + n * 16) = acc[ai][bj][m][n] + bv[bj][n]; }
    }
};
template <int ACT  > struct EpiBf16 {
    static constexpr bool PERM = true, AFTER_DRAIN = false;
    bf16_t* O; int ldc; const float* bias; int split_cols; size_t split_stride;
    __device__ __forceinline__ void operator()(const f32x4 (&acc)[2][2][4][2], const Unit& u, int wr, int wc, int fr, int fq) const {
        const int row0 = u.pm * BM + wr * 64 + fr; int colt = u.pn * BM; bf16_t* base = O;
        if (split_cols) { const int t = colt / split_cols; base += (size_t)t * split_stride; colt -= t * split_cols; }
        const int col0 = colt + wc * 32 + 8 * fq, bcol0 = u.pn * BM + wc * 32 + 8 * fq;
        f32x4 bv[2][2];
#pragma unroll
        for (int bj = 0; bj < 2; ++bj)
#pragma unroll
            for (int n = 0; n < 2; ++n) bv[bj][n] = bias ? *(const f32x4*)(bias + bcol0 + bj * HALF + 4 * n) : (f32x4){0.f, 0.f, 0.f, 0.f};
#pragma unroll
        for (int ai = 0; ai < 2; ++ai)
#pragma unroll
            for (int m = 0; m < 4; ++m) { bf16_t* rowp = base + (size_t)(row0 + ai * HALF + m * 16) * ldc + col0;
#pragma unroll
                for (int bj = 0; bj < 2; ++bj) { f32x4 v0 = acc[ai][bj][m][0] + bv[bj][0], v1 = acc[ai][bj][m][1] + bv[bj][1];
                    if (ACT == 1) { f32x2 a = gelu_pk((f32x2){v0[0], v0[1]}), b = gelu_pk((f32x2){v0[2], v0[3]}), c = gelu_pk((f32x2){v1[0], v1[1]}), d = gelu_pk((f32x2){v1[2], v1[3]});
                        v0 = (f32x4){a.x, a.y, b.x, b.y}; v1 = (f32x4){c.x, c.y, d.x, d.y}; }
                    if (ACT == 2) {
#pragma unroll
                        for (int j = 0; j < 4; ++j) { v0[j] = 0.5f * v0[j] * (1.0f + erff(v0[j] * 0.70710678f)); v1[j] = 0.5f * v1[j] * (1.0f + erff(v1[j] * 0.70710678f)); } }
                    u32x4 w; w.x = cvt_pk_bf16(v0[0], v0[1]); w.y = cvt_pk_bf16(v0[2], v0[3]); w.z = cvt_pk_bf16(v1[0], v1[1]); w.w = cvt_pk_bf16(v1[2], v1[3]);
                    *(u32x4*)(rowp + bj * HALF) = w; } }
    }
};

struct PanelStats {
    unsigned* xbuf;
    unsigned* cnt;
    unsigned* tmo;
    int ntn; float eps;
    unsigned code;
    __device__ __forceinline__ bool run(const f32x4 (&v)[2][2][4][2], const Unit& u, int wr, int wc, int fr, int fq, PG8_LAS unsigned char* lds, int wid, int lane) const {
        typedef float f32x2v __attribute__((ext_vector_type(2)));
        PG8_LAS f32x2v* P = (PG8_LAS f32x2v*)lds;
        PG8_LAS f32x2v* S = (PG8_LAS f32x2v*)(lds + 8192);
        PG8_LAS unsigned* flag = (PG8_LAS unsigned*)(lds + 8192 + 2048);
#pragma unroll
        for (int ai = 0; ai < 2; ++ai)
#pragma unroll
            for (int m = 0; m < 4; ++m) {
                float s = 0.f;
#pragma unroll
                for (int bj = 0; bj < 2; ++bj)
#pragma unroll
                    for (int n = 0; n < 2; ++n) { const f32x4 x = v[ai][bj][m][n]; s += (x[0] + x[1]) + (x[2] + x[3]); }
                s += __shfl_xor(s, 16); s += __shfl_xor(s, 32);
                const float mw = s * (1.0f / 64.0f); float q = 0.f;
#pragma unroll
                for (int bj = 0; bj < 2; ++bj)
#pragma unroll
                    for (int n = 0; n < 2; ++n) { const f32x4 d = v[ai][bj][m][n] - mw; q += (d[0] * d[0] + d[1] * d[1]) + (d[2] * d[2] + d[3] * d[3]); }
                q += __shfl_xor(q, 16); q += __shfl_xor(q, 32);
                if (fq == 0) P[(ai * HALF + wr * 64 + m * 16 + fr) * 4 + wc] = (f32x2v){mw, q};
            }
        asm volatile("s_waitcnt lgkmcnt(0)" ::: "memory"); __builtin_amdgcn_s_barrier(); asm volatile("" ::: "memory");
#if defined(BROKEN_NO_WAIT)
        if (blockIdx.x >= 64) { const long long t0 = clock64(); while (clock64() - t0 < 60000) __builtin_amdgcn_s_sleep(8); }
#endif
        const int row = wid * 32 + (lane & 31);
        if (lane < 32) {
            const f32x2v a = P[row * 4 + 0], b = P[row * 4 + 1], c = P[row * 4 + 2], d = P[row * 4 + 3];
            const float mt = (a.x + b.x + c.x + d.x) * 0.25f;
            const float da = a.x - mt, db = b.x - mt, dc = c.x - mt, dd = d.x - mt;
            const float m2 = (a.y + b.y) + (c.y + d.y) + 64.0f * ((da * da + db * db) + (dc * dc + dd * dd));
            unsigned long long* slot = (unsigned long long*)xbuf + ((size_t)(u.pm * BM + row) * 4 + u.pn);
            __hip_atomic_store(slot, ((unsigned long long)__float_as_uint(m2) << 32) | __float_as_uint(mt), __ATOMIC_RELAXED, __HIP_MEMORY_SCOPE_AGENT);
        }
        asm volatile("s_waitcnt vmcnt(0)" ::: "memory");
        if (lane == 0) __hip_atomic_fetch_add(cnt + 64 * u.pm, 1u, __ATOMIC_RELAXED, __HIP_MEMORY_SCOPE_AGENT);
        if (wid == 0) {
            bool dead = false; const unsigned long long t0 = __builtin_amdgcn_s_memrealtime(); const unsigned want = 8u * (unsigned)ntn;
            for (;;) {
#if defined(BROKEN_NO_WAIT)
                break;
#endif
                if ((unsigned)__builtin_amdgcn_readfirstlane(__hip_atomic_load(cnt + 64 * u.pm, __ATOMIC_RELAXED, __HIP_MEMORY_SCOPE_AGENT)) >= want) break;
                if (__builtin_amdgcn_s_memrealtime() - t0 > 2000000ull) {
                    if (lane == 0) { unsigned expect = 0u; __hip_atomic_compare_exchange_strong(tmo + 1, &expect, code | (unsigned)(u.pm & 0xff), __ATOMIC_RELAXED, __ATOMIC_RELAXED, __HIP_MEMORY_SCOPE_AGENT);
                                     __hip_atomic_store(tmo, 1u, __ATOMIC_RELAXED, __HIP_MEMORY_SCOPE_AGENT); }
                    dead = true; break; }
                __builtin_amdgcn_s_sleep(2);
            }
            __builtin_amdgcn_fence(__ATOMIC_ACQUIRE, "agent");
            if (lane == 0) flag[0] = dead ? 1u : 0u;
        }
        asm volatile("s_waitcnt vmcnt(0) lgkmcnt(0)" ::: "memory"); __builtin_amdgcn_s_barrier(); asm volatile("" ::: "memory");
        const bool bad = flag[0] != 0u;
        if (lane < 32) {
            const unsigned long long* slot = (const unsigned long long*)xbuf + (size_t)(u.pm * BM + row) * 4; float mt[4], m2[4]; float ms = 0.f;
#pragma unroll
            for (int t = 0; t < 4; ++t) { if (t < ntn) { const unsigned long long w = __hip_atomic_load(slot + t, __ATOMIC_RELAXED, __HIP_MEMORY_SCOPE_AGENT); mt[t] = __uint_as_float((unsigned)w); m2[t] = __uint_as_float((unsigned)(w >> 32)); } else { mt[t] = 0.f; m2[t] = 0.f; } ms += mt[t]; }
            const float mean = ms / (float)ntn; float q = 0.f;
#pragma unroll
            for (int t = 0; t < 4; ++t) if (t < ntn) { const float dm = mt[t] - mean; q += m2[t] + 256.0f * dm * dm; }
            S[row] = (f32x2v){mean, 1.0f / sqrtf(q / (256.0f * (float)ntn) + eps)};
        }
        asm volatile("s_waitcnt lgkmcnt(0)" ::: "memory"); __builtin_amdgcn_s_barrier(); asm volatile("" ::: "memory");
        return bad;
    }
};
struct EpiLnRes {
    static constexpr bool PERM = false, AFTER_DRAIN = true;
    const float* base; float* out; int ldc; const float* bias; PanelStats st; unsigned poison;
    __device__ __forceinline__ void refuse(size_t i0, size_t stride, int M, int N) const { const float q = __builtin_nanf(""); for (size_t i = i0; i < (size_t)M * N; i += stride) out[(i / N) * ldc + i % N] = q;
        if (i0 == 0) { unsigned expect = 0u; __hip_atomic_compare_exchange_strong(st.tmo + 1, &expect, 0x7f0u, __ATOMIC_RELAXED, __ATOMIC_RELAXED, __HIP_MEMORY_SCOPE_AGENT); __hip_atomic_store(st.tmo, 1u, __ATOMIC_RELAXED, __HIP_MEMORY_SCOPE_AGENT); } }
    __device__ __forceinline__ void fused(f32x4 (&acc)[2][2][4][2], const Unit& u, int wr, int wc, int fr, int fq, PG8_LAS unsigned char* lds, int wid, int lane) const {
        typedef float f32x2v __attribute__((ext_vector_type(2)));
        const PG8_LAS f32x2v* S = (const PG8_LAS f32x2v*)(lds + 8192);
        const int col0 = u.pn * BM + wc * 32 + 4 * fq;
#pragma unroll
        for (int bj = 0; bj < 2; ++bj)
#pragma unroll
            for (int n = 0; n < 2; ++n) { const f32x4 bv = bias ? *(const f32x4*)(bias + col0 + bj * HALF + n * 16) : (f32x4){0.f, 0.f, 0.f, 0.f};
#pragma unroll
                for (int ai = 0; ai < 2; ++ai)
#pragma unroll
                    for (int m = 0; m < 4; ++m) acc[ai][bj][m][n] += bv; }
        const bool bad = st.run(acc, u, wr, wc, fr, fq, lds, wid, lane) || poison != 0u;
        const float qnan = __builtin_nanf("");
#pragma unroll
        for (int ai = 0; ai < 2; ++ai)
#pragma unroll
            for (int m = 0; m < 4; ++m) { const int r = ai * HALF + wr * 64 + m * 16 + fr; const f32x2v sr = S[r]; const size_t off = (size_t)(u.pm * BM + r) * ldc + col0;
#pragma unroll
                for (int bj = 0; bj < 2; ++bj)
#pragma unroll
                    for (int n = 0; n < 2; ++n) { const f32x4 bs = *(const f32x4*)(base + off + bj * HALF + n * 16); f32x4 o = bs + (acc[ai][bj][m][n] - sr.x) * sr.y;
                        if (bad) o = (f32x4){qnan, qnan, qnan, qnan}; *(f32x4*)(out + off + bj * HALF + n * 16) = o; }
                asm volatile("" ::: "memory"); }
    }
};
struct EpiLnResLn {
    static constexpr bool PERM = false, AFTER_DRAIN = true;
    const float* base; float* out; bf16_t* xn; int ldc; const float* bias; PanelStats st1, st2; unsigned poison;
    __device__ __forceinline__ void refuse(size_t i0, size_t stride, int M, int N) const { const float q = __builtin_nanf(""); for (size_t i = i0; i < (size_t)M * N; i += stride) { const size_t o = (i / N) * ldc + i % N; out[o] = q; xn[o] = (bf16_t)0x7fc0u; }
        if (i0 == 0) { unsigned expect = 0u; __hip_atomic_compare_exchange_strong(st1.tmo + 1, &expect, 0x7f0u, __ATOMIC_RELAXED, __ATOMIC_RELAXED, __HIP_MEMORY_SCOPE_AGENT); __hip_atomic_store(st1.tmo, 1u, __ATOMIC_RELAXED, __HIP_MEMORY_SCOPE_AGENT); } }
    __device__ __forceinline__ void fused(f32x4 (&acc)[2][2][4][2], const Unit& u, int wr, int wc, int fr, int fq, PG8_LAS unsigned char* lds, int wid, int lane) const {
        typedef float f32x2v __attribute__((ext_vector_type(2))); typedef unsigned u32x2v __attribute__((ext_vector_type(2)));
        const PG8_LAS f32x2v* S = (const PG8_LAS f32x2v*)(lds + 8192);
        const int col0 = u.pn * BM + wc * 32 + 4 * fq;
#pragma unroll
        for (int bj = 0; bj < 2; ++bj)
#pragma unroll
            for (int n = 0; n < 2; ++n) { const f32x4 bv = bias ? *(const f32x4*)(bias + col0 + bj * HALF + n * 16) : (f32x4){0.f, 0.f, 0.f, 0.f};
#pragma unroll
                for (int ai = 0; ai < 2; ++ai)
#pragma unroll
                    for (int m = 0; m < 4; ++m) acc[ai][bj][m][n] += bv; }
        bool bad = st1.run(acc, u, wr, wc, fr, fq, lds, wid, lane) || poison != 0u;
        const float qnan = __builtin_nanf("");
#pragma unroll
        for (int ai = 0; ai < 2; ++ai)
#pragma unroll
            for (int m = 0; m < 4; ++m) { const int r = ai * HALF + wr * 64 + m * 16 + fr; const f32x2v sr = S[r]; const size_t off = (size_t)(u.pm * BM + r) * ldc + col0;
#pragma unroll
                for (int bj = 0; bj < 2; ++bj)
#pragma unroll
                    for (int n = 0; n < 2; ++n) { const f32x4 bs = *(const f32x4*)(base + off + bj * HALF + n * 16); acc[ai][bj][m][n] = bs + (acc[ai][bj][m][n] - sr.x) * sr.y; }
                asm volatile("" : "+v"(acc[ai][0][m][0]), "+v"(acc[ai][0][m][1]), "+v"(acc[ai][1][m][0]), "+v"(acc[ai][1][m][1]));
                if (m & 1) asm volatile("" ::: "memory"); }
        const bool bad1 = bad;
        bad = st2.run(acc, u, wr, wc, fr, fq, lds, wid, lane) || bad;
#pragma unroll
        for (int ai = 0; ai < 2; ++ai)
#pragma unroll
            for (int m = 0; m < 4; ++m) { const int r = ai * HALF + wr * 64 + m * 16 + fr; const f32x2v sr = S[r]; const size_t off = (size_t)(u.pm * BM + r) * ldc + col0;
#pragma unroll
                for (int bj = 0; bj < 2; ++bj)
#pragma unroll
                    for (int n = 0; n < 2; ++n) { const f32x4 x1 = acc[ai][bj][m][n]; *(f32x4*)(out + off + bj * HALF + n * 16) = bad1 ? (f32x4){qnan, qnan, qnan, qnan} : x1;
                        const f32x4 o = (x1 - sr.x) * sr.y; u32x2v w; w.x = cvt_pk_bf16(o[0], o[1]); w.y = cvt_pk_bf16(o[2], o[3]);
                        if (bad) { w.x = 0x7fc07fc0u; w.y = 0x7fc07fc0u; } *(u32x2v*)(xn + off + bj * HALF + n * 16) = w; }
                asm volatile("" ::: "memory"); }
    }
};

template <class Epi, class Sched, bool STAMP = false>
__device__ __forceinline__ void gemm_phase(PG8_LAS unsigned char* lds, const Gemm g, const Sched& S, const Epi& E, unsigned long long* stamps) {
    const int tid = threadIdx.x, wid = __builtin_amdgcn_readfirstlane(tid >> 6), lane = tid & 63, wr = wid >> 2, wc = wid & 3, fr = lane & 15, fq = lane >> 4;
    const int K = g.K, nt = K / BK;
    int ts_lo = 0, ts_hi = 0, nts = 0; const unsigned long long rt_entry = STAMP ? (unsigned long long)wall_clock64() : 0ull;
#define PG8_STAMP() do { if (STAMP && wid == 0 && nts < 64) { const unsigned long long _c = (unsigned long long)clock64(); \
        ts_lo = (lane == nts) ? (int)(unsigned)_c : ts_lo; ts_hi = (lane == nts) ? (int)(unsigned)(_c >> 32) : ts_hi; ++nts; } } while (0)
    PG8_STAMP();
    unsigned voffA[2], voffB[2];
#pragma unroll
    for (int i = 0; i < 2; ++i) { int R, C; stage_rc(tid * 16 + i * 8192, R, C); const int Rb = Epi::PERM ? ((R & ~31) + perm32(R & 31)) : R;
        voffA[i] = (unsigned)(R * K + C) * 2u; voffB[i] = (unsigned)(Rb * K + C) * 2u; }
    const size_t kstep = (size_t)(BK * 2);
    const size_t hstep = (size_t)HALF * K * 2;
    const size_t tstep = 2 * hstep;
    const unsigned ldsw = (unsigned)wid * 1024u;
    const int aoff = lds_byte(wr * 64 + fr, fq * 8), boff = lds_byte(wc * 32 + fr, fq * 8);
#define PG8_SA(b, h) (((b) * 2 + (h)) * HTB)
#define PG8_SB(b, h) ((4 + (b) * 2 + (h)) * HTB)
#define PG8_STAGE(bufoff, gbase, voff) do { _Pragma("unroll") for (int _i = 0; _i < 2; ++_i) \
        __builtin_amdgcn_global_load_lds((const unsigned*)((const char*)(gbase) + (voff)[_i]), (PG8_LAS unsigned*)(lds + (bufoff) + ldsw + _i * 8192), 16, 0, 0); } while (0)
#define PG8_LDA(dst, b, h) do { _Pragma("unroll") for (int m = 0; m < 4; ++m) _Pragma("unroll") for (int k = 0; k < 2; ++k) dst[m][k] = *(const PG8_LAS bf16x8*)(lds + PG8_SA(b, h) + aoff + m * 2048 + k * 1024); } while (0)
#define PG8_LDB(dst, b, h) do { _Pragma("unroll") for (int n = 0; n < 2; ++n) _Pragma("unroll") for (int k = 0; k < 2; ++k) dst[n][k] = *(const PG8_LAS bf16x8*)(lds + PG8_SB(b, h) + boff + n * 2048 + k * 1024); } while (0)
#define PG8_MMA(ai, bj, At, Bt) do { __builtin_amdgcn_s_setprio(1); _Pragma("unroll") for (int m = 0; m < 4; ++m) _Pragma("unroll") for (int n = 0; n < 2; ++n) _Pragma("unroll") for (int k = 0; k < 2; ++k) \
        acc[ai][bj][m][n] = __builtin_amdgcn_mfma_f32_16x16x32_bf16(Bt[n][k], At[m][k], acc[ai][bj][m][n], 0, 0, 0); __builtin_amdgcn_s_setprio(0); } while (0)
#define PG8_WAIT_V(n) asm volatile("s_waitcnt vmcnt(" #n ")" ::: "memory")
#define PG8_WAIT_L(n) asm volatile("s_waitcnt lgkmcnt(" #n ")" ::: "memory")
#define PG8_BAR __builtin_amdgcn_s_barrier()
#define PG8_SCHED __builtin_amdgcn_sched_barrier(0)
    Unit cur, nxt; int ui = 0;
    if (!S.next(0, cur)) return;
    f32x4 acc[2][2][4][2];
#pragma unroll
    for (int a = 0; a < 2; ++a)
#pragma unroll
        for (int b = 0; b < 2; ++b)
#pragma unroll
            for (int m = 0; m < 4; ++m)
#pragma unroll
                for (int n = 0; n < 2; ++n) acc[a][b][m][n] = (f32x4){0.f, 0.f, 0.f, 0.f};
    bf16x8 At[4][2], B0[2][2], B1[2][2];
    const char* cA = (const char*)g.A + (size_t)cur.pm * tstep; const char* cB = (const char*)g.Bt + (size_t)cur.pn * tstep;
    S.a_ready(cur);
    PG8_STAGE(PG8_SB(0, 0), cB, voffB); PG8_STAGE(PG8_SA(0, 0), cA, voffA); PG8_STAGE(PG8_SB(0, 1), cB + hstep, voffB); PG8_STAGE(PG8_SA(0, 1), cA + hstep, voffA);
    if (wr == 1) PG8_BAR;
    PG8_WAIT_V(4); PG8_BAR;
    PG8_STAGE(PG8_SB(1, 0), cB + kstep, voffB); PG8_STAGE(PG8_SA(1, 0), cA + kstep, voffA); PG8_STAGE(PG8_SB(1, 1), cB + hstep + kstep, voffB);
    PG8_WAIT_V(6); PG8_BAR;
    PG8_STAMP();
    for (;;) {
        const bool has_next = S.next(ui + 1, nxt);
        const char* nA = has_next ? (const char*)g.A + (size_t)nxt.pm * tstep : cA; const char* nB = has_next ? (const char*)g.Bt + (size_t)nxt.pn * tstep : cB;
        for (int t = 0; t < nt; t += 2) {
            const bool last = (t == nt - 2);
            const char* a1 = cA + (size_t)(t + 1) * kstep;
            const char* a2 = last ? nA : cA + (size_t)(t + 2) * kstep; const char* b2 = last ? nB : cB + (size_t)(t + 2) * kstep;
            const char* a3 = a2 + kstep; const char* b3 = b2 + kstep;
            if (last && has_next) S.a_ready(nxt);
            PG8_LDB(B0, 0, 0); PG8_SCHED; PG8_LDA(At, 0, 0); PG8_STAGE(PG8_SA(1, 1), a1 + hstep, voffA);
            PG8_WAIT_L(8); PG8_BAR; PG8_WAIT_L(0); PG8_MMA(0, 0, At, B0); PG8_BAR; PG8_SCHED;
            PG8_LDB(B1, 0, 1); PG8_STAGE(PG8_SB(0, 0), b2, voffB);
            PG8_BAR; PG8_WAIT_L(0); PG8_MMA(0, 1, At, B1); PG8_BAR;
            PG8_LDA(At, 0, 1); PG8_STAGE(PG8_SA(0, 0), a2, voffA);
            PG8_BAR; PG8_WAIT_L(0); PG8_MMA(1, 0, At, B0); PG8_BAR; PG8_SCHED;
            PG8_STAGE(PG8_SB(0, 1), b2 + hstep, voffB);
            PG8_WAIT_V(6); PG8_BAR; PG8_MMA(1, 1, At, B1); PG8_BAR;
            PG8_LDB(B0, 1, 0); PG8_SCHED; PG8_LDA(At, 1, 0); PG8_STAGE(PG8_SA(0, 1), a2 + hstep, voffA);
            PG8_WAIT_L(8); PG8_BAR; PG8_WAIT_L(0); PG8_MMA(0, 0, At, B0); PG8_BAR; PG8_SCHED;
            PG8_LDB(B1, 1, 1); PG8_STAGE(PG8_SB(1, 0), b3, voffB);
            PG8_BAR; PG8_WAIT_L(0); PG8_MMA(0, 1, At, B1); PG8_BAR;
            PG8_LDA(At, 1, 1); PG8_STAGE(PG8_SA(1, 0), a3, voffA);
            PG8_BAR; PG8_WAIT_L(0); PG8_MMA(1, 0, At, B0); PG8_BAR; PG8_SCHED;
            PG8_STAGE(PG8_SB(1, 1), b3 + hstep, voffB);
            PG8_WAIT_V(6); PG8_BAR; PG8_MMA(1, 1, At, B1); PG8_BAR;
        }
        PG8_STAMP();
        if constexpr (!Epi::AFTER_DRAIN) { E(acc, cur, wr, wc, fr, fq); S.done(cur); }
        PG8_STAMP();
        if (!has_next) break;
#pragma unroll
        for (int a = 0; a < 2; ++a)
#pragma unroll
            for (int b = 0; b < 2; ++b)
#pragma unroll
                for (int m = 0; m < 4; ++m)
#pragma unroll
                    for (int n = 0; n < 2; ++n) acc[a][b][m][n] = (f32x4){0.f, 0.f, 0.f, 0.f};
        cur = nxt; cA = nA; cB = nB; ++ui;
    }
    PG8_WAIT_V(0);
    if (wr == 0) PG8_BAR;
    PG8_BAR;
    if constexpr (Epi::AFTER_DRAIN) { E.fused(acc, cur, wr, wc, fr, fq, lds, wid, lane); S.done(cur); }
    PG8_STAMP();
    if (STAMP && wid == 0) { stamps[lane] = lane < nts ? (((unsigned long long)(unsigned)ts_hi << 32) | (unsigned)ts_lo) : 0ull;
        if (lane == 62) stamps[62] = rt_entry; if (lane == 63) stamps[63] = (unsigned long long)wall_clock64(); }
#undef PG8_STAMP
#undef PG8_SA
#undef PG8_SB
#undef PG8_STAGE
#undef PG8_LDA
#undef PG8_LDB
#undef PG8_MMA
#undef PG8_WAIT_V
#undef PG8_WAIT_L
#undef PG8_BAR
#undef PG8_SCHED
}
}
#define XB_TMO      128
#define XB_XCNT(j)  (256  + 64 * (j))
#define XB_XSUB(j)  (1280 + 64 * (j))
#define XB_XGEN(j)  (2304 + 64 * (j))
#define XB_TOP      3328
#define XB_TOPGEN   3392
#define XCD_BAR_WORDS 3456
#define XB_SPIN_CAP (1u << 18)
#define LAS __attribute__((address_space(3)))

__device__ __forceinline__ unsigned xb_ld(unsigned* p)              { return __hip_atomic_load(p, __ATOMIC_RELAXED, __HIP_MEMORY_SCOPE_AGENT); }
__device__ __forceinline__ unsigned xb_add(unsigned* p, unsigned v) { return __hip_atomic_fetch_add(p, v, __ATOMIC_RELAXED, __HIP_MEMORY_SCOPE_AGENT); }
__device__ __forceinline__ unsigned xb_xcc_id() { return (unsigned)__builtin_amdgcn_s_getreg((3 << 11) | 20) & 0xFu; }
#define XB_SPIN(cond, bar) do { unsigned _sp = 0; while (cond) { __builtin_amdgcn_s_sleep(1); \
    if ((++_sp & 255u) == 0u) { if (xb_ld(&(bar)[XB_TMO])) break; if (_sp > XB_SPIN_CAP) { atomicAdd(&(bar)[XB_TMO], 1u); break; } } } } while (0)

struct XcdBarrier {
    unsigned* bar; unsigned x;
    volatile LAS unsigned* st;
};

__device__ __forceinline__ XcdBarrier xcd_barrier_post(unsigned* bar, volatile LAS unsigned* st) {
    XcdBarrier b; b.bar = bar; b.x = xb_xcc_id(); b.st = st;
    if (threadIdx.x == 0) (void)xb_add(&bar[XB_XCNT(b.x)], 1u);
    return b;
}
__device__ __forceinline__ void xcd_barrier_complete(unsigned* bar, unsigned x, unsigned& nloc, unsigned& nx) {
    const unsigned G = gridDim.x * gridDim.y * gridDim.z;
    unsigned sum, cnt, mine, sp = 0u;
    for (;;) {
        sum = 0u; cnt = 0u; mine = 0u;
#pragma unroll
        for (unsigned j = 0; j < 16; ++j) { const unsigned c = xb_ld(&bar[XB_XCNT(j)]); sum += c; cnt += (c > 0u) ? 1u : 0u; mine = (j == x) ? c : mine; }
        if (sum == G) break;
        __builtin_amdgcn_s_sleep(1);
        if ((++sp & 255u) == 0u) { if (xb_ld(&bar[XB_TMO])) break; if (sp > XB_SPIN_CAP) { atomicAdd(&bar[XB_TMO], 1u); break; } }
    }
    nloc = mine > 0u ? mine : 1u; nx = cnt > 0u ? cnt : 1u;
}

__device__ __forceinline__ void xcd_barrier(const XcdBarrier& b) {
    asm volatile("s_waitcnt vmcnt(0)" ::: "memory");
    __syncthreads();
    if (threadIdx.x == 0) {
        unsigned* bar = b.bar;
        __builtin_amdgcn_s_waitcnt(0);
        unsigned nloc = b.st[0], nx = b.st[1];
        if (nloc == 0u) { xcd_barrier_complete(bar, b.x, nloc, nx); b.st[0] = nloc; b.st[1] = nx; }
        const unsigned old = xb_add(&bar[XB_XSUB(b.x)], 1u);
        const unsigned gen = old / nloc;
        if (old + 1u == (gen + 1u) * nloc) {
            __builtin_amdgcn_fence(__ATOMIC_RELEASE, "agent");
            asm volatile("s_waitcnt vmcnt(0)" ::: "memory");
            const unsigned og = xb_add(&bar[XB_TOP], 1u);
            const unsigned tg = og / nx;
            if (og + 1u == (tg + 1u) * nx) xb_add(&bar[XB_TOPGEN], 1u);
            else XB_SPIN(xb_ld(&bar[XB_TOPGEN]) == tg, bar);
            __builtin_amdgcn_fence(__ATOMIC_ACQUIRE, "agent");
            xb_add(&bar[XB_XGEN(b.x)], 1u);
            asm volatile("s_waitcnt vmcnt(0)" ::: "memory");
        } else {
            XB_SPIN(xb_ld(&bar[XB_XGEN(b.x)]) == gen, bar);
            __builtin_amdgcn_fence(__ATOMIC_ACQUIRE, "agent");
            asm volatile("s_waitcnt vmcnt(0)" ::: "memory");
        }
    }
    __syncthreads();
}


namespace mk {
typedef unsigned short bf16_t;
typedef float f32x4 __attribute__((ext_vector_type(4)));
typedef short bf16x8 __attribute__((ext_vector_type(8)));
typedef short s16x4 __attribute__((ext_vector_type(4)));
typedef unsigned u32x4 __attribute__((ext_vector_type(4)));
typedef unsigned u32x2 __attribute__((ext_vector_type(2)));
typedef float f32x2 __attribute__((ext_vector_type(2)));
constexpr int D = 2048, NTOK_P = 16384, NTOK_S = 256, NTOK = 16640;
constexpr int DIN = 5632, DATT = 1536, DLRU = 512, NH = 12, HD = 128;
constexpr int NEXP = 16384;
constexpr float ALPHA = 1.189207115002721f;
constexpr float LN_EPS = 1e-5f;
constexpr float ATT_SCALE = 0.08838834764831845f;
constexpr float LOG2E = 1.4426950408889634f;
constexpr size_t O_YP = 0, O_YS = 33554432, O_KP = 34078720, O_VP = 59244544, O_CP = 84410368, O_HP = 84422656,
                 O_KS = 84426752, O_VS = 185090048, O_CS = 285753344, O_HS = 285802496, O_END = 285818880;
constexpr size_t WS_CTL = 0;
constexpr size_t WS_XB = 65536;
constexpr size_t WS_WINT = WS_XB + (size_t)NTOK * D * 2;
constexpr size_t WS_WOT = WS_WINT + (size_t)DIN * D * 2;
constexpr size_t WS_WQT = WS_WOT + (size_t)D * D * 2;
constexpr size_t WS_UB = WS_WQT + (size_t)D * D * 2;
constexpr size_t WS_VB = WS_UB + (size_t)NEXP * D * 2;
constexpr size_t WS_QF = WS_VB + (size_t)NEXP * D * 2;
constexpr size_t WS_XR = WS_QF + (size_t)NTOK * DATT * 4;
constexpr size_t WS_GATE = WS_XR + (size_t)NTOK * DLRU * 4;
constexpr size_t WS_AR = WS_GATE + (size_t)NTOK * DLRU * 4;
constexpr size_t WS_PRE1 = WS_AR + (size_t)NTOK * D * 2;
constexpr size_t WS_X1F = WS_PRE1 + (size_t)NTOK * D * 4;
constexpr size_t WS_X1B = WS_X1F + (size_t)NTOK * D * 4;
constexpr size_t WS_QP = WS_X1B + (size_t)NTOK * D * 2;
constexpr size_t WS_EIDX = WS_QP + (size_t)NTOK * D * 4;
constexpr size_t WS_GW = WS_EIDX + (size_t)NTOK * 128 * 4;
constexpr size_t WS_SU = WS_GW + (size_t)NTOK * 128 * 4;
constexpr size_t WS_SV = WS_SU + (size_t)NEXP * 4;
constexpr size_t WS_SX = WS_SV + (size_t)NEXP * 4;
constexpr size_t WS_X1Q = WS_SX + (size_t)NTOK * 4;
constexpr size_t WS_SKB = WS_X1Q + (size_t)NTOK * D;
constexpr size_t WS_QB = WS_SKB + (size_t)8 * 2 * 128 * 128 * 2;
constexpr size_t WS_KB = WS_QB + (size_t)NTOK_P * DATT * 2;
constexpr size_t WS_VB16 = WS_KB + (size_t)NTOK_P * DATT * 2;
constexpr size_t WS_PO = WS_VB16 + (size_t)NTOK_P * DATT * 2;
constexpr size_t WS_PM = WS_PO + (size_t)2 * NTOK_P * DATT * 2;
constexpr size_t WS_PL = WS_PM + (size_t)2 * NTOK_P * NH * 4;
constexpr size_t WS_R0 = WS_PL + (size_t)2 * NTOK_P * NH * 4;
constexpr size_t WS_R1 = WS_R0 + (size_t)NTOK_P * DLRU * 4;
constexpr size_t WS_HE = WS_R1 + (size_t)NTOK_P * DLRU * 4;
constexpr size_t WS_AE = WS_HE + (size_t)8 * 32 * 512 * 4;
constexpr size_t WS_END = WS_AE + (size_t)8 * 32 * 512 * 4;

constexpr int NTHREADS = 512;
constexpr int LDS_BYTES = 148480;
constexpr int MISC_OFF = 147456;

struct Params {
    const float* x_prompt; const float* x_sample; const float* cache_k; const float* cache_v; const float* state_conv; const float* state_h;
    const float* w_in; const float* conv_w; const float* conv_b; const float* lru_w_a; const float* lru_b_a; const float* lru_w_x; const float* lru_b_x;
    const float* lru_lambda; const float* w_out; const float* ln1_g; const float* ln1_b; const float* w_query; const float* sub_keys;
    const float* peer_u; const float* peer_v; const float* ln2_g; const float* ln2_b;
    float* out; unsigned char* ws; int ph_lo, ph_hi;
};

__device__ __forceinline__ unsigned f2bf(float f) { unsigned u = __float_as_uint(f); u += 0x7fffu + ((u >> 16) & 1u); return u >> 16; }
__device__ __forceinline__ unsigned pack2(float a, float b) { return f2bf(a) | (f2bf(b) << 16); }
__device__ __forceinline__ float bflo(unsigned w) { return __uint_as_float(w << 16); }
__device__ __forceinline__ float bfhi(unsigned w) { return __uint_as_float(w & 0xffff0000u); }
__device__ __forceinline__ float wave_sum(float v) {
#pragma unroll
    for (int o = 32; o >= 1; o >>= 1) v += __shfl_xor(v, o);
    return v;
}
__device__ __forceinline__ float wave_max(float v) {
#pragma unroll
    for (int o = 32; o >= 1; o >>= 1) v = fmaxf(v, __shfl_xor(v, o));
    return v;
}
__device__ __forceinline__ float gelu_exact(float v) { return 0.5f * v * (1.0f + erff(v * 0.7071067811865476f)); }
__device__ __forceinline__ float sigmoidf(float v) { return 1.0f / (1.0f + expf(-v)); }
__device__ __forceinline__ float readlane_f(float v, int l) { return __int_as_float(__builtin_amdgcn_readlane(__float_as_int(v), l)); }

__device__ __forceinline__ void convert_flat(const float* src, bf16_t* dst, size_t n8, size_t gtid, size_t gstride) {
    for (size_t i = gtid; i < n8; i += gstride) {
        const float4 a = ((const float4*)src)[2 * i], b = ((const float4*)src)[2 * i + 1];
        uint4 w; w.x = pack2(a.x, a.y); w.y = pack2(a.z, a.w); w.z = pack2(b.x, b.y); w.w = pack2(b.z, b.w);
        ((uint4*)dst)[i] = w;
    }
}
__device__ __forceinline__ void transpose_convert(const float* src, bf16_t* dst, int K, int N, LAS float* tile) {
    const int tid = threadIdx.x, ntn = N / 64, ntiles = (K / 64) * ntn;
    for (int tl = blockIdx.x; tl < ntiles; tl += gridDim.x) {
        const int kt = tl / ntn, nt = tl - kt * ntn;
#pragma unroll
        for (int i = 0; i < 8; ++i) { const int r = (tid >> 6) + 8 * i, c = tid & 63; tile[r * 65 + c] = src[(size_t)(kt * 64 + r) * N + nt * 64 + c]; }
        __syncthreads();
#pragma unroll
        for (int i = 0; i < 4; ++i) { const int n = (tid >> 5) + 16 * i, k0 = 2 * (tid & 31);
            const unsigned v = pack2(tile[k0 * 65 + n], tile[(k0 + 1) * 65 + n]);
            *(unsigned*)(dst + (size_t)(nt * 64 + n) * K + kt * 64 + k0) = v; }
        __syncthreads();
    }
}
__device__ __forceinline__ void quant_tables(const Params& P) {
    const int lane = threadIdx.x & 63, gw = blockIdx.x * 8 + (threadIdx.x >> 6), nw = gridDim.x * 8;
    for (int it = gw; it < 2 * NEXP; it += nw) {
        const bool isv = it >= NEXP; const int row = isv ? it - NEXP : it;
        const float* src = (isv ? P.peer_v : P.peer_u) + (size_t)row * D;
        float4 v[8]; float am = 0.f;
#pragma unroll
        for (int j = 0; j < 2; ++j)
#pragma unroll
            for (int i = 0; i < 4; ++i) { const float4 t = *(const float4*)(src + j * 1024 + lane * 16 + i * 4); v[j * 4 + i] = t; am = fmaxf(am, fmaxf(fmaxf(fabsf(t.x), fabsf(t.y)), fmaxf(fabsf(t.z), fabsf(t.w)))); }
        am = wave_max(am); if (am == 0.f) am = 1.f;
        if (!isv) {
            const float inv = 127.0f / am;
            unsigned char* dst = P.ws + WS_UB + (size_t)row * D;
#pragma unroll
            for (int j = 0; j < 2; ++j) { u32x4 w;
#pragma unroll
                for (int i = 0; i < 4; ++i) { const float4 t = v[j * 4 + i];
                    const int a = (int)rintf(t.x * inv), b = (int)rintf(t.y * inv), c = (int)rintf(t.z * inv), d = (int)rintf(t.w * inv);
                    w[i] = (unsigned)(a & 255) | ((unsigned)(b & 255) << 8) | ((unsigned)(c & 255) << 16) | ((unsigned)(d & 255) << 24); }
                *(u32x4*)(dst + j * 1024 + lane * 16) = w; }
            if (lane == 0) ((float*)(P.ws + WS_SU))[row] = am * (1.0f / 127.0f);
        } else {
            const float inv = 224.0f / am;
            unsigned char* dst = P.ws + WS_VB + (size_t)row * D;
#pragma unroll
            for (int j = 0; j < 2; ++j) { u32x4 w;
#pragma unroll
                for (int i = 0; i < 4; ++i) { const float4 t = v[j * 4 + i]; int o = 0;
                    o = __builtin_amdgcn_cvt_pk_fp8_f32(t.x * inv, t.y * inv, o, false); o = __builtin_amdgcn_cvt_pk_fp8_f32(t.z * inv, t.w * inv, o, true); w[i] = (unsigned)o; }
                *(u32x4*)(dst + j * 1024 + lane * 16) = w; }
            if (lane == 0) ((float*)(P.ws + WS_SV))[row] = am * (1.0f / 224.0f);
        }
    }
}
__device__ __forceinline__ void phase_prologue(const Params& P, LAS unsigned char* lds) {
    const size_t gtid = (size_t)blockIdx.x * NTHREADS + threadIdx.x, gstride = (size_t)gridDim.x * NTHREADS;
    unsigned char* ws = P.ws;
    convert_flat(P.x_prompt, (bf16_t*)(ws + WS_XB), (size_t)NTOK_P * D / 8, gtid, gstride);
    convert_flat(P.x_sample, (bf16_t*)(ws + WS_XB) + (size_t)NTOK_P * D, (size_t)NTOK_S * D / 8, gtid, gstride);
    quant_tables(P);
    convert_flat(P.sub_keys, (bf16_t*)(ws + WS_SKB), (size_t)8 * 2 * 128 * 128 / 8, gtid, gstride);
    transpose_convert(P.w_in, (bf16_t*)(ws + WS_WINT), D, DIN, (LAS float*)lds);
    transpose_convert(P.w_out, (bf16_t*)(ws + WS_WOT), D, D, (LAS float*)lds);
    transpose_convert(P.w_query, (bf16_t*)(ws + WS_WQT), D, D, (LAS float*)lds);
    const size_t n4b = (size_t)2040 * DATT / 4, tot = 32 * n4b;
    for (size_t i = gtid; i < 2 * tot; i += gstride) {
        const int tz = i >= tot; const size_t j = i - (tz ? tot : 0); const size_t b = j / n4b, r = j - b * n4b;
        const float4* src = (const float4*)(tz ? P.cache_v : P.cache_k) + (b * 2048 + 8) * (DATT / 4) + r;
        float4* dst = (float4*)(P.out + (tz ? O_VS : O_KS)) + b * 2048 * (DATT / 4) + r;
        *dst = *src;
    }
}

struct EpiProj {
    static constexpr bool PERM = false, AFTER_DRAIN = false;
    float* out; float* QF; float* XR; float* GATE; bf16_t* QB; bf16_t* KB; bf16_t* VB16;
    __device__ __forceinline__ void operator()(const f32x4 (&acc)[2][2][4][2], const pg8::Unit& u, int wr, int wc, int fr, int fq) const {
        const int pn = u.pn; const int coff = wc * 32 + 4 * fq;
#pragma unroll
        for (int ai = 0; ai < 2; ++ai)
#pragma unroll
            for (int m = 0; m < 4; ++m) {
                const int row = u.pm * 256 + ai * 128 + wr * 64 + m * 16 + fr;
                const bool prompt = row < NTOK_P;
                float* rowp = nullptr; bf16_t* rowb = nullptr; float bsc = 1.0f;
                if (pn < 6) { if (prompt) { rowb = QB + (size_t)row * DATT + pn * 256; bsc = ATT_SCALE * LOG2E; } else rowp = QF + (size_t)row * DATT + pn * 256; }
                else if (pn < 18) {
                    const int isv = pn >= 12; const int c0 = (pn - (isv ? 12 : 6)) * 256;
                    if (prompt) { rowp = out + (isv ? O_VP : O_KP) + (size_t)row * DATT + c0; rowb = (isv ? VB16 : KB) + (size_t)row * DATT + c0; }
                    else { const int rr = row - NTOK_P, b = rr >> 3, t = rr & 7; rowp = out + (isv ? O_VS : O_KS) + ((size_t)b * 2048 + 2040 + t) * DATT + c0; }
                } else if (pn < 20) rowp = XR + (size_t)row * DLRU + (pn - 18) * 256;
                else rowp = GATE + (size_t)row * DLRU + (pn - 20) * 256;
#pragma unroll
                for (int bj = 0; bj < 2; ++bj)
#pragma unroll
                    for (int n = 0; n < 2; ++n) {
                        const f32x4 v = acc[ai][bj][m][n];
                        if (rowp) *(f32x4*)(rowp + coff + bj * 128 + n * 16) = v;
                        if (rowb) { u32x2 w; w.x = pg8::cvt_pk_bf16(v[0] * bsc, v[1] * bsc); w.y = pg8::cvt_pk_bf16(v[2] * bsc, v[3] * bsc); *(u32x2*)(rowb + coff + bj * 128 + n * 16) = w; }
                    }
            }
    }
};
struct EpiOut {
    static constexpr bool PERM = false, AFTER_DRAIN = false;
    const float* xp; const float* xs; float* pre;
    __device__ __forceinline__ void operator()(const f32x4 (&acc)[2][2][4][2], const pg8::Unit& u, int wr, int wc, int fr, int fq) const {
        const int col0 = u.pn * 256 + wc * 32 + 4 * fq;
#pragma unroll
        for (int ai = 0; ai < 2; ++ai)
#pragma unroll
            for (int m = 0; m < 4; ++m) {
                const int row = u.pm * 256 + ai * 128 + wr * 64 + m * 16 + fr;
                const float* xr = (row < NTOK_P ? xp + (size_t)row * D : xs + (size_t)(row - NTOK_P) * D) + col0;
                float* pr = pre + (size_t)row * D + col0;
#pragma unroll
                for (int bj = 0; bj < 2; ++bj)
#pragma unroll
                    for (int n = 0; n < 2; ++n) { const f32x4 xv = *(const f32x4*)(xr + bj * 128 + n * 16); *(f32x4*)(pr + bj * 128 + n * 16) = xv * ALPHA + acc[ai][bj][m][n]; }
            }
    }
};
struct EpiPlain {
    static constexpr bool PERM = false, AFTER_DRAIN = false;
    float* C; int ldc;
    __device__ __forceinline__ void operator()(const f32x4 (&acc)[2][2][4][2], const pg8::Unit& u, int wr, int wc, int fr, int fq) const {
        const int col0 = u.pn * 256 + wc * 32 + 4 * fq;
#pragma unroll
        for (int ai = 0; ai < 2; ++ai)
#pragma unroll
            for (int m = 0; m < 4; ++m) {
                const int row = u.pm * 256 + ai * 128 + wr * 64 + m * 16 + fr;
                float* pr = C + (size_t)row * ldc + col0;
#pragma unroll
                for (int bj = 0; bj < 2; ++bj)
#pragma unroll
                    for (int n = 0; n < 2; ++n) *(f32x4*)(pr + bj * 128 + n * 16) = acc[ai][bj][m][n];
            }
    }
};

struct EpiBf16Plain {
    static constexpr bool PERM = false, AFTER_DRAIN = false;
    bf16_t* C; int ldc;
    __device__ __forceinline__ void operator()(const f32x4 (&acc)[2][2][4][2], const pg8::Unit& u, int wr, int wc, int fr, int fq) const {
        const int col0 = u.pn * 256 + wc * 32 + 4 * fq;
#pragma unroll
        for (int ai = 0; ai < 2; ++ai)
#pragma unroll
            for (int m = 0; m < 4; ++m) {
                const int row = u.pm * 256 + ai * 128 + wr * 64 + m * 16 + fr;
                bf16_t* pr = C + (size_t)row * ldc + col0;
#pragma unroll
                for (int bj = 0; bj < 2; ++bj)
#pragma unroll
                    for (int n = 0; n < 2; ++n) { const f32x4 v = acc[ai][bj][m][n]; u32x2 w; w.x = pg8::cvt_pk_bf16(v[0], v[1]); w.y = pg8::cvt_pk_bf16(v[2], v[3]); *(u32x2*)(pr + bj * 128 + n * 16) = w; }
            }
    }
};

__device__ __forceinline__ const float* kv_row(const Params& P, bool isv, bool samp, int b, int pos, int h) {
    if (!samp) return P.out + (isv ? O_VP : O_KP) + ((size_t)(b * 2048 + pos) * DATT + h * HD);
    if (pos < 2048) return (isv ? P.cache_v : P.cache_k) + ((size_t)(b * 2048 + pos) * DATT + h * HD);
    return P.out + (isv ? O_VS : O_KS) + ((size_t)(b * 2048 + 2040 + (pos - 2048)) * DATT + h * HD);
}
__device__ __forceinline__ void attn_simple_unit(const Params& P, int row, int h, LAS float* wl, int lane) {
    const bool samp = row >= NTOK_P; int b, t;
    if (!samp) { b = row >> 11; t = row & 2047; } else { b = (row - NTOK_P) >> 3; t = (row - NTOK_P) & 7; }
    const float* qrow = (const float*)(P.ws + WS_QF) + (size_t)row * DATT + h * HD;
    wl[lane] = qrow[lane]; wl[64 + lane] = qrow[64 + lane];
    __builtin_amdgcn_wave_barrier();
    const float slope = exp2f(-8.0f * (float)(h + 1) / 12.0f);
    const int base = samp ? 2048 : 0;
    float sc[7]; float mx = -INFINITY;
#pragma unroll
    for (int r = 0; r < 7; ++r) {
        const int idx = r * 64 + lane; float s = -INFINITY;
        if (idx < 387) {
            const int pz = idx / 129, d = idx - pz * 129, dil = 1 << (2 * pz), pos = base + t - dil * d;
            if (pos >= 0) {
                const float4* kr = (const float4*)kv_row(P, false, samp, b, pos, h); float a = 0.f;
#pragma unroll 8
                for (int e4 = 0; e4 < 32; ++e4) { const float4 kv = kr[e4]; const f32x4 qv = ((LAS f32x4*)wl)[e4]; a += kv.x * qv.x + kv.y * qv.y + kv.z * qv.z + kv.w * qv.w; }
                s = a * ATT_SCALE - slope * (float)(dil * d);
            }
        }
        sc[r] = s; mx = fmaxf(mx, s);
    }
    mx = wave_max(mx);
    float l = 0.f;
#pragma unroll
    for (int r = 0; r < 7; ++r) { const float p = (sc[r] == -INFINITY) ? 0.f : expf(sc[r] - mx); wl[128 + r * 64 + lane] = p; l += p; }
    l = wave_sum(l);
    __builtin_amdgcn_wave_barrier();
    float o0 = 0.f, o1 = 0.f;
    for (int idx = 0; idx < 387; ++idx) {
        const float p = wl[128 + idx];
        if (p != 0.f) {
            const int pz = idx / 129, d = idx - pz * 129, dil = 1 << (2 * pz), pos = base + t - dil * d;
            const float2 vv = ((const float2*)kv_row(P, true, samp, b, pos, h))[lane];
            o0 += p * vv.x; o1 += p * vv.y;
        }
    }
    const float inv = 1.0f / l;
    bf16_t* ar = (bf16_t*)(P.ws + WS_AR) + (size_t)row * D + h * HD;
    *(unsigned*)(ar + 2 * lane) = pack2(o0 * inv, o1 * inv);
    __builtin_amdgcn_wave_barrier();
}

constexpr int KVS = 288, VOFF = 73728;
template <int MODE>
__device__ __forceinline__ void attn_unit(const Params& P, int p, int b, int h, int r, int c, LAS unsigned char* lds) {
    const int tid = threadIdx.x, lane = tid & 63, w = __builtin_amdgcn_readfirstlane(tid >> 6);
    const int dil = 1 << (2 * p);
    const bf16_t* Qb = (const bf16_t*)(P.ws + WS_QB); const bf16_t* Kb = (const bf16_t*)(P.ws + WS_KB); const bf16_t* Vb = (const bf16_t*)(P.ws + WS_VB16);
    const size_t tok0 = (size_t)b * 2048;
    const int j0 = 128 * c - 128, rho0 = (c == 0) ? 128 : 0;
#pragma unroll
    for (int it = 0; it < 8; ++it) {
        const int rho = it * 32 + (tid >> 4), ch = tid & 15;
        if (rho >= rho0) {
            const size_t tok = tok0 + (size_t)((j0 + rho) * dil + r);
            const u32x4 kv = *(const u32x4*)(Kb + tok * DATT + h * HD + ch * 8);
            const u32x4 vv = *(const u32x4*)(Vb + tok * DATT + h * HD + ch * 8);
            *(LAS u32x4*)(lds + rho * KVS + ch * 16) = kv;
            *(LAS u32x4*)(lds + VOFF + rho * KVS + ch * 16) = vv;
        }
    }
    const int cq = lane & 15, g = lane >> 4;
    const int iq = 128 * c + 16 * w + cq;
    const size_t qtok = tok0 + (size_t)(iq * dil + r);
    bf16x8 qf[4];
#pragma unroll
    for (int ks = 0; ks < 4; ++ks) qf[ks] = *(const bf16x8*)(Qb + qtok * DATT + h * HD + 32 * ks + 8 * g);
    __syncthreads();
    const int ktmin = (8 - w - 8 * c) > 0 ? (8 - w - 8 * c) : 0;
    const float slope2 = exp2f(-8.0f * (float)(h + 1) / 12.0f) * LOG2E * (float)dil;
    f32x4 s[9]; float m = -INFINITY;
#pragma unroll
    for (int kt = 0; kt < 9; ++kt) {
        if (kt >= ktmin) {
            f32x4 acc = {0.f, 0.f, 0.f, 0.f};
#pragma unroll
            for (int ks = 0; ks < 4; ++ks) { const bf16x8 kf = *(const LAS bf16x8*)(lds + (16 * w + 16 * kt + cq) * KVS + (32 * ks + 8 * g) * 2); acc = __builtin_amdgcn_mfma_f32_16x16x32_bf16(kf, qf[ks], acc, 0, 0, 0); }
#pragma unroll
            for (int ii = 0; ii < 4; ++ii) { const int dist = cq + 128 - 16 * kt - 4 * g - ii; float v = acc[ii] - slope2 * (float)dist;
                if (kt == 0 && dist > 128) v = -INFINITY; if (kt == 8 && dist < 0) v = -INFINITY; acc[ii] = v; m = fmaxf(m, v); }
            s[kt] = acc;
        } else s[kt] = (f32x4){-INFINITY, -INFINITY, -INFINITY, -INFINITY};
    }
    m = fmaxf(m, __shfl_xor(m, 16)); m = fmaxf(m, __shfl_xor(m, 32));
    float l = 0.f;
#pragma unroll
    for (int kt = 0; kt < 9; ++kt)
#pragma unroll
        for (int ii = 0; ii < 4; ++ii) { const float pp = exp2f(s[kt][ii] - m); s[kt][ii] = pp; l += pp; }
    l += __shfl_xor(l, 16); l += __shfl_xor(l, 32);
    f32x4 o[8];
#pragma unroll
    for (int dt = 0; dt < 8; ++dt) o[dt] = (f32x4){0.f, 0.f, 0.f, 0.f};
#pragma unroll
    for (int kk = 0; kk < 5; ++kk) {
        const int T0 = 2 * kk, T1 = 2 * kk + 1;
        if (T1 >= ktmin || T0 == 8) {
            u32x4 pw; pw.x = pg8::cvt_pk_bf16(s[T0][0], s[T0][1]); pw.y = pg8::cvt_pk_bf16(s[T0][2], s[T0][3]);
            if (T1 <= 8) { pw.z = pg8::cvt_pk_bf16(s[T1 <= 8 ? T1 : 8][0], s[T1 <= 8 ? T1 : 8][1]); pw.w = pg8::cvt_pk_bf16(s[T1 <= 8 ? T1 : 8][2], s[T1 <= 8 ? T1 : 8][3]); } else { pw.z = 0u; pw.w = 0u; }
            const bf16x8 pf = __builtin_bit_cast(bf16x8, pw);
            const int rT0 = (T0 >= ktmin) ? T0 : 8, rT1 = (T1 <= 8 && T1 >= ktmin) ? T1 : 8;
            const int a0 = VOFF + (16 * w + 16 * rT0 + 4 * g + (cq >> 2)) * KVS + 8 * (cq & 3);
            const int a1 = VOFF + (16 * w + 16 * rT1 + 4 * g + (cq >> 2)) * KVS + 8 * (cq & 3);
#pragma unroll
            for (int dt = 0; dt < 8; ++dt) {
                const s16x4 v0 = __builtin_amdgcn_ds_read_tr16_b64_v4i16((LAS s16x4*)(lds + a0 + dt * 32));
                const s16x4 v1 = __builtin_amdgcn_ds_read_tr16_b64_v4i16((LAS s16x4*)(lds + a1 + dt * 32));
                const bf16x8 vf = {v0[0], v0[1], v0[2], v0[3], v1[0], v1[1], v1[2], v1[3]};
                o[dt] = __builtin_amdgcn_mfma_f32_16x16x32_bf16(vf, pf, o[dt], 0, 0, 0);
            }
        }
    }
    const float inv = 1.0f / l;
    if (MODE == 0) {
        bf16_t* po = (bf16_t*)(P.ws + WS_PO) + ((size_t)p * NTOK_P + qtok) * DATT + h * HD + 4 * g;
#pragma unroll
        for (int dt = 0; dt < 8; ++dt) { u32x2 wv; wv.x = pg8::cvt_pk_bf16(o[dt][0] * inv, o[dt][1] * inv); wv.y = pg8::cvt_pk_bf16(o[dt][2] * inv, o[dt][3] * inv); *(u32x2*)(po + 16 * dt) = wv; }
        if (g == 0) { ((float*)(P.ws + WS_PM))[((size_t)p * NTOK_P + qtok) * NH + h] = m; ((float*)(P.ws + WS_PL))[((size_t)p * NTOK_P + qtok) * NH + h] = l; }
    } else {
        const float* PM = (const float*)(P.ws + WS_PM); const float* PL = (const float*)(P.ws + WS_PL);
        const float m0 = PM[qtok * NH + h], l0 = PL[qtok * NH + h], m1 = PM[((size_t)NTOK_P + qtok) * NH + h], l1 = PL[((size_t)NTOK_P + qtok) * NH + h];
        const float M = fmaxf(m, fmaxf(m0, m1));
        const float w2 = exp2f(m - M), w0 = exp2f(m0 - M) * l0, w1 = exp2f(m1 - M) * l1;
        const float rden = 1.0f / (w2 * l + w0 + w1);
        const bf16_t* p0 = (const bf16_t*)(P.ws + WS_PO) + qtok * DATT + h * HD + 4 * g;
        const bf16_t* p1 = p0 + (size_t)NTOK_P * DATT;
        bf16_t* ar = (bf16_t*)(P.ws + WS_AR) + qtok * D + h * HD + 4 * g;
#pragma unroll
        for (int dt = 0; dt < 8; ++dt) {
            const u32x2 x0 = *(const u32x2*)(p0 + 16 * dt), x1 = *(const u32x2*)(p1 + 16 * dt);
            const float r0 = (w2 * o[dt][0] + w0 * bflo(x0.x) + w1 * bflo(x1.x)) * rden, r1 = (w2 * o[dt][1] + w0 * bfhi(x0.x) + w1 * bfhi(x1.x)) * rden;
            const float r2 = (w2 * o[dt][2] + w0 * bflo(x0.y) + w1 * bflo(x1.y)) * rden, r3 = (w2 * o[dt][3] + w0 * bfhi(x0.y) + w1 * bfhi(x1.y)) * rden;
            u32x2 wv; wv.x = pg8::cvt_pk_bf16(r0, r1); wv.y = pg8::cvt_pk_bf16(r2, r3); *(u32x2*)(ar + 16 * dt) = wv;
        }
    }
    __syncthreads();
}

__device__ __forceinline__ void lru_unit(const Params& P, bool samp, int b, int n, int k, int lane) {
    const int T = samp ? 8 : 64; const int row0 = samp ? NTOK_P + b * 8 : b * 2048 + k * 64; const int ch = n * 64 + lane;
    float wa[64], wx[64];
#pragma unroll
    for (int c = 0; c < 64; ++c) { wa[c] = P.lru_w_a[(n * 64 + c) * 64 + lane]; wx[c] = P.lru_w_x[(n * 64 + c) * 64 + lane]; }
    const float ba = P.lru_b_a[ch], bx = P.lru_b_x[ch], lam = P.lru_lambda[ch];
    const float sp = log1pf(expf(-lam));
    const float cw0 = P.conv_w[ch], cw1 = P.conv_w[512 + ch], cw2 = P.conv_w[1024 + ch], cw3 = P.conv_w[1536 + ch], cb = P.conv_b[ch];
    const float* XR = (const float*)(P.ws + WS_XR); const float* GT = (const float*)(P.ws + WS_GATE);
    float* R0 = (float*)(P.ws + WS_R0); float* R1 = (float*)(P.ws + WS_R1); bf16_t* AR = (bf16_t*)(P.ws + WS_AR);
    float x0 = 0.f, x1 = 0.f, x2 = 0.f, h = 0.f, A = 1.f;
    if (samp) { x0 = P.state_conv[(b * 3 + 0) * 512 + ch]; x1 = P.state_conv[(b * 3 + 1) * 512 + ch]; x2 = P.state_conv[(b * 3 + 2) * 512 + ch]; h = P.state_h[b * 512 + ch]; }
    else if (k > 0) { x0 = XR[(size_t)(row0 - 3) * DLRU + ch]; x1 = XR[(size_t)(row0 - 2) * DLRU + ch]; x2 = XR[(size_t)(row0 - 1) * DLRU + ch]; }
    for (int t0 = 0; t0 < T; t0 += 8) {
        float xin[8], gt[8];
#pragma unroll
        for (int i = 0; i < 8; ++i) { xin[i] = XR[(size_t)(row0 + t0 + i) * DLRU + ch]; gt[i] = GT[(size_t)(row0 + t0 + i) * DLRU + ch]; }
#pragma unroll
        for (int i = 0; i < 8; ++i) {
            const float xc = ((x0 * cw0 + x1 * cw1) + x2 * cw2) + xin[i] * cw3 + cb;
            x0 = x1; x1 = x2; x2 = xin[i];
            float ra = 0.f, ri = 0.f;
#pragma unroll
            for (int c = 0; c < 64; ++c) { const float xcc = readlane_f(xc, c); ra += xcc * wa[c]; ri += xcc * wx[c]; if ((c & 15) == 15) __builtin_amdgcn_sched_barrier(0); }
            const float rr = sigmoidf(ra + ba), ig = sigmoidf(ri + bx);
            const float log_a = -8.0f * rr * sp; const float a = expf(log_a);
            const float u = sqrtf(-expm1f(2.0f * log_a)) * (ig * xc);
            h = a * h + u; A = a * A;
            const float ge = gelu_exact(gt[i]);
            if (samp) AR[(size_t)(row0 + t0 + i) * D + DATT + ch] = (bf16_t)f2bf(h * ge);
            else { R0[(size_t)(row0 + t0 + i) * DLRU + ch] = h * ge; R1[(size_t)(row0 + t0 + i) * DLRU + ch] = A * ge; }
        }
    }
    if (samp) { P.out[O_HS + (size_t)b * 512 + ch] = h; float* co = P.out + O_CS + (size_t)b * 3 * 512 + ch; co[0] = x0; co[512] = x1; co[1024] = x2; }
    else {
        ((float*)(P.ws + WS_HE))[((size_t)(b * 32 + k)) * 512 + ch] = h; ((float*)(P.ws + WS_AE))[((size_t)(b * 32 + k)) * 512 + ch] = A;
        if (k == 31) { float* co = P.out + O_CP + (size_t)b * 3 * 512 + ch; co[0] = x0; co[512] = x1; co[1024] = x2; }
    }
}

__device__ __forceinline__ void phase_mix_a(const Params& P, LAS unsigned char* lds) {
    const int lane = threadIdx.x & 63, wave = __builtin_amdgcn_readfirstlane(threadIdx.x >> 6);
    const int gw = blockIdx.x * 8 + wave, nw = gridDim.x * 8;
    for (int u = gw; u < 2048 + 256; u += nw) { const bool samp = u >= 2048; const int v = samp ? u - 2048 : u; lru_unit(P, samp, samp ? (v >> 3) : (v >> 8), samp ? (v & 7) : ((v >> 5) & 7), v & 31, lane); }
    { LAS float* wl = (LAS float*)lds + wave * 576;
      for (int u = gw; u < NTOK_S * NH; u += nw) attn_simple_unit(P, NTOK_P + u / NH, u % NH, wl, lane); }
    __syncthreads();
    for (int u = blockIdx.x; u < 3072; u += gridDim.x) {
        const int p = u / 1536, rem = u - p * 1536, bh = rem >> 4, rc = rem & 15;
        const int b = bh / NH, h = bh - b * NH;
        const int r = p == 0 ? 0 : (rc >> 2), c = p == 0 ? rc : (rc & 3);
        attn_unit<0>(P, p, b, h, r, c, lds);
    }
}
__device__ __forceinline__ void phase_mix_b(const Params& P, LAS unsigned char* lds) {
    {
        const int gt = blockIdx.x * NTHREADS + threadIdx.x;
        for (int i = gt; i < 8 * 32 * 512; i += gridDim.x * NTHREADS) {
            const int ch = i & 511, k = (i >> 9) & 31, b = i >> 14;
            const float* HE = (const float*)(P.ws + WS_HE) + (size_t)b * 32 * 512 + ch; const float* AE = (const float*)(P.ws + WS_AE) + (size_t)b * 32 * 512 + ch;
            float hin = 0.f;
            for (int kk = 0; kk < k; ++kk) hin = HE[kk * 512] + AE[kk * 512] * hin;
            const float* R0 = (const float*)(P.ws + WS_R0) + (size_t)(b * 2048 + k * 64) * DLRU + ch; const float* R1 = (const float*)(P.ws + WS_R1) + (size_t)(b * 2048 + k * 64) * DLRU + ch;
            bf16_t* ar = (bf16_t*)(P.ws + WS_AR) + (size_t)(b * 2048 + k * 64) * D + DATT + ch;
#pragma unroll 8
            for (int t = 0; t < 64; ++t) ar[(size_t)t * D] = (bf16_t)f2bf(R0[(size_t)t * DLRU] + R1[(size_t)t * DLRU] * hin);
            if (k == 31) P.out[O_HP + (size_t)b * 512 + ch] = HE[31 * 512] + AE[31 * 512] * hin;
        }
    }
    for (int u = blockIdx.x; u < 1536; u += gridDim.x) {
        const int bh = u >> 4, r = u & 15; const int b = bh / NH, h = bh - b * NH;
        attn_unit<1>(P, 2, b, h, r, 0, lds);
    }
}

__device__ __forceinline__ void phase_ln1(const Params& P) {
    const int lane = threadIdx.x & 63, wave = threadIdx.x >> 6;
    const float* pre = (const float*)(P.ws + WS_PRE1); float* x1f = (float*)(P.ws + WS_X1F); bf16_t* x1b = (bf16_t*)(P.ws + WS_X1B);
    for (int row = blockIdx.x * 8 + wave; row < NTOK; row += gridDim.x * 8) {
        float4 v[8]; float s = 0.f;
#pragma unroll
        for (int j = 0; j < 8; ++j) { v[j] = *(const float4*)(pre + (size_t)row * D + (j >> 2) * 1024 + lane * 16 + (j & 3) * 4); s += (v[j].x + v[j].y) + (v[j].z + v[j].w); }
        const float mean = wave_sum(s) * (1.0f / D); float q = 0.f;
#pragma unroll
        for (int j = 0; j < 8; ++j) { const float a = v[j].x - mean, b = v[j].y - mean, c = v[j].z - mean, d = v[j].w - mean; q += (a * a + b * b) + (c * c + d * d); }
        const float rstd = rsqrtf(wave_sum(q) * (1.0f / D) + LN_EPS);
        float am = 0.f;
#pragma unroll
        for (int j = 0; j < 8; ++j) { const int col = (j >> 2) * 1024 + lane * 16 + (j & 3) * 4; const float4 g = *(const float4*)(P.ln1_g + col), bb = *(const float4*)(P.ln1_b + col);
            float4 o; o.x = (v[j].x - mean) * rstd * g.x + bb.x; o.y = (v[j].y - mean) * rstd * g.y + bb.y; o.z = (v[j].z - mean) * rstd * g.z + bb.z; o.w = (v[j].w - mean) * rstd * g.w + bb.w;
            v[j] = o; am = fmaxf(am, fmaxf(fmaxf(fabsf(o.x), fabsf(o.y)), fmaxf(fabsf(o.z), fabsf(o.w))));
            *(float4*)(x1f + (size_t)row * D + col) = o;
            uint2 w; w.x = pack2(o.x, o.y); w.y = pack2(o.z, o.w); *(uint2*)(x1b + (size_t)row * D + col) = w; }
        am = wave_max(am); if (am == 0.f) am = 1.f;
        const float inv = 127.0f / am;
        unsigned char* xq = P.ws + WS_X1Q + (size_t)row * D;
#pragma unroll
        for (int j = 0; j < 2; ++j) { u32x4 w;
#pragma unroll
            for (int i = 0; i < 4; ++i) { const float4 t = v[j * 4 + i];
                const int a = (int)rintf(t.x * inv), b = (int)rintf(t.y * inv), c = (int)rintf(t.z * inv), d = (int)rintf(t.w * inv);
                w[i] = (unsigned)(a & 255) | ((unsigned)(b & 255) << 8) | ((unsigned)(c & 255) << 16) | ((unsigned)(d & 255) << 24); }
            *(u32x4*)(xq + j * 1024 + lane * 16) = w; }
        if (lane == 0) ((float*)(P.ws + WS_SX))[row] = am * (1.0f / 127.0f);
    }
}

__device__ __forceinline__ int mono(float v) { const int b = __float_as_int(v); return b ^ ((b >> 31) & 0x7fffffff); }
__device__ __forceinline__ float unmono(int k) { return __int_as_float(k ^ ((k >> 31) & 0x7fffffff)); }
#define MK_INSERT16(L, X) do { int _x = (X); _Pragma("unroll") for (int _j = 0; _j < 16; ++_j) { const int _hi = max(L[_j], _x); _x = min(L[_j], _x); L[_j] = _hi; } } while (0)

template <int N> __device__ __forceinline__ void bitonic_sort_desc(int (&v)[N]) {
#pragma unroll
    for (int k = 2; k <= N; k <<= 1)
#pragma unroll
        for (int j = k >> 1; j > 0; j >>= 1)
#pragma unroll
            for (int i = 0; i < N; ++i) { const int l = i ^ j;
                if (l > i) { const int a = v[i], b = v[l]; if ((i & k) == 0) { v[i] = max(a, b); v[l] = min(a, b); } else { v[i] = min(a, b); v[l] = max(a, b); } } }
}
template <int N> __device__ __forceinline__ void bitonic_merge_desc(int (&v)[N]) {
#pragma unroll
    for (int j = N >> 1; j > 0; j >>= 1)
#pragma unroll
        for (int i = 0; i < N; ++i) { const int l = i ^ j; if (l > i) { const int a = v[i], b = v[l]; v[i] = max(a, b); v[l] = min(a, b); } }
}
__device__ __forceinline__ void xlane_merge16(int (&v)[16], int off) {
    int c[16];
#pragma unroll
    for (int i = 0; i < 16; ++i) c[i] = max(v[i], __shfl_xor(v[15 - i], off));
#pragma unroll
    for (int i = 0; i < 16; ++i) v[i] = c[i];
    bitonic_merge_desc<16>(v);
}
__device__ __forceinline__ int sel4(int g, int a, int b, int c, int d) { return g == 0 ? a : (g == 1 ? b : (g == 2 ? c : d)); }
__device__ __forceinline__ float sel4f(int g, float a, float b, float c, float d) { return g == 0 ? a : (g == 1 ? b : (g == 2 ? c : d)); }
__device__ __forceinline__ constexpr int cand_a(int role, int i) {
    return role == 0 ? 0 : role == 1 ? (i < 8 ? 1 : (i < 13 ? 2 : 4)) : role == 2 ? (i < 4 ? 3 : (i < 6 ? 5 : (i < 8 ? 6 : (i < 10 ? 7 : 8 + (i - 10))))) : (i < 2 ? 14 + i : -1);
}
__device__ __forceinline__ constexpr int cand_b(int role, int i) {
    return role == 0 ? i : role == 1 ? (i < 8 ? i : (i < 13 ? i - 8 : i - 13)) : role == 2 ? (i < 4 ? i : (i < 6 ? i - 4 : (i < 8 ? i - 6 : (i < 10 ? i - 8 : 0)))) : 0;
}

__device__ __forceinline__ void route_unit(const Params& P, int h, int tg, LAS unsigned char* lds, LAS int* lst) {
    const int lane = threadIdx.x & 63, w = __builtin_amdgcn_readfirstlane(threadIdx.x >> 6);
    const int cq = lane & 15, g = lane >> 4;
    const int tok = tg * 128 + w * 16 + cq;
    const bf16_t* qrow = (const bf16_t*)(P.ws + WS_QP) + (size_t)tok * D + h * 256;
    int L0[16], L1[16];
#pragma unroll
    for (int p = 0; p < 2; ++p) {
        bf16x8 qf[4];
#pragma unroll
        for (int ks = 0; ks < 4; ++ks) qf[ks] = *(const bf16x8*)(qrow + p * 128 + 32 * ks + 8 * g);
        int v0[16], v1[16];
#pragma unroll
        for (int kt = 0; kt < 8; ++kt) {
            f32x4 acc = {0.f, 0.f, 0.f, 0.f};
#pragma unroll
            for (int ks = 0; ks < 4; ++ks) { const bf16x8 kf = *(const LAS bf16x8*)(lds + (p * 128 + 16 * kt + cq) * KVS + (32 * ks + 8 * g) * 2); acc = __builtin_amdgcn_mfma_f32_16x16x32_bf16(kf, qf[ks], acc, 0, 0, 0); }
#pragma unroll
            for (int ii = 0; ii < 4; ++ii) { const int key = (mono(acc[ii]) & ~127) | (16 * kt + 4 * g + ii); if (kt < 4) v0[kt * 4 + ii] = key; else v1[(kt - 4) * 4 + ii] = key; }
        }
        bitonic_sort_desc<16>(v0); bitonic_sort_desc<16>(v1);
#pragma unroll
        for (int i = 0; i < 16; ++i) v0[i] = max(v0[i], v1[15 - i]);
        bitonic_merge_desc<16>(v0);
        xlane_merge16(v0, 16); xlane_merge16(v0, 32);
#pragma unroll
        for (int i = 0; i < 16; ++i) { if (p == 0) L0[i] = v0[i]; else L1[i] = v0[i]; }
    }
    if (g == 0) {
#pragma unroll
        for (int i = 0; i < 16; ++i) lst[(cq * 2 + 0) * 16 + i] = L0[i];
    }
    if (g == 1) {
#pragma unroll
        for (int i = 0; i < 16; ++i) lst[(cq * 2 + 1) * 16 + i] = L1[i];
    }
    float f0[16], f1[16];
#pragma unroll
    for (int i = 0; i < 16; ++i) { f0[i] = unmono(L0[i] & ~127); f1[i] = unmono(L1[i] & ~127); }
    int c[16];
#pragma unroll
    for (int i = 0; i < 16; ++i) {
        constexpr int NEG = (int)0x80000000;
        const float va = sel4f(g, f0[cand_a(0, i)], f0[cand_a(1, i)], f0[cand_a(2, i)], f0[cand_a(3, i) < 0 ? 0 : cand_a(3, i)]);
        const float vb = sel4f(g, f1[cand_b(0, i)], f1[cand_b(1, i)], f1[cand_b(2, i)], f1[cand_b(3, i)]);
        const int id = sel4(g, (cand_a(0, i) << 4) | cand_b(0, i), (cand_a(1, i) << 4) | cand_b(1, i), (cand_a(2, i) << 4) | cand_b(2, i), ((cand_a(3, i) < 0 ? 0 : cand_a(3, i)) << 4) | cand_b(3, i));
        int key = (mono(va + vb) & ~255) | id;
        if (cand_a(3, i) < 0) key = (g == 3) ? NEG : key;
        c[i] = key;
    }
    bitonic_sort_desc<16>(c);
    xlane_merge16(c, 16); xlane_merge16(c, 32);
    const float mx = unmono(c[0] & ~255);
    float e[16]; float sum = 0.f;
#pragma unroll
    for (int i = 0; i < 16; ++i) { e[i] = exp2f((unmono(c[i] & ~255) - mx) * LOG2E); sum += e[i]; }
    const float inv = 1.0f / sum;
    __builtin_amdgcn_wave_barrier();
    int ei[4]; float gi[4];
#pragma unroll
    for (int j = 0; j < 4; ++j) {
        const int key = sel4(g, c[j], c[4 + j], c[8 + j], c[12 + j]);
        gi[j] = sel4f(g, e[j], e[4 + j], e[8 + j], e[12 + j]) * inv;
        const int a = (key >> 4) & 15, b = key & 15;
        const int i0 = lst[(cq * 2 + 0) * 16 + a] & 127, i1 = lst[(cq * 2 + 1) * 16 + b] & 127;
        ei[j] = i0 * 128 + i1;
    }
    int* EIDX = (int*)(P.ws + WS_EIDX); float* GW = (float*)(P.ws + WS_GW);
    *(int4*)(EIDX + (size_t)tok * 128 + h * 16 + 4 * g) = make_int4(ei[0], ei[1], ei[2], ei[3]);
    *(float4*)(GW + (size_t)tok * 128 + h * 16 + 4 * g) = make_float4(gi[0], gi[1], gi[2], gi[3]);
    __builtin_amdgcn_wave_barrier();
}
__device__ __forceinline__ void phase_route(const Params& P, LAS unsigned char* lds) {
    const int tid = threadIdx.x, wave = __builtin_amdgcn_readfirstlane(tid >> 6);
    const int h = blockIdx.x & 7, slot = blockIdx.x >> 3, nslot = gridDim.x >> 3;
    const bf16_t* sk = (const bf16_t*)(P.ws + WS_SKB) + (size_t)h * 2 * 128 * 128;
#pragma unroll
    for (int it = 0; it < 8; ++it) { const int row = it * 32 + (tid >> 4), ch = tid & 15; *(LAS u32x4*)(lds + row * KVS + ch * 16) = *(const u32x4*)(sk + (size_t)row * 128 + ch * 8); }
    __syncthreads();
    LAS int* lst = (LAS int*)(lds + 73728) + wave * 512;
    for (int tg = slot; tg < NTOK / 128; tg += nslot) route_unit(P, h, tg, lds, lst);
}

struct ExpGrp { u32x4 u[4][2]; u32x4 v[4][2]; };
__device__ __forceinline__ void exp_load(ExpGrp& G, __amdgpu_buffer_rsrc_t ru, __amdgpu_buffer_rsrc_t rv, int e_lo, int e_hi, int grp, int lane) {
#pragma unroll
    for (int j = 0; j < 4; ++j) {
        const int k = grp * 4 + j; const int e = __builtin_amdgcn_readlane(k < 64 ? e_lo : e_hi, k & 63);
        const int so = e * D, vo = lane * 16;
        G.u[j][0] = __builtin_amdgcn_raw_buffer_load_b128(ru, vo, so, 0); G.u[j][1] = __builtin_amdgcn_raw_buffer_load_b128(ru, vo + 1024, so, 0);
        G.v[j][0] = __builtin_amdgcn_raw_buffer_load_b128(rv, vo, so, 0); G.v[j][1] = __builtin_amdgcn_raw_buffer_load_b128(rv, vo + 1024, so, 0);
    }
}
__device__ __forceinline__ void exp_consume(const ExpGrp& G, const u32x4 (&xq)[2], float (&acc)[32], float a_lo, float a_hi, float b_lo, float b_hi, int grp, int lane) {
    int d[4];
#pragma unroll
    for (int j = 0; j < 4; ++j) { int t = 0;
#pragma unroll
        for (int jj = 0; jj < 2; ++jj)
#pragma unroll
            for (int i = 0; i < 4; ++i) t = __builtin_amdgcn_sdot4((int)G.u[j][jj][i], (int)xq[jj][i], t, false);
        d[j] = t; }
    const bool b5 = (lane & 32) != 0, b4 = (lane & 16) != 0;
    int r0 = (b5 ? d[2] : d[0]) + __shfl_xor(b5 ? d[0] : d[2], 32);
    int r1 = (b5 ? d[3] : d[1]) + __shfl_xor(b5 ? d[1] : d[3], 32);
    int r = (b4 ? r1 : r0) + __shfl_xor(b4 ? r0 : r1, 16);
    r += __shfl_xor(r, 8); r += __shfl_xor(r, 4); r += __shfl_xor(r, 2); r += __shfl_xor(r, 1);
    const int myj = (b5 ? 2 : 0) + (b4 ? 1 : 0), myk = grp * 4 + myj;
    const float ak = __shfl(myk < 64 ? a_lo : a_hi, myk & 63), bk = __shfl(myk < 64 ? b_lo : b_hi, myk & 63);
    const float wmine = bk * gelu_exact((float)r * ak);
#pragma unroll
    for (int j = 0; j < 4; ++j) {
        const float w = readlane_f(wmine, (j >> 1) * 32 + (j & 1) * 16);
        __builtin_amdgcn_sched_barrier(0);
#pragma unroll
        for (int jj = 0; jj < 2; ++jj)
#pragma unroll
            for (int i = 0; i < 4; ++i) {
                const f32x2 lo = __builtin_amdgcn_cvt_pk_f32_fp8((int)G.v[j][jj][i], false), hi = __builtin_amdgcn_cvt_pk_f32_fp8((int)G.v[j][jj][i], true);
                acc[jj * 16 + i * 4 + 0] += w * lo.x; acc[jj * 16 + i * 4 + 1] += w * lo.y; acc[jj * 16 + i * 4 + 2] += w * hi.x; acc[jj * 16 + i * 4 + 3] += w * hi.y;
            }
    }
}
__device__ __forceinline__ void phase_experts(const Params& P) {
    const int lane = threadIdx.x & 63, wave = threadIdx.x >> 6;
    const float* x1f = (const float*)(P.ws + WS_X1F);
    const int* EIDX = (const int*)(P.ws + WS_EIDX); const float* GW = (const float*)(P.ws + WS_GW);
    const __amdgpu_buffer_rsrc_t UQ = __builtin_amdgcn_make_buffer_rsrc((void*)(P.ws + WS_UB), 0, NEXP * D, 0x00020000);
    const __amdgpu_buffer_rsrc_t VQ = __builtin_amdgcn_make_buffer_rsrc((void*)(P.ws + WS_VB), 0, NEXP * D, 0x00020000);
    const float* SU = (const float*)(P.ws + WS_SU); const float* SV = (const float*)(P.ws + WS_SV); const float* SX = (const float*)(P.ws + WS_SX);
    for (int row = blockIdx.x * 8 + wave; row < NTOK; row += gridDim.x * 8) {
        u32x4 xq[2];
        xq[0] = *(const u32x4*)(P.ws + WS_X1Q + (size_t)row * D + lane * 16); xq[1] = *(const u32x4*)(P.ws + WS_X1Q + (size_t)row * D + 1024 + lane * 16);
        const float sx = SX[row];
        const int e_lo = EIDX[(size_t)row * 128 + lane], e_hi = EIDX[(size_t)row * 128 + 64 + lane];
        const float g_lo = GW[(size_t)row * 128 + lane], g_hi = GW[(size_t)row * 128 + 64 + lane];
        const float a_lo = SU[e_lo] * sx, a_hi = SU[e_hi] * sx, b_lo = g_lo * SV[e_lo], b_hi = g_hi * SV[e_hi];
        float acc[32];
#pragma unroll
        for (int i = 0; i < 32; ++i) acc[i] = 0.f;
        ExpGrp GA, GB;
        exp_load(GA, UQ, VQ, e_lo, e_hi, 0, lane);
#pragma unroll 1
        for (int grp = 0; grp < 32; grp += 2) {
            exp_load(GB, UQ, VQ, e_lo, e_hi, grp + 1, lane);
            exp_consume(GA, xq, acc, a_lo, a_hi, b_lo, b_hi, grp, lane);
            exp_load(GA, UQ, VQ, e_lo, e_hi, grp + 2 < 32 ? grp + 2 : 0, lane);
            exp_consume(GB, xq, acc, a_lo, a_hi, b_lo, b_hi, grp + 1, lane);
        }
        float s = 0.f;
#pragma unroll
        for (int jj = 0; jj < 2; ++jj)
#pragma unroll
            for (int i = 0; i < 4; ++i) { const float4 xv = *(const float4*)(x1f + (size_t)row * D + jj * 1024 + lane * 16 + i * 4);
                acc[jj * 16 + i * 4 + 0] += ALPHA * xv.x; acc[jj * 16 + i * 4 + 1] += ALPHA * xv.y; acc[jj * 16 + i * 4 + 2] += ALPHA * xv.z; acc[jj * 16 + i * 4 + 3] += ALPHA * xv.w; }
#pragma unroll
        for (int i = 0; i < 32; ++i) s += acc[i];
        const float mean = wave_sum(s) * (1.0f / D); float q = 0.f;
#pragma unroll
        for (int i = 0; i < 32; ++i) { const float dd = acc[i] - mean; q += dd * dd; }
        const float rstd = rsqrtf(wave_sum(q) * (1.0f / D) + LN_EPS);
        float* yo = P.out + (row < NTOK_P ? O_YP + (size_t)row * D : O_YS + (size_t)(row - NTOK_P) * D);
        int lo16 = lane * 16; asm volatile("" : "+v"(lo16));
#pragma unroll
        for (int jj = 0; jj < 2; ++jj)
#pragma unroll
            for (int i = 0; i < 4; ++i) {
                const int col = jj * 1024 + lo16 + i * 4;
                const float4 g0 = *(const float4*)(P.ln2_g + col), b0 = *(const float4*)(P.ln2_b + col);
                float4 o;
                o.x = (acc[jj * 16 + i * 4 + 0] - mean) * rstd * g0.x + b0.x; o.y = (acc[jj * 16 + i * 4 + 1] - mean) * rstd * g0.y + b0.y;
                o.z = (acc[jj * 16 + i * 4 + 2] - mean) * rstd * g0.z + b0.z; o.w = (acc[jj * 16 + i * 4 + 3] - mean) * rstd * g0.w + b0.w;
                *(float4*)(yo + col) = o;
            }
    }
}

constexpr int NPHASE = 9;
__global__ void __launch_bounds__(NTHREADS, 2) fwd(Params P) {
    extern __shared__ __attribute__((aligned(16))) unsigned char lds_raw[];
    LAS unsigned char* lds = (LAS unsigned char*)lds_raw;
    volatile LAS unsigned* misc = (volatile LAS unsigned*)(lds + MISC_OFF);
    const int lo = P.ph_lo, hi = P.ph_hi;
    XcdBarrier bar; bar.bar = (unsigned*)(P.ws + WS_CTL); bar.x = 0; bar.st = nullptr;
    if (hi - lo > 1) {
        if (threadIdx.x == 0) { misc[0] = 0u; misc[1] = 0u; misc[2] = 0u; misc[3] = 0u; }
        __syncthreads();
        bar = xcd_barrier_post((unsigned*)(P.ws + WS_CTL), misc);
    }
#ifndef MK_PHASE_MASK
#define MK_PHASE_MASK 0x1ff
#endif
#define IN(k) (((MK_PHASE_MASK >> (k)) & 1) && lo <= (k) && (k) < hi)
#define SEAM(k) do { if (IN(k) && IN((k) + 1)) xcd_barrier(bar); } while (0)
    if (IN(0)) { phase_prologue(P, lds); }
    SEAM(0);
    if (IN(1)) {
        pg8::Gemm g{(const pg8::bf16_t*)(P.ws + WS_XB), (const pg8::bf16_t*)(P.ws + WS_WINT), NTOK, DIN, D};
        pg8::StaticOrder S; S.init(NTOK, DIN, (int)gridDim.x, (int)blockIdx.x);
        EpiProj E{P.out, (float*)(P.ws + WS_QF), (float*)(P.ws + WS_XR), (float*)(P.ws + WS_GATE), (bf16_t*)(P.ws + WS_QB), (bf16_t*)(P.ws + WS_KB), (bf16_t*)(P.ws + WS_VB16)};
        pg8::gemm_phase<EpiProj, pg8::StaticOrder, false>(lds, g, S, E, nullptr);
    }
    SEAM(1);
    if (IN(2)) { phase_mix_a(P, lds); }
    SEAM(2);
    if (IN(3)) { phase_mix_b(P, lds); }
    SEAM(3);
    if (IN(4)) {
        pg8::Gemm g{(const pg8::bf16_t*)(P.ws + WS_AR), (const pg8::bf16_t*)(P.ws + WS_WOT), NTOK, D, D};
        pg8::StaticOrder S; S.init(NTOK, D, (int)gridDim.x, (int)blockIdx.x);
        EpiOut E{P.x_prompt, P.x_sample, (float*)(P.ws + WS_PRE1)};
        pg8::gemm_phase<EpiOut, pg8::StaticOrder, false>(lds, g, S, E, nullptr);
    }
    SEAM(4);
    if (IN(5)) { phase_ln1(P); }
    SEAM(5);
    if (IN(6)) {
        pg8::Gemm g{(const pg8::bf16_t*)(P.ws + WS_X1B), (const pg8::bf16_t*)(P.ws + WS_WQT), NTOK, D, D};
        pg8::StaticOrder S; S.init(NTOK, D, (int)gridDim.x, (int)blockIdx.x);
        EpiBf16Plain E{(bf16_t*)(P.ws + WS_QP), D};
        pg8::gemm_phase<EpiBf16Plain, pg8::StaticOrder, false>(lds, g, S, E, nullptr);
    }
    SEAM(6);
    if (IN(7)) { phase_route(P, lds); }
    SEAM(7);
    if (IN(8)) { phase_experts(P); }
#ifdef MK_REP
    if (IN(MK_REP)) { MK_REP_CALL; }
#endif
#undef IN
#undef SEAM
}
}

#ifndef MK_N_LAUNCHES
#define MK_N_LAUNCHES 1
#endif
extern "C" void kernel_launch(void* const* d_in, const int* in_sizes, int n_in, void* d_out, int out_size, void* d_ws, size_t ws_size, hipStream_t stream) {
    using namespace mk;
    static int grid = 0;
    if (grid == 0) {
        if (n_in != 23 || (size_t)out_size != O_END || ws_size < WS_END) { fprintf(stderr, "kernel_launch: unexpected shapes: n_in %d out %d ws %zu (need %zu)\n", n_in, out_size, ws_size, (size_t)WS_END); grid = -1; return; }
        int dev = 0, cus = 0, per_cu = 0;
        if (hipGetDevice(&dev) != hipSuccess || hipDeviceGetAttribute(&cus, hipDeviceAttributeMultiprocessorCount, dev) != hipSuccess) { grid = -1; return; }
        if (hipFuncSetAttribute((const void*)fwd, hipFuncAttributeMaxDynamicSharedMemorySize, LDS_BYTES) != hipSuccess) { fprintf(stderr, "kernel_launch: hipFuncSetAttribute failed\n"); grid = -1; return; }
        if (hipOccupancyMaxActiveBlocksPerMultiprocessor(&per_cu, (const void*)fwd, NTHREADS, LDS_BYTES) != hipSuccess || per_cu < 1) { fprintf(stderr, "kernel_launch: occupancy query says %d\n", per_cu); }
        (void)hipGetLastError();
        grid = cus;
    }
    if (grid < 0) return;
    (void)hipMemsetAsync((char*)d_ws + WS_CTL, 0, 65536, stream);
    Params p{};
    p.x_prompt = (const float*)d_in[0]; p.x_sample = (const float*)d_in[1]; p.cache_k = (const float*)d_in[2]; p.cache_v = (const float*)d_in[3];
    p.state_conv = (const float*)d_in[4]; p.state_h = (const float*)d_in[5]; p.w_in = (const float*)d_in[6]; p.conv_w = (const float*)d_in[7]; p.conv_b = (const float*)d_in[8];
    p.lru_w_a = (const float*)d_in[9]; p.lru_b_a = (const float*)d_in[10]; p.lru_w_x = (const float*)d_in[11]; p.lru_b_x = (const float*)d_in[12]; p.lru_lambda = (const float*)d_in[13];
    p.w_out = (const float*)d_in[14]; p.ln1_g = (const float*)d_in[15]; p.ln1_b = (const float*)d_in[16]; p.w_query = (const float*)d_in[17]; p.sub_keys = (const float*)d_in[18];
    p.peer_u = (const float*)d_in[19]; p.peer_v = (const float*)d_in[20]; p.ln2_g = (const float*)d_in[21]; p.ln2_b = (const float*)d_in[22];
    p.out = (float*)d_out; p.ws = (unsigned char*)d_ws;
#if MK_N_LAUNCHES == 1
    p.ph_lo = 0; p.ph_hi = NPHASE;
    hipLaunchKernelGGL(fwd, dim3(grid), dim3(NTHREADS), LDS_BYTES, stream, p);
#else
    for (int k = 0; k < NPHASE; ++k) { p.ph_lo = k; p.ph_hi = k + 1; hipLaunchKernelGGL(fwd, dim3(grid), dim3(NTHREADS), LDS_BYTES, stream, p); }
#endif
    const hipError_t le = hipPeekAtLastError();
    if (le != hipSuccess) fprintf(stderr, "kernel_launch: launch failed: %s\n", hipGetErrorName(le));
}
```

```cpp
#include <hip/hip_runtime.h>
#include <cstdio>
#include <cstdint>
namespace pg8 {
#define PG8_LAS __attribute__((address_space(3)))
typedef unsigned short bf16_t;
typedef short bf16x8 __attribute__((ext_vector_type(8)));
typedef float f32x4 __attribute__((ext_vector_type(4)));
typedef unsigned u32x4 __attribute__((ext_vector_type(4)));
constexpr int BM = 256, BK = 64, HALF = 128, HTB = HALF * BK * 2  , STAGE_BYTES = 8 * HTB, NXCD = 8, WGM = 8;

__host__ __device__ __forceinline__ int lds_byte(int r, int c) { const int st = (r >> 4) * 2 + (c >> 5), rr = r & 15, cc = c & 31, ob = rr * 64 + cc * 2; return st * 1024 + (ob ^ (((ob >> 9) & 1) << 5)); }
__host__ __device__ __forceinline__ void stage_rc(int b, int& R, int& C) { const int st = b / 1024, sb = b % 1024, swz = sb ^ (((sb >> 9) & 1) << 5); R = (st >> 1) * 16 + swz / 64; C = (st & 1) * 32 + (swz % 64) / 2; }
__host__ __device__ __forceinline__ int perm32(int rho) { const int n = rho >> 4, i = rho & 15; return 8 * (i >> 2) + 4 * n + (i & 3); }

struct Unit { int pm, pn; };
struct Gemm { const bf16_t* A; const bf16_t* Bt; int M, N, K; };

struct StaticOrder {
    int nM, nN, nwg, G, c;
    __host__ __device__ void init(int M, int N, int G_, int c_) { nM = M / BM; nN = N / BM; nwg = nM * nN; G = G_; c = c_; }
    __host__ __device__ bool next(int i, Unit& u) const {
        const long L = (long)i * G + c; if (L >= nwg) return false;
        int wgid = (int)L; { const int q = nwg / NXCD, r = nwg % NXCD, xcd = wgid % NXCD, off = wgid / NXCD; wgid = (xcd < r ? xcd * (q + 1) : r * (q + 1) + (xcd - r) * q) + off; }
        const int nig = WGM * nN, gid = wgid / nig, fm = gid * WGM, gsz = (nM - fm) < WGM ? (nM - fm) : WGM;
        u.pm = fm + ((wgid % nig) % gsz); u.pn = (wgid % nig) / gsz; return true;
    }
    __device__ __forceinline__ void a_ready(const Unit&) const {}
    __device__ __forceinline__ void done(const Unit&) const {}
};
struct CountedOrder : StaticOrder {
    const unsigned* ready; unsigned need; unsigned* tmo;
    __device__ __forceinline__ void a_ready(const Unit& u) const {
        if (threadIdx.x < 64) {
            const unsigned long long t0 = __builtin_amdgcn_s_memrealtime(); unsigned polls = 0;
            while ((unsigned)__builtin_amdgcn_readfirstlane(__hip_atomic_load(ready + 64 * u.pm, __ATOMIC_RELAXED, __HIP_MEMORY_SCOPE_AGENT)) < need) {
                if ((++polls & 255u) == 0u && __builtin_amdgcn_readfirstlane(__hip_atomic_load(tmo, __ATOMIC_RELAXED, __HIP_MEMORY_SCOPE_AGENT)) != 0u) break;
                if (__builtin_amdgcn_s_memrealtime() - t0 > 2000000ull) {
                    if (threadIdx.x == 0) { unsigned expect = 0u; __hip_atomic_compare_exchange_strong(tmo + 1, &expect, 0x600u | (unsigned)(u.pm & 0xff), __ATOMIC_RELAXED, __ATOMIC_RELAXED, __HIP_MEMORY_SCOPE_AGENT); __hip_atomic_store(tmo, 1u, __ATOMIC_RELAXED, __HIP_MEMORY_SCOPE_AGENT); }
                    break; }
                __builtin_amdgcn_s_sleep(2); }
            __builtin_amdgcn_fence(__ATOMIC_ACQUIRE, "agent");
            asm volatile("s_waitcnt vmcnt(0)" ::: "memory");
        }
#if !defined(BROKEN_HOOK_NO_BARRIER)
        asm volatile("" ::: "memory"); __builtin_amdgcn_s_barrier(); asm volatile("" ::: "memory");
#endif
    }
};

__device__ __forceinline__ unsigned cvt_pk_bf16(float lo, float hi) { unsigned r; asm volatile("v_cvt_pk_bf16_f32 %0, %1, %2" : "=v"(r) : "v"(lo), "v"(hi)); return r; }
typedef float f32x2 __attribute__((ext_vector_type(2)));
__device__ __forceinline__ f32x2 gelu_pk(f32x2 v) {
    const f32x2 av = __builtin_elementwise_abs(v), d = av * 0.2316418882f + 1.0f;
    f32x2 t; t.x = __builtin_amdgcn_rcpf(d.x); t.y = __builtin_amdgcn_rcpf(d.y);
    f32x2 q = t * 0.5307027145f + (-0.7265760135f); q = q * t + 0.7107068705f; q = q * t + (-0.142248368f); q = q * t + 0.127414796f; q = q * t;
    const f32x2 s = (v * v) * (-0.72134752044f);
    f32x2 e; e.x = __builtin_amdgcn_exp2f(s.x); e.y = __builtin_amdgcn_exp2f(s.y);
    const f32x2 m = v * (q * e), r = v - m;
    f32x2 o; o.x = v.x < 0.f ? m.x : r.x; o.y = v.y < 0.f ? m.y : r.y; return o;
}

struct EpiF32 {
    static constexpr bool PERM = false, AFTER_DRAIN = false;
    float* C; int ldc; const float* bias;
    __device__ __forceinline__ void operator()(const f32x4 (&acc)[2][2][4][2], const Unit& u, int wr, int wc, int fr, int fq) const {
        const int row0 = u.pm * BM + wr * 64 + fr, col0 = u.pn * BM + wc * 32 + 4 * fq;
        f32x4 bv[2][2];
#pragma unroll
        for (int bj = 0; bj < 2; ++bj)
#pragma unroll
            for (int n = 0; n < 2; ++n) bv[bj][n] = bias ? *(const f32x4*)(bias + col0 + bj * HALF + n * 16) : (f32x4){0.f, 0.f, 0.f, 0.f};
#pragma unroll
        for (int ai = 0; ai < 2; ++ai)
#pragma unroll
            for (int m = 0; m < 4; ++m) { float* rowp = C + (size_t)(row0 + ai * HALF + m * 16) * ldc + col0;
#pragma unroll
                for (int bj = 0; bj < 2; ++bj)
#pragma unroll
                    for (int n = 0; n < 2; ++n) *(f32x4*)(rowp + bj * HALF + n * 16) = acc[ai][bj][m][n] + bv[bj][n]; }
    }
};
template <int ACT  > struct EpiBf16 {
    static constexpr bool PERM = true, AFTER_DRAIN = false;
    bf16_t* O; int ldc; const float* bias; int split_cols; size_t split_stride;
    __device__ __forceinline__ void operator()(const f32x4 (&acc)[2][2][4][2], const Unit& u, int wr, int wc, int fr, int fq) const {
        const int row0 = u.pm * BM + wr * 64 + fr; int colt = u.pn * BM; bf16_t* base = O;
        if (split_cols) { const int t = colt / split_cols; base += (size_t)t * split_stride; colt -= t * split_cols; }
        const int col0 = colt + wc * 32 + 8 * fq, bcol0 = u.pn * BM + wc * 32 + 8 * fq;
        f32x4 bv[2][2];
#pragma unroll
        for (int bj = 0; bj < 2; ++bj)
#pragma unroll
            for (int n = 0; n < 2; ++n) bv[bj][n] = bias ? *(const f32x4*)(bias + bcol0 + bj * HALF + 4 * n) : (f32x4){0.f, 0.f, 0.f, 0.f};
#pragma unroll
        for (int ai = 0; ai < 2; ++ai)
#pragma unroll
            for (int m = 0; m < 4; ++m) { bf16_t* rowp = base + (size_t)(row0 + ai * HALF + m * 16) * ldc + col0;
#pragma unroll
                for (int bj = 0; bj < 2; ++bj) { f32x4 v0 = acc[ai][bj][m][0] + bv[bj][0], v1 = acc[ai][bj][m][1] + bv[bj][1];
                    if (ACT == 1) { f32x2 a = gelu_pk((f32x2){v0[0], v0[1]}), b = gelu_pk((f32x2){v0[2], v0[3]}), c = gelu_pk((f32x2){v1[0], v1[1]}), d = gelu_pk((f32x2){v1[2], v1[3]});
                        v0 = (f32x4){a.x, a.y, b.x, b.y}; v1 = (f32x4){c.x, c.y, d.x, d.y}; }
                    if (ACT == 2) {
#pragma unroll
                        for (int j = 0; j < 4; ++j) { v0[j] = 0.5f * v0[j] * (1.0f + erff(v0[j] * 0.70710678f)); v1[j] = 0.5f * v1[j] * (1.0f + erff(v1[j] * 0.70710678f)); } }
                    u32x4 w; w.x = cvt_pk_bf16(v0[0], v0[1]); w.y = cvt_pk_bf16(v0[2], v0[3]); w.z = cvt_pk_bf16(v1[0], v1[1]); w.w = cvt_pk_bf16(v1[2], v1[3]);
                    *(u32x4*)(rowp + bj * HALF) = w; } }
    }
};

struct PanelStats {
    unsigned* xbuf;
    unsigned* cnt;
    unsigned* tmo;
    int ntn; float eps;
    unsigned code;
    __device__ __forceinline__ bool run(const f32x4 (&v)[2][2][4][2], const Unit& u, int wr, int wc, int fr, int fq, PG8_LAS unsigned char* lds, int wid, int lane) const {
        typedef float f32x2v __attribute__((ext_vector_type(2)));
        PG8_LAS f32x2v* P = (PG8_LAS f32x2v*)lds;
        PG8_LAS f32x2v* S = (PG8_LAS f32x2v*)(lds + 8192);
        PG8_LAS unsigned* flag = (PG8_LAS unsigned*)(lds + 8192 + 2048);
#pragma unroll
        for (int ai = 0; ai < 2; ++ai)
#pragma unroll
            for (int m = 0; m < 4; ++m) {
                float s = 0.f;
#pragma unroll
                for (int bj = 0; bj < 2; ++bj)
#pragma unroll
                    for (int n = 0; n < 2; ++n) { const f32x4 x = v[ai][bj][m][n]; s += (x[0] + x[1]) + (x[2] + x[3]); }
                s += __shfl_xor(s, 16); s += __shfl_xor(s, 32);
                const float mw = s * (1.0f / 64.0f); float q = 0.f;
#pragma unroll
                for (int bj = 0; bj < 2; ++bj)
#pragma unroll
                    for (int n = 0; n < 2; ++n) { const f32x4 d = v[ai][bj][m][n] - mw; q += (d[0] * d[0] + d[1] * d[1]) + (d[2] * d[2] + d[3] * d[3]); }
                q += __shfl_xor(q, 16); q += __shfl_xor(q, 32);
                if (fq == 0) P[(ai * HALF + wr * 64 + m * 16 + fr) * 4 + wc] = (f32x2v){mw, q};
            }
        asm volatile("s_waitcnt lgkmcnt(0)" ::: "memory"); __builtin_amdgcn_s_barrier(); asm volatile("" ::: "memory");
#if defined(BROKEN_NO_WAIT)
        if (blockIdx.x >= 64) { const long long t0 = clock64(); while (clock64() - t0 < 60000) __builtin_amdgcn_s_sleep(8); }
#endif
        const int row = wid * 32 + (lane & 31);
        if (lane < 32) {
            const f32x2v a = P[row * 4 + 0], b = P[row * 4 + 1], c = P[row * 4 + 2], d = P[row * 4 + 3];
            const float mt = (a.x + b.x + c.x + d.x) * 0.25f;
            const float da = a.x - mt, db = b.x - mt, dc = c.x - mt, dd = d.x - mt;
            const float m2 = (a.y + b.y) + (c.y + d.y) + 64.0f * ((da * da + db * db) + (dc * dc + dd * dd));
            unsigned long long* slot = (unsigned long long*)xbuf + ((size_t)(u.pm * BM + row) * 4 + u.pn);
            __hip_atomic_store(slot, ((unsigned long long)__float_as_uint(m2) << 32) | __float_as_uint(mt), __ATOMIC_RELAXED, __HIP_MEMORY_SCOPE_AGENT);
        }
        asm volatile("s_waitcnt vmcnt(0)" ::: "memory");
        if (lane == 0) __hip_atomic_fetch_add(cnt + 64 * u.pm, 1u, __ATOMIC_RELAXED, __HIP_MEMORY_SCOPE_AGENT);
        if (wid == 0) {
            bool dead = false; const unsigned long long t0 = __builtin_amdgcn_s_memrealtime(); const unsigned want = 8u * (unsigned)ntn;
            for (;;) {
#if defined(BROKEN_NO_WAIT)
                break;
#endif
                if ((unsigned)__builtin_amdgcn_readfirstlane(__hip_atomic_load(cnt + 64 * u.pm, __ATOMIC_RELAXED, __HIP_MEMORY_SCOPE_AGENT)) >= want) break;
                if (__builtin_amdgcn_s_memrealtime() - t0 > 2000000ull) {
                    if (lane == 0) { unsigned expect = 0u; __hip_atomic_compare_exchange_strong(tmo + 1, &expect, code | (unsigned)(u.pm & 0xff), __ATOMIC_RELAXED, __ATOMIC_RELAXED, __HIP_MEMORY_SCOPE_AGENT);
                                     __hip_atomic_store(tmo, 1u, __ATOMIC_RELAXED, __HIP_MEMORY_SCOPE_AGENT); }
                    dead = true; break; }
                __builtin_amdgcn_s_sleep(2);
            }
            __builtin_amdgcn_fence(__ATOMIC_ACQUIRE, "agent");
            if (lane == 0) flag[0] = dead ? 1u : 0u;
        }
        asm volatile("s_waitcnt vmcnt(0) lgkmcnt(0)" ::: "memory"); __builtin_amdgcn_s_barrier(); asm volatile("" ::: "memory");
        const bool bad = flag[0] != 0u;
        if (lane < 32) {
            const unsigned long long* slot = (const unsigned long long*)xbuf + (size_t)(u.pm * BM + row) * 4; float mt[4], m2[4]; float ms = 0.f;
#pragma unroll
            for (int t = 0; t < 4; ++t) { if (t < ntn) { const unsigned long long w = __hip_atomic_load(slot + t, __ATOMIC_RELAXED, __HIP_MEMORY_SCOPE_AGENT); mt[t] = __uint_as_float((unsigned)w); m2[t] = __uint_as_float((unsigned)(w >> 32)); } else { mt[t] = 0.f; m2[t] = 0.f; } ms += mt[t]; }
            const float mean = ms / (float)ntn; float q = 0.f;
#pragma unroll
            for (int t = 0; t < 4; ++t) if (t < ntn) { const float dm = mt[t] - mean; q += m2[t] + 256.0f * dm * dm; }
            S[row] = (f32x2v){mean, 1.0f / sqrtf(q / (256.0f * (float)ntn) + eps)};
        }
        asm volatile("s_waitcnt lgkmcnt(0)" ::: "memory"); __builtin_amdgcn_s_barrier(); asm volatile("" ::: "memory");
        return bad;
    }
};
struct EpiLnRes {
    static constexpr bool PERM = false, AFTER_DRAIN = true;
    const float* base; float* out; int ldc; const float* bias; PanelStats st; unsigned poison;
    __device__ __forceinline__ void refuse(size_t i0, size_t stride, int M, int N) const { const float q = __builtin_nanf(""); for (size_t i = i0; i < (size_t)M * N; i += stride) out[(i / N) * ldc + i % N] = q;
        if (i0 == 0) { unsigned expect = 0u; __hip_atomic_compare_exchange_strong(st.tmo + 1, &expect, 0x7f0u, __ATOMIC_RELAXED, __ATOMIC_RELAXED, __HIP_MEMORY_SCOPE_AGENT); __hip_atomic_store(st.tmo, 1u, __ATOMIC_RELAXED, __HIP_MEMORY_SCOPE_AGENT); } }
    __device__ __forceinline__ void fused(f32x4 (&acc)[2][2][4][2], const Unit& u, int wr, int wc, int fr, int fq, PG8_LAS unsigned char* lds, int wid, int lane) const {
        typedef float f32x2v __attribute__((ext_vector_type(2)));
        const PG8_LAS f32x2v* S = (const PG8_LAS f32x2v*)(lds + 8192);
        const int col0 = u.pn * BM + wc * 32 + 4 * fq;
#pragma unroll
        for (int bj = 0; bj < 2; ++bj)
#pragma unroll
            for (int n = 0; n < 2; ++n) { const f32x4 bv = bias ? *(const f32x4*)(bias + col0 + bj * HALF + n * 16) : (f32x4){0.f, 0.f, 0.f, 0.f};
#pragma unroll
                for (int ai = 0; ai < 2; ++ai)
#pragma unroll
                    for (int m = 0; m < 4; ++m) acc[ai][bj][m][n] += bv; }
        const bool bad = st.run(acc, u, wr, wc, fr, fq, lds, wid, lane) || poison != 0u;
        const float qnan = __builtin_nanf("");
#pragma unroll
        for (int ai = 0; ai < 2; ++ai)
#pragma unroll
            for (int m = 0; m < 4; ++m) { const int r = ai * HALF + wr * 64 + m * 16 + fr; const f32x2v sr = S[r]; const size_t off = (size_t)(u.pm * BM + r) * ldc + col0;
#pragma unroll
                for (int bj = 0; bj < 2; ++bj)
#pragma unroll
                    for (int n = 0; n < 2; ++n) { const f32x4 bs = *(const f32x4*)(base + off + bj * HALF + n * 16); f32x4 o = bs + (acc[ai][bj][m][n] - sr.x) * sr.y;
                        if (bad) o = (f32x4){qnan, qnan, qnan, qnan}; *(f32x4*)(out + off + bj * HALF + n * 16) = o; }
                asm volatile("" ::: "memory"); }
    }
};
struct EpiLnResLn {
    static constexpr bool PERM = false, AFTER_DRAIN = true;
    const float* base; float* out; bf16_t* xn; int ldc; const float* bias; PanelStats st1, st2; unsigned poison;
    __device__ __forceinline__ void refuse(size_t i0, size_t stride, int M, int N) const { const float q = __builtin_nanf(""); for (size_t i = i0; i < (size_t)M * N; i += stride) { const size_t o = (i / N) * ldc + i % N; out[o] = q; xn[o] = (bf16_t)0x7fc0u; }
        if (i0 == 0) { unsigned expect = 0u; __hip_atomic_compare_exchange_strong(st1.tmo + 1, &expect, 0x7f0u, __ATOMIC_RELAXED, __ATOMIC_RELAXED, __HIP_MEMORY_SCOPE_AGENT); __hip_atomic_store(st1.tmo, 1u, __ATOMIC_RELAXED, __HIP_MEMORY_SCOPE_AGENT); } }
    __device__ __forceinline__ void fused(f32x4 (&acc)[2][2][4][2], const Unit& u, int wr, int wc, int fr, int fq, PG8_LAS unsigned char* lds, int wid, int lane) const {
        typedef float f32x2v __attribute__((ext_vector_type(2))); typedef unsigned u32x2v __attribute__((ext_vector_type(2)));
        const PG8_LAS f32x2v* S = (const PG8_LAS f32x2v*)(lds + 8192);
        const int col0 = u.pn * BM + wc * 32 + 4 * fq;
#pragma unroll
        for (int bj = 0; bj < 2; ++bj)
#pragma unroll
            for (int n = 0; n < 2; ++n) { const f32x4 bv = bias ? *(const f32x4*)(bias + col0 + bj * HALF + n * 16) : (f32x4){0.f, 0.f, 0.f, 0.f};
#pragma unroll
                for (int ai = 0; ai < 2; ++ai)
#pragma unroll
                    for (int m = 0; m < 4; ++m) acc[ai][bj][m][n] += bv; }
        bool bad = st1.run(acc, u, wr, wc, fr, fq, lds, wid, lane) || poison != 0u;
        const float qnan = __builtin_nanf("");
#pragma unroll
        for (int ai = 0; ai < 2; ++ai)
#pragma unroll
            for (int m = 0; m < 4; ++m) { const int r = ai * HALF + wr * 64 + m * 16 + fr; const f32x2v sr = S[r]; const size_t off = (size_t)(u.pm * BM + r) * ldc + col0;
#pragma unroll
                for (int bj = 0; bj < 2; ++bj)
#pragma unroll
                    for (int n = 0; n < 2; ++n) { const f32x4 bs = *(const f32x4*)(base + off + bj * HALF + n * 16); acc[ai][bj][m][n] = bs + (acc[ai][bj][m][n] - sr.x) * sr.y; }
                asm volatile("" : "+v"(acc[ai][0][m][0]), "+v"(acc[ai][0][m][1]), "+v"(acc[ai][1][m][0]), "+v"(acc[ai][1][m][1]));
                if (m & 1) asm volatile("" ::: "memory"); }
        const bool bad1 = bad;
        bad = st2.run(acc, u, wr, wc, fr, fq, lds, wid, lane) || bad;
#pragma unroll
        for (int ai = 0; ai < 2; ++ai)
#pragma unroll
            for (int m = 0; m < 4; ++m) { const int r = ai * HALF + wr * 64 + m * 16 + fr; const f32x2v sr = S[r]; const size_t off = (size_t)(u.pm * BM + r) * ldc + col0;
#pragma unroll
                for (int bj = 0; bj < 2; ++bj)
#pragma unroll
                    for (int n = 0; n < 2; ++n) { const f32x4 x1 = acc[ai][bj][m][n]; *(f32x4*)(out + off + bj * HALF + n * 16) = bad1 ? (f32x4){qnan, qnan, qnan, qnan} : x1;
                        const f32x4 o = (x1 - sr.x) * sr.y; u32x2v w; w.x = cvt_pk_bf16(o[0], o[1]); w.y = cvt_pk_bf16(o[2], o[3]);
                        if (bad) { w.x = 0x7fc07fc0u; w.y = 0x7fc07fc0u; } *(u32x2v*)(xn + off + bj * HALF + n * 16) = w; }
                asm volatile("" ::: "memory"); }
    }
};

template <class Epi, class Sched, bool STAMP = false>
__device__ __forceinline__ void gemm_phase(PG8_LAS unsigned char* lds, const Gemm g, const Sched& S, const Epi& E, unsigned long long* stamps) {
    const int tid = threadIdx.x, wid = __builtin_amdgcn_readfirstlane(tid >> 6), lane = tid & 63, wr = wid >> 2, wc = wid & 3, fr = lane & 15, fq = lane >> 4;
    const int K = g.K, nt = K / BK;
    int ts_lo = 0, ts_hi = 0, nts = 0; const unsigned long long rt_entry = STAMP ? (unsigned long long)wall_clock64() : 0ull;
#define PG8_STAMP() do { if (STAMP && wid == 0 && nts < 64) { const unsigned long long _c = (unsigned long long)clock64(); \
        ts_lo = (lane == nts) ? (int)(unsigned)_c : ts_lo; ts_hi = (lane == nts) ? (int)(unsigned)(_c >> 32) : ts_hi; ++nts; } } while (0)
    PG8_STAMP();
    unsigned voffA[2], voffB[2];
#pragma unroll
    for (int i = 0; i < 2; ++i) { int R, C; stage_rc(tid * 16 + i * 8192, R, C); const int Rb = Epi::PERM ? ((R & ~31) + perm32(R & 31)) : R;
        voffA[i] = (unsigned)(R * K + C) * 2u; voffB[i] = (unsigned)(Rb * K + C) * 2u; }
    const size_t kstep = (size_t)(BK * 2);
    const size_t hstep = (size_t)HALF * K * 2;
    const size_t tstep = 2 * hstep;
    const unsigned ldsw = (unsigned)wid * 1024u;
    const int aoff = lds_byte(wr * 64 + fr, fq * 8), boff = lds_byte(wc * 32 + fr, fq * 8);
#define PG8_SA(b, h) (((b) * 2 + (h)) * HTB)
#define PG8_SB(b, h) ((4 + (b) * 2 + (h)) * HTB)
#define PG8_STAGE(bufoff, gbase, voff) do { _Pragma("unroll") for (int _i = 0; _i < 2; ++_i) \
        __builtin_amdgcn_global_load_lds((const unsigned*)((const char*)(gbase) + (voff)[_i]), (PG8_LAS unsigned*)(lds + (bufoff) + ldsw + _i * 8192), 16, 0, 0); } while (0)
#define PG8_LDA(dst, b, h) do { _Pragma("unroll") for (int m = 0; m < 4; ++m) _Pragma("unroll") for (int k = 0; k < 2; ++k) dst[m][k] = *(const PG8_LAS bf16x8*)(lds + PG8_SA(b, h) + aoff + m * 2048 + k * 1024); } while (0)
#define PG8_LDB(dst, b, h) do { _Pragma("unroll") for (int n = 0; n < 2; ++n) _Pragma("unroll") for (int k = 0; k < 2; ++k) dst[n][k] = *(const PG8_LAS bf16x8*)(lds + PG8_SB(b, h) + boff + n * 2048 + k * 1024); } while (0)
#define PG8_MMA(ai, bj, At, Bt) do { __builtin_amdgcn_s_setprio(1); _Pragma("unroll") for (int m = 0; m < 4; ++m) _Pragma("unroll") for (int n = 0; n < 2; ++n) _Pragma("unroll") for (int k = 0; k < 2; ++k) \
        acc[ai][bj][m][n] = __builtin_amdgcn_mfma_f32_16x16x32_bf16(Bt[n][k], At[m][k], acc[ai][bj][m][n], 0, 0, 0); __builtin_amdgcn_s_setprio(0); } while (0)
#define PG8_WAIT_V(n) asm volatile("s_waitcnt vmcnt(" #n ")" ::: "memory")
#define PG8_WAIT_L(n) asm volatile("s_waitcnt lgkmcnt(" #n ")" ::: "memory")
#define PG8_BAR __builtin_amdgcn_s_barrier()
#define PG8_SCHED __builtin_amdgcn_sched_barrier(0)
    Unit cur, nxt; int ui = 0;
    if (!S.next(0, cur)) return;
    f32x4 acc[2][2][4][2];
#pragma unroll
    for (int a = 0; a < 2; ++a)
#pragma unroll
        for (int b = 0; b < 2; ++b)
#pragma unroll
            for (int m = 0; m < 4; ++m)
#pragma unroll
                for (int n = 0; n < 2; ++n) acc[a][b][m][n] = (f32x4){0.f, 0.f, 0.f, 0.f};
    bf16x8 At[4][2], B0[2][2], B1[2][2];
    const char* cA = (const char*)g.A + (size_t)cur.pm * tstep; const char* cB = (const char*)g.Bt + (size_t)cur.pn * tstep;
    S.a_ready(cur);
    PG8_STAGE(PG8_SB(0, 0), cB, voffB); PG8_STAGE(PG8_SA(0, 0), cA, voffA); PG8_STAGE(PG8_SB(0, 1), cB + hstep, voffB); PG8_STAGE(PG8_SA(0, 1), cA + hstep, voffA);
    if (wr == 1) PG8_BAR;
    PG8_WAIT_V(4); PG8_BAR;
    PG8_STAGE(PG8_SB(1, 0), cB + kstep, voffB); PG8_STAGE(PG8_SA(1, 0), cA + kstep, voffA); PG8_STAGE(PG8_SB(1, 1), cB + hstep + kstep, voffB);
    PG8_WAIT_V(6); PG8_BAR;
    PG8_STAMP();
    for (;;) {
        const bool has_next = S.next(ui + 1, nxt);
        const char* nA = has_next ? (const char*)g.A + (size_t)nxt.pm * tstep : cA; const char* nB = has_next ? (const char*)g.Bt + (size_t)nxt.pn * tstep : cB;
        for (int t = 0; t < nt; t += 2) {
            const bool last = (t == nt - 2);
            const char* a1 = cA + (size_t)(t + 1) * kstep;
            const char* a2 = last ? nA : cA + (size_t)(t + 2) * kstep; const char* b2 = last ? nB : cB + (size_t)(t + 2) * kstep;
            const char* a3 = a2 + kstep; const char* b3 = b2 + kstep;
            if (last && has_next) S.a_ready(nxt);
            PG8_LDB(B0, 0, 0); PG8_SCHED; PG8_LDA(At, 0, 0); PG8_STAGE(PG8_SA(1, 1), a1 + hstep, voffA);
            PG8_WAIT_L(8); PG8_BAR; PG8_WAIT_L(0); PG8_MMA(0, 0, At, B0); PG8_BAR; PG8_SCHED;
            PG8_LDB(B1, 0, 1); PG8_STAGE(PG8_SB(0, 0), b2, voffB);
            PG8_BAR; PG8_WAIT_L(0); PG8_MMA(0, 1, At, B1); PG8_BAR;
            PG8_LDA(At, 0, 1); PG8_STAGE(PG8_SA(0, 0), a2, voffA);
            PG8_BAR; PG8_WAIT_L(0); PG8_MMA(1, 0, At, B0); PG8_BAR; PG8_SCHED;
            PG8_STAGE(PG8_SB(0, 1), b2 + hstep, voffB);
            PG8_WAIT_V(6); PG8_BAR; PG8_MMA(1, 1, At, B1); PG8_BAR;
            PG8_LDB(B0, 1, 0); PG8_SCHED; PG8_LDA(At, 1, 0); PG8_STAGE(PG8_SA(0, 1), a2 + hstep, voffA);
            PG8_WAIT_L(8); PG8_BAR; PG8_WAIT_L(0); PG8_MMA(0, 0, At, B0); PG8_BAR; PG8_SCHED;
            PG8_LDB(B1, 1, 1); PG8_STAGE(PG8_SB(1, 0), b3, voffB);
            PG8_BAR; PG8_WAIT_L(0); PG8_MMA(0, 1, At, B1); PG8_BAR;
            PG8_LDA(At, 1, 1); PG8_STAGE(PG8_SA(1, 0), a3, voffA);
            PG8_BAR; PG8_WAIT_L(0); PG8_MMA(1, 0, At, B0); PG8_BAR; PG8_SCHED;
            PG8_STAGE(PG8_SB(1, 1), b3 + hstep, voffB);
            PG8_WAIT_V(6); PG8_BAR; PG8_MMA(1, 1, At, B1); PG8_BAR;
        }
        PG8_STAMP();
        if constexpr (!Epi::AFTER_DRAIN) { E(acc, cur, wr, wc, fr, fq); S.done(cur); }
        PG8_STAMP();
        if (!has_next) break;
#pragma unroll
        for (int a = 0; a < 2; ++a)
#pragma unroll
            for (int b = 0; b < 2; ++b)
#pragma unroll
                for (int m = 0; m < 4; ++m)
#pragma unroll
                    for (int n = 0; n < 2; ++n) acc[a][b][m][n] = (f32x4){0.f, 0.f, 0.f, 0.f};
        cur = nxt; cA = nA; cB = nB; ++ui;
    }
    PG8_WAIT_V(0);
    if (wr == 0) PG8_BAR;
    PG8_BAR;
    if constexpr (Epi::AFTER_DRAIN) { E.fused(acc, cur, wr, wc, fr, fq, lds, wid, lane); S.done(cur); }
    PG8_STAMP();
    if (STAMP && wid == 0) { stamps[lane] = lane < nts ? (((unsigned long long)(unsigned)ts_hi << 32) | (unsigned)ts_lo) : 0ull;
        if (lane == 62) stamps[62] = rt_entry; if (lane == 63) stamps[63] = (unsigned long long)wall_clock64(); }
#undef PG8_STAMP
#undef PG8_SA
#undef PG8_SB
#undef PG8_STAGE
#undef PG8_LDA
#undef PG8_LDB
#undef PG8_MMA
#undef PG8_WAIT_V
#undef PG8_WAIT_L
#undef PG8_BAR
#undef PG8_SCHED
}
}
#define XB_TMO      128
#define XB_XCNT(j)  (256  + 64 * (j))
#define XB_XSUB(j)  (1280 + 64 * (j))
#define XB_XGEN(j)  (2304 + 64 * (j))
#define XB_TOP      3328
#define XB_TOPGEN   3392
#define XCD_BAR_WORDS 3456
#define XB_SPIN_CAP (1u << 18)
#define LAS __attribute__((address_space(3)))

__device__ __forceinline__ unsigned xb_ld(unsigned* p)              { return __hip_atomic_load(p, __ATOMIC_RELAXED, __HIP_MEMORY_SCOPE_AGENT); }
__device__ __forceinline__ unsigned xb_add(unsigned* p, unsigned v) { return __hip_atomic_fetch_add(p, v, __ATOMIC_RELAXED, __HIP_MEMORY_SCOPE_AGENT); }
__device__ __forceinline__ unsigned xb_xcc_id() { return (unsigned)__builtin_amdgcn_s_getreg((3 << 11) | 20) & 0xFu; }
#define XB_SPIN(cond, bar) do { unsigned _sp = 0; while (cond) { __builtin_amdgcn_s_sleep(1); \
    if ((++_sp & 255u) == 0u) { if (xb_ld(&(bar)[XB_TMO])) break; if (_sp > XB_SPIN_CAP) { atomicAdd(&(bar)[XB_TMO], 1u); break; } } } } while (0)

struct XcdBarrier {
    unsigned* bar; unsigned x;
    volatile LAS unsigned* st;
};

__device__ __forceinline__ XcdBarrier xcd_barrier_post(unsigned* bar, volatile LAS unsigned* st) {
    XcdBarrier b; b.bar = bar; b.x = xb_xcc_id(); b.st = st;
    if (threadIdx.x == 0) (void)xb_add(&bar[XB_XCNT(b.x)], 1u);
    return b;
}
__device__ __forceinline__ void xcd_barrier_complete(unsigned* bar, unsigned x, unsigned& nloc, unsigned& nx) {
    const unsigned G = gridDim.x * gridDim.y * gridDim.z;
    unsigned sum, cnt, mine, sp = 0u;
    for (;;) {
        sum = 0u; cnt = 0u; mine = 0u;
#pragma unroll
        for (unsigned j = 0; j < 16; ++j) { const unsigned c = xb_ld(&bar[XB_XCNT(j)]); sum += c; cnt += (c > 0u) ? 1u : 0u; mine = (j == x) ? c : mine; }
        if (sum == G) break;
        __builtin_amdgcn_s_sleep(1);
        if ((++sp & 255u) == 0u) { if (xb_ld(&bar[XB_TMO])) break; if (sp > XB_SPIN_CAP) { atomicAdd(&bar[XB_TMO], 1u); break; } }
    }
    nloc = mine > 0u ? mine : 1u; nx = cnt > 0u ? cnt : 1u;
}

__device__ __forceinline__ void xcd_barrier(const XcdBarrier& b) {
    asm volatile("s_waitcnt vmcnt(0)" ::: "memory");
    __syncthreads();
    if (threadIdx.x == 0) {
        unsigned* bar = b.bar;
        __builtin_amdgcn_s_waitcnt(0);
        unsigned nloc = b.st[0], nx = b.st[1];
        if (nloc == 0u) { xcd_barrier_complete(bar, b.x, nloc, nx); b.st[0] = nloc; b.st[1] = nx; }
        const unsigned old = xb_add(&bar[XB_XSUB(b.x)], 1u);
        const unsigned gen = old / nloc;
        if (old + 1u == (gen + 1u) * nloc) {
            __builtin_amdgcn_fence(__ATOMIC_RELEASE, "agent");
            asm volatile("s_waitcnt vmcnt(0)" ::: "memory");
            const unsigned og = xb_add(&bar[XB_TOP], 1u);
            const unsigned tg = og / nx;
            if (og + 1u == (tg + 1u) * nx) xb_add(&bar[XB_TOPGEN], 1u);
            else XB_SPIN(xb_ld(&bar[XB_TOPGEN]) == tg, bar);
            __builtin_amdgcn_fence(__ATOMIC_ACQUIRE, "agent");
            xb_add(&bar[XB_XGEN(b.x)], 1u);
            asm volatile("s_waitcnt vmcnt(0)" ::: "memory");
        } else {
            XB_SPIN(xb_ld(&bar[XB_XGEN(b.x)]) == gen, bar);
            __builtin_amdgcn_fence(__ATOMIC_ACQUIRE, "agent");
            asm volatile("s_waitcnt vmcnt(0)" ::: "memory");
        }
    }
    __syncthreads();
}


namespace mk {
typedef unsigned short bf16_t;
typedef float f32x4 __attribute__((ext_vector_type(4)));
typedef short bf16x8 __attribute__((ext_vector_type(8)));
typedef short s16x4 __attribute__((ext_vector_type(4)));
typedef unsigned u32x4 __attribute__((ext_vector_type(4)));
typedef unsigned u32x2 __attribute__((ext_vector_type(2)));
typedef float f32x2 __attribute__((ext_vector_type(2)));
constexpr int D = 2048, NTOK_P = 16384, NTOK_S = 256, NTOK = 16640;
constexpr int DIN = 5632, DATT = 1536, DLRU = 512, NH = 12, HD = 128;
constexpr int NEXP = 16384;
constexpr float ALPHA = 1.189207115002721f;
constexpr float LN_EPS = 1e-5f;
constexpr float ATT_SCALE = 0.08838834764831845f;
constexpr float LOG2E = 1.4426950408889634f;
constexpr size_t O_YP = 0, O_YS = 33554432, O_KP = 34078720, O_VP = 59244544, O_CP = 84410368, O_HP = 84422656,
                 O_KS = 84426752, O_VS = 185090048, O_CS = 285753344, O_HS = 285802496, O_END = 285818880;
constexpr size_t WS_CTL = 0;
constexpr size_t WS_XB = 65536;
constexpr size_t WS_WINT = WS_XB + (size_t)NTOK * D * 2;
constexpr size_t WS_WOT = WS_WINT + (size_t)DIN * D * 2;
constexpr size_t WS_WQT = WS_WOT + (size_t)D * D * 2;
constexpr size_t WS_UB = WS_WQT + (size_t)D * D * 2;
constexpr size_t WS_VB = WS_UB + (size_t)NEXP * D * 2;
constexpr size_t WS_QF = WS_VB + (size_t)NEXP * D * 2;
constexpr size_t WS_XR = WS_QF + (size_t)NTOK * DATT * 4;
constexpr size_t WS_GATE = WS_XR + (size_t)NTOK * DLRU * 4;
constexpr size_t WS_AR = WS_GATE + (size_t)NTOK * DLRU * 4;
constexpr size_t WS_PRE1 = WS_AR + (size_t)NTOK * D * 2;
constexpr size_t WS_X1F = WS_PRE1 + (size_t)NTOK * D * 4;
constexpr size_t WS_X1B = WS_X1F + (size_t)NTOK * D * 4;
constexpr size_t WS_QP = WS_X1B + (size_t)NTOK * D * 2;
constexpr size_t WS_EIDX = WS_QP + (size_t)NTOK * D * 4;
constexpr size_t WS_GW = WS_EIDX + (size_t)NTOK * 128 * 4;
constexpr size_t WS_SU = WS_GW + (size_t)NTOK * 128 * 4;
constexpr size_t WS_SV = WS_SU + (size_t)NEXP * 4;
constexpr size_t WS_SX = WS_SV + (size_t)NEXP * 4;
constexpr size_t WS_X1Q = WS_SX + (size_t)NTOK * 4;
constexpr size_t WS_SKB = WS_X1Q + (size_t)NTOK * D;
constexpr size_t WS_QB = WS_SKB + (size_t)8 * 2 * 128 * 128 * 2;
constexpr size_t WS_KB = WS_QB + (size_t)NTOK * DATT * 2;
constexpr size_t WS_VB16 = WS_KB + (size_t)NTOK_P * DATT * 2;
constexpr size_t WS_PO = WS_VB16 + (size_t)NTOK_P * DATT * 2;
constexpr size_t WS_PM = WS_PO + (size_t)2 * NTOK_P * DATT * 2;
constexpr size_t WS_PL = WS_PM + (size_t)2 * NTOK_P * NH * 4;
constexpr size_t WS_R0 = WS_PL + (size_t)2 * NTOK_P * NH * 4;
constexpr size_t WS_R1 = WS_R0 + (size_t)NTOK_P * DLRU * 4;
constexpr size_t WS_HE = WS_R1 + (size_t)NTOK_P * DLRU * 4;
constexpr size_t WS_AE = WS_HE + (size_t)8 * 32 * 512 * 4;
constexpr size_t WS_PS = WS_AE + (size_t)8 * 32 * 512 * 4;
constexpr size_t WS_END = WS_PS + (size_t)32 * 12 * 9 * 8 * 130 * 4;

constexpr int NTHREADS = 512;
constexpr int LDS_BYTES = 148480;
constexpr int MISC_OFF = 147456;

struct Params {
    const float* x_prompt; const float* x_sample; const float* cache_k; const float* cache_v; const float* state_conv; const float* state_h;
    const float* w_in; const float* conv_w; const float* conv_b; const float* lru_w_a; const float* lru_b_a; const float* lru_w_x; const float* lru_b_x;
    const float* lru_lambda; const float* w_out; const float* ln1_g; const float* ln1_b; const float* w_query; const float* sub_keys;
    const float* peer_u; const float* peer_v; const float* ln2_g; const float* ln2_b;
    float* out; unsigned char* ws; int ph_lo, ph_hi;
};

__device__ __forceinline__ unsigned f2bf(float f) { unsigned u = __float_as_uint(f); u += 0x7fffu + ((u >> 16) & 1u); return u >> 16; }
__device__ __forceinline__ unsigned pack2(float a, float b) { return f2bf(a) | (f2bf(b) << 16); }
__device__ __forceinline__ float bflo(unsigned w) { return __uint_as_float(w << 16); }
__device__ __forceinline__ float bfhi(unsigned w) { return __uint_as_float(w & 0xffff0000u); }
__device__ __forceinline__ float wave_sum(float v) {
#pragma unroll
    for (int o = 32; o >= 1; o >>= 1) v += __shfl_xor(v, o);
    return v;
}
__device__ __forceinline__ float wave_max(float v) {
#pragma unroll
    for (int o = 32; o >= 1; o >>= 1) v = fmaxf(v, __shfl_xor(v, o));
    return v;
}
__device__ __forceinline__ float gelu_exact(float v) { return 0.5f * v * (1.0f + erff(v * 0.7071067811865476f)); }
__device__ __forceinline__ float sigmoidf(float v) { return 1.0f / (1.0f + expf(-v)); }
__device__ __forceinline__ float readlane_f(float v, int l) { return __int_as_float(__builtin_amdgcn_readlane(__float_as_int(v), l)); }

__device__ __forceinline__ void convert_flat(const float* src, bf16_t* dst, size_t n8, size_t gtid, size_t gstride) {
    for (size_t i = gtid; i < n8; i += gstride) {
        const float4 a = ((const float4*)src)[2 * i], b = ((const float4*)src)[2 * i + 1];
        uint4 w; w.x = pack2(a.x, a.y); w.y = pack2(a.z, a.w); w.z = pack2(b.x, b.y); w.w = pack2(b.z, b.w);
        ((uint4*)dst)[i] = w;
    }
}
__device__ __forceinline__ void transpose_convert(const float* src, bf16_t* dst, int K, int N, LAS float* tile) {
    const int tid = threadIdx.x, ntn = N / 64, ntiles = (K / 64) * ntn;
    for (int tl = blockIdx.x; tl < ntiles; tl += gridDim.x) {
        const int kt = tl / ntn, nt = tl - kt * ntn;
#pragma unroll
        for (int i = 0; i < 8; ++i) { const int r = (tid >> 6) + 8 * i, c = tid & 63; tile[r * 65 + c] = src[(size_t)(kt * 64 + r) * N + nt * 64 + c]; }
        __syncthreads();
#pragma unroll
        for (int i = 0; i < 4; ++i) { const int n = (tid >> 5) + 16 * i, k0 = 2 * (tid & 31);
            const unsigned v = pack2(tile[k0 * 65 + n], tile[(k0 + 1) * 65 + n]);
            *(unsigned*)(dst + (size_t)(nt * 64 + n) * K + kt * 64 + k0) = v; }
        __syncthreads();
    }
}
__device__ __forceinline__ void quant_tables(const Params& P) {
    const int lane = threadIdx.x & 63, gw = blockIdx.x * 8 + (threadIdx.x >> 6), nw = gridDim.x * 8;
    for (int it = gw; it < 2 * NEXP; it += nw) {
        const bool isv = it >= NEXP; const int row = isv ? it - NEXP : it;
        const float* src = (isv ? P.peer_v : P.peer_u) + (size_t)row * D;
        float4 v[8]; float am = 0.f;
#pragma unroll
        for (int j = 0; j < 2; ++j)
#pragma unroll
            for (int i = 0; i < 4; ++i) { const float4 t = *(const float4*)(src + j * 1024 + lane * 16 + i * 4); v[j * 4 + i] = t; am = fmaxf(am, fmaxf(fmaxf(fabsf(t.x), fabsf(t.y)), fmaxf(fabsf(t.z), fabsf(t.w)))); }
        am = wave_max(am); if (am == 0.f) am = 1.f;
        if (!isv) {
            const float inv = 127.0f / am;
            unsigned char* dst = P.ws + WS_UB + (size_t)row * D;
#pragma unroll
            for (int j = 0; j < 2; ++j) { u32x4 w;
#pragma unroll
                for (int i = 0; i < 4; ++i) { const float4 t = v[j * 4 + i];
                    const int a = (int)rintf(t.x * inv), b = (int)rintf(t.y * inv), c = (int)rintf(t.z * inv), d = (int)rintf(t.w * inv);
                    w[i] = (unsigned)(a & 255) | ((unsigned)(b & 255) << 8) | ((unsigned)(c & 255) << 16) | ((unsigned)(d & 255) << 24); }
                *(u32x4*)(dst + j * 1024 + lane * 16) = w; }
            if (lane == 0) ((float*)(P.ws + WS_SU))[row] = am * (1.0f / 127.0f);
        } else {
            const float inv = 224.0f / am;
            unsigned char* dst = P.ws + WS_VB + (size_t)row * D;
#pragma unroll
            for (int j = 0; j < 2; ++j) { u32x4 w;
#pragma unroll
                for (int i = 0; i < 4; ++i) { const float4 t = v[j * 4 + i]; int o = 0;
                    o = __builtin_amdgcn_cvt_pk_fp8_f32(t.x * inv, t.y * inv, o, false); o = __builtin_amdgcn_cvt_pk_fp8_f32(t.z * inv, t.w * inv, o, true); w[i] = (unsigned)o; }
                *(u32x4*)(dst + j * 1024 + lane * 16) = w; }
            if (lane == 0) ((float*)(P.ws + WS_SV))[row] = am * (1.0f / 224.0f);
        }
    }
}
__device__ __forceinline__ void phase_prologue(const Params& P, LAS unsigned char* lds) {
    const size_t gtid = (size_t)blockIdx.x * NTHREADS + threadIdx.x, gstride = (size_t)gridDim.x * NTHREADS;
    unsigned char* ws = P.ws;
    convert_flat(P.x_prompt, (bf16_t*)(ws + WS_XB), (size_t)NTOK_P * D / 8, gtid, gstride);
    convert_flat(P.x_sample, (bf16_t*)(ws + WS_XB) + (size_t)NTOK_P * D, (size_t)NTOK_S * D / 8, gtid, gstride);
    quant_tables(P);
    convert_flat(P.sub_keys, (bf16_t*)(ws + WS_SKB), (size_t)8 * 2 * 128 * 128 / 8, gtid, gstride);
    transpose_convert(P.w_in, (bf16_t*)(ws + WS_WINT), D, DIN, (LAS float*)lds);
    transpose_convert(P.w_out, (bf16_t*)(ws + WS_WOT), D, D, (LAS float*)lds);
    transpose_convert(P.w_query, (bf16_t*)(ws + WS_WQT), D, D, (LAS float*)lds);
}

struct EpiProj {
    static constexpr bool PERM = false, AFTER_DRAIN = false;
    float* out; float* QF; float* XR; float* GATE; bf16_t* QB; bf16_t* KB; bf16_t* VB16;
    __device__ __forceinline__ void operator()(const f32x4 (&acc)[2][2][4][2], const pg8::Unit& u, int wr, int wc, int fr, int fq) const {
        const int pn = u.pn; const int coff = wc * 32 + 4 * fq;
#pragma unroll
        for (int ai = 0; ai < 2; ++ai)
#pragma unroll
            for (int m = 0; m < 4; ++m) {
                const int row = u.pm * 256 + ai * 128 + wr * 64 + m * 16 + fr;
                const bool prompt = row < NTOK_P;
                float* rowp = nullptr; bf16_t* rowb = nullptr; float bsc = 1.0f;
                if (pn < 6) { rowb = QB + (size_t)row * DATT + pn * 256; bsc = ATT_SCALE * LOG2E; }
                else if (pn < 18) {
                    const int isv = pn >= 12; const int c0 = (pn - (isv ? 12 : 6)) * 256;
                    if (prompt) { rowp = out + (isv ? O_VP : O_KP) + (size_t)row * DATT + c0; rowb = (isv ? VB16 : KB) + (size_t)row * DATT + c0; }
                    else { const int rr = row - NTOK_P, b = rr >> 3, t = rr & 7; rowp = out + (isv ? O_VS : O_KS) + ((size_t)b * 2048 + 2040 + t) * DATT + c0; }
                } else if (pn < 20) rowp = XR + (size_t)row * DLRU + (pn - 18) * 256;
                else rowp = GATE + (size_t)row * DLRU + (pn - 20) * 256;
#pragma unroll
                for (int bj = 0; bj < 2; ++bj)
#pragma unroll
                    for (int n = 0; n < 2; ++n) {
                        const f32x4 v = acc[ai][bj][m][n];
                        if (rowp) *(f32x4*)(rowp + coff + bj * 128 + n * 16) = v;
                        if (rowb) { u32x2 w; w.x = pg8::cvt_pk_bf16(v[0] * bsc, v[1] * bsc); w.y = pg8::cvt_pk_bf16(v[2] * bsc, v[3] * bsc); *(u32x2*)(rowb + coff + bj * 128 + n * 16) = w; }
                    }
            }
    }
};
struct EpiOut {
    static constexpr bool PERM = false, AFTER_DRAIN = false;
    const float* xp; const float* xs; float* pre;
    __device__ __forceinline__ void operator()(const f32x4 (&acc)[2][2][4][2], const pg8::Unit& u, int wr, int wc, int fr, int fq) const {
        const int col0 = u.pn * 256 + wc * 32 + 4 * fq;
#pragma unroll
        for (int ai = 0; ai < 2; ++ai)
#pragma unroll
            for (int m = 0; m < 4; ++m) {
                const int row = u.pm * 256 + ai * 128 + wr * 64 + m * 16 + fr;
                const float* xr = (row < NTOK_P ? xp + (size_t)row * D : xs + (size_t)(row - NTOK_P) * D) + col0;
                float* pr = pre + (size_t)row * D + col0;
#pragma unroll
                for (int bj = 0; bj < 2; ++bj)
#pragma unroll
                    for (int n = 0; n < 2; ++n) { const f32x4 xv = *(const f32x4*)(xr + bj * 128 + n * 16); *(f32x4*)(pr + bj * 128 + n * 16) = xv * ALPHA + acc[ai][bj][m][n]; }
            }
    }
};
struct EpiPlain {
    static constexpr bool PERM = false, AFTER_DRAIN = false;
    float* C; int ldc;
    __device__ __forceinline__ void operator()(const f32x4 (&acc)[2][2][4][2], const pg8::Unit& u, int wr, int wc, int fr, int fq) const {
        const int col0 = u.pn * 256 + wc * 32 + 4 * fq;
#pragma unroll
        for (int ai = 0; ai < 2; ++ai)
#pragma unroll
            for (int m = 0; m < 4; ++m) {
                const int row = u.pm * 256 + ai * 128 + wr * 64 + m * 16 + fr;
                float* pr = C + (size_t)row * ldc + col0;
#pragma unroll
                for (int bj = 0; bj < 2; ++bj)
#pragma unroll
                    for (int n = 0; n < 2; ++n) *(f32x4*)(pr + bj * 128 + n * 16) = acc[ai][bj][m][n];
            }
    }
};

struct EpiBf16Plain {
    static constexpr bool PERM = false, AFTER_DRAIN = false;
    bf16_t* C; int ldc;
    __device__ __forceinline__ void operator()(const f32x4 (&acc)[2][2][4][2], const pg8::Unit& u, int wr, int wc, int fr, int fq) const {
        const int col0 = u.pn * 256 + wc * 32 + 4 * fq;
#pragma unroll
        for (int ai = 0; ai < 2; ++ai)
#pragma unroll
            for (int m = 0; m < 4; ++m) {
                const int row = u.pm * 256 + ai * 128 + wr * 64 + m * 16 + fr;
                bf16_t* pr = C + (size_t)row * ldc + col0;
#pragma unroll
                for (int bj = 0; bj < 2; ++bj)
#pragma unroll
                    for (int n = 0; n < 2; ++n) { const f32x4 v = acc[ai][bj][m][n]; u32x2 w; w.x = pg8::cvt_pk_bf16(v[0], v[1]); w.y = pg8::cvt_pk_bf16(v[2], v[3]); *(u32x2*)(pr + bj * 128 + n * 16) = w; }
            }
    }
};

constexpr int KVS = 288, VOFF = 73728;
template <int MODE>
__device__ __forceinline__ void attn_unit(const Params& P, int p, int b, int h, int r, int c, LAS unsigned char* lds) {
    const int tid = threadIdx.x, lane = tid & 63, w = __builtin_amdgcn_readfirstlane(tid >> 6);
    const int dil = 1 << (2 * p);
    const bf16_t* Qb = (const bf16_t*)(P.ws + WS_QB); const bf16_t* Kb = (const bf16_t*)(P.ws + WS_KB); const bf16_t* Vb = (const bf16_t*)(P.ws + WS_VB16);
    const size_t tok0 = (size_t)b * 2048;
    const int j0 = 128 * c - 128, rho0 = (c == 0) ? 128 : 0;
#pragma unroll
    for (int it = 0; it < 8; ++it) {
        const int rho = it * 32 + (tid >> 4), ch = tid & 15;
        if (rho >= rho0) {
            const size_t tok = tok0 + (size_t)((j0 + rho) * dil + r);
            const u32x4 kv = *(const u32x4*)(Kb + tok * DATT + h * HD + ch * 8);
            const u32x4 vv = *(const u32x4*)(Vb + tok * DATT + h * HD + ch * 8);
            *(LAS u32x4*)(lds + rho * KVS + ch * 16) = kv;
            *(LAS u32x4*)(lds + VOFF + rho * KVS + ch * 16) = vv;
        }
    }
    const int cq = lane & 15, g = lane >> 4;
    const int iq = 128 * c + 16 * w + cq;
    const size_t qtok = tok0 + (size_t)(iq * dil + r);
    bf16x8 qf[4];
#pragma unroll
    for (int ks = 0; ks < 4; ++ks) qf[ks] = *(const bf16x8*)(Qb + qtok * DATT + h * HD + 32 * ks + 8 * g);
    __syncthreads();
    const int ktmin = (8 - w - 8 * c) > 0 ? (8 - w - 8 * c) : 0;
    const float slope2 = exp2f(-8.0f * (float)(h + 1) / 12.0f) * LOG2E * (float)dil;
    f32x4 s[9]; float m = -INFINITY;
#pragma unroll
    for (int kt = 0; kt < 9; ++kt) {
        if (kt >= ktmin) {
            f32x4 acc = {0.f, 0.f, 0.f, 0.f};
#pragma unroll
            for (int ks = 0; ks < 4; ++ks) { const bf16x8 kf = *(const LAS bf16x8*)(lds + (16 * w + 16 * kt + cq) * KVS + (32 * ks + 8 * g) * 2); acc = __builtin_amdgcn_mfma_f32_16x16x32_bf16(kf, qf[ks], acc, 0, 0, 0); }
#pragma unroll
            for (int ii = 0; ii < 4; ++ii) { const int dist = cq + 128 - 16 * kt - 4 * g - ii; float v = acc[ii] - slope2 * (float)dist;
                if (kt == 0 && dist > 128) v = -INFINITY; if (kt == 8 && dist < 0) v = -INFINITY; acc[ii] = v; m = fmaxf(m, v); }
            s[kt] = acc;
        } else s[kt] = (f32x4){-INFINITY, -INFINITY, -INFINITY, -INFINITY};
    }
    m = fmaxf(m, __shfl_xor(m, 16)); m = fmaxf(m, __shfl_xor(m, 32));
    float l = 0.f;
#pragma unroll
    for (int kt = 0; kt < 9; ++kt)
#pragma unroll
        for (int ii = 0; ii < 4; ++ii) { const float pp = exp2f(s[kt][ii] - m); s[kt][ii] = pp; l += pp; }
    l += __shfl_xor(l, 16); l += __shfl_xor(l, 32);
    f32x4 o[8];
#pragma unroll
    for (int dt = 0; dt < 8; ++dt) o[dt] = (f32x4){0.f, 0.f, 0.f, 0.f};
#pragma unroll
    for (int kk = 0; kk < 5; ++kk) {
        const int T0 = 2 * kk, T1 = 2 * kk + 1;
        if (T1 >= ktmin || T0 == 8) {
            u32x4 pw; pw.x = pg8::cvt_pk_bf16(s[T0][0], s[T0][1]); pw.y = pg8::cvt_pk_bf16(s[T0][2], s[T0][3]);
            if (T1 <= 8) { pw.z = pg8::cvt_pk_bf16(s[T1 <= 8 ? T1 : 8][0], s[T1 <= 8 ? T1 : 8][1]); pw.w = pg8::cvt_pk_bf16(s[T1 <= 8 ? T1 : 8][2], s[T1 <= 8 ? T1 : 8][3]); } else { pw.z = 0u; pw.w = 0u; }
            const bf16x8 pf = __builtin_bit_cast(bf16x8, pw);
            const int rT0 = (T0 >= ktmin) ? T0 : 8, rT1 = (T1 <= 8 && T1 >= ktmin) ? T1 : 8;
            const int a0 = VOFF + (16 * w + 16 * rT0 + 4 * g + (cq >> 2)) * KVS + 8 * (cq & 3);
            const int a1 = VOFF + (16 * w + 16 * rT1 + 4 * g + (cq >> 2)) * KVS + 8 * (cq & 3);
#pragma unroll
            for (int dt = 0; dt < 8; ++dt) {
                const s16x4 v0 = __builtin_amdgcn_ds_read_tr16_b64_v4i16((LAS s16x4*)(lds + a0 + dt * 32));
                const s16x4 v1 = __builtin_amdgcn_ds_read_tr16_b64_v4i16((LAS s16x4*)(lds + a1 + dt * 32));
                const bf16x8 vf = {v0[0], v0[1], v0[2], v0[3], v1[0], v1[1], v1[2], v1[3]};
                o[dt] = __builtin_amdgcn_mfma_f32_16x16x32_bf16(vf, pf, o[dt], 0, 0, 0);
            }
        }
    }
    const float inv = 1.0f / l;
    if (MODE == 0) {
        bf16_t* po = (bf16_t*)(P.ws + WS_PO) + ((size_t)p * NTOK_P + qtok) * DATT + h * HD + 4 * g;
#pragma unroll
        for (int dt = 0; dt < 8; ++dt) { u32x2 wv; wv.x = pg8::cvt_pk_bf16(o[dt][0] * inv, o[dt][1] * inv); wv.y = pg8::cvt_pk_bf16(o[dt][2] * inv, o[dt][3] * inv); *(u32x2*)(po + 16 * dt) = wv; }
        if (g == 0) { ((float*)(P.ws + WS_PM))[((size_t)p * NTOK_P + qtok) * NH + h] = m; ((float*)(P.ws + WS_PL))[((size_t)p * NTOK_P + qtok) * NH + h] = l; }
    } else {
        const float* PM = (const float*)(P.ws + WS_PM); const float* PL = (const float*)(P.ws + WS_PL);
        const float m0 = PM[qtok * NH + h], l0 = PL[qtok * NH + h], m1 = PM[((size_t)NTOK_P + qtok) * NH + h], l1 = PL[((size_t)NTOK_P + qtok) * NH + h];
        const float M = fmaxf(m, fmaxf(m0, m1));
        const float w2 = exp2f(m - M), w0 = exp2f(m0 - M) * l0, w1 = exp2f(m1 - M) * l1;
        const float rden = 1.0f / (w2 * l + w0 + w1);
        const bf16_t* p0 = (const bf16_t*)(P.ws + WS_PO) + qtok * DATT + h * HD + 4 * g;
        const bf16_t* p1 = p0 + (size_t)NTOK_P * DATT;
        bf16_t* ar = (bf16_t*)(P.ws + WS_AR) + qtok * D + h * HD + 4 * g;
#pragma unroll
        for (int dt = 0; dt < 8; ++dt) {
            const u32x2 x0 = *(const u32x2*)(p0 + 16 * dt), x1 = *(const u32x2*)(p1 + 16 * dt);
            const float r0 = (w2 * o[dt][0] + w0 * bflo(x0.x) + w1 * bflo(x1.x)) * rden, r1 = (w2 * o[dt][1] + w0 * bfhi(x0.x) + w1 * bfhi(x1.x)) * rden;
            const float r2 = (w2 * o[dt][2] + w0 * bflo(x0.y) + w1 * bflo(x1.y)) * rden, r3 = (w2 * o[dt][3] + w0 * bfhi(x0.y) + w1 * bfhi(x1.y)) * rden;
            u32x2 wv; wv.x = pg8::cvt_pk_bf16(r0, r1); wv.y = pg8::cvt_pk_bf16(r2, r3); *(u32x2*)(ar + 16 * dt) = wv;
        }
    }
    __syncthreads();
}

__device__ __forceinline__ void samp_unit(const Params& P, int b, int h, int k, LAS unsigned char* lds) {
    const int tid = threadIdx.x, lane = tid & 63, w = __builtin_amdgcn_readfirstlane(tid >> 6);
    const int cq = lane & 15, g = lane >> 4;
    if (k < 8) {
#pragma unroll 4
        for (int it = 0; it < 16; ++it) {
            const int rho = it * 16 + (tid >> 5), ch4 = tid & 31, c = 256 * k + rho;
            const size_t so = ((size_t)(b * 2048 + c)) * DATT + h * HD + ch4 * 4;
            const float4 kf = *(const float4*)(P.cache_k + so), vf = *(const float4*)(P.cache_v + so);
            if (c >= 8) { const size_t od = ((size_t)(b * 2048 + c - 8)) * DATT + h * HD + ch4 * 4; *(float4*)(P.out + O_KS + od) = kf; *(float4*)(P.out + O_VS + od) = vf; }
            u32x2 kw, vw; kw.x = pg8::cvt_pk_bf16(kf.x, kf.y); kw.y = pg8::cvt_pk_bf16(kf.z, kf.w); vw.x = pg8::cvt_pk_bf16(vf.x, vf.y); vw.y = pg8::cvt_pk_bf16(vf.z, vf.w);
            *(LAS u32x2*)(lds + rho * KVS + ch4 * 8) = kw; *(LAS u32x2*)(lds + VOFF + rho * KVS + ch4 * 8) = vw;
        }
    } else {
        const int rho = tid >> 5, ch4 = tid & 31;
        u32x2 kw = {0u, 0u}, vw = {0u, 0u};
        if (rho < 8) { const size_t so = ((size_t)(b * 2048 + 2040 + rho)) * DATT + h * HD + ch4 * 4; const float4 kf = *(const float4*)(P.out + O_KS + so), vf = *(const float4*)(P.out + O_VS + so);
            kw.x = pg8::cvt_pk_bf16(kf.x, kf.y); kw.y = pg8::cvt_pk_bf16(kf.z, kf.w); vw.x = pg8::cvt_pk_bf16(vf.x, vf.y); vw.y = pg8::cvt_pk_bf16(vf.z, vf.w); }
        *(LAS u32x2*)(lds + rho * KVS + ch4 * 8) = kw; *(LAS u32x2*)(lds + VOFF + rho * KVS + ch4 * 8) = vw;
        *(LAS u32x2*)(lds + (16 + rho) * KVS + ch4 * 8) = (u32x2){0u, 0u}; *(LAS u32x2*)(lds + VOFF + (16 + rho) * KVS + ch4 * 8) = (u32x2){0u, 0u};
    }
    const int t = cq & 7;
    const bf16_t* Qb = (const bf16_t*)(P.ws + WS_QB) + ((size_t)(NTOK_P + b * 8 + t)) * DATT + h * HD;
    bf16x8 qf[4];
#pragma unroll
    for (int ks = 0; ks < 4; ++ks) qf[ks] = *(const bf16x8*)(Qb + 32 * ks + 8 * g);
    __syncthreads();
    const float slope2 = exp2f(-8.0f * (float)(h + 1) / 12.0f) * LOG2E;
    const bool active = (k < 8) || (w == 0);
    f32x4 s[2]; float m = -INFINITY;
#pragma unroll
    for (int j = 0; j < 2; ++j) {
        f32x4 acc = {0.f, 0.f, 0.f, 0.f};
        if (active) {
#pragma unroll
            for (int ks = 0; ks < 4; ++ks) { const bf16x8 kf = *(const LAS bf16x8*)(lds + (32 * w + 16 * j + cq) * KVS + (32 * ks + 8 * g) * 2); acc = __builtin_amdgcn_mfma_f32_16x16x32_bf16(kf, qf[ks], acc, 0, 0, 0); }
        }
#pragma unroll
        for (int ii = 0; ii < 4; ++ii) {
            const int c = 256 * k + 32 * w + 16 * j + 4 * g + ii, dist = 2048 + t - c;
            int mult = (dist <= 128 ? 1 : 0) + (((dist & 3) == 0 && dist <= 512) ? 1 : 0) + (((dist & 15) == 0 && dist <= 2048) ? 1 : 0);
            if (dist < 0 || !active || c > 2055) mult = 0;
            const float v = mult ? acc[ii] - slope2 * (float)dist : -INFINITY;
            acc[ii] = v; m = fmaxf(m, v);
            s[j][ii] = (float)mult;
            s[j][ii] = v;
        }
    }
    m = fmaxf(m, __shfl_xor(m, 16)); m = fmaxf(m, __shfl_xor(m, 32));
    const float mref = (m == -INFINITY) ? 0.f : m;
    float l = 0.f;
#pragma unroll
    for (int j = 0; j < 2; ++j)
#pragma unroll
        for (int ii = 0; ii < 4; ++ii) {
            const int c = 256 * k + 32 * w + 16 * j + 4 * g + ii, dist = 2048 + t - c;
            const int mult = (dist <= 128 ? 1 : 0) + (((dist & 3) == 0 && dist <= 512) ? 1 : 0) + (((dist & 15) == 0 && dist <= 2048) ? 1 : 0);
            const float pp = (float)mult * exp2f(s[j][ii] - mref); s[j][ii] = pp; l += pp; }
    l += __shfl_xor(l, 16); l += __shfl_xor(l, 32);
    f32x4 o[8];
    {
        u32x4 pw; pw.x = pg8::cvt_pk_bf16(s[0][0], s[0][1]); pw.y = pg8::cvt_pk_bf16(s[0][2], s[0][3]); pw.z = pg8::cvt_pk_bf16(s[1][0], s[1][1]); pw.w = pg8::cvt_pk_bf16(s[1][2], s[1][3]);
        const bf16x8 pf = __builtin_bit_cast(bf16x8, pw);
        const int rw = active ? w : 0;
        const int a0 = VOFF + (32 * rw + 4 * g + (cq >> 2)) * KVS + 8 * (cq & 3), a1 = a0 + 16 * KVS;
#pragma unroll
        for (int dt = 0; dt < 8; ++dt) {
            const s16x4 v0 = __builtin_amdgcn_ds_read_tr16_b64_v4i16((LAS s16x4*)(lds + a0 + dt * 32));
            const s16x4 v1 = __builtin_amdgcn_ds_read_tr16_b64_v4i16((LAS s16x4*)(lds + a1 + dt * 32));
            const bf16x8 vf = {v0[0], v0[1], v0[2], v0[3], v1[0], v1[1], v1[2], v1[3]};
            o[dt] = __builtin_amdgcn_mfma_f32_16x16x32_bf16(vf, pf, (f32x4){0.f, 0.f, 0.f, 0.f}, 0, 0, 0);
        }
    }
    __syncthreads();
    LAS float* OL = (LAS float*)lds;
    LAS float* ML = (LAS float*)(lds + 32768);
    if (cq < 8) {
#pragma unroll
        for (int dt = 0; dt < 8; ++dt) *(LAS f32x4*)(OL + (w * 8 + cq) * 128 + 16 * dt + 4 * g) = o[dt];
        if (g == 0) { ML[(w * 8 + cq) * 2 + 0] = m; ML[(w * 8 + cq) * 2 + 1] = l; }
    }
    __syncthreads();
    {
        const int q = w; float M = -INFINITY;
#pragma unroll
        for (int ww = 0; ww < 8; ++ww) M = fmaxf(M, ML[(ww * 8 + q) * 2]);
        const float Mr = (M == -INFINITY) ? 0.f : M;
        float L = 0.f, o0 = 0.f, o1 = 0.f;
#pragma unroll
        for (int ww = 0; ww < 8; ++ww) { const float f = exp2f(ML[(ww * 8 + q) * 2] - Mr); L += f * ML[(ww * 8 + q) * 2 + 1];
            o0 += f * OL[(ww * 8 + q) * 128 + 2 * lane]; o1 += f * OL[(ww * 8 + q) * 128 + 2 * lane + 1]; }
        float* ps = (float*)(P.ws + WS_PS) + ((((size_t)(b * NH + h)) * 9 + k) * 8 + q) * 130;
        if (lane == 0) { ps[0] = M; ps[1] = L; }
        *(float2*)(ps + 2 + 2 * lane) = make_float2(o0, o1);
    }
    __syncthreads();
}
__device__ __forceinline__ void samp_merge_unit(const Params& P, int b, int t, int h, int lane) {
    const float* ps = (const float*)(P.ws + WS_PS) + ((size_t)(b * NH + h)) * 9 * 8 * 130 + (size_t)t * 130;
    float M = -INFINITY;
#pragma unroll
    for (int k = 0; k < 9; ++k) M = fmaxf(M, ps[(size_t)k * 8 * 130]);
    float L = 0.f, o0 = 0.f, o1 = 0.f;
#pragma unroll
    for (int k = 0; k < 9; ++k) { const float* pk = ps + (size_t)k * 8 * 130; const float f = exp2f(pk[0] - M); L += f * pk[1]; const float2 ov = *(const float2*)(pk + 2 + 2 * lane); o0 += f * ov.x; o1 += f * ov.y; }
    const float inv = 1.0f / L;
    bf16_t* ar = (bf16_t*)(P.ws + WS_AR) + ((size_t)(NTOK_P + b * 8 + t)) * D + h * HD;
    *(unsigned*)(ar + 2 * lane) = pack2(o0 * inv, o1 * inv);
}

__device__ __forceinline__ void lru_unit(const Params& P, bool samp, int b, int n, int k, int lane) {
    const int T = samp ? 8 : 64; const int row0 = samp ? NTOK_P + b * 8 : b * 2048 + k * 64; const int ch = n * 64 + lane;
    float wa[64], wx[64];
#pragma unroll
    for (int c = 0; c < 64; ++c) { wa[c] = P.lru_w_a[(n * 64 + c) * 64 + lane]; wx[c] = P.lru_w_x[(n * 64 + c) * 64 + lane]; }
    const float ba = P.lru_b_a[ch], bx = P.lru_b_x[ch], lam = P.lru_lambda[ch];
    const float sp = log1pf(expf(-lam));
    const float cw0 = P.conv_w[ch], cw1 = P.conv_w[512 + ch], cw2 = P.conv_w[1024 + ch], cw3 = P.conv_w[1536 + ch], cb = P.conv_b[ch];
    const float* XR = (const float*)(P.ws + WS_XR); const float* GT = (const float*)(P.ws + WS_GATE);
    float* R0 = (float*)(P.ws + WS_R0); float* R1 = (float*)(P.ws + WS_R1); bf16_t* AR = (bf16_t*)(P.ws + WS_AR);
    float x0 = 0.f, x1 = 0.f, x2 = 0.f, h = 0.f, A = 1.f;
    if (samp) { x0 = P.state_conv[(b * 3 + 0) * 512 + ch]; x1 = P.state_conv[(b * 3 + 1) * 512 + ch]; x2 = P.state_conv[(b * 3 + 2) * 512 + ch]; h = P.state_h[b * 512 + ch]; }
    else if (k > 0) { x0 = XR[(size_t)(row0 - 3) * DLRU + ch]; x1 = XR[(size_t)(row0 - 2) * DLRU + ch]; x2 = XR[(size_t)(row0 - 1) * DLRU + ch]; }
    for (int t0 = 0; t0 < T; t0 += 8) {
        float xin[8], gt[8];
#pragma unroll
        for (int i = 0; i < 8; ++i) { xin[i] = XR[(size_t)(row0 + t0 + i) * DLRU + ch]; gt[i] = GT[(size_t)(row0 + t0 + i) * DLRU + ch]; }
#pragma unroll
        for (int i = 0; i < 8; ++i) {
            const float xc = ((x0 * cw0 + x1 * cw1) + x2 * cw2) + xin[i] * cw3 + cb;
            x0 = x1; x1 = x2; x2 = xin[i];
            float ra = 0.f, ri = 0.f;
#pragma unroll
            for (int c = 0; c < 64; ++c) { const float xcc = readlane_f(xc, c); ra += xcc * wa[c]; ri += xcc * wx[c]; if ((c & 15) == 15) __builtin_amdgcn_sched_barrier(0); }
            const float rr = sigmoidf(ra + ba), ig = sigmoidf(ri + bx);
            const float log_a = -8.0f * rr * sp; const float a = expf(log_a);
            const float u = sqrtf(-expm1f(2.0f * log_a)) * (ig * xc);
            h = a * h + u; A = a * A;
            const float ge = gelu_exact(gt[i]);
            if (samp) AR[(size_t)(row0 + t0 + i) * D + DATT + ch] = (bf16_t)f2bf(h * ge);
            else { R0[(size_t)(row0 + t0 + i) * DLRU + ch] = h * ge; R1[(size_t)(row0 + t0 + i) * DLRU + ch] = A * ge; }
        }
    }
    if (samp) { P.out[O_HS + (size_t)b * 512 + ch] = h; float* co = P.out + O_CS + (size_t)b * 3 * 512 + ch; co[0] = x0; co[512] = x1; co[1024] = x2; }
    else {
        ((float*)(P.ws + WS_HE))[((size_t)(b * 32 + k)) * 512 + ch] = h; ((float*)(P.ws + WS_AE))[((size_t)(b * 32 + k)) * 512 + ch] = A;
        if (k == 31) { float* co = P.out + O_CP + (size_t)b * 3 * 512 + ch; co[0] = x0; co[512] = x1; co[1024] = x2; }
    }
}

__device__ __forceinline__ void phase_mix_a(const Params& P, LAS unsigned char* lds) {
    const int lane = threadIdx.x & 63, wave = __builtin_amdgcn_readfirstlane(threadIdx.x >> 6);
    const int gw = blockIdx.x * 8 + wave, nw = gridDim.x * 8;
    for (int u = gw; u < 2048 + 256; u += nw) { const bool samp = u >= 2048; const int v = samp ? u - 2048 : u; lru_unit(P, samp, samp ? (v >> 3) : (v >> 8), samp ? (v & 7) : ((v >> 5) & 7), v & 31, lane); }
    __syncthreads();
#pragma unroll 1
    for (int pass = 0; pass < 2; ++pass) {
        if ((pass ^ (int)(blockIdx.x & 1)) == 0) {
            for (int u = blockIdx.x; u < 384 * 9; u += gridDim.x) { const int k = u % 9, bh = u / 9; samp_unit(P, bh / NH, bh % NH, k, lds); }
        } else {
            for (int u = blockIdx.x; u < 3072; u += gridDim.x) {
                const int p = u / 1536, rem = u - p * 1536, bh = rem >> 4, rc = rem & 15;
                const int b = bh / NH, h = bh - b * NH;
                const int r = p == 0 ? 0 : (rc >> 2), c = p == 0 ? rc : (rc & 3);
                attn_unit<0>(P, p, b, h, r, c, lds);
            }
        }
    }
}
__device__ __forceinline__ void phase_mix_b(const Params& P, LAS unsigned char* lds) {
    {
        const int gt = blockIdx.x * NTHREADS + threadIdx.x;
        for (int i = gt; i < 8 * 32 * 512; i += gridDim.x * NTHREADS) {
            const int ch = i & 511, k = (i >> 9) & 31, b = i >> 14;
            const float* HE = (const float*)(P.ws + WS_HE) + (size_t)b * 32 * 512 + ch; const float* AE = (const float*)(P.ws + WS_AE) + (size_t)b * 32 * 512 + ch;
            float hin = 0.f;
            for (int kk = 0; kk < k; ++kk) hin = HE[kk * 512] + AE[kk * 512] * hin;
            const float* R0 = (const float*)(P.ws + WS_R0) + (size_t)(b * 2048 + k * 64) * DLRU + ch; const float* R1 = (const float*)(P.ws + WS_R1) + (size_t)(b * 2048 + k * 64) * DLRU + ch;
            bf16_t* ar = (bf16_t*)(P.ws + WS_AR) + (size_t)(b * 2048 + k * 64) * D + DATT + ch;
#pragma unroll 8
            for (int t = 0; t < 64; ++t) ar[(size_t)t * D] = (bf16_t)f2bf(R0[(size_t)t * DLRU] + R1[(size_t)t * DLRU] * hin);
            if (k == 31) P.out[O_HP + (size_t)b * 512 + ch] = HE[31 * 512] + AE[31 * 512] * hin;
        }
    }
    { const int lane = threadIdx.x & 63, gw = blockIdx.x * 8 + (threadIdx.x >> 6);
      for (int u = gw; u < NTOK_S * NH; u += gridDim.x * 8) { const int row = u / NH, h = u - row * NH; samp_merge_unit(P, row >> 3, row & 7, h, lane); } }
    for (int u = blockIdx.x; u < 1536; u += gridDim.x) {
        const int bh = u >> 4, r = u & 15; const int b = bh / NH, h = bh - b * NH;
        attn_unit<1>(P, 2, b, h, r, 0, lds);
    }
}

__device__ __forceinline__ void phase_ln1(const Params& P) {
    const int lane = threadIdx.x & 63, wave = threadIdx.x >> 6;
    const float* pre = (const float*)(P.ws + WS_PRE1); float* x1f = (float*)(P.ws + WS_X1F); bf16_t* x1b = (bf16_t*)(P.ws + WS_X1B);
    for (int row = blockIdx.x * 8 + wave; row < NTOK; row += gridDim.x * 8) {
        float4 v[8]; float s = 0.f;
#pragma unroll
        for (int j = 0; j < 8; ++j) { v[j] = *(const float4*)(pre + (size_t)row * D + (j >> 2) * 1024 + lane * 16 + (j & 3) * 4); s += (v[j].x + v[j].y) + (v[j].z + v[j].w); }
        const float mean = wave_sum(s) * (1.0f / D); float q = 0.f;
#pragma unroll
        for (int j = 0; j < 8; ++j) { const float a = v[j].x - mean, b = v[j].y - mean, c = v[j].z - mean, d = v[j].w - mean; q += (a * a + b * b) + (c * c + d * d); }
        const float rstd = rsqrtf(wave_sum(q) * (1.0f / D) + LN_EPS);
        float am = 0.f;
#pragma unroll
        for (int j = 0; j < 8; ++j) { const int col = (j >> 2) * 1024 + lane * 16 + (j & 3) * 4; const float4 g = *(const float4*)(P.ln1_g + col), bb = *(const float4*)(P.ln1_b + col);
            float4 o; o.x = (v[j].x - mean) * rstd * g.x + bb.x; o.y = (v[j].y - mean) * rstd * g.y + bb.y; o.z = (v[j].z - mean) * rstd * g.z + bb.z; o.w = (v[j].w - mean) * rstd * g.w + bb.w;
            v[j] = o; am = fmaxf(am, fmaxf(fmaxf(fabsf(o.x), fabsf(o.y)), fmaxf(fabsf(o.z), fabsf(o.w))));
            *(float4*)(x1f + (size_t)row * D + col) = o;
            uint2 w; w.x = pack2(o.x, o.y); w.y = pack2(o.z, o.w); *(uint2*)(x1b + (size_t)row * D + col) = w; }
        am = wave_max(am); if (am == 0.f) am = 1.f;
        const float inv = 127.0f / am;
        unsigned char* xq = P.ws + WS_X1Q + (size_t)row * D;
#pragma unroll
        for (int j = 0; j < 2; ++j) { u32x4 w;
#pragma unroll
            for (int i = 0; i < 4; ++i) { const float4 t = v[j * 4 + i];
                const int a = (int)rintf(t.x * inv), b = (int)rintf(t.y * inv), c = (int)rintf(t.z * inv), d = (int)rintf(t.w * inv);
                w[i] = (unsigned)(a & 255) | ((unsigned)(b & 255) << 8) | ((unsigned)(c & 255) << 16) | ((unsigned)(d & 255) << 24); }
            *(u32x4*)(xq + j * 1024 + lane * 16) = w; }
        if (lane == 0) ((float*)(P.ws + WS_SX))[row] = am * (1.0f / 127.0f);
    }
}

__device__ __forceinline__ int mono(float v) { const int b = __float_as_int(v); return b ^ ((b >> 31) & 0x7fffffff); }
__device__ __forceinline__ float unmono(int k) { return __int_as_float(k ^ ((k >> 31) & 0x7fffffff)); }
#define MK_INSERT16(L, X) do { int _x = (X); _Pragma("unroll") for (int _j = 0; _j < 16; ++_j) { const int _hi = max(L[_j], _x); _x = min(L[_j], _x); L[_j] = _hi; } } while (0)

template <int N> __device__ __forceinline__ void bitonic_sort_desc(int (&v)[N]) {
#pragma unroll
    for (int k = 2; k <= N; k <<= 1)
#pragma unroll
        for (int j = k >> 1; j > 0; j >>= 1)
#pragma unroll
            for (int i = 0; i < N; ++i) { const int l = i ^ j;
                if (l > i) { const int a = v[i], b = v[l]; if ((i & k) == 0) { v[i] = max(a, b); v[l] = min(a, b); } else { v[i] = min(a, b); v[l] = max(a, b); } } }
}
template <int N> __device__ __forceinline__ void bitonic_merge_desc(int (&v)[N]) {
#pragma unroll
    for (int j = N >> 1; j > 0; j >>= 1)
#pragma unroll
        for (int i = 0; i < N; ++i) { const int l = i ^ j; if (l > i) { const int a = v[i], b = v[l]; v[i] = max(a, b); v[l] = min(a, b); } }
}
__device__ __forceinline__ void xlane_merge16(int (&v)[16], int off) {
    int c[16];
#pragma unroll
    for (int i = 0; i < 16; ++i) c[i] = max(v[i], __shfl_xor(v[15 - i], off));
#pragma unroll
    for (int i = 0; i < 16; ++i) v[i] = c[i];
    bitonic_merge_desc<16>(v);
}
__device__ __forceinline__ int sel4(int g, int a, int b, int c, int d) { return g == 0 ? a : (g == 1 ? b : (g == 2 ? c : d)); }
__device__ __forceinline__ float sel4f(int g, float a, float b, float c, float d) { return g == 0 ? a : (g == 1 ? b : (g == 2 ? c : d)); }
__device__ __forceinline__ constexpr int cand_a(int role, int i) {
    return role == 0 ? 0 : role == 1 ? (i < 8 ? 1 : (i < 13 ? 2 : 4)) : role == 2 ? (i < 4 ? 3 : (i < 6 ? 5 : (i < 8 ? 6 : (i < 10 ? 7 : 8 + (i - 10))))) : (i < 2 ? 14 + i : -1);
}
__device__ __forceinline__ constexpr int cand_b(int role, int i) {
    return role == 0 ? i : role == 1 ? (i < 8 ? i : (i < 13 ? i - 8 : i - 13)) : role == 2 ? (i < 4 ? i : (i < 6 ? i - 4 : (i < 8 ? i - 6 : (i < 10 ? i - 8 : 0)))) : 0;
}

__device__ __forceinline__ void route_unit(const Params& P, int h, int tg, LAS unsigned char* lds, LAS int* lst) {
    const int lane = threadIdx.x & 63, w = __builtin_amdgcn_readfirstlane(threadIdx.x >> 6);
    const int cq = lane & 15, g = lane >> 4;
    const int tok = tg * 128 + w * 16 + cq;
    const bf16_t* qrow = (const bf16_t*)(P.ws + WS_QP) + (size_t)tok * D + h * 256;
    int L0[16], L1[16];
#pragma unroll
    for (int p = 0; p < 2; ++p) {
        bf16x8 qf[4];
#pragma unroll
        for (int ks = 0; ks < 4; ++ks) qf[ks] = *(const bf16x8*)(qrow + p * 128 + 32 * ks + 8 * g);
        int v0[16], v1[16];
#pragma unroll
        for (int kt = 0; kt < 8; ++kt) {
            f32x4 acc = {0.f, 0.f, 0.f, 0.f};
#pragma unroll
            for (int ks = 0; ks < 4; ++ks) { const bf16x8 kf = *(const LAS bf16x8*)(lds + (p * 128 + 16 * kt + cq) * KVS + (32 * ks + 8 * g) * 2); acc = __builtin_amdgcn_mfma_f32_16x16x32_bf16(kf, qf[ks], acc, 0, 0, 0); }
#pragma unroll
            for (int ii = 0; ii < 4; ++ii) { const int key = (mono(acc[ii]) & ~127) | (16 * kt + 4 * g + ii); if (kt < 4) v0[kt * 4 + ii] = key; else v1[(kt - 4) * 4 + ii] = key; }
        }
        bitonic_sort_desc<16>(v0); bitonic_sort_desc<16>(v1);
#pragma unroll
        for (int i = 0; i < 16; ++i) v0[i] = max(v0[i], v1[15 - i]);
        bitonic_merge_desc<16>(v0);
        xlane_merge16(v0, 16); xlane_merge16(v0, 32);
#pragma unroll
        for (int i = 0; i < 16; ++i) { if (p == 0) L0[i] = v0[i]; else L1[i] = v0[i]; }
    }
    if (g == 0) {
#pragma unroll
        for (int i = 0; i < 16; ++i) lst[(cq * 2 + 0) * 16 + i] = L0[i];
    }
    if (g == 1) {
#pragma unroll
        for (int i = 0; i < 16; ++i) lst[(cq * 2 + 1) * 16 + i] = L1[i];
    }
    float f0[16], f1[16];
#pragma unroll
    for (int i = 0; i < 16; ++i) { f0[i] = unmono(L0[i] & ~127); f1[i] = unmono(L1[i] & ~127); }
    int c[16];
#pragma unroll
    for (int i = 0; i < 16; ++i) {
        constexpr int NEG = (int)0x80000000;
        const float va = sel4f(g, f0[cand_a(0, i)], f0[cand_a(1, i)], f0[cand_a(2, i)], f0[cand_a(3, i) < 0 ? 0 : cand_a(3, i)]);
        const float vb = sel4f(g, f1[cand_b(0, i)], f1[cand_b(1, i)], f1[cand_b(2, i)], f1[cand_b(3, i)]);
        const int id = sel4(g, (cand_a(0, i) << 4) | cand_b(0, i), (cand_a(1, i) << 4) | cand_b(1, i), (cand_a(2, i) << 4) | cand_b(2, i), ((cand_a(3, i) < 0 ? 0 : cand_a(3, i)) << 4) | cand_b(3, i));
        int key = (mono(va + vb) & ~255) | id;
        if (cand_a(3, i) < 0) key = (g == 3) ? NEG : key;
        c[i] = key;
    }
    bitonic_sort_desc<16>(c);
    xlane_merge16(c, 16); xlane_merge16(c, 32);
    const float mx = unmono(c[0] & ~255);
    float e[16]; float sum = 0.f;
#pragma unroll
    for (int i = 0; i < 16; ++i) { e[i] = exp2f((unmono(c[i] & ~255) - mx) * LOG2E); sum += e[i]; }
    const float inv = 1.0f / sum;
    __builtin_amdgcn_wave_barrier();
    int ei[4]; float gi[4];
#pragma unroll
    for (int j = 0; j < 4; ++j) {
        const int key = sel4(g, c[j], c[4 + j], c[8 + j], c[12 + j]);
        gi[j] = sel4f(g, e[j], e[4 + j], e[8 + j], e[12 + j]) * inv;
        const int a = (key >> 4) & 15, b = key & 15;
        const int i0 = lst[(cq * 2 + 0) * 16 + a] & 127, i1 = lst[(cq * 2 + 1) * 16 + b] & 127;
        ei[j] = i0 * 128 + i1;
    }
    int* EIDX = (int*)(P.ws + WS_EIDX); float* GW = (float*)(P.ws + WS_GW);
    *(int4*)(EIDX + (size_t)tok * 128 + h * 16 + 4 * g) = make_int4(ei[0], ei[1], ei[2], ei[3]);
    *(float4*)(GW + (size_t)tok * 128 + h * 16 + 4 * g) = make_float4(gi[0], gi[1], gi[2], gi[3]);
    __builtin_amdgcn_wave_barrier();
}
__device__ __forceinline__ void phase_route(const Params& P, LAS unsigned char* lds) {
    const int tid = threadIdx.x, wave = __builtin_amdgcn_readfirstlane(tid >> 6);
    const int h = blockIdx.x & 7, slot = blockIdx.x >> 3, nslot = gridDim.x >> 3;
    const bf16_t* sk = (const bf16_t*)(P.ws + WS_SKB) + (size_t)h * 2 * 128 * 128;
#pragma unroll
    for (int it = 0; it < 8; ++it) { const int row = it * 32 + (tid >> 4), ch = tid & 15; *(LAS u32x4*)(lds + row * KVS + ch * 16) = *(const u32x4*)(sk + (size_t)row * 128 + ch * 8); }
    __syncthreads();
    LAS int* lst = (LAS int*)(lds + 73728) + wave * 512;
    for (int tg = slot; tg < NTOK / 128; tg += nslot) route_unit(P, h, tg, lds, lst);
}

struct ExpGrp { u32x4 u[4][2]; u32x4 v[4][2]; };
__device__ __forceinline__ void exp_load(ExpGrp& G, __amdgpu_buffer_rsrc_t ru, __amdgpu_buffer_rsrc_t rv, int e_lo, int e_hi, int grp, int lane) {
#pragma unroll
    for (int j = 0; j < 4; ++j) {
        const int k = grp * 4 + j; const int e = __builtin_amdgcn_readlane(k < 64 ? e_lo : e_hi, k & 63);
        const int so = e * D, vo = lane * 16;
        G.u[j][0] = __builtin_amdgcn_raw_buffer_load_b128(ru, vo, so, 0); G.u[j][1] = __builtin_amdgcn_raw_buffer_load_b128(ru, vo + 1024, so, 0);
        G.v[j][0] = __builtin_amdgcn_raw_buffer_load_b128(rv, vo, so, 0); G.v[j][1] = __builtin_amdgcn_raw_buffer_load_b128(rv, vo + 1024, so, 0);
    }
}
__device__ __forceinline__ void exp_consume(const ExpGrp& G, const u32x4 (&xq)[2], float (&acc)[32], float a_lo, float a_hi, float b_lo, float b_hi, int grp, int lane) {
    int d[4];
#pragma unroll
    for (int j = 0; j < 4; ++j) { int t = 0;
#pragma unroll
        for (int jj = 0; jj < 2; ++jj)
#pragma unroll
            for (int i = 0; i < 4; ++i) t = __builtin_amdgcn_sdot4((int)G.u[j][jj][i], (int)xq[jj][i], t, false);
        d[j] = t; }
    const bool b5 = (lane & 32) != 0, b4 = (lane & 16) != 0;
    int r0 = (b5 ? d[2] : d[0]) + __shfl_xor(b5 ? d[0] : d[2], 32);
    int r1 = (b5 ? d[3] : d[1]) + __shfl_xor(b5 ? d[1] : d[3], 32);
    int r = (b4 ? r1 : r0) + __shfl_xor(b4 ? r0 : r1, 16);
    r += __shfl_xor(r, 8); r += __shfl_xor(r, 4); r += __shfl_xor(r, 2); r += __shfl_xor(r, 1);
    const int myj = (b5 ? 2 : 0) + (b4 ? 1 : 0), myk = grp * 4 + myj;
    const float ak = __shfl(myk < 64 ? a_lo : a_hi, myk & 63), bk = __shfl(myk < 64 ? b_lo : b_hi, myk & 63);
    const float wmine = bk * gelu_exact((float)r * ak);
#pragma unroll
    for (int j = 0; j < 4; ++j) {
        const float w = readlane_f(wmine, (j >> 1) * 32 + (j & 1) * 16);
        __builtin_amdgcn_sched_barrier(0);
#pragma unroll
        for (int jj = 0; jj < 2; ++jj)
#pragma unroll
            for (int i = 0; i < 4; ++i) {
                const f32x2 lo = __builtin_amdgcn_cvt_pk_f32_fp8((int)G.v[j][jj][i], false), hi = __builtin_amdgcn_cvt_pk_f32_fp8((int)G.v[j][jj][i], true);
                acc[jj * 16 + i * 4 + 0] += w * lo.x; acc[jj * 16 + i * 4 + 1] += w * lo.y; acc[jj * 16 + i * 4 + 2] += w * hi.x; acc[jj * 16 + i * 4 + 3] += w * hi.y;
            }
    }
}
__device__ __forceinline__ void phase_experts(const Params& P) {
    const int lane = threadIdx.x & 63, wave = threadIdx.x >> 6;
    const float* x1f = (const float*)(P.ws + WS_X1F);
    const int* EIDX = (const int*)(P.ws + WS_EIDX); const float* GW = (const float*)(P.ws + WS_GW);
    const __amdgpu_buffer_rsrc_t UQ = __builtin_amdgcn_make_buffer_rsrc((void*)(P.ws + WS_UB), 0, NEXP * D, 0x00020000);
    const __amdgpu_buffer_rsrc_t VQ = __builtin_amdgcn_make_buffer_rsrc((void*)(P.ws + WS_VB), 0, NEXP * D, 0x00020000);
    const float* SU = (const float*)(P.ws + WS_SU); const float* SV = (const float*)(P.ws + WS_SV); const float* SX = (const float*)(P.ws + WS_SX);
    for (int row = blockIdx.x * 8 + wave; row < NTOK; row += gridDim.x * 8) {
        u32x4 xq[2];
        xq[0] = *(const u32x4*)(P.ws + WS_X1Q + (size_t)row * D + lane * 16); xq[1] = *(const u32x4*)(P.ws + WS_X1Q + (size_t)row * D + 1024 + lane * 16);
        const float sx = SX[row];
        const int e_lo = EIDX[(size_t)row * 128 + lane], e_hi = EIDX[(size_t)row * 128 + 64 + lane];
        const float g_lo = GW[(size_t)row * 128 + lane], g_hi = GW[(size_t)row * 128 + 64 + lane];
        const float a_lo = SU[e_lo] * sx, a_hi = SU[e_hi] * sx, b_lo = g_lo * SV[e_lo], b_hi = g_hi * SV[e_hi];
        float acc[32];
#pragma unroll
        for (int i = 0; i < 32; ++i) acc[i] = 0.f;
        ExpGrp GA, GB;
        exp_load(GA, UQ, VQ, e_lo, e_hi, 0, lane);
#pragma unroll 1
        for (int grp = 0; grp < 32; grp += 2) {
            exp_load(GB, UQ, VQ, e_lo, e_hi, grp + 1, lane);
            exp_consume(GA, xq, acc, a_lo, a_hi, b_lo, b_hi, grp, lane);
            exp_load(GA, UQ, VQ, e_lo, e_hi, grp + 2 < 32 ? grp + 2 : 0, lane);
            exp_consume(GB, xq, acc, a_lo, a_hi, b_lo, b_hi, grp + 1, lane);
        }
        float s = 0.f;
#pragma unroll
        for (int jj = 0; jj < 2; ++jj)
#pragma unroll
            for (int i = 0; i < 4; ++i) { const float4 xv = *(const float4*)(x1f + (size_t)row * D + jj * 1024 + lane * 16 + i * 4);
                acc[jj * 16 + i * 4 + 0] += ALPHA * xv.x; acc[jj * 16 + i * 4 + 1] += ALPHA * xv.y; acc[jj * 16 + i * 4 + 2] += ALPHA * xv.z; acc[jj * 16 + i * 4 + 3] += ALPHA * xv.w; }
#pragma unroll
        for (int i = 0; i < 32; ++i) s += acc[i];
        const float mean = wave_sum(s) * (1.0f / D); float q = 0.f;
#pragma unroll
        for (int i = 0; i < 32; ++i) { const float dd = acc[i] - mean; q += dd * dd; }
        const float rstd = rsqrtf(wave_sum(q) * (1.0f / D) + LN_EPS);
        float* yo = P.out + (row < NTOK_P ? O_YP + (size_t)row * D : O_YS + (size_t)(row - NTOK_P) * D);
        int lo16 = lane * 16; asm volatile("" : "+v"(lo16));
#pragma unroll
        for (int jj = 0; jj < 2; ++jj)
#pragma unroll
            for (int i = 0; i < 4; ++i) {
                const int col = jj * 1024 + lo16 + i * 4;
                const float4 g0 = *(const float4*)(P.ln2_g + col), b0 = *(const float4*)(P.ln2_b + col);
                float4 o;
                o.x = (acc[jj * 16 + i * 4 + 0] - mean) * rstd * g0.x + b0.x; o.y = (acc[jj * 16 + i * 4 + 1] - mean) * rstd * g0.y + b0.y;
                o.z = (acc[jj * 16 + i * 4 + 2] - mean) * rstd * g0.z + b0.z; o.w = (acc[jj * 16 + i * 4 + 3] - mean) * rstd * g0.w + b0.w;
                *(float4*)(yo + col) = o;
            }
    }
}

constexpr int NPHASE = 9;
__global__ void __launch_bounds__(NTHREADS, 2) fwd(Params P) {
    extern __shared__ __attribute__((aligned(16))) unsigned char lds_raw[];
    LAS unsigned char* lds = (LAS unsigned char*)lds_raw;
    volatile LAS unsigned* misc = (volatile LAS unsigned*)(lds + MISC_OFF);
    const int lo = P.ph_lo, hi = P.ph_hi;
    XcdBarrier bar; bar.bar = (unsigned*)(P.ws + WS_CTL); bar.x = 0; bar.st = nullptr;
    if (hi - lo > 1) {
        if (threadIdx.x == 0) { misc[0] = 0u; misc[1] = 0u; misc[2] = 0u; misc[3] = 0u; }
        __syncthreads();
        bar = xcd_barrier_post((unsigned*)(P.ws + WS_CTL), misc);
    }
#ifndef MK_REPMASK
#define MK_REPMASK 0
#endif
#ifndef MK_PHASE_MASK
#define MK_PHASE_MASK 0x1ff
#endif
#define IN(k) (((MK_PHASE_MASK >> (k)) & 1) && lo <= (k) && (k) < hi)
#define SEAM(k) do { if (IN(k) && IN((k) + 1)) xcd_barrier(bar); } while (0)
    if (IN(0)) { phase_prologue(P, lds); }
    SEAM(0);
    if (IN(1)) {
        pg8::Gemm g{(const pg8::bf16_t*)(P.ws + WS_XB), (const pg8::bf16_t*)(P.ws + WS_WINT), NTOK, DIN, D};
        pg8::StaticOrder S; S.init(NTOK, DIN, (int)gridDim.x, (int)blockIdx.x);
        EpiProj E{P.out, (float*)(P.ws + WS_QF), (float*)(P.ws + WS_XR), (float*)(P.ws + WS_GATE), (bf16_t*)(P.ws + WS_QB), (bf16_t*)(P.ws + WS_KB), (bf16_t*)(P.ws + WS_VB16)};
        pg8::gemm_phase<EpiProj, pg8::StaticOrder, false>(lds, g, S, E, nullptr);
    }
    SEAM(1);
    if (IN(2)) { phase_mix_a(P, lds); }
    SEAM(2);
    if (IN(3)) { phase_mix_b(P, lds); }
    SEAM(3);
    if (IN(4)) {
        pg8::Gemm g{(const pg8::bf16_t*)(P.ws + WS_AR), (const pg8::bf16_t*)(P.ws + WS_WOT), NTOK, D, D};
        pg8::StaticOrder S; S.init(NTOK, D, (int)gridDim.x, (int)blockIdx.x);
        EpiOut E{P.x_prompt, P.x_sample, (float*)(P.ws + WS_PRE1)};
        pg8::gemm_phase<EpiOut, pg8::StaticOrder, false>(lds, g, S, E, nullptr);
    }
    SEAM(4);
    if (IN(5)) { phase_ln1(P); }
    SEAM(5);
    if (IN(6)) {
        pg8::Gemm g{(const pg8::bf16_t*)(P.ws + WS_X1B), (const pg8::bf16_t*)(P.ws + WS_WQT), NTOK, D, D};
        pg8::StaticOrder S; S.init(NTOK, D, (int)gridDim.x, (int)blockIdx.x);
        EpiBf16Plain E{(bf16_t*)(P.ws + WS_QP), D};
        pg8::gemm_phase<EpiBf16Plain, pg8::StaticOrder, false>(lds, g, S, E, nullptr);
    }
    SEAM(6);
    if (IN(7)) { phase_route(P, lds); }
    SEAM(7);
    if (IN(8)) { phase_experts(P); }
#undef IN
#undef SEAM
}
}

#ifndef MK_N_LAUNCHES
#define MK_N_LAUNCHES 1
#endif
extern "C" void kernel_launch(void* const* d_in, const int* in_sizes, int n_in, void* d_out, int out_size, void* d_ws, size_t ws_size, hipStream_t stream) {
    using namespace mk;
    static int grid = 0;
    if (grid == 0) {
        if (n_in != 23 || (size_t)out_size != O_END || ws_size < WS_END) { fprintf(stderr, "kernel_launch: unexpected shapes: n_in %d out %d ws %zu (need %zu)\n", n_in, out_size, ws_size, (size_t)WS_END); grid = -1; return; }
        int dev = 0, cus = 0, per_cu = 0;
        if (hipGetDevice(&dev) != hipSuccess || hipDeviceGetAttribute(&cus, hipDeviceAttributeMultiprocessorCount, dev) != hipSuccess) { grid = -1; return; }
        if (hipFuncSetAttribute((const void*)fwd, hipFuncAttributeMaxDynamicSharedMemorySize, LDS_BYTES) != hipSuccess) { fprintf(stderr, "kernel_launch: hipFuncSetAttribute failed\n"); grid = -1; return; }
        if (hipOccupancyMaxActiveBlocksPerMultiprocessor(&per_cu, (const void*)fwd, NTHREADS, LDS_BYTES) != hipSuccess || per_cu < 1) { fprintf(stderr, "kernel_launch: occupancy query says %d\n", per_cu); }
        (void)hipGetLastError();
        grid = cus;
    }
    if (grid < 0) return;
    (void)hipMemsetAsync((char*)d_ws + WS_CTL, 0, 65536, stream);
    Params p{};
    p.x_prompt = (const float*)d_in[0]; p.x_sample = (const float*)d_in[1]; p.cache_k = (const float*)d_in[2]; p.cache_v = (const float*)d_in[3];
    p.state_conv = (const float*)d_in[4]; p.state_h = (const float*)d_in[5]; p.w_in = (const float*)d_in[6]; p.conv_w = (const float*)d_in[7]; p.conv_b = (const float*)d_in[8];
    p.lru_w_a = (const float*)d_in[9]; p.lru_b_a = (const float*)d_in[10]; p.lru_w_x = (const float*)d_in[11]; p.lru_b_x = (const float*)d_in[12]; p.lru_lambda = (const float*)d_in[13];
    p.w_out = (const float*)d_in[14]; p.ln1_g = (const float*)d_in[15]; p.ln1_b = (const float*)d_in[16]; p.w_query = (const float*)d_in[17]; p.sub_keys = (const float*)d_in[18];
    p.peer_u = (const float*)d_in[19]; p.peer_v = (const float*)d_in[20]; p.ln2_g = (const float*)d_in[21]; p.ln2_b = (const float*)d_in[22];
    p.out = (float*)d_out; p.ws = (unsigned char*)d_ws;
#if MK_N_LAUNCHES == 1
    p.ph_lo = 0; p.ph_hi = NPHASE;
    hipLaunchKernelGGL(fwd, dim3(grid), dim3(NTHREADS), LDS_BYTES, stream, p);
#else
    for (int k = 0; k < NPHASE; ++k) { p.ph_lo = k; p.ph_hi = k + 1; hipLaunchKernelGGL(fwd, dim3(grid), dim3(NTHREADS), LDS_BYTES, stream, p);
#ifdef MK_EXTRA_PHASE
        if (k == MK_EXTRA_PHASE) hipLaunchKernelGGL(fwd, dim3(grid), dim3(NTHREADS), LDS_BYTES, stream, p);
#endif
    }
#endif
    const hipError_t le = hipPeekAtLastError();
    if (le != hipSuccess) fprintf(stderr, "kernel_launch: launch failed: %s\n", hipGetErrorName(le));
}
```

```cpp
#include <hip/hip_runtime.h>
#include <cstdio>
#include <cstdint>
namespace pg8 {
#define PG8_LAS __attribute__((address_space(3)))
typedef unsigned short bf16_t;
typedef short bf16x8 __attribute__((ext_vector_type(8)));
typedef float f32x4 __attribute__((ext_vector_type(4)));
typedef unsigned u32x4 __attribute__((ext_vector_type(4)));
constexpr int BM = 256, BK = 64, HALF = 128, HTB = HALF * BK * 2  , STAGE_BYTES = 8 * HTB, NXCD = 8, WGM = 8;

__host__ __device__ __forceinline__ int lds_byte(int r, int c) { const int st = (r >> 4) * 2 + (c >> 5), rr = r & 15, cc = c & 31, ob = rr * 64 + cc * 2; return st * 1024 + (ob ^ (((ob >> 9) & 1) << 5)); }
__host__ __device__ __forceinline__ void stage_rc(int b, int& R, int& C) { const int st = b / 1024, sb = b % 1024, swz = sb ^ (((sb >> 9) & 1) << 5); R = (st >> 1) * 16 + swz / 64; C = (st & 1) * 32 + (swz % 64) / 2; }
__host__ __device__ __forceinline__ int perm32(int rho) { const int n = rho >> 4, i = rho & 15; return 8 * (i >> 2) + 4 * n + (i & 3); }

struct Unit { int pm, pn; };
struct Gemm { const bf16_t* A; const bf16_t* Bt; int M, N, K; };

struct StaticOrder {
    int nM, nN, nwg, G, c;
    __host__ __device__ void init(int M, int N, int G_, int c_) { nM = M / BM; nN = N / BM; nwg = nM * nN; G = G_; c = c_; }
    __host__ __device__ bool next(int i, Unit& u) const {
        const long L = (long)i * G + c; if (L >= nwg) return false;
        int wgid = (int)L; { const int q = nwg / NXCD, r = nwg % NXCD, xcd = wgid % NXCD, off = wgid / NXCD; wgid = (xcd < r ? xcd * (q + 1) : r * (q + 1) + (xcd - r) * q) + off; }
        const int nig = WGM * nN, gid = wgid / nig, fm = gid * WGM, gsz = (nM - fm) < WGM ? (nM - fm) : WGM;
        u.pm = fm + ((wgid % nig) % gsz); u.pn = (wgid % nig) / gsz; return true;
    }
    __device__ __forceinline__ void a_ready(const Unit&) const {}
    __device__ __forceinline__ void done(const Unit&) const {}
};
struct CountedOrder : StaticOrder {
    const unsigned* ready; unsigned need; unsigned* tmo;
    __device__ __forceinline__ void a_ready(const Unit& u) const {
        if (threadIdx.x < 64) {
            const unsigned long long t0 = __builtin_amdgcn_s_memrealtime(); unsigned polls = 0;
            while ((unsigned)__builtin_amdgcn_readfirstlane(__hip_atomic_load(ready + 64 * u.pm, __ATOMIC_RELAXED, __HIP_MEMORY_SCOPE_AGENT)) < need) {
                if ((++polls & 255u) == 0u && __builtin_amdgcn_readfirstlane(__hip_atomic_load(tmo, __ATOMIC_RELAXED, __HIP_MEMORY_SCOPE_AGENT)) != 0u) break;
                if (__builtin_amdgcn_s_memrealtime() - t0 > 2000000ull) {
                    if (threadIdx.x == 0) { unsigned expect = 0u; __hip_atomic_compare_exchange_strong(tmo + 1, &expect, 0x600u | (unsigned)(u.pm & 0xff), __ATOMIC_RELAXED, __ATOMIC_RELAXED, __HIP_MEMORY_SCOPE_AGENT); __hip_atomic_store(tmo, 1u, __ATOMIC_RELAXED, __HIP_MEMORY_SCOPE_AGENT); }
                    break; }
                __builtin_amdgcn_s_sleep(2); }
            __builtin_amdgcn_fence(__ATOMIC_ACQUIRE, "agent");
            asm volatile("s_waitcnt vmcnt(0)" ::: "memory");
        }
#if !defined(BROKEN_HOOK_NO_BARRIER)
        asm volatile("" ::: "memory"); __builtin_amdgcn_s_barrier(); asm volatile("" ::: "memory");
#endif
    }
};

__device__ __forceinline__ unsigned cvt_pk_bf16(float lo, float hi) { unsigned r; asm volatile("v_cvt_pk_bf16_f32 %0, %1, %2" : "=v"(r) : "v"(lo), "v"(hi)); return r; }
typedef float f32x2 __attribute__((ext_vector_type(2)));
__device__ __forceinline__ f32x2 gelu_pk(f32x2 v) {
    const f32x2 av = __builtin_elementwise_abs(v), d = av * 0.2316418882f + 1.0f;
    f32x2 t; t.x = __builtin_amdgcn_rcpf(d.x); t.y = __builtin_amdgcn_rcpf(d.y);
    f32x2 q = t * 0.5307027145f + (-0.7265760135f); q = q * t + 0.7107068705f; q = q * t + (-0.142248368f); q = q * t + 0.127414796f; q = q * t;
    const f32x2 s = (v * v) * (-0.72134752044f);
    f32x2 e; e.x = __builtin_amdgcn_exp2f(s.x); e.y = __builtin_amdgcn_exp2f(s.y);
    const f32x2 m = v * (q * e), r = v - m;
    f32x2 o; o.x = v.x < 0.f ? m.x : r.x; o.y = v.y < 0.f ? m.y : r.y; return o;
}

struct EpiF32 {
    static constexpr bool PERM = false, AFTER_DRAIN = false;
    float* C; int ldc; const float* bias;
    __device__ __forceinline__ void operator()(const f32x4 (&acc)[2][2][4][2], const Unit& u, int wr, int wc, int fr, int fq) const {
        const int row0 = u.pm * BM + wr * 64 + fr, col0 = u.pn * BM + wc * 32 + 4 * fq;
        f32x4 bv[2][2];
#pragma unroll
        for (int bj = 0; bj < 2; ++bj)
#pragma unroll
            for (int n = 0; n < 2; ++n) bv[bj][n] = bias ? *(const f32x4*)(bias + col0 + bj * HALF + n * 16) : (f32x4){0.f, 0.f, 0.f, 0.f};
#pragma unroll
        for (int ai = 0; ai < 2; ++ai)
#pragma unroll
            for (int m = 0; m < 4; ++m) { float* rowp = C + (size_t)(row0 + ai * HALF + m * 16) * ldc + col0;
#pragma unroll
                for (int bj = 0; bj < 2; ++bj)
#pragma unroll
                    for (int n = 0; n < 2; ++n) *(f32x4*)(rowp + bj * HALF + n * 16) = acc[ai][bj][m][n] + bv[bj][n]; }
    }
};
template <int ACT  > struct EpiBf16 {
    static constexpr bool PERM = true, AFTER_DRAIN = false;
    bf16_t* O; int ldc; const float* bias; int split_cols; size_t split_stride;
    __device__ __forceinline__ void operator()(const f32x4 (&acc)[2][2][4][2], const Unit& u, int wr, int wc, int fr, int fq) const {
        const int row0 = u.pm * BM + wr * 64 + fr; int colt = u.pn * BM; bf16_t* base = O;
        if (split_cols) { const int t = colt / split_cols; base += (size_t)t * split_stride; colt -= t * split_cols; }
        const int col0 = colt + wc * 32 + 8 * fq, bcol0 = u.pn * BM + wc * 32 + 8 * fq;
        f32x4 bv[2][2];
#pragma unroll
        for (int bj = 0; bj < 2; ++bj)
#pragma unroll
            for (int n = 0; n < 2; ++n) bv[bj][n] = bias ? *(const f32x4*)(bias + bcol0 + bj * HALF + 4 * n) : (f32x4){0.f, 0.f, 0.f, 0.f};
#pragma unroll
        for (int ai = 0; ai < 2; ++ai)
#pragma unroll
            for (int m = 0; m < 4; ++m) { bf16_t* rowp = base + (size_t)(row0 + ai * HALF + m * 16) * ldc + col0;
#pragma unroll
                for (int bj = 0; bj < 2; ++bj) { f32x4 v0 = acc[ai][bj][m][0] + bv[bj][0], v1 = acc[ai][bj][m][1] + bv[bj][1];
                    if (ACT == 1) { f32x2 a = gelu_pk((f32x2){v0[0], v0[1]}), b = gelu_pk((f32x2){v0[2], v0[3]}), c = gelu_pk((f32x2){v1[0], v1[1]}), d = gelu_pk((f32x2){v1[2], v1[3]});
                        v0 = (f32x4){a.x, a.y, b.x, b.y}; v1 = (f32x4){c.x, c.y, d.x, d.y}; }
                    if (ACT == 2) {
#pragma unroll
                        for (int j = 0; j < 4; ++j) { v0[j] = 0.5f * v0[j] * (1.0f + erff(v0[j] * 0.70710678f)); v1[j] = 0.5f * v1[j] * (1.0f + erff(v1[j] * 0.70710678f)); } }
                    u32x4 w; w.x = cvt_pk_bf16(v0[0], v0[1]); w.y = cvt_pk_bf16(v0[2], v0[3]); w.z = cvt_pk_bf16(v1[0], v1[1]); w.w = cvt_pk_bf16(v1[2], v1[3]);
                    *(u32x4*)(rowp + bj * HALF) = w; } }
    }
};

struct PanelStats {
    unsigned* xbuf;
    unsigned* cnt;
    unsigned* tmo;
    int ntn; float eps;
    unsigned code;
    __device__ __forceinline__ bool run(const f32x4 (&v)[2][2][4][2], const Unit& u, int wr, int wc, int fr, int fq, PG8_LAS unsigned char* lds, int wid, int lane) const {
        typedef float f32x2v __attribute__((ext_vector_type(2)));
        PG8_LAS f32x2v* P = (PG8_LAS f32x2v*)lds;
        PG8_LAS f32x2v* S = (PG8_LAS f32x2v*)(lds + 8192);
        PG8_LAS unsigned* flag = (PG8_LAS unsigned*)(lds + 8192 + 2048);
#pragma unroll
        for (int ai = 0; ai < 2; ++ai)
#pragma unroll
            for (int m = 0; m < 4; ++m) {
                float s = 0.f;
#pragma unroll
                for (int bj = 0; bj < 2; ++bj)
#pragma unroll
                    for (int n = 0; n < 2; ++n) { const f32x4 x = v[ai][bj][m][n]; s += (x[0] + x[1]) + (x[2] + x[3]); }
                s += __shfl_xor(s, 16); s += __shfl_xor(s, 32);
                const float mw = s * (1.0f / 64.0f); float q = 0.f;
#pragma unroll
                for (int bj = 0; bj < 2; ++bj)
#pragma unroll
                    for (int n = 0; n < 2; ++n) { const f32x4 d = v[ai][bj][m][n] - mw; q += (d[0] * d[0] + d[1] * d[1]) + (d[2] * d[2] + d[3] * d[3]); }
                q += __shfl_xor(q, 16); q += __shfl_xor(q, 32);
                if (fq == 0) P[(ai * HALF + wr * 64 + m * 16 + fr) * 4 + wc] = (f32x2v){mw, q};
            }
        asm volatile("s_waitcnt lgkmcnt(0)" ::: "memory"); __builtin_amdgcn_s_barrier(); asm volatile("" ::: "memory");
#if defined(BROKEN_NO_WAIT)
        if (blockIdx.x >= 64) { const long long t0 = clock64(); while (clock64() - t0 < 60000) __builtin_amdgcn_s_sleep(8); }
#endif
        const int row = wid * 32 + (lane & 31);
        if (lane < 32) {
            const f32x2v a = P[row * 4 + 0], b = P[row * 4 + 1], c = P[row * 4 + 2], d = P[row * 4 + 3];
            const float mt = (a.x + b.x + c.x + d.x) * 0.25f;
            const float da = a.x - mt, db = b.x - mt, dc = c.x - mt, dd = d.x - mt;
            const float m2 = (a.y + b.y) + (c.y + d.y) + 64.0f * ((da * da + db * db) + (dc * dc + dd * dd));
            unsigned long long* slot = (unsigned long long*)xbuf + ((size_t)(u.pm * BM + row) * 4 + u.pn);
            __hip_atomic_store(slot, ((unsigned long long)__float_as_uint(m2) << 32) | __float_as_uint(mt), __ATOMIC_RELAXED, __HIP_MEMORY_SCOPE_AGENT);
        }
        asm volatile("s_waitcnt vmcnt(0)" ::: "memory");
        if (lane == 0) __hip_atomic_fetch_add(cnt + 64 * u.pm, 1u, __ATOMIC_RELAXED, __HIP_MEMORY_SCOPE_AGENT);
        if (wid == 0) {
            bool dead = false; const unsigned long long t0 = __builtin_amdgcn_s_memrealtime(); const unsigned want = 8u * (unsigned)ntn;
            for (;;) {
#if defined(BROKEN_NO_WAIT)
                break;
#endif
                if ((unsigned)__builtin_amdgcn_readfirstlane(__hip_atomic_load(cnt + 64 * u.pm, __ATOMIC_RELAXED, __HIP_MEMORY_SCOPE_AGENT)) >= want) break;
                if (__builtin_amdgcn_s_memrealtime() - t0 > 2000000ull) {
                    if (lane == 0) { unsigned expect = 0u; __hip_atomic_compare_exchange_strong(tmo + 1, &expect, code | (unsigned)(u.pm & 0xff), __ATOMIC_RELAXED, __ATOMIC_RELAXED, __HIP_MEMORY_SCOPE_AGENT);
                                     __hip_atomic_store(tmo, 1u, __ATOMIC_RELAXED, __HIP_MEMORY_SCOPE_AGENT); }
                    dead = true; break; }
                __builtin_amdgcn_s_sleep(2);
            }
            __builtin_amdgcn_fence(__ATOMIC_ACQUIRE, "agent");
            if (lane == 0) flag[0] = dead ? 1u : 0u;
        }
        asm volatile("s_waitcnt vmcnt(0) lgkmcnt(0)" ::: "memory"); __builtin_amdgcn_s_barrier(); asm volatile("" ::: "memory");
        const bool bad = flag[0] != 0u;
        if (lane < 32) {
            const unsigned long long* slot = (const unsigned long long*)xbuf + (size_t)(u.pm * BM + row) * 4; float mt[4], m2[4]; float ms = 0.f;
#pragma unroll
            for (int t = 0; t < 4; ++t) { if (t < ntn) { const unsigned long long w = __hip_atomic_load(slot + t, __ATOMIC_RELAXED, __HIP_MEMORY_SCOPE_AGENT); mt[t] = __uint_as_float((unsigned)w); m2[t] = __uint_as_float((unsigned)(w >> 32)); } else { mt[t] = 0.f; m2[t] = 0.f; } ms += mt[t]; }
            const float mean = ms / (float)ntn; float q = 0.f;
#pragma unroll
            for (int t = 0; t < 4; ++t) if (t < ntn) { const float dm = mt[t] - mean; q += m2[t] + 256.0f * dm * dm; }
            S[row] = (f32x2v){mean, 1.0f / sqrtf(q / (256.0f * (float)ntn) + eps)};
        }
        asm volatile("s_waitcnt lgkmcnt(0)" ::: "memory"); __builtin_amdgcn_s_barrier(); asm volatile("" ::: "memory");
        return bad;
    }
};
struct EpiLnRes {
    static constexpr bool PERM = false, AFTER_DRAIN = true;
    const float* base; float* out; int ldc; const float* bias; PanelStats st; unsigned poison;
    __device__ __forceinline__ void refuse(size_t i0, size_t stride, int M, int N) const { const float q = __builtin_nanf(""); for (size_t i = i0; i < (size_t)M * N; i += stride) out[(i / N) * ldc + i % N] = q;
        if (i0 == 0) { unsigned expect = 0u; __hip_atomic_compare_exchange_strong(st.tmo + 1, &expect, 0x7f0u, __ATOMIC_RELAXED, __ATOMIC_RELAXED, __HIP_MEMORY_SCOPE_AGENT); __hip_atomic_store(st.tmo, 1u, __ATOMIC_RELAXED, __HIP_MEMORY_SCOPE_AGENT); } }
    __device__ __forceinline__ void fused(f32x4 (&acc)[2][2][4][2], const Unit& u, int wr, int wc, int fr, int fq, PG8_LAS unsigned char* lds, int wid, int lane) const {
        typedef float f32x2v __attribute__((ext_vector_type(2)));
        const PG8_LAS f32x2v* S = (const PG8_LAS f32x2v*)(lds + 8192);
        const int col0 = u.pn * BM + wc * 32 + 4 * fq;
#pragma unroll
        for (int bj = 0; bj < 2; ++bj)
#pragma unroll
            for (int n = 0; n < 2; ++n) { const f32x4 bv = bias ? *(const f32x4*)(bias + col0 + bj * HALF + n * 16) : (f32x4){0.f, 0.f, 0.f, 0.f};
#pragma unroll
                for (int ai = 0; ai < 2; ++ai)
#pragma unroll
                    for (int m = 0; m < 4; ++m) acc[ai][bj][m][n] += bv; }
        const bool bad = st.run(acc, u, wr, wc, fr, fq, lds, wid, lane) || poison != 0u;
        const float qnan = __builtin_nanf("");
#pragma unroll
        for (int ai = 0; ai < 2; ++ai)
#pragma unroll
            for (int m = 0; m < 4; ++m) { const int r = ai * HALF + wr * 64 + m * 16 + fr; const f32x2v sr = S[r]; const size_t off = (size_t)(u.pm * BM + r) * ldc + col0;
#pragma unroll
                for (int bj = 0; bj < 2; ++bj)
#pragma unroll
                    for (int n = 0; n < 2; ++n) { const f32x4 bs = *(const f32x4*)(base + off + bj * HALF + n * 16); f32x4 o = bs + (acc[ai][bj][m][n] - sr.x) * sr.y;
                        if (bad) o = (f32x4){qnan, qnan, qnan, qnan}; *(f32x4*)(out + off + bj * HALF + n * 16) = o; }
                asm volatile("" ::: "memory"); }
    }
};
struct EpiLnResLn {
    static constexpr bool PERM = false, AFTER_DRAIN = true;
    const float* base; float* out; bf16_t* xn; int ldc; const float* bias; PanelStats st1, st2; unsigned poison;
    __device__ __forceinline__ void refuse(size_t i0, size_t stride, int M, int N) const { const float q = __builtin_nanf(""); for (size_t i = i0; i < (size_t)M * N; i += stride) { const size_t o = (i / N) * ldc + i % N; out[o] = q; xn[o] = (bf16_t)0x7fc0u; }
        if (i0 == 0) { unsigned expect = 0u; __hip_atomic_compare_exchange_strong(st1.tmo + 1, &expect, 0x7f0u, __ATOMIC_RELAXED, __ATOMIC_RELAXED, __HIP_MEMORY_SCOPE_AGENT); __hip_atomic_store(st1.tmo, 1u, __ATOMIC_RELAXED, __HIP_MEMORY_SCOPE_AGENT); } }
    __device__ __forceinline__ void fused(f32x4 (&acc)[2][2][4][2], const Unit& u, int wr, int wc, int fr, int fq, PG8_LAS unsigned char* lds, int wid, int lane) const {
        typedef float f32x2v __attribute__((ext_vector_type(2))); typedef unsigned u32x2v __attribute__((ext_vector_type(2)));
        const PG8_LAS f32x2v* S = (const PG8_LAS f32x2v*)(lds + 8192);
        const int col0 = u.pn * BM + wc * 32 + 4 * fq;
#pragma unroll
        for (int bj = 0; bj < 2; ++bj)
#pragma unroll
            for (int n = 0; n < 2; ++n) { const f32x4 bv = bias ? *(const f32x4*)(bias + col0 + bj * HALF + n * 16) : (f32x4){0.f, 0.f, 0.f, 0.f};
#pragma unroll
                for (int ai = 0; ai < 2; ++ai)
#pragma unroll
                    for (int m = 0; m < 4; ++m) acc[ai][bj][m][n] += bv; }
        bool bad = st1.run(acc, u, wr, wc, fr, fq, lds, wid, lane) || poison != 0u;
        const float qnan = __builtin_nanf("");
#pragma unroll
        for (int ai = 0; ai < 2; ++ai)
#pragma unroll
            for (int m = 0; m < 4; ++m) { const int r = ai * HALF + wr * 64 + m * 16 + fr; const f32x2v sr = S[r]; const size_t off = (size_t)(u.pm * BM + r) * ldc + col0;
#pragma unroll
                for (int bj = 0; bj < 2; ++bj)
#pragma unroll
                    for (int n = 0; n < 2; ++n) { const f32x4 bs = *(const f32x4*)(base + off + bj * HALF + n * 16); acc[ai][bj][m][n] = bs + (acc[ai][bj][m][n] - sr.x) * sr.y; }
                asm volatile("" : "+v"(acc[ai][0][m][0]), "+v"(acc[ai][0][m][1]), "+v"(acc[ai][1][m][0]), "+v"(acc[ai][1][m][1]));
                if (m & 1) asm volatile("" ::: "memory"); }
        const bool bad1 = bad;
        bad = st2.run(acc, u, wr, wc, fr, fq, lds, wid, lane) || bad;
#pragma unroll
        for (int ai = 0; ai < 2; ++ai)
#pragma unroll
            for (int m = 0; m < 4; ++m) { const int r = ai * HALF + wr * 64 + m * 16 + fr; const f32x2v sr = S[r]; const size_t off = (size_t)(u.pm * BM + r) * ldc + col0;
#pragma unroll
                for (int bj = 0; bj < 2; ++bj)
#pragma unroll
                    for (int n = 0; n < 2; ++n) { const f32x4 x1 = acc[ai][bj][m][n]; *(f32x4*)(out + off + bj * HALF + n * 16) = bad1 ? (f32x4){qnan, qnan, qnan, qnan} : x1;
                        const f32x4 o = (x1 - sr.x) * sr.y; u32x2v w; w.x = cvt_pk_bf16(o[0], o[1]); w.y = cvt_pk_bf16(o[2], o[3]);
                        if (bad) { w.x = 0x7fc07fc0u; w.y = 0x7fc07fc0u; } *(u32x2v*)(xn + off + bj * HALF + n * 16) = w; }
                asm volatile("" ::: "memory"); }
    }
};

template <class Epi, class Sched, bool STAMP = false>
__device__ __forceinline__ void gemm_phase(PG8_LAS unsigned char* lds, const Gemm g, const Sched& S, const Epi& E, unsigned long long* stamps) {
    const int tid = threadIdx.x, wid = __builtin_amdgcn_readfirstlane(tid >> 6), lane = tid & 63, wr = wid >> 2, wc = wid & 3, fr = lane & 15, fq = lane >> 4;
    const int K = g.K, nt = K / BK;
    int ts_lo = 0, ts_hi = 0, nts = 0; const unsigned long long rt_entry = STAMP ? (unsigned long long)wall_clock64() : 0ull;
#define PG8_STAMP() do { if (STAMP && wid == 0 && nts < 64) { const unsigned long long _c = (unsigned long long)clock64(); \
        ts_lo = (lane == nts) ? (int)(unsigned)_c : ts_lo; ts_hi = (lane == nts) ? (int)(unsigned)(_c >> 32) : ts_hi; ++nts; } } while (0)
    PG8_STAMP();
    unsigned voffA[2], voffB[2];
#pragma unroll
    for (int i = 0; i < 2; ++i) { int R, C; stage_rc(tid * 16 + i * 8192, R, C); const int Rb = Epi::PERM ? ((R & ~31) + perm32(R & 31)) : R;
        voffA[i] = (unsigned)(R * K + C) * 2u; voffB[i] = (unsigned)(Rb * K + C) * 2u; }
    const size_t kstep = (size_t)(BK * 2);
    const size_t hstep = (size_t)HALF * K * 2;
    const size_t tstep = 2 * hstep;
    const unsigned ldsw = (unsigned)wid * 1024u;
    const int aoff = lds_byte(wr * 64 + fr, fq * 8), boff = lds_byte(wc * 32 + fr, fq * 8);
#define PG8_SA(b, h) (((b) * 2 + (h)) * HTB)
#define PG8_SB(b, h) ((4 + (b) * 2 + (h)) * HTB)
#define PG8_STAGE(bufoff, gbase, voff) do { _Pragma("unroll") for (int _i = 0; _i < 2; ++_i) \
        __builtin_amdgcn_global_load_lds((const unsigned*)((const char*)(gbase) + (voff)[_i]), (PG8_LAS unsigned*)(lds + (bufoff) + ldsw + _i * 8192), 16, 0, 0); } while (0)
#define PG8_LDA(dst, b, h) do { _Pragma("unroll") for (int m = 0; m < 4; ++m) _Pragma("unroll") for (int k = 0; k < 2; ++k) dst[m][k] = *(const PG8_LAS bf16x8*)(lds + PG8_SA(b, h) + aoff + m * 2048 + k * 1024); } while (0)
#define PG8_LDB(dst, b, h) do { _Pragma("unroll") for (int n = 0; n < 2; ++n) _Pragma("unroll") for (int k = 0; k < 2; ++k) dst[n][k] = *(const PG8_LAS bf16x8*)(lds + PG8_SB(b, h) + boff + n * 2048 + k * 1024); } while (0)
#define PG8_MMA(ai, bj, At, Bt) do { __builtin_amdgcn_s_setprio(1); _Pragma("unroll") for (int m = 0; m < 4; ++m) _Pragma("unroll") for (int n = 0; n < 2; ++n) _Pragma("unroll") for (int k = 0; k < 2; ++k) \
        acc[ai][bj][m][n] = __builtin_amdgcn_mfma_f32_16x16x32_bf16(Bt[n][k], At[m][k], acc[ai][bj][m][n], 0, 0, 0); __builtin_amdgcn_s_setprio(0); } while (0)
#define PG8_WAIT_V(n) asm volatile("s_waitcnt vmcnt(" #n ")" ::: "memory")
#define PG8_WAIT_L(n) asm volatile("s_waitcnt lgkmcnt(" #n ")" ::: "memory")
#define PG8_BAR __builtin_amdgcn_s_barrier()
#define PG8_SCHED __builtin_amdgcn_sched_barrier(0)
    Unit cur, nxt; int ui = 0;
    if (!S.next(0, cur)) return;
    f32x4 acc[2][2][4][2];
#pragma unroll
    for (int a = 0; a < 2; ++a)
#pragma unroll
        for (int b = 0; b < 2; ++b)
#pragma unroll
            for (int m = 0; m < 4; ++m)
#pragma unroll
                for (int n = 0; n < 2; ++n) acc[a][b][m][n] = (f32x4){0.f, 0.f, 0.f, 0.f};
    bf16x8 At[4][2], B0[2][2], B1[2][2];
    const char* cA = (const char*)g.A + (size_t)cur.pm * tstep; const char* cB = (const char*)g.Bt + (size_t)cur.pn * tstep;
    S.a_ready(cur);
    PG8_STAGE(PG8_SB(0, 0), cB, voffB); PG8_STAGE(PG8_SA(0, 0), cA, voffA); PG8_STAGE(PG8_SB(0, 1), cB + hstep, voffB); PG8_STAGE(PG8_SA(0, 1), cA + hstep, voffA);
    if (wr == 1) PG8_BAR;
    PG8_WAIT_V(4); PG8_BAR;
    PG8_STAGE(PG8_SB(1, 0), cB + kstep, voffB); PG8_STAGE(PG8_SA(1, 0), cA + kstep, voffA); PG8_STAGE(PG8_SB(1, 1), cB + hstep + kstep, voffB);
    PG8_WAIT_V(6); PG8_BAR;
    PG8_STAMP();
    for (;;) {
        const bool has_next = S.next(ui + 1, nxt);
        const char* nA = has_next ? (const char*)g.A + (size_t)nxt.pm * tstep : cA; const char* nB = has_next ? (const char*)g.Bt + (size_t)nxt.pn * tstep : cB;
        for (int t = 0; t < nt; t += 2) {
            const bool last = (t == nt - 2);
            const char* a1 = cA + (size_t)(t + 1) * kstep;
            const char* a2 = last ? nA : cA + (size_t)(t + 2) * kstep; const char* b2 = last ? nB : cB + (size_t)(t + 2) * kstep;
            const char* a3 = a2 + kstep; const char* b3 = b2 + kstep;
            if (last && has_next) S.a_ready(nxt);
            PG8_LDB(B0, 0, 0); PG8_SCHED; PG8_LDA(At, 0, 0); PG8_STAGE(PG8_SA(1, 1), a1 + hstep, voffA);
            PG8_WAIT_L(8); PG8_BAR; PG8_WAIT_L(0); PG8_MMA(0, 0, At, B0); PG8_BAR; PG8_SCHED;
            PG8_LDB(B1, 0, 1); PG8_STAGE(PG8_SB(0, 0), b2, voffB);
            PG8_BAR; PG8_WAIT_L(0); PG8_MMA(0, 1, At, B1); PG8_BAR;
            PG8_LDA(At, 0, 1); PG8_STAGE(PG8_SA(0, 0), a2, voffA);
            PG8_BAR; PG8_WAIT_L(0); PG8_MMA(1, 0, At, B0); PG8_BAR; PG8_SCHED;
            PG8_STAGE(PG8_SB(0, 1), b2 + hstep, voffB);
            PG8_WAIT_V(6); PG8_BAR; PG8_MMA(1, 1, At, B1); PG8_BAR;
            PG8_LDB(B0, 1, 0); PG8_SCHED; PG8_LDA(At, 1, 0); PG8_STAGE(PG8_SA(0, 1), a2 + hstep, voffA);
            PG8_WAIT_L(8); PG8_BAR; PG8_WAIT_L(0); PG8_MMA(0, 0, At, B0); PG8_BAR; PG8_SCHED;
            PG8_LDB(B1, 1, 1); PG8_STAGE(PG8_SB(1, 0), b3, voffB);
            PG8_BAR; PG8_WAIT_L(0); PG8_MMA(0, 1, At, B1); PG8_BAR;
            PG8_LDA(At, 1, 1); PG8_STAGE(PG8_SA(1, 0), a3, voffA);
            PG8_BAR; PG8_WAIT_L(0); PG8_MMA(1, 0, At, B0); PG8_BAR; PG8_SCHED;
            PG8_STAGE(PG8_SB(1, 1), b3 + hstep, voffB);
            PG8_WAIT_V(6); PG8_BAR; PG8_MMA(1, 1, At, B1); PG8_BAR;
        }
        PG8_STAMP();
        if constexpr (!Epi::AFTER_DRAIN) { E(acc, cur, wr, wc, fr, fq); S.done(cur); }
        PG8_STAMP();
        if (!has_next) break;
#pragma unroll
        for (int a = 0; a < 2; ++a)
#pragma unroll
            for (int b = 0; b < 2; ++b)
#pragma unroll
                for (int m = 0; m < 4; ++m)
#pragma unroll
                    for (int n = 0; n < 2; ++n) acc[a][b][m][n] = (f32x4){0.f, 0.f, 0.f, 0.f};
        cur = nxt; cA = nA; cB = nB; ++ui;
    }
    PG8_WAIT_V(0);
    if (wr == 0) PG8_BAR;
    PG8_BAR;
    if constexpr (Epi::AFTER_DRAIN) { E.fused(acc, cur, wr, wc, fr, fq, lds, wid, lane); S.done(cur); }
    PG8_STAMP();
    if (STAMP && wid == 0) { stamps[lane] = lane < nts ? (((unsigned long long)(unsigned)ts_hi << 32) | (unsigned)ts_lo) : 0ull;
        if (lane == 62) stamps[62] = rt_entry; if (lane == 63) stamps[63] = (unsigned long long)wall_clock64(); }
#undef PG8_STAMP
#undef PG8_SA
#undef PG8_SB
#undef PG8_STAGE
#undef PG8_LDA
#undef PG8_LDB
#undef PG8_MMA
#undef PG8_WAIT_V
#undef PG8_WAIT_L
#undef PG8_BAR
#undef PG8_SCHED
}
}
#define XB_TMO      128
#define XB_XCNT(j)  (256  + 64 * (j))
#define XB_XSUB(j)  (1280 + 64 * (j))
#define XB_XGEN(j)  (2304 + 64 * (j))
#define XB_TOP      3328
#define XB_TOPGEN   3392
#define XCD_BAR_WORDS 3456
#define XB_SPIN_CAP (1u << 18)
#define LAS __attribute__((address_space(3)))

__device__ __forceinline__ unsigned xb_ld(unsigned* p)              { return __hip_atomic_load(p, __ATOMIC_RELAXED, __HIP_MEMORY_SCOPE_AGENT); }
__device__ __forceinline__ unsigned xb_add(unsigned* p, unsigned v) { return __hip_atomic_fetch_add(p, v, __ATOMIC_RELAXED, __HIP_MEMORY_SCOPE_AGENT); }
__device__ __forceinline__ unsigned xb_xcc_id() { return (unsigned)__builtin_amdgcn_s_getreg((3 << 11) | 20) & 0xFu; }
#define XB_SPIN(cond, bar) do { unsigned _sp = 0; while (cond) { __builtin_amdgcn_s_sleep(1); \
    if ((++_sp & 255u) == 0u) { if (xb_ld(&(bar)[XB_TMO])) break; if (_sp > XB_SPIN_CAP) { atomicAdd(&(bar)[XB_TMO], 1u); break; } } } } while (0)

struct XcdBarrier {
    unsigned* bar; unsigned x;
    volatile LAS unsigned* st;
};

__device__ __forceinline__ XcdBarrier xcd_barrier_post(unsigned* bar, volatile LAS unsigned* st) {
    XcdBarrier b; b.bar = bar; b.x = xb_xcc_id(); b.st = st;
    if (threadIdx.x == 0) (void)xb_add(&bar[XB_XCNT(b.x)], 1u);
    return b;
}
__device__ __forceinline__ void xcd_barrier_complete(unsigned* bar, unsigned x, unsigned& nloc, unsigned& nx) {
    const unsigned G = gridDim.x * gridDim.y * gridDim.z;
    unsigned sum, cnt, mine, sp = 0u;
    for (;;) {
        sum = 0u; cnt = 0u; mine = 0u;
#pragma unroll
        for (unsigned j = 0; j < 16; ++j) { const unsigned c = xb_ld(&bar[XB_XCNT(j)]); sum += c; cnt += (c > 0u) ? 1u : 0u; mine = (j == x) ? c : mine; }
        if (sum == G) break;
        __builtin_amdgcn_s_sleep(1);
        if ((++sp & 255u) == 0u) { if (xb_ld(&bar[XB_TMO])) break; if (sp > XB_SPIN_CAP) { atomicAdd(&bar[XB_TMO], 1u); break; } }
    }
    nloc = mine > 0u ? mine : 1u; nx = cnt > 0u ? cnt : 1u;
}

__device__ __forceinline__ void xcd_barrier(const XcdBarrier& b) {
    asm volatile("s_waitcnt vmcnt(0)" ::: "memory");
    __syncthreads();
    if (threadIdx.x == 0) {
        unsigned* bar = b.bar;
        __builtin_amdgcn_s_waitcnt(0);
        unsigned nloc = b.st[0], nx = b.st[1];
        if (nloc == 0u) { xcd_barrier_complete(bar, b.x, nloc, nx); b.st[0] = nloc; b.st[1] = nx; }
        const unsigned old = xb_add(&bar[XB_XSUB(b.x)], 1u);
        const unsigned gen = old / nloc;
        if (old + 1u == (gen + 1u) * nloc) {
            __builtin_amdgcn_fence(__ATOMIC_RELEASE, "agent");
            asm volatile("s_waitcnt vmcnt(0)" ::: "memory");
            const unsigned og = xb_add(&bar[XB_TOP], 1u);
            const unsigned tg = og / nx;
            if (og + 1u == (tg + 1u) * nx) xb_add(&bar[XB_TOPGEN], 1u);
            else XB_SPIN(xb_ld(&bar[XB_TOPGEN]) == tg, bar);
            __builtin_amdgcn_fence(__ATOMIC_ACQUIRE, "agent");
            xb_add(&bar[XB_XGEN(b.x)], 1u);
            asm volatile("s_waitcnt vmcnt(0)" ::: "memory");
        } else {
            XB_SPIN(xb_ld(&bar[XB_XGEN(b.x)]) == gen, bar);
            __builtin_amdgcn_fence(__ATOMIC_ACQUIRE, "agent");
            asm volatile("s_waitcnt vmcnt(0)" ::: "memory");
        }
    }
    __syncthreads();
}


namespace mk {
typedef unsigned short bf16_t;
typedef float f32x4 __attribute__((ext_vector_type(4)));
typedef short bf16x8 __attribute__((ext_vector_type(8)));
typedef short s16x4 __attribute__((ext_vector_type(4)));
typedef unsigned u32x4 __attribute__((ext_vector_type(4)));
typedef unsigned u32x2 __attribute__((ext_vector_type(2)));
typedef float f32x2 __attribute__((ext_vector_type(2)));
constexpr int D = 2048, NTOK_P = 16384, NTOK_S = 256, NTOK = 16640;
constexpr int DIN = 5632, DATT = 1536, DLRU = 512, NH = 12, HD = 128;
constexpr int NEXP = 16384;
constexpr float ALPHA = 1.189207115002721f;
constexpr float LN_EPS = 1e-5f;
constexpr float ATT_SCALE = 0.08838834764831845f;
constexpr float LOG2E = 1.4426950408889634f;
constexpr size_t O_YP = 0, O_YS = 33554432, O_KP = 34078720, O_VP = 59244544, O_CP = 84410368, O_HP = 84422656,
                 O_KS = 84426752, O_VS = 185090048, O_CS = 285753344, O_HS = 285802496, O_END = 285818880;
constexpr size_t WS_CTL = 0;
constexpr size_t WS_XB = 65536;
constexpr size_t WS_WINT = WS_XB + (size_t)NTOK * D * 2;
constexpr size_t WS_WOT = WS_WINT + (size_t)DIN * D * 2;
constexpr size_t WS_WQT = WS_WOT + (size_t)D * D * 2;
constexpr size_t WS_UB = WS_WQT + (size_t)D * D * 2;
constexpr size_t WS_VB = WS_UB + (size_t)NEXP * D * 2;
constexpr size_t WS_QF = WS_VB + (size_t)NEXP * D * 2;
constexpr size_t WS_XR = WS_QF + (size_t)NTOK * DATT * 4;
constexpr size_t WS_GATE = WS_XR + (size_t)NTOK * DLRU * 4;
constexpr size_t WS_AR = WS_GATE + (size_t)NTOK * DLRU * 4;
constexpr size_t WS_PRE1 = WS_AR + (size_t)NTOK * D * 2;
constexpr size_t WS_X1F = WS_PRE1 + (size_t)NTOK * D * 4;
constexpr size_t WS_X1B = WS_X1F + (size_t)NTOK * D * 4;
constexpr size_t WS_QP = WS_X1B + (size_t)NTOK * D * 2;
constexpr size_t WS_EIDX = WS_QP + (size_t)NTOK * D * 4;
constexpr size_t WS_GW = WS_EIDX + (size_t)NTOK * 128 * 4;
constexpr size_t WS_SU = WS_GW + (size_t)NTOK * 128 * 4;
constexpr size_t WS_SV = WS_SU + (size_t)NEXP * 4;
constexpr size_t WS_SX = WS_SV + (size_t)NEXP * 4;
constexpr size_t WS_X1Q = WS_SX + (size_t)NTOK * 4;
constexpr size_t WS_SKB = WS_X1Q + (size_t)NTOK * D;
constexpr size_t WS_QB = WS_SKB + (size_t)8 * 2 * 128 * 128 * 2;
constexpr size_t WS_KB = WS_QB + (size_t)NTOK * DATT * 2;
constexpr size_t WS_VB16 = WS_KB + (size_t)NTOK_P * DATT * 2;
constexpr size_t WS_PO = WS_VB16 + (size_t)NTOK_P * DATT * 2;
constexpr size_t WS_PM = WS_PO + (size_t)2 * NTOK_P * DATT * 2;
constexpr size_t WS_PL = WS_PM + (size_t)2 * NTOK_P * NH * 4;
constexpr size_t WS_R0 = WS_PL + (size_t)2 * NTOK_P * NH * 4;
constexpr size_t WS_R1 = WS_R0 + (size_t)NTOK_P * DLRU * 4;
constexpr size_t WS_HE = WS_R1 + (size_t)NTOK_P * DLRU * 4;
constexpr size_t WS_AE = WS_HE + (size_t)8 * 32 * 512 * 4;
constexpr size_t WS_PS = WS_AE + (size_t)8 * 32 * 512 * 4;
constexpr size_t WS_END = WS_PS + (size_t)32 * 12 * 9 * 8 * 130 * 4;

constexpr int NTHREADS = 512;
constexpr int LDS_BYTES = 148480;
constexpr int MISC_OFF = 147456;

struct Params {
    const float* x_prompt; const float* x_sample; const float* cache_k; const float* cache_v; const float* state_conv; const float* state_h;
    const float* w_in; const float* conv_w; const float* conv_b; const float* lru_w_a; const float* lru_b_a; const float* lru_w_x; const float* lru_b_x;
    const float* lru_lambda; const float* w_out; const float* ln1_g; const float* ln1_b; const float* w_query; const float* sub_keys;
    const float* peer_u; const float* peer_v; const float* ln2_g; const float* ln2_b;
    float* out; unsigned char* ws; int ph_lo, ph_hi;
};

__device__ __forceinline__ unsigned f2bf(float f) { unsigned u = __float_as_uint(f); u += 0x7fffu + ((u >> 16) & 1u); return u >> 16; }
__device__ __forceinline__ unsigned pack2(float a, float b) { return f2bf(a) | (f2bf(b) << 16); }
__device__ __forceinline__ float bflo(unsigned w) { return __uint_as_float(w << 16); }
__device__ __forceinline__ float bfhi(unsigned w) { return __uint_as_float(w & 0xffff0000u); }
__device__ __forceinline__ float wave_sum(float v) {
#pragma unroll
    for (int o = 32; o >= 1; o >>= 1) v += __shfl_xor(v, o);
    return v;
}
__device__ __forceinline__ float wave_max(float v) {
#pragma unroll
    for (int o = 32; o >= 1; o >>= 1) v = fmaxf(v, __shfl_xor(v, o));
    return v;
}
__device__ __forceinline__ float gelu_exact(float v) { return 0.5f * v * (1.0f + erff(v * 0.7071067811865476f)); }
__device__ __forceinline__ float sigmoidf(float v) { return 1.0f / (1.0f + expf(-v)); }
__device__ __forceinline__ float readlane_f(float v, int l) { return __int_as_float(__builtin_amdgcn_readlane(__float_as_int(v), l)); }

__device__ __forceinline__ void convert_flat(const float* src, bf16_t* dst, size_t n8, size_t gtid, size_t gstride) {
    for (size_t i = gtid; i < n8; i += gstride) {
        const float4 a = ((const float4*)src)[2 * i], b = ((const float4*)src)[2 * i + 1];
        uint4 w; w.x = pack2(a.x, a.y); w.y = pack2(a.z, a.w); w.z = pack2(b.x, b.y); w.w = pack2(b.z, b.w);
        ((uint4*)dst)[i] = w;
    }
}
__device__ __forceinline__ void transpose_convert(const float* src, bf16_t* dst, int K, int N, LAS float* tile) {
    const int tid = threadIdx.x, ntn = N / 64, ntiles = (K / 64) * ntn;
    for (int tl = blockIdx.x; tl < ntiles; tl += gridDim.x) {
        const int kt = tl / ntn, nt = tl - kt * ntn;
#pragma unroll
        for (int i = 0; i < 8; ++i) { const int r = (tid >> 6) + 8 * i, c = tid & 63; tile[r * 65 + c] = src[(size_t)(kt * 64 + r) * N + nt * 64 + c]; }
        __syncthreads();
#pragma unroll
        for (int i = 0; i < 4; ++i) { const int n = (tid >> 5) + 16 * i, k0 = 2 * (tid & 31);
            const unsigned v = pack2(tile[k0 * 65 + n], tile[(k0 + 1) * 65 + n]);
            *(unsigned*)(dst + (size_t)(nt * 64 + n) * K + kt * 64 + k0) = v; }
        __syncthreads();
    }
}
constexpr int TROW = 1152;
__device__ __forceinline__ void quant_tables(const Params& P) {
    const int lane = threadIdx.x & 63, gw = blockIdx.x * 8 + (threadIdx.x >> 6), nw = gridDim.x * 8;
    for (int it = gw; it < 2 * NEXP; it += nw) {
        const bool isv = it >= NEXP; const int row = isv ? it - NEXP : it;
        const float* src = (isv ? P.peer_v : P.peer_u) + (size_t)row * D;
        float4 v[8]; float cm[2];
#pragma unroll
        for (int j = 0; j < 2; ++j) { float am = 0.f;
#pragma unroll
            for (int i = 0; i < 4; ++i) { const float4 t = *(const float4*)(src + j * 1024 + lane * 16 + i * 4); v[j * 4 + i] = t; am = fmaxf(am, fmaxf(fmaxf(fabsf(t.x), fabsf(t.y)), fmaxf(fabsf(t.z), fabsf(t.w)))); }
            cm[j] = am; }
        float rm = wave_max(fmaxf(cm[0], cm[1])); if (rm == 0.f) rm = 1.f;
        unsigned char* dst = P.ws + (isv ? WS_VB : WS_UB) + (size_t)row * TROW;
        u32x4 w; unsigned sqp = 0u;
#pragma unroll
        for (int j = 0; j < 2; ++j) {
            int sq = (int)ceilf(cm[j] / rm * 255.0f); sq = sq < 1 ? 1 : (sq > 255 ? 255 : sq);
            sqp |= (unsigned)sq << (8 * j);
            const float inv = (255.0f * 7.0f) / (rm * (float)sq);
#pragma unroll
            for (int hh = 0; hh < 2; ++hh) { unsigned dw = 0u;
#pragma unroll
                for (int e = 0; e < 8; ++e) { const float4 t = v[j * 4 + hh * 2 + (e >> 2)]; const float x = (e & 3) == 0 ? t.x : ((e & 3) == 1 ? t.y : ((e & 3) == 2 ? t.z : t.w));
                    int n = (int)rintf(x * inv); n = n < -7 ? -7 : (n > 7 ? 7 : n); dw |= (unsigned)(n + 8) << (4 * e); }
                w[j * 2 + hh] = dw; }
        }
        *(u32x4*)(dst + lane * 16) = w;
        *(unsigned short*)(dst + 1024 + lane * 2) = (unsigned short)sqp;
        if (lane == 0) ((float*)(P.ws + (isv ? WS_SV : WS_SU)))[row] = rm * (1.0f / (255.0f * 7.0f));
    }
}
__device__ __forceinline__ void phase_prologue(const Params& P, LAS unsigned char* lds) {
    const size_t gtid = (size_t)blockIdx.x * NTHREADS + threadIdx.x, gstride = (size_t)gridDim.x * NTHREADS;
    unsigned char* ws = P.ws;
    convert_flat(P.x_prompt, (bf16_t*)(ws + WS_XB), (size_t)NTOK_P * D / 8, gtid, gstride);
    convert_flat(P.x_sample, (bf16_t*)(ws + WS_XB) + (size_t)NTOK_P * D, (size_t)NTOK_S * D / 8, gtid, gstride);
    quant_tables(P);
    convert_flat(P.sub_keys, (bf16_t*)(ws + WS_SKB), (size_t)8 * 2 * 128 * 128 / 8, gtid, gstride);
    transpose_convert(P.w_in, (bf16_t*)(ws + WS_WINT), D, DIN, (LAS float*)lds);
    transpose_convert(P.w_out, (bf16_t*)(ws + WS_WOT), D, D, (LAS float*)lds);
    transpose_convert(P.w_query, (bf16_t*)(ws + WS_WQT), D, D, (LAS float*)lds);
}

struct EpiProj {
    static constexpr bool PERM = false, AFTER_DRAIN = false;
    float* out; float* QF; float* XR; float* GATE; bf16_t* QB; bf16_t* KB; bf16_t* VB16;
    __device__ __forceinline__ void operator()(const f32x4 (&acc)[2][2][4][2], const pg8::Unit& u, int wr, int wc, int fr, int fq) const {
        const int pn = u.pn; const int coff = wc * 32 + 4 * fq;
#pragma unroll
        for (int ai = 0; ai < 2; ++ai)
#pragma unroll
            for (int m = 0; m < 4; ++m) {
                const int row = u.pm * 256 + ai * 128 + wr * 64 + m * 16 + fr;
                const bool prompt = row < NTOK_P;
                float* rowp = nullptr; bf16_t* rowb = nullptr; float bsc = 1.0f;
                if (pn < 6) { rowb = QB + (size_t)row * DATT + pn * 256; bsc = ATT_SCALE * LOG2E; }
                else if (pn < 18) {
                    const int isv = pn >= 12; const int c0 = (pn - (isv ? 12 : 6)) * 256;
                    if (prompt) { rowp = out + (isv ? O_VP : O_KP) + (size_t)row * DATT + c0; rowb = (isv ? VB16 : KB) + (size_t)row * DATT + c0; }
                    else { const int rr = row - NTOK_P, b = rr >> 3, t = rr & 7; rowp = out + (isv ? O_VS : O_KS) + ((size_t)b * 2048 + 2040 + t) * DATT + c0; }
                } else if (pn < 20) rowp = XR + (size_t)row * DLRU + (pn - 18) * 256;
                else rowp = GATE + (size_t)row * DLRU + (pn - 20) * 256;
#pragma unroll
                for (int bj = 0; bj < 2; ++bj)
#pragma unroll
                    for (int n = 0; n < 2; ++n) {
                        const f32x4 v = acc[ai][bj][m][n];
                        if (rowp) *(f32x4*)(rowp + coff + bj * 128 + n * 16) = v;
                        if (rowb) { u32x2 w; w.x = pg8::cvt_pk_bf16(v[0] * bsc, v[1] * bsc); w.y = pg8::cvt_pk_bf16(v[2] * bsc, v[3] * bsc); *(u32x2*)(rowb + coff + bj * 128 + n * 16) = w; }
                    }
            }
    }
};
struct EpiOut {
    static constexpr bool PERM = false, AFTER_DRAIN = false;
    const float* xp; const float* xs; float* pre;
    __device__ __forceinline__ void operator()(const f32x4 (&acc)[2][2][4][2], const pg8::Unit& u, int wr, int wc, int fr, int fq) const {
        const int col0 = u.pn * 256 + wc * 32 + 4 * fq;
#pragma unroll
        for (int ai = 0; ai < 2; ++ai)
#pragma unroll
            for (int m = 0; m < 4; ++m) {
                const int row = u.pm * 256 + ai * 128 + wr * 64 + m * 16 + fr;
                const float* xr = (row < NTOK_P ? xp + (size_t)row * D : xs + (size_t)(row - NTOK_P) * D) + col0;
                float* pr = pre + (size_t)row * D + col0;
#pragma unroll
                for (int bj = 0; bj < 2; ++bj)
#pragma unroll
                    for (int n = 0; n < 2; ++n) { const f32x4 xv = *(const f32x4*)(xr + bj * 128 + n * 16); *(f32x4*)(pr + bj * 128 + n * 16) = xv * ALPHA + acc[ai][bj][m][n]; }
            }
    }
};
struct EpiPlain {
    static constexpr bool PERM = false, AFTER_DRAIN = false;
    float* C; int ldc;
    __device__ __forceinline__ void operator()(const f32x4 (&acc)[2][2][4][2], const pg8::Unit& u, int wr, int wc, int fr, int fq) const {
        const int col0 = u.pn * 256 + wc * 32 + 4 * fq;
#pragma unroll
        for (int ai = 0; ai < 2; ++ai)
#pragma unroll
            for (int m = 0; m < 4; ++m) {
                const int row = u.pm * 256 + ai * 128 + wr * 64 + m * 16 + fr;
                float* pr = C + (size_t)row * ldc + col0;
#pragma unroll
                for (int bj = 0; bj < 2; ++bj)
#pragma unroll
                    for (int n = 0; n < 2; ++n) *(f32x4*)(pr + bj * 128 + n * 16) = acc[ai][bj][m][n];
            }
    }
};

struct EpiBf16Plain {
    static constexpr bool PERM = false, AFTER_DRAIN = false;
    bf16_t* C; int ldc;
    __device__ __forceinline__ void operator()(const f32x4 (&acc)[2][2][4][2], const pg8::Unit& u, int wr, int wc, int fr, int fq) const {
        const int col0 = u.pn * 256 + wc * 32 + 4 * fq;
#pragma unroll
        for (int ai = 0; ai < 2; ++ai)
#pragma unroll
            for (int m = 0; m < 4; ++m) {
                const int row = u.pm * 256 + ai * 128 + wr * 64 + m * 16 + fr;
                bf16_t* pr = C + (size_t)row * ldc + col0;
#pragma unroll
                for (int bj = 0; bj < 2; ++bj)
#pragma unroll
                    for (int n = 0; n < 2; ++n) { const f32x4 v = acc[ai][bj][m][n]; u32x2 w; w.x = pg8::cvt_pk_bf16(v[0], v[1]); w.y = pg8::cvt_pk_bf16(v[2], v[3]); *(u32x2*)(pr + bj * 128 + n * 16) = w; }
            }
    }
};

constexpr int KVS = 288, VOFF = 73728;
template <int MODE>
__device__ __forceinline__ void attn_unit(const Params& P, int p, int b, int h, int r, int c, LAS unsigned char* lds) {
    const int tid = threadIdx.x, lane = tid & 63, w = __builtin_amdgcn_readfirstlane(tid >> 6);
    const int dil = 1 << (2 * p);
    const bf16_t* Qb = (const bf16_t*)(P.ws + WS_QB); const bf16_t* Kb = (const bf16_t*)(P.ws + WS_KB); const bf16_t* Vb = (const bf16_t*)(P.ws + WS_VB16);
    const size_t tok0 = (size_t)b * 2048;
    const int j0 = 128 * c - 128, rho0 = (c == 0) ? 128 : 0;
#pragma unroll
    for (int it = 0; it < 8; ++it) {
        const int rho = it * 32 + (tid >> 4), ch = tid & 15;
        if (rho >= rho0) {
            const size_t tok = tok0 + (size_t)((j0 + rho) * dil + r);
            const u32x4 kv = *(const u32x4*)(Kb + tok * DATT + h * HD + ch * 8);
            const u32x4 vv = *(const u32x4*)(Vb + tok * DATT + h * HD + ch * 8);
            *(LAS u32x4*)(lds + rho * KVS + ch * 16) = kv;
            *(LAS u32x4*)(lds + VOFF + rho * KVS + ch * 16) = vv;
        }
    }
    const int cq = lane & 15, g = lane >> 4;
    const int iq = 128 * c + 16 * w + cq;
    const size_t qtok = tok0 + (size_t)(iq * dil + r);
    bf16x8 qf[4];
#pragma unroll
    for (int ks = 0; ks < 4; ++ks) qf[ks] = *(const bf16x8*)(Qb + qtok * DATT + h * HD + 32 * ks + 8 * g);
    __syncthreads();
    const int ktmin = (8 - w - 8 * c) > 0 ? (8 - w - 8 * c) : 0;
    const float slope2 = exp2f(-8.0f * (float)(h + 1) / 12.0f) * LOG2E * (float)dil;
    f32x4 s[9]; float m = -INFINITY;
#pragma unroll
    for (int kt = 0; kt < 9; ++kt) {
        if (kt >= ktmin) {
            f32x4 acc = {0.f, 0.f, 0.f, 0.f};
#pragma unroll
            for (int ks = 0; ks < 4; ++ks) { const bf16x8 kf = *(const LAS bf16x8*)(lds + (16 * w + 16 * kt + cq) * KVS + (32 * ks + 8 * g) * 2); acc = __builtin_amdgcn_mfma_f32_16x16x32_bf16(kf, qf[ks], acc, 0, 0, 0); }
#pragma unroll
            for (int ii = 0; ii < 4; ++ii) { const int dist = cq + 128 - 16 * kt - 4 * g - ii; float v = acc[ii] - slope2 * (float)dist;
                if (kt == 0 && dist > 128) v = -INFINITY; if (kt == 8 && dist < 0) v = -INFINITY; acc[ii] = v; m = fmaxf(m, v); }
            s[kt] = acc;
        } else s[kt] = (f32x4){-INFINITY, -INFINITY, -INFINITY, -INFINITY};
    }
    m = fmaxf(m, __shfl_xor(m, 16)); m = fmaxf(m, __shfl_xor(m, 32));
    float l = 0.f;
#pragma unroll
    for (int kt = 0; kt < 9; ++kt)
#pragma unroll
        for (int ii = 0; ii < 4; ++ii) { const float pp = exp2f(s[kt][ii] - m); s[kt][ii] = pp; l += pp; }
    l += __shfl_xor(l, 16); l += __shfl_xor(l, 32);
    f32x4 o[8];
#pragma unroll
    for (int dt = 0; dt < 8; ++dt) o[dt] = (f32x4){0.f, 0.f, 0.f, 0.f};
#pragma unroll
    for (int kk = 0; kk < 5; ++kk) {
        const int T0 = 2 * kk, T1 = 2 * kk + 1;
        if (T1 >= ktmin || T0 == 8) {
            u32x4 pw; pw.x = pg8::cvt_pk_bf16(s[T0][0], s[T0][1]); pw.y = pg8::cvt_pk_bf16(s[T0][2], s[T0][3]);
            if (T1 <= 8) { pw.z = pg8::cvt_pk_bf16(s[T1 <= 8 ? T1 : 8][0], s[T1 <= 8 ? T1 : 8][1]); pw.w = pg8::cvt_pk_bf16(s[T1 <= 8 ? T1 : 8][2], s[T1 <= 8 ? T1 : 8][3]); } else { pw.z = 0u; pw.w = 0u; }
            const bf16x8 pf = __builtin_bit_cast(bf16x8, pw);
            const int rT0 = (T0 >= ktmin) ? T0 : 8, rT1 = (T1 <= 8 && T1 >= ktmin) ? T1 : 8;
            const int a0 = VOFF + (16 * w + 16 * rT0 + 4 * g + (cq >> 2)) * KVS + 8 * (cq & 3);
            const int a1 = VOFF + (16 * w + 16 * rT1 + 4 * g + (cq >> 2)) * KVS + 8 * (cq & 3);
#pragma unroll
            for (int dt = 0; dt < 8; ++dt) {
                const s16x4 v0 = __builtin_amdgcn_ds_read_tr16_b64_v4i16((LAS s16x4*)(lds + a0 + dt * 32));
                const s16x4 v1 = __builtin_amdgcn_ds_read_tr16_b64_v4i16((LAS s16x4*)(lds + a1 + dt * 32));
                const bf16x8 vf = {v0[0], v0[1], v0[2], v0[3], v1[0], v1[1], v1[2], v1[3]};
                o[dt] = __builtin_amdgcn_mfma_f32_16x16x32_bf16(vf, pf, o[dt], 0, 0, 0);
            }
        }
    }
    const float inv = 1.0f / l;
    if (MODE == 0) {
        bf16_t* po = (bf16_t*)(P.ws + WS_PO) + ((size_t)p * NTOK_P + qtok) * DATT + h * HD + 4 * g;
#pragma unroll
        for (int dt = 0; dt < 8; ++dt) { u32x2 wv; wv.x = pg8::cvt_pk_bf16(o[dt][0] * inv, o[dt][1] * inv); wv.y = pg8::cvt_pk_bf16(o[dt][2] * inv, o[dt][3] * inv); *(u32x2*)(po + 16 * dt) = wv; }
        if (g == 0) { ((float*)(P.ws + WS_PM))[((size_t)p * NTOK_P + qtok) * NH + h] = m; ((float*)(P.ws + WS_PL))[((size_t)p * NTOK_P + qtok) * NH + h] = l; }
    } else {
        const float* PM = (const float*)(P.ws + WS_PM); const float* PL = (const float*)(P.ws + WS_PL);
        const float m0 = PM[qtok * NH + h], l0 = PL[qtok * NH + h], m1 = PM[((size_t)NTOK_P + qtok) * NH + h], l1 = PL[((size_t)NTOK_P + qtok) * NH + h];
        const float M = fmaxf(m, fmaxf(m0, m1));
        const float w2 = exp2f(m - M), w0 = exp2f(m0 - M) * l0, w1 = exp2f(m1 - M) * l1;
        const float rden = 1.0f / (w2 * l + w0 + w1);
        const bf16_t* p0 = (const bf16_t*)(P.ws + WS_PO) + qtok * DATT + h * HD + 4 * g;
        const bf16_t* p1 = p0 + (size_t)NTOK_P * DATT;
        bf16_t* ar = (bf16_t*)(P.ws + WS_AR) + qtok * D + h * HD + 4 * g;
#pragma unroll
        for (int dt = 0; dt < 8; ++dt) {
            const u32x2 x0 = *(const u32x2*)(p0 + 16 * dt), x1 = *(const u32x2*)(p1 + 16 * dt);
            const float r0 = (w2 * o[dt][0] + w0 * bflo(x0.x) + w1 * bflo(x1.x)) * rden, r1 = (w2 * o[dt][1] + w0 * bfhi(x0.x) + w1 * bfhi(x1.x)) * rden;
            const float r2 = (w2 * o[dt][2] + w0 * bflo(x0.y) + w1 * bflo(x1.y)) * rden, r3 = (w2 * o[dt][3] + w0 * bfhi(x0.y) + w1 * bfhi(x1.y)) * rden;
            u32x2 wv; wv.x = pg8::cvt_pk_bf16(r0, r1); wv.y = pg8::cvt_pk_bf16(r2, r3); *(u32x2*)(ar + 16 * dt) = wv;
        }
    }
    __syncthreads();
}

__device__ __forceinline__ void samp_unit(const Params& P, int b, int h, int k, LAS unsigned char* lds) {
    const int tid = threadIdx.x, lane = tid & 63, w = __builtin_amdgcn_readfirstlane(tid >> 6);
    const int cq = lane & 15, g = lane >> 4;
    if (k < 8) {
#pragma unroll 4
        for (int it = 0; it < 16; ++it) {
            const int rho = it * 16 + (tid >> 5), ch4 = tid & 31, c = 256 * k + rho;
            const size_t so = ((size_t)(b * 2048 + c)) * DATT + h * HD + ch4 * 4;
            const float4 kf = *(const float4*)(P.cache_k + so), vf = *(const float4*)(P.cache_v + so);
            if (c >= 8) { const size_t od = ((size_t)(b * 2048 + c - 8)) * DATT + h * HD + ch4 * 4; *(float4*)(P.out + O_KS + od) = kf; *(float4*)(P.out + O_VS + od) = vf; }
            u32x2 kw, vw; kw.x = pg8::cvt_pk_bf16(kf.x, kf.y); kw.y = pg8::cvt_pk_bf16(kf.z, kf.w); vw.x = pg8::cvt_pk_bf16(vf.x, vf.y); vw.y = pg8::cvt_pk_bf16(vf.z, vf.w);
            *(LAS u32x2*)(lds + rho * KVS + ch4 * 8) = kw; *(LAS u32x2*)(lds + VOFF + rho * KVS + ch4 * 8) = vw;
        }
    } else {
        const int rho = tid >> 5, ch4 = tid & 31;
        u32x2 kw = {0u, 0u}, vw = {0u, 0u};
        if (rho < 8) { const size_t so = ((size_t)(b * 2048 + 2040 + rho)) * DATT + h * HD + ch4 * 4; const float4 kf = *(const float4*)(P.out + O_KS + so), vf = *(const float4*)(P.out + O_VS + so);
            kw.x = pg8::cvt_pk_bf16(kf.x, kf.y); kw.y = pg8::cvt_pk_bf16(kf.z, kf.w); vw.x = pg8::cvt_pk_bf16(vf.x, vf.y); vw.y = pg8::cvt_pk_bf16(vf.z, vf.w); }
        *(LAS u32x2*)(lds + rho * KVS + ch4 * 8) = kw; *(LAS u32x2*)(lds + VOFF + rho * KVS + ch4 * 8) = vw;
        *(LAS u32x2*)(lds + (16 + rho) * KVS + ch4 * 8) = (u32x2){0u, 0u}; *(LAS u32x2*)(lds + VOFF + (16 + rho) * KVS + ch4 * 8) = (u32x2){0u, 0u};
    }
    const int t = cq & 7;
    const bf16_t* Qb = (const bf16_t*)(P.ws + WS_QB) + ((size_t)(NTOK_P + b * 8 + t)) * DATT + h * HD;
    bf16x8 qf[4];
#pragma unroll
    for (int ks = 0; ks < 4; ++ks) qf[ks] = *(const bf16x8*)(Qb + 32 * ks + 8 * g);
    __syncthreads();
    const float slope2 = exp2f(-8.0f * (float)(h + 1) / 12.0f) * LOG2E;
    const bool active = (k < 8) || (w == 0);
    f32x4 s[2]; float m = -INFINITY;
#pragma unroll
    for (int j = 0; j < 2; ++j) {
        f32x4 acc = {0.f, 0.f, 0.f, 0.f};
        if (active) {
#pragma unroll
            for (int ks = 0; ks < 4; ++ks) { const bf16x8 kf = *(const LAS bf16x8*)(lds + (32 * w + 16 * j + cq) * KVS + (32 * ks + 8 * g) * 2); acc = __builtin_amdgcn_mfma_f32_16x16x32_bf16(kf, qf[ks], acc, 0, 0, 0); }
        }
#pragma unroll
        for (int ii = 0; ii < 4; ++ii) {
            const int c = 256 * k + 32 * w + 16 * j + 4 * g + ii, dist = 2048 + t - c;
            int mult = (dist <= 128 ? 1 : 0) + (((dist & 3) == 0 && dist <= 512) ? 1 : 0) + (((dist & 15) == 0 && dist <= 2048) ? 1 : 0);
            if (dist < 0 || !active || c > 2055) mult = 0;
            const float v = mult ? acc[ii] - slope2 * (float)dist : -INFINITY;
            acc[ii] = v; m = fmaxf(m, v);
            s[j][ii] = (float)mult;
            s[j][ii] = v;
        }
    }
    m = fmaxf(m, __shfl_xor(m, 16)); m = fmaxf(m, __shfl_xor(m, 32));
    const float mref = (m == -INFINITY) ? 0.f : m;
    float l = 0.f;
#pragma unroll
    for (int j = 0; j < 2; ++j)
#pragma unroll
        for (int ii = 0; ii < 4; ++ii) {
            const int c = 256 * k + 32 * w + 16 * j + 4 * g + ii, dist = 2048 + t - c;
            const int mult = (dist <= 128 ? 1 : 0) + (((dist & 3) == 0 && dist <= 512) ? 1 : 0) + (((dist & 15) == 0 && dist <= 2048) ? 1 : 0);
            const float pp = (float)mult * exp2f(s[j][ii] - mref); s[j][ii] = pp; l += pp; }
    l += __shfl_xor(l, 16); l += __shfl_xor(l, 32);
    f32x4 o[8];
    {
        u32x4 pw; pw.x = pg8::cvt_pk_bf16(s[0][0], s[0][1]); pw.y = pg8::cvt_pk_bf16(s[0][2], s[0][3]); pw.z = pg8::cvt_pk_bf16(s[1][0], s[1][1]); pw.w = pg8::cvt_pk_bf16(s[1][2], s[1][3]);
        const bf16x8 pf = __builtin_bit_cast(bf16x8, pw);
        const int rw = active ? w : 0;
        const int a0 = VOFF + (32 * rw + 4 * g + (cq >> 2)) * KVS + 8 * (cq & 3), a1 = a0 + 16 * KVS;
#pragma unroll
        for (int dt = 0; dt < 8; ++dt) {
            const s16x4 v0 = __builtin_amdgcn_ds_read_tr16_b64_v4i16((LAS s16x4*)(lds + a0 + dt * 32));
            const s16x4 v1 = __builtin_amdgcn_ds_read_tr16_b64_v4i16((LAS s16x4*)(lds + a1 + dt * 32));
            const bf16x8 vf = {v0[0], v0[1], v0[2], v0[3], v1[0], v1[1], v1[2], v1[3]};
            o[dt] = __builtin_amdgcn_mfma_f32_16x16x32_bf16(vf, pf, (f32x4){0.f, 0.f, 0.f, 0.f}, 0, 0, 0);
        }
    }
    __syncthreads();
    LAS float* OL = (LAS float*)lds;
    LAS float* ML = (LAS float*)(lds + 32768);
    if (cq < 8) {
#pragma unroll
        for (int dt = 0; dt < 8; ++dt) *(LAS f32x4*)(OL + (w * 8 + cq) * 128 + 16 * dt + 4 * g) = o[dt];
        if (g == 0) { ML[(w * 8 + cq) * 2 + 0] = m; ML[(w * 8 + cq) * 2 + 1] = l; }
    }
    __syncthreads();
    {
        const int q = w; float M = -INFINITY;
#pragma unroll
        for (int ww = 0; ww < 8; ++ww) M = fmaxf(M, ML[(ww * 8 + q) * 2]);
        const float Mr = (M == -INFINITY) ? 0.f : M;
        float L = 0.f, o0 = 0.f, o1 = 0.f;
#pragma unroll
        for (int ww = 0; ww < 8; ++ww) { const float f = exp2f(ML[(ww * 8 + q) * 2] - Mr); L += f * ML[(ww * 8 + q) * 2 + 1];
            o0 += f * OL[(ww * 8 + q) * 128 + 2 * lane]; o1 += f * OL[(ww * 8 + q) * 128 + 2 * lane + 1]; }
        float* ps = (float*)(P.ws + WS_PS) + ((((size_t)(b * NH + h)) * 9 + k) * 8 + q) * 130;
        if (lane == 0) { ps[0] = M; ps[1] = L; }
        *(float2*)(ps + 2 + 2 * lane) = make_float2(o0, o1);
    }
    __syncthreads();
}
__device__ __forceinline__ void samp_merge_unit(const Params& P, int b, int t, int h, int lane) {
    const float* ps = (const float*)(P.ws + WS_PS) + ((size_t)(b * NH + h)) * 9 * 8 * 130 + (size_t)t * 130;
    float M = -INFINITY;
#pragma unroll
    for (int k = 0; k < 9; ++k) M = fmaxf(M, ps[(size_t)k * 8 * 130]);
    float L = 0.f, o0 = 0.f, o1 = 0.f;
#pragma unroll
    for (int k = 0; k < 9; ++k) { const float* pk = ps + (size_t)k * 8 * 130; const float f = exp2f(pk[0] - M); L += f * pk[1]; const float2 ov = *(const float2*)(pk + 2 + 2 * lane); o0 += f * ov.x; o1 += f * ov.y; }
    const float inv = 1.0f / L;
    bf16_t* ar = (bf16_t*)(P.ws + WS_AR) + ((size_t)(NTOK_P + b * 8 + t)) * D + h * HD;
    *(unsigned*)(ar + 2 * lane) = pack2(o0 * inv, o1 * inv);
}

__device__ __forceinline__ void lru_unit(const Params& P, bool samp, int b, int n, int k, int lane) {
    const int T = samp ? 8 : 64; const int row0 = samp ? NTOK_P + b * 8 : b * 2048 + k * 64; const int ch = n * 64 + lane;
    float wa[64], wx[64];
#pragma unroll
    for (int c = 0; c < 64; ++c) { wa[c] = P.lru_w_a[(n * 64 + c) * 64 + lane]; wx[c] = P.lru_w_x[(n * 64 + c) * 64 + lane]; }
    const float ba = P.lru_b_a[ch], bx = P.lru_b_x[ch], lam = P.lru_lambda[ch];
    const float sp = log1pf(expf(-lam));
    const float cw0 = P.conv_w[ch], cw1 = P.conv_w[512 + ch], cw2 = P.conv_w[1024 + ch], cw3 = P.conv_w[1536 + ch], cb = P.conv_b[ch];
    const float* XR = (const float*)(P.ws + WS_XR); const float* GT = (const float*)(P.ws + WS_GATE);
    float* R0 = (float*)(P.ws + WS_R0); float* R1 = (float*)(P.ws + WS_R1); bf16_t* AR = (bf16_t*)(P.ws + WS_AR);
    float x0 = 0.f, x1 = 0.f, x2 = 0.f, h = 0.f, A = 1.f;
    if (samp) { x0 = P.state_conv[(b * 3 + 0) * 512 + ch]; x1 = P.state_conv[(b * 3 + 1) * 512 + ch]; x2 = P.state_conv[(b * 3 + 2) * 512 + ch]; h = P.state_h[b * 512 + ch]; }
    else if (k > 0) { x0 = XR[(size_t)(row0 - 3) * DLRU + ch]; x1 = XR[(size_t)(row0 - 2) * DLRU + ch]; x2 = XR[(size_t)(row0 - 1) * DLRU + ch]; }
    for (int t0 = 0; t0 < T; t0 += 8) {
        float xin[8], gt[8];
#pragma unroll
        for (int i = 0; i < 8; ++i) { xin[i] = XR[(size_t)(row0 + t0 + i) * DLRU + ch]; gt[i] = GT[(size_t)(row0 + t0 + i) * DLRU + ch]; }
#pragma unroll
        for (int i = 0; i < 8; ++i) {
            const float xc = ((x0 * cw0 + x1 * cw1) + x2 * cw2) + xin[i] * cw3 + cb;
            x0 = x1; x1 = x2; x2 = xin[i];
            float ra = 0.f, ri = 0.f;
#pragma unroll
            for (int c = 0; c < 64; ++c) { const float xcc = readlane_f(xc, c); ra += xcc * wa[c]; ri += xcc * wx[c]; if ((c & 15) == 15) __builtin_amdgcn_sched_barrier(0); }
            const float rr = sigmoidf(ra + ba), ig = sigmoidf(ri + bx);
            const float log_a = -8.0f * rr * sp; const float a = expf(log_a);
            const float u = sqrtf(-expm1f(2.0f * log_a)) * (ig * xc);
            h = a * h + u; A = a * A;
            const float ge = gelu_exact(gt[i]);
            if (samp) AR[(size_t)(row0 + t0 + i) * D + DATT + ch] = (bf16_t)f2bf(h * ge);
            else { R0[(size_t)(row0 + t0 + i) * DLRU + ch] = h * ge; R1[(size_t)(row0 + t0 + i) * DLRU + ch] = A * ge; }
        }
    }
    if (samp) { P.out[O_HS + (size_t)b * 512 + ch] = h; float* co = P.out + O_CS + (size_t)b * 3 * 512 + ch; co[0] = x0; co[512] = x1; co[1024] = x2; }
    else {
        ((float*)(P.ws + WS_HE))[((size_t)(b * 32 + k)) * 512 + ch] = h; ((float*)(P.ws + WS_AE))[((size_t)(b * 32 + k)) * 512 + ch] = A;
        if (k == 31) { float* co = P.out + O_CP + (size_t)b * 3 * 512 + ch; co[0] = x0; co[512] = x1; co[1024] = x2; }
    }
}

__device__ __forceinline__ void phase_lru(const Params& P) {
    const int lane = threadIdx.x & 63, wave = __builtin_amdgcn_readfirstlane(threadIdx.x >> 6);
    const int gw = blockIdx.x * 8 + wave, nw = gridDim.x * 8;
    for (int u = gw; u < 2048 + 256; u += nw) { const bool samp = u >= 2048; const int v = samp ? u - 2048 : u; lru_unit(P, samp, samp ? (v >> 3) : (v >> 8), samp ? (v & 7) : ((v >> 5) & 7), v & 31, lane); }
}
__device__ __forceinline__ void phase_samp(const Params& P, LAS unsigned char* lds) {
    for (int u = blockIdx.x; u < 384 * 9; u += gridDim.x) { const int k = u % 9, bh = u / 9; samp_unit(P, bh / NH, bh % NH, k, lds); }
}
__device__ __forceinline__ void phase_attn01(const Params& P, LAS unsigned char* lds) {
    for (int u = blockIdx.x; u < 3072; u += gridDim.x) {
        const int p = u / 1536, rem = u - p * 1536, bh = rem >> 4, rc = rem & 15;
        const int b = bh / NH, h = bh - b * NH;
        const int r = p == 0 ? 0 : (rc >> 2), c = p == 0 ? rc : (rc & 3);
        attn_unit<0>(P, p, b, h, r, c, lds);
    }
}
__device__ __forceinline__ void phase_mix_b(const Params& P, LAS unsigned char* lds) {
    {
        const int gt = blockIdx.x * NTHREADS + threadIdx.x;
        for (int i = gt; i < 8 * 32 * 512; i += gridDim.x * NTHREADS) {
            const int ch = i & 511, k = (i >> 9) & 31, b = i >> 14;
            const float* HE = (const float*)(P.ws + WS_HE) + (size_t)b * 32 * 512 + ch; const float* AE = (const float*)(P.ws + WS_AE) + (size_t)b * 32 * 512 + ch;
            float hin = 0.f;
            for (int kk = 0; kk < k; ++kk) hin = HE[kk * 512] + AE[kk * 512] * hin;
            const float* R0 = (const float*)(P.ws + WS_R0) + (size_t)(b * 2048 + k * 64) * DLRU + ch; const float* R1 = (const float*)(P.ws + WS_R1) + (size_t)(b * 2048 + k * 64) * DLRU + ch;
            bf16_t* ar = (bf16_t*)(P.ws + WS_AR) + (size_t)(b * 2048 + k * 64) * D + DATT + ch;
#pragma unroll 8
            for (int t = 0; t < 64; ++t) ar[(size_t)t * D] = (bf16_t)f2bf(R0[(size_t)t * DLRU] + R1[(size_t)t * DLRU] * hin);
            if (k == 31) P.out[O_HP + (size_t)b * 512 + ch] = HE[31 * 512] + AE[31 * 512] * hin;
        }
    }
    { const int lane = threadIdx.x & 63, gw = blockIdx.x * 8 + (threadIdx.x >> 6);
      for (int u = gw; u < NTOK_S * NH; u += gridDim.x * 8) { const int row = u / NH, h = u - row * NH; samp_merge_unit(P, row >> 3, row & 7, h, lane); } }
    for (int u = blockIdx.x; u < 1536; u += gridDim.x) {
        const int bh = u >> 4, r = u & 15; const int b = bh / NH, h = bh - b * NH;
        attn_unit<1>(P, 2, b, h, r, 0, lds);
    }
}

__device__ __forceinline__ void phase_ln1(const Params& P) {
    const int lane = threadIdx.x & 63, wave = threadIdx.x >> 6;
    const float* pre = (const float*)(P.ws + WS_PRE1); bf16_t* x1b = (bf16_t*)(P.ws + WS_X1B);
    for (int row = blockIdx.x * 8 + wave; row < NTOK; row += gridDim.x * 8) {
        float4 v[8]; float s = 0.f;
#pragma unroll
        for (int j = 0; j < 8; ++j) { v[j] = *(const float4*)(pre + (size_t)row * D + (j >> 2) * 1024 + lane * 16 + (j & 3) * 4); s += (v[j].x + v[j].y) + (v[j].z + v[j].w); }
        const float mean = wave_sum(s) * (1.0f / D); float q = 0.f;
#pragma unroll
        for (int j = 0; j < 8; ++j) { const float a = v[j].x - mean, b = v[j].y - mean, c = v[j].z - mean, d = v[j].w - mean; q += (a * a + b * b) + (c * c + d * d); }
        const float rstd = rsqrtf(wave_sum(q) * (1.0f / D) + LN_EPS);
        float am = 0.f;
#pragma unroll
        for (int j = 0; j < 8; ++j) { const int col = (j >> 2) * 1024 + lane * 16 + (j & 3) * 4; const float4 g = *(const float4*)(P.ln1_g + col), bb = *(const float4*)(P.ln1_b + col);
            float4 o; o.x = (v[j].x - mean) * rstd * g.x + bb.x; o.y = (v[j].y - mean) * rstd * g.y + bb.y; o.z = (v[j].z - mean) * rstd * g.z + bb.z; o.w = (v[j].w - mean) * rstd * g.w + bb.w;
            v[j] = o; am = fmaxf(am, fmaxf(fmaxf(fabsf(o.x), fabsf(o.y)), fmaxf(fabsf(o.z), fabsf(o.w))));
            uint2 w; w.x = pack2(o.x, o.y); w.y = pack2(o.z, o.w); *(uint2*)(x1b + (size_t)row * D + col) = w; }
        am = wave_max(am); if (am == 0.f) am = 1.f;
        const float inv = 127.0f / am;
        unsigned char* xq = P.ws + WS_X1Q + (size_t)row * D;
#pragma unroll
        for (int j = 0; j < 2; ++j) { u32x4 w;
#pragma unroll
            for (int i = 0; i < 4; ++i) { const float4 t = v[j * 4 + i];
                const int a = (int)rintf(t.x * inv), b = (int)rintf(t.y * inv), c = (int)rintf(t.z * inv), d = (int)rintf(t.w * inv);
                w[i] = (unsigned)(a & 255) | ((unsigned)(b & 255) << 8) | ((unsigned)(c & 255) << 16) | ((unsigned)(d & 255) << 24); }
            *(u32x4*)(xq + j * 1024 + lane * 16) = w; }
        if (lane == 0) ((float*)(P.ws + WS_SX))[row] = am * (1.0f / 127.0f);
    }
}

__device__ __forceinline__ int mono(float v) { const int b = __float_as_int(v); return b ^ ((b >> 31) & 0x7fffffff); }
__device__ __forceinline__ float unmono(int k) { return __int_as_float(k ^ ((k >> 31) & 0x7fffffff)); }
#define MK_INSERT16(L, X) do { int _x = (X); _Pragma("unroll") for (int _j = 0; _j < 16; ++_j) { const int _hi = max(L[_j], _x); _x = min(L[_j], _x); L[_j] = _hi; } } while (0)

template <int N> __device__ __forceinline__ void bitonic_sort_desc(int (&v)[N]) {
#pragma unroll
    for (int k = 2; k <= N; k <<= 1)
#pragma unroll
        for (int j = k >> 1; j > 0; j >>= 1)
#pragma unroll
            for (int i = 0; i < N; ++i) { const int l = i ^ j;
                if (l > i) { const int a = v[i], b = v[l]; if ((i & k) == 0) { v[i] = max(a, b); v[l] = min(a, b); } else { v[i] = min(a, b); v[l] = max(a, b); } } }
}
template <int N> __device__ __forceinline__ void bitonic_merge_desc(int (&v)[N]) {
#pragma unroll
    for (int j = N >> 1; j > 0; j >>= 1)
#pragma unroll
        for (int i = 0; i < N; ++i) { const int l = i ^ j; if (l > i) { const int a = v[i], b = v[l]; v[i] = max(a, b); v[l] = min(a, b); } }
}
__device__ __forceinline__ void xlane_merge16(int (&v)[16], int off) {
    int c[16];
#pragma unroll
    for (int i = 0; i < 16; ++i) c[i] = max(v[i], __shfl_xor(v[15 - i], off));
#pragma unroll
    for (int i = 0; i < 16; ++i) v[i] = c[i];
    bitonic_merge_desc<16>(v);
}
__device__ __forceinline__ int sel4(int g, int a, int b, int c, int d) { return g == 0 ? a : (g == 1 ? b : (g == 2 ? c : d)); }
__device__ __forceinline__ float sel4f(int g, float a, float b, float c, float d) { return g == 0 ? a : (g == 1 ? b : (g == 2 ? c : d)); }
__device__ __forceinline__ constexpr int cand_a(int role, int i) {
    return role == 0 ? 0 : role == 1 ? (i < 8 ? 1 : (i < 13 ? 2 : 4)) : role == 2 ? (i < 4 ? 3 : (i < 6 ? 5 : (i < 8 ? 6 : (i < 10 ? 7 : 8 + (i - 10))))) : (i < 2 ? 14 + i : -1);
}
__device__ __forceinline__ constexpr int cand_b(int role, int i) {
    return role == 0 ? i : role == 1 ? (i < 8 ? i : (i < 13 ? i - 8 : i - 13)) : role == 2 ? (i < 4 ? i : (i < 6 ? i - 4 : (i < 8 ? i - 6 : (i < 10 ? i - 8 : 0)))) : 0;
}

__device__ __forceinline__ void route_unit(const Params& P, int h, int tg, LAS unsigned char* lds, LAS int* lst) {
    const int lane = threadIdx.x & 63, w = __builtin_amdgcn_readfirstlane(threadIdx.x >> 6);
    const int cq = lane & 15, g = lane >> 4;
    const int tok = tg * 128 + w * 16 + cq;
    const bf16_t* qrow = (const bf16_t*)(P.ws + WS_QP) + (size_t)tok * D + h * 256;
    int L0[16], L1[16];
#pragma unroll
    for (int p = 0; p < 2; ++p) {
        bf16x8 qf[4];
#pragma unroll
        for (int ks = 0; ks < 4; ++ks) qf[ks] = *(const bf16x8*)(qrow + p * 128 + 32 * ks + 8 * g);
        int v0[16], v1[16];
#pragma unroll
        for (int kt = 0; kt < 8; ++kt) {
            f32x4 acc = {0.f, 0.f, 0.f, 0.f};
#pragma unroll
            for (int ks = 0; ks < 4; ++ks) { const bf16x8 kf = *(const LAS bf16x8*)(lds + (p * 128 + 16 * kt + cq) * KVS + (32 * ks + 8 * g) * 2); acc = __builtin_amdgcn_mfma_f32_16x16x32_bf16(kf, qf[ks], acc, 0, 0, 0); }
#pragma unroll
            for (int ii = 0; ii < 4; ++ii) { const int key = (mono(acc[ii]) & ~127) | (16 * kt + 4 * g + ii); if (kt < 4) v0[kt * 4 + ii] = key; else v1[(kt - 4) * 4 + ii] = key; }
        }
        bitonic_sort_desc<16>(v0); bitonic_sort_desc<16>(v1);
#pragma unroll
        for (int i = 0; i < 16; ++i) v0[i] = max(v0[i], v1[15 - i]);
        bitonic_merge_desc<16>(v0);
        xlane_merge16(v0, 16); xlane_merge16(v0, 32);
#pragma unroll
        for (int i = 0; i < 16; ++i) { if (p == 0) L0[i] = v0[i]; else L1[i] = v0[i]; }
    }
    if (g == 0) {
#pragma unroll
        for (int i = 0; i < 16; ++i) lst[(cq * 2 + 0) * 16 + i] = L0[i];
    }
    if (g == 1) {
#pragma unroll
        for (int i = 0; i < 16; ++i) lst[(cq * 2 + 1) * 16 + i] = L1[i];
    }
    float f0[16], f1[16];
#pragma unroll
    for (int i = 0; i < 16; ++i) { f0[i] = unmono(L0[i] & ~127); f1[i] = unmono(L1[i] & ~127); }
    int c[16];
#pragma unroll
    for (int i = 0; i < 16; ++i) {
        constexpr int NEG = (int)0x80000000;
        const float va = sel4f(g, f0[cand_a(0, i)], f0[cand_a(1, i)], f0[cand_a(2, i)], f0[cand_a(3, i) < 0 ? 0 : cand_a(3, i)]);
        const float vb = sel4f(g, f1[cand_b(0, i)], f1[cand_b(1, i)], f1[cand_b(2, i)], f1[cand_b(3, i)]);
        const int id = sel4(g, (cand_a(0, i) << 4) | cand_b(0, i), (cand_a(1, i) << 4) | cand_b(1, i), (cand_a(2, i) << 4) | cand_b(2, i), ((cand_a(3, i) < 0 ? 0 : cand_a(3, i)) << 4) | cand_b(3, i));
        int key = (mono(va + vb) & ~255) | id;
        if (cand_a(3, i) < 0) key = (g == 3) ? NEG : key;
        c[i] = key;
    }
    bitonic_sort_desc<16>(c);
    xlane_merge16(c, 16); xlane_merge16(c, 32);
    const float mx = unmono(c[0] & ~255);
    float e[16]; float sum = 0.f;
#pragma unroll
    for (int i = 0; i < 16; ++i) { e[i] = exp2f((unmono(c[i] & ~255) - mx) * LOG2E); sum += e[i]; }
    const float inv = 1.0f / sum;
    __builtin_amdgcn_wave_barrier();
    int ei[4]; float gi[4];
#pragma unroll
    for (int j = 0; j < 4; ++j) {
        const int key = sel4(g, c[j], c[4 + j], c[8 + j], c[12 + j]);
        gi[j] = sel4f(g, e[j], e[4 + j], e[8 + j], e[12 + j]) * inv;
        const int a = (key >> 4) & 15, b = key & 15;
        const int i0 = lst[(cq * 2 + 0) * 16 + a] & 127, i1 = lst[(cq * 2 + 1) * 16 + b] & 127;
        ei[j] = i0 * 128 + i1;
    }
    int* EIDX = (int*)(P.ws + WS_EIDX); float* GW = (float*)(P.ws + WS_GW);
    *(int4*)(EIDX + (size_t)tok * 128 + h * 16 + 4 * g) = make_int4(ei[0], ei[1], ei[2], ei[3]);
    *(float4*)(GW + (size_t)tok * 128 + h * 16 + 4 * g) = make_float4(gi[0], gi[1], gi[2], gi[3]);
    __builtin_amdgcn_wave_barrier();
}
__device__ __forceinline__ void phase_route(const Params& P, LAS unsigned char* lds) {
    const int tid = threadIdx.x, wave = __builtin_amdgcn_readfirstlane(tid >> 6);
    const int h = blockIdx.x & 7, slot = blockIdx.x >> 3, nslot = gridDim.x >> 3;
    const bf16_t* sk = (const bf16_t*)(P.ws + WS_SKB) + (size_t)h * 2 * 128 * 128;
#pragma unroll
    for (int it = 0; it < 8; ++it) { const int row = it * 32 + (tid >> 4), ch = tid & 15; *(LAS u32x4*)(lds + row * KVS + ch * 16) = *(const u32x4*)(sk + (size_t)row * 128 + ch * 8); }
    __syncthreads();
    LAS int* lst = (LAS int*)(lds + 73728) + wave * 512;
    for (int tg = slot; tg < NTOK / 128; tg += nslot) route_unit(P, h, tg, lds, lst);
}

#ifndef MK_EG
#define MK_EG 2
#endif
__device__ __forceinline__ float ubf(unsigned x, int k) { return (float)((x >> (8 * k)) & 0xffu); }
constexpr int EG = MK_EG;
struct ExpGrp { u32x4 u[EG]; u32x4 v[EG]; unsigned su[EG]; unsigned sv[EG]; };
__device__ __forceinline__ void exp_load(ExpGrp& G, __amdgpu_buffer_rsrc_t ru, __amdgpu_buffer_rsrc_t rv, int e_lo, int e_hi, int grp, int lane) {
#pragma unroll
    for (int j = 0; j < EG; ++j) {
        const int k = grp * EG + j; const int e = __builtin_amdgcn_readlane(k < 64 ? e_lo : e_hi, k & 63);
        const int so = e * TROW;
        G.u[j] = __builtin_amdgcn_raw_buffer_load_b128(ru, lane * 16, so, 0); G.su[j] = __builtin_amdgcn_raw_buffer_load_b16(ru, 1024 + lane * 2, so, 0);
        G.v[j] = __builtin_amdgcn_raw_buffer_load_b128(rv, lane * 16, so, 0); G.sv[j] = __builtin_amdgcn_raw_buffer_load_b16(rv, 1024 + lane * 2, so, 0);
    }
}
__device__ __forceinline__ void exp_consume(const ExpGrp& G, const int (&xe)[4], const int (&xo)[4], const int (&X8)[2], f32x2 (&acc)[16], float (&bias)[2],
                                            float a_lo, float a_hi, float b_lo, float b_hi, int grp, int lane) {
    int d[EG];
#pragma unroll
    for (int j = 0; j < EG; ++j) {
        int tot = 0;
#pragma unroll
        for (int jj = 0; jj < 2; ++jj) { int t = -X8[jj];
#pragma unroll
            for (int hh = 0; hh < 2; ++hh) { const unsigned wv = G.u[j][jj * 2 + hh];
                t = __builtin_amdgcn_sdot4((int)(wv & 0x0F0F0F0Fu), xe[jj * 2 + hh], t, false); t = __builtin_amdgcn_sdot4((int)((wv >> 4) & 0x0F0F0F0Fu), xo[jj * 2 + hh], t, false); }
            tot += t * (int)((G.su[j] >> (8 * jj)) & 255u); }
        d[j] = tot;
    }
    int r;
    int myj;
    if (EG == 2) {
        const bool b5 = (lane & 32) != 0;
        r = (b5 ? d[1 % EG] : d[0]) + __shfl_xor(b5 ? d[0] : d[1 % EG], 32);
        r += __shfl_xor(r, 16); r += __shfl_xor(r, 8); r += __shfl_xor(r, 4); r += __shfl_xor(r, 2); r += __shfl_xor(r, 1);
        myj = b5 ? 1 : 0;
    } else if (EG == 4) {
        const bool b5 = (lane & 32) != 0, b4 = (lane & 16) != 0;
        const int r0 = (b5 ? d[2 % EG] : d[0]) + __shfl_xor(b5 ? d[0] : d[2 % EG], 32);
        const int r1 = (b5 ? d[3 % EG] : d[1 % EG]) + __shfl_xor(b5 ? d[1 % EG] : d[3 % EG], 32);
        r = (b4 ? r1 : r0) + __shfl_xor(b4 ? r0 : r1, 16);
        r += __shfl_xor(r, 8); r += __shfl_xor(r, 4); r += __shfl_xor(r, 2); r += __shfl_xor(r, 1);
        myj = (b5 ? 2 : 0) + (b4 ? 1 : 0);
    } else {
        const bool b5 = (lane & 32) != 0, b4 = (lane & 16) != 0, b3 = (lane & 8) != 0;
        int q[4];
#pragma unroll
        for (int i = 0; i < 4; ++i) q[i] = (b5 ? d[(i + 4) % EG] : d[i]) + __shfl_xor(b5 ? d[i] : d[(i + 4) % EG], 32);
        const int p0 = (b4 ? q[2] : q[0]) + __shfl_xor(b4 ? q[0] : q[2], 16);
        const int p1 = (b4 ? q[3] : q[1]) + __shfl_xor(b4 ? q[1] : q[3], 16);
        r = (b3 ? p1 : p0) + __shfl_xor(b3 ? p0 : p1, 8);
        r += __shfl_xor(r, 4); r += __shfl_xor(r, 2); r += __shfl_xor(r, 1);
        myj = (b5 ? 4 : 0) + (b4 ? 2 : 0) + (b3 ? 1 : 0);
    }
    const int myk = grp * EG + myj;
    const float ak = __shfl(myk < 64 ? a_lo : a_hi, myk & 63), bk = __shfl(myk < 64 ? b_lo : b_hi, myk & 63);
    const float wmine = bk * gelu_exact((float)r * ak);
#pragma unroll
    for (int j = 0; j < EG; ++j) {
        const float w = readlane_f(wmine, EG == 2 ? j * 32 : (EG == 4 ? ((j >> 1) * 32 + (j & 1) * 16) : ((j >> 2) * 32 + ((j >> 1) & 1) * 16 + (j & 1) * 8)));
        __builtin_amdgcn_sched_barrier(0);
#pragma unroll
        for (int jj = 0; jj < 2; ++jj) {
            const float c = w * (float)((G.sv[j] >> (8 * jj)) & 255u); bias[jj] += c; const f32x2 c2 = {c, c};
#pragma unroll
            for (int hh = 0; hh < 2; ++hh) { const unsigned wv = G.v[j][jj * 2 + hh]; const unsigned ev = wv & 0x0F0F0F0Fu, od = (wv >> 4) & 0x0F0F0F0Fu;
                const f32x2 n0 = {ubf(ev, 0), ubf(od, 0)}, n1 = {ubf(ev, 1), ubf(od, 1)};
                const f32x2 n2 = {ubf(ev, 2), ubf(od, 2)}, n3 = {ubf(ev, 3), ubf(od, 3)};
                f32x2* ac = &acc[jj * 8 + hh * 4];
                ac[0] = __builtin_elementwise_fma(n0, c2, ac[0]); ac[1] = __builtin_elementwise_fma(n1, c2, ac[1]); ac[2] = __builtin_elementwise_fma(n2, c2, ac[2]); ac[3] = __builtin_elementwise_fma(n3, c2, ac[3]);
                __builtin_amdgcn_sched_barrier(0);
            }
        }
    }
}
__device__ __forceinline__ void phase_experts(const Params& P) {
    const int lane = threadIdx.x & 63, wave = threadIdx.x >> 6;
    const bf16_t* x1b = (const bf16_t*)(P.ws + WS_X1B);
    const int* EIDX = (const int*)(P.ws + WS_EIDX); const float* GW = (const float*)(P.ws + WS_GW);
    const __amdgpu_buffer_rsrc_t UQ = __builtin_amdgcn_make_buffer_rsrc((void*)(P.ws + WS_UB), 0, NEXP * TROW, 0x00020000);
    const __amdgpu_buffer_rsrc_t VQ = __builtin_amdgcn_make_buffer_rsrc((void*)(P.ws + WS_VB), 0, NEXP * TROW, 0x00020000);
    const float* SU = (const float*)(P.ws + WS_SU); const float* SV = (const float*)(P.ws + WS_SV); const float* SX = (const float*)(P.ws + WS_SX);
    for (int row = blockIdx.x * 8 + wave; row < NTOK; row += gridDim.x * 8) {
        int ln = lane; asm volatile("" : "+v"(ln));
        int xe[4], xo[4], X8[2];
        {
            const u32x4 x0 = *(const u32x4*)(P.ws + WS_X1Q + (size_t)row * D + ln * 16), x1 = *(const u32x4*)(P.ws + WS_X1Q + (size_t)row * D + 1024 + ln * 16);
#pragma unroll
            for (int hh = 0; hh < 2; ++hh) {
                xe[hh] = (int)__builtin_amdgcn_perm(x0[2 * hh + 1], x0[2 * hh], 0x06040200u); xo[hh] = (int)__builtin_amdgcn_perm(x0[2 * hh + 1], x0[2 * hh], 0x07050301u);
                xe[2 + hh] = (int)__builtin_amdgcn_perm(x1[2 * hh + 1], x1[2 * hh], 0x06040200u); xo[2 + hh] = (int)__builtin_amdgcn_perm(x1[2 * hh + 1], x1[2 * hh], 0x07050301u);
            }
            int s0 = 0, s1 = 0;
#pragma unroll
            for (int i = 0; i < 4; ++i) { s0 = __builtin_amdgcn_sdot4((int)x0[i], 0x01010101, s0, false); s1 = __builtin_amdgcn_sdot4((int)x1[i], 0x01010101, s1, false); }
            X8[0] = 8 * s0; X8[1] = 8 * s1;
        }
        const float sx = SX[row];
        const int e_lo = EIDX[(size_t)row * 128 + ln], e_hi = EIDX[(size_t)row * 128 + 64 + ln];
        const float g_lo = GW[(size_t)row * 128 + ln], g_hi = GW[(size_t)row * 128 + 64 + ln];
        const float a_lo = SU[e_lo] * sx, a_hi = SU[e_hi] * sx, b_lo = g_lo * SV[e_lo], b_hi = g_hi * SV[e_hi];
        f32x2 acc[16]; float bias[2] = {0.f, 0.f};
#pragma unroll
        for (int i = 0; i < 16; ++i) acc[i] = (f32x2){0.f, 0.f};
        ExpGrp GA, GB;
        exp_load(GA, UQ, VQ, e_lo, e_hi, 0, lane);
#pragma unroll 1
        for (int grp = 0; grp < 128 / EG; grp += 2) {
            exp_load(GB, UQ, VQ, e_lo, e_hi, grp + 1, lane);
            exp_consume(GA, xe, xo, X8, acc, bias, a_lo, a_hi, b_lo, b_hi, grp, lane);
            exp_load(GA, UQ, VQ, e_lo, e_hi, grp + 2 < 128 / EG ? grp + 2 : 0, lane);
            exp_consume(GB, xe, xo, X8, acc, bias, a_lo, a_hi, b_lo, b_hi, grp + 1, lane);
        }
        float s = 0.f;
#pragma unroll
        for (int jj = 0; jj < 2; ++jj) {
            const float b8 = 8.0f * bias[jj];
#pragma unroll
            for (int hh = 0; hh < 2; ++hh) {
                const u32x4 xa = *(const u32x4*)(x1b + (size_t)row * D + jj * 1024 + ln * 16 + hh * 8);
#pragma unroll
                for (int i = 0; i < 4; ++i) { f32x2 t = acc[jj * 8 + hh * 4 + i]; t[0] = t[0] - b8 + ALPHA * bflo(xa[i]); t[1] = t[1] - b8 + ALPHA * bfhi(xa[i]); acc[jj * 8 + hh * 4 + i] = t; s += t[0] + t[1]; }
            }
        }
        const float mean = wave_sum(s) * (1.0f / D); float q = 0.f;
#pragma unroll
        for (int i = 0; i < 16; ++i) { const float d0 = acc[i][0] - mean, d1 = acc[i][1] - mean; q += d0 * d0 + d1 * d1; }
        const float rstd = rsqrtf(wave_sum(q) * (1.0f / D) + LN_EPS);
        float* yo = P.out + (row < NTOK_P ? O_YP + (size_t)row * D : O_YS + (size_t)(row - NTOK_P) * D);
        const int lo16 = ln * 16;
#pragma unroll
        for (int jj = 0; jj < 2; ++jj)
#pragma unroll
            for (int i = 0; i < 4; ++i) {
                const int col = jj * 1024 + lo16 + i * 4;
                const float4 g0 = *(const float4*)(P.ln2_g + col), b0 = *(const float4*)(P.ln2_b + col);
                const f32x2 v0 = acc[jj * 8 + i * 2], v1 = acc[jj * 8 + i * 2 + 1];
                float4 o;
                o.x = (v0[0] - mean) * rstd * g0.x + b0.x; o.y = (v0[1] - mean) * rstd * g0.y + b0.y;
                o.z = (v1[0] - mean) * rstd * g0.z + b0.z; o.w = (v1[1] - mean) * rstd * g0.w + b0.w;
                *(float4*)(yo + col) = o;
            }
    }
}

constexpr int NPHASE = 11;
__global__ void __launch_bounds__(NTHREADS, 2) fwd(Params P) {
    extern __shared__ __attribute__((aligned(16))) unsigned char lds_raw[];
    LAS unsigned char* lds = (LAS unsigned char*)lds_raw;
    volatile LAS unsigned* misc = (volatile LAS unsigned*)(lds + MISC_OFF);
    const int lo = P.ph_lo, hi = P.ph_hi;
    XcdBarrier bar; bar.bar = (unsigned*)(P.ws + WS_CTL); bar.x = 0; bar.st = nullptr;
    if (hi - lo > 1) {
        if (threadIdx.x == 0) { misc[0] = 0u; misc[1] = 0u; misc[2] = 0u; misc[3] = 0u; }
        __syncthreads();
        bar = xcd_barrier_post((unsigned*)(P.ws + WS_CTL), misc);
    }
#ifndef MK_REPMASK
#define MK_REPMASK 0
#endif
#ifndef MK_PHASE_MASK
#define MK_PHASE_MASK 0x7ff
#endif
#define IN(k) (((MK_PHASE_MASK >> (k)) & 1) && lo <= (k) && (k) < hi)
#define SEAM(k) do { if (IN(k) && IN((k) + 1)) xcd_barrier(bar); } while (0)
    if (IN(0)) { phase_prologue(P, lds); }
    SEAM(0);
    if (IN(1)) {
        pg8::Gemm g{(const pg8::bf16_t*)(P.ws + WS_XB), (const pg8::bf16_t*)(P.ws + WS_WINT), NTOK, DIN, D};
        pg8::StaticOrder S; S.init(NTOK, DIN, (int)gridDim.x, (int)blockIdx.x);
        EpiProj E{P.out, (float*)(P.ws + WS_QF), (float*)(P.ws + WS_XR), (float*)(P.ws + WS_GATE), (bf16_t*)(P.ws + WS_QB), (bf16_t*)(P.ws + WS_KB), (bf16_t*)(P.ws + WS_VB16)};
        pg8::gemm_phase<EpiProj, pg8::StaticOrder, false>(lds, g, S, E, nullptr);
    }
    SEAM(1);
    if (IN(2)) { phase_lru(P); }
    if (IN(2) && IN(3)) __syncthreads();
    if (IN(3)) { phase_samp(P, lds); }
    if (IN(4)) { phase_attn01(P, lds); }
    SEAM(4);
    if (IN(5)) { phase_mix_b(P, lds); }
    SEAM(5);
    if (IN(6)) {
        pg8::Gemm g{(const pg8::bf16_t*)(P.ws + WS_AR), (const pg8::bf16_t*)(P.ws + WS_WOT), NTOK, D, D};
        pg8::StaticOrder S; S.init(NTOK, D, (int)gridDim.x, (int)blockIdx.x);
        EpiOut E{P.x_prompt, P.x_sample, (float*)(P.ws + WS_PRE1)};
        pg8::gemm_phase<EpiOut, pg8::StaticOrder, false>(lds, g, S, E, nullptr);
    }
    SEAM(6);
    if (IN(7)) { phase_ln1(P); }
    SEAM(7);
    if (IN(8)) {
        pg8::Gemm g{(const pg8::bf16_t*)(P.ws + WS_X1B), (const pg8::bf16_t*)(P.ws + WS_WQT), NTOK, D, D};
        pg8::StaticOrder S; S.init(NTOK, D, (int)gridDim.x, (int)blockIdx.x);
        EpiBf16Plain E{(bf16_t*)(P.ws + WS_QP), D};
        pg8::gemm_phase<EpiBf16Plain, pg8::StaticOrder, false>(lds, g, S, E, nullptr);
    }
    SEAM(8);
    if (IN(9)) { phase_route(P, lds); }
    SEAM(9);
    if (IN(10)) { phase_experts(P); }
#undef IN
#undef SEAM
}
}

#ifndef MK_N_LAUNCHES
#define MK_N_LAUNCHES 1
#endif
extern "C" void kernel_launch(void* const* d_in, const int* in_sizes, int n_in, void* d_out, int out_size, void* d_ws, size_t ws_size, hipStream_t stream) {
    using namespace mk;
    static int grid = 0;
    if (grid == 0) {
        if (n_in != 23 || (size_t)out_size != O_END || ws_size < WS_END) { fprintf(stderr, "kernel_launch: unexpected shapes: n_in %d out %d ws %zu (need %zu)\n", n_in, out_size, ws_size, (size_t)WS_END); grid = -1; return; }
        int dev = 0, cus = 0, per_cu = 0;
        if (hipGetDevice(&dev) != hipSuccess || hipDeviceGetAttribute(&cus, hipDeviceAttributeMultiprocessorCount, dev) != hipSuccess) { grid = -1; return; }
        if (hipFuncSetAttribute((const void*)fwd, hipFuncAttributeMaxDynamicSharedMemorySize, LDS_BYTES) != hipSuccess) { fprintf(stderr, "kernel_launch: hipFuncSetAttribute failed\n"); grid = -1; return; }
        if (hipOccupancyMaxActiveBlocksPerMultiprocessor(&per_cu, (const void*)fwd, NTHREADS, LDS_BYTES) != hipSuccess || per_cu < 1) { fprintf(stderr, "kernel_launch: occupancy query says %d\n", per_cu); }
        (void)hipGetLastError();
        grid = cus;
    }
    if (grid < 0) return;
    (void)hipMemsetAsync((char*)d_ws + WS_CTL, 0, 65536, stream);
    Params p{};
    p.x_prompt = (const float*)d_in[0]; p.x_sample = (const float*)d_in[1]; p.cache_k = (const float*)d_in[2]; p.cache_v = (const float*)d_in[3];
    p.state_conv = (const float*)d_in[4]; p.state_h = (const float*)d_in[5]; p.w_in = (const float*)d_in[6]; p.conv_w = (const float*)d_in[7]; p.conv_b = (const float*)d_in[8];
    p.lru_w_a = (const float*)d_in[9]; p.lru_b_a = (const float*)d_in[10]; p.lru_w_x = (const float*)d_in[11]; p.lru_b_x = (const float*)d_in[12]; p.lru_lambda = (const float*)d_in[13];
    p.w_out = (const float*)d_in[14]; p.ln1_g = (const float*)d_in[15]; p.ln1_b = (const float*)d_in[16]; p.w_query = (const float*)d_in[17]; p.sub_keys = (const float*)d_in[18];
    p.peer_u = (const float*)d_in[19]; p.peer_v = (const float*)d_in[20]; p.ln2_g = (const float*)d_in[21]; p.ln2_b = (const float*)d_in[22];
    p.out = (float*)d_out; p.ws = (unsigned char*)d_ws;
#if MK_N_LAUNCHES == 1
    p.ph_lo = 0; p.ph_hi = NPHASE;
    hipLaunchKernelGGL(fwd, dim3(grid), dim3(NTHREADS), LDS_BYTES, stream, p);
#else
    for (int k = 0; k < NPHASE; ++k) { p.ph_lo = k; p.ph_hi = k + 1; hipLaunchKernelGGL(fwd, dim3(grid), dim3(NTHREADS), LDS_BYTES, stream, p);
#ifdef MK_EXTRA_PHASE
        if (k == MK_EXTRA_PHASE) hipLaunchKernelGGL(fwd, dim3(grid), dim3(NTHREADS), LDS_BYTES, stream, p);
#endif
    }
#endif
    const hipError_t le = hipPeekAtLastError();
    if (le != hipSuccess) fprintf(stderr, "kernel_launch: launch failed: %s\n", hipGetErrorName(le));
}
```

```cpp
#include <hip/hip_runtime.h>
#include <cstdio>
#include <cstdint>
namespace pg8 {
#define PG8_LAS __attribute__((address_space(3)))
typedef unsigned short bf16_t;
typedef short bf16x8 __attribute__((ext_vector_type(8)));
typedef float f32x4 __attribute__((ext_vector_type(4)));
typedef unsigned u32x4 __attribute__((ext_vector_type(4)));
constexpr int BM = 256, BK = 64, HALF = 128, HTB = HALF * BK * 2  , STAGE_BYTES = 8 * HTB, NXCD = 8, WGM = 8;

__host__ __device__ __forceinline__ int lds_byte(int r, int c) { const int st = (r >> 4) * 2 + (c >> 5), rr = r & 15, cc = c & 31, ob = rr * 64 + cc * 2; return st * 1024 + (ob ^ (((ob >> 9) & 1) << 5)); }
__host__ __device__ __forceinline__ void stage_rc(int b, int& R, int& C) { const int st = b / 1024, sb = b % 1024, swz = sb ^ (((sb >> 9) & 1) << 5); R = (st >> 1) * 16 + swz / 64; C = (st & 1) * 32 + (swz % 64) / 2; }
__host__ __device__ __forceinline__ int perm32(int rho) { const int n = rho >> 4, i = rho & 15; return 8 * (i >> 2) + 4 * n + (i & 3); }

struct Unit { int pm, pn; };
struct Gemm { const bf16_t* A; const bf16_t* Bt; int M, N, K; };

struct StaticOrder {
    int nM, nN, nwg, G, c;
    __host__ __device__ void init(int M, int N, int G_, int c_) { nM = M / BM; nN = N / BM; nwg = nM * nN; G = G_; c = c_; }
    __host__ __device__ bool next(int i, Unit& u) const {
        const long L = (long)i * G + c; if (L >= nwg) return false;
        int wgid = (int)L; { const int q = nwg / NXCD, r = nwg % NXCD, xcd = wgid % NXCD, off = wgid / NXCD; wgid = (xcd < r ? xcd * (q + 1) : r * (q + 1) + (xcd - r) * q) + off; }
        const int nig = WGM * nN, gid = wgid / nig, fm = gid * WGM, gsz = (nM - fm) < WGM ? (nM - fm) : WGM;
        u.pm = fm + ((wgid % nig) % gsz); u.pn = (wgid % nig) / gsz; return true;
    }
    __device__ __forceinline__ void a_ready(const Unit&) const {}
    __device__ __forceinline__ void done(const Unit&) const {}
};
struct CountedOrder : StaticOrder {
    const unsigned* ready; unsigned need; unsigned* tmo;
    __device__ __forceinline__ void a_ready(const Unit& u) const {
        if (threadIdx.x < 64) {
            const unsigned long long t0 = __builtin_amdgcn_s_memrealtime(); unsigned polls = 0;
            while ((unsigned)__builtin_amdgcn_readfirstlane(__hip_atomic_load(ready + 64 * u.pm, __ATOMIC_RELAXED, __HIP_MEMORY_SCOPE_AGENT)) < need) {
                if ((++polls & 255u) == 0u && __builtin_amdgcn_readfirstlane(__hip_atomic_load(tmo, __ATOMIC_RELAXED, __HIP_MEMORY_SCOPE_AGENT)) != 0u) break;
                if (__builtin_amdgcn_s_memrealtime() - t0 > 2000000ull) {
                    if (threadIdx.x == 0) { unsigned expect = 0u; __hip_atomic_compare_exchange_strong(tmo + 1, &expect, 0x600u | (unsigned)(u.pm & 0xff), __ATOMIC_RELAXED, __ATOMIC_RELAXED, __HIP_MEMORY_SCOPE_AGENT); __hip_atomic_store(tmo, 1u, __ATOMIC_RELAXED, __HIP_MEMORY_SCOPE_AGENT); }
                    break; }
                __builtin_amdgcn_s_sleep(2); }
            __builtin_amdgcn_fence(__ATOMIC_ACQUIRE, "agent");
            asm volatile("s_waitcnt vmcnt(0)" ::: "memory");
        }
#if !defined(BROKEN_HOOK_NO_BARRIER)
        asm volatile("" ::: "memory"); __builtin_amdgcn_s_barrier(); asm volatile("" ::: "memory");
#endif
    }
};

__device__ __forceinline__ unsigned cvt_pk_bf16(float lo, float hi) { unsigned r; asm volatile("v_cvt_pk_bf16_f32 %0, %1, %2" : "=v"(r) : "v"(lo), "v"(hi)); return r; }
typedef float f32x2 __attribute__((ext_vector_type(2)));
__device__ __forceinline__ f32x2 gelu_pk(f32x2 v) {
    const f32x2 av = __builtin_elementwise_abs(v), d = av * 0.2316418882f + 1.0f;
    f32x2 t; t.x = __builtin_amdgcn_rcpf(d.x); t.y = __builtin_amdgcn_rcpf(d.y);
    f32x2 q = t * 0.5307027145f + (-0.7265760135f); q = q * t + 0.7107068705f; q = q * t + (-0.142248368f); q = q * t + 0.127414796f; q = q * t;
    const f32x2 s = (v * v) * (-0.72134752044f);
    f32x2 e; e.x = __builtin_amdgcn_exp2f(s.x); e.y = __builtin_amdgcn_exp2f(s.y);
    const f32x2 m = v * (q * e), r = v - m;
    f32x2 o; o.x = v.x < 0.f ? m.x : r.x; o.y = v.y < 0.f ? m.y : r.y; return o;
}

struct EpiF32 {
    static constexpr bool PERM = false, AFTER_DRAIN = false;
    float* C; int ldc; const float* bias;
    __device__ __forceinline__ void operator()(const f32x4 (&acc)[2][2][4][2], const Unit& u, int wr, int wc, int fr, int fq) const {
        const int row0 = u.pm * BM + wr * 64 + fr, col0 = u.pn * BM + wc * 32 + 4 * fq;
        f32x4 bv[2][2];
#pragma unroll
        for (int bj = 0; bj < 2; ++bj)
#pragma unroll
            for (int n = 0; n < 2; ++n) bv[bj][n] = bias ? *(const f32x4*)(bias + col0 + bj * HALF + n * 16) : (f32x4){0.f, 0.f, 0.f, 0.f};
#pragma unroll
        for (int ai = 0; ai < 2; ++ai)
#pragma unroll
            for (int m = 0; m < 4; ++m) { float* rowp = C + (size_t)(row0 + ai * HALF + m * 16) * ldc + col0;
#pragma unroll
                for (int bj = 0; bj < 2; ++bj)
#pragma unroll
                    for (int n = 0; n < 2; ++n) *(f32x4*)(rowp + bj * HALF + n * 16) = acc[ai][bj][m][n] + bv[bj][n]; }
    }
};
template <int ACT  > struct EpiBf16 {
    static constexpr bool PERM = true, AFTER_DRAIN = false;
    bf16_t* O; int ldc; const float* bias; int split_cols; size_t split_stride;
    __device__ __forceinline__ void operator()(const f32x4 (&acc)[2][2][4][2], const Unit& u, int wr, int wc, int fr, int fq) const {
        const int row0 = u.pm * BM + wr * 64 + fr; int colt = u.pn * BM; bf16_t* base = O;
        if (split_cols) { const int t = colt / split_cols; base += (size_t)t * split_stride; colt -= t * split_cols; }
        const int col0 = colt + wc * 32 + 8 * fq, bcol0 = u.pn * BM + wc * 32 + 8 * fq;
        f32x4 bv[2][2];
#pragma unroll
        for (int bj = 0; bj < 2; ++bj)
#pragma unroll
            for (int n = 0; n < 2; ++n) bv[bj][n] = bias ? *(const f32x4*)(bias + bcol0 + bj * HALF + 4 * n) : (f32x4){0.f, 0.f, 0.f, 0.f};
#pragma unroll
        for (int ai = 0; ai < 2; ++ai)
#pragma unroll
            for (int m = 0; m < 4; ++m) { bf16_t* rowp = base + (size_t)(row0 + ai * HALF + m * 16) * ldc + col0;
#pragma unroll
                for (int bj = 0; bj < 2; ++bj) { f32x4 v0 = acc[ai][bj][m][0] + bv[bj][0], v1 = acc[ai][bj][m][1] + bv[bj][1];
                    if (ACT == 1) { f32x2 a = gelu_pk((f32x2){v0[0], v0[1]}), b = gelu_pk((f32x2){v0[2], v0[3]}), c = gelu_pk((f32x2){v1[0], v1[1]}), d = gelu_pk((f32x2){v1[2], v1[3]});
                        v0 = (f32x4){a.x, a.y, b.x, b.y}; v1 = (f32x4){c.x, c.y, d.x, d.y}; }
                    if (ACT == 2) {
#pragma unroll
                        for (int j = 0; j < 4; ++j) { v0[j] = 0.5f * v0[j] * (1.0f + erff(v0[j] * 0.70710678f)); v1[j] = 0.5f * v1[j] * (1.0f + erff(v1[j] * 0.70710678f)); } }
                    u32x4 w; w.x = cvt_pk_bf16(v0[0], v0[1]); w.y = cvt_pk_bf16(v0[2], v0[3]); w.z = cvt_pk_bf16(v1[0], v1[1]); w.w = cvt_pk_bf16(v1[2], v1[3]);
                    *(u32x4*)(rowp + bj * HALF) = w; } }
    }
};

struct PanelStats {
    unsigned* xbuf;
    unsigned* cnt;
    unsigned* tmo;
    int ntn; float eps;
    unsigned code;
    __device__ __forceinline__ bool run(const f32x4 (&v)[2][2][4][2], const Unit& u, int wr, int wc, int fr, int fq, PG8_LAS unsigned char* lds, int wid, int lane) const {
        typedef float f32x2v __attribute__((ext_vector_type(2)));
        PG8_LAS f32x2v* P = (PG8_LAS f32x2v*)lds;
        PG8_LAS f32x2v* S = (PG8_LAS f32x2v*)(lds + 8192);
        PG8_LAS unsigned* flag = (PG8_LAS unsigned*)(lds + 8192 + 2048);
#pragma unroll
        for (int ai = 0; ai < 2; ++ai)
#pragma unroll
            for (int m = 0; m < 4; ++m) {
                float s = 0.f;
#pragma unroll
                for (int bj = 0; bj < 2; ++bj)
#pragma unroll
                    for (int n = 0; n < 2; ++n) { const f32x4 x = v[ai][bj][m][n]; s += (x[0] + x[1]) + (x[2] + x[3]); }
                s += __shfl_xor(s, 16); s += __shfl_xor(s, 32);
                const float mw = s * (1.0f / 64.0f); float q = 0.f;
#pragma unroll
                for (int bj = 0; bj < 2; ++bj)
#pragma unroll
                    for (int n = 0; n < 2; ++n) { const f32x4 d = v[ai][bj][m][n] - mw; q += (d[0] * d[0] + d[1] * d[1]) + (d[2] * d[2] + d[3] * d[3]); }
                q += __shfl_xor(q, 16); q += __shfl_xor(q, 32);
                if (fq == 0) P[(ai * HALF + wr * 64 + m * 16 + fr) * 4 + wc] = (f32x2v){mw, q};
            }
        asm volatile("s_waitcnt lgkmcnt(0)" ::: "memory"); __builtin_amdgcn_s_barrier(); asm volatile("" ::: "memory");
#if defined(BROKEN_NO_WAIT)
        if (blockIdx.x >= 64) { const long long t0 = clock64(); while (clock64() - t0 < 60000) __builtin_amdgcn_s_sleep(8); }
#endif
        const int row = wid * 32 + (lane & 31);
        if (lane < 32) {
            const f32x2v a = P[row * 4 + 0], b = P[row * 4 + 1], c = P[row * 4 + 2], d = P[row * 4 + 3];
            const float mt = (a.x + b.x + c.x + d.x) * 0.25f;
            const float da = a.x - mt, db = b.x - mt, dc = c.x - mt, dd = d.x - mt;
            const float m2 = (a.y + b.y) + (c.y + d.y) + 64.0f * ((da * da + db * db) + (dc * dc + dd * dd));
            unsigned long long* slot = (unsigned long long*)xbuf + ((size_t)(u.pm * BM + row) * 4 + u.pn);
            __hip_atomic_store(slot, ((unsigned long long)__float_as_uint(m2) << 32) | __float_as_uint(mt), __ATOMIC_RELAXED, __HIP_MEMORY_SCOPE_AGENT);
        }
        asm volatile("s_waitcnt vmcnt(0)" ::: "memory");
        if (lane == 0) __hip_atomic_fetch_add(cnt + 64 * u.pm, 1u, __ATOMIC_RELAXED, __HIP_MEMORY_SCOPE_AGENT);
        if (wid == 0) {
            bool dead = false; const unsigned long long t0 = __builtin_amdgcn_s_memrealtime(); const unsigned want = 8u * (unsigned)ntn;
            for (;;) {
#if defined(BROKEN_NO_WAIT)
                break;
#endif
                if ((unsigned)__builtin_amdgcn_readfirstlane(__hip_atomic_load(cnt + 64 * u.pm, __ATOMIC_RELAXED, __HIP_MEMORY_SCOPE_AGENT)) >= want) break;
                if (__builtin_amdgcn_s_memrealtime() - t0 > 2000000ull) {
                    if (lane == 0) { unsigned expect = 0u; __hip_atomic_compare_exchange_strong(tmo + 1, &expect, code | (unsigned)(u.pm & 0xff), __ATOMIC_RELAXED, __ATOMIC_RELAXED, __HIP_MEMORY_SCOPE_AGENT);
                                     __hip_atomic_store(tmo, 1u, __ATOMIC_RELAXED, __HIP_MEMORY_SCOPE_AGENT); }
                    dead = true; break; }
                __builtin_amdgcn_s_sleep(2);
            }
            __builtin_amdgcn_fence(__ATOMIC_ACQUIRE, "agent");
            if (lane == 0) flag[0] = dead ? 1u : 0u;
        }
        asm volatile("s_waitcnt vmcnt(0) lgkmcnt(0)" ::: "memory"); __builtin_amdgcn_s_barrier(); asm volatile("" ::: "memory");
        const bool bad = flag[0] != 0u;
        if (lane < 32) {
            const unsigned long long* slot = (const unsigned long long*)xbuf + (size_t)(u.pm * BM + row) * 4; float mt[4], m2[4]; float ms = 0.f;
#pragma unroll
            for (int t = 0; t < 4; ++t) { if (t < ntn) { const unsigned long long w = __hip_atomic_load(slot + t, __ATOMIC_RELAXED, __HIP_MEMORY_SCOPE_AGENT); mt[t] = __uint_as_float((unsigned)w); m2[t] = __uint_as_float((unsigned)(w >> 32)); } else { mt[t] = 0.f; m2[t] = 0.f; } ms += mt[t]; }
            const float mean = ms / (float)ntn; float q = 0.f;
#pragma unroll
            for (int t = 0; t < 4; ++t) if (t < ntn) { const float dm = mt[t] - mean; q += m2[t] + 256.0f * dm * dm; }
            S[row] = (f32x2v){mean, 1.0f / sqrtf(q / (256.0f * (float)ntn) + eps)};
        }
        asm volatile("s_waitcnt lgkmcnt(0)" ::: "memory"); __builtin_amdgcn_s_barrier(); asm volatile("" ::: "memory");
        return bad;
    }
};
struct EpiLnRes {
    static constexpr bool PERM = false, AFTER_DRAIN = true;
    const float* base; float* out; int ldc; const float* bias; PanelStats st; unsigned poison;
    __device__ __forceinline__ void refuse(size_t i0, size_t stride, int M, int N) const { const float q = __builtin_nanf(""); for (size_t i = i0; i < (size_t)M * N; i += stride) out[(i / N) * ldc + i % N] = q;
        if (i0 == 0) { unsigned expect = 0u; __hip_atomic_compare_exchange_strong(st.tmo + 1, &expect, 0x7f0u, __ATOMIC_RELAXED, __ATOMIC_RELAXED, __HIP_MEMORY_SCOPE_AGENT); __hip_atomic_store(st.tmo, 1u, __ATOMIC_RELAXED, __HIP_MEMORY_SCOPE_AGENT); } }
    __device__ __forceinline__ void fused(f32x4 (&acc)[2][2][4][2], const Unit& u, int wr, int wc, int fr, int fq, PG8_LAS unsigned char* lds, int wid, int lane) const {
        typedef float f32x2v __attribute__((ext_vector_type(2)));
        const PG8_LAS f32x2v* S = (const PG8_LAS f32x2v*)(lds + 8192);
        const int col0 = u.pn * BM + wc * 32 + 4 * fq;
#pragma unroll
        for (int bj = 0; bj < 2; ++bj)
#pragma unroll
            for (int n = 0; n < 2; ++n) { const f32x4 bv = bias ? *(const f32x4*)(bias + col0 + bj * HALF + n * 16) : (f32x4){0.f, 0.f, 0.f, 0.f};
#pragma unroll
                for (int ai = 0; ai < 2; ++ai)
#pragma unroll
                    for (int m = 0; m < 4; ++m) acc[ai][bj][m][n] += bv; }
        const bool bad = st.run(acc, u, wr, wc, fr, fq, lds, wid, lane) || poison != 0u;
        const float qnan = __builtin_nanf("");
#pragma unroll
        for (int ai = 0; ai < 2; ++ai)
#pragma unroll
            for (int m = 0; m < 4; ++m) { const int r = ai * HALF + wr * 64 + m * 16 + fr; const f32x2v sr = S[r]; const size_t off = (size_t)(u.pm * BM + r) * ldc + col0;
#pragma unroll
                for (int bj = 0; bj < 2; ++bj)
#pragma unroll
                    for (int n = 0; n < 2; ++n) { const f32x4 bs = *(const f32x4*)(base + off + bj * HALF + n * 16); f32x4 o = bs + (acc[ai][bj][m][n] - sr.x) * sr.y;
                        if (bad) o = (f32x4){qnan, qnan, qnan, qnan}; *(f32x4*)(out + off + bj * HALF + n * 16) = o; }
                asm volatile("" ::: "memory"); }
    }
};
struct EpiLnResLn {
    static constexpr bool PERM = false, AFTER_DRAIN = true;
    const float* base; float* out; bf16_t* xn; int ldc; const float* bias; PanelStats st1, st2; unsigned poison;
    __device__ __forceinline__ void refuse(size_t i0, size_t stride, int M, int N) const { const float q = __builtin_nanf(""); for (size_t i = i0; i < (size_t)M * N; i += stride) { const size_t o = (i / N) * ldc + i % N; out[o] = q; xn[o] = (bf16_t)0x7fc0u; }
        if (i0 == 0) { unsigned expect = 0u; __hip_atomic_compare_exchange_strong(st1.tmo + 1, &expect, 0x7f0u, __ATOMIC_RELAXED, __ATOMIC_RELAXED, __HIP_MEMORY_SCOPE_AGENT); __hip_atomic_store(st1.tmo, 1u, __ATOMIC_RELAXED, __HIP_MEMORY_SCOPE_AGENT); } }
    __device__ __forceinline__ void fused(f32x4 (&acc)[2][2][4][2], const Unit& u, int wr, int wc, int fr, int fq, PG8_LAS unsigned char* lds, int wid, int lane) const {
        typedef float f32x2v __attribute__((ext_vector_type(2))); typedef unsigned u32x2v __attribute__((ext_vector_type(2)));
        const PG8_LAS f32x2v* S = (const PG8_LAS f32x2v*)(lds + 8192);
        const int col0 = u.pn * BM + wc * 32 + 4 * fq;
#pragma unroll
        for (int bj = 0; bj < 2; ++bj)
#pragma unroll
            for (int n = 0; n < 2; ++n) { const f32x4 bv = bias ? *(const f32x4*)(bias + col0 + bj * HALF + n * 16) : (f32x4){0.f, 0.f, 0.f, 0.f};
#pragma unroll
                for (int ai = 0; ai < 2; ++ai)
#pragma unroll
                    for (int m = 0; m < 4; ++m) acc[ai][bj][m][n] += bv; }
        bool bad = st1.run(acc, u, wr, wc, fr, fq, lds, wid, lane) || poison != 0u;
        const float qnan = __builtin_nanf("");
#pragma unroll
        for (int ai = 0; ai < 2; ++ai)
#pragma unroll
            for (int m = 0; m < 4; ++m) { const int r = ai * HALF + wr * 64 + m * 16 + fr; const f32x2v sr = S[r]; const size_t off = (size_t)(u.pm * BM + r) * ldc + col0;
#pragma unroll
                for (int bj = 0; bj < 2; ++bj)
#pragma unroll
                    for (int n = 0; n < 2; ++n) { const f32x4 bs = *(const f32x4*)(base + off + bj * HALF + n * 16); acc[ai][bj][m][n] = bs + (acc[ai][bj][m][n] - sr.x) * sr.y; }
                asm volatile("" : "+v"(acc[ai][0][m][0]), "+v"(acc[ai][0][m][1]), "+v"(acc[ai][1][m][0]), "+v"(acc[ai][1][m][1]));
                if (m & 1) asm volatile("" ::: "memory"); }
        const bool bad1 = bad;
        bad = st2.run(acc, u, wr, wc, fr, fq, lds, wid, lane) || bad;
#pragma unroll
        for (int ai = 0; ai < 2; ++ai)
#pragma unroll
            for (int m = 0; m < 4; ++m) { const int r = ai * HALF + wr * 64 + m * 16 + fr; const f32x2v sr = S[r]; const size_t off = (size_t)(u.pm * BM + r) * ldc + col0;
#pragma unroll
                for (int bj = 0; bj < 2; ++bj)
#pragma unroll
                    for (int n = 0; n < 2; ++n) { const f32x4 x1 = acc[ai][bj][m][n]; *(f32x4*)(out + off + bj * HALF + n * 16) = bad1 ? (f32x4){qnan, qnan, qnan, qnan} : x1;
                        const f32x4 o = (x1 - sr.x) * sr.y; u32x2v w; w.x = cvt_pk_bf16(o[0], o[1]); w.y = cvt_pk_bf16(o[2], o[3]);
                        if (bad) { w.x = 0x7fc07fc0u; w.y = 0x7fc07fc0u; } *(u32x2v*)(xn + off + bj * HALF + n * 16) = w; }
                asm volatile("" ::: "memory"); }
    }
};

template <class Epi, class Sched, bool STAMP = false>
__device__ __forceinline__ void gemm_phase(PG8_LAS unsigned char* lds, const Gemm g, const Sched& S, const Epi& E, unsigned long long* stamps) {
    const int tid = threadIdx.x, wid = __builtin_amdgcn_readfirstlane(tid >> 6), lane = tid & 63, wr = wid >> 2, wc = wid & 3, fr = lane & 15, fq = lane >> 4;
    const int K = g.K, nt = K / BK;
    int ts_lo = 0, ts_hi = 0, nts = 0; const unsigned long long rt_entry = STAMP ? (unsigned long long)wall_clock64() : 0ull;
#define PG8_STAMP() do { if (STAMP && wid == 0 && nts < 64) { const unsigned long long _c = (unsigned long long)clock64(); \
        ts_lo = (lane == nts) ? (int)(unsigned)_c : ts_lo; ts_hi = (lane == nts) ? (int)(unsigned)(_c >> 32) : ts_hi; ++nts; } } while (0)
    PG8_STAMP();
    unsigned voffA[2], voffB[2];
#pragma unroll
    for (int i = 0; i < 2; ++i) { int R, C; stage_rc(tid * 16 + i * 8192, R, C); const int Rb = Epi::PERM ? ((R & ~31) + perm32(R & 31)) : R;
        voffA[i] = (unsigned)(R * K + C) * 2u; voffB[i] = (unsigned)(Rb * K + C) * 2u; }
    const size_t kstep = (size_t)(BK * 2);
    const size_t hstep = (size_t)HALF * K * 2;
    const size_t tstep = 2 * hstep;
    const unsigned ldsw = (unsigned)wid * 1024u;
    const int aoff = lds_byte(wr * 64 + fr, fq * 8), boff = lds_byte(wc * 32 + fr, fq * 8);
#define PG8_SA(b, h) (((b) * 2 + (h)) * HTB)
#define PG8_SB(b, h) ((4 + (b) * 2 + (h)) * HTB)
#define PG8_STAGE(bufoff, gbase, voff) do { _Pragma("unroll") for (int _i = 0; _i < 2; ++_i) \
        __builtin_amdgcn_global_load_lds((const unsigned*)((const char*)(gbase) + (voff)[_i]), (PG8_LAS unsigned*)(lds + (bufoff) + ldsw + _i * 8192), 16, 0, 0); } while (0)
#define PG8_LDA(dst, b, h) do { _Pragma("unroll") for (int m = 0; m < 4; ++m) _Pragma("unroll") for (int k = 0; k < 2; ++k) dst[m][k] = *(const PG8_LAS bf16x8*)(lds + PG8_SA(b, h) + aoff + m * 2048 + k * 1024); } while (0)
#define PG8_LDB(dst, b, h) do { _Pragma("unroll") for (int n = 0; n < 2; ++n) _Pragma("unroll") for (int k = 0; k < 2; ++k) dst[n][k] = *(const PG8_LAS bf16x8*)(lds + PG8_SB(b, h) + boff + n * 2048 + k * 1024); } while (0)
#define PG8_MMA(ai, bj, At, Bt) do { __builtin_amdgcn_s_setprio(1); _Pragma("unroll") for (int m = 0; m < 4; ++m) _Pragma("unroll") for (int n = 0; n < 2; ++n) _Pragma("unroll") for (int k = 0; k < 2; ++k) \
        acc[ai][bj][m][n] = __builtin_amdgcn_mfma_f32_16x16x32_bf16(Bt[n][k], At[m][k], acc[ai][bj][m][n], 0, 0, 0); __builtin_amdgcn_s_setprio(0); } while (0)
#define PG8_WAIT_V(n) asm volatile("s_waitcnt vmcnt(" #n ")" ::: "memory")
#define PG8_WAIT_L(n) asm volatile("s_waitcnt lgkmcnt(" #n ")" ::: "memory")
#define PG8_BAR __builtin_amdgcn_s_barrier()
#define PG8_SCHED __builtin_amdgcn_sched_barrier(0)
    Unit cur, nxt; int ui = 0;
    if (!S.next(0, cur)) return;
    f32x4 acc[2][2][4][2];
#pragma unroll
    for (int a = 0; a < 2; ++a)
#pragma unroll
        for (int b = 0; b < 2; ++b)
#pragma unroll
            for (int m = 0; m < 4; ++m)
#pragma unroll
                for (int n = 0; n < 2; ++n) acc[a][b][m][n] = (f32x4){0.f, 0.f, 0.f, 0.f};
    bf16x8 At[4][2], B0[2][2], B1[2][2];
    const char* cA = (const char*)g.A + (size_t)cur.pm * tstep; const char* cB = (const char*)g.Bt + (size_t)cur.pn * tstep;
    S.a_ready(cur);
    PG8_STAGE(PG8_SB(0, 0), cB, voffB); PG8_STAGE(PG8_SA(0, 0), cA, voffA); PG8_STAGE(PG8_SB(0, 1), cB + hstep, voffB); PG8_STAGE(PG8_SA(0, 1), cA + hstep, voffA);
    if (wr == 1) PG8_BAR;
    PG8_WAIT_V(4); PG8_BAR;
    PG8_STAGE(PG8_SB(1, 0), cB + kstep, voffB); PG8_STAGE(PG8_SA(1, 0), cA + kstep, voffA); PG8_STAGE(PG8_SB(1, 1), cB + hstep + kstep, voffB);
    PG8_WAIT_V(6); PG8_BAR;
    PG8_STAMP();
    for (;;) {
        const bool has_next = S.next(ui + 1, nxt);
        const char* nA = has_next ? (const char*)g.A + (size_t)nxt.pm * tstep : cA; const char* nB = has_next ? (const char*)g.Bt + (size_t)nxt.pn * tstep : cB;
        for (int t = 0; t < nt; t += 2) {
            const bool last = (t == nt - 2);
            const char* a1 = cA + (size_t)(t + 1) * kstep;
            const char* a2 = last ? nA : cA + (size_t)(t + 2) * kstep; const char* b2 = last ? nB : cB + (size_t)(t + 2) * kstep;
            const char* a3 = a2 + kstep; const char* b3 = b2 + kstep;
            if (last && has_next) S.a_ready(nxt);
            PG8_LDB(B0, 0, 0); PG8_SCHED; PG8_LDA(At, 0, 0); PG8_STAGE(PG8_SA(1, 1), a1 + hstep, voffA);
            PG8_WAIT_L(8); PG8_BAR; PG8_WAIT_L(0); PG8_MMA(0, 0, At, B0); PG8_BAR; PG8_SCHED;
            PG8_LDB(B1, 0, 1); PG8_STAGE(PG8_SB(0, 0), b2, voffB);
            PG8_BAR; PG8_WAIT_L(0); PG8_MMA(0, 1, At, B1); PG8_BAR;
            PG8_LDA(At, 0, 1); PG8_STAGE(PG8_SA(0, 0), a2, voffA);
            PG8_BAR; PG8_WAIT_L(0); PG8_MMA(1, 0, At, B0); PG8_BAR; PG8_SCHED;
            PG8_STAGE(PG8_SB(0, 1), b2 + hstep, voffB);
            PG8_WAIT_V(6); PG8_BAR; PG8_MMA(1, 1, At, B1); PG8_BAR;
            PG8_LDB(B0, 1, 0); PG8_SCHED; PG8_LDA(At, 1, 0); PG8_STAGE(PG8_SA(0, 1), a2 + hstep, voffA);
            PG8_WAIT_L(8); PG8_BAR; PG8_WAIT_L(0); PG8_MMA(0, 0, At, B0); PG8_BAR; PG8_SCHED;
            PG8_LDB(B1, 1, 1); PG8_STAGE(PG8_SB(1, 0), b3, voffB);
            PG8_BAR; PG8_WAIT_L(0); PG8_MMA(0, 1, At, B1); PG8_BAR;
            PG8_LDA(At, 1, 1); PG8_STAGE(PG8_SA(1, 0), a3, voffA);
            PG8_BAR; PG8_WAIT_L(0); PG8_MMA(1, 0, At, B0); PG8_BAR; PG8_SCHED;
            PG8_STAGE(PG8_SB(1, 1), b3 + hstep, voffB);
            PG8_WAIT_V(6); PG8_BAR; PG8_MMA(1, 1, At, B1); PG8_BAR;
        }
        PG8_STAMP();
        if constexpr (!Epi::AFTER_DRAIN) { E(acc, cur, wr, wc, fr, fq); S.done(cur); }
        PG8_STAMP();
        if (!has_next) break;
#pragma unroll
        for (int a = 0; a < 2; ++a)
#pragma unroll
            for (int b = 0; b < 2; ++b)
#pragma unroll
                for (int m = 0; m < 4; ++m)
#pragma unroll
                    for (int n = 0; n < 2; ++n) acc[a][b][m][n] = (f32x4){0.f, 0.f, 0.f, 0.f};
        cur = nxt; cA = nA; cB = nB; ++ui;
    }
    PG8_WAIT_V(0);
    if (wr == 0) PG8_BAR;
    PG8_BAR;
    if constexpr (Epi::AFTER_DRAIN) { E.fused(acc, cur, wr, wc, fr, fq, lds, wid, lane); S.done(cur); }
    PG8_STAMP();
    if (STAMP && wid == 0) { stamps[lane] = lane < nts ? (((unsigned long long)(unsigned)ts_hi << 32) | (unsigned)ts_lo) : 0ull;
        if (lane == 62) stamps[62] = rt_entry; if (lane == 63) stamps[63] = (unsigned long long)wall_clock64(); }
#undef PG8_STAMP
#undef PG8_SA
#undef PG8_SB
#undef PG8_STAGE
#undef PG8_LDA
#undef PG8_LDB
#undef PG8_MMA
#undef PG8_WAIT_V
#undef PG8_WAIT_L
#undef PG8_BAR
#undef PG8_SCHED
}
}
#define XB_TMO      128
#define XB_XCNT(j)  (256  + 64 * (j))
#define XB_XSUB(j)  (1280 + 64 * (j))
#define XB_XGEN(j)  (2304 + 64 * (j))
#define XB_TOP      3328
#define XB_TOPGEN   3392
#define XCD_BAR_WORDS 3456
#define XB_SPIN_CAP (1u << 18)
#define LAS __attribute__((address_space(3)))

__device__ __forceinline__ unsigned xb_ld(unsigned* p)              { return __hip_atomic_load(p, __ATOMIC_RELAXED, __HIP_MEMORY_SCOPE_AGENT); }
__device__ __forceinline__ unsigned xb_add(unsigned* p, unsigned v) { return __hip_atomic_fetch_add(p, v, __ATOMIC_RELAXED, __HIP_MEMORY_SCOPE_AGENT); }
__device__ __forceinline__ unsigned xb_xcc_id() { return (unsigned)__builtin_amdgcn_s_getreg((3 << 11) | 20) & 0xFu; }
#define XB_SPIN(cond, bar) do { unsigned _sp = 0; while (cond) { __builtin_amdgcn_s_sleep(1); \
    if ((++_sp & 255u) == 0u) { if (xb_ld(&(bar)[XB_TMO])) break; if (_sp > XB_SPIN_CAP) { atomicAdd(&(bar)[XB_TMO], 1u); break; } } } } while (0)

struct XcdBarrier {
    unsigned* bar; unsigned x;
    volatile LAS unsigned* st;
};

__device__ __forceinline__ XcdBarrier xcd_barrier_post(unsigned* bar, volatile LAS unsigned* st) {
    XcdBarrier b; b.bar = bar; b.x = xb_xcc_id(); b.st = st;
    if (threadIdx.x == 0) (void)xb_add(&bar[XB_XCNT(b.x)], 1u);
    return b;
}
__device__ __forceinline__ void xcd_barrier_complete(unsigned* bar, unsigned x, unsigned& nloc, unsigned& nx) {
    const unsigned G = gridDim.x * gridDim.y * gridDim.z;
    unsigned sum, cnt, mine, sp = 0u;
    for (;;) {
        sum = 0u; cnt = 0u; mine = 0u;
#pragma unroll
        for (unsigned j = 0; j < 16; ++j) { const unsigned c = xb_ld(&bar[XB_XCNT(j)]); sum += c; cnt += (c > 0u) ? 1u : 0u; mine = (j == x) ? c : mine; }
        if (sum == G) break;
        __builtin_amdgcn_s_sleep(1);
        if ((++sp & 255u) == 0u) { if (xb_ld(&bar[XB_TMO])) break; if (sp > XB_SPIN_CAP) { atomicAdd(&bar[XB_TMO], 1u); break; } }
    }
    nloc = mine > 0u ? mine : 1u; nx = cnt > 0u ? cnt : 1u;
}

__device__ __forceinline__ void xcd_barrier(const XcdBarrier& b) {
    asm volatile("s_waitcnt vmcnt(0)" ::: "memory");
    __syncthreads();
    if (threadIdx.x == 0) {
        unsigned* bar = b.bar;
        __builtin_amdgcn_s_waitcnt(0);
        unsigned nloc = b.st[0], nx = b.st[1];
        if (nloc == 0u) { xcd_barrier_complete(bar, b.x, nloc, nx); b.st[0] = nloc; b.st[1] = nx; }
        const unsigned old = xb_add(&bar[XB_XSUB(b.x)], 1u);
        const unsigned gen = old / nloc;
        if (old + 1u == (gen + 1u) * nloc) {
            __builtin_amdgcn_fence(__ATOMIC_RELEASE, "agent");
            asm volatile("s_waitcnt vmcnt(0)" ::: "memory");
            const unsigned og = xb_add(&bar[XB_TOP], 1u);
            const unsigned tg = og / nx;
            if (og + 1u == (tg + 1u) * nx) xb_add(&bar[XB_TOPGEN], 1u);
            else XB_SPIN(xb_ld(&bar[XB_TOPGEN]) == tg, bar);
            __builtin_amdgcn_fence(__ATOMIC_ACQUIRE, "agent");
            xb_add(&bar[XB_XGEN(b.x)], 1u);
            asm volatile("s_waitcnt vmcnt(0)" ::: "memory");
        } else {
            XB_SPIN(xb_ld(&bar[XB_XGEN(b.x)]) == gen, bar);
            __builtin_amdgcn_fence(__ATOMIC_ACQUIRE, "agent");
            asm volatile("s_waitcnt vmcnt(0)" ::: "memory");
        }
    }
    __syncthreads();
}


namespace mk {
typedef unsigned short bf16_t;
typedef float f32x4 __attribute__((ext_vector_type(4)));
typedef short bf16x8 __attribute__((ext_vector_type(8)));
typedef short s16x4 __attribute__((ext_vector_type(4)));
typedef unsigned u32x4 __attribute__((ext_vector_type(4)));
typedef unsigned u32x2 __attribute__((ext_vector_type(2)));
typedef float f32x2 __attribute__((ext_vector_type(2)));
constexpr int D = 2048, NTOK_P = 16384, NTOK_S = 256, NTOK = 16640;
constexpr int DIN = 5632, DATT = 1536, DLRU = 512, NH = 12, HD = 128;
constexpr int NEXP = 16384;
constexpr float ALPHA = 1.189207115002721f;
constexpr float LN_EPS = 1e-5f;
constexpr float ATT_SCALE = 0.08838834764831845f;
constexpr float LOG2E = 1.4426950408889634f;
constexpr size_t O_YP = 0, O_YS = 33554432, O_KP = 34078720, O_VP = 59244544, O_CP = 84410368, O_HP = 84422656,
                 O_KS = 84426752, O_VS = 185090048, O_CS = 285753344, O_HS = 285802496, O_END = 285818880;
constexpr size_t WS_CTL = 0;
constexpr size_t WS_XB = 65536;
constexpr size_t WS_WINT = WS_XB + (size_t)NTOK * D * 2;
constexpr size_t WS_WOT = WS_WINT + (size_t)DIN * D * 2;
constexpr size_t WS_WQT = WS_WOT + (size_t)D * D * 2;
constexpr size_t WS_UB = WS_WQT + (size_t)D * D * 2;
constexpr size_t WS_VB = WS_UB + (size_t)NEXP * D * 2;
constexpr size_t WS_QF = WS_VB + (size_t)NEXP * D * 2;
constexpr size_t WS_XR = WS_QF + (size_t)NTOK * DATT * 4;
constexpr size_t WS_GATE = WS_XR + (size_t)NTOK * DLRU * 4;
constexpr size_t WS_AR = WS_GATE + (size_t)NTOK * DLRU * 4;
constexpr size_t WS_PRE1 = WS_AR + (size_t)NTOK * D * 2;
constexpr size_t WS_X1F = WS_PRE1 + (size_t)NTOK * D * 4;
constexpr size_t WS_X1B = WS_X1F + (size_t)NTOK * D * 4;
constexpr size_t WS_QP = WS_X1B + (size_t)NTOK * D * 2;
constexpr size_t WS_EIDX = WS_QP + (size_t)NTOK * D * 4;
constexpr size_t WS_GW = WS_EIDX + (size_t)NTOK * 128 * 4;
constexpr size_t WS_SU = WS_GW + (size_t)NTOK * 128 * 4;
constexpr size_t WS_SV = WS_SU + (size_t)NEXP * 4;
constexpr size_t WS_SX = WS_SV + (size_t)NEXP * 4;
constexpr size_t WS_X1Q = WS_SX + (size_t)NTOK * 4;
constexpr size_t WS_SKB = WS_X1Q + (size_t)NTOK * D;
constexpr size_t WS_QB = WS_SKB + (size_t)8 * 2 * 128 * 128 * 2;
constexpr size_t WS_KB = WS_QB + (size_t)NTOK * DATT * 2;
constexpr size_t WS_VB16 = WS_KB + (size_t)NTOK_P * DATT * 2;
constexpr size_t WS_PO = WS_VB16 + (size_t)NTOK_P * DATT * 2;
constexpr size_t WS_PM = WS_PO + (size_t)2 * NTOK_P * DATT * 2;
constexpr size_t WS_PL = WS_PM + (size_t)2 * NTOK_P * NH * 4;
constexpr size_t WS_R0 = WS_PL + (size_t)2 * NTOK_P * NH * 4;
constexpr size_t WS_R1 = WS_R0 + (size_t)NTOK_P * DLRU * 4;
constexpr size_t WS_HE = WS_R1 + (size_t)NTOK_P * DLRU * 4;
constexpr size_t WS_AE = WS_HE + (size_t)8 * 32 * 512 * 4;
constexpr size_t WS_PS = WS_AE + (size_t)8 * 32 * 512 * 4;
constexpr size_t WS_END = WS_PS + (size_t)32 * 12 * 9 * 8 * 130 * 4;

constexpr int NTHREADS = 512;
constexpr int LDS_BYTES = 148480;
constexpr int MISC_OFF = 147456;

struct Params {
    const float* x_prompt; const float* x_sample; const float* cache_k; const float* cache_v; const float* state_conv; const float* state_h;
    const float* w_in; const float* conv_w; const float* conv_b; const float* lru_w_a; const float* lru_b_a; const float* lru_w_x; const float* lru_b_x;
    const float* lru_lambda; const float* w_out; const float* ln1_g; const float* ln1_b; const float* w_query; const float* sub_keys;
    const float* peer_u; const float* peer_v; const float* ln2_g; const float* ln2_b;
    float* out; unsigned char* ws; int ph_lo, ph_hi;
};

__device__ __forceinline__ unsigned f2bf(float f) { unsigned u = __float_as_uint(f); u += 0x7fffu + ((u >> 16) & 1u); return u >> 16; }
__device__ __forceinline__ unsigned pack2(float a, float b) { return f2bf(a) | (f2bf(b) << 16); }
__device__ __forceinline__ float bflo(unsigned w) { return __uint_as_float(w << 16); }
__device__ __forceinline__ float bfhi(unsigned w) { return __uint_as_float(w & 0xffff0000u); }
__device__ __forceinline__ float wave_sum(float v) {
#pragma unroll
    for (int o = 32; o >= 1; o >>= 1) v += __shfl_xor(v, o);
    return v;
}
__device__ __forceinline__ float wave_max(float v) {
#pragma unroll
    for (int o = 32; o >= 1; o >>= 1) v = fmaxf(v, __shfl_xor(v, o));
    return v;
}
__device__ __forceinline__ float gelu_exact(float v) { return 0.5f * v * (1.0f + erff(v * 0.7071067811865476f)); }
__device__ __forceinline__ float gelu_as(float v) {
    const float av = fabsf(v), t = __builtin_amdgcn_rcpf(av * 0.2316418882f + 1.0f);
    float q = t * 0.5307027145f + (-0.7265760135f); q = q * t + 0.7107068705f; q = q * t + (-0.142248368f); q = q * t + 0.127414796f; q = q * t;
    const float e = __builtin_amdgcn_exp2f((v * v) * (-0.72134752044f));
    const float m = v * (q * e);
    return v < 0.f ? m : v - m;
}
__device__ __forceinline__ float sigmoidf(float v) { return 1.0f / (1.0f + expf(-v)); }
__device__ __forceinline__ float readlane_f(float v, int l) { return __int_as_float(__builtin_amdgcn_readlane(__float_as_int(v), l)); }

__device__ __forceinline__ void convert_flat(const float* src, bf16_t* dst, size_t n8, size_t gtid, size_t gstride) {
    for (size_t i = gtid; i < n8; i += gstride) {
        const float4 a = ((const float4*)src)[2 * i], b = ((const float4*)src)[2 * i + 1];
        uint4 w; w.x = pack2(a.x, a.y); w.y = pack2(a.z, a.w); w.z = pack2(b.x, b.y); w.w = pack2(b.z, b.w);
        ((uint4*)dst)[i] = w;
    }
}
__device__ __forceinline__ void transpose_convert(const float* src, bf16_t* dst, int K, int N, LAS float* tile) {
    const int tid = threadIdx.x, ntn = N / 64, ntiles = (K / 64) * ntn;
    for (int tl = blockIdx.x; tl < ntiles; tl += gridDim.x) {
        const int kt = tl / ntn, nt = tl - kt * ntn;
#pragma unroll
        for (int i = 0; i < 8; ++i) { const int r = (tid >> 6) + 8 * i, c = tid & 63; tile[r * 65 + c] = src[(size_t)(kt * 64 + r) * N + nt * 64 + c]; }
        __syncthreads();
#pragma unroll
        for (int i = 0; i < 4; ++i) { const int n = (tid >> 5) + 16 * i, k0 = 2 * (tid & 31);
            const unsigned v = pack2(tile[k0 * 65 + n], tile[(k0 + 1) * 65 + n]);
            *(unsigned*)(dst + (size_t)(nt * 64 + n) * K + kt * 64 + k0) = v; }
        __syncthreads();
    }
}
constexpr int TROW = 1152;
__device__ __forceinline__ void quant_tables(const Params& P) {
    const int lane = threadIdx.x & 63, gw = blockIdx.x * 8 + (threadIdx.x >> 6), nw = gridDim.x * 8;
    for (int it = gw; it < 2 * NEXP; it += nw) {
        const bool isv = it >= NEXP; const int row = isv ? it - NEXP : it;
        const float* src = (isv ? P.peer_v : P.peer_u) + (size_t)row * D;
        float4 v[8]; float cm[2];
#pragma unroll
        for (int j = 0; j < 2; ++j) { float am = 0.f;
#pragma unroll
            for (int i = 0; i < 4; ++i) { const float4 t = *(const float4*)(src + j * 1024 + lane * 16 + i * 4); v[j * 4 + i] = t; am = fmaxf(am, fmaxf(fmaxf(fabsf(t.x), fabsf(t.y)), fmaxf(fabsf(t.z), fabsf(t.w)))); }
            cm[j] = am; }
        float rm = wave_max(fmaxf(cm[0], cm[1])); if (rm == 0.f) rm = 1.f;
        unsigned char* dst = P.ws + (isv ? WS_VB : WS_UB) + (size_t)row * TROW;
        u32x4 w; unsigned sqp = 0u;
#pragma unroll
        for (int j = 0; j < 2; ++j) {
            int sq = (int)ceilf(cm[j] / rm * 255.0f); sq = sq < 1 ? 1 : (sq > 255 ? 255 : sq);
            sqp |= (unsigned)sq << (8 * j);
            const float inv = (255.0f * 7.0f) / (rm * (float)sq);
#pragma unroll
            for (int hh = 0; hh < 2; ++hh) { unsigned dw = 0u;
#pragma unroll
                for (int e = 0; e < 8; ++e) { const float4 t = v[j * 4 + hh * 2 + (e >> 2)]; const float x = (e & 3) == 0 ? t.x : ((e & 3) == 1 ? t.y : ((e & 3) == 2 ? t.z : t.w));
                    int n = (int)rintf(x * inv); n = n < -7 ? -7 : (n > 7 ? 7 : n); dw |= (unsigned)(n + 8) << (4 * e); }
                w[j * 2 + hh] = dw; }
        }
        *(u32x4*)(dst + lane * 16) = w;
        *(unsigned short*)(dst + 1024 + lane * 2) = (unsigned short)sqp;
        if (lane == 0) ((float*)(P.ws + (isv ? WS_SV : WS_SU)))[row] = rm * (1.0f / (255.0f * 7.0f));
    }
}
__device__ __forceinline__ void phase_prologue(const Params& P, LAS unsigned char* lds) {
    const size_t gtid = (size_t)blockIdx.x * NTHREADS + threadIdx.x, gstride = (size_t)gridDim.x * NTHREADS;
    unsigned char* ws = P.ws;
    convert_flat(P.x_prompt, (bf16_t*)(ws + WS_XB), (size_t)NTOK_P * D / 8, gtid, gstride);
    convert_flat(P.x_sample, (bf16_t*)(ws + WS_XB) + (size_t)NTOK_P * D, (size_t)NTOK_S * D / 8, gtid, gstride);
    quant_tables(P);
    convert_flat(P.sub_keys, (bf16_t*)(ws + WS_SKB), (size_t)8 * 2 * 128 * 128 / 8, gtid, gstride);
    transpose_convert(P.w_in, (bf16_t*)(ws + WS_WINT), D, DIN, (LAS float*)lds);
    transpose_convert(P.w_out, (bf16_t*)(ws + WS_WOT), D, D, (LAS float*)lds);
    transpose_convert(P.w_query, (bf16_t*)(ws + WS_WQT), D, D, (LAS float*)lds);
}

struct EpiProj {
    static constexpr bool PERM = false, AFTER_DRAIN = false;
    float* out; float* QF; float* XR; float* GATE; bf16_t* QB; bf16_t* KB; bf16_t* VB16;
    __device__ __forceinline__ void operator()(const f32x4 (&acc)[2][2][4][2], const pg8::Unit& u, int wr, int wc, int fr, int fq) const {
        const int pn = u.pn; const int coff = wc * 32 + 4 * fq;
#pragma unroll
        for (int ai = 0; ai < 2; ++ai)
#pragma unroll
            for (int m = 0; m < 4; ++m) {
                const int row = u.pm * 256 + ai * 128 + wr * 64 + m * 16 + fr;
                const bool prompt = row < NTOK_P;
                float* rowp = nullptr; bf16_t* rowb = nullptr; float bsc = 1.0f;
                if (pn < 6) { rowb = QB + (size_t)row * DATT + pn * 256; bsc = ATT_SCALE * LOG2E; }
                else if (pn < 18) {
                    const int isv = pn >= 12; const int c0 = (pn - (isv ? 12 : 6)) * 256;
                    if (prompt) { rowp = out + (isv ? O_VP : O_KP) + (size_t)row * DATT + c0; rowb = (isv ? VB16 : KB) + (size_t)row * DATT + c0; }
                    else { const int rr = row - NTOK_P, b = rr >> 3, t = rr & 7; rowp = out + (isv ? O_VS : O_KS) + ((size_t)b * 2048 + 2040 + t) * DATT + c0; }
                } else if (pn < 20) rowp = XR + (size_t)row * DLRU + (pn - 18) * 256;
                else rowp = GATE + (size_t)row * DLRU + (pn - 20) * 256;
#pragma unroll
                for (int bj = 0; bj < 2; ++bj)
#pragma unroll
                    for (int n = 0; n < 2; ++n) {
                        const f32x4 v = acc[ai][bj][m][n];
                        if (rowp) *(f32x4*)(rowp + coff + bj * 128 + n * 16) = v;
                        if (rowb) { u32x2 w; w.x = pg8::cvt_pk_bf16(v[0] * bsc, v[1] * bsc); w.y = pg8::cvt_pk_bf16(v[2] * bsc, v[3] * bsc); *(u32x2*)(rowb + coff + bj * 128 + n * 16) = w; }
                    }
            }
    }
};
struct EpiOut {
    static constexpr bool PERM = false, AFTER_DRAIN = false;
    const float* xp; const float* xs; float* pre;
    __device__ __forceinline__ void operator()(const f32x4 (&acc)[2][2][4][2], const pg8::Unit& u, int wr, int wc, int fr, int fq) const {
        const int col0 = u.pn * 256 + wc * 32 + 4 * fq;
#pragma unroll
        for (int ai = 0; ai < 2; ++ai)
#pragma unroll
            for (int m = 0; m < 4; ++m) {
                const int row = u.pm * 256 + ai * 128 + wr * 64 + m * 16 + fr;
                const float* xr = (row < NTOK_P ? xp + (size_t)row * D : xs + (size_t)(row - NTOK_P) * D) + col0;
                float* pr = pre + (size_t)row * D + col0;
#pragma unroll
                for (int bj = 0; bj < 2; ++bj)
#pragma unroll
                    for (int n = 0; n < 2; ++n) { const f32x4 xv = *(const f32x4*)(xr + bj * 128 + n * 16); *(f32x4*)(pr + bj * 128 + n * 16) = xv * ALPHA + acc[ai][bj][m][n]; }
            }
    }
};
struct EpiPlain {
    static constexpr bool PERM = false, AFTER_DRAIN = false;
    float* C; int ldc;
    __device__ __forceinline__ void operator()(const f32x4 (&acc)[2][2][4][2], const pg8::Unit& u, int wr, int wc, int fr, int fq) const {
        const int col0 = u.pn * 256 + wc * 32 + 4 * fq;
#pragma unroll
        for (int ai = 0; ai < 2; ++ai)
#pragma unroll
            for (int m = 0; m < 4; ++m) {
                const int row = u.pm * 256 + ai * 128 + wr * 64 + m * 16 + fr;
                float* pr = C + (size_t)row * ldc + col0;
#pragma unroll
                for (int bj = 0; bj < 2; ++bj)
#pragma unroll
                    for (int n = 0; n < 2; ++n) *(f32x4*)(pr + bj * 128 + n * 16) = acc[ai][bj][m][n];
            }
    }
};

struct EpiBf16Plain {
    static constexpr bool PERM = false, AFTER_DRAIN = false;
    bf16_t* C; int ldc;
    __device__ __forceinline__ void operator()(const f32x4 (&acc)[2][2][4][2], const pg8::Unit& u, int wr, int wc, int fr, int fq) const {
        const int col0 = u.pn * 256 + wc * 32 + 4 * fq;
#pragma unroll
        for (int ai = 0; ai < 2; ++ai)
#pragma unroll
            for (int m = 0; m < 4; ++m) {
                const int row = u.pm * 256 + ai * 128 + wr * 64 + m * 16 + fr;
                bf16_t* pr = C + (size_t)row * ldc + col0;
#pragma unroll
                for (int bj = 0; bj < 2; ++bj)
#pragma unroll
                    for (int n = 0; n < 2; ++n) { const f32x4 v = acc[ai][bj][m][n]; u32x2 w; w.x = pg8::cvt_pk_bf16(v[0], v[1]); w.y = pg8::cvt_pk_bf16(v[2], v[3]); *(u32x2*)(pr + bj * 128 + n * 16) = w; }
            }
    }
};

template <int MODE>
__device__ __forceinline__ void sample_rows_gemm(const Params& P, const bf16_t* A, const bf16_t* Wt) {
    const int lane = threadIdx.x & 63, w = __builtin_amdgcn_readfirstlane(threadIdx.x >> 6);
    const int c = lane & 15, g = lane >> 4;
    const int ncol = D / (int)gridDim.x;
    const int n0 = blockIdx.x * ncol;
    const int t0 = NTOK_P + 32 * w;
    const bf16_t* wrow = Wt + (size_t)(n0 + (c < ncol ? c : ncol - 1)) * D + 8 * g;
    const bf16_t* x0 = A + (size_t)(t0 + c) * D + 8 * g; const bf16_t* x1 = x0 + (size_t)16 * D;
    f32x4 acc0 = {0.f, 0.f, 0.f, 0.f}, acc1 = {0.f, 0.f, 0.f, 0.f};
#pragma unroll 8
    for (int ks = 0; ks < D / 32; ++ks) {
        const bf16x8 wf = *(const bf16x8*)(wrow + 32 * ks), b0 = *(const bf16x8*)(x0 + 32 * ks), b1 = *(const bf16x8*)(x1 + 32 * ks);
        acc0 = __builtin_amdgcn_mfma_f32_16x16x32_bf16(wf, b0, acc0, 0, 0, 0); acc1 = __builtin_amdgcn_mfma_f32_16x16x32_bf16(wf, b1, acc1, 0, 0, 0);
    }
    if (4 * g < ncol) {
#pragma unroll
        for (int tt = 0; tt < 2; ++tt) {
            const int row = t0 + 16 * tt + c; const f32x4 a = tt ? acc1 : acc0; const int col = n0 + 4 * g;
            if (MODE == 0) { const f32x4 xv = *(const f32x4*)(P.x_sample + (size_t)(row - NTOK_P) * D + col); *(f32x4*)((float*)(P.ws + WS_PRE1) + (size_t)row * D + col) = xv * ALPHA + a; }
            else { u32x2 wv; wv.x = pg8::cvt_pk_bf16(a[0], a[1]); wv.y = pg8::cvt_pk_bf16(a[2], a[3]); *(u32x2*)((bf16_t*)(P.ws + WS_QP) + (size_t)row * D + col) = wv; }
        }
    }
}

constexpr int KVS = 288, VOFF = 73728;
template <int MODE>
__device__ __forceinline__ void attn_unit(const Params& P, int p, int b, int h, int r, int c, LAS unsigned char* lds) {
    const int tid = threadIdx.x, lane = tid & 63, w = __builtin_amdgcn_readfirstlane(tid >> 6);
    const int dil = 1 << (2 * p);
    const bf16_t* Qb = (const bf16_t*)(P.ws + WS_QB); const bf16_t* Kb = (const bf16_t*)(P.ws + WS_KB); const bf16_t* Vb = (const bf16_t*)(P.ws + WS_VB16);
    const size_t tok0 = (size_t)b * 2048;
    const int j0 = 128 * c - 128, rho0 = (c == 0) ? 128 : 0;
#pragma unroll
    for (int it = 0; it < 8; ++it) {
        const int rho = it * 32 + (tid >> 4), ch = tid & 15;
        if (rho >= rho0) {
            const size_t tok = tok0 + (size_t)((j0 + rho) * dil + r);
            const u32x4 kv = *(const u32x4*)(Kb + tok * DATT + h * HD + ch * 8);
            const u32x4 vv = *(const u32x4*)(Vb + tok * DATT + h * HD + ch * 8);
            *(LAS u32x4*)(lds + rho * KVS + ch * 16) = kv;
            *(LAS u32x4*)(lds + VOFF + rho * KVS + ch * 16) = vv;
        }
    }
    const int cq = lane & 15, g = lane >> 4;
    const int iq = 128 * c + 16 * w + cq;
    const size_t qtok = tok0 + (size_t)(iq * dil + r);
    bf16x8 qf[4];
#pragma unroll
    for (int ks = 0; ks < 4; ++ks) qf[ks] = *(const bf16x8*)(Qb + qtok * DATT + h * HD + 32 * ks + 8 * g);
    __syncthreads();
    const int ktmin = (8 - w - 8 * c) > 0 ? (8 - w - 8 * c) : 0;
    const float slope2 = exp2f(-8.0f * (float)(h + 1) / 12.0f) * LOG2E * (float)dil;
    f32x4 s[9]; float m = -INFINITY;
#pragma unroll
    for (int kt = 0; kt < 9; ++kt) {
        if (kt >= ktmin) {
            f32x4 acc = {0.f, 0.f, 0.f, 0.f};
#pragma unroll
            for (int ks = 0; ks < 4; ++ks) { const bf16x8 kf = *(const LAS bf16x8*)(lds + (16 * w + 16 * kt + cq) * KVS + (32 * ks + 8 * g) * 2); acc = __builtin_amdgcn_mfma_f32_16x16x32_bf16(kf, qf[ks], acc, 0, 0, 0); }
#pragma unroll
            for (int ii = 0; ii < 4; ++ii) { const int dist = cq + 128 - 16 * kt - 4 * g - ii; float v = acc[ii] - slope2 * (float)dist;
                if (kt == 0 && dist > 128) v = -INFINITY; if (kt == 8 && dist < 0) v = -INFINITY; acc[ii] = v; m = fmaxf(m, v); }
            s[kt] = acc;
        } else s[kt] = (f32x4){-INFINITY, -INFINITY, -INFINITY, -INFINITY};
    }
    m = fmaxf(m, __shfl_xor(m, 16)); m = fmaxf(m, __shfl_xor(m, 32));
    float l = 0.f;
#pragma unroll
    for (int kt = 0; kt < 9; ++kt)
#pragma unroll
        for (int ii = 0; ii < 4; ++ii) { const float pp = exp2f(s[kt][ii] - m); s[kt][ii] = pp; l += pp; }
    l += __shfl_xor(l, 16); l += __shfl_xor(l, 32);
    f32x4 o[8];
#pragma unroll
    for (int dt = 0; dt < 8; ++dt) o[dt] = (f32x4){0.f, 0.f, 0.f, 0.f};
#pragma unroll
    for (int kk = 0; kk < 5; ++kk) {
        const int T0 = 2 * kk, T1 = 2 * kk + 1;
        if (T1 >= ktmin || T0 == 8) {
            u32x4 pw; pw.x = pg8::cvt_pk_bf16(s[T0][0], s[T0][1]); pw.y = pg8::cvt_pk_bf16(s[T0][2], s[T0][3]);
            if (T1 <= 8) { pw.z = pg8::cvt_pk_bf16(s[T1 <= 8 ? T1 : 8][0], s[T1 <= 8 ? T1 : 8][1]); pw.w = pg8::cvt_pk_bf16(s[T1 <= 8 ? T1 : 8][2], s[T1 <= 8 ? T1 : 8][3]); } else { pw.z = 0u; pw.w = 0u; }
            const bf16x8 pf = __builtin_bit_cast(bf16x8, pw);
            const int rT0 = (T0 >= ktmin) ? T0 : 8, rT1 = (T1 <= 8 && T1 >= ktmin) ? T1 : 8;
            const int a0 = VOFF + (16 * w + 16 * rT0 + 4 * g + (cq >> 2)) * KVS + 8 * (cq & 3);
            const int a1 = VOFF + (16 * w + 16 * rT1 + 4 * g + (cq >> 2)) * KVS + 8 * (cq & 3);
#pragma unroll
            for (int dt = 0; dt < 8; ++dt) {
                const s16x4 v0 = __builtin_amdgcn_ds_read_tr16_b64_v4i16((LAS s16x4*)(lds + a0 + dt * 32));
                const s16x4 v1 = __builtin_amdgcn_ds_read_tr16_b64_v4i16((LAS s16x4*)(lds + a1 + dt * 32));
                const bf16x8 vf = {v0[0], v0[1], v0[2], v0[3], v1[0], v1[1], v1[2], v1[3]};
                o[dt] = __builtin_amdgcn_mfma_f32_16x16x32_bf16(vf, pf, o[dt], 0, 0, 0);
            }
        }
    }
    const float inv = 1.0f / l;
    if (MODE == 0) {
        bf16_t* po = (bf16_t*)(P.ws + WS_PO) + ((size_t)p * NTOK_P + qtok) * DATT + h * HD + 4 * g;
#pragma unroll
        for (int dt = 0; dt < 8; ++dt) { u32x2 wv; wv.x = pg8::cvt_pk_bf16(o[dt][0] * inv, o[dt][1] * inv); wv.y = pg8::cvt_pk_bf16(o[dt][2] * inv, o[dt][3] * inv); *(u32x2*)(po + 16 * dt) = wv; }
        if (g == 0) { ((float*)(P.ws + WS_PM))[((size_t)p * NTOK_P + qtok) * NH + h] = m; ((float*)(P.ws + WS_PL))[((size_t)p * NTOK_P + qtok) * NH + h] = l; }
    } else {
        const float* PM = (const float*)(P.ws + WS_PM); const float* PL = (const float*)(P.ws + WS_PL);
        const float m0 = PM[qtok * NH + h], l0 = PL[qtok * NH + h], m1 = PM[((size_t)NTOK_P + qtok) * NH + h], l1 = PL[((size_t)NTOK_P + qtok) * NH + h];
        const float M = fmaxf(m, fmaxf(m0, m1));
        const float w2 = exp2f(m - M), w0 = exp2f(m0 - M) * l0, w1 = exp2f(m1 - M) * l1;
        const float rden = 1.0f / (w2 * l + w0 + w1);
        const bf16_t* p0 = (const bf16_t*)(P.ws + WS_PO) + qtok * DATT + h * HD + 4 * g;
        const bf16_t* p1 = p0 + (size_t)NTOK_P * DATT;
        bf16_t* ar = (bf16_t*)(P.ws + WS_AR) + qtok * D + h * HD + 4 * g;
#pragma unroll
        for (int dt = 0; dt < 8; ++dt) {
            const u32x2 x0 = *(const u32x2*)(p0 + 16 * dt), x1 = *(const u32x2*)(p1 + 16 * dt);
            const float r0 = (w2 * o[dt][0] + w0 * bflo(x0.x) + w1 * bflo(x1.x)) * rden, r1 = (w2 * o[dt][1] + w0 * bfhi(x0.x) + w1 * bfhi(x1.x)) * rden;
            const float r2 = (w2 * o[dt][2] + w0 * bflo(x0.y) + w1 * bflo(x1.y)) * rden, r3 = (w2 * o[dt][3] + w0 * bfhi(x0.y) + w1 * bfhi(x1.y)) * rden;
            u32x2 wv; wv.x = pg8::cvt_pk_bf16(r0, r1); wv.y = pg8::cvt_pk_bf16(r2, r3); *(u32x2*)(ar + 16 * dt) = wv;
        }
    }
    __syncthreads();
}

__device__ __forceinline__ void samp_unit(const Params& P, int b, int h, int k, LAS unsigned char* lds) {
    const int tid = threadIdx.x, lane = tid & 63, w = __builtin_amdgcn_readfirstlane(tid >> 6);
    const int cq = lane & 15, g = lane >> 4;
    if (k < 8) {
#pragma unroll 4
        for (int it = 0; it < 16; ++it) {
            const int rho = it * 16 + (tid >> 5), ch4 = tid & 31, c = 256 * k + rho;
            const size_t so = ((size_t)(b * 2048 + c)) * DATT + h * HD + ch4 * 4;
            const float4 kf = *(const float4*)(P.cache_k + so), vf = *(const float4*)(P.cache_v + so);
            if (c >= 8) { const size_t od = ((size_t)(b * 2048 + c - 8)) * DATT + h * HD + ch4 * 4; *(float4*)(P.out + O_KS + od) = kf; *(float4*)(P.out + O_VS + od) = vf; }
            u32x2 kw, vw; kw.x = pg8::cvt_pk_bf16(kf.x, kf.y); kw.y = pg8::cvt_pk_bf16(kf.z, kf.w); vw.x = pg8::cvt_pk_bf16(vf.x, vf.y); vw.y = pg8::cvt_pk_bf16(vf.z, vf.w);
            *(LAS u32x2*)(lds + rho * KVS + ch4 * 8) = kw; *(LAS u32x2*)(lds + VOFF + rho * KVS + ch4 * 8) = vw;
        }
    } else {
        const int rho = tid >> 5, ch4 = tid & 31;
        u32x2 kw = {0u, 0u}, vw = {0u, 0u};
        if (rho < 8) { const size_t so = ((size_t)(b * 2048 + 2040 + rho)) * DATT + h * HD + ch4 * 4; const float4 kf = *(const float4*)(P.out + O_KS + so), vf = *(const float4*)(P.out + O_VS + so);
            kw.x = pg8::cvt_pk_bf16(kf.x, kf.y); kw.y = pg8::cvt_pk_bf16(kf.z, kf.w); vw.x = pg8::cvt_pk_bf16(vf.x, vf.y); vw.y = pg8::cvt_pk_bf16(vf.z, vf.w); }
        *(LAS u32x2*)(lds + rho * KVS + ch4 * 8) = kw; *(LAS u32x2*)(lds + VOFF + rho * KVS + ch4 * 8) = vw;
        *(LAS u32x2*)(lds + (16 + rho) * KVS + ch4 * 8) = (u32x2){0u, 0u}; *(LAS u32x2*)(lds + VOFF + (16 + rho) * KVS + ch4 * 8) = (u32x2){0u, 0u};
    }
    const int t = cq & 7;
    const bf16_t* Qb = (const bf16_t*)(P.ws + WS_QB) + ((size_t)(NTOK_P + b * 8 + t)) * DATT + h * HD;
    bf16x8 qf[4];
#pragma unroll
    for (int ks = 0; ks < 4; ++ks) qf[ks] = *(const bf16x8*)(Qb + 32 * ks + 8 * g);
    __syncthreads();
    const float slope2 = exp2f(-8.0f * (float)(h + 1) / 12.0f) * LOG2E;
    const bool active = (k < 8) || (w == 0);
    f32x4 s[2]; float m = -INFINITY;
#pragma unroll
    for (int j = 0; j < 2; ++j) {
        f32x4 acc = {0.f, 0.f, 0.f, 0.f};
        if (active) {
#pragma unroll
            for (int ks = 0; ks < 4; ++ks) { const bf16x8 kf = *(const LAS bf16x8*)(lds + (32 * w + 16 * j + cq) * KVS + (32 * ks + 8 * g) * 2); acc = __builtin_amdgcn_mfma_f32_16x16x32_bf16(kf, qf[ks], acc, 0, 0, 0); }
        }
#pragma unroll
        for (int ii = 0; ii < 4; ++ii) {
            const int c = 256 * k + 32 * w + 16 * j + 4 * g + ii, dist = 2048 + t - c;
            int mult = (dist <= 128 ? 1 : 0) + (((dist & 3) == 0 && dist <= 512) ? 1 : 0) + (((dist & 15) == 0 && dist <= 2048) ? 1 : 0);
            if (dist < 0 || !active || c > 2055) mult = 0;
            const float v = mult ? acc[ii] - slope2 * (float)dist : -INFINITY;
            acc[ii] = v; m = fmaxf(m, v);
            s[j][ii] = (float)mult;
            s[j][ii] = v;
        }
    }
    m = fmaxf(m, __shfl_xor(m, 16)); m = fmaxf(m, __shfl_xor(m, 32));
    const float mref = (m == -INFINITY) ? 0.f : m;
    float l = 0.f;
#pragma unroll
    for (int j = 0; j < 2; ++j)
#pragma unroll
        for (int ii = 0; ii < 4; ++ii) {
            const int c = 256 * k + 32 * w + 16 * j + 4 * g + ii, dist = 2048 + t - c;
            const int mult = (dist <= 128 ? 1 : 0) + (((dist & 3) == 0 && dist <= 512) ? 1 : 0) + (((dist & 15) == 0 && dist <= 2048) ? 1 : 0);
            const float pp = (float)mult * exp2f(s[j][ii] - mref); s[j][ii] = pp; l += pp; }
    l += __shfl_xor(l, 16); l += __shfl_xor(l, 32);
    f32x4 o[8];
    {
        u32x4 pw; pw.x = pg8::cvt_pk_bf16(s[0][0], s[0][1]); pw.y = pg8::cvt_pk_bf16(s[0][2], s[0][3]); pw.z = pg8::cvt_pk_bf16(s[1][0], s[1][1]); pw.w = pg8::cvt_pk_bf16(s[1][2], s[1][3]);
        const bf16x8 pf = __builtin_bit_cast(bf16x8, pw);
        const int rw = active ? w : 0;
        const int a0 = VOFF + (32 * rw + 4 * g + (cq >> 2)) * KVS + 8 * (cq & 3), a1 = a0 + 16 * KVS;
#pragma unroll
        for (int dt = 0; dt < 8; ++dt) {
            const s16x4 v0 = __builtin_amdgcn_ds_read_tr16_b64_v4i16((LAS s16x4*)(lds + a0 + dt * 32));
            const s16x4 v1 = __builtin_amdgcn_ds_read_tr16_b64_v4i16((LAS s16x4*)(lds + a1 + dt * 32));
            const bf16x8 vf = {v0[0], v0[1], v0[2], v0[3], v1[0], v1[1], v1[2], v1[3]};
            o[dt] = __builtin_amdgcn_mfma_f32_16x16x32_bf16(vf, pf, (f32x4){0.f, 0.f, 0.f, 0.f}, 0, 0, 0);
        }
    }
    __syncthreads();
    LAS float* OL = (LAS float*)lds;
    LAS float* ML = (LAS float*)(lds + 32768);
    if (cq < 8) {
#pragma unroll
        for (int dt = 0; dt < 8; ++dt) *(LAS f32x4*)(OL + (w * 8 + cq) * 128 + 16 * dt + 4 * g) = o[dt];
        if (g == 0) { ML[(w * 8 + cq) * 2 + 0] = m; ML[(w * 8 + cq) * 2 + 1] = l; }
    }
    __syncthreads();
    {
        const int q = w; float M = -INFINITY;
#pragma unroll
        for (int ww = 0; ww < 8; ++ww) M = fmaxf(M, ML[(ww * 8 + q) * 2]);
        const float Mr = (M == -INFINITY) ? 0.f : M;
        float L = 0.f, o0 = 0.f, o1 = 0.f;
#pragma unroll
        for (int ww = 0; ww < 8; ++ww) { const float f = exp2f(ML[(ww * 8 + q) * 2] - Mr); L += f * ML[(ww * 8 + q) * 2 + 1];
            o0 += f * OL[(ww * 8 + q) * 128 + 2 * lane]; o1 += f * OL[(ww * 8 + q) * 128 + 2 * lane + 1]; }
        float* ps = (float*)(P.ws + WS_PS) + ((((size_t)(b * NH + h)) * 9 + k) * 8 + q) * 130;
        if (lane == 0) { ps[0] = M; ps[1] = L; }
        *(float2*)(ps + 2 + 2 * lane) = make_float2(o0, o1);
    }
    __syncthreads();
}
__device__ __forceinline__ void samp_merge_unit(const Params& P, int b, int t, int h, int lane) {
    const float* ps = (const float*)(P.ws + WS_PS) + ((size_t)(b * NH + h)) * 9 * 8 * 130 + (size_t)t * 130;
    float M = -INFINITY;
#pragma unroll
    for (int k = 0; k < 9; ++k) M = fmaxf(M, ps[(size_t)k * 8 * 130]);
    float L = 0.f, o0 = 0.f, o1 = 0.f;
#pragma unroll
    for (int k = 0; k < 9; ++k) { const float* pk = ps + (size_t)k * 8 * 130; const float f = exp2f(pk[0] - M); L += f * pk[1]; const float2 ov = *(const float2*)(pk + 2 + 2 * lane); o0 += f * ov.x; o1 += f * ov.y; }
    const float inv = 1.0f / L;
    bf16_t* ar = (bf16_t*)(P.ws + WS_AR) + ((size_t)(NTOK_P + b * 8 + t)) * D + h * HD;
    *(unsigned*)(ar + 2 * lane) = pack2(o0 * inv, o1 * inv);
}

__device__ __forceinline__ void lru_unit(const Params& P, bool samp, int b, int n, int k, int lane) {
    const int T = samp ? 8 : 64; const int row0 = samp ? NTOK_P + b * 8 : b * 2048 + k * 64; const int ch = n * 64 + lane;
    float wa[64], wx[64];
#pragma unroll
    for (int c = 0; c < 64; ++c) { wa[c] = P.lru_w_a[(n * 64 + c) * 64 + lane]; wx[c] = P.lru_w_x[(n * 64 + c) * 64 + lane]; }
    const float ba = P.lru_b_a[ch], bx = P.lru_b_x[ch], lam = P.lru_lambda[ch];
    const float sp = log1pf(expf(-lam));
    const float cw0 = P.conv_w[ch], cw1 = P.conv_w[512 + ch], cw2 = P.conv_w[1024 + ch], cw3 = P.conv_w[1536 + ch], cb = P.conv_b[ch];
    const float* XR = (const float*)(P.ws + WS_XR); const float* GT = (const float*)(P.ws + WS_GATE);
    float* R0 = (float*)(P.ws + WS_R0); float* R1 = (float*)(P.ws + WS_R1); bf16_t* AR = (bf16_t*)(P.ws + WS_AR);
    float x0 = 0.f, x1 = 0.f, x2 = 0.f, h = 0.f, A = 1.f;
    if (samp) { x0 = P.state_conv[(b * 3 + 0) * 512 + ch]; x1 = P.state_conv[(b * 3 + 1) * 512 + ch]; x2 = P.state_conv[(b * 3 + 2) * 512 + ch]; h = P.state_h[b * 512 + ch]; }
    else if (k > 0) { x0 = XR[(size_t)(row0 - 3) * DLRU + ch]; x1 = XR[(size_t)(row0 - 2) * DLRU + ch]; x2 = XR[(size_t)(row0 - 1) * DLRU + ch]; }
    for (int t0 = 0; t0 < T; t0 += 8) {
        float xin[8], gt[8];
#pragma unroll
        for (int i = 0; i < 8; ++i) { xin[i] = XR[(size_t)(row0 + t0 + i) * DLRU + ch]; gt[i] = GT[(size_t)(row0 + t0 + i) * DLRU + ch]; }
#pragma unroll
        for (int i = 0; i < 8; ++i) {
            const float xc = ((x0 * cw0 + x1 * cw1) + x2 * cw2) + xin[i] * cw3 + cb;
            x0 = x1; x1 = x2; x2 = xin[i];
            float ra = 0.f, ri = 0.f;
#pragma unroll
            for (int c = 0; c < 64; ++c) { const float xcc = readlane_f(xc, c); ra += xcc * wa[c]; ri += xcc * wx[c]; if ((c & 15) == 15) __builtin_amdgcn_sched_barrier(0); }
            const float rr = sigmoidf(ra + ba), ig = sigmoidf(ri + bx);
            const float log_a = -8.0f * rr * sp; const float a = expf(log_a);
            const float u = sqrtf(-expm1f(2.0f * log_a)) * (ig * xc);
            h = a * h + u; A = a * A;
            const float ge = gelu_exact(gt[i]);
            if (samp) AR[(size_t)(row0 + t0 + i) * D + DATT + ch] = (bf16_t)f2bf(h * ge);
            else { R0[(size_t)(row0 + t0 + i) * DLRU + ch] = h * ge; R1[(size_t)(row0 + t0 + i) * DLRU + ch] = A * ge; }
        }
    }
    if (samp) { P.out[O_HS + (size_t)b * 512 + ch] = h; float* co = P.out + O_CS + (size_t)b * 3 * 512 + ch; co[0] = x0; co[512] = x1; co[1024] = x2; }
    else {
        ((float*)(P.ws + WS_HE))[((size_t)(b * 32 + k)) * 512 + ch] = h; ((float*)(P.ws + WS_AE))[((size_t)(b * 32 + k)) * 512 + ch] = A;
        if (k == 31) { float* co = P.out + O_CP + (size_t)b * 3 * 512 + ch; co[0] = x0; co[512] = x1; co[1024] = x2; }
    }
}

__device__ __forceinline__ void phase_lru(const Params& P) {
    const int lane = threadIdx.x & 63, wave = __builtin_amdgcn_readfirstlane(threadIdx.x >> 6);
    const int gw = blockIdx.x * 8 + wave, nw = gridDim.x * 8;
    for (int u = gw; u < 2048 + 256; u += nw) { const bool samp = u >= 2048; const int v = samp ? u - 2048 : u; lru_unit(P, samp, samp ? (v >> 3) : (v >> 8), samp ? (v & 7) : ((v >> 5) & 7), v & 31, lane); }
}
__device__ __forceinline__ void phase_samp(const Params& P, LAS unsigned char* lds) {
    for (int u = blockIdx.x; u < 384 * 9; u += gridDim.x) { const int k = u % 9, bh = u / 9; samp_unit(P, bh / NH, bh % NH, k, lds); }
}
__device__ __forceinline__ void phase_attn01(const Params& P, LAS unsigned char* lds) {
    for (int u = blockIdx.x; u < 3072; u += gridDim.x) {
        const int p = u / 1536, rem = u - p * 1536, bh = rem >> 4, rc = rem & 15;
        const int b = bh / NH, h = bh - b * NH;
        const int r = p == 0 ? 0 : (rc >> 2), c = p == 0 ? rc : (rc & 3);
        attn_unit<0>(P, p, b, h, r, c, lds);
    }
}
__device__ __forceinline__ void phase_mix_b(const Params& P, LAS unsigned char* lds) {
    {
        const int gt = blockIdx.x * NTHREADS + threadIdx.x;
        for (int i = gt; i < 8 * 32 * 512; i += gridDim.x * NTHREADS) {
            const int ch = i & 511, k = (i >> 9) & 31, b = i >> 14;
            const float* HE = (const float*)(P.ws + WS_HE) + (size_t)b * 32 * 512 + ch; const float* AE = (const float*)(P.ws + WS_AE) + (size_t)b * 32 * 512 + ch;
            float hin = 0.f;
            for (int kk = 0; kk < k; ++kk) hin = HE[kk * 512] + AE[kk * 512] * hin;
            const float* R0 = (const float*)(P.ws + WS_R0) + (size_t)(b * 2048 + k * 64) * DLRU + ch; const float* R1 = (const float*)(P.ws + WS_R1) + (size_t)(b * 2048 + k * 64) * DLRU + ch;
            bf16_t* ar = (bf16_t*)(P.ws + WS_AR) + (size_t)(b * 2048 + k * 64) * D + DATT + ch;
#pragma unroll 8
            for (int t = 0; t < 64; ++t) ar[(size_t)t * D] = (bf16_t)f2bf(R0[(size_t)t * DLRU] + R1[(size_t)t * DLRU] * hin);
            if (k == 31) P.out[O_HP + (size_t)b * 512 + ch] = HE[31 * 512] + AE[31 * 512] * hin;
        }
    }
    { const int lane = threadIdx.x & 63, gw = blockIdx.x * 8 + (threadIdx.x >> 6);
      for (int u = gw; u < NTOK_S * NH; u += gridDim.x * 8) { const int row = u / NH, h = u - row * NH; samp_merge_unit(P, row >> 3, row & 7, h, lane); } }
    for (int u = blockIdx.x; u < 1536; u += gridDim.x) {
        const int bh = u >> 4, r = u & 15; const int b = bh / NH, h = bh - b * NH;
        attn_unit<1>(P, 2, b, h, r, 0, lds);
    }
}

__device__ __forceinline__ void phase_ln1(const Params& P) {
    const int lane = threadIdx.x & 63, wave = threadIdx.x >> 6;
    const float* pre = (const float*)(P.ws + WS_PRE1); bf16_t* x1b = (bf16_t*)(P.ws + WS_X1B);
    for (int row = blockIdx.x * 8 + wave; row < NTOK; row += gridDim.x * 8) {
        float4 v[8]; float s = 0.f;
#pragma unroll
        for (int j = 0; j < 8; ++j) { v[j] = *(const float4*)(pre + (size_t)row * D + (j >> 2) * 1024 + lane * 16 + (j & 3) * 4); s += (v[j].x + v[j].y) + (v[j].z + v[j].w); }
        const float mean = wave_sum(s) * (1.0f / D); float q = 0.f;
#pragma unroll
        for (int j = 0; j < 8; ++j) { const float a = v[j].x - mean, b = v[j].y - mean, c = v[j].z - mean, d = v[j].w - mean; q += (a * a + b * b) + (c * c + d * d); }
        const float rstd = rsqrtf(wave_sum(q) * (1.0f / D) + LN_EPS);
        float am = 0.f;
#pragma unroll
        for (int j = 0; j < 8; ++j) { const int col = (j >> 2) * 1024 + lane * 16 + (j & 3) * 4; const float4 g = *(const float4*)(P.ln1_g + col), bb = *(const float4*)(P.ln1_b + col);
            float4 o; o.x = (v[j].x - mean) * rstd * g.x + bb.x; o.y = (v[j].y - mean) * rstd * g.y + bb.y; o.z = (v[j].z - mean) * rstd * g.z + bb.z; o.w = (v[j].w - mean) * rstd * g.w + bb.w;
            v[j] = o; am = fmaxf(am, fmaxf(fmaxf(fabsf(o.x), fabsf(o.y)), fmaxf(fabsf(o.z), fabsf(o.w))));
            uint2 w; w.x = pack2(o.x, o.y); w.y = pack2(o.z, o.w); *(uint2*)(x1b + (size_t)row * D + col) = w; }
        am = wave_max(am); if (am == 0.f) am = 1.f;
        const float inv = 127.0f / am;
        unsigned char* xq = P.ws + WS_X1Q + (size_t)row * D;
#pragma unroll
        for (int j = 0; j < 2; ++j) { u32x4 w;
#pragma unroll
            for (int i = 0; i < 4; ++i) { const float4 t = v[j * 4 + i];
                const int a = (int)rintf(t.x * inv), b = (int)rintf(t.y * inv), c = (int)rintf(t.z * inv), d = (int)rintf(t.w * inv);
                w[i] = (unsigned)(a & 255) | ((unsigned)(b & 255) << 8) | ((unsigned)(c & 255) << 16) | ((unsigned)(d & 255) << 24); }
            *(u32x4*)(xq + j * 1024 + lane * 16) = w; }
        if (lane == 0) ((float*)(P.ws + WS_SX))[row] = am * (1.0f / 127.0f);
    }
}

__device__ __forceinline__ int mono(float v) { const int b = __float_as_int(v); return b ^ ((b >> 31) & 0x7fffffff); }
__device__ __forceinline__ float unmono(int k) { return __int_as_float(k ^ ((k >> 31) & 0x7fffffff)); }
#define MK_INSERT16(L, X) do { int _x = (X); _Pragma("unroll") for (int _j = 0; _j < 16; ++_j) { const int _hi = max(L[_j], _x); _x = min(L[_j], _x); L[_j] = _hi; } } while (0)

template <int N> __device__ __forceinline__ void bitonic_sort_desc(int (&v)[N]) {
#pragma unroll
    for (int k = 2; k <= N; k <<= 1)
#pragma unroll
        for (int j = k >> 1; j > 0; j >>= 1)
#pragma unroll
            for (int i = 0; i < N; ++i) { const int l = i ^ j;
                if (l > i) { const int a = v[i], b = v[l]; if ((i & k) == 0) { v[i] = max(a, b); v[l] = min(a, b); } else { v[i] = min(a, b); v[l] = max(a, b); } } }
}
template <int N> __device__ __forceinline__ void bitonic_merge_desc(int (&v)[N]) {
#pragma unroll
    for (int j = N >> 1; j > 0; j >>= 1)
#pragma unroll
        for (int i = 0; i < N; ++i) { const int l = i ^ j; if (l > i) { const int a = v[i], b = v[l]; v[i] = max(a, b); v[l] = min(a, b); } }
}
__device__ __forceinline__ void xlane_merge16(int (&v)[16], int off) {
    int c[16];
#pragma unroll
    for (int i = 0; i < 16; ++i) c[i] = max(v[i], __shfl_xor(v[15 - i], off));
#pragma unroll
    for (int i = 0; i < 16; ++i) v[i] = c[i];
    bitonic_merge_desc<16>(v);
}
__device__ __forceinline__ int sel4(int g, int a, int b, int c, int d) { return g == 0 ? a : (g == 1 ? b : (g == 2 ? c : d)); }
__device__ __forceinline__ float sel4f(int g, float a, float b, float c, float d) { return g == 0 ? a : (g == 1 ? b : (g == 2 ? c : d)); }
__device__ __forceinline__ constexpr int cand_a(int role, int i) {
    return role == 0 ? 0 : role == 1 ? (i < 8 ? 1 : (i < 13 ? 2 : 4)) : role == 2 ? (i < 4 ? 3 : (i < 6 ? 5 : (i < 8 ? 6 : (i < 10 ? 7 : 8 + (i - 10))))) : (i < 2 ? 14 + i : -1);
}
__device__ __forceinline__ constexpr int cand_b(int role, int i) {
    return role == 0 ? i : role == 1 ? (i < 8 ? i : (i < 13 ? i - 8 : i - 13)) : role == 2 ? (i < 4 ? i : (i < 6 ? i - 4 : (i < 8 ? i - 6 : (i < 10 ? i - 8 : 0)))) : 0;
}

__device__ __forceinline__ void route_unit(const Params& P, int h, int tg, LAS unsigned char* lds, LAS int* lst) {
    const int lane = threadIdx.x & 63, w = __builtin_amdgcn_readfirstlane(threadIdx.x >> 6);
    const int cq = lane & 15, g = lane >> 4;
    const int tok = tg * 128 + w * 16 + cq;
    const bf16_t* qrow = (const bf16_t*)(P.ws + WS_QP) + (size_t)tok * D + h * 256;
    int L0[16], L1[16];
#pragma unroll
    for (int p = 0; p < 2; ++p) {
        bf16x8 qf[4];
#pragma unroll
        for (int ks = 0; ks < 4; ++ks) qf[ks] = *(const bf16x8*)(qrow + p * 128 + 32 * ks + 8 * g);
        int v0[16], v1[16];
#pragma unroll
        for (int kt = 0; kt < 8; ++kt) {
            f32x4 acc = {0.f, 0.f, 0.f, 0.f};
#pragma unroll
            for (int ks = 0; ks < 4; ++ks) { const bf16x8 kf = *(const LAS bf16x8*)(lds + (p * 128 + 16 * kt + cq) * KVS + (32 * ks + 8 * g) * 2); acc = __builtin_amdgcn_mfma_f32_16x16x32_bf16(kf, qf[ks], acc, 0, 0, 0); }
#pragma unroll
            for (int ii = 0; ii < 4; ++ii) { const int key = (mono(acc[ii]) & ~127) | (16 * kt + 4 * g + ii); if (kt < 4) v0[kt * 4 + ii] = key; else v1[(kt - 4) * 4 + ii] = key; }
        }
        bitonic_sort_desc<16>(v0); bitonic_sort_desc<16>(v1);
#pragma unroll
        for (int i = 0; i < 16; ++i) v0[i] = max(v0[i], v1[15 - i]);
        bitonic_merge_desc<16>(v0);
        xlane_merge16(v0, 16); xlane_merge16(v0, 32);
#pragma unroll
        for (int i = 0; i < 16; ++i) { if (p == 0) L0[i] = v0[i]; else L1[i] = v0[i]; }
    }
    if (g == 0) {
#pragma unroll
        for (int i = 0; i < 16; ++i) lst[(cq * 2 + 0) * 16 + i] = L0[i];
    }
    if (g == 1) {
#pragma unroll
        for (int i = 0; i < 16; ++i) lst[(cq * 2 + 1) * 16 + i] = L1[i];
    }
    float f0[16], f1[16];
#pragma unroll
    for (int i = 0; i < 16; ++i) { f0[i] = unmono(L0[i] & ~127); f1[i] = unmono(L1[i] & ~127); }
    int c[16];
#pragma unroll
    for (int i = 0; i < 16; ++i) {
        constexpr int NEG = (int)0x80000000;
        const float va = sel4f(g, f0[cand_a(0, i)], f0[cand_a(1, i)], f0[cand_a(2, i)], f0[cand_a(3, i) < 0 ? 0 : cand_a(3, i)]);
        const float vb = sel4f(g, f1[cand_b(0, i)], f1[cand_b(1, i)], f1[cand_b(2, i)], f1[cand_b(3, i)]);
        const int id = sel4(g, (cand_a(0, i) << 4) | cand_b(0, i), (cand_a(1, i) << 4) | cand_b(1, i), (cand_a(2, i) << 4) | cand_b(2, i), ((cand_a(3, i) < 0 ? 0 : cand_a(3, i)) << 4) | cand_b(3, i));
        int key = (mono(va + vb) & ~255) | id;
        if (cand_a(3, i) < 0) key = (g == 3) ? NEG : key;
        c[i] = key;
    }
    bitonic_sort_desc<16>(c);
    xlane_merge16(c, 16); xlane_merge16(c, 32);
    const float mx = unmono(c[0] & ~255);
    float e[16]; float sum = 0.f;
#pragma unroll
    for (int i = 0; i < 16; ++i) { e[i] = exp2f((unmono(c[i] & ~255) - mx) * LOG2E); sum += e[i]; }
    const float inv = 1.0f / sum;
    __builtin_amdgcn_wave_barrier();
    int ei[4]; float gi[4];
#pragma unroll
    for (int j = 0; j < 4; ++j) {
        const int key = sel4(g, c[j], c[4 + j], c[8 + j], c[12 + j]);
        gi[j] = sel4f(g, e[j], e[4 + j], e[8 + j], e[12 + j]) * inv;
        const int a = (key >> 4) & 15, b = key & 15;
        const int i0 = lst[(cq * 2 + 0) * 16 + a] & 127, i1 = lst[(cq * 2 + 1) * 16 + b] & 127;
        ei[j] = i0 * 128 + i1;
    }
    int* EIDX = (int*)(P.ws + WS_EIDX); float* GW = (float*)(P.ws + WS_GW);
    *(int4*)(EIDX + (size_t)tok * 128 + h * 16 + 4 * g) = make_int4(ei[0], ei[1], ei[2], ei[3]);
    *(float4*)(GW + (size_t)tok * 128 + h * 16 + 4 * g) = make_float4(gi[0], gi[1], gi[2], gi[3]);
    __builtin_amdgcn_wave_barrier();
}
__device__ __forceinline__ void phase_route(const Params& P, LAS unsigned char* lds) {
    const int tid = threadIdx.x, wave = __builtin_amdgcn_readfirstlane(tid >> 6);
    const int h = blockIdx.x & 7, slot = blockIdx.x >> 3, nslot = gridDim.x >> 3;
    const bf16_t* sk = (const bf16_t*)(P.ws + WS_SKB) + (size_t)h * 2 * 128 * 128;
#pragma unroll
    for (int it = 0; it < 8; ++it) { const int row = it * 32 + (tid >> 4), ch = tid & 15; *(LAS u32x4*)(lds + row * KVS + ch * 16) = *(const u32x4*)(sk + (size_t)row * 128 + ch * 8); }
    __syncthreads();
    LAS int* lst = (LAS int*)(lds + 73728) + wave * 512;
    for (int tg = slot; tg < NTOK / 128; tg += nslot) route_unit(P, h, tg, lds, lst);
}

__device__ __forceinline__ float ubf(unsigned x, int k) { return (float)((x >> (8 * k)) & 0xffu); }
constexpr int XSLOT = 1280, XGRP = 4 * XSLOT, XWAVE = 3 * XGRP;
__device__ __forceinline__ void dma_group(const unsigned char* tab, int e_lo, int e_hi, int g, LAS unsigned char* sb, int lane) {
#pragma unroll
    for (int j = 0; j < 4; ++j) {
        const int k = g * 4 + j; const int e = __builtin_amdgcn_readlane(k < 64 ? e_lo : e_hi, k & 63);
        const unsigned char* rp = tab + (size_t)e * TROW;
        __builtin_amdgcn_global_load_lds((const unsigned*)(rp + lane * 16), (LAS unsigned*)(sb + j * XSLOT), 16, 0, 0);
        __builtin_amdgcn_global_load_lds((const unsigned*)(rp + 1024 + lane * 4), (LAS unsigned*)(sb + j * XSLOT + 1024), 4, 0, 0);
    }
}
__device__ __forceinline__ void u_consume(const LAS unsigned char* sb, const int (&xe)[4], const int (&xo)[4], const int (&X8)[2], float a_lo, float a_hi, float b_lo, float b_hi, int g, int lane, float& w_lo, float& w_hi) {
    int d[4];
#pragma unroll
    for (int j = 0; j < 4; ++j) {
        const u32x4 nb = *(const LAS u32x4*)(sb + j * XSLOT + lane * 16); const unsigned sc = *(const LAS unsigned short*)(sb + j * XSLOT + 1024 + lane * 2);
        int tot = 0;
#pragma unroll
        for (int jj = 0; jj < 2; ++jj) { int t = -X8[jj];
#pragma unroll
            for (int hh = 0; hh < 2; ++hh) { const unsigned wv = nb[jj * 2 + hh];
                t = __builtin_amdgcn_sdot4((int)(wv & 0x0F0F0F0Fu), xe[jj * 2 + hh], t, false); t = __builtin_amdgcn_sdot4((int)((wv >> 4) & 0x0F0F0F0Fu), xo[jj * 2 + hh], t, false); }
            tot += t * (int)((sc >> (8 * jj)) & 255u); }
        d[j] = tot;
    }
    const bool b5 = (lane & 32) != 0, b4 = (lane & 16) != 0;
    const int r0 = (b5 ? d[2] : d[0]) + __shfl_xor(b5 ? d[0] : d[2], 32);
    const int r1 = (b5 ? d[3] : d[1]) + __shfl_xor(b5 ? d[1] : d[3], 32);
    int r = (b4 ? r1 : r0) + __shfl_xor(b4 ? r0 : r1, 16);
    r += __shfl_xor(r, 8); r += __shfl_xor(r, 4); r += __shfl_xor(r, 2); r += __shfl_xor(r, 1);
    const int tot = __shfl(r, (lane & 3) * 16);
    const bool mine = ((lane >> 2) == (g & 15));
    const bool hi = g >= 16;
    const float wv = (hi ? b_hi : b_lo) * gelu_as((float)tot * (hi ? a_hi : a_lo));
    if (hi) w_hi = mine ? wv : w_hi; else w_lo = mine ? wv : w_lo;
}
__device__ __forceinline__ void v_consume(const LAS unsigned char* sb, f32x2 (&acc)[16], float (&bias)[2], float w_lo, float w_hi, int g, int lane) {
#pragma unroll 1
    for (int j = 0; j < 4; ++j) {
        const int k = g * 4 + j; const float w = readlane_f(k < 64 ? w_lo : w_hi, k & 63);
        const u32x4 nb = *(const LAS u32x4*)(sb + j * XSLOT + lane * 16); const unsigned sc = *(const LAS unsigned short*)(sb + j * XSLOT + 1024 + lane * 2);
#pragma unroll
        for (int jj = 0; jj < 2; ++jj) {
            const float c = w * (float)((sc >> (8 * jj)) & 255u); bias[jj] += c; const f32x2 c2 = {c, c};
#pragma unroll
            for (int hh = 0; hh < 2; ++hh) { const unsigned wv = nb[jj * 2 + hh]; unsigned ev = wv & 0x0F0F0F0Fu, od = (wv >> 4) & 0x0F0F0F0Fu;
                asm volatile("" : "+v"(ev), "+v"(od));
                const f32x2 n0 = {ubf(ev, 0), ubf(od, 0)}, n1 = {ubf(ev, 1), ubf(od, 1)};
                const f32x2 n2 = {ubf(ev, 2), ubf(od, 2)}, n3 = {ubf(ev, 3), ubf(od, 3)};
                f32x2* ac = &acc[jj * 8 + hh * 4];
                ac[0] = __builtin_elementwise_fma(n0, c2, ac[0]); ac[1] = __builtin_elementwise_fma(n1, c2, ac[1]); ac[2] = __builtin_elementwise_fma(n2, c2, ac[2]); ac[3] = __builtin_elementwise_fma(n3, c2, ac[3]);
            }
        }
    }
}
__device__ __forceinline__ void phase_experts(const Params& P, LAS unsigned char* lds) {
    const int lane = threadIdx.x & 63, wave = __builtin_amdgcn_readfirstlane(threadIdx.x >> 6);
    const bf16_t* x1b = (const bf16_t*)(P.ws + WS_X1B);
    const int* EIDX = (const int*)(P.ws + WS_EIDX); const float* GW = (const float*)(P.ws + WS_GW);
    const unsigned char* UQ = P.ws + WS_UB; const unsigned char* VQ = P.ws + WS_VB;
    const float* SU = (const float*)(P.ws + WS_SU); const float* SV = (const float*)(P.ws + WS_SV); const float* SX = (const float*)(P.ws + WS_SX);
    LAS unsigned char* wb = lds + wave * XWAVE;
    for (int row = blockIdx.x * 8 + wave; row < NTOK; row += gridDim.x * 8) {
        int ln = lane; asm volatile("" : "+v"(ln));
        int xe[4], xo[4], X8[2];
        {
            const u32x4 x0 = *(const u32x4*)(P.ws + WS_X1Q + (size_t)row * D + ln * 16), x1 = *(const u32x4*)(P.ws + WS_X1Q + (size_t)row * D + 1024 + ln * 16);
#pragma unroll
            for (int hh = 0; hh < 2; ++hh) {
                xe[hh] = (int)__builtin_amdgcn_perm(x0[2 * hh + 1], x0[2 * hh], 0x06040200u); xo[hh] = (int)__builtin_amdgcn_perm(x0[2 * hh + 1], x0[2 * hh], 0x07050301u);
                xe[2 + hh] = (int)__builtin_amdgcn_perm(x1[2 * hh + 1], x1[2 * hh], 0x06040200u); xo[2 + hh] = (int)__builtin_amdgcn_perm(x1[2 * hh + 1], x1[2 * hh], 0x07050301u);
            }
            int s0 = 0, s1 = 0;
#pragma unroll
            for (int i = 0; i < 4; ++i) { s0 = __builtin_amdgcn_sdot4((int)x0[i], 0x01010101, s0, false); s1 = __builtin_amdgcn_sdot4((int)x1[i], 0x01010101, s1, false); }
            X8[0] = 8 * s0; X8[1] = 8 * s1;
        }
        const float sx = SX[row];
        const int e_lo = EIDX[(size_t)row * 128 + ln], e_hi = EIDX[(size_t)row * 128 + 64 + ln];
        const float g_lo = GW[(size_t)row * 128 + ln], g_hi = GW[(size_t)row * 128 + 64 + ln];
        const float a_lo = SU[e_lo] * sx, a_hi = SU[e_hi] * sx, b_lo = g_lo * SV[e_lo], b_hi = g_hi * SV[e_hi];
        float w_lo = 0.f, w_hi = 0.f;
        asm volatile("s_waitcnt vmcnt(0)" ::: "memory");
        dma_group(UQ, e_lo, e_hi, 0, wb, lane); dma_group(UQ, e_lo, e_hi, 1, wb + XGRP, lane);
        int sg = 0;
#pragma unroll 1
        for (int g = 0; g < 32; ++g) {
            const int sn = sg == 0 ? 2 : sg - 1;
            if (g + 2 < 32) dma_group(UQ, e_lo, e_hi, g + 2, wb + sn * XGRP, lane); else dma_group(VQ, e_lo, e_hi, g + 2 - 32, wb + sn * XGRP, lane);
            asm volatile("s_waitcnt vmcnt(16)" ::: "memory");
            u_consume(wb + sg * XGRP, xe, xo, X8, a_lo, a_hi, b_lo, b_hi, g, lane, w_lo, w_hi);
            sg = sg == 2 ? 0 : sg + 1;
        }
        f32x2 acc[16]; float bias[2] = {0.f, 0.f};
#pragma unroll
        for (int i = 0; i < 16; ++i) acc[i] = (f32x2){0.f, 0.f};
#pragma unroll 1
        for (int g = 0; g < 32; ++g) {
            const int sn = sg == 0 ? 2 : sg - 1;
            dma_group(VQ, e_lo, e_hi, (g + 2) & 31, wb + sn * XGRP, lane);
            asm volatile("s_waitcnt vmcnt(16)" ::: "memory");
            v_consume(wb + sg * XGRP, acc, bias, w_lo, w_hi, g, lane);
            sg = sg == 2 ? 0 : sg + 1;
        }
        asm volatile("s_waitcnt vmcnt(0)" ::: "memory");
        float s = 0.f;
#pragma unroll
        for (int jj = 0; jj < 2; ++jj) {
            const float b8 = 8.0f * bias[jj];
#pragma unroll
            for (int hh = 0; hh < 2; ++hh) {
                const u32x4 xa = *(const u32x4*)(x1b + (size_t)row * D + jj * 1024 + ln * 16 + hh * 8);
#pragma unroll
                for (int i = 0; i < 4; ++i) { f32x2 t = acc[jj * 8 + hh * 4 + i]; t[0] = t[0] - b8 + ALPHA * bflo(xa[i]); t[1] = t[1] - b8 + ALPHA * bfhi(xa[i]); acc[jj * 8 + hh * 4 + i] = t; s += t[0] + t[1]; }
            }
        }
        const float mean = wave_sum(s) * (1.0f / D); float q = 0.f;
#pragma unroll
        for (int i = 0; i < 16; ++i) { const float d0 = acc[i][0] - mean, d1 = acc[i][1] - mean; q += d0 * d0 + d1 * d1; }
        const float rstd = rsqrtf(wave_sum(q) * (1.0f / D) + LN_EPS);
        float* yo = P.out + (row < NTOK_P ? O_YP + (size_t)row * D : O_YS + (size_t)(row - NTOK_P) * D);
        const int lo16 = ln * 16;
#pragma unroll
        for (int jj = 0; jj < 2; ++jj)
#pragma unroll
            for (int i = 0; i < 4; ++i) {
                const int col = jj * 1024 + lo16 + i * 4;
                const float4 g0 = *(const float4*)(P.ln2_g + col), b0 = *(const float4*)(P.ln2_b + col);
                const f32x2 v0 = acc[jj * 8 + i * 2], v1 = acc[jj * 8 + i * 2 + 1];
                float4 o;
                o.x = (v0[0] - mean) * rstd * g0.x + b0.x; o.y = (v0[1] - mean) * rstd * g0.y + b0.y;
                o.z = (v1[0] - mean) * rstd * g0.z + b0.z; o.w = (v1[1] - mean) * rstd * g0.w + b0.w;
                *(float4*)(yo + col) = o;
            }
    }
}

constexpr int NPHASE = 11;
__global__ void __launch_bounds__(NTHREADS, 2) fwd(Params P) {
    extern __shared__ __attribute__((aligned(16))) unsigned char lds_raw[];
    LAS unsigned char* lds = (LAS unsigned char*)lds_raw;
    volatile LAS unsigned* misc = (volatile LAS unsigned*)(lds + MISC_OFF);
    const int lo = P.ph_lo, hi = P.ph_hi;
    XcdBarrier bar; bar.bar = (unsigned*)(P.ws + WS_CTL); bar.x = 0; bar.st = nullptr;
    if (hi - lo > 1) {
        if (threadIdx.x == 0) { misc[0] = 0u; misc[1] = 0u; misc[2] = 0u; misc[3] = 0u; }
        __syncthreads();
        bar = xcd_barrier_post((unsigned*)(P.ws + WS_CTL), misc);
    }
#ifndef MK_REPMASK
#define MK_REPMASK 0
#endif
#ifndef MK_PHASE_MASK
#define MK_PHASE_MASK 0x7ff
#endif
#define IN(k) (((MK_PHASE_MASK >> (k)) & 1) && lo <= (k) && (k) < hi)
#define SEAM(k) do { if (IN(k) && IN((k) + 1)) xcd_barrier(bar); } while (0)
    if (IN(0)) { phase_prologue(P, lds); }
    SEAM(0);
    if (IN(1)) {
        pg8::Gemm g{(const pg8::bf16_t*)(P.ws + WS_XB), (const pg8::bf16_t*)(P.ws + WS_WINT), NTOK, DIN, D};
        pg8::StaticOrder S; S.init(NTOK, DIN, (int)gridDim.x, (int)blockIdx.x);
        EpiProj E{P.out, (float*)(P.ws + WS_QF), (float*)(P.ws + WS_XR), (float*)(P.ws + WS_GATE), (bf16_t*)(P.ws + WS_QB), (bf16_t*)(P.ws + WS_KB), (bf16_t*)(P.ws + WS_VB16)};
        pg8::gemm_phase<EpiProj, pg8::StaticOrder, false>(lds, g, S, E, nullptr);
    }
    SEAM(1);
    if (IN(2)) { phase_lru(P); }
    if (IN(2) && IN(3)) __syncthreads();
    if (IN(3)) { phase_samp(P, lds); }
    if (IN(4)) { phase_attn01(P, lds); }
    SEAM(4);
    if (IN(5)) { phase_mix_b(P, lds); }
    SEAM(5);
    if (IN(6)) {
        sample_rows_gemm<0>(P, (const bf16_t*)(P.ws + WS_AR), (const bf16_t*)(P.ws + WS_WOT));
        pg8::Gemm g{(const pg8::bf16_t*)(P.ws + WS_AR), (const pg8::bf16_t*)(P.ws + WS_WOT), NTOK_P, D, D};
        pg8::StaticOrder S; S.init(NTOK_P, D, (int)gridDim.x, (int)blockIdx.x);
        EpiOut E{P.x_prompt, P.x_sample, (float*)(P.ws + WS_PRE1)};
        pg8::gemm_phase<EpiOut, pg8::StaticOrder, false>(lds, g, S, E, nullptr);
    }
    SEAM(6);
    if (IN(7)) { phase_ln1(P); }
    SEAM(7);
    if (IN(8)) {
        sample_rows_gemm<1>(P, (const bf16_t*)(P.ws + WS_X1B), (const bf16_t*)(P.ws + WS_WQT));
        pg8::Gemm g{(const pg8::bf16_t*)(P.ws + WS_X1B), (const pg8::bf16_t*)(P.ws + WS_WQT), NTOK_P, D, D};
        pg8::StaticOrder S; S.init(NTOK_P, D, (int)gridDim.x, (int)blockIdx.x);
        EpiBf16Plain E{(bf16_t*)(P.ws + WS_QP), D};
        pg8::gemm_phase<EpiBf16Plain, pg8::StaticOrder, false>(lds, g, S, E, nullptr);
    }
    SEAM(8);
    if (IN(9)) { phase_route(P, lds); }
    SEAM(9);
    if (IN(10)) { phase_experts(P, lds); }
#undef IN
#undef SEAM
}
}

#ifndef MK_N_LAUNCHES
#define MK_N_LAUNCHES 1
#endif
extern "C" void kernel_launch(void* const* d_in, const int* in_sizes, int n_in, void* d_out, int out_size, void* d_ws, size_t ws_size, hipStream_t stream) {
    using namespace mk;
    static int grid = 0;
    if (grid == 0) {
        if (n_in != 23 || (size_t)out_size != O_END || ws_size < WS_END) { fprintf(stderr, "kernel_launch: unexpected shapes: n_in %d out %d ws %zu (need %zu)\n", n_in, out_size, ws_size, (size_t)WS_END); grid = -1; return; }
        int dev = 0, cus = 0, per_cu = 0;
        if (hipGetDevice(&dev) != hipSuccess || hipDeviceGetAttribute(&cus, hipDeviceAttributeMultiprocessorCount, dev) != hipSuccess) { grid = -1; return; }
        if (hipFuncSetAttribute((const void*)fwd, hipFuncAttributeMaxDynamicSharedMemorySize, LDS_BYTES) != hipSuccess) { fprintf(stderr, "kernel_launch: hipFuncSetAttribute failed\n"); grid = -1; return; }
        if (hipOccupancyMaxActiveBlocksPerMultiprocessor(&per_cu, (const void*)fwd, NTHREADS, LDS_BYTES) != hipSuccess || per_cu < 1) { fprintf(stderr, "kernel_launch: occupancy query says %d\n", per_cu); }
        (void)hipGetLastError();
        grid = cus;
    }
    if (grid < 0) return;
    (void)hipMemsetAsync((char*)d_ws + WS_CTL, 0, 65536, stream);
    Params p{};
    p.x_prompt = (const float*)d_in[0]; p.x_sample = (const float*)d_in[1]; p.cache_k = (const float*)d_in[2]; p.cache_v = (const float*)d_in[3];
    p.state_conv = (const float*)d_in[4]; p.state_h = (const float*)d_in[5]; p.w_in = (const float*)d_in[6]; p.conv_w = (const float*)d_in[7]; p.conv_b = (const float*)d_in[8];
    p.lru_w_a = (const float*)d_in[9]; p.lru_b_a = (const float*)d_in[10]; p.lru_w_x = (const float*)d_in[11]; p.lru_b_x = (const float*)d_in[12]; p.lru_lambda = (const float*)d_in[13];
    p.w_out = (const float*)d_in[14]; p.ln1_g = (const float*)d_in[15]; p.ln1_b = (const float*)d_in[16]; p.w_query = (const float*)d_in[17]; p.sub_keys = (const float*)d_in[18];
    p.peer_u = (const float*)d_in[19]; p.peer_v = (const float*)d_in[20]; p.ln2_g = (const float*)d_in[21]; p.ln2_b = (const float*)d_in[22];
    p.out = (float*)d_out; p.ws = (unsigned char*)d_ws;
#if MK_N_LAUNCHES == 1
    p.ph_lo = 0; p.ph_hi = NPHASE;
    hipLaunchKernelGGL(fwd, dim3(grid), dim3(NTHREADS), LDS_BYTES, stream, p);
#else
    for (int k = 0; k < NPHASE; ++k) { p.ph_lo = k; p.ph_hi = k + 1; hipLaunchKernelGGL(fwd, dim3(grid), dim3(NTHREADS), LDS_BYTES, stream, p);
#ifdef MK_EXTRA_PHASE
        if (k == MK_EXTRA_PHASE) hipLaunchKernelGGL(fwd, dim3(grid), dim3(NTHREADS), LDS_BYTES, stream, p);
#endif
    }
#endif
    const hipError_t le = hipPeekAtLastError();
    if (le != hipSuccess) fprintf(stderr, "kernel_launch: launch failed: %s\n", hipGetErrorName(le));
}
```

```cpp
#include <hip/hip_runtime.h>
#include <cstdio>
#include <cstdint>
namespace pg8 {
#define PG8_LAS __attribute__((address_space(3)))
typedef unsigned short bf16_t;
typedef short bf16x8 __attribute__((ext_vector_type(8)));
typedef float f32x4 __attribute__((ext_vector_type(4)));
typedef unsigned u32x4 __attribute__((ext_vector_type(4)));
constexpr int BM = 256, BK = 64, HALF = 128, HTB = HALF * BK * 2  , STAGE_BYTES = 8 * HTB, NXCD = 8, WGM = 8;

__host__ __device__ __forceinline__ int lds_byte(int r, int c) { const int st = (r >> 4) * 2 + (c >> 5), rr = r & 15, cc = c & 31, ob = rr * 64 + cc * 2; return st * 1024 + (ob ^ (((ob >> 9) & 1) << 5)); }
__host__ __device__ __forceinline__ void stage_rc(int b, int& R, int& C) { const int st = b / 1024, sb = b % 1024, swz = sb ^ (((sb >> 9) & 1) << 5); R = (st >> 1) * 16 + swz / 64; C = (st & 1) * 32 + (swz % 64) / 2; }
__host__ __device__ __forceinline__ int perm32(int rho) { const int n = rho >> 4, i = rho & 15; return 8 * (i >> 2) + 4 * n + (i & 3); }

struct Unit { int pm, pn; };
struct Gemm { const bf16_t* A; const bf16_t* Bt; int M, N, K; };

struct StaticOrder {
    int nM, nN, nwg, G, c;
    __host__ __device__ void init(int M, int N, int G_, int c_) { nM = M / BM; nN = N / BM; nwg = nM * nN; G = G_; c = c_; }
    __host__ __device__ bool next(int i, Unit& u) const {
        const long L = (long)i * G + c; if (L >= nwg) return false;
        int wgid = (int)L; { const int q = nwg / NXCD, r = nwg % NXCD, xcd = wgid % NXCD, off = wgid / NXCD; wgid = (xcd < r ? xcd * (q + 1) : r * (q + 1) + (xcd - r) * q) + off; }
        const int nig = WGM * nN, gid = wgid / nig, fm = gid * WGM, gsz = (nM - fm) < WGM ? (nM - fm) : WGM;
        u.pm = fm + ((wgid % nig) % gsz); u.pn = (wgid % nig) / gsz; return true;
    }
    __device__ __forceinline__ void a_ready(const Unit&) const {}
    __device__ __forceinline__ void done(const Unit&) const {}
};
struct CountedOrder : StaticOrder {
    const unsigned* ready; unsigned need; unsigned* tmo;
    __device__ __forceinline__ void a_ready(const Unit& u) const {
        if (threadIdx.x < 64) {
            const unsigned long long t0 = __builtin_amdgcn_s_memrealtime(); unsigned polls = 0;
            while ((unsigned)__builtin_amdgcn_readfirstlane(__hip_atomic_load(ready + 64 * u.pm, __ATOMIC_RELAXED, __HIP_MEMORY_SCOPE_AGENT)) < need) {
                if ((++polls & 255u) == 0u && __builtin_amdgcn_readfirstlane(__hip_atomic_load(tmo, __ATOMIC_RELAXED, __HIP_MEMORY_SCOPE_AGENT)) != 0u) break;
                if (__builtin_amdgcn_s_memrealtime() - t0 > 2000000ull) {
                    if (threadIdx.x == 0) { unsigned expect = 0u; __hip_atomic_compare_exchange_strong(tmo + 1, &expect, 0x600u | (unsigned)(u.pm & 0xff), __ATOMIC_RELAXED, __ATOMIC_RELAXED, __HIP_MEMORY_SCOPE_AGENT); __hip_atomic_store(tmo, 1u, __ATOMIC_RELAXED, __HIP_MEMORY_SCOPE_AGENT); }
                    break; }
                __builtin_amdgcn_s_sleep(2); }
            __builtin_amdgcn_fence(__ATOMIC_ACQUIRE, "agent");
            asm volatile("s_waitcnt vmcnt(0)" ::: "memory");
        }
#if !defined(BROKEN_HOOK_NO_BARRIER)
        asm volatile("" ::: "memory"); __builtin_amdgcn_s_barrier(); asm volatile("" ::: "memory");
#endif
    }
};

__device__ __forceinline__ unsigned cvt_pk_bf16(float lo, float hi) { unsigned r; asm volatile("v_cvt_pk_bf16_f32 %0, %1, %2" : "=v"(r) : "v"(lo), "v"(hi)); return r; }
typedef float f32x2 __attribute__((ext_vector_type(2)));
__device__ __forceinline__ f32x2 gelu_pk(f32x2 v) {
    const f32x2 av = __builtin_elementwise_abs(v), d = av * 0.2316418882f + 1.0f;
    f32x2 t; t.x = __builtin_amdgcn_rcpf(d.x); t.y = __builtin_amdgcn_rcpf(d.y);
    f32x2 q = t * 0.5307027145f + (-0.7265760135f); q = q * t + 0.7107068705f; q = q * t + (-0.142248368f); q = q * t + 0.127414796f; q = q * t;
    const f32x2 s = (v * v) * (-0.72134752044f);
    f32x2 e; e.x = __builtin_amdgcn_exp2f(s.x); e.y = __builtin_amdgcn_exp2f(s.y);
    const f32x2 m = v * (q * e), r = v - m;
    f32x2 o; o.x = v.x < 0.f ? m.x : r.x; o.y = v.y < 0.f ? m.y : r.y; return o;
}

struct EpiF32 {
    static constexpr bool PERM = false, AFTER_DRAIN = false;
    float* C; int ldc; const float* bias;
    __device__ __forceinline__ void operator()(const f32x4 (&acc)[2][2][4][2], const Unit& u, int wr, int wc, int fr, int fq) const {
        const int row0 = u.pm * BM + wr * 64 + fr, col0 = u.pn * BM + wc * 32 + 4 * fq;
        f32x4 bv[2][2];
#pragma unroll
        for (int bj = 0; bj < 2; ++bj)
#pragma unroll
            for (int n = 0; n < 2; ++n) bv[bj][n] = bias ? *(const f32x4*)(bias + col0 + bj * HALF + n * 16) : (f32x4){0.f, 0.f, 0.f, 0.f};
#pragma unroll
        for (int ai = 0; ai < 2; ++ai)
#pragma unroll
            for (int m = 0; m < 4; ++m) { float* rowp = C + (size_t)(row0 + ai * HALF + m * 16) * ldc + col0;
#pragma unroll
                for (int bj = 0; bj < 2; ++bj)
#pragma unroll
                    for (int n = 0; n < 2; ++n) *(f32x4*)(rowp + bj * HALF + n * 16) = acc[ai][bj][m][n] + bv[bj][n]; }
    }
};
template <int ACT  > struct EpiBf16 {
    static constexpr bool PERM = true, AFTER_DRAIN = false;
    bf16_t* O; int ldc; const float* bias; int split_cols; size_t split_stride;
    __device__ __forceinline__ void operator()(const f32x4 (&acc)[2][2][4][2], const Unit& u, int wr, int wc, int fr, int fq) const {
        const int row0 = u.pm * BM + wr * 64 + fr; int colt = u.pn * BM; bf16_t* base = O;
        if (split_cols) { const int t = colt / split_cols; base += (size_t)t * split_stride; colt -= t * split_cols; }
        const int col0 = colt + wc * 32 + 8 * fq, bcol0 = u.pn * BM + wc * 32 + 8 * fq;
        f32x4 bv[2][2];
#pragma unroll
        for (int bj = 0; bj < 2; ++bj)
#pragma unroll
            for (int n = 0; n < 2; ++n) bv[bj][n] = bias ? *(const f32x4*)(bias + bcol0 + bj * HALF + 4 * n) : (f32x4){0.f, 0.f, 0.f, 0.f};
#pragma unroll
        for (int ai = 0; ai < 2; ++ai)
#pragma unroll
            for (int m = 0; m < 4; ++m) { bf16_t* rowp = base + (size_t)(row0 + ai * HALF + m * 16) * ldc + col0;
#pragma unroll
                for (int bj = 0; bj < 2; ++bj) { f32x4 v0 = acc[ai][bj][m][0] + bv[bj][0], v1 = acc[ai][bj][m][1] + bv[bj][1];
                    if (ACT == 1) { f32x2 a = gelu_pk((f32x2){v0[0], v0[1]}), b = gelu_pk((f32x2){v0[2], v0[3]}), c = gelu_pk((f32x2){v1[0], v1[1]}), d = gelu_pk((f32x2){v1[2], v1[3]});
                        v0 = (f32x4){a.x, a.y, b.x, b.y}; v1 = (f32x4){c.x, c.y, d.x, d.y}; }
                    if (ACT == 2) {
#pragma unroll
                        for (int j = 0; j < 4; ++j) { v0[j] = 0.5f * v0[j] * (1.0f + erff(v0[j] * 0.70710678f)); v1[j] = 0.5f * v1[j] * (1.0f + erff(v1[j] * 0.70710678f)); } }
                    u32x4 w; w.x = cvt_pk_bf16(v0[0], v0[1]); w.y = cvt_pk_bf16(v0[2], v0[3]); w.z = cvt_pk_bf16(v1[0], v1[1]); w.w = cvt_pk_bf16(v1[2], v1[3]);
                    *(u32x4*)(rowp + bj * HALF) = w; } }
    }
};

struct PanelStats {
    unsigned* xbuf;
    unsigned* cnt;
    unsigned* tmo;
    int ntn; float eps;
    unsigned code;
    __device__ __forceinline__ bool run(const f32x4 (&v)[2][2][4][2], const Unit& u, int wr, int wc, int fr, int fq, PG8_LAS unsigned char* lds, int wid, int lane) const {
        typedef float f32x2v __attribute__((ext_vector_type(2)));
        PG8_LAS f32x2v* P = (PG8_LAS f32x2v*)lds;
        PG8_LAS f32x2v* S = (PG8_LAS f32x2v*)(lds + 8192);
        PG8_LAS unsigned* flag = (PG8_LAS unsigned*)(lds + 8192 + 2048);
#pragma unroll
        for (int ai = 0; ai < 2; ++ai)
#pragma unroll
            for (int m = 0; m < 4; ++m) {
                float s = 0.f;
#pragma unroll
                for (int bj = 0; bj < 2; ++bj)
#pragma unroll
                    for (int n = 0; n < 2; ++n) { const f32x4 x = v[ai][bj][m][n]; s += (x[0] + x[1]) + (x[2] + x[3]); }
                s += __shfl_xor(s, 16); s += __shfl_xor(s, 32);
                const float mw = s * (1.0f / 64.0f); float q = 0.f;
#pragma unroll
                for (int bj = 0; bj < 2; ++bj)
#pragma unroll
                    for (int n = 0; n < 2; ++n) { const f32x4 d = v[ai][bj][m][n] - mw; q += (d[0] * d[0] + d[1] * d[1]) + (d[2] * d[2] + d[3] * d[3]); }
                q += __shfl_xor(q, 16); q += __shfl_xor(q, 32);
                if (fq == 0) P[(ai * HALF + wr * 64 + m * 16 + fr) * 4 + wc] = (f32x2v){mw, q};
            }
        asm volatile("s_waitcnt lgkmcnt(0)" ::: "memory"); __builtin_amdgcn_s_barrier(); asm volatile("" ::: "memory");
#if defined(BROKEN_NO_WAIT)
        if (blockIdx.x >= 64) { const long long t0 = clock64(); while (clock64() - t0 < 60000) __builtin_amdgcn_s_sleep(8); }
#endif
        const int row = wid * 32 + (lane & 31);
        if (lane < 32) {
            const f32x2v a = P[row * 4 + 0], b = P[row * 4 + 1], c = P[row * 4 + 2], d = P[row * 4 + 3];
            const float mt = (a.x + b.x + c.x + d.x) * 0.25f;
            const float da = a.x - mt, db = b.x - mt, dc = c.x - mt, dd = d.x - mt;
            const float m2 = (a.y + b.y) + (c.y + d.y) + 64.0f * ((da * da + db * db) + (dc * dc + dd * dd));
            unsigned long long* slot = (unsigned long long*)xbuf + ((size_t)(u.pm * BM + row) * 4 + u.pn);
            __hip_atomic_store(slot, ((unsigned long long)__float_as_uint(m2) << 32) | __float_as_uint(mt), __ATOMIC_RELAXED, __HIP_MEMORY_SCOPE_AGENT);
        }
        asm volatile("s_waitcnt vmcnt(0)" ::: "memory");
        if (lane == 0) __hip_atomic_fetch_add(cnt + 64 * u.pm, 1u, __ATOMIC_RELAXED, __HIP_MEMORY_SCOPE_AGENT);
        if (wid == 0) {
            bool dead = false; const unsigned long long t0 = __builtin_amdgcn_s_memrealtime(); const unsigned want = 8u * (unsigned)ntn;
            for (;;) {
#if defined(BROKEN_NO_WAIT)
                break;
#endif
                if ((unsigned)__builtin_amdgcn_readfirstlane(__hip_atomic_load(cnt + 64 * u.pm, __ATOMIC_RELAXED, __HIP_MEMORY_SCOPE_AGENT)) >= want) break;
                if (__builtin_amdgcn_s_memrealtime() - t0 > 2000000ull) {
                    if (lane == 0) { unsigned expect = 0u; __hip_atomic_compare_exchange_strong(tmo + 1, &expect, code | (unsigned)(u.pm & 0xff), __ATOMIC_RELAXED, __ATOMIC_RELAXED, __HIP_MEMORY_SCOPE_AGENT);
                                     __hip_atomic_store(tmo, 1u, __ATOMIC_RELAXED, __HIP_MEMORY_SCOPE_AGENT); }
                    dead = true; break; }
                __builtin_amdgcn_s_sleep(2);
            }
            __builtin_amdgcn_fence(__ATOMIC_ACQUIRE, "agent");
            if (lane == 0) flag[0] = dead ? 1u : 0u;
        }
        asm volatile("s_waitcnt vmcnt(0) lgkmcnt(0)" ::: "memory"); __builtin_amdgcn_s_barrier(); asm volatile("" ::: "memory");
        const bool bad = flag[0] != 0u;
        if (lane < 32) {
            const unsigned long long* slot = (const unsigned long long*)xbuf + (size_t)(u.pm * BM + row) * 4; float mt[4], m2[4]; float ms = 0.f;
#pragma unroll
            for (int t = 0; t < 4; ++t) { if (t < ntn) { const unsigned long long w = __hip_atomic_load(slot + t, __ATOMIC_RELAXED, __HIP_MEMORY_SCOPE_AGENT); mt[t] = __uint_as_float((unsigned)w); m2[t] = __uint_as_float((unsigned)(w >> 32)); } else { mt[t] = 0.f; m2[t] = 0.f; } ms += mt[t]; }
            const float mean = ms / (float)ntn; float q = 0.f;
#pragma unroll
            for (int t = 0; t < 4; ++t) if (t < ntn) { const float dm = mt[t] - mean; q += m2[t] + 256.0f * dm * dm; }
            S[row] = (f32x2v){mean, 1.0f / sqrtf(q / (256.0f * (float)ntn) + eps)};
        }
        asm volatile("s_waitcnt lgkmcnt(0)" ::: "memory"); __builtin_amdgcn_s_barrier(); asm volatile("" ::: "memory");
        return bad;
    }
};
struct EpiLnRes {
    static constexpr bool PERM = false, AFTER_DRAIN = true;
    const float* base; float* out; int ldc; const float* bias; PanelStats st; unsigned poison;
    __device__ __forceinline__ void refuse(size_t i0, size_t stride, int M, int N) const { const float q = __builtin_nanf(""); for (size_t i = i0; i < (size_t)M * N; i += stride) out[(i / N) * ldc + i % N] = q;
        if (i0 == 0) { unsigned expect = 0u; __hip_atomic_compare_exchange_strong(st.tmo + 1, &expect, 0x7f0u, __ATOMIC_RELAXED, __ATOMIC_RELAXED, __HIP_MEMORY_SCOPE_AGENT); __hip_atomic_store(st.tmo, 1u, __ATOMIC_RELAXED, __HIP_MEMORY_SCOPE_AGENT); } }
    __device__ __forceinline__ void fused(f32x4 (&acc)[2][2][4][2], const Unit& u, int wr, int wc, int fr, int fq, PG8_LAS unsigned char* lds, int wid, int lane) const {
        typedef float f32x2v __attribute__((ext_vector_type(2)));
        const PG8_LAS f32x2v* S = (const PG8_LAS f32x2v*)(lds + 8192);
        const int col0 = u.pn * BM + wc * 32 + 4 * fq;
#pragma unroll
        for (int bj = 0; bj < 2; ++bj)
#pragma unroll
            for (int n = 0; n < 2; ++n) { const f32x4 bv = bias ? *(const f32x4*)(bias + col0 + bj * HALF + n * 16) : (f32x4){0.f, 0.f, 0.f, 0.f};
#pragma unroll
                for (int ai = 0; ai < 2; ++ai)
#pragma unroll
                    for (int m = 0; m < 4; ++m) acc[ai][bj][m][n] += bv; }
        const bool bad = st.run(acc, u, wr, wc, fr, fq, lds, wid, lane) || poison != 0u;
        const float qnan = __builtin_nanf("");
#pragma unroll
        for (int ai = 0; ai < 2; ++ai)
#pragma unroll
            for (int m = 0; m < 4; ++m) { const int r = ai * HALF + wr * 64 + m * 16 + fr; const f32x2v sr = S[r]; const size_t off = (size_t)(u.pm * BM + r) * ldc + col0;
#pragma unroll
                for (int bj = 0; bj < 2; ++bj)
#pragma unroll
                    for (int n = 0; n < 2; ++n) { const f32x4 bs = *(const f32x4*)(base + off + bj * HALF + n * 16); f32x4 o = bs + (acc[ai][bj][m][n] - sr.x) * sr.y;
                        if (bad) o = (f32x4){qnan, qnan, qnan, qnan}; *(f32x4*)(out + off + bj * HALF + n * 16) = o; }
                asm volatile("" ::: "memory"); }
    }
};
struct EpiLnResLn {
    static constexpr bool PERM = false, AFTER_DRAIN = true;
    const float* base; float* out; bf16_t* xn; int ldc; const float* bias; PanelStats st1, st2; unsigned poison;
    __device__ __forceinline__ void refuse(size_t i0, size_t stride, int M, int N) const { const float q = __builtin_nanf(""); for (size_t i = i0; i < (size_t)M * N; i += stride) { const size_t o = (i / N) * ldc + i % N; out[o] = q; xn[o] = (bf16_t)0x7fc0u; }
        if (i0 == 0) { unsigned expect = 0u; __hip_atomic_compare_exchange_strong(st1.tmo + 1, &expect, 0x7f0u, __ATOMIC_RELAXED, __ATOMIC_RELAXED, __HIP_MEMORY_SCOPE_AGENT); __hip_atomic_store(st1.tmo, 1u, __ATOMIC_RELAXED, __HIP_MEMORY_SCOPE_AGENT); } }
    __device__ __forceinline__ void fused(f32x4 (&acc)[2][2][4][2], const Unit& u, int wr, int wc, int fr, int fq, PG8_LAS unsigned char* lds, int wid, int lane) const {
        typedef float f32x2v __attribute__((ext_vector_type(2))); typedef unsigned u32x2v __attribute__((ext_vector_type(2)));
        const PG8_LAS f32x2v* S = (const PG8_LAS f32x2v*)(lds + 8192);
        const int col0 = u.pn * BM + wc * 32 + 4 * fq;
#pragma unroll
        for (int bj = 0; bj < 2; ++bj)
#pragma unroll
            for (int n = 0; n < 2; ++n) { const f32x4 bv = bias ? *(const f32x4*)(bias + col0 + bj * HALF + n * 16) : (f32x4){0.f, 0.f, 0.f, 0.f};
#pragma unroll
                for (int ai = 0; ai < 2; ++ai)
#pragma unroll
                    for (int m = 0; m < 4; ++m) acc[ai][bj][m][n] += bv; }
        bool bad = st1.run(acc, u, wr, wc, fr, fq, lds, wid, lane) || poison != 0u;
        const float qnan = __builtin_nanf("");
#pragma unroll
        for (int ai = 0; ai < 2; ++ai)
#pragma unroll
            for (int m = 0; m < 4; ++m) { const int r = ai * HALF + wr * 64 + m * 16 + fr; const f32x2v sr = S[r]; const size_t off = (size_t)(u.pm * BM + r) * ldc + col0;
#pragma unroll
                for (int bj = 0; bj < 2; ++bj)
#pragma unroll
                    for (int n = 0; n < 2; ++n) { const f32x4 bs = *(const f32x4*)(base + off + bj * HALF + n * 16); acc[ai][bj][m][n] = bs + (acc[ai][bj][m][n] - sr.x) * sr.y; }
                asm volatile("" : "+v"(acc[ai][0][m][0]), "+v"(acc[ai][0][m][1]), "+v"(acc[ai][1][m][0]), "+v"(acc[ai][1][m][1]));
                if (m & 1) asm volatile("" ::: "memory"); }
        const bool bad1 = bad;
        bad = st2.run(acc, u, wr, wc, fr, fq, lds, wid, lane) || bad;
#pragma unroll
        for (int ai = 0; ai < 2; ++ai)
#pragma unroll
            for (int m = 0; m < 4; ++m) { const int r = ai * HALF + wr * 64 + m * 16 + fr; const f32x2v sr = S[r]; const size_t off = (size_t)(u.pm * BM + r) * ldc + col0;
#pragma unroll
                for (int bj = 0; bj < 2; ++bj)
#pragma unroll
                    for (int n = 0; n < 2; ++n) { const f32x4 x1 = acc[ai][bj][m][n]; *(f32x4*)(out + off + bj * HALF + n * 16) = bad1 ? (f32x4){qnan, qnan, qnan, qnan} : x1;
                        const f32x4 o = (x1 - sr.x) * sr.y; u32x2v w; w.x = cvt_pk_bf16(o[0], o[1]); w.y = cvt_pk_bf16(o[2], o[3]);
                        if (bad) { w.x = 0x7fc07fc0u; w.y = 0x7fc07fc0u; } *(u32x2v*)(xn + off + bj * HALF + n * 16) = w; }
                asm volatile("" ::: "memory"); }
    }
};

template <class Epi, class Sched, bool STAMP = false>
__device__ __forceinline__ void gemm_phase(PG8_LAS unsigned char* lds, const Gemm g, const Sched& S, const Epi& E, unsigned long long* stamps) {
    const int tid = threadIdx.x, wid = __builtin_amdgcn_readfirstlane(tid >> 6), lane = tid & 63, wr = wid >> 2, wc = wid & 3, fr = lane & 15, fq = lane >> 4;
    const int K = g.K, nt = K / BK;
    int ts_lo = 0, ts_hi = 0, nts = 0; const unsigned long long rt_entry = STAMP ? (unsigned long long)wall_clock64() : 0ull;
#define PG8_STAMP() do { if (STAMP && wid == 0 && nts < 64) { const unsigned long long _c = (unsigned long long)clock64(); \
        ts_lo = (lane == nts) ? (int)(unsigned)_c : ts_lo; ts_hi = (lane == nts) ? (int)(unsigned)(_c >> 32) : ts_hi; ++nts; } } while (0)
    PG8_STAMP();
    unsigned voffA[2], voffB[2];
#pragma unroll
    for (int i = 0; i < 2; ++i) { int R, C; stage_rc(tid * 16 + i * 8192, R, C); const int Rb = Epi::PERM ? ((R & ~31) + perm32(R & 31)) : R;
        voffA[i] = (unsigned)(R * K + C) * 2u; voffB[i] = (unsigned)(Rb * K + C) * 2u; }
    const size_t kstep = (size_t)(BK * 2);
    const size_t hstep = (size_t)HALF * K * 2;
    const size_t tstep = 2 * hstep;
    const unsigned ldsw = (unsigned)wid * 1024u;
    const int aoff = lds_byte(wr * 64 + fr, fq * 8), boff = lds_byte(wc * 32 + fr, fq * 8);
#define PG8_SA(b, h) (((b) * 2 + (h)) * HTB)
#define PG8_SB(b, h) ((4 + (b) * 2 + (h)) * HTB)
#define PG8_STAGE(bufoff, gbase, voff) do { _Pragma("unroll") for (int _i = 0; _i < 2; ++_i) \
        __builtin_amdgcn_global_load_lds((const unsigned*)((const char*)(gbase) + (voff)[_i]), (PG8_LAS unsigned*)(lds + (bufoff) + ldsw + _i * 8192), 16, 0, 0); } while (0)
#define PG8_LDA(dst, b, h) do { _Pragma("unroll") for (int m = 0; m < 4; ++m) _Pragma("unroll") for (int k = 0; k < 2; ++k) dst[m][k] = *(const PG8_LAS bf16x8*)(lds + PG8_SA(b, h) + aoff + m * 2048 + k * 1024); } while (0)
#define PG8_LDB(dst, b, h) do { _Pragma("unroll") for (int n = 0; n < 2; ++n) _Pragma("unroll") for (int k = 0; k < 2; ++k) dst[n][k] = *(const PG8_LAS bf16x8*)(lds + PG8_SB(b, h) + boff + n * 2048 + k * 1024); } while (0)
#define PG8_MMA(ai, bj, At, Bt) do { __builtin_amdgcn_s_setprio(1); _Pragma("unroll") for (int m = 0; m < 4; ++m) _Pragma("unroll") for (int n = 0; n < 2; ++n) _Pragma("unroll") for (int k = 0; k < 2; ++k) \
        acc[ai][bj][m][n] = __builtin_amdgcn_mfma_f32_16x16x32_bf16(Bt[n][k], At[m][k], acc[ai][bj][m][n], 0, 0, 0); __builtin_amdgcn_s_setprio(0); } while (0)
#define PG8_WAIT_V(n) asm volatile("s_waitcnt vmcnt(" #n ")" ::: "memory")
#define PG8_WAIT_L(n) asm volatile("s_waitcnt lgkmcnt(" #n ")" ::: "memory")
#define PG8_BAR __builtin_amdgcn_s_barrier()
#define PG8_SCHED __builtin_amdgcn_sched_barrier(0)
    Unit cur, nxt; int ui = 0;
    if (!S.next(0, cur)) return;
    f32x4 acc[2][2][4][2];
#pragma unroll
    for (int a = 0; a < 2; ++a)
#pragma unroll
        for (int b = 0; b < 2; ++b)
#pragma unroll
            for (int m = 0; m < 4; ++m)
#pragma unroll
                for (int n = 0; n < 2; ++n) acc[a][b][m][n] = (f32x4){0.f, 0.f, 0.f, 0.f};
    bf16x8 At[4][2], B0[2][2], B1[2][2];
    const char* cA = (const char*)g.A + (size_t)cur.pm * tstep; const char* cB = (const char*)g.Bt + (size_t)cur.pn * tstep;
    S.a_ready(cur);
    PG8_STAGE(PG8_SB(0, 0), cB, voffB); PG8_STAGE(PG8_SA(0, 0), cA, voffA); PG8_STAGE(PG8_SB(0, 1), cB + hstep, voffB); PG8_STAGE(PG8_SA(0, 1), cA + hstep, voffA);
    if (wr == 1) PG8_BAR;
    PG8_WAIT_V(4); PG8_BAR;
    PG8_STAGE(PG8_SB(1, 0), cB + kstep, voffB); PG8_STAGE(PG8_SA(1, 0), cA + kstep, voffA); PG8_STAGE(PG8_SB(1, 1), cB + hstep + kstep, voffB);
    PG8_WAIT_V(6); PG8_BAR;
    PG8_STAMP();
    for (;;) {
        const bool has_next = S.next(ui + 1, nxt);
        const char* nA = has_next ? (const char*)g.A + (size_t)nxt.pm * tstep : cA; const char* nB = has_next ? (const char*)g.Bt + (size_t)nxt.pn * tstep : cB;
        for (int t = 0; t < nt; t += 2) {
            const bool last = (t == nt - 2);
            const char* a1 = cA + (size_t)(t + 1) * kstep;
            const char* a2 = last ? nA : cA + (size_t)(t + 2) * kstep; const char* b2 = last ? nB : cB + (size_t)(t + 2) * kstep;
            const char* a3 = a2 + kstep; const char* b3 = b2 + kstep;
            if (last && has_next) S.a_ready(nxt);
            PG8_LDB(B0, 0, 0); PG8_SCHED; PG8_LDA(At, 0, 0); PG8_STAGE(PG8_SA(1, 1), a1 + hstep, voffA);
            PG8_WAIT_L(8); PG8_BAR; PG8_WAIT_L(0); PG8_MMA(0, 0, At, B0); PG8_BAR; PG8_SCHED;
            PG8_LDB(B1, 0, 1); PG8_STAGE(PG8_SB(0, 0), b2, voffB);
            PG8_BAR; PG8_WAIT_L(0); PG8_MMA(0, 1, At, B1); PG8_BAR;
            PG8_LDA(At, 0, 1); PG8_STAGE(PG8_SA(0, 0), a2, voffA);
            PG8_BAR; PG8_WAIT_L(0); PG8_MMA(1, 0, At, B0); PG8_BAR; PG8_SCHED;
            PG8_STAGE(PG8_SB(0, 1), b2 + hstep, voffB);
            PG8_WAIT_V(6); PG8_BAR; PG8_MMA(1, 1, At, B1); PG8_BAR;
            PG8_LDB(B0, 1, 0); PG8_SCHED; PG8_LDA(At, 1, 0); PG8_STAGE(PG8_SA(0, 1), a2 + hstep, voffA);
            PG8_WAIT_L(8); PG8_BAR; PG8_WAIT_L(0); PG8_MMA(0, 0, At, B0); PG8_BAR; PG8_SCHED;
            PG8_LDB(B1, 1, 1); PG8_STAGE(PG8_SB(1, 0), b3, voffB);
            PG8_BAR; PG8_WAIT_L(0); PG8_MMA(0, 1, At, B1); PG8_BAR;
            PG8_LDA(At, 1, 1); PG8_STAGE(PG8_SA(1, 0), a3, voffA);
            PG8_BAR; PG8_WAIT_L(0); PG8_MMA(1, 0, At, B0); PG8_BAR; PG8_SCHED;
            PG8_STAGE(PG8_SB(1, 1), b3 + hstep, voffB);
            PG8_WAIT_V(6); PG8_BAR; PG8_MMA(1, 1, At, B1); PG8_BAR;
        }
        PG8_STAMP();
        if constexpr (!Epi::AFTER_DRAIN) { E(acc, cur, wr, wc, fr, fq); S.done(cur); }
        PG8_STAMP();
        if (!has_next) break;
#pragma unroll
        for (int a = 0; a < 2; ++a)
#pragma unroll
            for (int b = 0; b < 2; ++b)
#pragma unroll
                for (int m = 0; m < 4; ++m)
#pragma unroll
                    for (int n = 0; n < 2; ++n) acc[a][b][m][n] = (f32x4){0.f, 0.f, 0.f, 0.f};
        cur = nxt; cA = nA; cB = nB; ++ui;
    }
    PG8_WAIT_V(0);
    if (wr == 0) PG8_BAR;
    PG8_BAR;
    if constexpr (Epi::AFTER_DRAIN) { E.fused(acc, cur, wr, wc, fr, fq, lds, wid, lane); S.done(cur); }
    PG8_STAMP();
    if (STAMP && wid == 0) { stamps[lane] = lane < nts ? (((unsigned long long)(unsigned)ts_hi << 32) | (unsigned)ts_lo) : 0ull;
        if (lane == 62) stamps[62] = rt_entry; if (lane == 63) stamps[63] = (unsigned long long)wall_clock64(); }
#undef PG8_STAMP
#undef PG8_SA
#undef PG8_SB
#undef PG8_STAGE
#undef PG8_LDA
#undef PG8_LDB
#undef PG8_MMA
#undef PG8_WAIT_V
#undef PG8_WAIT_L
#undef PG8_BAR
#undef PG8_SCHED
}
}
#define XB_TMO      128
#define XB_XCNT(j)  (256  + 64 * (j))
#define XB_XSUB(j)  (1280 + 64 * (j))
#define XB_XGEN(j)  (2304 + 64 * (j))
#define XB_TOP      3328
#define XB_TOPGEN   3392
#define XCD_BAR_WORDS 3456
#define XB_SPIN_CAP (1u << 18)
#define LAS __attribute__((address_space(3)))

__device__ __forceinline__ unsigned xb_ld(unsigned* p)              { return __hip_atomic_load(p, __ATOMIC_RELAXED, __HIP_MEMORY_SCOPE_AGENT); }
__device__ __forceinline__ unsigned xb_add(unsigned* p, unsigned v) { return __hip_atomic_fetch_add(p, v, __ATOMIC_RELAXED, __HIP_MEMORY_SCOPE_AGENT); }
__device__ __forceinline__ unsigned xb_xcc_id() { return (unsigned)__builtin_amdgcn_s_getreg((3 << 11) | 20) & 0xFu; }
#define XB_SPIN(cond, bar) do { unsigned _sp = 0; while (cond) { __builtin_amdgcn_s_sleep(1); \
    if ((++_sp & 255u) == 0u) { if (xb_ld(&(bar)[XB_TMO])) break; if (_sp > XB_SPIN_CAP) { atomicAdd(&(bar)[XB_TMO], 1u); break; } } } } while (0)

struct XcdBarrier {
    unsigned* bar; unsigned x;
    volatile LAS unsigned* st;
};

__device__ __forceinline__ XcdBarrier xcd_barrier_post(unsigned* bar, volatile LAS unsigned* st) {
    XcdBarrier b; b.bar = bar; b.x = xb_xcc_id(); b.st = st;
    if (threadIdx.x == 0) (void)xb_add(&bar[XB_XCNT(b.x)], 1u);
    return b;
}
__device__ __forceinline__ void xcd_barrier_complete(unsigned* bar, unsigned x, unsigned& nloc, unsigned& nx) {
    const unsigned G = gridDim.x * gridDim.y * gridDim.z;
    unsigned sum, cnt, mine, sp = 0u;
    for (;;) {
        sum = 0u; cnt = 0u; mine = 0u;
#pragma unroll
        for (unsigned j = 0; j < 16; ++j) { const unsigned c = xb_ld(&bar[XB_XCNT(j)]); sum += c; cnt += (c > 0u) ? 1u : 0u; mine = (j == x) ? c : mine; }
        if (sum == G) break;
        __builtin_amdgcn_s_sleep(1);
        if ((++sp & 255u) == 0u) { if (xb_ld(&bar[XB_TMO])) break; if (sp > XB_SPIN_CAP) { atomicAdd(&bar[XB_TMO], 1u); break; } }
    }
    nloc = mine > 0u ? mine : 1u; nx = cnt > 0u ? cnt : 1u;
}

__device__ __forceinline__ void xcd_barrier(const XcdBarrier& b) {
    asm volatile("s_waitcnt vmcnt(0)" ::: "memory");
    __syncthreads();
    if (threadIdx.x == 0) {
        unsigned* bar = b.bar;
        __builtin_amdgcn_s_waitcnt(0);
        unsigned nloc = b.st[0], nx = b.st[1];
        if (nloc == 0u) { xcd_barrier_complete(bar, b.x, nloc, nx); b.st[0] = nloc; b.st[1] = nx; }
        const unsigned old = xb_add(&bar[XB_XSUB(b.x)], 1u);
        const unsigned gen = old / nloc;
        if (old + 1u == (gen + 1u) * nloc) {
            __builtin_amdgcn_fence(__ATOMIC_RELEASE, "agent");
            asm volatile("s_waitcnt vmcnt(0)" ::: "memory");
            const unsigned og = xb_add(&bar[XB_TOP], 1u);
            const unsigned tg = og / nx;
            if (og + 1u == (tg + 1u) * nx) xb_add(&bar[XB_TOPGEN], 1u);
            else XB_SPIN(xb_ld(&bar[XB_TOPGEN]) == tg, bar);
            __builtin_amdgcn_fence(__ATOMIC_ACQUIRE, "agent");
            xb_add(&bar[XB_XGEN(b.x)], 1u);
            asm volatile("s_waitcnt vmcnt(0)" ::: "memory");
        } else {
            XB_SPIN(xb_ld(&bar[XB_XGEN(b.x)]) == gen, bar);
            __builtin_amdgcn_fence(__ATOMIC_ACQUIRE, "agent");
            asm volatile("s_waitcnt vmcnt(0)" ::: "memory");
        }
    }
    __syncthreads();
}


namespace mk {
typedef unsigned short bf16_t;
typedef float f32x4 __attribute__((ext_vector_type(4)));
typedef short bf16x8 __attribute__((ext_vector_type(8)));
typedef short s16x4 __attribute__((ext_vector_type(4)));
typedef unsigned u32x4 __attribute__((ext_vector_type(4)));
typedef unsigned u32x2 __attribute__((ext_vector_type(2)));
typedef float f32x2 __attribute__((ext_vector_type(2)));
constexpr int D = 2048, NTOK_P = 16384, NTOK_S = 256, NTOK = 16640;
constexpr int DIN = 5632, DATT = 1536, DLRU = 512, NH = 12, HD = 128;
constexpr int NEXP = 16384;
constexpr float ALPHA = 1.189207115002721f;
constexpr float LN_EPS = 1e-5f;
constexpr float ATT_SCALE = 0.08838834764831845f;
constexpr float LOG2E = 1.4426950408889634f;
constexpr size_t O_YP = 0, O_YS = 33554432, O_KP = 34078720, O_VP = 59244544, O_CP = 84410368, O_HP = 84422656,
                 O_KS = 84426752, O_VS = 185090048, O_CS = 285753344, O_HS = 285802496, O_END = 285818880;
constexpr size_t WS_CTL = 0;
constexpr size_t WS_XB = 65536;
constexpr size_t WS_WINT = WS_XB + (size_t)NTOK * D * 2;
constexpr size_t WS_WOT = WS_WINT + (size_t)DIN * D * 2;
constexpr size_t WS_WQT = WS_WOT + (size_t)D * D * 2;
constexpr size_t WS_UB = WS_WQT + (size_t)D * D * 2;
constexpr size_t WS_VB = WS_UB + (size_t)NEXP * D * 2;
constexpr size_t WS_QF = WS_VB + (size_t)NEXP * D * 2;
constexpr size_t WS_XR = WS_QF + (size_t)NTOK * DATT * 4;
constexpr size_t WS_GATE = WS_XR + (size_t)NTOK * DLRU * 4;
constexpr size_t WS_AR = WS_GATE + (size_t)NTOK * DLRU * 4;
constexpr size_t WS_PRE1 = WS_AR + (size_t)NTOK * D * 2;
constexpr size_t WS_X1F = WS_PRE1 + (size_t)NTOK * D * 4;
constexpr size_t WS_X1B = WS_X1F + (size_t)NTOK * D * 4;
constexpr size_t WS_QP = WS_X1B + (size_t)NTOK * D * 2;
constexpr size_t WS_EIDX = WS_QP + (size_t)NTOK * D * 4;
constexpr size_t WS_GW = WS_EIDX + (size_t)NTOK * 128 * 4;
constexpr size_t WS_SU = WS_GW + (size_t)NTOK * 128 * 4;
constexpr size_t WS_SV = WS_SU + (size_t)NEXP * 4;
constexpr size_t WS_SX = WS_SV + (size_t)NEXP * 4;
constexpr size_t WS_X1Q = WS_SX + (size_t)NTOK * 4;
constexpr size_t WS_SKB = WS_X1Q + (size_t)NTOK * D;
constexpr size_t WS_QB = WS_SKB + (size_t)8 * 2 * 128 * 128 * 2;
constexpr size_t WS_KB = WS_QB + (size_t)NTOK * DATT * 2;
constexpr size_t WS_VB16 = WS_KB + (size_t)NTOK_P * DATT * 2;
constexpr size_t WS_PO = WS_VB16 + (size_t)NTOK_P * DATT * 2;
constexpr size_t WS_PM = WS_PO + (size_t)2 * NTOK_P * DATT * 2;
constexpr size_t WS_PL = WS_PM + (size_t)2 * NTOK_P * NH * 4;
constexpr size_t WS_R0 = WS_PL + (size_t)2 * NTOK_P * NH * 4;
constexpr size_t WS_R1 = WS_R0 + (size_t)NTOK_P * DLRU * 4;
constexpr size_t WS_HE = WS_R1 + (size_t)NTOK_P * DLRU * 4;
constexpr size_t WS_AE = WS_HE + (size_t)8 * 32 * 512 * 4;
constexpr size_t WS_PS = WS_AE + (size_t)8 * 32 * 512 * 4;
constexpr size_t WS_END = WS_PS + (size_t)32 * 12 * 9 * 8 * 130 * 4;

constexpr int NTHREADS = 512;
constexpr int LDS_BYTES = 148480;
constexpr int MISC_OFF = 147456;

struct Params {
    const float* x_prompt; const float* x_sample; const float* cache_k; const float* cache_v; const float* state_conv; const float* state_h;
    const float* w_in; const float* conv_w; const float* conv_b; const float* lru_w_a; const float* lru_b_a; const float* lru_w_x; const float* lru_b_x;
    const float* lru_lambda; const float* w_out; const float* ln1_g; const float* ln1_b; const float* w_query; const float* sub_keys;
    const float* peer_u; const float* peer_v; const float* ln2_g; const float* ln2_b;
    float* out; unsigned char* ws; int ph_lo, ph_hi;
};

__device__ __forceinline__ unsigned f2bf(float f) { unsigned u = __float_as_uint(f); u += 0x7fffu + ((u >> 16) & 1u); return u >> 16; }
__device__ __forceinline__ unsigned pack2(float a, float b) { return f2bf(a) | (f2bf(b) << 16); }
__device__ __forceinline__ float bflo(unsigned w) { return __uint_as_float(w << 16); }
__device__ __forceinline__ float bfhi(unsigned w) { return __uint_as_float(w & 0xffff0000u); }
__device__ __forceinline__ float wave_sum(float v) {
#pragma unroll
    for (int o = 32; o >= 1; o >>= 1) v += __shfl_xor(v, o);
    return v;
}
__device__ __forceinline__ float wave_max(float v) {
#pragma unroll
    for (int o = 32; o >= 1; o >>= 1) v = fmaxf(v, __shfl_xor(v, o));
    return v;
}
__device__ __forceinline__ float gelu_exact(float v) { return 0.5f * v * (1.0f + erff(v * 0.7071067811865476f)); }
__device__ __forceinline__ float gelu_as(float v) {
    const float av = fabsf(v), t = __builtin_amdgcn_rcpf(av * 0.2316418882f + 1.0f);
    float q = t * 0.5307027145f + (-0.7265760135f); q = q * t + 0.7107068705f; q = q * t + (-0.142248368f); q = q * t + 0.127414796f; q = q * t;
    const float e = __builtin_amdgcn_exp2f((v * v) * (-0.72134752044f));
    const float m = v * (q * e);
    return v < 0.f ? m : v - m;
}
__device__ __forceinline__ float sigmoidf(float v) { return 1.0f / (1.0f + expf(-v)); }
__device__ __forceinline__ float readlane_f(float v, int l) { return __int_as_float(__builtin_amdgcn_readlane(__float_as_int(v), l)); }

__device__ __forceinline__ void convert_flat(const float* src, bf16_t* dst, size_t n8, size_t gtid, size_t gstride) {
    for (size_t i = gtid; i < n8; i += gstride) {
        const float4 a = ((const float4*)src)[2 * i], b = ((const float4*)src)[2 * i + 1];
        uint4 w; w.x = pack2(a.x, a.y); w.y = pack2(a.z, a.w); w.z = pack2(b.x, b.y); w.w = pack2(b.z, b.w);
        ((uint4*)dst)[i] = w;
    }
}
__device__ __forceinline__ void transpose_convert(const float* src, bf16_t* dst, int K, int N, LAS float* tile) {
    const int tid = threadIdx.x, ntn = N / 64, ntiles = (K / 64) * ntn;
    for (int tl = blockIdx.x; tl < ntiles; tl += gridDim.x) {
        const int kt = tl / ntn, nt = tl - kt * ntn;
#pragma unroll
        for (int i = 0; i < 8; ++i) { const int r = (tid >> 6) + 8 * i, c = tid & 63; tile[r * 65 + c] = src[(size_t)(kt * 64 + r) * N + nt * 64 + c]; }
        __syncthreads();
#pragma unroll
        for (int i = 0; i < 4; ++i) { const int n = (tid >> 5) + 16 * i, k0 = 2 * (tid & 31);
            const unsigned v = pack2(tile[k0 * 65 + n], tile[(k0 + 1) * 65 + n]);
            *(unsigned*)(dst + (size_t)(nt * 64 + n) * K + kt * 64 + k0) = v; }
        __syncthreads();
    }
}
constexpr int TROW = 1152;
__device__ __forceinline__ void quant_tables(const Params& P) {
    const int lane = threadIdx.x & 63, gw = blockIdx.x * 8 + (threadIdx.x >> 6), nw = gridDim.x * 8;
    for (int it = gw; it < 2 * NEXP; it += nw) {
        const bool isv = it >= NEXP; const int row = isv ? it - NEXP : it;
        const float* src = (isv ? P.peer_v : P.peer_u) + (size_t)row * D;
        float4 v[8]; float cm[2];
#pragma unroll
        for (int j = 0; j < 2; ++j) { float am = 0.f;
#pragma unroll
            for (int i = 0; i < 4; ++i) { const float4 t = *(const float4*)(src + j * 1024 + lane * 16 + i * 4); v[j * 4 + i] = t; am = fmaxf(am, fmaxf(fmaxf(fabsf(t.x), fabsf(t.y)), fmaxf(fabsf(t.z), fabsf(t.w)))); }
            cm[j] = am; }
        float rm = wave_max(fmaxf(cm[0], cm[1])); if (rm == 0.f) rm = 1.f;
        unsigned char* dst = P.ws + (isv ? WS_VB : WS_UB) + (size_t)row * TROW;
        u32x4 w; unsigned sqp = 0u;
#pragma unroll
        for (int j = 0; j < 2; ++j) {
            int sq = (int)ceilf(cm[j] / rm * 255.0f); sq = sq < 1 ? 1 : (sq > 255 ? 255 : sq);
            sqp |= (unsigned)sq << (8 * j);
            const float inv = (255.0f * 7.0f) / (rm * (float)sq);
#pragma unroll
            for (int hh = 0; hh < 2; ++hh) { unsigned dw = 0u;
#pragma unroll
                for (int e = 0; e < 8; ++e) { const float4 t = v[j * 4 + hh * 2 + (e >> 2)]; const float x = (e & 3) == 0 ? t.x : ((e & 3) == 1 ? t.y : ((e & 3) == 2 ? t.z : t.w));
                    int n = (int)rintf(x * inv); n = n < -7 ? -7 : (n > 7 ? 7 : n); dw |= (unsigned)(n + 8) << (4 * e); }
                w[j * 2 + hh] = dw; }
        }
        *(u32x4*)(dst + lane * 16) = w;
        *(unsigned short*)(dst + 1024 + lane * 2) = (unsigned short)sqp;
        if (lane == 0) ((float*)(P.ws + (isv ? WS_SV : WS_SU)))[row] = rm * (1.0f / (255.0f * 7.0f));
    }
}
__device__ __forceinline__ void phase_prologue(const Params& P, LAS unsigned char* lds) {
    const size_t gtid = (size_t)blockIdx.x * NTHREADS + threadIdx.x, gstride = (size_t)gridDim.x * NTHREADS;
    unsigned char* ws = P.ws;
    convert_flat(P.x_prompt, (bf16_t*)(ws + WS_XB), (size_t)NTOK_P * D / 8, gtid, gstride);
    convert_flat(P.x_sample, (bf16_t*)(ws + WS_XB) + (size_t)NTOK_P * D, (size_t)NTOK_S * D / 8, gtid, gstride);
    convert_flat(P.sub_keys, (bf16_t*)(ws + WS_SKB), (size_t)8 * 2 * 128 * 128 / 8, gtid, gstride);
    transpose_convert(P.w_in, (bf16_t*)(ws + WS_WINT), D, DIN, (LAS float*)lds);
    transpose_convert(P.w_out, (bf16_t*)(ws + WS_WOT), D, D, (LAS float*)lds);
    transpose_convert(P.w_query, (bf16_t*)(ws + WS_WQT), D, D, (LAS float*)lds);
}

struct EpiProj {
    static constexpr bool PERM = false, AFTER_DRAIN = false;
    float* out; float* QF; float* XR; float* GATE; bf16_t* QB; bf16_t* KB; bf16_t* VB16;
    __device__ __forceinline__ void operator()(const f32x4 (&acc)[2][2][4][2], const pg8::Unit& u, int wr, int wc, int fr, int fq) const {
        const int pn = u.pn; const int coff = wc * 32 + 4 * fq;
#pragma unroll
        for (int ai = 0; ai < 2; ++ai)
#pragma unroll
            for (int m = 0; m < 4; ++m) {
                const int row = u.pm * 256 + ai * 128 + wr * 64 + m * 16 + fr;
                const bool prompt = row < NTOK_P;
                float* rowp = nullptr; bf16_t* rowb = nullptr; float bsc = 1.0f;
                if (pn < 6) { rowb = QB + (size_t)row * DATT + pn * 256; bsc = ATT_SCALE * LOG2E; }
                else if (pn < 18) {
                    const int isv = pn >= 12; const int c0 = (pn - (isv ? 12 : 6)) * 256;
                    if (prompt) { rowp = out + (isv ? O_VP : O_KP) + (size_t)row * DATT + c0; rowb = (isv ? VB16 : KB) + (size_t)row * DATT + c0; }
                    else { const int rr = row - NTOK_P, b = rr >> 3, t = rr & 7; rowp = out + (isv ? O_VS : O_KS) + ((size_t)b * 2048 + 2040 + t) * DATT + c0; }
                } else if (pn < 20) rowp = XR + (size_t)row * DLRU + (pn - 18) * 256;
                else rowp = GATE + (size_t)row * DLRU + (pn - 20) * 256;
#pragma unroll
                for (int bj = 0; bj < 2; ++bj)
#pragma unroll
                    for (int n = 0; n < 2; ++n) {
                        const f32x4 v = acc[ai][bj][m][n];
                        if (rowp) *(f32x4*)(rowp + coff + bj * 128 + n * 16) = v;
                        if (rowb) { u32x2 w; w.x = pg8::cvt_pk_bf16(v[0] * bsc, v[1] * bsc); w.y = pg8::cvt_pk_bf16(v[2] * bsc, v[3] * bsc); *(u32x2*)(rowb + coff + bj * 128 + n * 16) = w; }
                    }
            }
    }
};
struct EpiOut {
    static constexpr bool PERM = false, AFTER_DRAIN = false;
    const float* xp; const float* xs; float* pre;
    __device__ __forceinline__ void operator()(const f32x4 (&acc)[2][2][4][2], const pg8::Unit& u, int wr, int wc, int fr, int fq) const {
        const int col0 = u.pn * 256 + wc * 32 + 4 * fq;
#pragma unroll
        for (int ai = 0; ai < 2; ++ai)
#pragma unroll
            for (int m = 0; m < 4; ++m) {
                const int row = u.pm * 256 + ai * 128 + wr * 64 + m * 16 + fr;
                const float* xr = (row < NTOK_P ? xp + (size_t)row * D : xs + (size_t)(row - NTOK_P) * D) + col0;
                float* pr = pre + (size_t)row * D + col0;
#pragma unroll
                for (int bj = 0; bj < 2; ++bj)
#pragma unroll
                    for (int n = 0; n < 2; ++n) { const f32x4 xv = *(const f32x4*)(xr + bj * 128 + n * 16); *(f32x4*)(pr + bj * 128 + n * 16) = xv * ALPHA + acc[ai][bj][m][n]; }
            }
    }
};
struct EpiPlain {
    static constexpr bool PERM = false, AFTER_DRAIN = false;
    float* C; int ldc;
    __device__ __forceinline__ void operator()(const f32x4 (&acc)[2][2][4][2], const pg8::Unit& u, int wr, int wc, int fr, int fq) const {
        const int col0 = u.pn * 256 + wc * 32 + 4 * fq;
#pragma unroll
        for (int ai = 0; ai < 2; ++ai)
#pragma unroll
            for (int m = 0; m < 4; ++m) {
                const int row = u.pm * 256 + ai * 128 + wr * 64 + m * 16 + fr;
                float* pr = C + (size_t)row * ldc + col0;
#pragma unroll
                for (int bj = 0; bj < 2; ++bj)
#pragma unroll
                    for (int n = 0; n < 2; ++n) *(f32x4*)(pr + bj * 128 + n * 16) = acc[ai][bj][m][n];
            }
    }
};

struct EpiBf16Plain {
    static constexpr bool PERM = false, AFTER_DRAIN = false;
    bf16_t* C; int ldc;
    __device__ __forceinline__ void operator()(const f32x4 (&acc)[2][2][4][2], const pg8::Unit& u, int wr, int wc, int fr, int fq) const {
        const int col0 = u.pn * 256 + wc * 32 + 4 * fq;
#pragma unroll
        for (int ai = 0; ai < 2; ++ai)
#pragma unroll
            for (int m = 0; m < 4; ++m) {
                const int row = u.pm * 256 + ai * 128 + wr * 64 + m * 16 + fr;
                bf16_t* pr = C + (size_t)row * ldc + col0;
#pragma unroll
                for (int bj = 0; bj < 2; ++bj)
#pragma unroll
                    for (int n = 0; n < 2; ++n) { const f32x4 v = acc[ai][bj][m][n]; u32x2 w; w.x = pg8::cvt_pk_bf16(v[0], v[1]); w.y = pg8::cvt_pk_bf16(v[2], v[3]); *(u32x2*)(pr + bj * 128 + n * 16) = w; }
            }
    }
};

template <int MODE>
__device__ __forceinline__ void sample_rows_gemm(const Params& P, const bf16_t* A, const bf16_t* Wt) {
    const int lane = threadIdx.x & 63, w = __builtin_amdgcn_readfirstlane(threadIdx.x >> 6);
    const int c = lane & 15, g = lane >> 4;
    const int ncol = D / (int)gridDim.x;
    const int n0 = blockIdx.x * ncol;
    const int t0 = NTOK_P + 32 * w;
    const bf16_t* wrow = Wt + (size_t)(n0 + (c < ncol ? c : ncol - 1)) * D + 8 * g;
    const bf16_t* x0 = A + (size_t)(t0 + c) * D + 8 * g; const bf16_t* x1 = x0 + (size_t)16 * D;
    f32x4 acc0 = {0.f, 0.f, 0.f, 0.f}, acc1 = {0.f, 0.f, 0.f, 0.f};
#pragma unroll 8
    for (int ks = 0; ks < D / 32; ++ks) {
        const bf16x8 wf = *(const bf16x8*)(wrow + 32 * ks), b0 = *(const bf16x8*)(x0 + 32 * ks), b1 = *(const bf16x8*)(x1 + 32 * ks);
        acc0 = __builtin_amdgcn_mfma_f32_16x16x32_bf16(wf, b0, acc0, 0, 0, 0); acc1 = __builtin_amdgcn_mfma_f32_16x16x32_bf16(wf, b1, acc1, 0, 0, 0);
    }
    if (4 * g < ncol) {
#pragma unroll
        for (int tt = 0; tt < 2; ++tt) {
            const int row = t0 + 16 * tt + c; const f32x4 a = tt ? acc1 : acc0; const int col = n0 + 4 * g;
            if (MODE == 0) { const f32x4 xv = *(const f32x4*)(P.x_sample + (size_t)(row - NTOK_P) * D + col); *(f32x4*)((float*)(P.ws + WS_PRE1) + (size_t)row * D + col) = xv * ALPHA + a; }
            else { u32x2 wv; wv.x = pg8::cvt_pk_bf16(a[0], a[1]); wv.y = pg8::cvt_pk_bf16(a[2], a[3]); *(u32x2*)((bf16_t*)(P.ws + WS_QP) + (size_t)row * D + col) = wv; }
        }
    }
}

constexpr int KVS = 288, VOFF = 73728;
template <int MODE>
__device__ __forceinline__ void attn_unit(const Params& P, int p, int b, int h, int r, int c, LAS unsigned char* lds) {
    const int tid = threadIdx.x, lane = tid & 63, w = __builtin_amdgcn_readfirstlane(tid >> 6);
    const int dil = 1 << (2 * p);
    const bf16_t* Qb = (const bf16_t*)(P.ws + WS_QB); const bf16_t* Kb = (const bf16_t*)(P.ws + WS_KB); const bf16_t* Vb = (const bf16_t*)(P.ws + WS_VB16);
    const size_t tok0 = (size_t)b * 2048;
    const int j0 = 128 * c - 128, rho0 = (c == 0) ? 128 : 0;
#pragma unroll
    for (int it = 0; it < 8; ++it) {
        const int rho = it * 32 + (tid >> 4), ch = tid & 15;
        if (rho >= rho0) {
            const size_t tok = tok0 + (size_t)((j0 + rho) * dil + r);
            const u32x4 kv = *(const u32x4*)(Kb + tok * DATT + h * HD + ch * 8);
            const u32x4 vv = *(const u32x4*)(Vb + tok * DATT + h * HD + ch * 8);
            *(LAS u32x4*)(lds + rho * KVS + ch * 16) = kv;
            *(LAS u32x4*)(lds + VOFF + rho * KVS + ch * 16) = vv;
        }
    }
    const int cq = lane & 15, g = lane >> 4;
    const int iq = 128 * c + 16 * w + cq;
    const size_t qtok = tok0 + (size_t)(iq * dil + r);
    bf16x8 qf[4];
#pragma unroll
    for (int ks = 0; ks < 4; ++ks) qf[ks] = *(const bf16x8*)(Qb + qtok * DATT + h * HD + 32 * ks + 8 * g);
    __syncthreads();
    const int ktmin = (8 - w - 8 * c) > 0 ? (8 - w - 8 * c) : 0;
    const float slope2 = exp2f(-8.0f * (float)(h + 1) / 12.0f) * LOG2E * (float)dil;
    f32x4 s[9]; float m = -INFINITY;
#pragma unroll
    for (int kt = 0; kt < 9; ++kt) {
        if (kt >= ktmin) {
            f32x4 acc = {0.f, 0.f, 0.f, 0.f};
#pragma unroll
            for (int ks = 0; ks < 4; ++ks) { const bf16x8 kf = *(const LAS bf16x8*)(lds + (16 * w + 16 * kt + cq) * KVS + (32 * ks + 8 * g) * 2); acc = __builtin_amdgcn_mfma_f32_16x16x32_bf16(kf, qf[ks], acc, 0, 0, 0); }
#pragma unroll
            for (int ii = 0; ii < 4; ++ii) { const int dist = cq + 128 - 16 * kt - 4 * g - ii; float v = acc[ii] - slope2 * (float)dist;
                if (kt == 0 && dist > 128) v = -INFINITY; if (kt == 8 && dist < 0) v = -INFINITY; acc[ii] = v; m = fmaxf(m, v); }
            s[kt] = acc;
        } else s[kt] = (f32x4){-INFINITY, -INFINITY, -INFINITY, -INFINITY};
    }
    m = fmaxf(m, __shfl_xor(m, 16)); m = fmaxf(m, __shfl_xor(m, 32));
    float l = 0.f;
#pragma unroll
    for (int kt = 0; kt < 9; ++kt)
#pragma unroll
        for (int ii = 0; ii < 4; ++ii) { const float pp = exp2f(s[kt][ii] - m); s[kt][ii] = pp; l += pp; }
    l += __shfl_xor(l, 16); l += __shfl_xor(l, 32);
    f32x4 o[8];
#pragma unroll
    for (int dt = 0; dt < 8; ++dt) o[dt] = (f32x4){0.f, 0.f, 0.f, 0.f};
#pragma unroll
    for (int kk = 0; kk < 5; ++kk) {
        const int T0 = 2 * kk, T1 = 2 * kk + 1;
        if (T1 >= ktmin || T0 == 8) {
            u32x4 pw; pw.x = pg8::cvt_pk_bf16(s[T0][0], s[T0][1]); pw.y = pg8::cvt_pk_bf16(s[T0][2], s[T0][3]);
            if (T1 <= 8) { pw.z = pg8::cvt_pk_bf16(s[T1 <= 8 ? T1 : 8][0], s[T1 <= 8 ? T1 : 8][1]); pw.w = pg8::cvt_pk_bf16(s[T1 <= 8 ? T1 : 8][2], s[T1 <= 8 ? T1 : 8][3]); } else { pw.z = 0u; pw.w = 0u; }
            const bf16x8 pf = __builtin_bit_cast(bf16x8, pw);
            const int rT0 = (T0 >= ktmin) ? T0 : 8, rT1 = (T1 <= 8 && T1 >= ktmin) ? T1 : 8;
            const int a0 = VOFF + (16 * w + 16 * rT0 + 4 * g + (cq >> 2)) * KVS + 8 * (cq & 3);
            const int a1 = VOFF + (16 * w + 16 * rT1 + 4 * g + (cq >> 2)) * KVS + 8 * (cq & 3);
#pragma unroll
            for (int dt = 0; dt < 8; ++dt) {
                const s16x4 v0 = __builtin_amdgcn_ds_read_tr16_b64_v4i16((LAS s16x4*)(lds + a0 + dt * 32));
                const s16x4 v1 = __builtin_amdgcn_ds_read_tr16_b64_v4i16((LAS s16x4*)(lds + a1 + dt * 32));
                const bf16x8 vf = {v0[0], v0[1], v0[2], v0[3], v1[0], v1[1], v1[2], v1[3]};
                o[dt] = __builtin_amdgcn_mfma_f32_16x16x32_bf16(vf, pf, o[dt], 0, 0, 0);
            }
        }
    }
    const float inv = 1.0f / l;
    if (MODE == 0) {
        bf16_t* po = (bf16_t*)(P.ws + WS_PO) + ((size_t)p * NTOK_P + qtok) * DATT + h * HD + 4 * g;
#pragma unroll
        for (int dt = 0; dt < 8; ++dt) { u32x2 wv; wv.x = pg8::cvt_pk_bf16(o[dt][0] * inv, o[dt][1] * inv); wv.y = pg8::cvt_pk_bf16(o[dt][2] * inv, o[dt][3] * inv); *(u32x2*)(po + 16 * dt) = wv; }
        if (g == 0) { ((float*)(P.ws + WS_PM))[((size_t)p * NTOK_P + qtok) * NH + h] = m; ((float*)(P.ws + WS_PL))[((size_t)p * NTOK_P + qtok) * NH + h] = l; }
    } else {
        const float* PM = (const float*)(P.ws + WS_PM); const float* PL = (const float*)(P.ws + WS_PL);
        const float m0 = PM[qtok * NH + h], l0 = PL[qtok * NH + h], m1 = PM[((size_t)NTOK_P + qtok) * NH + h], l1 = PL[((size_t)NTOK_P + qtok) * NH + h];
        const float M = fmaxf(m, fmaxf(m0, m1));
        const float w2 = exp2f(m - M), w0 = exp2f(m0 - M) * l0, w1 = exp2f(m1 - M) * l1;
        const float rden = 1.0f / (w2 * l + w0 + w1);
        const bf16_t* p0 = (const bf16_t*)(P.ws + WS_PO) + qtok * DATT + h * HD + 4 * g;
        const bf16_t* p1 = p0 + (size_t)NTOK_P * DATT;
        bf16_t* ar = (bf16_t*)(P.ws + WS_AR) + qtok * D + h * HD + 4 * g;
#pragma unroll
        for (int dt = 0; dt < 8; ++dt) {
            const u32x2 x0 = *(const u32x2*)(p0 + 16 * dt), x1 = *(const u32x2*)(p1 + 16 * dt);
            const float r0 = (w2 * o[dt][0] + w0 * bflo(x0.x) + w1 * bflo(x1.x)) * rden, r1 = (w2 * o[dt][1] + w0 * bfhi(x0.x) + w1 * bfhi(x1.x)) * rden;
            const float r2 = (w2 * o[dt][2] + w0 * bflo(x0.y) + w1 * bflo(x1.y)) * rden, r3 = (w2 * o[dt][3] + w0 * bfhi(x0.y) + w1 * bfhi(x1.y)) * rden;
            u32x2 wv; wv.x = pg8::cvt_pk_bf16(r0, r1); wv.y = pg8::cvt_pk_bf16(r2, r3); *(u32x2*)(ar + 16 * dt) = wv;
        }
    }
    __syncthreads();
}

__device__ __forceinline__ void samp_unit(const Params& P, int b, int h, int k, LAS unsigned char* lds) {
    const int tid = threadIdx.x, lane = tid & 63, w = __builtin_amdgcn_readfirstlane(tid >> 6);
    const int cq = lane & 15, g = lane >> 4;
    if (k < 8) {
#pragma unroll 4
        for (int it = 0; it < 16; ++it) {
            const int rho = it * 16 + (tid >> 5), ch4 = tid & 31, c = 256 * k + rho;
            const size_t so = ((size_t)(b * 2048 + c)) * DATT + h * HD + ch4 * 4;
            const float4 kf = *(const float4*)(P.cache_k + so), vf = *(const float4*)(P.cache_v + so);
            if (c >= 8) { const size_t od = ((size_t)(b * 2048 + c - 8)) * DATT + h * HD + ch4 * 4; *(float4*)(P.out + O_KS + od) = kf; *(float4*)(P.out + O_VS + od) = vf; }
            u32x2 kw, vw; kw.x = pg8::cvt_pk_bf16(kf.x, kf.y); kw.y = pg8::cvt_pk_bf16(kf.z, kf.w); vw.x = pg8::cvt_pk_bf16(vf.x, vf.y); vw.y = pg8::cvt_pk_bf16(vf.z, vf.w);
            *(LAS u32x2*)(lds + rho * KVS + ch4 * 8) = kw; *(LAS u32x2*)(lds + VOFF + rho * KVS + ch4 * 8) = vw;
        }
    } else {
        const int rho = tid >> 5, ch4 = tid & 31;
        u32x2 kw = {0u, 0u}, vw = {0u, 0u};
        if (rho < 8) { const size_t so = ((size_t)(b * 2048 + 2040 + rho)) * DATT + h * HD + ch4 * 4; const float4 kf = *(const float4*)(P.out + O_KS + so), vf = *(const float4*)(P.out + O_VS + so);
            kw.x = pg8::cvt_pk_bf16(kf.x, kf.y); kw.y = pg8::cvt_pk_bf16(kf.z, kf.w); vw.x = pg8::cvt_pk_bf16(vf.x, vf.y); vw.y = pg8::cvt_pk_bf16(vf.z, vf.w); }
        *(LAS u32x2*)(lds + rho * KVS + ch4 * 8) = kw; *(LAS u32x2*)(lds + VOFF + rho * KVS + ch4 * 8) = vw;
        *(LAS u32x2*)(lds + (16 + rho) * KVS + ch4 * 8) = (u32x2){0u, 0u}; *(LAS u32x2*)(lds + VOFF + (16 + rho) * KVS + ch4 * 8) = (u32x2){0u, 0u};
    }
    const int t = cq & 7;
    const bf16_t* Qb = (const bf16_t*)(P.ws + WS_QB) + ((size_t)(NTOK_P + b * 8 + t)) * DATT + h * HD;
    bf16x8 qf[4];
#pragma unroll
    for (int ks = 0; ks < 4; ++ks) qf[ks] = *(const bf16x8*)(Qb + 32 * ks + 8 * g);
    __syncthreads();
    const float slope2 = exp2f(-8.0f * (float)(h + 1) / 12.0f) * LOG2E;
    const bool active = (k < 8) || (w == 0);
    f32x4 s[2]; float m = -INFINITY;
#pragma unroll
    for (int j = 0; j < 2; ++j) {
        f32x4 acc = {0.f, 0.f, 0.f, 0.f};
        if (active) {
#pragma unroll
            for (int ks = 0; ks < 4; ++ks) { const bf16x8 kf = *(const LAS bf16x8*)(lds + (32 * w + 16 * j + cq) * KVS + (32 * ks + 8 * g) * 2); acc = __builtin_amdgcn_mfma_f32_16x16x32_bf16(kf, qf[ks], acc, 0, 0, 0); }
        }
#pragma unroll
        for (int ii = 0; ii < 4; ++ii) {
            const int c = 256 * k + 32 * w + 16 * j + 4 * g + ii, dist = 2048 + t - c;
            int mult = (dist <= 128 ? 1 : 0) + (((dist & 3) == 0 && dist <= 512) ? 1 : 0) + (((dist & 15) == 0 && dist <= 2048) ? 1 : 0);
            if (dist < 0 || !active || c > 2055) mult = 0;
            const float v = mult ? acc[ii] - slope2 * (float)dist : -INFINITY;
            acc[ii] = v; m = fmaxf(m, v);
            s[j][ii] = (float)mult;
            s[j][ii] = v;
        }
    }
    m = fmaxf(m, __shfl_xor(m, 16)); m = fmaxf(m, __shfl_xor(m, 32));
    const float mref = (m == -INFINITY) ? 0.f : m;
    float l = 0.f;
#pragma unroll
    for (int j = 0; j < 2; ++j)
#pragma unroll
        for (int ii = 0; ii < 4; ++ii) {
            const int c = 256 * k + 32 * w + 16 * j + 4 * g + ii, dist = 2048 + t - c;
            const int mult = (dist <= 128 ? 1 : 0) + (((dist & 3) == 0 && dist <= 512) ? 1 : 0) + (((dist & 15) == 0 && dist <= 2048) ? 1 : 0);
            const float pp = (float)mult * exp2f(s[j][ii] - mref); s[j][ii] = pp; l += pp; }
    l += __shfl_xor(l, 16); l += __shfl_xor(l, 32);
    f32x4 o[8];
    {
        u32x4 pw; pw.x = pg8::cvt_pk_bf16(s[0][0], s[0][1]); pw.y = pg8::cvt_pk_bf16(s[0][2], s[0][3]); pw.z = pg8::cvt_pk_bf16(s[1][0], s[1][1]); pw.w = pg8::cvt_pk_bf16(s[1][2], s[1][3]);
        const bf16x8 pf = __builtin_bit_cast(bf16x8, pw);
        const int rw = active ? w : 0;
        const int a0 = VOFF + (32 * rw + 4 * g + (cq >> 2)) * KVS + 8 * (cq & 3), a1 = a0 + 16 * KVS;
#pragma unroll
        for (int dt = 0; dt < 8; ++dt) {
            const s16x4 v0 = __builtin_amdgcn_ds_read_tr16_b64_v4i16((LAS s16x4*)(lds + a0 + dt * 32));
            const s16x4 v1 = __builtin_amdgcn_ds_read_tr16_b64_v4i16((LAS s16x4*)(lds + a1 + dt * 32));
            const bf16x8 vf = {v0[0], v0[1], v0[2], v0[3], v1[0], v1[1], v1[2], v1[3]};
            o[dt] = __builtin_amdgcn_mfma_f32_16x16x32_bf16(vf, pf, (f32x4){0.f, 0.f, 0.f, 0.f}, 0, 0, 0);
        }
    }
    __syncthreads();
    LAS float* OL = (LAS float*)lds;
    LAS float* ML = (LAS float*)(lds + 32768);
    if (cq < 8) {
#pragma unroll
        for (int dt = 0; dt < 8; ++dt) *(LAS f32x4*)(OL + (w * 8 + cq) * 128 + 16 * dt + 4 * g) = o[dt];
        if (g == 0) { ML[(w * 8 + cq) * 2 + 0] = m; ML[(w * 8 + cq) * 2 + 1] = l; }
    }
    __syncthreads();
    {
        const int q = w; float M = -INFINITY;
#pragma unroll
        for (int ww = 0; ww < 8; ++ww) M = fmaxf(M, ML[(ww * 8 + q) * 2]);
        const float Mr = (M == -INFINITY) ? 0.f : M;
        float L = 0.f, o0 = 0.f, o1 = 0.f;
#pragma unroll
        for (int ww = 0; ww < 8; ++ww) { const float f = exp2f(ML[(ww * 8 + q) * 2] - Mr); L += f * ML[(ww * 8 + q) * 2 + 1];
            o0 += f * OL[(ww * 8 + q) * 128 + 2 * lane]; o1 += f * OL[(ww * 8 + q) * 128 + 2 * lane + 1]; }
        float* ps = (float*)(P.ws + WS_PS) + ((((size_t)(b * NH + h)) * 9 + k) * 8 + q) * 130;
        if (lane == 0) { ps[0] = M; ps[1] = L; }
        *(float2*)(ps + 2 + 2 * lane) = make_float2(o0, o1);
    }
    __syncthreads();
}
__device__ __forceinline__ void samp_merge_unit(const Params& P, int b, int t, int h, int lane) {
    const float* ps = (const float*)(P.ws + WS_PS) + ((size_t)(b * NH + h)) * 9 * 8 * 130 + (size_t)t * 130;
    float M = -INFINITY;
#pragma unroll
    for (int k = 0; k < 9; ++k) M = fmaxf(M, ps[(size_t)k * 8 * 130]);
    float L = 0.f, o0 = 0.f, o1 = 0.f;
#pragma unroll
    for (int k = 0; k < 9; ++k) { const float* pk = ps + (size_t)k * 8 * 130; const float f = exp2f(pk[0] - M); L += f * pk[1]; const float2 ov = *(const float2*)(pk + 2 + 2 * lane); o0 += f * ov.x; o1 += f * ov.y; }
    const float inv = 1.0f / L;
    bf16_t* ar = (bf16_t*)(P.ws + WS_AR) + ((size_t)(NTOK_P + b * 8 + t)) * D + h * HD;
    *(unsigned*)(ar + 2 * lane) = pack2(o0 * inv, o1 * inv);
}

__device__ __forceinline__ void lru_unit(const Params& P, bool samp, int b, int n, int k, int lane) {
    const int T = samp ? 8 : 64; const int row0 = samp ? NTOK_P + b * 8 : b * 2048 + k * 64; const int ch = n * 64 + lane;
    float wa[64], wx[64];
#pragma unroll
    for (int c = 0; c < 64; ++c) { wa[c] = P.lru_w_a[(n * 64 + c) * 64 + lane]; wx[c] = P.lru_w_x[(n * 64 + c) * 64 + lane]; }
    const float ba = P.lru_b_a[ch], bx = P.lru_b_x[ch], lam = P.lru_lambda[ch];
    const float sp = log1pf(expf(-lam));
    const float cw0 = P.conv_w[ch], cw1 = P.conv_w[512 + ch], cw2 = P.conv_w[1024 + ch], cw3 = P.conv_w[1536 + ch], cb = P.conv_b[ch];
    const float* XR = (const float*)(P.ws + WS_XR); const float* GT = (const float*)(P.ws + WS_GATE);
    float* R0 = (float*)(P.ws + WS_R0); float* R1 = (float*)(P.ws + WS_R1); bf16_t* AR = (bf16_t*)(P.ws + WS_AR);
    float x0 = 0.f, x1 = 0.f, x2 = 0.f, h = 0.f, A = 1.f;
    if (samp) { x0 = P.state_conv[(b * 3 + 0) * 512 + ch]; x1 = P.state_conv[(b * 3 + 1) * 512 + ch]; x2 = P.state_conv[(b * 3 + 2) * 512 + ch]; h = P.state_h[b * 512 + ch]; }
    else if (k > 0) { x0 = XR[(size_t)(row0 - 3) * DLRU + ch]; x1 = XR[(size_t)(row0 - 2) * DLRU + ch]; x2 = XR[(size_t)(row0 - 1) * DLRU + ch]; }
    for (int t0 = 0; t0 < T; t0 += 8) {
        float xin[8], gt[8];
#pragma unroll
        for (int i = 0; i < 8; ++i) { xin[i] = XR[(size_t)(row0 + t0 + i) * DLRU + ch]; gt[i] = GT[(size_t)(row0 + t0 + i) * DLRU + ch]; }
#pragma unroll
        for (int i = 0; i < 8; ++i) {
            const float xc = ((x0 * cw0 + x1 * cw1) + x2 * cw2) + xin[i] * cw3 + cb;
            x0 = x1; x1 = x2; x2 = xin[i];
            float ra = 0.f, ri = 0.f;
#pragma unroll
            for (int c = 0; c < 64; ++c) { const float xcc = readlane_f(xc, c); ra += xcc * wa[c]; ri += xcc * wx[c]; if ((c & 15) == 15) __builtin_amdgcn_sched_barrier(0); }
            const float rr = sigmoidf(ra + ba), ig = sigmoidf(ri + bx);
            const float log_a = -8.0f * rr * sp; const float a = expf(log_a);
            const float u = sqrtf(-expm1f(2.0f * log_a)) * (ig * xc);
            h = a * h + u; A = a * A;
            const float ge = gelu_exact(gt[i]);
            if (samp) AR[(size_t)(row0 + t0 + i) * D + DATT + ch] = (bf16_t)f2bf(h * ge);
            else { R0[(size_t)(row0 + t0 + i) * DLRU + ch] = h * ge; R1[(size_t)(row0 + t0 + i) * DLRU + ch] = A * ge; }
        }
    }
    if (samp) { P.out[O_HS + (size_t)b * 512 + ch] = h; float* co = P.out + O_CS + (size_t)b * 3 * 512 + ch; co[0] = x0; co[512] = x1; co[1024] = x2; }
    else {
        ((float*)(P.ws + WS_HE))[((size_t)(b * 32 + k)) * 512 + ch] = h; ((float*)(P.ws + WS_AE))[((size_t)(b * 32 + k)) * 512 + ch] = A;
        if (k == 31) { float* co = P.out + O_CP + (size_t)b * 3 * 512 + ch; co[0] = x0; co[512] = x1; co[1024] = x2; }
    }
}

__device__ __forceinline__ void phase_lru(const Params& P) {
    const int lane = threadIdx.x & 63, wave = __builtin_amdgcn_readfirstlane(threadIdx.x >> 6);
    const int gw = blockIdx.x * 8 + wave, nw = gridDim.x * 8;
#pragma unroll 1
    for (int pass = 0; pass < 2; ++pass) {
        if ((pass ^ (wave & 1)) == 0) {
            for (int u = gw; u < 2048 + 256; u += nw) { const bool samp = u >= 2048; const int v = samp ? u - 2048 : u; lru_unit(P, samp, samp ? (v >> 3) : (v >> 8), samp ? (v & 7) : ((v >> 5) & 7), v & 31, lane); }
        } else quant_tables(P);
    }
}
__device__ __forceinline__ void phase_samp(const Params& P, LAS unsigned char* lds) {
    for (int u = blockIdx.x; u < 384 * 9; u += gridDim.x) { const int k = u % 9, bh = u / 9; samp_unit(P, bh / NH, bh % NH, k, lds); }
}
__device__ __forceinline__ void phase_attn01(const Params& P, LAS unsigned char* lds) {
    for (int u = blockIdx.x; u < 3072; u += gridDim.x) {
        const int p = u / 1536, rem = u - p * 1536, bh = rem >> 4, rc = rem & 15;
        const int b = bh / NH, h = bh - b * NH;
        const int r = p == 0 ? 0 : (rc >> 2), c = p == 0 ? rc : (rc & 3);
        attn_unit<0>(P, p, b, h, r, c, lds);
    }
}
__device__ __forceinline__ void phase_mix_b(const Params& P, LAS unsigned char* lds) {
    {
        const int gt = blockIdx.x * NTHREADS + threadIdx.x;
        for (int i = gt; i < 8 * 32 * 512; i += gridDim.x * NTHREADS) {
            const int ch = i & 511, k = (i >> 9) & 31, b = i >> 14;
            const float* HE = (const float*)(P.ws + WS_HE) + (size_t)b * 32 * 512 + ch; const float* AE = (const float*)(P.ws + WS_AE) + (size_t)b * 32 * 512 + ch;
            float hin = 0.f;
            for (int kk = 0; kk < k; ++kk) hin = HE[kk * 512] + AE[kk * 512] * hin;
            const float* R0 = (const float*)(P.ws + WS_R0) + (size_t)(b * 2048 + k * 64) * DLRU + ch; const float* R1 = (const float*)(P.ws + WS_R1) + (size_t)(b * 2048 + k * 64) * DLRU + ch;
            bf16_t* ar = (bf16_t*)(P.ws + WS_AR) + (size_t)(b * 2048 + k * 64) * D + DATT + ch;
#pragma unroll 8
            for (int t = 0; t < 64; ++t) ar[(size_t)t * D] = (bf16_t)f2bf(R0[(size_t)t * DLRU] + R1[(size_t)t * DLRU] * hin);
            if (k == 31) P.out[O_HP + (size_t)b * 512 + ch] = HE[31 * 512] + AE[31 * 512] * hin;
        }
    }
    { const int lane = threadIdx.x & 63, gw = blockIdx.x * 8 + (threadIdx.x >> 6);
      for (int u = gw; u < NTOK_S * NH; u += gridDim.x * 8) { const int row = u / NH, h = u - row * NH; samp_merge_unit(P, row >> 3, row & 7, h, lane); } }
    for (int u = blockIdx.x; u < 1536; u += gridDim.x) {
        const int bh = u >> 4, r = u & 15; const int b = bh / NH, h = bh - b * NH;
        attn_unit<1>(P, 2, b, h, r, 0, lds);
    }
}

__device__ __forceinline__ void phase_ln1(const Params& P) {
    const int lane = threadIdx.x & 63, wave = threadIdx.x >> 6;
    const float* pre = (const float*)(P.ws + WS_PRE1); bf16_t* x1b = (bf16_t*)(P.ws + WS_X1B);
    for (int row = blockIdx.x * 8 + wave; row < NTOK; row += gridDim.x * 8) {
        float4 v[8]; float s = 0.f;
#pragma unroll
        for (int j = 0; j < 8; ++j) { v[j] = *(const float4*)(pre + (size_t)row * D + (j >> 2) * 1024 + lane * 16 + (j & 3) * 4); s += (v[j].x + v[j].y) + (v[j].z + v[j].w); }
        const float mean = wave_sum(s) * (1.0f / D); float q = 0.f;
#pragma unroll
        for (int j = 0; j < 8; ++j) { const float a = v[j].x - mean, b = v[j].y - mean, c = v[j].z - mean, d = v[j].w - mean; q += (a * a + b * b) + (c * c + d * d); }
        const float rstd = rsqrtf(wave_sum(q) * (1.0f / D) + LN_EPS);
        float am = 0.f;
#pragma unroll
        for (int j = 0; j < 8; ++j) { const int col = (j >> 2) * 1024 + lane * 16 + (j & 3) * 4; const float4 g = *(const float4*)(P.ln1_g + col), bb = *(const float4*)(P.ln1_b + col);
            float4 o; o.x = (v[j].x - mean) * rstd * g.x + bb.x; o.y = (v[j].y - mean) * rstd * g.y + bb.y; o.z = (v[j].z - mean) * rstd * g.z + bb.z; o.w = (v[j].w - mean) * rstd * g.w + bb.w;
            v[j] = o; am = fmaxf(am, fmaxf(fmaxf(fabsf(o.x), fabsf(o.y)), fmaxf(fabsf(o.z), fabsf(o.w))));
            uint2 w; w.x = pack2(o.x, o.y); w.y = pack2(o.z, o.w); *(uint2*)(x1b + (size_t)row * D + col) = w; }
        am = wave_max(am); if (am == 0.f) am = 1.f;
        const float inv = 127.0f / am;
        unsigned char* xq = P.ws + WS_X1Q + (size_t)row * D;
#pragma unroll
        for (int j = 0; j < 2; ++j) { u32x4 w;
#pragma unroll
            for (int i = 0; i < 4; ++i) { const float4 t = v[j * 4 + i];
                const int a = (int)rintf(t.x * inv), b = (int)rintf(t.y * inv), c = (int)rintf(t.z * inv), d = (int)rintf(t.w * inv);
                w[i] = (unsigned)(a & 255) | ((unsigned)(b & 255) << 8) | ((unsigned)(c & 255) << 16) | ((unsigned)(d & 255) << 24); }
            *(u32x4*)(xq + j * 1024 + lane * 16) = w; }
        if (lane == 0) ((float*)(P.ws + WS_SX))[row] = am * (1.0f / 127.0f);
    }
}

__device__ __forceinline__ int mono(float v) { const int b = __float_as_int(v); return b ^ ((b >> 31) & 0x7fffffff); }
__device__ __forceinline__ float unmono(int k) { return __int_as_float(k ^ ((k >> 31) & 0x7fffffff)); }
#define MK_INSERT16(L, X) do { int _x = (X); _Pragma("unroll") for (int _j = 0; _j < 16; ++_j) { const int _hi = max(L[_j], _x); _x = min(L[_j], _x); L[_j] = _hi; } } while (0)

template <int N> __device__ __forceinline__ void bitonic_sort_desc(int (&v)[N]) {
#pragma unroll
    for (int k = 2; k <= N; k <<= 1)
#pragma unroll
        for (int j = k >> 1; j > 0; j >>= 1)
#pragma unroll
            for (int i = 0; i < N; ++i) { const int l = i ^ j;
                if (l > i) { const int a = v[i], b = v[l]; if ((i & k) == 0) { v[i] = max(a, b); v[l] = min(a, b); } else { v[i] = min(a, b); v[l] = max(a, b); } } }
}
template <int N> __device__ __forceinline__ void bitonic_merge_desc(int (&v)[N]) {
#pragma unroll
    for (int j = N >> 1; j > 0; j >>= 1)
#pragma unroll
        for (int i = 0; i < N; ++i) { const int l = i ^ j; if (l > i) { const int a = v[i], b = v[l]; v[i] = max(a, b); v[l] = min(a, b); } }
}
__device__ __forceinline__ void xlane_merge16(int (&v)[16], int off) {
    int c[16];
#pragma unroll
    for (int i = 0; i < 16; ++i) c[i] = max(v[i], __shfl_xor(v[15 - i], off));
#pragma unroll
    for (int i = 0; i < 16; ++i) v[i] = c[i];
    bitonic_merge_desc<16>(v);
}
__device__ __forceinline__ int sel4(int g, int a, int b, int c, int d) { return g == 0 ? a : (g == 1 ? b : (g == 2 ? c : d)); }
__device__ __forceinline__ float sel4f(int g, float a, float b, float c, float d) { return g == 0 ? a : (g == 1 ? b : (g == 2 ? c : d)); }
__device__ __forceinline__ constexpr int cand_a(int role, int i) {
    return role == 0 ? 0 : role == 1 ? (i < 8 ? 1 : (i < 13 ? 2 : 4)) : role == 2 ? (i < 4 ? 3 : (i < 6 ? 5 : (i < 8 ? 6 : (i < 10 ? 7 : 8 + (i - 10))))) : (i < 2 ? 14 + i : -1);
}
__device__ __forceinline__ constexpr int cand_b(int role, int i) {
    return role == 0 ? i : role == 1 ? (i < 8 ? i : (i < 13 ? i - 8 : i - 13)) : role == 2 ? (i < 4 ? i : (i < 6 ? i - 4 : (i < 8 ? i - 6 : (i < 10 ? i - 8 : 0)))) : 0;
}

__device__ __forceinline__ void route_unit(const Params& P, int h, int tg, LAS unsigned char* lds, LAS int* lst) {
    const int lane = threadIdx.x & 63, w = __builtin_amdgcn_readfirstlane(threadIdx.x >> 6);
    const int cq = lane & 15, g = lane >> 4;
    const int tok = tg * 128 + w * 16 + cq;
    const bf16_t* qrow = (const bf16_t*)(P.ws + WS_QP) + (size_t)tok * D + h * 256;
    int L0[16], L1[16];
#pragma unroll
    for (int p = 0; p < 2; ++p) {
        bf16x8 qf[4];
#pragma unroll
        for (int ks = 0; ks < 4; ++ks) qf[ks] = *(const bf16x8*)(qrow + p * 128 + 32 * ks + 8 * g);
        int v0[16], v1[16];
#pragma unroll
        for (int kt = 0; kt < 8; ++kt) {
            f32x4 acc = {0.f, 0.f, 0.f, 0.f};
#pragma unroll
            for (int ks = 0; ks < 4; ++ks) { const bf16x8 kf = *(const LAS bf16x8*)(lds + (p * 128 + 16 * kt + cq) * KVS + (32 * ks + 8 * g) * 2); acc = __builtin_amdgcn_mfma_f32_16x16x32_bf16(kf, qf[ks], acc, 0, 0, 0); }
#pragma unroll
            for (int ii = 0; ii < 4; ++ii) { const int key = (mono(acc[ii]) & ~127) | (16 * kt + 4 * g + ii); if (kt < 4) v0[kt * 4 + ii] = key; else v1[(kt - 4) * 4 + ii] = key; }
        }
        bitonic_sort_desc<16>(v0); bitonic_sort_desc<16>(v1);
#pragma unroll
        for (int i = 0; i < 16; ++i) v0[i] = max(v0[i], v1[15 - i]);
        bitonic_merge_desc<16>(v0);
        xlane_merge16(v0, 16); xlane_merge16(v0, 32);
#pragma unroll
        for (int i = 0; i < 16; ++i) { if (p == 0) L0[i] = v0[i]; else L1[i] = v0[i]; }
    }
    if (g == 0) {
#pragma unroll
        for (int i = 0; i < 16; ++i) lst[(cq * 2 + 0) * 16 + i] = L0[i];
    }
    if (g == 1) {
#pragma unroll
        for (int i = 0; i < 16; ++i) lst[(cq * 2 + 1) * 16 + i] = L1[i];
    }
    float f0[16], f1[16];
#pragma unroll
    for (int i = 0; i < 16; ++i) { f0[i] = unmono(L0[i] & ~127); f1[i] = unmono(L1[i] & ~127); }
    int c[16];
#pragma unroll
    for (int i = 0; i < 16; ++i) {
        constexpr int NEG = (int)0x80000000;
        const float va = sel4f(g, f0[cand_a(0, i)], f0[cand_a(1, i)], f0[cand_a(2, i)], f0[cand_a(3, i) < 0 ? 0 : cand_a(3, i)]);
        const float vb = sel4f(g, f1[cand_b(0, i)], f1[cand_b(1, i)], f1[cand_b(2, i)], f1[cand_b(3, i)]);
        const int id = sel4(g, (cand_a(0, i) << 4) | cand_b(0, i), (cand_a(1, i) << 4) | cand_b(1, i), (cand_a(2, i) << 4) | cand_b(2, i), ((cand_a(3, i) < 0 ? 0 : cand_a(3, i)) << 4) | cand_b(3, i));
        int key = (mono(va + vb) & ~255) | id;
        if (cand_a(3, i) < 0) key = (g == 3) ? NEG : key;
        c[i] = key;
    }
    bitonic_sort_desc<16>(c);
    xlane_merge16(c, 16); xlane_merge16(c, 32);
    const float mx = unmono(c[0] & ~255);
    float e[16]; float sum = 0.f;
#pragma unroll
    for (int i = 0; i < 16; ++i) { e[i] = exp2f((unmono(c[i] & ~255) - mx) * LOG2E); sum += e[i]; }
    const float inv = 1.0f / sum;
    __builtin_amdgcn_wave_barrier();
    int ei[4]; float gi[4];
#pragma unroll
    for (int j = 0; j < 4; ++j) {
        const int key = sel4(g, c[j], c[4 + j], c[8 + j], c[12 + j]);
        gi[j] = sel4f(g, e[j], e[4 + j], e[8 + j], e[12 + j]) * inv;
        const int a = (key >> 4) & 15, b = key & 15;
        const int i0 = lst[(cq * 2 + 0) * 16 + a] & 127, i1 = lst[(cq * 2 + 1) * 16 + b] & 127;
        ei[j] = i0 * 128 + i1;
    }
    int* EIDX = (int*)(P.ws + WS_EIDX); float* GW = (float*)(P.ws + WS_GW);
    *(int4*)(EIDX + (size_t)tok * 128 + h * 16 + 4 * g) = make_int4(ei[0], ei[1], ei[2], ei[3]);
    *(float4*)(GW + (size_t)tok * 128 + h * 16 + 4 * g) = make_float4(gi[0], gi[1], gi[2], gi[3]);
    __builtin_amdgcn_wave_barrier();
}
__device__ __forceinline__ void phase_route(const Params& P, LAS unsigned char* lds) {
    const int tid = threadIdx.x, wave = __builtin_amdgcn_readfirstlane(tid >> 6);
    const int h = blockIdx.x & 7, slot = blockIdx.x >> 3, nslot = gridDim.x >> 3;
    const bf16_t* sk = (const bf16_t*)(P.ws + WS_SKB) + (size_t)h * 2 * 128 * 128;
#pragma unroll
    for (int it = 0; it < 8; ++it) { const int row = it * 32 + (tid >> 4), ch = tid & 15; *(LAS u32x4*)(lds + row * KVS + ch * 16) = *(const u32x4*)(sk + (size_t)row * 128 + ch * 8); }
    __syncthreads();
    LAS int* lst = (LAS int*)(lds + 73728) + wave * 512;
    for (int tg = slot; tg < NTOK / 128; tg += nslot) route_unit(P, h, tg, lds, lst);
}

__device__ __forceinline__ float ubf(unsigned x, int k) { return (float)((x >> (8 * k)) & 0xffu); }
constexpr int XSLOT = 1152, XGRP = 4 * XSLOT, XNG = 4, XWAVE = XNG * XGRP;
__device__ __forceinline__ void dma_group(__amdgpu_buffer_rsrc_t tab, int e_lo, int e_hi, int g, LAS unsigned char* sb, int lane) {
#pragma unroll
    for (int j = 0; j < 4; ++j) {
        const int k = g * 4 + j; const int e = __builtin_amdgcn_readlane(k < 64 ? e_lo : e_hi, k & 63);
        const int so = e * TROW;
        __builtin_amdgcn_raw_ptr_buffer_load_lds(tab, (LAS void*)(sb + j * XSLOT), 16, lane * 16, so, 0, 0);
        if (lane < 8) __builtin_amdgcn_raw_ptr_buffer_load_lds(tab, (LAS void*)(sb + j * XSLOT + 1024), 16, 1024 + lane * 16, so, 0, 0);
    }
}
__device__ __forceinline__ void u_consume(const LAS unsigned char* sb, const int (&xe)[4], const int (&xo)[4], const int (&X8)[2], float a_lo, float a_hi, float b_lo, float b_hi, int g, int lane, float& w_lo, float& w_hi) {
    int d[4];
#pragma unroll
    for (int j = 0; j < 4; ++j) {
        const u32x4 nb = *(const LAS u32x4*)(sb + j * XSLOT + lane * 16); const unsigned sc = *(const LAS unsigned short*)(sb + j * XSLOT + 1024 + lane * 2);
        int tot = 0;
#pragma unroll
        for (int jj = 0; jj < 2; ++jj) { int t = -X8[jj];
#pragma unroll
            for (int hh = 0; hh < 2; ++hh) { const unsigned wv = nb[jj * 2 + hh];
                t = __builtin_amdgcn_sdot4((int)(wv & 0x0F0F0F0Fu), xe[jj * 2 + hh], t, false); t = __builtin_amdgcn_sdot4((int)((wv >> 4) & 0x0F0F0F0Fu), xo[jj * 2 + hh], t, false); }
            tot += t * (int)((sc >> (8 * jj)) & 255u); }
        d[j] = tot;
    }
    const auto s02 = __builtin_amdgcn_permlane32_swap((unsigned)d[0], (unsigned)d[2], false, false);
    const auto s13 = __builtin_amdgcn_permlane32_swap((unsigned)d[1], (unsigned)d[3], false, false);
    const int r0 = (int)s02[0] + (int)s02[1], r1 = (int)s13[0] + (int)s13[1];
    const auto s01 = __builtin_amdgcn_permlane16_swap((unsigned)r0, (unsigned)r1, false, false);
    int r = (int)s01[0] + (int)s01[1];
    r += __builtin_amdgcn_update_dpp(0, r, 0x128, 0xf, 0xf, false);
    r += __builtin_amdgcn_update_dpp(0, r, 0x124, 0xf, 0xf, false);
    r += __builtin_amdgcn_update_dpp(0, r, 0x4E, 0xf, 0xf, false);
    r += __builtin_amdgcn_update_dpp(0, r, 0xB1, 0xf, 0xf, false);
    const int tot = __shfl(r, (lane & 3) * 16);
    const bool mine = ((lane >> 2) == (g & 15));
    const bool hi = g >= 16;
    const float wv = (hi ? b_hi : b_lo) * gelu_as((float)tot * (hi ? a_hi : a_lo));
    if (hi) w_hi = mine ? wv : w_hi; else w_lo = mine ? wv : w_lo;
}
__device__ __forceinline__ void v_consume(const LAS unsigned char* sb, f32x2 (&acc)[16], float (&bias)[2], float w_lo, float w_hi, int g, int lane) {
#pragma unroll
    for (int j = 0; j < 4; ++j) {
        const int k = g * 4 + j; const float w = readlane_f(k < 64 ? w_lo : w_hi, k & 63);
        const u32x4 nb = *(const LAS u32x4*)(sb + j * XSLOT + lane * 16); const unsigned sc = *(const LAS unsigned short*)(sb + j * XSLOT + 1024 + lane * 2);
#pragma unroll
        for (int jj = 0; jj < 2; ++jj) {
            const float c = w * (float)((sc >> (8 * jj)) & 255u); bias[jj] += c; const f32x2 c2 = {c, c};
#pragma unroll
            for (int hh = 0; hh < 2; ++hh) { const unsigned wv = nb[jj * 2 + hh]; unsigned ev = wv & 0x0F0F0F0Fu, od = (wv >> 4) & 0x0F0F0F0Fu;
                asm volatile("" : "+v"(ev), "+v"(od));
                const f32x2 n0 = {ubf(ev, 0), ubf(od, 0)}, n1 = {ubf(ev, 1), ubf(od, 1)};
                const f32x2 n2 = {ubf(ev, 2), ubf(od, 2)}, n3 = {ubf(ev, 3), ubf(od, 3)};
                f32x2* ac = &acc[jj * 8 + hh * 4];
                ac[0] = __builtin_elementwise_fma(n0, c2, ac[0]); ac[1] = __builtin_elementwise_fma(n1, c2, ac[1]); ac[2] = __builtin_elementwise_fma(n2, c2, ac[2]); ac[3] = __builtin_elementwise_fma(n3, c2, ac[3]);
            }
        }
    }
}
__device__ __forceinline__ void phase_experts(const Params& P, LAS unsigned char* lds) {
    const int lane = threadIdx.x & 63, wave = __builtin_amdgcn_readfirstlane(threadIdx.x >> 6);
    const bf16_t* x1b = (const bf16_t*)(P.ws + WS_X1B);
    const int* EIDX = (const int*)(P.ws + WS_EIDX); const float* GW = (const float*)(P.ws + WS_GW);
    const __amdgpu_buffer_rsrc_t UQ = __builtin_amdgcn_make_buffer_rsrc((void*)(P.ws + WS_UB), 0, NEXP * TROW, 0x00020000);
    const __amdgpu_buffer_rsrc_t VQ = __builtin_amdgcn_make_buffer_rsrc((void*)(P.ws + WS_VB), 0, NEXP * TROW, 0x00020000);
    const float* SU = (const float*)(P.ws + WS_SU); const float* SV = (const float*)(P.ws + WS_SV); const float* SX = (const float*)(P.ws + WS_SX);
    LAS unsigned char* wb = lds + wave * XWAVE;
    for (int row = blockIdx.x * 8 + wave; row < NTOK; row += gridDim.x * 8) {
        int ln = lane; asm volatile("" : "+v"(ln));
        int xe[4], xo[4], X8[2];
        {
            const u32x4 x0 = *(const u32x4*)(P.ws + WS_X1Q + (size_t)row * D + ln * 16), x1 = *(const u32x4*)(P.ws + WS_X1Q + (size_t)row * D + 1024 + ln * 16);
#pragma unroll
            for (int hh = 0; hh < 2; ++hh) {
                xe[hh] = (int)__builtin_amdgcn_perm(x0[2 * hh + 1], x0[2 * hh], 0x06040200u); xo[hh] = (int)__builtin_amdgcn_perm(x0[2 * hh + 1], x0[2 * hh], 0x07050301u);
                xe[2 + hh] = (int)__builtin_amdgcn_perm(x1[2 * hh + 1], x1[2 * hh], 0x06040200u); xo[2 + hh] = (int)__builtin_amdgcn_perm(x1[2 * hh + 1], x1[2 * hh], 0x07050301u);
            }
            int s0 = 0, s1 = 0;
#pragma unroll
            for (int i = 0; i < 4; ++i) { s0 = __builtin_amdgcn_sdot4((int)x0[i], 0x01010101, s0, false); s1 = __builtin_amdgcn_sdot4((int)x1[i], 0x01010101, s1, false); }
            X8[0] = 8 * s0; X8[1] = 8 * s1;
        }
        const float sx = SX[row];
        const int e_lo = EIDX[(size_t)row * 128 + ln], e_hi = EIDX[(size_t)row * 128 + 64 + ln];
        const float g_lo = GW[(size_t)row * 128 + ln], g_hi = GW[(size_t)row * 128 + 64 + ln];
        const float a_lo = SU[e_lo] * sx, a_hi = SU[e_hi] * sx, b_lo = g_lo * SV[e_lo], b_hi = g_hi * SV[e_hi];
        float w_lo = 0.f, w_hi = 0.f;
        asm volatile("s_waitcnt vmcnt(0)" ::: "memory");
        dma_group(UQ, e_lo, e_hi, 0, wb, lane); dma_group(UQ, e_lo, e_hi, 1, wb + XGRP, lane); dma_group(UQ, e_lo, e_hi, 2, wb + 2 * XGRP, lane);
        int sg = 0;
#pragma unroll 1
        for (int g = 0; g < 32; ++g) {
            const int sn = (sg + 3) & 3;
            if (g + 3 < 32) dma_group(UQ, e_lo, e_hi, g + 3, wb + sn * XGRP, lane); else dma_group(VQ, e_lo, e_hi, g + 3 - 32, wb + sn * XGRP, lane);
            asm volatile("s_waitcnt vmcnt(24)" ::: "memory");
            u_consume(wb + sg * XGRP, xe, xo, X8, a_lo, a_hi, b_lo, b_hi, g, lane, w_lo, w_hi);
            sg = (sg + 1) & 3;
        }
        f32x2 acc[16]; float bias[2] = {0.f, 0.f};
#pragma unroll
        for (int i = 0; i < 16; ++i) acc[i] = (f32x2){0.f, 0.f};
#pragma unroll 1
        for (int g = 0; g < 32; ++g) {
            const int sn = (sg + 3) & 3;
            dma_group(VQ, e_lo, e_hi, (g + 3) & 31, wb + sn * XGRP, lane);
            asm volatile("s_waitcnt vmcnt(24)" ::: "memory");
            v_consume(wb + sg * XGRP, acc, bias, w_lo, w_hi, g, lane);
            sg = (sg + 1) & 3;
        }
        asm volatile("s_waitcnt vmcnt(0)" ::: "memory");
        float s = 0.f;
#pragma unroll
        for (int jj = 0; jj < 2; ++jj) {
            const float b8 = 8.0f * bias[jj];
#pragma unroll
            for (int hh = 0; hh < 2; ++hh) {
                const u32x4 xa = *(const u32x4*)(x1b + (size_t)row * D + jj * 1024 + ln * 16 + hh * 8);
#pragma unroll
                for (int i = 0; i < 4; ++i) { f32x2 t = acc[jj * 8 + hh * 4 + i]; t[0] = t[0] - b8 + ALPHA * bflo(xa[i]); t[1] = t[1] - b8 + ALPHA * bfhi(xa[i]); acc[jj * 8 + hh * 4 + i] = t; s += t[0] + t[1]; }
            }
        }
        const float mean = wave_sum(s) * (1.0f / D); float q = 0.f;
#pragma unroll
        for (int i = 0; i < 16; ++i) { const float d0 = acc[i][0] - mean, d1 = acc[i][1] - mean; q += d0 * d0 + d1 * d1; }
        const float rstd = rsqrtf(wave_sum(q) * (1.0f / D) + LN_EPS);
        float* yo = P.out + (row < NTOK_P ? O_YP + (size_t)row * D : O_YS + (size_t)(row - NTOK_P) * D);
        const int lo16 = ln * 16;
#pragma unroll
        for (int jj = 0; jj < 2; ++jj)
#pragma unroll
            for (int i = 0; i < 4; ++i) {
                const int col = jj * 1024 + lo16 + i * 4;
                const float4 g0 = *(const float4*)(P.ln2_g + col), b0 = *(const float4*)(P.ln2_b + col);
                const f32x2 v0 = acc[jj * 8 + i * 2], v1 = acc[jj * 8 + i * 2 + 1];
                float4 o;
                o.x = (v0[0] - mean) * rstd * g0.x + b0.x; o.y = (v0[1] - mean) * rstd * g0.y + b0.y;
                o.z = (v1[0] - mean) * rstd * g0.z + b0.z; o.w = (v1[1] - mean) * rstd * g0.w + b0.w;
                *(float4*)(yo + col) = o;
            }
    }
}

constexpr int NPHASE = 11;
__global__ void __launch_bounds__(NTHREADS, 2) fwd(Params P) {
    extern __shared__ __attribute__((aligned(16))) unsigned char lds_raw[];
    LAS unsigned char* lds = (LAS unsigned char*)lds_raw;
    volatile LAS unsigned* misc = (volatile LAS unsigned*)(lds + MISC_OFF);
    const int lo = P.ph_lo, hi = P.ph_hi;
    XcdBarrier bar; bar.bar = (unsigned*)(P.ws + WS_CTL); bar.x = 0; bar.st = nullptr;
    if (hi - lo > 1) {
        if (threadIdx.x == 0) { misc[0] = 0u; misc[1] = 0u; misc[2] = 0u; misc[3] = 0u; }
        __syncthreads();
        bar = xcd_barrier_post((unsigned*)(P.ws + WS_CTL), misc);
    }
#ifndef MK_REPMASK
#define MK_REPMASK 0
#endif
#ifndef MK_PHASE_MASK
#define MK_PHASE_MASK 0x7ff
#endif
#define IN(k) (((MK_PHASE_MASK >> (k)) & 1) && lo <= (k) && (k) < hi)
#define SEAM(k) do { if (IN(k) && IN((k) + 1)) xcd_barrier(bar); } while (0)
    if (IN(0)) { phase_prologue(P, lds); }
    SEAM(0);
    if (IN(1)) {
        pg8::Gemm g{(const pg8::bf16_t*)(P.ws + WS_XB), (const pg8::bf16_t*)(P.ws + WS_WINT), NTOK, DIN, D};
        pg8::StaticOrder S; S.init(NTOK, DIN, (int)gridDim.x, (int)blockIdx.x);
        EpiProj E{P.out, (float*)(P.ws + WS_QF), (float*)(P.ws + WS_XR), (float*)(P.ws + WS_GATE), (bf16_t*)(P.ws + WS_QB), (bf16_t*)(P.ws + WS_KB), (bf16_t*)(P.ws + WS_VB16)};
        pg8::gemm_phase<EpiProj, pg8::StaticOrder, false>(lds, g, S, E, nullptr);
    }
    SEAM(1);
    if (IN(2)) { phase_lru(P); }
    if (IN(2) && IN(3)) __syncthreads();
    if (IN(3)) { phase_samp(P, lds); }
    if (IN(4)) { phase_attn01(P, lds); }
    SEAM(4);
    if (IN(5)) { phase_mix_b(P, lds); }
    SEAM(5);
    if (IN(6)) {
        sample_rows_gemm<0>(P, (const bf16_t*)(P.ws + WS_AR), (const bf16_t*)(P.ws + WS_WOT));
        pg8::Gemm g{(const pg8::bf16_t*)(P.ws + WS_AR), (const pg8::bf16_t*)(P.ws + WS_WOT), NTOK_P, D, D};
        pg8::StaticOrder S; S.init(NTOK_P, D, (int)gridDim.x, (int)blockIdx.x);
        EpiOut E{P.x_prompt, P.x_sample, (float*)(P.ws + WS_PRE1)};
        pg8::gemm_phase<EpiOut, pg8::StaticOrder, false>(lds, g, S, E, nullptr);
    }
    SEAM(6);
    if (IN(7)) { phase_ln1(P); }
    SEAM(7);
    if (IN(8)) {
        sample_rows_gemm<1>(P, (const bf16_t*)(P.ws + WS_X1B), (const bf16_t*)(P.ws + WS_WQT));
        pg8::Gemm g{(const pg8::bf16_t*)(P.ws + WS_X1B), (const pg8::bf16_t*)(P.ws + WS_WQT), NTOK_P, D, D};
        pg8::StaticOrder S; S.init(NTOK_P, D, (int)gridDim.x, (int)blockIdx.x);
        EpiBf16Plain E{(bf16_t*)(P.ws + WS_QP), D};
        pg8::gemm_phase<EpiBf16Plain, pg8::StaticOrder, false>(lds, g, S, E, nullptr);
    }
    SEAM(8);
    if (IN(9)) { phase_route(P, lds); }
    SEAM(9);
    if (IN(10)) { phase_experts(P, lds); }
#undef IN
#undef SEAM
}
}

#ifndef MK_N_LAUNCHES
#define MK_N_LAUNCHES 1
#endif
extern "C" void kernel_launch(void* const* d_in, const int* in_sizes, int n_in, void* d_out, int out_size, void* d_ws, size_t ws_size, hipStream_t stream) {
    using namespace mk;
    static int grid = 0;
    if (grid == 0) {
        if (n_in != 23 || (size_t)out_size != O_END || ws_size < WS_END) { fprintf(stderr, "kernel_launch: unexpected shapes: n_in %d out %d ws %zu (need %zu)\n", n_in, out_size, ws_size, (size_t)WS_END); grid = -1; return; }
        int dev = 0, cus = 0, per_cu = 0;
        if (hipGetDevice(&dev) != hipSuccess || hipDeviceGetAttribute(&cus, hipDeviceAttributeMultiprocessorCount, dev) != hipSuccess) { grid = -1; return; }
        if (hipFuncSetAttribute((const void*)fwd, hipFuncAttributeMaxDynamicSharedMemorySize, LDS_BYTES) != hipSuccess) { fprintf(stderr, "kernel_launch: hipFuncSetAttribute failed\n"); grid = -1; return; }
        if (hipOccupancyMaxActiveBlocksPerMultiprocessor(&per_cu, (const void*)fwd, NTHREADS, LDS_BYTES) != hipSuccess || per_cu < 1) { fprintf(stderr, "kernel_launch: occupancy query says %d\n", per_cu); }
        (void)hipGetLastError();
        grid = cus;
    }
    if (grid < 0) return;
    (void)hipMemsetAsync((char*)d_ws + WS_CTL, 0, 65536, stream);
    Params p{};
    p.x_prompt = (const float*)d_in[0]; p.x_sample = (const float*)d_in[1]; p.cache_k = (const float*)d_in[2]; p.cache_v = (const float*)d_in[3];
    p.state_conv = (const float*)d_in[4]; p.state_h = (const float*)d_in[5]; p.w_in = (const float*)d_in[6]; p.conv_w = (const float*)d_in[7]; p.conv_b = (const float*)d_in[8];
    p.lru_w_a = (const float*)d_in[9]; p.lru_b_a = (const float*)d_in[10]; p.lru_w_x = (const float*)d_in[11]; p.lru_b_x = (const float*)d_in[12]; p.lru_lambda = (const float*)d_in[13];
    p.w_out = (const float*)d_in[14]; p.ln1_g = (const float*)d_in[15]; p.ln1_b = (const float*)d_in[16]; p.w_query = (const float*)d_in[17]; p.sub_keys = (const float*)d_in[18];
    p.peer_u = (const float*)d_in[19]; p.peer_v = (const float*)d_in[20]; p.ln2_g = (const float*)d_in[21]; p.ln2_b = (const float*)d_in[22];
    p.out = (float*)d_out; p.ws = (unsigned char*)d_ws;
#if MK_N_LAUNCHES == 1
    p.ph_lo = 0; p.ph_hi = NPHASE;
    hipLaunchKernelGGL(fwd, dim3(grid), dim3(NTHREADS), LDS_BYTES, stream, p);
#else
    for (int k = 0; k < NPHASE; ++k) { p.ph_lo = k; p.ph_hi = k + 1; hipLaunchKernelGGL(fwd, dim3(grid), dim3(NTHREADS), LDS_BYTES, stream, p);
#ifdef MK_EXTRA_PHASE
        if (k == MK_EXTRA_PHASE) hipLaunchKernelGGL(fwd, dim3(grid), dim3(NTHREADS), LDS_BYTES, stream, p);
#endif
    }
#endif
    const hipError_t le = hipPeekAtLastError();
    if (le != hipSuccess) fprintf(stderr, "kernel_launch: launch failed: %s\n", hipGetErrorName(le));
}
```

```cpp
#include <hip/hip_runtime.h>
#include <cstdio>
#include <cstdint>
namespace pg8 {
#define PG8_LAS __attribute__((address_space(3)))
typedef unsigned short bf16_t;
typedef short bf16x8 __attribute__((ext_vector_type(8)));
typedef float f32x4 __attribute__((ext_vector_type(4)));
typedef unsigned u32x4 __attribute__((ext_vector_type(4)));
constexpr int BM = 256, BK = 64, HALF = 128, HTB = HALF * BK * 2  , STAGE_BYTES = 8 * HTB, NXCD = 8, WGM = 8;

__host__ __device__ __forceinline__ int lds_byte(int r, int c) { const int st = (r >> 4) * 2 + (c >> 5), rr = r & 15, cc = c & 31, ob = rr * 64 + cc * 2; return st * 1024 + (ob ^ (((ob >> 9) & 1) << 5)); }
__host__ __device__ __forceinline__ void stage_rc(int b, int& R, int& C) { const int st = b / 1024, sb = b % 1024, swz = sb ^ (((sb >> 9) & 1) << 5); R = (st >> 1) * 16 + swz / 64; C = (st & 1) * 32 + (swz % 64) / 2; }
__host__ __device__ __forceinline__ int perm32(int rho) { const int n = rho >> 4, i = rho & 15; return 8 * (i >> 2) + 4 * n + (i & 3); }

struct Unit { int pm, pn; };
struct Gemm { const bf16_t* A; const bf16_t* Bt; int M, N, K; };

struct StaticOrder {
    int nM, nN, nwg, G, c;
    __host__ __device__ void init(int M, int N, int G_, int c_) { nM = M / BM; nN = N / BM; nwg = nM * nN; G = G_; c = c_; }
    __host__ __device__ bool next(int i, Unit& u) const {
        const long L = (long)i * G + c; if (L >= nwg) return false;
        int wgid = (int)L; { const int q = nwg / NXCD, r = nwg % NXCD, xcd = wgid % NXCD, off = wgid / NXCD; wgid = (xcd < r ? xcd * (q + 1) : r * (q + 1) + (xcd - r) * q) + off; }
        const int nig = WGM * nN, gid = wgid / nig, fm = gid * WGM, gsz = (nM - fm) < WGM ? (nM - fm) : WGM;
        u.pm = fm + ((wgid % nig) % gsz); u.pn = (wgid % nig) / gsz; return true;
    }
    __device__ __forceinline__ void a_ready(const Unit&) const {}
    __device__ __forceinline__ void done(const Unit&) const {}
};
struct CountedOrder : StaticOrder {
    const unsigned* ready; unsigned need; unsigned* tmo;
    __device__ __forceinline__ void a_ready(const Unit& u) const {
        if (threadIdx.x < 64) {
            const unsigned long long t0 = __builtin_amdgcn_s_memrealtime(); unsigned polls = 0;
            while ((unsigned)__builtin_amdgcn_readfirstlane(__hip_atomic_load(ready + 64 * u.pm, __ATOMIC_RELAXED, __HIP_MEMORY_SCOPE_AGENT)) < need) {
                if ((++polls & 255u) == 0u && __builtin_amdgcn_readfirstlane(__hip_atomic_load(tmo, __ATOMIC_RELAXED, __HIP_MEMORY_SCOPE_AGENT)) != 0u) break;
                if (__builtin_amdgcn_s_memrealtime() - t0 > 2000000ull) {
                    if (threadIdx.x == 0) { unsigned expect = 0u; __hip_atomic_compare_exchange_strong(tmo + 1, &expect, 0x600u | (unsigned)(u.pm & 0xff), __ATOMIC_RELAXED, __ATOMIC_RELAXED, __HIP_MEMORY_SCOPE_AGENT); __hip_atomic_store(tmo, 1u, __ATOMIC_RELAXED, __HIP_MEMORY_SCOPE_AGENT); }
                    break; }
                __builtin_amdgcn_s_sleep(2); }
            __builtin_amdgcn_fence(__ATOMIC_ACQUIRE, "agent");
            asm volatile("s_waitcnt vmcnt(0)" ::: "memory");
        }
#if !defined(BROKEN_HOOK_NO_BARRIER)
        asm volatile("" ::: "memory"); __builtin_amdgcn_s_barrier(); asm volatile("" ::: "memory");
#endif
    }
};

__device__ __forceinline__ unsigned cvt_pk_bf16(float lo, float hi) { unsigned r; asm volatile("v_cvt_pk_bf16_f32 %0, %1, %2" : "=v"(r) : "v"(lo), "v"(hi)); return r; }
typedef float f32x2 __attribute__((ext_vector_type(2)));
__device__ __forceinline__ f32x2 gelu_pk(f32x2 v) {
    const f32x2 av = __builtin_elementwise_abs(v), d = av * 0.2316418882f + 1.0f;
    f32x2 t; t.x = __builtin_amdgcn_rcpf(d.x); t.y = __builtin_amdgcn_rcpf(d.y);
    f32x2 q = t * 0.5307027145f + (-0.7265760135f); q = q * t + 0.7107068705f; q = q * t + (-0.142248368f); q = q * t + 0.127414796f; q = q * t;
    const f32x2 s = (v * v) * (-0.72134752044f);
    f32x2 e; e.x = __builtin_amdgcn_exp2f(s.x); e.y = __builtin_amdgcn_exp2f(s.y);
    const f32x2 m = v * (q * e), r = v - m;
    f32x2 o; o.x = v.x < 0.f ? m.x : r.x; o.y = v.y < 0.f ? m.y : r.y; return o;
}

struct EpiF32 {
    static constexpr bool PERM = false, AFTER_DRAIN = false;
    float* C; int ldc; const float* bias;
    __device__ __forceinline__ void operator()(const f32x4 (&acc)[2][2][4][2], const Unit& u, int wr, int wc, int fr, int fq) const {
        const int row0 = u.pm * BM + wr * 64 + fr, col0 = u.pn * BM + wc * 32 + 4 * fq;
        f32x4 bv[2][2];
#pragma unroll
        for (int bj = 0; bj < 2; ++bj)
#pragma unroll
            for (int n = 0; n < 2; ++n) bv[bj][n] = bias ? *(const f32x4*)(bias + col0 + bj * HALF + n * 16) : (f32x4){0.f, 0.f, 0.f, 0.f};
#pragma unroll
        for (int ai = 0; ai < 2; ++ai)
#pragma unroll
            for (int m = 0; m < 4; ++m) { float* rowp = C + (size_t)(row0 + ai * HALF + m * 16) * ldc + col0;
#pragma unroll
                for (int bj = 0; bj < 2; ++bj)
#pragma unroll
                    for (int n = 0; n < 2; ++n) *(f32x4*)(rowp + bj * HALF + n * 16) = acc[ai][bj][m][n] + bv[bj][n]; }
    }
};
template <int ACT  > struct EpiBf16 {
    static constexpr bool PERM = true, AFTER_DRAIN = false;
    bf16_t* O; int ldc; const float* bias; int split_cols; size_t split_stride;
    __device__ __forceinline__ void operator()(const f32x4 (&acc)[2][2][4][2], const Unit& u, int wr, int wc, int fr, int fq) const {
        const int row0 = u.pm * BM + wr * 64 + fr; int colt = u.pn * BM; bf16_t* base = O;
        if (split_cols) { const int t = colt / split_cols; base += (size_t)t * split_stride; colt -= t * split_cols; }
        const int col0 = colt + wc * 32 + 8 * fq, bcol0 = u.pn * BM + wc * 32 + 8 * fq;
        f32x4 bv[2][2];
#pragma unroll
        for (int bj = 0; bj < 2; ++bj)
#pragma unroll
            for (int n = 0; n < 2; ++n) bv[bj][n] = bias ? *(const f32x4*)(bias + bcol0 + bj * HALF + 4 * n) : (f32x4){0.f, 0.f, 0.f, 0.f};
#pragma unroll
        for (int ai = 0; ai < 2; ++ai)
#pragma unroll
            for (int m = 0; m < 4; ++m) { bf16_t* rowp = base + (size_t)(row0 + ai * HALF + m * 16) * ldc + col0;
#pragma unroll
                for (int bj = 0; bj < 2; ++bj) { f32x4 v0 = acc[ai][bj][m][0] + bv[bj][0], v1 = acc[ai][bj][m][1] + bv[bj][1];
                    if (ACT == 1) { f32x2 a = gelu_pk((f32x2){v0[0], v0[1]}), b = gelu_pk((f32x2){v0[2], v0[3]}), c = gelu_pk((f32x2){v1[0], v1[1]}), d = gelu_pk((f32x2){v1[2], v1[3]});
                        v0 = (f32x4){a.x, a.y, b.x, b.y}; v1 = (f32x4){c.x, c.y, d.x, d.y}; }
                    if (ACT == 2) {
#pragma unroll
                        for (int j = 0; j < 4; ++j) { v0[j] = 0.5f * v0[j] * (1.0f + erff(v0[j] * 0.70710678f)); v1[j] = 0.5f * v1[j] * (1.0f + erff(v1[j] * 0.70710678f)); } }
                    u32x4 w; w.x = cvt_pk_bf16(v0[0], v0[1]); w.y = cvt_pk_bf16(v0[2], v0[3]); w.z = cvt_pk_bf16(v1[0], v1[1]); w.w = cvt_pk_bf16(v1[2], v1[3]);
                    *(u32x4*)(rowp + bj * HALF) = w; } }
    }
};

struct PanelStats {
    unsigned* xbuf;
    unsigned* cnt;
    unsigned* tmo;
    int ntn; float eps;
    unsigned code;
    __device__ __forceinline__ bool run(const f32x4 (&v)[2][2][4][2], const Unit& u, int wr, int wc, int fr, int fq, PG8_LAS unsigned char* lds, int wid, int lane) const {
        typedef float f32x2v __attribute__((ext_vector_type(2)));
        PG8_LAS f32x2v* P = (PG8_LAS f32x2v*)lds;
        PG8_LAS f32x2v* S = (PG8_LAS f32x2v*)(lds + 8192);
        PG8_LAS unsigned* flag = (PG8_LAS unsigned*)(lds + 8192 + 2048);
#pragma unroll
        for (int ai = 0; ai < 2; ++ai)
#pragma unroll
            for (int m = 0; m < 4; ++m) {
                float s = 0.f;
#pragma unroll
                for (int bj = 0; bj < 2; ++bj)
#pragma unroll
                    for (int n = 0; n < 2; ++n) { const f32x4 x = v[ai][bj][m][n]; s += (x[0] + x[1]) + (x[2] + x[3]); }
                s += __shfl_xor(s, 16); s += __shfl_xor(s, 32);
                const float mw = s * (1.0f / 64.0f); float q = 0.f;
#pragma unroll
                for (int bj = 0; bj < 2; ++bj)
#pragma unroll
                    for (int n = 0; n < 2; ++n) { const f32x4 d = v[ai][bj][m][n] - mw; q += (d[0] * d[0] + d[1] * d[1]) + (d[2] * d[2] + d[3] * d[3]); }
                q += __shfl_xor(q, 16); q += __shfl_xor(q, 32);
                if (fq == 0) P[(ai * HALF + wr * 64 + m * 16 + fr) * 4 + wc] = (f32x2v){mw, q};
            }
        asm volatile("s_waitcnt lgkmcnt(0)" ::: "memory"); __builtin_amdgcn_s_barrier(); asm volatile("" ::: "memory");
#if defined(BROKEN_NO_WAIT)
        if (blockIdx.x >= 64) { const long long t0 = clock64(); while (clock64() - t0 < 60000) __builtin_amdgcn_s_sleep(8); }
#endif
        const int row = wid * 32 + (lane & 31);
        if (lane < 32) {
            const f32x2v a = P[row * 4 + 0], b = P[row * 4 + 1], c = P[row * 4 + 2], d = P[row * 4 + 3];
            const float mt = (a.x + b.x + c.x + d.x) * 0.25f;
            const float da = a.x - mt, db = b.x - mt, dc = c.x - mt, dd = d.x - mt;
            const float m2 = (a.y + b.y) + (c.y + d.y) + 64.0f * ((da * da + db * db) + (dc * dc + dd * dd));
            unsigned long long* slot = (unsigned long long*)xbuf + ((size_t)(u.pm * BM + row) * 4 + u.pn);
            __hip_atomic_store(slot, ((unsigned long long)__float_as_uint(m2) << 32) | __float_as_uint(mt), __ATOMIC_RELAXED, __HIP_MEMORY_SCOPE_AGENT);
        }
        asm volatile("s_waitcnt vmcnt(0)" ::: "memory");
        if (lane == 0) __hip_atomic_fetch_add(cnt + 64 * u.pm, 1u, __ATOMIC_RELAXED, __HIP_MEMORY_SCOPE_AGENT);
        if (wid == 0) {
            bool dead = false; const unsigned long long t0 = __builtin_amdgcn_s_memrealtime(); const unsigned want = 8u * (unsigned)ntn;
            for (;;) {
#if defined(BROKEN_NO_WAIT)
                break;
#endif
                if ((unsigned)__builtin_amdgcn_readfirstlane(__hip_atomic_load(cnt + 64 * u.pm, __ATOMIC_RELAXED, __HIP_MEMORY_SCOPE_AGENT)) >= want) break;
                if (__builtin_amdgcn_s_memrealtime() - t0 > 2000000ull) {
                    if (lane == 0) { unsigned expect = 0u; __hip_atomic_compare_exchange_strong(tmo + 1, &expect, code | (unsigned)(u.pm & 0xff), __ATOMIC_RELAXED, __ATOMIC_RELAXED, __HIP_MEMORY_SCOPE_AGENT);
                                     __hip_atomic_store(tmo, 1u, __ATOMIC_RELAXED, __HIP_MEMORY_SCOPE_AGENT); }
                    dead = true; break; }
                __builtin_amdgcn_s_sleep(2);
            }
            __builtin_amdgcn_fence(__ATOMIC_ACQUIRE, "agent");
            if (lane == 0) flag[0] = dead ? 1u : 0u;
        }
        asm volatile("s_waitcnt vmcnt(0) lgkmcnt(0)" ::: "memory"); __builtin_amdgcn_s_barrier(); asm volatile("" ::: "memory");
        const bool bad = flag[0] != 0u;
        if (lane < 32) {
            const unsigned long long* slot = (const unsigned long long*)xbuf + (size_t)(u.pm * BM + row) * 4; float mt[4], m2[4]; float ms = 0.f;
#pragma unroll
            for (int t = 0; t < 4; ++t) { if (t < ntn) { const unsigned long long w = __hip_atomic_load(slot + t, __ATOMIC_RELAXED, __HIP_MEMORY_SCOPE_AGENT); mt[t] = __uint_as_float((unsigned)w); m2[t] = __uint_as_float((unsigned)(w >> 32)); } else { mt[t] = 0.f; m2[t] = 0.f; } ms += mt[t]; }
            const float mean = ms / (float)ntn; float q = 0.f;
#pragma unroll
            for (int t = 0; t < 4; ++t) if (t < ntn) { const float dm = mt[t] - mean; q += m2[t] + 256.0f * dm * dm; }
            S[row] = (f32x2v){mean, 1.0f / sqrtf(q / (256.0f * (float)ntn) + eps)};
        }
        asm volatile("s_waitcnt lgkmcnt(0)" ::: "memory"); __builtin_amdgcn_s_barrier(); asm volatile("" ::: "memory");
        return bad;
    }
};
struct EpiLnRes {
    static constexpr bool PERM = false, AFTER_DRAIN = true;
    const float* base; float* out; int ldc; const float* bias; PanelStats st; unsigned poison;
    __device__ __forceinline__ void refuse(size_t i0, size_t stride, int M, int N) const { const float q = __builtin_nanf(""); for (size_t i = i0; i < (size_t)M * N; i += stride) out[(i / N) * ldc + i % N] = q;
        if (i0 == 0) { unsigned expect = 0u; __hip_atomic_compare_exchange_strong(st.tmo + 1, &expect, 0x7f0u, __ATOMIC_RELAXED, __ATOMIC_RELAXED, __HIP_MEMORY_SCOPE_AGENT); __hip_atomic_store(st.tmo, 1u, __ATOMIC_RELAXED, __HIP_MEMORY_SCOPE_AGENT); } }
    __device__ __forceinline__ void fused(f32x4 (&acc)[2][2][4][2], const Unit& u, int wr, int wc, int fr, int fq, PG8_LAS unsigned char* lds, int wid, int lane) const {
        typedef float f32x2v __attribute__((ext_vector_type(2)));
        const PG8_LAS f32x2v* S = (const PG8_LAS f32x2v*)(lds + 8192);
        const int col0 = u.pn * BM + wc * 32 + 4 * fq;
#pragma unroll
        for (int bj = 0; bj < 2; ++bj)
#pragma unroll
            for (int n = 0; n < 2; ++n) { const f32x4 bv = bias ? *(const f32x4*)(bias + col0 + bj * HALF + n * 16) : (f32x4){0.f, 0.f, 0.f, 0.f};
#pragma unroll
                for (int ai = 0; ai < 2; ++ai)
#pragma unroll
                    for (int m = 0; m < 4; ++m) acc[ai][bj][m][n] += bv; }
        const bool bad = st.run(acc, u, wr, wc, fr, fq, lds, wid, lane) || poison != 0u;
        const float qnan = __builtin_nanf("");
#pragma unroll
        for (int ai = 0; ai < 2; ++ai)
#pragma unroll
            for (int m = 0; m < 4; ++m) { const int r = ai * HALF + wr * 64 + m * 16 + fr; const f32x2v sr = S[r]; const size_t off = (size_t)(u.pm * BM + r) * ldc + col0;
#pragma unroll
                for (int bj = 0; bj < 2; ++bj)
#pragma unroll
                    for (int n = 0; n < 2; ++n) { const f32x4 bs = *(const f32x4*)(base + off + bj * HALF + n * 16); f32x4 o = bs + (acc[ai][bj][m][n] - sr.x) * sr.y;
                        if (bad) o = (f32x4){qnan, qnan, qnan, qnan}; *(f32x4*)(out + off + bj * HALF + n * 16) = o; }
                asm volatile("" ::: "memory"); }
    }
};
struct EpiLnResLn {
    static constexpr bool PERM = false, AFTER_DRAIN = true;
    const float* base; float* out; bf16_t* xn; int ldc; const float* bias; PanelStats st1, st2; unsigned poison;
    __device__ __forceinline__ void refuse(size_t i0, size_t stride, int M, int N) const { const float q = __builtin_nanf(""); for (size_t i = i0; i < (size_t)M * N; i += stride) { const size_t o = (i / N) * ldc + i % N; out[o] = q; xn[o] = (bf16_t)0x7fc0u; }
        if (i0 == 0) { unsigned expect = 0u; __hip_atomic_compare_exchange_strong(st1.tmo + 1, &expect, 0x7f0u, __ATOMIC_RELAXED, __ATOMIC_RELAXED, __HIP_MEMORY_SCOPE_AGENT); __hip_atomic_store(st1.tmo, 1u, __ATOMIC_RELAXED, __HIP_MEMORY_SCOPE_AGENT); } }
    __device__ __forceinline__ void fused(f32x4 (&acc)[2][2][4][2], const Unit& u, int wr, int wc, int fr, int fq, PG8_LAS unsigned char* lds, int wid, int lane) const {
        typedef float f32x2v __attribute__((ext_vector_type(2))); typedef unsigned u32x2v __attribute__((ext_vector_type(2)));
        const PG8_LAS f32x2v* S = (const PG8_LAS f32x2v*)(lds + 8192);
        const int col0 = u.pn * BM + wc * 32 + 4 * fq;
#pragma unroll
        for (int bj = 0; bj < 2; ++bj)
#pragma unroll
            for (int n = 0; n < 2; ++n) { const f32x4 bv = bias ? *(const f32x4*)(bias + col0 + bj * HALF + n * 16) : (f32x4){0.f, 0.f, 0.f, 0.f};
#pragma unroll
                for (int ai = 0; ai < 2; ++ai)
#pragma unroll
                    for (int m = 0; m < 4; ++m) acc[ai][bj][m][n] += bv; }
        bool bad = st1.run(acc, u, wr, wc, fr, fq, lds, wid, lane) || poison != 0u;
        const float qnan = __builtin_nanf("");
#pragma unroll
        for (int ai = 0; ai < 2; ++ai)
#pragma unroll
            for (int m = 0; m < 4; ++m) { const int r = ai * HALF + wr * 64 + m * 16 + fr; const f32x2v sr = S[r]; const size_t off = (size_t)(u.pm * BM + r) * ldc + col0;
#pragma unroll
                for (int bj = 0; bj < 2; ++bj)
#pragma unroll
                    for (int n = 0; n < 2; ++n) { const f32x4 bs = *(const f32x4*)(base + off + bj * HALF + n * 16); acc[ai][bj][m][n] = bs + (acc[ai][bj][m][n] - sr.x) * sr.y; }
                asm volatile("" : "+v"(acc[ai][0][m][0]), "+v"(acc[ai][0][m][1]), "+v"(acc[ai][1][m][0]), "+v"(acc[ai][1][m][1]));
                if (m & 1) asm volatile("" ::: "memory"); }
        const bool bad1 = bad;
        bad = st2.run(acc, u, wr, wc, fr, fq, lds, wid, lane) || bad;
#pragma unroll
        for (int ai = 0; ai < 2; ++ai)
#pragma unroll
            for (int m = 0; m < 4; ++m) { const int r = ai * HALF + wr * 64 + m * 16 + fr; const f32x2v sr = S[r]; const size_t off = (size_t)(u.pm * BM + r) * ldc + col0;
#pragma unroll
                for (int bj = 0; bj < 2; ++bj)
#pragma unroll
                    for (int n = 0; n < 2; ++n) { const f32x4 x1 = acc[ai][bj][m][n]; *(f32x4*)(out + off + bj * HALF + n * 16) = bad1 ? (f32x4){qnan, qnan, qnan, qnan} : x1;
                        const f32x4 o = (x1 - sr.x) * sr.y; u32x2v w; w.x = cvt_pk_bf16(o[0], o[1]); w.y = cvt_pk_bf16(o[2], o[3]);
                        if (bad) { w.x = 0x7fc07fc0u; w.y = 0x7fc07fc0u; } *(u32x2v*)(xn + off + bj * HALF + n * 16) = w; }
                asm volatile("" ::: "memory"); }
    }
};

template <class Epi, class Sched, bool STAMP = false>
__device__ __forceinline__ void gemm_phase(PG8_LAS unsigned char* lds, const Gemm g, const Sched& S, const Epi& E, unsigned long long* stamps) {
    const int tid = threadIdx.x, wid = __builtin_amdgcn_readfirstlane(tid >> 6), lane = tid & 63, wr = wid >> 2, wc = wid & 3, fr = lane & 15, fq = lane >> 4;
    const int K = g.K, nt = K / BK;
    int ts_lo = 0, ts_hi = 0, nts = 0; const unsigned long long rt_entry = STAMP ? (unsigned long long)wall_clock64() : 0ull;
#define PG8_STAMP() do { if (STAMP && wid == 0 && nts < 64) { const unsigned long long _c = (unsigned long long)clock64(); \
        ts_lo = (lane == nts) ? (int)(unsigned)_c : ts_lo; ts_hi = (lane == nts) ? (int)(unsigned)(_c >> 32) : ts_hi; ++nts; } } while (0)
    PG8_STAMP();
    unsigned voffA[2], voffB[2];
#pragma unroll
    for (int i = 0; i < 2; ++i) { int R, C; stage_rc(tid * 16 + i * 8192, R, C); const int Rb = Epi::PERM ? ((R & ~31) + perm32(R & 31)) : R;
        voffA[i] = (unsigned)(R * K + C) * 2u; voffB[i] = (unsigned)(Rb * K + C) * 2u; }
    const size_t kstep = (size_t)(BK * 2);
    const size_t hstep = (size_t)HALF * K * 2;
    const size_t tstep = 2 * hstep;
    const unsigned ldsw = (unsigned)wid * 1024u;
    const int aoff = lds_byte(wr * 64 + fr, fq * 8), boff = lds_byte(wc * 32 + fr, fq * 8);
#define PG8_SA(b, h) (((b) * 2 + (h)) * HTB)
#define PG8_SB(b, h) ((4 + (b) * 2 + (h)) * HTB)
#define PG8_STAGE(bufoff, gbase, voff) do { _Pragma("unroll") for (int _i = 0; _i < 2; ++_i) \
        __builtin_amdgcn_global_load_lds((const unsigned*)((const char*)(gbase) + (voff)[_i]), (PG8_LAS unsigned*)(lds + (bufoff) + ldsw + _i * 8192), 16, 0, 0); } while (0)
#define PG8_LDA(dst, b, h) do { _Pragma("unroll") for (int m = 0; m < 4; ++m) _Pragma("unroll") for (int k = 0; k < 2; ++k) dst[m][k] = *(const PG8_LAS bf16x8*)(lds + PG8_SA(b, h) + aoff + m * 2048 + k * 1024); } while (0)
#define PG8_LDB(dst, b, h) do { _Pragma("unroll") for (int n = 0; n < 2; ++n) _Pragma("unroll") for (int k = 0; k < 2; ++k) dst[n][k] = *(const PG8_LAS bf16x8*)(lds + PG8_SB(b, h) + boff + n * 2048 + k * 1024); } while (0)
#define PG8_MMA(ai, bj, At, Bt) do { __builtin_amdgcn_s_setprio(1); _Pragma("unroll") for (int m = 0; m < 4; ++m) _Pragma("unroll") for (int n = 0; n < 2; ++n) _Pragma("unroll") for (int k = 0; k < 2; ++k) \
        acc[ai][bj][m][n] = __builtin_amdgcn_mfma_f32_16x16x32_bf16(Bt[n][k], At[m][k], acc[ai][bj][m][n], 0, 0, 0); __builtin_amdgcn_s_setprio(0); } while (0)
#define PG8_WAIT_V(n) asm volatile("s_waitcnt vmcnt(" #n ")" ::: "memory")
#define PG8_WAIT_L(n) asm volatile("s_waitcnt lgkmcnt(" #n ")" ::: "memory")
#define PG8_BAR __builtin_amdgcn_s_barrier()
#define PG8_SCHED __builtin_amdgcn_sched_barrier(0)
    Unit cur, nxt; int ui = 0;
    if (!S.next(0, cur)) return;
    f32x4 acc[2][2][4][2];
#pragma unroll
    for (int a = 0; a < 2; ++a)
#pragma unroll
        for (int b = 0; b < 2; ++b)
#pragma unroll
            for (int m = 0; m < 4; ++m)
#pragma unroll
                for (int n = 0; n < 2; ++n) acc[a][b][m][n] = (f32x4){0.f, 0.f, 0.f, 0.f};
    bf16x8 At[4][2], B0[2][2], B1[2][2];
    const char* cA = (const char*)g.A + (size_t)cur.pm * tstep; const char* cB = (const char*)g.Bt + (size_t)cur.pn * tstep;
    S.a_ready(cur);
    PG8_STAGE(PG8_SB(0, 0), cB, voffB); PG8_STAGE(PG8_SA(0, 0), cA, voffA); PG8_STAGE(PG8_SB(0, 1), cB + hstep, voffB); PG8_STAGE(PG8_SA(0, 1), cA + hstep, voffA);
    if (wr == 1) PG8_BAR;
    PG8_WAIT_V(4); PG8_BAR;
    PG8_STAGE(PG8_SB(1, 0), cB + kstep, voffB); PG8_STAGE(PG8_SA(1, 0), cA + kstep, voffA); PG8_STAGE(PG8_SB(1, 1), cB + hstep + kstep, voffB);
    PG8_WAIT_V(6); PG8_BAR;
    PG8_STAMP();
    for (;;) {
        const bool has_next = S.next(ui + 1, nxt);
        const char* nA = has_next ? (const char*)g.A + (size_t)nxt.pm * tstep : cA; const char* nB = has_next ? (const char*)g.Bt + (size_t)nxt.pn * tstep : cB;
        for (int t = 0; t < nt; t += 2) {
            const bool last = (t == nt - 2);
            const char* a1 = cA + (size_t)(t + 1) * kstep;
            const char* a2 = last ? nA : cA + (size_t)(t + 2) * kstep; const char* b2 = last ? nB : cB + (size_t)(t + 2) * kstep;
            const char* a3 = a2 + kstep; const char* b3 = b2 + kstep;
            if (last && has_next) S.a_ready(nxt);
            PG8_LDB(B0, 0, 0); PG8_SCHED; PG8_LDA(At, 0, 0); PG8_STAGE(PG8_SA(1, 1), a1 + hstep, voffA);
            PG8_WAIT_L(8); PG8_BAR; PG8_WAIT_L(0); PG8_MMA(0, 0, At, B0); PG8_BAR; PG8_SCHED;
            PG8_LDB(B1, 0, 1); PG8_STAGE(PG8_SB(0, 0), b2, voffB);
            PG8_BAR; PG8_WAIT_L(0); PG8_MMA(0, 1, At, B1); PG8_BAR;
            PG8_LDA(At, 0, 1); PG8_STAGE(PG8_SA(0, 0), a2, voffA);
            PG8_BAR; PG8_WAIT_L(0); PG8_MMA(1, 0, At, B0); PG8_BAR; PG8_SCHED;
            PG8_STAGE(PG8_SB(0, 1), b2 + hstep, voffB);
            PG8_WAIT_V(6); PG8_BAR; PG8_MMA(1, 1, At, B1); PG8_BAR;
            PG8_LDB(B0, 1, 0); PG8_SCHED; PG8_LDA(At, 1, 0); PG8_STAGE(PG8_SA(0, 1), a2 + hstep, voffA);
            PG8_WAIT_L(8); PG8_BAR; PG8_WAIT_L(0); PG8_MMA(0, 0, At, B0); PG8_BAR; PG8_SCHED;
            PG8_LDB(B1, 1, 1); PG8_STAGE(PG8_SB(1, 0), b3, voffB);
            PG8_BAR; PG8_WAIT_L(0); PG8_MMA(0, 1, At, B1); PG8_BAR;
            PG8_LDA(At, 1, 1); PG8_STAGE(PG8_SA(1, 0), a3, voffA);
            PG8_BAR; PG8_WAIT_L(0); PG8_MMA(1, 0, At, B0); PG8_BAR; PG8_SCHED;
            PG8_STAGE(PG8_SB(1, 1), b3 + hstep, voffB);
            PG8_WAIT_V(6); PG8_BAR; PG8_MMA(1, 1, At, B1); PG8_BAR;
        }
        PG8_STAMP();
        if constexpr (!Epi::AFTER_DRAIN) { E(acc, cur, wr, wc, fr, fq); S.done(cur); }
        PG8_STAMP();
        if (!has_next) break;
#pragma unroll
        for (int a = 0; a < 2; ++a)
#pragma unroll
            for (int b = 0; b < 2; ++b)
#pragma unroll
                for (int m = 0; m < 4; ++m)
#pragma unroll
                    for (int n = 0; n < 2; ++n) acc[a][b][m][n] = (f32x4){0.f, 0.f, 0.f, 0.f};
        cur = nxt; cA = nA; cB = nB; ++ui;
    }
    PG8_WAIT_V(0);
    if (wr == 0) PG8_BAR;
    PG8_BAR;
    if constexpr (Epi::AFTER_DRAIN) { E.fused(acc, cur, wr, wc, fr, fq, lds, wid, lane); S.done(cur); }
    PG8_STAMP();
    if (STAMP && wid == 0) { stamps[lane] = lane < nts ? (((unsigned long long)(unsigned)ts_hi << 32) | (unsigned)ts_lo) : 0ull;
        if (lane == 62) stamps[62] = rt_entry; if (lane == 63) stamps[63] = (unsigned long long)wall_clock64(); }
#undef PG8_STAMP
#undef PG8_SA
#undef PG8_SB
#undef PG8_STAGE
#undef PG8_LDA
#undef PG8_LDB
#undef PG8_MMA
#undef PG8_WAIT_V
#undef PG8_WAIT_L
#undef PG8_BAR
#undef PG8_SCHED
}
}
#define XB_TMO      128
#define XB_XCNT(j)  (256  + 64 * (j))
#define XB_XSUB(j)  (1280 + 64 * (j))
#define XB_XGEN(j)  (2304 + 64 * (j))
#define XB_TOP      3328
#define XB_TOPGEN   3392
#define XCD_BAR_WORDS 3456
#define XB_SPIN_CAP (1u << 18)
#define LAS __attribute__((address_space(3)))

__device__ __forceinline__ unsigned xb_ld(unsigned* p)              { return __hip_atomic_load(p, __ATOMIC_RELAXED, __HIP_MEMORY_SCOPE_AGENT); }
__device__ __forceinline__ unsigned xb_add(unsigned* p, unsigned v) { return __hip_atomic_fetch_add(p, v, __ATOMIC_RELAXED, __HIP_MEMORY_SCOPE_AGENT); }
__device__ __forceinline__ unsigned xb_xcc_id() { return (unsigned)__builtin_amdgcn_s_getreg((3 << 11) | 20) & 0xFu; }
#define XB_SPIN(cond, bar) do { unsigned _sp = 0; while (cond) { __builtin_amdgcn_s_sleep(1); \
    if ((++_sp & 255u) == 0u) { if (xb_ld(&(bar)[XB_TMO])) break; if (_sp > XB_SPIN_CAP) { atomicAdd(&(bar)[XB_TMO], 1u); break; } } } } while (0)

struct XcdBarrier {
    unsigned* bar; unsigned x;
    volatile LAS unsigned* st;
};

__device__ __forceinline__ XcdBarrier xcd_barrier_post(unsigned* bar, volatile LAS unsigned* st) {
    XcdBarrier b; b.bar = bar; b.x = xb_xcc_id(); b.st = st;
    if (threadIdx.x == 0) (void)xb_add(&bar[XB_XCNT(b.x)], 1u);
    return b;
}
__device__ __forceinline__ void xcd_barrier_complete(unsigned* bar, unsigned x, unsigned& nloc, unsigned& nx) {
    const unsigned G = gridDim.x * gridDim.y * gridDim.z;
    unsigned sum, cnt, mine, sp = 0u;
    for (;;) {
        sum = 0u; cnt = 0u; mine = 0u;
#pragma unroll
        for (unsigned j = 0; j < 16; ++j) { const unsigned c = xb_ld(&bar[XB_XCNT(j)]); sum += c; cnt += (c > 0u) ? 1u : 0u; mine = (j == x) ? c : mine; }
        if (sum == G) break;
        __builtin_amdgcn_s_sleep(1);
        if ((++sp & 255u) == 0u) { if (xb_ld(&bar[XB_TMO])) break; if (sp > XB_SPIN_CAP) { atomicAdd(&bar[XB_TMO], 1u); break; } }
    }
    nloc = mine > 0u ? mine : 1u; nx = cnt > 0u ? cnt : 1u;
}

__device__ __forceinline__ void xcd_barrier(const XcdBarrier& b) {
    asm volatile("s_waitcnt vmcnt(0)" ::: "memory");
    __syncthreads();
    if (threadIdx.x == 0) {
        unsigned* bar = b.bar;
        __builtin_amdgcn_s_waitcnt(0);
        unsigned nloc = b.st[0], nx = b.st[1];
        if (nloc == 0u) { xcd_barrier_complete(bar, b.x, nloc, nx); b.st[0] = nloc; b.st[1] = nx; }
        const unsigned old = xb_add(&bar[XB_XSUB(b.x)], 1u);
        const unsigned gen = old / nloc;
        if (old + 1u == (gen + 1u) * nloc) {
            __builtin_amdgcn_fence(__ATOMIC_RELEASE, "agent");
            asm volatile("s_waitcnt vmcnt(0)" ::: "memory");
            const unsigned og = xb_add(&bar[XB_TOP], 1u);
            const unsigned tg = og / nx;
            if (og + 1u == (tg + 1u) * nx) xb_add(&bar[XB_TOPGEN], 1u);
            else XB_SPIN(xb_ld(&bar[XB_TOPGEN]) == tg, bar);
            __builtin_amdgcn_fence(__ATOMIC_ACQUIRE, "agent");
            xb_add(&bar[XB_XGEN(b.x)], 1u);
            asm volatile("s_waitcnt vmcnt(0)" ::: "memory");
        } else {
            XB_SPIN(xb_ld(&bar[XB_XGEN(b.x)]) == gen, bar);
            __builtin_amdgcn_fence(__ATOMIC_ACQUIRE, "agent");
            asm volatile("s_waitcnt vmcnt(0)" ::: "memory");
        }
    }
    __syncthreads();
}


namespace mk {
typedef unsigned short bf16_t;
typedef float f32x4 __attribute__((ext_vector_type(4)));
typedef short bf16x8 __attribute__((ext_vector_type(8)));
typedef short s16x4 __attribute__((ext_vector_type(4)));
typedef unsigned u32x4 __attribute__((ext_vector_type(4)));
typedef unsigned u32x2 __attribute__((ext_vector_type(2)));
typedef float f32x2 __attribute__((ext_vector_type(2)));
constexpr int D = 2048, NTOK_P = 16384, NTOK_S = 256, NTOK = 16640;
constexpr int DIN = 5632, DATT = 1536, DLRU = 512, NH = 12, HD = 128;
constexpr int NEXP = 16384;
constexpr float ALPHA = 1.189207115002721f;
constexpr float LN_EPS = 1e-5f;
constexpr float ATT_SCALE = 0.08838834764831845f;
constexpr float LOG2E = 1.4426950408889634f;
constexpr size_t O_YP = 0, O_YS = 33554432, O_KP = 34078720, O_VP = 59244544, O_CP = 84410368, O_HP = 84422656,
                 O_KS = 84426752, O_VS = 185090048, O_CS = 285753344, O_HS = 285802496, O_END = 285818880;
constexpr size_t WS_CTL = 0;
constexpr size_t WS_XB = 65536;
constexpr size_t WS_WINT = WS_XB + (size_t)NTOK * D * 2;
constexpr size_t WS_WOT = WS_WINT + (size_t)DIN * D * 2;
constexpr size_t WS_WQT = WS_WOT + (size_t)D * D * 2;
constexpr size_t WS_UB = WS_WQT + (size_t)D * D * 2;
constexpr size_t WS_VB = WS_UB + (size_t)NEXP * D * 2;
constexpr size_t WS_QF = WS_VB + (size_t)NEXP * D * 2;
constexpr size_t WS_XR = WS_QF + (size_t)NTOK * DATT * 4;
constexpr size_t WS_GATE = WS_XR + (size_t)NTOK * DLRU * 4;
constexpr size_t WS_AR = WS_GATE + (size_t)NTOK * DLRU * 4;
constexpr size_t WS_PRE1 = WS_AR + (size_t)NTOK * D * 2;
constexpr size_t WS_X1F = WS_PRE1 + (size_t)NTOK * D * 4;
constexpr size_t WS_X1B = WS_X1F + (size_t)NTOK * D * 4;
constexpr size_t WS_QP = WS_X1B + (size_t)NTOK * D * 2;
constexpr size_t WS_EIDX = WS_QP + (size_t)NTOK * D * 4;
constexpr size_t WS_GW = WS_EIDX + (size_t)NTOK * 128 * 4;
constexpr size_t WS_SU = WS_GW + (size_t)NTOK * 128 * 4;
constexpr size_t WS_SV = WS_SU + (size_t)NEXP * 4;
constexpr size_t WS_SX = WS_SV + (size_t)NEXP * 4;
constexpr size_t WS_X1Q = WS_SX + (size_t)NTOK * 4;
constexpr size_t WS_SKB = WS_X1Q + (size_t)NTOK * D;
constexpr size_t WS_QB = WS_SKB + (size_t)8 * 2 * 128 * 128 * 2;
constexpr size_t WS_KB = WS_QB + (size_t)NTOK * DATT * 2;
constexpr size_t WS_VB16 = WS_KB + (size_t)NTOK_P * DATT * 2;
constexpr size_t WS_PO = WS_VB16 + (size_t)NTOK_P * DATT * 2;
constexpr size_t WS_PM = WS_PO + (size_t)2 * NTOK_P * DATT * 2;
constexpr size_t WS_PL = WS_PM + (size_t)2 * NTOK_P * NH * 4;
constexpr size_t WS_R0 = WS_PL + (size_t)2 * NTOK_P * NH * 4;
constexpr size_t WS_R1 = WS_R0 + (size_t)NTOK_P * DLRU * 4;
constexpr size_t WS_HE = WS_R1 + (size_t)NTOK_P * DLRU * 4;
constexpr size_t WS_AE = WS_HE + (size_t)8 * 32 * 512 * 4;
constexpr size_t WS_PS = WS_AE + (size_t)8 * 32 * 512 * 4;
constexpr size_t WS_END = WS_PS + (size_t)32 * 12 * 9 * 8 * 130 * 4;

constexpr int NTHREADS = 512;
constexpr int LDS_BYTES = 148480;
constexpr int MISC_OFF = 147456;

struct Params {
    const float* x_prompt; const float* x_sample; const float* cache_k; const float* cache_v; const float* state_conv; const float* state_h;
    const float* w_in; const float* conv_w; const float* conv_b; const float* lru_w_a; const float* lru_b_a; const float* lru_w_x; const float* lru_b_x;
    const float* lru_lambda; const float* w_out; const float* ln1_g; const float* ln1_b; const float* w_query; const float* sub_keys;
    const float* peer_u; const float* peer_v; const float* ln2_g; const float* ln2_b;
    float* out; unsigned char* ws; int ph_lo, ph_hi;
};

__device__ __forceinline__ unsigned f2bf(float f) { unsigned u = __float_as_uint(f); u += 0x7fffu + ((u >> 16) & 1u); return u >> 16; }
__device__ __forceinline__ unsigned pack2(float a, float b) { return f2bf(a) | (f2bf(b) << 16); }
__device__ __forceinline__ float bflo(unsigned w) { return __uint_as_float(w << 16); }
__device__ __forceinline__ float bfhi(unsigned w) { return __uint_as_float(w & 0xffff0000u); }
__device__ __forceinline__ float wave_sum(float v) {
#pragma unroll
    for (int o = 32; o >= 1; o >>= 1) v += __shfl_xor(v, o);
    return v;
}
__device__ __forceinline__ float wave_max(float v) {
#pragma unroll
    for (int o = 32; o >= 1; o >>= 1) v = fmaxf(v, __shfl_xor(v, o));
    return v;
}
__device__ __forceinline__ float gelu_exact(float v) { return 0.5f * v * (1.0f + erff(v * 0.7071067811865476f)); }
__device__ __forceinline__ float gelu_as(float v) {
    const float av = fabsf(v), t = __builtin_amdgcn_rcpf(av * 0.2316418882f + 1.0f);
    float q = t * 0.5307027145f + (-0.7265760135f); q = q * t + 0.7107068705f; q = q * t + (-0.142248368f); q = q * t + 0.127414796f; q = q * t;
    const float e = __builtin_amdgcn_exp2f((v * v) * (-0.72134752044f));
    const float m = v * (q * e);
    return v < 0.f ? m : v - m;
}
__device__ __forceinline__ float sigmoidf(float v) { return 1.0f / (1.0f + expf(-v)); }
__device__ __forceinline__ float readlane_f(float v, int l) { return __int_as_float(__builtin_amdgcn_readlane(__float_as_int(v), l)); }

__device__ __forceinline__ void convert_flat(const float* src, bf16_t* dst, size_t n8, size_t gtid, size_t gstride) {
    for (size_t i = gtid; i < n8; i += gstride) {
        const float4 a = ((const float4*)src)[2 * i], b = ((const float4*)src)[2 * i + 1];
        uint4 w; w.x = pack2(a.x, a.y); w.y = pack2(a.z, a.w); w.z = pack2(b.x, b.y); w.w = pack2(b.z, b.w);
        ((uint4*)dst)[i] = w;
    }
}
__device__ __forceinline__ void transpose_convert(const float* src, bf16_t* dst, int K, int N, LAS float* tile) {
    const int tid = threadIdx.x, ntn = N / 64, ntiles = (K / 64) * ntn;
    for (int tl = blockIdx.x; tl < ntiles; tl += gridDim.x) {
        const int kt = tl / ntn, nt = tl - kt * ntn;
#pragma unroll
        for (int i = 0; i < 8; ++i) { const int r = (tid >> 6) + 8 * i, c = tid & 63; tile[r * 65 + c] = src[(size_t)(kt * 64 + r) * N + nt * 64 + c]; }
        __syncthreads();
#pragma unroll
        for (int i = 0; i < 4; ++i) { const int n = (tid >> 5) + 16 * i, k0 = 2 * (tid & 31);
            const unsigned v = pack2(tile[k0 * 65 + n], tile[(k0 + 1) * 65 + n]);
            *(unsigned*)(dst + (size_t)(nt * 64 + n) * K + kt * 64 + k0) = v; }
        __syncthreads();
    }
}
constexpr int TROW = 1152;
__device__ __forceinline__ void quant_tables(const Params& P) {
    const int lane = threadIdx.x & 63, gw = blockIdx.x * 8 + (threadIdx.x >> 6), nw = gridDim.x * 8;
    for (int it = gw; it < 2 * NEXP; it += nw) {
        const bool isv = it >= NEXP; const int row = isv ? it - NEXP : it;
        const float* src = (isv ? P.peer_v : P.peer_u) + (size_t)row * D;
        float4 v[8]; float cm[2];
#pragma unroll
        for (int j = 0; j < 2; ++j) { float am = 0.f;
#pragma unroll
            for (int i = 0; i < 4; ++i) { const float4 t = *(const float4*)(src + j * 1024 + lane * 16 + i * 4); v[j * 4 + i] = t; am = fmaxf(am, fmaxf(fmaxf(fabsf(t.x), fabsf(t.y)), fmaxf(fabsf(t.z), fabsf(t.w)))); }
            cm[j] = am; }
        float rm = wave_max(fmaxf(cm[0], cm[1])); if (rm == 0.f) rm = 1.f;
        unsigned char* dst = P.ws + (isv ? WS_VB : WS_UB) + (size_t)row * TROW;
        u32x4 w; unsigned sqp = 0u;
#pragma unroll
        for (int j = 0; j < 2; ++j) {
            int sq = (int)ceilf(cm[j] / rm * 255.0f); sq = sq < 1 ? 1 : (sq > 255 ? 255 : sq);
            sqp |= (unsigned)sq << (8 * j);
            const float inv = (255.0f * 7.0f) / (rm * (float)sq);
#pragma unroll
            for (int hh = 0; hh < 2; ++hh) { unsigned dw = 0u;
#pragma unroll
                for (int e = 0; e < 8; ++e) { const float4 t = v[j * 4 + hh * 2 + (e >> 2)]; const float x = (e & 3) == 0 ? t.x : ((e & 3) == 1 ? t.y : ((e & 3) == 2 ? t.z : t.w));
                    int n = (int)rintf(x * inv); n = n < -7 ? -7 : (n > 7 ? 7 : n); dw |= (unsigned)(isv ? n + 8 : (n & 15)) << (4 * e); }
                w[j * 2 + hh] = dw; }
        }
        *(u32x4*)(dst + lane * 16) = w;
        *(unsigned short*)(dst + 1024 + lane * 2) = (unsigned short)sqp;
        if (lane == 0) ((float*)(P.ws + (isv ? WS_SV : WS_SU)))[row] = rm * (1.0f / (255.0f * 7.0f));
    }
}
__device__ __forceinline__ void phase_prologue(const Params& P, LAS unsigned char* lds) {
    const size_t gtid = (size_t)blockIdx.x * NTHREADS + threadIdx.x, gstride = (size_t)gridDim.x * NTHREADS;
    unsigned char* ws = P.ws;
    convert_flat(P.x_prompt, (bf16_t*)(ws + WS_XB), (size_t)NTOK_P * D / 8, gtid, gstride);
    convert_flat(P.x_sample, (bf16_t*)(ws + WS_XB) + (size_t)NTOK_P * D, (size_t)NTOK_S * D / 8, gtid, gstride);
    convert_flat(P.sub_keys, (bf16_t*)(ws + WS_SKB), (size_t)8 * 2 * 128 * 128 / 8, gtid, gstride);
    transpose_convert(P.w_in, (bf16_t*)(ws + WS_WINT), D, DIN, (LAS float*)lds);
    transpose_convert(P.w_out, (bf16_t*)(ws + WS_WOT), D, D, (LAS float*)lds);
    transpose_convert(P.w_query, (bf16_t*)(ws + WS_WQT), D, D, (LAS float*)lds);
}

struct EpiProj {
    static constexpr bool PERM = false, AFTER_DRAIN = false;
    float* out; float* QF; float* XR; float* GATE; bf16_t* QB; bf16_t* KB; bf16_t* VB16;
    __device__ __forceinline__ void operator()(const f32x4 (&acc)[2][2][4][2], const pg8::Unit& u, int wr, int wc, int fr, int fq) const {
        const int pn = u.pn; const int coff = wc * 32 + 4 * fq;
#pragma unroll
        for (int ai = 0; ai < 2; ++ai)
#pragma unroll
            for (int m = 0; m < 4; ++m) {
                const int row = u.pm * 256 + ai * 128 + wr * 64 + m * 16 + fr;
                const bool prompt = row < NTOK_P;
                float* rowp = nullptr; bf16_t* rowb = nullptr; float bsc = 1.0f;
                if (pn < 6) { rowb = QB + (size_t)row * DATT + pn * 256; bsc = ATT_SCALE * LOG2E; }
                else if (pn < 18) {
                    const int isv = pn >= 12; const int c0 = (pn - (isv ? 12 : 6)) * 256;
                    if (prompt) { rowp = out + (isv ? O_VP : O_KP) + (size_t)row * DATT + c0; rowb = (isv ? VB16 : KB) + (size_t)row * DATT + c0; }
                    else { const int rr = row - NTOK_P, b = rr >> 3, t = rr & 7; rowp = out + (isv ? O_VS : O_KS) + ((size_t)b * 2048 + 2040 + t) * DATT + c0; }
                } else if (pn < 20) rowp = XR + (size_t)row * DLRU + (pn - 18) * 256;
                else rowp = GATE + (size_t)row * DLRU + (pn - 20) * 256;
#pragma unroll
                for (int bj = 0; bj < 2; ++bj)
#pragma unroll
                    for (int n = 0; n < 2; ++n) {
                        const f32x4 v = acc[ai][bj][m][n];
                        if (rowp) *(f32x4*)(rowp + coff + bj * 128 + n * 16) = v;
                        if (rowb) { u32x2 w; w.x = pg8::cvt_pk_bf16(v[0] * bsc, v[1] * bsc); w.y = pg8::cvt_pk_bf16(v[2] * bsc, v[3] * bsc); *(u32x2*)(rowb + coff + bj * 128 + n * 16) = w; }
                    }
            }
    }
};
struct EpiOut {
    static constexpr bool PERM = false, AFTER_DRAIN = false;
    const float* xp; const float* xs; float* pre;
    __device__ __forceinline__ void operator()(const f32x4 (&acc)[2][2][4][2], const pg8::Unit& u, int wr, int wc, int fr, int fq) const {
        const int col0 = u.pn * 256 + wc * 32 + 4 * fq;
#pragma unroll
        for (int ai = 0; ai < 2; ++ai)
#pragma unroll
            for (int m = 0; m < 4; ++m) {
                const int row = u.pm * 256 + ai * 128 + wr * 64 + m * 16 + fr;
                const float* xr = (row < NTOK_P ? xp + (size_t)row * D : xs + (size_t)(row - NTOK_P) * D) + col0;
                float* pr = pre + (size_t)row * D + col0;
#pragma unroll
                for (int bj = 0; bj < 2; ++bj)
#pragma unroll
                    for (int n = 0; n < 2; ++n) { const f32x4 xv = *(const f32x4*)(xr + bj * 128 + n * 16); *(f32x4*)(pr + bj * 128 + n * 16) = xv * ALPHA + acc[ai][bj][m][n]; }
            }
    }
};
struct EpiPlain {
    static constexpr bool PERM = false, AFTER_DRAIN = false;
    float* C; int ldc;
    __device__ __forceinline__ void operator()(const f32x4 (&acc)[2][2][4][2], const pg8::Unit& u, int wr, int wc, int fr, int fq) const {
        const int col0 = u.pn * 256 + wc * 32 + 4 * fq;
#pragma unroll
        for (int ai = 0; ai < 2; ++ai)
#pragma unroll
            for (int m = 0; m < 4; ++m) {
                const int row = u.pm * 256 + ai * 128 + wr * 64 + m * 16 + fr;
                float* pr = C + (size_t)row * ldc + col0;
#pragma unroll
                for (int bj = 0; bj < 2; ++bj)
#pragma unroll
                    for (int n = 0; n < 2; ++n) *(f32x4*)(pr + bj * 128 + n * 16) = acc[ai][bj][m][n];
            }
    }
};

struct EpiBf16Plain {
    static constexpr bool PERM = false, AFTER_DRAIN = false;
    bf16_t* C; int ldc;
    __device__ __forceinline__ void operator()(const f32x4 (&acc)[2][2][4][2], const pg8::Unit& u, int wr, int wc, int fr, int fq) const {
        const int col0 = u.pn * 256 + wc * 32 + 4 * fq;
#pragma unroll
        for (int ai = 0; ai < 2; ++ai)
#pragma unroll
            for (int m = 0; m < 4; ++m) {
                const int row = u.pm * 256 + ai * 128 + wr * 64 + m * 16 + fr;
                bf16_t* pr = C + (size_t)row * ldc + col0;
#pragma unroll
                for (int bj = 0; bj < 2; ++bj)
#pragma unroll
                    for (int n = 0; n < 2; ++n) { const f32x4 v = acc[ai][bj][m][n]; u32x2 w; w.x = pg8::cvt_pk_bf16(v[0], v[1]); w.y = pg8::cvt_pk_bf16(v[2], v[3]); *(u32x2*)(pr + bj * 128 + n * 16) = w; }
            }
    }
};

template <int MODE>
__device__ __forceinline__ void sample_rows_gemm(const Params& P, const bf16_t* A, const bf16_t* Wt) {
    const int lane = threadIdx.x & 63, w = __builtin_amdgcn_readfirstlane(threadIdx.x >> 6);
    const int c = lane & 15, g = lane >> 4;
    const int ncol = D / (int)gridDim.x;
    const int n0 = blockIdx.x * ncol;
    const int t0 = NTOK_P + 32 * w;
    const bf16_t* wrow = Wt + (size_t)(n0 + (c < ncol ? c : ncol - 1)) * D + 8 * g;
    const bf16_t* x0 = A + (size_t)(t0 + c) * D + 8 * g; const bf16_t* x1 = x0 + (size_t)16 * D;
    f32x4 acc0 = {0.f, 0.f, 0.f, 0.f}, acc1 = {0.f, 0.f, 0.f, 0.f};
#pragma unroll 8
    for (int ks = 0; ks < D / 32; ++ks) {
        const bf16x8 wf = *(const bf16x8*)(wrow + 32 * ks), b0 = *(const bf16x8*)(x0 + 32 * ks), b1 = *(const bf16x8*)(x1 + 32 * ks);
        acc0 = __builtin_amdgcn_mfma_f32_16x16x32_bf16(wf, b0, acc0, 0, 0, 0); acc1 = __builtin_amdgcn_mfma_f32_16x16x32_bf16(wf, b1, acc1, 0, 0, 0);
    }
    if (4 * g < ncol) {
#pragma unroll
        for (int tt = 0; tt < 2; ++tt) {
            const int row = t0 + 16 * tt + c; const f32x4 a = tt ? acc1 : acc0; const int col = n0 + 4 * g;
            if (MODE == 0) { const f32x4 xv = *(const f32x4*)(P.x_sample + (size_t)(row - NTOK_P) * D + col); *(f32x4*)((float*)(P.ws + WS_PRE1) + (size_t)row * D + col) = xv * ALPHA + a; }
            else { u32x2 wv; wv.x = pg8::cvt_pk_bf16(a[0], a[1]); wv.y = pg8::cvt_pk_bf16(a[2], a[3]); *(u32x2*)((bf16_t*)(P.ws + WS_QP) + (size_t)row * D + col) = wv; }
        }
    }
}

constexpr int KVS = 288, VOFF = 73728;
template <int MODE>
__device__ __forceinline__ void attn_unit(const Params& P, int p, int b, int h, int r, int c, LAS unsigned char* lds) {
    const int tid = threadIdx.x, lane = tid & 63, w = __builtin_amdgcn_readfirstlane(tid >> 6);
    const int dil = 1 << (2 * p);
    const bf16_t* Qb = (const bf16_t*)(P.ws + WS_QB); const bf16_t* Kb = (const bf16_t*)(P.ws + WS_KB); const bf16_t* Vb = (const bf16_t*)(P.ws + WS_VB16);
    const size_t tok0 = (size_t)b * 2048;
    const int j0 = 128 * c - 128, rho0 = (c == 0) ? 128 : 0;
#pragma unroll
    for (int it = 0; it < 8; ++it) {
        const int rho = it * 32 + (tid >> 4), ch = tid & 15;
        if (rho >= rho0) {
            const size_t tok = tok0 + (size_t)((j0 + rho) * dil + r);
            const u32x4 kv = *(const u32x4*)(Kb + tok * DATT + h * HD + ch * 8);
            const u32x4 vv = *(const u32x4*)(Vb + tok * DATT + h * HD + ch * 8);
            *(LAS u32x4*)(lds + rho * KVS + ch * 16) = kv;
            *(LAS u32x4*)(lds + VOFF + rho * KVS + ch * 16) = vv;
        }
    }
    const int cq = lane & 15, g = lane >> 4;
    const int iq = 128 * c + 16 * w + cq;
    const size_t qtok = tok0 + (size_t)(iq * dil + r);
    bf16x8 qf[4];
#pragma unroll
    for (int ks = 0; ks < 4; ++ks) qf[ks] = *(const bf16x8*)(Qb + qtok * DATT + h * HD + 32 * ks + 8 * g);
    __syncthreads();
    const int ktmin = (8 - w - 8 * c) > 0 ? (8 - w - 8 * c) : 0;
    const float slope2 = exp2f(-8.0f * (float)(h + 1) / 12.0f) * LOG2E * (float)dil;
    f32x4 s[9]; float m = -INFINITY;
#pragma unroll
    for (int kt = 0; kt < 9; ++kt) {
        if (kt >= ktmin) {
            f32x4 acc = {0.f, 0.f, 0.f, 0.f};
#pragma unroll
            for (int ks = 0; ks < 4; ++ks) { const bf16x8 kf = *(const LAS bf16x8*)(lds + (16 * w + 16 * kt + cq) * KVS + (32 * ks + 8 * g) * 2); acc = __builtin_amdgcn_mfma_f32_16x16x32_bf16(kf, qf[ks], acc, 0, 0, 0); }
#pragma unroll
            for (int ii = 0; ii < 4; ++ii) { const int dist = cq + 128 - 16 * kt - 4 * g - ii; float v = acc[ii] - slope2 * (float)dist;
                if (kt == 0 && dist > 128) v = -INFINITY; if (kt == 8 && dist < 0) v = -INFINITY; acc[ii] = v; m = fmaxf(m, v); }
            s[kt] = acc;
        } else s[kt] = (f32x4){-INFINITY, -INFINITY, -INFINITY, -INFINITY};
    }
    m = fmaxf(m, __shfl_xor(m, 16)); m = fmaxf(m, __shfl_xor(m, 32));
    float l = 0.f;
#pragma unroll
    for (int kt = 0; kt < 9; ++kt)
#pragma unroll
        for (int ii = 0; ii < 4; ++ii) { const float pp = exp2f(s[kt][ii] - m); s[kt][ii] = pp; l += pp; }
    l += __shfl_xor(l, 16); l += __shfl_xor(l, 32);
    f32x4 o[8];
#pragma unroll
    for (int dt = 0; dt < 8; ++dt) o[dt] = (f32x4){0.f, 0.f, 0.f, 0.f};
#pragma unroll
    for (int kk = 0; kk < 5; ++kk) {
        const int T0 = 2 * kk, T1 = 2 * kk + 1;
        if (T1 >= ktmin || T0 == 8) {
            u32x4 pw; pw.x = pg8::cvt_pk_bf16(s[T0][0], s[T0][1]); pw.y = pg8::cvt_pk_bf16(s[T0][2], s[T0][3]);
            if (T1 <= 8) { pw.z = pg8::cvt_pk_bf16(s[T1 <= 8 ? T1 : 8][0], s[T1 <= 8 ? T1 : 8][1]); pw.w = pg8::cvt_pk_bf16(s[T1 <= 8 ? T1 : 8][2], s[T1 <= 8 ? T1 : 8][3]); } else { pw.z = 0u; pw.w = 0u; }
            const bf16x8 pf = __builtin_bit_cast(bf16x8, pw);
            const int rT0 = (T0 >= ktmin) ? T0 : 8, rT1 = (T1 <= 8 && T1 >= ktmin) ? T1 : 8;
            const int a0 = VOFF + (16 * w + 16 * rT0 + 4 * g + (cq >> 2)) * KVS + 8 * (cq & 3);
            const int a1 = VOFF + (16 * w + 16 * rT1 + 4 * g + (cq >> 2)) * KVS + 8 * (cq & 3);
#pragma unroll
            for (int dt = 0; dt < 8; ++dt) {
                const s16x4 v0 = __builtin_amdgcn_ds_read_tr16_b64_v4i16((LAS s16x4*)(lds + a0 + dt * 32));
                const s16x4 v1 = __builtin_amdgcn_ds_read_tr16_b64_v4i16((LAS s16x4*)(lds + a1 + dt * 32));
                const bf16x8 vf = {v0[0], v0[1], v0[2], v0[3], v1[0], v1[1], v1[2], v1[3]};
                o[dt] = __builtin_amdgcn_mfma_f32_16x16x32_bf16(vf, pf, o[dt], 0, 0, 0);
            }
        }
    }
    const float inv = 1.0f / l;
    if (MODE == 0) {
        bf16_t* po = (bf16_t*)(P.ws + WS_PO) + ((size_t)p * NTOK_P + qtok) * DATT + h * HD + 4 * g;
#pragma unroll
        for (int dt = 0; dt < 8; ++dt) { u32x2 wv; wv.x = pg8::cvt_pk_bf16(o[dt][0] * inv, o[dt][1] * inv); wv.y = pg8::cvt_pk_bf16(o[dt][2] * inv, o[dt][3] * inv); *(u32x2*)(po + 16 * dt) = wv; }
        if (g == 0) { ((float*)(P.ws + WS_PM))[((size_t)p * NTOK_P + qtok) * NH + h] = m; ((float*)(P.ws + WS_PL))[((size_t)p * NTOK_P + qtok) * NH + h] = l; }
    } else {
        const float* PM = (const float*)(P.ws + WS_PM); const float* PL = (const float*)(P.ws + WS_PL);
        const float m0 = PM[qtok * NH + h], l0 = PL[qtok * NH + h], m1 = PM[((size_t)NTOK_P + qtok) * NH + h], l1 = PL[((size_t)NTOK_P + qtok) * NH + h];
        const float M = fmaxf(m, fmaxf(m0, m1));
        const float w2 = exp2f(m - M), w0 = exp2f(m0 - M) * l0, w1 = exp2f(m1 - M) * l1;
        const float rden = 1.0f / (w2 * l + w0 + w1);
        const bf16_t* p0 = (const bf16_t*)(P.ws + WS_PO) + qtok * DATT + h * HD + 4 * g;
        const bf16_t* p1 = p0 + (size_t)NTOK_P * DATT;
        bf16_t* ar = (bf16_t*)(P.ws + WS_AR) + qtok * D + h * HD + 4 * g;
#pragma unroll
        for (int dt = 0; dt < 8; ++dt) {
            const u32x2 x0 = *(const u32x2*)(p0 + 16 * dt), x1 = *(const u32x2*)(p1 + 16 * dt);
            const float r0 = (w2 * o[dt][0] + w0 * bflo(x0.x) + w1 * bflo(x1.x)) * rden, r1 = (w2 * o[dt][1] + w0 * bfhi(x0.x) + w1 * bfhi(x1.x)) * rden;
            const float r2 = (w2 * o[dt][2] + w0 * bflo(x0.y) + w1 * bflo(x1.y)) * rden, r3 = (w2 * o[dt][3] + w0 * bfhi(x0.y) + w1 * bfhi(x1.y)) * rden;
            u32x2 wv; wv.x = pg8::cvt_pk_bf16(r0, r1); wv.y = pg8::cvt_pk_bf16(r2, r3); *(u32x2*)(ar + 16 * dt) = wv;
        }
    }
    __syncthreads();
}

__device__ __forceinline__ void samp_unit(const Params& P, int b, int h, int k, LAS unsigned char* lds) {
    const int tid = threadIdx.x, lane = tid & 63, w = __builtin_amdgcn_readfirstlane(tid >> 6);
    const int cq = lane & 15, g = lane >> 4;
    if (k < 8) {
#pragma unroll 4
        for (int it = 0; it < 16; ++it) {
            const int rho = it * 16 + (tid >> 5), ch4 = tid & 31, c = 256 * k + rho;
            const size_t so = ((size_t)(b * 2048 + c)) * DATT + h * HD + ch4 * 4;
            const float4 kf = *(const float4*)(P.cache_k + so), vf = *(const float4*)(P.cache_v + so);
            if (c >= 8) { const size_t od = ((size_t)(b * 2048 + c - 8)) * DATT + h * HD + ch4 * 4; *(float4*)(P.out + O_KS + od) = kf; *(float4*)(P.out + O_VS + od) = vf; }
            u32x2 kw, vw; kw.x = pg8::cvt_pk_bf16(kf.x, kf.y); kw.y = pg8::cvt_pk_bf16(kf.z, kf.w); vw.x = pg8::cvt_pk_bf16(vf.x, vf.y); vw.y = pg8::cvt_pk_bf16(vf.z, vf.w);
            *(LAS u32x2*)(lds + rho * KVS + ch4 * 8) = kw; *(LAS u32x2*)(lds + VOFF + rho * KVS + ch4 * 8) = vw;
        }
    } else {
        const int rho = tid >> 5, ch4 = tid & 31;
        u32x2 kw = {0u, 0u}, vw = {0u, 0u};
        if (rho < 8) { const size_t so = ((size_t)(b * 2048 + 2040 + rho)) * DATT + h * HD + ch4 * 4; const float4 kf = *(const float4*)(P.out + O_KS + so), vf = *(const float4*)(P.out + O_VS + so);
            kw.x = pg8::cvt_pk_bf16(kf.x, kf.y); kw.y = pg8::cvt_pk_bf16(kf.z, kf.w); vw.x = pg8::cvt_pk_bf16(vf.x, vf.y); vw.y = pg8::cvt_pk_bf16(vf.z, vf.w); }
        *(LAS u32x2*)(lds + rho * KVS + ch4 * 8) = kw; *(LAS u32x2*)(lds + VOFF + rho * KVS + ch4 * 8) = vw;
        *(LAS u32x2*)(lds + (16 + rho) * KVS + ch4 * 8) = (u32x2){0u, 0u}; *(LAS u32x2*)(lds + VOFF + (16 + rho) * KVS + ch4 * 8) = (u32x2){0u, 0u};
    }
    const int t = cq & 7;
    const bf16_t* Qb = (const bf16_t*)(P.ws + WS_QB) + ((size_t)(NTOK_P + b * 8 + t)) * DATT + h * HD;
    bf16x8 qf[4];
#pragma unroll
    for (int ks = 0; ks < 4; ++ks) qf[ks] = *(const bf16x8*)(Qb + 32 * ks + 8 * g);
    __syncthreads();
    const float slope2 = exp2f(-8.0f * (float)(h + 1) / 12.0f) * LOG2E;
    const bool active = (k < 8) || (w == 0);
    f32x4 s[2]; float m = -INFINITY;
#pragma unroll
    for (int j = 0; j < 2; ++j) {
        f32x4 acc = {0.f, 0.f, 0.f, 0.f};
        if (active) {
#pragma unroll
            for (int ks = 0; ks < 4; ++ks) { const bf16x8 kf = *(const LAS bf16x8*)(lds + (32 * w + 16 * j + cq) * KVS + (32 * ks + 8 * g) * 2); acc = __builtin_amdgcn_mfma_f32_16x16x32_bf16(kf, qf[ks], acc, 0, 0, 0); }
        }
#pragma unroll
        for (int ii = 0; ii < 4; ++ii) {
            const int c = 256 * k + 32 * w + 16 * j + 4 * g + ii, dist = 2048 + t - c;
            int mult = (dist <= 128 ? 1 : 0) + (((dist & 3) == 0 && dist <= 512) ? 1 : 0) + (((dist & 15) == 0 && dist <= 2048) ? 1 : 0);
            if (dist < 0 || !active || c > 2055) mult = 0;
            const float v = mult ? acc[ii] - slope2 * (float)dist : -INFINITY;
            acc[ii] = v; m = fmaxf(m, v);
            s[j][ii] = (float)mult;
            s[j][ii] = v;
        }
    }
    m = fmaxf(m, __shfl_xor(m, 16)); m = fmaxf(m, __shfl_xor(m, 32));
    const float mref = (m == -INFINITY) ? 0.f : m;
    float l = 0.f;
#pragma unroll
    for (int j = 0; j < 2; ++j)
#pragma unroll
        for (int ii = 0; ii < 4; ++ii) {
            const int c = 256 * k + 32 * w + 16 * j + 4 * g + ii, dist = 2048 + t - c;
            const int mult = (dist <= 128 ? 1 : 0) + (((dist & 3) == 0 && dist <= 512) ? 1 : 0) + (((dist & 15) == 0 && dist <= 2048) ? 1 : 0);
            const float pp = (float)mult * exp2f(s[j][ii] - mref); s[j][ii] = pp; l += pp; }
    l += __shfl_xor(l, 16); l += __shfl_xor(l, 32);
    f32x4 o[8];
    {
        u32x4 pw; pw.x = pg8::cvt_pk_bf16(s[0][0], s[0][1]); pw.y = pg8::cvt_pk_bf16(s[0][2], s[0][3]); pw.z = pg8::cvt_pk_bf16(s[1][0], s[1][1]); pw.w = pg8::cvt_pk_bf16(s[1][2], s[1][3]);
        const bf16x8 pf = __builtin_bit_cast(bf16x8, pw);
        const int rw = active ? w : 0;
        const int a0 = VOFF + (32 * rw + 4 * g + (cq >> 2)) * KVS + 8 * (cq & 3), a1 = a0 + 16 * KVS;
#pragma unroll
        for (int dt = 0; dt < 8; ++dt) {
            const s16x4 v0 = __builtin_amdgcn_ds_read_tr16_b64_v4i16((LAS s16x4*)(lds + a0 + dt * 32));
            const s16x4 v1 = __builtin_amdgcn_ds_read_tr16_b64_v4i16((LAS s16x4*)(lds + a1 + dt * 32));
            const bf16x8 vf = {v0[0], v0[1], v0[2], v0[3], v1[0], v1[1], v1[2], v1[3]};
            o[dt] = __builtin_amdgcn_mfma_f32_16x16x32_bf16(vf, pf, (f32x4){0.f, 0.f, 0.f, 0.f}, 0, 0, 0);
        }
    }
    __syncthreads();
    LAS float* OL = (LAS float*)lds;
    LAS float* ML = (LAS float*)(lds + 32768);
    if (cq < 8) {
#pragma unroll
        for (int dt = 0; dt < 8; ++dt) *(LAS f32x4*)(OL + (w * 8 + cq) * 128 + 16 * dt + 4 * g) = o[dt];
        if (g == 0) { ML[(w * 8 + cq) * 2 + 0] = m; ML[(w * 8 + cq) * 2 + 1] = l; }
    }
    __syncthreads();
    {
        const int q = w; float M = -INFINITY;
#pragma unroll
        for (int ww = 0; ww < 8; ++ww) M = fmaxf(M, ML[(ww * 8 + q) * 2]);
        const float Mr = (M == -INFINITY) ? 0.f : M;
        float L = 0.f, o0 = 0.f, o1 = 0.f;
#pragma unroll
        for (int ww = 0; ww < 8; ++ww) { const float f = exp2f(ML[(ww * 8 + q) * 2] - Mr); L += f * ML[(ww * 8 + q) * 2 + 1];
            o0 += f * OL[(ww * 8 + q) * 128 + 2 * lane]; o1 += f * OL[(ww * 8 + q) * 128 + 2 * lane + 1]; }
        float* ps = (float*)(P.ws + WS_PS) + ((((size_t)(b * NH + h)) * 9 + k) * 8 + q) * 130;
        if (lane == 0) { ps[0] = M; ps[1] = L; }
        *(float2*)(ps + 2 + 2 * lane) = make_float2(o0, o1);
    }
    __syncthreads();
}
__device__ __forceinline__ void samp_merge_unit(const Params& P, int b, int t, int h, int lane) {
    const float* ps = (const float*)(P.ws + WS_PS) + ((size_t)(b * NH + h)) * 9 * 8 * 130 + (size_t)t * 130;
    float M = -INFINITY;
#pragma unroll
    for (int k = 0; k < 9; ++k) M = fmaxf(M, ps[(size_t)k * 8 * 130]);
    float L = 0.f, o0 = 0.f, o1 = 0.f;
#pragma unroll
    for (int k = 0; k < 9; ++k) { const float* pk = ps + (size_t)k * 8 * 130; const float f = exp2f(pk[0] - M); L += f * pk[1]; const float2 ov = *(const float2*)(pk + 2 + 2 * lane); o0 += f * ov.x; o1 += f * ov.y; }
    const float inv = 1.0f / L;
    bf16_t* ar = (bf16_t*)(P.ws + WS_AR) + ((size_t)(NTOK_P + b * 8 + t)) * D + h * HD;
    *(unsigned*)(ar + 2 * lane) = pack2(o0 * inv, o1 * inv);
}

__device__ __forceinline__ void lru_unit(const Params& P, bool samp, int b, int n, int k, int lane) {
    const int T = samp ? 8 : 64; const int row0 = samp ? NTOK_P + b * 8 : b * 2048 + k * 64; const int ch = n * 64 + lane;
    float wa[64], wx[64];
#pragma unroll
    for (int c = 0; c < 64; ++c) { wa[c] = P.lru_w_a[(n * 64 + c) * 64 + lane]; wx[c] = P.lru_w_x[(n * 64 + c) * 64 + lane]; }
    const float ba = P.lru_b_a[ch], bx = P.lru_b_x[ch], lam = P.lru_lambda[ch];
    const float sp = log1pf(expf(-lam));
    const float cw0 = P.conv_w[ch], cw1 = P.conv_w[512 + ch], cw2 = P.conv_w[1024 + ch], cw3 = P.conv_w[1536 + ch], cb = P.conv_b[ch];
    const float* XR = (const float*)(P.ws + WS_XR); const float* GT = (const float*)(P.ws + WS_GATE);
    float* R0 = (float*)(P.ws + WS_R0); float* R1 = (float*)(P.ws + WS_R1); bf16_t* AR = (bf16_t*)(P.ws + WS_AR);
    float x0 = 0.f, x1 = 0.f, x2 = 0.f, h = 0.f, A = 1.f;
    if (samp) { x0 = P.state_conv[(b * 3 + 0) * 512 + ch]; x1 = P.state_conv[(b * 3 + 1) * 512 + ch]; x2 = P.state_conv[(b * 3 + 2) * 512 + ch]; h = P.state_h[b * 512 + ch]; }
    else if (k > 0) { x0 = XR[(size_t)(row0 - 3) * DLRU + ch]; x1 = XR[(size_t)(row0 - 2) * DLRU + ch]; x2 = XR[(size_t)(row0 - 1) * DLRU + ch]; }
    for (int t0 = 0; t0 < T; t0 += 8) {
        float xin[8], gt[8];
#pragma unroll
        for (int i = 0; i < 8; ++i) { xin[i] = XR[(size_t)(row0 + t0 + i) * DLRU + ch]; gt[i] = GT[(size_t)(row0 + t0 + i) * DLRU + ch]; }
#pragma unroll
        for (int i = 0; i < 8; ++i) {
            const float xc = ((x0 * cw0 + x1 * cw1) + x2 * cw2) + xin[i] * cw3 + cb;
            x0 = x1; x1 = x2; x2 = xin[i];
            float ra = 0.f, ri = 0.f;
#pragma unroll
            for (int c = 0; c < 64; ++c) { const float xcc = readlane_f(xc, c); ra += xcc * wa[c]; ri += xcc * wx[c]; if ((c & 15) == 15) __builtin_amdgcn_sched_barrier(0); }
            const float rr = sigmoidf(ra + ba), ig = sigmoidf(ri + bx);
            const float log_a = -8.0f * rr * sp; const float a = expf(log_a);
            const float u = sqrtf(-expm1f(2.0f * log_a)) * (ig * xc);
            h = a * h + u; A = a * A;
            const float ge = gelu_exact(gt[i]);
            if (samp) AR[(size_t)(row0 + t0 + i) * D + DATT + ch] = (bf16_t)f2bf(h * ge);
            else { R0[(size_t)(row0 + t0 + i) * DLRU + ch] = h * ge; R1[(size_t)(row0 + t0 + i) * DLRU + ch] = A * ge; }
        }
    }
    if (samp) { P.out[O_HS + (size_t)b * 512 + ch] = h; float* co = P.out + O_CS + (size_t)b * 3 * 512 + ch; co[0] = x0; co[512] = x1; co[1024] = x2; }
    else {
        ((float*)(P.ws + WS_HE))[((size_t)(b * 32 + k)) * 512 + ch] = h; ((float*)(P.ws + WS_AE))[((size_t)(b * 32 + k)) * 512 + ch] = A;
        if (k == 31) { float* co = P.out + O_CP + (size_t)b * 3 * 512 + ch; co[0] = x0; co[512] = x1; co[1024] = x2; }
    }
}

__device__ __forceinline__ void phase_lru(const Params& P) {
    const int lane = threadIdx.x & 63, wave = __builtin_amdgcn_readfirstlane(threadIdx.x >> 6);
    const int gw = blockIdx.x * 8 + wave, nw = gridDim.x * 8;
#pragma unroll 1
    for (int pass = 0; pass < 2; ++pass) {
        if ((pass ^ (wave & 1)) == 0) {
            for (int u = gw; u < 2048 + 256; u += nw) { const bool samp = u >= 2048; const int v = samp ? u - 2048 : u; lru_unit(P, samp, samp ? (v >> 3) : (v >> 8), samp ? (v & 7) : ((v >> 5) & 7), v & 31, lane); }
        } else quant_tables(P);
    }
}
__device__ __forceinline__ void phase_samp(const Params& P, LAS unsigned char* lds) {
    for (int u = blockIdx.x; u < 384 * 9; u += gridDim.x) { const int k = u % 9, bh = u / 9; samp_unit(P, bh / NH, bh % NH, k, lds); }
}
__device__ __forceinline__ void phase_attn01(const Params& P, LAS unsigned char* lds) {
    for (int u = blockIdx.x; u < 3072; u += gridDim.x) {
        const int p = u / 1536, rem = u - p * 1536, bh = rem >> 4, rc = rem & 15;
        const int b = bh / NH, h = bh - b * NH;
        const int r = p == 0 ? 0 : (rc >> 2), c = p == 0 ? rc : (rc & 3);
        attn_unit<0>(P, p, b, h, r, c, lds);
    }
}
__device__ __forceinline__ void phase_mix_b(const Params& P, LAS unsigned char* lds) {
    {
        const int gt = blockIdx.x * NTHREADS + threadIdx.x;
        for (int i = gt; i < 8 * 32 * 512; i += gridDim.x * NTHREADS) {
            const int ch = i & 511, k = (i >> 9) & 31, b = i >> 14;
            const float* HE = (const float*)(P.ws + WS_HE) + (size_t)b * 32 * 512 + ch; const float* AE = (const float*)(P.ws + WS_AE) + (size_t)b * 32 * 512 + ch;
            float hin = 0.f;
            for (int kk = 0; kk < k; ++kk) hin = HE[kk * 512] + AE[kk * 512] * hin;
            const float* R0 = (const float*)(P.ws + WS_R0) + (size_t)(b * 2048 + k * 64) * DLRU + ch; const float* R1 = (const float*)(P.ws + WS_R1) + (size_t)(b * 2048 + k * 64) * DLRU + ch;
            bf16_t* ar = (bf16_t*)(P.ws + WS_AR) + (size_t)(b * 2048 + k * 64) * D + DATT + ch;
#pragma unroll 8
            for (int t = 0; t < 64; ++t) ar[(size_t)t * D] = (bf16_t)f2bf(R0[(size_t)t * DLRU] + R1[(size_t)t * DLRU] * hin);
            if (k == 31) P.out[O_HP + (size_t)b * 512 + ch] = HE[31 * 512] + AE[31 * 512] * hin;
        }
    }
    { const int lane = threadIdx.x & 63, gw = blockIdx.x * 8 + (threadIdx.x >> 6);
      for (int u = gw; u < NTOK_S * NH; u += gridDim.x * 8) { const int row = u / NH, h = u - row * NH; samp_merge_unit(P, row >> 3, row & 7, h, lane); } }
    for (int u = blockIdx.x; u < 1536; u += gridDim.x) {
        const int bh = u >> 4, r = u & 15; const int b = bh / NH, h = bh - b * NH;
        attn_unit<1>(P, 2, b, h, r, 0, lds);
    }
}

__device__ __forceinline__ void phase_ln1(const Params& P) {
    const int lane = threadIdx.x & 63, wave = threadIdx.x >> 6;
    const float* pre = (const float*)(P.ws + WS_PRE1); bf16_t* x1b = (bf16_t*)(P.ws + WS_X1B);
    for (int row = blockIdx.x * 8 + wave; row < NTOK; row += gridDim.x * 8) {
        float4 v[8]; float s = 0.f;
#pragma unroll
        for (int j = 0; j < 8; ++j) { v[j] = *(const float4*)(pre + (size_t)row * D + (j >> 2) * 1024 + lane * 16 + (j & 3) * 4); s += (v[j].x + v[j].y) + (v[j].z + v[j].w); }
        const float mean = wave_sum(s) * (1.0f / D); float q = 0.f;
#pragma unroll
        for (int j = 0; j < 8; ++j) { const float a = v[j].x - mean, b = v[j].y - mean, c = v[j].z - mean, d = v[j].w - mean; q += (a * a + b * b) + (c * c + d * d); }
        const float rstd = rsqrtf(wave_sum(q) * (1.0f / D) + LN_EPS);
        float am = 0.f;
#pragma unroll
        for (int j = 0; j < 8; ++j) { const int col = (j >> 2) * 1024 + lane * 16 + (j & 3) * 4; const float4 g = *(const float4*)(P.ln1_g + col), bb = *(const float4*)(P.ln1_b + col);
            float4 o; o.x = (v[j].x - mean) * rstd * g.x + bb.x; o.y = (v[j].y - mean) * rstd * g.y + bb.y; o.z = (v[j].z - mean) * rstd * g.z + bb.z; o.w = (v[j].w - mean) * rstd * g.w + bb.w;
            v[j] = o; am = fmaxf(am, fmaxf(fmaxf(fabsf(o.x), fabsf(o.y)), fmaxf(fabsf(o.z), fabsf(o.w))));
            uint2 w; w.x = pack2(o.x, o.y); w.y = pack2(o.z, o.w); *(uint2*)(x1b + (size_t)row * D + col) = w; }
        am = wave_max(am); if (am == 0.f) am = 1.f;
        const float inv = 119.0f / am;
        unsigned char* xq = P.ws + WS_X1Q + (size_t)row * D;
        u32x4 wh, wl;
#pragma unroll
        for (int d = 0; d < 4; ++d) { unsigned dh = 0u, dl = 0u;
#pragma unroll
            for (int e = 0; e < 8; ++e) { const float4 t = v[d * 2 + (e >> 2)]; const float x = (e & 3) == 0 ? t.x : ((e & 3) == 1 ? t.y : ((e & 3) == 2 ? t.z : t.w));
                const int q = (int)rintf(x * inv); dl |= (unsigned)(q & 15) << (4 * e); dh |= (unsigned)(((q + 8) >> 4) & 15) << (4 * e); }
            wh[d] = dh; wl[d] = dl; }
        *(u32x4*)(xq + lane * 32) = wh; *(u32x4*)(xq + lane * 32 + 16) = wl;
        if (lane == 0) ((float*)(P.ws + WS_SX))[row] = am * (1.0f / 119.0f);
    }
}

__device__ __forceinline__ int mono(float v) { const int b = __float_as_int(v); return b ^ ((b >> 31) & 0x7fffffff); }
__device__ __forceinline__ float unmono(int k) { return __int_as_float(k ^ ((k >> 31) & 0x7fffffff)); }
#define MK_INSERT16(L, X) do { int _x = (X); _Pragma("unroll") for (int _j = 0; _j < 16; ++_j) { const int _hi = max(L[_j], _x); _x = min(L[_j], _x); L[_j] = _hi; } } while (0)

template <int N> __device__ __forceinline__ void bitonic_sort_desc(int (&v)[N]) {
#pragma unroll
    for (int k = 2; k <= N; k <<= 1)
#pragma unroll
        for (int j = k >> 1; j > 0; j >>= 1)
#pragma unroll
            for (int i = 0; i < N; ++i) { const int l = i ^ j;
                if (l > i) { const int a = v[i], b = v[l]; if ((i & k) == 0) { v[i] = max(a, b); v[l] = min(a, b); } else { v[i] = min(a, b); v[l] = max(a, b); } } }
}
template <int N> __device__ __forceinline__ void bitonic_merge_desc(int (&v)[N]) {
#pragma unroll
    for (int j = N >> 1; j > 0; j >>= 1)
#pragma unroll
        for (int i = 0; i < N; ++i) { const int l = i ^ j; if (l > i) { const int a = v[i], b = v[l]; v[i] = max(a, b); v[l] = min(a, b); } }
}
__device__ __forceinline__ void xlane_merge16(int (&v)[16], int off) {
    int c[16];
#pragma unroll
    for (int i = 0; i < 16; ++i) c[i] = max(v[i], __shfl_xor(v[15 - i], off));
#pragma unroll
    for (int i = 0; i < 16; ++i) v[i] = c[i];
    bitonic_merge_desc<16>(v);
}
__device__ __forceinline__ int sel4(int g, int a, int b, int c, int d) { return g == 0 ? a : (g == 1 ? b : (g == 2 ? c : d)); }
__device__ __forceinline__ float sel4f(int g, float a, float b, float c, float d) { return g == 0 ? a : (g == 1 ? b : (g == 2 ? c : d)); }
__device__ __forceinline__ constexpr int cand_a(int role, int i) {
    return role == 0 ? 0 : role == 1 ? (i < 8 ? 1 : (i < 13 ? 2 : 4)) : role == 2 ? (i < 4 ? 3 : (i < 6 ? 5 : (i < 8 ? 6 : (i < 10 ? 7 : 8 + (i - 10))))) : (i < 2 ? 14 + i : -1);
}
__device__ __forceinline__ constexpr int cand_b(int role, int i) {
    return role == 0 ? i : role == 1 ? (i < 8 ? i : (i < 13 ? i - 8 : i - 13)) : role == 2 ? (i < 4 ? i : (i < 6 ? i - 4 : (i < 8 ? i - 6 : (i < 10 ? i - 8 : 0)))) : 0;
}

__device__ __forceinline__ void route_unit(const Params& P, int h, int tg, LAS unsigned char* lds, LAS int* lst) {
    const int lane = threadIdx.x & 63, w = __builtin_amdgcn_readfirstlane(threadIdx.x >> 6);
    const int cq = lane & 15, g = lane >> 4;
    const int tok = tg * 128 + w * 16 + cq;
    const bf16_t* qrow = (const bf16_t*)(P.ws + WS_QP) + (size_t)tok * D + h * 256;
    int L0[16], L1[16];
#pragma unroll
    for (int p = 0; p < 2; ++p) {
        bf16x8 qf[4];
#pragma unroll
        for (int ks = 0; ks < 4; ++ks) qf[ks] = *(const bf16x8*)(qrow + p * 128 + 32 * ks + 8 * g);
        int v0[16], v1[16];
#pragma unroll
        for (int kt = 0; kt < 8; ++kt) {
            f32x4 acc = {0.f, 0.f, 0.f, 0.f};
#pragma unroll
            for (int ks = 0; ks < 4; ++ks) { const bf16x8 kf = *(const LAS bf16x8*)(lds + (p * 128 + 16 * kt + cq) * KVS + (32 * ks + 8 * g) * 2); acc = __builtin_amdgcn_mfma_f32_16x16x32_bf16(kf, qf[ks], acc, 0, 0, 0); }
#pragma unroll
            for (int ii = 0; ii < 4; ++ii) { const int key = (mono(acc[ii]) & ~127) | (16 * kt + 4 * g + ii); if (kt < 4) v0[kt * 4 + ii] = key; else v1[(kt - 4) * 4 + ii] = key; }
        }
        bitonic_sort_desc<16>(v0); bitonic_sort_desc<16>(v1);
#pragma unroll
        for (int i = 0; i < 16; ++i) v0[i] = max(v0[i], v1[15 - i]);
        bitonic_merge_desc<16>(v0);
        xlane_merge16(v0, 16); xlane_merge16(v0, 32);
#pragma unroll
        for (int i = 0; i < 16; ++i) { if (p == 0) L0[i] = v0[i]; else L1[i] = v0[i]; }
    }
    if (g == 0) {
#pragma unroll
        for (int i = 0; i < 16; ++i) lst[(cq * 2 + 0) * 16 + i] = L0[i];
    }
    if (g == 1) {
#pragma unroll
        for (int i = 0; i < 16; ++i) lst[(cq * 2 + 1) * 16 + i] = L1[i];
    }
    float f0[16], f1[16];
#pragma unroll
    for (int i = 0; i < 16; ++i) { f0[i] = unmono(L0[i] & ~127); f1[i] = unmono(L1[i] & ~127); }
    int c[16];
#pragma unroll
    for (int i = 0; i < 16; ++i) {
        constexpr int NEG = (int)0x80000000;
        const float va = sel4f(g, f0[cand_a(0, i)], f0[cand_a(1, i)], f0[cand_a(2, i)], f0[cand_a(3, i) < 0 ? 0 : cand_a(3, i)]);
        const float vb = sel4f(g, f1[cand_b(0, i)], f1[cand_b(1, i)], f1[cand_b(2, i)], f1[cand_b(3, i)]);
        const int id = sel4(g, (cand_a(0, i) << 4) | cand_b(0, i), (cand_a(1, i) << 4) | cand_b(1, i), (cand_a(2, i) << 4) | cand_b(2, i), ((cand_a(3, i) < 0 ? 0 : cand_a(3, i)) << 4) | cand_b(3, i));
        int key = (mono(va + vb) & ~255) | id;
        if (cand_a(3, i) < 0) key = (g == 3) ? NEG : key;
        c[i] = key;
    }
    bitonic_sort_desc<16>(c);
    xlane_merge16(c, 16); xlane_merge16(c, 32);
    const float mx = unmono(c[0] & ~255);
    float e[16]; float sum = 0.f;
#pragma unroll
    for (int i = 0; i < 16; ++i) { e[i] = exp2f((unmono(c[i] & ~255) - mx) * LOG2E); sum += e[i]; }
    const float inv = 1.0f / sum;
    __builtin_amdgcn_wave_barrier();
    int ei[4]; float gi[4];
#pragma unroll
    for (int j = 0; j < 4; ++j) {
        const int key = sel4(g, c[j], c[4 + j], c[8 + j], c[12 + j]);
        gi[j] = sel4f(g, e[j], e[4 + j], e[8 + j], e[12 + j]) * inv;
        const int a = (key >> 4) & 15, b = key & 15;
        const int i0 = lst[(cq * 2 + 0) * 16 + a] & 127, i1 = lst[(cq * 2 + 1) * 16 + b] & 127;
        ei[j] = i0 * 128 + i1;
    }
    int* EIDX = (int*)(P.ws + WS_EIDX); float* GW = (float*)(P.ws + WS_GW);
    *(int4*)(EIDX + (size_t)tok * 128 + h * 16 + 4 * g) = make_int4(ei[0], ei[1], ei[2], ei[3]);
    *(float4*)(GW + (size_t)tok * 128 + h * 16 + 4 * g) = make_float4(gi[0], gi[1], gi[2], gi[3]);
    __builtin_amdgcn_wave_barrier();
}
__device__ __forceinline__ void phase_route(const Params& P, LAS unsigned char* lds) {
    const int tid = threadIdx.x, wave = __builtin_amdgcn_readfirstlane(tid >> 6);
    const int h = blockIdx.x & 7, slot = blockIdx.x >> 3, nslot = gridDim.x >> 3;
    const bf16_t* sk = (const bf16_t*)(P.ws + WS_SKB) + (size_t)h * 2 * 128 * 128;
#pragma unroll
    for (int it = 0; it < 8; ++it) { const int row = it * 32 + (tid >> 4), ch = tid & 15; *(LAS u32x4*)(lds + row * KVS + ch * 16) = *(const u32x4*)(sk + (size_t)row * 128 + ch * 8); }
    __syncthreads();
    LAS int* lst = (LAS int*)(lds + 73728) + wave * 512;
    for (int tg = slot; tg < NTOK / 128; tg += nslot) route_unit(P, h, tg, lds, lst);
}

__device__ __forceinline__ float ubf(unsigned x, int k) { return (float)((x >> (8 * k)) & 0xffu); }
constexpr int XSLOT = 1152, XGRP = 4 * XSLOT, XNG = 4, XWAVE = XNG * XGRP;
__device__ __forceinline__ void dma_group(__amdgpu_buffer_rsrc_t tab, int e_lo, int e_hi, int g, LAS unsigned char* sb, int lane) {
#pragma unroll
    for (int j = 0; j < 4; ++j) {
        const int k = g * 4 + j; const int e = __builtin_amdgcn_readlane(k < 64 ? e_lo : e_hi, k & 63);
        const int so = e * TROW;
        __builtin_amdgcn_raw_ptr_buffer_load_lds(tab, (LAS void*)(sb + j * XSLOT), 16, lane * 16, so, 0, 0);
        if (lane < 8) __builtin_amdgcn_raw_ptr_buffer_load_lds(tab, (LAS void*)(sb + j * XSLOT + 1024), 16, 1024 + lane * 16, so, 0, 0);
    }
}
__device__ __forceinline__ void u_consume(const LAS unsigned char* sb, const u32x4& xh, const u32x4& xl, float a_lo, float a_hi, float b_lo, float b_hi, int g, int lane, float& w_lo, float& w_hi) {
    int d[4];
#pragma unroll
    for (int j = 0; j < 4; ++j) {
        const u32x4 nb = *(const LAS u32x4*)(sb + j * XSLOT + lane * 16); const unsigned sc = *(const LAS unsigned short*)(sb + j * XSLOT + 1024 + lane * 2);
        int tot = 0;
#pragma unroll
        for (int jj = 0; jj < 2; ++jj) {
            int th = __builtin_amdgcn_sdot8((int)nb[jj * 2], (int)xh[jj * 2], 0, false); th = __builtin_amdgcn_sdot8((int)nb[jj * 2 + 1], (int)xh[jj * 2 + 1], th, false);
            int tl = __builtin_amdgcn_sdot8((int)nb[jj * 2], (int)xl[jj * 2], 0, false); tl = __builtin_amdgcn_sdot8((int)nb[jj * 2 + 1], (int)xl[jj * 2 + 1], tl, false);
            tot += (16 * th + tl) * (int)((sc >> (8 * jj)) & 255u); }
        d[j] = tot;
    }
    const auto s02 = __builtin_amdgcn_permlane32_swap((unsigned)d[0], (unsigned)d[2], false, false);
    const auto s13 = __builtin_amdgcn_permlane32_swap((unsigned)d[1], (unsigned)d[3], false, false);
    const int r0 = (int)s02[0] + (int)s02[1], r1 = (int)s13[0] + (int)s13[1];
    const auto s01 = __builtin_amdgcn_permlane16_swap((unsigned)r0, (unsigned)r1, false, false);
    int r = (int)s01[0] + (int)s01[1];
    r += __builtin_amdgcn_update_dpp(0, r, 0x128, 0xf, 0xf, false);
    r += __builtin_amdgcn_update_dpp(0, r, 0x124, 0xf, 0xf, false);
    r += __builtin_amdgcn_update_dpp(0, r, 0x4E, 0xf, 0xf, false);
    r += __builtin_amdgcn_update_dpp(0, r, 0xB1, 0xf, 0xf, false);
    const int tot = __shfl(r, (lane & 3) * 16);
    const bool mine = ((lane >> 2) == (g & 15));
    const bool hi = g >= 16;
    const float wv = (hi ? b_hi : b_lo) * gelu_as((float)tot * (hi ? a_hi : a_lo));
    if (hi) w_hi = mine ? wv : w_hi; else w_lo = mine ? wv : w_lo;
}
__device__ __forceinline__ void v_consume(const LAS unsigned char* sb, int (&acc)[32], int (&bias)[2], float w_lo, float w_hi, float inv_sw, int g, int lane) {
    u32x4 nb[4]; int wq[2] = {0, 0};
#pragma unroll
    for (int j = 0; j < 4; ++j) {
        const int k = g * 4 + j; const float w = readlane_f(k < 64 ? w_lo : w_hi, k & 63) * inv_sw;
        nb[j] = *(const LAS u32x4*)(sb + j * XSLOT + lane * 16); const unsigned sc = *(const LAS unsigned short*)(sb + j * XSLOT + 1024 + lane * 2);
#pragma unroll
        for (int jj = 0; jj < 2; ++jj) { const int q = (int)rintf(w * (float)((sc >> (8 * jj)) & 255u)); wq[jj] |= (q & 255) << (8 * j); }
    }
    bias[0] = __builtin_amdgcn_sdot4(wq[0], 0x01010101, bias[0], false); bias[1] = __builtin_amdgcn_sdot4(wq[1], 0x01010101, bias[1], false);
#pragma unroll
    for (int i = 0; i < 4; ++i) {
        const unsigned r0 = nb[0][i], r1 = nb[1][i], r2 = nb[2][i], r3 = nb[3][i];
        const unsigned p01a = __builtin_amdgcn_perm(r1, r0, 0x05010400u), p01b = __builtin_amdgcn_perm(r1, r0, 0x07030602u);
        const unsigned p23a = __builtin_amdgcn_perm(r3, r2, 0x05010400u), p23b = __builtin_amdgcn_perm(r3, r2, 0x07030602u);
        const unsigned t0 = __builtin_amdgcn_perm(p23a, p01a, 0x05040100u), t1 = __builtin_amdgcn_perm(p23a, p01a, 0x07060302u);
        const unsigned t2 = __builtin_amdgcn_perm(p23b, p01b, 0x05040100u), t3 = __builtin_amdgcn_perm(p23b, p01b, 0x07060302u);
        const int wv = wq[i >> 1];
        acc[i * 8 + 0] = __builtin_amdgcn_sdot4((int)(t0 & 0x0F0F0F0Fu), wv, acc[i * 8 + 0], false); acc[i * 8 + 1] = __builtin_amdgcn_sdot4((int)((t0 >> 4) & 0x0F0F0F0Fu), wv, acc[i * 8 + 1], false);
        acc[i * 8 + 2] = __builtin_amdgcn_sdot4((int)(t1 & 0x0F0F0F0Fu), wv, acc[i * 8 + 2], false); acc[i * 8 + 3] = __builtin_amdgcn_sdot4((int)((t1 >> 4) & 0x0F0F0F0Fu), wv, acc[i * 8 + 3], false);
        acc[i * 8 + 4] = __builtin_amdgcn_sdot4((int)(t2 & 0x0F0F0F0Fu), wv, acc[i * 8 + 4], false); acc[i * 8 + 5] = __builtin_amdgcn_sdot4((int)((t2 >> 4) & 0x0F0F0F0Fu), wv, acc[i * 8 + 5], false);
        acc[i * 8 + 6] = __builtin_amdgcn_sdot4((int)(t3 & 0x0F0F0F0Fu), wv, acc[i * 8 + 6], false); acc[i * 8 + 7] = __builtin_amdgcn_sdot4((int)((t3 >> 4) & 0x0F0F0F0Fu), wv, acc[i * 8 + 7], false);
    }
}
__device__ __forceinline__ void phase_experts(const Params& P, LAS unsigned char* lds) {
    const int lane = threadIdx.x & 63, wave = __builtin_amdgcn_readfirstlane(threadIdx.x >> 6);
    const bf16_t* x1b = (const bf16_t*)(P.ws + WS_X1B);
    const int* EIDX = (const int*)(P.ws + WS_EIDX); const float* GW = (const float*)(P.ws + WS_GW);
    const __amdgpu_buffer_rsrc_t UQ = __builtin_amdgcn_make_buffer_rsrc((void*)(P.ws + WS_UB), 0, NEXP * TROW, 0x00020000);
    const __amdgpu_buffer_rsrc_t VQ = __builtin_amdgcn_make_buffer_rsrc((void*)(P.ws + WS_VB), 0, NEXP * TROW, 0x00020000);
    const float* SU = (const float*)(P.ws + WS_SU); const float* SV = (const float*)(P.ws + WS_SV); const float* SX = (const float*)(P.ws + WS_SX);
    LAS unsigned char* wb = lds + wave * XWAVE;
    for (int row = blockIdx.x * 8 + wave; row < NTOK; row += gridDim.x * 8) {
        int ln = lane; asm volatile("" : "+v"(ln));
        const u32x4 xh = *(const u32x4*)(P.ws + WS_X1Q + (size_t)row * D + ln * 32), xl = *(const u32x4*)(P.ws + WS_X1Q + (size_t)row * D + ln * 32 + 16);
        const float sx = SX[row];
        const int e_lo = EIDX[(size_t)row * 128 + ln], e_hi = EIDX[(size_t)row * 128 + 64 + ln];
        const float g_lo = GW[(size_t)row * 128 + ln], g_hi = GW[(size_t)row * 128 + 64 + ln];
        const float a_lo = SU[e_lo] * sx, a_hi = SU[e_hi] * sx, b_lo = g_lo * SV[e_lo], b_hi = g_hi * SV[e_hi];
        float w_lo = 0.f, w_hi = 0.f;
        asm volatile("s_waitcnt vmcnt(0)" ::: "memory");
        dma_group(UQ, e_lo, e_hi, 0, wb, lane); dma_group(UQ, e_lo, e_hi, 1, wb + XGRP, lane); dma_group(UQ, e_lo, e_hi, 2, wb + 2 * XGRP, lane);
        int sg = 0;
#pragma unroll 1
        for (int g = 0; g < 32; ++g) {
            const int sn = (sg + 3) & 3;
            if (g + 3 < 32) dma_group(UQ, e_lo, e_hi, g + 3, wb + sn * XGRP, lane); else dma_group(VQ, e_lo, e_hi, g + 3 - 32, wb + sn * XGRP, lane);
            asm volatile("s_waitcnt vmcnt(24)" ::: "memory");
            u_consume(wb + sg * XGRP, xh, xl, a_lo, a_hi, b_lo, b_hi, g, lane, w_lo, w_hi);
            sg = (sg + 1) & 3;
        }
        float wmax = wave_max(fmaxf(fabsf(w_lo), fabsf(w_hi))); if (wmax == 0.f) wmax = 1.f;
        const float scale_w = wmax * (255.0f / 127.0f), inv_sw = 1.0f / scale_w;
        int acc[32]; int bias[2] = {0, 0};
#pragma unroll
        for (int i = 0; i < 32; ++i) acc[i] = 0;
#pragma unroll 1
        for (int g = 0; g < 32; ++g) {
            const int sn = (sg + 3) & 3;
            dma_group(VQ, e_lo, e_hi, (g + 3) & 31, wb + sn * XGRP, lane);
            asm volatile("s_waitcnt vmcnt(24)" ::: "memory");
            v_consume(wb + sg * XGRP, acc, bias, w_lo, w_hi, inv_sw, g, lane);
            sg = (sg + 1) & 3;
        }
        asm volatile("s_waitcnt vmcnt(0)" ::: "memory");
        float val[32]; float s = 0.f;
#pragma unroll
        for (int jj = 0; jj < 2; ++jj) {
            const int b8 = 8 * bias[jj];
#pragma unroll
            for (int hh = 0; hh < 2; ++hh) {
                const u32x4 xa = *(const u32x4*)(x1b + (size_t)row * D + jj * 1024 + ln * 16 + hh * 8);
#pragma unroll
                for (int i = 0; i < 4; ++i) { const int e0 = jj * 16 + hh * 8 + 2 * i;
                    val[e0] = scale_w * (float)(acc[e0] - b8) + ALPHA * bflo(xa[i]); val[e0 + 1] = scale_w * (float)(acc[e0 + 1] - b8) + ALPHA * bfhi(xa[i]); s += val[e0] + val[e0 + 1]; }
            }
        }
        const float mean = wave_sum(s) * (1.0f / D); float q = 0.f;
#pragma unroll
        for (int i = 0; i < 32; ++i) { const float d0 = val[i] - mean; q += d0 * d0; }
        const float rstd = rsqrtf(wave_sum(q) * (1.0f / D) + LN_EPS);
        float* yo = P.out + (row < NTOK_P ? O_YP + (size_t)row * D : O_YS + (size_t)(row - NTOK_P) * D);
        const int lo16 = ln * 16;
#pragma unroll
        for (int jj = 0; jj < 2; ++jj)
#pragma unroll
            for (int i = 0; i < 4; ++i) {
                const int col = jj * 1024 + lo16 + i * 4;
                const float4 g0 = *(const float4*)(P.ln2_g + col), b0 = *(const float4*)(P.ln2_b + col);
                float4 o;
                o.x = (val[jj * 16 + i * 4 + 0] - mean) * rstd * g0.x + b0.x; o.y = (val[jj * 16 + i * 4 + 1] - mean) * rstd * g0.y + b0.y;
                o.z = (val[jj * 16 + i * 4 + 2] - mean) * rstd * g0.z + b0.z; o.w = (val[jj * 16 + i * 4 + 3] - mean) * rstd * g0.w + b0.w;
                *(float4*)(yo + col) = o;
            }
    }
}

constexpr int NPHASE = 11;
__global__ void __launch_bounds__(NTHREADS, 2) fwd(Params P) {
    extern __shared__ __attribute__((aligned(16))) unsigned char lds_raw[];
    LAS unsigned char* lds = (LAS unsigned char*)lds_raw;
    volatile LAS unsigned* misc = (volatile LAS unsigned*)(lds + MISC_OFF);
    const int lo = P.ph_lo, hi = P.ph_hi;
    XcdBarrier bar; bar.bar = (unsigned*)(P.ws + WS_CTL); bar.x = 0; bar.st = nullptr;
    if (hi - lo > 1) {
        if (threadIdx.x == 0) { misc[0] = 0u; misc[1] = 0u; misc[2] = 0u; misc[3] = 0u; }
        __syncthreads();
        bar = xcd_barrier_post((unsigned*)(P.ws + WS_CTL), misc);
    }
#ifndef MK_REPMASK
#define MK_REPMASK 0
#endif
#ifndef MK_PHASE_MASK
#define MK_PHASE_MASK 0x7ff
#endif
#define IN(k) (((MK_PHASE_MASK >> (k)) & 1) && lo <= (k) && (k) < hi)
#define SEAM(k) do { if (IN(k) && IN((k) + 1)) xcd_barrier(bar); } while (0)
    if (IN(0)) { phase_prologue(P, lds); }
    SEAM(0);
    if (IN(1)) {
        pg8::Gemm g{(const pg8::bf16_t*)(P.ws + WS_XB), (const pg8::bf16_t*)(P.ws + WS_WINT), NTOK, DIN, D};
        pg8::StaticOrder S; S.init(NTOK, DIN, (int)gridDim.x, (int)blockIdx.x);
        EpiProj E{P.out, (float*)(P.ws + WS_QF), (float*)(P.ws + WS_XR), (float*)(P.ws + WS_GATE), (bf16_t*)(P.ws + WS_QB), (bf16_t*)(P.ws + WS_KB), (bf16_t*)(P.ws + WS_VB16)};
        pg8::gemm_phase<EpiProj, pg8::StaticOrder, false>(lds, g, S, E, nullptr);
    }
    SEAM(1);
    if (IN(2)) { phase_lru(P); }
    if (IN(2) && IN(3)) __syncthreads();
    if (IN(3)) { phase_samp(P, lds); }
    if (IN(4)) { phase_attn01(P, lds); }
    SEAM(4);
    if (IN(5)) { phase_mix_b(P, lds); }
    SEAM(5);
    if (IN(6)) {
        sample_rows_gemm<0>(P, (const bf16_t*)(P.ws + WS_AR), (const bf16_t*)(P.ws + WS_WOT));
        pg8::Gemm g{(const pg8::bf16_t*)(P.ws + WS_AR), (const pg8::bf16_t*)(P.ws + WS_WOT), NTOK_P, D, D};
        pg8::StaticOrder S; S.init(NTOK_P, D, (int)gridDim.x, (int)blockIdx.x);
        EpiOut E{P.x_prompt, P.x_sample, (float*)(P.ws + WS_PRE1)};
        pg8::gemm_phase<EpiOut, pg8::StaticOrder, false>(lds, g, S, E, nullptr);
    }
    SEAM(6);
    if (IN(7)) { phase_ln1(P); }
    SEAM(7);
    if (IN(8)) {
        sample_rows_gemm<1>(P, (const bf16_t*)(P.ws + WS_X1B), (const bf16_t*)(P.ws + WS_WQT));
        pg8::Gemm g{(const pg8::bf16_t*)(P.ws + WS_X1B), (const pg8::bf16_t*)(P.ws + WS_WQT), NTOK_P, D, D};
        pg8::StaticOrder S; S.init(NTOK_P, D, (int)gridDim.x, (int)blockIdx.x);
        EpiBf16Plain E{(bf16_t*)(P.ws + WS_QP), D};
        pg8::gemm_phase<EpiBf16Plain, pg8::StaticOrder, false>(lds, g, S, E, nullptr);
    }
    SEAM(8);
    if (IN(9)) { phase_route(P, lds); }
    SEAM(9);
    if (IN(10)) { phase_experts(P, lds); }
#undef IN
#undef SEAM
}
}

#ifndef MK_N_LAUNCHES
#define MK_N_LAUNCHES 1
#endif
extern "C" void kernel_launch(void* const* d_in, const int* in_sizes, int n_in, void* d_out, int out_size, void* d_ws, size_t ws_size, hipStream_t stream) {
    using namespace mk;
    static int grid = 0;
    if (grid == 0) {
        if (n_in != 23 || (size_t)out_size != O_END || ws_size < WS_END) { fprintf(stderr, "kernel_launch: unexpected shapes: n_in %d out %d ws %zu (need %zu)\n", n_in, out_size, ws_size, (size_t)WS_END); grid = -1; return; }
        int dev = 0, cus = 0, per_cu = 0;
        if (hipGetDevice(&dev) != hipSuccess || hipDeviceGetAttribute(&cus, hipDeviceAttributeMultiprocessorCount, dev) != hipSuccess) { grid = -1; return; }
        if (hipFuncSetAttribute((const void*)fwd, hipFuncAttributeMaxDynamicSharedMemorySize, LDS_BYTES) != hipSuccess) { fprintf(stderr, "kernel_launch: hipFuncSetAttribute failed\n"); grid = -1; return; }
        if (hipOccupancyMaxActiveBlocksPerMultiprocessor(&per_cu, (const void*)fwd, NTHREADS, LDS_BYTES) != hipSuccess || per_cu < 1) { fprintf(stderr, "kernel_launch: occupancy query says %d\n", per_cu); }
        (void)hipGetLastError();
        grid = cus;
    }
    if (grid < 0) return;
    (void)hipMemsetAsync((char*)d_ws + WS_CTL, 0, 65536, stream);
    Params p{};
    p.x_prompt = (const float*)d_in[0]; p.x_sample = (const float*)d_in[1]; p.cache_k = (const float*)d_in[2]; p.cache_v = (const float*)d_in[3];
    p.state_conv = (const float*)d_in[4]; p.state_h = (const float*)d_in[5]; p.w_in = (const float*)d_in[6]; p.conv_w = (const float*)d_in[7]; p.conv_b = (const float*)d_in[8];
    p.lru_w_a = (const float*)d_in[9]; p.lru_b_a = (const float*)d_in[10]; p.lru_w_x = (const float*)d_in[11]; p.lru_b_x = (const float*)d_in[12]; p.lru_lambda = (const float*)d_in[13];
    p.w_out = (const float*)d_in[14]; p.ln1_g = (const float*)d_in[15]; p.ln1_b = (const float*)d_in[16]; p.w_query = (const float*)d_in[17]; p.sub_keys = (const float*)d_in[18];
    p.peer_u = (const float*)d_in[19]; p.peer_v = (const float*)d_in[20]; p.ln2_g = (const float*)d_in[21]; p.ln2_b = (const float*)d_in[22];
    p.out = (float*)d_out; p.ws = (unsigned char*)d_ws;
#if MK_N_LAUNCHES == 1
    p.ph_lo = 0; p.ph_hi = NPHASE;
    hipLaunchKernelGGL(fwd, dim3(grid), dim3(NTHREADS), LDS_BYTES, stream, p);
#else
    for (int k = 0; k < NPHASE; ++k) { p.ph_lo = k; p.ph_hi = k + 1; hipLaunchKernelGGL(fwd, dim3(grid), dim3(NTHREADS), LDS_BYTES, stream, p);
#ifdef MK_EXTRA_PHASE
        if (k == MK_EXTRA_PHASE) hipLaunchKernelGGL(fwd, dim3(grid), dim3(NTHREADS), LDS_BYTES, stream, p);
#endif
    }
#endif
    const hipError_t le = hipPeekAtLastError();
    if (le != hipSuccess) fprintf(stderr, "kernel_launch: launch failed: %s\n", hipGetErrorName(le));
}
```

```cpp
#include <hip/hip_runtime.h>
#include <cstdio>
#include <cstdint>
namespace pg8 {
#define PG8_LAS __attribute__((address_space(3)))
typedef unsigned short bf16_t;
typedef short bf16x8 __attribute__((ext_vector_type(8)));
typedef float f32x4 __attribute__((ext_vector_type(4)));
typedef unsigned u32x4 __attribute__((ext_vector_type(4)));
constexpr int BM = 256, BK = 64, HALF = 128, HTB = HALF * BK * 2  , STAGE_BYTES = 8 * HTB, NXCD = 8, WGM = 8;

__host__ __device__ __forceinline__ int lds_byte(int r, int c) { const int st = (r >> 4) * 2 + (c >> 5), rr = r & 15, cc = c & 31, ob = rr * 64 + cc * 2; return st * 1024 + (ob ^ (((ob >> 9) & 1) << 5)); }
__host__ __device__ __forceinline__ void stage_rc(int b, int& R, int& C) { const int st = b / 1024, sb = b % 1024, swz = sb ^ (((sb >> 9) & 1) << 5); R = (st >> 1) * 16 + swz / 64; C = (st & 1) * 32 + (swz % 64) / 2; }
__host__ __device__ __forceinline__ int perm32(int rho) { const int n = rho >> 4, i = rho & 15; return 8 * (i >> 2) + 4 * n + (i & 3); }

struct Unit { int pm, pn; };
struct Gemm { const bf16_t* A; const bf16_t* Bt; int M, N, K; };

struct StaticOrder {
    int nM, nN, nwg, G, c;
    __host__ __device__ void init(int M, int N, int G_, int c_) { nM = M / BM; nN = N / BM; nwg = nM * nN; G = G_; c = c_; }
    __host__ __device__ bool next(int i, Unit& u) const {
        const long L = (long)i * G + c; if (L >= nwg) return false;
        int wgid = (int)L; { const int q = nwg / NXCD, r = nwg % NXCD, xcd = wgid % NXCD, off = wgid / NXCD; wgid = (xcd < r ? xcd * (q + 1) : r * (q + 1) + (xcd - r) * q) + off; }
        const int nig = WGM * nN, gid = wgid / nig, fm = gid * WGM, gsz = (nM - fm) < WGM ? (nM - fm) : WGM;
        u.pm = fm + ((wgid % nig) % gsz); u.pn = (wgid % nig) / gsz; return true;
    }
    __device__ __forceinline__ void a_ready(const Unit&) const {}
    __device__ __forceinline__ void done(const Unit&) const {}
};
struct CountedOrder : StaticOrder {
    const unsigned* ready; unsigned need; unsigned* tmo;
    __device__ __forceinline__ void a_ready(const Unit& u) const {
        if (threadIdx.x < 64) {
            const unsigned long long t0 = __builtin_amdgcn_s_memrealtime(); unsigned polls = 0;
            while ((unsigned)__builtin_amdgcn_readfirstlane(__hip_atomic_load(ready + 64 * u.pm, __ATOMIC_RELAXED, __HIP_MEMORY_SCOPE_AGENT)) < need) {
                if ((++polls & 255u) == 0u && __builtin_amdgcn_readfirstlane(__hip_atomic_load(tmo, __ATOMIC_RELAXED, __HIP_MEMORY_SCOPE_AGENT)) != 0u) break;
                if (__builtin_amdgcn_s_memrealtime() - t0 > 2000000ull) {
                    if (threadIdx.x == 0) { unsigned expect = 0u; __hip_atomic_compare_exchange_strong(tmo + 1, &expect, 0x600u | (unsigned)(u.pm & 0xff), __ATOMIC_RELAXED, __ATOMIC_RELAXED, __HIP_MEMORY_SCOPE_AGENT); __hip_atomic_store(tmo, 1u, __ATOMIC_RELAXED, __HIP_MEMORY_SCOPE_AGENT); }
                    break; }
                __builtin_amdgcn_s_sleep(2); }
            __builtin_amdgcn_fence(__ATOMIC_ACQUIRE, "agent");
            asm volatile("s_waitcnt vmcnt(0)" ::: "memory");
        }
#if !defined(BROKEN_HOOK_NO_BARRIER)
        asm volatile("" ::: "memory"); __builtin_amdgcn_s_barrier(); asm volatile("" ::: "memory");
#endif
    }
};

__device__ __forceinline__ unsigned cvt_pk_bf16(float lo, float hi) { unsigned r; asm volatile("v_cvt_pk_bf16_f32 %0, %1, %2" : "=v"(r) : "v"(lo), "v"(hi)); return r; }
typedef float f32x2 __attribute__((ext_vector_type(2)));
__device__ __forceinline__ f32x2 gelu_pk(f32x2 v) {
    const f32x2 av = __builtin_elementwise_abs(v), d = av * 0.2316418882f + 1.0f;
    f32x2 t; t.x = __builtin_amdgcn_rcpf(d.x); t.y = __builtin_amdgcn_rcpf(d.y);
    f32x2 q = t * 0.5307027145f + (-0.7265760135f); q = q * t + 0.7107068705f; q = q * t + (-0.142248368f); q = q * t + 0.127414796f; q = q * t;
    const f32x2 s = (v * v) * (-0.72134752044f);
    f32x2 e; e.x = __builtin_amdgcn_exp2f(s.x); e.y = __builtin_amdgcn_exp2f(s.y);
    const f32x2 m = v * (q * e), r = v - m;
    f32x2 o; o.x = v.x < 0.f ? m.x : r.x; o.y = v.y < 0.f ? m.y : r.y; return o;
}

struct EpiF32 {
    static constexpr bool PERM = false, AFTER_DRAIN = false;
    float* C; int ldc; const float* bias;
    __device__ __forceinline__ void operator()(const f32x4 (&acc)[2][2][4][2], const Unit& u, int wr, int wc, int fr, int fq) const {
        const int row0 = u.pm * BM + wr * 64 + fr, col0 = u.pn * BM + wc * 32 + 4 * fq;
        f32x4 bv[2][2];
#pragma unroll
        for (int bj = 0; bj < 2; ++bj)
#pragma unroll
            for (int n = 0; n < 2; ++n) bv[bj][n] = bias ? *(const f32x4*)(bias + col0 + bj * HALF + n * 16) : (f32x4){0.f, 0.f, 0.f, 0.f};
#pragma unroll
        for (int ai = 0; ai < 2; ++ai)
#pragma unroll
            for (int m = 0; m < 4; ++m) { float* rowp = C + (size_t)(row0 + ai * HALF + m * 16) * ldc + col0;
#pragma unroll
                for (int bj = 0; bj < 2; ++bj)
#pragma unroll
                    for (int n = 0; n < 2; ++n) *(f32x4*)(rowp + bj * HALF + n * 16) = acc[ai][bj][m][n] + bv[bj][n]; }
    }
};
template <int ACT  > struct EpiBf16 {
    static constexpr bool PERM = true, AFTER_DRAIN = false;
    bf16_t* O; int ldc; const float* bias; int split_cols; size_t split_stride;
    __device__ __forceinline__ void operator()(const f32x4 (&acc)[2][2][4][2], const Unit& u, int wr, int wc, int fr, int fq) const {
        const int row0 = u.pm * BM + wr * 64 + fr; int colt = u.pn * BM; bf16_t* base = O;
        if (split_cols) { const int t = colt / split_cols; base += (size_t)t * split_stride; colt -= t * split_cols; }
        const int col0 = colt + wc * 32 + 8 * fq, bcol0 = u.pn * BM + wc * 32 + 8 * fq;
        f32x4 bv[2][2];
#pragma unroll
        for (int bj = 0; bj < 2; ++bj)
#pragma unroll
            for (int n = 0; n < 2; ++n) bv[bj][n] = bias ? *(const f32x4*)(bias + bcol0 + bj * HALF + 4 * n) : (f32x4){0.f, 0.f, 0.f, 0.f};
#pragma unroll
        for (int ai = 0; ai < 2; ++ai)
#pragma unroll
            for (int m = 0; m < 4; ++m) { bf16_t* rowp = base + (size_t)(row0 + ai * HALF + m * 16) * ldc + col0;
#pragma unroll
                for (int bj = 0; bj < 2; ++bj) { f32x4 v0 = acc[ai][bj][m][0] + bv[bj][0], v1 = acc[ai][bj][m][1] + bv[bj][1];
                    if (ACT == 1) { f32x2 a = gelu_pk((f32x2){v0[0], v0[1]}), b = gelu_pk((f32x2){v0[2], v0[3]}), c = gelu_pk((f32x2){v1[0], v1[1]}), d = gelu_pk((f32x2){v1[2], v1[3]});
                        v0 = (f32x4){a.x, a.y, b.x, b.y}; v1 = (f32x4){c.x, c.y, d.x, d.y}; }
                    if (ACT == 2) {
#pragma unroll
                        for (int j = 0; j < 4; ++j) { v0[j] = 0.5f * v0[j] * (1.0f + erff(v0[j] * 0.70710678f)); v1[j] = 0.5f * v1[j] * (1.0f + erff(v1[j] * 0.70710678f)); } }
                    u32x4 w; w.x = cvt_pk_bf16(v0[0], v0[1]); w.y = cvt_pk_bf16(v0[2], v0[3]); w.z = cvt_pk_bf16(v1[0], v1[1]); w.w = cvt_pk_bf16(v1[2], v1[3]);
                    *(u32x4*)(rowp + bj * HALF) = w; } }
    }
};

struct PanelStats {
    unsigned* xbuf;
    unsigned* cnt;
    unsigned* tmo;
    int ntn; float eps;
    unsigned code;
    __device__ __forceinline__ bool run(const f32x4 (&v)[2][2][4][2], const Unit& u, int wr, int wc, int fr, int fq, PG8_LAS unsigned char* lds, int wid, int lane) const {
        typedef float f32x2v __attribute__((ext_vector_type(2)));
        PG8_LAS f32x2v* P = (PG8_LAS f32x2v*)lds;
        PG8_LAS f32x2v* S = (PG8_LAS f32x2v*)(lds + 8192);
        PG8_LAS unsigned* flag = (PG8_LAS unsigned*)(lds + 8192 + 2048);
#pragma unroll
        for (int ai = 0; ai < 2; ++ai)
#pragma unroll
            for (int m = 0; m < 4; ++m) {
                float s = 0.f;
#pragma unroll
                for (int bj = 0; bj < 2; ++bj)
#pragma unroll
                    for (int n = 0; n < 2; ++n) { const f32x4 x = v[ai][bj][m][n]; s += (x[0] + x[1]) + (x[2] + x[3]); }
                s += __shfl_xor(s, 16); s += __shfl_xor(s, 32);
                const float mw = s * (1.0f / 64.0f); float q = 0.f;
#pragma unroll
                for (int bj = 0; bj < 2; ++bj)
#pragma unroll
                    for (int n = 0; n < 2; ++n) { const f32x4 d = v[ai][bj][m][n] - mw; q += (d[0] * d[0] + d[1] * d[1]) + (d[2] * d[2] + d[3] * d[3]); }
                q += __shfl_xor(q, 16); q += __shfl_xor(q, 32);
                if (fq == 0) P[(ai * HALF + wr * 64 + m * 16 + fr) * 4 + wc] = (f32x2v){mw, q};
            }
        asm volatile("s_waitcnt lgkmcnt(0)" ::: "memory"); __builtin_amdgcn_s_barrier(); asm volatile("" ::: "memory");
#if defined(BROKEN_NO_WAIT)
        if (blockIdx.x >= 64) { const long long t0 = clock64(); while (clock64() - t0 < 60000) __builtin_amdgcn_s_sleep(8); }
#endif
        const int row = wid * 32 + (lane & 31);
        if (lane < 32) {
            const f32x2v a = P[row * 4 + 0], b = P[row * 4 + 1], c = P[row * 4 + 2], d = P[row * 4 + 3];
            const float mt = (a.x + b.x + c.x + d.x) * 0.25f;
            const float da = a.x - mt, db = b.x - mt, dc = c.x - mt, dd = d.x - mt;
            const float m2 = (a.y + b.y) + (c.y + d.y) + 64.0f * ((da * da + db * db) + (dc * dc + dd * dd));
            unsigned long long* slot = (unsigned long long*)xbuf + ((size_t)(u.pm * BM + row) * 4 + u.pn);
            __hip_atomic_store(slot, ((unsigned long long)__float_as_uint(m2) << 32) | __float_as_uint(mt), __ATOMIC_RELAXED, __HIP_MEMORY_SCOPE_AGENT);
        }
        asm volatile("s_waitcnt vmcnt(0)" ::: "memory");
        if (lane == 0) __hip_atomic_fetch_add(cnt + 64 * u.pm, 1u, __ATOMIC_RELAXED, __HIP_MEMORY_SCOPE_AGENT);
        if (wid == 0) {
            bool dead = false; const unsigned long long t0 = __builtin_amdgcn_s_memrealtime(); const unsigned want = 8u * (unsigned)ntn;
            for (;;) {
#if defined(BROKEN_NO_WAIT)
                break;
#endif
                if ((unsigned)__builtin_amdgcn_readfirstlane(__hip_atomic_load(cnt + 64 * u.pm, __ATOMIC_RELAXED, __HIP_MEMORY_SCOPE_AGENT)) >= want) break;
                if (__builtin_amdgcn_s_memrealtime() - t0 > 2000000ull) {
                    if (lane == 0) { unsigned expect = 0u; __hip_atomic_compare_exchange_strong(tmo + 1, &expect, code | (unsigned)(u.pm & 0xff), __ATOMIC_RELAXED, __ATOMIC_RELAXED, __HIP_MEMORY_SCOPE_AGENT);
                                     __hip_atomic_store(tmo, 1u, __ATOMIC_RELAXED, __HIP_MEMORY_SCOPE_AGENT); }
                    dead = true; break; }
                __builtin_amdgcn_s_sleep(2);
            }
            __builtin_amdgcn_fence(__ATOMIC_ACQUIRE, "agent");
            if (lane == 0) flag[0] = dead ? 1u : 0u;
        }
        asm volatile("s_waitcnt vmcnt(0) lgkmcnt(0)" ::: "memory"); __builtin_amdgcn_s_barrier(); asm volatile("" ::: "memory");
        const bool bad = flag[0] != 0u;
        if (lane < 32) {
            const unsigned long long* slot = (const unsigned long long*)xbuf + (size_t)(u.pm * BM + row) * 4; float mt[4], m2[4]; float ms = 0.f;
#pragma unroll
            for (int t = 0; t < 4; ++t) { if (t < ntn) { const unsigned long long w = __hip_atomic_load(slot + t, __ATOMIC_RELAXED, __HIP_MEMORY_SCOPE_AGENT); mt[t] = __uint_as_float((unsigned)w); m2[t] = __uint_as_float((unsigned)(w >> 32)); } else { mt[t] = 0.f; m2[t] = 0.f; } ms += mt[t]; }
            const float mean = ms / (float)ntn; float q = 0.f;
#pragma unroll
            for (int t = 0; t < 4; ++t) if (t < ntn) { const float dm = mt[t] - mean; q += m2[t] + 256.0f * dm * dm; }
            S[row] = (f32x2v){mean, 1.0f / sqrtf(q / (256.0f * (float)ntn) + eps)};
        }
        asm volatile("s_waitcnt lgkmcnt(0)" ::: "memory"); __builtin_amdgcn_s_barrier(); asm volatile("" ::: "memory");
        return bad;
    }
};
struct EpiLnRes {
    static constexpr bool PERM = false, AFTER_DRAIN = true;
    const float* base; float* out; int ldc; const float* bias; PanelStats st; unsigned poison;
    __device__ __forceinline__ void refuse(size_t i0, size_t stride, int M, int N) const { const float q = __builtin_nanf(""); for (size_t i = i0; i < (size_t)M * N; i += stride) out[(i / N) * ldc + i % N] = q;
        if (i0 == 0) { unsigned expect = 0u; __hip_atomic_compare_exchange_strong(st.tmo + 1, &expect, 0x7f0u, __ATOMIC_RELAXED, __ATOMIC_RELAXED, __HIP_MEMORY_SCOPE_AGENT); __hip_atomic_store(st.tmo, 1u, __ATOMIC_RELAXED, __HIP_MEMORY_SCOPE_AGENT); } }
    __device__ __forceinline__ void fused(f32x4 (&acc)[2][2][4][2], const Unit& u, int wr, int wc, int fr, int fq, PG8_LAS unsigned char* lds, int wid, int lane) const {
        typedef float f32x2v __attribute__((ext_vector_type(2)));
        const PG8_LAS f32x2v* S = (const PG8_LAS f32x2v*)(lds + 8192);
        const int col0 = u.pn * BM + wc * 32 + 4 * fq;
#pragma unroll
        for (int bj = 0; bj < 2; ++bj)
#pragma unroll
            for (int n = 0; n < 2; ++n) { const f32x4 bv = bias ? *(const f32x4*)(bias + col0 + bj * HALF + n * 16) : (f32x4){0.f, 0.f, 0.f, 0.f};
#pragma unroll
                for (int ai = 0; ai < 2; ++ai)
#pragma unroll
                    for (int m = 0; m < 4; ++m) acc[ai][bj][m][n] += bv; }
        const bool bad = st.run(acc, u, wr, wc, fr, fq, lds, wid, lane) || poison != 0u;
        const float qnan = __builtin_nanf("");
#pragma unroll
        for (int ai = 0; ai < 2; ++ai)
#pragma unroll
            for (int m = 0; m < 4; ++m) { const int r = ai * HALF + wr * 64 + m * 16 + fr; const f32x2v sr = S[r]; const size_t off = (size_t)(u.pm * BM + r) * ldc + col0;
#pragma unroll
                for (int bj = 0; bj < 2; ++bj)
#pragma unroll
                    for (int n = 0; n < 2; ++n) { const f32x4 bs = *(const f32x4*)(base + off + bj * HALF + n * 16); f32x4 o = bs + (acc[ai][bj][m][n] - sr.x) * sr.y;
                        if (bad) o = (f32x4){qnan, qnan, qnan, qnan}; *(f32x4*)(out + off + bj * HALF + n * 16) = o; }
                asm volatile("" ::: "memory"); }
    }
};
struct EpiLnResLn {
    static constexpr bool PERM = false, AFTER_DRAIN = true;
    const float* base; float* out; bf16_t* xn; int ldc; const float* bias; PanelStats st1, st2; unsigned poison;
    __device__ __forceinline__ void refuse(size_t i0, size_t stride, int M, int N) const { const float q = __builtin_nanf(""); for (size_t i = i0; i < (size_t)M * N; i += stride) { const size_t o = (i / N) * ldc + i % N; out[o] = q; xn[o] = (bf16_t)0x7fc0u; }
        if (i0 == 0) { unsigned expect = 0u; __hip_atomic_compare_exchange_strong(st1.tmo + 1, &expect, 0x7f0u, __ATOMIC_RELAXED, __ATOMIC_RELAXED, __HIP_MEMORY_SCOPE_AGENT); __hip_atomic_store(st1.tmo, 1u, __ATOMIC_RELAXED, __HIP_MEMORY_SCOPE_AGENT); } }
    __device__ __forceinline__ void fused(f32x4 (&acc)[2][2][4][2], const Unit& u, int wr, int wc, int fr, int fq, PG8_LAS unsigned char* lds, int wid, int lane) const {
        typedef float f32x2v __attribute__((ext_vector_type(2))); typedef unsigned u32x2v __attribute__((ext_vector_type(2)));
        const PG8_LAS f32x2v* S = (const PG8_LAS f32x2v*)(lds + 8192);
        const int col0 = u.pn * BM + wc * 32 + 4 * fq;
#pragma unroll
        for (int bj = 0; bj < 2; ++bj)
#pragma unroll
            for (int n = 0; n < 2; ++n) { const f32x4 bv = bias ? *(const f32x4*)(bias + col0 + bj * HALF + n * 16) : (f32x4){0.f, 0.f, 0.f, 0.f};
#pragma unroll
                for (int ai = 0; ai < 2; ++ai)
#pragma unroll
                    for (int m = 0; m < 4; ++m) acc[ai][bj][m][n] += bv; }
        bool bad = st1.run(acc, u, wr, wc, fr, fq, lds, wid, lane) || poison != 0u;
        const float qnan = __builtin_nanf("");
#pragma unroll
        for (int ai = 0; ai < 2; ++ai)
#pragma unroll
            for (int m = 0; m < 4; ++m) { const int r = ai * HALF + wr * 64 + m * 16 + fr; const f32x2v sr = S[r]; const size_t off = (size_t)(u.pm * BM + r) * ldc + col0;
#pragma unroll
                for (int bj = 0; bj < 2; ++bj)
#pragma unroll
                    for (int n = 0; n < 2; ++n) { const f32x4 bs = *(const f32x4*)(base + off + bj * HALF + n * 16); acc[ai][bj][m][n] = bs + (acc[ai][bj][m][n] - sr.x) * sr.y; }
                asm volatile("" : "+v"(acc[ai][0][m][0]), "+v"(acc[ai][0][m][1]), "+v"(acc[ai][1][m][0]), "+v"(acc[ai][1][m][1]));
                if (m & 1) asm volatile("" ::: "memory"); }
        const bool bad1 = bad;
        bad = st2.run(acc, u, wr, wc, fr, fq, lds, wid, lane) || bad;
#pragma unroll
        for (int ai = 0; ai < 2; ++ai)
#pragma unroll
            for (int m = 0; m < 4; ++m) { const int r = ai * HALF + wr * 64 + m * 16 + fr; const f32x2v sr = S[r]; const size_t off = (size_t)(u.pm * BM + r) * ldc + col0;
#pragma unroll
                for (int bj = 0; bj < 2; ++bj)
#pragma unroll
                    for (int n = 0; n < 2; ++n) { const f32x4 x1 = acc[ai][bj][m][n]; *(f32x4*)(out + off + bj * HALF + n * 16) = bad1 ? (f32x4){qnan, qnan, qnan, qnan} : x1;
                        const f32x4 o = (x1 - sr.x) * sr.y; u32x2v w; w.x = cvt_pk_bf16(o[0], o[1]); w.y = cvt_pk_bf16(o[2], o[3]);
                        if (bad) { w.x = 0x7fc07fc0u; w.y = 0x7fc07fc0u; } *(u32x2v*)(xn + off + bj * HALF + n * 16) = w; }
                asm volatile("" ::: "memory"); }
    }
};

template <class Epi, class Sched, bool STAMP = false>
__device__ __forceinline__ void gemm_phase(PG8_LAS unsigned char* lds, const Gemm g, const Sched& S, const Epi& E, unsigned long long* stamps) {
    const int tid = threadIdx.x, wid = __builtin_amdgcn_readfirstlane(tid >> 6), lane = tid & 63, wr = wid >> 2, wc = wid & 3, fr = lane & 15, fq = lane >> 4;
    const int K = g.K, nt = K / BK;
    int ts_lo = 0, ts_hi = 0, nts = 0; const unsigned long long rt_entry = STAMP ? (unsigned long long)wall_clock64() : 0ull;
#define PG8_STAMP() do { if (STAMP && wid == 0 && nts < 64) { const unsigned long long _c = (unsigned long long)clock64(); \
        ts_lo = (lane == nts) ? (int)(unsigned)_c : ts_lo; ts_hi = (lane == nts) ? (int)(unsigned)(_c >> 32) : ts_hi; ++nts; } } while (0)
    PG8_STAMP();
    unsigned voffA[2], voffB[2];
#pragma unroll
    for (int i = 0; i < 2; ++i) { int R, C; stage_rc(tid * 16 + i * 8192, R, C); const int Rb = Epi::PERM ? ((R & ~31) + perm32(R & 31)) : R;
        voffA[i] = (unsigned)(R * K + C) * 2u; voffB[i] = (unsigned)(Rb * K + C) * 2u; }
    const size_t kstep = (size_t)(BK * 2);
    const size_t hstep = (size_t)HALF * K * 2;
    const size_t tstep = 2 * hstep;
    const unsigned ldsw = (unsigned)wid * 1024u;
    const int aoff = lds_byte(wr * 64 + fr, fq * 8), boff = lds_byte(wc * 32 + fr, fq * 8);
#define PG8_SA(b, h) (((b) * 2 + (h)) * HTB)
#define PG8_SB(b, h) ((4 + (b) * 2 + (h)) * HTB)
#define PG8_STAGE(bufoff, gbase, voff) do { _Pragma("unroll") for (int _i = 0; _i < 2; ++_i) \
        __builtin_amdgcn_global_load_lds((const unsigned*)((const char*)(gbase) + (voff)[_i]), (PG8_LAS unsigned*)(lds + (bufoff) + ldsw + _i * 8192), 16, 0, 0); } while (0)
#define PG8_LDA(dst, b, h) do { _Pragma("unroll") for (int m = 0; m < 4; ++m) _Pragma("unroll") for (int k = 0; k < 2; ++k) dst[m][k] = *(const PG8_LAS bf16x8*)(lds + PG8_SA(b, h) + aoff + m * 2048 + k * 1024); } while (0)
#define PG8_LDB(dst, b, h) do { _Pragma("unroll") for (int n = 0; n < 2; ++n) _Pragma("unroll") for (int k = 0; k < 2; ++k) dst[n][k] = *(const PG8_LAS bf16x8*)(lds + PG8_SB(b, h) + boff + n * 2048 + k * 1024); } while (0)
#define PG8_MMA(ai, bj, At, Bt) do { __builtin_amdgcn_s_setprio(1); _Pragma("unroll") for (int m = 0; m < 4; ++m) _Pragma("unroll") for (int n = 0; n < 2; ++n) _Pragma("unroll") for (int k = 0; k < 2; ++k) \
        acc[ai][bj][m][n] = __builtin_amdgcn_mfma_f32_16x16x32_bf16(Bt[n][k], At[m][k], acc[ai][bj][m][n], 0, 0, 0); __builtin_amdgcn_s_setprio(0); } while (0)
#define PG8_WAIT_V(n) asm volatile("s_waitcnt vmcnt(" #n ")" ::: "memory")
#define PG8_WAIT_L(n) asm volatile("s_waitcnt lgkmcnt(" #n ")" ::: "memory")
#define PG8_BAR __builtin_amdgcn_s_barrier()
#define PG8_SCHED __builtin_amdgcn_sched_barrier(0)
    Unit cur, nxt; int ui = 0;
    if (!S.next(0, cur)) return;
    f32x4 acc[2][2][4][2];
#pragma unroll
    for (int a = 0; a < 2; ++a)
#pragma unroll
        for (int b = 0; b < 2; ++b)
#pragma unroll
            for (int m = 0; m < 4; ++m)
#pragma unroll
                for (int n = 0; n < 2; ++n) acc[a][b][m][n] = (f32x4){0.f, 0.f, 0.f, 0.f};
    bf16x8 At[4][2], B0[2][2], B1[2][2];
    const char* cA = (const char*)g.A + (size_t)cur.pm * tstep; const char* cB = (const char*)g.Bt + (size_t)cur.pn * tstep;
    S.a_ready(cur);
    PG8_STAGE(PG8_SB(0, 0), cB, voffB); PG8_STAGE(PG8_SA(0, 0), cA, voffA); PG8_STAGE(PG8_SB(0, 1), cB + hstep, voffB); PG8_STAGE(PG8_SA(0, 1), cA + hstep, voffA);
    if (wr == 1) PG8_BAR;
    PG8_WAIT_V(4); PG8_BAR;
    PG8_STAGE(PG8_SB(1, 0), cB + kstep, voffB); PG8_STAGE(PG8_SA(1, 0), cA + kstep, voffA); PG8_STAGE(PG8_SB(1, 1), cB + hstep + kstep, voffB);
    PG8_WAIT_V(6); PG8_BAR;
    PG8_STAMP();
    for (;;) {
        const bool has_next = S.next(ui + 1, nxt);
        const char* nA = has_next ? (const char*)g.A + (size_t)nxt.pm * tstep : cA; const char* nB = has_next ? (const char*)g.Bt + (size_t)nxt.pn * tstep : cB;
        for (int t = 0; t < nt; t += 2) {
            const bool last = (t == nt - 2);
            const char* a1 = cA + (size_t)(t + 1) * kstep;
            const char* a2 = last ? nA : cA + (size_t)(t + 2) * kstep; const char* b2 = last ? nB : cB + (size_t)(t + 2) * kstep;
            const char* a3 = a2 + kstep; const char* b3 = b2 + kstep;
            if (last && has_next) S.a_ready(nxt);
            PG8_LDB(B0, 0, 0); PG8_SCHED; PG8_LDA(At, 0, 0); PG8_STAGE(PG8_SA(1, 1), a1 + hstep, voffA);
            PG8_WAIT_L(8); PG8_BAR; PG8_WAIT_L(0); PG8_MMA(0, 0, At, B0); PG8_BAR; PG8_SCHED;
            PG8_LDB(B1, 0, 1); PG8_STAGE(PG8_SB(0, 0), b2, voffB);
            PG8_BAR; PG8_WAIT_L(0); PG8_MMA(0, 1, At, B1); PG8_BAR;
            PG8_LDA(At, 0, 1); PG8_STAGE(PG8_SA(0, 0), a2, voffA);
            PG8_BAR; PG8_WAIT_L(0); PG8_MMA(1, 0, At, B0); PG8_BAR; PG8_SCHED;
            PG8_STAGE(PG8_SB(0, 1), b2 + hstep, voffB);
            PG8_WAIT_V(6); PG8_BAR; PG8_MMA(1, 1, At, B1); PG8_BAR;
            PG8_LDB(B0, 1, 0); PG8_SCHED; PG8_LDA(At, 1, 0); PG8_STAGE(PG8_SA(0, 1), a2 + hstep, voffA);
            PG8_WAIT_L(8); PG8_BAR; PG8_WAIT_L(0); PG8_MMA(0, 0, At, B0); PG8_BAR; PG8_SCHED;
            PG8_LDB(B1, 1, 1); PG8_STAGE(PG8_SB(1, 0), b3, voffB);
            PG8_BAR; PG8_WAIT_L(0); PG8_MMA(0, 1, At, B1); PG8_BAR;
            PG8_LDA(At, 1, 1); PG8_STAGE(PG8_SA(1, 0), a3, voffA);
            PG8_BAR; PG8_WAIT_L(0); PG8_MMA(1, 0, At, B0); PG8_BAR; PG8_SCHED;
            PG8_STAGE(PG8_SB(1, 1), b3 + hstep, voffB);
            PG8_WAIT_V(6); PG8_BAR; PG8_MMA(1, 1, At, B1); PG8_BAR;
        }
        PG8_STAMP();
        if constexpr (!Epi::AFTER_DRAIN) { E(acc, cur, wr, wc, fr, fq); S.done(cur); }
        PG8_STAMP();
        if (!has_next) break;
#pragma unroll
        for (int a = 0; a < 2; ++a)
#pragma unroll
            for (int b = 0; b < 2; ++b)
#pragma unroll
                for (int m = 0; m < 4; ++m)
#pragma unroll
                    for (int n = 0; n < 2; ++n) acc[a][b][m][n] = (f32x4){0.f, 0.f, 0.f, 0.f};
        cur = nxt; cA = nA; cB = nB; ++ui;
    }
    PG8_WAIT_V(0);
    if (wr == 0) PG8_BAR;
    PG8_BAR;
    if constexpr (Epi::AFTER_DRAIN) { E.fused(acc, cur, wr, wc, fr, fq, lds, wid, lane); S.done(cur); }
    PG8_STAMP();
    if (STAMP && wid == 0) { stamps[lane] = lane < nts ? (((unsigned long long)(unsigned)ts_hi << 32) | (unsigned)ts_lo) : 0ull;
        if (lane == 62) stamps[62] = rt_entry; if (lane == 63) stamps[63] = (unsigned long long)wall_clock64(); }
#undef PG8_STAMP
#undef PG8_SA
#undef PG8_SB
#undef PG8_STAGE
#undef PG8_LDA
#undef PG8_LDB
#undef PG8_MMA
#undef PG8_WAIT_V
#undef PG8_WAIT_L
#undef PG8_BAR
#undef PG8_SCHED
}
}
#define XB_TMO      128
#define XB_XCNT(j)  (256  + 64 * (j))
#define XB_XSUB(j)  (1280 + 64 * (j))
#define XB_XGEN(j)  (2304 + 64 * (j))
#define XB_TOP      3328
#define XB_TOPGEN   3392
#define XCD_BAR_WORDS 3456
#define XB_SPIN_CAP (1u << 18)
#define LAS __attribute__((address_space(3)))

__device__ __forceinline__ unsigned xb_ld(unsigned* p)              { return __hip_atomic_load(p, __ATOMIC_RELAXED, __HIP_MEMORY_SCOPE_AGENT); }
__device__ __forceinline__ unsigned xb_add(unsigned* p, unsigned v) { return __hip_atomic_fetch_add(p, v, __ATOMIC_RELAXED, __HIP_MEMORY_SCOPE_AGENT); }
__device__ __forceinline__ unsigned xb_xcc_id() { return (unsigned)__builtin_amdgcn_s_getreg((3 << 11) | 20) & 0xFu; }
#define XB_SPIN(cond, bar) do { unsigned _sp = 0; while (cond) { __builtin_amdgcn_s_sleep(1); \
    if ((++_sp & 255u) == 0u) { if (xb_ld(&(bar)[XB_TMO])) break; if (_sp > XB_SPIN_CAP) { atomicAdd(&(bar)[XB_TMO], 1u); break; } } } } while (0)

struct XcdBarrier {
    unsigned* bar; unsigned x;
    volatile LAS unsigned* st;
};

__device__ __forceinline__ XcdBarrier xcd_barrier_post(unsigned* bar, volatile LAS unsigned* st) {
    XcdBarrier b; b.bar = bar; b.x = xb_xcc_id(); b.st = st;
    if (threadIdx.x == 0) (void)xb_add(&bar[XB_XCNT(b.x)], 1u);
    return b;
}
__device__ __forceinline__ void xcd_barrier_complete(unsigned* bar, unsigned x, unsigned& nloc, unsigned& nx) {
    const unsigned G = gridDim.x * gridDim.y * gridDim.z;
    unsigned sum, cnt, mine, sp = 0u;
    for (;;) {
        sum = 0u; cnt = 0u; mine = 0u;
#pragma unroll
        for (unsigned j = 0; j < 16; ++j) { const unsigned c = xb_ld(&bar[XB_XCNT(j)]); sum += c; cnt += (c > 0u) ? 1u : 0u; mine = (j == x) ? c : mine; }
        if (sum == G) break;
        __builtin_amdgcn_s_sleep(1);
        if ((++sp & 255u) == 0u) { if (xb_ld(&bar[XB_TMO])) break; if (sp > XB_SPIN_CAP) { atomicAdd(&bar[XB_TMO], 1u); break; } }
    }
    nloc = mine > 0u ? mine : 1u; nx = cnt > 0u ? cnt : 1u;
}

__device__ __forceinline__ void xcd_barrier(const XcdBarrier& b) {
    asm volatile("s_waitcnt vmcnt(0)" ::: "memory");
    __syncthreads();
    if (threadIdx.x == 0) {
        unsigned* bar = b.bar;
        __builtin_amdgcn_s_waitcnt(0);
        unsigned nloc = b.st[0], nx = b.st[1];
        if (nloc == 0u) { xcd_barrier_complete(bar, b.x, nloc, nx); b.st[0] = nloc; b.st[1] = nx; }
        const unsigned old = xb_add(&bar[XB_XSUB(b.x)], 1u);
        const unsigned gen = old / nloc;
        if (old + 1u == (gen + 1u) * nloc) {
            __builtin_amdgcn_fence(__ATOMIC_RELEASE, "agent");
            asm volatile("s_waitcnt vmcnt(0)" ::: "memory");
            const unsigned og = xb_add(&bar[XB_TOP], 1u);
            const unsigned tg = og / nx;
            if (og + 1u == (tg + 1u) * nx) xb_add(&bar[XB_TOPGEN], 1u);
            else XB_SPIN(xb_ld(&bar[XB_TOPGEN]) == tg, bar);
            __builtin_amdgcn_fence(__ATOMIC_ACQUIRE, "agent");
            xb_add(&bar[XB_XGEN(b.x)], 1u);
            asm volatile("s_waitcnt vmcnt(0)" ::: "memory");
        } else {
            XB_SPIN(xb_ld(&bar[XB_XGEN(b.x)]) == gen, bar);
            __builtin_amdgcn_fence(__ATOMIC_ACQUIRE, "agent");
            asm volatile("s_waitcnt vmcnt(0)" ::: "memory");
        }
    }
    __syncthreads();
}


#ifndef MK_N_LAUNCHES
#define MK_N_LAUNCHES 1
#endif
namespace mk {
typedef unsigned short bf16_t;
typedef float f32x4 __attribute__((ext_vector_type(4)));
typedef short bf16x8 __attribute__((ext_vector_type(8)));
typedef short s16x4 __attribute__((ext_vector_type(4)));
typedef unsigned u32x4 __attribute__((ext_vector_type(4)));
typedef unsigned u32x2 __attribute__((ext_vector_type(2)));
typedef float f32x2 __attribute__((ext_vector_type(2)));
constexpr int D = 2048, NTOK_P = 16384, NTOK_S = 256, NTOK = 16640;
constexpr int DIN = 5632, DATT = 1536, DLRU = 512, NH = 12, HD = 128;
constexpr int NEXP = 16384;
constexpr float ALPHA = 1.189207115002721f;
constexpr float LN_EPS = 1e-5f;
constexpr float ATT_SCALE = 0.08838834764831845f;
constexpr float LOG2E = 1.4426950408889634f;
constexpr size_t O_YP = 0, O_YS = 33554432, O_KP = 34078720, O_VP = 59244544, O_CP = 84410368, O_HP = 84422656,
                 O_KS = 84426752, O_VS = 185090048, O_CS = 285753344, O_HS = 285802496, O_END = 285818880;
constexpr size_t WS_CTL = 0;
constexpr size_t WS_XB = 65536;
constexpr size_t WS_WINT = WS_XB + (size_t)NTOK * D * 2;
constexpr size_t WS_WOT = WS_WINT + (size_t)DIN * D * 2;
constexpr size_t WS_WQT = WS_WOT + (size_t)D * D * 2;
constexpr size_t WS_UB = WS_WQT + (size_t)D * D * 2;
constexpr size_t WS_VB = WS_UB + (size_t)NEXP * D * 2;
constexpr size_t WS_QF = WS_VB + (size_t)NEXP * D * 2;
constexpr size_t WS_XR = WS_QF + (size_t)NTOK * DATT * 4;
constexpr size_t WS_GATE = WS_XR + (size_t)NTOK * DLRU * 4;
constexpr size_t WS_AR = WS_GATE + (size_t)NTOK * DLRU * 4;
constexpr size_t WS_PRE1 = WS_AR + (size_t)NTOK * D * 2;
constexpr size_t WS_X1F = WS_PRE1 + (size_t)NTOK * D * 4;
constexpr size_t WS_X1B = WS_X1F + (size_t)NTOK * D * 4;
constexpr size_t WS_QP = WS_X1B + (size_t)NTOK * D * 2;
constexpr size_t WS_EIDX = WS_QP + (size_t)NTOK * D * 4;
constexpr size_t WS_GW = WS_EIDX + (size_t)NTOK * 128 * 4;
constexpr size_t WS_SU = WS_GW + (size_t)NTOK * 128 * 4;
constexpr size_t WS_SV = WS_SU + (size_t)NEXP * 4;
constexpr size_t WS_SX = WS_SV + (size_t)NEXP * 4;
constexpr size_t WS_X1Q = WS_SX + (size_t)NTOK * 4;
constexpr size_t WS_SKB = WS_X1Q + (size_t)NTOK * D;
constexpr size_t WS_QB = WS_SKB + (size_t)8 * 2 * 128 * 128 * 2;
constexpr size_t WS_KB = WS_QB + (size_t)NTOK * DATT * 2;
constexpr size_t WS_VB16 = WS_KB + (size_t)NTOK_P * DATT * 2;
constexpr size_t WS_PO = WS_VB16 + (size_t)NTOK_P * DATT * 2;
constexpr size_t WS_PM = WS_PO + (size_t)2 * NTOK_P * DATT * 2;
constexpr size_t WS_PL = WS_PM + (size_t)2 * NTOK_P * NH * 4;
constexpr size_t WS_R0 = WS_PL + (size_t)2 * NTOK_P * NH * 4;
constexpr size_t WS_R1 = WS_R0 + (size_t)NTOK_P * DLRU * 4;
constexpr size_t WS_HE = WS_R1 + (size_t)NTOK_P * DLRU * 4;
constexpr size_t WS_AE = WS_HE + (size_t)8 * 32 * 512 * 4;
constexpr size_t WS_PS = WS_AE + (size_t)8 * 32 * 512 * 4;
constexpr size_t WS_END = WS_PS + (size_t)32 * 12 * 9 * 8 * 130 * 4;

constexpr int NTHREADS = 512;
constexpr int LDS_BYTES = 148480;
constexpr int MISC_OFF = 147456;

struct Params {
    const float* x_prompt; const float* x_sample; const float* cache_k; const float* cache_v; const float* state_conv; const float* state_h;
    const float* w_in; const float* conv_w; const float* conv_b; const float* lru_w_a; const float* lru_b_a; const float* lru_w_x; const float* lru_b_x;
    const float* lru_lambda; const float* w_out; const float* ln1_g; const float* ln1_b; const float* w_query; const float* sub_keys;
    const float* peer_u; const float* peer_v; const float* ln2_g; const float* ln2_b;
    float* out; unsigned char* ws; int ph_lo, ph_hi;
};

__device__ __forceinline__ unsigned f2bf(float f) { unsigned u = __float_as_uint(f); u += 0x7fffu + ((u >> 16) & 1u); return u >> 16; }
__device__ __forceinline__ unsigned pack2(float a, float b) { return f2bf(a) | (f2bf(b) << 16); }
__device__ __forceinline__ float bflo(unsigned w) { return __uint_as_float(w << 16); }
__device__ __forceinline__ float bfhi(unsigned w) { return __uint_as_float(w & 0xffff0000u); }
__device__ __forceinline__ float wave_sum(float v) {
#pragma unroll
    for (int o = 32; o >= 1; o >>= 1) v += __shfl_xor(v, o);
    return v;
}
__device__ __forceinline__ float wave_max(float v) {
#pragma unroll
    for (int o = 32; o >= 1; o >>= 1) v = fmaxf(v, __shfl_xor(v, o));
    return v;
}
__device__ __forceinline__ float gelu_exact(float v) { return 0.5f * v * (1.0f + erff(v * 0.7071067811865476f)); }
__device__ __forceinline__ float gelu_as(float v) {
    const float av = fabsf(v), t = __builtin_amdgcn_rcpf(av * 0.2316418882f + 1.0f);
    float q = t * 0.5307027145f + (-0.7265760135f); q = q * t + 0.7107068705f; q = q * t + (-0.142248368f); q = q * t + 0.127414796f; q = q * t;
    const float e = __builtin_amdgcn_exp2f((v * v) * (-0.72134752044f));
    const float m = v * (q * e);
    return v < 0.f ? m : v - m;
}
__device__ __forceinline__ float sigmoidf(float v) { return 1.0f / (1.0f + expf(-v)); }
__device__ __forceinline__ float readlane_f(float v, int l) { return __int_as_float(__builtin_amdgcn_readlane(__float_as_int(v), l)); }

__device__ __forceinline__ void convert_flat(const float* src, bf16_t* dst, size_t n8, size_t gtid, size_t gstride) {
    for (size_t i = gtid; i < n8; i += gstride) {
        const float4 a = ((const float4*)src)[2 * i], b = ((const float4*)src)[2 * i + 1];
        uint4 w; w.x = pack2(a.x, a.y); w.y = pack2(a.z, a.w); w.z = pack2(b.x, b.y); w.w = pack2(b.z, b.w);
        ((uint4*)dst)[i] = w;
    }
}
__device__ __forceinline__ void transpose_convert(const float* src, bf16_t* dst, int K, int N, LAS float* tile) {
    const int tid = threadIdx.x, ntn = N / 64, ntiles = (K / 64) * ntn;
    for (int tl = blockIdx.x; tl < ntiles; tl += gridDim.x) {
        const int kt = tl / ntn, nt = tl - kt * ntn;
#pragma unroll
        for (int i = 0; i < 8; ++i) { const int r = (tid >> 6) + 8 * i, c = tid & 63; tile[r * 65 + c] = src[(size_t)(kt * 64 + r) * N + nt * 64 + c]; }
        __syncthreads();
#pragma unroll
        for (int i = 0; i < 4; ++i) { const int n = (tid >> 5) + 16 * i, k0 = 2 * (tid & 31);
            const unsigned v = pack2(tile[k0 * 65 + n], tile[(k0 + 1) * 65 + n]);
            *(unsigned*)(dst + (size_t)(nt * 64 + n) * K + kt * 64 + k0) = v; }
        __syncthreads();
    }
}
constexpr int TROW = 1152;
__device__ __forceinline__ void quant_tables(const Params& P) {
    const int lane = threadIdx.x & 63, gw = blockIdx.x * 8 + (threadIdx.x >> 6), nw = gridDim.x * 8;
    for (int it = gw; it < 2 * NEXP; it += nw) {
        const bool isv = it >= NEXP; const int row = isv ? it - NEXP : it;
        const float* src = (isv ? P.peer_v : P.peer_u) + (size_t)row * D;
        float4 v[8]; float cm[2];
#pragma unroll
        for (int j = 0; j < 2; ++j) { float am = 0.f;
#pragma unroll
            for (int i = 0; i < 4; ++i) { const float4 t = *(const float4*)(src + j * 1024 + lane * 16 + i * 4); v[j * 4 + i] = t; am = fmaxf(am, fmaxf(fmaxf(fabsf(t.x), fabsf(t.y)), fmaxf(fabsf(t.z), fabsf(t.w)))); }
            cm[j] = am; }
        float rm = wave_max(fmaxf(cm[0], cm[1])); if (rm == 0.f) rm = 1.f;
        unsigned char* dst = P.ws + (isv ? WS_VB : WS_UB) + (size_t)row * TROW;
        u32x4 w; unsigned sqp = 0u;
#pragma unroll
        for (int j = 0; j < 2; ++j) {
            int sq = (int)ceilf(cm[j] / rm * 255.0f); sq = sq < 1 ? 1 : (sq > 255 ? 255 : sq);
            sqp |= (unsigned)sq << (8 * j);
            const float inv = (255.0f * 7.0f) / (rm * (float)sq);
#pragma unroll
            for (int hh = 0; hh < 2; ++hh) { unsigned dw = 0u;
#pragma unroll
                for (int e = 0; e < 8; ++e) { const float4 t = v[j * 4 + hh * 2 + (e >> 2)]; const float x = (e & 3) == 0 ? t.x : ((e & 3) == 1 ? t.y : ((e & 3) == 2 ? t.z : t.w));
                    int n = (int)rintf(x * inv); n = n < -7 ? -7 : (n > 7 ? 7 : n); dw |= (unsigned)(isv ? n + 8 : (n & 15)) << (4 * e); }
                w[j * 2 + hh] = dw; }
        }
        *(u32x4*)(dst + lane * 16) = w;
        *(unsigned short*)(dst + 1024 + lane * 2) = (unsigned short)sqp;
        if (lane == 0) ((float*)(P.ws + (isv ? WS_SV : WS_SU)))[row] = rm * (1.0f / (255.0f * 7.0f));
    }
}
__device__ __forceinline__ void phase_prologue(const Params& P, LAS unsigned char* lds) {
    const size_t gtid = (size_t)blockIdx.x * NTHREADS + threadIdx.x, gstride = (size_t)gridDim.x * NTHREADS;
    unsigned char* ws = P.ws;
    convert_flat(P.x_prompt, (bf16_t*)(ws + WS_XB), (size_t)NTOK_P * D / 8, gtid, gstride);
    convert_flat(P.x_sample, (bf16_t*)(ws + WS_XB) + (size_t)NTOK_P * D, (size_t)NTOK_S * D / 8, gtid, gstride);
    convert_flat(P.sub_keys, (bf16_t*)(ws + WS_SKB), (size_t)8 * 2 * 128 * 128 / 8, gtid, gstride);
    transpose_convert(P.w_in, (bf16_t*)(ws + WS_WINT), D, DIN, (LAS float*)lds);
    transpose_convert(P.w_out, (bf16_t*)(ws + WS_WOT), D, D, (LAS float*)lds);
    transpose_convert(P.w_query, (bf16_t*)(ws + WS_WQT), D, D, (LAS float*)lds);
}

struct EpiProj {
    static constexpr bool PERM = false, AFTER_DRAIN = false;
    float* out; float* QF; float* XR; float* GATE; bf16_t* QB; bf16_t* KB; bf16_t* VB16;
    __device__ __forceinline__ void operator()(const f32x4 (&acc)[2][2][4][2], const pg8::Unit& u, int wr, int wc, int fr, int fq) const {
        const int pn = u.pn; const int coff = wc * 32 + 4 * fq;
#pragma unroll
        for (int ai = 0; ai < 2; ++ai)
#pragma unroll
            for (int m = 0; m < 4; ++m) {
                const int row = u.pm * 256 + ai * 128 + wr * 64 + m * 16 + fr;
                const bool prompt = row < NTOK_P;
                float* rowp = nullptr; bf16_t* rowb = nullptr; float bsc = 1.0f;
                if (pn < 6) { rowb = QB + (size_t)row * DATT + pn * 256; bsc = ATT_SCALE * LOG2E; }
                else if (pn < 18) {
                    const int isv = pn >= 12; const int c0 = (pn - (isv ? 12 : 6)) * 256;
                    if (prompt) { rowp = out + (isv ? O_VP : O_KP) + (size_t)row * DATT + c0; rowb = (isv ? VB16 : KB) + (size_t)row * DATT + c0; }
                    else { const int rr = row - NTOK_P, b = rr >> 3, t = rr & 7; rowp = out + (isv ? O_VS : O_KS) + ((size_t)b * 2048 + 2040 + t) * DATT + c0; }
                } else if (pn < 20) rowp = XR + (size_t)row * DLRU + (pn - 18) * 256;
                else rowp = GATE + (size_t)row * DLRU + (pn - 20) * 256;
#pragma unroll
                for (int bj = 0; bj < 2; ++bj)
#pragma unroll
                    for (int n = 0; n < 2; ++n) {
                        const f32x4 v = acc[ai][bj][m][n];
                        if (rowp) *(f32x4*)(rowp + coff + bj * 128 + n * 16) = v;
                        if (rowb) { u32x2 w; w.x = pg8::cvt_pk_bf16(v[0] * bsc, v[1] * bsc); w.y = pg8::cvt_pk_bf16(v[2] * bsc, v[3] * bsc); *(u32x2*)(rowb + coff + bj * 128 + n * 16) = w; }
                    }
            }
    }
};
struct EpiOut {
    static constexpr bool PERM = false, AFTER_DRAIN = false;
    const float* xp; const float* xs; float* pre;
    __device__ __forceinline__ void operator()(const f32x4 (&acc)[2][2][4][2], const pg8::Unit& u, int wr, int wc, int fr, int fq) const {
        const int col0 = u.pn * 256 + wc * 32 + 4 * fq;
#pragma unroll
        for (int ai = 0; ai < 2; ++ai)
#pragma unroll
            for (int m = 0; m < 4; ++m) {
                const int row = u.pm * 256 + ai * 128 + wr * 64 + m * 16 + fr;
                const float* xr = (row < NTOK_P ? xp + (size_t)row * D : xs + (size_t)(row - NTOK_P) * D) + col0;
                float* pr = pre + (size_t)row * D + col0;
#pragma unroll
                for (int bj = 0; bj < 2; ++bj)
#pragma unroll
                    for (int n = 0; n < 2; ++n) { const f32x4 xv = *(const f32x4*)(xr + bj * 128 + n * 16); *(f32x4*)(pr + bj * 128 + n * 16) = xv * ALPHA + acc[ai][bj][m][n]; }
            }
    }
};
struct EpiPlain {
    static constexpr bool PERM = false, AFTER_DRAIN = false;
    float* C; int ldc;
    __device__ __forceinline__ void operator()(const f32x4 (&acc)[2][2][4][2], const pg8::Unit& u, int wr, int wc, int fr, int fq) const {
        const int col0 = u.pn * 256 + wc * 32 + 4 * fq;
#pragma unroll
        for (int ai = 0; ai < 2; ++ai)
#pragma unroll
            for (int m = 0; m < 4; ++m) {
                const int row = u.pm * 256 + ai * 128 + wr * 64 + m * 16 + fr;
                float* pr = C + (size_t)row * ldc + col0;
#pragma unroll
                for (int bj = 0; bj < 2; ++bj)
#pragma unroll
                    for (int n = 0; n < 2; ++n) *(f32x4*)(pr + bj * 128 + n * 16) = acc[ai][bj][m][n];
            }
    }
};

struct EpiBf16Plain {
    static constexpr bool PERM = false, AFTER_DRAIN = false;
    bf16_t* C; int ldc;
    __device__ __forceinline__ void operator()(const f32x4 (&acc)[2][2][4][2], const pg8::Unit& u, int wr, int wc, int fr, int fq) const {
        const int col0 = u.pn * 256 + wc * 32 + 4 * fq;
#pragma unroll
        for (int ai = 0; ai < 2; ++ai)
#pragma unroll
            for (int m = 0; m < 4; ++m) {
                const int row = u.pm * 256 + ai * 128 + wr * 64 + m * 16 + fr;
                bf16_t* pr = C + (size_t)row * ldc + col0;
#pragma unroll
                for (int bj = 0; bj < 2; ++bj)
#pragma unroll
                    for (int n = 0; n < 2; ++n) { const f32x4 v = acc[ai][bj][m][n]; u32x2 w; w.x = pg8::cvt_pk_bf16(v[0], v[1]); w.y = pg8::cvt_pk_bf16(v[2], v[3]); *(u32x2*)(pr + bj * 128 + n * 16) = w; }
            }
    }
};

template <int MODE>
__device__ __forceinline__ void sample_rows_gemm(const Params& P, const bf16_t* A, const bf16_t* Wt, LAS unsigned char* lds) {
    const int tid = threadIdx.x, lane = tid & 63, w = __builtin_amdgcn_readfirstlane(tid >> 6);
    const int c = lane & 15, g = lane >> 4;
    for (int tile = blockIdx.x; tile < 256; tile += gridDim.x) {
        const int tg = tile & 7, cg = tile >> 3;
        const int k0 = 256 * w;
        const bf16_t* wp = Wt + (size_t)(64 * cg + c) * D + k0 + 8 * g;
        const bf16_t* xp = A + (size_t)(NTOK_P + 32 * tg + c) * D + k0 + 8 * g;
        f32x4 acc[4][2];
#pragma unroll
        for (int ct = 0; ct < 4; ++ct) { acc[ct][0] = (f32x4){0.f, 0.f, 0.f, 0.f}; acc[ct][1] = (f32x4){0.f, 0.f, 0.f, 0.f}; }
#pragma unroll 4
        for (int ks = 0; ks < 8; ++ks) {
            bf16x8 wf[4], xf[2];
#pragma unroll
            for (int ct = 0; ct < 4; ++ct) wf[ct] = *(const bf16x8*)(wp + (size_t)(16 * ct) * D + 32 * ks);
#pragma unroll
            for (int tt = 0; tt < 2; ++tt) xf[tt] = *(const bf16x8*)(xp + (size_t)(16 * tt) * D + 32 * ks);
#pragma unroll
            for (int ct = 0; ct < 4; ++ct)
#pragma unroll
                for (int tt = 0; tt < 2; ++tt) acc[ct][tt] = __builtin_amdgcn_mfma_f32_16x16x32_bf16(wf[ct], xf[tt], acc[ct][tt], 0, 0, 0);
        }
        LAS float* part = (LAS float*)lds;
#pragma unroll
        for (int ct = 0; ct < 4; ++ct)
#pragma unroll
            for (int tt = 0; tt < 2; ++tt) *(LAS f32x4*)(part + ((w * 32 + 16 * tt + c) * 64 + 16 * ct + 4 * g)) = acc[ct][tt];
        __syncthreads();
        {
            const int tok = tid >> 4, c4 = (tid & 15) * 4;
            f32x4 sum = {0.f, 0.f, 0.f, 0.f};
#pragma unroll
            for (int ww = 0; ww < 8; ++ww) sum += *(const LAS f32x4*)(part + ((ww * 32 + tok) * 64 + c4));
            const int row = NTOK_P + 32 * tg + tok, col = 64 * cg + c4;
            if (MODE == 0) { const f32x4 xv = *(const f32x4*)(P.x_sample + (size_t)(row - NTOK_P) * D + col); *(f32x4*)((float*)(P.ws + WS_PRE1) + (size_t)row * D + col) = xv * ALPHA + sum; }
            else { u32x2 wv; wv.x = pg8::cvt_pk_bf16(sum[0], sum[1]); wv.y = pg8::cvt_pk_bf16(sum[2], sum[3]); *(u32x2*)((bf16_t*)(P.ws + WS_QP) + (size_t)row * D + col) = wv; }
        }
        __syncthreads();
    }
}

constexpr int KVS = 288, VOFF = 73728;
template <int MODE>
__device__ __forceinline__ void attn_unit(const Params& P, int p, int b, int h, int r, int c, LAS unsigned char* lds) {
    const int tid = threadIdx.x, lane = tid & 63, w = __builtin_amdgcn_readfirstlane(tid >> 6);
    const int dil = 1 << (2 * p);
    const bf16_t* Qb = (const bf16_t*)(P.ws + WS_QB); const bf16_t* Kb = (const bf16_t*)(P.ws + WS_KB); const bf16_t* Vb = (const bf16_t*)(P.ws + WS_VB16);
    const size_t tok0 = (size_t)b * 2048;
    const int j0 = 128 * c - 128, rho0 = (c == 0) ? 128 : 0;
#pragma unroll
    for (int it = 0; it < 8; ++it) {
        const int rho = it * 32 + (tid >> 4), ch = tid & 15;
        if (rho >= rho0) {
            const size_t tok = tok0 + (size_t)((j0 + rho) * dil + r);
            const u32x4 kv = *(const u32x4*)(Kb + tok * DATT + h * HD + ch * 8);
            const u32x4 vv = *(const u32x4*)(Vb + tok * DATT + h * HD + ch * 8);
            *(LAS u32x4*)(lds + rho * KVS + ch * 16) = kv;
            *(LAS u32x4*)(lds + VOFF + rho * KVS + ch * 16) = vv;
        }
    }
    const int cq = lane & 15, g = lane >> 4;
    const int iq = 128 * c + 16 * w + cq;
    const size_t qtok = tok0 + (size_t)(iq * dil + r);
    bf16x8 qf[4];
#pragma unroll
    for (int ks = 0; ks < 4; ++ks) qf[ks] = *(const bf16x8*)(Qb + qtok * DATT + h * HD + 32 * ks + 8 * g);
    __syncthreads();
    const int ktmin = (8 - w - 8 * c) > 0 ? (8 - w - 8 * c) : 0;
    const float slope2 = exp2f(-8.0f * (float)(h + 1) / 12.0f) * LOG2E * (float)dil;
    f32x4 s[9]; float m = -INFINITY;
#pragma unroll
    for (int kt = 0; kt < 9; ++kt) {
        if (kt >= ktmin) {
            f32x4 acc = {0.f, 0.f, 0.f, 0.f};
#pragma unroll
            for (int ks = 0; ks < 4; ++ks) { const bf16x8 kf = *(const LAS bf16x8*)(lds + (16 * w + 16 * kt + cq) * KVS + (32 * ks + 8 * g) * 2); acc = __builtin_amdgcn_mfma_f32_16x16x32_bf16(kf, qf[ks], acc, 0, 0, 0); }
#pragma unroll
            for (int ii = 0; ii < 4; ++ii) { const int dist = cq + 128 - 16 * kt - 4 * g - ii; float v = acc[ii] - slope2 * (float)dist;
                if (kt == 0 && dist > 128) v = -INFINITY; if (kt == 8 && dist < 0) v = -INFINITY; acc[ii] = v; m = fmaxf(m, v); }
            s[kt] = acc;
        } else s[kt] = (f32x4){-INFINITY, -INFINITY, -INFINITY, -INFINITY};
    }
    m = fmaxf(m, __shfl_xor(m, 16)); m = fmaxf(m, __shfl_xor(m, 32));
    float l = 0.f;
#pragma unroll
    for (int kt = 0; kt < 9; ++kt)
#pragma unroll
        for (int ii = 0; ii < 4; ++ii) { const float pp = exp2f(s[kt][ii] - m); s[kt][ii] = pp; l += pp; }
    l += __shfl_xor(l, 16); l += __shfl_xor(l, 32);
    f32x4 o[8];
#pragma unroll
    for (int dt = 0; dt < 8; ++dt) o[dt] = (f32x4){0.f, 0.f, 0.f, 0.f};
#pragma unroll
    for (int kk = 0; kk < 5; ++kk) {
        const int T0 = 2 * kk, T1 = 2 * kk + 1;
        if (T1 >= ktmin || T0 == 8) {
            u32x4 pw; pw.x = pg8::cvt_pk_bf16(s[T0][0], s[T0][1]); pw.y = pg8::cvt_pk_bf16(s[T0][2], s[T0][3]);
            if (T1 <= 8) { pw.z = pg8::cvt_pk_bf16(s[T1 <= 8 ? T1 : 8][0], s[T1 <= 8 ? T1 : 8][1]); pw.w = pg8::cvt_pk_bf16(s[T1 <= 8 ? T1 : 8][2], s[T1 <= 8 ? T1 : 8][3]); } else { pw.z = 0u; pw.w = 0u; }
            const bf16x8 pf = __builtin_bit_cast(bf16x8, pw);
            const int rT0 = (T0 >= ktmin) ? T0 : 8, rT1 = (T1 <= 8 && T1 >= ktmin) ? T1 : 8;
            const int a0 = VOFF + (16 * w + 16 * rT0 + 4 * g + (cq >> 2)) * KVS + 8 * (cq & 3);
            const int a1 = VOFF + (16 * w + 16 * rT1 + 4 * g + (cq >> 2)) * KVS + 8 * (cq & 3);
#pragma unroll
            for (int dt = 0; dt < 8; ++dt) {
                const s16x4 v0 = __builtin_amdgcn_ds_read_tr16_b64_v4i16((LAS s16x4*)(lds + a0 + dt * 32));
                const s16x4 v1 = __builtin_amdgcn_ds_read_tr16_b64_v4i16((LAS s16x4*)(lds + a1 + dt * 32));
                const bf16x8 vf = {v0[0], v0[1], v0[2], v0[3], v1[0], v1[1], v1[2], v1[3]};
                o[dt] = __builtin_amdgcn_mfma_f32_16x16x32_bf16(vf, pf, o[dt], 0, 0, 0);
            }
        }
    }
    const float inv = 1.0f / l;
    if (MODE == 0) {
        bf16_t* po = (bf16_t*)(P.ws + WS_PO) + ((size_t)p * NTOK_P + qtok) * DATT + h * HD + 4 * g;
#pragma unroll
        for (int dt = 0; dt < 8; ++dt) { u32x2 wv; wv.x = pg8::cvt_pk_bf16(o[dt][0] * inv, o[dt][1] * inv); wv.y = pg8::cvt_pk_bf16(o[dt][2] * inv, o[dt][3] * inv); *(u32x2*)(po + 16 * dt) = wv; }
        if (g == 0) { ((float*)(P.ws + WS_PM))[((size_t)p * NTOK_P + qtok) * NH + h] = m; ((float*)(P.ws + WS_PL))[((size_t)p * NTOK_P + qtok) * NH + h] = l; }
    } else {
        const float* PM = (const float*)(P.ws + WS_PM); const float* PL = (const float*)(P.ws + WS_PL);
        const float m0 = PM[qtok * NH + h], l0 = PL[qtok * NH + h], m1 = PM[((size_t)NTOK_P + qtok) * NH + h], l1 = PL[((size_t)NTOK_P + qtok) * NH + h];
        const float M = fmaxf(m, fmaxf(m0, m1));
        const float w2 = exp2f(m - M), w0 = exp2f(m0 - M) * l0, w1 = exp2f(m1 - M) * l1;
        const float rden = 1.0f / (w2 * l + w0 + w1);
        const bf16_t* p0 = (const bf16_t*)(P.ws + WS_PO) + qtok * DATT + h * HD + 4 * g;
        const bf16_t* p1 = p0 + (size_t)NTOK_P * DATT;
        bf16_t* ar = (bf16_t*)(P.ws + WS_AR) + qtok * D + h * HD + 4 * g;
#pragma unroll
        for (int dt = 0; dt < 8; ++dt) {
            const u32x2 x0 = *(const u32x2*)(p0 + 16 * dt), x1 = *(const u32x2*)(p1 + 16 * dt);
            const float r0 = (w2 * o[dt][0] + w0 * bflo(x0.x) + w1 * bflo(x1.x)) * rden, r1 = (w2 * o[dt][1] + w0 * bfhi(x0.x) + w1 * bfhi(x1.x)) * rden;
            const float r2 = (w2 * o[dt][2] + w0 * bflo(x0.y) + w1 * bflo(x1.y)) * rden, r3 = (w2 * o[dt][3] + w0 * bfhi(x0.y) + w1 * bfhi(x1.y)) * rden;
            u32x2 wv; wv.x = pg8::cvt_pk_bf16(r0, r1); wv.y = pg8::cvt_pk_bf16(r2, r3); *(u32x2*)(ar + 16 * dt) = wv;
        }
    }
    __syncthreads();
}

__device__ __forceinline__ void samp_unit(const Params& P, int b, int h, int k, LAS unsigned char* lds) {
    const int tid = threadIdx.x, lane = tid & 63, w = __builtin_amdgcn_readfirstlane(tid >> 6);
    const int cq = lane & 15, g = lane >> 4;
    if (k < 8) {
#pragma unroll 4
        for (int it = 0; it < 16; ++it) {
            const int rho = it * 16 + (tid >> 5), ch4 = tid & 31, c = 256 * k + rho;
            const size_t so = ((size_t)(b * 2048 + c)) * DATT + h * HD + ch4 * 4;
            const float4 kf = *(const float4*)(P.cache_k + so), vf = *(const float4*)(P.cache_v + so);
            if (c >= 8) { const size_t od = ((size_t)(b * 2048 + c - 8)) * DATT + h * HD + ch4 * 4; *(float4*)(P.out + O_KS + od) = kf; *(float4*)(P.out + O_VS + od) = vf; }
            u32x2 kw, vw; kw.x = pg8::cvt_pk_bf16(kf.x, kf.y); kw.y = pg8::cvt_pk_bf16(kf.z, kf.w); vw.x = pg8::cvt_pk_bf16(vf.x, vf.y); vw.y = pg8::cvt_pk_bf16(vf.z, vf.w);
            *(LAS u32x2*)(lds + rho * KVS + ch4 * 8) = kw; *(LAS u32x2*)(lds + VOFF + rho * KVS + ch4 * 8) = vw;
        }
    } else {
        const int rho = tid >> 5, ch4 = tid & 31;
        u32x2 kw = {0u, 0u}, vw = {0u, 0u};
        if (rho < 8) { const size_t so = ((size_t)(b * 2048 + 2040 + rho)) * DATT + h * HD + ch4 * 4; const float4 kf = *(const float4*)(P.out + O_KS + so), vf = *(const float4*)(P.out + O_VS + so);
            kw.x = pg8::cvt_pk_bf16(kf.x, kf.y); kw.y = pg8::cvt_pk_bf16(kf.z, kf.w); vw.x = pg8::cvt_pk_bf16(vf.x, vf.y); vw.y = pg8::cvt_pk_bf16(vf.z, vf.w); }
        *(LAS u32x2*)(lds + rho * KVS + ch4 * 8) = kw; *(LAS u32x2*)(lds + VOFF + rho * KVS + ch4 * 8) = vw;
        *(LAS u32x2*)(lds + (16 + rho) * KVS + ch4 * 8) = (u32x2){0u, 0u}; *(LAS u32x2*)(lds + VOFF + (16 + rho) * KVS + ch4 * 8) = (u32x2){0u, 0u};
    }
    const int t = cq & 7;
    const bf16_t* Qb = (const bf16_t*)(P.ws + WS_QB) + ((size_t)(NTOK_P + b * 8 + t)) * DATT + h * HD;
    bf16x8 qf[4];
#pragma unroll
    for (int ks = 0; ks < 4; ++ks) qf[ks] = *(const bf16x8*)(Qb + 32 * ks + 8 * g);
    __syncthreads();
    const float slope2 = exp2f(-8.0f * (float)(h + 1) / 12.0f) * LOG2E;
    const bool active = (k < 8) || (w == 0);
    f32x4 s[2]; float m = -INFINITY;
#pragma unroll
    for (int j = 0; j < 2; ++j) {
        f32x4 acc = {0.f, 0.f, 0.f, 0.f};
        if (active) {
#pragma unroll
            for (int ks = 0; ks < 4; ++ks) { const bf16x8 kf = *(const LAS bf16x8*)(lds + (32 * w + 16 * j + cq) * KVS + (32 * ks + 8 * g) * 2); acc = __builtin_amdgcn_mfma_f32_16x16x32_bf16(kf, qf[ks], acc, 0, 0, 0); }
        }
#pragma unroll
        for (int ii = 0; ii < 4; ++ii) {
            const int c = 256 * k + 32 * w + 16 * j + 4 * g + ii, dist = 2048 + t - c;
            int mult = (dist <= 128 ? 1 : 0) + (((dist & 3) == 0 && dist <= 512) ? 1 : 0) + (((dist & 15) == 0 && dist <= 2048) ? 1 : 0);
            if (dist < 0 || !active || c > 2055) mult = 0;
            const float v = mult ? acc[ii] - slope2 * (float)dist : -INFINITY;
            acc[ii] = v; m = fmaxf(m, v);
            s[j][ii] = (float)mult;
            s[j][ii] = v;
        }
    }
    m = fmaxf(m, __shfl_xor(m, 16)); m = fmaxf(m, __shfl_xor(m, 32));
    const float mref = (m == -INFINITY) ? 0.f : m;
    float l = 0.f;
#pragma unroll
    for (int j = 0; j < 2; ++j)
#pragma unroll
        for (int ii = 0; ii < 4; ++ii) {
            const int c = 256 * k + 32 * w + 16 * j + 4 * g + ii, dist = 2048 + t - c;
            const int mult = (dist <= 128 ? 1 : 0) + (((dist & 3) == 0 && dist <= 512) ? 1 : 0) + (((dist & 15) == 0 && dist <= 2048) ? 1 : 0);
            const float pp = (float)mult * exp2f(s[j][ii] - mref); s[j][ii] = pp; l += pp; }
    l += __shfl_xor(l, 16); l += __shfl_xor(l, 32);
    f32x4 o[8];
    {
        u32x4 pw; pw.x = pg8::cvt_pk_bf16(s[0][0], s[0][1]); pw.y = pg8::cvt_pk_bf16(s[0][2], s[0][3]); pw.z = pg8::cvt_pk_bf16(s[1][0], s[1][1]); pw.w = pg8::cvt_pk_bf16(s[1][2], s[1][3]);
        const bf16x8 pf = __builtin_bit_cast(bf16x8, pw);
        const int rw = active ? w : 0;
        const int a0 = VOFF + (32 * rw + 4 * g + (cq >> 2)) * KVS + 8 * (cq & 3), a1 = a0 + 16 * KVS;
#pragma unroll
        for (int dt = 0; dt < 8; ++dt) {
            const s16x4 v0 = __builtin_amdgcn_ds_read_tr16_b64_v4i16((LAS s16x4*)(lds + a0 + dt * 32));
            const s16x4 v1 = __builtin_amdgcn_ds_read_tr16_b64_v4i16((LAS s16x4*)(lds + a1 + dt * 32));
            const bf16x8 vf = {v0[0], v0[1], v0[2], v0[3], v1[0], v1[1], v1[2], v1[3]};
            o[dt] = __builtin_amdgcn_mfma_f32_16x16x32_bf16(vf, pf, (f32x4){0.f, 0.f, 0.f, 0.f}, 0, 0, 0);
        }
    }
    __syncthreads();
    LAS float* OL = (LAS float*)lds;
    LAS float* ML = (LAS float*)(lds + 32768);
    if (cq < 8) {
#pragma unroll
        for (int dt = 0; dt < 8; ++dt) *(LAS f32x4*)(OL + (w * 8 + cq) * 128 + 16 * dt + 4 * g) = o[dt];
        if (g == 0) { ML[(w * 8 + cq) * 2 + 0] = m; ML[(w * 8 + cq) * 2 + 1] = l; }
    }
    __syncthreads();
    {
        const int q = w; float M = -INFINITY;
#pragma unroll
        for (int ww = 0; ww < 8; ++ww) M = fmaxf(M, ML[(ww * 8 + q) * 2]);
        const float Mr = (M == -INFINITY) ? 0.f : M;
        float L = 0.f, o0 = 0.f, o1 = 0.f;
#pragma unroll
        for (int ww = 0; ww < 8; ++ww) { const float f = exp2f(ML[(ww * 8 + q) * 2] - Mr); L += f * ML[(ww * 8 + q) * 2 + 1];
            o0 += f * OL[(ww * 8 + q) * 128 + 2 * lane]; o1 += f * OL[(ww * 8 + q) * 128 + 2 * lane + 1]; }
        float* ps = (float*)(P.ws + WS_PS) + ((((size_t)(b * NH + h)) * 9 + k) * 8 + q) * 130;
        if (lane == 0) { ps[0] = M; ps[1] = L; }
        *(float2*)(ps + 2 + 2 * lane) = make_float2(o0, o1);
    }
    __syncthreads();
}
__device__ __forceinline__ void samp_merge_unit(const Params& P, int b, int t, int h, int lane) {
    const float* ps = (const float*)(P.ws + WS_PS) + ((size_t)(b * NH + h)) * 9 * 8 * 130 + (size_t)t * 130;
    float M = -INFINITY;
#pragma unroll
    for (int k = 0; k < 9; ++k) M = fmaxf(M, ps[(size_t)k * 8 * 130]);
    float L = 0.f, o0 = 0.f, o1 = 0.f;
#pragma unroll
    for (int k = 0; k < 9; ++k) { const float* pk = ps + (size_t)k * 8 * 130; const float f = exp2f(pk[0] - M); L += f * pk[1]; const float2 ov = *(const float2*)(pk + 2 + 2 * lane); o0 += f * ov.x; o1 += f * ov.y; }
    const float inv = 1.0f / L;
    bf16_t* ar = (bf16_t*)(P.ws + WS_AR) + ((size_t)(NTOK_P + b * 8 + t)) * D + h * HD;
    *(unsigned*)(ar + 2 * lane) = pack2(o0 * inv, o1 * inv);
}

__device__ __forceinline__ void lru_unit(const Params& P, bool samp, int b, int n, int k, int lane) {
    const int T = samp ? 8 : 64; const int row0 = samp ? NTOK_P + b * 8 : b * 2048 + k * 64; const int ch = n * 64 + lane;
    float wa[64], wx[64];
#pragma unroll
    for (int c = 0; c < 64; ++c) { wa[c] = P.lru_w_a[(n * 64 + c) * 64 + lane]; wx[c] = P.lru_w_x[(n * 64 + c) * 64 + lane]; }
    const float ba = P.lru_b_a[ch], bx = P.lru_b_x[ch], lam = P.lru_lambda[ch];
    const float sp = log1pf(expf(-lam));
    const float cw0 = P.conv_w[ch], cw1 = P.conv_w[512 + ch], cw2 = P.conv_w[1024 + ch], cw3 = P.conv_w[1536 + ch], cb = P.conv_b[ch];
    const float* XR = (const float*)(P.ws + WS_XR); const float* GT = (const float*)(P.ws + WS_GATE);
    float* R0 = (float*)(P.ws + WS_R0); float* R1 = (float*)(P.ws + WS_R1); bf16_t* AR = (bf16_t*)(P.ws + WS_AR);
    float x0 = 0.f, x1 = 0.f, x2 = 0.f, h = 0.f, A = 1.f;
    if (samp) { x0 = P.state_conv[(b * 3 + 0) * 512 + ch]; x1 = P.state_conv[(b * 3 + 1) * 512 + ch]; x2 = P.state_conv[(b * 3 + 2) * 512 + ch]; h = P.state_h[b * 512 + ch]; }
    else if (k > 0) { x0 = XR[(size_t)(row0 - 3) * DLRU + ch]; x1 = XR[(size_t)(row0 - 2) * DLRU + ch]; x2 = XR[(size_t)(row0 - 1) * DLRU + ch]; }
    for (int t0 = 0; t0 < T; t0 += 8) {
        float xin[8], gt[8];
#pragma unroll
        for (int i = 0; i < 8; ++i) { xin[i] = XR[(size_t)(row0 + t0 + i) * DLRU + ch]; gt[i] = GT[(size_t)(row0 + t0 + i) * DLRU + ch]; }
#pragma unroll
        for (int i = 0; i < 8; ++i) {
            const float xc = ((x0 * cw0 + x1 * cw1) + x2 * cw2) + xin[i] * cw3 + cb;
            x0 = x1; x1 = x2; x2 = xin[i];
            float ra = 0.f, ri = 0.f;
#pragma unroll
            for (int c = 0; c < 64; ++c) { const float xcc = readlane_f(xc, c); ra += xcc * wa[c]; ri += xcc * wx[c]; if ((c & 15) == 15) __builtin_amdgcn_sched_barrier(0); }
            const float rr = sigmoidf(ra + ba), ig = sigmoidf(ri + bx);
            const float log_a = -8.0f * rr * sp; const float a = expf(log_a);
            const float u = sqrtf(-expm1f(2.0f * log_a)) * (ig * xc);
            h = a * h + u; A = a * A;
            const float ge = gelu_exact(gt[i]);
            if (samp) AR[(size_t)(row0 + t0 + i) * D + DATT + ch] = (bf16_t)f2bf(h * ge);
            else { R0[(size_t)(row0 + t0 + i) * DLRU + ch] = h * ge; R1[(size_t)(row0 + t0 + i) * DLRU + ch] = A * ge; }
        }
    }
    if (samp) { P.out[O_HS + (size_t)b * 512 + ch] = h; float* co = P.out + O_CS + (size_t)b * 3 * 512 + ch; co[0] = x0; co[512] = x1; co[1024] = x2; }
    else {
        ((float*)(P.ws + WS_HE))[((size_t)(b * 32 + k)) * 512 + ch] = h; ((float*)(P.ws + WS_AE))[((size_t)(b * 32 + k)) * 512 + ch] = A;
        if (k == 31) { float* co = P.out + O_CP + (size_t)b * 3 * 512 + ch; co[0] = x0; co[512] = x1; co[1024] = x2; }
    }
}

__device__ __forceinline__ void phase_lru(const Params& P) {
    const int lane = threadIdx.x & 63, wave = __builtin_amdgcn_readfirstlane(threadIdx.x >> 6);
    const int gw = blockIdx.x * 8 + wave, nw = gridDim.x * 8;
#pragma unroll 1
    for (int pass = 0; pass < 2; ++pass) {
        if ((pass ^ (wave & 1)) == 0) {
            for (int u = gw; u < 2048 + 256; u += nw) { const bool samp = u >= 2048; const int v = samp ? u - 2048 : u; lru_unit(P, samp, samp ? (v >> 3) : (v >> 8), samp ? (v & 7) : ((v >> 5) & 7), v & 31, lane); }
        } else quant_tables(P);
    }
}
__device__ __forceinline__ void phase_samp(const Params& P, LAS unsigned char* lds) {
    for (int u = blockIdx.x; u < 384 * 9; u += gridDim.x) { const int k = u % 9, bh = u / 9; samp_unit(P, bh / NH, bh % NH, k, lds); }
}
__device__ __forceinline__ void phase_attn01(const Params& P, LAS unsigned char* lds) {
    for (int u = blockIdx.x; u < 3072; u += gridDim.x) {
        const int p = u / 1536, rem = u - p * 1536, bh = rem >> 4, rc = rem & 15;
        const int b = bh / NH, h = bh - b * NH;
        const int r = p == 0 ? 0 : (rc >> 2), c = p == 0 ? rc : (rc & 3);
        attn_unit<0>(P, p, b, h, r, c, lds);
    }
}
__device__ __forceinline__ void phase_mix_b(const Params& P, LAS unsigned char* lds) {
    {
        const int gt = blockIdx.x * NTHREADS + threadIdx.x;
        for (int i = gt; i < 8 * 32 * 512; i += gridDim.x * NTHREADS) {
            const int ch = i & 511, k = (i >> 9) & 31, b = i >> 14;
            const float* HE = (const float*)(P.ws + WS_HE) + (size_t)b * 32 * 512 + ch; const float* AE = (const float*)(P.ws + WS_AE) + (size_t)b * 32 * 512 + ch;
            float hin = 0.f;
            for (int kk = 0; kk < k; ++kk) hin = HE[kk * 512] + AE[kk * 512] * hin;
            const float* R0 = (const float*)(P.ws + WS_R0) + (size_t)(b * 2048 + k * 64) * DLRU + ch; const float* R1 = (const float*)(P.ws + WS_R1) + (size_t)(b * 2048 + k * 64) * DLRU + ch;
            bf16_t* ar = (bf16_t*)(P.ws + WS_AR) + (size_t)(b * 2048 + k * 64) * D + DATT + ch;
#pragma unroll 8
            for (int t = 0; t < 64; ++t) ar[(size_t)t * D] = (bf16_t)f2bf(R0[(size_t)t * DLRU] + R1[(size_t)t * DLRU] * hin);
            if (k == 31) P.out[O_HP + (size_t)b * 512 + ch] = HE[31 * 512] + AE[31 * 512] * hin;
        }
    }
    { const int lane = threadIdx.x & 63, gw = blockIdx.x * 8 + (threadIdx.x >> 6);
      for (int u = gw; u < NTOK_S * NH; u += gridDim.x * 8) { const int row = u / NH, h = u - row * NH; samp_merge_unit(P, row >> 3, row & 7, h, lane); } }
    for (int u = blockIdx.x; u < 1536; u += gridDim.x) {
        const int bh = u >> 4, r = u & 15; const int b = bh / NH, h = bh - b * NH;
        attn_unit<1>(P, 2, b, h, r, 0, lds);
    }
}

__device__ __forceinline__ void phase_ln1(const Params& P) {
    const int lane = threadIdx.x & 63, wave = threadIdx.x >> 6;
    const float* pre = (const float*)(P.ws + WS_PRE1); bf16_t* x1b = (bf16_t*)(P.ws + WS_X1B);
    for (int row = blockIdx.x * 8 + wave; row < NTOK; row += gridDim.x * 8) {
        float4 v[8]; float s = 0.f;
#pragma unroll
        for (int j = 0; j < 8; ++j) { v[j] = *(const float4*)(pre + (size_t)row * D + (j >> 2) * 1024 + lane * 16 + (j & 3) * 4); s += (v[j].x + v[j].y) + (v[j].z + v[j].w); }
        const float mean = wave_sum(s) * (1.0f / D); float q = 0.f;
#pragma unroll
        for (int j = 0; j < 8; ++j) { const float a = v[j].x - mean, b = v[j].y - mean, c = v[j].z - mean, d = v[j].w - mean; q += (a * a + b * b) + (c * c + d * d); }
        const float rstd = rsqrtf(wave_sum(q) * (1.0f / D) + LN_EPS);
        float am = 0.f;
#pragma unroll
        for (int j = 0; j < 8; ++j) { const int col = (j >> 2) * 1024 + lane * 16 + (j & 3) * 4; const float4 g = *(const float4*)(P.ln1_g + col), bb = *(const float4*)(P.ln1_b + col);
            float4 o; o.x = (v[j].x - mean) * rstd * g.x + bb.x; o.y = (v[j].y - mean) * rstd * g.y + bb.y; o.z = (v[j].z - mean) * rstd * g.z + bb.z; o.w = (v[j].w - mean) * rstd * g.w + bb.w;
            v[j] = o; am = fmaxf(am, fmaxf(fmaxf(fabsf(o.x), fabsf(o.y)), fmaxf(fabsf(o.z), fabsf(o.w))));
            uint2 w; w.x = pack2(o.x, o.y); w.y = pack2(o.z, o.w); *(uint2*)(x1b + (size_t)row * D + col) = w; }
        am = wave_max(am); if (am == 0.f) am = 1.f;
        const float inv = 119.0f / am;
        unsigned char* xq = P.ws + WS_X1Q + (size_t)row * D;
        u32x4 wh, wl;
#pragma unroll
        for (int d = 0; d < 4; ++d) { unsigned dh = 0u, dl = 0u;
#pragma unroll
            for (int e = 0; e < 8; ++e) { const float4 t = v[d * 2 + (e >> 2)]; const float x = (e & 3) == 0 ? t.x : ((e & 3) == 1 ? t.y : ((e & 3) == 2 ? t.z : t.w));
                const int q = (int)rintf(x * inv); dl |= (unsigned)(q & 15) << (4 * e); dh |= (unsigned)(((q + 8) >> 4) & 15) << (4 * e); }
            wh[d] = dh; wl[d] = dl; }
        *(u32x4*)(xq + lane * 32) = wh; *(u32x4*)(xq + lane * 32 + 16) = wl;
        if (lane == 0) ((float*)(P.ws + WS_SX))[row] = am * (1.0f / 119.0f);
    }
}

__device__ __forceinline__ int mono(float v) { const int b = __float_as_int(v); return b ^ ((b >> 31) & 0x7fffffff); }
__device__ __forceinline__ float unmono(int k) { return __int_as_float(k ^ ((k >> 31) & 0x7fffffff)); }
#define MK_INSERT16(L, X) do { int _x = (X); _Pragma("unroll") for (int _j = 0; _j < 16; ++_j) { const int _hi = max(L[_j], _x); _x = min(L[_j], _x); L[_j] = _hi; } } while (0)

template <int N> __device__ __forceinline__ void bitonic_sort_desc(int (&v)[N]) {
#pragma unroll
    for (int k = 2; k <= N; k <<= 1)
#pragma unroll
        for (int j = k >> 1; j > 0; j >>= 1)
#pragma unroll
            for (int i = 0; i < N; ++i) { const int l = i ^ j;
                if (l > i) { const int a = v[i], b = v[l]; if ((i & k) == 0) { v[i] = max(a, b); v[l] = min(a, b); } else { v[i] = min(a, b); v[l] = max(a, b); } } }
}
template <int N> __device__ __forceinline__ void bitonic_merge_desc(int (&v)[N]) {
#pragma unroll
    for (int j = N >> 1; j > 0; j >>= 1)
#pragma unroll
        for (int i = 0; i < N; ++i) { const int l = i ^ j; if (l > i) { const int a = v[i], b = v[l]; v[i] = max(a, b); v[l] = min(a, b); } }
}
__device__ __forceinline__ void xlane_merge16(int (&v)[16], int off) {
    int c[16];
#pragma unroll
    for (int i = 0; i < 16; ++i) c[i] = max(v[i], __shfl_xor(v[15 - i], off));
#pragma unroll
    for (int i = 0; i < 16; ++i) v[i] = c[i];
    bitonic_merge_desc<16>(v);
}
__device__ __forceinline__ int sel4(int g, int a, int b, int c, int d) { return g == 0 ? a : (g == 1 ? b : (g == 2 ? c : d)); }
__device__ __forceinline__ float sel4f(int g, float a, float b, float c, float d) { return g == 0 ? a : (g == 1 ? b : (g == 2 ? c : d)); }
__device__ __forceinline__ constexpr int cand_a(int role, int i) {
    return role == 0 ? 0 : role == 1 ? (i < 8 ? 1 : (i < 13 ? 2 : 4)) : role == 2 ? (i < 4 ? 3 : (i < 6 ? 5 : (i < 8 ? 6 : (i < 10 ? 7 : 8 + (i - 10))))) : (i < 2 ? 14 + i : -1);
}
__device__ __forceinline__ constexpr int cand_b(int role, int i) {
    return role == 0 ? i : role == 1 ? (i < 8 ? i : (i < 13 ? i - 8 : i - 13)) : role == 2 ? (i < 4 ? i : (i < 6 ? i - 4 : (i < 8 ? i - 6 : (i < 10 ? i - 8 : 0)))) : 0;
}

__device__ __forceinline__ void route_unit(const Params& P, int h, int tg, LAS unsigned char* lds, LAS int* lst) {
    const int lane = threadIdx.x & 63, w = __builtin_amdgcn_readfirstlane(threadIdx.x >> 6);
    const int cq = lane & 15, g = lane >> 4;
    const int tok = tg * 128 + w * 16 + cq;
    const bf16_t* qrow = (const bf16_t*)(P.ws + WS_QP) + (size_t)tok * D + h * 256;
    int L0[16], L1[16];
#pragma unroll
    for (int p = 0; p < 2; ++p) {
        bf16x8 qf[4];
#pragma unroll
        for (int ks = 0; ks < 4; ++ks) qf[ks] = *(const bf16x8*)(qrow + p * 128 + 32 * ks + 8 * g);
        int v0[16], v1[16];
#pragma unroll
        for (int kt = 0; kt < 8; ++kt) {
            f32x4 acc = {0.f, 0.f, 0.f, 0.f};
#pragma unroll
            for (int ks = 0; ks < 4; ++ks) { const bf16x8 kf = *(const LAS bf16x8*)(lds + (p * 128 + 16 * kt + cq) * KVS + (32 * ks + 8 * g) * 2); acc = __builtin_amdgcn_mfma_f32_16x16x32_bf16(kf, qf[ks], acc, 0, 0, 0); }
#pragma unroll
            for (int ii = 0; ii < 4; ++ii) { const int key = (mono(acc[ii]) & ~127) | (16 * kt + 4 * g + ii); if (kt < 4) v0[kt * 4 + ii] = key; else v1[(kt - 4) * 4 + ii] = key; }
        }
        bitonic_sort_desc<16>(v0); bitonic_sort_desc<16>(v1);
#pragma unroll
        for (int i = 0; i < 16; ++i) v0[i] = max(v0[i], v1[15 - i]);
        bitonic_merge_desc<16>(v0);
        xlane_merge16(v0, 16); xlane_merge16(v0, 32);
#pragma unroll
        for (int i = 0; i < 16; ++i) { if (p == 0) L0[i] = v0[i]; else L1[i] = v0[i]; }
    }
    if (g == 0) {
#pragma unroll
        for (int i = 0; i < 16; ++i) lst[(cq * 2 + 0) * 16 + i] = L0[i];
    }
    if (g == 1) {
#pragma unroll
        for (int i = 0; i < 16; ++i) lst[(cq * 2 + 1) * 16 + i] = L1[i];
    }
    float f0[16], f1[16];
#pragma unroll
    for (int i = 0; i < 16; ++i) { f0[i] = unmono(L0[i] & ~127); f1[i] = unmono(L1[i] & ~127); }
    int c[16];
#pragma unroll
    for (int i = 0; i < 16; ++i) {
        constexpr int NEG = (int)0x80000000;
        const float va = sel4f(g, f0[cand_a(0, i)], f0[cand_a(1, i)], f0[cand_a(2, i)], f0[cand_a(3, i) < 0 ? 0 : cand_a(3, i)]);
        const float vb = sel4f(g, f1[cand_b(0, i)], f1[cand_b(1, i)], f1[cand_b(2, i)], f1[cand_b(3, i)]);
        const int id = sel4(g, (cand_a(0, i) << 4) | cand_b(0, i), (cand_a(1, i) << 4) | cand_b(1, i), (cand_a(2, i) << 4) | cand_b(2, i), ((cand_a(3, i) < 0 ? 0 : cand_a(3, i)) << 4) | cand_b(3, i));
        int key = (mono(va + vb) & ~255) | id;
        if (cand_a(3, i) < 0) key = (g == 3) ? NEG : key;
        c[i] = key;
    }
    bitonic_sort_desc<16>(c);
    xlane_merge16(c, 16); xlane_merge16(c, 32);
    const float mx = unmono(c[0] & ~255);
    float e[16]; float sum = 0.f;
#pragma unroll
    for (int i = 0; i < 16; ++i) { e[i] = exp2f((unmono(c[i] & ~255) - mx) * LOG2E); sum += e[i]; }
    const float inv = 1.0f / sum;
    __builtin_amdgcn_wave_barrier();
    int ei[4]; float gi[4];
#pragma unroll
    for (int j = 0; j < 4; ++j) {
        const int key = sel4(g, c[j], c[4 + j], c[8 + j], c[12 + j]);
        gi[j] = sel4f(g, e[j], e[4 + j], e[8 + j], e[12 + j]) * inv;
        const int a = (key >> 4) & 15, b = key & 15;
        const int i0 = lst[(cq * 2 + 0) * 16 + a] & 127, i1 = lst[(cq * 2 + 1) * 16 + b] & 127;
        ei[j] = i0 * 128 + i1;
    }
    int* EIDX = (int*)(P.ws + WS_EIDX); float* GW = (float*)(P.ws + WS_GW);
    *(int4*)(EIDX + (size_t)tok * 128 + h * 16 + 4 * g) = make_int4(ei[0], ei[1], ei[2], ei[3]);
    *(float4*)(GW + (size_t)tok * 128 + h * 16 + 4 * g) = make_float4(gi[0], gi[1], gi[2], gi[3]);
    __builtin_amdgcn_wave_barrier();
}
__device__ __forceinline__ void phase_route(const Params& P, LAS unsigned char* lds) {
    const int tid = threadIdx.x, wave = __builtin_amdgcn_readfirstlane(tid >> 6);
    const int h = blockIdx.x & 7, slot = blockIdx.x >> 3, nslot = gridDim.x >> 3;
    const bf16_t* sk = (const bf16_t*)(P.ws + WS_SKB) + (size_t)h * 2 * 128 * 128;
#pragma unroll
    for (int it = 0; it < 8; ++it) { const int row = it * 32 + (tid >> 4), ch = tid & 15; *(LAS u32x4*)(lds + row * KVS + ch * 16) = *(const u32x4*)(sk + (size_t)row * 128 + ch * 8); }
    __syncthreads();
    LAS int* lst = (LAS int*)(lds + 73728) + wave * 512;
    for (int tg = slot; tg < NTOK / 128; tg += nslot) route_unit(P, h, tg, lds, lst);
}

__device__ __forceinline__ float ubf(unsigned x, int k) { return (float)((x >> (8 * k)) & 0xffu); }
constexpr int XSLOT = 1152, XGRP = 4 * XSLOT, XNG = 4, XWAVE = XNG * XGRP;
__device__ __forceinline__ void dma_group(__amdgpu_buffer_rsrc_t tab, int e_lo, int e_hi, int g, LAS unsigned char* sb, int lane) {
#pragma unroll
    for (int j = 0; j < 4; ++j) {
        const int k = g * 4 + j; const int e = __builtin_amdgcn_readlane(k < 64 ? e_lo : e_hi, k & 63);
        const int so = e * TROW;
        __builtin_amdgcn_raw_ptr_buffer_load_lds(tab, (LAS void*)(sb + j * XSLOT), 16, lane * 16, so, 0, 0);
        if (lane < 8) __builtin_amdgcn_raw_ptr_buffer_load_lds(tab, (LAS void*)(sb + j * XSLOT + 1024), 16, 1024 + lane * 16, so, 0, 0);
    }
}
__device__ __forceinline__ void u_consume(const LAS unsigned char* sb, const u32x4& xh, const u32x4& xl, float a_lo, float a_hi, float b_lo, float b_hi, int g, int lane, float& w_lo, float& w_hi) {
    int d[4];
#pragma unroll
    for (int j = 0; j < 4; ++j) {
        const u32x4 nb = *(const LAS u32x4*)(sb + j * XSLOT + lane * 16); const unsigned sc = *(const LAS unsigned short*)(sb + j * XSLOT + 1024 + lane * 2);
        int tot = 0;
#pragma unroll
        for (int jj = 0; jj < 2; ++jj) {
            int th = __builtin_amdgcn_sdot8((int)nb[jj * 2], (int)xh[jj * 2], 0, false); th = __builtin_amdgcn_sdot8((int)nb[jj * 2 + 1], (int)xh[jj * 2 + 1], th, false);
            int tl = __builtin_amdgcn_sdot8((int)nb[jj * 2], (int)xl[jj * 2], 0, false); tl = __builtin_amdgcn_sdot8((int)nb[jj * 2 + 1], (int)xl[jj * 2 + 1], tl, false);
            tot += (16 * th + tl) * (int)((sc >> (8 * jj)) & 255u); }
        d[j] = tot;
    }
    const auto s02 = __builtin_amdgcn_permlane32_swap((unsigned)d[0], (unsigned)d[2], false, false);
    const auto s13 = __builtin_amdgcn_permlane32_swap((unsigned)d[1], (unsigned)d[3], false, false);
    const int r0 = (int)s02[0] + (int)s02[1], r1 = (int)s13[0] + (int)s13[1];
    const auto s01 = __builtin_amdgcn_permlane16_swap((unsigned)r0, (unsigned)r1, false, false);
    int r = (int)s01[0] + (int)s01[1];
    r += __builtin_amdgcn_update_dpp(0, r, 0x128, 0xf, 0xf, false);
    r += __builtin_amdgcn_update_dpp(0, r, 0x124, 0xf, 0xf, false);
    r += __builtin_amdgcn_update_dpp(0, r, 0x4E, 0xf, 0xf, false);
    r += __builtin_amdgcn_update_dpp(0, r, 0xB1, 0xf, 0xf, false);
    const int tot = __shfl(r, (lane & 3) * 16);
    const bool mine = ((lane >> 2) == (g & 15));
    const bool hi = g >= 16;
    const float wv = (hi ? b_hi : b_lo) * gelu_as((float)tot * (hi ? a_hi : a_lo));
    if (hi) w_hi = mine ? wv : w_hi; else w_lo = mine ? wv : w_lo;
}
__device__ __forceinline__ void v_consume(const LAS unsigned char* sb, int (&acc)[32], int (&bias)[2], float w_lo, float w_hi, float inv_sw, int g, int lane) {
    u32x4 nb[4]; int wq[2] = {0, 0};
#pragma unroll
    for (int j = 0; j < 4; ++j) {
        const int k = g * 4 + j; const float w = readlane_f(k < 64 ? w_lo : w_hi, k & 63) * inv_sw;
        nb[j] = *(const LAS u32x4*)(sb + j * XSLOT + lane * 16); const unsigned sc = *(const LAS unsigned short*)(sb + j * XSLOT + 1024 + lane * 2);
#pragma unroll
        for (int jj = 0; jj < 2; ++jj) { const int q = (int)rintf(w * (float)((sc >> (8 * jj)) & 255u)); wq[jj] |= (q & 255) << (8 * j); }
    }
    bias[0] = __builtin_amdgcn_sdot4(wq[0], 0x01010101, bias[0], false); bias[1] = __builtin_amdgcn_sdot4(wq[1], 0x01010101, bias[1], false);
#pragma unroll
    for (int i = 0; i < 4; ++i) {
        const unsigned r0 = nb[0][i], r1 = nb[1][i], r2 = nb[2][i], r3 = nb[3][i];
        const unsigned p01a = __builtin_amdgcn_perm(r1, r0, 0x05010400u), p01b = __builtin_amdgcn_perm(r1, r0, 0x07030602u);
        const unsigned p23a = __builtin_amdgcn_perm(r3, r2, 0x05010400u), p23b = __builtin_amdgcn_perm(r3, r2, 0x07030602u);
        const unsigned t0 = __builtin_amdgcn_perm(p23a, p01a, 0x05040100u), t1 = __builtin_amdgcn_perm(p23a, p01a, 0x07060302u);
        const unsigned t2 = __builtin_amdgcn_perm(p23b, p01b, 0x05040100u), t3 = __builtin_amdgcn_perm(p23b, p01b, 0x07060302u);
        const int wv = wq[i >> 1];
        acc[i * 8 + 0] = __builtin_amdgcn_sdot4((int)(t0 & 0x0F0F0F0Fu), wv, acc[i * 8 + 0], false); acc[i * 8 + 1] = __builtin_amdgcn_sdot4((int)((t0 >> 4) & 0x0F0F0F0Fu), wv, acc[i * 8 + 1], false);
        acc[i * 8 + 2] = __builtin_amdgcn_sdot4((int)(t1 & 0x0F0F0F0Fu), wv, acc[i * 8 + 2], false); acc[i * 8 + 3] = __builtin_amdgcn_sdot4((int)((t1 >> 4) & 0x0F0F0F0Fu), wv, acc[i * 8 + 3], false);
        acc[i * 8 + 4] = __builtin_amdgcn_sdot4((int)(t2 & 0x0F0F0F0Fu), wv, acc[i * 8 + 4], false); acc[i * 8 + 5] = __builtin_amdgcn_sdot4((int)((t2 >> 4) & 0x0F0F0F0Fu), wv, acc[i * 8 + 5], false);
        acc[i * 8 + 6] = __builtin_amdgcn_sdot4((int)(t3 & 0x0F0F0F0Fu), wv, acc[i * 8 + 6], false); acc[i * 8 + 7] = __builtin_amdgcn_sdot4((int)((t3 >> 4) & 0x0F0F0F0Fu), wv, acc[i * 8 + 7], false);
    }
}
__device__ __forceinline__ void phase_experts(const Params& P, LAS unsigned char* lds) {
    const int lane = threadIdx.x & 63, wave = __builtin_amdgcn_readfirstlane(threadIdx.x >> 6);
    const bf16_t* x1b = (const bf16_t*)(P.ws + WS_X1B);
    const int* EIDX = (const int*)(P.ws + WS_EIDX); const float* GW = (const float*)(P.ws + WS_GW);
    const __amdgpu_buffer_rsrc_t UQ = __builtin_amdgcn_make_buffer_rsrc((void*)(P.ws + WS_UB), 0, NEXP * TROW, 0x00020000);
    const __amdgpu_buffer_rsrc_t VQ = __builtin_amdgcn_make_buffer_rsrc((void*)(P.ws + WS_VB), 0, NEXP * TROW, 0x00020000);
    const float* SU = (const float*)(P.ws + WS_SU); const float* SV = (const float*)(P.ws + WS_SV); const float* SX = (const float*)(P.ws + WS_SX);
    LAS unsigned char* wb = lds + wave * XWAVE;
    for (int row = blockIdx.x * 8 + wave; row < NTOK; row += gridDim.x * 8) {
        int ln = lane; asm volatile("" : "+v"(ln));
        const u32x4 xh = *(const u32x4*)(P.ws + WS_X1Q + (size_t)row * D + ln * 32), xl = *(const u32x4*)(P.ws + WS_X1Q + (size_t)row * D + ln * 32 + 16);
        const float sx = SX[row];
        const int e_lo = EIDX[(size_t)row * 128 + ln], e_hi = EIDX[(size_t)row * 128 + 64 + ln];
        const float g_lo = GW[(size_t)row * 128 + ln], g_hi = GW[(size_t)row * 128 + 64 + ln];
        const float a_lo = SU[e_lo] * sx, a_hi = SU[e_hi] * sx, b_lo = g_lo * SV[e_lo], b_hi = g_hi * SV[e_hi];
        float w_lo = 0.f, w_hi = 0.f;
        asm volatile("s_waitcnt vmcnt(0)" ::: "memory");
        dma_group(UQ, e_lo, e_hi, 0, wb, lane); dma_group(UQ, e_lo, e_hi, 1, wb + XGRP, lane); dma_group(UQ, e_lo, e_hi, 2, wb + 2 * XGRP, lane);
        int sg = 0;
#pragma unroll 1
        for (int g = 0; g < 32; ++g) {
            const int sn = (sg + 3) & 3;
            if (g + 3 < 32) dma_group(UQ, e_lo, e_hi, g + 3, wb + sn * XGRP, lane); else dma_group(VQ, e_lo, e_hi, g + 3 - 32, wb + sn * XGRP, lane);
            asm volatile("s_waitcnt vmcnt(24)" ::: "memory");
            u_consume(wb + sg * XGRP, xh, xl, a_lo, a_hi, b_lo, b_hi, g, lane, w_lo, w_hi);
            sg = (sg + 1) & 3;
        }
        float wmax = wave_max(fmaxf(fabsf(w_lo), fabsf(w_hi))); if (wmax == 0.f) wmax = 1.f;
        const float scale_w = wmax * (255.0f / 127.0f), inv_sw = 1.0f / scale_w;
        int acc[32]; int bias[2] = {0, 0};
#pragma unroll
        for (int i = 0; i < 32; ++i) acc[i] = 0;
#pragma unroll 1
        for (int g = 0; g < 32; ++g) {
            const int sn = (sg + 3) & 3;
            dma_group(VQ, e_lo, e_hi, (g + 3) & 31, wb + sn * XGRP, lane);
            asm volatile("s_waitcnt vmcnt(24)" ::: "memory");
            v_consume(wb + sg * XGRP, acc, bias, w_lo, w_hi, inv_sw, g, lane);
            sg = (sg + 1) & 3;
        }
        asm volatile("s_waitcnt vmcnt(0)" ::: "memory");
        float val[32]; float s = 0.f;
#pragma unroll
        for (int jj = 0; jj < 2; ++jj) {
            const int b8 = 8 * bias[jj];
#pragma unroll
            for (int hh = 0; hh < 2; ++hh) {
                const u32x4 xa = *(const u32x4*)(x1b + (size_t)row * D + jj * 1024 + ln * 16 + hh * 8);
#pragma unroll
                for (int i = 0; i < 4; ++i) { const int e0 = jj * 16 + hh * 8 + 2 * i;
                    val[e0] = scale_w * (float)(acc[e0] - b8) + ALPHA * bflo(xa[i]); val[e0 + 1] = scale_w * (float)(acc[e0 + 1] - b8) + ALPHA * bfhi(xa[i]); s += val[e0] + val[e0 + 1]; }
            }
        }
        const float mean = wave_sum(s) * (1.0f / D); float q = 0.f;
#pragma unroll
        for (int i = 0; i < 32; ++i) { const float d0 = val[i] - mean; q += d0 * d0; }
        const float rstd = rsqrtf(wave_sum(q) * (1.0f / D) + LN_EPS);
        float* yo = P.out + (row < NTOK_P ? O_YP + (size_t)row * D : O_YS + (size_t)(row - NTOK_P) * D);
        const int lo16 = ln * 16;
#pragma unroll
        for (int jj = 0; jj < 2; ++jj)
#pragma unroll
            for (int i = 0; i < 4; ++i) {
                const int col = jj * 1024 + lo16 + i * 4;
                const float4 g0 = *(const float4*)(P.ln2_g + col), b0 = *(const float4*)(P.ln2_b + col);
                float4 o;
                o.x = (val[jj * 16 + i * 4 + 0] - mean) * rstd * g0.x + b0.x; o.y = (val[jj * 16 + i * 4 + 1] - mean) * rstd * g0.y + b0.y;
                o.z = (val[jj * 16 + i * 4 + 2] - mean) * rstd * g0.z + b0.z; o.w = (val[jj * 16 + i * 4 + 3] - mean) * rstd * g0.w + b0.w;
                *(float4*)(yo + col) = o;
            }
    }
}

constexpr int NPHASE = 11;
__global__ void __launch_bounds__(NTHREADS, 2) fwd(Params P) {
    extern __shared__ __attribute__((aligned(16))) unsigned char lds_raw[];
    LAS unsigned char* lds = (LAS unsigned char*)lds_raw;
    volatile LAS unsigned* misc = (volatile LAS unsigned*)(lds + MISC_OFF);
    const int lo = P.ph_lo, hi = P.ph_hi;
    XcdBarrier bar; bar.bar = (unsigned*)(P.ws + WS_CTL); bar.x = 0; bar.st = nullptr;
    if (hi - lo > 1) {
        if (threadIdx.x == 0) { misc[0] = 0u; misc[1] = 0u; misc[2] = 0u; misc[3] = 0u; }
        __syncthreads();
        bar = xcd_barrier_post((unsigned*)(P.ws + WS_CTL), misc);
    }
#ifndef MK_REPMASK
#define MK_REPMASK 0
#endif
#ifndef MK_PHASE_MASK
#define MK_PHASE_MASK 0x7ff
#endif
#define IN(k) (((MK_PHASE_MASK >> (k)) & 1) && lo <= (k) && (k) < hi)
#define SEAM(k) do { if (IN(k) && IN((k) + 1)) xcd_barrier(bar); } while (0)
    if (IN(0)) { phase_prologue(P, lds); }
    SEAM(0);
    if (IN(1)) {
        pg8::Gemm g{(const pg8::bf16_t*)(P.ws + WS_XB), (const pg8::bf16_t*)(P.ws + WS_WINT), NTOK, DIN, D};
        pg8::StaticOrder S; S.init(NTOK, DIN, (int)gridDim.x, (int)blockIdx.x);
        EpiProj E{P.out, (float*)(P.ws + WS_QF), (float*)(P.ws + WS_XR), (float*)(P.ws + WS_GATE), (bf16_t*)(P.ws + WS_QB), (bf16_t*)(P.ws + WS_KB), (bf16_t*)(P.ws + WS_VB16)};
        pg8::gemm_phase<EpiProj, pg8::StaticOrder, false>(lds, g, S, E, nullptr);
    }
    SEAM(1);
    if (IN(2)) { phase_lru(P); }
    if (IN(3)) { phase_samp(P, lds); }
    if (IN(4)) { phase_attn01(P, lds); }
    SEAM(4);
    if (IN(5)) { phase_mix_b(P, lds); }
    SEAM(5);
    if (IN(6)) {
        sample_rows_gemm<0>(P, (const bf16_t*)(P.ws + WS_AR), (const bf16_t*)(P.ws + WS_WOT), lds);
        pg8::Gemm g{(const pg8::bf16_t*)(P.ws + WS_AR), (const pg8::bf16_t*)(P.ws + WS_WOT), NTOK_P, D, D};
        pg8::StaticOrder S; S.init(NTOK_P, D, (int)gridDim.x, (int)blockIdx.x);
        EpiOut E{P.x_prompt, P.x_sample, (float*)(P.ws + WS_PRE1)};
        pg8::gemm_phase<EpiOut, pg8::StaticOrder, false>(lds, g, S, E, nullptr);
    }
    SEAM(6);
    if (IN(7)) { phase_ln1(P); }
    SEAM(7);
    if (IN(8)) {
        sample_rows_gemm<1>(P, (const bf16_t*)(P.ws + WS_X1B), (const bf16_t*)(P.ws + WS_WQT), lds);
        pg8::Gemm g{(const pg8::bf16_t*)(P.ws + WS_X1B), (const pg8::bf16_t*)(P.ws + WS_WQT), NTOK_P, D, D};
        pg8::StaticOrder S; S.init(NTOK_P, D, (int)gridDim.x, (int)blockIdx.x);
        EpiBf16Plain E{(bf16_t*)(P.ws + WS_QP), D};
        pg8::gemm_phase<EpiBf16Plain, pg8::StaticOrder, false>(lds, g, S, E, nullptr);
    }
    SEAM(8);
    if (IN(9)) { phase_route(P, lds); }
    SEAM(9);
    if (IN(10)) { phase_experts(P, lds); }
#undef IN
#undef SEAM
}
}

extern "C" void kernel_launch(void* const* d_in, const int* in_sizes, int n_in, void* d_out, int out_size, void* d_ws, size_t ws_size, hipStream_t stream) {
    using namespace mk;
    static int grid = 0;
    if (grid == 0) {
        if (n_in != 23 || (size_t)out_size != O_END || ws_size < WS_END) { fprintf(stderr, "kernel_launch: unexpected shapes: n_in %d out %d ws %zu (need %zu)\n", n_in, out_size, ws_size, (size_t)WS_END); grid = -1; return; }
        int dev = 0, cus = 0, per_cu = 0;
        if (hipGetDevice(&dev) != hipSuccess || hipDeviceGetAttribute(&cus, hipDeviceAttributeMultiprocessorCount, dev) != hipSuccess) { grid = -1; return; }
        if (hipFuncSetAttribute((const void*)fwd, hipFuncAttributeMaxDynamicSharedMemorySize, LDS_BYTES) != hipSuccess) { fprintf(stderr, "kernel_launch: hipFuncSetAttribute failed\n"); grid = -1; return; }
        if (hipOccupancyMaxActiveBlocksPerMultiprocessor(&per_cu, (const void*)fwd, NTHREADS, LDS_BYTES) != hipSuccess || per_cu < 1) { fprintf(stderr, "kernel_launch: occupancy query says %d\n", per_cu); }
        (void)hipGetLastError();
        grid = cus;
    }
    if (grid < 0) return;
    (void)hipMemsetAsync((char*)d_ws + WS_CTL, 0, 65536, stream);
    Params p{};
    p.x_prompt = (const float*)d_in[0]; p.x_sample = (const float*)d_in[1]; p.cache_k = (const float*)d_in[2]; p.cache_v = (const float*)d_in[3];
    p.state_conv = (const float*)d_in[4]; p.state_h = (const float*)d_in[5]; p.w_in = (const float*)d_in[6]; p.conv_w = (const float*)d_in[7]; p.conv_b = (const float*)d_in[8];
    p.lru_w_a = (const float*)d_in[9]; p.lru_b_a = (const float*)d_in[10]; p.lru_w_x = (const float*)d_in[11]; p.lru_b_x = (const float*)d_in[12]; p.lru_lambda = (const float*)d_in[13];
    p.w_out = (const float*)d_in[14]; p.ln1_g = (const float*)d_in[15]; p.ln1_b = (const float*)d_in[16]; p.w_query = (const float*)d_in[17]; p.sub_keys = (const float*)d_in[18];
    p.peer_u = (const float*)d_in[19]; p.peer_v = (const float*)d_in[20]; p.ln2_g = (const float*)d_in[21]; p.ln2_b = (const float*)d_in[22];
    p.out = (float*)d_out; p.ws = (unsigned char*)d_ws;
#if MK_N_LAUNCHES == 1
    p.ph_lo = 0; p.ph_hi = NPHASE;
    hipLaunchKernelGGL(fwd, dim3(grid), dim3(NTHREADS), LDS_BYTES, stream, p);
#else
    for (int k = 0; k < NPHASE; ++k) { p.ph_lo = k; p.ph_hi = k + 1; hipLaunchKernelGGL(fwd, dim3(grid), dim3(NTHREADS), LDS_BYTES, stream, p);
#ifdef MK_EXTRA_PHASE
        if (k == MK_EXTRA_PHASE) hipLaunchKernelGGL(fwd, dim3(grid), dim3(NTHREADS), LDS_BYTES, stream, p);
#endif
    }
#endif
    const hipError_t le = hipPeekAtLastError();
    if (le != hipSuccess) fprintf(stderr, "kernel_launch: launch failed: %s\n", hipGetErrorName(le));
}
```

```cpp
#include <hip/hip_runtime.h>
#include <cstdio>
#include <cstdint>
namespace pg8 {
#define PG8_LAS __attribute__((address_space(3)))
typedef unsigned short bf16_t;
typedef short bf16x8 __attribute__((ext_vector_type(8)));
typedef float f32x4 __attribute__((ext_vector_type(4)));
typedef unsigned u32x4 __attribute__((ext_vector_type(4)));
constexpr int BM = 256, BK = 64, HALF = 128, HTB = HALF * BK * 2  , STAGE_BYTES = 8 * HTB, NXCD = 8, WGM = 8;

__host__ __device__ __forceinline__ int lds_byte(int r, int c) { const int st = (r >> 4) * 2 + (c >> 5), rr = r & 15, cc = c & 31, ob = rr * 64 + cc * 2; return st * 1024 + (ob ^ (((ob >> 9) & 1) << 5)); }
__host__ __device__ __forceinline__ void stage_rc(int b, int& R, int& C) { const int st = b / 1024, sb = b % 1024, swz = sb ^ (((sb >> 9) & 1) << 5); R = (st >> 1) * 16 + swz / 64; C = (st & 1) * 32 + (swz % 64) / 2; }
__host__ __device__ __forceinline__ int perm32(int rho) { const int n = rho >> 4, i = rho & 15; return 8 * (i >> 2) + 4 * n + (i & 3); }

struct Unit { int pm, pn; };
struct Gemm { const bf16_t* A; const bf16_t* Bt; int M, N, K; };

struct StaticOrder {
    int nM, nN, nwg, G, c;
    __host__ __device__ void init(int M, int N, int G_, int c_) { nM = M / BM; nN = N / BM; nwg = nM * nN; G = G_; c = c_; }
    __host__ __device__ bool next(int i, Unit& u) const {
        const long L = (long)i * G + c; if (L >= nwg) return false;
        int wgid = (int)L; { const int q = nwg / NXCD, r = nwg % NXCD, xcd = wgid % NXCD, off = wgid / NXCD; wgid = (xcd < r ? xcd * (q + 1) : r * (q + 1) + (xcd - r) * q) + off; }
        const int nig = WGM * nN, gid = wgid / nig, fm = gid * WGM, gsz = (nM - fm) < WGM ? (nM - fm) : WGM;
        u.pm = fm + ((wgid % nig) % gsz); u.pn = (wgid % nig) / gsz; return true;
    }
    __device__ __forceinline__ void a_ready(const Unit&) const {}
    __device__ __forceinline__ void done(const Unit&) const {}
};
struct CountedOrder : StaticOrder {
    const unsigned* ready; unsigned need; unsigned* tmo;
    __device__ __forceinline__ void a_ready(const Unit& u) const {
        if (threadIdx.x < 64) {
            const unsigned long long t0 = __builtin_amdgcn_s_memrealtime(); unsigned polls = 0;
            while ((unsigned)__builtin_amdgcn_readfirstlane(__hip_atomic_load(ready + 64 * u.pm, __ATOMIC_RELAXED, __HIP_MEMORY_SCOPE_AGENT)) < need) {
                if ((++polls & 255u) == 0u && __builtin_amdgcn_readfirstlane(__hip_atomic_load(tmo, __ATOMIC_RELAXED, __HIP_MEMORY_SCOPE_AGENT)) != 0u) break;
                if (__builtin_amdgcn_s_memrealtime() - t0 > 2000000ull) {
                    if (threadIdx.x == 0) { unsigned expect = 0u; __hip_atomic_compare_exchange_strong(tmo + 1, &expect, 0x600u | (unsigned)(u.pm & 0xff), __ATOMIC_RELAXED, __ATOMIC_RELAXED, __HIP_MEMORY_SCOPE_AGENT); __hip_atomic_store(tmo, 1u, __ATOMIC_RELAXED, __HIP_MEMORY_SCOPE_AGENT); }
                    break; }
                __builtin_amdgcn_s_sleep(2); }
            __builtin_amdgcn_fence(__ATOMIC_ACQUIRE, "agent");
            asm volatile("s_waitcnt vmcnt(0)" ::: "memory");
        }
#if !defined(BROKEN_HOOK_NO_BARRIER)
        asm volatile("" ::: "memory"); __builtin_amdgcn_s_barrier(); asm volatile("" ::: "memory");
#endif
    }
};

__device__ __forceinline__ unsigned cvt_pk_bf16(float lo, float hi) { unsigned r; asm volatile("v_cvt_pk_bf16_f32 %0, %1, %2" : "=v"(r) : "v"(lo), "v"(hi)); return r; }
typedef float f32x2 __attribute__((ext_vector_type(2)));
__device__ __forceinline__ f32x2 gelu_pk(f32x2 v) {
    const f32x2 av = __builtin_elementwise_abs(v), d = av * 0.2316418882f + 1.0f;
    f32x2 t; t.x = __builtin_amdgcn_rcpf(d.x); t.y = __builtin_amdgcn_rcpf(d.y);
    f32x2 q = t * 0.5307027145f + (-0.7265760135f); q = q * t + 0.7107068705f; q = q * t + (-0.142248368f); q = q * t + 0.127414796f; q = q * t;
    const f32x2 s = (v * v) * (-0.72134752044f);
    f32x2 e; e.x = __builtin_amdgcn_exp2f(s.x); e.y = __builtin_amdgcn_exp2f(s.y);
    const f32x2 m = v * (q * e), r = v - m;
    f32x2 o; o.x = v.x < 0.f ? m.x : r.x; o.y = v.y < 0.f ? m.y : r.y; return o;
}

struct EpiF32 {
    static constexpr bool PERM = false, AFTER_DRAIN = false;
    float* C; int ldc; const float* bias;
    __device__ __forceinline__ void operator()(const f32x4 (&acc)[2][2][4][2], const Unit& u, int wr, int wc, int fr, int fq) const {
        const int row0 = u.pm * BM + wr * 64 + fr, col0 = u.pn * BM + wc * 32 + 4 * fq;
        f32x4 bv[2][2];
#pragma unroll
        for (int bj = 0; bj < 2; ++bj)
#pragma unroll
            for (int n = 0; n < 2; ++n) bv[bj][n] = bias ? *(const f32x4*)(bias + col0 + bj * HALF + n * 16) : (f32x4){0.f, 0.f, 0.f, 0.f};
#pragma unroll
        for (int ai = 0; ai < 2; ++ai)
#pragma unroll
            for (int m = 0; m < 4; ++m) { float* rowp = C + (size_t)(row0 + ai * HALF + m * 16) * ldc + col0;
#pragma unroll
                for (int bj = 0; bj < 2; ++bj)
#pragma unroll
                    for (int n = 0; n < 2; ++n) *(f32x4*)(rowp + bj * HALF + n * 16) = acc[ai][bj][m][n] + bv[bj][n]; }
    }
};
template <int ACT  > struct EpiBf16 {
    static constexpr bool PERM = true, AFTER_DRAIN = false;
    bf16_t* O; int ldc; const float* bias; int split_cols; size_t split_stride;
    __device__ __forceinline__ void operator()(const f32x4 (&acc)[2][2][4][2], const Unit& u, int wr, int wc, int fr, int fq) const {
        const int row0 = u.pm * BM + wr * 64 + fr; int colt = u.pn * BM; bf16_t* base = O;
        if (split_cols) { const int t = colt / split_cols; base += (size_t)t * split_stride; colt -= t * split_cols; }
        const int col0 = colt + wc * 32 + 8 * fq, bcol0 = u.pn * BM + wc * 32 + 8 * fq;
        f32x4 bv[2][2];
#pragma unroll
        for (int bj = 0; bj < 2; ++bj)
#pragma unroll
            for (int n = 0; n < 2; ++n) bv[bj][n] = bias ? *(const f32x4*)(bias + bcol0 + bj * HALF + 4 * n) : (f32x4){0.f, 0.f, 0.f, 0.f};
#pragma unroll
        for (int ai = 0; ai < 2; ++ai)
#pragma unroll
            for (int m = 0; m < 4; ++m) { bf16_t* rowp = base + (size_t)(row0 + ai * HALF + m * 16) * ldc + col0;
#pragma unroll
                for (int bj = 0; bj < 2; ++bj) { f32x4 v0 = acc[ai][bj][m][0] + bv[bj][0], v1 = acc[ai][bj][m][1] + bv[bj][1];
                    if (ACT == 1) { f32x2 a = gelu_pk((f32x2){v0[0], v0[1]}), b = gelu_pk((f32x2){v0[2], v0[3]}), c = gelu_pk((f32x2){v1[0], v1[1]}), d = gelu_pk((f32x2){v1[2], v1[3]});
                        v0 = (f32x4){a.x, a.y, b.x, b.y}; v1 = (f32x4){c.x, c.y, d.x, d.y}; }
                    if (ACT == 2) {
#pragma unroll
                        for (int j = 0; j < 4; ++j) { v0[j] = 0.5f * v0[j] * (1.0f + erff(v0[j] * 0.70710678f)); v1[j] = 0.5f * v1[j] * (1.0f + erff(v1[j] * 0.70710678f)); } }
                    u32x4 w; w.x = cvt_pk_bf16(v0[0], v0[1]); w.y = cvt_pk_bf16(v0[2], v0[3]); w.z = cvt_pk_bf16(v1[0], v1[1]); w.w = cvt_pk_bf16(v1[2], v1[3]);
                    *(u32x4*)(rowp + bj * HALF) = w; } }
    }
};

struct PanelStats {
    unsigned* xbuf;
    unsigned* cnt;
    unsigned* tmo;
    int ntn; float eps;
    unsigned code;
    __device__ __forceinline__ bool run(const f32x4 (&v)[2][2][4][2], const Unit& u, int wr, int wc, int fr, int fq, PG8_LAS unsigned char* lds, int wid, int lane) const {
        typedef float f32x2v __attribute__((ext_vector_type(2)));
        PG8_LAS f32x2v* P = (PG8_LAS f32x2v*)lds;
        PG8_LAS f32x2v* S = (PG8_LAS f32x2v*)(lds + 8192);
        PG8_LAS unsigned* flag = (PG8_LAS unsigned*)(lds + 8192 + 2048);
#pragma unroll
        for (int ai = 0; ai < 2; ++ai)
#pragma unroll
            for (int m = 0; m < 4; ++m) {
                float s = 0.f;
#pragma unroll
                for (int bj = 0; bj < 2; ++bj)
#pragma unroll
                    for (int n = 0; n < 2; ++n) { const f32x4 x = v[ai][bj][m][n]; s += (x[0] + x[1]) + (x[2] + x[3]); }
                s += __shfl_xor(s, 16); s += __shfl_xor(s, 32);
                const float mw = s * (1.0f / 64.0f); float q = 0.f;
#pragma unroll
                for (int bj = 0; bj < 2; ++bj)
#pragma unroll
                    for (int n = 0; n < 2; ++n) { const f32x4 d = v[ai][bj][m][n] - mw; q += (d[0] * d[0] + d[1] * d[1]) + (d[2] * d[2] + d[3] * d[3]); }
                q += __shfl_xor(q, 16); q += __shfl_xor(q, 32);
                if (fq == 0) P[(ai * HALF + wr * 64 + m * 16 + fr) * 4 + wc] = (f32x2v){mw, q};
            }
        asm volatile("s_waitcnt lgkmcnt(0)" ::: "memory"); __builtin_amdgcn_s_barrier(); asm volatile("" ::: "memory");
#if defined(BROKEN_NO_WAIT)
        if (blockIdx.x >= 64) { const long long t0 = clock64(); while (clock64() - t0 < 60000) __builtin_amdgcn_s_sleep(8); }
#endif
        const int row = wid * 32 + (lane & 31);
        if (lane < 32) {
            const f32x2v a = P[row * 4 + 0], b = P[row * 4 + 1], c = P[row * 4 + 2], d = P[row * 4 + 3];
            const float mt = (a.x + b.x + c.x + d.x) * 0.25f;
            const float da = a.x - mt, db = b.x - mt, dc = c.x - mt, dd = d.x - mt;
            const float m2 = (a.y + b.y) + (c.y + d.y) + 64.0f * ((da * da + db * db) + (dc * dc + dd * dd));
            unsigned long long* slot = (unsigned long long*)xbuf + ((size_t)(u.pm * BM + row) * 4 + u.pn);
            __hip_atomic_store(slot, ((unsigned long long)__float_as_uint(m2) << 32) | __float_as_uint(mt), __ATOMIC_RELAXED, __HIP_MEMORY_SCOPE_AGENT);
        }
        asm volatile("s_waitcnt vmcnt(0)" ::: "memory");
        if (lane == 0) __hip_atomic_fetch_add(cnt + 64 * u.pm, 1u, __ATOMIC_RELAXED, __HIP_MEMORY_SCOPE_AGENT);
        if (wid == 0) {
            bool dead = false; const unsigned long long t0 = __builtin_amdgcn_s_memrealtime(); const unsigned want = 8u * (unsigned)ntn;
            for (;;) {
#if defined(BROKEN_NO_WAIT)
                break;
#endif
                if ((unsigned)__builtin_amdgcn_readfirstlane(__hip_atomic_load(cnt + 64 * u.pm, __ATOMIC_RELAXED, __HIP_MEMORY_SCOPE_AGENT)) >= want) break;
                if (__builtin_amdgcn_s_memrealtime() - t0 > 2000000ull) {
                    if (lane == 0) { unsigned expect = 0u; __hip_atomic_compare_exchange_strong(tmo + 1, &expect, code | (unsigned)(u.pm & 0xff), __ATOMIC_RELAXED, __ATOMIC_RELAXED, __HIP_MEMORY_SCOPE_AGENT);
                                     __hip_atomic_store(tmo, 1u, __ATOMIC_RELAXED, __HIP_MEMORY_SCOPE_AGENT); }
                    dead = true; break; }
                __builtin_amdgcn_s_sleep(2);
            }
            __builtin_amdgcn_fence(__ATOMIC_ACQUIRE, "agent");
            if (lane == 0) flag[0] = dead ? 1u : 0u;
        }
        asm volatile("s_waitcnt vmcnt(0) lgkmcnt(0)" ::: "memory"); __builtin_amdgcn_s_barrier(); asm volatile("" ::: "memory");
        const bool bad = flag[0] != 0u;
        if (lane < 32) {
            const unsigned long long* slot = (const unsigned long long*)xbuf + (size_t)(u.pm * BM + row) * 4; float mt[4], m2[4]; float ms = 0.f;
#pragma unroll
            for (int t = 0; t < 4; ++t) { if (t < ntn) { const unsigned long long w = __hip_atomic_load(slot + t, __ATOMIC_RELAXED, __HIP_MEMORY_SCOPE_AGENT); mt[t] = __uint_as_float((unsigned)w); m2[t] = __uint_as_float((unsigned)(w >> 32)); } else { mt[t] = 0.f; m2[t] = 0.f; } ms += mt[t]; }
            const float mean = ms / (float)ntn; float q = 0.f;
#pragma unroll
            for (int t = 0; t < 4; ++t) if (t < ntn) { const float dm = mt[t] - mean; q += m2[t] + 256.0f * dm * dm; }
            S[row] = (f32x2v){mean, 1.0f / sqrtf(q / (256.0f * (float)ntn) + eps)};
        }
        asm volatile("s_waitcnt lgkmcnt(0)" ::: "memory"); __builtin_amdgcn_s_barrier(); asm volatile("" ::: "memory");
        return bad;
    }
};
struct EpiLnRes {
    static constexpr bool PERM = false, AFTER_DRAIN = true;
    const float* base; float* out; int ldc; const float* bias; PanelStats st; unsigned poison;
    __device__ __forceinline__ void refuse(size_t i0, size_t stride, int M, int N) const { const float q = __builtin_nanf(""); for (size_t i = i0; i < (size_t)M * N; i += stride) out[(i / N) * ldc + i % N] = q;
        if (i0 == 0) { unsigned expect = 0u; __hip_atomic_compare_exchange_strong(st.tmo + 1, &expect, 0x7f0u, __ATOMIC_RELAXED, __ATOMIC_RELAXED, __HIP_MEMORY_SCOPE_AGENT); __hip_atomic_store(st.tmo, 1u, __ATOMIC_RELAXED, __HIP_MEMORY_SCOPE_AGENT); } }
    __device__ __forceinline__ void fused(f32x4 (&acc)[2][2][4][2], const Unit& u, int wr, int wc, int fr, int fq, PG8_LAS unsigned char* lds, int wid, int lane) const {
        typedef float f32x2v __attribute__((ext_vector_type(2)));
        const PG8_LAS f32x2v* S = (const PG8_LAS f32x2v*)(lds + 8192);
        const int col0 = u.pn * BM + wc * 32 + 4 * fq;
#pragma unroll
        for (int bj = 0; bj < 2; ++bj)
#pragma unroll
            for (int n = 0; n < 2; ++n) { const f32x4 bv = bias ? *(const f32x4*)(bias + col0 + bj * HALF + n * 16) : (f32x4){0.f, 0.f, 0.f, 0.f};
#pragma unroll
                for (int ai = 0; ai < 2; ++ai)
#pragma unroll
                    for (int m = 0; m < 4; ++m) acc[ai][bj][m][n] += bv; }
        const bool bad = st.run(acc, u, wr, wc, fr, fq, lds, wid, lane) || poison != 0u;
        const float qnan = __builtin_nanf("");
#pragma unroll
        for (int ai = 0; ai < 2; ++ai)
#pragma unroll
            for (int m = 0; m < 4; ++m) { const int r = ai * HALF + wr * 64 + m * 16 + fr; const f32x2v sr = S[r]; const size_t off = (size_t)(u.pm * BM + r) * ldc + col0;
#pragma unroll
                for (int bj = 0; bj < 2; ++bj)
#pragma unroll
                    for (int n = 0; n < 2; ++n) { const f32x4 bs = *(const f32x4*)(base + off + bj * HALF + n * 16); f32x4 o = bs + (acc[ai][bj][m][n] - sr.x) * sr.y;
                        if (bad) o = (f32x4){qnan, qnan, qnan, qnan}; *(f32x4*)(out + off + bj * HALF + n * 16) = o; }
                asm volatile("" ::: "memory"); }
    }
};
struct EpiLnResLn {
    static constexpr bool PERM = false, AFTER_DRAIN = true;
    const float* base; float* out; bf16_t* xn; int ldc; const float* bias; PanelStats st1, st2; unsigned poison;
    __device__ __forceinline__ void refuse(size_t i0, size_t stride, int M, int N) const { const float q = __builtin_nanf(""); for (size_t i = i0; i < (size_t)M * N; i += stride) { const size_t o = (i / N) * ldc + i % N; out[o] = q; xn[o] = (bf16_t)0x7fc0u; }
        if (i0 == 0) { unsigned expect = 0u; __hip_atomic_compare_exchange_strong(st1.tmo + 1, &expect, 0x7f0u, __ATOMIC_RELAXED, __ATOMIC_RELAXED, __HIP_MEMORY_SCOPE_AGENT); __hip_atomic_store(st1.tmo, 1u, __ATOMIC_RELAXED, __HIP_MEMORY_SCOPE_AGENT); } }
    __device__ __forceinline__ void fused(f32x4 (&acc)[2][2][4][2], const Unit& u, int wr, int wc, int fr, int fq, PG8_LAS unsigned char* lds, int wid, int lane) const {
        typedef float f32x2v __attribute__((ext_vector_type(2))); typedef unsigned u32x2v __attribute__((ext_vector_type(2)));
        const PG8_LAS f32x2v* S = (const PG8_LAS f32x2v*)(lds + 8192);
        const int col0 = u.pn * BM + wc * 32 + 4 * fq;
#pragma unroll
        for (int bj = 0; bj < 2; ++bj)
#pragma unroll
            for (int n = 0; n < 2; ++n) { const f32x4 bv = bias ? *(const f32x4*)(bias + col0 + bj * HALF + n * 16) : (f32x4){0.f, 0.f, 0.f, 0.f};
#pragma unroll
                for (int ai = 0; ai < 2; ++ai)
#pragma unroll
                    for (int m = 0; m < 4; ++m) acc[ai][bj][m][n] += bv; }
        bool bad = st1.run(acc, u, wr, wc, fr, fq, lds, wid, lane) || poison != 0u;
        const float qnan = __builtin_nanf("");
#pragma unroll
        for (int ai = 0; ai < 2; ++ai)
#pragma unroll
            for (int m = 0; m < 4; ++m) { const int r = ai * HALF + wr * 64 + m * 16 + fr; const f32x2v sr = S[r]; const size_t off = (size_t)(u.pm * BM + r) * ldc + col0;
#pragma unroll
                for (int bj = 0; bj < 2; ++bj)
#pragma unroll
                    for (int n = 0; n < 2; ++n) { const f32x4 bs = *(const f32x4*)(base + off + bj * HALF + n * 16); acc[ai][bj][m][n] = bs + (acc[ai][bj][m][n] - sr.x) * sr.y; }
                asm volatile("" : "+v"(acc[ai][0][m][0]), "+v"(acc[ai][0][m][1]), "+v"(acc[ai][1][m][0]), "+v"(acc[ai][1][m][1]));
                if (m & 1) asm volatile("" ::: "memory"); }
        const bool bad1 = bad;
        bad = st2.run(acc, u, wr, wc, fr, fq, lds, wid, lane) || bad;
#pragma unroll
        for (int ai = 0; ai < 2; ++ai)
#pragma unroll
            for (int m = 0; m < 4; ++m) { const int r = ai * HALF + wr * 64 + m * 16 + fr; const f32x2v sr = S[r]; const size_t off = (size_t)(u.pm * BM + r) * ldc + col0;
#pragma unroll
                for (int bj = 0; bj < 2; ++bj)
#pragma unroll
                    for (int n = 0; n < 2; ++n) { const f32x4 x1 = acc[ai][bj][m][n]; *(f32x4*)(out + off + bj * HALF + n * 16) = bad1 ? (f32x4){qnan, qnan, qnan, qnan} : x1;
                        const f32x4 o = (x1 - sr.x) * sr.y; u32x2v w; w.x = cvt_pk_bf16(o[0], o[1]); w.y = cvt_pk_bf16(o[2], o[3]);
                        if (bad) { w.x = 0x7fc07fc0u; w.y = 0x7fc07fc0u; } *(u32x2v*)(xn + off + bj * HALF + n * 16) = w; }
                asm volatile("" ::: "memory"); }
    }
};

template <class Epi, class Sched, bool STAMP = false>
__device__ __forceinline__ void gemm_phase(PG8_LAS unsigned char* lds, const Gemm g, const Sched& S, const Epi& E, unsigned long long* stamps) {
    const int tid = threadIdx.x, wid = __builtin_amdgcn_readfirstlane(tid >> 6), lane = tid & 63, wr = wid >> 2, wc = wid & 3, fr = lane & 15, fq = lane >> 4;
    const int K = g.K, nt = K / BK;
    int ts_lo = 0, ts_hi = 0, nts = 0; const unsigned long long rt_entry = STAMP ? (unsigned long long)wall_clock64() : 0ull;
#define PG8_STAMP() do { if (STAMP && wid == 0 && nts < 64) { const unsigned long long _c = (unsigned long long)clock64(); \
        ts_lo = (lane == nts) ? (int)(unsigned)_c : ts_lo; ts_hi = (lane == nts) ? (int)(unsigned)(_c >> 32) : ts_hi; ++nts; } } while (0)
    PG8_STAMP();
    unsigned voffA[2], voffB[2];
#pragma unroll
    for (int i = 0; i < 2; ++i) { int R, C; stage_rc(tid * 16 + i * 8192, R, C); const int Rb = Epi::PERM ? ((R & ~31) + perm32(R & 31)) : R;
        voffA[i] = (unsigned)(R * K + C) * 2u; voffB[i] = (unsigned)(Rb * K + C) * 2u; }
    const size_t kstep = (size_t)(BK * 2);
    const size_t hstep = (size_t)HALF * K * 2;
    const size_t tstep = 2 * hstep;
    const unsigned ldsw = (unsigned)wid * 1024u;
    const int aoff = lds_byte(wr * 64 + fr, fq * 8), boff = lds_byte(wc * 32 + fr, fq * 8);
#define PG8_SA(b, h) (((b) * 2 + (h)) * HTB)
#define PG8_SB(b, h) ((4 + (b) * 2 + (h)) * HTB)
#define PG8_STAGE(bufoff, gbase, voff) do { _Pragma("unroll") for (int _i = 0; _i < 2; ++_i) \
        __builtin_amdgcn_global_load_lds((const unsigned*)((const char*)(gbase) + (voff)[_i]), (PG8_LAS unsigned*)(lds + (bufoff) + ldsw + _i * 8192), 16, 0, 0); } while (0)
#define PG8_LDA(dst, b, h) do { _Pragma("unroll") for (int m = 0; m < 4; ++m) _Pragma("unroll") for (int k = 0; k < 2; ++k) dst[m][k] = *(const PG8_LAS bf16x8*)(lds + PG8_SA(b, h) + aoff + m * 2048 + k * 1024); } while (0)
#define PG8_LDB(dst, b, h) do { _Pragma("unroll") for (int n = 0; n < 2; ++n) _Pragma("unroll") for (int k = 0; k < 2; ++k) dst[n][k] = *(const PG8_LAS bf16x8*)(lds + PG8_SB(b, h) + boff + n * 2048 + k * 1024); } while (0)
#define PG8_MMA(ai, bj, At, Bt) do { __builtin_amdgcn_s_setprio(1); _Pragma("unroll") for (int m = 0; m < 4; ++m) _Pragma("unroll") for (int n = 0; n < 2; ++n) _Pragma("unroll") for (int k = 0; k < 2; ++k) \
        acc[ai][bj][m][n] = __builtin_amdgcn_mfma_f32_16x16x32_bf16(Bt[n][k], At[m][k], acc[ai][bj][m][n], 0, 0, 0); __builtin_amdgcn_s_setprio(0); } while (0)
#define PG8_WAIT_V(n) asm volatile("s_waitcnt vmcnt(" #n ")" ::: "memory")
#define PG8_WAIT_L(n) asm volatile("s_waitcnt lgkmcnt(" #n ")" ::: "memory")
#define PG8_BAR __builtin_amdgcn_s_barrier()
#define PG8_SCHED __builtin_amdgcn_sched_barrier(0)
    Unit cur, nxt; int ui = 0;
    if (!S.next(0, cur)) return;
    f32x4 acc[2][2][4][2];
#pragma unroll
    for (int a = 0; a < 2; ++a)
#pragma unroll
        for (int b = 0; b < 2; ++b)
#pragma unroll
            for (int m = 0; m < 4; ++m)
#pragma unroll
                for (int n = 0; n < 2; ++n) acc[a][b][m][n] = (f32x4){0.f, 0.f, 0.f, 0.f};
    bf16x8 At[4][2], B0[2][2], B1[2][2];
    const char* cA = (const char*)g.A + (size_t)cur.pm * tstep; const char* cB = (const char*)g.Bt + (size_t)cur.pn * tstep;
    S.a_ready(cur);
    PG8_STAGE(PG8_SB(0, 0), cB, voffB); PG8_STAGE(PG8_SA(0, 0), cA, voffA); PG8_STAGE(PG8_SB(0, 1), cB + hstep, voffB); PG8_STAGE(PG8_SA(0, 1), cA + hstep, voffA);
    if (wr == 1) PG8_BAR;
    PG8_WAIT_V(4); PG8_BAR;
    PG8_STAGE(PG8_SB(1, 0), cB + kstep, voffB); PG8_STAGE(PG8_SA(1, 0), cA + kstep, voffA); PG8_STAGE(PG8_SB(1, 1), cB + hstep + kstep, voffB);
    PG8_WAIT_V(6); PG8_BAR;
    PG8_STAMP();
    for (;;) {
        const bool has_next = S.next(ui + 1, nxt);
        const char* nA = has_next ? (const char*)g.A + (size_t)nxt.pm * tstep : cA; const char* nB = has_next ? (const char*)g.Bt + (size_t)nxt.pn * tstep : cB;
        for (int t = 0; t < nt; t += 2) {
            const bool last = (t == nt - 2);
            const char* a1 = cA + (size_t)(t + 1) * kstep;
            const char* a2 = last ? nA : cA + (size_t)(t + 2) * kstep; const char* b2 = last ? nB : cB + (size_t)(t + 2) * kstep;
            const char* a3 = a2 + kstep; const char* b3 = b2 + kstep;
            if (last && has_next) S.a_ready(nxt);
            PG8_LDB(B0, 0, 0); PG8_SCHED; PG8_LDA(At, 0, 0); PG8_STAGE(PG8_SA(1, 1), a1 + hstep, voffA);
            PG8_WAIT_L(8); PG8_BAR; PG8_WAIT_L(0); PG8_MMA(0, 0, At, B0); PG8_BAR; PG8_SCHED;
            PG8_LDB(B1, 0, 1); PG8_STAGE(PG8_SB(0, 0), b2, voffB);
            PG8_BAR; PG8_WAIT_L(0); PG8_MMA(0, 1, At, B1); PG8_BAR;
            PG8_LDA(At, 0, 1); PG8_STAGE(PG8_SA(0, 0), a2, voffA);
            PG8_BAR; PG8_WAIT_L(0); PG8_MMA(1, 0, At, B0); PG8_BAR; PG8_SCHED;
            PG8_STAGE(PG8_SB(0, 1), b2 + hstep, voffB);
            PG8_WAIT_V(6); PG8_BAR; PG8_MMA(1, 1, At, B1); PG8_BAR;
            PG8_LDB(B0, 1, 0); PG8_SCHED; PG8_LDA(At, 1, 0); PG8_STAGE(PG8_SA(0, 1), a2 + hstep, voffA);
            PG8_WAIT_L(8); PG8_BAR; PG8_WAIT_L(0); PG8_MMA(0, 0, At, B0); PG8_BAR; PG8_SCHED;
            PG8_LDB(B1, 1, 1); PG8_STAGE(PG8_SB(1, 0), b3, voffB);
            PG8_BAR; PG8_WAIT_L(0); PG8_MMA(0, 1, At, B1); PG8_BAR;
            PG8_LDA(At, 1, 1); PG8_STAGE(PG8_SA(1, 0), a3, voffA);
            PG8_BAR; PG8_WAIT_L(0); PG8_MMA(1, 0, At, B0); PG8_BAR; PG8_SCHED;
            PG8_STAGE(PG8_SB(1, 1), b3 + hstep, voffB);
            PG8_WAIT_V(6); PG8_BAR; PG8_MMA(1, 1, At, B1); PG8_BAR;
        }
        PG8_STAMP();
        if constexpr (!Epi::AFTER_DRAIN) { E(acc, cur, wr, wc, fr, fq); S.done(cur); }
        PG8_STAMP();
        if (!has_next) break;
#pragma unroll
        for (int a = 0; a < 2; ++a)
#pragma unroll
            for (int b = 0; b < 2; ++b)
#pragma unroll
                for (int m = 0; m < 4; ++m)
#pragma unroll
                    for (int n = 0; n < 2; ++n) acc[a][b][m][n] = (f32x4){0.f, 0.f, 0.f, 0.f};
        cur = nxt; cA = nA; cB = nB; ++ui;
    }
    PG8_WAIT_V(0);
    if (wr == 0) PG8_BAR;
    PG8_BAR;
    if constexpr (Epi::AFTER_DRAIN) { E.fused(acc, cur, wr, wc, fr, fq, lds, wid, lane); S.done(cur); }
    PG8_STAMP();
    if (STAMP && wid == 0) { stamps[lane] = lane < nts ? (((unsigned long long)(unsigned)ts_hi << 32) | (unsigned)ts_lo) : 0ull;
        if (lane == 62) stamps[62] = rt_entry; if (lane == 63) stamps[63] = (unsigned long long)wall_clock64(); }
#undef PG8_STAMP
#undef PG8_SA
#undef PG8_SB
#undef PG8_STAGE
#undef PG8_LDA
#undef PG8_LDB
#undef PG8_MMA
#undef PG8_WAIT_V
#undef PG8_WAIT_L
#undef PG8_BAR
#undef PG8_SCHED
}
}
#define XB_TMO      128
#define XB_XCNT(j)  (256  + 64 * (j))
#define XB_XSUB(j)  (1280 + 64 * (j))
#define XB_XGEN(j)  (2304 + 64 * (j))
#define XB_TOP      3328
#define XB_TOPGEN   3392
#define XCD_BAR_WORDS 3456
#define XB_SPIN_CAP (1u << 18)
#define LAS __attribute__((address_space(3)))

__device__ __forceinline__ unsigned xb_ld(unsigned* p)              { return __hip_atomic_load(p, __ATOMIC_RELAXED, __HIP_MEMORY_SCOPE_AGENT); }
__device__ __forceinline__ unsigned xb_add(unsigned* p, unsigned v) { return __hip_atomic_fetch_add(p, v, __ATOMIC_RELAXED, __HIP_MEMORY_SCOPE_AGENT); }
__device__ __forceinline__ unsigned xb_xcc_id() { return (unsigned)__builtin_amdgcn_s_getreg((3 << 11) | 20) & 0xFu; }
#define XB_SPIN(cond, bar) do { unsigned _sp = 0; while (cond) { __builtin_amdgcn_s_sleep(1); \
    if ((++_sp & 255u) == 0u) { if (xb_ld(&(bar)[XB_TMO])) break; if (_sp > XB_SPIN_CAP) { atomicAdd(&(bar)[XB_TMO], 1u); break; } } } } while (0)

struct XcdBarrier {
    unsigned* bar; unsigned x;
    volatile LAS unsigned* st;
};

__device__ __forceinline__ XcdBarrier xcd_barrier_post(unsigned* bar, volatile LAS unsigned* st) {
    XcdBarrier b; b.bar = bar; b.x = xb_xcc_id(); b.st = st;
    if (threadIdx.x == 0) (void)xb_add(&bar[XB_XCNT(b.x)], 1u);
    return b;
}
__device__ __forceinline__ void xcd_barrier_complete(unsigned* bar, unsigned x, unsigned& nloc, unsigned& nx) {
    const unsigned G = gridDim.x * gridDim.y * gridDim.z;
    unsigned sum, cnt, mine, sp = 0u;
    for (;;) {
        sum = 0u; cnt = 0u; mine = 0u;
#pragma unroll
        for (unsigned j = 0; j < 16; ++j) { const unsigned c = xb_ld(&bar[XB_XCNT(j)]); sum += c; cnt += (c > 0u) ? 1u : 0u; mine = (j == x) ? c : mine; }
        if (sum == G) break;
        __builtin_amdgcn_s_sleep(1);
        if ((++sp & 255u) == 0u) { if (xb_ld(&bar[XB_TMO])) break; if (sp > XB_SPIN_CAP) { atomicAdd(&bar[XB_TMO], 1u); break; } }
    }
    nloc = mine > 0u ? mine : 1u; nx = cnt > 0u ? cnt : 1u;
}

__device__ __forceinline__ void xcd_barrier(const XcdBarrier& b) {
    asm volatile("s_waitcnt vmcnt(0)" ::: "memory");
    __syncthreads();
    if (threadIdx.x == 0) {
        unsigned* bar = b.bar;
        __builtin_amdgcn_s_waitcnt(0);
        unsigned nloc = b.st[0], nx = b.st[1];
        if (nloc == 0u) { xcd_barrier_complete(bar, b.x, nloc, nx); b.st[0] = nloc; b.st[1] = nx; }
        const unsigned old = xb_add(&bar[XB_XSUB(b.x)], 1u);
        const unsigned gen = old / nloc;
        if (old + 1u == (gen + 1u) * nloc) {
            __builtin_amdgcn_fence(__ATOMIC_RELEASE, "agent");
            asm volatile("s_waitcnt vmcnt(0)" ::: "memory");
            const unsigned og = xb_add(&bar[XB_TOP], 1u);
            const unsigned tg = og / nx;
            if (og + 1u == (tg + 1u) * nx) xb_add(&bar[XB_TOPGEN], 1u);
            else XB_SPIN(xb_ld(&bar[XB_TOPGEN]) == tg, bar);
            __builtin_amdgcn_fence(__ATOMIC_ACQUIRE, "agent");
            xb_add(&bar[XB_XGEN(b.x)], 1u);
            asm volatile("s_waitcnt vmcnt(0)" ::: "memory");
        } else {
            XB_SPIN(xb_ld(&bar[XB_XGEN(b.x)]) == gen, bar);
            __builtin_amdgcn_fence(__ATOMIC_ACQUIRE, "agent");
            asm volatile("s_waitcnt vmcnt(0)" ::: "memory");
        }
    }
    __syncthreads();
}


#ifndef MK_N_LAUNCHES
#define MK_N_LAUNCHES 1
#endif
namespace mk {
typedef unsigned short bf16_t;
typedef float f32x4 __attribute__((ext_vector_type(4)));
typedef short bf16x8 __attribute__((ext_vector_type(8)));
typedef short s16x4 __attribute__((ext_vector_type(4)));
typedef unsigned u32x4 __attribute__((ext_vector_type(4)));
typedef unsigned u32x2 __attribute__((ext_vector_type(2)));
typedef float f32x2 __attribute__((ext_vector_type(2)));
constexpr int D = 2048, NTOK_P = 16384, NTOK_S = 256, NTOK = 16640;
constexpr int DIN = 5632, DATT = 1536, DLRU = 512, NH = 12, HD = 128;
constexpr int NEXP = 16384;
constexpr float ALPHA = 1.189207115002721f;
constexpr float LN_EPS = 1e-5f;
constexpr float ATT_SCALE = 0.08838834764831845f;
constexpr float LOG2E = 1.4426950408889634f;
constexpr size_t O_YP = 0, O_YS = 33554432, O_KP = 34078720, O_VP = 59244544, O_CP = 84410368, O_HP = 84422656,
                 O_KS = 84426752, O_VS = 185090048, O_CS = 285753344, O_HS = 285802496, O_END = 285818880;
constexpr size_t WS_CTL = 0;
constexpr size_t WS_XB = 65536;
constexpr size_t WS_WINT = WS_XB + (size_t)NTOK * D * 2;
constexpr size_t WS_WOT = WS_WINT + (size_t)DIN * D * 2;
constexpr size_t WS_WQT = WS_WOT + (size_t)D * D * 2;
constexpr size_t WS_UB = WS_WQT + (size_t)D * D * 2;
constexpr size_t WS_VB = WS_UB + (size_t)NEXP * D * 2;
constexpr size_t WS_QF = WS_VB + (size_t)NEXP * D * 2;
constexpr size_t WS_XR = WS_QF + (size_t)NTOK * DATT * 4;
constexpr size_t WS_GATE = WS_XR + (size_t)NTOK * DLRU * 4;
constexpr size_t WS_AR = WS_GATE + (size_t)NTOK * DLRU * 4;
constexpr size_t WS_PRE1 = WS_AR + (size_t)NTOK * D * 2;
constexpr size_t WS_X1F = WS_PRE1 + (size_t)NTOK * D * 4;
constexpr size_t WS_X1B = WS_X1F + (size_t)NTOK * D * 4;
constexpr size_t WS_QP = WS_X1B + (size_t)NTOK * D * 2;
constexpr size_t WS_EIDX = WS_QP + (size_t)NTOK * D * 4;
constexpr size_t WS_GW = WS_EIDX + (size_t)NTOK * 128 * 4;
constexpr size_t WS_SU = WS_GW + (size_t)NTOK * 128 * 4;
constexpr size_t WS_SV = WS_SU + (size_t)NEXP * 4;
constexpr size_t WS_SX = WS_SV + (size_t)NEXP * 4;
constexpr size_t WS_X1Q = WS_SX + (size_t)NTOK * 4;
constexpr size_t WS_SKB = WS_X1Q + (size_t)NTOK * D;
constexpr size_t WS_QB = WS_SKB + (size_t)8 * 2 * 128 * 128 * 2;
constexpr size_t WS_KB = WS_QB + (size_t)NTOK * DATT * 2;
constexpr size_t WS_VB16 = WS_KB + (size_t)NTOK_P * DATT * 2;
constexpr size_t WS_PO = WS_VB16 + (size_t)NTOK_P * DATT * 2;
constexpr size_t WS_PM = WS_PO + (size_t)2 * NTOK_P * DATT * 2;
constexpr size_t WS_PL = WS_PM + (size_t)2 * NTOK_P * NH * 4;
constexpr size_t WS_R0 = WS_PL + (size_t)2 * NTOK_P * NH * 4;
constexpr size_t WS_R1 = WS_R0 + (size_t)NTOK_P * DLRU * 4;
constexpr size_t WS_HE = WS_R1 + (size_t)NTOK_P * DLRU * 4;
constexpr size_t WS_AE = WS_HE + (size_t)8 * 32 * 512 * 4;
constexpr size_t WS_LW = WS_AE + (size_t)8 * 32 * 512 * 4;
constexpr size_t WS_PS = WS_LW + (size_t)2 * 8 * 64 * 64 * 2;
constexpr size_t WS_END = WS_PS + (size_t)32 * 12 * 9 * 8 * 130 * 4;

constexpr int NTHREADS = 512;
constexpr int LDS_BYTES = 148480;
constexpr int MISC_OFF = 147456;

struct Params {
    const float* x_prompt; const float* x_sample; const float* cache_k; const float* cache_v; const float* state_conv; const float* state_h;
    const float* w_in; const float* conv_w; const float* conv_b; const float* lru_w_a; const float* lru_b_a; const float* lru_w_x; const float* lru_b_x;
    const float* lru_lambda; const float* w_out; const float* ln1_g; const float* ln1_b; const float* w_query; const float* sub_keys;
    const float* peer_u; const float* peer_v; const float* ln2_g; const float* ln2_b;
    float* out; unsigned char* ws; int ph_lo, ph_hi;
};

__device__ __forceinline__ unsigned f2bf(float f) { unsigned u = __float_as_uint(f); u += 0x7fffu + ((u >> 16) & 1u); return u >> 16; }
__device__ __forceinline__ unsigned pack2(float a, float b) { return f2bf(a) | (f2bf(b) << 16); }
__device__ __forceinline__ float bflo(unsigned w) { return __uint_as_float(w << 16); }
__device__ __forceinline__ float bfhi(unsigned w) { return __uint_as_float(w & 0xffff0000u); }
__device__ __forceinline__ float wave_sum(float v) {
#pragma unroll
    for (int o = 32; o >= 1; o >>= 1) v += __shfl_xor(v, o);
    return v;
}
__device__ __forceinline__ float wave_max(float v) {
#pragma unroll
    for (int o = 32; o >= 1; o >>= 1) v = fmaxf(v, __shfl_xor(v, o));
    return v;
}
__device__ __forceinline__ float gelu_exact(float v) { return 0.5f * v * (1.0f + erff(v * 0.7071067811865476f)); }
__device__ __forceinline__ float gelu_as(float v) {
    const float av = fabsf(v), t = __builtin_amdgcn_rcpf(av * 0.2316418882f + 1.0f);
    float q = t * 0.5307027145f + (-0.7265760135f); q = q * t + 0.7107068705f; q = q * t + (-0.142248368f); q = q * t + 0.127414796f; q = q * t;
    const float e = __builtin_amdgcn_exp2f((v * v) * (-0.72134752044f));
    const float m = v * (q * e);
    return v < 0.f ? m : v - m;
}
__device__ __forceinline__ float sigmoidf(float v) { return 1.0f / (1.0f + expf(-v)); }
__device__ __forceinline__ float readlane_f(float v, int l) { return __int_as_float(__builtin_amdgcn_readlane(__float_as_int(v), l)); }

__device__ __forceinline__ void convert_flat(const float* src, bf16_t* dst, size_t n8, size_t gtid, size_t gstride) {
    for (size_t i = gtid; i < n8; i += gstride) {
        const float4 a = ((const float4*)src)[2 * i], b = ((const float4*)src)[2 * i + 1];
        uint4 w; w.x = pack2(a.x, a.y); w.y = pack2(a.z, a.w); w.z = pack2(b.x, b.y); w.w = pack2(b.z, b.w);
        ((uint4*)dst)[i] = w;
    }
}
__device__ __forceinline__ void transpose_convert(const float* src, bf16_t* dst, int K, int N, LAS float* tile) {
    const int tid = threadIdx.x, ntn = N / 64, ntiles = (K / 64) * ntn;
    for (int tl = blockIdx.x; tl < ntiles; tl += gridDim.x) {
        const int kt = tl / ntn, nt = tl - kt * ntn;
#pragma unroll
        for (int i = 0; i < 8; ++i) { const int r = (tid >> 6) + 8 * i, c = tid & 63; tile[r * 65 + c] = src[(size_t)(kt * 64 + r) * N + nt * 64 + c]; }
        __syncthreads();
#pragma unroll
        for (int i = 0; i < 4; ++i) { const int n = (tid >> 5) + 16 * i, k0 = 2 * (tid & 31);
            const unsigned v = pack2(tile[k0 * 65 + n], tile[(k0 + 1) * 65 + n]);
            *(unsigned*)(dst + (size_t)(nt * 64 + n) * K + kt * 64 + k0) = v; }
        __syncthreads();
    }
}
constexpr int TROW = 1152;
__device__ __forceinline__ void quant_tables(const Params& P) {
    const int lane = threadIdx.x & 63, gw = blockIdx.x * 8 + (threadIdx.x >> 6), nw = gridDim.x * 8;
    for (int it = gw; it < 2 * NEXP; it += nw) {
        const bool isv = it >= NEXP; const int row = isv ? it - NEXP : it;
        const float* src = (isv ? P.peer_v : P.peer_u) + (size_t)row * D;
        float4 v[8]; float cm[2];
#pragma unroll
        for (int j = 0; j < 2; ++j) { float am = 0.f;
#pragma unroll
            for (int i = 0; i < 4; ++i) { const float4 t = *(const float4*)(src + j * 1024 + lane * 16 + i * 4); v[j * 4 + i] = t; am = fmaxf(am, fmaxf(fmaxf(fabsf(t.x), fabsf(t.y)), fmaxf(fabsf(t.z), fabsf(t.w)))); }
            cm[j] = am; }
        float rm = wave_max(fmaxf(cm[0], cm[1])); if (rm == 0.f) rm = 1.f;
        unsigned char* dst = P.ws + (isv ? WS_VB : WS_UB) + (size_t)row * TROW;
        u32x4 w; unsigned sqp = 0u;
#pragma unroll
        for (int j = 0; j < 2; ++j) {
            int sq = (int)ceilf(cm[j] / rm * 255.0f); sq = sq < 1 ? 1 : (sq > 255 ? 255 : sq);
            sqp |= (unsigned)sq << (8 * j);
            const float inv = (255.0f * 7.0f) / (rm * (float)sq);
#pragma unroll
            for (int hh = 0; hh < 2; ++hh) { unsigned dw = 0u;
#pragma unroll
                for (int e = 0; e < 8; ++e) { const float4 t = v[j * 4 + hh * 2 + (e >> 2)]; const float x = (e & 3) == 0 ? t.x : ((e & 3) == 1 ? t.y : ((e & 3) == 2 ? t.z : t.w));
                    int n = (int)rintf(x * inv); n = n < -7 ? -7 : (n > 7 ? 7 : n); dw |= (unsigned)(isv ? n + 8 : (n & 15)) << (4 * e); }
                w[j * 2 + hh] = dw; }
        }
        *(u32x4*)(dst + lane * 16) = w;
        *(unsigned short*)(dst + 1024 + lane * 2) = (unsigned short)sqp;
        if (lane == 0) ((float*)(P.ws + (isv ? WS_SV : WS_SU)))[row] = rm * (1.0f / (255.0f * 7.0f));
    }
}
__device__ __forceinline__ void phase_prologue(const Params& P, LAS unsigned char* lds) {
    const size_t gtid = (size_t)blockIdx.x * NTHREADS + threadIdx.x, gstride = (size_t)gridDim.x * NTHREADS;
    unsigned char* ws = P.ws;
    convert_flat(P.x_prompt, (bf16_t*)(ws + WS_XB), (size_t)NTOK_P * D / 8, gtid, gstride);
    convert_flat(P.x_sample, (bf16_t*)(ws + WS_XB) + (size_t)NTOK_P * D, (size_t)NTOK_S * D / 8, gtid, gstride);
    convert_flat(P.sub_keys, (bf16_t*)(ws + WS_SKB), (size_t)8 * 2 * 128 * 128 / 8, gtid, gstride);
    for (size_t i = gtid; i < (size_t)2 * 8 * 64 * 64; i += gstride) {
        const int c = (int)(i & 63), d = (int)((i >> 6) & 63), n = (int)((i >> 12) & 7), m = (int)(i >> 15);
        ((bf16_t*)(ws + WS_LW))[i] = (bf16_t)f2bf((m ? P.lru_w_x : P.lru_w_a)[(n * 64 + c) * 64 + d]); }
    transpose_convert(P.w_in, (bf16_t*)(ws + WS_WINT), D, DIN, (LAS float*)lds);
    transpose_convert(P.w_out, (bf16_t*)(ws + WS_WOT), D, D, (LAS float*)lds);
    transpose_convert(P.w_query, (bf16_t*)(ws + WS_WQT), D, D, (LAS float*)lds);
}

struct EpiProj {
    static constexpr bool PERM = true, AFTER_DRAIN = false;
    float* out; bf16_t* XR; bf16_t* GATE; bf16_t* QB; bf16_t* KB; bf16_t* VB16;
    __device__ __forceinline__ void operator()(const f32x4 (&acc)[2][2][4][2], const pg8::Unit& u, int wr, int wc, int fr, int fq) const {
        const int pn = u.pn; const int coff = wc * 32 + 8 * fq;
#pragma unroll
        for (int ai = 0; ai < 2; ++ai)
#pragma unroll
            for (int m = 0; m < 4; ++m) {
                const int row = u.pm * 256 + ai * 128 + wr * 64 + m * 16 + fr;
                const bool prompt = row < NTOK_P;
                float* rowp = nullptr; bf16_t* rowb = nullptr; float bsc = 1.0f;
                if (pn < 6) { rowb = QB + (size_t)row * DATT + pn * 256; bsc = ATT_SCALE * LOG2E; }
                else if (pn < 18) {
                    const int isv = pn >= 12; const int c0 = (pn - (isv ? 12 : 6)) * 256;
                    if (prompt) { rowp = out + (isv ? O_VP : O_KP) + (size_t)row * DATT + c0; rowb = (isv ? VB16 : KB) + (size_t)row * DATT + c0; }
                    else { const int rr = row - NTOK_P, b = rr >> 3, t = rr & 7; rowp = out + (isv ? O_VS : O_KS) + ((size_t)b * 2048 + 2040 + t) * DATT + c0; }
                } else if (pn < 20) rowb = XR + (size_t)row * DLRU + (pn - 18) * 256;
                else rowb = GATE + (size_t)row * DLRU + (pn - 20) * 256;
#pragma unroll
                for (int bj = 0; bj < 2; ++bj) {
                    const f32x4 v0 = acc[ai][bj][m][0], v1 = acc[ai][bj][m][1];
                    if (rowp) { *(f32x4*)(rowp + coff + bj * 128) = v0; *(f32x4*)(rowp + coff + bj * 128 + 4) = v1; }
                    if (rowb) { u32x4 w; w.x = pg8::cvt_pk_bf16(v0[0] * bsc, v0[1] * bsc); w.y = pg8::cvt_pk_bf16(v0[2] * bsc, v0[3] * bsc); w.z = pg8::cvt_pk_bf16(v1[0] * bsc, v1[1] * bsc); w.w = pg8::cvt_pk_bf16(v1[2] * bsc, v1[3] * bsc);
                        *(u32x4*)(rowb + coff + bj * 128) = w; }
                }
            }
    }
};
struct EpiOut {
    static constexpr bool PERM = true, AFTER_DRAIN = false;
    const bf16_t* xb; bf16_t* pre;
    __device__ __forceinline__ void operator()(const f32x4 (&acc)[2][2][4][2], const pg8::Unit& u, int wr, int wc, int fr, int fq) const {
        const int col0 = u.pn * 256 + wc * 32 + 8 * fq;
#pragma unroll
        for (int ai = 0; ai < 2; ++ai)
#pragma unroll
            for (int m = 0; m < 4; ++m) {
                const int row = u.pm * 256 + ai * 128 + wr * 64 + m * 16 + fr;
                const bf16_t* xr = xb + (size_t)row * D + col0; bf16_t* pr = pre + (size_t)row * D + col0;
#pragma unroll
                for (int bj = 0; bj < 2; ++bj) {
                    const u32x4 xv = *(const u32x4*)(xr + bj * 128); const f32x4 v0 = acc[ai][bj][m][0], v1 = acc[ai][bj][m][1];
                    u32x4 w;
                    w.x = pg8::cvt_pk_bf16(ALPHA * bflo(xv.x) + v0[0], ALPHA * bfhi(xv.x) + v0[1]); w.y = pg8::cvt_pk_bf16(ALPHA * bflo(xv.y) + v0[2], ALPHA * bfhi(xv.y) + v0[3]);
                    w.z = pg8::cvt_pk_bf16(ALPHA * bflo(xv.z) + v1[0], ALPHA * bfhi(xv.z) + v1[1]); w.w = pg8::cvt_pk_bf16(ALPHA * bflo(xv.w) + v1[2], ALPHA * bfhi(xv.w) + v1[3]);
                    *(u32x4*)(pr + bj * 128) = w;
                }
            }
    }
};
struct EpiPlain {
    static constexpr bool PERM = false, AFTER_DRAIN = false;
    float* C; int ldc;
    __device__ __forceinline__ void operator()(const f32x4 (&acc)[2][2][4][2], const pg8::Unit& u, int wr, int wc, int fr, int fq) const {
        const int col0 = u.pn * 256 + wc * 32 + 4 * fq;
#pragma unroll
        for (int ai = 0; ai < 2; ++ai)
#pragma unroll
            for (int m = 0; m < 4; ++m) {
                const int row = u.pm * 256 + ai * 128 + wr * 64 + m * 16 + fr;
                float* pr = C + (size_t)row * ldc + col0;
#pragma unroll
                for (int bj = 0; bj < 2; ++bj)
#pragma unroll
                    for (int n = 0; n < 2; ++n) *(f32x4*)(pr + bj * 128 + n * 16) = acc[ai][bj][m][n];
            }
    }
};

struct EpiBf16Plain {
    static constexpr bool PERM = true, AFTER_DRAIN = false;
    bf16_t* C; int ldc;
    __device__ __forceinline__ void operator()(const f32x4 (&acc)[2][2][4][2], const pg8::Unit& u, int wr, int wc, int fr, int fq) const {
        const int col0 = u.pn * 256 + wc * 32 + 8 * fq;
#pragma unroll
        for (int ai = 0; ai < 2; ++ai)
#pragma unroll
            for (int m = 0; m < 4; ++m) {
                const int row = u.pm * 256 + ai * 128 + wr * 64 + m * 16 + fr;
                bf16_t* pr = C + (size_t)row * ldc + col0;
#pragma unroll
                for (int bj = 0; bj < 2; ++bj) { const f32x4 v0 = acc[ai][bj][m][0], v1 = acc[ai][bj][m][1]; u32x4 w;
                    w.x = pg8::cvt_pk_bf16(v0[0], v0[1]); w.y = pg8::cvt_pk_bf16(v0[2], v0[3]); w.z = pg8::cvt_pk_bf16(v1[0], v1[1]); w.w = pg8::cvt_pk_bf16(v1[2], v1[3]);
                    *(u32x4*)(pr + bj * 128) = w; }
            }
    }
};

template <int MODE>
__device__ __forceinline__ void sample_rows_gemm(const Params& P, const bf16_t* A, const bf16_t* Wt, LAS unsigned char* lds) {
    const int tid = threadIdx.x, lane = tid & 63, w = __builtin_amdgcn_readfirstlane(tid >> 6);
    const int c = lane & 15, g = lane >> 4;
    for (int tile = blockIdx.x; tile < 256; tile += gridDim.x) {
        const int tg = tile & 7, cg = tile >> 3;
        const int k0 = 256 * w;
        const bf16_t* wp = Wt + (size_t)(64 * cg + c) * D + k0 + 8 * g;
        const bf16_t* xp = A + (size_t)(NTOK_P + 32 * tg + c) * D + k0 + 8 * g;
        f32x4 acc[4][2];
#pragma unroll
        for (int ct = 0; ct < 4; ++ct) { acc[ct][0] = (f32x4){0.f, 0.f, 0.f, 0.f}; acc[ct][1] = (f32x4){0.f, 0.f, 0.f, 0.f}; }
#pragma unroll 4
        for (int ks = 0; ks < 8; ++ks) {
            bf16x8 wf[4], xf[2];
#pragma unroll
            for (int ct = 0; ct < 4; ++ct) wf[ct] = *(const bf16x8*)(wp + (size_t)(16 * ct) * D + 32 * ks);
#pragma unroll
            for (int tt = 0; tt < 2; ++tt) xf[tt] = *(const bf16x8*)(xp + (size_t)(16 * tt) * D + 32 * ks);
#pragma unroll
            for (int ct = 0; ct < 4; ++ct)
#pragma unroll
                for (int tt = 0; tt < 2; ++tt) acc[ct][tt] = __builtin_amdgcn_mfma_f32_16x16x32_bf16(wf[ct], xf[tt], acc[ct][tt], 0, 0, 0);
        }
        LAS float* part = (LAS float*)lds;
#pragma unroll
        for (int ct = 0; ct < 4; ++ct)
#pragma unroll
            for (int tt = 0; tt < 2; ++tt) *(LAS f32x4*)(part + ((w * 32 + 16 * tt + c) * 64 + 16 * ct + 4 * g)) = acc[ct][tt];
        __syncthreads();
        {
            const int tok = tid >> 4, c4 = (tid & 15) * 4;
            f32x4 sum = {0.f, 0.f, 0.f, 0.f};
#pragma unroll
            for (int ww = 0; ww < 8; ++ww) sum += *(const LAS f32x4*)(part + ((ww * 32 + tok) * 64 + c4));
            const int row = NTOK_P + 32 * tg + tok, col = 64 * cg + c4;
            if (MODE == 0) { const f32x4 xv = *(const f32x4*)(P.x_sample + (size_t)(row - NTOK_P) * D + col); const f32x4 r = xv * ALPHA + sum; u32x2 wv; wv.x = pg8::cvt_pk_bf16(r[0], r[1]); wv.y = pg8::cvt_pk_bf16(r[2], r[3]); *(u32x2*)((bf16_t*)(P.ws + WS_PRE1) + (size_t)row * D + col) = wv; }
            else { u32x2 wv; wv.x = pg8::cvt_pk_bf16(sum[0], sum[1]); wv.y = pg8::cvt_pk_bf16(sum[2], sum[3]); *(u32x2*)((bf16_t*)(P.ws + WS_QP) + (size_t)row * D + col) = wv; }
        }
        __syncthreads();
    }
}

constexpr int KVS = 288, VOFF = 73728;
template <int MODE>
__device__ __forceinline__ void attn_unit(const Params& P, int p, int b, int h, int r, int c, LAS unsigned char* lds) {
    const int tid = threadIdx.x, lane = tid & 63, w = __builtin_amdgcn_readfirstlane(tid >> 6);
    const int dil = 1 << (2 * p);
    const bf16_t* Qb = (const bf16_t*)(P.ws + WS_QB); const bf16_t* Kb = (const bf16_t*)(P.ws + WS_KB); const bf16_t* Vb = (const bf16_t*)(P.ws + WS_VB16);
    const size_t tok0 = (size_t)b * 2048;
    const int j0 = 128 * c - 128, rho0 = (c == 0) ? 128 : 0;
#pragma unroll
    for (int it = 0; it < 8; ++it) {
        const int rho = it * 32 + (tid >> 4), ch = tid & 15;
        if (rho >= rho0) {
            const size_t tok = tok0 + (size_t)((j0 + rho) * dil + r);
            const u32x4 kv = *(const u32x4*)(Kb + tok * DATT + h * HD + ch * 8);
            const u32x4 vv = *(const u32x4*)(Vb + tok * DATT + h * HD + ch * 8);
            *(LAS u32x4*)(lds + rho * KVS + ch * 16) = kv;
            *(LAS u32x4*)(lds + VOFF + rho * KVS + ch * 16) = vv;
        }
    }
    const int cq = lane & 15, g = lane >> 4;
    const int iq = 128 * c + 16 * w + cq;
    const size_t qtok = tok0 + (size_t)(iq * dil + r);
    bf16x8 qf[4];
#pragma unroll
    for (int ks = 0; ks < 4; ++ks) qf[ks] = *(const bf16x8*)(Qb + qtok * DATT + h * HD + 32 * ks + 8 * g);
    __syncthreads();
    const int ktmin = (8 - w - 8 * c) > 0 ? (8 - w - 8 * c) : 0;
    const float slope2 = exp2f(-8.0f * (float)(h + 1) / 12.0f) * LOG2E * (float)dil;
    f32x4 s[9]; float m = -INFINITY;
#pragma unroll
    for (int kt = 0; kt < 9; ++kt) {
        if (kt >= ktmin) {
            f32x4 acc = {0.f, 0.f, 0.f, 0.f};
#pragma unroll
            for (int ks = 0; ks < 4; ++ks) { const bf16x8 kf = *(const LAS bf16x8*)(lds + (16 * w + 16 * kt + cq) * KVS + (32 * ks + 8 * g) * 2); acc = __builtin_amdgcn_mfma_f32_16x16x32_bf16(kf, qf[ks], acc, 0, 0, 0); }
#pragma unroll
            for (int ii = 0; ii < 4; ++ii) { const int dist = cq + 128 - 16 * kt - 4 * g - ii; float v = acc[ii] - slope2 * (float)dist;
                if (kt == 0 && dist > 128) v = -INFINITY; if (kt == 8 && dist < 0) v = -INFINITY; acc[ii] = v; m = fmaxf(m, v); }
            s[kt] = acc;
        } else s[kt] = (f32x4){-INFINITY, -INFINITY, -INFINITY, -INFINITY};
    }
    m = fmaxf(m, __shfl_xor(m, 16)); m = fmaxf(m, __shfl_xor(m, 32));
    float l = 0.f;
#pragma unroll
    for (int kt = 0; kt < 9; ++kt)
#pragma unroll
        for (int ii = 0; ii < 4; ++ii) { const float pp = exp2f(s[kt][ii] - m); s[kt][ii] = pp; l += pp; }
    l += __shfl_xor(l, 16); l += __shfl_xor(l, 32);
    f32x4 o[8];
#pragma unroll
    for (int dt = 0; dt < 8; ++dt) o[dt] = (f32x4){0.f, 0.f, 0.f, 0.f};
#pragma unroll
    for (int kk = 0; kk < 5; ++kk) {
        const int T0 = 2 * kk, T1 = 2 * kk + 1;
        if (T1 >= ktmin || T0 == 8) {
            u32x4 pw; pw.x = pg8::cvt_pk_bf16(s[T0][0], s[T0][1]); pw.y = pg8::cvt_pk_bf16(s[T0][2], s[T0][3]);
            if (T1 <= 8) { pw.z = pg8::cvt_pk_bf16(s[T1 <= 8 ? T1 : 8][0], s[T1 <= 8 ? T1 : 8][1]); pw.w = pg8::cvt_pk_bf16(s[T1 <= 8 ? T1 : 8][2], s[T1 <= 8 ? T1 : 8][3]); } else { pw.z = 0u; pw.w = 0u; }
            const bf16x8 pf = __builtin_bit_cast(bf16x8, pw);
            const int rT0 = (T0 >= ktmin) ? T0 : 8, rT1 = (T1 <= 8 && T1 >= ktmin) ? T1 : 8;
            const int a0 = VOFF + (16 * w + 16 * rT0 + 4 * g + (cq >> 2)) * KVS + 8 * (cq & 3);
            const int a1 = VOFF + (16 * w + 16 * rT1 + 4 * g + (cq >> 2)) * KVS + 8 * (cq & 3);
#pragma unroll
            for (int dt = 0; dt < 8; ++dt) {
                const s16x4 v0 = __builtin_amdgcn_ds_read_tr16_b64_v4i16((LAS s16x4*)(lds + a0 + dt * 32));
                const s16x4 v1 = __builtin_amdgcn_ds_read_tr16_b64_v4i16((LAS s16x4*)(lds + a1 + dt * 32));
                const bf16x8 vf = {v0[0], v0[1], v0[2], v0[3], v1[0], v1[1], v1[2], v1[3]};
                o[dt] = __builtin_amdgcn_mfma_f32_16x16x32_bf16(vf, pf, o[dt], 0, 0, 0);
            }
        }
    }
    const float inv = 1.0f / l;
    if (MODE == 0) {
        bf16_t* po = (bf16_t*)(P.ws + WS_PO) + ((size_t)p * NTOK_P + qtok) * DATT + h * HD + 4 * g;
#pragma unroll
        for (int dt = 0; dt < 8; ++dt) { u32x2 wv; wv.x = pg8::cvt_pk_bf16(o[dt][0] * inv, o[dt][1] * inv); wv.y = pg8::cvt_pk_bf16(o[dt][2] * inv, o[dt][3] * inv); *(u32x2*)(po + 16 * dt) = wv; }
        if (g == 0) { ((float*)(P.ws + WS_PM))[((size_t)p * NTOK_P + qtok) * NH + h] = m; ((float*)(P.ws + WS_PL))[((size_t)p * NTOK_P + qtok) * NH + h] = l; }
    } else {
        const float* PM = (const float*)(P.ws + WS_PM); const float* PL = (const float*)(P.ws + WS_PL);
        const float m0 = PM[qtok * NH + h], l0 = PL[qtok * NH + h], m1 = PM[((size_t)NTOK_P + qtok) * NH + h], l1 = PL[((size_t)NTOK_P + qtok) * NH + h];
        const float M = fmaxf(m, fmaxf(m0, m1));
        const float w2 = exp2f(m - M), w0 = exp2f(m0 - M) * l0, w1 = exp2f(m1 - M) * l1;
        const float rden = 1.0f / (w2 * l + w0 + w1);
        const bf16_t* p0 = (const bf16_t*)(P.ws + WS_PO) + qtok * DATT + h * HD + 4 * g;
        const bf16_t* p1 = p0 + (size_t)NTOK_P * DATT;
        bf16_t* ar = (bf16_t*)(P.ws + WS_AR) + qtok * D + h * HD + 4 * g;
#pragma unroll
        for (int dt = 0; dt < 8; ++dt) {
            const u32x2 x0 = *(const u32x2*)(p0 + 16 * dt), x1 = *(const u32x2*)(p1 + 16 * dt);
            const float r0 = (w2 * o[dt][0] + w0 * bflo(x0.x) + w1 * bflo(x1.x)) * rden, r1 = (w2 * o[dt][1] + w0 * bfhi(x0.x) + w1 * bfhi(x1.x)) * rden;
            const float r2 = (w2 * o[dt][2] + w0 * bflo(x0.y) + w1 * bflo(x1.y)) * rden, r3 = (w2 * o[dt][3] + w0 * bfhi(x0.y) + w1 * bfhi(x1.y)) * rden;
            u32x2 wv; wv.x = pg8::cvt_pk_bf16(r0, r1); wv.y = pg8::cvt_pk_bf16(r2, r3); *(u32x2*)(ar + 16 * dt) = wv;
        }
    }
    __syncthreads();
}

__device__ __forceinline__ void samp_unit(const Params& P, int b, int h, int k, LAS unsigned char* lds) {
    const int tid = threadIdx.x, lane = tid & 63, w = __builtin_amdgcn_readfirstlane(tid >> 6);
    const int cq = lane & 15, g = lane >> 4;
    if (k < 8) {
#pragma unroll 4
        for (int it = 0; it < 16; ++it) {
            const int rho = it * 16 + (tid >> 5), ch4 = tid & 31, c = 256 * k + rho;
            const size_t so = ((size_t)(b * 2048 + c)) * DATT + h * HD + ch4 * 4;
            const float4 kf = *(const float4*)(P.cache_k + so), vf = *(const float4*)(P.cache_v + so);
            if (c >= 8) { const size_t od = ((size_t)(b * 2048 + c - 8)) * DATT + h * HD + ch4 * 4; *(float4*)(P.out + O_KS + od) = kf; *(float4*)(P.out + O_VS + od) = vf; }
            u32x2 kw, vw; kw.x = pg8::cvt_pk_bf16(kf.x, kf.y); kw.y = pg8::cvt_pk_bf16(kf.z, kf.w); vw.x = pg8::cvt_pk_bf16(vf.x, vf.y); vw.y = pg8::cvt_pk_bf16(vf.z, vf.w);
            *(LAS u32x2*)(lds + rho * KVS + ch4 * 8) = kw; *(LAS u32x2*)(lds + VOFF + rho * KVS + ch4 * 8) = vw;
        }
    } else {
        const int rho = tid >> 5, ch4 = tid & 31;
        u32x2 kw = {0u, 0u}, vw = {0u, 0u};
        if (rho < 8) { const size_t so = ((size_t)(b * 2048 + 2040 + rho)) * DATT + h * HD + ch4 * 4; const float4 kf = *(const float4*)(P.out + O_KS + so), vf = *(const float4*)(P.out + O_VS + so);
            kw.x = pg8::cvt_pk_bf16(kf.x, kf.y); kw.y = pg8::cvt_pk_bf16(kf.z, kf.w); vw.x = pg8::cvt_pk_bf16(vf.x, vf.y); vw.y = pg8::cvt_pk_bf16(vf.z, vf.w); }
        *(LAS u32x2*)(lds + rho * KVS + ch4 * 8) = kw; *(LAS u32x2*)(lds + VOFF + rho * KVS + ch4 * 8) = vw;
        *(LAS u32x2*)(lds + (16 + rho) * KVS + ch4 * 8) = (u32x2){0u, 0u}; *(LAS u32x2*)(lds + VOFF + (16 + rho) * KVS + ch4 * 8) = (u32x2){0u, 0u};
    }
    const int t = cq & 7;
    const bf16_t* Qb = (const bf16_t*)(P.ws + WS_QB) + ((size_t)(NTOK_P + b * 8 + t)) * DATT + h * HD;
    bf16x8 qf[4];
#pragma unroll
    for (int ks = 0; ks < 4; ++ks) qf[ks] = *(const bf16x8*)(Qb + 32 * ks + 8 * g);
    __syncthreads();
    const float slope2 = exp2f(-8.0f * (float)(h + 1) / 12.0f) * LOG2E;
    const bool active = (k < 8) || (w == 0);
    f32x4 s[2]; float m = -INFINITY;
#pragma unroll
    for (int j = 0; j < 2; ++j) {
        f32x4 acc = {0.f, 0.f, 0.f, 0.f};
        if (active) {
#pragma unroll
            for (int ks = 0; ks < 4; ++ks) { const bf16x8 kf = *(const LAS bf16x8*)(lds + (32 * w + 16 * j + cq) * KVS + (32 * ks + 8 * g) * 2); acc = __builtin_amdgcn_mfma_f32_16x16x32_bf16(kf, qf[ks], acc, 0, 0, 0); }
        }
#pragma unroll
        for (int ii = 0; ii < 4; ++ii) {
            const int c = 256 * k + 32 * w + 16 * j + 4 * g + ii, dist = 2048 + t - c;
            int mult = (dist <= 128 ? 1 : 0) + (((dist & 3) == 0 && dist <= 512) ? 1 : 0) + (((dist & 15) == 0 && dist <= 2048) ? 1 : 0);
            if (dist < 0 || !active || c > 2055) mult = 0;
            const float v = mult ? acc[ii] - slope2 * (float)dist : -INFINITY;
            acc[ii] = v; m = fmaxf(m, v);
            s[j][ii] = (float)mult;
            s[j][ii] = v;
        }
    }
    m = fmaxf(m, __shfl_xor(m, 16)); m = fmaxf(m, __shfl_xor(m, 32));
    const float mref = (m == -INFINITY) ? 0.f : m;
    float l = 0.f;
#pragma unroll
    for (int j = 0; j < 2; ++j)
#pragma unroll
        for (int ii = 0; ii < 4; ++ii) {
            const int c = 256 * k + 32 * w + 16 * j + 4 * g + ii, dist = 2048 + t - c;
            const int mult = (dist <= 128 ? 1 : 0) + (((dist & 3) == 0 && dist <= 512) ? 1 : 0) + (((dist & 15) == 0 && dist <= 2048) ? 1 : 0);
            const float pp = (float)mult * exp2f(s[j][ii] - mref); s[j][ii] = pp; l += pp; }
    l += __shfl_xor(l, 16); l += __shfl_xor(l, 32);
    f32x4 o[8];
    {
        u32x4 pw; pw.x = pg8::cvt_pk_bf16(s[0][0], s[0][1]); pw.y = pg8::cvt_pk_bf16(s[0][2], s[0][3]); pw.z = pg8::cvt_pk_bf16(s[1][0], s[1][1]); pw.w = pg8::cvt_pk_bf16(s[1][2], s[1][3]);
        const bf16x8 pf = __builtin_bit_cast(bf16x8, pw);
        const int rw = active ? w : 0;
        const int a0 = VOFF + (32 * rw + 4 * g + (cq >> 2)) * KVS + 8 * (cq & 3), a1 = a0 + 16 * KVS;
#pragma unroll
        for (int dt = 0; dt < 8; ++dt) {
            const s16x4 v0 = __builtin_amdgcn_ds_read_tr16_b64_v4i16((LAS s16x4*)(lds + a0 + dt * 32));
            const s16x4 v1 = __builtin_amdgcn_ds_read_tr16_b64_v4i16((LAS s16x4*)(lds + a1 + dt * 32));
            const bf16x8 vf = {v0[0], v0[1], v0[2], v0[3], v1[0], v1[1], v1[2], v1[3]};
            o[dt] = __builtin_amdgcn_mfma_f32_16x16x32_bf16(vf, pf, (f32x4){0.f, 0.f, 0.f, 0.f}, 0, 0, 0);
        }
    }
    __syncthreads();
    LAS float* OL = (LAS float*)lds;
    LAS float* ML = (LAS float*)(lds + 32768);
    if (cq < 8) {
#pragma unroll
        for (int dt = 0; dt < 8; ++dt) *(LAS f32x4*)(OL + (w * 8 + cq) * 128 + 16 * dt + 4 * g) = o[dt];
        if (g == 0) { ML[(w * 8 + cq) * 2 + 0] = m; ML[(w * 8 + cq) * 2 + 1] = l; }
    }
    __syncthreads();
    {
        const int q = w; float M = -INFINITY;
#pragma unroll
        for (int ww = 0; ww < 8; ++ww) M = fmaxf(M, ML[(ww * 8 + q) * 2]);
        const float Mr = (M == -INFINITY) ? 0.f : M;
        float L = 0.f, o0 = 0.f, o1 = 0.f;
#pragma unroll
        for (int ww = 0; ww < 8; ++ww) { const float f = exp2f(ML[(ww * 8 + q) * 2] - Mr); L += f * ML[(ww * 8 + q) * 2 + 1];
            o0 += f * OL[(ww * 8 + q) * 128 + 2 * lane]; o1 += f * OL[(ww * 8 + q) * 128 + 2 * lane + 1]; }
        float* ps = (float*)(P.ws + WS_PS) + ((((size_t)(b * NH + h)) * 9 + k) * 8 + q) * 130;
        if (lane == 0) { ps[0] = M; ps[1] = L; }
        *(float2*)(ps + 2 + 2 * lane) = make_float2(o0, o1);
    }
    __syncthreads();
}
__device__ __forceinline__ void samp_merge_unit(const Params& P, int b, int t, int h, int lane) {
    const float* ps = (const float*)(P.ws + WS_PS) + ((size_t)(b * NH + h)) * 9 * 8 * 130 + (size_t)t * 130;
    float M = -INFINITY;
#pragma unroll
    for (int k = 0; k < 9; ++k) M = fmaxf(M, ps[(size_t)k * 8 * 130]);
    float L = 0.f, o0 = 0.f, o1 = 0.f;
#pragma unroll
    for (int k = 0; k < 9; ++k) { const float* pk = ps + (size_t)k * 8 * 130; const float f = exp2f(pk[0] - M); L += f * pk[1]; const float2 ov = *(const float2*)(pk + 2 + 2 * lane); o0 += f * ov.x; o1 += f * ov.y; }
    const float inv = 1.0f / L;
    bf16_t* ar = (bf16_t*)(P.ws + WS_AR) + ((size_t)(NTOK_P + b * 8 + t)) * D + h * HD;
    *(unsigned*)(ar + 2 * lane) = pack2(o0 * inv, o1 * inv);
}

constexpr int LRU_XS = 144, LRU_GS = 68, LRU_WAVE = 16 * LRU_XS + 2 * 16 * LRU_GS * 4;
__device__ __forceinline__ void lru_unit(const Params& P, bool samp, int b, int n, int k, int lane, LAS unsigned char* wl) {
    const int T = samp ? 8 : 64; const int row0 = samp ? NTOK_P + b * 8 : b * 2048 + k * 64; const int ch = n * 64 + lane;
    const int cq = lane & 15, g = lane >> 4;
    bf16x8 wf[2][4][2];
    { const bf16_t* lw = (const bf16_t*)(P.ws + WS_LW);
#pragma unroll
      for (int m = 0; m < 2; ++m)
#pragma unroll
        for (int ct = 0; ct < 4; ++ct)
#pragma unroll
            for (int ks = 0; ks < 2; ++ks) wf[m][ct][ks] = *(const bf16x8*)(lw + ((size_t)((m * 8 + n) * 64 + 16 * ct + cq)) * 64 + 32 * ks + 8 * g); }
    const float ba = P.lru_b_a[ch], bx = P.lru_b_x[ch], lam = P.lru_lambda[ch];
    const float sp8 = -8.0f * LOG2E * log1pf(expf(-lam));
    const float cw0 = P.conv_w[ch], cw1 = P.conv_w[512 + ch], cw2 = P.conv_w[1024 + ch], cw3 = P.conv_w[1536 + ch], cb = P.conv_b[ch];
    const bf16_t* XR = (const bf16_t*)(P.ws + WS_XR); const bf16_t* GT = (const bf16_t*)(P.ws + WS_GATE);
    float* R0 = (float*)(P.ws + WS_R0); float* R1 = (float*)(P.ws + WS_R1); bf16_t* AR = (bf16_t*)(P.ws + WS_AR);
    LAS unsigned char* xcb = wl; LAS float* G = (LAS float*)(wl + 16 * LRU_XS);
    float x0 = 0.f, x1 = 0.f, x2 = 0.f, h = 0.f, A = 1.f;
    if (samp) { x0 = P.state_conv[(b * 3 + 0) * 512 + ch]; x1 = P.state_conv[(b * 3 + 1) * 512 + ch]; x2 = P.state_conv[(b * 3 + 2) * 512 + ch]; h = P.state_h[b * 512 + ch]; }
    else if (k > 0) { x0 = bflo(XR[(size_t)(row0 - 3) * DLRU + ch]); x1 = bflo(XR[(size_t)(row0 - 2) * DLRU + ch]); x2 = bflo(XR[(size_t)(row0 - 1) * DLRU + ch]); }
#pragma unroll 1
    for (int t0 = 0; t0 < T; t0 += 16) {
        const int ns = (T - t0) < 16 ? (T - t0) : 16;
        float xc[16], gt[16];
#pragma unroll
        for (int i = 0; i < 16; ++i) { const int r = row0 + t0 + (i < ns ? i : ns - 1); xc[i] = bflo(XR[(size_t)r * DLRU + ch]); gt[i] = bflo(GT[(size_t)r * DLRU + ch]); }
#pragma unroll
        for (int i = 0; i < 16; ++i) {
            const float xin = xc[i]; const float v = ((x0 * cw0 + x1 * cw1) + x2 * cw2) + xin * cw3 + cb;
            if (i < ns) { x0 = x1; x1 = x2; x2 = xin; }
            xc[i] = v;
            *(LAS bf16_t*)(xcb + i * LRU_XS + lane * 2) = (bf16_t)f2bf(v);
        }
        __builtin_amdgcn_wave_barrier();
        const bf16x8 a0 = *(const LAS bf16x8*)(xcb + cq * LRU_XS + (8 * g) * 2), a1 = *(const LAS bf16x8*)(xcb + cq * LRU_XS + (32 + 8 * g) * 2);
#pragma unroll
        for (int m = 0; m < 2; ++m)
#pragma unroll
            for (int ct = 0; ct < 4; ++ct) {
                f32x4 acc = __builtin_amdgcn_mfma_f32_16x16x32_bf16(a0, wf[m][ct][0], (f32x4){0.f, 0.f, 0.f, 0.f}, 0, 0, 0);
                acc = __builtin_amdgcn_mfma_f32_16x16x32_bf16(a1, wf[m][ct][1], acc, 0, 0, 0);
#pragma unroll
                for (int ii = 0; ii < 4; ++ii) G[(m * 16 + 4 * g + ii) * LRU_GS + 16 * ct + cq] = acc[ii];
            }
        __builtin_amdgcn_wave_barrier();
#pragma unroll
        for (int i = 0; i < 16; ++i) {
            if (i < ns) {
                const float ra = G[i * LRU_GS + lane] + ba, ri = G[(16 + i) * LRU_GS + lane] + bx;
                const float r = __builtin_amdgcn_rcpf(1.0f + __builtin_amdgcn_exp2f(-LOG2E * ra)), ig = __builtin_amdgcn_rcpf(1.0f + __builtin_amdgcn_exp2f(-LOG2E * ri));
                const float a = __builtin_amdgcn_exp2f(sp8 * r);
                const float u = __builtin_amdgcn_sqrtf(fmaxf(1.0f - a * a, 0.f)) * (ig * xc[i]);
                h = a * h + u; A = a * A;
                const float ge = gelu_as(gt[i]);
                if (samp) AR[(size_t)(row0 + t0 + i) * D + DATT + ch] = (bf16_t)f2bf(h * ge);
                else { R0[(size_t)(row0 + t0 + i) * DLRU + ch] = h * ge; R1[(size_t)(row0 + t0 + i) * DLRU + ch] = A * ge; }
            }
        }
        __builtin_amdgcn_wave_barrier();
    }
    if (samp) { P.out[O_HS + (size_t)b * 512 + ch] = h; float* co = P.out + O_CS + (size_t)b * 3 * 512 + ch; co[0] = x0; co[512] = x1; co[1024] = x2; }
    else {
        ((float*)(P.ws + WS_HE))[((size_t)(b * 32 + k)) * 512 + ch] = h; ((float*)(P.ws + WS_AE))[((size_t)(b * 32 + k)) * 512 + ch] = A;
        if (k == 31) { float* co = P.out + O_CP + (size_t)b * 3 * 512 + ch; co[0] = x0; co[512] = x1; co[1024] = x2; }
    }
}

__device__ __forceinline__ void phase_lru(const Params& P, LAS unsigned char* lds) {
    const int lane = threadIdx.x & 63, wave = __builtin_amdgcn_readfirstlane(threadIdx.x >> 6);
    const int gw = blockIdx.x * 8 + wave, nw = gridDim.x * 8;
#pragma unroll 1
    for (int pass = 0; pass < 2; ++pass) {
        if ((pass ^ (wave & 1)) == 0) {
            for (int u = gw; u < 2048 + 256; u += nw) { const bool samp = u >= 2048; const int v = samp ? u - 2048 : u; lru_unit(P, samp, samp ? (v >> 3) : (v >> 8), samp ? (v & 7) : ((v >> 5) & 7), v & 31, lane, lds + wave * LRU_WAVE); }
        } else quant_tables(P);
    }
    __syncthreads();
}
__device__ __forceinline__ void phase_samp(const Params& P, LAS unsigned char* lds) {
    for (int u = blockIdx.x; u < 384 * 9; u += gridDim.x) { const int k = u % 9, bh = u / 9; samp_unit(P, bh / NH, bh % NH, k, lds); }
}
__device__ __forceinline__ void phase_attn01(const Params& P, LAS unsigned char* lds) {
    for (int u = blockIdx.x; u < 3072; u += gridDim.x) {
        const int p = u / 1536, rem = u - p * 1536, bh = rem >> 4, rc = rem & 15;
        const int b = bh / NH, h = bh - b * NH;
        const int r = p == 0 ? 0 : (rc >> 2), c = p == 0 ? rc : (rc & 3);
        attn_unit<0>(P, p, b, h, r, c, lds);
    }
}
__device__ __forceinline__ void phase_mix_b(const Params& P, LAS unsigned char* lds) {
    {
        const int gt = blockIdx.x * NTHREADS + threadIdx.x;
        for (int i = gt; i < 8 * 32 * 512; i += gridDim.x * NTHREADS) {
            const int ch = i & 511, k = (i >> 9) & 31, b = i >> 14;
            const float* HE = (const float*)(P.ws + WS_HE) + (size_t)b * 32 * 512 + ch; const float* AE = (const float*)(P.ws + WS_AE) + (size_t)b * 32 * 512 + ch;
            float hin = 0.f;
            for (int kk = 0; kk < k; ++kk) hin = HE[kk * 512] + AE[kk * 512] * hin;
            const float* R0 = (const float*)(P.ws + WS_R0) + (size_t)(b * 2048 + k * 64) * DLRU + ch; const float* R1 = (const float*)(P.ws + WS_R1) + (size_t)(b * 2048 + k * 64) * DLRU + ch;
            bf16_t* ar = (bf16_t*)(P.ws + WS_AR) + (size_t)(b * 2048 + k * 64) * D + DATT + ch;
#pragma unroll 8
            for (int t = 0; t < 64; ++t) ar[(size_t)t * D] = (bf16_t)f2bf(R0[(size_t)t * DLRU] + R1[(size_t)t * DLRU] * hin);
            if (k == 31) P.out[O_HP + (size_t)b * 512 + ch] = HE[31 * 512] + AE[31 * 512] * hin;
        }
    }
    { const int lane = threadIdx.x & 63, gw = blockIdx.x * 8 + (threadIdx.x >> 6);
      for (int u = gw; u < NTOK_S * NH; u += gridDim.x * 8) { const int row = u / NH, h = u - row * NH; samp_merge_unit(P, row >> 3, row & 7, h, lane); } }
    for (int u = blockIdx.x; u < 1536; u += gridDim.x) {
        const int bh = u >> 4, r = u & 15; const int b = bh / NH, h = bh - b * NH;
        attn_unit<1>(P, 2, b, h, r, 0, lds);
    }
}

__device__ __forceinline__ void phase_ln1(const Params& P) {
    const int lane = threadIdx.x & 63, wave = threadIdx.x >> 6;
    const bf16_t* pre = (const bf16_t*)(P.ws + WS_PRE1); bf16_t* x1b = (bf16_t*)(P.ws + WS_X1B);
    for (int row = blockIdx.x * 8 + wave; row < NTOK; row += gridDim.x * 8) {
        float4 v[8]; float s = 0.f;
#pragma unroll
        for (int j = 0; j < 8; j += 2) { const u32x4 pw = *(const u32x4*)(pre + (size_t)row * D + (j >> 2) * 1024 + lane * 16 + (j & 3) * 4);
            v[j] = make_float4(bflo(pw.x), bfhi(pw.x), bflo(pw.y), bfhi(pw.y)); v[j + 1] = make_float4(bflo(pw.z), bfhi(pw.z), bflo(pw.w), bfhi(pw.w));
            s += (v[j].x + v[j].y) + (v[j].z + v[j].w) + (v[j + 1].x + v[j + 1].y) + (v[j + 1].z + v[j + 1].w); }
        const float mean = wave_sum(s) * (1.0f / D); float q = 0.f;
#pragma unroll
        for (int j = 0; j < 8; ++j) { const float a = v[j].x - mean, b = v[j].y - mean, c = v[j].z - mean, d = v[j].w - mean; q += (a * a + b * b) + (c * c + d * d); }
        const float rstd = rsqrtf(wave_sum(q) * (1.0f / D) + LN_EPS);
        float am = 0.f;
#pragma unroll
        for (int j = 0; j < 8; ++j) { const int col = (j >> 2) * 1024 + lane * 16 + (j & 3) * 4; const float4 g = *(const float4*)(P.ln1_g + col), bb = *(const float4*)(P.ln1_b + col);
            float4 o; o.x = (v[j].x - mean) * rstd * g.x + bb.x; o.y = (v[j].y - mean) * rstd * g.y + bb.y; o.z = (v[j].z - mean) * rstd * g.z + bb.z; o.w = (v[j].w - mean) * rstd * g.w + bb.w;
            v[j] = o; am = fmaxf(am, fmaxf(fmaxf(fabsf(o.x), fabsf(o.y)), fmaxf(fabsf(o.z), fabsf(o.w))));
            uint2 w; w.x = pack2(o.x, o.y); w.y = pack2(o.z, o.w); *(uint2*)(x1b + (size_t)row * D + col) = w; }
        am = wave_max(am); if (am == 0.f) am = 1.f;
        const float inv = 119.0f / am;
        unsigned char* xq = P.ws + WS_X1Q + (size_t)row * D;
        u32x4 wh, wl;
#pragma unroll
        for (int d = 0; d < 4; ++d) { unsigned dh = 0u, dl = 0u;
#pragma unroll
            for (int e = 0; e < 8; ++e) { const float4 t = v[d * 2 + (e >> 2)]; const float x = (e & 3) == 0 ? t.x : ((e & 3) == 1 ? t.y : ((e & 3) == 2 ? t.z : t.w));
                const int q = (int)rintf(x * inv); dl |= (unsigned)(q & 15) << (4 * e); dh |= (unsigned)(((q + 8) >> 4) & 15) << (4 * e); }
            wh[d] = dh; wl[d] = dl; }
        *(u32x4*)(xq + lane * 32) = wh; *(u32x4*)(xq + lane * 32 + 16) = wl;
        if (lane == 0) ((float*)(P.ws + WS_SX))[row] = am * (1.0f / 119.0f);
    }
}

__device__ __forceinline__ int mono(float v) { const int b = __float_as_int(v); return b ^ ((b >> 31) & 0x7fffffff); }
__device__ __forceinline__ float unmono(int k) { return __int_as_float(k ^ ((k >> 31) & 0x7fffffff)); }
#define MK_INSERT16(L, X) do { int _x = (X); _Pragma("unroll") for (int _j = 0; _j < 16; ++_j) { const int _hi = max(L[_j], _x); _x = min(L[_j], _x); L[_j] = _hi; } } while (0)

template <int N> __device__ __forceinline__ void bitonic_sort_desc(int (&v)[N]) {
#pragma unroll
    for (int k = 2; k <= N; k <<= 1)
#pragma unroll
        for (int j = k >> 1; j > 0; j >>= 1)
#pragma unroll
            for (int i = 0; i < N; ++i) { const int l = i ^ j;
                if (l > i) { const int a = v[i], b = v[l]; if ((i & k) == 0) { v[i] = max(a, b); v[l] = min(a, b); } else { v[i] = min(a, b); v[l] = max(a, b); } } }
}
template <int N> __device__ __forceinline__ void bitonic_merge_desc(int (&v)[N]) {
#pragma unroll
    for (int j = N >> 1; j > 0; j >>= 1)
#pragma unroll
        for (int i = 0; i < N; ++i) { const int l = i ^ j; if (l > i) { const int a = v[i], b = v[l]; v[i] = max(a, b); v[l] = min(a, b); } }
}
__device__ __forceinline__ void xlane_merge16(int (&v)[16], int off) {
    int c[16];
#pragma unroll
    for (int i = 0; i < 16; ++i) c[i] = max(v[i], __shfl_xor(v[15 - i], off));
#pragma unroll
    for (int i = 0; i < 16; ++i) v[i] = c[i];
    bitonic_merge_desc<16>(v);
}
__device__ __forceinline__ int sel4(int g, int a, int b, int c, int d) { return g == 0 ? a : (g == 1 ? b : (g == 2 ? c : d)); }
__device__ __forceinline__ float sel4f(int g, float a, float b, float c, float d) { return g == 0 ? a : (g == 1 ? b : (g == 2 ? c : d)); }
__device__ __forceinline__ constexpr int cand_a(int role, int i) {
    return role == 0 ? 0 : role == 1 ? (i < 8 ? 1 : (i < 13 ? 2 : 4)) : role == 2 ? (i < 4 ? 3 : (i < 6 ? 5 : (i < 8 ? 6 : (i < 10 ? 7 : 8 + (i - 10))))) : (i < 2 ? 14 + i : -1);
}
__device__ __forceinline__ constexpr int cand_b(int role, int i) {
    return role == 0 ? i : role == 1 ? (i < 8 ? i : (i < 13 ? i - 8 : i - 13)) : role == 2 ? (i < 4 ? i : (i < 6 ? i - 4 : (i < 8 ? i - 6 : (i < 10 ? i - 8 : 0)))) : 0;
}

__device__ __forceinline__ void route_unit(const Params& P, int h, int tg, LAS unsigned char* lds, LAS int* lst) {
    const int lane = threadIdx.x & 63, w = __builtin_amdgcn_readfirstlane(threadIdx.x >> 6);
    const int cq = lane & 15, g = lane >> 4;
    const int tok = tg * 128 + w * 16 + cq;
    const bf16_t* qrow = (const bf16_t*)(P.ws + WS_QP) + (size_t)tok * D + h * 256;
    int L0[16], L1[16];
#pragma unroll
    for (int p = 0; p < 2; ++p) {
        bf16x8 qf[4];
#pragma unroll
        for (int ks = 0; ks < 4; ++ks) qf[ks] = *(const bf16x8*)(qrow + p * 128 + 32 * ks + 8 * g);
        int v0[16], v1[16];
#pragma unroll
        for (int kt = 0; kt < 8; ++kt) {
            f32x4 acc = {0.f, 0.f, 0.f, 0.f};
#pragma unroll
            for (int ks = 0; ks < 4; ++ks) { const bf16x8 kf = *(const LAS bf16x8*)(lds + (p * 128 + 16 * kt + cq) * KVS + (32 * ks + 8 * g) * 2); acc = __builtin_amdgcn_mfma_f32_16x16x32_bf16(kf, qf[ks], acc, 0, 0, 0); }
#pragma unroll
            for (int ii = 0; ii < 4; ++ii) { const int key = (mono(acc[ii]) & ~127) | (16 * kt + 4 * g + ii); if (kt < 4) v0[kt * 4 + ii] = key; else v1[(kt - 4) * 4 + ii] = key; }
        }
        bitonic_sort_desc<16>(v0); bitonic_sort_desc<16>(v1);
#pragma unroll
        for (int i = 0; i < 16; ++i) v0[i] = max(v0[i], v1[15 - i]);
        bitonic_merge_desc<16>(v0);
        xlane_merge16(v0, 16); xlane_merge16(v0, 32);
#pragma unroll
        for (int i = 0; i < 16; ++i) { if (p == 0) L0[i] = v0[i]; else L1[i] = v0[i]; }
    }
    if (g == 0) {
#pragma unroll
        for (int i = 0; i < 16; ++i) lst[(cq * 2 + 0) * 16 + i] = L0[i];
    }
    if (g == 1) {
#pragma unroll
        for (int i = 0; i < 16; ++i) lst[(cq * 2 + 1) * 16 + i] = L1[i];
    }
    float f0[16], f1[16];
#pragma unroll
    for (int i = 0; i < 16; ++i) { f0[i] = unmono(L0[i] & ~127); f1[i] = unmono(L1[i] & ~127); }
    int c[16];
#pragma unroll
    for (int i = 0; i < 16; ++i) {
        constexpr int NEG = (int)0x80000000;
        const float va = sel4f(g, f0[cand_a(0, i)], f0[cand_a(1, i)], f0[cand_a(2, i)], f0[cand_a(3, i) < 0 ? 0 : cand_a(3, i)]);
        const float vb = sel4f(g, f1[cand_b(0, i)], f1[cand_b(1, i)], f1[cand_b(2, i)], f1[cand_b(3, i)]);
        const int id = sel4(g, (cand_a(0, i) << 4) | cand_b(0, i), (cand_a(1, i) << 4) | cand_b(1, i), (cand_a(2, i) << 4) | cand_b(2, i), ((cand_a(3, i) < 0 ? 0 : cand_a(3, i)) << 4) | cand_b(3, i));
        int key = (mono(va + vb) & ~255) | id;
        if (cand_a(3, i) < 0) key = (g == 3) ? NEG : key;
        c[i] = key;
    }
    bitonic_sort_desc<16>(c);
    xlane_merge16(c, 16); xlane_merge16(c, 32);
    const float mx = unmono(c[0] & ~255);
    float e[16]; float sum = 0.f;
#pragma unroll
    for (int i = 0; i < 16; ++i) { e[i] = exp2f((unmono(c[i] & ~255) - mx) * LOG2E); sum += e[i]; }
    const float inv = 1.0f / sum;
    __builtin_amdgcn_wave_barrier();
    int ei[4]; float gi[4];
#pragma unroll
    for (int j = 0; j < 4; ++j) {
        const int key = sel4(g, c[j], c[4 + j], c[8 + j], c[12 + j]);
        gi[j] = sel4f(g, e[j], e[4 + j], e[8 + j], e[12 + j]) * inv;
        const int a = (key >> 4) & 15, b = key & 15;
        const int i0 = lst[(cq * 2 + 0) * 16 + a] & 127, i1 = lst[(cq * 2 + 1) * 16 + b] & 127;
        ei[j] = i0 * 128 + i1;
    }
    int* EIDX = (int*)(P.ws + WS_EIDX); float* GW = (float*)(P.ws + WS_GW);
    *(int4*)(EIDX + (size_t)tok * 128 + h * 16 + 4 * g) = make_int4(ei[0], ei[1], ei[2], ei[3]);
    *(float4*)(GW + (size_t)tok * 128 + h * 16 + 4 * g) = make_float4(gi[0], gi[1], gi[2], gi[3]);
    __builtin_amdgcn_wave_barrier();
}
__device__ __forceinline__ void phase_route(const Params& P, LAS unsigned char* lds) {
    const int tid = threadIdx.x, wave = __builtin_amdgcn_readfirstlane(tid >> 6);
    const int h = blockIdx.x & 7, slot = blockIdx.x >> 3, nslot = gridDim.x >> 3;
    const bf16_t* sk = (const bf16_t*)(P.ws + WS_SKB) + (size_t)h * 2 * 128 * 128;
#pragma unroll
    for (int it = 0; it < 8; ++it) { const int row = it * 32 + (tid >> 4), ch = tid & 15; *(LAS u32x4*)(lds + row * KVS + ch * 16) = *(const u32x4*)(sk + (size_t)row * 128 + ch * 8); }
    __syncthreads();
    LAS int* lst = (LAS int*)(lds + 73728) + wave * 512;
    for (int tg = slot; tg < NTOK / 128; tg += nslot) route_unit(P, h, tg, lds, lst);
}

__device__ __forceinline__ float ubf(unsigned x, int k) { return (float)((x >> (8 * k)) & 0xffu); }
constexpr int XSLOT = 1152, XGRP = 4 * XSLOT, XNG = 4, XWAVE = XNG * XGRP;
__device__ __forceinline__ void dma_group(__amdgpu_buffer_rsrc_t tab, int e_lo, int e_hi, int g, LAS unsigned char* sb, int lane) {
#pragma unroll
    for (int j = 0; j < 4; ++j) {
        const int k = g * 4 + j; const int e = __builtin_amdgcn_readlane(k < 64 ? e_lo : e_hi, k & 63);
        const int so = e * TROW;
        __builtin_amdgcn_raw_ptr_buffer_load_lds(tab, (LAS void*)(sb + j * XSLOT), 16, lane * 16, so, 0, 0);
        if (lane < 8) __builtin_amdgcn_raw_ptr_buffer_load_lds(tab, (LAS void*)(sb + j * XSLOT + 1024), 16, 1024 + lane * 16, so, 0, 0);
    }
}
__device__ __forceinline__ void u_consume(const LAS unsigned char* sb, const u32x4& xh, const u32x4& xl, float a_lo, float a_hi, float b_lo, float b_hi, int g, int lane, float& w_lo, float& w_hi) {
    int d[4];
#pragma unroll
    for (int j = 0; j < 4; ++j) {
        const u32x4 nb = *(const LAS u32x4*)(sb + j * XSLOT + lane * 16); const unsigned sc = *(const LAS unsigned short*)(sb + j * XSLOT + 1024 + lane * 2);
        int tot = 0;
#pragma unroll
        for (int jj = 0; jj < 2; ++jj) {
            int th = __builtin_amdgcn_sdot8((int)nb[jj * 2], (int)xh[jj * 2], 0, false); th = __builtin_amdgcn_sdot8((int)nb[jj * 2 + 1], (int)xh[jj * 2 + 1], th, false);
            int tl = __builtin_amdgcn_sdot8((int)nb[jj * 2], (int)xl[jj * 2], 0, false); tl = __builtin_amdgcn_sdot8((int)nb[jj * 2 + 1], (int)xl[jj * 2 + 1], tl, false);
            tot += (16 * th + tl) * (int)((sc >> (8 * jj)) & 255u); }
        d[j] = tot;
    }
    const auto s02 = __builtin_amdgcn_permlane32_swap((unsigned)d[0], (unsigned)d[2], false, false);
    const auto s13 = __builtin_amdgcn_permlane32_swap((unsigned)d[1], (unsigned)d[3], false, false);
    const int r0 = (int)s02[0] + (int)s02[1], r1 = (int)s13[0] + (int)s13[1];
    const auto s01 = __builtin_amdgcn_permlane16_swap((unsigned)r0, (unsigned)r1, false, false);
    int r = (int)s01[0] + (int)s01[1];
    r += __builtin_amdgcn_update_dpp(0, r, 0x128, 0xf, 0xf, false);
    r += __builtin_amdgcn_update_dpp(0, r, 0x124, 0xf, 0xf, false);
    r += __builtin_amdgcn_update_dpp(0, r, 0x4E, 0xf, 0xf, false);
    r += __builtin_amdgcn_update_dpp(0, r, 0xB1, 0xf, 0xf, false);
    const int tot = __shfl(r, (lane & 3) * 16);
    const bool mine = ((lane >> 2) == (g & 15));
    const bool hi = g >= 16;
    const float wv = (hi ? b_hi : b_lo) * gelu_as((float)tot * (hi ? a_hi : a_lo));
    if (hi) w_hi = mine ? wv : w_hi; else w_lo = mine ? wv : w_lo;
}
__device__ __forceinline__ void v_consume(const LAS unsigned char* sb, int (&acc)[32], int (&bias)[2], float w_lo, float w_hi, float inv_sw, int g, int lane) {
    u32x4 nb[4]; int wq[2] = {0, 0};
#pragma unroll
    for (int j = 0; j < 4; ++j) {
        const int k = g * 4 + j; const float w = readlane_f(k < 64 ? w_lo : w_hi, k & 63) * inv_sw;
        nb[j] = *(const LAS u32x4*)(sb + j * XSLOT + lane * 16); const unsigned sc = *(const LAS unsigned short*)(sb + j * XSLOT + 1024 + lane * 2);
#pragma unroll
        for (int jj = 0; jj < 2; ++jj) { const int q = (int)rintf(w * (float)((sc >> (8 * jj)) & 255u)); wq[jj] |= (q & 255) << (8 * j); }
    }
    bias[0] = __builtin_amdgcn_sdot4(wq[0], 0x01010101, bias[0], false); bias[1] = __builtin_amdgcn_sdot4(wq[1], 0x01010101, bias[1], false);
#pragma unroll
    for (int i = 0; i < 4; ++i) {
        const unsigned r0 = nb[0][i], r1 = nb[1][i], r2 = nb[2][i], r3 = nb[3][i];
        const unsigned p01a = __builtin_amdgcn_perm(r1, r0, 0x05010400u), p01b = __builtin_amdgcn_perm(r1, r0, 0x07030602u);
        const unsigned p23a = __builtin_amdgcn_perm(r3, r2, 0x05010400u), p23b = __builtin_amdgcn_perm(r3, r2, 0x07030602u);
        const unsigned t0 = __builtin_amdgcn_perm(p23a, p01a, 0x05040100u), t1 = __builtin_amdgcn_perm(p23a, p01a, 0x07060302u);
        const unsigned t2 = __builtin_amdgcn_perm(p23b, p01b, 0x05040100u), t3 = __builtin_amdgcn_perm(p23b, p01b, 0x07060302u);
        const int wv = wq[i >> 1];
        acc[i * 8 + 0] = __builtin_amdgcn_sdot4((int)(t0 & 0x0F0F0F0Fu), wv, acc[i * 8 + 0], false); acc[i * 8 + 1] = __builtin_amdgcn_sdot4((int)((t0 >> 4) & 0x0F0F0F0Fu), wv, acc[i * 8 + 1], false);
        acc[i * 8 + 2] = __builtin_amdgcn_sdot4((int)(t1 & 0x0F0F0F0Fu), wv, acc[i * 8 + 2], false); acc[i * 8 + 3] = __builtin_amdgcn_sdot4((int)((t1 >> 4) & 0x0F0F0F0Fu), wv, acc[i * 8 + 3], false);
        acc[i * 8 + 4] = __builtin_amdgcn_sdot4((int)(t2 & 0x0F0F0F0Fu), wv, acc[i * 8 + 4], false); acc[i * 8 + 5] = __builtin_amdgcn_sdot4((int)((t2 >> 4) & 0x0F0F0F0Fu), wv, acc[i * 8 + 5], false);
        acc[i * 8 + 6] = __builtin_amdgcn_sdot4((int)(t3 & 0x0F0F0F0Fu), wv, acc[i * 8 + 6], false); acc[i * 8 + 7] = __builtin_amdgcn_sdot4((int)((t3 >> 4) & 0x0F0F0F0Fu), wv, acc[i * 8 + 7], false);
    }
}
__device__ __forceinline__ void phase_experts(const Params& P, LAS unsigned char* lds) {
    const int lane = threadIdx.x & 63, wave = __builtin_amdgcn_readfirstlane(threadIdx.x >> 6);
    const bf16_t* x1b = (const bf16_t*)(P.ws + WS_X1B);
    const int* EIDX = (const int*)(P.ws + WS_EIDX); const float* GW = (const float*)(P.ws + WS_GW);
    const __amdgpu_buffer_rsrc_t UQ = __builtin_amdgcn_make_buffer_rsrc((void*)(P.ws + WS_UB), 0, NEXP * TROW, 0x00020000);
    const __amdgpu_buffer_rsrc_t VQ = __builtin_amdgcn_make_buffer_rsrc((void*)(P.ws + WS_VB), 0, NEXP * TROW, 0x00020000);
    const float* SU = (const float*)(P.ws + WS_SU); const float* SV = (const float*)(P.ws + WS_SV); const float* SX = (const float*)(P.ws + WS_SX);
    LAS unsigned char* wb = lds + wave * XWAVE;
    for (int row = blockIdx.x * 8 + wave; row < NTOK; row += gridDim.x * 8) {
        int ln = lane; asm volatile("" : "+v"(ln));
        const u32x4 xh = *(const u32x4*)(P.ws + WS_X1Q + (size_t)row * D + ln * 32), xl = *(const u32x4*)(P.ws + WS_X1Q + (size_t)row * D + ln * 32 + 16);
        const float sx = SX[row];
        const int e_lo = EIDX[(size_t)row * 128 + ln], e_hi = EIDX[(size_t)row * 128 + 64 + ln];
        const float g_lo = GW[(size_t)row * 128 + ln], g_hi = GW[(size_t)row * 128 + 64 + ln];
        const float a_lo = SU[e_lo] * sx, a_hi = SU[e_hi] * sx, b_lo = g_lo * SV[e_lo], b_hi = g_hi * SV[e_hi];
        float w_lo = 0.f, w_hi = 0.f;
        asm volatile("s_waitcnt vmcnt(0)" ::: "memory");
        dma_group(UQ, e_lo, e_hi, 0, wb, lane); dma_group(UQ, e_lo, e_hi, 1, wb + XGRP, lane); dma_group(UQ, e_lo, e_hi, 2, wb + 2 * XGRP, lane);
        int sg = 0;
#pragma unroll 1
        for (int g = 0; g < 32; ++g) {
            const int sn = (sg + 3) & 3;
            if (g + 3 < 32) dma_group(UQ, e_lo, e_hi, g + 3, wb + sn * XGRP, lane); else dma_group(VQ, e_lo, e_hi, g + 3 - 32, wb + sn * XGRP, lane);
            asm volatile("s_waitcnt vmcnt(24)" ::: "memory");
            u_consume(wb + sg * XGRP, xh, xl, a_lo, a_hi, b_lo, b_hi, g, lane, w_lo, w_hi);
            sg = (sg + 1) & 3;
        }
        float wmax = wave_max(fmaxf(fabsf(w_lo), fabsf(w_hi))); if (wmax == 0.f) wmax = 1.f;
        const float scale_w = wmax * (255.0f / 127.0f), inv_sw = 1.0f / scale_w;
        int acc[32]; int bias[2] = {0, 0};
#pragma unroll
        for (int i = 0; i < 32; ++i) acc[i] = 0;
#pragma unroll 1
        for (int g = 0; g < 32; ++g) {
            const int sn = (sg + 3) & 3;
            dma_group(VQ, e_lo, e_hi, (g + 3) & 31, wb + sn * XGRP, lane);
            asm volatile("s_waitcnt vmcnt(24)" ::: "memory");
            v_consume(wb + sg * XGRP, acc, bias, w_lo, w_hi, inv_sw, g, lane);
            sg = (sg + 1) & 3;
        }
        asm volatile("s_waitcnt vmcnt(0)" ::: "memory");
        float val[32]; float s = 0.f;
#pragma unroll
        for (int jj = 0; jj < 2; ++jj) {
            const int b8 = 8 * bias[jj];
#pragma unroll
            for (int hh = 0; hh < 2; ++hh) {
                const u32x4 xa = *(const u32x4*)(x1b + (size_t)row * D + jj * 1024 + ln * 16 + hh * 8);
#pragma unroll
                for (int i = 0; i < 4; ++i) { const int e0 = jj * 16 + hh * 8 + 2 * i;
                    val[e0] = scale_w * (float)(acc[e0] - b8) + ALPHA * bflo(xa[i]); val[e0 + 1] = scale_w * (float)(acc[e0 + 1] - b8) + ALPHA * bfhi(xa[i]); s += val[e0] + val[e0 + 1]; }
            }
        }
        const float mean = wave_sum(s) * (1.0f / D); float q = 0.f;
#pragma unroll
        for (int i = 0; i < 32; ++i) { const float d0 = val[i] - mean; q += d0 * d0; }
        const float rstd = rsqrtf(wave_sum(q) * (1.0f / D) + LN_EPS);
        float* yo = P.out + (row < NTOK_P ? O_YP + (size_t)row * D : O_YS + (size_t)(row - NTOK_P) * D);
        const int lo16 = ln * 16;
#pragma unroll
        for (int jj = 0; jj < 2; ++jj)
#pragma unroll
            for (int i = 0; i < 4; ++i) {
                const int col = jj * 1024 + lo16 + i * 4;
                const float4 g0 = *(const float4*)(P.ln2_g + col), b0 = *(const float4*)(P.ln2_b + col);
                float4 o;
                o.x = (val[jj * 16 + i * 4 + 0] - mean) * rstd * g0.x + b0.x; o.y = (val[jj * 16 + i * 4 + 1] - mean) * rstd * g0.y + b0.y;
                o.z = (val[jj * 16 + i * 4 + 2] - mean) * rstd * g0.z + b0.z; o.w = (val[jj * 16 + i * 4 + 3] - mean) * rstd * g0.w + b0.w;
                *(float4*)(yo + col) = o;
            }
    }
}

constexpr int NPHASE = 11;
__global__ void __launch_bounds__(NTHREADS, 2) fwd(Params P) {
    extern __shared__ __attribute__((aligned(16))) unsigned char lds_raw[];
    LAS unsigned char* lds = (LAS unsigned char*)lds_raw;
    volatile LAS unsigned* misc = (volatile LAS unsigned*)(lds + MISC_OFF);
    const int lo = P.ph_lo, hi = P.ph_hi;
    XcdBarrier bar; bar.bar = (unsigned*)(P.ws + WS_CTL); bar.x = 0; bar.st = nullptr;
    if (hi - lo > 1) {
        if (threadIdx.x == 0) { misc[0] = 0u; misc[1] = 0u; misc[2] = 0u; misc[3] = 0u; }
        __syncthreads();
        bar = xcd_barrier_post((unsigned*)(P.ws + WS_CTL), misc);
    }
#ifndef MK_REPMASK
#define MK_REPMASK 0
#endif
#ifndef MK_PHASE_MASK
#define MK_PHASE_MASK 0x7ff
#endif
#define IN(k) (((MK_PHASE_MASK >> (k)) & 1) && lo <= (k) && (k) < hi)
#define SEAM(k) do { if (IN(k) && IN((k) + 1)) xcd_barrier(bar); } while (0)
    if (IN(0)) { phase_prologue(P, lds); }
    SEAM(0);
    if (IN(1)) {
        pg8::Gemm g{(const pg8::bf16_t*)(P.ws + WS_XB), (const pg8::bf16_t*)(P.ws + WS_WINT), NTOK, DIN, D};
        pg8::StaticOrder S; S.init(NTOK, DIN, (int)gridDim.x, (int)blockIdx.x);
        EpiProj E{P.out, (bf16_t*)(P.ws + WS_XR), (bf16_t*)(P.ws + WS_GATE), (bf16_t*)(P.ws + WS_QB), (bf16_t*)(P.ws + WS_KB), (bf16_t*)(P.ws + WS_VB16)};
        pg8::gemm_phase<EpiProj, pg8::StaticOrder, false>(lds, g, S, E, nullptr);
    }
    SEAM(1);
    if (IN(2)) { phase_lru(P, lds); }
    if (IN(3)) { phase_samp(P, lds); }
    if (IN(4)) { phase_attn01(P, lds); }
    SEAM(4);
    if (IN(5)) { phase_mix_b(P, lds); }
    SEAM(5);
    if (IN(6)) {
        sample_rows_gemm<0>(P, (const bf16_t*)(P.ws + WS_AR), (const bf16_t*)(P.ws + WS_WOT), lds);
        pg8::Gemm g{(const pg8::bf16_t*)(P.ws + WS_AR), (const pg8::bf16_t*)(P.ws + WS_WOT), NTOK_P, D, D};
        pg8::StaticOrder S; S.init(NTOK_P, D, (int)gridDim.x, (int)blockIdx.x);
        EpiOut E{(const bf16_t*)(P.ws + WS_XB), (bf16_t*)(P.ws + WS_PRE1)};
        pg8::gemm_phase<EpiOut, pg8::StaticOrder, false>(lds, g, S, E, nullptr);
    }
    SEAM(6);
    if (IN(7)) { phase_ln1(P); }
    SEAM(7);
    if (IN(8)) {
        sample_rows_gemm<1>(P, (const bf16_t*)(P.ws + WS_X1B), (const bf16_t*)(P.ws + WS_WQT), lds);
        pg8::Gemm g{(const pg8::bf16_t*)(P.ws + WS_X1B), (const pg8::bf16_t*)(P.ws + WS_WQT), NTOK_P, D, D};
        pg8::StaticOrder S; S.init(NTOK_P, D, (int)gridDim.x, (int)blockIdx.x);
        EpiBf16Plain E{(bf16_t*)(P.ws + WS_QP), D};
        pg8::gemm_phase<EpiBf16Plain, pg8::StaticOrder, false>(lds, g, S, E, nullptr);
    }
    SEAM(8);
    if (IN(9)) { phase_route(P, lds); }
    SEAM(9);
    if (IN(10)) { phase_experts(P, lds); }
#undef IN
#undef SEAM
}
}

extern "C" void kernel_launch(void* const* d_in, const int* in_sizes, int n_in, void* d_out, int out_size, void* d_ws, size_t ws_size, hipStream_t stream) {
    using namespace mk;
    static int grid = 0;
    if (grid == 0) {
        if (n_in != 23 || (size_t)out_size != O_END || ws_size < WS_END) { fprintf(stderr, "kernel_launch: unexpected shapes: n_in %d out %d ws %zu (need %zu)\n", n_in, out_size, ws_size, (size_t)WS_END); grid = -1; return; }
        int dev = 0, cus = 0, per_cu = 0;
        if (hipGetDevice(&dev) != hipSuccess || hipDeviceGetAttribute(&cus, hipDeviceAttributeMultiprocessorCount, dev) != hipSuccess) { grid = -1; return; }
        if (hipFuncSetAttribute((const void*)fwd, hipFuncAttributeMaxDynamicSharedMemorySize, LDS_BYTES) != hipSuccess) { fprintf(stderr, "kernel_launch: hipFuncSetAttribute failed\n"); grid = -1; return; }
        if (hipOccupancyMaxActiveBlocksPerMultiprocessor(&per_cu, (const void*)fwd, NTHREADS, LDS_BYTES) != hipSuccess || per_cu < 1) { fprintf(stderr, "kernel_launch: occupancy query says %d\n", per_cu); }
        (void)hipGetLastError();
        grid = cus;
    }
    if (grid < 0) return;
    (void)hipMemsetAsync((char*)d_ws + WS_CTL, 0, 65536, stream);
    Params p{};
    p.x_prompt = (const float*)d_in[0]; p.x_sample = (const float*)d_in[1]; p.cache_k = (const float*)d_in[2]; p.cache_v = (const float*)d_in[3];
    p.state_conv = (const float*)d_in[4]; p.state_h = (const float*)d_in[5]; p.w_in = (const float*)d_in[6]; p.conv_w = (const float*)d_in[7]; p.conv_b = (const float*)d_in[8];
    p.lru_w_a = (const float*)d_in[9]; p.lru_b_a = (const float*)d_in[10]; p.lru_w_x = (const float*)d_in[11]; p.lru_b_x = (const float*)d_in[12]; p.lru_lambda = (const float*)d_in[13];
    p.w_out = (const float*)d_in[14]; p.ln1_g = (const float*)d_in[15]; p.ln1_b = (const float*)d_in[16]; p.w_query = (const float*)d_in[17]; p.sub_keys = (const float*)d_in[18];
    p.peer_u = (const float*)d_in[19]; p.peer_v = (const float*)d_in[20]; p.ln2_g = (const float*)d_in[21]; p.ln2_b = (const float*)d_in[22];
    p.out = (float*)d_out; p.ws = (unsigned char*)d_ws;
#if MK_N_LAUNCHES == 1
    p.ph_lo = 0; p.ph_hi = NPHASE;
    hipLaunchKernelGGL(fwd, dim3(grid), dim3(NTHREADS), LDS_BYTES, stream, p);
#else
    for (int k = 0; k < NPHASE; ++k) { p.ph_lo = k; p.ph_hi = k + 1; hipLaunchKernelGGL(fwd, dim3(grid), dim3(NTHREADS), LDS_BYTES, stream, p);
#ifdef MK_EXTRA_PHASE
        if (k == MK_EXTRA_PHASE) hipLaunchKernelGGL(fwd, dim3(grid), dim3(NTHREADS), LDS_BYTES, stream, p);
#endif
    }
#endif
    const hipError_t le = hipPeekAtLastError();
    if (le != hipSuccess) fprintf(stderr, "kernel_launch: launch failed: %s\n", hipGetErrorName(le));
}
```

```cpp
#include <hip/hip_runtime.h>
#include <cstdio>
#include <cstdint>
namespace pg8 {
#define PG8_LAS __attribute__((address_space(3)))
typedef unsigned short bf16_t;
typedef short bf16x8 __attribute__((ext_vector_type(8)));
typedef float f32x4 __attribute__((ext_vector_type(4)));
typedef unsigned u32x4 __attribute__((ext_vector_type(4)));
constexpr int BM = 256, BK = 64, HALF = 128, HTB = HALF * BK * 2  , STAGE_BYTES = 8 * HTB, NXCD = 8, WGM = 8;

__host__ __device__ __forceinline__ int lds_byte(int r, int c) { const int st = (r >> 4) * 2 + (c >> 5), rr = r & 15, cc = c & 31, ob = rr * 64 + cc * 2; return st * 1024 + (ob ^ (((ob >> 9) & 1) << 5)); }
__host__ __device__ __forceinline__ void stage_rc(int b, int& R, int& C) { const int st = b / 1024, sb = b % 1024, swz = sb ^ (((sb >> 9) & 1) << 5); R = (st >> 1) * 16 + swz / 64; C = (st & 1) * 32 + (swz % 64) / 2; }
__host__ __device__ __forceinline__ int perm32(int rho) { const int n = rho >> 4, i = rho & 15; return 8 * (i >> 2) + 4 * n + (i & 3); }

struct Unit { int pm, pn; };
struct Gemm { const bf16_t* A; const bf16_t* Bt; int M, N, K; };

struct StaticOrder {
    int nM, nN, nwg, G, c;
    __host__ __device__ void init(int M, int N, int G_, int c_) { nM = M / BM; nN = N / BM; nwg = nM * nN; G = G_; c = c_; }
    __host__ __device__ bool next(int i, Unit& u) const {
        const long L = (long)i * G + c; if (L >= nwg) return false;
        int wgid = (int)L; { const int q = nwg / NXCD, r = nwg % NXCD, xcd = wgid % NXCD, off = wgid / NXCD; wgid = (xcd < r ? xcd * (q + 1) : r * (q + 1) + (xcd - r) * q) + off; }
        const int nig = WGM * nN, gid = wgid / nig, fm = gid * WGM, gsz = (nM - fm) < WGM ? (nM - fm) : WGM;
        u.pm = fm + ((wgid % nig) % gsz); u.pn = (wgid % nig) / gsz; return true;
    }
    __device__ __forceinline__ void a_ready(const Unit&) const {}
    __device__ __forceinline__ void done(const Unit&) const {}
};
struct CountedOrder : StaticOrder {
    const unsigned* ready; unsigned need; unsigned* tmo;
    __device__ __forceinline__ void a_ready(const Unit& u) const {
        if (threadIdx.x < 64) {
            const unsigned long long t0 = __builtin_amdgcn_s_memrealtime(); unsigned polls = 0;
            while ((unsigned)__builtin_amdgcn_readfirstlane(__hip_atomic_load(ready + 64 * u.pm, __ATOMIC_RELAXED, __HIP_MEMORY_SCOPE_AGENT)) < need) {
                if ((++polls & 255u) == 0u && __builtin_amdgcn_readfirstlane(__hip_atomic_load(tmo, __ATOMIC_RELAXED, __HIP_MEMORY_SCOPE_AGENT)) != 0u) break;
                if (__builtin_amdgcn_s_memrealtime() - t0 > 2000000ull) {
                    if (threadIdx.x == 0) { unsigned expect = 0u; __hip_atomic_compare_exchange_strong(tmo + 1, &expect, 0x600u | (unsigned)(u.pm & 0xff), __ATOMIC_RELAXED, __ATOMIC_RELAXED, __HIP_MEMORY_SCOPE_AGENT); __hip_atomic_store(tmo, 1u, __ATOMIC_RELAXED, __HIP_MEMORY_SCOPE_AGENT); }
                    break; }
                __builtin_amdgcn_s_sleep(2); }
            __builtin_amdgcn_fence(__ATOMIC_ACQUIRE, "agent");
            asm volatile("s_waitcnt vmcnt(0)" ::: "memory");
        }
#if !defined(BROKEN_HOOK_NO_BARRIER)
        asm volatile("" ::: "memory"); __builtin_amdgcn_s_barrier(); asm volatile("" ::: "memory");
#endif
    }
};

__device__ __forceinline__ unsigned cvt_pk_bf16(float lo, float hi) { unsigned r; asm volatile("v_cvt_pk_bf16_f32 %0, %1, %2" : "=v"(r) : "v"(lo), "v"(hi)); return r; }
typedef float f32x2 __attribute__((ext_vector_type(2)));
__device__ __forceinline__ f32x2 gelu_pk(f32x2 v) {
    const f32x2 av = __builtin_elementwise_abs(v), d = av * 0.2316418882f + 1.0f;
    f32x2 t; t.x = __builtin_amdgcn_rcpf(d.x); t.y = __builtin_amdgcn_rcpf(d.y);
    f32x2 q = t * 0.5307027145f + (-0.7265760135f); q = q * t + 0.7107068705f; q = q * t + (-0.142248368f); q = q * t + 0.127414796f; q = q * t;
    const f32x2 s = (v * v) * (-0.72134752044f);
    f32x2 e; e.x = __builtin_amdgcn_exp2f(s.x); e.y = __builtin_amdgcn_exp2f(s.y);
    const f32x2 m = v * (q * e), r = v - m;
    f32x2 o; o.x = v.x < 0.f ? m.x : r.x; o.y = v.y < 0.f ? m.y : r.y; return o;
}

struct EpiF32 {
    static constexpr bool PERM = false, AFTER_DRAIN = false;
    float* C; int ldc; const float* bias;
    __device__ __forceinline__ void operator()(const f32x4 (&acc)[2][2][4][2], const Unit& u, int wr, int wc, int fr, int fq) const {
        const int row0 = u.pm * BM + wr * 64 + fr, col0 = u.pn * BM + wc * 32 + 4 * fq;
        f32x4 bv[2][2];
#pragma unroll
        for (int bj = 0; bj < 2; ++bj)
#pragma unroll
            for (int n = 0; n < 2; ++n) bv[bj][n] = bias ? *(const f32x4*)(bias + col0 + bj * HALF + n * 16) : (f32x4){0.f, 0.f, 0.f, 0.f};
#pragma unroll
        for (int ai = 0; ai < 2; ++ai)
#pragma unroll
            for (int m = 0; m < 4; ++m) { float* rowp = C + (size_t)(row0 + ai * HALF + m * 16) * ldc + col0;
#pragma unroll
                for (int bj = 0; bj < 2; ++bj)
#pragma unroll
                    for (int n = 0; n < 2; ++n) *(f32x4*)(rowp + bj * HALF + n * 16) = acc[ai][bj][m][n] + bv[bj][n]; }
    }
};
template <int ACT  > struct EpiBf16 {
    static constexpr bool PERM = true, AFTER_DRAIN = false;
    bf16_t* O; int ldc; const float* bias; int split_cols; size_t split_stride;
    __device__ __forceinline__ void operator()(const f32x4 (&acc)[2][2][4][2], const Unit& u, int wr, int wc, int fr, int fq) const {
        const int row0 = u.pm * BM + wr * 64 + fr; int colt = u.pn * BM; bf16_t* base = O;
        if (split_cols) { const int t = colt / split_cols; base += (size_t)t * split_stride; colt -= t * split_cols; }
        const int col0 = colt + wc * 32 + 8 * fq, bcol0 = u.pn * BM + wc * 32 + 8 * fq;
        f32x4 bv[2][2];
#pragma unroll
        for (int bj = 0; bj < 2; ++bj)
#pragma unroll
            for (int n = 0; n < 2; ++n) bv[bj][n] = bias ? *(const f32x4*)(bias + bcol0 + bj * HALF + 4 * n) : (f32x4){0.f, 0.f, 0.f, 0.f};
#pragma unroll
        for (int ai = 0; ai < 2; ++ai)
#pragma unroll
            for (int m = 0; m < 4; ++m) { bf16_t* rowp = base + (size_t)(row0 + ai * HALF + m * 16) * ldc + col0;
#pragma unroll
                for (int bj = 0; bj < 2; ++bj) { f32x4 v0 = acc[ai][bj][m][0] + bv[bj][0], v1 = acc[ai][bj][m][1] + bv[bj][1];
                    if (ACT == 1) { f32x2 a = gelu_pk((f32x2){v0[0], v0[1]}), b = gelu_pk((f32x2){v0[2], v0[3]}), c = gelu_pk((f32x2){v1[0], v1[1]}), d = gelu_pk((f32x2){v1[2], v1[3]});
                        v0 = (f32x4){a.x, a.y, b.x, b.y}; v1 = (f32x4){c.x, c.y, d.x, d.y}; }
                    if (ACT == 2) {
#pragma unroll
                        for (int j = 0; j < 4; ++j) { v0[j] = 0.5f * v0[j] * (1.0f + erff(v0[j] * 0.70710678f)); v1[j] = 0.5f * v1[j] * (1.0f + erff(v1[j] * 0.70710678f)); } }
                    u32x4 w; w.x = cvt_pk_bf16(v0[0], v0[1]); w.y = cvt_pk_bf16(v0[2], v0[3]); w.z = cvt_pk_bf16(v1[0], v1[1]); w.w = cvt_pk_bf16(v1[2], v1[3]);
                    *(u32x4*)(rowp + bj * HALF) = w; } }
    }
};

struct PanelStats {
    unsigned* xbuf;
    unsigned* cnt;
    unsigned* tmo;
    int ntn; float eps;
    unsigned code;
    __device__ __forceinline__ bool run(const f32x4 (&v)[2][2][4][2], const Unit& u, int wr, int wc, int fr, int fq, PG8_LAS unsigned char* lds, int wid, int lane) const {
        typedef float f32x2v __attribute__((ext_vector_type(2)));
        PG8_LAS f32x2v* P = (PG8_LAS f32x2v*)lds;
        PG8_LAS f32x2v* S = (PG8_LAS f32x2v*)(lds + 8192);
        PG8_LAS unsigned* flag = (PG8_LAS unsigned*)(lds + 8192 + 2048);
#pragma unroll
        for (int ai = 0; ai < 2; ++ai)
#pragma unroll
            for (int m = 0; m < 4; ++m) {
                float s = 0.f;
#pragma unroll
                for (int bj = 0; bj < 2; ++bj)
#pragma unroll
                    for (int n = 0; n < 2; ++n) { const f32x4 x = v[ai][bj][m][n]; s += (x[0] + x[1]) + (x[2] + x[3]); }
                s += __shfl_xor(s, 16); s += __shfl_xor(s, 32);
                const float mw = s * (1.0f / 64.0f); float q = 0.f;
#pragma unroll
                for (int bj = 0; bj < 2; ++bj)
#pragma unroll
                    for (int n = 0; n < 2; ++n) { const f32x4 d = v[ai][bj][m][n] - mw; q += (d[0] * d[0] + d[1] * d[1]) + (d[2] * d[2] + d[3] * d[3]); }
                q += __shfl_xor(q, 16); q += __shfl_xor(q, 32);
                if (fq == 0) P[(ai * HALF + wr * 64 + m * 16 + fr) * 4 + wc] = (f32x2v){mw, q};
            }
        asm volatile("s_waitcnt lgkmcnt(0)" ::: "memory"); __builtin_amdgcn_s_barrier(); asm volatile("" ::: "memory");
#if defined(BROKEN_NO_WAIT)
        if (blockIdx.x >= 64) { const long long t0 = clock64(); while (clock64() - t0 < 60000) __builtin_amdgcn_s_sleep(8); }
#endif
        const int row = wid * 32 + (lane & 31);
        if (lane < 32) {
            const f32x2v a = P[row * 4 + 0], b = P[row * 4 + 1], c = P[row * 4 + 2], d = P[row * 4 + 3];
            const float mt = (a.x + b.x + c.x + d.x) * 0.25f;
            const float da = a.x - mt, db = b.x - mt, dc = c.x - mt, dd = d.x - mt;
            const float m2 = (a.y + b.y) + (c.y + d.y) + 64.0f * ((da * da + db * db) + (dc * dc + dd * dd));
            unsigned long long* slot = (unsigned long long*)xbuf + ((size_t)(u.pm * BM + row) * 4 + u.pn);
            __hip_atomic_store(slot, ((unsigned long long)__float_as_uint(m2) << 32) | __float_as_uint(mt), __ATOMIC_RELAXED, __HIP_MEMORY_SCOPE_AGENT);
        }
        asm volatile("s_waitcnt vmcnt(0)" ::: "memory");
        if (lane == 0) __hip_atomic_fetch_add(cnt + 64 * u.pm, 1u, __ATOMIC_RELAXED, __HIP_MEMORY_SCOPE_AGENT);
        if (wid == 0) {
            bool dead = false; const unsigned long long t0 = __builtin_amdgcn_s_memrealtime(); const unsigned want = 8u * (unsigned)ntn;
            for (;;) {
#if defined(BROKEN_NO_WAIT)
                break;
#endif
                if ((unsigned)__builtin_amdgcn_readfirstlane(__hip_atomic_load(cnt + 64 * u.pm, __ATOMIC_RELAXED, __HIP_MEMORY_SCOPE_AGENT)) >= want) break;
                if (__builtin_amdgcn_s_memrealtime() - t0 > 2000000ull) {
                    if (lane == 0) { unsigned expect = 0u; __hip_atomic_compare_exchange_strong(tmo + 1, &expect, code | (unsigned)(u.pm & 0xff), __ATOMIC_RELAXED, __ATOMIC_RELAXED, __HIP_MEMORY_SCOPE_AGENT);
                                     __hip_atomic_store(tmo, 1u, __ATOMIC_RELAXED, __HIP_MEMORY_SCOPE_AGENT); }
                    dead = true; break; }
                __builtin_amdgcn_s_sleep(2);
            }
            __builtin_amdgcn_fence(__ATOMIC_ACQUIRE, "agent");
            if (lane == 0) flag[0] = dead ? 1u : 0u;
        }
        asm volatile("s_waitcnt vmcnt(0) lgkmcnt(0)" ::: "memory"); __builtin_amdgcn_s_barrier(); asm volatile("" ::: "memory");
        const bool bad = flag[0] != 0u;
        if (lane < 32) {
            const unsigned long long* slot = (const unsigned long long*)xbuf + (size_t)(u.pm * BM + row) * 4; float mt[4], m2[4]; float ms = 0.f;
#pragma unroll
            for (int t = 0; t < 4; ++t) { if (t < ntn) { const unsigned long long w = __hip_atomic_load(slot + t, __ATOMIC_RELAXED, __HIP_MEMORY_SCOPE_AGENT); mt[t] = __uint_as_float((unsigned)w); m2[t] = __uint_as_float((unsigned)(w >> 32)); } else { mt[t] = 0.f; m2[t] = 0.f; } ms += mt[t]; }
            const float mean = ms / (float)ntn; float q = 0.f;
#pragma unroll
            for (int t = 0; t < 4; ++t) if (t < ntn) { const float dm = mt[t] - mean; q += m2[t] + 256.0f * dm * dm; }
            S[row] = (f32x2v){mean, 1.0f / sqrtf(q / (256.0f * (float)ntn) + eps)};
        }
        asm volatile("s_waitcnt lgkmcnt(0)" ::: "memory"); __builtin_amdgcn_s_barrier(); asm volatile("" ::: "memory");
        return bad;
    }
};
struct EpiLnRes {
    static constexpr bool PERM = false, AFTER_DRAIN = true;
    const float* base; float* out; int ldc; const float* bias; PanelStats st; unsigned poison;
    __device__ __forceinline__ void refuse(size_t i0, size_t stride, int M, int N) const { const float q = __builtin_nanf(""); for (size_t i = i0; i < (size_t)M * N; i += stride) out[(i / N) * ldc + i % N] = q;
        if (i0 == 0) { unsigned expect = 0u; __hip_atomic_compare_exchange_strong(st.tmo + 1, &expect, 0x7f0u, __ATOMIC_RELAXED, __ATOMIC_RELAXED, __HIP_MEMORY_SCOPE_AGENT); __hip_atomic_store(st.tmo, 1u, __ATOMIC_RELAXED, __HIP_MEMORY_SCOPE_AGENT); } }
    __device__ __forceinline__ void fused(f32x4 (&acc)[2][2][4][2], const Unit& u, int wr, int wc, int fr, int fq, PG8_LAS unsigned char* lds, int wid, int lane) const {
        typedef float f32x2v __attribute__((ext_vector_type(2)));
        const PG8_LAS f32x2v* S = (const PG8_LAS f32x2v*)(lds + 8192);
        const int col0 = u.pn * BM + wc * 32 + 4 * fq;
#pragma unroll
        for (int bj = 0; bj < 2; ++bj)
#pragma unroll
            for (int n = 0; n < 2; ++n) { const f32x4 bv = bias ? *(const f32x4*)(bias + col0 + bj * HALF + n * 16) : (f32x4){0.f, 0.f, 0.f, 0.f};
#pragma unroll
                for (int ai = 0; ai < 2; ++ai)
#pragma unroll
                    for (int m = 0; m < 4; ++m) acc[ai][bj][m][n] += bv; }
        const bool bad = st.run(acc, u, wr, wc, fr, fq, lds, wid, lane) || poison != 0u;
        const float qnan = __builtin_nanf("");
#pragma unroll
        for (int ai = 0; ai < 2; ++ai)
#pragma unroll
            for (int m = 0; m < 4; ++m) { const int r = ai * HALF + wr * 64 + m * 16 + fr; const f32x2v sr = S[r]; const size_t off = (size_t)(u.pm * BM + r) * ldc + col0;
#pragma unroll
                for (int bj = 0; bj < 2; ++bj)
#pragma unroll
                    for (int n = 0; n < 2; ++n) { const f32x4 bs = *(const f32x4*)(base + off + bj * HALF + n * 16); f32x4 o = bs + (acc[ai][bj][m][n] - sr.x) * sr.y;
                        if (bad) o = (f32x4){qnan, qnan, qnan, qnan}; *(f32x4*)(out + off + bj * HALF + n * 16) = o; }
                asm volatile("" ::: "memory"); }
    }
};
struct EpiLnResLn {
    static constexpr bool PERM = false, AFTER_DRAIN = true;
    const float* base; float* out; bf16_t* xn; int ldc; const float* bias; PanelStats st1, st2; unsigned poison;
    __device__ __forceinline__ void refuse(size_t i0, size_t stride, int M, int N) const { const float q = __builtin_nanf(""); for (size_t i = i0; i < (size_t)M * N; i += stride) { const size_t o = (i / N) * ldc + i % N; out[o] = q; xn[o] = (bf16_t)0x7fc0u; }
        if (i0 == 0) { unsigned expect = 0u; __hip_atomic_compare_exchange_strong(st1.tmo + 1, &expect, 0x7f0u, __ATOMIC_RELAXED, __ATOMIC_RELAXED, __HIP_MEMORY_SCOPE_AGENT); __hip_atomic_store(st1.tmo, 1u, __ATOMIC_RELAXED, __HIP_MEMORY_SCOPE_AGENT); } }
    __device__ __forceinline__ void fused(f32x4 (&acc)[2][2][4][2], const Unit& u, int wr, int wc, int fr, int fq, PG8_LAS unsigned char* lds, int wid, int lane) const {
        typedef float f32x2v __attribute__((ext_vector_type(2))); typedef unsigned u32x2v __attribute__((ext_vector_type(2)));
        const PG8_LAS f32x2v* S = (const PG8_LAS f32x2v*)(lds + 8192);
        const int col0 = u.pn * BM + wc * 32 + 4 * fq;
#pragma unroll
        for (int bj = 0; bj < 2; ++bj)
#pragma unroll
            for (int n = 0; n < 2; ++n) { const f32x4 bv = bias ? *(const f32x4*)(bias + col0 + bj * HALF + n * 16) : (f32x4){0.f, 0.f, 0.f, 0.f};
#pragma unroll
                for (int ai = 0; ai < 2; ++ai)
#pragma unroll
                    for (int m = 0; m < 4; ++m) acc[ai][bj][m][n] += bv; }
        bool bad = st1.run(acc, u, wr, wc, fr, fq, lds, wid, lane) || poison != 0u;
        const float qnan = __builtin_nanf("");
#pragma unroll
        for (int ai = 0; ai < 2; ++ai)
#pragma unroll
            for (int m = 0; m < 4; ++m) { const int r = ai * HALF + wr * 64 + m * 16 + fr; const f32x2v sr = S[r]; const size_t off = (size_t)(u.pm * BM + r) * ldc + col0;
#pragma unroll
                for (int bj = 0; bj < 2; ++bj)
#pragma unroll
                    for (int n = 0; n < 2; ++n) { const f32x4 bs = *(const f32x4*)(base + off + bj * HALF + n * 16); acc[ai][bj][m][n] = bs + (acc[ai][bj][m][n] - sr.x) * sr.y; }
                asm volatile("" : "+v"(acc[ai][0][m][0]), "+v"(acc[ai][0][m][1]), "+v"(acc[ai][1][m][0]), "+v"(acc[ai][1][m][1]));
                if (m & 1) asm volatile("" ::: "memory"); }
        const bool bad1 = bad;
        bad = st2.run(acc, u, wr, wc, fr, fq, lds, wid, lane) || bad;
#pragma unroll
        for (int ai = 0; ai < 2; ++ai)
#pragma unroll
            for (int m = 0; m < 4; ++m) { const int r = ai * HALF + wr * 64 + m * 16 + fr; const f32x2v sr = S[r]; const size_t off = (size_t)(u.pm * BM + r) * ldc + col0;
#pragma unroll
                for (int bj = 0; bj < 2; ++bj)
#pragma unroll
                    for (int n = 0; n < 2; ++n) { const f32x4 x1 = acc[ai][bj][m][n]; *(f32x4*)(out + off + bj * HALF + n * 16) = bad1 ? (f32x4){qnan, qnan, qnan, qnan} : x1;
                        const f32x4 o = (x1 - sr.x) * sr.y; u32x2v w; w.x = cvt_pk_bf16(o[0], o[1]); w.y = cvt_pk_bf16(o[2], o[3]);
                        if (bad) { w.x = 0x7fc07fc0u; w.y = 0x7fc07fc0u; } *(u32x2v*)(xn + off + bj * HALF + n * 16) = w; }
                asm volatile("" ::: "memory"); }
    }
};

template <class Epi, class Sched, bool STAMP = false>
__device__ __forceinline__ void gemm_phase(PG8_LAS unsigned char* lds, const Gemm g, const Sched& S, const Epi& E, unsigned long long* stamps) {
    const int tid = threadIdx.x, wid = __builtin_amdgcn_readfirstlane(tid >> 6), lane = tid & 63, wr = wid >> 2, wc = wid & 3, fr = lane & 15, fq = lane >> 4;
    const int K = g.K, nt = K / BK;
    int ts_lo = 0, ts_hi = 0, nts = 0; const unsigned long long rt_entry = STAMP ? (unsigned long long)wall_clock64() : 0ull;
#define PG8_STAMP() do { if (STAMP && wid == 0 && nts < 64) { const unsigned long long _c = (unsigned long long)clock64(); \
        ts_lo = (lane == nts) ? (int)(unsigned)_c : ts_lo; ts_hi = (lane == nts) ? (int)(unsigned)(_c >> 32) : ts_hi; ++nts; } } while (0)
    PG8_STAMP();
    unsigned voffA[2], voffB[2];
#pragma unroll
    for (int i = 0; i < 2; ++i) { int R, C; stage_rc(tid * 16 + i * 8192, R, C); const int Rb = Epi::PERM ? ((R & ~31) + perm32(R & 31)) : R;
        voffA[i] = (unsigned)(R * K + C) * 2u; voffB[i] = (unsigned)(Rb * K + C) * 2u; }
    const size_t kstep = (size_t)(BK * 2);
    const size_t hstep = (size_t)HALF * K * 2;
    const size_t tstep = 2 * hstep;
    const unsigned ldsw = (unsigned)wid * 1024u;
    const int aoff = lds_byte(wr * 64 + fr, fq * 8), boff = lds_byte(wc * 32 + fr, fq * 8);
#define PG8_SA(b, h) (((b) * 2 + (h)) * HTB)
#define PG8_SB(b, h) ((4 + (b) * 2 + (h)) * HTB)
#define PG8_STAGE(bufoff, gbase, voff) do { _Pragma("unroll") for (int _i = 0; _i < 2; ++_i) \
        __builtin_amdgcn_global_load_lds((const unsigned*)((const char*)(gbase) + (voff)[_i]), (PG8_LAS unsigned*)(lds + (bufoff) + ldsw + _i * 8192), 16, 0, 0); } while (0)
#define PG8_LDA(dst, b, h) do { _Pragma("unroll") for (int m = 0; m < 4; ++m) _Pragma("unroll") for (int k = 0; k < 2; ++k) dst[m][k] = *(const PG8_LAS bf16x8*)(lds + PG8_SA(b, h) + aoff + m * 2048 + k * 1024); } while (0)
#define PG8_LDB(dst, b, h) do { _Pragma("unroll") for (int n = 0; n < 2; ++n) _Pragma("unroll") for (int k = 0; k < 2; ++k) dst[n][k] = *(const PG8_LAS bf16x8*)(lds + PG8_SB(b, h) + boff + n * 2048 + k * 1024); } while (0)
#define PG8_MMA(ai, bj, At, Bt) do { __builtin_amdgcn_s_setprio(1); _Pragma("unroll") for (int m = 0; m < 4; ++m) _Pragma("unroll") for (int n = 0; n < 2; ++n) _Pragma("unroll") for (int k = 0; k < 2; ++k) \
        acc[ai][bj][m][n] = __builtin_amdgcn_mfma_f32_16x16x32_bf16(Bt[n][k], At[m][k], acc[ai][bj][m][n], 0, 0, 0); __builtin_amdgcn_s_setprio(0); } while (0)
#define PG8_WAIT_V(n) asm volatile("s_waitcnt vmcnt(" #n ")" ::: "memory")
#define PG8_WAIT_L(n) asm volatile("s_waitcnt lgkmcnt(" #n ")" ::: "memory")
#define PG8_BAR __builtin_amdgcn_s_barrier()
#define PG8_SCHED __builtin_amdgcn_sched_barrier(0)
    Unit cur, nxt; int ui = 0;
    if (!S.next(0, cur)) return;
    f32x4 acc[2][2][4][2];
#pragma unroll
    for (int a = 0; a < 2; ++a)
#pragma unroll
        for (int b = 0; b < 2; ++b)
#pragma unroll
            for (int m = 0; m < 4; ++m)
#pragma unroll
                for (int n = 0; n < 2; ++n) acc[a][b][m][n] = (f32x4){0.f, 0.f, 0.f, 0.f};
    bf16x8 At[4][2], B0[2][2], B1[2][2];
    const char* cA = (const char*)g.A + (size_t)cur.pm * tstep; const char* cB = (const char*)g.Bt + (size_t)cur.pn * tstep;
    S.a_ready(cur);
    PG8_STAGE(PG8_SB(0, 0), cB, voffB); PG8_STAGE(PG8_SA(0, 0), cA, voffA); PG8_STAGE(PG8_SB(0, 1), cB + hstep, voffB); PG8_STAGE(PG8_SA(0, 1), cA + hstep, voffA);
    if (wr == 1) PG8_BAR;
    PG8_WAIT_V(4); PG8_BAR;
    PG8_STAGE(PG8_SB(1, 0), cB + kstep, voffB); PG8_STAGE(PG8_SA(1, 0), cA + kstep, voffA); PG8_STAGE(PG8_SB(1, 1), cB + hstep + kstep, voffB);
    PG8_WAIT_V(6); PG8_BAR;
    PG8_STAMP();
    for (;;) {
        const bool has_next = S.next(ui + 1, nxt);
        const char* nA = has_next ? (const char*)g.A + (size_t)nxt.pm * tstep : cA; const char* nB = has_next ? (const char*)g.Bt + (size_t)nxt.pn * tstep : cB;
        for (int t = 0; t < nt; t += 2) {
            const bool last = (t == nt - 2);
            const char* a1 = cA + (size_t)(t + 1) * kstep;
            const char* a2 = last ? nA : cA + (size_t)(t + 2) * kstep; const char* b2 = last ? nB : cB + (size_t)(t + 2) * kstep;
            const char* a3 = a2 + kstep; const char* b3 = b2 + kstep;
            if (last && has_next) S.a_ready(nxt);
            PG8_LDB(B0, 0, 0); PG8_SCHED; PG8_LDA(At, 0, 0); PG8_STAGE(PG8_SA(1, 1), a1 + hstep, voffA);
            PG8_WAIT_L(8); PG8_BAR; PG8_WAIT_L(0); PG8_MMA(0, 0, At, B0); PG8_BAR; PG8_SCHED;
            PG8_LDB(B1, 0, 1); PG8_STAGE(PG8_SB(0, 0), b2, voffB);
            PG8_BAR; PG8_WAIT_L(0); PG8_MMA(0, 1, At, B1); PG8_BAR;
            PG8_LDA(At, 0, 1); PG8_STAGE(PG8_SA(0, 0), a2, voffA);
            PG8_BAR; PG8_WAIT_L(0); PG8_MMA(1, 0, At, B0); PG8_BAR; PG8_SCHED;
            PG8_STAGE(PG8_SB(0, 1), b2 + hstep, voffB);
            PG8_WAIT_V(6); PG8_BAR; PG8_MMA(1, 1, At, B1); PG8_BAR;
            PG8_LDB(B0, 1, 0); PG8_SCHED; PG8_LDA(At, 1, 0); PG8_STAGE(PG8_SA(0, 1), a2 + hstep, voffA);
            PG8_WAIT_L(8); PG8_BAR; PG8_WAIT_L(0); PG8_MMA(0, 0, At, B0); PG8_BAR; PG8_SCHED;
            PG8_LDB(B1, 1, 1); PG8_STAGE(PG8_SB(1, 0), b3, voffB);
            PG8_BAR; PG8_WAIT_L(0); PG8_MMA(0, 1, At, B1); PG8_BAR;
            PG8_LDA(At, 1, 1); PG8_STAGE(PG8_SA(1, 0), a3, voffA);
            PG8_BAR; PG8_WAIT_L(0); PG8_MMA(1, 0, At, B0); PG8_BAR; PG8_SCHED;
            PG8_STAGE(PG8_SB(1, 1), b3 + hstep, voffB);
            PG8_WAIT_V(6); PG8_BAR; PG8_MMA(1, 1, At, B1); PG8_BAR;
        }
        PG8_STAMP();
        if constexpr (!Epi::AFTER_DRAIN) { E(acc, cur, wr, wc, fr, fq); S.done(cur); }
        PG8_STAMP();
        if (!has_next) break;
#pragma unroll
        for (int a = 0; a < 2; ++a)
#pragma unroll
            for (int b = 0; b < 2; ++b)
#pragma unroll
                for (int m = 0; m < 4; ++m)
#pragma unroll
                    for (int n = 0; n < 2; ++n) acc[a][b][m][n] = (f32x4){0.f, 0.f, 0.f, 0.f};
        cur = nxt; cA = nA; cB = nB; ++ui;
    }
    PG8_WAIT_V(0);
    if (wr == 0) PG8_BAR;
    PG8_BAR;
    if constexpr (Epi::AFTER_DRAIN) { E.fused(acc, cur, wr, wc, fr, fq, lds, wid, lane); S.done(cur); }
    PG8_STAMP();
    if (STAMP && wid == 0) { stamps[lane] = lane < nts ? (((unsigned long long)(unsigned)ts_hi << 32) | (unsigned)ts_lo) : 0ull;
        if (lane == 62) stamps[62] = rt_entry; if (lane == 63) stamps[63] = (unsigned long long)wall_clock64(); }
#undef PG8_STAMP
#undef PG8_SA
#undef PG8_SB
#undef PG8_STAGE
#undef PG8_LDA
#undef PG8_LDB
#undef PG8_MMA
#undef PG8_WAIT_V
#undef PG8_WAIT_L
#undef PG8_BAR
#undef PG8_SCHED
}
}
#define XB_TMO      128
#define XB_XCNT(j)  (256  + 64 * (j))
#define XB_XSUB(j)  (1280 + 64 * (j))
#define XB_XGEN(j)  (2304 + 64 * (j))
#define XB_TOP      3328
#define XB_TOPGEN   3392
#define XCD_BAR_WORDS 3456
#define XB_SPIN_CAP (1u << 18)
#define LAS __attribute__((address_space(3)))

__device__ __forceinline__ unsigned xb_ld(unsigned* p)              { return __hip_atomic_load(p, __ATOMIC_RELAXED, __HIP_MEMORY_SCOPE_AGENT); }
__device__ __forceinline__ unsigned xb_add(unsigned* p, unsigned v) { return __hip_atomic_fetch_add(p, v, __ATOMIC_RELAXED, __HIP_MEMORY_SCOPE_AGENT); }
__device__ __forceinline__ unsigned xb_xcc_id() { return (unsigned)__builtin_amdgcn_s_getreg((3 << 11) | 20) & 0xFu; }
#define XB_SPIN(cond, bar) do { unsigned _sp = 0; while (cond) { __builtin_amdgcn_s_sleep(1); \
    if ((++_sp & 255u) == 0u) { if (xb_ld(&(bar)[XB_TMO])) break; if (_sp > XB_SPIN_CAP) { atomicAdd(&(bar)[XB_TMO], 1u); break; } } } } while (0)

struct XcdBarrier {
    unsigned* bar; unsigned x;
    volatile LAS unsigned* st;
};

__device__ __forceinline__ XcdBarrier xcd_barrier_post(unsigned* bar, volatile LAS unsigned* st) {
    XcdBarrier b; b.bar = bar; b.x = xb_xcc_id(); b.st = st;
    if (threadIdx.x == 0) (void)xb_add(&bar[XB_XCNT(b.x)], 1u);
    return b;
}
__device__ __forceinline__ void xcd_barrier_complete(unsigned* bar, unsigned x, unsigned& nloc, unsigned& nx) {
    const unsigned G = gridDim.x * gridDim.y * gridDim.z;
    unsigned sum, cnt, mine, sp = 0u;
    for (;;) {
        sum = 0u; cnt = 0u; mine = 0u;
#pragma unroll
        for (unsigned j = 0; j < 16; ++j) { const unsigned c = xb_ld(&bar[XB_XCNT(j)]); sum += c; cnt += (c > 0u) ? 1u : 0u; mine = (j == x) ? c : mine; }
        if (sum == G) break;
        __builtin_amdgcn_s_sleep(1);
        if ((++sp & 255u) == 0u) { if (xb_ld(&bar[XB_TMO])) break; if (sp > XB_SPIN_CAP) { atomicAdd(&bar[XB_TMO], 1u); break; } }
    }
    nloc = mine > 0u ? mine : 1u; nx = cnt > 0u ? cnt : 1u;
}

__device__ __forceinline__ void xcd_barrier(const XcdBarrier& b) {
    asm volatile("s_waitcnt vmcnt(0)" ::: "memory");
    __syncthreads();
    if (threadIdx.x == 0) {
        unsigned* bar = b.bar;
        __builtin_amdgcn_s_waitcnt(0);
        unsigned nloc = b.st[0], nx = b.st[1];
        if (nloc == 0u) { xcd_barrier_complete(bar, b.x, nloc, nx); b.st[0] = nloc; b.st[1] = nx; }
        const unsigned old = xb_add(&bar[XB_XSUB(b.x)], 1u);
        const unsigned gen = old / nloc;
        if (old + 1u == (gen + 1u) * nloc) {
            __builtin_amdgcn_fence(__ATOMIC_RELEASE, "agent");
            asm volatile("s_waitcnt vmcnt(0)" ::: "memory");
            const unsigned og = xb_add(&bar[XB_TOP], 1u);
            const unsigned tg = og / nx;
            if (og + 1u == (tg + 1u) * nx) xb_add(&bar[XB_TOPGEN], 1u);
            else XB_SPIN(xb_ld(&bar[XB_TOPGEN]) == tg, bar);
            __builtin_amdgcn_fence(__ATOMIC_ACQUIRE, "agent");
            xb_add(&bar[XB_XGEN(b.x)], 1u);
            asm volatile("s_waitcnt vmcnt(0)" ::: "memory");
        } else {
            XB_SPIN(xb_ld(&bar[XB_XGEN(b.x)]) == gen, bar);
            __builtin_amdgcn_fence(__ATOMIC_ACQUIRE, "agent");
            asm volatile("s_waitcnt vmcnt(0)" ::: "memory");
        }
    }
    __syncthreads();
}


#ifndef MK_N_LAUNCHES
#define MK_N_LAUNCHES 1
#endif
namespace mk {
typedef unsigned short bf16_t;
typedef float f32x4 __attribute__((ext_vector_type(4)));
typedef short bf16x8 __attribute__((ext_vector_type(8)));
typedef short s16x4 __attribute__((ext_vector_type(4)));
typedef unsigned u32x4 __attribute__((ext_vector_type(4)));
typedef unsigned u32x2 __attribute__((ext_vector_type(2)));
typedef float f32x2 __attribute__((ext_vector_type(2)));
constexpr int D = 2048, NTOK_P = 16384, NTOK_S = 256, NTOK = 16640;
constexpr int DIN = 5632, DATT = 1536, DLRU = 512, NH = 12, HD = 128;
constexpr int NEXP = 16384;
constexpr float ALPHA = 1.189207115002721f;
constexpr float LN_EPS = 1e-5f;
constexpr float ATT_SCALE = 0.08838834764831845f;
constexpr float LOG2E = 1.4426950408889634f;
constexpr size_t O_YP = 0, O_YS = 33554432, O_KP = 34078720, O_VP = 59244544, O_CP = 84410368, O_HP = 84422656,
                 O_KS = 84426752, O_VS = 185090048, O_CS = 285753344, O_HS = 285802496, O_END = 285818880;
constexpr size_t WS_CTL = 0;
constexpr size_t WS_XB = 65536;
constexpr size_t WS_WINT = WS_XB + (size_t)NTOK * D * 2;
constexpr size_t WS_WOT = WS_WINT + (size_t)DIN * D * 2;
constexpr size_t WS_WQT = WS_WOT + (size_t)D * D * 2;
constexpr size_t WS_UB = WS_WQT + (size_t)D * D * 2;
constexpr size_t WS_VB = WS_UB + (size_t)NEXP * D * 2;
constexpr size_t WS_QF = WS_VB + (size_t)NEXP * D * 2;
constexpr size_t WS_XR = WS_QF + (size_t)NTOK * DATT * 4;
constexpr size_t WS_GATE = WS_XR + (size_t)NTOK * DLRU * 4;
constexpr size_t WS_AR = WS_GATE + (size_t)NTOK * DLRU * 4;
constexpr size_t WS_PRE1 = WS_AR + (size_t)NTOK * D * 2;
constexpr size_t WS_X1F = WS_PRE1 + (size_t)NTOK * D * 4;
constexpr size_t WS_X1B = WS_X1F + (size_t)NTOK * D * 4;
constexpr size_t WS_QP = WS_X1B + (size_t)NTOK * D * 2;
constexpr size_t WS_EIDX = WS_QP + (size_t)NTOK * D * 4;
constexpr size_t WS_GW = WS_EIDX + (size_t)NTOK * 128 * 4;
constexpr size_t WS_SU = WS_GW + (size_t)NTOK * 128 * 4;
constexpr size_t WS_SV = WS_SU + (size_t)NEXP * 4;
constexpr size_t WS_SX = WS_SV + (size_t)NEXP * 4;
constexpr size_t WS_X1Q = WS_SX + (size_t)NTOK * 4;
constexpr size_t WS_SKB = WS_X1Q + (size_t)NTOK * D;
constexpr size_t WS_QB = WS_SKB + (size_t)8 * 2 * 128 * 128 * 2;
constexpr size_t WS_KB = WS_QB + (size_t)NTOK * DATT * 2;
constexpr size_t WS_VB16 = WS_KB + (size_t)NTOK_P * DATT * 2;
constexpr size_t WS_PO = WS_VB16 + (size_t)NTOK_P * DATT * 2;
constexpr size_t WS_PM = WS_PO + (size_t)2 * NTOK_P * DATT * 2;
constexpr size_t WS_PL = WS_PM + (size_t)2 * NTOK_P * NH * 4;
constexpr size_t WS_R0 = WS_PL + (size_t)2 * NTOK_P * NH * 4;
constexpr size_t WS_R1 = WS_R0 + (size_t)NTOK_P * DLRU * 4;
constexpr size_t WS_HE = WS_R1 + (size_t)NTOK_P * DLRU * 4;
constexpr size_t WS_AE = WS_HE + (size_t)8 * 32 * 512 * 4;
constexpr size_t WS_LW = WS_AE + (size_t)8 * 32 * 512 * 4;
constexpr size_t WS_PS = WS_LW + (size_t)2 * 8 * 64 * 64 * 2;
constexpr size_t WS_END = WS_PS + (size_t)32 * 12 * 9 * 8 * 130 * 4;

constexpr int NTHREADS = 512;
constexpr int LDS_BYTES = 148480;
constexpr int MISC_OFF = 147456;

struct Params {
    const float* x_prompt; const float* x_sample; const float* cache_k; const float* cache_v; const float* state_conv; const float* state_h;
    const float* w_in; const float* conv_w; const float* conv_b; const float* lru_w_a; const float* lru_b_a; const float* lru_w_x; const float* lru_b_x;
    const float* lru_lambda; const float* w_out; const float* ln1_g; const float* ln1_b; const float* w_query; const float* sub_keys;
    const float* peer_u; const float* peer_v; const float* ln2_g; const float* ln2_b;
    float* out; unsigned char* ws; int ph_lo, ph_hi;
};

__device__ __forceinline__ unsigned f2bf(float f) { unsigned u = __float_as_uint(f); u += 0x7fffu + ((u >> 16) & 1u); return u >> 16; }
__device__ __forceinline__ unsigned pack2(float a, float b) { return f2bf(a) | (f2bf(b) << 16); }
__device__ __forceinline__ float bflo(unsigned w) { return __uint_as_float(w << 16); }
__device__ __forceinline__ float bfhi(unsigned w) { return __uint_as_float(w & 0xffff0000u); }
__device__ __forceinline__ float wave_sum(float v) {
#pragma unroll
    for (int o = 32; o >= 1; o >>= 1) v += __shfl_xor(v, o);
    return v;
}
__device__ __forceinline__ float wave_max(float v) {
#pragma unroll
    for (int o = 32; o >= 1; o >>= 1) v = fmaxf(v, __shfl_xor(v, o));
    return v;
}
__device__ __forceinline__ float gelu_exact(float v) { return 0.5f * v * (1.0f + erff(v * 0.7071067811865476f)); }
__device__ __forceinline__ float gelu_as(float v) {
    const float av = fabsf(v), t = __builtin_amdgcn_rcpf(av * 0.2316418882f + 1.0f);
    float q = t * 0.5307027145f + (-0.7265760135f); q = q * t + 0.7107068705f; q = q * t + (-0.142248368f); q = q * t + 0.127414796f; q = q * t;
    const float e = __builtin_amdgcn_exp2f((v * v) * (-0.72134752044f));
    const float m = v * (q * e);
    return v < 0.f ? m : v - m;
}
__device__ __forceinline__ float sigmoidf(float v) { return 1.0f / (1.0f + expf(-v)); }
__device__ __forceinline__ float readlane_f(float v, int l) { return __int_as_float(__builtin_amdgcn_readlane(__float_as_int(v), l)); }

__device__ __forceinline__ void convert_flat(const float* src, bf16_t* dst, size_t n8, size_t gtid, size_t gstride) {
    for (size_t i = gtid; i < n8; i += gstride) {
        const float4 a = ((const float4*)src)[2 * i], b = ((const float4*)src)[2 * i + 1];
        uint4 w; w.x = pack2(a.x, a.y); w.y = pack2(a.z, a.w); w.z = pack2(b.x, b.y); w.w = pack2(b.z, b.w);
        ((uint4*)dst)[i] = w;
    }
}
__device__ __forceinline__ void transpose_convert(const float* src, bf16_t* dst, int K, int N, LAS float* tile) {
    const int tid = threadIdx.x, ntn = N / 64, ntiles = (K / 64) * ntn;
    for (int tl = blockIdx.x; tl < ntiles; tl += gridDim.x) {
        const int kt = tl / ntn, nt = tl - kt * ntn;
#pragma unroll
        for (int i = 0; i < 8; ++i) { const int r = (tid >> 6) + 8 * i, c = tid & 63; tile[r * 65 + c] = src[(size_t)(kt * 64 + r) * N + nt * 64 + c]; }
        __syncthreads();
#pragma unroll
        for (int i = 0; i < 4; ++i) { const int n = (tid >> 5) + 16 * i, k0 = 2 * (tid & 31);
            const unsigned v = pack2(tile[k0 * 65 + n], tile[(k0 + 1) * 65 + n]);
            *(unsigned*)(dst + (size_t)(nt * 64 + n) * K + kt * 64 + k0) = v; }
        __syncthreads();
    }
}
constexpr int TROW = 1152;
__device__ __forceinline__ void quant_row_load(const Params& P, int it, int lane, float4 (&v)[8]) {
    const bool isv = it >= NEXP; const int row = isv ? it - NEXP : it;
    const float* src = (isv ? P.peer_v : P.peer_u) + (size_t)row * D;
#pragma unroll
    for (int j = 0; j < 2; ++j)
#pragma unroll
        for (int i = 0; i < 4; ++i) v[j * 4 + i] = *(const float4*)(src + j * 1024 + lane * 16 + i * 4);
}
__device__ __forceinline__ void quant_row_store(const Params& P, int it, int lane, const float4 (&v)[8]) {
    const bool isv = it >= NEXP; const int row = isv ? it - NEXP : it;
    float cm[2];
#pragma unroll
    for (int j = 0; j < 2; ++j) { float am = 0.f;
#pragma unroll
        for (int i = 0; i < 4; ++i) { const float4 t = v[j * 4 + i]; am = fmaxf(am, fmaxf(fmaxf(fabsf(t.x), fabsf(t.y)), fmaxf(fabsf(t.z), fabsf(t.w)))); }
        cm[j] = am; }
    float rm = wave_max(fmaxf(cm[0], cm[1])); if (rm == 0.f) rm = 1.f;
    unsigned char* dst = P.ws + (isv ? WS_VB : WS_UB) + (size_t)row * TROW;
    u32x4 w; unsigned sqp = 0u;
#pragma unroll
    for (int j = 0; j < 2; ++j) {
        int sq = (int)ceilf(cm[j] / rm * 255.0f); sq = sq < 1 ? 1 : (sq > 255 ? 255 : sq);
        sqp |= (unsigned)sq << (8 * j);
        const float inv = (255.0f * 7.0f) / (rm * (float)sq);
#pragma unroll
        for (int hh = 0; hh < 2; ++hh) { unsigned dw = 0u;
#pragma unroll
            for (int e = 0; e < 8; ++e) { const float4 t = v[j * 4 + hh * 2 + (e >> 2)]; const float x = (e & 3) == 0 ? t.x : ((e & 3) == 1 ? t.y : ((e & 3) == 2 ? t.z : t.w));
                int n = (int)rintf(x * inv); n = n < -7 ? -7 : (n > 7 ? 7 : n); dw |= (unsigned)(isv ? n + 8 : (n & 15)) << (4 * e); }
            w[j * 2 + hh] = dw; }
    }
    *(u32x4*)(dst + lane * 16) = w;
    *(unsigned short*)(dst + 1024 + lane * 2) = (unsigned short)sqp;
    if (lane == 0) ((float*)(P.ws + (isv ? WS_SV : WS_SU)))[row] = rm * (1.0f / (255.0f * 7.0f));
}
__device__ __forceinline__ void quant_tables(const Params& P, int gw, int nw) {
    const int lane = threadIdx.x & 63;
    float4 va[8], vb[8];
    int it = gw;
    if (it < 2 * NEXP) quant_row_load(P, it, lane, va);
#pragma unroll 1
    for (; it < 2 * NEXP; it += 2 * nw) {
        if (it + nw < 2 * NEXP) quant_row_load(P, it + nw, lane, vb);
        quant_row_store(P, it, lane, va);
        if (it + nw < 2 * NEXP) {
            if (it + 2 * nw < 2 * NEXP) quant_row_load(P, it + 2 * nw, lane, va);
            quant_row_store(P, it + nw, lane, vb);
        }
    }
}
__device__ __forceinline__ void phase_prologue(const Params& P, LAS unsigned char* lds) {
    const size_t gtid = (size_t)blockIdx.x * NTHREADS + threadIdx.x, gstride = (size_t)gridDim.x * NTHREADS;
    unsigned char* ws = P.ws;
    convert_flat(P.x_prompt, (bf16_t*)(ws + WS_XB), (size_t)NTOK_P * D / 8, gtid, gstride);
    convert_flat(P.x_sample, (bf16_t*)(ws + WS_XB) + (size_t)NTOK_P * D, (size_t)NTOK_S * D / 8, gtid, gstride);
    convert_flat(P.sub_keys, (bf16_t*)(ws + WS_SKB), (size_t)8 * 2 * 128 * 128 / 8, gtid, gstride);
    for (size_t i = gtid; i < (size_t)2 * 8 * 64 * 64; i += gstride) {
        const int c = (int)(i & 63), d = (int)((i >> 6) & 63), n = (int)((i >> 12) & 7), m = (int)(i >> 15);
        ((bf16_t*)(ws + WS_LW))[i] = (bf16_t)f2bf((m ? P.lru_w_x : P.lru_w_a)[(n * 64 + c) * 64 + d]); }
    transpose_convert(P.w_in, (bf16_t*)(ws + WS_WINT), D, DIN, (LAS float*)lds);
    transpose_convert(P.w_out, (bf16_t*)(ws + WS_WOT), D, D, (LAS float*)lds);
    transpose_convert(P.w_query, (bf16_t*)(ws + WS_WQT), D, D, (LAS float*)lds);
}

struct EpiProj {
    static constexpr bool PERM = true, AFTER_DRAIN = false;
    float* out; bf16_t* XR; bf16_t* GATE; bf16_t* QB; bf16_t* KB; bf16_t* VB16;
    __device__ __forceinline__ void operator()(const f32x4 (&acc)[2][2][4][2], const pg8::Unit& u, int wr, int wc, int fr, int fq) const {
        const int pn = u.pn; const int coff = wc * 32 + 8 * fq;
#pragma unroll
        for (int ai = 0; ai < 2; ++ai)
#pragma unroll
            for (int m = 0; m < 4; ++m) {
                const int row = u.pm * 256 + ai * 128 + wr * 64 + m * 16 + fr;
                const bool prompt = row < NTOK_P;
                float* rowp = nullptr; bf16_t* rowb = nullptr; float bsc = 1.0f;
                if (pn < 6) { rowb = QB + (size_t)row * DATT + pn * 256; bsc = ATT_SCALE * LOG2E; }
                else if (pn < 18) {
                    const int isv = pn >= 12; const int c0 = (pn - (isv ? 12 : 6)) * 256;
                    if (prompt) { rowp = out + (isv ? O_VP : O_KP) + (size_t)row * DATT + c0; rowb = (isv ? VB16 : KB) + (size_t)row * DATT + c0; }
                    else { const int rr = row - NTOK_P, b = rr >> 3, t = rr & 7; rowp = out + (isv ? O_VS : O_KS) + ((size_t)b * 2048 + 2040 + t) * DATT + c0; }
                } else if (pn < 20) rowb = XR + (size_t)row * DLRU + (pn - 18) * 256;
                else rowb = GATE + (size_t)row * DLRU + (pn - 20) * 256;
#pragma unroll
                for (int bj = 0; bj < 2; ++bj) {
                    const f32x4 v0 = acc[ai][bj][m][0], v1 = acc[ai][bj][m][1];
                    if (rowp) { *(f32x4*)(rowp + coff + bj * 128) = v0; *(f32x4*)(rowp + coff + bj * 128 + 4) = v1; }
                    if (rowb) { u32x4 w; w.x = pg8::cvt_pk_bf16(v0[0] * bsc, v0[1] * bsc); w.y = pg8::cvt_pk_bf16(v0[2] * bsc, v0[3] * bsc); w.z = pg8::cvt_pk_bf16(v1[0] * bsc, v1[1] * bsc); w.w = pg8::cvt_pk_bf16(v1[2] * bsc, v1[3] * bsc);
                        *(u32x4*)(rowb + coff + bj * 128) = w; }
                }
            }
    }
};
struct EpiOut {
    static constexpr bool PERM = true, AFTER_DRAIN = false;
    const bf16_t* xb; bf16_t* pre;
    __device__ __forceinline__ void operator()(const f32x4 (&acc)[2][2][4][2], const pg8::Unit& u, int wr, int wc, int fr, int fq) const {
        const int col0 = u.pn * 256 + wc * 32 + 8 * fq;
#pragma unroll
        for (int ai = 0; ai < 2; ++ai)
#pragma unroll
            for (int m = 0; m < 4; ++m) {
                const int row = u.pm * 256 + ai * 128 + wr * 64 + m * 16 + fr;
                const bf16_t* xr = xb + (size_t)row * D + col0; bf16_t* pr = pre + (size_t)row * D + col0;
#pragma unroll
                for (int bj = 0; bj < 2; ++bj) {
                    const u32x4 xv = *(const u32x4*)(xr + bj * 128); const f32x4 v0 = acc[ai][bj][m][0], v1 = acc[ai][bj][m][1];
                    u32x4 w;
                    w.x = pg8::cvt_pk_bf16(ALPHA * bflo(xv.x) + v0[0], ALPHA * bfhi(xv.x) + v0[1]); w.y = pg8::cvt_pk_bf16(ALPHA * bflo(xv.y) + v0[2], ALPHA * bfhi(xv.y) + v0[3]);
                    w.z = pg8::cvt_pk_bf16(ALPHA * bflo(xv.z) + v1[0], ALPHA * bfhi(xv.z) + v1[1]); w.w = pg8::cvt_pk_bf16(ALPHA * bflo(xv.w) + v1[2], ALPHA * bfhi(xv.w) + v1[3]);
                    *(u32x4*)(pr + bj * 128) = w;
                }
            }
    }
};
struct EpiPlain {
    static constexpr bool PERM = false, AFTER_DRAIN = false;
    float* C; int ldc;
    __device__ __forceinline__ void operator()(const f32x4 (&acc)[2][2][4][2], const pg8::Unit& u, int wr, int wc, int fr, int fq) const {
        const int col0 = u.pn * 256 + wc * 32 + 4 * fq;
#pragma unroll
        for (int ai = 0; ai < 2; ++ai)
#pragma unroll
            for (int m = 0; m < 4; ++m) {
                const int row = u.pm * 256 + ai * 128 + wr * 64 + m * 16 + fr;
                float* pr = C + (size_t)row * ldc + col0;
#pragma unroll
                for (int bj = 0; bj < 2; ++bj)
#pragma unroll
                    for (int n = 0; n < 2; ++n) *(f32x4*)(pr + bj * 128 + n * 16) = acc[ai][bj][m][n];
            }
    }
};

struct EpiBf16Plain {
    static constexpr bool PERM = true, AFTER_DRAIN = false;
    bf16_t* C; int ldc;
    __device__ __forceinline__ void operator()(const f32x4 (&acc)[2][2][4][2], const pg8::Unit& u, int wr, int wc, int fr, int fq) const {
        const int col0 = u.pn * 256 + wc * 32 + 8 * fq;
#pragma unroll
        for (int ai = 0; ai < 2; ++ai)
#pragma unroll
            for (int m = 0; m < 4; ++m) {
                const int row = u.pm * 256 + ai * 128 + wr * 64 + m * 16 + fr;
                bf16_t* pr = C + (size_t)row * ldc + col0;
#pragma unroll
                for (int bj = 0; bj < 2; ++bj) { const f32x4 v0 = acc[ai][bj][m][0], v1 = acc[ai][bj][m][1]; u32x4 w;
                    w.x = pg8::cvt_pk_bf16(v0[0], v0[1]); w.y = pg8::cvt_pk_bf16(v0[2], v0[3]); w.z = pg8::cvt_pk_bf16(v1[0], v1[1]); w.w = pg8::cvt_pk_bf16(v1[2], v1[3]);
                    *(u32x4*)(pr + bj * 128) = w; }
            }
    }
};

template <int MODE>
__device__ __forceinline__ void sample_rows_gemm(const Params& P, const bf16_t* A, const bf16_t* Wt, LAS unsigned char* lds) {
    const int tid = threadIdx.x, lane = tid & 63, w = __builtin_amdgcn_readfirstlane(tid >> 6);
    const int c = lane & 15, g = lane >> 4;
    for (int tile = blockIdx.x; tile < 256; tile += gridDim.x) {
        const int tg = tile & 7, cg = tile >> 3;
        const int k0 = 256 * w;
        const bf16_t* wp = Wt + (size_t)(64 * cg + c) * D + k0 + 8 * g;
        const bf16_t* xp = A + (size_t)(NTOK_P + 32 * tg + c) * D + k0 + 8 * g;
        f32x4 acc[4][2];
#pragma unroll
        for (int ct = 0; ct < 4; ++ct) { acc[ct][0] = (f32x4){0.f, 0.f, 0.f, 0.f}; acc[ct][1] = (f32x4){0.f, 0.f, 0.f, 0.f}; }
#pragma unroll 4
        for (int ks = 0; ks < 8; ++ks) {
            bf16x8 wf[4], xf[2];
#pragma unroll
            for (int ct = 0; ct < 4; ++ct) wf[ct] = *(const bf16x8*)(wp + (size_t)(16 * ct) * D + 32 * ks);
#pragma unroll
            for (int tt = 0; tt < 2; ++tt) xf[tt] = *(const bf16x8*)(xp + (size_t)(16 * tt) * D + 32 * ks);
#pragma unroll
            for (int ct = 0; ct < 4; ++ct)
#pragma unroll
                for (int tt = 0; tt < 2; ++tt) acc[ct][tt] = __builtin_amdgcn_mfma_f32_16x16x32_bf16(wf[ct], xf[tt], acc[ct][tt], 0, 0, 0);
        }
        LAS float* part = (LAS float*)lds;
#pragma unroll
        for (int ct = 0; ct < 4; ++ct)
#pragma unroll
            for (int tt = 0; tt < 2; ++tt) *(LAS f32x4*)(part + ((w * 32 + 16 * tt + c) * 64 + 16 * ct + 4 * g)) = acc[ct][tt];
        __syncthreads();
        {
            const int tok = tid >> 4, c4 = (tid & 15) * 4;
            f32x4 sum = {0.f, 0.f, 0.f, 0.f};
#pragma unroll
            for (int ww = 0; ww < 8; ++ww) sum += *(const LAS f32x4*)(part + ((ww * 32 + tok) * 64 + c4));
            const int row = NTOK_P + 32 * tg + tok, col = 64 * cg + c4;
            if (MODE == 0) { const f32x4 xv = *(const f32x4*)(P.x_sample + (size_t)(row - NTOK_P) * D + col); const f32x4 r = xv * ALPHA + sum; u32x2 wv; wv.x = pg8::cvt_pk_bf16(r[0], r[1]); wv.y = pg8::cvt_pk_bf16(r[2], r[3]); *(u32x2*)((bf16_t*)(P.ws + WS_PRE1) + (size_t)row * D + col) = wv; }
            else { u32x2 wv; wv.x = pg8::cvt_pk_bf16(sum[0], sum[1]); wv.y = pg8::cvt_pk_bf16(sum[2], sum[3]); *(u32x2*)((bf16_t*)(P.ws + WS_QP) + (size_t)row * D + col) = wv; }
        }
        __syncthreads();
    }
}

constexpr int KVS = 288, VOFF = 73728;
struct AttnKV { u32x4 k[8], v[8]; };
struct AttnId { int p, b, h, r, c; };
__device__ __forceinline__ void attn_fetch(const Params& P, const AttnId& u, AttnKV& R) {
    const int tid = threadIdx.x; const int dil = 1 << (2 * u.p);
    const bf16_t* Kb = (const bf16_t*)(P.ws + WS_KB); const bf16_t* Vb = (const bf16_t*)(P.ws + WS_VB16);
    const size_t tok0 = (size_t)u.b * 2048; const int j0 = 128 * u.c - 128, rho0 = (u.c == 0) ? 128 : 0;
#pragma unroll
    for (int it = 0; it < 8; ++it) {
        const int rho = it * 32 + (tid >> 4), ch = tid & 15;
        if (rho >= rho0) {
            const size_t tok = tok0 + (size_t)((j0 + rho) * dil + u.r);
            R.k[it] = *(const u32x4*)(Kb + tok * DATT + u.h * HD + ch * 8);
            R.v[it] = *(const u32x4*)(Vb + tok * DATT + u.h * HD + ch * 8);
        }
    }
}
__device__ __forceinline__ void attn_commit(const AttnId& u, const AttnKV& R, LAS unsigned char* lds) {
    const int tid = threadIdx.x; const int rho0 = (u.c == 0) ? 128 : 0;
#pragma unroll
    for (int it = 0; it < 8; ++it) {
        const int rho = it * 32 + (tid >> 4), ch = tid & 15;
        if (rho >= rho0) { *(LAS u32x4*)(lds + rho * KVS + ch * 16) = R.k[it]; *(LAS u32x4*)(lds + VOFF + rho * KVS + ch * 16) = R.v[it]; }
    }
}
template <int MODE>
__device__ __forceinline__ void attn_unit(const Params& P, const AttnId& uid, AttnKV& R, bool has_next, const AttnId& nid, LAS unsigned char* lds) {
    const int tid = threadIdx.x, lane = tid & 63, w = __builtin_amdgcn_readfirstlane(tid >> 6);
    const int p = uid.p, b = uid.b, h = uid.h, r = uid.r, c = uid.c;
    const int dil = 1 << (2 * p);
    const bf16_t* Qb = (const bf16_t*)(P.ws + WS_QB);
    const size_t tok0 = (size_t)b * 2048;
    attn_commit(uid, R, lds);
    const int cq = lane & 15, g = lane >> 4;
    const int iq = 128 * c + 16 * w + cq;
    const size_t qtok = tok0 + (size_t)(iq * dil + r);
    bf16x8 qf[4];
#pragma unroll
    for (int ks = 0; ks < 4; ++ks) qf[ks] = *(const bf16x8*)(Qb + qtok * DATT + h * HD + 32 * ks + 8 * g);
    __syncthreads();
    if (has_next) attn_fetch(P, nid, R);
    const int ktmin = (8 - w - 8 * c) > 0 ? (8 - w - 8 * c) : 0;
    const float slope2 = exp2f(-8.0f * (float)(h + 1) / 12.0f) * LOG2E * (float)dil;
    f32x4 s[9]; float m = -INFINITY;
#pragma unroll
    for (int kt = 0; kt < 9; ++kt) {
        if (kt >= ktmin) {
            f32x4 acc = {0.f, 0.f, 0.f, 0.f};
#pragma unroll
            for (int ks = 0; ks < 4; ++ks) { const bf16x8 kf = *(const LAS bf16x8*)(lds + (16 * w + 16 * kt + cq) * KVS + (32 * ks + 8 * g) * 2); acc = __builtin_amdgcn_mfma_f32_16x16x32_bf16(kf, qf[ks], acc, 0, 0, 0); }
#pragma unroll
            for (int ii = 0; ii < 4; ++ii) { const int dist = cq + 128 - 16 * kt - 4 * g - ii; float v = acc[ii] - slope2 * (float)dist;
                if (kt == 0 && dist > 128) v = -INFINITY; if (kt == 8 && dist < 0) v = -INFINITY; acc[ii] = v; m = fmaxf(m, v); }
            s[kt] = acc;
        } else s[kt] = (f32x4){-INFINITY, -INFINITY, -INFINITY, -INFINITY};
    }
    m = fmaxf(m, __shfl_xor(m, 16)); m = fmaxf(m, __shfl_xor(m, 32));
    float l = 0.f;
#pragma unroll
    for (int kt = 0; kt < 9; ++kt)
#pragma unroll
        for (int ii = 0; ii < 4; ++ii) { const float pp = exp2f(s[kt][ii] - m); s[kt][ii] = pp; l += pp; }
    l += __shfl_xor(l, 16); l += __shfl_xor(l, 32);
    f32x4 o[8];
#pragma unroll
    for (int dt = 0; dt < 8; ++dt) o[dt] = (f32x4){0.f, 0.f, 0.f, 0.f};
#pragma unroll
    for (int kk = 0; kk < 5; ++kk) {
        const int T0 = 2 * kk, T1 = 2 * kk + 1;
        if (T1 >= ktmin || T0 == 8) {
            u32x4 pw; pw.x = pg8::cvt_pk_bf16(s[T0][0], s[T0][1]); pw.y = pg8::cvt_pk_bf16(s[T0][2], s[T0][3]);
            if (T1 <= 8) { pw.z = pg8::cvt_pk_bf16(s[T1 <= 8 ? T1 : 8][0], s[T1 <= 8 ? T1 : 8][1]); pw.w = pg8::cvt_pk_bf16(s[T1 <= 8 ? T1 : 8][2], s[T1 <= 8 ? T1 : 8][3]); } else { pw.z = 0u; pw.w = 0u; }
            const bf16x8 pf = __builtin_bit_cast(bf16x8, pw);
            const int rT0 = (T0 >= ktmin) ? T0 : 8, rT1 = (T1 <= 8 && T1 >= ktmin) ? T1 : 8;
            const int a0 = VOFF + (16 * w + 16 * rT0 + 4 * g + (cq >> 2)) * KVS + 8 * (cq & 3);
            const int a1 = VOFF + (16 * w + 16 * rT1 + 4 * g + (cq >> 2)) * KVS + 8 * (cq & 3);
#pragma unroll
            for (int dt = 0; dt < 8; ++dt) {
                const s16x4 v0 = __builtin_amdgcn_ds_read_tr16_b64_v4i16((LAS s16x4*)(lds + a0 + dt * 32));
                const s16x4 v1 = __builtin_amdgcn_ds_read_tr16_b64_v4i16((LAS s16x4*)(lds + a1 + dt * 32));
                const bf16x8 vf = {v0[0], v0[1], v0[2], v0[3], v1[0], v1[1], v1[2], v1[3]};
                o[dt] = __builtin_amdgcn_mfma_f32_16x16x32_bf16(vf, pf, o[dt], 0, 0, 0);
            }
        }
    }
    const float inv = 1.0f / l;
    if (MODE == 0) {
        bf16_t* po = (bf16_t*)(P.ws + WS_PO) + ((size_t)p * NTOK_P + qtok) * DATT + h * HD + 4 * g;
#pragma unroll
        for (int dt = 0; dt < 8; ++dt) { u32x2 wv; wv.x = pg8::cvt_pk_bf16(o[dt][0] * inv, o[dt][1] * inv); wv.y = pg8::cvt_pk_bf16(o[dt][2] * inv, o[dt][3] * inv); *(u32x2*)(po + 16 * dt) = wv; }
        if (g == 0) { ((float*)(P.ws + WS_PM))[((size_t)p * NTOK_P + qtok) * NH + h] = m; ((float*)(P.ws + WS_PL))[((size_t)p * NTOK_P + qtok) * NH + h] = l; }
    } else {
        const float* PM = (const float*)(P.ws + WS_PM); const float* PL = (const float*)(P.ws + WS_PL);
        const float m0 = PM[qtok * NH + h], l0 = PL[qtok * NH + h], m1 = PM[((size_t)NTOK_P + qtok) * NH + h], l1 = PL[((size_t)NTOK_P + qtok) * NH + h];
        const float M = fmaxf(m, fmaxf(m0, m1));
        const float w2 = exp2f(m - M), w0 = exp2f(m0 - M) * l0, w1 = exp2f(m1 - M) * l1;
        const float rden = 1.0f / (w2 * l + w0 + w1);
        const bf16_t* p0 = (const bf16_t*)(P.ws + WS_PO) + qtok * DATT + h * HD + 4 * g;
        const bf16_t* p1 = p0 + (size_t)NTOK_P * DATT;
        bf16_t* ar = (bf16_t*)(P.ws + WS_AR) + qtok * D + h * HD + 4 * g;
#pragma unroll
        for (int dt = 0; dt < 8; ++dt) {
            const u32x2 x0 = *(const u32x2*)(p0 + 16 * dt), x1 = *(const u32x2*)(p1 + 16 * dt);
            const float r0 = (w2 * o[dt][0] + w0 * bflo(x0.x) + w1 * bflo(x1.x)) * rden, r1 = (w2 * o[dt][1] + w0 * bfhi(x0.x) + w1 * bfhi(x1.x)) * rden;
            const float r2 = (w2 * o[dt][2] + w0 * bflo(x0.y) + w1 * bflo(x1.y)) * rden, r3 = (w2 * o[dt][3] + w0 * bfhi(x0.y) + w1 * bfhi(x1.y)) * rden;
            u32x2 wv; wv.x = pg8::cvt_pk_bf16(r0, r1); wv.y = pg8::cvt_pk_bf16(r2, r3); *(u32x2*)(ar + 16 * dt) = wv;
        }
    }
    __syncthreads();
}

__device__ __forceinline__ void samp_unit(const Params& P, int b, int h, int k, LAS unsigned char* lds) {
    const int tid = threadIdx.x, lane = tid & 63, w = __builtin_amdgcn_readfirstlane(tid >> 6);
    const int cq = lane & 15, g = lane >> 4;
    if (k < 8) {
#pragma unroll 4
        for (int it = 0; it < 16; ++it) {
            const int rho = it * 16 + (tid >> 5), ch4 = tid & 31, c = 256 * k + rho;
            const size_t so = ((size_t)(b * 2048 + c)) * DATT + h * HD + ch4 * 4;
            const float4 kf = *(const float4*)(P.cache_k + so), vf = *(const float4*)(P.cache_v + so);
            if (c >= 8) { const size_t od = ((size_t)(b * 2048 + c - 8)) * DATT + h * HD + ch4 * 4; *(float4*)(P.out + O_KS + od) = kf; *(float4*)(P.out + O_VS + od) = vf; }
            u32x2 kw, vw; kw.x = pg8::cvt_pk_bf16(kf.x, kf.y); kw.y = pg8::cvt_pk_bf16(kf.z, kf.w); vw.x = pg8::cvt_pk_bf16(vf.x, vf.y); vw.y = pg8::cvt_pk_bf16(vf.z, vf.w);
            *(LAS u32x2*)(lds + rho * KVS + ch4 * 8) = kw; *(LAS u32x2*)(lds + VOFF + rho * KVS + ch4 * 8) = vw;
        }
    } else {
        const int rho = tid >> 5, ch4 = tid & 31;
        u32x2 kw = {0u, 0u}, vw = {0u, 0u};
        if (rho < 8) { const size_t so = ((size_t)(b * 2048 + 2040 + rho)) * DATT + h * HD + ch4 * 4; const float4 kf = *(const float4*)(P.out + O_KS + so), vf = *(const float4*)(P.out + O_VS + so);
            kw.x = pg8::cvt_pk_bf16(kf.x, kf.y); kw.y = pg8::cvt_pk_bf16(kf.z, kf.w); vw.x = pg8::cvt_pk_bf16(vf.x, vf.y); vw.y = pg8::cvt_pk_bf16(vf.z, vf.w); }
        *(LAS u32x2*)(lds + rho * KVS + ch4 * 8) = kw; *(LAS u32x2*)(lds + VOFF + rho * KVS + ch4 * 8) = vw;
        *(LAS u32x2*)(lds + (16 + rho) * KVS + ch4 * 8) = (u32x2){0u, 0u}; *(LAS u32x2*)(lds + VOFF + (16 + rho) * KVS + ch4 * 8) = (u32x2){0u, 0u};
    }
    const int t = cq & 7;
    const bf16_t* Qb = (const bf16_t*)(P.ws + WS_QB) + ((size_t)(NTOK_P + b * 8 + t)) * DATT + h * HD;
    bf16x8 qf[4];
#pragma unroll
    for (int ks = 0; ks < 4; ++ks) qf[ks] = *(const bf16x8*)(Qb + 32 * ks + 8 * g);
    __syncthreads();
    const float slope2 = exp2f(-8.0f * (float)(h + 1) / 12.0f) * LOG2E;
    const bool active = (k < 8) || (w == 0);
    f32x4 s[2]; float m = -INFINITY;
#pragma unroll
    for (int j = 0; j < 2; ++j) {
        f32x4 acc = {0.f, 0.f, 0.f, 0.f};
        if (active) {
#pragma unroll
            for (int ks = 0; ks < 4; ++ks) { const bf16x8 kf = *(const LAS bf16x8*)(lds + (32 * w + 16 * j + cq) * KVS + (32 * ks + 8 * g) * 2); acc = __builtin_amdgcn_mfma_f32_16x16x32_bf16(kf, qf[ks], acc, 0, 0, 0); }
        }
#pragma unroll
        for (int ii = 0; ii < 4; ++ii) {
            const int c = 256 * k + 32 * w + 16 * j + 4 * g + ii, dist = 2048 + t - c;
            int mult = (dist <= 128 ? 1 : 0) + (((dist & 3) == 0 && dist <= 512) ? 1 : 0) + (((dist & 15) == 0 && dist <= 2048) ? 1 : 0);
            if (dist < 0 || !active || c > 2055) mult = 0;
            const float v = mult ? acc[ii] - slope2 * (float)dist : -INFINITY;
            acc[ii] = v; m = fmaxf(m, v);
            s[j][ii] = (float)mult;
            s[j][ii] = v;
        }
    }
    m = fmaxf(m, __shfl_xor(m, 16)); m = fmaxf(m, __shfl_xor(m, 32));
    const float mref = (m == -INFINITY) ? 0.f : m;
    float l = 0.f;
#pragma unroll
    for (int j = 0; j < 2; ++j)
#pragma unroll
        for (int ii = 0; ii < 4; ++ii) {
            const int c = 256 * k + 32 * w + 16 * j + 4 * g + ii, dist = 2048 + t - c;
            const int mult = (dist <= 128 ? 1 : 0) + (((dist & 3) == 0 && dist <= 512) ? 1 : 0) + (((dist & 15) == 0 && dist <= 2048) ? 1 : 0);
            const float pp = (float)mult * exp2f(s[j][ii] - mref); s[j][ii] = pp; l += pp; }
    l += __shfl_xor(l, 16); l += __shfl_xor(l, 32);
    f32x4 o[8];
    {
        u32x4 pw; pw.x = pg8::cvt_pk_bf16(s[0][0], s[0][1]); pw.y = pg8::cvt_pk_bf16(s[0][2], s[0][3]); pw.z = pg8::cvt_pk_bf16(s[1][0], s[1][1]); pw.w = pg8::cvt_pk_bf16(s[1][2], s[1][3]);
        const bf16x8 pf = __builtin_bit_cast(bf16x8, pw);
        const int rw = active ? w : 0;
        const int a0 = VOFF + (32 * rw + 4 * g + (cq >> 2)) * KVS + 8 * (cq & 3), a1 = a0 + 16 * KVS;
#pragma unroll
        for (int dt = 0; dt < 8; ++dt) {
            const s16x4 v0 = __builtin_amdgcn_ds_read_tr16_b64_v4i16((LAS s16x4*)(lds + a0 + dt * 32));
            const s16x4 v1 = __builtin_amdgcn_ds_read_tr16_b64_v4i16((LAS s16x4*)(lds + a1 + dt * 32));
            const bf16x8 vf = {v0[0], v0[1], v0[2], v0[3], v1[0], v1[1], v1[2], v1[3]};
            o[dt] = __builtin_amdgcn_mfma_f32_16x16x32_bf16(vf, pf, (f32x4){0.f, 0.f, 0.f, 0.f}, 0, 0, 0);
        }
    }
    __syncthreads();
    LAS float* OL = (LAS float*)lds;
    LAS float* ML = (LAS float*)(lds + 32768);
    if (cq < 8) {
#pragma unroll
        for (int dt = 0; dt < 8; ++dt) *(LAS f32x4*)(OL + (w * 8 + cq) * 128 + 16 * dt + 4 * g) = o[dt];
        if (g == 0) { ML[(w * 8 + cq) * 2 + 0] = m; ML[(w * 8 + cq) * 2 + 1] = l; }
    }
    __syncthreads();
    {
        const int q = w; float M = -INFINITY;
#pragma unroll
        for (int ww = 0; ww < 8; ++ww) M = fmaxf(M, ML[(ww * 8 + q) * 2]);
        const float Mr = (M == -INFINITY) ? 0.f : M;
        float L = 0.f, o0 = 0.f, o1 = 0.f;
#pragma unroll
        for (int ww = 0; ww < 8; ++ww) { const float f = exp2f(ML[(ww * 8 + q) * 2] - Mr); L += f * ML[(ww * 8 + q) * 2 + 1];
            o0 += f * OL[(ww * 8 + q) * 128 + 2 * lane]; o1 += f * OL[(ww * 8 + q) * 128 + 2 * lane + 1]; }
        float* ps = (float*)(P.ws + WS_PS) + ((((size_t)(b * NH + h)) * 9 + k) * 8 + q) * 130;
        if (lane == 0) { ps[0] = M; ps[1] = L; }
        *(float2*)(ps + 2 + 2 * lane) = make_float2(o0, o1);
    }
    __syncthreads();
}
__device__ __forceinline__ void samp_merge_unit(const Params& P, int b, int t, int h, int lane) {
    const float* ps = (const float*)(P.ws + WS_PS) + ((size_t)(b * NH + h)) * 9 * 8 * 130 + (size_t)t * 130;
    float M = -INFINITY;
#pragma unroll
    for (int k = 0; k < 9; ++k) M = fmaxf(M, ps[(size_t)k * 8 * 130]);
    float L = 0.f, o0 = 0.f, o1 = 0.f;
#pragma unroll
    for (int k = 0; k < 9; ++k) { const float* pk = ps + (size_t)k * 8 * 130; const float f = exp2f(pk[0] - M); L += f * pk[1]; const float2 ov = *(const float2*)(pk + 2 + 2 * lane); o0 += f * ov.x; o1 += f * ov.y; }
    const float inv = 1.0f / L;
    bf16_t* ar = (bf16_t*)(P.ws + WS_AR) + ((size_t)(NTOK_P + b * 8 + t)) * D + h * HD;
    *(unsigned*)(ar + 2 * lane) = pack2(o0 * inv, o1 * inv);
}

constexpr int LRU_XS = 144, LRU_GS = 68, LRU_WAVE = 16 * LRU_XS + 2 * 16 * LRU_GS * 4;
__device__ __forceinline__ void lru_unit(const Params& P, bool samp, int b, int n, int k, int lane, LAS unsigned char* wl) {
    const int T = samp ? 8 : 64; const int row0 = samp ? NTOK_P + b * 8 : b * 2048 + k * 64; const int ch = n * 64 + lane;
    const int cq = lane & 15, g = lane >> 4;
    bf16x8 wf[2][4][2];
    { const bf16_t* lw = (const bf16_t*)(P.ws + WS_LW);
#pragma unroll
      for (int m = 0; m < 2; ++m)
#pragma unroll
        for (int ct = 0; ct < 4; ++ct)
#pragma unroll
            for (int ks = 0; ks < 2; ++ks) wf[m][ct][ks] = *(const bf16x8*)(lw + ((size_t)((m * 8 + n) * 64 + 16 * ct + cq)) * 64 + 32 * ks + 8 * g); }
    const float ba = P.lru_b_a[ch], bx = P.lru_b_x[ch], lam = P.lru_lambda[ch];
    const float sp8 = -8.0f * LOG2E * log1pf(expf(-lam));
    const float cw0 = P.conv_w[ch], cw1 = P.conv_w[512 + ch], cw2 = P.conv_w[1024 + ch], cw3 = P.conv_w[1536 + ch], cb = P.conv_b[ch];
    const bf16_t* XR = (const bf16_t*)(P.ws + WS_XR); const bf16_t* GT = (const bf16_t*)(P.ws + WS_GATE);
    float* R0 = (float*)(P.ws + WS_R0); float* R1 = (float*)(P.ws + WS_R1); bf16_t* AR = (bf16_t*)(P.ws + WS_AR);
    LAS unsigned char* xcb = wl; LAS float* G = (LAS float*)(wl + 16 * LRU_XS);
    float x0 = 0.f, x1 = 0.f, x2 = 0.f, h = 0.f, A = 1.f;
    if (samp) { x0 = P.state_conv[(b * 3 + 0) * 512 + ch]; x1 = P.state_conv[(b * 3 + 1) * 512 + ch]; x2 = P.state_conv[(b * 3 + 2) * 512 + ch]; h = P.state_h[b * 512 + ch]; }
    else if (k > 0) { x0 = bflo(XR[(size_t)(row0 - 3) * DLRU + ch]); x1 = bflo(XR[(size_t)(row0 - 2) * DLRU + ch]); x2 = bflo(XR[(size_t)(row0 - 1) * DLRU + ch]); }
#pragma unroll 1
    for (int t0 = 0; t0 < T; t0 += 16) {
        const int ns = (T - t0) < 16 ? (T - t0) : 16;
        float xc[16], gt[16];
#pragma unroll
        for (int i = 0; i < 16; ++i) { const int r = row0 + t0 + (i < ns ? i : ns - 1); xc[i] = bflo(XR[(size_t)r * DLRU + ch]); gt[i] = bflo(GT[(size_t)r * DLRU + ch]); }
#pragma unroll
        for (int i = 0; i < 16; ++i) {
            const float xin = xc[i]; const float v = ((x0 * cw0 + x1 * cw1) + x2 * cw2) + xin * cw3 + cb;
            if (i < ns) { x0 = x1; x1 = x2; x2 = xin; }
            xc[i] = v;
            *(LAS bf16_t*)(xcb + i * LRU_XS + lane * 2) = (bf16_t)f2bf(v);
        }
        __builtin_amdgcn_wave_barrier();
        const bf16x8 a0 = *(const LAS bf16x8*)(xcb + cq * LRU_XS + (8 * g) * 2), a1 = *(const LAS bf16x8*)(xcb + cq * LRU_XS + (32 + 8 * g) * 2);
#pragma unroll
        for (int m = 0; m < 2; ++m)
#pragma unroll
            for (int ct = 0; ct < 4; ++ct) {
                f32x4 acc = __builtin_amdgcn_mfma_f32_16x16x32_bf16(a0, wf[m][ct][0], (f32x4){0.f, 0.f, 0.f, 0.f}, 0, 0, 0);
                acc = __builtin_amdgcn_mfma_f32_16x16x32_bf16(a1, wf[m][ct][1], acc, 0, 0, 0);
#pragma unroll
                for (int ii = 0; ii < 4; ++ii) G[(m * 16 + 4 * g + ii) * LRU_GS + 16 * ct + cq] = acc[ii];
            }
        __builtin_amdgcn_wave_barrier();
#pragma unroll
        for (int i = 0; i < 16; ++i) {
            if (i < ns) {
                const float ra = G[i * LRU_GS + lane] + ba, ri = G[(16 + i) * LRU_GS + lane] + bx;
                const float r = __builtin_amdgcn_rcpf(1.0f + __builtin_amdgcn_exp2f(-LOG2E * ra)), ig = __builtin_amdgcn_rcpf(1.0f + __builtin_amdgcn_exp2f(-LOG2E * ri));
                const float a = __builtin_amdgcn_exp2f(sp8 * r);
                const float u = __builtin_amdgcn_sqrtf(fmaxf(1.0f - a * a, 0.f)) * (ig * xc[i]);
                h = a * h + u; A = a * A;
                const float ge = gelu_as(gt[i]);
                if (samp) AR[(size_t)(row0 + t0 + i) * D + DATT + ch] = (bf16_t)f2bf(h * ge);
                else { R0[(size_t)(row0 + t0 + i) * DLRU + ch] = h * ge; R1[(size_t)(row0 + t0 + i) * DLRU + ch] = A * ge; }
            }
        }
        __builtin_amdgcn_wave_barrier();
    }
    if (samp) { P.out[O_HS + (size_t)b * 512 + ch] = h; float* co = P.out + O_CS + (size_t)b * 3 * 512 + ch; co[0] = x0; co[512] = x1; co[1024] = x2; }
    else {
        ((float*)(P.ws + WS_HE))[((size_t)(b * 32 + k)) * 512 + ch] = h; ((float*)(P.ws + WS_AE))[((size_t)(b * 32 + k)) * 512 + ch] = A;
        if (k == 31) { float* co = P.out + O_CP + (size_t)b * 3 * 512 + ch; co[0] = x0; co[512] = x1; co[1024] = x2; }
    }
}

__device__ __forceinline__ void phase_lru(const Params& P, LAS unsigned char* lds) {
    const int lane = threadIdx.x & 63, wave = __builtin_amdgcn_readfirstlane(threadIdx.x >> 6);
    const int gw = blockIdx.x * 8 + wave, nw = gridDim.x * 8;
#pragma unroll 1
    for (int pass = 0; pass < 2; ++pass) {
        if ((pass ^ (wave & 1)) == 0) {
            for (int u = gw; u < 2048 + 256; u += nw) { const bool samp = u >= 2048; const int v = samp ? u - 2048 : u; lru_unit(P, samp, samp ? (v >> 3) : (v >> 8), samp ? (v & 7) : ((v >> 5) & 7), v & 31, lane, lds + wave * LRU_WAVE); }
        } else quant_tables(P, gw, nw);
    }
    __syncthreads();
}
__device__ __forceinline__ void phase_samp(const Params& P, LAS unsigned char* lds) {
    for (int u = blockIdx.x; u < 384 * 9; u += gridDim.x) { const int k = u % 9, bh = u / 9; samp_unit(P, bh / NH, bh % NH, k, lds); }
}
__device__ __forceinline__ AttnId attn01_id(int u) {
    const int p = u / 1536, rem = u - p * 1536, bh = rem >> 4, rc = rem & 15; const int b = bh / NH, h = bh - b * NH;
    return AttnId{p, b, h, p == 0 ? 0 : (rc >> 2), p == 0 ? rc : (rc & 3)};
}
__device__ __forceinline__ void phase_attn01(const Params& P, LAS unsigned char* lds) {
    AttnKV R; int u = blockIdx.x;
    if (u < 3072) attn_fetch(P, attn01_id(u), R);
    for (; u < 3072; u += gridDim.x) {
        const int un = u + (int)gridDim.x; const bool hn = un < 3072;
        attn_unit<0>(P, attn01_id(u), R, hn, attn01_id(hn ? un : u), lds);
    }
}
__device__ __forceinline__ void phase_mix_b(const Params& P, LAS unsigned char* lds) {
    {
        const int gt = blockIdx.x * NTHREADS + threadIdx.x;
        for (int i = gt; i < 8 * 32 * 512; i += gridDim.x * NTHREADS) {
            const int ch = i & 511, k = (i >> 9) & 31, b = i >> 14;
            const float* HE = (const float*)(P.ws + WS_HE) + (size_t)b * 32 * 512 + ch; const float* AE = (const float*)(P.ws + WS_AE) + (size_t)b * 32 * 512 + ch;
            float hin = 0.f;
            for (int kk = 0; kk < k; ++kk) hin = HE[kk * 512] + AE[kk * 512] * hin;
            const float* R0 = (const float*)(P.ws + WS_R0) + (size_t)(b * 2048 + k * 64) * DLRU + ch; const float* R1 = (const float*)(P.ws + WS_R1) + (size_t)(b * 2048 + k * 64) * DLRU + ch;
            bf16_t* ar = (bf16_t*)(P.ws + WS_AR) + (size_t)(b * 2048 + k * 64) * D + DATT + ch;
#pragma unroll 8
            for (int t = 0; t < 64; ++t) ar[(size_t)t * D] = (bf16_t)f2bf(R0[(size_t)t * DLRU] + R1[(size_t)t * DLRU] * hin);
            if (k == 31) P.out[O_HP + (size_t)b * 512 + ch] = HE[31 * 512] + AE[31 * 512] * hin;
        }
    }
    { const int lane = threadIdx.x & 63, gw = blockIdx.x * 8 + (threadIdx.x >> 6);
      for (int u = gw; u < NTOK_S * NH; u += gridDim.x * 8) { const int row = u / NH, h = u - row * NH; samp_merge_unit(P, row >> 3, row & 7, h, lane); } }
    {
        AttnKV R; int u = blockIdx.x;
        if (u < 1536) attn_fetch(P, AttnId{2, (u >> 4) / NH, (u >> 4) % NH, u & 15, 0}, R);
        for (; u < 1536; u += gridDim.x) {
            const int un = u + (int)gridDim.x; const bool hn = un < 1536; const int uu = hn ? un : u;
            attn_unit<1>(P, AttnId{2, (u >> 4) / NH, (u >> 4) % NH, u & 15, 0}, R, hn, AttnId{2, (uu >> 4) / NH, (uu >> 4) % NH, uu & 15, 0}, lds);
        }
    }
}

__device__ __forceinline__ void phase_ln1(const Params& P) {
    const int lane = threadIdx.x & 63, wave = threadIdx.x >> 6;
    const bf16_t* pre = (const bf16_t*)(P.ws + WS_PRE1); bf16_t* x1b = (bf16_t*)(P.ws + WS_X1B);
    for (int row = blockIdx.x * 8 + wave; row < NTOK; row += gridDim.x * 8) {
        float4 v[8]; float s = 0.f;
#pragma unroll
        for (int j = 0; j < 8; j += 2) { const u32x4 pw = *(const u32x4*)(pre + (size_t)row * D + (j >> 2) * 1024 + lane * 16 + (j & 3) * 4);
            v[j] = make_float4(bflo(pw.x), bfhi(pw.x), bflo(pw.y), bfhi(pw.y)); v[j + 1] = make_float4(bflo(pw.z), bfhi(pw.z), bflo(pw.w), bfhi(pw.w));
            s += (v[j].x + v[j].y) + (v[j].z + v[j].w) + (v[j + 1].x + v[j + 1].y) + (v[j + 1].z + v[j + 1].w); }
        const float mean = wave_sum(s) * (1.0f / D); float q = 0.f;
#pragma unroll
        for (int j = 0; j < 8; ++j) { const float a = v[j].x - mean, b = v[j].y - mean, c = v[j].z - mean, d = v[j].w - mean; q += (a * a + b * b) + (c * c + d * d); }
        const float rstd = rsqrtf(wave_sum(q) * (1.0f / D) + LN_EPS);
        float am = 0.f;
#pragma unroll
        for (int j = 0; j < 8; ++j) { const int col = (j >> 2) * 1024 + lane * 16 + (j & 3) * 4; const float4 g = *(const float4*)(P.ln1_g + col), bb = *(const float4*)(P.ln1_b + col);
            float4 o; o.x = (v[j].x - mean) * rstd * g.x + bb.x; o.y = (v[j].y - mean) * rstd * g.y + bb.y; o.z = (v[j].z - mean) * rstd * g.z + bb.z; o.w = (v[j].w - mean) * rstd * g.w + bb.w;
            v[j] = o; am = fmaxf(am, fmaxf(fmaxf(fabsf(o.x), fabsf(o.y)), fmaxf(fabsf(o.z), fabsf(o.w))));
            uint2 w; w.x = pack2(o.x, o.y); w.y = pack2(o.z, o.w); *(uint2*)(x1b + (size_t)row * D + col) = w; }
        am = wave_max(am); if (am == 0.f) am = 1.f;
        const float inv = 119.0f / am;
        unsigned char* xq = P.ws + WS_X1Q + (size_t)row * D;
        u32x4 wh, wl;
#pragma unroll
        for (int d = 0; d < 4; ++d) { unsigned dh = 0u, dl = 0u;
#pragma unroll
            for (int e = 0; e < 8; ++e) { const float4 t = v[d * 2 + (e >> 2)]; const float x = (e & 3) == 0 ? t.x : ((e & 3) == 1 ? t.y : ((e & 3) == 2 ? t.z : t.w));
                const int q = (int)rintf(x * inv); dl |= (unsigned)(q & 15) << (4 * e); dh |= (unsigned)(((q + 8) >> 4) & 15) << (4 * e); }
            wh[d] = dh; wl[d] = dl; }
        *(u32x4*)(xq + lane * 32) = wh; *(u32x4*)(xq + lane * 32 + 16) = wl;
        if (lane == 0) ((float*)(P.ws + WS_SX))[row] = am * (1.0f / 119.0f);
    }
}

__device__ __forceinline__ int mono(float v) { const int b = __float_as_int(v); return b ^ ((b >> 31) & 0x7fffffff); }
__device__ __forceinline__ float unmono(int k) { return __int_as_float(k ^ ((k >> 31) & 0x7fffffff)); }
#define MK_INSERT16(L, X) do { int _x = (X); _Pragma("unroll") for (int _j = 0; _j < 16; ++_j) { const int _hi = max(L[_j], _x); _x = min(L[_j], _x); L[_j] = _hi; } } while (0)

template <int N> __device__ __forceinline__ void bitonic_sort_desc(int (&v)[N]) {
#pragma unroll
    for (int k = 2; k <= N; k <<= 1)
#pragma unroll
        for (int j = k >> 1; j > 0; j >>= 1)
#pragma unroll
            for (int i = 0; i < N; ++i) { const int l = i ^ j;
                if (l > i) { const int a = v[i], b = v[l]; if ((i & k) == 0) { v[i] = max(a, b); v[l] = min(a, b); } else { v[i] = min(a, b); v[l] = max(a, b); } } }
}
template <int N> __device__ __forceinline__ void bitonic_merge_desc(int (&v)[N]) {
#pragma unroll
    for (int j = N >> 1; j > 0; j >>= 1)
#pragma unroll
        for (int i = 0; i < N; ++i) { const int l = i ^ j; if (l > i) { const int a = v[i], b = v[l]; v[i] = max(a, b); v[l] = min(a, b); } }
}
__device__ __forceinline__ void xlane_merge16(int (&v)[16], int off) {
    int c[16];
#pragma unroll
    for (int i = 0; i < 16; ++i) c[i] = max(v[i], __shfl_xor(v[15 - i], off));
#pragma unroll
    for (int i = 0; i < 16; ++i) v[i] = c[i];
    bitonic_merge_desc<16>(v);
}
__device__ __forceinline__ int sel4(int g, int a, int b, int c, int d) { return g == 0 ? a : (g == 1 ? b : (g == 2 ? c : d)); }
__device__ __forceinline__ float sel4f(int g, float a, float b, float c, float d) { return g == 0 ? a : (g == 1 ? b : (g == 2 ? c : d)); }
__device__ __forceinline__ constexpr int cand_a(int role, int i) {
    return role == 0 ? 0 : role == 1 ? (i < 8 ? 1 : (i < 13 ? 2 : 4)) : role == 2 ? (i < 4 ? 3 : (i < 6 ? 5 : (i < 8 ? 6 : (i < 10 ? 7 : 8 + (i - 10))))) : (i < 2 ? 14 + i : -1);
}
__device__ __forceinline__ constexpr int cand_b(int role, int i) {
    return role == 0 ? i : role == 1 ? (i < 8 ? i : (i < 13 ? i - 8 : i - 13)) : role == 2 ? (i < 4 ? i : (i < 6 ? i - 4 : (i < 8 ? i - 6 : (i < 10 ? i - 8 : 0)))) : 0;
}

__device__ __forceinline__ void route_unit(const Params& P, int h, int tg, LAS unsigned char* lds, LAS int* lst) {
    const int lane = threadIdx.x & 63, w = __builtin_amdgcn_readfirstlane(threadIdx.x >> 6);
    const int cq = lane & 15, g = lane >> 4;
    const int tok = tg * 128 + w * 16 + cq;
    const bf16_t* qrow = (const bf16_t*)(P.ws + WS_QP) + (size_t)tok * D + h * 256;
    int L0[16], L1[16];
#pragma unroll
    for (int p = 0; p < 2; ++p) {
        bf16x8 qf[4];
#pragma unroll
        for (int ks = 0; ks < 4; ++ks) qf[ks] = *(const bf16x8*)(qrow + p * 128 + 32 * ks + 8 * g);
        int v0[16], v1[16];
#pragma unroll
        for (int kt = 0; kt < 8; ++kt) {
            f32x4 acc = {0.f, 0.f, 0.f, 0.f};
#pragma unroll
            for (int ks = 0; ks < 4; ++ks) { const bf16x8 kf = *(const LAS bf16x8*)(lds + (p * 128 + 16 * kt + cq) * KVS + (32 * ks + 8 * g) * 2); acc = __builtin_amdgcn_mfma_f32_16x16x32_bf16(kf, qf[ks], acc, 0, 0, 0); }
#pragma unroll
            for (int ii = 0; ii < 4; ++ii) { const int key = (mono(acc[ii]) & ~127) | (16 * kt + 4 * g + ii); if (kt < 4) v0[kt * 4 + ii] = key; else v1[(kt - 4) * 4 + ii] = key; }
        }
        bitonic_sort_desc<16>(v0); bitonic_sort_desc<16>(v1);
#pragma unroll
        for (int i = 0; i < 16; ++i) v0[i] = max(v0[i], v1[15 - i]);
        bitonic_merge_desc<16>(v0);
        xlane_merge16(v0, 16); xlane_merge16(v0, 32);
#pragma unroll
        for (int i = 0; i < 16; ++i) { if (p == 0) L0[i] = v0[i]; else L1[i] = v0[i]; }
    }
    if (g == 0) {
#pragma unroll
        for (int i = 0; i < 16; ++i) lst[(cq * 2 + 0) * 16 + i] = L0[i];
    }
    if (g == 1) {
#pragma unroll
        for (int i = 0; i < 16; ++i) lst[(cq * 2 + 1) * 16 + i] = L1[i];
    }
    float f0[16], f1[16];
#pragma unroll
    for (int i = 0; i < 16; ++i) { f0[i] = unmono(L0[i] & ~127); f1[i] = unmono(L1[i] & ~127); }
    int c[16];
#pragma unroll
    for (int i = 0; i < 16; ++i) {
        constexpr int NEG = (int)0x80000000;
        const float va = sel4f(g, f0[cand_a(0, i)], f0[cand_a(1, i)], f0[cand_a(2, i)], f0[cand_a(3, i) < 0 ? 0 : cand_a(3, i)]);
        const float vb = sel4f(g, f1[cand_b(0, i)], f1[cand_b(1, i)], f1[cand_b(2, i)], f1[cand_b(3, i)]);
        const int id = sel4(g, (cand_a(0, i) << 4) | cand_b(0, i), (cand_a(1, i) << 4) | cand_b(1, i), (cand_a(2, i) << 4) | cand_b(2, i), ((cand_a(3, i) < 0 ? 0 : cand_a(3, i)) << 4) | cand_b(3, i));
        int key = (mono(va + vb) & ~255) | id;
        if (cand_a(3, i) < 0) key = (g == 3) ? NEG : key;
        c[i] = key;
    }
    bitonic_sort_desc<16>(c);
    xlane_merge16(c, 16); xlane_merge16(c, 32);
    const float mx = unmono(c[0] & ~255);
    float e[16]; float sum = 0.f;
#pragma unroll
    for (int i = 0; i < 16; ++i) { e[i] = exp2f((unmono(c[i] & ~255) - mx) * LOG2E); sum += e[i]; }
    const float inv = 1.0f / sum;
    __builtin_amdgcn_wave_barrier();
    int ei[4]; float gi[4];
#pragma unroll
    for (int j = 0; j < 4; ++j) {
        const int key = sel4(g, c[j], c[4 + j], c[8 + j], c[12 + j]);
        gi[j] = sel4f(g, e[j], e[4 + j], e[8 + j], e[12 + j]) * inv;
        const int a = (key >> 4) & 15, b = key & 15;
        const int i0 = lst[(cq * 2 + 0) * 16 + a] & 127, i1 = lst[(cq * 2 + 1) * 16 + b] & 127;
        ei[j] = i0 * 128 + i1;
    }
    int* EIDX = (int*)(P.ws + WS_EIDX); float* GW = (float*)(P.ws + WS_GW);
    *(int4*)(EIDX + (size_t)tok * 128 + h * 16 + 4 * g) = make_int4(ei[0], ei[1], ei[2], ei[3]);
    *(float4*)(GW + (size_t)tok * 128 + h * 16 + 4 * g) = make_float4(gi[0], gi[1], gi[2], gi[3]);
    __builtin_amdgcn_wave_barrier();
}
__device__ __forceinline__ void phase_route(const Params& P, LAS unsigned char* lds) {
    const int tid = threadIdx.x, wave = __builtin_amdgcn_readfirstlane(tid >> 6);
    const int h = blockIdx.x & 7, slot = blockIdx.x >> 3, nslot = gridDim.x >> 3;
    const bf16_t* sk = (const bf16_t*)(P.ws + WS_SKB) + (size_t)h * 2 * 128 * 128;
#pragma unroll
    for (int it = 0; it < 8; ++it) { const int row = it * 32 + (tid >> 4), ch = tid & 15; *(LAS u32x4*)(lds + row * KVS + ch * 16) = *(const u32x4*)(sk + (size_t)row * 128 + ch * 8); }
    __syncthreads();
    LAS int* lst = (LAS int*)(lds + 73728) + wave * 512;
    for (int tg = slot; tg < NTOK / 128; tg += nslot) route_unit(P, h, tg, lds, lst);
}

__device__ __forceinline__ float ubf(unsigned x, int k) { return (float)((x >> (8 * k)) & 0xffu); }
constexpr int XSLOT = 1152, XGRP = 4 * XSLOT, XNG = 4, XWAVE = XNG * XGRP;
__device__ __forceinline__ void dma_group(__amdgpu_buffer_rsrc_t tab, int e_lo, int e_hi, int g, LAS unsigned char* sb, int lane) {
#pragma unroll
    for (int j = 0; j < 4; ++j) {
        const int k = g * 4 + j; const int e = __builtin_amdgcn_readlane(k < 64 ? e_lo : e_hi, k & 63);
        const int so = e * TROW;
        __builtin_amdgcn_raw_ptr_buffer_load_lds(tab, (LAS void*)(sb + j * XSLOT), 16, lane * 16, so, 0, 0);
        if (lane < 8) __builtin_amdgcn_raw_ptr_buffer_load_lds(tab, (LAS void*)(sb + j * XSLOT + 1024), 16, 1024 + lane * 16, so, 0, 0);
    }
}
__device__ __forceinline__ void u_consume(const LAS unsigned char* sb, const u32x4& xh, const u32x4& xl, float a_lo, float a_hi, float b_lo, float b_hi, int g, int lane, float& w_lo, float& w_hi) {
    int d[4];
#pragma unroll
    for (int j = 0; j < 4; ++j) {
        const u32x4 nb = *(const LAS u32x4*)(sb + j * XSLOT + lane * 16); const unsigned sc = *(const LAS unsigned short*)(sb + j * XSLOT + 1024 + lane * 2);
        int tot = 0;
#pragma unroll
        for (int jj = 0; jj < 2; ++jj) {
            int th = __builtin_amdgcn_sdot8((int)nb[jj * 2], (int)xh[jj * 2], 0, false); th = __builtin_amdgcn_sdot8((int)nb[jj * 2 + 1], (int)xh[jj * 2 + 1], th, false);
            int tl = __builtin_amdgcn_sdot8((int)nb[jj * 2], (int)xl[jj * 2], 0, false); tl = __builtin_amdgcn_sdot8((int)nb[jj * 2 + 1], (int)xl[jj * 2 + 1], tl, false);
            tot += (16 * th + tl) * (int)((sc >> (8 * jj)) & 255u); }
        d[j] = tot;
    }
    const auto s02 = __builtin_amdgcn_permlane32_swap((unsigned)d[0], (unsigned)d[2], false, false);
    const auto s13 = __builtin_amdgcn_permlane32_swap((unsigned)d[1], (unsigned)d[3], false, false);
    const int r0 = (int)s02[0] + (int)s02[1], r1 = (int)s13[0] + (int)s13[1];
    const auto s01 = __builtin_amdgcn_permlane16_swap((unsigned)r0, (unsigned)r1, false, false);
    int r = (int)s01[0] + (int)s01[1];
    r += __builtin_amdgcn_update_dpp(0, r, 0x128, 0xf, 0xf, false);
    r += __builtin_amdgcn_update_dpp(0, r, 0x124, 0xf, 0xf, false);
    r += __builtin_amdgcn_update_dpp(0, r, 0x4E, 0xf, 0xf, false);
    r += __builtin_amdgcn_update_dpp(0, r, 0xB1, 0xf, 0xf, false);
    const int tot = __shfl(r, (lane & 3) * 16);
    const bool mine = ((lane >> 2) == (g & 15));
    const bool hi = g >= 16;
    const float wv = (hi ? b_hi : b_lo) * gelu_as((float)tot * (hi ? a_hi : a_lo));
    if (hi) w_hi = mine ? wv : w_hi; else w_lo = mine ? wv : w_lo;
}
__device__ __forceinline__ void v_consume(const LAS unsigned char* sb, int (&acc)[32], int (&bias)[2], float w_lo, float w_hi, float inv_sw, int g, int lane) {
    u32x4 nb[4]; int wq[2] = {0, 0};
#pragma unroll
    for (int j = 0; j < 4; ++j) {
        const int k = g * 4 + j; const float w = readlane_f(k < 64 ? w_lo : w_hi, k & 63) * inv_sw;
        nb[j] = *(const LAS u32x4*)(sb + j * XSLOT + lane * 16); const unsigned sc = *(const LAS unsigned short*)(sb + j * XSLOT + 1024 + lane * 2);
#pragma unroll
        for (int jj = 0; jj < 2; ++jj) { const int q = (int)rintf(w * (float)((sc >> (8 * jj)) & 255u)); wq[jj] |= (q & 255) << (8 * j); }
    }
    bias[0] = __builtin_amdgcn_sdot4(wq[0], 0x01010101, bias[0], false); bias[1] = __builtin_amdgcn_sdot4(wq[1], 0x01010101, bias[1], false);
#pragma unroll
    for (int i = 0; i < 4; ++i) {
        const unsigned r0 = nb[0][i], r1 = nb[1][i], r2 = nb[2][i], r3 = nb[3][i];
        const unsigned p01a = __builtin_amdgcn_perm(r1, r0, 0x05010400u), p01b = __builtin_amdgcn_perm(r1, r0, 0x07030602u);
        const unsigned p23a = __builtin_amdgcn_perm(r3, r2, 0x05010400u), p23b = __builtin_amdgcn_perm(r3, r2, 0x07030602u);
        const unsigned t0 = __builtin_amdgcn_perm(p23a, p01a, 0x05040100u), t1 = __builtin_amdgcn_perm(p23a, p01a, 0x07060302u);
        const unsigned t2 = __builtin_amdgcn_perm(p23b, p01b, 0x05040100u), t3 = __builtin_amdgcn_perm(p23b, p01b, 0x07060302u);
        const int wv = wq[i >> 1];
        acc[i * 8 + 0] = __builtin_amdgcn_sdot4((int)(t0 & 0x0F0F0F0Fu), wv, acc[i * 8 + 0], false); acc[i * 8 + 1] = __builtin_amdgcn_sdot4((int)((t0 >> 4) & 0x0F0F0F0Fu), wv, acc[i * 8 + 1], false);
        acc[i * 8 + 2] = __builtin_amdgcn_sdot4((int)(t1 & 0x0F0F0F0Fu), wv, acc[i * 8 + 2], false); acc[i * 8 + 3] = __builtin_amdgcn_sdot4((int)((t1 >> 4) & 0x0F0F0F0Fu), wv, acc[i * 8 + 3], false);
        acc[i * 8 + 4] = __builtin_amdgcn_sdot4((int)(t2 & 0x0F0F0F0Fu), wv, acc[i * 8 + 4], false); acc[i * 8 + 5] = __builtin_amdgcn_sdot4((int)((t2 >> 4) & 0x0F0F0F0Fu), wv, acc[i * 8 + 5], false);
        acc[i * 8 + 6] = __builtin_amdgcn_sdot4((int)(t3 & 0x0F0F0F0Fu), wv, acc[i * 8 + 6], false); acc[i * 8 + 7] = __builtin_amdgcn_sdot4((int)((t3 >> 4) & 0x0F0F0F0Fu), wv, acc[i * 8 + 7], false);
    }
}
__device__ __forceinline__ void exp_epilogue(const Params& P, int row, int ln, const int (&acc)[32], const int (&bias)[2], float scale_w) {
    const bf16_t* x1b = (const bf16_t*)(P.ws + WS_X1B);
    float val[32]; float s = 0.f;
#pragma unroll
    for (int jj = 0; jj < 2; ++jj) {
        const int b8 = 8 * bias[jj];
#pragma unroll
        for (int hh = 0; hh < 2; ++hh) {
            const u32x4 xa = *(const u32x4*)(x1b + (size_t)row * D + jj * 1024 + ln * 16 + hh * 8);
#pragma unroll
            for (int i = 0; i < 4; ++i) { const int e0 = jj * 16 + hh * 8 + 2 * i;
                val[e0] = scale_w * (float)(acc[e0] - b8) + ALPHA * bflo(xa[i]); val[e0 + 1] = scale_w * (float)(acc[e0 + 1] - b8) + ALPHA * bfhi(xa[i]); s += val[e0] + val[e0 + 1]; }
        }
    }
    const float mean = wave_sum(s) * (1.0f / D); float q = 0.f;
#pragma unroll
    for (int i = 0; i < 32; ++i) { const float d0 = val[i] - mean; q += d0 * d0; }
    const float rstd = rsqrtf(wave_sum(q) * (1.0f / D) + LN_EPS);
    float* yo = P.out + (row < NTOK_P ? O_YP + (size_t)row * D : O_YS + (size_t)(row - NTOK_P) * D);
    const int lo16 = ln * 16;
#pragma unroll
    for (int jj = 0; jj < 2; ++jj)
#pragma unroll
        for (int i = 0; i < 4; ++i) {
            const int col = jj * 1024 + lo16 + i * 4;
            const float4 g0 = *(const float4*)(P.ln2_g + col), b0 = *(const float4*)(P.ln2_b + col);
            float4 o;
            o.x = (val[jj * 16 + i * 4 + 0] - mean) * rstd * g0.x + b0.x; o.y = (val[jj * 16 + i * 4 + 1] - mean) * rstd * g0.y + b0.y;
            o.z = (val[jj * 16 + i * 4 + 2] - mean) * rstd * g0.z + b0.z; o.w = (val[jj * 16 + i * 4 + 3] - mean) * rstd * g0.w + b0.w;
            *(float4*)(yo + col) = o;
        }
}
__device__ __forceinline__ void phase_experts(const Params& P, LAS unsigned char* lds) {
    const int lane = threadIdx.x & 63, wave = __builtin_amdgcn_readfirstlane(threadIdx.x >> 6);
    const int* EIDX = (const int*)(P.ws + WS_EIDX); const float* GW = (const float*)(P.ws + WS_GW);
    const __amdgpu_buffer_rsrc_t UQ = __builtin_amdgcn_make_buffer_rsrc((void*)(P.ws + WS_UB), 0, NEXP * TROW, 0x00020000);
    const __amdgpu_buffer_rsrc_t VQ = __builtin_amdgcn_make_buffer_rsrc((void*)(P.ws + WS_VB), 0, NEXP * TROW, 0x00020000);
    const float* SU = (const float*)(P.ws + WS_SU); const float* SV = (const float*)(P.ws + WS_SV); const float* SX = (const float*)(P.ws + WS_SX);
    LAS unsigned char* wb = lds + wave * XWAVE;
    for (int row = blockIdx.x * 8 + wave; row < NTOK_P; row += gridDim.x * 8) {
        int ln = lane; asm volatile("" : "+v"(ln));
        const u32x4 xh = *(const u32x4*)(P.ws + WS_X1Q + (size_t)row * D + ln * 32), xl = *(const u32x4*)(P.ws + WS_X1Q + (size_t)row * D + ln * 32 + 16);
        const float sx = SX[row];
        const int e_lo = EIDX[(size_t)row * 128 + ln], e_hi = EIDX[(size_t)row * 128 + 64 + ln];
        const float g_lo = GW[(size_t)row * 128 + ln], g_hi = GW[(size_t)row * 128 + 64 + ln];
        const float a_lo = SU[e_lo] * sx, a_hi = SU[e_hi] * sx, b_lo = g_lo * SV[e_lo], b_hi = g_hi * SV[e_hi];
        float w_lo = 0.f, w_hi = 0.f;
        asm volatile("s_waitcnt vmcnt(0)" ::: "memory");
        dma_group(UQ, e_lo, e_hi, 0, wb, lane); dma_group(UQ, e_lo, e_hi, 1, wb + XGRP, lane); dma_group(UQ, e_lo, e_hi, 2, wb + 2 * XGRP, lane);
        int sg = 0;
#pragma unroll 1
        for (int g = 0; g < 32; ++g) {
            const int sn = (sg + 3) & 3;
            if (g + 3 < 32) dma_group(UQ, e_lo, e_hi, g + 3, wb + sn * XGRP, lane); else dma_group(VQ, e_lo, e_hi, g + 3 - 32, wb + sn * XGRP, lane);
            asm volatile("s_waitcnt vmcnt(24)" ::: "memory");
            u_consume(wb + sg * XGRP, xh, xl, a_lo, a_hi, b_lo, b_hi, g, lane, w_lo, w_hi);
            sg = (sg + 1) & 3;
        }
        float wmax = wave_max(fmaxf(fabsf(w_lo), fabsf(w_hi))); if (wmax == 0.f) wmax = 1.f;
        const float scale_w = wmax * (255.0f / 127.0f), inv_sw = 1.0f / scale_w;
        int acc[32]; int bias[2] = {0, 0};
#pragma unroll
        for (int i = 0; i < 32; ++i) acc[i] = 0;
#pragma unroll 1
        for (int g = 0; g < 32; ++g) {
            const int sn = (sg + 3) & 3;
            dma_group(VQ, e_lo, e_hi, (g + 3) & 31, wb + sn * XGRP, lane);
            asm volatile("s_waitcnt vmcnt(24)" ::: "memory");
            v_consume(wb + sg * XGRP, acc, bias, w_lo, w_hi, inv_sw, g, lane);
            sg = (sg + 1) & 3;
        }
        asm volatile("s_waitcnt vmcnt(0)" ::: "memory");
        exp_epilogue(P, row, ln, acc, bias, scale_w);
    }
    LAS int* cmax = (LAS int*)(lds + MISC_OFF + 64);
    __syncthreads();
    for (int ct = blockIdx.x; ct < NTOK_S; ct += gridDim.x) {
        const int row = NTOK_P + ct;
        int ln = lane; asm volatile("" : "+v"(ln));
        const u32x4 xh = *(const u32x4*)(P.ws + WS_X1Q + (size_t)row * D + ln * 32), xl = *(const u32x4*)(P.ws + WS_X1Q + (size_t)row * D + ln * 32 + 16);
        const float sx = SX[row];
        const int kk = 16 * wave + (ln & 15);
        const int e_loc = EIDX[(size_t)row * 128 + kk]; const float g_loc = GW[(size_t)row * 128 + kk];
        const float a_loc = SU[e_loc] * sx, b_loc = g_loc * SV[e_loc];
        float w_loc = 0.f, w_dummy = 0.f;
        asm volatile("s_waitcnt vmcnt(0)" ::: "memory");
#pragma unroll
        for (int g = 0; g < 4; ++g) dma_group(UQ, e_loc, e_loc, g, wb + g * XGRP, lane);
        asm volatile("s_waitcnt vmcnt(0)" ::: "memory");
#pragma unroll
        for (int g = 0; g < 4; ++g) u_consume(wb + g * XGRP, xh, xl, a_loc, a_loc, b_loc, b_loc, g, lane, w_loc, w_dummy);
#pragma unroll
        for (int g = 0; g < 4; ++g) dma_group(VQ, e_loc, e_loc, g, wb + g * XGRP, lane);
        const float wm = wave_max(ln < 16 ? fabsf(w_loc) : 0.f);
        if (lane == 0) cmax[wave] = __float_as_int(wm);
        __syncthreads();
        float wmax = 0.f;
#pragma unroll
        for (int ww = 0; ww < 8; ++ww) wmax = fmaxf(wmax, __int_as_float(cmax[ww]));
        if (wmax == 0.f) wmax = 1.f;
        const float scale_w = wmax * (255.0f / 127.0f), inv_sw = 1.0f / scale_w;
        int acc[32]; int bias[2] = {0, 0};
#pragma unroll
        for (int i = 0; i < 32; ++i) acc[i] = 0;
        asm volatile("s_waitcnt vmcnt(0)" ::: "memory");
#pragma unroll
        for (int g = 0; g < 4; ++g) v_consume(wb + g * XGRP, acc, bias, w_loc, w_loc, inv_sw, g, lane);
        __builtin_amdgcn_wave_barrier();
        {
            LAS int* pp = (LAS int*)wb + lane * 36;
#pragma unroll
            for (int i = 0; i < 8; ++i) *(LAS u32x4*)(pp + 4 * i) = (u32x4){(unsigned)acc[4 * i], (unsigned)acc[4 * i + 1], (unsigned)acc[4 * i + 2], (unsigned)acc[4 * i + 3]};
            pp[32] = bias[0]; pp[33] = bias[1];
        }
        __syncthreads();
        if (wave == 0) {
#pragma unroll
            for (int i = 0; i < 32; ++i) acc[i] = 0;
            bias[0] = 0; bias[1] = 0;
#pragma unroll 1
            for (int ww = 0; ww < 8; ++ww) {
                const LAS int* pp = (const LAS int*)(lds + ww * XWAVE) + lane * 36;
#pragma unroll
                for (int i = 0; i < 8; ++i) { const u32x4 t = *(const LAS u32x4*)(pp + 4 * i); acc[4 * i] += (int)t[0]; acc[4 * i + 1] += (int)t[1]; acc[4 * i + 2] += (int)t[2]; acc[4 * i + 3] += (int)t[3]; }
                bias[0] += pp[32]; bias[1] += pp[33];
            }
            exp_epilogue(P, row, ln, acc, bias, scale_w);
        }
        __syncthreads();
    }
}

constexpr int NPHASE = 11;
__global__ void __launch_bounds__(NTHREADS, 2) fwd(Params P) {
    extern __shared__ __attribute__((aligned(16))) unsigned char lds_raw[];
    LAS unsigned char* lds = (LAS unsigned char*)lds_raw;
    volatile LAS unsigned* misc = (volatile LAS unsigned*)(lds + MISC_OFF);
    const int lo = P.ph_lo, hi = P.ph_hi;
    XcdBarrier bar; bar.bar = (unsigned*)(P.ws + WS_CTL); bar.x = 0; bar.st = nullptr;
    if (hi - lo > 1) {
        if (threadIdx.x == 0) { misc[0] = 0u; misc[1] = 0u; misc[2] = 0u; misc[3] = 0u; }
        __syncthreads();
        bar = xcd_barrier_post((unsigned*)(P.ws + WS_CTL), misc);
    }
#ifndef MK_REPMASK
#define MK_REPMASK 0
#endif
#ifndef MK_PHASE_MASK
#define MK_PHASE_MASK 0x7ff
#endif
#define IN(k) (((MK_PHASE_MASK >> (k)) & 1) && lo <= (k) && (k) < hi)
#define SEAM(k) do { if (IN(k) && IN((k) + 1)) xcd_barrier(bar); } while (0)
    if (IN(0)) { phase_prologue(P, lds); }
    SEAM(0);
    if (IN(1)) {
        pg8::Gemm g{(const pg8::bf16_t*)(P.ws + WS_XB), (const pg8::bf16_t*)(P.ws + WS_WINT), NTOK, DIN, D};
        pg8::StaticOrder S; S.init(NTOK, DIN, (int)gridDim.x, (int)blockIdx.x);
        EpiProj E{P.out, (bf16_t*)(P.ws + WS_XR), (bf16_t*)(P.ws + WS_GATE), (bf16_t*)(P.ws + WS_QB), (bf16_t*)(P.ws + WS_KB), (bf16_t*)(P.ws + WS_VB16)};
        pg8::gemm_phase<EpiProj, pg8::StaticOrder, false>(lds, g, S, E, nullptr);
    }
    SEAM(1);
    if (IN(2)) { phase_lru(P, lds); }
    if (IN(3)) { phase_samp(P, lds); }
    if (IN(4)) { phase_attn01(P, lds); }
    SEAM(4);
    if (IN(5)) { phase_mix_b(P, lds); }
    SEAM(5);
    if (IN(6)) {
        sample_rows_gemm<0>(P, (const bf16_t*)(P.ws + WS_AR), (const bf16_t*)(P.ws + WS_WOT), lds);
        pg8::Gemm g{(const pg8::bf16_t*)(P.ws + WS_AR), (const pg8::bf16_t*)(P.ws + WS_WOT), NTOK_P, D, D};
        pg8::StaticOrder S; S.init(NTOK_P, D, (int)gridDim.x, (int)blockIdx.x);
        EpiOut E{(const bf16_t*)(P.ws + WS_XB), (bf16_t*)(P.ws + WS_PRE1)};
        pg8::gemm_phase<EpiOut, pg8::StaticOrder, false>(lds, g, S, E, nullptr);
    }
    SEAM(6);
    if (IN(7)) { phase_ln1(P); }
    SEAM(7);
    if (IN(8)) {
        sample_rows_gemm<1>(P, (const bf16_t*)(P.ws + WS_X1B), (const bf16_t*)(P.ws + WS_WQT), lds);
        pg8::Gemm g{(const pg8::bf16_t*)(P.ws + WS_X1B), (const pg8::bf16_t*)(P.ws + WS_WQT), NTOK_P, D, D};
        pg8::StaticOrder S; S.init(NTOK_P, D, (int)gridDim.x, (int)blockIdx.x);
        EpiBf16Plain E{(bf16_t*)(P.ws + WS_QP), D};
        pg8::gemm_phase<EpiBf16Plain, pg8::StaticOrder, false>(lds, g, S, E, nullptr);
    }
    SEAM(8);
    if (IN(9)) { phase_route(P, lds); }
    SEAM(9);
    if (IN(10)) { phase_experts(P, lds); }
#undef IN
#undef SEAM
}
}

extern "C" void kernel_launch(void* const* d_in, const int* in_sizes, int n_in, void* d_out, int out_size, void* d_ws, size_t ws_size, hipStream_t stream) {
    using namespace mk;
    static int grid = 0;
    if (grid == 0) {
        if (n_in != 23 || (size_t)out_size != O_END || ws_size < WS_END) { fprintf(stderr, "kernel_launch: unexpected shapes: n_in %d out %d ws %zu (need %zu)\n", n_in, out_size, ws_size, (size_t)WS_END); grid = -1; return; }
        int dev = 0, cus = 0, per_cu = 0;
        if (hipGetDevice(&dev) != hipSuccess || hipDeviceGetAttribute(&cus, hipDeviceAttributeMultiprocessorCount, dev) != hipSuccess) { grid = -1; return; }
        if (hipFuncSetAttribute((const void*)fwd, hipFuncAttributeMaxDynamicSharedMemorySize, LDS_BYTES) != hipSuccess) { fprintf(stderr, "kernel_launch: hipFuncSetAttribute failed\n"); grid = -1; return; }
        if (hipOccupancyMaxActiveBlocksPerMultiprocessor(&per_cu, (const void*)fwd, NTHREADS, LDS_BYTES) != hipSuccess || per_cu < 1) { fprintf(stderr, "kernel_launch: occupancy query says %d\n", per_cu); }
        (void)hipGetLastError();
        grid = cus;
    }
    if (grid < 0) return;
    (void)hipMemsetAsync((char*)d_ws + WS_CTL, 0, 65536, stream);
    Params p{};
    p.x_prompt = (const float*)d_in[0]; p.x_sample = (const float*)d_in[1]; p.cache_k = (const float*)d_in[2]; p.cache_v = (const float*)d_in[3];
    p.state_conv = (const float*)d_in[4]; p.state_h = (const float*)d_in[5]; p.w_in = (const float*)d_in[6]; p.conv_w = (const float*)d_in[7]; p.conv_b = (const float*)d_in[8];
    p.lru_w_a = (const float*)d_in[9]; p.lru_b_a = (const float*)d_in[10]; p.lru_w_x = (const float*)d_in[11]; p.lru_b_x = (const float*)d_in[12]; p.lru_lambda = (const float*)d_in[13];
    p.w_out = (const float*)d_in[14]; p.ln1_g = (const float*)d_in[15]; p.ln1_b = (const float*)d_in[16]; p.w_query = (const float*)d_in[17]; p.sub_keys = (const float*)d_in[18];
    p.peer_u = (const float*)d_in[19]; p.peer_v = (const float*)d_in[20]; p.ln2_g = (const float*)d_in[21]; p.ln2_b = (const float*)d_in[22];
    p.out = (float*)d_out; p.ws = (unsigned char*)d_ws;
#if MK_N_LAUNCHES == 1
    p.ph_lo = 0; p.ph_hi = NPHASE;
    hipLaunchKernelGGL(fwd, dim3(grid), dim3(NTHREADS), LDS_BYTES, stream, p);
#else
    for (int k = 0; k < NPHASE; ++k) { p.ph_lo = k; p.ph_hi = k + 1; hipLaunchKernelGGL(fwd, dim3(grid), dim3(NTHREADS), LDS_BYTES, stream, p);
#ifdef MK_EXTRA_PHASE
        if (k == MK_EXTRA_PHASE) hipLaunchKernelGGL(fwd, dim3(grid), dim3(NTHREADS), LDS_BYTES, stream, p);
#endif
    }
#endif
    const hipError_t le = hipPeekAtLastError();
    if (le != hipSuccess) fprintf(stderr, "kernel_launch: launch failed: %s\n", hipGetErrorName(le));
}
```

```cpp
#include <hip/hip_runtime.h>
#include <cstdio>
#include <cstdint>
namespace pg8 {
#define PG8_LAS __attribute__((address_space(3)))
typedef unsigned short bf16_t;
typedef short bf16x8 __attribute__((ext_vector_type(8)));
typedef float f32x4 __attribute__((ext_vector_type(4)));
typedef unsigned u32x4 __attribute__((ext_vector_type(4)));
constexpr int BM = 256, BK = 64, HALF = 128, HTB = HALF * BK * 2  , STAGE_BYTES = 8 * HTB, NXCD = 8, WGM = 8;

__host__ __device__ __forceinline__ int lds_byte(int r, int c) { const int st = (r >> 4) * 2 + (c >> 5), rr = r & 15, cc = c & 31, ob = rr * 64 + cc * 2; return st * 1024 + (ob ^ (((ob >> 9) & 1) << 5)); }
__host__ __device__ __forceinline__ void stage_rc(int b, int& R, int& C) { const int st = b / 1024, sb = b % 1024, swz = sb ^ (((sb >> 9) & 1) << 5); R = (st >> 1) * 16 + swz / 64; C = (st & 1) * 32 + (swz % 64) / 2; }
__host__ __device__ __forceinline__ int perm32(int rho) { const int n = rho >> 4, i = rho & 15; return 8 * (i >> 2) + 4 * n + (i & 3); }

struct Unit { int pm, pn; };
struct Gemm { const bf16_t* A; const bf16_t* Bt; int M, N, K; };

struct StaticOrder {
    int nM, nN, nwg, G, c;
    __host__ __device__ void init(int M, int N, int G_, int c_) { nM = M / BM; nN = N / BM; nwg = nM * nN; G = G_; c = c_; }
    __host__ __device__ bool next(int i, Unit& u) const {
        const long L = (long)i * G + c; if (L >= nwg) return false;
        int wgid = (int)L; { const int q = nwg / NXCD, r = nwg % NXCD, xcd = wgid % NXCD, off = wgid / NXCD; wgid = (xcd < r ? xcd * (q + 1) : r * (q + 1) + (xcd - r) * q) + off; }
        const int nig = WGM * nN, gid = wgid / nig, fm = gid * WGM, gsz = (nM - fm) < WGM ? (nM - fm) : WGM;
        u.pm = fm + ((wgid % nig) % gsz); u.pn = (wgid % nig) / gsz; return true;
    }
    __device__ __forceinline__ void a_ready(const Unit&) const {}
    __device__ __forceinline__ void done(const Unit&) const {}
};
struct CountedOrder : StaticOrder {
    const unsigned* ready; unsigned need; unsigned* tmo;
    __device__ __forceinline__ void a_ready(const Unit& u) const {
        if (threadIdx.x < 64) {
            const unsigned long long t0 = __builtin_amdgcn_s_memrealtime(); unsigned polls = 0;
            while ((unsigned)__builtin_amdgcn_readfirstlane(__hip_atomic_load(ready + 64 * u.pm, __ATOMIC_RELAXED, __HIP_MEMORY_SCOPE_AGENT)) < need) {
                if ((++polls & 255u) == 0u && __builtin_amdgcn_readfirstlane(__hip_atomic_load(tmo, __ATOMIC_RELAXED, __HIP_MEMORY_SCOPE_AGENT)) != 0u) break;
                if (__builtin_amdgcn_s_memrealtime() - t0 > 2000000ull) {
                    if (threadIdx.x == 0) { unsigned expect = 0u; __hip_atomic_compare_exchange_strong(tmo + 1, &expect, 0x600u | (unsigned)(u.pm & 0xff), __ATOMIC_RELAXED, __ATOMIC_RELAXED, __HIP_MEMORY_SCOPE_AGENT); __hip_atomic_store(tmo, 1u, __ATOMIC_RELAXED, __HIP_MEMORY_SCOPE_AGENT); }
                    break; }
                __builtin_amdgcn_s_sleep(2); }
            __builtin_amdgcn_fence(__ATOMIC_ACQUIRE, "agent");
            asm volatile("s_waitcnt vmcnt(0)" ::: "memory");
        }
#if !defined(BROKEN_HOOK_NO_BARRIER)
        asm volatile("" ::: "memory"); __builtin_amdgcn_s_barrier(); asm volatile("" ::: "memory");
#endif
    }
};

__device__ __forceinline__ unsigned cvt_pk_bf16(float lo, float hi) { unsigned r; asm volatile("v_cvt_pk_bf16_f32 %0, %1, %2" : "=v"(r) : "v"(lo), "v"(hi)); return r; }
typedef float f32x2 __attribute__((ext_vector_type(2)));
__device__ __forceinline__ f32x2 gelu_pk(f32x2 v) {
    const f32x2 av = __builtin_elementwise_abs(v), d = av * 0.2316418882f + 1.0f;
    f32x2 t; t.x = __builtin_amdgcn_rcpf(d.x); t.y = __builtin_amdgcn_rcpf(d.y);
    f32x2 q = t * 0.5307027145f + (-0.7265760135f); q = q * t + 0.7107068705f; q = q * t + (-0.142248368f); q = q * t + 0.127414796f; q = q * t;
    const f32x2 s = (v * v) * (-0.72134752044f);
    f32x2 e; e.x = __builtin_amdgcn_exp2f(s.x); e.y = __builtin_amdgcn_exp2f(s.y);
    const f32x2 m = v * (q * e), r = v - m;
    f32x2 o; o.x = v.x < 0.f ? m.x : r.x; o.y = v.y < 0.f ? m.y : r.y; return o;
}

struct EpiF32 {
    static constexpr bool PERM = false, AFTER_DRAIN = false;
    float* C; int ldc; const float* bias;
    __device__ __forceinline__ void operator()(const f32x4 (&acc)[2][2][4][2], const Unit& u, int wr, int wc, int fr, int fq) const {
        const int row0 = u.pm * BM + wr * 64 + fr, col0 = u.pn * BM + wc * 32 + 4 * fq;
        f32x4 bv[2][2];
#pragma unroll
        for (int bj = 0; bj < 2; ++bj)
#pragma unroll
            for (int n = 0; n < 2; ++n) bv[bj][n] = bias ? *(const f32x4*)(bias + col0 + bj * HALF + n * 16) : (f32x4){0.f, 0.f, 0.f, 0.f};
#pragma unroll
        for (int ai = 0; ai < 2; ++ai)
#pragma unroll
            for (int m = 0; m < 4; ++m) { float* rowp = C + (size_t)(row0 + ai * HALF + m * 16) * ldc + col0;
#pragma unroll
                for (int bj = 0; bj < 2; ++bj)
#pragma unroll
                    for (int n = 0; n < 2; ++n) *(f32x4*)(rowp + bj * HALF + n * 16) = acc[ai][bj][m][n] + bv[bj][n]; }
    }
};
template <int ACT  > struct EpiBf16 {
    static constexpr bool PERM = true, AFTER_DRAIN = false;
    bf16_t* O; int ldc; const float* bias; int split_cols; size_t split_stride;
    __device__ __forceinline__ void operator()(const f32x4 (&acc)[2][2][4][2], const Unit& u, int wr, int wc, int fr, int fq) const {
        const int row0 = u.pm * BM + wr * 64 + fr; int colt = u.pn * BM; bf16_t* base = O;
        if (split_cols) { const int t = colt / split_cols; base += (size_t)t * split_stride; colt -= t * split_cols; }
        const int col0 = colt + wc * 32 + 8 * fq, bcol0 = u.pn * BM + wc * 32 + 8 * fq;
        f32x4 bv[2][2];
#pragma unroll
        for (int bj = 0; bj < 2; ++bj)
#pragma unroll
            for (int n = 0; n < 2; ++n) bv[bj][n] = bias ? *(const f32x4*)(bias + bcol0 + bj * HALF + 4 * n) : (f32x4){0.f, 0.f, 0.f, 0.f};
#pragma unroll
        for (int ai = 0; ai < 2; ++ai)
#pragma unroll
            for (int m = 0; m < 4; ++m) { bf16_t* rowp = base + (size_t)(row0 + ai * HALF + m * 16) * ldc + col0;
#pragma unroll
                for (int bj = 0; bj < 2; ++bj) { f32x4 v0 = acc[ai][bj][m][0] + bv[bj][0], v1 = acc[ai][bj][m][1] + bv[bj][1];
                    if (ACT == 1) { f32x2 a = gelu_pk((f32x2){v0[0], v0[1]}), b = gelu_pk((f32x2){v0[2], v0[3]}), c = gelu_pk((f32x2){v1[0], v1[1]}), d = gelu_pk((f32x2){v1[2], v1[3]});
                        v0 = (f32x4){a.x, a.y, b.x, b.y}; v1 = (f32x4){c.x, c.y, d.x, d.y}; }
                    if (ACT == 2) {
#pragma unroll
                        for (int j = 0; j < 4; ++j) { v0[j] = 0.5f * v0[j] * (1.0f + erff(v0[j] * 0.70710678f)); v1[j] = 0.5f * v1[j] * (1.0f + erff(v1[j] * 0.70710678f)); } }
                    u32x4 w; w.x = cvt_pk_bf16(v0[0], v0[1]); w.y = cvt_pk_bf16(v0[2], v0[3]); w.z = cvt_pk_bf16(v1[0], v1[1]); w.w = cvt_pk_bf16(v1[2], v1[3]);
                    *(u32x4*)(rowp + bj * HALF) = w; } }
    }
};

struct PanelStats {
    unsigned* xbuf;
    unsigned* cnt;
    unsigned* tmo;
    int ntn; float eps;
    unsigned code;
    __device__ __forceinline__ bool run(const f32x4 (&v)[2][2][4][2], const Unit& u, int wr, int wc, int fr, int fq, PG8_LAS unsigned char* lds, int wid, int lane) const {
        typedef float f32x2v __attribute__((ext_vector_type(2)));
        PG8_LAS f32x2v* P = (PG8_LAS f32x2v*)lds;
        PG8_LAS f32x2v* S = (PG8_LAS f32x2v*)(lds + 8192);
        PG8_LAS unsigned* flag = (PG8_LAS unsigned*)(lds + 8192 + 2048);
#pragma unroll
        for (int ai = 0; ai < 2; ++ai)
#pragma unroll
            for (int m = 0; m < 4; ++m) {
                float s = 0.f;
#pragma unroll
                for (int bj = 0; bj < 2; ++bj)
#pragma unroll
                    for (int n = 0; n < 2; ++n) { const f32x4 x = v[ai][bj][m][n]; s += (x[0] + x[1]) + (x[2] + x[3]); }
                s += __shfl_xor(s, 16); s += __shfl_xor(s, 32);
                const float mw = s * (1.0f / 64.0f); float q = 0.f;
#pragma unroll
                for (int bj = 0; bj < 2; ++bj)
#pragma unroll
                    for (int n = 0; n < 2; ++n) { const f32x4 d = v[ai][bj][m][n] - mw; q += (d[0] * d[0] + d[1] * d[1]) + (d[2] * d[2] + d[3] * d[3]); }
                q += __shfl_xor(q, 16); q += __shfl_xor(q, 32);
                if (fq == 0) P[(ai * HALF + wr * 64 + m * 16 + fr) * 4 + wc] = (f32x2v){mw, q};
            }
        asm volatile("s_waitcnt lgkmcnt(0)" ::: "memory"); __builtin_amdgcn_s_barrier(); asm volatile("" ::: "memory");
#if defined(BROKEN_NO_WAIT)
        if (blockIdx.x >= 64) { const long long t0 = clock64(); while (clock64() - t0 < 60000) __builtin_amdgcn_s_sleep(8); }
#endif
        const int row = wid * 32 + (lane & 31);
        if (lane < 32) {
            const f32x2v a = P[row * 4 + 0], b = P[row * 4 + 1], c = P[row * 4 + 2], d = P[row * 4 + 3];
            const float mt = (a.x + b.x + c.x + d.x) * 0.25f;
            const float da = a.x - mt, db = b.x - mt, dc = c.x - mt, dd = d.x - mt;
            const float m2 = (a.y + b.y) + (c.y + d.y) + 64.0f * ((da * da + db * db) + (dc * dc + dd * dd));
            unsigned long long* slot = (unsigned long long*)xbuf + ((size_t)(u.pm * BM + row) * 4 + u.pn);
            __hip_atomic_store(slot, ((unsigned long long)__float_as_uint(m2) << 32) | __float_as_uint(mt), __ATOMIC_RELAXED, __HIP_MEMORY_SCOPE_AGENT);
        }
        asm volatile("s_waitcnt vmcnt(0)" ::: "memory");
        if (lane == 0) __hip_atomic_fetch_add(cnt + 64 * u.pm, 1u, __ATOMIC_RELAXED, __HIP_MEMORY_SCOPE_AGENT);
        if (wid == 0) {
            bool dead = false; const unsigned long long t0 = __builtin_amdgcn_s_memrealtime(); const unsigned want = 8u * (unsigned)ntn;
            for (;;) {
#if defined(BROKEN_NO_WAIT)
                break;
#endif
                if ((unsigned)__builtin_amdgcn_readfirstlane(__hip_atomic_load(cnt + 64 * u.pm, __ATOMIC_RELAXED, __HIP_MEMORY_SCOPE_AGENT)) >= want) break;
                if (__builtin_amdgcn_s_memrealtime() - t0 > 2000000ull) {
                    if (lane == 0) { unsigned expect = 0u; __hip_atomic_compare_exchange_strong(tmo + 1, &expect, code | (unsigned)(u.pm & 0xff), __ATOMIC_RELAXED, __ATOMIC_RELAXED, __HIP_MEMORY_SCOPE_AGENT);
                                     __hip_atomic_store(tmo, 1u, __ATOMIC_RELAXED, __HIP_MEMORY_SCOPE_AGENT); }
                    dead = true; break; }
                __builtin_amdgcn_s_sleep(2);
            }
            __builtin_amdgcn_fence(__ATOMIC_ACQUIRE, "agent");
            if (lane == 0) flag[0] = dead ? 1u : 0u;
        }
        asm volatile("s_waitcnt vmcnt(0) lgkmcnt(0)" ::: "memory"); __builtin_amdgcn_s_barrier(); asm volatile("" ::: "memory");
        const bool bad = flag[0] != 0u;
        if (lane < 32) {
            const unsigned long long* slot = (const unsigned long long*)xbuf + (size_t)(u.pm * BM + row) * 4; float mt[4], m2[4]; float ms = 0.f;
#pragma unroll
            for (int t = 0; t < 4; ++t) { if (t < ntn) { const unsigned long long w = __hip_atomic_load(slot + t, __ATOMIC_RELAXED, __HIP_MEMORY_SCOPE_AGENT); mt[t] = __uint_as_float((unsigned)w); m2[t] = __uint_as_float((unsigned)(w >> 32)); } else { mt[t] = 0.f; m2[t] = 0.f; } ms += mt[t]; }
            const float mean = ms / (float)ntn; float q = 0.f;
#pragma unroll
            for (int t = 0; t < 4; ++t) if (t < ntn) { const float dm = mt[t] - mean; q += m2[t] + 256.0f * dm * dm; }
            S[row] = (f32x2v){mean, 1.0f / sqrtf(q / (256.0f * (float)ntn) + eps)};
        }
        asm volatile("s_waitcnt lgkmcnt(0)" ::: "memory"); __builtin_amdgcn_s_barrier(); asm volatile("" ::: "memory");
        return bad;
    }
};
struct EpiLnRes {
    static constexpr bool PERM = false, AFTER_DRAIN = true;
    const float* base; float* out; int ldc; const float* bias; PanelStats st; unsigned poison;
    __device__ __forceinline__ void refuse(size_t i0, size_t stride, int M, int N) const { const float q = __builtin_nanf(""); for (size_t i = i0; i < (size_t)M * N; i += stride) out[(i / N) * ldc + i % N] = q;
        if (i0 == 0) { unsigned expect = 0u; __hip_atomic_compare_exchange_strong(st.tmo + 1, &expect, 0x7f0u, __ATOMIC_RELAXED, __ATOMIC_RELAXED, __HIP_MEMORY_SCOPE_AGENT); __hip_atomic_store(st.tmo, 1u, __ATOMIC_RELAXED, __HIP_MEMORY_SCOPE_AGENT); } }
    __device__ __forceinline__ void fused(f32x4 (&acc)[2][2][4][2], const Unit& u, int wr, int wc, int fr, int fq, PG8_LAS unsigned char* lds, int wid, int lane) const {
        typedef float f32x2v __attribute__((ext_vector_type(2)));
        const PG8_LAS f32x2v* S = (const PG8_LAS f32x2v*)(lds + 8192);
        const int col0 = u.pn * BM + wc * 32 + 4 * fq;
#pragma unroll
        for (int bj = 0; bj < 2; ++bj)
#pragma unroll
            for (int n = 0; n < 2; ++n) { const f32x4 bv = bias ? *(const f32x4*)(bias + col0 + bj * HALF + n * 16) : (f32x4){0.f, 0.f, 0.f, 0.f};
#pragma unroll
                for (int ai = 0; ai < 2; ++ai)
#pragma unroll
                    for (int m = 0; m < 4; ++m) acc[ai][bj][m][n] += bv; }
        const bool bad = st.run(acc, u, wr, wc, fr, fq, lds, wid, lane) || poison != 0u;
        const float qnan = __builtin_nanf("");
#pragma unroll
        for (int ai = 0; ai < 2; ++ai)
#pragma unroll
            for (int m = 0; m < 4; ++m) { const int r = ai * HALF + wr * 64 + m * 16 + fr; const f32x2v sr = S[r]; const size_t off = (size_t)(u.pm * BM + r) * ldc + col0;
#pragma unroll
                for (int bj = 0; bj < 2; ++bj)
#pragma unroll
                    for (int n = 0; n < 2; ++n) { const f32x4 bs = *(const f32x4*)(base + off + bj * HALF + n * 16); f32x4 o = bs + (acc[ai][bj][m][n] - sr.x) * sr.y;
                        if (bad) o = (f32x4){qnan, qnan, qnan, qnan}; *(f32x4*)(out + off + bj * HALF + n * 16) = o; }
                asm volatile("" ::: "memory"); }
    }
};
struct EpiLnResLn {
    static constexpr bool PERM = false, AFTER_DRAIN = true;
    const float* base; float* out; bf16_t* xn; int ldc; const float* bias; PanelStats st1, st2; unsigned poison;
    __device__ __forceinline__ void refuse(size_t i0, size_t stride, int M, int N) const { const float q = __builtin_nanf(""); for (size_t i = i0; i < (size_t)M * N; i += stride) { const size_t o = (i / N) * ldc + i % N; out[o] = q; xn[o] = (bf16_t)0x7fc0u; }
        if (i0 == 0) { unsigned expect = 0u; __hip_atomic_compare_exchange_strong(st1.tmo + 1, &expect, 0x7f0u, __ATOMIC_RELAXED, __ATOMIC_RELAXED, __HIP_MEMORY_SCOPE_AGENT); __hip_atomic_store(st1.tmo, 1u, __ATOMIC_RELAXED, __HIP_MEMORY_SCOPE_AGENT); } }
    __device__ __forceinline__ void fused(f32x4 (&acc)[2][2][4][2], const Unit& u, int wr, int wc, int fr, int fq, PG8_LAS unsigned char* lds, int wid, int lane) const {
        typedef float f32x2v __attribute__((ext_vector_type(2))); typedef unsigned u32x2v __attribute__((ext_vector_type(2)));
        const PG8_LAS f32x2v* S = (const PG8_LAS f32x2v*)(lds + 8192);
        const int col0 = u.pn * BM + wc * 32 + 4 * fq;
#pragma unroll
        for (int bj = 0; bj < 2; ++bj)
#pragma unroll
            for (int n = 0; n < 2; ++n) { const f32x4 bv = bias ? *(const f32x4*)(bias + col0 + bj * HALF + n * 16) : (f32x4){0.f, 0.f, 0.f, 0.f};
#pragma unroll
                for (int ai = 0; ai < 2; ++ai)
#pragma unroll
                    for (int m = 0; m < 4; ++m) acc[ai][bj][m][n] += bv; }
        bool bad = st1.run(acc, u, wr, wc, fr, fq, lds, wid, lane) || poison != 0u;
        const float qnan = __builtin_nanf("");
#pragma unroll
        for (int ai = 0; ai < 2; ++ai)
#pragma unroll
            for (int m = 0; m < 4; ++m) { const int r = ai * HALF + wr * 64 + m * 16 + fr; const f32x2v sr = S[r]; const size_t off = (size_t)(u.pm * BM + r) * ldc + col0;
#pragma unroll
                for (int bj = 0; bj < 2; ++bj)
#pragma unroll
                    for (int n = 0; n < 2; ++n) { const f32x4 bs = *(const f32x4*)(base + off + bj * HALF + n * 16); acc[ai][bj][m][n] = bs + (acc[ai][bj][m][n] - sr.x) * sr.y; }
                asm volatile("" : "+v"(acc[ai][0][m][0]), "+v"(acc[ai][0][m][1]), "+v"(acc[ai][1][m][0]), "+v"(acc[ai][1][m][1]));
                if (m & 1) asm volatile("" ::: "memory"); }
        const bool bad1 = bad;
        bad = st2.run(acc, u, wr, wc, fr, fq, lds, wid, lane) || bad;
#pragma unroll
        for (int ai = 0; ai < 2; ++ai)
#pragma unroll
            for (int m = 0; m < 4; ++m) { const int r = ai * HALF + wr * 64 + m * 16 + fr; const f32x2v sr = S[r]; const size_t off = (size_t)(u.pm * BM + r) * ldc + col0;
#pragma unroll
                for (int bj = 0; bj < 2; ++bj)
#pragma unroll
                    for (int n = 0; n < 2; ++n) { const f32x4 x1 = acc[ai][bj][m][n]; *(f32x4*)(out + off + bj * HALF + n * 16) = bad1 ? (f32x4){qnan, qnan, qnan, qnan} : x1;
                        const f32x4 o = (x1 - sr.x) * sr.y; u32x2v w; w.x = cvt_pk_bf16(o[0], o[1]); w.y = cvt_pk_bf16(o[2], o[3]);
                        if (bad) { w.x = 0x7fc07fc0u; w.y = 0x7fc07fc0u; } *(u32x2v*)(xn + off + bj * HALF + n * 16) = w; }
                asm volatile("" ::: "memory"); }
    }
};

template <class Epi, class Sched, bool STAMP = false>
__device__ __forceinline__ void gemm_phase(PG8_LAS unsigned char* lds, const Gemm g, const Sched& S, const Epi& E, unsigned long long* stamps) {
    const int tid = threadIdx.x, wid = __builtin_amdgcn_readfirstlane(tid >> 6), lane = tid & 63, wr = wid >> 2, wc = wid & 3, fr = lane & 15, fq = lane >> 4;
    const int K = g.K, nt = K / BK;
    int ts_lo = 0, ts_hi = 0, nts = 0; const unsigned long long rt_entry = STAMP ? (unsigned long long)wall_clock64() : 0ull;
#define PG8_STAMP() do { if (STAMP && wid == 0 && nts < 64) { const unsigned long long _c = (unsigned long long)clock64(); \
        ts_lo = (lane == nts) ? (int)(unsigned)_c : ts_lo; ts_hi = (lane == nts) ? (int)(unsigned)(_c >> 32) : ts_hi; ++nts; } } while (0)
    PG8_STAMP();
    unsigned voffA[2], voffB[2];
#pragma unroll
    for (int i = 0; i < 2; ++i) { int R, C; stage_rc(tid * 16 + i * 8192, R, C); const int Rb = Epi::PERM ? ((R & ~31) + perm32(R & 31)) : R;
        voffA[i] = (unsigned)(R * K + C) * 2u; voffB[i] = (unsigned)(Rb * K + C) * 2u; }
    const size_t kstep = (size_t)(BK * 2);
    const size_t hstep = (size_t)HALF * K * 2;
    const size_t tstep = 2 * hstep;
    const unsigned ldsw = (unsigned)wid * 1024u;
    const int aoff = lds_byte(wr * 64 + fr, fq * 8), boff = lds_byte(wc * 32 + fr, fq * 8);
#define PG8_SA(b, h) (((b) * 2 + (h)) * HTB)
#define PG8_SB(b, h) ((4 + (b) * 2 + (h)) * HTB)
#define PG8_STAGE(bufoff, gbase, voff) do { _Pragma("unroll") for (int _i = 0; _i < 2; ++_i) \
        __builtin_amdgcn_global_load_lds((const unsigned*)((const char*)(gbase) + (voff)[_i]), (PG8_LAS unsigned*)(lds + (bufoff) + ldsw + _i * 8192), 16, 0, 0); } while (0)
#define PG8_LDA(dst, b, h) do { _Pragma("unroll") for (int m = 0; m < 4; ++m) _Pragma("unroll") for (int k = 0; k < 2; ++k) dst[m][k] = *(const PG8_LAS bf16x8*)(lds + PG8_SA(b, h) + aoff + m * 2048 + k * 1024); } while (0)
#define PG8_LDB(dst, b, h) do { _Pragma("unroll") for (int n = 0; n < 2; ++n) _Pragma("unroll") for (int k = 0; k < 2; ++k) dst[n][k] = *(const PG8_LAS bf16x8*)(lds + PG8_SB(b, h) + boff + n * 2048 + k * 1024); } while (0)
#define PG8_MMA(ai, bj, At, Bt) do { __builtin_amdgcn_s_setprio(1); _Pragma("unroll") for (int m = 0; m < 4; ++m) _Pragma("unroll") for (int n = 0; n < 2; ++n) _Pragma("unroll") for (int k = 0; k < 2; ++k) \
        acc[ai][bj][m][n] = __builtin_amdgcn_mfma_f32_16x16x32_bf16(Bt[n][k], At[m][k], acc[ai][bj][m][n], 0, 0, 0); __builtin_amdgcn_s_setprio(0); } while (0)
#define PG8_WAIT_V(n) asm volatile("s_waitcnt vmcnt(" #n ")" ::: "memory")
#define PG8_WAIT_L(n) asm volatile("s_waitcnt lgkmcnt(" #n ")" ::: "memory")
#define PG8_BAR __builtin_amdgcn_s_barrier()
#define PG8_SCHED __builtin_amdgcn_sched_barrier(0)
    Unit cur, nxt; int ui = 0;
    if (!S.next(0, cur)) return;
    f32x4 acc[2][2][4][2];
#pragma unroll
    for (int a = 0; a < 2; ++a)
#pragma unroll
        for (int b = 0; b < 2; ++b)
#pragma unroll
            for (int m = 0; m < 4; ++m)
#pragma unroll
                for (int n = 0; n < 2; ++n) acc[a][b][m][n] = (f32x4){0.f, 0.f, 0.f, 0.f};
    bf16x8 At[4][2], B0[2][2], B1[2][2];
    const char* cA = (const char*)g.A + (size_t)cur.pm * tstep; const char* cB = (const char*)g.Bt + (size_t)cur.pn * tstep;
    S.a_ready(cur);
    PG8_STAGE(PG8_SB(0, 0), cB, voffB); PG8_STAGE(PG8_SA(0, 0), cA, voffA); PG8_STAGE(PG8_SB(0, 1), cB + hstep, voffB); PG8_STAGE(PG8_SA(0, 1), cA + hstep, voffA);
    if (wr == 1) PG8_BAR;
    PG8_WAIT_V(4); PG8_BAR;
    PG8_STAGE(PG8_SB(1, 0), cB + kstep, voffB); PG8_STAGE(PG8_SA(1, 0), cA + kstep, voffA); PG8_STAGE(PG8_SB(1, 1), cB + hstep + kstep, voffB);
    PG8_WAIT_V(6); PG8_BAR;
    PG8_STAMP();
    for (;;) {
        const bool has_next = S.next(ui + 1, nxt);
        const char* nA = has_next ? (const char*)g.A + (size_t)nxt.pm * tstep : cA; const char* nB = has_next ? (const char*)g.Bt + (size_t)nxt.pn * tstep : cB;
        for (int t = 0; t < nt; t += 2) {
            const bool last = (t == nt - 2);
            const char* a1 = cA + (size_t)(t + 1) * kstep;
            const char* a2 = last ? nA : cA + (size_t)(t + 2) * kstep; const char* b2 = last ? nB : cB + (size_t)(t + 2) * kstep;
            const char* a3 = a2 + kstep; const char* b3 = b2 + kstep;
            if (last && has_next) S.a_ready(nxt);
            PG8_LDB(B0, 0, 0); PG8_SCHED; PG8_LDA(At, 0, 0); PG8_STAGE(PG8_SA(1, 1), a1 + hstep, voffA);
            PG8_WAIT_L(8); PG8_BAR; PG8_WAIT_L(0); PG8_MMA(0, 0, At, B0); PG8_BAR; PG8_SCHED;
            PG8_LDB(B1, 0, 1); PG8_STAGE(PG8_SB(0, 0), b2, voffB);
            PG8_BAR; PG8_WAIT_L(0); PG8_MMA(0, 1, At, B1); PG8_BAR;
            PG8_LDA(At, 0, 1); PG8_STAGE(PG8_SA(0, 0), a2, voffA);
            PG8_BAR; PG8_WAIT_L(0); PG8_MMA(1, 0, At, B0); PG8_BAR; PG8_SCHED;
            PG8_STAGE(PG8_SB(0, 1), b2 + hstep, voffB);
            PG8_WAIT_V(6); PG8_BAR; PG8_MMA(1, 1, At, B1); PG8_BAR;
            PG8_LDB(B0, 1, 0); PG8_SCHED; PG8_LDA(At, 1, 0); PG8_STAGE(PG8_SA(0, 1), a2 + hstep, voffA);
            PG8_WAIT_L(8); PG8_BAR; PG8_WAIT_L(0); PG8_MMA(0, 0, At, B0); PG8_BAR; PG8_SCHED;
            PG8_LDB(B1, 1, 1); PG8_STAGE(PG8_SB(1, 0), b3, voffB);
            PG8_BAR; PG8_WAIT_L(0); PG8_MMA(0, 1, At, B1); PG8_BAR;
            PG8_LDA(At, 1, 1); PG8_STAGE(PG8_SA(1, 0), a3, voffA);
            PG8_BAR; PG8_WAIT_L(0); PG8_MMA(1, 0, At, B0); PG8_BAR; PG8_SCHED;
            PG8_STAGE(PG8_SB(1, 1), b3 + hstep, voffB);
            PG8_WAIT_V(6); PG8_BAR; PG8_MMA(1, 1, At, B1); PG8_BAR;
        }
        PG8_STAMP();
        if constexpr (!Epi::AFTER_DRAIN) { E(acc, cur, wr, wc, fr, fq); S.done(cur); }
        PG8_STAMP();
        if (!has_next) break;
#pragma unroll
        for (int a = 0; a < 2; ++a)
#pragma unroll
            for (int b = 0; b < 2; ++b)
#pragma unroll
                for (int m = 0; m < 4; ++m)
#pragma unroll
                    for (int n = 0; n < 2; ++n) acc[a][b][m][n] = (f32x4){0.f, 0.f, 0.f, 0.f};
        cur = nxt; cA = nA; cB = nB; ++ui;
    }
    PG8_WAIT_V(0);
    if (wr == 0) PG8_BAR;
    PG8_BAR;
    if constexpr (Epi::AFTER_DRAIN) { E.fused(acc, cur, wr, wc, fr, fq, lds, wid, lane); S.done(cur); }
    PG8_STAMP();
    if (STAMP && wid == 0) { stamps[lane] = lane < nts ? (((unsigned long long)(unsigned)ts_hi << 32) | (unsigned)ts_lo) : 0ull;
        if (lane == 62) stamps[62] = rt_entry; if (lane == 63) stamps[63] = (unsigned long long)wall_clock64(); }
#undef PG8_STAMP
#undef PG8_SA
#undef PG8_SB
#undef PG8_STAGE
#undef PG8_LDA
#undef PG8_LDB
#undef PG8_MMA
#undef PG8_WAIT_V
#undef PG8_WAIT_L
#undef PG8_BAR
#undef PG8_SCHED
}
}
#define XB_TMO      128
#define XB_XCNT(j)  (256  + 64 * (j))
#define XB_XSUB(j)  (1280 + 64 * (j))
#define XB_XGEN(j)  (2304 + 64 * (j))
#define XB_TOP      3328
#define XB_TOPGEN   3392
#define XCD_BAR_WORDS 3456
#define XB_SPIN_CAP (1u << 18)
#define LAS __attribute__((address_space(3)))

__device__ __forceinline__ unsigned xb_ld(unsigned* p)              { return __hip_atomic_load(p, __ATOMIC_RELAXED, __HIP_MEMORY_SCOPE_AGENT); }
__device__ __forceinline__ unsigned xb_add(unsigned* p, unsigned v) { return __hip_atomic_fetch_add(p, v, __ATOMIC_RELAXED, __HIP_MEMORY_SCOPE_AGENT); }
__device__ __forceinline__ unsigned xb_xcc_id() { return (unsigned)__builtin_amdgcn_s_getreg((3 << 11) | 20) & 0xFu; }
#define XB_SPIN(cond, bar) do { unsigned _sp = 0; while (cond) { __builtin_amdgcn_s_sleep(1); \
    if ((++_sp & 255u) == 0u) { if (xb_ld(&(bar)[XB_TMO])) break; if (_sp > XB_SPIN_CAP) { atomicAdd(&(bar)[XB_TMO], 1u); break; } } } } while (0)

struct XcdBarrier {
    unsigned* bar; unsigned x;
    volatile LAS unsigned* st;
};

__device__ __forceinline__ XcdBarrier xcd_barrier_post(unsigned* bar, volatile LAS unsigned* st) {
    XcdBarrier b; b.bar = bar; b.x = xb_xcc_id(); b.st = st;
    if (threadIdx.x == 0) (void)xb_add(&bar[XB_XCNT(b.x)], 1u);
    return b;
}
__device__ __forceinline__ void xcd_barrier_complete(unsigned* bar, unsigned x, unsigned& nloc, unsigned& nx) {
    const unsigned G = gridDim.x * gridDim.y * gridDim.z;
    unsigned sum, cnt, mine, sp = 0u;
    for (;;) {
        sum = 0u; cnt = 0u; mine = 0u;
#pragma unroll
        for (unsigned j = 0; j < 16; ++j) { const unsigned c = xb_ld(&bar[XB_XCNT(j)]); sum += c; cnt += (c > 0u) ? 1u : 0u; mine = (j == x) ? c : mine; }
        if (sum == G) break;
        __builtin_amdgcn_s_sleep(1);
        if ((++sp & 255u) == 0u) { if (xb_ld(&bar[XB_TMO])) break; if (sp > XB_SPIN_CAP) { atomicAdd(&bar[XB_TMO], 1u); break; } }
    }
    nloc = mine > 0u ? mine : 1u; nx = cnt > 0u ? cnt : 1u;
}

__device__ __forceinline__ void xcd_barrier(const XcdBarrier& b) {
    asm volatile("s_waitcnt vmcnt(0)" ::: "memory");
    __syncthreads();
    if (threadIdx.x == 0) {
        unsigned* bar = b.bar;
        __builtin_amdgcn_s_waitcnt(0);
        unsigned nloc = b.st[0], nx = b.st[1];
        if (nloc == 0u) { xcd_barrier_complete(bar, b.x, nloc, nx); b.st[0] = nloc; b.st[1] = nx; }
        const unsigned old = xb_add(&bar[XB_XSUB(b.x)], 1u);
        const unsigned gen = old / nloc;
        if (old + 1u == (gen + 1u) * nloc) {
            __builtin_amdgcn_fence(__ATOMIC_RELEASE, "agent");
            asm volatile("s_waitcnt vmcnt(0)" ::: "memory");
            const unsigned og = xb_add(&bar[XB_TOP], 1u);
            const unsigned tg = og / nx;
            if (og + 1u == (tg + 1u) * nx) xb_add(&bar[XB_TOPGEN], 1u);
            else XB_SPIN(xb_ld(&bar[XB_TOPGEN]) == tg, bar);
            __builtin_amdgcn_fence(__ATOMIC_ACQUIRE, "agent");
            xb_add(&bar[XB_XGEN(b.x)], 1u);
            asm volatile("s_waitcnt vmcnt(0)" ::: "memory");
        } else {
            XB_SPIN(xb_ld(&bar[XB_XGEN(b.x)]) == gen, bar);
            __builtin_amdgcn_fence(__ATOMIC_ACQUIRE, "agent");
            asm volatile("s_waitcnt vmcnt(0)" ::: "memory");
        }
    }
    __syncthreads();
}


#ifndef MK_N_LAUNCHES
#define MK_N_LAUNCHES 1
#endif
namespace mk {
typedef unsigned short bf16_t;
typedef float f32x4 __attribute__((ext_vector_type(4)));
typedef short bf16x8 __attribute__((ext_vector_type(8)));
typedef short s16x4 __attribute__((ext_vector_type(4)));
typedef unsigned u32x4 __attribute__((ext_vector_type(4)));
typedef unsigned u32x2 __attribute__((ext_vector_type(2)));
typedef float f32x2 __attribute__((ext_vector_type(2)));
constexpr int D = 2048, NTOK_P = 16384, NTOK_S = 256, NTOK = 16640;
constexpr int DIN = 5632, DATT = 1536, DLRU = 512, NH = 12, HD = 128;
constexpr int NEXP = 16384;
constexpr float ALPHA = 1.189207115002721f;
constexpr float LN_EPS = 1e-5f;
constexpr float ATT_SCALE = 0.08838834764831845f;
constexpr float LOG2E = 1.4426950408889634f;
constexpr size_t O_YP = 0, O_YS = 33554432, O_KP = 34078720, O_VP = 59244544, O_CP = 84410368, O_HP = 84422656,
                 O_KS = 84426752, O_VS = 185090048, O_CS = 285753344, O_HS = 285802496, O_END = 285818880;
constexpr size_t WS_CTL = 0;
constexpr size_t WS_XB = 65536;
constexpr size_t WS_WINT = WS_XB + (size_t)NTOK * D * 2;
constexpr size_t WS_WOT = WS_WINT + (size_t)DIN * D * 2;
constexpr size_t WS_WQT = WS_WOT + (size_t)D * D * 2;
constexpr size_t WS_UB = WS_WQT + (size_t)D * D * 2;
constexpr size_t WS_VB = WS_UB + (size_t)NEXP * D * 2;
constexpr size_t WS_QF = WS_VB + (size_t)NEXP * D * 2;
constexpr size_t WS_XR = WS_QF + (size_t)NTOK * DATT * 4;
constexpr size_t WS_GATE = WS_XR + (size_t)NTOK * DLRU * 4;
constexpr size_t WS_AR = WS_GATE + (size_t)NTOK * DLRU * 4;
constexpr size_t WS_PRE1 = WS_AR + (size_t)NTOK * D * 2;
constexpr size_t WS_X1F = WS_PRE1 + (size_t)NTOK * D * 4;
constexpr size_t WS_X1B = WS_X1F + (size_t)NTOK * D * 4;
constexpr size_t WS_QP = WS_X1B + (size_t)NTOK * D * 2;
constexpr size_t WS_EIDX = WS_QP + (size_t)NTOK * D * 4;
constexpr size_t WS_GW = WS_EIDX + (size_t)NTOK * 128 * 4;
constexpr size_t WS_SU = WS_GW + (size_t)NTOK * 128 * 4;
constexpr size_t WS_SV = WS_SU + (size_t)NEXP * 4;
constexpr size_t WS_SX = WS_SV + (size_t)NEXP * 4;
constexpr size_t WS_X1Q = WS_SX + (size_t)NTOK * 4;
constexpr size_t WS_SKB = WS_X1Q + (size_t)NTOK * D;
constexpr size_t WS_QB = WS_SKB + (size_t)8 * 2 * 128 * 128 * 2;
constexpr size_t WS_KB = WS_QB + (size_t)NTOK * DATT * 2;
constexpr size_t WS_VB16 = WS_KB + (size_t)NTOK_P * DATT * 2;
constexpr size_t WS_PO = WS_VB16 + (size_t)NTOK_P * DATT * 2;
constexpr size_t WS_PM = WS_PO + (size_t)2 * NTOK_P * DATT * 2;
constexpr size_t WS_PL = WS_PM + (size_t)2 * NTOK_P * NH * 4;
constexpr size_t WS_R0 = WS_PL + (size_t)2 * NTOK_P * NH * 4;
constexpr size_t WS_R1 = WS_R0 + (size_t)NTOK_P * DLRU * 4;
constexpr size_t WS_HE = WS_R1 + (size_t)NTOK_P * DLRU * 4;
constexpr size_t WS_AE = WS_HE + (size_t)8 * 32 * 512 * 4;
constexpr size_t WS_LW = WS_AE + (size_t)8 * 32 * 512 * 4;
constexpr size_t WS_PS = WS_LW + (size_t)2 * 8 * 64 * 64 * 2;
constexpr size_t WS_END = WS_PS + (size_t)32 * 12 * 9 * 8 * 130 * 4;

constexpr int NTHREADS = 512;
constexpr int LDS_BYTES = 148480;
constexpr int MISC_OFF = 147456;

struct Params {
    const float* x_prompt; const float* x_sample; const float* cache_k; const float* cache_v; const float* state_conv; const float* state_h;
    const float* w_in; const float* conv_w; const float* conv_b; const float* lru_w_a; const float* lru_b_a; const float* lru_w_x; const float* lru_b_x;
    const float* lru_lambda; const float* w_out; const float* ln1_g; const float* ln1_b; const float* w_query; const float* sub_keys;
    const float* peer_u; const float* peer_v; const float* ln2_g; const float* ln2_b;
    float* out; unsigned char* ws; int ph_lo, ph_hi;
};

__device__ __forceinline__ unsigned f2bf(float f) { unsigned u = __float_as_uint(f); u += 0x7fffu + ((u >> 16) & 1u); return u >> 16; }
__device__ __forceinline__ unsigned pack2(float a, float b) { return f2bf(a) | (f2bf(b) << 16); }
__device__ __forceinline__ float bflo(unsigned w) { return __uint_as_float(w << 16); }
__device__ __forceinline__ float bfhi(unsigned w) { return __uint_as_float(w & 0xffff0000u); }
__device__ __forceinline__ float wave_sum(float v) {
#pragma unroll
    for (int o = 32; o >= 1; o >>= 1) v += __shfl_xor(v, o);
    return v;
}
__device__ __forceinline__ float wave_max(float v) {
#pragma unroll
    for (int o = 32; o >= 1; o >>= 1) v = fmaxf(v, __shfl_xor(v, o));
    return v;
}
__device__ __forceinline__ float gelu_exact(float v) { return 0.5f * v * (1.0f + erff(v * 0.7071067811865476f)); }
__device__ __forceinline__ float gelu_as(float v) {
    const float av = fabsf(v), t = __builtin_amdgcn_rcpf(av * 0.2316418882f + 1.0f);
    float q = t * 0.5307027145f + (-0.7265760135f); q = q * t + 0.7107068705f; q = q * t + (-0.142248368f); q = q * t + 0.127414796f; q = q * t;
    const float e = __builtin_amdgcn_exp2f((v * v) * (-0.72134752044f));
    const float m = v * (q * e);
    return v < 0.f ? m : v - m;
}
__device__ __forceinline__ float sigmoidf(float v) { return 1.0f / (1.0f + expf(-v)); }
__device__ __forceinline__ float readlane_f(float v, int l) { return __int_as_float(__builtin_amdgcn_readlane(__float_as_int(v), l)); }

__device__ __forceinline__ void convert_flat(const float* src, bf16_t* dst, size_t n8, size_t gtid, size_t gstride) {
    for (size_t i = gtid; i < n8; i += gstride) {
        const float4 a = ((const float4*)src)[2 * i], b = ((const float4*)src)[2 * i + 1];
        uint4 w; w.x = pack2(a.x, a.y); w.y = pack2(a.z, a.w); w.z = pack2(b.x, b.y); w.w = pack2(b.z, b.w);
        ((uint4*)dst)[i] = w;
    }
}
__device__ __forceinline__ void transpose_convert(const float* src, bf16_t* dst, int K, int N, LAS float* tile) {
    const int tid = threadIdx.x, ntn = N / 64, ntiles = (K / 64) * ntn;
    for (int tl = blockIdx.x; tl < ntiles; tl += gridDim.x) {
        const int kt = tl / ntn, nt = tl - kt * ntn;
#pragma unroll
        for (int i = 0; i < 8; ++i) { const int r = (tid >> 6) + 8 * i, c = tid & 63; tile[r * 65 + c] = src[(size_t)(kt * 64 + r) * N + nt * 64 + c]; }
        __syncthreads();
#pragma unroll
        for (int i = 0; i < 4; ++i) { const int n = (tid >> 5) + 16 * i, k0 = 2 * (tid & 31);
            const unsigned v = pack2(tile[k0 * 65 + n], tile[(k0 + 1) * 65 + n]);
            *(unsigned*)(dst + (size_t)(nt * 64 + n) * K + kt * 64 + k0) = v; }
        __syncthreads();
    }
}
constexpr int TROW = 1152;
__device__ __forceinline__ void quant_row_load(const Params& P, int it, int lane, float4 (&v)[8]) {
    const bool isv = it >= NEXP; const int row = isv ? it - NEXP : it;
    const float* src = (isv ? P.peer_v : P.peer_u) + (size_t)row * D;
#pragma unroll
    for (int j = 0; j < 2; ++j)
#pragma unroll
        for (int i = 0; i < 4; ++i) v[j * 4 + i] = *(const float4*)(src + j * 1024 + lane * 16 + i * 4);
}
__device__ __forceinline__ void quant_row_store(const Params& P, int it, int lane, const float4 (&v)[8]) {
    const bool isv = it >= NEXP; const int row = isv ? it - NEXP : it;
    float cm[2];
#pragma unroll
    for (int j = 0; j < 2; ++j) { float am = 0.f;
#pragma unroll
        for (int i = 0; i < 4; ++i) { const float4 t = v[j * 4 + i]; am = fmaxf(am, fmaxf(fmaxf(fabsf(t.x), fabsf(t.y)), fmaxf(fabsf(t.z), fabsf(t.w)))); }
        cm[j] = am; }
    float rm = wave_max(fmaxf(cm[0], cm[1])); if (rm == 0.f) rm = 1.f;
    unsigned char* dst = P.ws + (isv ? WS_VB : WS_UB) + (size_t)row * TROW;
    u32x4 w; unsigned sqp = 0u;
#pragma unroll
    for (int j = 0; j < 2; ++j) {
        int sq = (int)ceilf(cm[j] / rm * 255.0f); sq = sq < 1 ? 1 : (sq > 255 ? 255 : sq);
        sqp |= (unsigned)sq << (8 * j);
        const float inv = (255.0f * 7.0f) / (rm * (float)sq);
#pragma unroll
        for (int hh = 0; hh < 2; ++hh) { unsigned dw = 0u;
#pragma unroll
            for (int e = 0; e < 8; ++e) { const float4 t = v[j * 4 + hh * 2 + (e >> 2)]; const float x = (e & 3) == 0 ? t.x : ((e & 3) == 1 ? t.y : ((e & 3) == 2 ? t.z : t.w));
                int n = (int)rintf(x * inv); n = n < -7 ? -7 : (n > 7 ? 7 : n); dw |= (unsigned)(isv ? n + 8 : (n & 15)) << (4 * e); }
            w[j * 2 + hh] = dw; }
    }
    *(u32x4*)(dst + lane * 16) = w;
    *(unsigned short*)(dst + 1024 + lane * 2) = (unsigned short)sqp;
    if (lane == 0) ((float*)(P.ws + (isv ? WS_SV : WS_SU)))[row] = rm * (1.0f / (255.0f * 7.0f));
}
__device__ __forceinline__ void quant_tables(const Params& P, int gw, int nw) {
    const int lane = threadIdx.x & 63;
    float4 va[8], vb[8];
    int it = gw;
    if (it < 2 * NEXP) quant_row_load(P, it, lane, va);
#pragma unroll 1
    for (; it < 2 * NEXP; it += 2 * nw) {
        if (it + nw < 2 * NEXP) quant_row_load(P, it + nw, lane, vb);
        quant_row_store(P, it, lane, va);
        if (it + nw < 2 * NEXP) {
            if (it + 2 * nw < 2 * NEXP) quant_row_load(P, it + 2 * nw, lane, va);
            quant_row_store(P, it + nw, lane, vb);
        }
    }
}
__device__ __forceinline__ void phase_prologue(const Params& P, LAS unsigned char* lds) {
    const size_t gtid = (size_t)blockIdx.x * NTHREADS + threadIdx.x, gstride = (size_t)gridDim.x * NTHREADS;
    unsigned char* ws = P.ws;
    convert_flat(P.x_prompt, (bf16_t*)(ws + WS_XB), (size_t)NTOK_P * D / 8, gtid, gstride);
    convert_flat(P.x_sample, (bf16_t*)(ws + WS_XB) + (size_t)NTOK_P * D, (size_t)NTOK_S * D / 8, gtid, gstride);
    convert_flat(P.sub_keys, (bf16_t*)(ws + WS_SKB), (size_t)8 * 2 * 128 * 128 / 8, gtid, gstride);
    for (size_t i = gtid; i < (size_t)2 * 8 * 64 * 64; i += gstride) {
        const int c = (int)(i & 63), d = (int)((i >> 6) & 63), n = (int)((i >> 12) & 7), m = (int)(i >> 15);
        ((bf16_t*)(ws + WS_LW))[i] = (bf16_t)f2bf((m ? P.lru_w_x : P.lru_w_a)[(n * 64 + c) * 64 + d]); }
    transpose_convert(P.w_in, (bf16_t*)(ws + WS_WINT), D, DIN, (LAS float*)lds);
    transpose_convert(P.w_out, (bf16_t*)(ws + WS_WOT), D, D, (LAS float*)lds);
    transpose_convert(P.w_query, (bf16_t*)(ws + WS_WQT), D, D, (LAS float*)lds);
}

struct EpiProj {
    static constexpr bool PERM = true, AFTER_DRAIN = false;
    float* out; bf16_t* XR; bf16_t* GATE; bf16_t* QB; bf16_t* KB; bf16_t* VB16;
    __device__ __forceinline__ void operator()(const f32x4 (&acc)[2][2][4][2], const pg8::Unit& u, int wr, int wc, int fr, int fq) const {
        const int pn = u.pn; const int coff = wc * 32 + 8 * fq;
#pragma unroll
        for (int ai = 0; ai < 2; ++ai)
#pragma unroll
            for (int m = 0; m < 4; ++m) {
                const int row = u.pm * 256 + ai * 128 + wr * 64 + m * 16 + fr;
                const bool prompt = row < NTOK_P;
                float* rowp = nullptr; bf16_t* rowb = nullptr; float bsc = 1.0f;
                if (pn < 6) { rowb = QB + (size_t)row * DATT + pn * 256; bsc = ATT_SCALE * LOG2E; }
                else if (pn < 18) {
                    const int isv = pn >= 12; const int c0 = (pn - (isv ? 12 : 6)) * 256;
                    if (prompt) { rowp = out + (isv ? O_VP : O_KP) + (size_t)row * DATT + c0; rowb = (isv ? VB16 : KB) + (size_t)row * DATT + c0; }
                    else { const int rr = row - NTOK_P, b = rr >> 3, t = rr & 7; rowp = out + (isv ? O_VS : O_KS) + ((size_t)b * 2048 + 2040 + t) * DATT + c0; }
                } else if (pn < 20) rowb = XR + (size_t)row * DLRU + (pn - 18) * 256;
                else rowb = GATE + (size_t)row * DLRU + (pn - 20) * 256;
#pragma unroll
                for (int bj = 0; bj < 2; ++bj) {
                    const f32x4 v0 = acc[ai][bj][m][0], v1 = acc[ai][bj][m][1];
                    if (rowp) { *(f32x4*)(rowp + coff + bj * 128) = v0; *(f32x4*)(rowp + coff + bj * 128 + 4) = v1; }
                    if (rowb) { u32x4 w; w.x = pg8::cvt_pk_bf16(v0[0] * bsc, v0[1] * bsc); w.y = pg8::cvt_pk_bf16(v0[2] * bsc, v0[3] * bsc); w.z = pg8::cvt_pk_bf16(v1[0] * bsc, v1[1] * bsc); w.w = pg8::cvt_pk_bf16(v1[2] * bsc, v1[3] * bsc);
                        *(u32x4*)(rowb + coff + bj * 128) = w; }
                }
            }
    }
};
struct EpiOut {
    static constexpr bool PERM = true, AFTER_DRAIN = false;
    const bf16_t* xb; bf16_t* pre;
    __device__ __forceinline__ void operator()(const f32x4 (&acc)[2][2][4][2], const pg8::Unit& u, int wr, int wc, int fr, int fq) const {
        const int col0 = u.pn * 256 + wc * 32 + 8 * fq;
#pragma unroll
        for (int ai = 0; ai < 2; ++ai)
#pragma unroll
            for (int m = 0; m < 4; ++m) {
                const int row = u.pm * 256 + ai * 128 + wr * 64 + m * 16 + fr;
                const bf16_t* xr = xb + (size_t)row * D + col0; bf16_t* pr = pre + (size_t)row * D + col0;
#pragma unroll
                for (int bj = 0; bj < 2; ++bj) {
                    const u32x4 xv = *(const u32x4*)(xr + bj * 128); const f32x4 v0 = acc[ai][bj][m][0], v1 = acc[ai][bj][m][1];
                    u32x4 w;
                    w.x = pg8::cvt_pk_bf16(ALPHA * bflo(xv.x) + v0[0], ALPHA * bfhi(xv.x) + v0[1]); w.y = pg8::cvt_pk_bf16(ALPHA * bflo(xv.y) + v0[2], ALPHA * bfhi(xv.y) + v0[3]);
                    w.z = pg8::cvt_pk_bf16(ALPHA * bflo(xv.z) + v1[0], ALPHA * bfhi(xv.z) + v1[1]); w.w = pg8::cvt_pk_bf16(ALPHA * bflo(xv.w) + v1[2], ALPHA * bfhi(xv.w) + v1[3]);
                    *(u32x4*)(pr + bj * 128) = w;
                }
            }
    }
};
struct EpiPlain {
    static constexpr bool PERM = false, AFTER_DRAIN = false;
    float* C; int ldc;
    __device__ __forceinline__ void operator()(const f32x4 (&acc)[2][2][4][2], const pg8::Unit& u, int wr, int wc, int fr, int fq) const {
        const int col0 = u.pn * 256 + wc * 32 + 4 * fq;
#pragma unroll
        for (int ai = 0; ai < 2; ++ai)
#pragma unroll
            for (int m = 0; m < 4; ++m) {
                const int row = u.pm * 256 + ai * 128 + wr * 64 + m * 16 + fr;
                float* pr = C + (size_t)row * ldc + col0;
#pragma unroll
                for (int bj = 0; bj < 2; ++bj)
#pragma unroll
                    for (int n = 0; n < 2; ++n) *(f32x4*)(pr + bj * 128 + n * 16) = acc[ai][bj][m][n];
            }
    }
};

struct EpiBf16Plain {
    static constexpr bool PERM = true, AFTER_DRAIN = false;
    bf16_t* C; int ldc;
    __device__ __forceinline__ void operator()(const f32x4 (&acc)[2][2][4][2], const pg8::Unit& u, int wr, int wc, int fr, int fq) const {
        const int col0 = u.pn * 256 + wc * 32 + 8 * fq;
#pragma unroll
        for (int ai = 0; ai < 2; ++ai)
#pragma unroll
            for (int m = 0; m < 4; ++m) {
                const int row = u.pm * 256 + ai * 128 + wr * 64 + m * 16 + fr;
                bf16_t* pr = C + (size_t)row * ldc + col0;
#pragma unroll
                for (int bj = 0; bj < 2; ++bj) { const f32x4 v0 = acc[ai][bj][m][0], v1 = acc[ai][bj][m][1]; u32x4 w;
                    w.x = pg8::cvt_pk_bf16(v0[0], v0[1]); w.y = pg8::cvt_pk_bf16(v0[2], v0[3]); w.z = pg8::cvt_pk_bf16(v1[0], v1[1]); w.w = pg8::cvt_pk_bf16(v1[2], v1[3]);
                    *(u32x4*)(pr + bj * 128) = w; }
            }
    }
};

template <int MODE>
__device__ __forceinline__ void sample_rows_gemm(const Params& P, const bf16_t* A, const bf16_t* Wt, LAS unsigned char* lds) {
    const int tid = threadIdx.x, lane = tid & 63, w = __builtin_amdgcn_readfirstlane(tid >> 6);
    const int c = lane & 15, g = lane >> 4;
    for (int tile = blockIdx.x; tile < 256; tile += gridDim.x) {
        const int tg = tile & 7, cg = tile >> 3;
        const int k0 = 256 * w;
        const bf16_t* wp = Wt + (size_t)(64 * cg + c) * D + k0 + 8 * g;
        const bf16_t* xp = A + (size_t)(NTOK_P + 32 * tg + c) * D + k0 + 8 * g;
        f32x4 acc[4][2];
#pragma unroll
        for (int ct = 0; ct < 4; ++ct) { acc[ct][0] = (f32x4){0.f, 0.f, 0.f, 0.f}; acc[ct][1] = (f32x4){0.f, 0.f, 0.f, 0.f}; }
#pragma unroll 4
        for (int ks = 0; ks < 8; ++ks) {
            bf16x8 wf[4], xf[2];
#pragma unroll
            for (int ct = 0; ct < 4; ++ct) wf[ct] = *(const bf16x8*)(wp + (size_t)(16 * ct) * D + 32 * ks);
#pragma unroll
            for (int tt = 0; tt < 2; ++tt) xf[tt] = *(const bf16x8*)(xp + (size_t)(16 * tt) * D + 32 * ks);
#pragma unroll
            for (int ct = 0; ct < 4; ++ct)
#pragma unroll
                for (int tt = 0; tt < 2; ++tt) acc[ct][tt] = __builtin_amdgcn_mfma_f32_16x16x32_bf16(wf[ct], xf[tt], acc[ct][tt], 0, 0, 0);
        }
        LAS float* part = (LAS float*)lds;
#pragma unroll
        for (int ct = 0; ct < 4; ++ct)
#pragma unroll
            for (int tt = 0; tt < 2; ++tt) *(LAS f32x4*)(part + ((w * 32 + 16 * tt + c) * 64 + 16 * ct + 4 * g)) = acc[ct][tt];
        __syncthreads();
        {
            const int tok = tid >> 4, c4 = (tid & 15) * 4;
            f32x4 sum = {0.f, 0.f, 0.f, 0.f};
#pragma unroll
            for (int ww = 0; ww < 8; ++ww) sum += *(const LAS f32x4*)(part + ((ww * 32 + tok) * 64 + c4));
            const int row = NTOK_P + 32 * tg + tok, col = 64 * cg + c4;
            if (MODE == 0) { const f32x4 xv = *(const f32x4*)(P.x_sample + (size_t)(row - NTOK_P) * D + col); const f32x4 r = xv * ALPHA + sum; u32x2 wv; wv.x = pg8::cvt_pk_bf16(r[0], r[1]); wv.y = pg8::cvt_pk_bf16(r[2], r[3]); *(u32x2*)((bf16_t*)(P.ws + WS_PRE1) + (size_t)row * D + col) = wv; }
            else { u32x2 wv; wv.x = pg8::cvt_pk_bf16(sum[0], sum[1]); wv.y = pg8::cvt_pk_bf16(sum[2], sum[3]); *(u32x2*)((bf16_t*)(P.ws + WS_QP) + (size_t)row * D + col) = wv; }
        }
        __syncthreads();
    }
}

constexpr int KVS = 288, VOFF = 73728;
struct AttnKV { u32x4 k[8], v[8]; };
struct AttnId { int p, b, h, r, c; };
__device__ __forceinline__ void attn_fetch(const Params& P, const AttnId& u, AttnKV& R) {
    const int tid = threadIdx.x; const int dil = 1 << (2 * u.p);
    const bf16_t* Kb = (const bf16_t*)(P.ws + WS_KB); const bf16_t* Vb = (const bf16_t*)(P.ws + WS_VB16);
    const size_t tok0 = (size_t)u.b * 2048; const int j0 = 128 * u.c - 128, rho0 = (u.c == 0) ? 128 : 0;
#pragma unroll
    for (int it = 0; it < 8; ++it) {
        const int rho = it * 32 + (tid >> 4), ch = tid & 15;
        if (rho >= rho0) {
            const size_t tok = tok0 + (size_t)((j0 + rho) * dil + u.r);
            R.k[it] = *(const u32x4*)(Kb + tok * DATT + u.h * HD + ch * 8);
            R.v[it] = *(const u32x4*)(Vb + tok * DATT + u.h * HD + ch * 8);
        }
    }
}
__device__ __forceinline__ void attn_commit(const AttnId& u, const AttnKV& R, LAS unsigned char* lds) {
    const int tid = threadIdx.x; const int rho0 = (u.c == 0) ? 128 : 0;
#pragma unroll
    for (int it = 0; it < 8; ++it) {
        const int rho = it * 32 + (tid >> 4), ch = tid & 15;
        if (rho >= rho0) { *(LAS u32x4*)(lds + rho * KVS + ch * 16) = R.k[it]; *(LAS u32x4*)(lds + VOFF + rho * KVS + ch * 16) = R.v[it]; }
    }
}
template <int MODE>
__device__ __forceinline__ void attn_unit(const Params& P, const AttnId& uid, AttnKV& R, bool has_next, const AttnId& nid, LAS unsigned char* lds) {
    const int tid = threadIdx.x, lane = tid & 63, w = __builtin_amdgcn_readfirstlane(tid >> 6);
    const int p = uid.p, b = uid.b, h = uid.h, r = uid.r, c = uid.c;
    const int dil = 1 << (2 * p);
    const bf16_t* Qb = (const bf16_t*)(P.ws + WS_QB);
    const size_t tok0 = (size_t)b * 2048;
    attn_commit(uid, R, lds);
    const int cq = lane & 15, g = lane >> 4;
    const int iq = 128 * c + 16 * w + cq;
    const size_t qtok = tok0 + (size_t)(iq * dil + r);
    bf16x8 qf[4];
#pragma unroll
    for (int ks = 0; ks < 4; ++ks) qf[ks] = *(const bf16x8*)(Qb + qtok * DATT + h * HD + 32 * ks + 8 * g);
    __syncthreads();
    if (has_next) attn_fetch(P, nid, R);
    const int ktmin = (8 - w - 8 * c) > 0 ? (8 - w - 8 * c) : 0;
    const float slope2 = exp2f(-8.0f * (float)(h + 1) / 12.0f) * LOG2E * (float)dil;
    f32x4 s[9]; float m = -INFINITY;
#pragma unroll
    for (int kt = 0; kt < 9; ++kt) {
        if (kt >= ktmin) {
            f32x4 acc = {0.f, 0.f, 0.f, 0.f};
#pragma unroll
            for (int ks = 0; ks < 4; ++ks) { const bf16x8 kf = *(const LAS bf16x8*)(lds + (16 * w + 16 * kt + cq) * KVS + (32 * ks + 8 * g) * 2); acc = __builtin_amdgcn_mfma_f32_16x16x32_bf16(kf, qf[ks], acc, 0, 0, 0); }
#pragma unroll
            for (int ii = 0; ii < 4; ++ii) { const int dist = cq + 128 - 16 * kt - 4 * g - ii; float v = acc[ii] - slope2 * (float)dist;
                if (kt == 0 && dist > 128) v = -INFINITY; if (kt == 8 && dist < 0) v = -INFINITY; acc[ii] = v; m = fmaxf(m, v); }
            s[kt] = acc;
        } else s[kt] = (f32x4){-INFINITY, -INFINITY, -INFINITY, -INFINITY};
    }
    m = fmaxf(m, __shfl_xor(m, 16)); m = fmaxf(m, __shfl_xor(m, 32));
    float l = 0.f;
#pragma unroll
    for (int kt = 0; kt < 9; ++kt)
#pragma unroll
        for (int ii = 0; ii < 4; ++ii) { const float pp = exp2f(s[kt][ii] - m); s[kt][ii] = pp; l += pp; }
    l += __shfl_xor(l, 16); l += __shfl_xor(l, 32);
    f32x4 o[8];
#pragma unroll
    for (int dt = 0; dt < 8; ++dt) o[dt] = (f32x4){0.f, 0.f, 0.f, 0.f};
#pragma unroll
    for (int kk = 0; kk < 5; ++kk) {
        const int T0 = 2 * kk, T1 = 2 * kk + 1;
        if (T1 >= ktmin || T0 == 8) {
            u32x4 pw; pw.x = pg8::cvt_pk_bf16(s[T0][0], s[T0][1]); pw.y = pg8::cvt_pk_bf16(s[T0][2], s[T0][3]);
            if (T1 <= 8) { pw.z = pg8::cvt_pk_bf16(s[T1 <= 8 ? T1 : 8][0], s[T1 <= 8 ? T1 : 8][1]); pw.w = pg8::cvt_pk_bf16(s[T1 <= 8 ? T1 : 8][2], s[T1 <= 8 ? T1 : 8][3]); } else { pw.z = 0u; pw.w = 0u; }
            const bf16x8 pf = __builtin_bit_cast(bf16x8, pw);
            const int rT0 = (T0 >= ktmin) ? T0 : 8, rT1 = (T1 <= 8 && T1 >= ktmin) ? T1 : 8;
            const int a0 = VOFF + (16 * w + 16 * rT0 + 4 * g + (cq >> 2)) * KVS + 8 * (cq & 3);
            const int a1 = VOFF + (16 * w + 16 * rT1 + 4 * g + (cq >> 2)) * KVS + 8 * (cq & 3);
#pragma unroll
            for (int dt = 0; dt < 8; ++dt) {
                const s16x4 v0 = __builtin_amdgcn_ds_read_tr16_b64_v4i16((LAS s16x4*)(lds + a0 + dt * 32));
                const s16x4 v1 = __builtin_amdgcn_ds_read_tr16_b64_v4i16((LAS s16x4*)(lds + a1 + dt * 32));
                const bf16x8 vf = {v0[0], v0[1], v0[2], v0[3], v1[0], v1[1], v1[2], v1[3]};
                o[dt] = __builtin_amdgcn_mfma_f32_16x16x32_bf16(vf, pf, o[dt], 0, 0, 0);
            }
        }
    }
    const float inv = 1.0f / l;
    if (MODE == 0) {
        bf16_t* po = (bf16_t*)(P.ws + WS_PO) + ((size_t)p * NTOK_P + qtok) * DATT + h * HD + 4 * g;
#pragma unroll
        for (int dt = 0; dt < 8; ++dt) { u32x2 wv; wv.x = pg8::cvt_pk_bf16(o[dt][0] * inv, o[dt][1] * inv); wv.y = pg8::cvt_pk_bf16(o[dt][2] * inv, o[dt][3] * inv); *(u32x2*)(po + 16 * dt) = wv; }
        if (g == 0) { ((float*)(P.ws + WS_PM))[((size_t)p * NTOK_P + qtok) * NH + h] = m; ((float*)(P.ws + WS_PL))[((size_t)p * NTOK_P + qtok) * NH + h] = l; }
    } else {
        const float* PM = (const float*)(P.ws + WS_PM); const float* PL = (const float*)(P.ws + WS_PL);
        const float m0 = PM[qtok * NH + h], l0 = PL[qtok * NH + h], m1 = PM[((size_t)NTOK_P + qtok) * NH + h], l1 = PL[((size_t)NTOK_P + qtok) * NH + h];
        const float M = fmaxf(m, fmaxf(m0, m1));
        const float w2 = exp2f(m - M), w0 = exp2f(m0 - M) * l0, w1 = exp2f(m1 - M) * l1;
        const float rden = 1.0f / (w2 * l + w0 + w1);
        const bf16_t* p0 = (const bf16_t*)(P.ws + WS_PO) + qtok * DATT + h * HD + 4 * g;
        const bf16_t* p1 = p0 + (size_t)NTOK_P * DATT;
        bf16_t* ar = (bf16_t*)(P.ws + WS_AR) + qtok * D + h * HD + 4 * g;
#pragma unroll
        for (int dt = 0; dt < 8; ++dt) {
            const u32x2 x0 = *(const u32x2*)(p0 + 16 * dt), x1 = *(const u32x2*)(p1 + 16 * dt);
            const float r0 = (w2 * o[dt][0] + w0 * bflo(x0.x) + w1 * bflo(x1.x)) * rden, r1 = (w2 * o[dt][1] + w0 * bfhi(x0.x) + w1 * bfhi(x1.x)) * rden;
            const float r2 = (w2 * o[dt][2] + w0 * bflo(x0.y) + w1 * bflo(x1.y)) * rden, r3 = (w2 * o[dt][3] + w0 * bfhi(x0.y) + w1 * bfhi(x1.y)) * rden;
            u32x2 wv; wv.x = pg8::cvt_pk_bf16(r0, r1); wv.y = pg8::cvt_pk_bf16(r2, r3); *(u32x2*)(ar + 16 * dt) = wv;
        }
    }
    __syncthreads();
}

struct SampPre { float4 k[4], v[4]; };
__device__ __forceinline__ void samp_prefetch(const Params& P, int b, int h, int k, SampPre& R) {
    const int tid = threadIdx.x;
#pragma unroll
    for (int it = 0; it < 4; ++it) {
        const int rho = it * 16 + (tid >> 5), ch4 = tid & 31, c = 256 * k + rho;
        const size_t so = ((size_t)(b * 2048 + c)) * DATT + h * HD + ch4 * 4;
        R.k[it] = *(const float4*)(P.cache_k + so); R.v[it] = *(const float4*)(P.cache_v + so);
    }
}
__device__ __forceinline__ void samp_unit(const Params& P, int b, int h, int k, LAS unsigned char* lds, SampPre& R, bool have, bool pf_next, int nb, int nh, int nk) {
    const int tid = threadIdx.x, lane = tid & 63, w = __builtin_amdgcn_readfirstlane(tid >> 6);
    const int cq = lane & 15, g = lane >> 4;
    if (k < 8) {
        if (!have) samp_prefetch(P, b, h, k, R);
#pragma unroll
        for (int it = 0; it < 16; ++it) {
            const int rho = it * 16 + (tid >> 5), ch4 = tid & 31, c = 256 * k + rho;
            const size_t so = ((size_t)(b * 2048 + c)) * DATT + h * HD + ch4 * 4;
            float4 kf, vf;
            if (it < 4) { kf = R.k[it < 4 ? it : 0]; vf = R.v[it < 4 ? it : 0]; } else { kf = *(const float4*)(P.cache_k + so); vf = *(const float4*)(P.cache_v + so); }
            if (c >= 8) { const size_t od = ((size_t)(b * 2048 + c - 8)) * DATT + h * HD + ch4 * 4; *(float4*)(P.out + O_KS + od) = kf; *(float4*)(P.out + O_VS + od) = vf; }
            u32x2 kw, vw; kw.x = pg8::cvt_pk_bf16(kf.x, kf.y); kw.y = pg8::cvt_pk_bf16(kf.z, kf.w); vw.x = pg8::cvt_pk_bf16(vf.x, vf.y); vw.y = pg8::cvt_pk_bf16(vf.z, vf.w);
            *(LAS u32x2*)(lds + rho * KVS + ch4 * 8) = kw; *(LAS u32x2*)(lds + VOFF + rho * KVS + ch4 * 8) = vw;
            if ((it & 3) == 3) __builtin_amdgcn_sched_barrier(0);
        }
    } else {
        const int rho = tid >> 5, ch4 = tid & 31;
        u32x2 kw = {0u, 0u}, vw = {0u, 0u};
        if (rho < 8) { const size_t so = ((size_t)(b * 2048 + 2040 + rho)) * DATT + h * HD + ch4 * 4; const float4 kf = *(const float4*)(P.out + O_KS + so), vf = *(const float4*)(P.out + O_VS + so);
            kw.x = pg8::cvt_pk_bf16(kf.x, kf.y); kw.y = pg8::cvt_pk_bf16(kf.z, kf.w); vw.x = pg8::cvt_pk_bf16(vf.x, vf.y); vw.y = pg8::cvt_pk_bf16(vf.z, vf.w); }
        *(LAS u32x2*)(lds + rho * KVS + ch4 * 8) = kw; *(LAS u32x2*)(lds + VOFF + rho * KVS + ch4 * 8) = vw;
        *(LAS u32x2*)(lds + (16 + rho) * KVS + ch4 * 8) = (u32x2){0u, 0u}; *(LAS u32x2*)(lds + VOFF + (16 + rho) * KVS + ch4 * 8) = (u32x2){0u, 0u};
    }
    if (pf_next) samp_prefetch(P, nb, nh, nk, R);
    const int t = cq & 7;
    const bf16_t* Qb = (const bf16_t*)(P.ws + WS_QB) + ((size_t)(NTOK_P + b * 8 + t)) * DATT + h * HD;
    bf16x8 qf[4];
#pragma unroll
    for (int ks = 0; ks < 4; ++ks) qf[ks] = *(const bf16x8*)(Qb + 32 * ks + 8 * g);
    __syncthreads();
    const float slope2 = exp2f(-8.0f * (float)(h + 1) / 12.0f) * LOG2E;
    const bool active = (k < 8) || (w == 0);
    f32x4 s[2]; float m = -INFINITY;
#pragma unroll
    for (int j = 0; j < 2; ++j) {
        f32x4 acc = {0.f, 0.f, 0.f, 0.f};
        if (active) {
#pragma unroll
            for (int ks = 0; ks < 4; ++ks) { const bf16x8 kf = *(const LAS bf16x8*)(lds + (32 * w + 16 * j + cq) * KVS + (32 * ks + 8 * g) * 2); acc = __builtin_amdgcn_mfma_f32_16x16x32_bf16(kf, qf[ks], acc, 0, 0, 0); }
        }
#pragma unroll
        for (int ii = 0; ii < 4; ++ii) {
            const int c = 256 * k + 32 * w + 16 * j + 4 * g + ii, dist = 2048 + t - c;
            int mult = (dist <= 128 ? 1 : 0) + (((dist & 3) == 0 && dist <= 512) ? 1 : 0) + (((dist & 15) == 0 && dist <= 2048) ? 1 : 0);
            if (dist < 0 || !active || c > 2055) mult = 0;
            const float v = mult ? acc[ii] - slope2 * (float)dist : -INFINITY;
            acc[ii] = v; m = fmaxf(m, v);
            s[j][ii] = (float)mult;
            s[j][ii] = v;
        }
    }
    m = fmaxf(m, __shfl_xor(m, 16)); m = fmaxf(m, __shfl_xor(m, 32));
    const float mref = (m == -INFINITY) ? 0.f : m;
    float l = 0.f;
#pragma unroll
    for (int j = 0; j < 2; ++j)
#pragma unroll
        for (int ii = 0; ii < 4; ++ii) {
            const int c = 256 * k + 32 * w + 16 * j + 4 * g + ii, dist = 2048 + t - c;
            const int mult = (dist <= 128 ? 1 : 0) + (((dist & 3) == 0 && dist <= 512) ? 1 : 0) + (((dist & 15) == 0 && dist <= 2048) ? 1 : 0);
            const float pp = (float)mult * exp2f(s[j][ii] - mref); s[j][ii] = pp; l += pp; }
    l += __shfl_xor(l, 16); l += __shfl_xor(l, 32);
    f32x4 o[8];
    {
        u32x4 pw; pw.x = pg8::cvt_pk_bf16(s[0][0], s[0][1]); pw.y = pg8::cvt_pk_bf16(s[0][2], s[0][3]); pw.z = pg8::cvt_pk_bf16(s[1][0], s[1][1]); pw.w = pg8::cvt_pk_bf16(s[1][2], s[1][3]);
        const bf16x8 pf = __builtin_bit_cast(bf16x8, pw);
        const int rw = active ? w : 0;
        const int a0 = VOFF + (32 * rw + 4 * g + (cq >> 2)) * KVS + 8 * (cq & 3), a1 = a0 + 16 * KVS;
#pragma unroll
        for (int dt = 0; dt < 8; ++dt) {
            const s16x4 v0 = __builtin_amdgcn_ds_read_tr16_b64_v4i16((LAS s16x4*)(lds + a0 + dt * 32));
            const s16x4 v1 = __builtin_amdgcn_ds_read_tr16_b64_v4i16((LAS s16x4*)(lds + a1 + dt * 32));
            const bf16x8 vf = {v0[0], v0[1], v0[2], v0[3], v1[0], v1[1], v1[2], v1[3]};
            o[dt] = __builtin_amdgcn_mfma_f32_16x16x32_bf16(vf, pf, (f32x4){0.f, 0.f, 0.f, 0.f}, 0, 0, 0);
        }
    }
    __syncthreads();
    LAS float* OL = (LAS float*)lds;
    LAS float* ML = (LAS float*)(lds + 32768);
    if (cq < 8) {
#pragma unroll
        for (int dt = 0; dt < 8; ++dt) *(LAS f32x4*)(OL + (w * 8 + cq) * 128 + 16 * dt + 4 * g) = o[dt];
        if (g == 0) { ML[(w * 8 + cq) * 2 + 0] = m; ML[(w * 8 + cq) * 2 + 1] = l; }
    }
    __syncthreads();
    {
        const int q = w; float M = -INFINITY;
#pragma unroll
        for (int ww = 0; ww < 8; ++ww) M = fmaxf(M, ML[(ww * 8 + q) * 2]);
        const float Mr = (M == -INFINITY) ? 0.f : M;
        float L = 0.f, o0 = 0.f, o1 = 0.f;
#pragma unroll
        for (int ww = 0; ww < 8; ++ww) { const float f = exp2f(ML[(ww * 8 + q) * 2] - Mr); L += f * ML[(ww * 8 + q) * 2 + 1];
            o0 += f * OL[(ww * 8 + q) * 128 + 2 * lane]; o1 += f * OL[(ww * 8 + q) * 128 + 2 * lane + 1]; }
        float* ps = (float*)(P.ws + WS_PS) + ((((size_t)(b * NH + h)) * 9 + k) * 8 + q) * 130;
        if (lane == 0) { ps[0] = M; ps[1] = L; }
        *(float2*)(ps + 2 + 2 * lane) = make_float2(o0, o1);
    }
    __syncthreads();
}
__device__ __forceinline__ void samp_merge_unit(const Params& P, int b, int t, int h, int lane) {
    const float* ps = (const float*)(P.ws + WS_PS) + ((size_t)(b * NH + h)) * 9 * 8 * 130 + (size_t)t * 130;
    float M = -INFINITY;
#pragma unroll
    for (int k = 0; k < 9; ++k) M = fmaxf(M, ps[(size_t)k * 8 * 130]);
    float L = 0.f, o0 = 0.f, o1 = 0.f;
#pragma unroll
    for (int k = 0; k < 9; ++k) { const float* pk = ps + (size_t)k * 8 * 130; const float f = exp2f(pk[0] - M); L += f * pk[1]; const float2 ov = *(const float2*)(pk + 2 + 2 * lane); o0 += f * ov.x; o1 += f * ov.y; }
    const float inv = 1.0f / L;
    bf16_t* ar = (bf16_t*)(P.ws + WS_AR) + ((size_t)(NTOK_P + b * 8 + t)) * D + h * HD;
    *(unsigned*)(ar + 2 * lane) = pack2(o0 * inv, o1 * inv);
}

constexpr int LRU_XS = 144, LRU_GS = 68, LRU_WAVE = 16 * LRU_XS + 2 * 16 * LRU_GS * 4;
__device__ __forceinline__ void lru_unit(const Params& P, bool samp, int b, int n, int k, int lane, LAS unsigned char* wl) {
    const int T = samp ? 8 : 64; const int row0 = samp ? NTOK_P + b * 8 : b * 2048 + k * 64; const int ch = n * 64 + lane;
    const int cq = lane & 15, g = lane >> 4;
    bf16x8 wf[2][4][2];
    { const bf16_t* lw = (const bf16_t*)(P.ws + WS_LW);
#pragma unroll
      for (int m = 0; m < 2; ++m)
#pragma unroll
        for (int ct = 0; ct < 4; ++ct)
#pragma unroll
            for (int ks = 0; ks < 2; ++ks) wf[m][ct][ks] = *(const bf16x8*)(lw + ((size_t)((m * 8 + n) * 64 + 16 * ct + cq)) * 64 + 32 * ks + 8 * g); }
    const float ba = P.lru_b_a[ch], bx = P.lru_b_x[ch], lam = P.lru_lambda[ch];
    const float sp8 = -8.0f * LOG2E * log1pf(expf(-lam));
    const float cw0 = P.conv_w[ch], cw1 = P.conv_w[512 + ch], cw2 = P.conv_w[1024 + ch], cw3 = P.conv_w[1536 + ch], cb = P.conv_b[ch];
    const bf16_t* XR = (const bf16_t*)(P.ws + WS_XR); const bf16_t* GT = (const bf16_t*)(P.ws + WS_GATE);
    float* R0 = (float*)(P.ws + WS_R0); float* R1 = (float*)(P.ws + WS_R1); bf16_t* AR = (bf16_t*)(P.ws + WS_AR);
    LAS unsigned char* xcb = wl; LAS float* G = (LAS float*)(wl + 16 * LRU_XS);
    float x0 = 0.f, x1 = 0.f, x2 = 0.f, h = 0.f, A = 1.f;
    if (samp) { x0 = P.state_conv[(b * 3 + 0) * 512 + ch]; x1 = P.state_conv[(b * 3 + 1) * 512 + ch]; x2 = P.state_conv[(b * 3 + 2) * 512 + ch]; h = P.state_h[b * 512 + ch]; }
    else if (k > 0) { x0 = bflo(XR[(size_t)(row0 - 3) * DLRU + ch]); x1 = bflo(XR[(size_t)(row0 - 2) * DLRU + ch]); x2 = bflo(XR[(size_t)(row0 - 1) * DLRU + ch]); }
#pragma unroll 1
    for (int t0 = 0; t0 < T; t0 += 16) {
        const int ns = (T - t0) < 16 ? (T - t0) : 16;
        float xc[16], gt[16];
#pragma unroll
        for (int i = 0; i < 16; ++i) { const int r = row0 + t0 + (i < ns ? i : ns - 1); xc[i] = bflo(XR[(size_t)r * DLRU + ch]); gt[i] = bflo(GT[(size_t)r * DLRU + ch]); }
#pragma unroll
        for (int i = 0; i < 16; ++i) {
            const float xin = xc[i]; const float v = ((x0 * cw0 + x1 * cw1) + x2 * cw2) + xin * cw3 + cb;
            if (i < ns) { x0 = x1; x1 = x2; x2 = xin; }
            xc[i] = v;
            *(LAS bf16_t*)(xcb + i * LRU_XS + lane * 2) = (bf16_t)f2bf(v);
        }
        __builtin_amdgcn_wave_barrier();
        const bf16x8 a0 = *(const LAS bf16x8*)(xcb + cq * LRU_XS + (8 * g) * 2), a1 = *(const LAS bf16x8*)(xcb + cq * LRU_XS + (32 + 8 * g) * 2);
#pragma unroll
        for (int m = 0; m < 2; ++m)
#pragma unroll
            for (int ct = 0; ct < 4; ++ct) {
                f32x4 acc = __builtin_amdgcn_mfma_f32_16x16x32_bf16(a0, wf[m][ct][0], (f32x4){0.f, 0.f, 0.f, 0.f}, 0, 0, 0);
                acc = __builtin_amdgcn_mfma_f32_16x16x32_bf16(a1, wf[m][ct][1], acc, 0, 0, 0);
#pragma unroll
                for (int ii = 0; ii < 4; ++ii) G[(m * 16 + 4 * g + ii) * LRU_GS + 16 * ct + cq] = acc[ii];
            }
        __builtin_amdgcn_wave_barrier();
#pragma unroll
        for (int i = 0; i < 16; ++i) {
            if (i < ns) {
                const float ra = G[i * LRU_GS + lane] + ba, ri = G[(16 + i) * LRU_GS + lane] + bx;
                const float r = __builtin_amdgcn_rcpf(1.0f + __builtin_amdgcn_exp2f(-LOG2E * ra)), ig = __builtin_amdgcn_rcpf(1.0f + __builtin_amdgcn_exp2f(-LOG2E * ri));
                const float a = __builtin_amdgcn_exp2f(sp8 * r);
                const float u = __builtin_amdgcn_sqrtf(fmaxf(1.0f - a * a, 0.f)) * (ig * xc[i]);
                h = a * h + u; A = a * A;
                const float ge = gelu_as(gt[i]);
                if (samp) AR[(size_t)(row0 + t0 + i) * D + DATT + ch] = (bf16_t)f2bf(h * ge);
                else { R0[(size_t)(row0 + t0 + i) * DLRU + ch] = h * ge; R1[(size_t)(row0 + t0 + i) * DLRU + ch] = A * ge; }
            }
        }
        __builtin_amdgcn_wave_barrier();
    }
    if (samp) { P.out[O_HS + (size_t)b * 512 + ch] = h; float* co = P.out + O_CS + (size_t)b * 3 * 512 + ch; co[0] = x0; co[512] = x1; co[1024] = x2; }
    else {
        ((float*)(P.ws + WS_HE))[((size_t)(b * 32 + k)) * 512 + ch] = h; ((float*)(P.ws + WS_AE))[((size_t)(b * 32 + k)) * 512 + ch] = A;
        if (k == 31) { float* co = P.out + O_CP + (size_t)b * 3 * 512 + ch; co[0] = x0; co[512] = x1; co[1024] = x2; }
    }
}

__device__ __forceinline__ void phase_lru(const Params& P, LAS unsigned char* lds) {
    const int lane = threadIdx.x & 63, wave = __builtin_amdgcn_readfirstlane(threadIdx.x >> 6);
    const int gw = blockIdx.x * 8 + wave, nw = gridDim.x * 8;
#pragma unroll 1
    for (int pass = 0; pass < 2; ++pass) {
        if ((pass ^ (wave & 1)) == 0) {
            for (int u = gw; u < 2048 + 256; u += nw) { const bool samp = u >= 2048; const int v = samp ? u - 2048 : u; lru_unit(P, samp, samp ? (v >> 3) : (v >> 8), samp ? (v & 7) : ((v >> 5) & 7), v & 31, lane, lds + wave * LRU_WAVE); }
        } else quant_tables(P, gw, nw);
    }
    __syncthreads();
}
__device__ __forceinline__ void phase_samp(const Params& P, LAS unsigned char* lds) {
    SampPre R; bool have = false;
    int u = blockIdx.x;
    if (u < 384 * 9 && (u % 9) < 8) { const int bh = u / 9; samp_prefetch(P, bh / NH, bh % NH, u % 9, R); have = true; }
    for (; u < 384 * 9; u += gridDim.x) {
        const int k = u % 9, bh = u / 9; const int un = u + (int)gridDim.x; const bool pf = un < 384 * 9 && (un % 9) < 8; const int nbh = un / 9;
        samp_unit(P, bh / NH, bh % NH, k, lds, R, have, pf, nbh / NH, nbh % NH, un % 9);
        have = pf;
    }
}
__device__ __forceinline__ AttnId attn01_id(int u) {
    const int p = u / 1536, rem = u - p * 1536, bh = rem >> 4, rc = rem & 15; const int b = bh / NH, h = bh - b * NH;
    return AttnId{p, b, h, p == 0 ? 0 : (rc >> 2), p == 0 ? rc : (rc & 3)};
}
__device__ __forceinline__ void phase_attn01(const Params& P, LAS unsigned char* lds) {
    AttnKV R; int u = blockIdx.x;
    if (u < 3072) attn_fetch(P, attn01_id(u), R);
    for (; u < 3072; u += gridDim.x) {
        const int un = u + (int)gridDim.x; const bool hn = un < 3072;
        attn_unit<0>(P, attn01_id(u), R, hn, attn01_id(hn ? un : u), lds);
    }
}
__device__ __forceinline__ void phase_mix_b(const Params& P, LAS unsigned char* lds) {
    {
        const int gt = blockIdx.x * NTHREADS + threadIdx.x;
        for (int i = gt; i < 8 * 32 * 512; i += gridDim.x * NTHREADS) {
            const int ch = i & 511, k = (i >> 9) & 31, b = i >> 14;
            const float* HE = (const float*)(P.ws + WS_HE) + (size_t)b * 32 * 512 + ch; const float* AE = (const float*)(P.ws + WS_AE) + (size_t)b * 32 * 512 + ch;
            float hin = 0.f;
            for (int kk = 0; kk < k; ++kk) hin = HE[kk * 512] + AE[kk * 512] * hin;
            const float* R0 = (const float*)(P.ws + WS_R0) + (size_t)(b * 2048 + k * 64) * DLRU + ch; const float* R1 = (const float*)(P.ws + WS_R1) + (size_t)(b * 2048 + k * 64) * DLRU + ch;
            bf16_t* ar = (bf16_t*)(P.ws + WS_AR) + (size_t)(b * 2048 + k * 64) * D + DATT + ch;
#pragma unroll 8
            for (int t = 0; t < 64; ++t) ar[(size_t)t * D] = (bf16_t)f2bf(R0[(size_t)t * DLRU] + R1[(size_t)t * DLRU] * hin);
            if (k == 31) P.out[O_HP + (size_t)b * 512 + ch] = HE[31 * 512] + AE[31 * 512] * hin;
        }
    }
    { const int lane = threadIdx.x & 63, gw = blockIdx.x * 8 + (threadIdx.x >> 6);
      for (int u = gw; u < NTOK_S * NH; u += gridDim.x * 8) { const int row = u / NH, h = u - row * NH; samp_merge_unit(P, row >> 3, row & 7, h, lane); } }
    {
        AttnKV R; int u = blockIdx.x;
        if (u < 1536) attn_fetch(P, AttnId{2, (u >> 4) / NH, (u >> 4) % NH, u & 15, 0}, R);
        for (; u < 1536; u += gridDim.x) {
            const int un = u + (int)gridDim.x; const bool hn = un < 1536; const int uu = hn ? un : u;
            attn_unit<1>(P, AttnId{2, (u >> 4) / NH, (u >> 4) % NH, u & 15, 0}, R, hn, AttnId{2, (uu >> 4) / NH, (uu >> 4) % NH, uu & 15, 0}, lds);
        }
    }
}

__device__ __forceinline__ void phase_ln1(const Params& P) {
    const int lane = threadIdx.x & 63, wave = threadIdx.x >> 6;
    const bf16_t* pre = (const bf16_t*)(P.ws + WS_PRE1); bf16_t* x1b = (bf16_t*)(P.ws + WS_X1B);
    for (int row = blockIdx.x * 8 + wave; row < NTOK; row += gridDim.x * 8) {
        float4 v[8]; float s = 0.f;
#pragma unroll
        for (int j = 0; j < 8; j += 2) { const u32x4 pw = *(const u32x4*)(pre + (size_t)row * D + (j >> 2) * 1024 + lane * 16 + (j & 3) * 4);
            v[j] = make_float4(bflo(pw.x), bfhi(pw.x), bflo(pw.y), bfhi(pw.y)); v[j + 1] = make_float4(bflo(pw.z), bfhi(pw.z), bflo(pw.w), bfhi(pw.w));
            s += (v[j].x + v[j].y) + (v[j].z + v[j].w) + (v[j + 1].x + v[j + 1].y) + (v[j + 1].z + v[j + 1].w); }
        const float mean = wave_sum(s) * (1.0f / D); float q = 0.f;
#pragma unroll
        for (int j = 0; j < 8; ++j) { const float a = v[j].x - mean, b = v[j].y - mean, c = v[j].z - mean, d = v[j].w - mean; q += (a * a + b * b) + (c * c + d * d); }
        const float rstd = rsqrtf(wave_sum(q) * (1.0f / D) + LN_EPS);
        float am = 0.f;
#pragma unroll
        for (int j = 0; j < 8; ++j) { const int col = (j >> 2) * 1024 + lane * 16 + (j & 3) * 4; const float4 g = *(const float4*)(P.ln1_g + col), bb = *(const float4*)(P.ln1_b + col);
            float4 o; o.x = (v[j].x - mean) * rstd * g.x + bb.x; o.y = (v[j].y - mean) * rstd * g.y + bb.y; o.z = (v[j].z - mean) * rstd * g.z + bb.z; o.w = (v[j].w - mean) * rstd * g.w + bb.w;
            v[j] = o; am = fmaxf(am, fmaxf(fmaxf(fabsf(o.x), fabsf(o.y)), fmaxf(fabsf(o.z), fabsf(o.w))));
            uint2 w; w.x = pack2(o.x, o.y); w.y = pack2(o.z, o.w); *(uint2*)(x1b + (size_t)row * D + col) = w; }
        am = wave_max(am); if (am == 0.f) am = 1.f;
        const float inv = 119.0f / am;
        unsigned char* xq = P.ws + WS_X1Q + (size_t)row * D;
        u32x4 wh, wl;
#pragma unroll
        for (int d = 0; d < 4; ++d) { unsigned dh = 0u, dl = 0u;
#pragma unroll
            for (int e = 0; e < 8; ++e) { const float4 t = v[d * 2 + (e >> 2)]; const float x = (e & 3) == 0 ? t.x : ((e & 3) == 1 ? t.y : ((e & 3) == 2 ? t.z : t.w));
                const int q = (int)rintf(x * inv); dl |= (unsigned)(q & 15) << (4 * e); dh |= (unsigned)(((q + 8) >> 4) & 15) << (4 * e); }
            wh[d] = dh; wl[d] = dl; }
        *(u32x4*)(xq + lane * 32) = wh; *(u32x4*)(xq + lane * 32 + 16) = wl;
        if (lane == 0) ((float*)(P.ws + WS_SX))[row] = am * (1.0f / 119.0f);
    }
}

__device__ __forceinline__ int mono(float v) { const int b = __float_as_int(v); return b ^ ((b >> 31) & 0x7fffffff); }
__device__ __forceinline__ float unmono(int k) { return __int_as_float(k ^ ((k >> 31) & 0x7fffffff)); }
#define MK_INSERT16(L, X) do { int _x = (X); _Pragma("unroll") for (int _j = 0; _j < 16; ++_j) { const int _hi = max(L[_j], _x); _x = min(L[_j], _x); L[_j] = _hi; } } while (0)

template <int N> __device__ __forceinline__ void bitonic_sort_desc(int (&v)[N]) {
#pragma unroll
    for (int k = 2; k <= N; k <<= 1)
#pragma unroll
        for (int j = k >> 1; j > 0; j >>= 1)
#pragma unroll
            for (int i = 0; i < N; ++i) { const int l = i ^ j;
                if (l > i) { const int a = v[i], b = v[l]; if ((i & k) == 0) { v[i] = max(a, b); v[l] = min(a, b); } else { v[i] = min(a, b); v[l] = max(a, b); } } }
}
template <int N> __device__ __forceinline__ void bitonic_merge_desc(int (&v)[N]) {
#pragma unroll
    for (int j = N >> 1; j > 0; j >>= 1)
#pragma unroll
        for (int i = 0; i < N; ++i) { const int l = i ^ j; if (l > i) { const int a = v[i], b = v[l]; v[i] = max(a, b); v[l] = min(a, b); } }
}
__device__ __forceinline__ void xlane_merge16(int (&v)[16], int off) {
    int c[16];
#pragma unroll
    for (int i = 0; i < 16; ++i) c[i] = max(v[i], __shfl_xor(v[15 - i], off));
#pragma unroll
    for (int i = 0; i < 16; ++i) v[i] = c[i];
    bitonic_merge_desc<16>(v);
}
__device__ __forceinline__ int sel4(int g, int a, int b, int c, int d) { return g == 0 ? a : (g == 1 ? b : (g == 2 ? c : d)); }
__device__ __forceinline__ float sel4f(int g, float a, float b, float c, float d) { return g == 0 ? a : (g == 1 ? b : (g == 2 ? c : d)); }
__device__ __forceinline__ constexpr int cand_a(int role, int i) {
    return role == 0 ? 0 : role == 1 ? (i < 8 ? 1 : (i < 13 ? 2 : 4)) : role == 2 ? (i < 4 ? 3 : (i < 6 ? 5 : (i < 8 ? 6 : (i < 10 ? 7 : 8 + (i - 10))))) : (i < 2 ? 14 + i : -1);
}
__device__ __forceinline__ constexpr int cand_b(int role, int i) {
    return role == 0 ? i : role == 1 ? (i < 8 ? i : (i < 13 ? i - 8 : i - 13)) : role == 2 ? (i < 4 ? i : (i < 6 ? i - 4 : (i < 8 ? i - 6 : (i < 10 ? i - 8 : 0)))) : 0;
}

__device__ __forceinline__ void route_unit(const Params& P, int h, int tg, LAS unsigned char* lds, LAS int* lst) {
    const int lane = threadIdx.x & 63, w = __builtin_amdgcn_readfirstlane(threadIdx.x >> 6);
    const int cq = lane & 15, g = lane >> 4;
    const int tok = tg * 128 + w * 16 + cq;
    const bf16_t* qrow = (const bf16_t*)(P.ws + WS_QP) + (size_t)tok * D + h * 256;
    int L0[16], L1[16];
#pragma unroll
    for (int p = 0; p < 2; ++p) {
        bf16x8 qf[4];
#pragma unroll
        for (int ks = 0; ks < 4; ++ks) qf[ks] = *(const bf16x8*)(qrow + p * 128 + 32 * ks + 8 * g);
        int v0[16], v1[16];
#pragma unroll
        for (int kt = 0; kt < 8; ++kt) {
            f32x4 acc = {0.f, 0.f, 0.f, 0.f};
#pragma unroll
            for (int ks = 0; ks < 4; ++ks) { const bf16x8 kf = *(const LAS bf16x8*)(lds + (p * 128 + 16 * kt + cq) * KVS + (32 * ks + 8 * g) * 2); acc = __builtin_amdgcn_mfma_f32_16x16x32_bf16(kf, qf[ks], acc, 0, 0, 0); }
#pragma unroll
            for (int ii = 0; ii < 4; ++ii) { const int key = (mono(acc[ii]) & ~127) | (16 * kt + 4 * g + ii); if (kt < 4) v0[kt * 4 + ii] = key; else v1[(kt - 4) * 4 + ii] = key; }
        }
        bitonic_sort_desc<16>(v0); bitonic_sort_desc<16>(v1);
#pragma unroll
        for (int i = 0; i < 16; ++i) v0[i] = max(v0[i], v1[15 - i]);
        bitonic_merge_desc<16>(v0);
        xlane_merge16(v0, 16); xlane_merge16(v0, 32);
#pragma unroll
        for (int i = 0; i < 16; ++i) { if (p == 0) L0[i] = v0[i]; else L1[i] = v0[i]; }
    }
    if (g == 0) {
#pragma unroll
        for (int i = 0; i < 16; ++i) lst[(cq * 2 + 0) * 16 + i] = L0[i];
    }
    if (g == 1) {
#pragma unroll
        for (int i = 0; i < 16; ++i) lst[(cq * 2 + 1) * 16 + i] = L1[i];
    }
    float f0[16], f1[16];
#pragma unroll
    for (int i = 0; i < 16; ++i) { f0[i] = unmono(L0[i] & ~127); f1[i] = unmono(L1[i] & ~127); }
    int c[16];
#pragma unroll
    for (int i = 0; i < 16; ++i) {
        constexpr int NEG = (int)0x80000000;
        const float va = sel4f(g, f0[cand_a(0, i)], f0[cand_a(1, i)], f0[cand_a(2, i)], f0[cand_a(3, i) < 0 ? 0 : cand_a(3, i)]);
        const float vb = sel4f(g, f1[cand_b(0, i)], f1[cand_b(1, i)], f1[cand_b(2, i)], f1[cand_b(3, i)]);
        const int id = sel4(g, (cand_a(0, i) << 4) | cand_b(0, i), (cand_a(1, i) << 4) | cand_b(1, i), (cand_a(2, i) << 4) | cand_b(2, i), ((cand_a(3, i) < 0 ? 0 : cand_a(3, i)) << 4) | cand_b(3, i));
        int key = (mono(va + vb) & ~255) | id;
        if (cand_a(3, i) < 0) key = (g == 3) ? NEG : key;
        c[i] = key;
    }
    bitonic_sort_desc<16>(c);
    xlane_merge16(c, 16); xlane_merge16(c, 32);
    const float mx = unmono(c[0] & ~255);
    float e[16]; float sum = 0.f;
#pragma unroll
    for (int i = 0; i < 16; ++i) { e[i] = exp2f((unmono(c[i] & ~255) - mx) * LOG2E); sum += e[i]; }
    const float inv = 1.0f / sum;
    __builtin_amdgcn_wave_barrier();
    int ei[4]; float gi[4];
#pragma unroll
    for (int j = 0; j < 4; ++j) {
        const int key = sel4(g, c[j], c[4 + j], c[8 + j], c[12 + j]);
        gi[j] = sel4f(g, e[j], e[4 + j], e[8 + j], e[12 + j]) * inv;
        const int a = (key >> 4) & 15, b = key & 15;
        const int i0 = lst[(cq * 2 + 0) * 16 + a] & 127, i1 = lst[(cq * 2 + 1) * 16 + b] & 127;
        ei[j] = i0 * 128 + i1;
    }
    int* EIDX = (int*)(P.ws + WS_EIDX); float* GW = (float*)(P.ws + WS_GW);
    *(int4*)(EIDX + (size_t)tok * 128 + h * 16 + 4 * g) = make_int4(ei[0], ei[1], ei[2], ei[3]);
    *(float4*)(GW + (size_t)tok * 128 + h * 16 + 4 * g) = make_float4(gi[0], gi[1], gi[2], gi[3]);
    __builtin_amdgcn_wave_barrier();
}
__device__ __forceinline__ void phase_route(const Params& P, LAS unsigned char* lds) {
    const int tid = threadIdx.x, wave = __builtin_amdgcn_readfirstlane(tid >> 6);
    const int h = blockIdx.x & 7, slot = blockIdx.x >> 3, nslot = gridDim.x >> 3;
    const bf16_t* sk = (const bf16_t*)(P.ws + WS_SKB) + (size_t)h * 2 * 128 * 128;
#pragma unroll
    for (int it = 0; it < 8; ++it) { const int row = it * 32 + (tid >> 4), ch = tid & 15; *(LAS u32x4*)(lds + row * KVS + ch * 16) = *(const u32x4*)(sk + (size_t)row * 128 + ch * 8); }
    __syncthreads();
    LAS int* lst = (LAS int*)(lds + 73728) + wave * 512;
    for (int tg = slot; tg < NTOK / 128; tg += nslot) route_unit(P, h, tg, lds, lst);
}

__device__ __forceinline__ float ubf(unsigned x, int k) { return (float)((x >> (8 * k)) & 0xffu); }
constexpr int XSLOT = 1152, XGRP = 4 * XSLOT, XNG = 4, XWAVE = XNG * XGRP;
__device__ __forceinline__ void dma_group(__amdgpu_buffer_rsrc_t tab, int e_lo, int e_hi, int g, LAS unsigned char* sb, int lane) {
#pragma unroll
    for (int j = 0; j < 4; ++j) {
        const int k = g * 4 + j; const int e = __builtin_amdgcn_readlane(k < 64 ? e_lo : e_hi, k & 63);
        const int so = e * TROW;
        __builtin_amdgcn_raw_ptr_buffer_load_lds(tab, (LAS void*)(sb + j * XSLOT), 16, lane * 16, so, 0, 0);
        if (lane < 8) __builtin_amdgcn_raw_ptr_buffer_load_lds(tab, (LAS void*)(sb + j * XSLOT + 1024), 16, 1024 + lane * 16, so, 0, 0);
    }
}
__device__ __forceinline__ void u_consume(const LAS unsigned char* sb, const u32x4& xh, const u32x4& xl, float a_lo, float a_hi, float b_lo, float b_hi, int g, int lane, float& w_lo, float& w_hi) {
    int d[4];
#pragma unroll
    for (int j = 0; j < 4; ++j) {
        const u32x4 nb = *(const LAS u32x4*)(sb + j * XSLOT + lane * 16); const unsigned sc = *(const LAS unsigned short*)(sb + j * XSLOT + 1024 + lane * 2);
        int tot = 0;
#pragma unroll
        for (int jj = 0; jj < 2; ++jj) {
            int th = __builtin_amdgcn_sdot8((int)nb[jj * 2], (int)xh[jj * 2], 0, false); th = __builtin_amdgcn_sdot8((int)nb[jj * 2 + 1], (int)xh[jj * 2 + 1], th, false);
            int tl = __builtin_amdgcn_sdot8((int)nb[jj * 2], (int)xl[jj * 2], 0, false); tl = __builtin_amdgcn_sdot8((int)nb[jj * 2 + 1], (int)xl[jj * 2 + 1], tl, false);
            tot += (16 * th + tl) * (int)((sc >> (8 * jj)) & 255u); }
        d[j] = tot;
    }
    const auto s02 = __builtin_amdgcn_permlane32_swap((unsigned)d[0], (unsigned)d[2], false, false);
    const auto s13 = __builtin_amdgcn_permlane32_swap((unsigned)d[1], (unsigned)d[3], false, false);
    const int r0 = (int)s02[0] + (int)s02[1], r1 = (int)s13[0] + (int)s13[1];
    const auto s01 = __builtin_amdgcn_permlane16_swap((unsigned)r0, (unsigned)r1, false, false);
    int r = (int)s01[0] + (int)s01[1];
    r += __builtin_amdgcn_update_dpp(0, r, 0x128, 0xf, 0xf, false);
    r += __builtin_amdgcn_update_dpp(0, r, 0x124, 0xf, 0xf, false);
    r += __builtin_amdgcn_update_dpp(0, r, 0x4E, 0xf, 0xf, false);
    r += __builtin_amdgcn_update_dpp(0, r, 0xB1, 0xf, 0xf, false);
    const int tot = __shfl(r, (lane & 3) * 16);
    const bool mine = ((lane >> 2) == (g & 15));
    const bool hi = g >= 16;
    const float wv = (hi ? b_hi : b_lo) * gelu_as((float)tot * (hi ? a_hi : a_lo));
    if (hi) w_hi = mine ? wv : w_hi; else w_lo = mine ? wv : w_lo;
}
__device__ __forceinline__ void v_consume(const LAS unsigned char* sb, int (&acc)[32], int (&bias)[2], float w_lo, float w_hi, float inv_sw, int g, int lane) {
    u32x4 nb[4]; int wq[2] = {0, 0};
#pragma unroll
    for (int j = 0; j < 4; ++j) {
        const int k = g * 4 + j; const float w = readlane_f(k < 64 ? w_lo : w_hi, k & 63) * inv_sw;
        nb[j] = *(const LAS u32x4*)(sb + j * XSLOT + lane * 16); const unsigned sc = *(const LAS unsigned short*)(sb + j * XSLOT + 1024 + lane * 2);
#pragma unroll
        for (int jj = 0; jj < 2; ++jj) { const int q = (int)rintf(w * (float)((sc >> (8 * jj)) & 255u)); wq[jj] |= (q & 255) << (8 * j); }
    }
    bias[0] = __builtin_amdgcn_sdot4(wq[0], 0x01010101, bias[0], false); bias[1] = __builtin_amdgcn_sdot4(wq[1], 0x01010101, bias[1], false);
#pragma unroll
    for (int i = 0; i < 4; ++i) {
        const unsigned r0 = nb[0][i], r1 = nb[1][i], r2 = nb[2][i], r3 = nb[3][i];
        const unsigned p01a = __builtin_amdgcn_perm(r1, r0, 0x05010400u), p01b = __builtin_amdgcn_perm(r1, r0, 0x07030602u);
        const unsigned p23a = __builtin_amdgcn_perm(r3, r2, 0x05010400u), p23b = __builtin_amdgcn_perm(r3, r2, 0x07030602u);
        const unsigned t0 = __builtin_amdgcn_perm(p23a, p01a, 0x05040100u), t1 = __builtin_amdgcn_perm(p23a, p01a, 0x07060302u);
        const unsigned t2 = __builtin_amdgcn_perm(p23b, p01b, 0x05040100u), t3 = __builtin_amdgcn_perm(p23b, p01b, 0x07060302u);
        const int wv = wq[i >> 1];
        acc[i * 8 + 0] = __builtin_amdgcn_sdot4((int)(t0 & 0x0F0F0F0Fu), wv, acc[i * 8 + 0], false); acc[i * 8 + 1] = __builtin_amdgcn_sdot4((int)((t0 >> 4) & 0x0F0F0F0Fu), wv, acc[i * 8 + 1], false);
        acc[i * 8 + 2] = __builtin_amdgcn_sdot4((int)(t1 & 0x0F0F0F0Fu), wv, acc[i * 8 + 2], false); acc[i * 8 + 3] = __builtin_amdgcn_sdot4((int)((t1 >> 4) & 0x0F0F0F0Fu), wv, acc[i * 8 + 3], false);
        acc[i * 8 + 4] = __builtin_amdgcn_sdot4((int)(t2 & 0x0F0F0F0Fu), wv, acc[i * 8 + 4], false); acc[i * 8 + 5] = __builtin_amdgcn_sdot4((int)((t2 >> 4) & 0x0F0F0F0Fu), wv, acc[i * 8 + 5], false);
        acc[i * 8 + 6] = __builtin_amdgcn_sdot4((int)(t3 & 0x0F0F0F0Fu), wv, acc[i * 8 + 6], false); acc[i * 8 + 7] = __builtin_amdgcn_sdot4((int)((t3 >> 4) & 0x0F0F0F0Fu), wv, acc[i * 8 + 7], false);
    }
}
__device__ __forceinline__ void exp_epilogue(const Params& P, int row, int ln, const int (&acc)[32], const int (&bias)[2], float scale_w) {
    const bf16_t* x1b = (const bf16_t*)(P.ws + WS_X1B);
    float val[32]; float s = 0.f;
#pragma unroll
    for (int jj = 0; jj < 2; ++jj) {
        const int b8 = 8 * bias[jj];
#pragma unroll
        for (int hh = 0; hh < 2; ++hh) {
            const u32x4 xa = *(const u32x4*)(x1b + (size_t)row * D + jj * 1024 + ln * 16 + hh * 8);
#pragma unroll
            for (int i = 0; i < 4; ++i) { const int e0 = jj * 16 + hh * 8 + 2 * i;
                val[e0] = scale_w * (float)(acc[e0] - b8) + ALPHA * bflo(xa[i]); val[e0 + 1] = scale_w * (float)(acc[e0 + 1] - b8) + ALPHA * bfhi(xa[i]); s += val[e0] + val[e0 + 1]; }
        }
    }
    const float mean = wave_sum(s) * (1.0f / D); float q = 0.f;
#pragma unroll
    for (int i = 0; i < 32; ++i) { const float d0 = val[i] - mean; q += d0 * d0; }
    const float rstd = rsqrtf(wave_sum(q) * (1.0f / D) + LN_EPS);
    float* yo = P.out + (row < NTOK_P ? O_YP + (size_t)row * D : O_YS + (size_t)(row - NTOK_P) * D);
    const int lo16 = ln * 16;
#pragma unroll
    for (int jj = 0; jj < 2; ++jj)
#pragma unroll
        for (int i = 0; i < 4; ++i) {
            const int col = jj * 1024 + lo16 + i * 4;
            const float4 g0 = *(const float4*)(P.ln2_g + col), b0 = *(const float4*)(P.ln2_b + col);
            float4 o;
            o.x = (val[jj * 16 + i * 4 + 0] - mean) * rstd * g0.x + b0.x; o.y = (val[jj * 16 + i * 4 + 1] - mean) * rstd * g0.y + b0.y;
            o.z = (val[jj * 16 + i * 4 + 2] - mean) * rstd * g0.z + b0.z; o.w = (val[jj * 16 + i * 4 + 3] - mean) * rstd * g0.w + b0.w;
            *(float4*)(yo + col) = o;
        }
}
__device__ __forceinline__ void phase_experts(const Params& P, LAS unsigned char* lds) {
    const int lane = threadIdx.x & 63, wave = __builtin_amdgcn_readfirstlane(threadIdx.x >> 6);
    const int* EIDX = (const int*)(P.ws + WS_EIDX); const float* GW = (const float*)(P.ws + WS_GW);
    const __amdgpu_buffer_rsrc_t UQ = __builtin_amdgcn_make_buffer_rsrc((void*)(P.ws + WS_UB), 0, NEXP * TROW, 0x00020000);
    const __amdgpu_buffer_rsrc_t VQ = __builtin_amdgcn_make_buffer_rsrc((void*)(P.ws + WS_VB), 0, NEXP * TROW, 0x00020000);
    const float* SU = (const float*)(P.ws + WS_SU); const float* SV = (const float*)(P.ws + WS_SV); const float* SX = (const float*)(P.ws + WS_SX);
    LAS unsigned char* wb = lds + wave * XWAVE;
    for (int row = blockIdx.x * 8 + wave; row < NTOK_P; row += gridDim.x * 8) {
        int ln = lane; asm volatile("" : "+v"(ln));
        const u32x4 xh = *(const u32x4*)(P.ws + WS_X1Q + (size_t)row * D + ln * 32), xl = *(const u32x4*)(P.ws + WS_X1Q + (size_t)row * D + ln * 32 + 16);
        const float sx = SX[row];
        const int e_lo = EIDX[(size_t)row * 128 + ln], e_hi = EIDX[(size_t)row * 128 + 64 + ln];
        const float g_lo = GW[(size_t)row * 128 + ln], g_hi = GW[(size_t)row * 128 + 64 + ln];
        const float a_lo = SU[e_lo] * sx, a_hi = SU[e_hi] * sx, b_lo = g_lo * SV[e_lo], b_hi = g_hi * SV[e_hi];
        float w_lo = 0.f, w_hi = 0.f;
        asm volatile("s_waitcnt vmcnt(0)" ::: "memory");
        dma_group(UQ, e_lo, e_hi, 0, wb, lane); dma_group(UQ, e_lo, e_hi, 1, wb + XGRP, lane); dma_group(UQ, e_lo, e_hi, 2, wb + 2 * XGRP, lane);
        int sg = 0;
#pragma unroll 1
        for (int g = 0; g < 32; ++g) {
            const int sn = (sg + 3) & 3;
            if (g + 3 < 32) dma_group(UQ, e_lo, e_hi, g + 3, wb + sn * XGRP, lane); else dma_group(VQ, e_lo, e_hi, g + 3 - 32, wb + sn * XGRP, lane);
            asm volatile("s_waitcnt vmcnt(24)" ::: "memory");
            u_consume(wb + sg * XGRP, xh, xl, a_lo, a_hi, b_lo, b_hi, g, lane, w_lo, w_hi);
            sg = (sg + 1) & 3;
        }
        float wmax = wave_max(fmaxf(fabsf(w_lo), fabsf(w_hi))); if (wmax == 0.f) wmax = 1.f;
        const float scale_w = wmax * (255.0f / 127.0f), inv_sw = 1.0f / scale_w;
        int acc[32]; int bias[2] = {0, 0};
#pragma unroll
        for (int i = 0; i < 32; ++i) acc[i] = 0;
#pragma unroll 1
        for (int g = 0; g < 32; ++g) {
            const int sn = (sg + 3) & 3;
            dma_group(VQ, e_lo, e_hi, (g + 3) & 31, wb + sn * XGRP, lane);
            asm volatile("s_waitcnt vmcnt(24)" ::: "memory");
            v_consume(wb + sg * XGRP, acc, bias, w_lo, w_hi, inv_sw, g, lane);
            sg = (sg + 1) & 3;
        }
        asm volatile("s_waitcnt vmcnt(0)" ::: "memory");
        exp_epilogue(P, row, ln, acc, bias, scale_w);
    }
    LAS int* cmax = (LAS int*)(lds + MISC_OFF + 64);
    __syncthreads();
    for (int ct = blockIdx.x; ct < NTOK_S; ct += gridDim.x) {
        const int row = NTOK_P + ct;
        int ln = lane; asm volatile("" : "+v"(ln));
        const u32x4 xh = *(const u32x4*)(P.ws + WS_X1Q + (size_t)row * D + ln * 32), xl = *(const u32x4*)(P.ws + WS_X1Q + (size_t)row * D + ln * 32 + 16);
        const float sx = SX[row];
        const int kk = 16 * wave + (ln & 15);
        const int e_loc = EIDX[(size_t)row * 128 + kk]; const float g_loc = GW[(size_t)row * 128 + kk];
        const float a_loc = SU[e_loc] * sx, b_loc = g_loc * SV[e_loc];
        float w_loc = 0.f, w_dummy = 0.f;
        asm volatile("s_waitcnt vmcnt(0)" ::: "memory");
#pragma unroll
        for (int g = 0; g < 4; ++g) dma_group(UQ, e_loc, e_loc, g, wb + g * XGRP, lane);
        asm volatile("s_waitcnt vmcnt(0)" ::: "memory");
#pragma unroll
        for (int g = 0; g < 4; ++g) u_consume(wb + g * XGRP, xh, xl, a_loc, a_loc, b_loc, b_loc, g, lane, w_loc, w_dummy);
#pragma unroll
        for (int g = 0; g < 4; ++g) dma_group(VQ, e_loc, e_loc, g, wb + g * XGRP, lane);
        const float wm = wave_max(ln < 16 ? fabsf(w_loc) : 0.f);
        if (lane == 0) cmax[wave] = __float_as_int(wm);
        __syncthreads();
        float wmax = 0.f;
#pragma unroll
        for (int ww = 0; ww < 8; ++ww) wmax = fmaxf(wmax, __int_as_float(cmax[ww]));
        if (wmax == 0.f) wmax = 1.f;
        const float scale_w = wmax * (255.0f / 127.0f), inv_sw = 1.0f / scale_w;
        int acc[32]; int bias[2] = {0, 0};
#pragma unroll
        for (int i = 0; i < 32; ++i) acc[i] = 0;
        asm volatile("s_waitcnt vmcnt(0)" ::: "memory");
#pragma unroll
        for (int g = 0; g < 4; ++g) v_consume(wb + g * XGRP, acc, bias, w_loc, w_loc, inv_sw, g, lane);
        __builtin_amdgcn_wave_barrier();
        {
            LAS int* pp = (LAS int*)wb + lane * 36;
#pragma unroll
            for (int i = 0; i < 8; ++i) *(LAS u32x4*)(pp + 4 * i) = (u32x4){(unsigned)acc[4 * i], (unsigned)acc[4 * i + 1], (unsigned)acc[4 * i + 2], (unsigned)acc[4 * i + 3]};
            pp[32] = bias[0]; pp[33] = bias[1];
        }
        __syncthreads();
        if (wave == 0) {
#pragma unroll
            for (int i = 0; i < 32; ++i) acc[i] = 0;
            bias[0] = 0; bias[1] = 0;
#pragma unroll 1
            for (int ww = 0; ww < 8; ++ww) {
                const LAS int* pp = (const LAS int*)(lds + ww * XWAVE) + lane * 36;
#pragma unroll
                for (int i = 0; i < 8; ++i) { const u32x4 t = *(const LAS u32x4*)(pp + 4 * i); acc[4 * i] += (int)t[0]; acc[4 * i + 1] += (int)t[1]; acc[4 * i + 2] += (int)t[2]; acc[4 * i + 3] += (int)t[3]; }
                bias[0] += pp[32]; bias[1] += pp[33];
            }
            exp_epilogue(P, row, ln, acc, bias, scale_w);
        }
        __syncthreads();
    }
}

constexpr int NPHASE = 11;
__global__ void __launch_bounds__(NTHREADS, 2) fwd(Params P) {
    extern __shared__ __attribute__((aligned(16))) unsigned char lds_raw[];
    LAS unsigned char* lds = (LAS unsigned char*)lds_raw;
    volatile LAS unsigned* misc = (volatile LAS unsigned*)(lds + MISC_OFF);
    const int lo = P.ph_lo, hi = P.ph_hi;
    XcdBarrier bar; bar.bar = (unsigned*)(P.ws + WS_CTL); bar.x = 0; bar.st = nullptr;
    if (hi - lo > 1) {
        if (threadIdx.x == 0) { misc[0] = 0u; misc[1] = 0u; misc[2] = 0u; misc[3] = 0u; }
        __syncthreads();
        bar = xcd_barrier_post((unsigned*)(P.ws + WS_CTL), misc);
    }
#ifndef MK_REPMASK
#define MK_REPMASK 0
#endif
#ifndef MK_PHASE_MASK
#define MK_PHASE_MASK 0x7ff
#endif
#define IN(k) (((MK_PHASE_MASK >> (k)) & 1) && lo <= (k) && (k) < hi)
#define SEAM(k) do { if (IN(k) && IN((k) + 1)) xcd_barrier(bar); } while (0)
    if (IN(0)) { phase_prologue(P, lds); }
    SEAM(0);
    if (IN(1)) {
        pg8::Gemm g{(const pg8::bf16_t*)(P.ws + WS_XB), (const pg8::bf16_t*)(P.ws + WS_WINT), NTOK, DIN, D};
        pg8::StaticOrder S; S.init(NTOK, DIN, (int)gridDim.x, (int)blockIdx.x);
        EpiProj E{P.out, (bf16_t*)(P.ws + WS_XR), (bf16_t*)(P.ws + WS_GATE), (bf16_t*)(P.ws + WS_QB), (bf16_t*)(P.ws + WS_KB), (bf16_t*)(P.ws + WS_VB16)};
        pg8::gemm_phase<EpiProj, pg8::StaticOrder, false>(lds, g, S, E, nullptr);
    }
    SEAM(1);
    if (IN(2)) { phase_lru(P, lds); }
    if (IN(3)) { phase_samp(P, lds); }
    if (IN(4)) { phase_attn01(P, lds); }
    SEAM(4);
    if (IN(5)) { phase_mix_b(P, lds); }
    SEAM(5);
    if (IN(6)) {
        sample_rows_gemm<0>(P, (const bf16_t*)(P.ws + WS_AR), (const bf16_t*)(P.ws + WS_WOT), lds);
        pg8::Gemm g{(const pg8::bf16_t*)(P.ws + WS_AR), (const pg8::bf16_t*)(P.ws + WS_WOT), NTOK_P, D, D};
        pg8::StaticOrder S; S.init(NTOK_P, D, (int)gridDim.x, (int)blockIdx.x);
        EpiOut E{(const bf16_t*)(P.ws + WS_XB), (bf16_t*)(P.ws + WS_PRE1)};
        pg8::gemm_phase<EpiOut, pg8::StaticOrder, false>(lds, g, S, E, nullptr);
    }
    SEAM(6);
    if (IN(7)) { phase_ln1(P); }
    SEAM(7);
    if (IN(8)) {
        sample_rows_gemm<1>(P, (const bf16_t*)(P.ws + WS_X1B), (const bf16_t*)(P.ws + WS_WQT), lds);
        pg8::Gemm g{(const pg8::bf16_t*)(P.ws + WS_X1B), (const pg8::bf16_t*)(P.ws + WS_WQT), NTOK_P, D, D};
        pg8::StaticOrder S; S.init(NTOK_P, D, (int)gridDim.x, (int)blockIdx.x);
        EpiBf16Plain E{(bf16_t*)(P.ws + WS_QP), D};
        pg8::gemm_phase<EpiBf16Plain, pg8::StaticOrder, false>(lds, g, S, E, nullptr);
    }
    SEAM(8);
    if (IN(9)) { phase_route(P, lds); }
    SEAM(9);
    if (IN(10)) { phase_experts(P, lds); }
#undef IN
#undef SEAM
}
}

extern "C" void kernel_launch(void* const* d_in, const int* in_sizes, int n_in, void* d_out, int out_size, void* d_ws, size_t ws_size, hipStream_t stream) {
    using namespace mk;
    static int grid = 0;
    if (grid == 0) {
        if (n_in != 23 || (size_t)out_size != O_END || ws_size < WS_END) { fprintf(stderr, "kernel_launch: unexpected shapes: n_in %d out %d ws %zu (need %zu)\n", n_in, out_size, ws_size, (size_t)WS_END); grid = -1; return; }
        int dev = 0, cus = 0, per_cu = 0;
        if (hipGetDevice(&dev) != hipSuccess || hipDeviceGetAttribute(&cus, hipDeviceAttributeMultiprocessorCount, dev) != hipSuccess) { grid = -1; return; }
        if (hipFuncSetAttribute((const void*)fwd, hipFuncAttributeMaxDynamicSharedMemorySize, LDS_BYTES) != hipSuccess) { fprintf(stderr, "kernel_launch: hipFuncSetAttribute failed\n"); grid = -1; return; }
        if (hipOccupancyMaxActiveBlocksPerMultiprocessor(&per_cu, (const void*)fwd, NTHREADS, LDS_BYTES) != hipSuccess || per_cu < 1) { fprintf(stderr, "kernel_launch: occupancy query says %d\n", per_cu); }
        (void)hipGetLastError();
        grid = cus;
    }
    if (grid < 0) return;
    (void)hipMemsetAsync((char*)d_ws + WS_CTL, 0, 65536, stream);
    Params p{};
    p.x_prompt = (const float*)d_in[0]; p.x_sample = (const float*)d_in[1]; p.cache_k = (const float*)d_in[2]; p.cache_v = (const float*)d_in[3];
    p.state_conv = (const float*)d_in[4]; p.state_h = (const float*)d_in[5]; p.w_in = (const float*)d_in[6]; p.conv_w = (const float*)d_in[7]; p.conv_b = (const float*)d_in[8];
    p.lru_w_a = (const float*)d_in[9]; p.lru_b_a = (const float*)d_in[10]; p.lru_w_x = (const float*)d_in[11]; p.lru_b_x = (const float*)d_in[12]; p.lru_lambda = (const float*)d_in[13];
    p.w_out = (const float*)d_in[14]; p.ln1_g = (const float*)d_in[15]; p.ln1_b = (const float*)d_in[16]; p.w_query = (const float*)d_in[17]; p.sub_keys = (const float*)d_in[18];
    p.peer_u = (const float*)d_in[19]; p.peer_v = (const float*)d_in[20]; p.ln2_g = (const float*)d_in[21]; p.ln2_b = (const float*)d_in[22];
    p.out = (float*)d_out; p.ws = (unsigned char*)d_ws;
#if MK_N_LAUNCHES == 1
    p.ph_lo = 0; p.ph_hi = NPHASE;
    hipLaunchKernelGGL(fwd, dim3(grid), dim3(NTHREADS), LDS_BYTES, stream, p);
#else
    for (int k = 0; k < NPHASE; ++k) { p.ph_lo = k; p.ph_hi = k + 1; hipLaunchKernelGGL(fwd, dim3(grid), dim3(NTHREADS), LDS_BYTES, stream, p);
#ifdef MK_EXTRA_PHASE
        if (k == MK_EXTRA_PHASE) hipLaunchKernelGGL(fwd, dim3(grid), dim3(NTHREADS), LDS_BYTES, stream, p);
#endif
    }
#endif
    const hipError_t le = hipPeekAtLastError();
    if (le != hipSuccess) fprintf(stderr, "kernel_launch: launch failed: %s\n", hipGetErrorName(le));
}
```

```cpp
#include <hip/hip_runtime.h>
#include <cstdio>
#include <cstdint>
namespace pg8 {
#define PG8_LAS __attribute__((address_space(3)))
typedef unsigned short bf16_t;
typedef short bf16x8 __attribute__((ext_vector_type(8)));
typedef float f32x4 __attribute__((ext_vector_type(4)));
typedef unsigned u32x4 __attribute__((ext_vector_type(4)));
constexpr int BM = 256, BK = 64, HALF = 128, HTB = HALF * BK * 2  , STAGE_BYTES = 8 * HTB, NXCD = 8, WGM = 8;

__host__ __device__ __forceinline__ int lds_byte(int r, int c) { const int st = (r >> 4) * 2 + (c >> 5), rr = r & 15, cc = c & 31, ob = rr * 64 + cc * 2; return st * 1024 + (ob ^ (((ob >> 9) & 1) << 5)); }
__host__ __device__ __forceinline__ void stage_rc(int b, int& R, int& C) { const int st = b / 1024, sb = b % 1024, swz = sb ^ (((sb >> 9) & 1) << 5); R = (st >> 1) * 16 + swz / 64; C = (st & 1) * 32 + (swz % 64) / 2; }
__host__ __device__ __forceinline__ int perm32(int rho) { const int n = rho >> 4, i = rho & 15; return 8 * (i >> 2) + 4 * n + (i & 3); }

struct Unit { int pm, pn; };
struct Gemm { const bf16_t* A; const bf16_t* Bt; int M, N, K; };

struct StaticOrder {
    int nM, nN, nwg, G, c;
    __host__ __device__ void init(int M, int N, int G_, int c_) { nM = M / BM; nN = N / BM; nwg = nM * nN; G = G_; c = c_; }
    __host__ __device__ bool next(int i, Unit& u) const {
        const long L = (long)i * G + c; if (L >= nwg) return false;
        int wgid = (int)L; { const int q = nwg / NXCD, r = nwg % NXCD, xcd = wgid % NXCD, off = wgid / NXCD; wgid = (xcd < r ? xcd * (q + 1) : r * (q + 1) + (xcd - r) * q) + off; }
        const int nig = WGM * nN, gid = wgid / nig, fm = gid * WGM, gsz = (nM - fm) < WGM ? (nM - fm) : WGM;
        u.pm = fm + ((wgid % nig) % gsz); u.pn = (wgid % nig) / gsz; return true;
    }
    __device__ __forceinline__ void a_ready(const Unit&) const {}
    __device__ __forceinline__ void done(const Unit&) const {}
};
struct CountedOrder : StaticOrder {
    const unsigned* ready; unsigned need; unsigned* tmo;
    __device__ __forceinline__ void a_ready(const Unit& u) const {
        if (threadIdx.x < 64) {
            const unsigned long long t0 = __builtin_amdgcn_s_memrealtime(); unsigned polls = 0;
            while ((unsigned)__builtin_amdgcn_readfirstlane(__hip_atomic_load(ready + 64 * u.pm, __ATOMIC_RELAXED, __HIP_MEMORY_SCOPE_AGENT)) < need) {
                if ((++polls & 255u) == 0u && __builtin_amdgcn_readfirstlane(__hip_atomic_load(tmo, __ATOMIC_RELAXED, __HIP_MEMORY_SCOPE_AGENT)) != 0u) break;
                if (__builtin_amdgcn_s_memrealtime() - t0 > 2000000ull) {
                    if (threadIdx.x == 0) { unsigned expect = 0u; __hip_atomic_compare_exchange_strong(tmo + 1, &expect, 0x600u | (unsigned)(u.pm & 0xff), __ATOMIC_RELAXED, __ATOMIC_RELAXED, __HIP_MEMORY_SCOPE_AGENT); __hip_atomic_store(tmo, 1u, __ATOMIC_RELAXED, __HIP_MEMORY_SCOPE_AGENT); }
                    break; }
                __builtin_amdgcn_s_sleep(2); }
            __builtin_amdgcn_fence(__ATOMIC_ACQUIRE, "agent");
            asm volatile("s_waitcnt vmcnt(0)" ::: "memory");
        }
#if !defined(BROKEN_HOOK_NO_BARRIER)
        asm volatile("" ::: "memory"); __builtin_amdgcn_s_barrier(); asm volatile("" ::: "memory");
#endif
    }
};

__device__ __forceinline__ unsigned cvt_pk_bf16(float lo, float hi) { unsigned r; asm volatile("v_cvt_pk_bf16_f32 %0, %1, %2" : "=v"(r) : "v"(lo), "v"(hi)); return r; }
typedef float f32x2 __attribute__((ext_vector_type(2)));
__device__ __forceinline__ f32x2 gelu_pk(f32x2 v) {
    const f32x2 av = __builtin_elementwise_abs(v), d = av * 0.2316418882f + 1.0f;
    f32x2 t; t.x = __builtin_amdgcn_rcpf(d.x); t.y = __builtin_amdgcn_rcpf(d.y);
    f32x2 q = t * 0.5307027145f + (-0.7265760135f); q = q * t + 0.7107068705f; q = q * t + (-0.142248368f); q = q * t + 0.127414796f; q = q * t;
    const f32x2 s = (v * v) * (-0.72134752044f);
    f32x2 e; e.x = __builtin_amdgcn_exp2f(s.x); e.y = __builtin_amdgcn_exp2f(s.y);
    const f32x2 m = v * (q * e), r = v - m;
    f32x2 o; o.x = v.x < 0.f ? m.x : r.x; o.y = v.y < 0.f ? m.y : r.y; return o;
}

struct EpiF32 {
    static constexpr bool PERM = false, AFTER_DRAIN = false;
    float* C; int ldc; const float* bias;
    __device__ __forceinline__ void operator()(const f32x4 (&acc)[2][2][4][2], const Unit& u, int wr, int wc, int fr, int fq) const {
        const int row0 = u.pm * BM + wr * 64 + fr, col0 = u.pn * BM + wc * 32 + 4 * fq;
        f32x4 bv[2][2];
#pragma unroll
        for (int bj = 0; bj < 2; ++bj)
#pragma unroll
            for (int n = 0; n < 2; ++n) bv[bj][n] = bias ? *(const f32x4*)(bias + col0 + bj * HALF + n * 16) : (f32x4){0.f, 0.f, 0.f, 0.f};
#pragma unroll
        for (int ai = 0; ai < 2; ++ai)
#pragma unroll
            for (int m = 0; m < 4; ++m) { float* rowp = C + (size_t)(row0 + ai * HALF + m * 16) * ldc + col0;
#pragma unroll
                for (int bj = 0; bj < 2; ++bj)
#pragma unroll
                    for (int n = 0; n < 2; ++n) *(f32x4*)(rowp + bj * HALF + n * 16) = acc[ai][bj][m][n] + bv[bj][n]; }
    }
};
template <int ACT  > struct EpiBf16 {
    static constexpr bool PERM = true, AFTER_DRAIN = false;
    bf16_t* O; int ldc; const float* bias; int split_cols; size_t split_stride;
    __device__ __forceinline__ void operator()(const f32x4 (&acc)[2][2][4][2], const Unit& u, int wr, int wc, int fr, int fq) const {
        const int row0 = u.pm * BM + wr * 64 + fr; int colt = u.pn * BM; bf16_t* base = O;
        if (split_cols) { const int t = colt / split_cols; base += (size_t)t * split_stride; colt -= t * split_cols; }
        const int col0 = colt + wc * 32 + 8 * fq, bcol0 = u.pn * BM + wc * 32 + 8 * fq;
        f32x4 bv[2][2];
#pragma unroll
        for (int bj = 0; bj < 2; ++bj)
#pragma unroll
            for (int n = 0; n < 2; ++n) bv[bj][n] = bias ? *(const f32x4*)(bias + bcol0 + bj * HALF + 4 * n) : (f32x4){0.f, 0.f, 0.f, 0.f};
#pragma unroll
        for (int ai = 0; ai < 2; ++ai)
#pragma unroll
            for (int m = 0; m < 4; ++m) { bf16_t* rowp = base + (size_t)(row0 + ai * HALF + m * 16) * ldc + col0;
#pragma unroll
                for (int bj = 0; bj < 2; ++bj) { f32x4 v0 = acc[ai][bj][m][0] + bv[bj][0], v1 = acc[ai][bj][m][1] + bv[bj][1];
                    if (ACT == 1) { f32x2 a = gelu_pk((f32x2){v0[0], v0[1]}), b = gelu_pk((f32x2){v0[2], v0[3]}), c = gelu_pk((f32x2){v1[0], v1[1]}), d = gelu_pk((f32x2){v1[2], v1[3]});
                        v0 = (f32x4){a.x, a.y, b.x, b.y}; v1 = (f32x4){c.x, c.y, d.x, d.y}; }
                    if (ACT == 2) {
#pragma unroll
                        for (int j = 0; j < 4; ++j) { v0[j] = 0.5f * v0[j] * (1.0f + erff(v0[j] * 0.70710678f)); v1[j] = 0.5f * v1[j] * (1.0f + erff(v1[j] * 0.70710678f)); } }
                    u32x4 w; w.x = cvt_pk_bf16(v0[0], v0[1]); w.y = cvt_pk_bf16(v0[2], v0[3]); w.z = cvt_pk_bf16(v1[0], v1[1]); w.w = cvt_pk_bf16(v1[2], v1[3]);
                    *(u32x4*)(rowp + bj * HALF) = w; } }
    }
};

struct PanelStats {
    unsigned* xbuf;
    unsigned* cnt;
    unsigned* tmo;
    int ntn; float eps;
    unsigned code;
    __device__ __forceinline__ bool run(const f32x4 (&v)[2][2][4][2], const Unit& u, int wr, int wc, int fr, int fq, PG8_LAS unsigned char* lds, int wid, int lane) const {
        typedef float f32x2v __attribute__((ext_vector_type(2)));
        PG8_LAS f32x2v* P = (PG8_LAS f32x2v*)lds;
        PG8_LAS f32x2v* S = (PG8_LAS f32x2v*)(lds + 8192);
        PG8_LAS unsigned* flag = (PG8_LAS unsigned*)(lds + 8192 + 2048);
#pragma unroll
        for (int ai = 0; ai < 2; ++ai)
#pragma unroll
            for (int m = 0; m < 4; ++m) {
                float s = 0.f;
#pragma unroll
                for (int bj = 0; bj < 2; ++bj)
#pragma unroll
                    for (int n = 0; n < 2; ++n) { const f32x4 x = v[ai][bj][m][n]; s += (x[0] + x[1]) + (x[2] + x[3]); }
                s += __shfl_xor(s, 16); s += __shfl_xor(s, 32);
                const float mw = s * (1.0f / 64.0f); float q = 0.f;
#pragma unroll
                for (int bj = 0; bj < 2; ++bj)
#pragma unroll
                    for (int n = 0; n < 2; ++n) { const f32x4 d = v[ai][bj][m][n] - mw; q += (d[0] * d[0] + d[1] * d[1]) + (d[2] * d[2] + d[3] * d[3]); }
                q += __shfl_xor(q, 16); q += __shfl_xor(q, 32);
                if (fq == 0) P[(ai * HALF + wr * 64 + m * 16 + fr) * 4 + wc] = (f32x2v){mw, q};
            }
        asm volatile("s_waitcnt lgkmcnt(0)" ::: "memory"); __builtin_amdgcn_s_barrier(); asm volatile("" ::: "memory");
#if defined(BROKEN_NO_WAIT)
        if (blockIdx.x >= 64) { const long long t0 = clock64(); while (clock64() - t0 < 60000) __builtin_amdgcn_s_sleep(8); }
#endif
        const int row = wid * 32 + (lane & 31);
        if (lane < 32) {
            const f32x2v a = P[row * 4 + 0], b = P[row * 4 + 1], c = P[row * 4 + 2], d = P[row * 4 + 3];
            const float mt = (a.x + b.x + c.x + d.x) * 0.25f;
            const float da = a.x - mt, db = b.x - mt, dc = c.x - mt, dd = d.x - mt;
            const float m2 = (a.y + b.y) + (c.y + d.y) + 64.0f * ((da * da + db * db) + (dc * dc + dd * dd));
            unsigned long long* slot = (unsigned long long*)xbuf + ((size_t)(u.pm * BM + row) * 4 + u.pn);
            __hip_atomic_store(slot, ((unsigned long long)__float_as_uint(m2) << 32) | __float_as_uint(mt), __ATOMIC_RELAXED, __HIP_MEMORY_SCOPE_AGENT);
        }
        asm volatile("s_waitcnt vmcnt(0)" ::: "memory");
        if (lane == 0) __hip_atomic_fetch_add(cnt + 64 * u.pm, 1u, __ATOMIC_RELAXED, __HIP_MEMORY_SCOPE_AGENT);
        if (wid == 0) {
            bool dead = false; const unsigned long long t0 = __builtin_amdgcn_s_memrealtime(); const unsigned want = 8u * (unsigned)ntn;
            for (;;) {
#if defined(BROKEN_NO_WAIT)
                break;
#endif
                if ((unsigned)__builtin_amdgcn_readfirstlane(__hip_atomic_load(cnt + 64 * u.pm, __ATOMIC_RELAXED, __HIP_MEMORY_SCOPE_AGENT)) >= want) break;
                if (__builtin_amdgcn_s_memrealtime() - t0 > 2000000ull) {
                    if (lane == 0) { unsigned expect = 0u; __hip_atomic_compare_exchange_strong(tmo + 1, &expect, code | (unsigned)(u.pm & 0xff), __ATOMIC_RELAXED, __ATOMIC_RELAXED, __HIP_MEMORY_SCOPE_AGENT);
                                     __hip_atomic_store(tmo, 1u, __ATOMIC_RELAXED, __HIP_MEMORY_SCOPE_AGENT); }
                    dead = true; break; }
                __builtin_amdgcn_s_sleep(2);
            }
            __builtin_amdgcn_fence(__ATOMIC_ACQUIRE, "agent");
            if (lane == 0) flag[0] = dead ? 1u : 0u;
        }
        asm volatile("s_waitcnt vmcnt(0) lgkmcnt(0)" ::: "memory"); __builtin_amdgcn_s_barrier(); asm volatile("" ::: "memory");
        const bool bad = flag[0] != 0u;
        if (lane < 32) {
            const unsigned long long* slot = (const unsigned long long*)xbuf + (size_t)(u.pm * BM + row) * 4; float mt[4], m2[4]; float ms = 0.f;
#pragma unroll
            for (int t = 0; t < 4; ++t) { if (t < ntn) { const unsigned long long w = __hip_atomic_load(slot + t, __ATOMIC_RELAXED, __HIP_MEMORY_SCOPE_AGENT); mt[t] = __uint_as_float((unsigned)w); m2[t] = __uint_as_float((unsigned)(w >> 32)); } else { mt[t] = 0.f; m2[t] = 0.f; } ms += mt[t]; }
            const float mean = ms / (float)ntn; float q = 0.f;
#pragma unroll
            for (int t = 0; t < 4; ++t) if (t < ntn) { const float dm = mt[t] - mean; q += m2[t] + 256.0f * dm * dm; }
            S[row] = (f32x2v){mean, 1.0f / sqrtf(q / (256.0f * (float)ntn) + eps)};
        }
        asm volatile("s_waitcnt lgkmcnt(0)" ::: "memory"); __builtin_amdgcn_s_barrier(); asm volatile("" ::: "memory");
        return bad;
    }
};
struct EpiLnRes {
    static constexpr bool PERM = false, AFTER_DRAIN = true;
    const float* base; float* out; int ldc; const float* bias; PanelStats st; unsigned poison;
    __device__ __forceinline__ void refuse(size_t i0, size_t stride, int M, int N) const { const float q = __builtin_nanf(""); for (size_t i = i0; i < (size_t)M * N; i += stride) out[(i / N) * ldc + i % N] = q;
        if (i0 == 0) { unsigned expect = 0u; __hip_atomic_compare_exchange_strong(st.tmo + 1, &expect, 0x7f0u, __ATOMIC_RELAXED, __ATOMIC_RELAXED, __HIP_MEMORY_SCOPE_AGENT); __hip_atomic_store(st.tmo, 1u, __ATOMIC_RELAXED, __HIP_MEMORY_SCOPE_AGENT); } }
    __device__ __forceinline__ void fused(f32x4 (&acc)[2][2][4][2], const Unit& u, int wr, int wc, int fr, int fq, PG8_LAS unsigned char* lds, int wid, int lane) const {
        typedef float f32x2v __attribute__((ext_vector_type(2)));
        const PG8_LAS f32x2v* S = (const PG8_LAS f32x2v*)(lds + 8192);
        const int col0 = u.pn * BM + wc * 32 + 4 * fq;
#pragma unroll
        for (int bj = 0; bj < 2; ++bj)
#pragma unroll
            for (int n = 0; n < 2; ++n) { const f32x4 bv = bias ? *(const f32x4*)(bias + col0 + bj * HALF + n * 16) : (f32x4){0.f, 0.f, 0.f, 0.f};
#pragma unroll
                for (int ai = 0; ai < 2; ++ai)
#pragma unroll
                    for (int m = 0; m < 4; ++m) acc[ai][bj][m][n] += bv; }
        const bool bad = st.run(acc, u, wr, wc, fr, fq, lds, wid, lane) || poison != 0u;
        const float qnan = __builtin_nanf("");
#pragma unroll
        for (int ai = 0; ai < 2; ++ai)
#pragma unroll
            for (int m = 0; m < 4; ++m) { const int r = ai * HALF + wr * 64 + m * 16 + fr; const f32x2v sr = S[r]; const size_t off = (size_t)(u.pm * BM + r) * ldc + col0;
#pragma unroll
                for (int bj = 0; bj < 2; ++bj)
#pragma unroll
                    for (int n = 0; n < 2; ++n) { const f32x4 bs = *(const f32x4*)(base + off + bj * HALF + n * 16); f32x4 o = bs + (acc[ai][bj][m][n] - sr.x) * sr.y;
                        if (bad) o = (f32x4){qnan, qnan, qnan, qnan}; *(f32x4*)(out + off + bj * HALF + n * 16) = o; }
                asm volatile("" ::: "memory"); }
    }
};
struct EpiLnResLn {
    static constexpr bool PERM = false, AFTER_DRAIN = true;
    const float* base; float* out; bf16_t* xn; int ldc; const float* bias; PanelStats st1, st2; unsigned poison;
    __device__ __forceinline__ void refuse(size_t i0, size_t stride, int M, int N) const { const float q = __builtin_nanf(""); for (size_t i = i0; i < (size_t)M * N; i += stride) { const size_t o = (i / N) * ldc + i % N; out[o] = q; xn[o] = (bf16_t)0x7fc0u; }
        if (i0 == 0) { unsigned expect = 0u; __hip_atomic_compare_exchange_strong(st1.tmo + 1, &expect, 0x7f0u, __ATOMIC_RELAXED, __ATOMIC_RELAXED, __HIP_MEMORY_SCOPE_AGENT); __hip_atomic_store(st1.tmo, 1u, __ATOMIC_RELAXED, __HIP_MEMORY_SCOPE_AGENT); } }
    __device__ __forceinline__ void fused(f32x4 (&acc)[2][2][4][2], const Unit& u, int wr, int wc, int fr, int fq, PG8_LAS unsigned char* lds, int wid, int lane) const {
        typedef float f32x2v __attribute__((ext_vector_type(2))); typedef unsigned u32x2v __attribute__((ext_vector_type(2)));
        const PG8_LAS f32x2v* S = (const PG8_LAS f32x2v*)(lds + 8192);
        const int col0 = u.pn * BM + wc * 32 + 4 * fq;
#pragma unroll
        for (int bj = 0; bj < 2; ++bj)
#pragma unroll
            for (int n = 0; n < 2; ++n) { const f32x4 bv = bias ? *(const f32x4*)(bias + col0 + bj * HALF + n * 16) : (f32x4){0.f, 0.f, 0.f, 0.f};
#pragma unroll
                for (int ai = 0; ai < 2; ++ai)
#pragma unroll
                    for (int m = 0; m < 4; ++m) acc[ai][bj][m][n] += bv; }
        bool bad = st1.run(acc, u, wr, wc, fr, fq, lds, wid, lane) || poison != 0u;
        const float qnan = __builtin_nanf("");
#pragma unroll
        for (int ai = 0; ai < 2; ++ai)
#pragma unroll
            for (int m = 0; m < 4; ++m) { const int r = ai * HALF + wr * 64 + m * 16 + fr; const f32x2v sr = S[r]; const size_t off = (size_t)(u.pm * BM + r) * ldc + col0;
#pragma unroll
                for (int bj = 0; bj < 2; ++bj)
#pragma unroll
                    for (int n = 0; n < 2; ++n) { const f32x4 bs = *(const f32x4*)(base + off + bj * HALF + n * 16); acc[ai][bj][m][n] = bs + (acc[ai][bj][m][n] - sr.x) * sr.y; }
                asm volatile("" : "+v"(acc[ai][0][m][0]), "+v"(acc[ai][0][m][1]), "+v"(acc[ai][1][m][0]), "+v"(acc[ai][1][m][1]));
                if (m & 1) asm volatile("" ::: "memory"); }
        const bool bad1 = bad;
        bad = st2.run(acc, u, wr, wc, fr, fq, lds, wid, lane) || bad;
#pragma unroll
        for (int ai = 0; ai < 2; ++ai)
#pragma unroll
            for (int m = 0; m < 4; ++m) { const int r = ai * HALF + wr * 64 + m * 16 + fr; const f32x2v sr = S[r]; const size_t off = (size_t)(u.pm * BM + r) * ldc + col0;
#pragma unroll
                for (int bj = 0; bj < 2; ++bj)
#pragma unroll
                    for (int n = 0; n < 2; ++n) { const f32x4 x1 = acc[ai][bj][m][n]; *(f32x4*)(out + off + bj * HALF + n * 16) = bad1 ? (f32x4){qnan, qnan, qnan, qnan} : x1;
                        const f32x4 o = (x1 - sr.x) * sr.y; u32x2v w; w.x = cvt_pk_bf16(o[0], o[1]); w.y = cvt_pk_bf16(o[2], o[3]);
                        if (bad) { w.x = 0x7fc07fc0u; w.y = 0x7fc07fc0u; } *(u32x2v*)(xn + off + bj * HALF + n * 16) = w; }
                asm volatile("" ::: "memory"); }
    }
};

template <class Epi, class Sched, bool STAMP = false>
__device__ __forceinline__ void gemm_phase(PG8_LAS unsigned char* lds, const Gemm g, const Sched& S, const Epi& E, unsigned long long* stamps) {
    const int tid = threadIdx.x, wid = __builtin_amdgcn_readfirstlane(tid >> 6), lane = tid & 63, wr = wid >> 2, wc = wid & 3, fr = lane & 15, fq = lane >> 4;
    const int K = g.K, nt = K / BK;
    int ts_lo = 0, ts_hi = 0, nts = 0; const unsigned long long rt_entry = STAMP ? (unsigned long long)wall_clock64() : 0ull;
#define PG8_STAMP() do { if (STAMP && wid == 0 && nts < 64) { const unsigned long long _c = (unsigned long long)clock64(); \
        ts_lo = (lane == nts) ? (int)(unsigned)_c : ts_lo; ts_hi = (lane == nts) ? (int)(unsigned)(_c >> 32) : ts_hi; ++nts; } } while (0)
    PG8_STAMP();
    unsigned voffA[2], voffB[2];
#pragma unroll
    for (int i = 0; i < 2; ++i) { int R, C; stage_rc(tid * 16 + i * 8192, R, C); const int Rb = Epi::PERM ? ((R & ~31) + perm32(R & 31)) : R;
        voffA[i] = (unsigned)(R * K + C) * 2u; voffB[i] = (unsigned)(Rb * K + C) * 2u; }
    const size_t kstep = (size_t)(BK * 2);
    const size_t hstep = (size_t)HALF * K * 2;
    const size_t tstep = 2 * hstep;
    const unsigned ldsw = (unsigned)wid * 1024u;
    const int aoff = lds_byte(wr * 64 + fr, fq * 8), boff = lds_byte(wc * 32 + fr, fq * 8);
#define PG8_SA(b, h) (((b) * 2 + (h)) * HTB)
#define PG8_SB(b, h) ((4 + (b) * 2 + (h)) * HTB)
#define PG8_STAGE(bufoff, gbase, voff) do { _Pragma("unroll") for (int _i = 0; _i < 2; ++_i) \
        __builtin_amdgcn_global_load_lds((const unsigned*)((const char*)(gbase) + (voff)[_i]), (PG8_LAS unsigned*)(lds + (bufoff) + ldsw + _i * 8192), 16, 0, 0); } while (0)
#define PG8_LDA(dst, b, h) do { _Pragma("unroll") for (int m = 0; m < 4; ++m) _Pragma("unroll") for (int k = 0; k < 2; ++k) dst[m][k] = *(const PG8_LAS bf16x8*)(lds + PG8_SA(b, h) + aoff + m * 2048 + k * 1024); } while (0)
#define PG8_LDB(dst, b, h) do { _Pragma("unroll") for (int n = 0; n < 2; ++n) _Pragma("unroll") for (int k = 0; k < 2; ++k) dst[n][k] = *(const PG8_LAS bf16x8*)(lds + PG8_SB(b, h) + boff + n * 2048 + k * 1024); } while (0)
#define PG8_MMA(ai, bj, At, Bt) do { __builtin_amdgcn_s_setprio(1); _Pragma("unroll") for (int m = 0; m < 4; ++m) _Pragma("unroll") for (int n = 0; n < 2; ++n) _Pragma("unroll") for (int k = 0; k < 2; ++k) \
        acc[ai][bj][m][n] = __builtin_amdgcn_mfma_f32_16x16x32_bf16(Bt[n][k], At[m][k], acc[ai][bj][m][n], 0, 0, 0); __builtin_amdgcn_s_setprio(0); } while (0)
#define PG8_WAIT_V(n) asm volatile("s_waitcnt vmcnt(" #n ")" ::: "memory")
#define PG8_WAIT_L(n) asm volatile("s_waitcnt lgkmcnt(" #n ")" ::: "memory")
#define PG8_BAR __builtin_amdgcn_s_barrier()
#define PG8_SCHED __builtin_amdgcn_sched_barrier(0)
    Unit cur, nxt; int ui = 0;
    if (!S.next(0, cur)) return;
    f32x4 acc[2][2][4][2];
#pragma unroll
    for (int a = 0; a < 2; ++a)
#pragma unroll
        for (int b = 0; b < 2; ++b)
#pragma unroll
            for (int m = 0; m < 4; ++m)
#pragma unroll
                for (int n = 0; n < 2; ++n) acc[a][b][m][n] = (f32x4){0.f, 0.f, 0.f, 0.f};
    bf16x8 At[4][2], B0[2][2], B1[2][2];
    const char* cA = (const char*)g.A + (size_t)cur.pm * tstep; const char* cB = (const char*)g.Bt + (size_t)cur.pn * tstep;
    S.a_ready(cur);
    PG8_STAGE(PG8_SB(0, 0), cB, voffB); PG8_STAGE(PG8_SA(0, 0), cA, voffA); PG8_STAGE(PG8_SB(0, 1), cB + hstep, voffB); PG8_STAGE(PG8_SA(0, 1), cA + hstep, voffA);
    if (wr == 1) PG8_BAR;
    PG8_WAIT_V(4); PG8_BAR;
    PG8_STAGE(PG8_SB(1, 0), cB + kstep, voffB); PG8_STAGE(PG8_SA(1, 0), cA + kstep, voffA); PG8_STAGE(PG8_SB(1, 1), cB + hstep + kstep, voffB);
    PG8_WAIT_V(6); PG8_BAR;
    PG8_STAMP();
    for (;;) {
        const bool has_next = S.next(ui + 1, nxt);
        const char* nA = has_next ? (const char*)g.A + (size_t)nxt.pm * tstep : cA; const char* nB = has_next ? (const char*)g.Bt + (size_t)nxt.pn * tstep : cB;
        for (int t = 0; t < nt; t += 2) {
            const bool last = (t == nt - 2);
            const char* a1 = cA + (size_t)(t + 1) * kstep;
            const char* a2 = last ? nA : cA + (size_t)(t + 2) * kstep; const char* b2 = last ? nB : cB + (size_t)(t + 2) * kstep;
            const char* a3 = a2 + kstep; const char* b3 = b2 + kstep;
            if (last && has_next) S.a_ready(nxt);
            PG8_LDB(B0, 0, 0); PG8_SCHED; PG8_LDA(At, 0, 0); PG8_STAGE(PG8_SA(1, 1), a1 + hstep, voffA);
            PG8_WAIT_L(8); PG8_BAR; PG8_WAIT_L(0); PG8_MMA(0, 0, At, B0); PG8_BAR; PG8_SCHED;
            PG8_LDB(B1, 0, 1); PG8_STAGE(PG8_SB(0, 0), b2, voffB);
            PG8_BAR; PG8_WAIT_L(0); PG8_MMA(0, 1, At, B1); PG8_BAR;
            PG8_LDA(At, 0, 1); PG8_STAGE(PG8_SA(0, 0), a2, voffA);
            PG8_BAR; PG8_WAIT_L(0); PG8_MMA(1, 0, At, B0); PG8_BAR; PG8_SCHED;
            PG8_STAGE(PG8_SB(0, 1), b2 + hstep, voffB);
            PG8_WAIT_V(6); PG8_BAR; PG8_MMA(1, 1, At, B1); PG8_BAR;
            PG8_LDB(B0, 1, 0); PG8_SCHED; PG8_LDA(At, 1, 0); PG8_STAGE(PG8_SA(0, 1), a2 + hstep, voffA);
            PG8_WAIT_L(8); PG8_BAR; PG8_WAIT_L(0); PG8_MMA(0, 0, At, B0); PG8_BAR; PG8_SCHED;
            PG8_LDB(B1, 1, 1); PG8_STAGE(PG8_SB(1, 0), b3, voffB);
            PG8_BAR; PG8_WAIT_L(0); PG8_MMA(0, 1, At, B1); PG8_BAR;
            PG8_LDA(At, 1, 1); PG8_STAGE(PG8_SA(1, 0), a3, voffA);
            PG8_BAR; PG8_WAIT_L(0); PG8_MMA(1, 0, At, B0); PG8_BAR; PG8_SCHED;
            PG8_STAGE(PG8_SB(1, 1), b3 + hstep, voffB);
            PG8_WAIT_V(6); PG8_BAR; PG8_MMA(1, 1, At, B1); PG8_BAR;
        }
        PG8_STAMP();
        if constexpr (!Epi::AFTER_DRAIN) { E(acc, cur, wr, wc, fr, fq); S.done(cur); }
        PG8_STAMP();
        if (!has_next) break;
#pragma unroll
        for (int a = 0; a < 2; ++a)
#pragma unroll
            for (int b = 0; b < 2; ++b)
#pragma unroll
                for (int m = 0; m < 4; ++m)
#pragma unroll
                    for (int n = 0; n < 2; ++n) acc[a][b][m][n] = (f32x4){0.f, 0.f, 0.f, 0.f};
        cur = nxt; cA = nA; cB = nB; ++ui;
    }
    PG8_WAIT_V(0);
    if (wr == 0) PG8_BAR;
    PG8_BAR;
    if constexpr (Epi::AFTER_DRAIN) { E.fused(acc, cur, wr, wc, fr, fq, lds, wid, lane); S.done(cur); }
    PG8_STAMP();
    if (STAMP && wid == 0) { stamps[lane] = lane < nts ? (((unsigned long long)(unsigned)ts_hi << 32) | (unsigned)ts_lo) : 0ull;
        if (lane == 62) stamps[62] = rt_entry; if (lane == 63) stamps[63] = (unsigned long long)wall_clock64(); }
#undef PG8_STAMP
#undef PG8_SA
#undef PG8_SB
#undef PG8_STAGE
#undef PG8_LDA
#undef PG8_LDB
#undef PG8_MMA
#undef PG8_WAIT_V
#undef PG8_WAIT_L
#undef PG8_BAR
#undef PG8_SCHED
}
}
#define XB_TMO      128
#define XB_XCNT(j)  (256  + 64 * (j))
#define XB_XSUB(j)  (1280 + 64 * (j))
#define XB_XGEN(j)  (2304 + 64 * (j))
#define XB_TOP      3328
#define XB_TOPGEN   3392
#define XCD_BAR_WORDS 3456
#define XB_SPIN_CAP (1u << 18)
#define LAS __attribute__((address_space(3)))

__device__ __forceinline__ unsigned xb_ld(unsigned* p)              { return __hip_atomic_load(p, __ATOMIC_RELAXED, __HIP_MEMORY_SCOPE_AGENT); }
__device__ __forceinline__ unsigned xb_add(unsigned* p, unsigned v) { return __hip_atomic_fetch_add(p, v, __ATOMIC_RELAXED, __HIP_MEMORY_SCOPE_AGENT); }
__device__ __forceinline__ unsigned xb_xcc_id() { return (unsigned)__builtin_amdgcn_s_getreg((3 << 11) | 20) & 0xFu; }
#define XB_SPIN(cond, bar) do { unsigned _sp = 0; while (cond) { __builtin_amdgcn_s_sleep(1); \
    if ((++_sp & 255u) == 0u) { if (xb_ld(&(bar)[XB_TMO])) break; if (_sp > XB_SPIN_CAP) { atomicAdd(&(bar)[XB_TMO], 1u); break; } } } } while (0)

struct XcdBarrier {
    unsigned* bar; unsigned x;
    volatile LAS unsigned* st;
};

__device__ __forceinline__ XcdBarrier xcd_barrier_post(unsigned* bar, volatile LAS unsigned* st) {
    XcdBarrier b; b.bar = bar; b.x = xb_xcc_id(); b.st = st;
    if (threadIdx.x == 0) (void)xb_add(&bar[XB_XCNT(b.x)], 1u);
    return b;
}
__device__ __forceinline__ void xcd_barrier_complete(unsigned* bar, unsigned x, unsigned& nloc, unsigned& nx) {
    const unsigned G = gridDim.x * gridDim.y * gridDim.z;
    unsigned sum, cnt, mine, sp = 0u;
    for (;;) {
        sum = 0u; cnt = 0u; mine = 0u;
#pragma unroll
        for (unsigned j = 0; j < 16; ++j) { const unsigned c = xb_ld(&bar[XB_XCNT(j)]); sum += c; cnt += (c > 0u) ? 1u : 0u; mine = (j == x) ? c : mine; }
        if (sum == G) break;
        __builtin_amdgcn_s_sleep(1);
        if ((++sp & 255u) == 0u) { if (xb_ld(&bar[XB_TMO])) break; if (sp > XB_SPIN_CAP) { atomicAdd(&bar[XB_TMO], 1u); break; } }
    }
    nloc = mine > 0u ? mine : 1u; nx = cnt > 0u ? cnt : 1u;
}

__device__ __forceinline__ void xcd_barrier(const XcdBarrier& b) {
    asm volatile("s_waitcnt vmcnt(0)" ::: "memory");
    __syncthreads();
    if (threadIdx.x == 0) {
        unsigned* bar = b.bar;
        __builtin_amdgcn_s_waitcnt(0);
        unsigned nloc = b.st[0], nx = b.st[1];
        if (nloc == 0u) { xcd_barrier_complete(bar, b.x, nloc, nx); b.st[0] = nloc; b.st[1] = nx; }
        const unsigned old = xb_add(&bar[XB_XSUB(b.x)], 1u);
        const unsigned gen = old / nloc;
        if (old + 1u == (gen + 1u) * nloc) {
            __builtin_amdgcn_fence(__ATOMIC_RELEASE, "agent");
            asm volatile("s_waitcnt vmcnt(0)" ::: "memory");
            const unsigned og = xb_add(&bar[XB_TOP], 1u);
            const unsigned tg = og / nx;
            if (og + 1u == (tg + 1u) * nx) xb_add(&bar[XB_TOPGEN], 1u);
            else XB_SPIN(xb_ld(&bar[XB_TOPGEN]) == tg, bar);
            __builtin_amdgcn_fence(__ATOMIC_ACQUIRE, "agent");
            xb_add(&bar[XB_XGEN(b.x)], 1u);
            asm volatile("s_waitcnt vmcnt(0)" ::: "memory");
        } else {
            XB_SPIN(xb_ld(&bar[XB_XGEN(b.x)]) == gen, bar);
            __builtin_amdgcn_fence(__ATOMIC_ACQUIRE, "agent");
            asm volatile("s_waitcnt vmcnt(0)" ::: "memory");
        }
    }
    __syncthreads();
}


#ifndef MK_N_LAUNCHES
#define MK_N_LAUNCHES 1
#endif
namespace mk {
typedef unsigned short bf16_t;
typedef float f32x4 __attribute__((ext_vector_type(4)));
typedef short bf16x8 __attribute__((ext_vector_type(8)));
typedef short s16x4 __attribute__((ext_vector_type(4)));
typedef unsigned u32x4 __attribute__((ext_vector_type(4)));
typedef unsigned u32x2 __attribute__((ext_vector_type(2)));
typedef float f32x2 __attribute__((ext_vector_type(2)));
constexpr int D = 2048, NTOK_P = 16384, NTOK_S = 256, NTOK = 16640;
constexpr int DIN = 5632, DATT = 1536, DLRU = 512, NH = 12, HD = 128;
constexpr int NEXP = 16384;
constexpr float ALPHA = 1.189207115002721f;
constexpr float LN_EPS = 1e-5f;
constexpr float ATT_SCALE = 0.08838834764831845f;
constexpr float LOG2E = 1.4426950408889634f;
constexpr size_t O_YP = 0, O_YS = 33554432, O_KP = 34078720, O_VP = 59244544, O_CP = 84410368, O_HP = 84422656,
                 O_KS = 84426752, O_VS = 185090048, O_CS = 285753344, O_HS = 285802496, O_END = 285818880;
constexpr size_t WS_CTL = 0;
constexpr size_t WS_XB = 65536;
constexpr size_t WS_WINT = WS_XB + (size_t)NTOK * D * 2;
constexpr size_t WS_WOT = WS_WINT + (size_t)DIN * D * 2;
constexpr size_t WS_WQT = WS_WOT + (size_t)D * D * 2;
constexpr size_t WS_UB = WS_WQT + (size_t)D * D * 2;
constexpr size_t WS_VB = WS_UB + (size_t)NEXP * D * 2;
constexpr size_t WS_QF = WS_VB + (size_t)NEXP * D * 2;
constexpr size_t WS_XR = WS_QF + (size_t)NTOK * DATT * 4;
constexpr size_t WS_GATE = WS_XR + (size_t)NTOK * DLRU * 4;
constexpr size_t WS_AR = WS_GATE + (size_t)NTOK * DLRU * 4;
constexpr size_t WS_PRE1 = WS_AR + (size_t)NTOK * D * 2;
constexpr size_t WS_X1F = WS_PRE1 + (size_t)NTOK * D * 4;
constexpr size_t WS_X1B = WS_X1F + (size_t)NTOK * D * 4;
constexpr size_t WS_QP = WS_X1B + (size_t)NTOK * D * 2;
constexpr size_t WS_EIDX = WS_QP + (size_t)NTOK * D * 4;
constexpr size_t WS_GW = WS_EIDX + (size_t)NTOK * 128 * 4;
constexpr size_t WS_SU = WS_GW + (size_t)NTOK * 128 * 4;
constexpr size_t WS_SV = WS_SU + (size_t)NEXP * 4;
constexpr size_t WS_SX = WS_SV + (size_t)NEXP * 4;
constexpr size_t WS_X1Q = WS_SX + (size_t)NTOK * 4;
constexpr size_t WS_SKB = WS_X1Q + (size_t)NTOK * D;
constexpr size_t WS_QB = WS_SKB + (size_t)8 * 2 * 128 * 128 * 2;
constexpr size_t WS_KB = WS_QB + (size_t)NTOK * DATT * 2;
constexpr size_t WS_VB16 = WS_KB + (size_t)NTOK_P * DATT * 2;
constexpr size_t WS_PO = WS_VB16 + (size_t)NTOK_P * DATT * 2;
constexpr size_t WS_PM = WS_PO + (size_t)2 * NTOK_P * DATT * 2;
constexpr size_t WS_PL = WS_PM + (size_t)2 * NTOK_P * NH * 4;
constexpr size_t WS_R0 = WS_PL + (size_t)2 * NTOK_P * NH * 4;
constexpr size_t WS_R1 = WS_R0 + (size_t)NTOK_P * DLRU * 4;
constexpr size_t WS_HE = WS_R1 + (size_t)NTOK_P * DLRU * 4;
constexpr size_t WS_AE = WS_HE + (size_t)8 * 32 * 512 * 4;
constexpr size_t WS_LW = WS_AE + (size_t)8 * 32 * 512 * 4;
constexpr size_t WS_PS = WS_LW + (size_t)2 * 8 * 64 * 64 * 2;
constexpr size_t WS_END = WS_PS + (size_t)32 * 12 * 9 * 8 * 130 * 4;

constexpr int NTHREADS = 512;
constexpr int LDS_BYTES = 148480;
constexpr int MISC_OFF = 147456;

struct Params {
    const float* x_prompt; const float* x_sample; const float* cache_k; const float* cache_v; const float* state_conv; const float* state_h;
    const float* w_in; const float* conv_w; const float* conv_b; const float* lru_w_a; const float* lru_b_a; const float* lru_w_x; const float* lru_b_x;
    const float* lru_lambda; const float* w_out; const float* ln1_g; const float* ln1_b; const float* w_query; const float* sub_keys;
    const float* peer_u; const float* peer_v; const float* ln2_g; const float* ln2_b;
    float* out; unsigned char* ws; int ph_lo, ph_hi;
};

__device__ __forceinline__ unsigned f2bf(float f) { unsigned u = __float_as_uint(f); u += 0x7fffu + ((u >> 16) & 1u); return u >> 16; }
__device__ __forceinline__ unsigned pack2(float a, float b) { return f2bf(a) | (f2bf(b) << 16); }
__device__ __forceinline__ float bflo(unsigned w) { return __uint_as_float(w << 16); }
__device__ __forceinline__ float bfhi(unsigned w) { return __uint_as_float(w & 0xffff0000u); }
__device__ __forceinline__ float wave_sum(float v) {
#pragma unroll
    for (int o = 32; o >= 1; o >>= 1) v += __shfl_xor(v, o);
    return v;
}
__device__ __forceinline__ float wave_max(float v) {
#pragma unroll
    for (int o = 32; o >= 1; o >>= 1) v = fmaxf(v, __shfl_xor(v, o));
    return v;
}
__device__ __forceinline__ float gelu_exact(float v) { return 0.5f * v * (1.0f + erff(v * 0.7071067811865476f)); }
__device__ __forceinline__ float gelu_as(float v) {
    const float av = fabsf(v), t = __builtin_amdgcn_rcpf(av * 0.2316418882f + 1.0f);
    float q = t * 0.5307027145f + (-0.7265760135f); q = q * t + 0.7107068705f; q = q * t + (-0.142248368f); q = q * t + 0.127414796f; q = q * t;
    const float e = __builtin_amdgcn_exp2f((v * v) * (-0.72134752044f));
    const float m = v * (q * e);
    return v < 0.f ? m : v - m;
}
__device__ __forceinline__ float sigmoidf(float v) { return 1.0f / (1.0f + expf(-v)); }
__device__ __forceinline__ float readlane_f(float v, int l) { return __int_as_float(__builtin_amdgcn_readlane(__float_as_int(v), l)); }

__device__ __forceinline__ void convert_flat(const float* src, bf16_t* dst, size_t n8, size_t gtid, size_t gstride) {
    for (size_t i = gtid; i < n8; i += gstride) {
        const float4 a = ((const float4*)src)[2 * i], b = ((const float4*)src)[2 * i + 1];
        uint4 w; w.x = pack2(a.x, a.y); w.y = pack2(a.z, a.w); w.z = pack2(b.x, b.y); w.w = pack2(b.z, b.w);
        ((uint4*)dst)[i] = w;
    }
}
__device__ __forceinline__ void transpose_convert(const float* src, bf16_t* dst, int K, int N, LAS float* tile) {
    const int tid = threadIdx.x, ntn = N / 64, ntiles = (K / 64) * ntn;
    for (int tl = blockIdx.x; tl < ntiles; tl += gridDim.x) {
        const int kt = tl / ntn, nt = tl - kt * ntn;
#pragma unroll
        for (int i = 0; i < 8; ++i) { const int r = (tid >> 6) + 8 * i, c = tid & 63; tile[r * 65 + c] = src[(size_t)(kt * 64 + r) * N + nt * 64 + c]; }
        __syncthreads();
#pragma unroll
        for (int i = 0; i < 4; ++i) { const int n = (tid >> 5) + 16 * i, k0 = 2 * (tid & 31);
            const unsigned v = pack2(tile[k0 * 65 + n], tile[(k0 + 1) * 65 + n]);
            *(unsigned*)(dst + (size_t)(nt * 64 + n) * K + kt * 64 + k0) = v; }
        __syncthreads();
    }
}
constexpr int TROW = 1152;
__device__ __forceinline__ void quant_row_load(const Params& P, int it, int lane, float4 (&v)[8]) {
    const bool isv = it >= NEXP; const int row = isv ? it - NEXP : it;
    const float* src = (isv ? P.peer_v : P.peer_u) + (size_t)row * D;
#pragma unroll
    for (int j = 0; j < 2; ++j)
#pragma unroll
        for (int i = 0; i < 4; ++i) v[j * 4 + i] = *(const float4*)(src + j * 1024 + lane * 16 + i * 4);
}
__device__ __forceinline__ void quant_row_store(const Params& P, int it, int lane, const float4 (&v)[8]) {
    const bool isv = it >= NEXP; const int row = isv ? it - NEXP : it;
    float cm[2];
#pragma unroll
    for (int j = 0; j < 2; ++j) { float am = 0.f;
#pragma unroll
        for (int i = 0; i < 4; ++i) { const float4 t = v[j * 4 + i]; am = fmaxf(am, fmaxf(fmaxf(fabsf(t.x), fabsf(t.y)), fmaxf(fabsf(t.z), fabsf(t.w)))); }
        cm[j] = am; }
    float rm = wave_max(fmaxf(cm[0], cm[1])); if (rm == 0.f) rm = 1.f;
    unsigned char* dst = P.ws + (isv ? WS_VB : WS_UB) + (size_t)row * TROW;
    u32x4 w; unsigned sqp = 0u;
#pragma unroll
    for (int j = 0; j < 2; ++j) {
        int sq = (int)ceilf(cm[j] / rm * 255.0f); sq = sq < 1 ? 1 : (sq > 255 ? 255 : sq);
        sqp |= (unsigned)sq << (8 * j);
        const float inv = (255.0f * 7.0f) / (rm * (float)sq);
#pragma unroll
        for (int hh = 0; hh < 2; ++hh) { unsigned dw = 0u;
#pragma unroll
            for (int e = 0; e < 8; ++e) { const float4 t = v[j * 4 + hh * 2 + (e >> 2)]; const float x = (e & 3) == 0 ? t.x : ((e & 3) == 1 ? t.y : ((e & 3) == 2 ? t.z : t.w));
                int n = (int)rintf(x * inv); n = n < -7 ? -7 : (n > 7 ? 7 : n); dw |= (unsigned)(isv ? n + 8 : (n & 15)) << (4 * e); }
            w[j * 2 + hh] = dw; }
    }
    *(u32x4*)(dst + lane * 16) = w;
    *(unsigned short*)(dst + 1024 + lane * 2) = (unsigned short)sqp;
    if (lane == 0) ((float*)(P.ws + (isv ? WS_SV : WS_SU)))[row] = rm * (1.0f / (255.0f * 7.0f));
}
__device__ __forceinline__ void quant_tables(const Params& P, int gw, int nw) {
    const int lane = threadIdx.x & 63;
    float4 va[8], vb[8];
    int it = gw;
    if (it < 2 * NEXP) quant_row_load(P, it, lane, va);
#pragma unroll 1
    for (; it < 2 * NEXP; it += 2 * nw) {
        if (it + nw < 2 * NEXP) quant_row_load(P, it + nw, lane, vb);
        quant_row_store(P, it, lane, va);
        if (it + nw < 2 * NEXP) {
            if (it + 2 * nw < 2 * NEXP) quant_row_load(P, it + 2 * nw, lane, va);
            quant_row_store(P, it + nw, lane, vb);
        }
    }
}
__device__ __forceinline__ void phase_prologue(const Params& P, LAS unsigned char* lds) {
    const size_t gtid = (size_t)blockIdx.x * NTHREADS + threadIdx.x, gstride = (size_t)gridDim.x * NTHREADS;
    unsigned char* ws = P.ws;
    convert_flat(P.x_prompt, (bf16_t*)(ws + WS_XB), (size_t)NTOK_P * D / 8, gtid, gstride);
    convert_flat(P.x_sample, (bf16_t*)(ws + WS_XB) + (size_t)NTOK_P * D, (size_t)NTOK_S * D / 8, gtid, gstride);
    convert_flat(P.sub_keys, (bf16_t*)(ws + WS_SKB), (size_t)8 * 2 * 128 * 128 / 8, gtid, gstride);
    for (size_t i = gtid; i < (size_t)2 * 8 * 64 * 64; i += gstride) {
        const int c = (int)(i & 63), d = (int)((i >> 6) & 63), n = (int)((i >> 12) & 7), m = (int)(i >> 15);
        ((bf16_t*)(ws + WS_LW))[i] = (bf16_t)f2bf((m ? P.lru_w_x : P.lru_w_a)[(n * 64 + c) * 64 + d]); }
    transpose_convert(P.w_in, (bf16_t*)(ws + WS_WINT), D, DIN, (LAS float*)lds);
    transpose_convert(P.w_out, (bf16_t*)(ws + WS_WOT), D, D, (LAS float*)lds);
    transpose_convert(P.w_query, (bf16_t*)(ws + WS_WQT), D, D, (LAS float*)lds);
}

struct EpiProj {
    static constexpr bool PERM = true, AFTER_DRAIN = false;
    float* out; bf16_t* XR; bf16_t* GATE; bf16_t* QB; bf16_t* KB; bf16_t* VB16;
    __device__ __forceinline__ void operator()(const f32x4 (&acc)[2][2][4][2], const pg8::Unit& u, int wr, int wc, int fr, int fq) const {
        const int pn = u.pn; const int coff = wc * 32 + 8 * fq;
#pragma unroll
        for (int ai = 0; ai < 2; ++ai)
#pragma unroll
            for (int m = 0; m < 4; ++m) {
                const int row = u.pm * 256 + ai * 128 + wr * 64 + m * 16 + fr;
                const bool prompt = row < NTOK_P;
                float* rowp = nullptr; bf16_t* rowb = nullptr; float bsc = 1.0f;
                if (pn < 6) { rowb = QB + (size_t)row * DATT + pn * 256; bsc = ATT_SCALE * LOG2E; }
                else if (pn < 18) {
                    const int isv = pn >= 12; const int c0 = (pn - (isv ? 12 : 6)) * 256;
                    if (prompt) { rowp = out + (isv ? O_VP : O_KP) + (size_t)row * DATT + c0; rowb = (isv ? VB16 : KB) + (size_t)row * DATT + c0; }
                    else { const int rr = row - NTOK_P, b = rr >> 3, t = rr & 7; rowp = out + (isv ? O_VS : O_KS) + ((size_t)b * 2048 + 2040 + t) * DATT + c0; }
                } else if (pn < 20) rowb = XR + (size_t)row * DLRU + (pn - 18) * 256;
                else rowb = GATE + (size_t)row * DLRU + (pn - 20) * 256;
#pragma unroll
                for (int bj = 0; bj < 2; ++bj) {
                    const f32x4 v0 = acc[ai][bj][m][0], v1 = acc[ai][bj][m][1];
                    if (rowp) { *(f32x4*)(rowp + coff + bj * 128) = v0; *(f32x4*)(rowp + coff + bj * 128 + 4) = v1; }
                    if (rowb) { u32x4 w; w.x = pg8::cvt_pk_bf16(v0[0] * bsc, v0[1] * bsc); w.y = pg8::cvt_pk_bf16(v0[2] * bsc, v0[3] * bsc); w.z = pg8::cvt_pk_bf16(v1[0] * bsc, v1[1] * bsc); w.w = pg8::cvt_pk_bf16(v1[2] * bsc, v1[3] * bsc);
                        *(u32x4*)(rowb + coff + bj * 128) = w; }
                }
            }
    }
};
struct EpiOut {
    static constexpr bool PERM = true, AFTER_DRAIN = false;
    const bf16_t* xb; bf16_t* pre;
    __device__ __forceinline__ void operator()(const f32x4 (&acc)[2][2][4][2], const pg8::Unit& u, int wr, int wc, int fr, int fq) const {
        const int col0 = u.pn * 256 + wc * 32 + 8 * fq;
#pragma unroll
        for (int ai = 0; ai < 2; ++ai)
#pragma unroll
            for (int m = 0; m < 4; ++m) {
                const int row = u.pm * 256 + ai * 128 + wr * 64 + m * 16 + fr;
                const bf16_t* xr = xb + (size_t)row * D + col0; bf16_t* pr = pre + (size_t)row * D + col0;
#pragma unroll
                for (int bj = 0; bj < 2; ++bj) {
                    const u32x4 xv = *(const u32x4*)(xr + bj * 128); const f32x4 v0 = acc[ai][bj][m][0], v1 = acc[ai][bj][m][1];
                    u32x4 w;
                    w.x = pg8::cvt_pk_bf16(ALPHA * bflo(xv.x) + v0[0], ALPHA * bfhi(xv.x) + v0[1]); w.y = pg8::cvt_pk_bf16(ALPHA * bflo(xv.y) + v0[2], ALPHA * bfhi(xv.y) + v0[3]);
                    w.z = pg8::cvt_pk_bf16(ALPHA * bflo(xv.z) + v1[0], ALPHA * bfhi(xv.z) + v1[1]); w.w = pg8::cvt_pk_bf16(ALPHA * bflo(xv.w) + v1[2], ALPHA * bfhi(xv.w) + v1[3]);
                    *(u32x4*)(pr + bj * 128) = w;
                }
            }
    }
};
struct EpiPlain {
    static constexpr bool PERM = false, AFTER_DRAIN = false;
    float* C; int ldc;
    __device__ __forceinline__ void operator()(const f32x4 (&acc)[2][2][4][2], const pg8::Unit& u, int wr, int wc, int fr, int fq) const {
        const int col0 = u.pn * 256 + wc * 32 + 4 * fq;
#pragma unroll
        for (int ai = 0; ai < 2; ++ai)
#pragma unroll
            for (int m = 0; m < 4; ++m) {
                const int row = u.pm * 256 + ai * 128 + wr * 64 + m * 16 + fr;
                float* pr = C + (size_t)row * ldc + col0;
#pragma unroll
                for (int bj = 0; bj < 2; ++bj)
#pragma unroll
                    for (int n = 0; n < 2; ++n) *(f32x4*)(pr + bj * 128 + n * 16) = acc[ai][bj][m][n];
            }
    }
};

struct EpiBf16Plain {
    static constexpr bool PERM = true, AFTER_DRAIN = false;
    bf16_t* C; int ldc;
    __device__ __forceinline__ void operator()(const f32x4 (&acc)[2][2][4][2], const pg8::Unit& u, int wr, int wc, int fr, int fq) const {
        const int col0 = u.pn * 256 + wc * 32 + 8 * fq;
#pragma unroll
        for (int ai = 0; ai < 2; ++ai)
#pragma unroll
            for (int m = 0; m < 4; ++m) {
                const int row = u.pm * 256 + ai * 128 + wr * 64 + m * 16 + fr;
                bf16_t* pr = C + (size_t)row * ldc + col0;
#pragma unroll
                for (int bj = 0; bj < 2; ++bj) { const f32x4 v0 = acc[ai][bj][m][0], v1 = acc[ai][bj][m][1]; u32x4 w;
                    w.x = pg8::cvt_pk_bf16(v0[0], v0[1]); w.y = pg8::cvt_pk_bf16(v0[2], v0[3]); w.z = pg8::cvt_pk_bf16(v1[0], v1[1]); w.w = pg8::cvt_pk_bf16(v1[2], v1[3]);
                    *(u32x4*)(pr + bj * 128) = w; }
            }
    }
};

template <int MODE>
__device__ __forceinline__ void sample_rows_gemm(const Params& P, const bf16_t* A, const bf16_t* Wt, LAS unsigned char* lds) {
    const int tid = threadIdx.x, lane = tid & 63, w = __builtin_amdgcn_readfirstlane(tid >> 6);
    const int c = lane & 15, g = lane >> 4;
    for (int tile = blockIdx.x; tile < 256; tile += gridDim.x) {
        const int tg = tile & 7, cg = tile >> 3;
        const int k0 = 256 * w;
        const bf16_t* wp = Wt + (size_t)(64 * cg + c) * D + k0 + 8 * g;
        const bf16_t* xp = A + (size_t)(NTOK_P + 32 * tg + c) * D + k0 + 8 * g;
        f32x4 acc[4][2];
#pragma unroll
        for (int ct = 0; ct < 4; ++ct) { acc[ct][0] = (f32x4){0.f, 0.f, 0.f, 0.f}; acc[ct][1] = (f32x4){0.f, 0.f, 0.f, 0.f}; }
#pragma unroll 4
        for (int ks = 0; ks < 8; ++ks) {
            bf16x8 wf[4], xf[2];
#pragma unroll
            for (int ct = 0; ct < 4; ++ct) wf[ct] = *(const bf16x8*)(wp + (size_t)(16 * ct) * D + 32 * ks);
#pragma unroll
            for (int tt = 0; tt < 2; ++tt) xf[tt] = *(const bf16x8*)(xp + (size_t)(16 * tt) * D + 32 * ks);
#pragma unroll
            for (int ct = 0; ct < 4; ++ct)
#pragma unroll
                for (int tt = 0; tt < 2; ++tt) acc[ct][tt] = __builtin_amdgcn_mfma_f32_16x16x32_bf16(wf[ct], xf[tt], acc[ct][tt], 0, 0, 0);
        }
        LAS float* part = (LAS float*)lds;
#pragma unroll
        for (int ct = 0; ct < 4; ++ct)
#pragma unroll
            for (int tt = 0; tt < 2; ++tt) *(LAS f32x4*)(part + ((w * 32 + 16 * tt + c) * 64 + 16 * ct + 4 * g)) = acc[ct][tt];
        __syncthreads();
        {
            const int tok = tid >> 4, c4 = (tid & 15) * 4;
            f32x4 sum = {0.f, 0.f, 0.f, 0.f};
#pragma unroll
            for (int ww = 0; ww < 8; ++ww) sum += *(const LAS f32x4*)(part + ((ww * 32 + tok) * 64 + c4));
            const int row = NTOK_P + 32 * tg + tok, col = 64 * cg + c4;
            if (MODE == 0) { const f32x4 xv = *(const f32x4*)(P.x_sample + (size_t)(row - NTOK_P) * D + col); const f32x4 r = xv * ALPHA + sum; u32x2 wv; wv.x = pg8::cvt_pk_bf16(r[0], r[1]); wv.y = pg8::cvt_pk_bf16(r[2], r[3]); *(u32x2*)((bf16_t*)(P.ws + WS_PRE1) + (size_t)row * D + col) = wv; }
            else { u32x2 wv; wv.x = pg8::cvt_pk_bf16(sum[0], sum[1]); wv.y = pg8::cvt_pk_bf16(sum[2], sum[3]); *(u32x2*)((bf16_t*)(P.ws + WS_QP) + (size_t)row * D + col) = wv; }
        }
        __syncthreads();
    }
}

constexpr int KVS = 288, VOFF = 73728;
struct AttnKV { u32x4 k[8], v[8]; };
struct AttnId { int p, b, h, r, c; };
__device__ __forceinline__ void attn_fetch(const Params& P, const AttnId& u, AttnKV& R) {
    const int tid = threadIdx.x; const int dil = 1 << (2 * u.p);
    const bf16_t* Kb = (const bf16_t*)(P.ws + WS_KB); const bf16_t* Vb = (const bf16_t*)(P.ws + WS_VB16);
    const size_t tok0 = (size_t)u.b * 2048; const int j0 = 128 * u.c - 128, rho0 = (u.c == 0) ? 128 : 0;
#pragma unroll
    for (int it = 0; it < 8; ++it) {
        const int rho = it * 32 + (tid >> 4), ch = tid & 15;
        if (rho >= rho0) {
            const size_t tok = tok0 + (size_t)((j0 + rho) * dil + u.r);
            R.k[it] = *(const u32x4*)(Kb + tok * DATT + u.h * HD + ch * 8);
            R.v[it] = *(const u32x4*)(Vb + tok * DATT + u.h * HD + ch * 8);
        }
    }
}
__device__ __forceinline__ void attn_commit(const AttnId& u, const AttnKV& R, LAS unsigned char* lds) {
    const int tid = threadIdx.x; const int rho0 = (u.c == 0) ? 128 : 0;
#pragma unroll
    for (int it = 0; it < 8; ++it) {
        const int rho = it * 32 + (tid >> 4), ch = tid & 15;
        if (rho >= rho0) { *(LAS u32x4*)(lds + rho * KVS + ch * 16) = R.k[it]; *(LAS u32x4*)(lds + VOFF + rho * KVS + ch * 16) = R.v[it]; }
    }
}
template <int MODE>
__device__ __forceinline__ void attn_unit(const Params& P, const AttnId& uid, AttnKV& R, bool has_next, const AttnId& nid, LAS unsigned char* lds) {
    const int tid = threadIdx.x, lane = tid & 63, w = __builtin_amdgcn_readfirstlane(tid >> 6);
    const int p = uid.p, b = uid.b, h = uid.h, r = uid.r, c = uid.c;
    const int dil = 1 << (2 * p);
    const bf16_t* Qb = (const bf16_t*)(P.ws + WS_QB);
    const size_t tok0 = (size_t)b * 2048;
    attn_commit(uid, R, lds);
    const int cq = lane & 15, g = lane >> 4;
    const int iq = 128 * c + 16 * w + cq;
    const size_t qtok = tok0 + (size_t)(iq * dil + r);
    bf16x8 qf[4];
#pragma unroll
    for (int ks = 0; ks < 4; ++ks) qf[ks] = *(const bf16x8*)(Qb + qtok * DATT + h * HD + 32 * ks + 8 * g);
    __syncthreads();
    if (has_next) attn_fetch(P, nid, R);
    const int ktmin = (8 - w - 8 * c) > 0 ? (8 - w - 8 * c) : 0;
    const float slope2 = exp2f(-8.0f * (float)(h + 1) / 12.0f) * LOG2E * (float)dil;
    f32x4 s[9]; float m = -INFINITY;
#pragma unroll
    for (int kt = 0; kt < 9; ++kt) {
        if (kt >= ktmin) {
            f32x4 acc = {0.f, 0.f, 0.f, 0.f};
#pragma unroll
            for (int ks = 0; ks < 4; ++ks) { const bf16x8 kf = *(const LAS bf16x8*)(lds + (16 * w + 16 * kt + cq) * KVS + (32 * ks + 8 * g) * 2); acc = __builtin_amdgcn_mfma_f32_16x16x32_bf16(kf, qf[ks], acc, 0, 0, 0); }
#pragma unroll
            for (int ii = 0; ii < 4; ++ii) { const int dist = cq + 128 - 16 * kt - 4 * g - ii; float v = acc[ii] - slope2 * (float)dist;
                if (kt == 0 && dist > 128) v = -INFINITY; if (kt == 8 && dist < 0) v = -INFINITY; acc[ii] = v; m = fmaxf(m, v); }
            s[kt] = acc;
        } else s[kt] = (f32x4){-INFINITY, -INFINITY, -INFINITY, -INFINITY};
    }
    m = fmaxf(m, __shfl_xor(m, 16)); m = fmaxf(m, __shfl_xor(m, 32));
    float l = 0.f;
#pragma unroll
    for (int kt = 0; kt < 9; ++kt)
#pragma unroll
        for (int ii = 0; ii < 4; ++ii) { const float pp = exp2f(s[kt][ii] - m); s[kt][ii] = pp; l += pp; }
    l += __shfl_xor(l, 16); l += __shfl_xor(l, 32);
    f32x4 o[8];
#pragma unroll
    for (int dt = 0; dt < 8; ++dt) o[dt] = (f32x4){0.f, 0.f, 0.f, 0.f};
#pragma unroll
    for (int kk = 0; kk < 5; ++kk) {
        const int T0 = 2 * kk, T1 = 2 * kk + 1;
        if (T1 >= ktmin || T0 == 8) {
            u32x4 pw; pw.x = pg8::cvt_pk_bf16(s[T0][0], s[T0][1]); pw.y = pg8::cvt_pk_bf16(s[T0][2], s[T0][3]);
            if (T1 <= 8) { pw.z = pg8::cvt_pk_bf16(s[T1 <= 8 ? T1 : 8][0], s[T1 <= 8 ? T1 : 8][1]); pw.w = pg8::cvt_pk_bf16(s[T1 <= 8 ? T1 : 8][2], s[T1 <= 8 ? T1 : 8][3]); } else { pw.z = 0u; pw.w = 0u; }
            const bf16x8 pf = __builtin_bit_cast(bf16x8, pw);
            const int rT0 = (T0 >= ktmin) ? T0 : 8, rT1 = (T1 <= 8 && T1 >= ktmin) ? T1 : 8;
            const int a0 = VOFF + (16 * w + 16 * rT0 + 4 * g + (cq >> 2)) * KVS + 8 * (cq & 3);
            const int a1 = VOFF + (16 * w + 16 * rT1 + 4 * g + (cq >> 2)) * KVS + 8 * (cq & 3);
#pragma unroll
            for (int dt = 0; dt < 8; ++dt) {
                const s16x4 v0 = __builtin_amdgcn_ds_read_tr16_b64_v4i16((LAS s16x4*)(lds + a0 + dt * 32));
                const s16x4 v1 = __builtin_amdgcn_ds_read_tr16_b64_v4i16((LAS s16x4*)(lds + a1 + dt * 32));
                const bf16x8 vf = {v0[0], v0[1], v0[2], v0[3], v1[0], v1[1], v1[2], v1[3]};
                o[dt] = __builtin_amdgcn_mfma_f32_16x16x32_bf16(vf, pf, o[dt], 0, 0, 0);
            }
        }
    }
    const float inv = 1.0f / l;
    if (MODE == 0) {
        bf16_t* po = (bf16_t*)(P.ws + WS_PO) + ((size_t)p * NTOK_P + qtok) * DATT + h * HD + 4 * g;
#pragma unroll
        for (int dt = 0; dt < 8; ++dt) { u32x2 wv; wv.x = pg8::cvt_pk_bf16(o[dt][0] * inv, o[dt][1] * inv); wv.y = pg8::cvt_pk_bf16(o[dt][2] * inv, o[dt][3] * inv); *(u32x2*)(po + 16 * dt) = wv; }
        if (g == 0) { ((float*)(P.ws + WS_PM))[((size_t)p * NTOK_P + qtok) * NH + h] = m; ((float*)(P.ws + WS_PL))[((size_t)p * NTOK_P + qtok) * NH + h] = l; }
    } else {
        const float* PM = (const float*)(P.ws + WS_PM); const float* PL = (const float*)(P.ws + WS_PL);
        const float m0 = PM[qtok * NH + h], l0 = PL[qtok * NH + h], m1 = PM[((size_t)NTOK_P + qtok) * NH + h], l1 = PL[((size_t)NTOK_P + qtok) * NH + h];
        const float M = fmaxf(m, fmaxf(m0, m1));
        const float w2 = exp2f(m - M), w0 = exp2f(m0 - M) * l0, w1 = exp2f(m1 - M) * l1;
        const float rden = 1.0f / (w2 * l + w0 + w1);
        const bf16_t* p0 = (const bf16_t*)(P.ws + WS_PO) + qtok * DATT + h * HD + 4 * g;
        const bf16_t* p1 = p0 + (size_t)NTOK_P * DATT;
        bf16_t* ar = (bf16_t*)(P.ws + WS_AR) + qtok * D + h * HD + 4 * g;
#pragma unroll
        for (int dt = 0; dt < 8; ++dt) {
            const u32x2 x0 = *(const u32x2*)(p0 + 16 * dt), x1 = *(const u32x2*)(p1 + 16 * dt);
            const float r0 = (w2 * o[dt][0] + w0 * bflo(x0.x) + w1 * bflo(x1.x)) * rden, r1 = (w2 * o[dt][1] + w0 * bfhi(x0.x) + w1 * bfhi(x1.x)) * rden;
            const float r2 = (w2 * o[dt][2] + w0 * bflo(x0.y) + w1 * bflo(x1.y)) * rden, r3 = (w2 * o[dt][3] + w0 * bfhi(x0.y) + w1 * bfhi(x1.y)) * rden;
            u32x2 wv; wv.x = pg8::cvt_pk_bf16(r0, r1); wv.y = pg8::cvt_pk_bf16(r2, r3); *(u32x2*)(ar + 16 * dt) = wv;
        }
    }
    __syncthreads();
}

struct SampPre { float4 k[4], v[4]; };
__device__ __forceinline__ void samp_prefetch(const Params& P, int b, int h, int k, SampPre& R) {
    const int tid = threadIdx.x;
#pragma unroll
    for (int it = 0; it < 4; ++it) {
        const int rho = it * 16 + (tid >> 5), ch4 = tid & 31, c = 256 * k + rho;
        const size_t so = ((size_t)(b * 2048 + c)) * DATT + h * HD + ch4 * 4;
        R.k[it] = *(const float4*)(P.cache_k + so); R.v[it] = *(const float4*)(P.cache_v + so);
    }
}
__device__ __forceinline__ void samp_unit(const Params& P, int b, int h, int k, LAS unsigned char* lds, SampPre& R, bool have, bool pf_next, int nb, int nh, int nk) {
    const int tid = threadIdx.x, lane = tid & 63, w = __builtin_amdgcn_readfirstlane(tid >> 6);
    const int cq = lane & 15, g = lane >> 4;
    if (k < 8) {
        if (!have) samp_prefetch(P, b, h, k, R);
#pragma unroll
        for (int it = 0; it < 16; ++it) {
            const int rho = it * 16 + (tid >> 5), ch4 = tid & 31, c = 256 * k + rho;
            const size_t so = ((size_t)(b * 2048 + c)) * DATT + h * HD + ch4 * 4;
            float4 kf, vf;
            if (it < 4) { kf = R.k[it < 4 ? it : 0]; vf = R.v[it < 4 ? it : 0]; } else { kf = *(const float4*)(P.cache_k + so); vf = *(const float4*)(P.cache_v + so); }
            if (c >= 8) { const size_t od = ((size_t)(b * 2048 + c - 8)) * DATT + h * HD + ch4 * 4; *(float4*)(P.out + O_KS + od) = kf; *(float4*)(P.out + O_VS + od) = vf; }
            u32x2 kw, vw; kw.x = pg8::cvt_pk_bf16(kf.x, kf.y); kw.y = pg8::cvt_pk_bf16(kf.z, kf.w); vw.x = pg8::cvt_pk_bf16(vf.x, vf.y); vw.y = pg8::cvt_pk_bf16(vf.z, vf.w);
            *(LAS u32x2*)(lds + rho * KVS + ch4 * 8) = kw; *(LAS u32x2*)(lds + VOFF + rho * KVS + ch4 * 8) = vw;
            if ((it & 3) == 3) __builtin_amdgcn_sched_barrier(0);
        }
    } else {
        const int rho = tid >> 5, ch4 = tid & 31;
        u32x2 kw = {0u, 0u}, vw = {0u, 0u};
        if (rho < 8) { const size_t so = ((size_t)(b * 2048 + 2040 + rho)) * DATT + h * HD + ch4 * 4; const float4 kf = *(const float4*)(P.out + O_KS + so), vf = *(const float4*)(P.out + O_VS + so);
            kw.x = pg8::cvt_pk_bf16(kf.x, kf.y); kw.y = pg8::cvt_pk_bf16(kf.z, kf.w); vw.x = pg8::cvt_pk_bf16(vf.x, vf.y); vw.y = pg8::cvt_pk_bf16(vf.z, vf.w); }
        *(LAS u32x2*)(lds + rho * KVS + ch4 * 8) = kw; *(LAS u32x2*)(lds + VOFF + rho * KVS + ch4 * 8) = vw;
        *(LAS u32x2*)(lds + (16 + rho) * KVS + ch4 * 8) = (u32x2){0u, 0u}; *(LAS u32x2*)(lds + VOFF + (16 + rho) * KVS + ch4 * 8) = (u32x2){0u, 0u};
    }
    if (pf_next) samp_prefetch(P, nb, nh, nk, R);
    const int t = cq & 7;
    const bf16_t* Qb = (const bf16_t*)(P.ws + WS_QB) + ((size_t)(NTOK_P + b * 8 + t)) * DATT + h * HD;
    bf16x8 qf[4];
#pragma unroll
    for (int ks = 0; ks < 4; ++ks) qf[ks] = *(const bf16x8*)(Qb + 32 * ks + 8 * g);
    __syncthreads();
    const float slope2 = exp2f(-8.0f * (float)(h + 1) / 12.0f) * LOG2E;
    const bool active = (k < 8) || (w == 0);
    f32x4 s[2]; float m = -INFINITY;
#pragma unroll
    for (int j = 0; j < 2; ++j) {
        f32x4 acc = {0.f, 0.f, 0.f, 0.f};
        if (active) {
#pragma unroll
            for (int ks = 0; ks < 4; ++ks) { const bf16x8 kf = *(const LAS bf16x8*)(lds + (32 * w + 16 * j + cq) * KVS + (32 * ks + 8 * g) * 2); acc = __builtin_amdgcn_mfma_f32_16x16x32_bf16(kf, qf[ks], acc, 0, 0, 0); }
        }
#pragma unroll
        for (int ii = 0; ii < 4; ++ii) {
            const int c = 256 * k + 32 * w + 16 * j + 4 * g + ii, dist = 2048 + t - c;
            int mult = (dist <= 128 ? 1 : 0) + (((dist & 3) == 0 && dist <= 512) ? 1 : 0) + (((dist & 15) == 0 && dist <= 2048) ? 1 : 0);
            if (dist < 0 || !active || c > 2055) mult = 0;
            const float v = mult ? acc[ii] - slope2 * (float)dist : -INFINITY;
            acc[ii] = v; m = fmaxf(m, v);
            s[j][ii] = (float)mult;
            s[j][ii] = v;
        }
    }
    m = fmaxf(m, __shfl_xor(m, 16)); m = fmaxf(m, __shfl_xor(m, 32));
    const float mref = (m == -INFINITY) ? 0.f : m;
    float l = 0.f;
#pragma unroll
    for (int j = 0; j < 2; ++j)
#pragma unroll
        for (int ii = 0; ii < 4; ++ii) {
            const int c = 256 * k + 32 * w + 16 * j + 4 * g + ii, dist = 2048 + t - c;
            const int mult = (dist <= 128 ? 1 : 0) + (((dist & 3) == 0 && dist <= 512) ? 1 : 0) + (((dist & 15) == 0 && dist <= 2048) ? 1 : 0);
            const float pp = (float)mult * exp2f(s[j][ii] - mref); s[j][ii] = pp; l += pp; }
    l += __shfl_xor(l, 16); l += __shfl_xor(l, 32);
    f32x4 o[8];
    {
        u32x4 pw; pw.x = pg8::cvt_pk_bf16(s[0][0], s[0][1]); pw.y = pg8::cvt_pk_bf16(s[0][2], s[0][3]); pw.z = pg8::cvt_pk_bf16(s[1][0], s[1][1]); pw.w = pg8::cvt_pk_bf16(s[1][2], s[1][3]);
        const bf16x8 pf = __builtin_bit_cast(bf16x8, pw);
        const int rw = active ? w : 0;
        const int a0 = VOFF + (32 * rw + 4 * g + (cq >> 2)) * KVS + 8 * (cq & 3), a1 = a0 + 16 * KVS;
#pragma unroll
        for (int dt = 0; dt < 8; ++dt) {
            const s16x4 v0 = __builtin_amdgcn_ds_read_tr16_b64_v4i16((LAS s16x4*)(lds + a0 + dt * 32));
            const s16x4 v1 = __builtin_amdgcn_ds_read_tr16_b64_v4i16((LAS s16x4*)(lds + a1 + dt * 32));
            const bf16x8 vf = {v0[0], v0[1], v0[2], v0[3], v1[0], v1[1], v1[2], v1[3]};
            o[dt] = __builtin_amdgcn_mfma_f32_16x16x32_bf16(vf, pf, (f32x4){0.f, 0.f, 0.f, 0.f}, 0, 0, 0);
        }
    }
    __syncthreads();
    LAS float* OL = (LAS float*)lds;
    LAS float* ML = (LAS float*)(lds + 32768);
    if (cq < 8) {
#pragma unroll
        for (int dt = 0; dt < 8; ++dt) *(LAS f32x4*)(OL + (w * 8 + cq) * 128 + 16 * dt + 4 * g) = o[dt];
        if (g == 0) { ML[(w * 8 + cq) * 2 + 0] = m; ML[(w * 8 + cq) * 2 + 1] = l; }
    }
    __syncthreads();
    {
        const int q = w; float M = -INFINITY;
#pragma unroll
        for (int ww = 0; ww < 8; ++ww) M = fmaxf(M, ML[(ww * 8 + q) * 2]);
        const float Mr = (M == -INFINITY) ? 0.f : M;
        float L = 0.f, o0 = 0.f, o1 = 0.f;
#pragma unroll
        for (int ww = 0; ww < 8; ++ww) { const float f = exp2f(ML[(ww * 8 + q) * 2] - Mr); L += f * ML[(ww * 8 + q) * 2 + 1];
            o0 += f * OL[(ww * 8 + q) * 128 + 2 * lane]; o1 += f * OL[(ww * 8 + q) * 128 + 2 * lane + 1]; }
        float* ps = (float*)(P.ws + WS_PS) + ((((size_t)(b * NH + h)) * 9 + k) * 8 + q) * 130;
        if (lane == 0) { ps[0] = M; ps[1] = L; }
        *(float2*)(ps + 2 + 2 * lane) = make_float2(o0, o1);
    }
    __syncthreads();
}
__device__ __forceinline__ void samp_merge_unit(const Params& P, int b, int t, int h, int lane) {
    const float* ps = (const float*)(P.ws + WS_PS) + ((size_t)(b * NH + h)) * 9 * 8 * 130 + (size_t)t * 130;
    float M = -INFINITY;
#pragma unroll
    for (int k = 0; k < 9; ++k) M = fmaxf(M, ps[(size_t)k * 8 * 130]);
    float L = 0.f, o0 = 0.f, o1 = 0.f;
#pragma unroll
    for (int k = 0; k < 9; ++k) { const float* pk = ps + (size_t)k * 8 * 130; const float f = exp2f(pk[0] - M); L += f * pk[1]; const float2 ov = *(const float2*)(pk + 2 + 2 * lane); o0 += f * ov.x; o1 += f * ov.y; }
    const float inv = 1.0f / L;
    bf16_t* ar = (bf16_t*)(P.ws + WS_AR) + ((size_t)(NTOK_P + b * 8 + t)) * D + h * HD;
    *(unsigned*)(ar + 2 * lane) = pack2(o0 * inv, o1 * inv);
}

constexpr int LRU_XS = 144, LRU_GS = 68, LRU_WAVE = 16 * LRU_XS + 2 * 16 * LRU_GS * 4;
__device__ __forceinline__ void lru_unit(const Params& P, bool samp, int b, int n, int k, int lane, LAS unsigned char* wl) {
    const int T = samp ? 8 : 64; const int row0 = samp ? NTOK_P + b * 8 : b * 2048 + k * 64; const int ch = n * 64 + lane;
    const int cq = lane & 15, g = lane >> 4;
    bf16x8 wf[2][4][2];
    { const bf16_t* lw = (const bf16_t*)(P.ws + WS_LW);
#pragma unroll
      for (int m = 0; m < 2; ++m)
#pragma unroll
        for (int ct = 0; ct < 4; ++ct)
#pragma unroll
            for (int ks = 0; ks < 2; ++ks) wf[m][ct][ks] = *(const bf16x8*)(lw + ((size_t)((m * 8 + n) * 64 + 16 * ct + cq)) * 64 + 32 * ks + 8 * g); }
    const float ba = P.lru_b_a[ch], bx = P.lru_b_x[ch], lam = P.lru_lambda[ch];
    const float sp8 = -8.0f * LOG2E * log1pf(expf(-lam));
    const float cw0 = P.conv_w[ch], cw1 = P.conv_w[512 + ch], cw2 = P.conv_w[1024 + ch], cw3 = P.conv_w[1536 + ch], cb = P.conv_b[ch];
    const bf16_t* XR = (const bf16_t*)(P.ws + WS_XR); const bf16_t* GT = (const bf16_t*)(P.ws + WS_GATE);
    float* R0 = (float*)(P.ws + WS_R0); float* R1 = (float*)(P.ws + WS_R1); bf16_t* AR = (bf16_t*)(P.ws + WS_AR);
    LAS unsigned char* xcb = wl; LAS float* G = (LAS float*)(wl + 16 * LRU_XS);
    float x0 = 0.f, x1 = 0.f, x2 = 0.f, h = 0.f, A = 1.f;
    if (samp) { x0 = P.state_conv[(b * 3 + 0) * 512 + ch]; x1 = P.state_conv[(b * 3 + 1) * 512 + ch]; x2 = P.state_conv[(b * 3 + 2) * 512 + ch]; h = P.state_h[b * 512 + ch]; }
    else if (k > 0) { x0 = bflo(XR[(size_t)(row0 - 3) * DLRU + ch]); x1 = bflo(XR[(size_t)(row0 - 2) * DLRU + ch]); x2 = bflo(XR[(size_t)(row0 - 1) * DLRU + ch]); }
#pragma unroll 1
    for (int t0 = 0; t0 < T; t0 += 16) {
        const int ns = (T - t0) < 16 ? (T - t0) : 16;
        float xc[16], gt[16];
#pragma unroll
        for (int i = 0; i < 16; ++i) { const int r = row0 + t0 + (i < ns ? i : ns - 1); xc[i] = bflo(XR[(size_t)r * DLRU + ch]); gt[i] = bflo(GT[(size_t)r * DLRU + ch]); }
#pragma unroll
        for (int i = 0; i < 16; ++i) {
            const float xin = xc[i]; const float v = ((x0 * cw0 + x1 * cw1) + x2 * cw2) + xin * cw3 + cb;
            if (i < ns) { x0 = x1; x1 = x2; x2 = xin; }
            xc[i] = v;
            *(LAS bf16_t*)(xcb + i * LRU_XS + lane * 2) = (bf16_t)f2bf(v);
        }
        __builtin_amdgcn_wave_barrier();
        const bf16x8 a0 = *(const LAS bf16x8*)(xcb + cq * LRU_XS + (8 * g) * 2), a1 = *(const LAS bf16x8*)(xcb + cq * LRU_XS + (32 + 8 * g) * 2);
#pragma unroll
        for (int m = 0; m < 2; ++m)
#pragma unroll
            for (int ct = 0; ct < 4; ++ct) {
                f32x4 acc = __builtin_amdgcn_mfma_f32_16x16x32_bf16(a0, wf[m][ct][0], (f32x4){0.f, 0.f, 0.f, 0.f}, 0, 0, 0);
                acc = __builtin_amdgcn_mfma_f32_16x16x32_bf16(a1, wf[m][ct][1], acc, 0, 0, 0);
#pragma unroll
                for (int ii = 0; ii < 4; ++ii) G[(m * 16 + 4 * g + ii) * LRU_GS + 16 * ct + cq] = acc[ii];
            }
        __builtin_amdgcn_wave_barrier();
#pragma unroll
        for (int i = 0; i < 16; ++i) {
            if (i < ns) {
                const float ra = G[i * LRU_GS + lane] + ba, ri = G[(16 + i) * LRU_GS + lane] + bx;
                const float r = __builtin_amdgcn_rcpf(1.0f + __builtin_amdgcn_exp2f(-LOG2E * ra)), ig = __builtin_amdgcn_rcpf(1.0f + __builtin_amdgcn_exp2f(-LOG2E * ri));
                const float a = __builtin_amdgcn_exp2f(sp8 * r);
                const float u = __builtin_amdgcn_sqrtf(fmaxf(1.0f - a * a, 0.f)) * (ig * xc[i]);
                h = a * h + u; A = a * A;
                const float ge = gelu_as(gt[i]);
                if (samp) AR[(size_t)(row0 + t0 + i) * D + DATT + ch] = (bf16_t)f2bf(h * ge);
                else { R0[(size_t)(row0 + t0 + i) * DLRU + ch] = h * ge; R1[(size_t)(row0 + t0 + i) * DLRU + ch] = A * ge; }
            }
        }
        __builtin_amdgcn_wave_barrier();
    }
    if (samp) { P.out[O_HS + (size_t)b * 512 + ch] = h; float* co = P.out + O_CS + (size_t)b * 3 * 512 + ch; co[0] = x0; co[512] = x1; co[1024] = x2; }
    else {
        ((float*)(P.ws + WS_HE))[((size_t)(b * 32 + k)) * 512 + ch] = h; ((float*)(P.ws + WS_AE))[((size_t)(b * 32 + k)) * 512 + ch] = A;
        if (k == 31) { float* co = P.out + O_CP + (size_t)b * 3 * 512 + ch; co[0] = x0; co[512] = x1; co[1024] = x2; }
    }
}

__device__ __forceinline__ void phase_lru(const Params& P, LAS unsigned char* lds) {
    const int lane = threadIdx.x & 63, wave = __builtin_amdgcn_readfirstlane(threadIdx.x >> 6);
    const int gw = blockIdx.x * 8 + wave, nw = gridDim.x * 8;
#pragma unroll 1
    for (int pass = 0; pass < 2; ++pass) {
        if ((pass ^ (wave & 1)) == 0) {
            for (int u = gw; u < 2048 + 256; u += nw) { const bool samp = u >= 2048; const int v = samp ? u - 2048 : u; lru_unit(P, samp, samp ? (v >> 3) : (v >> 8), samp ? (v & 7) : ((v >> 5) & 7), v & 31, lane, lds + wave * LRU_WAVE); }
        } else quant_tables(P, gw, nw);
    }
    __syncthreads();
}
__device__ __forceinline__ void phase_samp(const Params& P, LAS unsigned char* lds) {
    SampPre R; bool have = false;
    int u = blockIdx.x;
    if (u < 384 * 9 && (u % 9) < 8) { const int bh = u / 9; samp_prefetch(P, bh / NH, bh % NH, u % 9, R); have = true; }
    for (; u < 384 * 9; u += gridDim.x) {
        const int k = u % 9, bh = u / 9; const int un = u + (int)gridDim.x; const bool pf = un < 384 * 9 && (un % 9) < 8; const int nbh = un / 9;
        samp_unit(P, bh / NH, bh % NH, k, lds, R, have, pf, nbh / NH, nbh % NH, un % 9);
        have = pf;
    }
}
__device__ __forceinline__ AttnId attn01_id(int u) {
    const int p = u / 1536, rem = u - p * 1536, bh = rem >> 4, rc = rem & 15; const int b = bh / NH, h = bh - b * NH;
    return AttnId{p, b, h, p == 0 ? 0 : (rc >> 2), p == 0 ? rc : (rc & 3)};
}
__device__ __forceinline__ void phase_attn01(const Params& P, LAS unsigned char* lds) {
    AttnKV R; int u = blockIdx.x;
    if (u < 3072) attn_fetch(P, attn01_id(u), R);
    for (; u < 3072; u += gridDim.x) {
        const int un = u + (int)gridDim.x; const bool hn = un < 3072;
        attn_unit<0>(P, attn01_id(u), R, hn, attn01_id(hn ? un : u), lds);
    }
}
__device__ __forceinline__ void phase_mix_b(const Params& P, LAS unsigned char* lds) {
    {
        const int gt = blockIdx.x * NTHREADS + threadIdx.x;
        for (int i = gt; i < 8 * 32 * 512; i += gridDim.x * NTHREADS) {
            const int ch = i & 511, k = (i >> 9) & 31, b = i >> 14;
            const float* HE = (const float*)(P.ws + WS_HE) + (size_t)b * 32 * 512 + ch; const float* AE = (const float*)(P.ws + WS_AE) + (size_t)b * 32 * 512 + ch;
            float he[31], ae[31];
#pragma unroll
            for (int kk = 0; kk < 31; ++kk) { he[kk] = kk < k ? HE[kk * 512] : 0.f; ae[kk] = kk < k ? AE[kk * 512] : 1.f; }
            float hin = 0.f;
#pragma unroll
            for (int kk = 0; kk < 31; ++kk) hin = kk < k ? he[kk] + ae[kk] * hin : hin;
            const float* R0 = (const float*)(P.ws + WS_R0) + (size_t)(b * 2048 + k * 64) * DLRU + ch; const float* R1 = (const float*)(P.ws + WS_R1) + (size_t)(b * 2048 + k * 64) * DLRU + ch;
            bf16_t* ar = (bf16_t*)(P.ws + WS_AR) + (size_t)(b * 2048 + k * 64) * D + DATT + ch;
#pragma unroll 16
            for (int t = 0; t < 64; ++t) ar[(size_t)t * D] = (bf16_t)f2bf(R0[(size_t)t * DLRU] + R1[(size_t)t * DLRU] * hin);
            if (k == 31) P.out[O_HP + (size_t)b * 512 + ch] = HE[31 * 512] + AE[31 * 512] * hin;
        }
    }
    { const int lane = threadIdx.x & 63, gw = blockIdx.x * 8 + (threadIdx.x >> 6);
      for (int u = gw; u < NTOK_S * NH; u += gridDim.x * 8) { const int row = u / NH, h = u - row * NH; samp_merge_unit(P, row >> 3, row & 7, h, lane); } }
    {
        AttnKV R; int u = blockIdx.x;
        if (u < 1536) attn_fetch(P, AttnId{2, (u >> 4) / NH, (u >> 4) % NH, u & 15, 0}, R);
        for (; u < 1536; u += gridDim.x) {
            const int un = u + (int)gridDim.x; const bool hn = un < 1536; const int uu = hn ? un : u;
            attn_unit<1>(P, AttnId{2, (u >> 4) / NH, (u >> 4) % NH, u & 15, 0}, R, hn, AttnId{2, (uu >> 4) / NH, (uu >> 4) % NH, uu & 15, 0}, lds);
        }
    }
}

__device__ __forceinline__ void phase_ln1(const Params& P) {
    const int lane = threadIdx.x & 63, wave = threadIdx.x >> 6;
    const bf16_t* pre = (const bf16_t*)(P.ws + WS_PRE1); bf16_t* x1b = (bf16_t*)(P.ws + WS_X1B);
    for (int row = blockIdx.x * 8 + wave; row < NTOK; row += gridDim.x * 8) {
        float4 v[8]; float s = 0.f;
#pragma unroll
        for (int j = 0; j < 8; j += 2) { const u32x4 pw = *(const u32x4*)(pre + (size_t)row * D + (j >> 2) * 1024 + lane * 16 + (j & 3) * 4);
            v[j] = make_float4(bflo(pw.x), bfhi(pw.x), bflo(pw.y), bfhi(pw.y)); v[j + 1] = make_float4(bflo(pw.z), bfhi(pw.z), bflo(pw.w), bfhi(pw.w));
            s += (v[j].x + v[j].y) + (v[j].z + v[j].w) + (v[j + 1].x + v[j + 1].y) + (v[j + 1].z + v[j + 1].w); }
        const float mean = wave_sum(s) * (1.0f / D); float q = 0.f;
#pragma unroll
        for (int j = 0; j < 8; ++j) { const float a = v[j].x - mean, b = v[j].y - mean, c = v[j].z - mean, d = v[j].w - mean; q += (a * a + b * b) + (c * c + d * d); }
        const float rstd = rsqrtf(wave_sum(q) * (1.0f / D) + LN_EPS);
        float am = 0.f;
#pragma unroll
        for (int j = 0; j < 8; ++j) { const int col = (j >> 2) * 1024 + lane * 16 + (j & 3) * 4; const float4 g = *(const float4*)(P.ln1_g + col), bb = *(const float4*)(P.ln1_b + col);
            float4 o; o.x = (v[j].x - mean) * rstd * g.x + bb.x; o.y = (v[j].y - mean) * rstd * g.y + bb.y; o.z = (v[j].z - mean) * rstd * g.z + bb.z; o.w = (v[j].w - mean) * rstd * g.w + bb.w;
            v[j] = o; am = fmaxf(am, fmaxf(fmaxf(fabsf(o.x), fabsf(o.y)), fmaxf(fabsf(o.z), fabsf(o.w))));
            uint2 w; w.x = pack2(o.x, o.y); w.y = pack2(o.z, o.w); *(uint2*)(x1b + (size_t)row * D + col) = w; }
        am = wave_max(am); if (am == 0.f) am = 1.f;
        const float inv = 119.0f / am;
        unsigned char* xq = P.ws + WS_X1Q + (size_t)row * D;
        u32x4 wh, wl;
#pragma unroll
        for (int d = 0; d < 4; ++d) { unsigned dh = 0u, dl = 0u;
#pragma unroll
            for (int e = 0; e < 8; ++e) { const float4 t = v[d * 2 + (e >> 2)]; const float x = (e & 3) == 0 ? t.x : ((e & 3) == 1 ? t.y : ((e & 3) == 2 ? t.z : t.w));
                const int q = (int)rintf(x * inv); dl |= (unsigned)(q & 15) << (4 * e); dh |= (unsigned)(((q + 8) >> 4) & 15) << (4 * e); }
            wh[d] = dh; wl[d] = dl; }
        *(u32x4*)(xq + lane * 32) = wh; *(u32x4*)(xq + lane * 32 + 16) = wl;
        if (lane == 0) ((float*)(P.ws + WS_SX))[row] = am * (1.0f / 119.0f);
    }
}

__device__ __forceinline__ int mono(float v) { const int b = __float_as_int(v); return b ^ ((b >> 31) & 0x7fffffff); }
__device__ __forceinline__ float unmono(int k) { return __int_as_float(k ^ ((k >> 31) & 0x7fffffff)); }
#define MK_INSERT16(L, X) do { int _x = (X); _Pragma("unroll") for (int _j = 0; _j < 16; ++_j) { const int _hi = max(L[_j], _x); _x = min(L[_j], _x); L[_j] = _hi; } } while (0)

template <int N> __device__ __forceinline__ void bitonic_sort_desc(int (&v)[N]) {
#pragma unroll
    for (int k = 2; k <= N; k <<= 1)
#pragma unroll
        for (int j = k >> 1; j > 0; j >>= 1)
#pragma unroll
            for (int i = 0; i < N; ++i) { const int l = i ^ j;
                if (l > i) { const int a = v[i], b = v[l]; if ((i & k) == 0) { v[i] = max(a, b); v[l] = min(a, b); } else { v[i] = min(a, b); v[l] = max(a, b); } } }
}
template <int N> __device__ __forceinline__ void bitonic_merge_desc(int (&v)[N]) {
#pragma unroll
    for (int j = N >> 1; j > 0; j >>= 1)
#pragma unroll
        for (int i = 0; i < N; ++i) { const int l = i ^ j; if (l > i) { const int a = v[i], b = v[l]; v[i] = max(a, b); v[l] = min(a, b); } }
}
__device__ __forceinline__ void xlane_merge16(int (&v)[16], int off) {
    int c[16];
#pragma unroll
    for (int i = 0; i < 16; ++i) c[i] = max(v[i], __shfl_xor(v[15 - i], off));
#pragma unroll
    for (int i = 0; i < 16; ++i) v[i] = c[i];
    bitonic_merge_desc<16>(v);
}
__device__ __forceinline__ int sel4(int g, int a, int b, int c, int d) { return g == 0 ? a : (g == 1 ? b : (g == 2 ? c : d)); }
__device__ __forceinline__ float sel4f(int g, float a, float b, float c, float d) { return g == 0 ? a : (g == 1 ? b : (g == 2 ? c : d)); }
__device__ __forceinline__ constexpr int cand_a(int role, int i) {
    return role == 0 ? 0 : role == 1 ? (i < 8 ? 1 : (i < 13 ? 2 : 4)) : role == 2 ? (i < 4 ? 3 : (i < 6 ? 5 : (i < 8 ? 6 : (i < 10 ? 7 : 8 + (i - 10))))) : (i < 2 ? 14 + i : -1);
}
__device__ __forceinline__ constexpr int cand_b(int role, int i) {
    return role == 0 ? i : role == 1 ? (i < 8 ? i : (i < 13 ? i - 8 : i - 13)) : role == 2 ? (i < 4 ? i : (i < 6 ? i - 4 : (i < 8 ? i - 6 : (i < 10 ? i - 8 : 0)))) : 0;
}

__device__ __forceinline__ void route_unit(const Params& P, int h, int tg, LAS unsigned char* lds, LAS int* lst) {
    const int lane = threadIdx.x & 63, w = __builtin_amdgcn_readfirstlane(threadIdx.x >> 6);
    const int cq = lane & 15, g = lane >> 4;
    const int tok = tg * 128 + w * 16 + cq;
    const bf16_t* qrow = (const bf16_t*)(P.ws + WS_QP) + (size_t)tok * D + h * 256;
    int L0[16], L1[16];
#pragma unroll
    for (int p = 0; p < 2; ++p) {
        bf16x8 qf[4];
#pragma unroll
        for (int ks = 0; ks < 4; ++ks) qf[ks] = *(const bf16x8*)(qrow + p * 128 + 32 * ks + 8 * g);
        int v0[16], v1[16];
#pragma unroll
        for (int kt = 0; kt < 8; ++kt) {
            f32x4 acc = {0.f, 0.f, 0.f, 0.f};
#pragma unroll
            for (int ks = 0; ks < 4; ++ks) { const bf16x8 kf = *(const LAS bf16x8*)(lds + (p * 128 + 16 * kt + cq) * KVS + (32 * ks + 8 * g) * 2); acc = __builtin_amdgcn_mfma_f32_16x16x32_bf16(kf, qf[ks], acc, 0, 0, 0); }
#pragma unroll
            for (int ii = 0; ii < 4; ++ii) { const int key = (mono(acc[ii]) & ~127) | (16 * kt + 4 * g + ii); if (kt < 4) v0[kt * 4 + ii] = key; else v1[(kt - 4) * 4 + ii] = key; }
        }
        bitonic_sort_desc<16>(v0); bitonic_sort_desc<16>(v1);
#pragma unroll
        for (int i = 0; i < 16; ++i) v0[i] = max(v0[i], v1[15 - i]);
        bitonic_merge_desc<16>(v0);
        xlane_merge16(v0, 16); xlane_merge16(v0, 32);
#pragma unroll
        for (int i = 0; i < 16; ++i) { if (p == 0) L0[i] = v0[i]; else L1[i] = v0[i]; }
    }
    if (g == 0) {
#pragma unroll
        for (int i = 0; i < 16; ++i) lst[(cq * 2 + 0) * 16 + i] = L0[i];
    }
    if (g == 1) {
#pragma unroll
        for (int i = 0; i < 16; ++i) lst[(cq * 2 + 1) * 16 + i] = L1[i];
    }
    float f0[16], f1[16];
#pragma unroll
    for (int i = 0; i < 16; ++i) { f0[i] = unmono(L0[i] & ~127); f1[i] = unmono(L1[i] & ~127); }
    int c[16];
#pragma unroll
    for (int i = 0; i < 16; ++i) {
        constexpr int NEG = (int)0x80000000;
        const float va = sel4f(g, f0[cand_a(0, i)], f0[cand_a(1, i)], f0[cand_a(2, i)], f0[cand_a(3, i) < 0 ? 0 : cand_a(3, i)]);
        const float vb = sel4f(g, f1[cand_b(0, i)], f1[cand_b(1, i)], f1[cand_b(2, i)], f1[cand_b(3, i)]);
        const int id = sel4(g, (cand_a(0, i) << 4) | cand_b(0, i), (cand_a(1, i) << 4) | cand_b(1, i), (cand_a(2, i) << 4) | cand_b(2, i), ((cand_a(3, i) < 0 ? 0 : cand_a(3, i)) << 4) | cand_b(3, i));
        int key = (mono(va + vb) & ~255) | id;
        if (cand_a(3, i) < 0) key = (g == 3) ? NEG : key;
        c[i] = key;
    }
    bitonic_sort_desc<16>(c);
    xlane_merge16(c, 16); xlane_merge16(c, 32);
    const float mx = unmono(c[0] & ~255);
    float e[16]; float sum = 0.f;
#pragma unroll
    for (int i = 0; i < 16; ++i) { e[i] = exp2f((unmono(c[i] & ~255) - mx) * LOG2E); sum += e[i]; }
    const float inv = 1.0f / sum;
    __builtin_amdgcn_wave_barrier();
    int ei[4]; float gi[4];
#pragma unroll
    for (int j = 0; j < 4; ++j) {
        const int key = sel4(g, c[j], c[4 + j], c[8 + j], c[12 + j]);
        gi[j] = sel4f(g, e[j], e[4 + j], e[8 + j], e[12 + j]) * inv;
        const int a = (key >> 4) & 15, b = key & 15;
        const int i0 = lst[(cq * 2 + 0) * 16 + a] & 127, i1 = lst[(cq * 2 + 1) * 16 + b] & 127;
        ei[j] = i0 * 128 + i1;
    }
    int* EIDX = (int*)(P.ws + WS_EIDX); float* GW = (float*)(P.ws + WS_GW);
    *(int4*)(EIDX + (size_t)tok * 128 + h * 16 + 4 * g) = make_int4(ei[0], ei[1], ei[2], ei[3]);
    *(float4*)(GW + (size_t)tok * 128 + h * 16 + 4 * g) = make_float4(gi[0], gi[1], gi[2], gi[3]);
    __builtin_amdgcn_wave_barrier();
}
__device__ __forceinline__ void phase_route(const Params& P, LAS unsigned char* lds) {
    const int tid = threadIdx.x, wave = __builtin_amdgcn_readfirstlane(tid >> 6);
    const int h = blockIdx.x & 7, slot = blockIdx.x >> 3, nslot = gridDim.x >> 3;
    const bf16_t* sk = (const bf16_t*)(P.ws + WS_SKB) + (size_t)h * 2 * 128 * 128;
#pragma unroll
    for (int it = 0; it < 8; ++it) { const int row = it * 32 + (tid >> 4), ch = tid & 15; *(LAS u32x4*)(lds + row * KVS + ch * 16) = *(const u32x4*)(sk + (size_t)row * 128 + ch * 8); }
    __syncthreads();
    LAS int* lst = (LAS int*)(lds + 73728) + wave * 512;
    for (int tg = slot; tg < NTOK / 128; tg += nslot) route_unit(P, h, tg, lds, lst);
}

__device__ __forceinline__ float ubf(unsigned x, int k) { return (float)((x >> (8 * k)) & 0xffu); }
constexpr int XSLOT = 1152, XGRP = 4 * XSLOT, XNG = 4, XWAVE = XNG * XGRP;
__device__ __forceinline__ void dma_group(__amdgpu_buffer_rsrc_t tab, int e_lo, int e_hi, int g, LAS unsigned char* sb, int lane) {
#pragma unroll
    for (int j = 0; j < 4; ++j) {
        const int k = g * 4 + j; const int e = __builtin_amdgcn_readlane(k < 64 ? e_lo : e_hi, k & 63);
        const int so = e * TROW;
        __builtin_amdgcn_raw_ptr_buffer_load_lds(tab, (LAS void*)(sb + j * XSLOT), 16, lane * 16, so, 0, 0);
        if (lane < 8) __builtin_amdgcn_raw_ptr_buffer_load_lds(tab, (LAS void*)(sb + j * XSLOT + 1024), 16, 1024 + lane * 16, so, 0, 0);
    }
}
__device__ __forceinline__ void u_consume(const LAS unsigned char* sb, const u32x4& xh, const u32x4& xl, float a_lo, float a_hi, float b_lo, float b_hi, int g, int lane, float& w_lo, float& w_hi) {
    int d[4];
#pragma unroll
    for (int j = 0; j < 4; ++j) {
        const u32x4 nb = *(const LAS u32x4*)(sb + j * XSLOT + lane * 16); const unsigned sc = *(const LAS unsigned short*)(sb + j * XSLOT + 1024 + lane * 2);
        int tot = 0;
#pragma unroll
        for (int jj = 0; jj < 2; ++jj) {
            int th = __builtin_amdgcn_sdot8((int)nb[jj * 2], (int)xh[jj * 2], 0, false); th = __builtin_amdgcn_sdot8((int)nb[jj * 2 + 1], (int)xh[jj * 2 + 1], th, false);
            int tl = __builtin_amdgcn_sdot8((int)nb[jj * 2], (int)xl[jj * 2], 0, false); tl = __builtin_amdgcn_sdot8((int)nb[jj * 2 + 1], (int)xl[jj * 2 + 1], tl, false);
            tot += (16 * th + tl) * (int)((sc >> (8 * jj)) & 255u); }
        d[j] = tot;
    }
    const auto s02 = __builtin_amdgcn_permlane32_swap((unsigned)d[0], (unsigned)d[2], false, false);
    const auto s13 = __builtin_amdgcn_permlane32_swap((unsigned)d[1], (unsigned)d[3], false, false);
    const int r0 = (int)s02[0] + (int)s02[1], r1 = (int)s13[0] + (int)s13[1];
    const auto s01 = __builtin_amdgcn_permlane16_swap((unsigned)r0, (unsigned)r1, false, false);
    int r = (int)s01[0] + (int)s01[1];
    r += __builtin_amdgcn_update_dpp(0, r, 0x128, 0xf, 0xf, false);
    r += __builtin_amdgcn_update_dpp(0, r, 0x124, 0xf, 0xf, false);
    r += __builtin_amdgcn_update_dpp(0, r, 0x4E, 0xf, 0xf, false);
    r += __builtin_amdgcn_update_dpp(0, r, 0xB1, 0xf, 0xf, false);
    const int tot = __shfl(r, (lane & 3) * 16);
    const bool mine = ((lane >> 2) == (g & 15));
    const bool hi = g >= 16;
    const float wv = (hi ? b_hi : b_lo) * gelu_as((float)tot * (hi ? a_hi : a_lo));
    if (hi) w_hi = mine ? wv : w_hi; else w_lo = mine ? wv : w_lo;
}
__device__ __forceinline__ void v_consume(const LAS unsigned char* sb, int (&acc)[32], int (&bias)[2], float w_lo, float w_hi, float inv_sw, int g, int lane) {
    u32x4 nb[4]; int wq[2] = {0, 0};
#pragma unroll
    for (int j = 0; j < 4; ++j) {
        const int k = g * 4 + j; const float w = readlane_f(k < 64 ? w_lo : w_hi, k & 63) * inv_sw;
        nb[j] = *(const LAS u32x4*)(sb + j * XSLOT + lane * 16); const unsigned sc = *(const LAS unsigned short*)(sb + j * XSLOT + 1024 + lane * 2);
#pragma unroll
        for (int jj = 0; jj < 2; ++jj) { const int q = (int)rintf(w * (float)((sc >> (8 * jj)) & 255u)); wq[jj] |= (q & 255) << (8 * j); }
    }
    bias[0] = __builtin_amdgcn_sdot4(wq[0], 0x01010101, bias[0], false); bias[1] = __builtin_amdgcn_sdot4(wq[1], 0x01010101, bias[1], false);
#pragma unroll
    for (int i = 0; i < 4; ++i) {
        const unsigned r0 = nb[0][i], r1 = nb[1][i], r2 = nb[2][i], r3 = nb[3][i];
        const unsigned p01a = __builtin_amdgcn_perm(r1, r0, 0x05010400u), p01b = __builtin_amdgcn_perm(r1, r0, 0x07030602u);
        const unsigned p23a = __builtin_amdgcn_perm(r3, r2, 0x05010400u), p23b = __builtin_amdgcn_perm(r3, r2, 0x07030602u);
        const unsigned t0 = __builtin_amdgcn_perm(p23a, p01a, 0x05040100u), t1 = __builtin_amdgcn_perm(p23a, p01a, 0x07060302u);
        const unsigned t2 = __builtin_amdgcn_perm(p23b, p01b, 0x05040100u), t3 = __builtin_amdgcn_perm(p23b, p01b, 0x07060302u);
        const int wv = wq[i >> 1];
        acc[i * 8 + 0] = __builtin_amdgcn_sdot4((int)(t0 & 0x0F0F0F0Fu), wv, acc[i * 8 + 0], false); acc[i * 8 + 1] = __builtin_amdgcn_sdot4((int)((t0 >> 4) & 0x0F0F0F0Fu), wv, acc[i * 8 + 1], false);
        acc[i * 8 + 2] = __builtin_amdgcn_sdot4((int)(t1 & 0x0F0F0F0Fu), wv, acc[i * 8 + 2], false); acc[i * 8 + 3] = __builtin_amdgcn_sdot4((int)((t1 >> 4) & 0x0F0F0F0Fu), wv, acc[i * 8 + 3], false);
        acc[i * 8 + 4] = __builtin_amdgcn_sdot4((int)(t2 & 0x0F0F0F0Fu), wv, acc[i * 8 + 4], false); acc[i * 8 + 5] = __builtin_amdgcn_sdot4((int)((t2 >> 4) & 0x0F0F0F0Fu), wv, acc[i * 8 + 5], false);
        acc[i * 8 + 6] = __builtin_amdgcn_sdot4((int)(t3 & 0x0F0F0F0Fu), wv, acc[i * 8 + 6], false); acc[i * 8 + 7] = __builtin_amdgcn_sdot4((int)((t3 >> 4) & 0x0F0F0F0Fu), wv, acc[i * 8 + 7], false);
    }
}
__device__ __forceinline__ void exp_epilogue(const Params& P, int row, int ln, const int (&acc)[32], const int (&bias)[2], float scale_w) {
    const bf16_t* x1b = (const bf16_t*)(P.ws + WS_X1B);
    float val[32]; float s = 0.f;
#pragma unroll
    for (int jj = 0; jj < 2; ++jj) {
        const int b8 = 8 * bias[jj];
#pragma unroll
        for (int hh = 0; hh < 2; ++hh) {
            const u32x4 xa = *(const u32x4*)(x1b + (size_t)row * D + jj * 1024 + ln * 16 + hh * 8);
#pragma unroll
            for (int i = 0; i < 4; ++i) { const int e0 = jj * 16 + hh * 8 + 2 * i;
                val[e0] = scale_w * (float)(acc[e0] - b8) + ALPHA * bflo(xa[i]); val[e0 + 1] = scale_w * (float)(acc[e0 + 1] - b8) + ALPHA * bfhi(xa[i]); s += val[e0] + val[e0 + 1]; }
        }
    }
    const float mean = wave_sum(s) * (1.0f / D); float q = 0.f;
#pragma unroll
    for (int i = 0; i < 32; ++i) { const float d0 = val[i] - mean; q += d0 * d0; }
    const float rstd = rsqrtf(wave_sum(q) * (1.0f / D) + LN_EPS);
    float* yo = P.out + (row < NTOK_P ? O_YP + (size_t)row * D : O_YS + (size_t)(row - NTOK_P) * D);
    const int lo16 = ln * 16;
#pragma unroll
    for (int jj = 0; jj < 2; ++jj)
#pragma unroll
        for (int i = 0; i < 4; ++i) {
            const int col = jj * 1024 + lo16 + i * 4;
            const float4 g0 = *(const float4*)(P.ln2_g + col), b0 = *(const float4*)(P.ln2_b + col);
            float4 o;
            o.x = (val[jj * 16 + i * 4 + 0] - mean) * rstd * g0.x + b0.x; o.y = (val[jj * 16 + i * 4 + 1] - mean) * rstd * g0.y + b0.y;
            o.z = (val[jj * 16 + i * 4 + 2] - mean) * rstd * g0.z + b0.z; o.w = (val[jj * 16 + i * 4 + 3] - mean) * rstd * g0.w + b0.w;
            *(float4*)(yo + col) = o;
        }
}
__device__ __forceinline__ void phase_experts(const Params& P, LAS unsigned char* lds) {
    const int lane = threadIdx.x & 63, wave = __builtin_amdgcn_readfirstlane(threadIdx.x >> 6);
    const int* EIDX = (const int*)(P.ws + WS_EIDX); const float* GW = (const float*)(P.ws + WS_GW);
    const __amdgpu_buffer_rsrc_t UQ = __builtin_amdgcn_make_buffer_rsrc((void*)(P.ws + WS_UB), 0, NEXP * TROW, 0x00020000);
    const __amdgpu_buffer_rsrc_t VQ = __builtin_amdgcn_make_buffer_rsrc((void*)(P.ws + WS_VB), 0, NEXP * TROW, 0x00020000);
    const float* SU = (const float*)(P.ws + WS_SU); const float* SV = (const float*)(P.ws + WS_SV); const float* SX = (const float*)(P.ws + WS_SX);
    LAS unsigned char* wb = lds + wave * XWAVE;
    constexpr int TPW = 8;
    const int row0 = blockIdx.x * 8 + wave, rstride = gridDim.x * 8;
    if (row0 + (TPW - 1) * rstride < NTOK_P) {
        u32x4 mxh[TPW], mxl[TPW]; int mel[TPW], meh[TPW]; float mal[TPW], mah[TPW], mbl[TPW], mbh[TPW];
#pragma unroll
        for (int i = 0; i < TPW; ++i) {
            const int row = row0 + i * rstride;
            mxh[i] = *(const u32x4*)(P.ws + WS_X1Q + (size_t)row * D + lane * 32); mxl[i] = *(const u32x4*)(P.ws + WS_X1Q + (size_t)row * D + lane * 32 + 16);
            mel[i] = EIDX[(size_t)row * 128 + lane]; meh[i] = EIDX[(size_t)row * 128 + 64 + lane];
            const float sx = SX[row];
            mal[i] = SU[mel[i]] * sx; mah[i] = SU[meh[i]] * sx; mbl[i] = GW[(size_t)row * 128 + lane] * SV[mel[i]]; mbh[i] = GW[(size_t)row * 128 + 64 + lane] * SV[meh[i]];
        }
        asm volatile("s_waitcnt vmcnt(0)" ::: "memory");
        dma_group(UQ, mel[0], meh[0], 0, wb, lane); dma_group(UQ, mel[0], meh[0], 1, wb + XGRP, lane); dma_group(UQ, mel[0], meh[0], 2, wb + 2 * XGRP, lane);
        int sg = 0;
#pragma unroll 1
        for (int i = 0; i < TPW; ++i) {
            const int row = row0 + i * rstride;
            u32x4 xh = mxh[0], xl = mxl[0]; int e_lo = mel[0], e_hi = meh[0], n_lo = mel[TPW - 1], n_hi = meh[TPW - 1]; float a_lo = mal[0], a_hi = mah[0], b_lo = mbl[0], b_hi = mbh[0];
#pragma unroll
            for (int j = 1; j < TPW; ++j) { const bool m = (i == j);
                xh[0] = m ? mxh[j][0] : xh[0]; xh[1] = m ? mxh[j][1] : xh[1]; xh[2] = m ? mxh[j][2] : xh[2]; xh[3] = m ? mxh[j][3] : xh[3];
                xl[0] = m ? mxl[j][0] : xl[0]; xl[1] = m ? mxl[j][1] : xl[1]; xl[2] = m ? mxl[j][2] : xl[2]; xl[3] = m ? mxl[j][3] : xl[3];
                e_lo = m ? mel[j] : e_lo; e_hi = m ? meh[j] : e_hi; a_lo = m ? mal[j] : a_lo; a_hi = m ? mah[j] : a_hi; b_lo = m ? mbl[j] : b_lo; b_hi = m ? mbh[j] : b_hi; }
#pragma unroll
            for (int j = 0; j < TPW - 1; ++j) { const bool m = (i == j); n_lo = m ? mel[j + 1] : n_lo; n_hi = m ? meh[j + 1] : n_hi; }
            const bool has_next = i + 1 < TPW;
            float w_lo = 0.f, w_hi = 0.f;
#pragma unroll 1
            for (int g = 0; g < 32; ++g) {
                const int sn = (sg + 3) & 3;
                if (g + 3 < 32) dma_group(UQ, e_lo, e_hi, g + 3, wb + sn * XGRP, lane); else dma_group(VQ, e_lo, e_hi, g + 3 - 32, wb + sn * XGRP, lane);
                asm volatile("s_waitcnt vmcnt(24)" ::: "memory");
                u_consume(wb + sg * XGRP, xh, xl, a_lo, a_hi, b_lo, b_hi, g, lane, w_lo, w_hi);
                sg = (sg + 1) & 3;
            }
            float wmax = wave_max(fmaxf(fabsf(w_lo), fabsf(w_hi))); if (wmax == 0.f) wmax = 1.f;
            const float scale_w = wmax * (255.0f / 127.0f), inv_sw = 1.0f / scale_w;
            int acc[32]; int bias[2] = {0, 0};
#pragma unroll
            for (int q = 0; q < 32; ++q) acc[q] = 0;
#pragma unroll 1
            for (int g = 0; g < 32; ++g) {
                const int sn = (sg + 3) & 3;
                if (g + 3 < 32) dma_group(VQ, e_lo, e_hi, g + 3, wb + sn * XGRP, lane);
                else if (has_next) dma_group(UQ, n_lo, n_hi, g + 3 - 32, wb + sn * XGRP, lane);
                else dma_group(VQ, e_lo, e_hi, g + 3 - 32, wb + sn * XGRP, lane);
                asm volatile("s_waitcnt vmcnt(24)" ::: "memory");
                v_consume(wb + sg * XGRP, acc, bias, w_lo, w_hi, inv_sw, g, lane);
                sg = (sg + 1) & 3;
            }
            int ln = lane; asm volatile("" : "+v"(ln));
            exp_epilogue(P, row, ln, acc, bias, scale_w);
        }
        asm volatile("s_waitcnt vmcnt(0)" ::: "memory");
    }
    for (int row = row0 + ((row0 + (TPW - 1) * rstride < NTOK_P) ? TPW * rstride : 0); row < NTOK_P; row += rstride) {
        int ln = lane; asm volatile("" : "+v"(ln));
        const u32x4 xh = *(const u32x4*)(P.ws + WS_X1Q + (size_t)row * D + ln * 32), xl = *(const u32x4*)(P.ws + WS_X1Q + (size_t)row * D + ln * 32 + 16);
        const float sx = SX[row];
        const int e_lo = EIDX[(size_t)row * 128 + ln], e_hi = EIDX[(size_t)row * 128 + 64 + ln];
        const float g_lo = GW[(size_t)row * 128 + ln], g_hi = GW[(size_t)row * 128 + 64 + ln];
        const float a_lo = SU[e_lo] * sx, a_hi = SU[e_hi] * sx, b_lo = g_lo * SV[e_lo], b_hi = g_hi * SV[e_hi];
        float w_lo = 0.f, w_hi = 0.f;
        asm volatile("s_waitcnt vmcnt(0)" ::: "memory");
        dma_group(UQ, e_lo, e_hi, 0, wb, lane); dma_group(UQ, e_lo, e_hi, 1, wb + XGRP, lane); dma_group(UQ, e_lo, e_hi, 2, wb + 2 * XGRP, lane);
        int sg = 0;
#pragma unroll 1
        for (int g = 0; g < 32; ++g) {
            const int sn = (sg + 3) & 3;
            if (g + 3 < 32) dma_group(UQ, e_lo, e_hi, g + 3, wb + sn * XGRP, lane); else dma_group(VQ, e_lo, e_hi, g + 3 - 32, wb + sn * XGRP, lane);
            asm volatile("s_waitcnt vmcnt(24)" ::: "memory");
            u_consume(wb + sg * XGRP, xh, xl, a_lo, a_hi, b_lo, b_hi, g, lane, w_lo, w_hi);
            sg = (sg + 1) & 3;
        }
        float wmax = wave_max(fmaxf(fabsf(w_lo), fabsf(w_hi))); if (wmax == 0.f) wmax = 1.f;
        const float scale_w = wmax * (255.0f / 127.0f), inv_sw = 1.0f / scale_w;
        int acc[32]; int bias[2] = {0, 0};
#pragma unroll
        for (int i = 0; i < 32; ++i) acc[i] = 0;
#pragma unroll 1
        for (int g = 0; g < 32; ++g) {
            const int sn = (sg + 3) & 3;
            dma_group(VQ, e_lo, e_hi, (g + 3) & 31, wb + sn * XGRP, lane);
            asm volatile("s_waitcnt vmcnt(24)" ::: "memory");
            v_consume(wb + sg * XGRP, acc, bias, w_lo, w_hi, inv_sw, g, lane);
            sg = (sg + 1) & 3;
        }
        asm volatile("s_waitcnt vmcnt(0)" ::: "memory");
        exp_epilogue(P, row, ln, acc, bias, scale_w);
    }
    LAS int* cmax = (LAS int*)(lds + MISC_OFF + 64);
    __syncthreads();
    for (int ct = blockIdx.x; ct < NTOK_S; ct += gridDim.x) {
        const int row = NTOK_P + ct;
        int ln = lane; asm volatile("" : "+v"(ln));
        const u32x4 xh = *(const u32x4*)(P.ws + WS_X1Q + (size_t)row * D + ln * 32), xl = *(const u32x4*)(P.ws + WS_X1Q + (size_t)row * D + ln * 32 + 16);
        const float sx = SX[row];
        const int kk = 16 * wave + (ln & 15);
        const int e_loc = EIDX[(size_t)row * 128 + kk]; const float g_loc = GW[(size_t)row * 128 + kk];
        const float a_loc = SU[e_loc] * sx, b_loc = g_loc * SV[e_loc];
        float w_loc = 0.f, w_dummy = 0.f;
        asm volatile("s_waitcnt vmcnt(0)" ::: "memory");
#pragma unroll
        for (int g = 0; g < 4; ++g) dma_group(UQ, e_loc, e_loc, g, wb + g * XGRP, lane);
        asm volatile("s_waitcnt vmcnt(0)" ::: "memory");
#pragma unroll
        for (int g = 0; g < 4; ++g) u_consume(wb + g * XGRP, xh, xl, a_loc, a_loc, b_loc, b_loc, g, lane, w_loc, w_dummy);
#pragma unroll
        for (int g = 0; g < 4; ++g) dma_group(VQ, e_loc, e_loc, g, wb + g * XGRP, lane);
        const float wm = wave_max(ln < 16 ? fabsf(w_loc) : 0.f);
        if (lane == 0) cmax[wave] = __float_as_int(wm);
        __syncthreads();
        float wmax = 0.f;
#pragma unroll
        for (int ww = 0; ww < 8; ++ww) wmax = fmaxf(wmax, __int_as_float(cmax[ww]));
        if (wmax == 0.f) wmax = 1.f;
        const float scale_w = wmax * (255.0f / 127.0f), inv_sw = 1.0f / scale_w;
        int acc[32]; int bias[2] = {0, 0};
#pragma unroll
        for (int i = 0; i < 32; ++i) acc[i] = 0;
        asm volatile("s_waitcnt vmcnt(0)" ::: "memory");
#pragma unroll
        for (int g = 0; g < 4; ++g) v_consume(wb + g * XGRP, acc, bias, w_loc, w_loc, inv_sw, g, lane);
        __builtin_amdgcn_wave_barrier();
        {
            LAS int* pp = (LAS int*)wb + lane * 36;
#pragma unroll
            for (int i = 0; i < 8; ++i) *(LAS u32x4*)(pp + 4 * i) = (u32x4){(unsigned)acc[4 * i], (unsigned)acc[4 * i + 1], (unsigned)acc[4 * i + 2], (unsigned)acc[4 * i + 3]};
            pp[32] = bias[0]; pp[33] = bias[1];
        }
        __syncthreads();
        if (wave == 0) {
#pragma unroll
            for (int i = 0; i < 32; ++i) acc[i] = 0;
            bias[0] = 0; bias[1] = 0;
#pragma unroll 1
            for (int ww = 0; ww < 8; ++ww) {
                const LAS int* pp = (const LAS int*)(lds + ww * XWAVE) + lane * 36;
#pragma unroll
                for (int i = 0; i < 8; ++i) { const u32x4 t = *(const LAS u32x4*)(pp + 4 * i); acc[4 * i] += (int)t[0]; acc[4 * i + 1] += (int)t[1]; acc[4 * i + 2] += (int)t[2]; acc[4 * i + 3] += (int)t[3]; }
                bias[0] += pp[32]; bias[1] += pp[33];
            }
            exp_epilogue(P, row, ln, acc, bias, scale_w);
        }
        __syncthreads();
    }
}

constexpr int NPHASE = 11;
__global__ void __launch_bounds__(NTHREADS, 2) fwd(Params P) {
    extern __shared__ __attribute__((aligned(16))) unsigned char lds_raw[];
    LAS unsigned char* lds = (LAS unsigned char*)lds_raw;
    volatile LAS unsigned* misc = (volatile LAS unsigned*)(lds + MISC_OFF);
    const int lo = P.ph_lo, hi = P.ph_hi;
    XcdBarrier bar; bar.bar = (unsigned*)(P.ws + WS_CTL); bar.x = 0; bar.st = nullptr;
    if (hi - lo > 1) {
        if (threadIdx.x == 0) { misc[0] = 0u; misc[1] = 0u; misc[2] = 0u; misc[3] = 0u; }
        __syncthreads();
        bar = xcd_barrier_post((unsigned*)(P.ws + WS_CTL), misc);
    }
#ifndef MK_REPMASK
#define MK_REPMASK 0
#endif
#ifndef MK_PHASE_MASK
#define MK_PHASE_MASK 0x7ff
#endif
#define IN(k) (((MK_PHASE_MASK >> (k)) & 1) && lo <= (k) && (k) < hi)
#define SEAM(k) do { if (IN(k) && IN((k) + 1)) xcd_barrier(bar); } while (0)
    if (IN(0)) { phase_prologue(P, lds); }
    SEAM(0);
    if (IN(1)) {
        pg8::Gemm g{(const pg8::bf16_t*)(P.ws + WS_XB), (const pg8::bf16_t*)(P.ws + WS_WINT), NTOK, DIN, D};
        pg8::StaticOrder S; S.init(NTOK, DIN, (int)gridDim.x, (int)blockIdx.x);
        EpiProj E{P.out, (bf16_t*)(P.ws + WS_XR), (bf16_t*)(P.ws + WS_GATE), (bf16_t*)(P.ws + WS_QB), (bf16_t*)(P.ws + WS_KB), (bf16_t*)(P.ws + WS_VB16)};
        pg8::gemm_phase<EpiProj, pg8::StaticOrder, false>(lds, g, S, E, nullptr);
    }
    SEAM(1);
    if (IN(2)) { phase_lru(P, lds); }
    if (IN(3)) { phase_samp(P, lds); }
    if (IN(4)) { phase_attn01(P, lds); }
    SEAM(4);
    if (IN(5)) { phase_mix_b(P, lds); }
    SEAM(5);
    if (IN(6)) {
        sample_rows_gemm<0>(P, (const bf16_t*)(P.ws + WS_AR), (const bf16_t*)(P.ws + WS_WOT), lds);
        pg8::Gemm g{(const pg8::bf16_t*)(P.ws + WS_AR), (const pg8::bf16_t*)(P.ws + WS_WOT), NTOK_P, D, D};
        pg8::StaticOrder S; S.init(NTOK_P, D, (int)gridDim.x, (int)blockIdx.x);
        EpiOut E{(const bf16_t*)(P.ws + WS_XB), (bf16_t*)(P.ws + WS_PRE1)};
        pg8::gemm_phase<EpiOut, pg8::StaticOrder, false>(lds, g, S, E, nullptr);
    }
    SEAM(6);
    if (IN(7)) { phase_ln1(P); }
    SEAM(7);
    if (IN(8)) {
        sample_rows_gemm<1>(P, (const bf16_t*)(P.ws + WS_X1B), (const bf16_t*)(P.ws + WS_WQT), lds);
        pg8::Gemm g{(const pg8::bf16_t*)(P.ws + WS_X1B), (const pg8::bf16_t*)(P.ws + WS_WQT), NTOK_P, D, D};
        pg8::StaticOrder S; S.init(NTOK_P, D, (int)gridDim.x, (int)blockIdx.x);
        EpiBf16Plain E{(bf16_t*)(P.ws + WS_QP), D};
        pg8::gemm_phase<EpiBf16Plain, pg8::StaticOrder, false>(lds, g, S, E, nullptr);
    }
    SEAM(8);
    if (IN(9)) { phase_route(P, lds); }
    SEAM(9);
    if (IN(10)) { phase_experts(P, lds); }
#undef IN
#undef SEAM
}
}

extern "C" void kernel_launch(void* const* d_in, const int* in_sizes, int n_in, void* d_out, int out_size, void* d_ws, size_t ws_size, hipStream_t stream) {
    using namespace mk;
    static int grid = 0;
    if (grid == 0) {
        if (n_in != 23 || (size_t)out_size != O_END || ws_size < WS_END) { fprintf(stderr, "kernel_launch: unexpected shapes: n_in %d out %d ws %zu (need %zu)\n", n_in, out_size, ws_size, (size_t)WS_END); grid = -1; return; }
        int dev = 0, cus = 0, per_cu = 0;
        if (hipGetDevice(&dev) != hipSuccess || hipDeviceGetAttribute(&cus, hipDeviceAttributeMultiprocessorCount, dev) != hipSuccess) { grid = -1; return; }
        if (hipFuncSetAttribute((const void*)fwd, hipFuncAttributeMaxDynamicSharedMemorySize, LDS_BYTES) != hipSuccess) { fprintf(stderr, "kernel_launch: hipFuncSetAttribute failed\n"); grid = -1; return; }
        if (hipOccupancyMaxActiveBlocksPerMultiprocessor(&per_cu, (const void*)fwd, NTHREADS, LDS_BYTES) != hipSuccess || per_cu < 1) { fprintf(stderr, "kernel_launch: occupancy query says %d\n", per_cu); }
        (void)hipGetLastError();
        grid = cus;
    }
    if (grid < 0) return;
    (void)hipMemsetAsync((char*)d_ws + WS_CTL, 0, 65536, stream);
    Params p{};
    p.x_prompt = (const float*)d_in[0]; p.x_sample = (const float*)d_in[1]; p.cache_k = (const float*)d_in[2]; p.cache_v = (const float*)d_in[3];
    p.state_conv = (const float*)d_in[4]; p.state_h = (const float*)d_in[5]; p.w_in = (const float*)d_in[6]; p.conv_w = (const float*)d_in[7]; p.conv_b = (const float*)d_in[8];
    p.lru_w_a = (const float*)d_in[9]; p.lru_b_a = (const float*)d_in[10]; p.lru_w_x = (const float*)d_in[11]; p.lru_b_x = (const float*)d_in[12]; p.lru_lambda = (const float*)d_in[13];
    p.w_out = (const float*)d_in[14]; p.ln1_g = (const float*)d_in[15]; p.ln1_b = (const float*)d_in[16]; p.w_query = (const float*)d_in[17]; p.sub_keys = (const float*)d_in[18];
    p.peer_u = (const float*)d_in[19]; p.peer_v = (const float*)d_in[20]; p.ln2_g = (const float*)d_in[21]; p.ln2_b = (const float*)d_in[22];
    p.out = (float*)d_out; p.ws = (unsigned char*)d_ws;
#if MK_N_LAUNCHES == 1
    p.ph_lo = 0; p.ph_hi = NPHASE;
    hipLaunchKernelGGL(fwd, dim3(grid), dim3(NTHREADS), LDS_BYTES, stream, p);
#else
    for (int k = 0; k < NPHASE; ++k) { p.ph_lo = k; p.ph_hi = k + 1; hipLaunchKernelGGL(fwd, dim3(grid), dim3(NTHREADS), LDS_BYTES, stream, p);
#ifdef MK_EXTRA_PHASE
        if (k == MK_EXTRA_PHASE) hipLaunchKernelGGL(fwd, dim3(grid), dim3(NTHREADS), LDS_BYTES, stream, p);
#endif
    }
#endif
    const hipError_t le = hipPeekAtLastError();
    if (le != hipSuccess) fprintf(stderr, "kernel_launch: launch failed: %s\n", hipGetErrorName(le));
}
```

```cpp
#include <hip/hip_runtime.h>
#include <cstdio>
#include <cstdint>
namespace pg8 {
#define PG8_LAS __attribute__((address_space(3)))
typedef unsigned short bf16_t;
typedef short bf16x8 __attribute__((ext_vector_type(8)));
typedef float f32x4 __attribute__((ext_vector_type(4)));
typedef unsigned u32x4 __attribute__((ext_vector_type(4)));
constexpr int BM = 256, BK = 64, HALF = 128, HTB = HALF * BK * 2  , STAGE_BYTES = 8 * HTB, NXCD = 8, WGM = 8;

__host__ __device__ __forceinline__ int lds_byte(int r, int c) { const int st = (r >> 4) * 2 + (c >> 5), rr = r & 15, cc = c & 31, ob = rr * 64 + cc * 2; return st * 1024 + (ob ^ (((ob >> 9) & 1) << 5)); }
__host__ __device__ __forceinline__ void stage_rc(int b, int& R, int& C) { const int st = b / 1024, sb = b % 1024, swz = sb ^ (((sb >> 9) & 1) << 5); R = (st >> 1) * 16 + swz / 64; C = (st & 1) * 32 + (swz % 64) / 2; }
__host__ __device__ __forceinline__ int perm32(int rho) { const int n = rho >> 4, i = rho & 15; return 8 * (i >> 2) + 4 * n + (i & 3); }

struct Unit { int pm, pn; };
struct Gemm { const bf16_t* A; const bf16_t* Bt; int M, N, K; };

struct StaticOrder {
    int nM, nN, nwg, G, c;
    __host__ __device__ void init(int M, int N, int G_, int c_) { nM = M / BM; nN = N / BM; nwg = nM * nN; G = G_; c = c_; }
    __host__ __device__ bool next(int i, Unit& u) const {
        const long L = (long)i * G + c; if (L >= nwg) return false;
        int wgid = (int)L; { const int q = nwg / NXCD, r = nwg % NXCD, xcd = wgid % NXCD, off = wgid / NXCD; wgid = (xcd < r ? xcd * (q + 1) : r * (q + 1) + (xcd - r) * q) + off; }
        const int nig = WGM * nN, gid = wgid / nig, fm = gid * WGM, gsz = (nM - fm) < WGM ? (nM - fm) : WGM;
        u.pm = fm + ((wgid % nig) % gsz); u.pn = (wgid % nig) / gsz; return true;
    }
    __device__ __forceinline__ void a_ready(const Unit&) const {}
    __device__ __forceinline__ void done(const Unit&) const {}
};
struct CountedOrder : StaticOrder {
    const unsigned* ready; unsigned need; unsigned* tmo;
    __device__ __forceinline__ void a_ready(const Unit& u) const {
        if (threadIdx.x < 64) {
            const unsigned long long t0 = __builtin_amdgcn_s_memrealtime(); unsigned polls = 0;
            while ((unsigned)__builtin_amdgcn_readfirstlane(__hip_atomic_load(ready + 64 * u.pm, __ATOMIC_RELAXED, __HIP_MEMORY_SCOPE_AGENT)) < need) {
                if ((++polls & 255u) == 0u && __builtin_amdgcn_readfirstlane(__hip_atomic_load(tmo, __ATOMIC_RELAXED, __HIP_MEMORY_SCOPE_AGENT)) != 0u) break;
                if (__builtin_amdgcn_s_memrealtime() - t0 > 2000000ull) {
                    if (threadIdx.x == 0) { unsigned expect = 0u; __hip_atomic_compare_exchange_strong(tmo + 1, &expect, 0x600u | (unsigned)(u.pm & 0xff), __ATOMIC_RELAXED, __ATOMIC_RELAXED, __HIP_MEMORY_SCOPE_AGENT); __hip_atomic_store(tmo, 1u, __ATOMIC_RELAXED, __HIP_MEMORY_SCOPE_AGENT); }
                    break; }
                __builtin_amdgcn_s_sleep(2); }
            __builtin_amdgcn_fence(__ATOMIC_ACQUIRE, "agent");
            asm volatile("s_waitcnt vmcnt(0)" ::: "memory");
        }
#if !defined(BROKEN_HOOK_NO_BARRIER)
        asm volatile("" ::: "memory"); __builtin_amdgcn_s_barrier(); asm volatile("" ::: "memory");
#endif
    }
};

__device__ __forceinline__ unsigned cvt_pk_bf16(float lo, float hi) { unsigned r; asm volatile("v_cvt_pk_bf16_f32 %0, %1, %2" : "=v"(r) : "v"(lo), "v"(hi)); return r; }
typedef float f32x2 __attribute__((ext_vector_type(2)));
__device__ __forceinline__ f32x2 gelu_pk(f32x2 v) {
    const f32x2 av = __builtin_elementwise_abs(v), d = av * 0.2316418882f + 1.0f;
    f32x2 t; t.x = __builtin_amdgcn_rcpf(d.x); t.y = __builtin_amdgcn_rcpf(d.y);
    f32x2 q = t * 0.5307027145f + (-0.7265760135f); q = q * t + 0.7107068705f; q = q * t + (-0.142248368f); q = q * t + 0.127414796f; q = q * t;
    const f32x2 s = (v * v) * (-0.72134752044f);
    f32x2 e; e.x = __builtin_amdgcn_exp2f(s.x); e.y = __builtin_amdgcn_exp2f(s.y);
    const f32x2 m = v * (q * e), r = v - m;
    f32x2 o; o.x = v.x < 0.f ? m.x : r.x; o.y = v.y < 0.f ? m.y : r.y; return o;
}

struct EpiF32 {
    static constexpr bool PERM = false, AFTER_DRAIN = false;
    float* C; int ldc; const float* bias;
    __device__ __forceinline__ void operator()(const f32x4 (&acc)[2][2][4][2], const Unit& u, int wr, int wc, int fr, int fq) const {
        const int row0 = u.pm * BM + wr * 64 + fr, col0 = u.pn * BM + wc * 32 + 4 * fq;
        f32x4 bv[2][2];
#pragma unroll
        for (int bj = 0; bj < 2; ++bj)
#pragma unroll
            for (int n = 0; n < 2; ++n) bv[bj][n] = bias ? *(const f32x4*)(bias + col0 + bj * HALF + n * 16) : (f32x4){0.f, 0.f, 0.f, 0.f};
#pragma unroll
        for (int ai = 0; ai < 2; ++ai)
#pragma unroll
            for (int m = 0; m < 4; ++m) { float* rowp = C + (size_t)(row0 + ai * HALF + m * 16) * ldc + col0;
#pragma unroll
                for (int bj = 0; bj < 2; ++bj)
#pragma unroll
                    for (int n = 0; n < 2; ++n) *(f32x4*)(rowp + bj * HALF + n * 16) = acc[ai][bj][m][n] + bv[bj][n]; }
    }
};
template <int ACT  > struct EpiBf16 {
    static constexpr bool PERM = true, AFTER_DRAIN = false;
    bf16_t* O; int ldc; const float* bias; int split_cols; size_t split_stride;
    __device__ __forceinline__ void operator()(const f32x4 (&acc)[2][2][4][2], const Unit& u, int wr, int wc, int fr, int fq) const {
        const int row0 = u.pm * BM + wr * 64 + fr; int colt = u.pn * BM; bf16_t* base = O;
        if (split_cols) { const int t = colt / split_cols; base += (size_t)t * split_stride; colt -= t * split_cols; }
        const int col0 = colt + wc * 32 + 8 * fq, bcol0 = u.pn * BM + wc * 32 + 8 * fq;
        f32x4 bv[2][2];
#pragma unroll
        for (int bj = 0; bj < 2; ++bj)
#pragma unroll
            for (int n = 0; n < 2; ++n) bv[bj][n] = bias ? *(const f32x4*)(bias + bcol0 + bj * HALF + 4 * n) : (f32x4){0.f, 0.f, 0.f, 0.f};
#pragma unroll
        for (int ai = 0; ai < 2; ++ai)
#pragma unroll
            for (int m = 0; m < 4; ++m) { bf16_t* rowp = base + (size_t)(row0 + ai * HALF + m * 16) * ldc + col0;
#pragma unroll
                for (int bj = 0; bj < 2; ++bj) { f32x4 v0 = acc[ai][bj][m][0] + bv[bj][0], v1 = acc[ai][bj][m][1] + bv[bj][1];
                    if (ACT == 1) { f32x2 a = gelu_pk((f32x2){v0[0], v0[1]}), b = gelu_pk((f32x2){v0[2], v0[3]}), c = gelu_pk((f32x2){v1[0], v1[1]}), d = gelu_pk((f32x2){v1[2], v1[3]});
                        v0 = (f32x4){a.x, a.y, b.x, b.y}; v1 = (f32x4){c.x, c.y, d.x, d.y}; }
                    if (ACT == 2) {
#pragma unroll
                        for (int j = 0; j < 4; ++j) { v0[j] = 0.5f * v0[j] * (1.0f + erff(v0[j] * 0.70710678f)); v1[j] = 0.5f * v1[j] * (1.0f + erff(v1[j] * 0.70710678f)); } }
                    u32x4 w; w.x = cvt_pk_bf16(v0[0], v0[1]); w.y = cvt_pk_bf16(v0[2], v0[3]); w.z = cvt_pk_bf16(v1[0], v1[1]); w.w = cvt_pk_bf16(v1[2], v1[3]);
                    *(u32x4*)(rowp + bj * HALF) = w; } }
    }
};

struct PanelStats {
    unsigned* xbuf;
    unsigned* cnt;
    unsigned* tmo;
    int ntn; float eps;
    unsigned code;
    __device__ __forceinline__ bool run(const f32x4 (&v)[2][2][4][2], const Unit& u, int wr, int wc, int fr, int fq, PG8_LAS unsigned char* lds, int wid, int lane) const {
        typedef float f32x2v __attribute__((ext_vector_type(2)));
        PG8_LAS f32x2v* P = (PG8_LAS f32x2v*)lds;
        PG8_LAS f32x2v* S = (PG8_LAS f32x2v*)(lds + 8192);
        PG8_LAS unsigned* flag = (PG8_LAS unsigned*)(lds + 8192 + 2048);
#pragma unroll
        for (int ai = 0; ai < 2; ++ai)
#pragma unroll
            for (int m = 0; m < 4; ++m) {
                float s = 0.f;
#pragma unroll
                for (int bj = 0; bj < 2; ++bj)
#pragma unroll
                    for (int n = 0; n < 2; ++n) { const f32x4 x = v[ai][bj][m][n]; s += (x[0] + x[1]) + (x[2] + x[3]); }
                s += __shfl_xor(s, 16); s += __shfl_xor(s, 32);
                const float mw = s * (1.0f / 64.0f); float q = 0.f;
#pragma unroll
                for (int bj = 0; bj < 2; ++bj)
#pragma unroll
                    for (int n = 0; n < 2; ++n) { const f32x4 d = v[ai][bj][m][n] - mw; q += (d[0] * d[0] + d[1] * d[1]) + (d[2] * d[2] + d[3] * d[3]); }
                q += __shfl_xor(q, 16); q += __shfl_xor(q, 32);
                if (fq == 0) P[(ai * HALF + wr * 64 + m * 16 + fr) * 4 + wc] = (f32x2v){mw, q};
            }
        asm volatile("s_waitcnt lgkmcnt(0)" ::: "memory"); __builtin_amdgcn_s_barrier(); asm volatile("" ::: "memory");
#if defined(BROKEN_NO_WAIT)
        if (blockIdx.x >= 64) { const long long t0 = clock64(); while (clock64() - t0 < 60000) __builtin_amdgcn_s_sleep(8); }
#endif
        const int row = wid * 32 + (lane & 31);
        if (lane < 32) {
            const f32x2v a = P[row * 4 + 0], b = P[row * 4 + 1], c = P[row * 4 + 2], d = P[row * 4 + 3];
            const float mt = (a.x + b.x + c.x + d.x) * 0.25f;
            const float da = a.x - mt, db = b.x - mt, dc = c.x - mt, dd = d.x - mt;
            const float m2 = (a.y + b.y) + (c.y + d.y) + 64.0f * ((da * da + db * db) + (dc * dc + dd * dd));
            unsigned long long* slot = (unsigned long long*)xbuf + ((size_t)(u.pm * BM + row) * 4 + u.pn);
            __hip_atomic_store(slot, ((unsigned long long)__float_as_uint(m2) << 32) | __float_as_uint(mt), __ATOMIC_RELAXED, __HIP_MEMORY_SCOPE_AGENT);
        }
        asm volatile("s_waitcnt vmcnt(0)" ::: "memory");
        if (lane == 0) __hip_atomic_fetch_add(cnt + 64 * u.pm, 1u, __ATOMIC_RELAXED, __HIP_MEMORY_SCOPE_AGENT);
        if (wid == 0) {
            bool dead = false; const unsigned long long t0 = __builtin_amdgcn_s_memrealtime(); const unsigned want = 8u * (unsigned)ntn;
            for (;;) {
#if defined(BROKEN_NO_WAIT)
                break;
#endif
                if ((unsigned)__builtin_amdgcn_readfirstlane(__hip_atomic_load(cnt + 64 * u.pm, __ATOMIC_RELAXED, __HIP_MEMORY_SCOPE_AGENT)) >= want) break;
                if (__builtin_amdgcn_s_memrealtime() - t0 > 2000000ull) {
                    if (lane == 0) { unsigned expect = 0u; __hip_atomic_compare_exchange_strong(tmo + 1, &expect, code | (unsigned)(u.pm & 0xff), __ATOMIC_RELAXED, __ATOMIC_RELAXED, __HIP_MEMORY_SCOPE_AGENT);
                                     __hip_atomic_store(tmo, 1u, __ATOMIC_RELAXED, __HIP_MEMORY_SCOPE_AGENT); }
                    dead = true; break; }
                __builtin_amdgcn_s_sleep(2);
            }
            __builtin_amdgcn_fence(__ATOMIC_ACQUIRE, "agent");
            if (lane == 0) flag[0] = dead ? 1u : 0u;
        }
        asm volatile("s_waitcnt vmcnt(0) lgkmcnt(0)" ::: "memory"); __builtin_amdgcn_s_barrier(); asm volatile("" ::: "memory");
        const bool bad = flag[0] != 0u;
        if (lane < 32) {
            const unsigned long long* slot = (const unsigned long long*)xbuf + (size_t)(u.pm * BM + row) * 4; float mt[4], m2[4]; float ms = 0.f;
#pragma unroll
            for (int t = 0; t < 4; ++t) { if (t < ntn) { const unsigned long long w = __hip_atomic_load(slot + t, __ATOMIC_RELAXED, __HIP_MEMORY_SCOPE_AGENT); mt[t] = __uint_as_float((unsigned)w); m2[t] = __uint_as_float((unsigned)(w >> 32)); } else { mt[t] = 0.f; m2[t] = 0.f; } ms += mt[t]; }
            const float mean = ms / (float)ntn; float q = 0.f;
#pragma unroll
            for (int t = 0; t < 4; ++t) if (t < ntn) { const float dm = mt[t] - mean; q += m2[t] + 256.0f * dm * dm; }
            S[row] = (f32x2v){mean, 1.0f / sqrtf(q / (256.0f * (float)ntn) + eps)};
        }
        asm volatile("s_waitcnt lgkmcnt(0)" ::: "memory"); __builtin_amdgcn_s_barrier(); asm volatile("" ::: "memory");
        return bad;
    }
};
struct EpiLnRes {
    static constexpr bool PERM = false, AFTER_DRAIN = true;
    const float* base; float* out; int ldc; const float* bias; PanelStats st; unsigned poison;
    __device__ __forceinline__ void refuse(size_t i0, size_t stride, int M, int N) const { const float q = __builtin_nanf(""); for (size_t i = i0; i < (size_t)M * N; i += stride) out[(i / N) * ldc + i % N] = q;
        if (i0 == 0) { unsigned expect = 0u; __hip_atomic_compare_exchange_strong(st.tmo + 1, &expect, 0x7f0u, __ATOMIC_RELAXED, __ATOMIC_RELAXED, __HIP_MEMORY_SCOPE_AGENT); __hip_atomic_store(st.tmo, 1u, __ATOMIC_RELAXED, __HIP_MEMORY_SCOPE_AGENT); } }
    __device__ __forceinline__ void fused(f32x4 (&acc)[2][2][4][2], const Unit& u, int wr, int wc, int fr, int fq, PG8_LAS unsigned char* lds, int wid, int lane) const {
        typedef float f32x2v __attribute__((ext_vector_type(2)));
        const PG8_LAS f32x2v* S = (const PG8_LAS f32x2v*)(lds + 8192);
        const int col0 = u.pn * BM + wc * 32 + 4 * fq;
#pragma unroll
        for (int bj = 0; bj < 2; ++bj)
#pragma unroll
            for (int n = 0; n < 2; ++n) { const f32x4 bv = bias ? *(const f32x4*)(bias + col0 + bj * HALF + n * 16) : (f32x4){0.f, 0.f, 0.f, 0.f};
#pragma unroll
                for (int ai = 0; ai < 2; ++ai)
#pragma unroll
                    for (int m = 0; m < 4; ++m) acc[ai][bj][m][n] += bv; }
        const bool bad = st.run(acc, u, wr, wc, fr, fq, lds, wid, lane) || poison != 0u;
        const float qnan = __builtin_nanf("");
#pragma unroll
        for (int ai = 0; ai < 2; ++ai)
#pragma unroll
            for (int m = 0; m < 4; ++m) { const int r = ai * HALF + wr * 64 + m * 16 + fr; const f32x2v sr = S[r]; const size_t off = (size_t)(u.pm * BM + r) * ldc + col0;
#pragma unroll
                for (int bj = 0; bj < 2; ++bj)
#pragma unroll
                    for (int n = 0; n < 2; ++n) { const f32x4 bs = *(const f32x4*)(base + off + bj * HALF + n * 16); f32x4 o = bs + (acc[ai][bj][m][n] - sr.x) * sr.y;
                        if (bad) o = (f32x4){qnan, qnan, qnan, qnan}; *(f32x4*)(out + off + bj * HALF + n * 16) = o; }
                asm volatile("" ::: "memory"); }
    }
};
struct EpiLnResLn {
    static constexpr bool PERM = false, AFTER_DRAIN = true;
    const float* base; float* out; bf16_t* xn; int ldc; const float* bias; PanelStats st1, st2; unsigned poison;
    __device__ __forceinline__ void refuse(size_t i0, size_t stride, int M, int N) const { const float q = __builtin_nanf(""); for (size_t i = i0; i < (size_t)M * N; i += stride) { const size_t o = (i / N) * ldc + i % N; out[o] = q; xn[o] = (bf16_t)0x7fc0u; }
        if (i0 == 0) { unsigned expect = 0u; __hip_atomic_compare_exchange_strong(st1.tmo + 1, &expect, 0x7f0u, __ATOMIC_RELAXED, __ATOMIC_RELAXED, __HIP_MEMORY_SCOPE_AGENT); __hip_atomic_store(st1.tmo, 1u, __ATOMIC_RELAXED, __HIP_MEMORY_SCOPE_AGENT); } }
    __device__ __forceinline__ void fused(f32x4 (&acc)[2][2][4][2], const Unit& u, int wr, int wc, int fr, int fq, PG8_LAS unsigned char* lds, int wid, int lane) const {
        typedef float f32x2v __attribute__((ext_vector_type(2))); typedef unsigned u32x2v __attribute__((ext_vector_type(2)));
        const PG8_LAS f32x2v* S = (const PG8_LAS f32x2v*)(lds + 8192);
        const int col0 = u.pn * BM + wc * 32 + 4 * fq;
#pragma unroll
        for (int bj = 0; bj < 2; ++bj)
#pragma unroll
            for (int n = 0; n < 2; ++n) { const f32x4 bv = bias ? *(const f32x4*)(bias + col0 + bj * HALF + n * 16) : (f32x4){0.f, 0.f, 0.f, 0.f};
#pragma unroll
                for (int ai = 0; ai < 2; ++ai)
#pragma unroll
                    for (int m = 0; m < 4; ++m) acc[ai][bj][m][n] += bv; }
        bool bad = st1.run(acc, u, wr, wc, fr, fq, lds, wid, lane) || poison != 0u;
        const float qnan = __builtin_nanf("");
#pragma unroll
        for (int ai = 0; ai < 2; ++ai)
#pragma unroll
            for (int m = 0; m < 4; ++m) { const int r = ai * HALF + wr * 64 + m * 16 + fr; const f32x2v sr = S[r]; const size_t off = (size_t)(u.pm * BM + r) * ldc + col0;
#pragma unroll
                for (int bj = 0; bj < 2; ++bj)
#pragma unroll
                    for (int n = 0; n < 2; ++n) { const f32x4 bs = *(const f32x4*)(base + off + bj * HALF + n * 16); acc[ai][bj][m][n] = bs + (acc[ai][bj][m][n] - sr.x) * sr.y; }
                asm volatile("" : "+v"(acc[ai][0][m][0]), "+v"(acc[ai][0][m][1]), "+v"(acc[ai][1][m][0]), "+v"(acc[ai][1][m][1]));
                if (m & 1) asm volatile("" ::: "memory"); }
        const bool bad1 = bad;
        bad = st2.run(acc, u, wr, wc, fr, fq, lds, wid, lane) || bad;
#pragma unroll
        for (int ai = 0; ai < 2; ++ai)
#pragma unroll
            for (int m = 0; m < 4; ++m) { const int r = ai * HALF + wr * 64 + m * 16 + fr; const f32x2v sr = S[r]; const size_t off = (size_t)(u.pm * BM + r) * ldc + col0;
#pragma unroll
                for (int bj = 0; bj < 2; ++bj)
#pragma unroll
                    for (int n = 0; n < 2; ++n) { const f32x4 x1 = acc[ai][bj][m][n]; *(f32x4*)(out + off + bj * HALF + n * 16) = bad1 ? (f32x4){qnan, qnan, qnan, qnan} : x1;
                        const f32x4 o = (x1 - sr.x) * sr.y; u32x2v w; w.x = cvt_pk_bf16(o[0], o[1]); w.y = cvt_pk_bf16(o[2], o[3]);
                        if (bad) { w.x = 0x7fc07fc0u; w.y = 0x7fc07fc0u; } *(u32x2v*)(xn + off + bj * HALF + n * 16) = w; }
                asm volatile("" ::: "memory"); }
    }
};

template <class Epi, class Sched, bool STAMP = false>
__device__ __forceinline__ void gemm_phase(PG8_LAS unsigned char* lds, const Gemm g, const Sched& S, const Epi& E, unsigned long long* stamps) {
    const int tid = threadIdx.x, wid = __builtin_amdgcn_readfirstlane(tid >> 6), lane = tid & 63, wr = wid >> 2, wc = wid & 3, fr = lane & 15, fq = lane >> 4;
    const int K = g.K, nt = K / BK;
    int ts_lo = 0, ts_hi = 0, nts = 0; const unsigned long long rt_entry = STAMP ? (unsigned long long)wall_clock64() : 0ull;
#define PG8_STAMP() do { if (STAMP && wid == 0 && nts < 64) { const unsigned long long _c = (unsigned long long)clock64(); \
        ts_lo = (lane == nts) ? (int)(unsigned)_c : ts_lo; ts_hi = (lane == nts) ? (int)(unsigned)(_c >> 32) : ts_hi; ++nts; } } while (0)
    PG8_STAMP();
    unsigned voffA[2], voffB[2];
#pragma unroll
    for (int i = 0; i < 2; ++i) { int R, C; stage_rc(tid * 16 + i * 8192, R, C); const int Rb = Epi::PERM ? ((R & ~31) + perm32(R & 31)) : R;
        voffA[i] = (unsigned)(R * K + C) * 2u; voffB[i] = (unsigned)(Rb * K + C) * 2u; }
    const size_t kstep = (size_t)(BK * 2);
    const size_t hstep = (size_t)HALF * K * 2;
    const size_t tstep = 2 * hstep;
    const unsigned ldsw = (unsigned)wid * 1024u;
    const int aoff = lds_byte(wr * 64 + fr, fq * 8), boff = lds_byte(wc * 32 + fr, fq * 8);
#define PG8_SA(b, h) (((b) * 2 + (h)) * HTB)
#define PG8_SB(b, h) ((4 + (b) * 2 + (h)) * HTB)
#define PG8_STAGE(bufoff, gbase, voff) do { _Pragma("unroll") for (int _i = 0; _i < 2; ++_i) \
        __builtin_amdgcn_global_load_lds((const unsigned*)((const char*)(gbase) + (voff)[_i]), (PG8_LAS unsigned*)(lds + (bufoff) + ldsw + _i * 8192), 16, 0, 0); } while (0)
#define PG8_LDA(dst, b, h) do { _Pragma("unroll") for (int m = 0; m < 4; ++m) _Pragma("unroll") for (int k = 0; k < 2; ++k) dst[m][k] = *(const PG8_LAS bf16x8*)(lds + PG8_SA(b, h) + aoff + m * 2048 + k * 1024); } while (0)
#define PG8_LDB(dst, b, h) do { _Pragma("unroll") for (int n = 0; n < 2; ++n) _Pragma("unroll") for (int k = 0; k < 2; ++k) dst[n][k] = *(const PG8_LAS bf16x8*)(lds + PG8_SB(b, h) + boff + n * 2048 + k * 1024); } while (0)
#define PG8_MMA(ai, bj, At, Bt) do { __builtin_amdgcn_s_setprio(1); _Pragma("unroll") for (int m = 0; m < 4; ++m) _Pragma("unroll") for (int n = 0; n < 2; ++n) _Pragma("unroll") for (int k = 0; k < 2; ++k) \
        acc[ai][bj][m][n] = __builtin_amdgcn_mfma_f32_16x16x32_bf16(Bt[n][k], At[m][k], acc[ai][bj][m][n], 0, 0, 0); __builtin_amdgcn_s_setprio(0); } while (0)
#define PG8_WAIT_V(n) asm volatile("s_waitcnt vmcnt(" #n ")" ::: "memory")
#define PG8_WAIT_L(n) asm volatile("s_waitcnt lgkmcnt(" #n ")" ::: "memory")
#define PG8_BAR __builtin_amdgcn_s_barrier()
#define PG8_SCHED __builtin_amdgcn_sched_barrier(0)
    Unit cur, nxt; int ui = 0;
    if (!S.next(0, cur)) return;
    f32x4 acc[2][2][4][2];
#pragma unroll
    for (int a = 0; a < 2; ++a)
#pragma unroll
        for (int b = 0; b < 2; ++b)
#pragma unroll
            for (int m = 0; m < 4; ++m)
#pragma unroll
                for (int n = 0; n < 2; ++n) acc[a][b][m][n] = (f32x4){0.f, 0.f, 0.f, 0.f};
    bf16x8 At[4][2], B0[2][2], B1[2][2];
    const char* cA = (const char*)g.A + (size_t)cur.pm * tstep; const char* cB = (const char*)g.Bt + (size_t)cur.pn * tstep;
    S.a_ready(cur);
    PG8_STAGE(PG8_SB(0, 0), cB, voffB); PG8_STAGE(PG8_SA(0, 0), cA, voffA); PG8_STAGE(PG8_SB(0, 1), cB + hstep, voffB); PG8_STAGE(PG8_SA(0, 1), cA + hstep, voffA);
    if (wr == 1) PG8_BAR;
    PG8_WAIT_V(4); PG8_BAR;
    PG8_STAGE(PG8_SB(1, 0), cB + kstep, voffB); PG8_STAGE(PG8_SA(1, 0), cA + kstep, voffA); PG8_STAGE(PG8_SB(1, 1), cB + hstep + kstep, voffB);
    PG8_WAIT_V(6); PG8_BAR;
    PG8_STAMP();
    for (;;) {
        const bool has_next = S.next(ui + 1, nxt);
        const char* nA = has_next ? (const char*)g.A + (size_t)nxt.pm * tstep : cA; const char* nB = has_next ? (const char*)g.Bt + (size_t)nxt.pn * tstep : cB;
        for (int t = 0; t < nt; t += 2) {
            const bool last = (t == nt - 2);
            const char* a1 = cA + (size_t)(t + 1) * kstep;
            const char* a2 = last ? nA : cA + (size_t)(t + 2) * kstep; const char* b2 = last ? nB : cB + (size_t)(t + 2) * kstep;
            const char* a3 = a2 + kstep; const char* b3 = b2 + kstep;
            if (last && has_next) S.a_ready(nxt);
            PG8_LDB(B0, 0, 0); PG8_SCHED; PG8_LDA(At, 0, 0); PG8_STAGE(PG8_SA(1, 1), a1 + hstep, voffA);
            PG8_WAIT_L(8); PG8_BAR; PG8_WAIT_L(0); PG8_MMA(0, 0, At, B0); PG8_BAR; PG8_SCHED;
            PG8_LDB(B1, 0, 1); PG8_STAGE(PG8_SB(0, 0), b2, voffB);
            PG8_BAR; PG8_WAIT_L(0); PG8_MMA(0, 1, At, B1); PG8_BAR;
            PG8_LDA(At, 0, 1); PG8_STAGE(PG8_SA(0, 0), a2, voffA);
            PG8_BAR; PG8_WAIT_L(0); PG8_MMA(1, 0, At, B0); PG8_BAR; PG8_SCHED;
            PG8_STAGE(PG8_SB(0, 1), b2 + hstep, voffB);
            PG8_WAIT_V(6); PG8_BAR; PG8_MMA(1, 1, At, B1); PG8_BAR;
            PG8_LDB(B0, 1, 0); PG8_SCHED; PG8_LDA(At, 1, 0); PG8_STAGE(PG8_SA(0, 1), a2 + hstep, voffA);
            PG8_WAIT_L(8); PG8_BAR; PG8_WAIT_L(0); PG8_MMA(0, 0, At, B0); PG8_BAR; PG8_SCHED;
            PG8_LDB(B1, 1, 1); PG8_STAGE(PG8_SB(1, 0), b3, voffB);
            PG8_BAR; PG8_WAIT_L(0); PG8_MMA(0, 1, At, B1); PG8_BAR;
            PG8_LDA(At, 1, 1); PG8_STAGE(PG8_SA(1, 0), a3, voffA);
            PG8_BAR; PG8_WAIT_L(0); PG8_MMA(1, 0, At, B0); PG8_BAR; PG8_SCHED;
            PG8_STAGE(PG8_SB(1, 1), b3 + hstep, voffB);
            PG8_WAIT_V(6); PG8_BAR; PG8_MMA(1, 1, At, B1); PG8_BAR;
        }
        PG8_STAMP();
        if constexpr (!Epi::AFTER_DRAIN) { E(acc, cur, wr, wc, fr, fq); S.done(cur); }
        PG8_STAMP();
        if (!has_next) break;
#pragma unroll
        for (int a = 0; a < 2; ++a)
#pragma unroll
            for (int b = 0; b < 2; ++b)
#pragma unroll
                for (int m = 0; m < 4; ++m)
#pragma unroll
                    for (int n = 0; n < 2; ++n) acc[a][b][m][n] = (f32x4){0.f, 0.f, 0.f, 0.f};
        cur = nxt; cA = nA; cB = nB; ++ui;
    }
    PG8_WAIT_V(0);
    if (wr == 0) PG8_BAR;
    PG8_BAR;
    if constexpr (Epi::AFTER_DRAIN) { E.fused(acc, cur, wr, wc, fr, fq, lds, wid, lane); S.done(cur); }
    PG8_STAMP();
    if (STAMP && wid == 0) { stamps[lane] = lane < nts ? (((unsigned long long)(unsigned)ts_hi << 32) | (unsigned)ts_lo) : 0ull;
        if (lane == 62) stamps[62] = rt_entry; if (lane == 63) stamps[63] = (unsigned long long)wall_clock64(); }
#undef PG8_STAMP
#undef PG8_SA
#undef PG8_SB
#undef PG8_STAGE
#undef PG8_LDA
#undef PG8_LDB
#undef PG8_MMA
#undef PG8_WAIT_V
#undef PG8_WAIT_L
#undef PG8_BAR
#undef PG8_SCHED
}
}
#define XB_TMO      128
#define XB_XCNT(j)  (256  + 64 * (j))
#define XB_XSUB(j)  (1280 + 64 * (j))
#define XB_XGEN(j)  (2304 + 64 * (j))
#define XB_TOP      3328
#define XB_TOPGEN   3392
#define XCD_BAR_WORDS 3456
#define XB_SPIN_CAP (1u << 18)
#define LAS __attribute__((address_space(3)))

__device__ __forceinline__ unsigned xb_ld(unsigned* p)              { return __hip_atomic_load(p, __ATOMIC_RELAXED, __HIP_MEMORY_SCOPE_AGENT); }
__device__ __forceinline__ unsigned xb_add(unsigned* p, unsigned v) { return __hip_atomic_fetch_add(p, v, __ATOMIC_RELAXED, __HIP_MEMORY_SCOPE_AGENT); }
__device__ __forceinline__ unsigned xb_xcc_id() { return (unsigned)__builtin_amdgcn_s_getreg((3 << 11) | 20) & 0xFu; }
#define XB_SPIN(cond, bar) do { unsigned _sp = 0; while (cond) { __builtin_amdgcn_s_sleep(1); \
    if ((++_sp & 255u) == 0u) { if (xb_ld(&(bar)[XB_TMO])) break; if (_sp > XB_SPIN_CAP) { atomicAdd(&(bar)[XB_TMO], 1u); break; } } } } while (0)

struct XcdBarrier {
    unsigned* bar; unsigned x;
    volatile LAS unsigned* st;
};

__device__ __forceinline__ XcdBarrier xcd_barrier_post(unsigned* bar, volatile LAS unsigned* st) {
    XcdBarrier b; b.bar = bar; b.x = xb_xcc_id(); b.st = st;
    if (threadIdx.x == 0) (void)xb_add(&bar[XB_XCNT(b.x)], 1u);
    return b;
}
__device__ __forceinline__ void xcd_barrier_complete(unsigned* bar, unsigned x, unsigned& nloc, unsigned& nx) {
    const unsigned G = gridDim.x * gridDim.y * gridDim.z;
    unsigned sum, cnt, mine, sp = 0u;
    for (;;) {
        sum = 0u; cnt = 0u; mine = 0u;
#pragma unroll
        for (unsigned j = 0; j < 16; ++j) { const unsigned c = xb_ld(&bar[XB_XCNT(j)]); sum += c; cnt += (c > 0u) ? 1u : 0u; mine = (j == x) ? c : mine; }
        if (sum == G) break;
        __builtin_amdgcn_s_sleep(1);
        if ((++sp & 255u) == 0u) { if (xb_ld(&bar[XB_TMO])) break; if (sp > XB_SPIN_CAP) { atomicAdd(&bar[XB_TMO], 1u); break; } }
    }
    nloc = mine > 0u ? mine : 1u; nx = cnt > 0u ? cnt : 1u;
}

__device__ __forceinline__ void xcd_barrier(const XcdBarrier& b) {
    asm volatile("s_waitcnt vmcnt(0)" ::: "memory");
    __syncthreads();
    if (threadIdx.x == 0) {
        unsigned* bar = b.bar;
        __builtin_amdgcn_s_waitcnt(0);
        unsigned nloc = b.st[0], nx = b.st[1];
        if (nloc == 0u) { xcd_barrier_complete(bar, b.x, nloc, nx); b.st[0] = nloc; b.st[1] = nx; }
        const unsigned old = xb_add(&bar[XB_XSUB(b.x)], 1u);
        const unsigned gen = old / nloc;
        if (old + 1u == (gen + 1u) * nloc) {
            __builtin_amdgcn_fence(__ATOMIC_RELEASE, "agent");
            asm volatile("s_waitcnt vmcnt(0)" ::: "memory");
            const unsigned og = xb_add(&bar[XB_TOP], 1u);
            const unsigned tg = og / nx;
            if (og + 1u == (tg + 1u) * nx) xb_add(&bar[XB_TOPGEN], 1u);
            else XB_SPIN(xb_ld(&bar[XB_TOPGEN]) == tg, bar);
            __builtin_amdgcn_fence(__ATOMIC_ACQUIRE, "agent");
            xb_add(&bar[XB_XGEN(b.x)], 1u);
            asm volatile("s_waitcnt vmcnt(0)" ::: "memory");
        } else {
            XB_SPIN(xb_ld(&bar[XB_XGEN(b.x)]) == gen, bar);
            __builtin_amdgcn_fence(__ATOMIC_ACQUIRE, "agent");
            asm volatile("s_waitcnt vmcnt(0)" ::: "memory");
        }
    }
    __syncthreads();
}


#ifndef MK_N_LAUNCHES
#define MK_N_LAUNCHES 1
#endif
#ifndef MK_QTAIL
#define MK_QTAIL 7680
#endif
#ifndef MK_QHEAD
#define MK_QHEAD 12288
#endif
namespace mk {
typedef unsigned short bf16_t;
typedef float f32x4 __attribute__((ext_vector_type(4)));
typedef short bf16x8 __attribute__((ext_vector_type(8)));
typedef short s16x4 __attribute__((ext_vector_type(4)));
typedef unsigned u32x4 __attribute__((ext_vector_type(4)));
typedef unsigned u32x2 __attribute__((ext_vector_type(2)));
typedef float f32x2 __attribute__((ext_vector_type(2)));
constexpr int D = 2048, NTOK_P = 16384, NTOK_S = 256, NTOK = 16640;
constexpr int DIN = 5632, DATT = 1536, DLRU = 512, NH = 12, HD = 128;
constexpr int NEXP = 16384;
constexpr float ALPHA = 1.189207115002721f;
constexpr float LN_EPS = 1e-5f;
constexpr float ATT_SCALE = 0.08838834764831845f;
constexpr float LOG2E = 1.4426950408889634f;
constexpr size_t O_YP = 0, O_YS = 33554432, O_KP = 34078720, O_VP = 59244544, O_CP = 84410368, O_HP = 84422656,
                 O_KS = 84426752, O_VS = 185090048, O_CS = 285753344, O_HS = 285802496, O_END = 285818880;
constexpr size_t WS_CTL = 0;
constexpr size_t WS_XB = 65536;
constexpr size_t WS_WINT = WS_XB + (size_t)NTOK * D * 2;
constexpr size_t WS_WOT = WS_WINT + (size_t)DIN * D * 2;
constexpr size_t WS_WQT = WS_WOT + (size_t)D * D * 2;
constexpr size_t WS_UB = WS_WQT + (size_t)D * D * 2;
constexpr size_t WS_VB = WS_UB + (size_t)NEXP * D * 2;
constexpr size_t WS_QF = WS_VB + (size_t)NEXP * D * 2;
constexpr size_t WS_XR = WS_QF + (size_t)NTOK * DATT * 4;
constexpr size_t WS_GATE = WS_XR + (size_t)NTOK * DLRU * 4;
constexpr size_t WS_AR = WS_GATE + (size_t)NTOK * DLRU * 4;
constexpr size_t WS_PRE1 = WS_AR + (size_t)NTOK * D * 2;
constexpr size_t WS_X1F = WS_PRE1 + (size_t)NTOK * D * 4;
constexpr size_t WS_X1B = WS_X1F + (size_t)NTOK * D * 4;
constexpr size_t WS_QP = WS_X1B + (size_t)NTOK * D * 2;
constexpr size_t WS_EIDX = WS_QP + (size_t)NTOK * D * 4;
constexpr size_t WS_GW = WS_EIDX + (size_t)NTOK * 128 * 4;
constexpr size_t WS_SU = WS_GW + (size_t)NTOK * 128 * 4;
constexpr size_t WS_SV = WS_SU + (size_t)NEXP * 4;
constexpr size_t WS_SX = WS_SV + (size_t)NEXP * 4;
constexpr size_t WS_X1Q = WS_SX + (size_t)NTOK * 4;
constexpr size_t WS_SKB = WS_X1Q + (size_t)NTOK * D;
constexpr size_t WS_QB = WS_SKB + (size_t)8 * 2 * 128 * 128 * 2;
constexpr size_t WS_KB = WS_QB + (size_t)NTOK * DATT * 2;
constexpr size_t WS_VB16 = WS_KB + (size_t)NTOK_P * DATT * 2;
constexpr size_t WS_PO = WS_VB16 + (size_t)NTOK_P * DATT * 2;
constexpr size_t WS_PM = WS_PO + (size_t)2 * NTOK_P * DATT * 2;
constexpr size_t WS_PL = WS_PM + (size_t)2 * NTOK_P * NH * 4;
constexpr size_t WS_R0 = WS_PL + (size_t)2 * NTOK_P * NH * 4;
constexpr size_t WS_R1 = WS_R0 + (size_t)NTOK_P * DLRU * 4;
constexpr size_t WS_HE = WS_R1 + (size_t)NTOK_P * DLRU * 4;
constexpr size_t WS_AE = WS_HE + (size_t)8 * 32 * 512 * 4;
constexpr size_t WS_LW = WS_AE + (size_t)8 * 32 * 512 * 4;
constexpr size_t WS_PS = WS_LW + (size_t)2 * 8 * 64 * 64 * 2;
constexpr size_t WS_END = WS_PS + (size_t)32 * 12 * 9 * 8 * 130 * 4;

constexpr int NTHREADS = 512;
constexpr int LDS_BYTES = 148480;
constexpr int MISC_OFF = 147456;

struct Params {
    const float* x_prompt; const float* x_sample; const float* cache_k; const float* cache_v; const float* state_conv; const float* state_h;
    const float* w_in; const float* conv_w; const float* conv_b; const float* lru_w_a; const float* lru_b_a; const float* lru_w_x; const float* lru_b_x;
    const float* lru_lambda; const float* w_out; const float* ln1_g; const float* ln1_b; const float* w_query; const float* sub_keys;
    const float* peer_u; const float* peer_v; const float* ln2_g; const float* ln2_b;
    float* out; unsigned char* ws; int ph_lo, ph_hi;
};

__device__ __forceinline__ unsigned f2bf(float f) { unsigned u = __float_as_uint(f); u += 0x7fffu + ((u >> 16) & 1u); return u >> 16; }
__device__ __forceinline__ unsigned pack2(float a, float b) { return f2bf(a) | (f2bf(b) << 16); }
__device__ __forceinline__ float bflo(unsigned w) { return __uint_as_float(w << 16); }
__device__ __forceinline__ float bfhi(unsigned w) { return __uint_as_float(w & 0xffff0000u); }
__device__ __forceinline__ float4 ntload4(const float* p) { const f32x4 v = __builtin_nontemporal_load((const f32x4*)p); return make_float4(v[0], v[1], v[2], v[3]); }
__device__ __forceinline__ void ntstore4(float* p, float4 v) { __builtin_nontemporal_store((f32x4){v.x, v.y, v.z, v.w}, (f32x4*)p); }
__device__ __forceinline__ float wave_sum(float v) {
#pragma unroll
    for (int o = 32; o >= 1; o >>= 1) v += __shfl_xor(v, o);
    return v;
}
__device__ __forceinline__ float wave_max(float v) {
#pragma unroll
    for (int o = 32; o >= 1; o >>= 1) v = fmaxf(v, __shfl_xor(v, o));
    return v;
}
__device__ __forceinline__ float gelu_exact(float v) { return 0.5f * v * (1.0f + erff(v * 0.7071067811865476f)); }
__device__ __forceinline__ float gelu_as(float v) {
    const float av = fabsf(v), t = __builtin_amdgcn_rcpf(av * 0.2316418882f + 1.0f);
    float q = t * 0.5307027145f + (-0.7265760135f); q = q * t + 0.7107068705f; q = q * t + (-0.142248368f); q = q * t + 0.127414796f; q = q * t;
    const float e = __builtin_amdgcn_exp2f((v * v) * (-0.72134752044f));
    const float m = v * (q * e);
    return v < 0.f ? m : v - m;
}
__device__ __forceinline__ float sigmoidf(float v) { return 1.0f / (1.0f + expf(-v)); }
__device__ __forceinline__ float readlane_f(float v, int l) { return __int_as_float(__builtin_amdgcn_readlane(__float_as_int(v), l)); }

__device__ __forceinline__ void convert_flat(const float* src, bf16_t* dst, size_t n8, size_t gtid, size_t gstride) {
    for (size_t i = gtid; i < n8; i += gstride) {
        const float4 a = ((const float4*)src)[2 * i], b = ((const float4*)src)[2 * i + 1];
        uint4 w; w.x = pack2(a.x, a.y); w.y = pack2(a.z, a.w); w.z = pack2(b.x, b.y); w.w = pack2(b.z, b.w);
        ((uint4*)dst)[i] = w;
    }
}
__device__ __forceinline__ void transpose_convert(const float* src, bf16_t* dst, int K, int N, LAS float* tile) {
    const int tid = threadIdx.x, ntn = N / 64, ntiles = (K / 64) * ntn;
    for (int tl = blockIdx.x; tl < ntiles; tl += gridDim.x) {
        const int kt = tl / ntn, nt = tl - kt * ntn;
#pragma unroll
        for (int i = 0; i < 8; ++i) { const int r = (tid >> 6) + 8 * i, c = tid & 63; tile[r * 65 + c] = src[(size_t)(kt * 64 + r) * N + nt * 64 + c]; }
        __syncthreads();
#pragma unroll
        for (int i = 0; i < 4; ++i) { const int n = (tid >> 5) + 16 * i, k0 = 2 * (tid & 31);
            const unsigned v = pack2(tile[k0 * 65 + n], tile[(k0 + 1) * 65 + n]);
            *(unsigned*)(dst + (size_t)(nt * 64 + n) * K + kt * 64 + k0) = v; }
        __syncthreads();
    }
}
constexpr int TROW = 1152;
__device__ __forceinline__ void quant_row_load(const Params& P, int it, int lane, float4 (&v)[8]) {
    const bool isv = it >= NEXP; const int row = isv ? it - NEXP : it;
    const float* src = (isv ? P.peer_v : P.peer_u) + (size_t)row * D;
#pragma unroll
    for (int j = 0; j < 2; ++j)
#pragma unroll
        for (int i = 0; i < 4; ++i) v[j * 4 + i] = *(const float4*)(src + j * 1024 + lane * 16 + i * 4);
}
__device__ __forceinline__ void quant_row_store(const Params& P, int it, int lane, const float4 (&v)[8]) {
    const bool isv = it >= NEXP; const int row = isv ? it - NEXP : it;
    float cm[2];
#pragma unroll
    for (int j = 0; j < 2; ++j) { float am = 0.f;
#pragma unroll
        for (int i = 0; i < 4; ++i) { const float4 t = v[j * 4 + i]; am = fmaxf(am, fmaxf(fmaxf(fabsf(t.x), fabsf(t.y)), fmaxf(fabsf(t.z), fabsf(t.w)))); }
        cm[j] = am; }
    float rm = wave_max(fmaxf(cm[0], cm[1])); if (rm == 0.f) rm = 1.f;
    unsigned char* dst = P.ws + (isv ? WS_VB : WS_UB) + (size_t)row * TROW;
    u32x4 w; unsigned sqp = 0u;
#pragma unroll
    for (int j = 0; j < 2; ++j) {
        int sq = (int)ceilf(cm[j] / rm * 255.0f); sq = sq < 1 ? 1 : (sq > 255 ? 255 : sq);
        sqp |= (unsigned)sq << (8 * j);
        const float inv = (255.0f * 7.0f) / (rm * (float)sq);
#pragma unroll
        for (int hh = 0; hh < 2; ++hh) { unsigned dw = 0u;
#pragma unroll
            for (int e = 0; e < 8; ++e) { const float4 t = v[j * 4 + hh * 2 + (e >> 2)]; const float x = (e & 3) == 0 ? t.x : ((e & 3) == 1 ? t.y : ((e & 3) == 2 ? t.z : t.w));
                int n = (int)rintf(x * inv); n = n < -7 ? -7 : (n > 7 ? 7 : n); dw |= (unsigned)(isv ? n + 8 : (n & 15)) << (4 * e); }
            w[j * 2 + hh] = dw; }
    }
    *(u32x4*)(dst + lane * 16) = w;
    *(unsigned short*)(dst + 1024 + lane * 2) = (unsigned short)sqp;
    if (lane == 0) ((float*)(P.ws + (isv ? WS_SV : WS_SU)))[row] = rm * (1.0f / (255.0f * 7.0f));
}
__device__ __forceinline__ void quant_tables(const Params& P, int gw, int nw, int lo, int hi) {
    const int lane = threadIdx.x & 63;
    float4 va[8], vb[8];
    int it = lo + gw;
    if (it < hi) quant_row_load(P, it, lane, va);
#pragma unroll 1
    for (; it < hi; it += 2 * nw) {
        if (it + nw < hi) quant_row_load(P, it + nw, lane, vb);
        quant_row_store(P, it, lane, va);
        if (it + nw < hi) {
            if (it + 2 * nw < hi) quant_row_load(P, it + 2 * nw, lane, va);
            quant_row_store(P, it + nw, lane, vb);
        }
    }
}
__device__ __forceinline__ void phase_prologue(const Params& P, LAS unsigned char* lds) {
    const size_t gtid = (size_t)blockIdx.x * NTHREADS + threadIdx.x, gstride = (size_t)gridDim.x * NTHREADS;
    unsigned char* ws = P.ws;
    convert_flat(P.x_prompt, (bf16_t*)(ws + WS_XB), (size_t)NTOK_P * D / 8, gtid, gstride);
    convert_flat(P.x_sample, (bf16_t*)(ws + WS_XB) + (size_t)NTOK_P * D, (size_t)NTOK_S * D / 8, gtid, gstride);
    convert_flat(P.sub_keys, (bf16_t*)(ws + WS_SKB), (size_t)8 * 2 * 128 * 128 / 8, gtid, gstride);
    for (size_t i = gtid; i < (size_t)2 * 8 * 64 * 64; i += gstride) {
        const int c = (int)(i & 63), d = (int)((i >> 6) & 63), n = (int)((i >> 12) & 7), m = (int)(i >> 15);
        ((bf16_t*)(ws + WS_LW))[i] = (bf16_t)f2bf((m ? P.lru_w_x : P.lru_w_a)[(n * 64 + c) * 64 + d]); }
    transpose_convert(P.w_in, (bf16_t*)(ws + WS_WINT), D, DIN, (LAS float*)lds);
    transpose_convert(P.w_out, (bf16_t*)(ws + WS_WOT), D, D, (LAS float*)lds);
    transpose_convert(P.w_query, (bf16_t*)(ws + WS_WQT), D, D, (LAS float*)lds);
}

struct EpiProj {
    static constexpr bool PERM = true, AFTER_DRAIN = false;
    float* out; bf16_t* XR; bf16_t* GATE; bf16_t* QB; bf16_t* KB; bf16_t* VB16;
    __device__ __forceinline__ void operator()(const f32x4 (&acc)[2][2][4][2], const pg8::Unit& u, int wr, int wc, int fr, int fq) const {
        const int pn = u.pn; const int coff = wc * 32 + 8 * fq;
#pragma unroll
        for (int ai = 0; ai < 2; ++ai)
#pragma unroll
            for (int m = 0; m < 4; ++m) {
                const int row = u.pm * 256 + ai * 128 + wr * 64 + m * 16 + fr;
                const bool prompt = row < NTOK_P;
                float* rowp = nullptr; bf16_t* rowb = nullptr; float bsc = 1.0f;
                if (pn < 6) { rowb = QB + (size_t)row * DATT + pn * 256; bsc = ATT_SCALE * LOG2E; }
                else if (pn < 18) {
                    const int isv = pn >= 12; const int c0 = (pn - (isv ? 12 : 6)) * 256;
                    if (prompt) { rowp = out + (isv ? O_VP : O_KP) + (size_t)row * DATT + c0; rowb = (isv ? VB16 : KB) + (size_t)row * DATT + c0; }
                    else { const int rr = row - NTOK_P, b = rr >> 3, t = rr & 7; rowp = out + (isv ? O_VS : O_KS) + ((size_t)b * 2048 + 2040 + t) * DATT + c0; }
                } else if (pn < 20) rowb = XR + (size_t)row * DLRU + (pn - 18) * 256;
                else rowb = GATE + (size_t)row * DLRU + (pn - 20) * 256;
#pragma unroll
                for (int bj = 0; bj < 2; ++bj) {
                    const f32x4 v0 = acc[ai][bj][m][0], v1 = acc[ai][bj][m][1];
                    if (rowp) { *(f32x4*)(rowp + coff + bj * 128) = v0; *(f32x4*)(rowp + coff + bj * 128 + 4) = v1; }
                    if (rowb) { u32x4 w; w.x = pg8::cvt_pk_bf16(v0[0] * bsc, v0[1] * bsc); w.y = pg8::cvt_pk_bf16(v0[2] * bsc, v0[3] * bsc); w.z = pg8::cvt_pk_bf16(v1[0] * bsc, v1[1] * bsc); w.w = pg8::cvt_pk_bf16(v1[2] * bsc, v1[3] * bsc);
                        *(u32x4*)(rowb + coff + bj * 128) = w; }
                }
            }
    }
};
struct EpiOut {
    static constexpr bool PERM = true, AFTER_DRAIN = false;
    const bf16_t* xb; bf16_t* pre;
    __device__ __forceinline__ void operator()(const f32x4 (&acc)[2][2][4][2], const pg8::Unit& u, int wr, int wc, int fr, int fq) const {
        const int col0 = u.pn * 256 + wc * 32 + 8 * fq;
        u32x4 xv[2][4][2];
#pragma unroll
        for (int ai = 0; ai < 2; ++ai)
#pragma unroll
            for (int m = 0; m < 4; ++m) { const int row = u.pm * 256 + ai * 128 + wr * 64 + m * 16 + fr;
#pragma unroll
                for (int bj = 0; bj < 2; ++bj) xv[ai][m][bj] = *(const u32x4*)(xb + (size_t)row * D + col0 + bj * 128); }
#pragma unroll
        for (int ai = 0; ai < 2; ++ai)
#pragma unroll
            for (int m = 0; m < 4; ++m) {
                const int row = u.pm * 256 + ai * 128 + wr * 64 + m * 16 + fr;
                bf16_t* pr = pre + (size_t)row * D + col0;
#pragma unroll
                for (int bj = 0; bj < 2; ++bj) {
                    const u32x4 x = xv[ai][m][bj]; const f32x4 v0 = acc[ai][bj][m][0], v1 = acc[ai][bj][m][1];
                    u32x4 w;
                    w.x = pg8::cvt_pk_bf16(ALPHA * bflo(x.x) + v0[0], ALPHA * bfhi(x.x) + v0[1]); w.y = pg8::cvt_pk_bf16(ALPHA * bflo(x.y) + v0[2], ALPHA * bfhi(x.y) + v0[3]);
                    w.z = pg8::cvt_pk_bf16(ALPHA * bflo(x.z) + v1[0], ALPHA * bfhi(x.z) + v1[1]); w.w = pg8::cvt_pk_bf16(ALPHA * bflo(x.w) + v1[2], ALPHA * bfhi(x.w) + v1[3]);
                    *(u32x4*)(pr + bj * 128) = w;
                }
            }
    }
};
struct EpiPlain {
    static constexpr bool PERM = false, AFTER_DRAIN = false;
    float* C; int ldc;
    __device__ __forceinline__ void operator()(const f32x4 (&acc)[2][2][4][2], const pg8::Unit& u, int wr, int wc, int fr, int fq) const {
        const int col0 = u.pn * 256 + wc * 32 + 4 * fq;
#pragma unroll
        for (int ai = 0; ai < 2; ++ai)
#pragma unroll
            for (int m = 0; m < 4; ++m) {
                const int row = u.pm * 256 + ai * 128 + wr * 64 + m * 16 + fr;
                float* pr = C + (size_t)row * ldc + col0;
#pragma unroll
                for (int bj = 0; bj < 2; ++bj)
#pragma unroll
                    for (int n = 0; n < 2; ++n) *(f32x4*)(pr + bj * 128 + n * 16) = acc[ai][bj][m][n];
            }
    }
};

struct EpiBf16Plain {
    static constexpr bool PERM = true, AFTER_DRAIN = false;
    bf16_t* C; int ldc;
    __device__ __forceinline__ void operator()(const f32x4 (&acc)[2][2][4][2], const pg8::Unit& u, int wr, int wc, int fr, int fq) const {
        const int col0 = u.pn * 256 + wc * 32 + 8 * fq;
#pragma unroll
        for (int ai = 0; ai < 2; ++ai)
#pragma unroll
            for (int m = 0; m < 4; ++m) {
                const int row = u.pm * 256 + ai * 128 + wr * 64 + m * 16 + fr;
                bf16_t* pr = C + (size_t)row * ldc + col0;
#pragma unroll
                for (int bj = 0; bj < 2; ++bj) { const f32x4 v0 = acc[ai][bj][m][0], v1 = acc[ai][bj][m][1]; u32x4 w;
                    w.x = pg8::cvt_pk_bf16(v0[0], v0[1]); w.y = pg8::cvt_pk_bf16(v0[2], v0[3]); w.z = pg8::cvt_pk_bf16(v1[0], v1[1]); w.w = pg8::cvt_pk_bf16(v1[2], v1[3]);
                    *(u32x4*)(pr + bj * 128) = w; }
            }
    }
};

template <int MODE>
__device__ __forceinline__ void sample_rows_gemm(const Params& P, const bf16_t* A, const bf16_t* Wt, LAS unsigned char* lds) {
    const int tid = threadIdx.x, lane = tid & 63, w = __builtin_amdgcn_readfirstlane(tid >> 6);
    const int c = lane & 15, g = lane >> 4;
    for (int tile = blockIdx.x; tile < 256; tile += gridDim.x) {
        const int tg = tile & 7, cg = tile >> 3;
        const int k0 = 256 * w;
        const bf16_t* wp = Wt + (size_t)(64 * cg + c) * D + k0 + 8 * g;
        const bf16_t* xp = A + (size_t)(NTOK_P + 32 * tg + c) * D + k0 + 8 * g;
        f32x4 acc[4][2];
#pragma unroll
        for (int ct = 0; ct < 4; ++ct) { acc[ct][0] = (f32x4){0.f, 0.f, 0.f, 0.f}; acc[ct][1] = (f32x4){0.f, 0.f, 0.f, 0.f}; }
        bf16x8 wf[8][4], xf[8][2];
#pragma unroll
        for (int ks = 0; ks < 8; ++ks) {
#pragma unroll
            for (int tt = 0; tt < 2; ++tt) xf[ks][tt] = *(const bf16x8*)(xp + (size_t)(16 * tt) * D + 32 * ks);
#pragma unroll
            for (int ct = 0; ct < 4; ++ct) wf[ks][ct] = *(const bf16x8*)(wp + (size_t)(16 * ct) * D + 32 * ks);
        }
        __builtin_amdgcn_sched_barrier(0);
#pragma unroll
        for (int ks = 0; ks < 8; ++ks)
#pragma unroll
            for (int ct = 0; ct < 4; ++ct)
#pragma unroll
                for (int tt = 0; tt < 2; ++tt) acc[ct][tt] = __builtin_amdgcn_mfma_f32_16x16x32_bf16(wf[ks][ct], xf[ks][tt], acc[ct][tt], 0, 0, 0);
        LAS float* part = (LAS float*)lds;
#pragma unroll
        for (int ct = 0; ct < 4; ++ct)
#pragma unroll
            for (int tt = 0; tt < 2; ++tt) *(LAS f32x4*)(part + ((w * 32 + 16 * tt + c) * 64 + 16 * ct + 4 * g)) = acc[ct][tt];
        __syncthreads();
        {
            const int tok = tid >> 4, c4 = (tid & 15) * 4;
            f32x4 sum = {0.f, 0.f, 0.f, 0.f};
#pragma unroll
            for (int ww = 0; ww < 8; ++ww) sum += *(const LAS f32x4*)(part + ((ww * 32 + tok) * 64 + c4));
            const int row = NTOK_P + 32 * tg + tok, col = 64 * cg + c4;
            if (MODE == 0) { const f32x4 xv = *(const f32x4*)(P.x_sample + (size_t)(row - NTOK_P) * D + col); const f32x4 r = xv * ALPHA + sum; u32x2 wv; wv.x = pg8::cvt_pk_bf16(r[0], r[1]); wv.y = pg8::cvt_pk_bf16(r[2], r[3]); *(u32x2*)((bf16_t*)(P.ws + WS_PRE1) + (size_t)row * D + col) = wv; }
            else { u32x2 wv; wv.x = pg8::cvt_pk_bf16(sum[0], sum[1]); wv.y = pg8::cvt_pk_bf16(sum[2], sum[3]); *(u32x2*)((bf16_t*)(P.ws + WS_QP) + (size_t)row * D + col) = wv; }
        }
        __syncthreads();
    }
}

constexpr int KVS = 288, VOFF = 73728;
struct AttnKV { u32x4 k[8], v[8]; bf16x8 q[4]; };
struct AttnId { int p, b, h, r, c; };
__device__ __forceinline__ void attn_fetch(const Params& P, const AttnId& u, AttnKV& R) {
    const int tid = threadIdx.x; const int dil = 1 << (2 * u.p);
    const bf16_t* Kb = (const bf16_t*)(P.ws + WS_KB); const bf16_t* Vb = (const bf16_t*)(P.ws + WS_VB16);
    const size_t tok0 = (size_t)u.b * 2048; const int j0 = 128 * u.c - 128, rho0 = (u.c == 0) ? 128 : 0;
    { const int lane = tid & 63, w = tid >> 6; const size_t qtok = tok0 + (size_t)((128 * u.c + 16 * w + (lane & 15)) * dil + u.r);
      const bf16_t* Qb = (const bf16_t*)(P.ws + WS_QB) + qtok * DATT + u.h * HD + 8 * (lane >> 4);
#pragma unroll
      for (int ks = 0; ks < 4; ++ks) R.q[ks] = *(const bf16x8*)(Qb + 32 * ks); }
#pragma unroll
    for (int it = 0; it < 8; ++it) {
        const int rho = it * 32 + (tid >> 4), ch = tid & 15;
        if (rho >= rho0) {
            const size_t tok = tok0 + (size_t)((j0 + rho) * dil + u.r);
            R.k[it] = *(const u32x4*)(Kb + tok * DATT + u.h * HD + ch * 8);
            R.v[it] = *(const u32x4*)(Vb + tok * DATT + u.h * HD + ch * 8);
        }
    }
}
__device__ __forceinline__ void attn_commit(const AttnId& u, const AttnKV& R, LAS unsigned char* lds) {
    const int tid = threadIdx.x; const int rho0 = (u.c == 0) ? 128 : 0;
#pragma unroll
    for (int it = 0; it < 8; ++it) {
        const int rho = it * 32 + (tid >> 4), ch = tid & 15;
        if (rho >= rho0) { *(LAS u32x4*)(lds + rho * KVS + ch * 16) = R.k[it]; *(LAS u32x4*)(lds + VOFF + rho * KVS + ch * 16) = R.v[it]; }
    }
}
template <int MODE>
__device__ __forceinline__ void attn_unit(const Params& P, const AttnId& uid, AttnKV& R, bool has_next, const AttnId& nid, LAS unsigned char* lds) {
    const int tid = threadIdx.x, lane = tid & 63, w = __builtin_amdgcn_readfirstlane(tid >> 6);
    const int p = uid.p, b = uid.b, h = uid.h, r = uid.r, c = uid.c;
    const int dil = 1 << (2 * p);
    const size_t tok0 = (size_t)b * 2048;
    attn_commit(uid, R, lds);
    const int cq = lane & 15, g = lane >> 4;
    const int iq = 128 * c + 16 * w + cq;
    const size_t qtok = tok0 + (size_t)(iq * dil + r);
    bf16x8 qf[4];
#pragma unroll
    for (int ks = 0; ks < 4; ++ks) qf[ks] = R.q[ks];
    __syncthreads();
#pragma unroll
    for (int ks = 0; ks < 4; ++ks) asm volatile("" : "+v"(qf[ks]));
    float m0 = 0.f, l0 = 0.f, m1 = 0.f, l1 = 0.f; u32x2 q0[8], q1[8];
    if (MODE == 1) {
        const float* PM = (const float*)(P.ws + WS_PM); const float* PL = (const float*)(P.ws + WS_PL);
        m0 = PM[qtok * NH + h]; l0 = PL[qtok * NH + h]; m1 = PM[((size_t)NTOK_P + qtok) * NH + h]; l1 = PL[((size_t)NTOK_P + qtok) * NH + h];
        const bf16_t* p0 = (const bf16_t*)(P.ws + WS_PO) + qtok * DATT + h * HD + 4 * g;
        const bf16_t* p1 = p0 + (size_t)NTOK_P * DATT;
#pragma unroll
        for (int dt = 0; dt < 8; ++dt) { q0[dt] = *(const u32x2*)(p0 + 16 * dt); q1[dt] = *(const u32x2*)(p1 + 16 * dt); }
        __builtin_amdgcn_sched_barrier(0);
    }
    if (has_next) attn_fetch(P, nid, R);
    const int ktmin = (8 - w - 8 * c) > 0 ? (8 - w - 8 * c) : 0;
    const float slope2 = exp2f(-8.0f * (float)(h + 1) / 12.0f) * LOG2E * (float)dil;
    f32x4 s[9]; float m = -INFINITY;
#pragma unroll
    for (int kt = 0; kt < 9; ++kt) {
        if (kt >= ktmin) {
            f32x4 acc = {0.f, 0.f, 0.f, 0.f};
#pragma unroll
            for (int ks = 0; ks < 4; ++ks) { const bf16x8 kf = *(const LAS bf16x8*)(lds + (16 * w + 16 * kt + cq) * KVS + (32 * ks + 8 * g) * 2); acc = __builtin_amdgcn_mfma_f32_16x16x32_bf16(kf, qf[ks], acc, 0, 0, 0); }
#pragma unroll
            for (int ii = 0; ii < 4; ++ii) { const int dist = cq + 128 - 16 * kt - 4 * g - ii; float v = acc[ii] - slope2 * (float)dist;
                if (kt == 0 && dist > 128) v = -INFINITY; if (kt == 8 && dist < 0) v = -INFINITY; acc[ii] = v; m = fmaxf(m, v); }
            s[kt] = acc;
        } else s[kt] = (f32x4){-INFINITY, -INFINITY, -INFINITY, -INFINITY};
    }
    m = fmaxf(m, __shfl_xor(m, 16)); m = fmaxf(m, __shfl_xor(m, 32));
    float l = 0.f;
#pragma unroll
    for (int kt = 0; kt < 9; ++kt)
#pragma unroll
        for (int ii = 0; ii < 4; ++ii) { const float pp = exp2f(s[kt][ii] - m); s[kt][ii] = pp; l += pp; }
    l += __shfl_xor(l, 16); l += __shfl_xor(l, 32);
    f32x4 o[8];
#pragma unroll
    for (int dt = 0; dt < 8; ++dt) o[dt] = (f32x4){0.f, 0.f, 0.f, 0.f};
#pragma unroll
    for (int kk = 0; kk < 5; ++kk) {
        const int T0 = 2 * kk, T1 = 2 * kk + 1;
        if (T1 >= ktmin || T0 == 8) {
            u32x4 pw; pw.x = pg8::cvt_pk_bf16(s[T0][0], s[T0][1]); pw.y = pg8::cvt_pk_bf16(s[T0][2], s[T0][3]);
            if (T1 <= 8) { pw.z = pg8::cvt_pk_bf16(s[T1 <= 8 ? T1 : 8][0], s[T1 <= 8 ? T1 : 8][1]); pw.w = pg8::cvt_pk_bf16(s[T1 <= 8 ? T1 : 8][2], s[T1 <= 8 ? T1 : 8][3]); } else { pw.z = 0u; pw.w = 0u; }
            const bf16x8 pf = __builtin_bit_cast(bf16x8, pw);
            const int rT0 = (T0 >= ktmin) ? T0 : 8, rT1 = (T1 <= 8 && T1 >= ktmin) ? T1 : 8;
            const int a0 = VOFF + (16 * w + 16 * rT0 + 4 * g + (cq >> 2)) * KVS + 8 * (cq & 3);
            const int a1 = VOFF + (16 * w + 16 * rT1 + 4 * g + (cq >> 2)) * KVS + 8 * (cq & 3);
#pragma unroll
            for (int dt = 0; dt < 8; ++dt) {
                const s16x4 v0 = __builtin_amdgcn_ds_read_tr16_b64_v4i16((LAS s16x4*)(lds + a0 + dt * 32));
                const s16x4 v1 = __builtin_amdgcn_ds_read_tr16_b64_v4i16((LAS s16x4*)(lds + a1 + dt * 32));
                const bf16x8 vf = {v0[0], v0[1], v0[2], v0[3], v1[0], v1[1], v1[2], v1[3]};
                o[dt] = __builtin_amdgcn_mfma_f32_16x16x32_bf16(vf, pf, o[dt], 0, 0, 0);
            }
        }
    }
    const float inv = 1.0f / l;
    if (MODE == 0) {
        bf16_t* po = (bf16_t*)(P.ws + WS_PO) + ((size_t)p * NTOK_P + qtok) * DATT + h * HD + 4 * g;
#pragma unroll
        for (int dt = 0; dt < 8; ++dt) { u32x2 wv; wv.x = pg8::cvt_pk_bf16(o[dt][0] * inv, o[dt][1] * inv); wv.y = pg8::cvt_pk_bf16(o[dt][2] * inv, o[dt][3] * inv); *(u32x2*)(po + 16 * dt) = wv; }
        if (g == 0) { ((float*)(P.ws + WS_PM))[((size_t)p * NTOK_P + qtok) * NH + h] = m; ((float*)(P.ws + WS_PL))[((size_t)p * NTOK_P + qtok) * NH + h] = l; }
    } else {
        const float M = fmaxf(m, fmaxf(m0, m1));
        const float w2 = exp2f(m - M), w0 = exp2f(m0 - M) * l0, w1 = exp2f(m1 - M) * l1;
        const float rden = 1.0f / (w2 * l + w0 + w1);
        bf16_t* ar = (bf16_t*)(P.ws + WS_AR) + qtok * D + h * HD + 4 * g;
#pragma unroll
        for (int dt = 0; dt < 8; ++dt) {
            const u32x2 x0 = q0[dt], x1 = q1[dt];
            const float r0 = (w2 * o[dt][0] + w0 * bflo(x0.x) + w1 * bflo(x1.x)) * rden, r1 = (w2 * o[dt][1] + w0 * bfhi(x0.x) + w1 * bfhi(x1.x)) * rden;
            const float r2 = (w2 * o[dt][2] + w0 * bflo(x0.y) + w1 * bflo(x1.y)) * rden, r3 = (w2 * o[dt][3] + w0 * bfhi(x0.y) + w1 * bfhi(x1.y)) * rden;
            u32x2 wv; wv.x = pg8::cvt_pk_bf16(r0, r1); wv.y = pg8::cvt_pk_bf16(r2, r3); *(u32x2*)(ar + 16 * dt) = wv;
        }
    }
    __syncthreads();
}

struct SampPre { float4 k[4], v[4]; bf16x8 q[4]; };
__device__ __forceinline__ void samp_qfetch(const Params& P, int b, int h, SampPre& R) {
    const int lane = threadIdx.x & 63;
    const bf16_t* Qb = (const bf16_t*)(P.ws + WS_QB) + ((size_t)(NTOK_P + b * 8 + (lane & 7))) * DATT + h * HD + 8 * (lane >> 4);
#pragma unroll
    for (int ks = 0; ks < 4; ++ks) R.q[ks] = *(const bf16x8*)(Qb + 32 * ks);
}
__device__ __forceinline__ void samp_prefetch(const Params& P, int b, int h, int k, SampPre& R) {
    const int tid = threadIdx.x;
    samp_qfetch(P, b, h, R);
#pragma unroll
    for (int it = 0; it < 4; ++it) {
        const int rho = it * 16 + (tid >> 5), ch4 = tid & 31, c = 256 * k + rho;
        const size_t so = ((size_t)(b * 2048 + c)) * DATT + h * HD + ch4 * 4;
        R.k[it] = *(const float4*)(P.cache_k + so); R.v[it] = *(const float4*)(P.cache_v + so);
    }
}
__device__ __forceinline__ void samp_unit(const Params& P, int b, int h, int k, LAS unsigned char* lds, SampPre& R, bool have, bool pf_next, int nb, int nh, int nk) {
    const int tid = threadIdx.x, lane = tid & 63, w = __builtin_amdgcn_readfirstlane(tid >> 6);
    const int cq = lane & 15, g = lane >> 4;
    if (k < 8) {
        if (!have) samp_prefetch(P, b, h, k, R);
#pragma unroll
        for (int it = 0; it < 16; ++it) {
            const int rho = it * 16 + (tid >> 5), ch4 = tid & 31, c = 256 * k + rho;
            const size_t so = ((size_t)(b * 2048 + c)) * DATT + h * HD + ch4 * 4;
            float4 kf, vf;
            if (it < 4) { kf = R.k[it < 4 ? it : 0]; vf = R.v[it < 4 ? it : 0]; } else { kf = *(const float4*)(P.cache_k + so); vf = *(const float4*)(P.cache_v + so); }
            if (c >= 8) { const size_t od = ((size_t)(b * 2048 + c - 8)) * DATT + h * HD + ch4 * 4; *(float4*)(P.out + O_KS + od) = kf; *(float4*)(P.out + O_VS + od) = vf; }
            u32x2 kw, vw; kw.x = pg8::cvt_pk_bf16(kf.x, kf.y); kw.y = pg8::cvt_pk_bf16(kf.z, kf.w); vw.x = pg8::cvt_pk_bf16(vf.x, vf.y); vw.y = pg8::cvt_pk_bf16(vf.z, vf.w);
            *(LAS u32x2*)(lds + rho * KVS + ch4 * 8) = kw; *(LAS u32x2*)(lds + VOFF + rho * KVS + ch4 * 8) = vw;
            if ((it & 3) == 3) __builtin_amdgcn_sched_barrier(0);
        }
    } else {
        samp_qfetch(P, b, h, R);
        const int rho = tid >> 5, ch4 = tid & 31;
        u32x2 kw = {0u, 0u}, vw = {0u, 0u};
        if (rho < 8) { const size_t so = ((size_t)(b * 2048 + 2040 + rho)) * DATT + h * HD + ch4 * 4; const float4 kf = *(const float4*)(P.out + O_KS + so), vf = *(const float4*)(P.out + O_VS + so);
            kw.x = pg8::cvt_pk_bf16(kf.x, kf.y); kw.y = pg8::cvt_pk_bf16(kf.z, kf.w); vw.x = pg8::cvt_pk_bf16(vf.x, vf.y); vw.y = pg8::cvt_pk_bf16(vf.z, vf.w); }
        *(LAS u32x2*)(lds + rho * KVS + ch4 * 8) = kw; *(LAS u32x2*)(lds + VOFF + rho * KVS + ch4 * 8) = vw;
        *(LAS u32x2*)(lds + (16 + rho) * KVS + ch4 * 8) = (u32x2){0u, 0u}; *(LAS u32x2*)(lds + VOFF + (16 + rho) * KVS + ch4 * 8) = (u32x2){0u, 0u};
    }
    const int t = cq & 7;
    bf16x8 qf[4];
#pragma unroll
    for (int ks = 0; ks < 4; ++ks) qf[ks] = R.q[ks];
#pragma unroll
    for (int ks = 0; ks < 4; ++ks) asm volatile("" : "+v"(qf[ks]));
    if (pf_next) samp_prefetch(P, nb, nh, nk, R);
    __syncthreads();
    const float slope2 = exp2f(-8.0f * (float)(h + 1) / 12.0f) * LOG2E;
    const bool active = (k < 8) || (w == 0);
    f32x4 s[2]; float m = -INFINITY;
#pragma unroll
    for (int j = 0; j < 2; ++j) {
        f32x4 acc = {0.f, 0.f, 0.f, 0.f};
        if (active) {
#pragma unroll
            for (int ks = 0; ks < 4; ++ks) { const bf16x8 kf = *(const LAS bf16x8*)(lds + (32 * w + 16 * j + cq) * KVS + (32 * ks + 8 * g) * 2); acc = __builtin_amdgcn_mfma_f32_16x16x32_bf16(kf, qf[ks], acc, 0, 0, 0); }
        }
#pragma unroll
        for (int ii = 0; ii < 4; ++ii) {
            const int c = 256 * k + 32 * w + 16 * j + 4 * g + ii, dist = 2048 + t - c;
            int mult = (dist <= 128 ? 1 : 0) + (((dist & 3) == 0 && dist <= 512) ? 1 : 0) + (((dist & 15) == 0 && dist <= 2048) ? 1 : 0);
            if (dist < 0 || !active || c > 2055) mult = 0;
            const float v = mult ? acc[ii] - slope2 * (float)dist : -INFINITY;
            acc[ii] = v; m = fmaxf(m, v);
            s[j][ii] = (float)mult;
            s[j][ii] = v;
        }
    }
    m = fmaxf(m, __shfl_xor(m, 16)); m = fmaxf(m, __shfl_xor(m, 32));
    const float mref = (m == -INFINITY) ? 0.f : m;
    float l = 0.f;
#pragma unroll
    for (int j = 0; j < 2; ++j)
#pragma unroll
        for (int ii = 0; ii < 4; ++ii) {
            const int c = 256 * k + 32 * w + 16 * j + 4 * g + ii, dist = 2048 + t - c;
            const int mult = (dist <= 128 ? 1 : 0) + (((dist & 3) == 0 && dist <= 512) ? 1 : 0) + (((dist & 15) == 0 && dist <= 2048) ? 1 : 0);
            const float pp = (float)mult * exp2f(s[j][ii] - mref); s[j][ii] = pp; l += pp; }
    l += __shfl_xor(l, 16); l += __shfl_xor(l, 32);
    f32x4 o[8];
    {
        u32x4 pw; pw.x = pg8::cvt_pk_bf16(s[0][0], s[0][1]); pw.y = pg8::cvt_pk_bf16(s[0][2], s[0][3]); pw.z = pg8::cvt_pk_bf16(s[1][0], s[1][1]); pw.w = pg8::cvt_pk_bf16(s[1][2], s[1][3]);
        const bf16x8 pf = __builtin_bit_cast(bf16x8, pw);
        const int rw = active ? w : 0;
        const int a0 = VOFF + (32 * rw + 4 * g + (cq >> 2)) * KVS + 8 * (cq & 3), a1 = a0 + 16 * KVS;
#pragma unroll
        for (int dt = 0; dt < 8; ++dt) {
            const s16x4 v0 = __builtin_amdgcn_ds_read_tr16_b64_v4i16((LAS s16x4*)(lds + a0 + dt * 32));
            const s16x4 v1 = __builtin_amdgcn_ds_read_tr16_b64_v4i16((LAS s16x4*)(lds + a1 + dt * 32));
            const bf16x8 vf = {v0[0], v0[1], v0[2], v0[3], v1[0], v1[1], v1[2], v1[3]};
            o[dt] = __builtin_amdgcn_mfma_f32_16x16x32_bf16(vf, pf, (f32x4){0.f, 0.f, 0.f, 0.f}, 0, 0, 0);
        }
    }
    __syncthreads();
    LAS float* OL = (LAS float*)lds;
    LAS float* ML = (LAS float*)(lds + 32768);
    if (cq < 8) {
#pragma unroll
        for (int dt = 0; dt < 8; ++dt) *(LAS f32x4*)(OL + (w * 8 + cq) * 128 + 16 * dt + 4 * g) = o[dt];
        if (g == 0) { ML[(w * 8 + cq) * 2 + 0] = m; ML[(w * 8 + cq) * 2 + 1] = l; }
    }
    __syncthreads();
    {
        const int q = w; float M = -INFINITY;
#pragma unroll
        for (int ww = 0; ww < 8; ++ww) M = fmaxf(M, ML[(ww * 8 + q) * 2]);
        const float Mr = (M == -INFINITY) ? 0.f : M;
        float L = 0.f, o0 = 0.f, o1 = 0.f;
#pragma unroll
        for (int ww = 0; ww < 8; ++ww) { const float f = exp2f(ML[(ww * 8 + q) * 2] - Mr); L += f * ML[(ww * 8 + q) * 2 + 1];
            o0 += f * OL[(ww * 8 + q) * 128 + 2 * lane]; o1 += f * OL[(ww * 8 + q) * 128 + 2 * lane + 1]; }
        float* ps = (float*)(P.ws + WS_PS) + ((((size_t)(b * NH + h)) * 9 + k) * 8 + q) * 130;
        if (lane == 0) { ps[0] = M; ps[1] = L; }
        *(float2*)(ps + 2 + 2 * lane) = make_float2(o0, o1);
    }
    __syncthreads();
}
__device__ __forceinline__ void samp_merge_unit(const Params& P, int b, int t, int h, int lane) {
    const float* ps = (const float*)(P.ws + WS_PS) + ((size_t)(b * NH + h)) * 9 * 8 * 130 + (size_t)t * 130;
    float M = -INFINITY;
#pragma unroll
    for (int k = 0; k < 9; ++k) M = fmaxf(M, ps[(size_t)k * 8 * 130]);
    float L = 0.f, o0 = 0.f, o1 = 0.f;
#pragma unroll
    for (int k = 0; k < 9; ++k) { const float* pk = ps + (size_t)k * 8 * 130; const float f = exp2f(pk[0] - M); L += f * pk[1]; const float2 ov = *(const float2*)(pk + 2 + 2 * lane); o0 += f * ov.x; o1 += f * ov.y; }
    const float inv = 1.0f / L;
    bf16_t* ar = (bf16_t*)(P.ws + WS_AR) + ((size_t)(NTOK_P + b * 8 + t)) * D + h * HD;
    *(unsigned*)(ar + 2 * lane) = pack2(o0 * inv, o1 * inv);
}

constexpr int LRU_XS = 144, LRU_GS = 68, LRU_WAVE = 16 * LRU_XS + 2 * 16 * LRU_GS * 4;
__device__ __forceinline__ void lru_unit(const Params& P, bool samp, int b, int n, int k, int lane, LAS unsigned char* wl) {
    const int T = samp ? 8 : 64; const int row0 = samp ? NTOK_P + b * 8 : b * 2048 + k * 64; const int ch = n * 64 + lane;
    const int cq = lane & 15, g = lane >> 4;
    bf16x8 wf[2][4][2];
    { const bf16_t* lw = (const bf16_t*)(P.ws + WS_LW);
#pragma unroll
      for (int m = 0; m < 2; ++m)
#pragma unroll
        for (int ct = 0; ct < 4; ++ct)
#pragma unroll
            for (int ks = 0; ks < 2; ++ks) wf[m][ct][ks] = *(const bf16x8*)(lw + ((size_t)((m * 8 + n) * 64 + 16 * ct + cq)) * 64 + 32 * ks + 8 * g); }
    const float ba = P.lru_b_a[ch], bx = P.lru_b_x[ch], lam = P.lru_lambda[ch];
    const float sp8 = -8.0f * LOG2E * log1pf(expf(-lam));
    const float cw0 = P.conv_w[ch], cw1 = P.conv_w[512 + ch], cw2 = P.conv_w[1024 + ch], cw3 = P.conv_w[1536 + ch], cb = P.conv_b[ch];
    const bf16_t* XR = (const bf16_t*)(P.ws + WS_XR); const bf16_t* GT = (const bf16_t*)(P.ws + WS_GATE);
    float* R0 = (float*)(P.ws + WS_R0); float* R1 = (float*)(P.ws + WS_R1); bf16_t* AR = (bf16_t*)(P.ws + WS_AR);
    LAS unsigned char* xcb = wl; LAS float* G = (LAS float*)(wl + 16 * LRU_XS);
    float x0 = 0.f, x1 = 0.f, x2 = 0.f, h = 0.f, A = 1.f;
    if (samp) { x0 = P.state_conv[(b * 3 + 0) * 512 + ch]; x1 = P.state_conv[(b * 3 + 1) * 512 + ch]; x2 = P.state_conv[(b * 3 + 2) * 512 + ch]; h = P.state_h[b * 512 + ch]; }
    else if (k > 0) { x0 = bflo(XR[(size_t)(row0 - 3) * DLRU + ch]); x1 = bflo(XR[(size_t)(row0 - 2) * DLRU + ch]); x2 = bflo(XR[(size_t)(row0 - 1) * DLRU + ch]); }
    unsigned xrn[16], gtn[16];
    { const int ns0 = T < 16 ? T : 16;
#pragma unroll
      for (int i = 0; i < 16; ++i) { const int r = row0 + (i < ns0 ? i : ns0 - 1); xrn[i] = XR[(size_t)r * DLRU + ch]; gtn[i] = GT[(size_t)r * DLRU + ch]; } }
    __builtin_amdgcn_sched_barrier(0);
#pragma unroll
    for (int i = 0; i < 16; ++i) { asm volatile("" : "+v"(xrn[i])); asm volatile("" : "+v"(gtn[i])); }
#pragma unroll 1
    for (int t0 = 0; t0 < T; t0 += 16) {
        const int ns = (T - t0) < 16 ? (T - t0) : 16;
        float xc[16], gt[16];
#pragma unroll
        for (int i = 0; i < 16; ++i) { xc[i] = bflo(xrn[i]); gt[i] = bflo(gtn[i]); }
        if (t0 + 16 < T) { const int nn = (T - t0 - 16) < 16 ? (T - t0 - 16) : 16;
#pragma unroll
            for (int i = 0; i < 16; ++i) { const int r = row0 + t0 + 16 + (i < nn ? i : nn - 1); xrn[i] = XR[(size_t)r * DLRU + ch]; gtn[i] = GT[(size_t)r * DLRU + ch]; } }
        __builtin_amdgcn_sched_barrier(0);
#pragma unroll
        for (int i = 0; i < 16; ++i) {
            const float xin = xc[i]; const float v = ((x0 * cw0 + x1 * cw1) + x2 * cw2) + xin * cw3 + cb;
            if (i < ns) { x0 = x1; x1 = x2; x2 = xin; }
            xc[i] = v;
            *(LAS bf16_t*)(xcb + i * LRU_XS + lane * 2) = (bf16_t)f2bf(v);
        }
        __builtin_amdgcn_wave_barrier();
        const bf16x8 a0 = *(const LAS bf16x8*)(xcb + cq * LRU_XS + (8 * g) * 2), a1 = *(const LAS bf16x8*)(xcb + cq * LRU_XS + (32 + 8 * g) * 2);
#pragma unroll
        for (int m = 0; m < 2; ++m)
#pragma unroll
            for (int ct = 0; ct < 4; ++ct) {
                f32x4 acc = __builtin_amdgcn_mfma_f32_16x16x32_bf16(a0, wf[m][ct][0], (f32x4){0.f, 0.f, 0.f, 0.f}, 0, 0, 0);
                acc = __builtin_amdgcn_mfma_f32_16x16x32_bf16(a1, wf[m][ct][1], acc, 0, 0, 0);
#pragma unroll
                for (int ii = 0; ii < 4; ++ii) G[(m * 16 + 4 * g + ii) * LRU_GS + 16 * ct + cq] = acc[ii];
            }
        __builtin_amdgcn_wave_barrier();
#pragma unroll
        for (int i = 0; i < 16; ++i) {
            if (i < ns) {
                const float ra = G[i * LRU_GS + lane] + ba, ri = G[(16 + i) * LRU_GS + lane] + bx;
                const float r = __builtin_amdgcn_rcpf(1.0f + __builtin_amdgcn_exp2f(-LOG2E * ra)), ig = __builtin_amdgcn_rcpf(1.0f + __builtin_amdgcn_exp2f(-LOG2E * ri));
                const float a = __builtin_amdgcn_exp2f(sp8 * r);
                const float u = __builtin_amdgcn_sqrtf(fmaxf(1.0f - a * a, 0.f)) * (ig * xc[i]);
                h = a * h + u; A = a * A;
                const float ge = gelu_as(gt[i]);
                if (samp) AR[(size_t)(row0 + t0 + i) * D + DATT + ch] = (bf16_t)f2bf(h * ge);
                else { R0[(size_t)(row0 + t0 + i) * DLRU + ch] = h * ge; R1[(size_t)(row0 + t0 + i) * DLRU + ch] = A * ge; }
            }
        }
        __builtin_amdgcn_wave_barrier();
    }
    if (samp) { P.out[O_HS + (size_t)b * 512 + ch] = h; float* co = P.out + O_CS + (size_t)b * 3 * 512 + ch; co[0] = x0; co[512] = x1; co[1024] = x2; }
    else {
        ((float*)(P.ws + WS_HE))[((size_t)(b * 32 + k)) * 512 + ch] = h; ((float*)(P.ws + WS_AE))[((size_t)(b * 32 + k)) * 512 + ch] = A;
        if (k == 31) { float* co = P.out + O_CP + (size_t)b * 3 * 512 + ch; co[0] = x0; co[512] = x1; co[1024] = x2; }
    }
}

__device__ __forceinline__ void phase_lru(const Params& P, LAS unsigned char* lds) {
    const int lane = threadIdx.x & 63, wave = __builtin_amdgcn_readfirstlane(threadIdx.x >> 6);
    const int gw = blockIdx.x * 8 + wave, nw = gridDim.x * 8;
#pragma unroll 1
    for (int pass = 0; pass < 2; ++pass) {
        if ((pass ^ (wave & 1)) == 0) {
            for (int u = gw; u < 2048 + 256; u += nw) { const bool samp = u >= 2048; const int v = samp ? u - 2048 : u; lru_unit(P, samp, samp ? (v >> 3) : (v >> 8), samp ? (v & 7) : ((v >> 5) & 7), v & 31, lane, lds + wave * LRU_WAVE); }
        } else quant_tables(P, gw, nw, MK_QHEAD, 2 * NEXP - MK_QTAIL);
    }
    __syncthreads();
}
__device__ __forceinline__ void phase_samp(const Params& P, LAS unsigned char* lds) {
    SampPre R; bool have = false;
    int u = blockIdx.x;
    if (u < 384 * 9 && (u % 9) < 8) { const int bh = u / 9; samp_prefetch(P, bh / NH, bh % NH, u % 9, R); have = true; }
    for (; u < 384 * 9; u += gridDim.x) {
        const int k = u % 9, bh = u / 9; const int un = u + (int)gridDim.x; const bool pf = un < 384 * 9 && (un % 9) < 8; const int nbh = un / 9;
        samp_unit(P, bh / NH, bh % NH, k, lds, R, have, pf, nbh / NH, nbh % NH, un % 9);
        have = pf;
    }
}
__device__ __forceinline__ AttnId attn01_id(int u) {
    const int p = u / 1536, rem = u - p * 1536, bh = rem >> 4, rc = rem & 15; const int b = bh / NH, h = bh - b * NH;
    return AttnId{p, b, h, p == 0 ? 0 : (rc >> 2), p == 0 ? rc : (rc & 3)};
}
__device__ __forceinline__ void phase_attn01(const Params& P, LAS unsigned char* lds) {
    AttnKV R; int u = blockIdx.x;
    if (u < 3072) attn_fetch(P, attn01_id(u), R);
    for (; u < 3072; u += gridDim.x) {
        const int un = u + (int)gridDim.x; const bool hn = un < 3072;
        attn_unit<0>(P, attn01_id(u), R, hn, attn01_id(hn ? un : u), lds);
    }
}
__device__ __forceinline__ void phase_mix_b(const Params& P, LAS unsigned char* lds) {
    {
        const int gt = blockIdx.x * NTHREADS + threadIdx.x;
        for (int i = gt; i < 8 * 32 * 512; i += gridDim.x * NTHREADS) {
            const int ch = i & 511, k = (i >> 9) & 31, b = i >> 14;
            const float* HE = (const float*)(P.ws + WS_HE) + (size_t)b * 32 * 512 + ch; const float* AE = (const float*)(P.ws + WS_AE) + (size_t)b * 32 * 512 + ch;
            float he[31], ae[31];
#pragma unroll
            for (int kk = 0; kk < 31; ++kk) { he[kk] = kk < k ? HE[kk * 512] : 0.f; ae[kk] = kk < k ? AE[kk * 512] : 1.f; }
            float hin = 0.f;
#pragma unroll
            for (int kk = 0; kk < 31; ++kk) hin = kk < k ? he[kk] + ae[kk] * hin : hin;
            const float* R0 = (const float*)(P.ws + WS_R0) + (size_t)(b * 2048 + k * 64) * DLRU + ch; const float* R1 = (const float*)(P.ws + WS_R1) + (size_t)(b * 2048 + k * 64) * DLRU + ch;
            bf16_t* ar = (bf16_t*)(P.ws + WS_AR) + (size_t)(b * 2048 + k * 64) * D + DATT + ch;
#pragma unroll 1
            for (int t0 = 0; t0 < 64; t0 += 16) {
                float r0[16], r1[16];
#pragma unroll
                for (int t = 0; t < 16; ++t) { r0[t] = R0[(size_t)(t0 + t) * DLRU]; r1[t] = R1[(size_t)(t0 + t) * DLRU]; }
#pragma unroll
                for (int t = 0; t < 16; ++t) ar[(size_t)(t0 + t) * D] = (bf16_t)f2bf(r0[t] + r1[t] * hin);
            }
            if (k == 31) P.out[O_HP + (size_t)b * 512 + ch] = HE[31 * 512] + AE[31 * 512] * hin;
        }
    }
    { const int lane = threadIdx.x & 63, gw = blockIdx.x * 8 + (threadIdx.x >> 6);
      for (int u = gw; u < NTOK_S * NH; u += gridDim.x * 8) { const int row = u / NH, h = u - row * NH; samp_merge_unit(P, row >> 3, row & 7, h, lane); } }
    {
        AttnKV R; int u = blockIdx.x;
        if (u < 1536) attn_fetch(P, AttnId{2, (u >> 4) / NH, (u >> 4) % NH, u & 15, 0}, R);
        for (; u < 1536; u += gridDim.x) {
            const int un = u + (int)gridDim.x; const bool hn = un < 1536; const int uu = hn ? un : u;
            attn_unit<1>(P, AttnId{2, (u >> 4) / NH, (u >> 4) % NH, u & 15, 0}, R, hn, AttnId{2, (uu >> 4) / NH, (uu >> 4) % NH, uu & 15, 0}, lds);
        }
    }
}

__device__ __forceinline__ void phase_ln1(const Params& P) {
    const int lane = threadIdx.x & 63, wave = threadIdx.x >> 6;
    const bf16_t* pre = (const bf16_t*)(P.ws + WS_PRE1); bf16_t* x1b = (bf16_t*)(P.ws + WS_X1B);
    const int rstep = gridDim.x * 8;
    float4 g8[8], b8[8];
#pragma unroll
    for (int j = 0; j < 8; ++j) { const int col = (j >> 2) * 1024 + lane * 16 + (j & 3) * 4; g8[j] = *(const float4*)(P.ln1_g + col); b8[j] = *(const float4*)(P.ln1_b + col); }
    u32x4 nx[4];
    { const int r0 = blockIdx.x * 8 + wave;
      if (r0 < NTOK) {
#pragma unroll
          for (int j = 0; j < 4; ++j) nx[j] = *(const u32x4*)(pre + (size_t)r0 * D + (j >> 1) * 1024 + lane * 16 + (j & 1) * 8); } }
#pragma unroll
    for (int j = 0; j < 4; ++j) asm volatile("" : "+v"(nx[j]));
    for (int row = blockIdx.x * 8 + wave; row < NTOK; row += rstep) {
        float4 v[8]; float s = 0.f;
        u32x4 cur[4];
#pragma unroll
        for (int j = 0; j < 4; ++j) cur[j] = nx[j];
        if (row + rstep < NTOK) {
#pragma unroll
            for (int j = 0; j < 4; ++j) nx[j] = *(const u32x4*)(pre + (size_t)(row + rstep) * D + (j >> 1) * 1024 + lane * 16 + (j & 1) * 8); }
#pragma unroll
        for (int j = 0; j < 8; j += 2) { const u32x4 pw = cur[j >> 1];
            v[j] = make_float4(bflo(pw.x), bfhi(pw.x), bflo(pw.y), bfhi(pw.y)); v[j + 1] = make_float4(bflo(pw.z), bfhi(pw.z), bflo(pw.w), bfhi(pw.w));
            s += (v[j].x + v[j].y) + (v[j].z + v[j].w) + (v[j + 1].x + v[j + 1].y) + (v[j + 1].z + v[j + 1].w); }
        const float mean = wave_sum(s) * (1.0f / D); float q = 0.f;
#pragma unroll
        for (int j = 0; j < 8; ++j) { const float a = v[j].x - mean, b = v[j].y - mean, c = v[j].z - mean, d = v[j].w - mean; q += (a * a + b * b) + (c * c + d * d); }
        const float rstd = rsqrtf(wave_sum(q) * (1.0f / D) + LN_EPS);
        float am = 0.f;
#pragma unroll
        for (int j = 0; j < 8; ++j) { const int col = (j >> 2) * 1024 + lane * 16 + (j & 3) * 4; const float4 g = g8[j], bb = b8[j];
            float4 o; o.x = (v[j].x - mean) * rstd * g.x + bb.x; o.y = (v[j].y - mean) * rstd * g.y + bb.y; o.z = (v[j].z - mean) * rstd * g.z + bb.z; o.w = (v[j].w - mean) * rstd * g.w + bb.w;
            v[j] = o; am = fmaxf(am, fmaxf(fmaxf(fabsf(o.x), fabsf(o.y)), fmaxf(fabsf(o.z), fabsf(o.w))));
            uint2 w; w.x = pack2(o.x, o.y); w.y = pack2(o.z, o.w); *(uint2*)(x1b + (size_t)row * D + col) = w; }
        am = wave_max(am); if (am == 0.f) am = 1.f;
        const float inv = 119.0f / am;
        unsigned char* xq = P.ws + WS_X1Q + (size_t)row * D;
        u32x4 wh, wl;
#pragma unroll
        for (int d = 0; d < 4; ++d) { unsigned dh = 0u, dl = 0u;
#pragma unroll
            for (int e = 0; e < 8; ++e) { const float4 t = v[d * 2 + (e >> 2)]; const float x = (e & 3) == 0 ? t.x : ((e & 3) == 1 ? t.y : ((e & 3) == 2 ? t.z : t.w));
                const int q = (int)rintf(x * inv); dl |= (unsigned)(q & 15) << (4 * e); dh |= (unsigned)(((q + 8) >> 4) & 15) << (4 * e); }
            wh[d] = dh; wl[d] = dl; }
        *(u32x4*)(xq + lane * 32) = wh; *(u32x4*)(xq + lane * 32 + 16) = wl;
        if (lane == 0) ((float*)(P.ws + WS_SX))[row] = am * (1.0f / 119.0f);
    }
}

__device__ __forceinline__ int mono(float v) { const int b = __float_as_int(v); return b ^ ((b >> 31) & 0x7fffffff); }
__device__ __forceinline__ float unmono(int k) { return __int_as_float(k ^ ((k >> 31) & 0x7fffffff)); }
#define MK_INSERT16(L, X) do { int _x = (X); _Pragma("unroll") for (int _j = 0; _j < 16; ++_j) { const int _hi = max(L[_j], _x); _x = min(L[_j], _x); L[_j] = _hi; } } while (0)

template <int N> __device__ __forceinline__ void bitonic_sort_desc(int (&v)[N]) {
#pragma unroll
    for (int k = 2; k <= N; k <<= 1)
#pragma unroll
        for (int j = k >> 1; j > 0; j >>= 1)
#pragma unroll
            for (int i = 0; i < N; ++i) { const int l = i ^ j;
                if (l > i) { const int a = v[i], b = v[l]; if ((i & k) == 0) { v[i] = max(a, b); v[l] = min(a, b); } else { v[i] = min(a, b); v[l] = max(a, b); } } }
}
template <int N> __device__ __forceinline__ void bitonic_merge_desc(int (&v)[N]) {
#pragma unroll
    for (int j = N >> 1; j > 0; j >>= 1)
#pragma unroll
        for (int i = 0; i < N; ++i) { const int l = i ^ j; if (l > i) { const int a = v[i], b = v[l]; v[i] = max(a, b); v[l] = min(a, b); } }
}
__device__ __forceinline__ void xlane_merge16(int (&v)[16], int off) {
    int c[16];
#pragma unroll
    for (int i = 0; i < 16; ++i) c[i] = max(v[i], __shfl_xor(v[15 - i], off));
#pragma unroll
    for (int i = 0; i < 16; ++i) v[i] = c[i];
    bitonic_merge_desc<16>(v);
}
__device__ __forceinline__ int sel4(int g, int a, int b, int c, int d) { return g == 0 ? a : (g == 1 ? b : (g == 2 ? c : d)); }
__device__ __forceinline__ float sel4f(int g, float a, float b, float c, float d) { return g == 0 ? a : (g == 1 ? b : (g == 2 ? c : d)); }
__device__ __forceinline__ constexpr int cand_a(int role, int i) {
    return role == 0 ? 0 : role == 1 ? (i < 8 ? 1 : (i < 13 ? 2 : 4)) : role == 2 ? (i < 4 ? 3 : (i < 6 ? 5 : (i < 8 ? 6 : (i < 10 ? 7 : 8 + (i - 10))))) : (i < 2 ? 14 + i : -1);
}
__device__ __forceinline__ constexpr int cand_b(int role, int i) {
    return role == 0 ? i : role == 1 ? (i < 8 ? i : (i < 13 ? i - 8 : i - 13)) : role == 2 ? (i < 4 ? i : (i < 6 ? i - 4 : (i < 8 ? i - 6 : (i < 10 ? i - 8 : 0)))) : 0;
}

__device__ __forceinline__ void route_qfetch(const Params& P, int h, int tg, bf16x8 (&qn)[8]) {
    const int lane = threadIdx.x & 63, w = __builtin_amdgcn_readfirstlane(threadIdx.x >> 6);
    const bf16_t* qrow = (const bf16_t*)(P.ws + WS_QP) + (size_t)(tg * 128 + w * 16 + (lane & 15)) * D + h * 256 + 8 * (lane >> 4);
#pragma unroll
    for (int i = 0; i < 8; ++i) qn[i] = *(const bf16x8*)(qrow + (i >> 2) * 128 + 32 * (i & 3));
}
__device__ __forceinline__ void route_unit(const Params& P, int h, int tg, LAS unsigned char* lds, LAS int* lst, bf16x8 (&qn)[8], bool has_next, int tg_next) {
    const int lane = threadIdx.x & 63, w = __builtin_amdgcn_readfirstlane(threadIdx.x >> 6);
    const int cq = lane & 15, g = lane >> 4;
    const int tok = tg * 128 + w * 16 + cq;
    bf16x8 qa[8];
#pragma unroll
    for (int i = 0; i < 8; ++i) { qa[i] = qn[i]; asm volatile("" : "+v"(qa[i])); }
    if (has_next) route_qfetch(P, h, tg_next, qn);
    __builtin_amdgcn_sched_barrier(0);
    int L0[16], L1[16];
#pragma unroll
    for (int p = 0; p < 2; ++p) {
        bf16x8 qf[4];
#pragma unroll
        for (int ks = 0; ks < 4; ++ks) qf[ks] = qa[p * 4 + ks];
        int v0[16], v1[16];
#pragma unroll
        for (int kt = 0; kt < 8; ++kt) {
            f32x4 acc = {0.f, 0.f, 0.f, 0.f};
#pragma unroll
            for (int ks = 0; ks < 4; ++ks) { const bf16x8 kf = *(const LAS bf16x8*)(lds + (p * 128 + 16 * kt + cq) * KVS + (32 * ks + 8 * g) * 2); acc = __builtin_amdgcn_mfma_f32_16x16x32_bf16(kf, qf[ks], acc, 0, 0, 0); }
#pragma unroll
            for (int ii = 0; ii < 4; ++ii) { const int key = (mono(acc[ii]) & ~127) | (16 * kt + 4 * g + ii); if (kt < 4) v0[kt * 4 + ii] = key; else v1[(kt - 4) * 4 + ii] = key; }
        }
        bitonic_sort_desc<16>(v0); bitonic_sort_desc<16>(v1);
#pragma unroll
        for (int i = 0; i < 16; ++i) v0[i] = max(v0[i], v1[15 - i]);
        bitonic_merge_desc<16>(v0);
        xlane_merge16(v0, 16); xlane_merge16(v0, 32);
#pragma unroll
        for (int i = 0; i < 16; ++i) { if (p == 0) L0[i] = v0[i]; else L1[i] = v0[i]; }
    }
    if (g == 0) {
#pragma unroll
        for (int i = 0; i < 16; ++i) lst[(cq * 2 + 0) * 16 + i] = L0[i];
    }
    if (g == 1) {
#pragma unroll
        for (int i = 0; i < 16; ++i) lst[(cq * 2 + 1) * 16 + i] = L1[i];
    }
    float f0[16], f1[16];
#pragma unroll
    for (int i = 0; i < 16; ++i) { f0[i] = unmono(L0[i] & ~127); f1[i] = unmono(L1[i] & ~127); }
    int c[16];
#pragma unroll
    for (int i = 0; i < 16; ++i) {
        constexpr int NEG = (int)0x80000000;
        const float va = sel4f(g, f0[cand_a(0, i)], f0[cand_a(1, i)], f0[cand_a(2, i)], f0[cand_a(3, i) < 0 ? 0 : cand_a(3, i)]);
        const float vb = sel4f(g, f1[cand_b(0, i)], f1[cand_b(1, i)], f1[cand_b(2, i)], f1[cand_b(3, i)]);
        const int id = sel4(g, (cand_a(0, i) << 4) | cand_b(0, i), (cand_a(1, i) << 4) | cand_b(1, i), (cand_a(2, i) << 4) | cand_b(2, i), ((cand_a(3, i) < 0 ? 0 : cand_a(3, i)) << 4) | cand_b(3, i));
        int key = (mono(va + vb) & ~255) | id;
        if (cand_a(3, i) < 0) key = (g == 3) ? NEG : key;
        c[i] = key;
    }
    bitonic_sort_desc<16>(c);
    xlane_merge16(c, 16); xlane_merge16(c, 32);
    const float mx = unmono(c[0] & ~255);
    float e[16]; float sum = 0.f;
#pragma unroll
    for (int i = 0; i < 16; ++i) { e[i] = exp2f((unmono(c[i] & ~255) - mx) * LOG2E); sum += e[i]; }
    const float inv = 1.0f / sum;
    __builtin_amdgcn_wave_barrier();
    int ei[4]; float gi[4];
#pragma unroll
    for (int j = 0; j < 4; ++j) {
        const int key = sel4(g, c[j], c[4 + j], c[8 + j], c[12 + j]);
        gi[j] = sel4f(g, e[j], e[4 + j], e[8 + j], e[12 + j]) * inv;
        const int a = (key >> 4) & 15, b = key & 15;
        const int i0 = lst[(cq * 2 + 0) * 16 + a] & 127, i1 = lst[(cq * 2 + 1) * 16 + b] & 127;
        ei[j] = i0 * 128 + i1;
    }
    int* EIDX = (int*)(P.ws + WS_EIDX); float* GW = (float*)(P.ws + WS_GW);
    *(int4*)(EIDX + (size_t)tok * 128 + h * 16 + 4 * g) = make_int4(ei[0], ei[1], ei[2], ei[3]);
    *(float4*)(GW + (size_t)tok * 128 + h * 16 + 4 * g) = make_float4(gi[0], gi[1], gi[2], gi[3]);
    __builtin_amdgcn_wave_barrier();
}
__device__ __forceinline__ void phase_route(const Params& P, LAS unsigned char* lds) {
    const int tid = threadIdx.x, wave = __builtin_amdgcn_readfirstlane(tid >> 6);
    const int h = blockIdx.x & 7, slot = blockIdx.x >> 3, nslot = gridDim.x >> 3;
    const bf16_t* sk = (const bf16_t*)(P.ws + WS_SKB) + (size_t)h * 2 * 128 * 128;
#pragma unroll
    for (int it = 0; it < 8; ++it) { const int row = it * 32 + (tid >> 4), ch = tid & 15; *(LAS u32x4*)(lds + row * KVS + ch * 16) = *(const u32x4*)(sk + (size_t)row * 128 + ch * 8); }
    __syncthreads();
    LAS int* lst = (LAS int*)(lds + 73728) + wave * 512;
    bf16x8 qn[8];
    if (slot < NTOK / 128) route_qfetch(P, h, slot, qn);
    for (int tg = slot; tg < NTOK / 128; tg += nslot) route_unit(P, h, tg, lds, lst, qn, tg + nslot < NTOK / 128, tg + nslot);
    { const int extra = (NTOK / 128) % nslot;
      if (extra != 0 && slot >= extra) quant_tables(P, ((slot - extra) * 8 + h) * 8 + wave, (nslot - extra) * 8 * 8, 2 * NEXP - MK_QTAIL, 2 * NEXP);
      else if (extra == 0) quant_tables(P, (int)blockIdx.x * 8 + wave, (int)gridDim.x * 8, 2 * NEXP - MK_QTAIL, 2 * NEXP); }
}

__device__ __forceinline__ float ubf(unsigned x, int k) { return (float)((x >> (8 * k)) & 0xffu); }
constexpr int XSLOT = 1152, XGRP = 4 * XSLOT, XNG = 4, XWAVE = XNG * XGRP;
__device__ __forceinline__ void dma_group(__amdgpu_buffer_rsrc_t tab, int e_lo, int e_hi, int g, LAS unsigned char* sb, int lane) {
#pragma unroll
    for (int j = 0; j < 4; ++j) {
        const int k = g * 4 + j; const int e = __builtin_amdgcn_readlane(k < 64 ? e_lo : e_hi, k & 63);
        const int so = e * TROW;
        __builtin_amdgcn_raw_ptr_buffer_load_lds(tab, (LAS void*)(sb + j * XSLOT), 16, lane * 16, so, 0, 0);
        if (lane < 8) __builtin_amdgcn_raw_ptr_buffer_load_lds(tab, (LAS void*)(sb + j * XSLOT + 1024), 16, 1024 + lane * 16, so, 0, 0);
    }
}
__device__ __forceinline__ void u_consume(const LAS unsigned char* sb, const u32x4& xh, const u32x4& xl, float a_lo, float a_hi, float b_lo, float b_hi, int g, int lane, float& w_lo, float& w_hi) {
    int d[4];
#pragma unroll
    for (int j = 0; j < 4; ++j) {
        const u32x4 nb = *(const LAS u32x4*)(sb + j * XSLOT + lane * 16); const unsigned sc = *(const LAS unsigned short*)(sb + j * XSLOT + 1024 + lane * 2);
        int tot = 0;
#pragma unroll
        for (int jj = 0; jj < 2; ++jj) {
            int th = __builtin_amdgcn_sdot8((int)nb[jj * 2], (int)xh[jj * 2], 0, false); th = __builtin_amdgcn_sdot8((int)nb[jj * 2 + 1], (int)xh[jj * 2 + 1], th, false);
            int tl = __builtin_amdgcn_sdot8((int)nb[jj * 2], (int)xl[jj * 2], 0, false); tl = __builtin_amdgcn_sdot8((int)nb[jj * 2 + 1], (int)xl[jj * 2 + 1], tl, false);
            tot += (16 * th + tl) * (int)((sc >> (8 * jj)) & 255u); }
        d[j] = tot;
    }
    const auto s02 = __builtin_amdgcn_permlane32_swap((unsigned)d[0], (unsigned)d[2], false, false);
    const auto s13 = __builtin_amdgcn_permlane32_swap((unsigned)d[1], (unsigned)d[3], false, false);
    const int r0 = (int)s02[0] + (int)s02[1], r1 = (int)s13[0] + (int)s13[1];
    const auto s01 = __builtin_amdgcn_permlane16_swap((unsigned)r0, (unsigned)r1, false, false);
    int r = (int)s01[0] + (int)s01[1];
    r += __builtin_amdgcn_update_dpp(0, r, 0x128, 0xf, 0xf, false);
    r += __builtin_amdgcn_update_dpp(0, r, 0x124, 0xf, 0xf, false);
    r += __builtin_amdgcn_update_dpp(0, r, 0x4E, 0xf, 0xf, false);
    r += __builtin_amdgcn_update_dpp(0, r, 0xB1, 0xf, 0xf, false);
    const int tot = __shfl(r, (lane & 3) * 16);
    const bool mine = ((lane >> 2) == (g & 15));
    const bool hi = g >= 16;
    const float wv = (hi ? b_hi : b_lo) * gelu_as((float)tot * (hi ? a_hi : a_lo));
    if (hi) w_hi = mine ? wv : w_hi; else w_lo = mine ? wv : w_lo;
}
__device__ __forceinline__ void v_consume(const LAS unsigned char* sb, int (&acc)[32], int (&bias)[2], float w_lo, float w_hi, float inv_sw, int g, int lane) {
    u32x4 nb[4]; int wq[2] = {0, 0};
#pragma unroll
    for (int j = 0; j < 4; ++j) {
        const int k = g * 4 + j; const float w = readlane_f(k < 64 ? w_lo : w_hi, k & 63) * inv_sw;
        nb[j] = *(const LAS u32x4*)(sb + j * XSLOT + lane * 16); const unsigned sc = *(const LAS unsigned short*)(sb + j * XSLOT + 1024 + lane * 2);
#pragma unroll
        for (int jj = 0; jj < 2; ++jj) { const int q = (int)rintf(w * (float)((sc >> (8 * jj)) & 255u)); wq[jj] |= (q & 255) << (8 * j); }
    }
    bias[0] = __builtin_amdgcn_sdot4(wq[0], 0x01010101, bias[0], false); bias[1] = __builtin_amdgcn_sdot4(wq[1], 0x01010101, bias[1], false);
#pragma unroll
    for (int i = 0; i < 4; ++i) {
        const unsigned r0 = nb[0][i], r1 = nb[1][i], r2 = nb[2][i], r3 = nb[3][i];
        const unsigned p01a = __builtin_amdgcn_perm(r1, r0, 0x05010400u), p01b = __builtin_amdgcn_perm(r1, r0, 0x07030602u);
        const unsigned p23a = __builtin_amdgcn_perm(r3, r2, 0x05010400u), p23b = __builtin_amdgcn_perm(r3, r2, 0x07030602u);
        const unsigned t0 = __builtin_amdgcn_perm(p23a, p01a, 0x05040100u), t1 = __builtin_amdgcn_perm(p23a, p01a, 0x07060302u);
        const unsigned t2 = __builtin_amdgcn_perm(p23b, p01b, 0x05040100u), t3 = __builtin_amdgcn_perm(p23b, p01b, 0x07060302u);
        const int wv = wq[i >> 1];
        acc[i * 8 + 0] = __builtin_amdgcn_sdot4((int)(t0 & 0x0F0F0F0Fu), wv, acc[i * 8 + 0], false); acc[i * 8 + 1] = __builtin_amdgcn_sdot4((int)((t0 >> 4) & 0x0F0F0F0Fu), wv, acc[i * 8 + 1], false);
        acc[i * 8 + 2] = __builtin_amdgcn_sdot4((int)(t1 & 0x0F0F0F0Fu), wv, acc[i * 8 + 2], false); acc[i * 8 + 3] = __builtin_amdgcn_sdot4((int)((t1 >> 4) & 0x0F0F0F0Fu), wv, acc[i * 8 + 3], false);
        acc[i * 8 + 4] = __builtin_amdgcn_sdot4((int)(t2 & 0x0F0F0F0Fu), wv, acc[i * 8 + 4], false); acc[i * 8 + 5] = __builtin_amdgcn_sdot4((int)((t2 >> 4) & 0x0F0F0F0Fu), wv, acc[i * 8 + 5], false);
        acc[i * 8 + 6] = __builtin_amdgcn_sdot4((int)(t3 & 0x0F0F0F0Fu), wv, acc[i * 8 + 6], false); acc[i * 8 + 7] = __builtin_amdgcn_sdot4((int)((t3 >> 4) & 0x0F0F0F0Fu), wv, acc[i * 8 + 7], false);
    }
}
__device__ __forceinline__ void wave_sort128(int& v0, int& v1, int lane) {
#pragma unroll
    for (int k = 2; k <= 128; k <<= 1) {
#pragma unroll
        for (int j = k >> 1; j > 0; j >>= 1) {
            if (j == 64) { const int lo = min(v0, v1), hi = max(v0, v1); v0 = lo; v1 = hi; }
            else {
                const int p0 = __shfl_xor(v0, j), p1 = __shfl_xor(v1, j);
                const bool lower = (lane & j) == 0;
                const bool asc0 = (lane & k) == 0, asc1 = ((64 + lane) & k) == 0;
                v0 = (lower == asc0) ? min(v0, p0) : max(v0, p0);
                v1 = (lower == asc1) ? min(v1, p1) : max(v1, p1);
            }
        }
    }
}
__device__ __forceinline__ void exp_epilogue(const Params& P, int row, int ln, const int (&acc)[32], const int (&bias)[2], float scale_w) {
    const bf16_t* x1b = (const bf16_t*)(P.ws + WS_X1B);
    float val[32]; float s = 0.f;
#pragma unroll
    for (int jj = 0; jj < 2; ++jj) {
        const int b8 = 8 * bias[jj];
#pragma unroll
        for (int hh = 0; hh < 2; ++hh) {
            const u32x4 xa = *(const u32x4*)(x1b + (size_t)row * D + jj * 1024 + ln * 16 + hh * 8);
#pragma unroll
            for (int i = 0; i < 4; ++i) { const int e0 = jj * 16 + hh * 8 + 2 * i;
                val[e0] = scale_w * (float)(acc[e0] - b8) + ALPHA * bflo(xa[i]); val[e0 + 1] = scale_w * (float)(acc[e0 + 1] - b8) + ALPHA * bfhi(xa[i]); s += val[e0] + val[e0 + 1]; }
        }
    }
    const float mean = wave_sum(s) * (1.0f / D); float q = 0.f;
#pragma unroll
    for (int i = 0; i < 32; ++i) { const float d0 = val[i] - mean; q += d0 * d0; }
    const float rstd = rsqrtf(wave_sum(q) * (1.0f / D) + LN_EPS);
    float* yo = P.out + (row < NTOK_P ? O_YP + (size_t)row * D : O_YS + (size_t)(row - NTOK_P) * D);
    const int lo16 = ln * 16;
    float4 gg[8], bb[8];
#pragma unroll
    for (int jj = 0; jj < 2; ++jj)
#pragma unroll
        for (int i = 0; i < 4; ++i) { const int col = jj * 1024 + lo16 + i * 4; gg[jj * 4 + i] = *(const float4*)(P.ln2_g + col); bb[jj * 4 + i] = *(const float4*)(P.ln2_b + col); }
#pragma unroll
    for (int jj = 0; jj < 2; ++jj)
#pragma unroll
        for (int i = 0; i < 4; ++i) {
            const int col = jj * 1024 + lo16 + i * 4;
            const float4 g0 = gg[jj * 4 + i], b0 = bb[jj * 4 + i];
            float4 o;
            o.x = (val[jj * 16 + i * 4 + 0] - mean) * rstd * g0.x + b0.x; o.y = (val[jj * 16 + i * 4 + 1] - mean) * rstd * g0.y + b0.y;
            o.z = (val[jj * 16 + i * 4 + 2] - mean) * rstd * g0.z + b0.z; o.w = (val[jj * 16 + i * 4 + 3] - mean) * rstd * g0.w + b0.w;
            *(float4*)(yo + col) = o;
        }
}
__device__ __forceinline__ void phase_experts(const Params& P, LAS unsigned char* lds) {
    const int lane = threadIdx.x & 63, wave = __builtin_amdgcn_readfirstlane(threadIdx.x >> 6);
    const int* EIDX = (const int*)(P.ws + WS_EIDX); const float* GW = (const float*)(P.ws + WS_GW);
    const __amdgpu_buffer_rsrc_t UQ = __builtin_amdgcn_make_buffer_rsrc((void*)(P.ws + WS_UB), 0, NEXP * TROW, 0x00020000);
    const __amdgpu_buffer_rsrc_t VQ = __builtin_amdgcn_make_buffer_rsrc((void*)(P.ws + WS_VB), 0, NEXP * TROW, 0x00020000);
    const float* SU = (const float*)(P.ws + WS_SU); const float* SV = (const float*)(P.ws + WS_SV); const float* SX = (const float*)(P.ws + WS_SX);
    LAS unsigned char* wb = lds + wave * XWAVE;
    constexpr int TPW = 8;
    const int row0 = blockIdx.x * 8 + wave, rstride = gridDim.x * 8;
    if (row0 + (TPW - 1) * rstride < NTOK_P) {
        u32x4 mxh[TPW], mxl[TPW]; int mel[TPW], meh[TPW]; float mal[TPW], mah[TPW], mbl[TPW], mbh[TPW];
#pragma unroll
        for (int i = 0; i < TPW; ++i) {
            const int row = row0 + i * rstride;
            mxh[i] = *(const u32x4*)(P.ws + WS_X1Q + (size_t)row * D + lane * 32); mxl[i] = *(const u32x4*)(P.ws + WS_X1Q + (size_t)row * D + lane * 32 + 16);
            int p0 = (EIDX[(size_t)row * 128 + lane] << 18) | min(262143, (int)(GW[(size_t)row * 128 + lane] * 262144.0f));
            int p1 = (EIDX[(size_t)row * 128 + 64 + lane] << 18) | min(262143, (int)(GW[(size_t)row * 128 + 64 + lane] * 262144.0f));
            wave_sort128(p0, p1, lane);
            mel[i] = (int)((unsigned)p0 >> 18); meh[i] = (int)((unsigned)p1 >> 18);
            const float gl = ((float)(p0 & 262143) + 0.5f) * (1.0f / 262144.0f), gh = ((float)(p1 & 262143) + 0.5f) * (1.0f / 262144.0f);
            const float sx = SX[row];
            mal[i] = SU[mel[i]] * sx; mah[i] = SU[meh[i]] * sx; mbl[i] = gl * SV[mel[i]]; mbh[i] = gh * SV[meh[i]];
        }
        asm volatile("s_waitcnt vmcnt(0)" ::: "memory");
        dma_group(UQ, mel[0], meh[0], 0, wb, lane); dma_group(UQ, mel[0], meh[0], 1, wb + XGRP, lane); dma_group(UQ, mel[0], meh[0], 2, wb + 2 * XGRP, lane);
        int sg = 0;
        float mwl[TPW], mwh[TPW];
#pragma unroll
        for (int j = 0; j < TPW; ++j) { mwl[j] = 0.f; mwh[j] = 0.f; }
        static_assert(TPW == 8, "the visit order below is written for 8 tokens per wave");
#pragma unroll 1
        for (int v = 0; v < 64; ++v) {
            const int ss = v >> 3, i = v & 7, i2 = (v + 1) & 7, s2 = (v + 1) >> 3;
            u32x4 xh = mxh[0], xl = mxl[0]; int e_lo = mel[0], e_hi = meh[0], n_lo = mel[0], n_hi = meh[0]; float a_lo = mal[0], a_hi = mah[0], b_lo = mbl[0], b_hi = mbh[0], w_lo = mwl[0], w_hi = mwh[0];
#pragma unroll
            for (int j = 1; j < TPW; ++j) { const bool m = (i == j), m2 = (i2 == j);
                xh[0] = m ? mxh[j][0] : xh[0]; xh[1] = m ? mxh[j][1] : xh[1]; xh[2] = m ? mxh[j][2] : xh[2]; xh[3] = m ? mxh[j][3] : xh[3];
                xl[0] = m ? mxl[j][0] : xl[0]; xl[1] = m ? mxl[j][1] : xl[1]; xl[2] = m ? mxl[j][2] : xl[2]; xl[3] = m ? mxl[j][3] : xl[3];
                e_lo = m ? mel[j] : e_lo; e_hi = m ? meh[j] : e_hi; a_lo = m ? mal[j] : a_lo; a_hi = m ? mah[j] : a_hi; b_lo = m ? mbl[j] : b_lo; b_hi = m ? mbh[j] : b_hi;
                w_lo = m ? mwl[j] : w_lo; w_hi = m ? mwh[j] : w_hi; n_lo = m2 ? mel[j] : n_lo; n_hi = m2 ? meh[j] : n_hi; }
#pragma unroll
            for (int gg = 0; gg < 4; ++gg) {
                const int sn = (sg + 3) & 3;
                if (gg == 0) dma_group(UQ, e_lo, e_hi, ss * 4 + 3, wb + sn * XGRP, lane);
                else if (v < 63) dma_group(UQ, n_lo, n_hi, s2 * 4 + gg - 1, wb + sn * XGRP, lane);
                else dma_group(VQ, n_lo, n_hi, gg - 1, wb + sn * XGRP, lane);
                asm volatile("s_waitcnt vmcnt(24)" ::: "memory");
                u_consume(wb + sg * XGRP, xh, xl, a_lo, a_hi, b_lo, b_hi, ss * 4 + gg, lane, w_lo, w_hi);
                sg = (sg + 1) & 3;
            }
#pragma unroll
            for (int j = 0; j < TPW; ++j) { const bool m = (i == j); mwl[j] = m ? w_lo : mwl[j]; mwh[j] = m ? w_hi : mwh[j]; }
        }
#pragma unroll 1
        for (int i = 0; i < TPW; ++i) {
            const int row = row0 + i * rstride;
            int e_lo = mel[0], e_hi = meh[0], n_lo = mel[0], n_hi = meh[0]; float w_lo = mwl[0], w_hi = mwh[0];
#pragma unroll
            for (int j = 1; j < TPW; ++j) { const bool m = (i == j); e_lo = m ? mel[j] : e_lo; e_hi = m ? meh[j] : e_hi; w_lo = m ? mwl[j] : w_lo; w_hi = m ? mwh[j] : w_hi; }
#pragma unroll
            for (int j = 0; j < TPW - 1; ++j) { const bool m = (i == j); n_lo = m ? mel[j + 1] : n_lo; n_hi = m ? meh[j + 1] : n_hi; }
            float wmax = wave_max(fmaxf(fabsf(w_lo), fabsf(w_hi))); if (wmax == 0.f) wmax = 1.f;
            const float scale_w = wmax * (255.0f / 127.0f), inv_sw = 1.0f / scale_w;
            int acc[32]; int bias[2] = {0, 0};
#pragma unroll
            for (int q = 0; q < 32; ++q) acc[q] = 0;
#pragma unroll 1
            for (int g = 0; g < 32; ++g) {
                const int sn = (sg + 3) & 3;
                if (g + 3 < 32) dma_group(VQ, e_lo, e_hi, g + 3, wb + sn * XGRP, lane);
                else dma_group(VQ, n_lo, n_hi, g + 3 - 32, wb + sn * XGRP, lane);
                asm volatile("s_waitcnt vmcnt(24)" ::: "memory");
                v_consume(wb + sg * XGRP, acc, bias, w_lo, w_hi, inv_sw, g, lane);
                sg = (sg + 1) & 3;
            }
            int ln = lane; asm volatile("" : "+v"(ln));
            exp_epilogue(P, row, ln, acc, bias, scale_w);
        }
        asm volatile("s_waitcnt vmcnt(0)" ::: "memory");
    }
    for (int row = row0 + ((row0 + (TPW - 1) * rstride < NTOK_P) ? TPW * rstride : 0); row < NTOK_P; row += rstride) {
        int ln = lane; asm volatile("" : "+v"(ln));
        const u32x4 xh = *(const u32x4*)(P.ws + WS_X1Q + (size_t)row * D + ln * 32), xl = *(const u32x4*)(P.ws + WS_X1Q + (size_t)row * D + ln * 32 + 16);
        const float sx = SX[row];
        const int e_lo = EIDX[(size_t)row * 128 + ln], e_hi = EIDX[(size_t)row * 128 + 64 + ln];
        const float g_lo = GW[(size_t)row * 128 + ln], g_hi = GW[(size_t)row * 128 + 64 + ln];
        const float a_lo = SU[e_lo] * sx, a_hi = SU[e_hi] * sx, b_lo = g_lo * SV[e_lo], b_hi = g_hi * SV[e_hi];
        float w_lo = 0.f, w_hi = 0.f;
        asm volatile("s_waitcnt vmcnt(0)" ::: "memory");
        dma_group(UQ, e_lo, e_hi, 0, wb, lane); dma_group(UQ, e_lo, e_hi, 1, wb + XGRP, lane); dma_group(UQ, e_lo, e_hi, 2, wb + 2 * XGRP, lane);
        int sg = 0;
#pragma unroll 1
        for (int g = 0; g < 32; ++g) {
            const int sn = (sg + 3) & 3;
            if (g + 3 < 32) dma_group(UQ, e_lo, e_hi, g + 3, wb + sn * XGRP, lane); else dma_group(VQ, e_lo, e_hi, g + 3 - 32, wb + sn * XGRP, lane);
            asm volatile("s_waitcnt vmcnt(24)" ::: "memory");
            u_consume(wb + sg * XGRP, xh, xl, a_lo, a_hi, b_lo, b_hi, g, lane, w_lo, w_hi);
            sg = (sg + 1) & 3;
        }
        float wmax = wave_max(fmaxf(fabsf(w_lo), fabsf(w_hi))); if (wmax == 0.f) wmax = 1.f;
        const float scale_w = wmax * (255.0f / 127.0f), inv_sw = 1.0f / scale_w;
        int acc[32]; int bias[2] = {0, 0};
#pragma unroll
        for (int i = 0; i < 32; ++i) acc[i] = 0;
#pragma unroll 1
        for (int g = 0; g < 32; ++g) {
            const int sn = (sg + 3) & 3;
            dma_group(VQ, e_lo, e_hi, (g + 3) & 31, wb + sn * XGRP, lane);
            asm volatile("s_waitcnt vmcnt(24)" ::: "memory");
            v_consume(wb + sg * XGRP, acc, bias, w_lo, w_hi, inv_sw, g, lane);
            sg = (sg + 1) & 3;
        }
        asm volatile("s_waitcnt vmcnt(0)" ::: "memory");
        exp_epilogue(P, row, ln, acc, bias, scale_w);
    }
    LAS int* cmax = (LAS int*)(lds + MISC_OFF + 64);
    __syncthreads();
    for (int ct = blockIdx.x; ct < NTOK_S; ct += gridDim.x) {
        const int row = NTOK_P + ct;
        int ln = lane; asm volatile("" : "+v"(ln));
        const u32x4 xh = *(const u32x4*)(P.ws + WS_X1Q + (size_t)row * D + ln * 32), xl = *(const u32x4*)(P.ws + WS_X1Q + (size_t)row * D + ln * 32 + 16);
        const float sx = SX[row];
        const int kk = 16 * wave + (ln & 15);
        const int e_loc = EIDX[(size_t)row * 128 + kk]; const float g_loc = GW[(size_t)row * 128 + kk];
        const float a_loc = SU[e_loc] * sx, b_loc = g_loc * SV[e_loc];
        float w_loc = 0.f, w_dummy = 0.f;
        asm volatile("s_waitcnt vmcnt(0)" ::: "memory");
#pragma unroll
        for (int g = 0; g < 4; ++g) dma_group(UQ, e_loc, e_loc, g, wb + g * XGRP, lane);
        asm volatile("s_waitcnt vmcnt(0)" ::: "memory");
#pragma unroll
        for (int g = 0; g < 4; ++g) u_consume(wb + g * XGRP, xh, xl, a_loc, a_loc, b_loc, b_loc, g, lane, w_loc, w_dummy);
#pragma unroll
        for (int g = 0; g < 4; ++g) dma_group(VQ, e_loc, e_loc, g, wb + g * XGRP, lane);
        const float wm = wave_max(ln < 16 ? fabsf(w_loc) : 0.f);
        if (lane == 0) cmax[wave] = __float_as_int(wm);
        __syncthreads();
        float wmax = 0.f;
#pragma unroll
        for (int ww = 0; ww < 8; ++ww) wmax = fmaxf(wmax, __int_as_float(cmax[ww]));
        if (wmax == 0.f) wmax = 1.f;
        const float scale_w = wmax * (255.0f / 127.0f), inv_sw = 1.0f / scale_w;
        int acc[32]; int bias[2] = {0, 0};
#pragma unroll
        for (int i = 0; i < 32; ++i) acc[i] = 0;
        asm volatile("s_waitcnt vmcnt(0)" ::: "memory");
#pragma unroll
        for (int g = 0; g < 4; ++g) v_consume(wb + g * XGRP, acc, bias, w_loc, w_loc, inv_sw, g, lane);
        __builtin_amdgcn_wave_barrier();
        {
            LAS int* pp = (LAS int*)wb + lane * 36;
#pragma unroll
            for (int i = 0; i < 8; ++i) *(LAS u32x4*)(pp + 4 * i) = (u32x4){(unsigned)acc[4 * i], (unsigned)acc[4 * i + 1], (unsigned)acc[4 * i + 2], (unsigned)acc[4 * i + 3]};
            pp[32] = bias[0]; pp[33] = bias[1];
        }
        __syncthreads();
        if (wave == 0) {
#pragma unroll
            for (int i = 0; i < 32; ++i) acc[i] = 0;
            bias[0] = 0; bias[1] = 0;
#pragma unroll 1
            for (int ww = 0; ww < 8; ++ww) {
                const LAS int* pp = (const LAS int*)(lds + ww * XWAVE) + lane * 36;
#pragma unroll
                for (int i = 0; i < 8; ++i) { const u32x4 t = *(const LAS u32x4*)(pp + 4 * i); acc[4 * i] += (int)t[0]; acc[4 * i + 1] += (int)t[1]; acc[4 * i + 2] += (int)t[2]; acc[4 * i + 3] += (int)t[3]; }
                bias[0] += pp[32]; bias[1] += pp[33];
            }
            exp_epilogue(P, row, ln, acc, bias, scale_w);
        }
        __syncthreads();
    }
}

constexpr int NPHASE = 11;
__global__ void __launch_bounds__(NTHREADS, 2) fwd(Params P) {
    extern __shared__ __attribute__((aligned(16))) unsigned char lds_raw[];
    LAS unsigned char* lds = (LAS unsigned char*)lds_raw;
    volatile LAS unsigned* misc = (volatile LAS unsigned*)(lds + MISC_OFF);
    const int lo = P.ph_lo, hi = P.ph_hi;
    XcdBarrier bar; bar.bar = (unsigned*)(P.ws + WS_CTL); bar.x = 0; bar.st = nullptr;
    if (hi - lo > 1) {
        if (threadIdx.x == 0) { misc[0] = 0u; misc[1] = 0u; misc[2] = 0u; misc[3] = 0u; }
        __syncthreads();
        bar = xcd_barrier_post((unsigned*)(P.ws + WS_CTL), misc);
    }
#ifndef MK_REPMASK
#define MK_REPMASK 0
#endif
#ifndef MK_PHASE_MASK
#define MK_PHASE_MASK 0x7ff
#endif
#define IN(k) (((MK_PHASE_MASK >> (k)) & 1) && lo <= (k) && (k) < hi)
#define SEAM(k) do { if (IN(k) && IN((k) + 1)) xcd_barrier(bar); } while (0)
    if (IN(0)) { phase_prologue(P, lds); }
    SEAM(0);
    if (IN(1)) {
        pg8::Gemm g{(const pg8::bf16_t*)(P.ws + WS_XB), (const pg8::bf16_t*)(P.ws + WS_WINT), NTOK, DIN, D};
        pg8::StaticOrder S; S.init(NTOK, DIN, (int)gridDim.x, (int)blockIdx.x);
        EpiProj E{P.out, (bf16_t*)(P.ws + WS_XR), (bf16_t*)(P.ws + WS_GATE), (bf16_t*)(P.ws + WS_QB), (bf16_t*)(P.ws + WS_KB), (bf16_t*)(P.ws + WS_VB16)};
        pg8::gemm_phase<EpiProj, pg8::StaticOrder, false>(lds, g, S, E, nullptr);
        { const int nwg = (NTOK / 256) * (DIN / 256), full = nwg % (int)gridDim.x;
          if (full != 0 && (int)blockIdx.x >= full) quant_tables(P, ((int)blockIdx.x - full) * 8 + (int)(threadIdx.x >> 6), ((int)gridDim.x - full) * 8, 0, MK_QHEAD);
          else if (full == 0) quant_tables(P, (int)blockIdx.x * 8 + (int)(threadIdx.x >> 6), (int)gridDim.x * 8, 0, MK_QHEAD); }
    }
    SEAM(1);
    if (IN(2)) { phase_lru(P, lds); }
    if (IN(3)) { phase_samp(P, lds); }
    if (IN(4)) { phase_attn01(P, lds); }
    SEAM(4);
    if (IN(5)) { phase_mix_b(P, lds); }
    SEAM(5);
    if (IN(6)) {
        sample_rows_gemm<0>(P, (const bf16_t*)(P.ws + WS_AR), (const bf16_t*)(P.ws + WS_WOT), lds);
        pg8::Gemm g{(const pg8::bf16_t*)(P.ws + WS_AR), (const pg8::bf16_t*)(P.ws + WS_WOT), NTOK_P, D, D};
        pg8::StaticOrder S; S.init(NTOK_P, D, (int)gridDim.x, (int)blockIdx.x);
        EpiOut E{(const bf16_t*)(P.ws + WS_XB), (bf16_t*)(P.ws + WS_PRE1)};
        pg8::gemm_phase<EpiOut, pg8::StaticOrder, false>(lds, g, S, E, nullptr);
    }
    SEAM(6);
    if (IN(7)) { phase_ln1(P); }
    SEAM(7);
    if (IN(8)) {
        sample_rows_gemm<1>(P, (const bf16_t*)(P.ws + WS_X1B), (const bf16_t*)(P.ws + WS_WQT), lds);
        pg8::Gemm g{(const pg8::bf16_t*)(P.ws + WS_X1B), (const pg8::bf16_t*)(P.ws + WS_WQT), NTOK_P, D, D};
        pg8::StaticOrder S; S.init(NTOK_P, D, (int)gridDim.x, (int)blockIdx.x);
        EpiBf16Plain E{(bf16_t*)(P.ws + WS_QP), D};
        pg8::gemm_phase<EpiBf16Plain, pg8::StaticOrder, false>(lds, g, S, E, nullptr);
    }
    SEAM(8);
    if (IN(9)) { phase_route(P, lds); }
    SEAM(9);
    if (IN(10)) { phase_experts(P, lds); }
#undef IN
#undef SEAM
}
}

extern "C" void kernel_launch(void* const* d_in, const int* in_sizes, int n_in, void* d_out, int out_size, void* d_ws, size_t ws_size, hipStream_t stream) {
    using namespace mk;
    static int grid = 0;
    if (grid == 0) {
        if (n_in != 23 || (size_t)out_size != O_END || ws_size < WS_END) { fprintf(stderr, "kernel_launch: unexpected shapes: n_in %d out %d ws %zu (need %zu)\n", n_in, out_size, ws_size, (size_t)WS_END); grid = -1; return; }
        int dev = 0, cus = 0, per_cu = 0;
        if (hipGetDevice(&dev) != hipSuccess || hipDeviceGetAttribute(&cus, hipDeviceAttributeMultiprocessorCount, dev) != hipSuccess) { grid = -1; return; }
        if (hipFuncSetAttribute((const void*)fwd, hipFuncAttributeMaxDynamicSharedMemorySize, LDS_BYTES) != hipSuccess) { fprintf(stderr, "kernel_launch: hipFuncSetAttribute failed\n"); grid = -1; return; }
        if (hipOccupancyMaxActiveBlocksPerMultiprocessor(&per_cu, (const void*)fwd, NTHREADS, LDS_BYTES) != hipSuccess || per_cu < 1) { fprintf(stderr, "kernel_launch: occupancy query says %d\n", per_cu); }
        (void)hipGetLastError();
        grid = cus;
    }
    if (grid < 0) return;
    (void)hipMemsetAsync((char*)d_ws + WS_CTL, 0, 65536, stream);
    Params p{};
    p.x_prompt = (const float*)d_in[0]; p.x_sample = (const float*)d_in[1]; p.cache_k = (const float*)d_in[2]; p.cache_v = (const float*)d_in[3];
    p.state_conv = (const float*)d_in[4]; p.state_h = (const float*)d_in[5]; p.w_in = (const float*)d_in[6]; p.conv_w = (const float*)d_in[7]; p.conv_b = (const float*)d_in[8];
    p.lru_w_a = (const float*)d_in[9]; p.lru_b_a = (const float*)d_in[10]; p.lru_w_x = (const float*)d_in[11]; p.lru_b_x = (const float*)d_in[12]; p.lru_lambda = (const float*)d_in[13];
    p.w_out = (const float*)d_in[14]; p.ln1_g = (const float*)d_in[15]; p.ln1_b = (const float*)d_in[16]; p.w_query = (const float*)d_in[17]; p.sub_keys = (const float*)d_in[18];
    p.peer_u = (const float*)d_in[19]; p.peer_v = (const float*)d_in[20]; p.ln2_g = (const float*)d_in[21]; p.ln2_b = (const float*)d_in[22];
    p.out = (float*)d_out; p.ws = (unsigned char*)d_ws;
#if MK_N_LAUNCHES == 1
    p.ph_lo = 0; p.ph_hi = NPHASE;
    hipLaunchKernelGGL(fwd, dim3(grid), dim3(NTHREADS), LDS_BYTES, stream, p);
#else
    for (int k = 0; k < NPHASE; ++k) { p.ph_lo = k; p.ph_hi = k + 1; hipLaunchKernelGGL(fwd, dim3(grid), dim3(NTHREADS), LDS_BYTES, stream, p);
#ifdef MK_EXTRA_PHASE
        if (k == MK_EXTRA_PHASE) hipLaunchKernelGGL(fwd, dim3(grid), dim3(NTHREADS), LDS_BYTES, stream, p);
#endif
    }
#endif
    const hipError_t le = hipPeekAtLastError();
    if (le != hipSuccess) fprintf(stderr, "kernel_launch: launch failed: %s\n", hipGetErrorName(le));
}
```

```cpp
#include <hip/hip_runtime.h>
#include <cstdio>
#include <cstdint>
namespace pg8 {
#define PG8_LAS __attribute__((address_space(3)))
typedef unsigned short bf16_t;
typedef short bf16x8 __attribute__((ext_vector_type(8)));
typedef float f32x4 __attribute__((ext_vector_type(4)));
typedef unsigned u32x4 __attribute__((ext_vector_type(4)));
constexpr int BM = 256, BK = 64, HALF = 128, HTB = HALF * BK * 2  , STAGE_BYTES = 8 * HTB, NXCD = 8, WGM = 8;

__host__ __device__ __forceinline__ int lds_byte(int r, int c) { const int st = (r >> 4) * 2 + (c >> 5), rr = r & 15, cc = c & 31, ob = rr * 64 + cc * 2; return st * 1024 + (ob ^ (((ob >> 9) & 1) << 5)); }
__host__ __device__ __forceinline__ void stage_rc(int b, int& R, int& C) { const int st = b / 1024, sb = b % 1024, swz = sb ^ (((sb >> 9) & 1) << 5); R = (st >> 1) * 16 + swz / 64; C = (st & 1) * 32 + (swz % 64) / 2; }
__host__ __device__ __forceinline__ int perm32(int rho) { const int n = rho >> 4, i = rho & 15; return 8 * (i >> 2) + 4 * n + (i & 3); }

struct Unit { int pm, pn; };
struct Gemm { const bf16_t* A; const bf16_t* Bt; int M, N, K; };

struct StaticOrder {
    int nM, nN, nwg, G, c;
    __host__ __device__ void init(int M, int N, int G_, int c_) { nM = M / BM; nN = N / BM; nwg = nM * nN; G = G_; c = c_; }
    __host__ __device__ bool next(int i, Unit& u) const {
        const long L = (long)i * G + c; if (L >= nwg) return false;
        int wgid = (int)L; { const int q = nwg / NXCD, r = nwg % NXCD, xcd = wgid % NXCD, off = wgid / NXCD; wgid = (xcd < r ? xcd * (q + 1) : r * (q + 1) + (xcd - r) * q) + off; }
        const int nig = WGM * nN, gid = wgid / nig, fm = gid * WGM, gsz = (nM - fm) < WGM ? (nM - fm) : WGM;
        u.pm = fm + ((wgid % nig) % gsz); u.pn = (wgid % nig) / gsz; return true;
    }
    __device__ __forceinline__ void a_ready(const Unit&) const {}
    __device__ __forceinline__ void done(const Unit&) const {}
};
struct CountedOrder : StaticOrder {
    const unsigned* ready; unsigned need; unsigned* tmo;
    __device__ __forceinline__ void a_ready(const Unit& u) const {
        if (threadIdx.x < 64) {
            const unsigned long long t0 = __builtin_amdgcn_s_memrealtime(); unsigned polls = 0;
            while ((unsigned)__builtin_amdgcn_readfirstlane(__hip_atomic_load(ready + 64 * u.pm, __ATOMIC_RELAXED, __HIP_MEMORY_SCOPE_AGENT)) < need) {
                if ((++polls & 255u) == 0u && __builtin_amdgcn_readfirstlane(__hip_atomic_load(tmo, __ATOMIC_RELAXED, __HIP_MEMORY_SCOPE_AGENT)) != 0u) break;
                if (__builtin_amdgcn_s_memrealtime() - t0 > 2000000ull) {
                    if (threadIdx.x == 0) { unsigned expect = 0u; __hip_atomic_compare_exchange_strong(tmo + 1, &expect, 0x600u | (unsigned)(u.pm & 0xff), __ATOMIC_RELAXED, __ATOMIC_RELAXED, __HIP_MEMORY_SCOPE_AGENT); __hip_atomic_store(tmo, 1u, __ATOMIC_RELAXED, __HIP_MEMORY_SCOPE_AGENT); }
                    break; }
                __builtin_amdgcn_s_sleep(2); }
            __builtin_amdgcn_fence(__ATOMIC_ACQUIRE, "agent");
            asm volatile("s_waitcnt vmcnt(0)" ::: "memory");
        }
#if !defined(BROKEN_HOOK_NO_BARRIER)
        asm volatile("" ::: "memory"); __builtin_amdgcn_s_barrier(); asm volatile("" ::: "memory");
#endif
    }
};

__device__ __forceinline__ unsigned cvt_pk_bf16(float lo, float hi) { unsigned r; asm volatile("v_cvt_pk_bf16_f32 %0, %1, %2" : "=v"(r) : "v"(lo), "v"(hi)); return r; }
typedef float f32x2 __attribute__((ext_vector_type(2)));
__device__ __forceinline__ f32x2 gelu_pk(f32x2 v) {
    const f32x2 av = __builtin_elementwise_abs(v), d = av * 0.2316418882f + 1.0f;
    f32x2 t; t.x = __builtin_amdgcn_rcpf(d.x); t.y = __builtin_amdgcn_rcpf(d.y);
    f32x2 q = t * 0.5307027145f + (-0.7265760135f); q = q * t + 0.7107068705f; q = q * t + (-0.142248368f); q = q * t + 0.127414796f; q = q * t;
    const f32x2 s = (v * v) * (-0.72134752044f);
    f32x2 e; e.x = __builtin_amdgcn_exp2f(s.x); e.y = __builtin_amdgcn_exp2f(s.y);
    const f32x2 m = v * (q * e), r = v - m;
    f32x2 o; o.x = v.x < 0.f ? m.x : r.x; o.y = v.y < 0.f ? m.y : r.y; return o;
}

struct EpiF32 {
    static constexpr bool PERM = false, AFTER_DRAIN = false;
    float* C; int ldc; const float* bias;
    __device__ __forceinline__ void operator()(const f32x4 (&acc)[2][2][4][2], const Unit& u, int wr, int wc, int fr, int fq) const {
        const int row0 = u.pm * BM + wr * 64 + fr, col0 = u.pn * BM + wc * 32 + 4 * fq;
        f32x4 bv[2][2];
#pragma unroll
        for (int bj = 0; bj < 2; ++bj)
#pragma unroll
            for (int n = 0; n < 2; ++n) bv[bj][n] = bias ? *(const f32x4*)(bias + col0 + bj * HALF + n * 16) : (f32x4){0.f, 0.f, 0.f, 0.f};
#pragma unroll
        for (int ai = 0; ai < 2; ++ai)
#pragma unroll
            for (int m = 0; m < 4; ++m) { float* rowp = C + (size_t)(row0 + ai * HALF + m * 16) * ldc + col0;
#pragma unroll
                for (int bj = 0; bj < 2; ++bj)
#pragma unroll
                    for (int n = 0; n < 2; ++n) *(f32x4*)(rowp + bj * HALF + n * 16) = acc[ai][bj][m][n] + bv[bj][n]; }
    }
};
template <int ACT  > struct EpiBf16 {
    static constexpr bool PERM = true, AFTER_DRAIN = false;
    bf16_t* O; int ldc; const float* bias; int split_cols; size_t split_stride;
    __device__ __forceinline__ void operator()(const f32x4 (&acc)[2][2][4][2], const Unit& u, int wr, int wc, int fr, int fq) const {
        const int row0 = u.pm * BM + wr * 64 + fr; int colt = u.pn * BM; bf16_t* base = O;
        if (split_cols) { const int t = colt / split_cols; base += (size_t)t * split_stride; colt -= t * split_cols; }
        const int col0 = colt + wc * 32 + 8 * fq, bcol0 = u.pn * BM + wc * 32 + 8 * fq;
        f32x4 bv[2][2];
#pragma unroll
        for (int bj = 0; bj < 2; ++bj)
#pragma unroll
            for (int n = 0; n < 2; ++n) bv[bj][n] = bias ? *(const f32x4*)(bias + bcol0 + bj * HALF + 4 * n) : (f32x4){0.f, 0.f, 0.f, 0.f};
#pragma unroll
        for (int ai = 0; ai < 2; ++ai)
#pragma unroll
            for (int m = 0; m < 4; ++m) { bf16_t* rowp = base + (size_t)(row0 + ai * HALF + m * 16) * ldc + col0;
#pragma unroll
                for (int bj = 0; bj < 2; ++bj) { f32x4 v0 = acc[ai][bj][m][0] + bv[bj][0], v1 = acc[ai][bj][m][1] + bv[bj][1];
                    if (ACT == 1) { f32x2 a = gelu_pk((f32x2){v0[0], v0[1]}), b = gelu_pk((f32x2){v0[2], v0[3]}), c = gelu_pk((f32x2){v1[0], v1[1]}), d = gelu_pk((f32x2){v1[2], v1[3]});
                        v0 = (f32x4){a.x, a.y, b.x, b.y}; v1 = (f32x4){c.x, c.y, d.x, d.y}; }
                    if (ACT == 2) {
#pragma unroll
                        for (int j = 0; j < 4; ++j) { v0[j] = 0.5f * v0[j] * (1.0f + erff(v0[j] * 0.70710678f)); v1[j] = 0.5f * v1[j] * (1.0f + erff(v1[j] * 0.70710678f)); } }
                    u32x4 w; w.x = cvt_pk_bf16(v0[0], v0[1]); w.y = cvt_pk_bf16(v0[2], v0[3]); w.z = cvt_pk_bf16(v1[0], v1[1]); w.w = cvt_pk_bf16(v1[2], v1[3]);
                    *(u32x4*)(rowp + bj * HALF) = w; } }
    }
};

struct PanelStats {
    unsigned* xbuf;
    unsigned* cnt;
    unsigned* tmo;
    int ntn; float eps;
    unsigned code;
    __device__ __forceinline__ bool run(const f32x4 (&v)[2][2][4][2], const Unit& u, int wr, int wc, int fr, int fq, PG8_LAS unsigned char* lds, int wid, int lane) const {
        typedef float f32x2v __attribute__((ext_vector_type(2)));
        PG8_LAS f32x2v* P = (PG8_LAS f32x2v*)lds;
        PG8_LAS f32x2v* S = (PG8_LAS f32x2v*)(lds + 8192);
        PG8_LAS unsigned* flag = (PG8_LAS unsigned*)(lds + 8192 + 2048);
#pragma unroll
        for (int ai = 0; ai < 2; ++ai)
#pragma unroll
            for (int m = 0; m < 4; ++m) {
                float s = 0.f;
#pragma unroll
                for (int bj = 0; bj < 2; ++bj)
#pragma unroll
                    for (int n = 0; n < 2; ++n) { const f32x4 x = v[ai][bj][m][n]; s += (x[0] + x[1]) + (x[2] + x[3]); }
                s += __shfl_xor(s, 16); s += __shfl_xor(s, 32);
                const float mw = s * (1.0f / 64.0f); float q = 0.f;
#pragma unroll
                for (int bj = 0; bj < 2; ++bj)
#pragma unroll
                    for (int n = 0; n < 2; ++n) { const f32x4 d = v[ai][bj][m][n] - mw; q += (d[0] * d[0] + d[1] * d[1]) + (d[2] * d[2] + d[3] * d[3]); }
                q += __shfl_xor(q, 16); q += __shfl_xor(q, 32);
                if (fq == 0) P[(ai * HALF + wr * 64 + m * 16 + fr) * 4 + wc] = (f32x2v){mw, q};
            }
        asm volatile("s_waitcnt lgkmcnt(0)" ::: "memory"); __builtin_amdgcn_s_barrier(); asm volatile("" ::: "memory");
#if defined(BROKEN_NO_WAIT)
        if (blockIdx.x >= 64) { const long long t0 = clock64(); while (clock64() - t0 < 60000) __builtin_amdgcn_s_sleep(8); }
#endif
        const int row = wid * 32 + (lane & 31);
        if (lane < 32) {
            const f32x2v a = P[row * 4 + 0], b = P[row * 4 + 1], c = P[row * 4 + 2], d = P[row * 4 + 3];
            const float mt = (a.x + b.x + c.x + d.x) * 0.25f;
            const float da = a.x - mt, db = b.x - mt, dc = c.x - mt, dd = d.x - mt;
            const float m2 = (a.y + b.y) + (c.y + d.y) + 64.0f * ((da * da + db * db) + (dc * dc + dd * dd));
            unsigned long long* slot = (unsigned long long*)xbuf + ((size_t)(u.pm * BM + row) * 4 + u.pn);
            __hip_atomic_store(slot, ((unsigned long long)__float_as_uint(m2) << 32) | __float_as_uint(mt), __ATOMIC_RELAXED, __HIP_MEMORY_SCOPE_AGENT);
        }
        asm volatile("s_waitcnt vmcnt(0)" ::: "memory");
        if (lane == 0) __hip_atomic_fetch_add(cnt + 64 * u.pm, 1u, __ATOMIC_RELAXED, __HIP_MEMORY_SCOPE_AGENT);
        if (wid == 0) {
            bool dead = false; const unsigned long long t0 = __builtin_amdgcn_s_memrealtime(); const unsigned want = 8u * (unsigned)ntn;
            for (;;) {
#if defined(BROKEN_NO_WAIT)
                break;
#endif
                if ((unsigned)__builtin_amdgcn_readfirstlane(__hip_atomic_load(cnt + 64 * u.pm, __ATOMIC_RELAXED, __HIP_MEMORY_SCOPE_AGENT)) >= want) break;
                if (__builtin_amdgcn_s_memrealtime() - t0 > 2000000ull) {
                    if (lane == 0) { unsigned expect = 0u; __hip_atomic_compare_exchange_strong(tmo + 1, &expect, code | (unsigned)(u.pm & 0xff), __ATOMIC_RELAXED, __ATOMIC_RELAXED, __HIP_MEMORY_SCOPE_AGENT);
                                     __hip_atomic_store(tmo, 1u, __ATOMIC_RELAXED, __HIP_MEMORY_SCOPE_AGENT); }
                    dead = true; break; }
                __builtin_amdgcn_s_sleep(2);
            }
            __builtin_amdgcn_fence(__ATOMIC_ACQUIRE, "agent");
            if (lane == 0) flag[0] = dead ? 1u : 0u;
        }
        asm volatile("s_waitcnt vmcnt(0) lgkmcnt(0)" ::: "memory"); __builtin_amdgcn_s_barrier(); asm volatile("" ::: "memory");
        const bool bad = flag[0] != 0u;
        if (lane < 32) {
            const unsigned long long* slot = (const unsigned long long*)xbuf + (size_t)(u.pm * BM + row) * 4; float mt[4], m2[4]; float ms = 0.f;
#pragma unroll
            for (int t = 0; t < 4; ++t) { if (t < ntn) { const unsigned long long w = __hip_atomic_load(slot + t, __ATOMIC_RELAXED, __HIP_MEMORY_SCOPE_AGENT); mt[t] = __uint_as_float((unsigned)w); m2[t] = __uint_as_float((unsigned)(w >> 32)); } else { mt[t] = 0.f; m2[t] = 0.f; } ms += mt[t]; }
            const float mean = ms / (float)ntn; float q = 0.f;
#pragma unroll
            for (int t = 0; t < 4; ++t) if (t < ntn) { const float dm = mt[t] - mean; q += m2[t] + 256.0f * dm * dm; }
            S[row] = (f32x2v){mean, 1.0f / sqrtf(q / (256.0f * (float)ntn) + eps)};
        }
        asm volatile("s_waitcnt lgkmcnt(0)" ::: "memory"); __builtin_amdgcn_s_barrier(); asm volatile("" ::: "memory");
        return bad;
    }
};
struct EpiLnRes {
    static constexpr bool PERM = false, AFTER_DRAIN = true;
    const float* base; float* out; int ldc; const float* bias; PanelStats st; unsigned poison;
    __device__ __forceinline__ void refuse(size_t i0, size_t stride, int M, int N) const { const float q = __builtin_nanf(""); for (size_t i = i0; i < (size_t)M * N; i += stride) out[(i / N) * ldc + i % N] = q;
        if (i0 == 0) { unsigned expect = 0u; __hip_atomic_compare_exchange_strong(st.tmo + 1, &expect, 0x7f0u, __ATOMIC_RELAXED, __ATOMIC_RELAXED, __HIP_MEMORY_SCOPE_AGENT); __hip_atomic_store(st.tmo, 1u, __ATOMIC_RELAXED, __HIP_MEMORY_SCOPE_AGENT); } }
    __device__ __forceinline__ void fused(f32x4 (&acc)[2][2][4][2], const Unit& u, int wr, int wc, int fr, int fq, PG8_LAS unsigned char* lds, int wid, int lane) const {
        typedef float f32x2v __attribute__((ext_vector_type(2)));
        const PG8_LAS f32x2v* S = (const PG8_LAS f32x2v*)(lds + 8192);
        const int col0 = u.pn * BM + wc * 32 + 4 * fq;
#pragma unroll
        for (int bj = 0; bj < 2; ++bj)
#pragma unroll
            for (int n = 0; n < 2; ++n) { const f32x4 bv = bias ? *(const f32x4*)(bias + col0 + bj * HALF + n * 16) : (f32x4){0.f, 0.f, 0.f, 0.f};
#pragma unroll
                for (int ai = 0; ai < 2; ++ai)
#pragma unroll
                    for (int m = 0; m < 4; ++m) acc[ai][bj][m][n] += bv; }
        const bool bad = st.run(acc, u, wr, wc, fr, fq, lds, wid, lane) || poison != 0u;
        const float qnan = __builtin_nanf("");
#pragma unroll
        for (int ai = 0; ai < 2; ++ai)
#pragma unroll
            for (int m = 0; m < 4; ++m) { const int r = ai * HALF + wr * 64 + m * 16 + fr; const f32x2v sr = S[r]; const size_t off = (size_t)(u.pm * BM + r) * ldc + col0;
#pragma unroll
                for (int bj = 0; bj < 2; ++bj)
#pragma unroll
                    for (int n = 0; n < 2; ++n) { const f32x4 bs = *(const f32x4*)(base + off + bj * HALF + n * 16); f32x4 o = bs + (acc[ai][bj][m][n] - sr.x) * sr.y;
                        if (bad) o = (f32x4){qnan, qnan, qnan, qnan}; *(f32x4*)(out + off + bj * HALF + n * 16) = o; }
                asm volatile("" ::: "memory"); }
    }
};
struct EpiLnResLn {
    static constexpr bool PERM = false, AFTER_DRAIN = true;
    const float* base; float* out; bf16_t* xn; int ldc; const float* bias; PanelStats st1, st2; unsigned poison;
    __device__ __forceinline__ void refuse(size_t i0, size_t stride, int M, int N) const { const float q = __builtin_nanf(""); for (size_t i = i0; i < (size_t)M * N; i += stride) { const size_t o = (i / N) * ldc + i % N; out[o] = q; xn[o] = (bf16_t)0x7fc0u; }
        if (i0 == 0) { unsigned expect = 0u; __hip_atomic_compare_exchange_strong(st1.tmo + 1, &expect, 0x7f0u, __ATOMIC_RELAXED, __ATOMIC_RELAXED, __HIP_MEMORY_SCOPE_AGENT); __hip_atomic_store(st1.tmo, 1u, __ATOMIC_RELAXED, __HIP_MEMORY_SCOPE_AGENT); } }
    __device__ __forceinline__ void fused(f32x4 (&acc)[2][2][4][2], const Unit& u, int wr, int wc, int fr, int fq, PG8_LAS unsigned char* lds, int wid, int lane) const {
        typedef float f32x2v __attribute__((ext_vector_type(2))); typedef unsigned u32x2v __attribute__((ext_vector_type(2)));
        const PG8_LAS f32x2v* S = (const PG8_LAS f32x2v*)(lds + 8192);
        const int col0 = u.pn * BM + wc * 32 + 4 * fq;
#pragma unroll
        for (int bj = 0; bj < 2; ++bj)
#pragma unroll
            for (int n = 0; n < 2; ++n) { const f32x4 bv = bias ? *(const f32x4*)(bias + col0 + bj * HALF + n * 16) : (f32x4){0.f, 0.f, 0.f, 0.f};
#pragma unroll
                for (int ai = 0; ai < 2; ++ai)
#pragma unroll
                    for (int m = 0; m < 4; ++m) acc[ai][bj][m][n] += bv; }
        bool bad = st1.run(acc, u, wr, wc, fr, fq, lds, wid, lane) || poison != 0u;
        const float qnan = __builtin_nanf("");
#pragma unroll
        for (int ai = 0; ai < 2; ++ai)
#pragma unroll
            for (int m = 0; m < 4; ++m) { const int r = ai * HALF + wr * 64 + m * 16 + fr; const f32x2v sr = S[r]; const size_t off = (size_t)(u.pm * BM + r) * ldc + col0;
#pragma unroll
                for (int bj = 0; bj < 2; ++bj)
#pragma unroll
                    for (int n = 0; n < 2; ++n) { const f32x4 bs = *(const f32x4*)(base + off + bj * HALF + n * 16); acc[ai][bj][m][n] = bs + (acc[ai][bj][m][n] - sr.x) * sr.y; }
                asm volatile("" : "+v"(acc[ai][0][m][0]), "+v"(acc[ai][0][m][1]), "+v"(acc[ai][1][m][0]), "+v"(acc[ai][1][m][1]));
                if (m & 1) asm volatile("" ::: "memory"); }
        const bool bad1 = bad;
        bad = st2.run(acc, u, wr, wc, fr, fq, lds, wid, lane) || bad;
#pragma unroll
        for (int ai = 0; ai < 2; ++ai)
#pragma unroll
            for (int m = 0; m < 4; ++m) { const int r = ai * HALF + wr * 64 + m * 16 + fr; const f32x2v sr = S[r]; const size_t off = (size_t)(u.pm * BM + r) * ldc + col0;
#pragma unroll
                for (int bj = 0; bj < 2; ++bj)
#pragma unroll
                    for (int n = 0; n < 2; ++n) { const f32x4 x1 = acc[ai][bj][m][n]; *(f32x4*)(out + off + bj * HALF + n * 16) = bad1 ? (f32x4){qnan, qnan, qnan, qnan} : x1;
                        const f32x4 o = (x1 - sr.x) * sr.y; u32x2v w; w.x = cvt_pk_bf16(o[0], o[1]); w.y = cvt_pk_bf16(o[2], o[3]);
                        if (bad) { w.x = 0x7fc07fc0u; w.y = 0x7fc07fc0u; } *(u32x2v*)(xn + off + bj * HALF + n * 16) = w; }
                asm volatile("" ::: "memory"); }
    }
};

template <class Epi, class Sched, bool STAMP = false>
__device__ __forceinline__ void gemm_phase(PG8_LAS unsigned char* lds, const Gemm g, const Sched& S, const Epi& E, unsigned long long* stamps) {
    const int tid = threadIdx.x, wid = __builtin_amdgcn_readfirstlane(tid >> 6), lane = tid & 63, wr = wid >> 2, wc = wid & 3, fr = lane & 15, fq = lane >> 4;
    const int K = g.K, nt = K / BK;
    int ts_lo = 0, ts_hi = 0, nts = 0; const unsigned long long rt_entry = STAMP ? (unsigned long long)wall_clock64() : 0ull;
#define PG8_STAMP() do { if (STAMP && wid == 0 && nts < 64) { const unsigned long long _c = (unsigned long long)clock64(); \
        ts_lo = (lane == nts) ? (int)(unsigned)_c : ts_lo; ts_hi = (lane == nts) ? (int)(unsigned)(_c >> 32) : ts_hi; ++nts; } } while (0)
    PG8_STAMP();
    unsigned voffA[2], voffB[2];
#pragma unroll
    for (int i = 0; i < 2; ++i) { int R, C; stage_rc(tid * 16 + i * 8192, R, C); const int Rb = Epi::PERM ? ((R & ~31) + perm32(R & 31)) : R;
        voffA[i] = (unsigned)(R * K + C) * 2u; voffB[i] = (unsigned)(Rb * K + C) * 2u; }
    const size_t kstep = (size_t)(BK * 2);
    const size_t hstep = (size_t)HALF * K * 2;
    const size_t tstep = 2 * hstep;
    const unsigned ldsw = (unsigned)wid * 1024u;
    const int aoff = lds_byte(wr * 64 + fr, fq * 8), boff = lds_byte(wc * 32 + fr, fq * 8);
#define PG8_SA(b, h) (((b) * 2 + (h)) * HTB)
#define PG8_SB(b, h) ((4 + (b) * 2 + (h)) * HTB)
#define PG8_STAGE(bufoff, gbase, voff) do { _Pragma("unroll") for (int _i = 0; _i < 2; ++_i) \
        __builtin_amdgcn_global_load_lds((const unsigned*)((const char*)(gbase) + (voff)[_i]), (PG8_LAS unsigned*)(lds + (bufoff) + ldsw + _i * 8192), 16, 0, 0); } while (0)
#define PG8_LDA(dst, b, h) do { _Pragma("unroll") for (int m = 0; m < 4; ++m) _Pragma("unroll") for (int k = 0; k < 2; ++k) dst[m][k] = *(const PG8_LAS bf16x8*)(lds + PG8_SA(b, h) + aoff + m * 2048 + k * 1024); } while (0)
#define PG8_LDB(dst, b, h) do { _Pragma("unroll") for (int n = 0; n < 2; ++n) _Pragma("unroll") for (int k = 0; k < 2; ++k) dst[n][k] = *(const PG8_LAS bf16x8*)(lds + PG8_SB(b, h) + boff + n * 2048 + k * 1024); } while (0)
#define PG8_MMA(ai, bj, At, Bt) do { __builtin_amdgcn_s_setprio(1); _Pragma("unroll") for (int m = 0; m < 4; ++m) _Pragma("unroll") for (int n = 0; n < 2; ++n) _Pragma("unroll") for (int k = 0; k < 2; ++k) \
        acc[ai][bj][m][n] = __builtin_amdgcn_mfma_f32_16x16x32_bf16(Bt[n][k], At[m][k], acc[ai][bj][m][n], 0, 0, 0); __builtin_amdgcn_s_setprio(0); } while (0)
#define PG8_WAIT_V(n) asm volatile("s_waitcnt vmcnt(" #n ")" ::: "memory")
#define PG8_WAIT_L(n) asm volatile("s_waitcnt lgkmcnt(" #n ")" ::: "memory")
#define PG8_BAR __builtin_amdgcn_s_barrier()
#define PG8_SCHED __builtin_amdgcn_sched_barrier(0)
    Unit cur, nxt; int ui = 0;
    if (!S.next(0, cur)) return;
    f32x4 acc[2][2][4][2];
#pragma unroll
    for (int a = 0; a < 2; ++a)
#pragma unroll
        for (int b = 0; b < 2; ++b)
#pragma unroll
            for (int m = 0; m < 4; ++m)
#pragma unroll
                for (int n = 0; n < 2; ++n) acc[a][b][m][n] = (f32x4){0.f, 0.f, 0.f, 0.f};
    bf16x8 At[4][2], B0[2][2], B1[2][2];
    const char* cA = (const char*)g.A + (size_t)cur.pm * tstep; const char* cB = (const char*)g.Bt + (size_t)cur.pn * tstep;
    S.a_ready(cur);
    PG8_STAGE(PG8_SB(0, 0), cB, voffB); PG8_STAGE(PG8_SA(0, 0), cA, voffA); PG8_STAGE(PG8_SB(0, 1), cB + hstep, voffB); PG8_STAGE(PG8_SA(0, 1), cA + hstep, voffA);
    if (wr == 1) PG8_BAR;
    PG8_WAIT_V(4); PG8_BAR;
    PG8_STAGE(PG8_SB(1, 0), cB + kstep, voffB); PG8_STAGE(PG8_SA(1, 0), cA + kstep, voffA); PG8_STAGE(PG8_SB(1, 1), cB + hstep + kstep, voffB);
    PG8_WAIT_V(6); PG8_BAR;
    PG8_STAMP();
    for (;;) {
        const bool has_next = S.next(ui + 1, nxt);
        const char* nA = has_next ? (const char*)g.A + (size_t)nxt.pm * tstep : cA; const char* nB = has_next ? (const char*)g.Bt + (size_t)nxt.pn * tstep : cB;
        for (int t = 0; t < nt; t += 2) {
            const bool last = (t == nt - 2);
            const char* a1 = cA + (size_t)(t + 1) * kstep;
            const char* a2 = last ? nA : cA + (size_t)(t + 2) * kstep; const char* b2 = last ? nB : cB + (size_t)(t + 2) * kstep;
            const char* a3 = a2 + kstep; const char* b3 = b2 + kstep;
            if (last && has_next) S.a_ready(nxt);
            PG8_LDB(B0, 0, 0); PG8_SCHED; PG8_LDA(At, 0, 0); PG8_STAGE(PG8_SA(1, 1), a1 + hstep, voffA);
            PG8_WAIT_L(8); PG8_BAR; PG8_WAIT_L(0); PG8_MMA(0, 0, At, B0); PG8_BAR; PG8_SCHED;
            PG8_LDB(B1, 0, 1); PG8_STAGE(PG8_SB(0, 0), b2, voffB);
            PG8_BAR; PG8_WAIT_L(0); PG8_MMA(0, 1, At, B1); PG8_BAR;
            PG8_LDA(At, 0, 1); PG8_STAGE(PG8_SA(0, 0), a2, voffA);
            PG8_BAR; PG8_WAIT_L(0); PG8_MMA(1, 0, At, B0); PG8_BAR; PG8_SCHED;
            PG8_STAGE(PG8_SB(0, 1), b2 + hstep, voffB);
            PG8_WAIT_V(6); PG8_BAR; PG8_MMA(1, 1, At, B1); PG8_BAR;
            PG8_LDB(B0, 1, 0); PG8_SCHED; PG8_LDA(At, 1, 0); PG8_STAGE(PG8_SA(0, 1), a2 + hstep, voffA);
            PG8_WAIT_L(8); PG8_BAR; PG8_WAIT_L(0); PG8_MMA(0, 0, At, B0); PG8_BAR; PG8_SCHED;
            PG8_LDB(B1, 1, 1); PG8_STAGE(PG8_SB(1, 0), b3, voffB);
            PG8_BAR; PG8_WAIT_L(0); PG8_MMA(0, 1, At, B1); PG8_BAR;
            PG8_LDA(At, 1, 1); PG8_STAGE(PG8_SA(1, 0), a3, voffA);
            PG8_BAR; PG8_WAIT_L(0); PG8_MMA(1, 0, At, B0); PG8_BAR; PG8_SCHED;
            PG8_STAGE(PG8_SB(1, 1), b3 + hstep, voffB);
            PG8_WAIT_V(6); PG8_BAR; PG8_MMA(1, 1, At, B1); PG8_BAR;
        }
        PG8_STAMP();
        if constexpr (!Epi::AFTER_DRAIN) { E(acc, cur, wr, wc, fr, fq); S.done(cur); }
        PG8_STAMP();
        if (!has_next) break;
#pragma unroll
        for (int a = 0; a < 2; ++a)
#pragma unroll
            for (int b = 0; b < 2; ++b)
#pragma unroll
                for (int m = 0; m < 4; ++m)
#pragma unroll
                    for (int n = 0; n < 2; ++n) acc[a][b][m][n] = (f32x4){0.f, 0.f, 0.f, 0.f};
        cur = nxt; cA = nA; cB = nB; ++ui;
    }
    PG8_WAIT_V(0);
    if (wr == 0) PG8_BAR;
    PG8_BAR;
    if constexpr (Epi::AFTER_DRAIN) { E.fused(acc, cur, wr, wc, fr, fq, lds, wid, lane); S.done(cur); }
    PG8_STAMP();
    if (STAMP && wid == 0) { stamps[lane] = lane < nts ? (((unsigned long long)(unsigned)ts_hi << 32) | (unsigned)ts_lo) : 0ull;
        if (lane == 62) stamps[62] = rt_entry; if (lane == 63) stamps[63] = (unsigned long long)wall_clock64(); }
#undef PG8_STAMP
#undef PG8_SA
#undef PG8_SB
#undef PG8_STAGE
#undef PG8_LDA
#undef PG8_LDB
#undef PG8_MMA
#undef PG8_WAIT_V
#undef PG8_WAIT_L
#undef PG8_BAR
#undef PG8_SCHED
}
}
#define XB_TMO      128
#define XB_XCNT(j)  (256  + 64 * (j))
#define XB_XSUB(j)  (1280 + 64 * (j))
#define XB_XGEN(j)  (2304 + 64 * (j))
#define XB_TOP      3328
#define XB_TOPGEN   3392
#define XCD_BAR_WORDS 3456
#define XB_SPIN_CAP (1u << 18)
#define LAS __attribute__((address_space(3)))

__device__ __forceinline__ unsigned xb_ld(unsigned* p)              { return __hip_atomic_load(p, __ATOMIC_RELAXED, __HIP_MEMORY_SCOPE_AGENT); }
__device__ __forceinline__ unsigned xb_add(unsigned* p, unsigned v) { return __hip_atomic_fetch_add(p, v, __ATOMIC_RELAXED, __HIP_MEMORY_SCOPE_AGENT); }
__device__ __forceinline__ unsigned xb_xcc_id() { return (unsigned)__builtin_amdgcn_s_getreg((3 << 11) | 20) & 0xFu; }
#define XB_SPIN(cond, bar) do { unsigned _sp = 0; while (cond) { __builtin_amdgcn_s_sleep(1); \
    if ((++_sp & 255u) == 0u) { if (xb_ld(&(bar)[XB_TMO])) break; if (_sp > XB_SPIN_CAP) { atomicAdd(&(bar)[XB_TMO], 1u); break; } } } } while (0)

struct XcdBarrier {
    unsigned* bar; unsigned x;
    volatile LAS unsigned* st;
};

__device__ __forceinline__ XcdBarrier xcd_barrier_post(unsigned* bar, volatile LAS unsigned* st) {
    XcdBarrier b; b.bar = bar; b.x = xb_xcc_id(); b.st = st;
    if (threadIdx.x == 0) (void)xb_add(&bar[XB_XCNT(b.x)], 1u);
    return b;
}
__device__ __forceinline__ void xcd_barrier_complete(unsigned* bar, unsigned x, unsigned& nloc, unsigned& nx) {
    const unsigned G = gridDim.x * gridDim.y * gridDim.z;
    unsigned sum, cnt, mine, sp = 0u;
    for (;;) {
        sum = 0u; cnt = 0u; mine = 0u;
#pragma unroll
        for (unsigned j = 0; j < 16; ++j) { const unsigned c = xb_ld(&bar[XB_XCNT(j)]); sum += c; cnt += (c > 0u) ? 1u : 0u; mine = (j == x) ? c : mine; }
        if (sum == G) break;
        __builtin_amdgcn_s_sleep(1);
        if ((++sp & 255u) == 0u) { if (xb_ld(&bar[XB_TMO])) break; if (sp > XB_SPIN_CAP) { atomicAdd(&bar[XB_TMO], 1u); break; } }
    }
    nloc = mine > 0u ? mine : 1u; nx = cnt > 0u ? cnt : 1u;
}

__device__ __forceinline__ void xcd_barrier(const XcdBarrier& b) {
    asm volatile("s_waitcnt vmcnt(0)" ::: "memory");
    __syncthreads();
    if (threadIdx.x == 0) {
        unsigned* bar = b.bar;
        __builtin_amdgcn_s_waitcnt(0);
        unsigned nloc = b.st[0], nx = b.st[1];
        if (nloc == 0u) { xcd_barrier_complete(bar, b.x, nloc, nx); b.st[0] = nloc; b.st[1] = nx; }
        const unsigned old = xb_add(&bar[XB_XSUB(b.x)], 1u);
        const unsigned gen = old / nloc;
        if (old + 1u == (gen + 1u) * nloc) {
            __builtin_amdgcn_fence(__ATOMIC_RELEASE, "agent");
            asm volatile("s_waitcnt vmcnt(0)" ::: "memory");
            const unsigned og = xb_add(&bar[XB_TOP], 1u);
            const unsigned tg = og / nx;
            if (og + 1u == (tg + 1u) * nx) xb_add(&bar[XB_TOPGEN], 1u);
            else XB_SPIN(xb_ld(&bar[XB_TOPGEN]) == tg, bar);
            __builtin_amdgcn_fence(__ATOMIC_ACQUIRE, "agent");
            xb_add(&bar[XB_XGEN(b.x)], 1u);
            asm volatile("s_waitcnt vmcnt(0)" ::: "memory");
        } else {
            XB_SPIN(xb_ld(&bar[XB_XGEN(b.x)]) == gen, bar);
            __builtin_amdgcn_fence(__ATOMIC_ACQUIRE, "agent");
            asm volatile("s_waitcnt vmcnt(0)" ::: "memory");
        }
    }
    __syncthreads();
}


#ifndef MK_N_LAUNCHES
#define MK_N_LAUNCHES 1
#endif
#ifndef MK_QTAIL
#define MK_QTAIL 7680
#endif
#ifndef MK_QHEAD
#define MK_QHEAD 12288
#endif
namespace mk {
typedef unsigned short bf16_t;
typedef float f32x4 __attribute__((ext_vector_type(4)));
typedef short bf16x8 __attribute__((ext_vector_type(8)));
typedef short s16x4 __attribute__((ext_vector_type(4)));
typedef unsigned u32x4 __attribute__((ext_vector_type(4)));
typedef unsigned u32x2 __attribute__((ext_vector_type(2)));
typedef float f32x2 __attribute__((ext_vector_type(2)));
constexpr int D = 2048, NTOK_P = 16384, NTOK_S = 256, NTOK = 16640;
constexpr int DIN = 5632, DATT = 1536, DLRU = 512, NH = 12, HD = 128;
constexpr int NEXP = 16384;
constexpr float ALPHA = 1.189207115002721f;
constexpr float LN_EPS = 1e-5f;
constexpr float ATT_SCALE = 0.08838834764831845f;
constexpr float LOG2E = 1.4426950408889634f;
constexpr size_t O_YP = 0, O_YS = 33554432, O_KP = 34078720, O_VP = 59244544, O_CP = 84410368, O_HP = 84422656,
                 O_KS = 84426752, O_VS = 185090048, O_CS = 285753344, O_HS = 285802496, O_END = 285818880;
constexpr size_t WS_CTL = 0;
constexpr size_t WS_XB = 65536;
constexpr size_t WS_WINT = WS_XB + (size_t)NTOK * D * 2;
constexpr size_t WS_WOT = WS_WINT + (size_t)DIN * D * 2;
constexpr size_t WS_WQT = WS_WOT + (size_t)D * D * 2;
constexpr size_t WS_UB = WS_WQT + (size_t)D * D * 2;
constexpr size_t WS_VB = WS_UB + (size_t)NEXP * D * 2;
constexpr size_t WS_QF = WS_VB + (size_t)NEXP * D * 2;
constexpr size_t WS_XR = WS_QF + (size_t)NTOK * DATT * 4;
constexpr size_t WS_GATE = WS_XR + (size_t)NTOK * DLRU * 4;
constexpr size_t WS_AR = WS_GATE + (size_t)NTOK * DLRU * 4;
constexpr size_t WS_PRE1 = WS_AR + (size_t)NTOK * D * 2;
constexpr size_t WS_X1F = WS_PRE1 + (size_t)NTOK * D * 4;
constexpr size_t WS_X1B = WS_X1F + (size_t)NTOK * D * 4;
constexpr size_t WS_QP = WS_X1B + (size_t)NTOK * D * 2;
constexpr size_t WS_EIDX = WS_QP + (size_t)NTOK * D * 4;
constexpr size_t WS_GW = WS_EIDX + (size_t)NTOK * 128 * 4;
constexpr size_t WS_SU = WS_GW + (size_t)NTOK * 128 * 4;
constexpr size_t WS_SV = WS_SU + (size_t)NEXP * 4;
constexpr size_t WS_SX = WS_SV + (size_t)NEXP * 4;
constexpr size_t WS_X1Q = WS_SX + (size_t)NTOK * 4;
constexpr size_t WS_SKB = WS_X1Q + (size_t)NTOK * D;
constexpr size_t WS_QB = WS_SKB + (size_t)8 * 2 * 128 * 128 * 2;
constexpr size_t WS_KB = WS_QB + (size_t)NTOK * DATT * 2;
constexpr size_t WS_VB16 = WS_KB + (size_t)NTOK_P * DATT * 2;
constexpr size_t WS_PO = WS_VB16 + (size_t)NTOK_P * DATT * 2;
constexpr size_t WS_PM = WS_PO + (size_t)2 * NTOK_P * DATT * 2;
constexpr size_t WS_PL = WS_PM + (size_t)2 * NTOK_P * NH * 4;
constexpr size_t WS_R0 = WS_PL + (size_t)2 * NTOK_P * NH * 4;
constexpr size_t WS_R1 = WS_R0 + (size_t)NTOK_P * DLRU * 4;
constexpr size_t WS_HE = WS_R1 + (size_t)NTOK_P * DLRU * 4;
constexpr size_t WS_AE = WS_HE + (size_t)8 * 32 * 512 * 4;
constexpr size_t WS_LW = WS_AE + (size_t)8 * 32 * 512 * 4;
constexpr size_t WS_PS = WS_LW + (size_t)2 * 8 * 64 * 64 * 2;
constexpr size_t WS_END = WS_PS + (size_t)32 * 12 * 9 * 8 * 130 * 4;

constexpr int NTHREADS = 512;
constexpr int LDS_BYTES = 148480;
constexpr int MISC_OFF = 147456;

struct Params {
    const float* x_prompt; const float* x_sample; const float* cache_k; const float* cache_v; const float* state_conv; const float* state_h;
    const float* w_in; const float* conv_w; const float* conv_b; const float* lru_w_a; const float* lru_b_a; const float* lru_w_x; const float* lru_b_x;
    const float* lru_lambda; const float* w_out; const float* ln1_g; const float* ln1_b; const float* w_query; const float* sub_keys;
    const float* peer_u; const float* peer_v; const float* ln2_g; const float* ln2_b;
    float* out; unsigned char* ws; int ph_lo, ph_hi;
};

__device__ __forceinline__ unsigned f2bf(float f) { unsigned u = __float_as_uint(f); u += 0x7fffu + ((u >> 16) & 1u); return u >> 16; }
__device__ __forceinline__ unsigned pack2(float a, float b) { return f2bf(a) | (f2bf(b) << 16); }
__device__ __forceinline__ float bflo(unsigned w) { return __uint_as_float(w << 16); }
__device__ __forceinline__ float bfhi(unsigned w) { return __uint_as_float(w & 0xffff0000u); }
__device__ __forceinline__ float4 ntload4(const float* p) { const f32x4 v = __builtin_nontemporal_load((const f32x4*)p); return make_float4(v[0], v[1], v[2], v[3]); }
__device__ __forceinline__ void ntstore4(float* p, float4 v) { __builtin_nontemporal_store((f32x4){v.x, v.y, v.z, v.w}, (f32x4*)p); }
__device__ __forceinline__ float wave_sum(float v) {
#pragma unroll
    for (int o = 32; o >= 1; o >>= 1) v += __shfl_xor(v, o);
    return v;
}
__device__ __forceinline__ float wave_max(float v) {
#pragma unroll
    for (int o = 32; o >= 1; o >>= 1) v = fmaxf(v, __shfl_xor(v, o));
    return v;
}
__device__ __forceinline__ float gelu_exact(float v) { return 0.5f * v * (1.0f + erff(v * 0.7071067811865476f)); }
__device__ __forceinline__ float gelu_as(float v) {
    const float av = fabsf(v), t = __builtin_amdgcn_rcpf(av * 0.2316418882f + 1.0f);
    float q = t * 0.5307027145f + (-0.7265760135f); q = q * t + 0.7107068705f; q = q * t + (-0.142248368f); q = q * t + 0.127414796f; q = q * t;
    const float e = __builtin_amdgcn_exp2f((v * v) * (-0.72134752044f));
    const float m = v * (q * e);
    return v < 0.f ? m : v - m;
}
__device__ __forceinline__ float sigmoidf(float v) { return 1.0f / (1.0f + expf(-v)); }
__device__ __forceinline__ float readlane_f(float v, int l) { return __int_as_float(__builtin_amdgcn_readlane(__float_as_int(v), l)); }

__device__ __forceinline__ void convert_flat(const float* src, bf16_t* dst, size_t n8, size_t gtid, size_t gstride) {
    for (size_t i = gtid; i < n8; i += gstride) {
        const float4 a = ((const float4*)src)[2 * i], b = ((const float4*)src)[2 * i + 1];
        uint4 w; w.x = pack2(a.x, a.y); w.y = pack2(a.z, a.w); w.z = pack2(b.x, b.y); w.w = pack2(b.z, b.w);
        ((uint4*)dst)[i] = w;
    }
}
__device__ __forceinline__ void transpose_convert(const float* src, bf16_t* dst, int K, int N, LAS float* tile) {
    const int tid = threadIdx.x, ntn = N / 64, ntiles = (K / 64) * ntn;
    for (int tl = blockIdx.x; tl < ntiles; tl += gridDim.x) {
        const int kt = tl / ntn, nt = tl - kt * ntn;
#pragma unroll
        for (int i = 0; i < 8; ++i) { const int r = (tid >> 6) + 8 * i, c = tid & 63; tile[r * 65 + c] = src[(size_t)(kt * 64 + r) * N + nt * 64 + c]; }
        __syncthreads();
#pragma unroll
        for (int i = 0; i < 4; ++i) { const int n = (tid >> 5) + 16 * i, k0 = 2 * (tid & 31);
            const unsigned v = pack2(tile[k0 * 65 + n], tile[(k0 + 1) * 65 + n]);
            *(unsigned*)(dst + (size_t)(nt * 64 + n) * K + kt * 64 + k0) = v; }
        __syncthreads();
    }
}
constexpr int TROW = 1152;
__device__ __forceinline__ void quant_row_load(const Params& P, int it, int lane, float4 (&v)[8]) {
    const bool isv = it >= NEXP; const int row = isv ? it - NEXP : it;
    const float* src = (isv ? P.peer_v : P.peer_u) + (size_t)row * D;
#pragma unroll
    for (int j = 0; j < 2; ++j)
#pragma unroll
        for (int i = 0; i < 4; ++i) v[j * 4 + i] = *(const float4*)(src + j * 1024 + lane * 16 + i * 4);
}
__device__ __forceinline__ void quant_row_store(const Params& P, int it, int lane, const float4 (&v)[8]) {
    const bool isv = it >= NEXP; const int row = isv ? it - NEXP : it;
    float cm[2];
#pragma unroll
    for (int j = 0; j < 2; ++j) { float am = 0.f;
#pragma unroll
        for (int i = 0; i < 4; ++i) { const float4 t = v[j * 4 + i]; am = fmaxf(am, fmaxf(fmaxf(fabsf(t.x), fabsf(t.y)), fmaxf(fabsf(t.z), fabsf(t.w)))); }
        cm[j] = am; }
    float rm = wave_max(fmaxf(cm[0], cm[1])); if (rm == 0.f) rm = 1.f;
    unsigned char* dst = P.ws + (isv ? WS_VB : WS_UB) + (size_t)row * TROW;
    u32x4 w; unsigned sqp = 0u;
#pragma unroll
    for (int j = 0; j < 2; ++j) {
        int sq = (int)ceilf(cm[j] / rm * 255.0f); sq = sq < 1 ? 1 : (sq > 255 ? 255 : sq);
        sqp |= (unsigned)sq << (8 * j);
        const float inv = (255.0f * 7.0f) / (rm * (float)sq);
#pragma unroll
        for (int hh = 0; hh < 2; ++hh) { unsigned dw = 0u;
#pragma unroll
            for (int e = 0; e < 8; ++e) { const float4 t = v[j * 4 + hh * 2 + (e >> 2)]; const float x = (e & 3) == 0 ? t.x : ((e & 3) == 1 ? t.y : ((e & 3) == 2 ? t.z : t.w));
                int n = (int)rintf(x * inv); n = n < -7 ? -7 : (n > 7 ? 7 : n); dw |= (unsigned)(isv ? n + 8 : (n & 15)) << (4 * e); }
            w[j * 2 + hh] = dw; }
    }
    *(u32x4*)(dst + lane * 16) = w;
    *(unsigned short*)(dst + 1024 + lane * 2) = (unsigned short)sqp;
    if (lane == 0) ((float*)(P.ws + (isv ? WS_SV : WS_SU)))[row] = rm * (1.0f / (255.0f * 7.0f));
}
__device__ __forceinline__ void quant_tables(const Params& P, int gw, int nw, int lo, int hi) {
    const int lane = threadIdx.x & 63;
    float4 va[8], vb[8];
    int it = lo + gw;
    if (it < hi) quant_row_load(P, it, lane, va);
#pragma unroll 1
    for (; it < hi; it += 2 * nw) {
        if (it + nw < hi) quant_row_load(P, it + nw, lane, vb);
        quant_row_store(P, it, lane, va);
        if (it + nw < hi) {
            if (it + 2 * nw < hi) quant_row_load(P, it + 2 * nw, lane, va);
            quant_row_store(P, it + nw, lane, vb);
        }
    }
}
__device__ __forceinline__ void phase_prologue(const Params& P, LAS unsigned char* lds) {
    const size_t gtid = (size_t)blockIdx.x * NTHREADS + threadIdx.x, gstride = (size_t)gridDim.x * NTHREADS;
    unsigned char* ws = P.ws;
    convert_flat(P.x_prompt, (bf16_t*)(ws + WS_XB), (size_t)NTOK_P * D / 8, gtid, gstride);
    convert_flat(P.x_sample, (bf16_t*)(ws + WS_XB) + (size_t)NTOK_P * D, (size_t)NTOK_S * D / 8, gtid, gstride);
    convert_flat(P.sub_keys, (bf16_t*)(ws + WS_SKB), (size_t)8 * 2 * 128 * 128 / 8, gtid, gstride);
    for (size_t i = gtid; i < (size_t)2 * 8 * 64 * 64; i += gstride) {
        const int c = (int)(i & 63), d = (int)((i >> 6) & 63), n = (int)((i >> 12) & 7), m = (int)(i >> 15);
        ((bf16_t*)(ws + WS_LW))[i] = (bf16_t)f2bf((m ? P.lru_w_x : P.lru_w_a)[(n * 64 + c) * 64 + d]); }
    transpose_convert(P.w_in, (bf16_t*)(ws + WS_WINT), D, DIN, (LAS float*)lds);
    transpose_convert(P.w_out, (bf16_t*)(ws + WS_WOT), D, D, (LAS float*)lds);
    transpose_convert(P.w_query, (bf16_t*)(ws + WS_WQT), D, D, (LAS float*)lds);
}

struct EpiProj {
    static constexpr bool PERM = true, AFTER_DRAIN = false;
    float* out; bf16_t* XR; bf16_t* GATE; bf16_t* QB; bf16_t* KB; bf16_t* VB16;
    __device__ __forceinline__ void operator()(const f32x4 (&acc)[2][2][4][2], const pg8::Unit& u, int wr, int wc, int fr, int fq) const {
        const int pn = u.pn; const int coff = wc * 32 + 8 * fq;
#pragma unroll
        for (int ai = 0; ai < 2; ++ai)
#pragma unroll
            for (int m = 0; m < 4; ++m) {
                const int row = u.pm * 256 + ai * 128 + wr * 64 + m * 16 + fr;
                const bool prompt = row < NTOK_P;
                float* rowp = nullptr; bf16_t* rowb = nullptr; float bsc = 1.0f;
                if (pn < 6) { rowb = QB + (size_t)row * DATT + pn * 256; bsc = ATT_SCALE * LOG2E; }
                else if (pn < 18) {
                    const int isv = pn >= 12; const int c0 = (pn - (isv ? 12 : 6)) * 256;
                    if (prompt) { rowp = out + (isv ? O_VP : O_KP) + (size_t)row * DATT + c0; rowb = (isv ? VB16 : KB) + (size_t)row * DATT + c0; }
                    else { const int rr = row - NTOK_P, b = rr >> 3, t = rr & 7; rowp = out + (isv ? O_VS : O_KS) + ((size_t)b * 2048 + 2040 + t) * DATT + c0; }
                } else if (pn < 20) rowb = XR + (size_t)row * DLRU + (pn - 18) * 256;
                else rowb = GATE + (size_t)row * DLRU + (pn - 20) * 256;
#pragma unroll
                for (int bj = 0; bj < 2; ++bj) {
                    const f32x4 v0 = acc[ai][bj][m][0], v1 = acc[ai][bj][m][1];
                    if (rowp) { *(f32x4*)(rowp + coff + bj * 128) = v0; *(f32x4*)(rowp + coff + bj * 128 + 4) = v1; }
                    if (rowb) { u32x4 w; w.x = pg8::cvt_pk_bf16(v0[0] * bsc, v0[1] * bsc); w.y = pg8::cvt_pk_bf16(v0[2] * bsc, v0[3] * bsc); w.z = pg8::cvt_pk_bf16(v1[0] * bsc, v1[1] * bsc); w.w = pg8::cvt_pk_bf16(v1[2] * bsc, v1[3] * bsc);
                        *(u32x4*)(rowb + coff + bj * 128) = w; }
                }
            }
    }
};
struct EpiOut {
    static constexpr bool PERM = true, AFTER_DRAIN = false;
    const bf16_t* xb; bf16_t* pre;
    __device__ __forceinline__ void operator()(const f32x4 (&acc)[2][2][4][2], const pg8::Unit& u, int wr, int wc, int fr, int fq) const {
        const int col0 = u.pn * 256 + wc * 32 + 8 * fq;
        u32x4 xv[2][4][2];
#pragma unroll
        for (int ai = 0; ai < 2; ++ai)
#pragma unroll
            for (int m = 0; m < 4; ++m) { const int row = u.pm * 256 + ai * 128 + wr * 64 + m * 16 + fr;
#pragma unroll
                for (int bj = 0; bj < 2; ++bj) xv[ai][m][bj] = *(const u32x4*)(xb + (size_t)row * D + col0 + bj * 128); }
#pragma unroll
        for (int ai = 0; ai < 2; ++ai)
#pragma unroll
            for (int m = 0; m < 4; ++m) {
                const int row = u.pm * 256 + ai * 128 + wr * 64 + m * 16 + fr;
                bf16_t* pr = pre + (size_t)row * D + col0;
#pragma unroll
                for (int bj = 0; bj < 2; ++bj) {
                    const u32x4 x = xv[ai][m][bj]; const f32x4 v0 = acc[ai][bj][m][0], v1 = acc[ai][bj][m][1];
                    u32x4 w;
                    w.x = pg8::cvt_pk_bf16(ALPHA * bflo(x.x) + v0[0], ALPHA * bfhi(x.x) + v0[1]); w.y = pg8::cvt_pk_bf16(ALPHA * bflo(x.y) + v0[2], ALPHA * bfhi(x.y) + v0[3]);
                    w.z = pg8::cvt_pk_bf16(ALPHA * bflo(x.z) + v1[0], ALPHA * bfhi(x.z) + v1[1]); w.w = pg8::cvt_pk_bf16(ALPHA * bflo(x.w) + v1[2], ALPHA * bfhi(x.w) + v1[3]);
                    *(u32x4*)(pr + bj * 128) = w;
                }
            }
    }
};
struct EpiPlain {
    static constexpr bool PERM = false, AFTER_DRAIN = false;
    float* C; int ldc;
    __device__ __forceinline__ void operator()(const f32x4 (&acc)[2][2][4][2], const pg8::Unit& u, int wr, int wc, int fr, int fq) const {
        const int col0 = u.pn * 256 + wc * 32 + 4 * fq;
#pragma unroll
        for (int ai = 0; ai < 2; ++ai)
#pragma unroll
            for (int m = 0; m < 4; ++m) {
                const int row = u.pm * 256 + ai * 128 + wr * 64 + m * 16 + fr;
                float* pr = C + (size_t)row * ldc + col0;
#pragma unroll
                for (int bj = 0; bj < 2; ++bj)
#pragma unroll
                    for (int n = 0; n < 2; ++n) *(f32x4*)(pr + bj * 128 + n * 16) = acc[ai][bj][m][n];
            }
    }
};

struct EpiBf16Plain {
    static constexpr bool PERM = true, AFTER_DRAIN = false;
    bf16_t* C; int ldc;
    __device__ __forceinline__ void operator()(const f32x4 (&acc)[2][2][4][2], const pg8::Unit& u, int wr, int wc, int fr, int fq) const {
        const int col0 = u.pn * 256 + wc * 32 + 8 * fq;
#pragma unroll
        for (int ai = 0; ai < 2; ++ai)
#pragma unroll
            for (int m = 0; m < 4; ++m) {
                const int row = u.pm * 256 + ai * 128 + wr * 64 + m * 16 + fr;
                bf16_t* pr = C + (size_t)row * ldc + col0;
#pragma unroll
                for (int bj = 0; bj < 2; ++bj) { const f32x4 v0 = acc[ai][bj][m][0], v1 = acc[ai][bj][m][1]; u32x4 w;
                    w.x = pg8::cvt_pk_bf16(v0[0], v0[1]); w.y = pg8::cvt_pk_bf16(v0[2], v0[3]); w.z = pg8::cvt_pk_bf16(v1[0], v1[1]); w.w = pg8::cvt_pk_bf16(v1[2], v1[3]);
                    *(u32x4*)(pr + bj * 128) = w; }
            }
    }
};

template <int MODE>
__device__ __forceinline__ void sample_rows_gemm(const Params& P, const bf16_t* A, const bf16_t* Wt, LAS unsigned char* lds) {
    const int tid = threadIdx.x, lane = tid & 63, w = __builtin_amdgcn_readfirstlane(tid >> 6);
    const int c = lane & 15, g = lane >> 4;
    for (int tile = blockIdx.x; tile < 256; tile += gridDim.x) {
        const int tg = tile & 7, cg = tile >> 3;
        const int k0 = 256 * w;
        const bf16_t* wp = Wt + (size_t)(64 * cg + c) * D + k0 + 8 * g;
        const bf16_t* xp = A + (size_t)(NTOK_P + 32 * tg + c) * D + k0 + 8 * g;
        f32x4 acc[4][2];
#pragma unroll
        for (int ct = 0; ct < 4; ++ct) { acc[ct][0] = (f32x4){0.f, 0.f, 0.f, 0.f}; acc[ct][1] = (f32x4){0.f, 0.f, 0.f, 0.f}; }
        bf16x8 wf[8][4], xf[8][2];
#pragma unroll
        for (int ks = 0; ks < 8; ++ks) {
#pragma unroll
            for (int tt = 0; tt < 2; ++tt) xf[ks][tt] = *(const bf16x8*)(xp + (size_t)(16 * tt) * D + 32 * ks);
#pragma unroll
            for (int ct = 0; ct < 4; ++ct) wf[ks][ct] = *(const bf16x8*)(wp + (size_t)(16 * ct) * D + 32 * ks);
        }
        __builtin_amdgcn_sched_barrier(0);
#pragma unroll
        for (int ks = 0; ks < 8; ++ks)
#pragma unroll
            for (int ct = 0; ct < 4; ++ct)
#pragma unroll
                for (int tt = 0; tt < 2; ++tt) acc[ct][tt] = __builtin_amdgcn_mfma_f32_16x16x32_bf16(wf[ks][ct], xf[ks][tt], acc[ct][tt], 0, 0, 0);
        LAS float* part = (LAS float*)lds;
#pragma unroll
        for (int ct = 0; ct < 4; ++ct)
#pragma unroll
            for (int tt = 0; tt < 2; ++tt) *(LAS f32x4*)(part + ((w * 32 + 16 * tt + c) * 64 + 16 * ct + 4 * g)) = acc[ct][tt];
        __syncthreads();
        {
            const int tok = tid >> 4, c4 = (tid & 15) * 4;
            f32x4 sum = {0.f, 0.f, 0.f, 0.f};
#pragma unroll
            for (int ww = 0; ww < 8; ++ww) sum += *(const LAS f32x4*)(part + ((ww * 32 + tok) * 64 + c4));
            const int row = NTOK_P + 32 * tg + tok, col = 64 * cg + c4;
            if (MODE == 0) { const f32x4 xv = *(const f32x4*)(P.x_sample + (size_t)(row - NTOK_P) * D + col); const f32x4 r = xv * ALPHA + sum; u32x2 wv; wv.x = pg8::cvt_pk_bf16(r[0], r[1]); wv.y = pg8::cvt_pk_bf16(r[2], r[3]); *(u32x2*)((bf16_t*)(P.ws + WS_PRE1) + (size_t)row * D + col) = wv; }
            else { u32x2 wv; wv.x = pg8::cvt_pk_bf16(sum[0], sum[1]); wv.y = pg8::cvt_pk_bf16(sum[2], sum[3]); *(u32x2*)((bf16_t*)(P.ws + WS_QP) + (size_t)row * D + col) = wv; }
        }
        __syncthreads();
    }
}

constexpr int KVS = 288, VOFF = 73728;
struct AttnKV { u32x4 k[8], v[8]; };
struct AttnId { int p, b, h, r, c; };
__device__ __forceinline__ void attn_fetch(const Params& P, const AttnId& u, AttnKV& R) {
    const int tid = threadIdx.x; const int dil = 1 << (2 * u.p);
    const bf16_t* Kb = (const bf16_t*)(P.ws + WS_KB); const bf16_t* Vb = (const bf16_t*)(P.ws + WS_VB16);
    const size_t tok0 = (size_t)u.b * 2048; const int j0 = 128 * u.c - 128, rho0 = (u.c == 0) ? 128 : 0;
#pragma unroll
    for (int it = 0; it < 8; ++it) {
        const int rho = it * 32 + (tid >> 4), ch = tid & 15;
        if (rho >= rho0) {
            const size_t tok = tok0 + (size_t)((j0 + rho) * dil + u.r);
            R.k[it] = *(const u32x4*)(Kb + tok * DATT + u.h * HD + ch * 8);
            R.v[it] = *(const u32x4*)(Vb + tok * DATT + u.h * HD + ch * 8);
        }
    }
}
__device__ __forceinline__ void attn_commit(const AttnId& u, const AttnKV& R, LAS unsigned char* lds) {
    const int tid = threadIdx.x; const int rho0 = (u.c == 0) ? 128 : 0;
#pragma unroll
    for (int it = 0; it < 8; ++it) {
        const int rho = it * 32 + (tid >> 4), ch = tid & 15;
        if (rho >= rho0) { *(LAS u32x4*)(lds + rho * KVS + ch * 16) = R.k[it]; *(LAS u32x4*)(lds + VOFF + rho * KVS + ch * 16) = R.v[it]; }
    }
}
template <int MODE>
__device__ __forceinline__ void attn_unit(const Params& P, const AttnId& uid, AttnKV& R, bool has_next, const AttnId& nid, LAS unsigned char* lds) {
    const int tid = threadIdx.x, lane = tid & 63, w = __builtin_amdgcn_readfirstlane(tid >> 6);
    const int p = uid.p, b = uid.b, h = uid.h, r = uid.r, c = uid.c;
    const int dil = 1 << (2 * p);
    const bf16_t* Qb = (const bf16_t*)(P.ws + WS_QB);
    const size_t tok0 = (size_t)b * 2048;
    attn_commit(uid, R, lds);
    const int cq = lane & 15, g = lane >> 4;
    const int iq = 128 * c + 16 * w + cq;
    const size_t qtok = tok0 + (size_t)(iq * dil + r);
    bf16x8 qf[4];
#pragma unroll
    for (int ks = 0; ks < 4; ++ks) qf[ks] = *(const bf16x8*)(Qb + qtok * DATT + h * HD + 32 * ks + 8 * g);
    __syncthreads();
#pragma unroll
    for (int ks = 0; ks < 4; ++ks) asm volatile("" : "+v"(qf[ks]));
    if (has_next) attn_fetch(P, nid, R);
    const int ktmin = (8 - w - 8 * c) > 0 ? (8 - w - 8 * c) : 0;
    const float slope2 = exp2f(-8.0f * (float)(h + 1) / 12.0f) * LOG2E * (float)dil;
    f32x4 s[9]; float m = -INFINITY;
#pragma unroll
    for (int kt = 0; kt < 9; ++kt) {
        if (kt >= ktmin) {
            f32x4 acc = {0.f, 0.f, 0.f, 0.f};
#pragma unroll
            for (int ks = 0; ks < 4; ++ks) { const bf16x8 kf = *(const LAS bf16x8*)(lds + (16 * w + 16 * kt + cq) * KVS + (32 * ks + 8 * g) * 2); acc = __builtin_amdgcn_mfma_f32_16x16x32_bf16(kf, qf[ks], acc, 0, 0, 0); }
#pragma unroll
            for (int ii = 0; ii < 4; ++ii) { const int dist = cq + 128 - 16 * kt - 4 * g - ii; float v = acc[ii] - slope2 * (float)dist;
                if (kt == 0 && dist > 128) v = -INFINITY; if (kt == 8 && dist < 0) v = -INFINITY; acc[ii] = v; m = fmaxf(m, v); }
            s[kt] = acc;
        } else s[kt] = (f32x4){-INFINITY, -INFINITY, -INFINITY, -INFINITY};
    }
    m = fmaxf(m, __shfl_xor(m, 16)); m = fmaxf(m, __shfl_xor(m, 32));
    float l = 0.f;
#pragma unroll
    for (int kt = 0; kt < 9; ++kt)
#pragma unroll
        for (int ii = 0; ii < 4; ++ii) { const float pp = exp2f(s[kt][ii] - m); s[kt][ii] = pp; l += pp; }
    l += __shfl_xor(l, 16); l += __shfl_xor(l, 32);
    f32x4 o[8];
#pragma unroll
    for (int dt = 0; dt < 8; ++dt) o[dt] = (f32x4){0.f, 0.f, 0.f, 0.f};
#pragma unroll
    for (int kk = 0; kk < 5; ++kk) {
        const int T0 = 2 * kk, T1 = 2 * kk + 1;
        if (T1 >= ktmin || T0 == 8) {
            u32x4 pw; pw.x = pg8::cvt_pk_bf16(s[T0][0], s[T0][1]); pw.y = pg8::cvt_pk_bf16(s[T0][2], s[T0][3]);
            if (T1 <= 8) { pw.z = pg8::cvt_pk_bf16(s[T1 <= 8 ? T1 : 8][0], s[T1 <= 8 ? T1 : 8][1]); pw.w = pg8::cvt_pk_bf16(s[T1 <= 8 ? T1 : 8][2], s[T1 <= 8 ? T1 : 8][3]); } else { pw.z = 0u; pw.w = 0u; }
            const bf16x8 pf = __builtin_bit_cast(bf16x8, pw);
            const int rT0 = (T0 >= ktmin) ? T0 : 8, rT1 = (T1 <= 8 && T1 >= ktmin) ? T1 : 8;
            const int a0 = VOFF + (16 * w + 16 * rT0 + 4 * g + (cq >> 2)) * KVS + 8 * (cq & 3);
            const int a1 = VOFF + (16 * w + 16 * rT1 + 4 * g + (cq >> 2)) * KVS + 8 * (cq & 3);
#pragma unroll
            for (int dt = 0; dt < 8; ++dt) {
                const s16x4 v0 = __builtin_amdgcn_ds_read_tr16_b64_v4i16((LAS s16x4*)(lds + a0 + dt * 32));
                const s16x4 v1 = __builtin_amdgcn_ds_read_tr16_b64_v4i16((LAS s16x4*)(lds + a1 + dt * 32));
                const bf16x8 vf = {v0[0], v0[1], v0[2], v0[3], v1[0], v1[1], v1[2], v1[3]};
                o[dt] = __builtin_amdgcn_mfma_f32_16x16x32_bf16(vf, pf, o[dt], 0, 0, 0);
            }
        }
    }
    const float inv = 1.0f / l;
    if (MODE == 0) {
        bf16_t* po = (bf16_t*)(P.ws + WS_PO) + ((size_t)p * NTOK_P + qtok) * DATT + h * HD + 4 * g;
#pragma unroll
        for (int dt = 0; dt < 8; ++dt) { u32x2 wv; wv.x = pg8::cvt_pk_bf16(o[dt][0] * inv, o[dt][1] * inv); wv.y = pg8::cvt_pk_bf16(o[dt][2] * inv, o[dt][3] * inv); *(u32x2*)(po + 16 * dt) = wv; }
        if (g == 0) { ((float*)(P.ws + WS_PM))[((size_t)p * NTOK_P + qtok) * NH + h] = m; ((float*)(P.ws + WS_PL))[((size_t)p * NTOK_P + qtok) * NH + h] = l; }
    } else {
        const float* PM = (const float*)(P.ws + WS_PM); const float* PL = (const float*)(P.ws + WS_PL);
        const float m0 = PM[qtok * NH + h], l0 = PL[qtok * NH + h], m1 = PM[((size_t)NTOK_P + qtok) * NH + h], l1 = PL[((size_t)NTOK_P + qtok) * NH + h];
        const float M = fmaxf(m, fmaxf(m0, m1));
        const float w2 = exp2f(m - M), w0 = exp2f(m0 - M) * l0, w1 = exp2f(m1 - M) * l1;
        const float rden = 1.0f / (w2 * l + w0 + w1);
        const bf16_t* p0 = (const bf16_t*)(P.ws + WS_PO) + qtok * DATT + h * HD + 4 * g;
        const bf16_t* p1 = p0 + (size_t)NTOK_P * DATT;
        bf16_t* ar = (bf16_t*)(P.ws + WS_AR) + qtok * D + h * HD + 4 * g;
        u32x2 q0[8], q1[8];
#pragma unroll
        for (int dt = 0; dt < 8; ++dt) { q0[dt] = *(const u32x2*)(p0 + 16 * dt); q1[dt] = *(const u32x2*)(p1 + 16 * dt); }
#pragma unroll
        for (int dt = 0; dt < 8; ++dt) {
            const u32x2 x0 = q0[dt], x1 = q1[dt];
            const float r0 = (w2 * o[dt][0] + w0 * bflo(x0.x) + w1 * bflo(x1.x)) * rden, r1 = (w2 * o[dt][1] + w0 * bfhi(x0.x) + w1 * bfhi(x1.x)) * rden;
            const float r2 = (w2 * o[dt][2] + w0 * bflo(x0.y) + w1 * bflo(x1.y)) * rden, r3 = (w2 * o[dt][3] + w0 * bfhi(x0.y) + w1 * bfhi(x1.y)) * rden;
            u32x2 wv; wv.x = pg8::cvt_pk_bf16(r0, r1); wv.y = pg8::cvt_pk_bf16(r2, r3); *(u32x2*)(ar + 16 * dt) = wv;
        }
    }
    __syncthreads();
}

struct SampPre { f32x4 k[4], v[4]; };
__device__ __forceinline__ void samp_prefetch(const Params& P, int b, int h, int k, SampPre& R) {
    const int tid = threadIdx.x;
    const size_t so = ((size_t)(b * 2048 + 256 * k + (tid >> 5))) * DATT + h * HD + (tid & 31) * 4;
#pragma unroll
    for (int it = 0; it < 4; ++it) { R.k[it] = *(const f32x4*)(P.cache_k + so + (size_t)it * 16 * DATT); R.v[it] = *(const f32x4*)(P.cache_v + so + (size_t)it * 16 * DATT); }
}
__device__ __forceinline__ void samp_load4(const float* ck, const float* cv, int s0, f32x4 (&kk)[4], f32x4 (&vv)[4]) {
#pragma unroll
    for (int j = 0; j < 4; ++j) { kk[j] = *(const f32x4*)(ck + (size_t)(s0 + j) * 16 * DATT); vv[j] = *(const f32x4*)(cv + (size_t)(s0 + j) * 16 * DATT); }
}
__device__ __forceinline__ void samp_put4(float* ok, float* ov, float* ok0, float* ov0, LAS unsigned char* lk, int s0, const f32x4 (&kk)[4], const f32x4 (&vv)[4]) {
#pragma unroll
    for (int j = 0; j < 4; ++j) {
        const int it = s0 + j; const f32x4 kf = kk[j], vf = vv[j];
        if (it == 0) { *(f32x4*)ok0 = kf; *(f32x4*)ov0 = vf; } else { *(f32x4*)(ok + (size_t)it * 16 * DATT) = kf; *(f32x4*)(ov + (size_t)it * 16 * DATT) = vf; }
        u32x2 kw, vw; kw.x = pg8::cvt_pk_bf16(kf[0], kf[1]); kw.y = pg8::cvt_pk_bf16(kf[2], kf[3]); vw.x = pg8::cvt_pk_bf16(vf[0], vf[1]); vw.y = pg8::cvt_pk_bf16(vf[2], vf[3]);
        *(LAS u32x2*)(lk + it * 16 * KVS) = kw; *(LAS u32x2*)(lk + VOFF + it * 16 * KVS) = vw;
    }
}
template <bool LAST>
__device__ __forceinline__ void samp_unit(const Params& P, int b, int h, int k, LAS unsigned char* lds, SampPre& R, int nb, int nh, int nk) {
    const int tid = threadIdx.x, lane = tid & 63, w = __builtin_amdgcn_readfirstlane(tid >> 6);
    const int cq = lane & 15, g = lane >> 4;
    const int t = cq & 7;
    bf16x8 qf[4];
    { const bf16_t* Qb = (const bf16_t*)(P.ws + WS_QB) + ((size_t)(NTOK_P + b * 8 + t)) * DATT + h * HD + 8 * g;
#pragma unroll
      for (int ks = 0; ks < 4; ++ks) qf[ks] = *(const bf16x8*)(Qb + 32 * ks); }
    if (!LAST) {
        const int r5 = tid >> 5, ch4 = tid & 31;
        const size_t so = ((size_t)(b * 2048 + 256 * k + r5)) * DATT + h * HD + ch4 * 4;
        const float* ck = P.cache_k + so; const float* cv = P.cache_v + so;
        float* ok = P.out + O_KS + so - (size_t)8 * DATT; float* ov = P.out + O_VS + so - (size_t)8 * DATT;
        const bool first_ok = (256 * k + r5) >= 8;
        float* junk = (float*)(P.ws + WS_QF) + lane * 4;
        float* ok0 = first_ok ? ok : junk; float* ov0 = first_ok ? ov : junk + 256;
        LAS unsigned char* lk = lds + r5 * KVS + ch4 * 8;
        f32x4 ka[4], va[4], kb[4], vb[4];
        samp_load4(ck, cv, 4, ka, va);
        __builtin_amdgcn_sched_barrier(0);
        samp_put4(ok, ov, ok0, ov0, lk, 0, R.k, R.v);
        samp_load4(ck, cv, 8, kb, vb);
        __builtin_amdgcn_sched_barrier(0);
        samp_put4(ok, ov, ok0, ov0, lk, 4, ka, va);
#pragma unroll
        for (int ks = 0; ks < 4; ++ks) asm volatile("" : "+v"(qf[ks]));
        samp_load4(ck, cv, 12, ka, va);
        samp_prefetch(P, nb, nh, nk, R);
        __builtin_amdgcn_sched_barrier(0);
        samp_put4(ok, ov, ok0, ov0, lk, 8, kb, vb);
        samp_put4(ok, ov, ok0, ov0, lk, 12, ka, va);
    } else {
        const int rho = tid >> 5, ch4 = tid & 31;
        u32x2 kw = {0u, 0u}, vw = {0u, 0u};
        if (rho < 8) { const size_t so = ((size_t)(b * 2048 + 2040 + rho)) * DATT + h * HD + ch4 * 4; const float4 kf = *(const float4*)(P.out + O_KS + so), vf = *(const float4*)(P.out + O_VS + so);
            kw.x = pg8::cvt_pk_bf16(kf.x, kf.y); kw.y = pg8::cvt_pk_bf16(kf.z, kf.w); vw.x = pg8::cvt_pk_bf16(vf.x, vf.y); vw.y = pg8::cvt_pk_bf16(vf.z, vf.w); }
        *(LAS u32x2*)(lds + rho * KVS + ch4 * 8) = kw; *(LAS u32x2*)(lds + VOFF + rho * KVS + ch4 * 8) = vw;
        *(LAS u32x2*)(lds + (16 + rho) * KVS + ch4 * 8) = (u32x2){0u, 0u}; *(LAS u32x2*)(lds + VOFF + (16 + rho) * KVS + ch4 * 8) = (u32x2){0u, 0u};
#pragma unroll
        for (int ks = 0; ks < 4; ++ks) asm volatile("" : "+v"(qf[ks]));
    }
    __syncthreads();
    const float slope2 = exp2f(-8.0f * (float)(h + 1) / 12.0f) * LOG2E;
    const bool active = (k < 8) || (w == 0);
    f32x4 s[2]; float m = -INFINITY;
#pragma unroll
    for (int j = 0; j < 2; ++j) {
        f32x4 acc = {0.f, 0.f, 0.f, 0.f};
        if (active) {
#pragma unroll
            for (int ks = 0; ks < 4; ++ks) { const bf16x8 kf = *(const LAS bf16x8*)(lds + (32 * w + 16 * j + cq) * KVS + (32 * ks + 8 * g) * 2); acc = __builtin_amdgcn_mfma_f32_16x16x32_bf16(kf, qf[ks], acc, 0, 0, 0); }
        }
#pragma unroll
        for (int ii = 0; ii < 4; ++ii) {
            const int c = 256 * k + 32 * w + 16 * j + 4 * g + ii, dist = 2048 + t - c;
            int mult = (dist <= 128 ? 1 : 0) + (((dist & 3) == 0 && dist <= 512) ? 1 : 0) + (((dist & 15) == 0 && dist <= 2048) ? 1 : 0);
            if (dist < 0 || !active || c > 2055) mult = 0;
            const float v = mult ? acc[ii] - slope2 * (float)dist : -INFINITY;
            acc[ii] = v; m = fmaxf(m, v);
            s[j][ii] = (float)mult;
            s[j][ii] = v;
        }
    }
    m = fmaxf(m, __shfl_xor(m, 16)); m = fmaxf(m, __shfl_xor(m, 32));
    const float mref = (m == -INFINITY) ? 0.f : m;
    float l = 0.f;
#pragma unroll
    for (int j = 0; j < 2; ++j)
#pragma unroll
        for (int ii = 0; ii < 4; ++ii) {
            const int c = 256 * k + 32 * w + 16 * j + 4 * g + ii, dist = 2048 + t - c;
            const int mult = (dist <= 128 ? 1 : 0) + (((dist & 3) == 0 && dist <= 512) ? 1 : 0) + (((dist & 15) == 0 && dist <= 2048) ? 1 : 0);
            const float pp = (float)mult * exp2f(s[j][ii] - mref); s[j][ii] = pp; l += pp; }
    l += __shfl_xor(l, 16); l += __shfl_xor(l, 32);
    f32x4 o[8];
    {
        u32x4 pw; pw.x = pg8::cvt_pk_bf16(s[0][0], s[0][1]); pw.y = pg8::cvt_pk_bf16(s[0][2], s[0][3]); pw.z = pg8::cvt_pk_bf16(s[1][0], s[1][1]); pw.w = pg8::cvt_pk_bf16(s[1][2], s[1][3]);
        const bf16x8 pf = __builtin_bit_cast(bf16x8, pw);
        const int rw = active ? w : 0;
        const int a0 = VOFF + (32 * rw + 4 * g + (cq >> 2)) * KVS + 8 * (cq & 3), a1 = a0 + 16 * KVS;
#pragma unroll
        for (int dt = 0; dt < 8; ++dt) {
            const s16x4 v0 = __builtin_amdgcn_ds_read_tr16_b64_v4i16((LAS s16x4*)(lds + a0 + dt * 32));
            const s16x4 v1 = __builtin_amdgcn_ds_read_tr16_b64_v4i16((LAS s16x4*)(lds + a1 + dt * 32));
            const bf16x8 vf = {v0[0], v0[1], v0[2], v0[3], v1[0], v1[1], v1[2], v1[3]};
            o[dt] = __builtin_amdgcn_mfma_f32_16x16x32_bf16(vf, pf, (f32x4){0.f, 0.f, 0.f, 0.f}, 0, 0, 0);
        }
    }
    __syncthreads();
    LAS float* OL = (LAS float*)lds;
    LAS float* ML = (LAS float*)(lds + 32768);
    if (cq < 8) {
#pragma unroll
        for (int dt = 0; dt < 8; ++dt) *(LAS f32x4*)(OL + (w * 8 + cq) * 128 + 16 * dt + 4 * g) = o[dt];
        if (g == 0) { ML[(w * 8 + cq) * 2 + 0] = m; ML[(w * 8 + cq) * 2 + 1] = l; }
    }
    __syncthreads();
    {
        const int q = w; float M = -INFINITY;
#pragma unroll
        for (int ww = 0; ww < 8; ++ww) M = fmaxf(M, ML[(ww * 8 + q) * 2]);
        const float Mr = (M == -INFINITY) ? 0.f : M;
        float L = 0.f, o0 = 0.f, o1 = 0.f;
#pragma unroll
        for (int ww = 0; ww < 8; ++ww) { const float f = exp2f(ML[(ww * 8 + q) * 2] - Mr); L += f * ML[(ww * 8 + q) * 2 + 1];
            o0 += f * OL[(ww * 8 + q) * 128 + 2 * lane]; o1 += f * OL[(ww * 8 + q) * 128 + 2 * lane + 1]; }
        float* ps = (float*)(P.ws + WS_PS) + ((((size_t)(b * NH + h)) * 9 + k) * 8 + q) * 130;
        if (lane == 0) { ps[0] = M; ps[1] = L; }
        *(float2*)(ps + 2 + 2 * lane) = make_float2(o0, o1);
    }
    __syncthreads();
}
__device__ __forceinline__ void samp_merge_unit(const Params& P, int b, int t, int h, int lane) {
    const float* ps = (const float*)(P.ws + WS_PS) + ((size_t)(b * NH + h)) * 9 * 8 * 130 + (size_t)t * 130;
    float M = -INFINITY;
#pragma unroll
    for (int k = 0; k < 9; ++k) M = fmaxf(M, ps[(size_t)k * 8 * 130]);
    float L = 0.f, o0 = 0.f, o1 = 0.f;
#pragma unroll
    for (int k = 0; k < 9; ++k) { const float* pk = ps + (size_t)k * 8 * 130; const float f = exp2f(pk[0] - M); L += f * pk[1]; const float2 ov = *(const float2*)(pk + 2 + 2 * lane); o0 += f * ov.x; o1 += f * ov.y; }
    const float inv = 1.0f / L;
    bf16_t* ar = (bf16_t*)(P.ws + WS_AR) + ((size_t)(NTOK_P + b * 8 + t)) * D + h * HD;
    *(unsigned*)(ar + 2 * lane) = pack2(o0 * inv, o1 * inv);
}

constexpr int LRU_XS = 144, LRU_GS = 68, LRU_WAVE = 16 * LRU_XS + 2 * 16 * LRU_GS * 4;
__device__ __forceinline__ void lru_unit(const Params& P, bool samp, int b, int n, int k, int lane, LAS unsigned char* wl) {
    const int T = samp ? 8 : 64; const int row0 = samp ? NTOK_P + b * 8 : b * 2048 + k * 64; const int ch = n * 64 + lane;
    const int cq = lane & 15, g = lane >> 4;
    bf16x8 wf[2][4][2];
    { const bf16_t* lw = (const bf16_t*)(P.ws + WS_LW);
#pragma unroll
      for (int m = 0; m < 2; ++m)
#pragma unroll
        for (int ct = 0; ct < 4; ++ct)
#pragma unroll
            for (int ks = 0; ks < 2; ++ks) wf[m][ct][ks] = *(const bf16x8*)(lw + ((size_t)((m * 8 + n) * 64 + 16 * ct + cq)) * 64 + 32 * ks + 8 * g); }
    const float ba = P.lru_b_a[ch], bx = P.lru_b_x[ch], lam = P.lru_lambda[ch];
    const float sp8 = -8.0f * LOG2E * log1pf(expf(-lam));
    const float cw0 = P.conv_w[ch], cw1 = P.conv_w[512 + ch], cw2 = P.conv_w[1024 + ch], cw3 = P.conv_w[1536 + ch], cb = P.conv_b[ch];
    const bf16_t* XR = (const bf16_t*)(P.ws + WS_XR); const bf16_t* GT = (const bf16_t*)(P.ws + WS_GATE);
    float* R0 = (float*)(P.ws + WS_R0); float* R1 = (float*)(P.ws + WS_R1); bf16_t* AR = (bf16_t*)(P.ws + WS_AR);
    LAS unsigned char* xcb = wl; LAS float* G = (LAS float*)(wl + 16 * LRU_XS);
    float x0 = 0.f, x1 = 0.f, x2 = 0.f, h = 0.f, A = 1.f;
    if (samp) { x0 = P.state_conv[(b * 3 + 0) * 512 + ch]; x1 = P.state_conv[(b * 3 + 1) * 512 + ch]; x2 = P.state_conv[(b * 3 + 2) * 512 + ch]; h = P.state_h[b * 512 + ch]; }
    else if (k > 0) { x0 = bflo(XR[(size_t)(row0 - 3) * DLRU + ch]); x1 = bflo(XR[(size_t)(row0 - 2) * DLRU + ch]); x2 = bflo(XR[(size_t)(row0 - 1) * DLRU + ch]); }
    unsigned xrn[16], gtn[16];
    { const int ns0 = T < 16 ? T : 16;
#pragma unroll
      for (int i = 0; i < 16; ++i) { const int r = row0 + (i < ns0 ? i : ns0 - 1); xrn[i] = XR[(size_t)r * DLRU + ch]; gtn[i] = GT[(size_t)r * DLRU + ch]; } }
    __builtin_amdgcn_sched_barrier(0);
#pragma unroll
    for (int i = 0; i < 16; ++i) { asm volatile("" : "+v"(xrn[i])); asm volatile("" : "+v"(gtn[i])); }
#pragma unroll 1
    for (int t0 = 0; t0 < T; t0 += 16) {
        const int ns = (T - t0) < 16 ? (T - t0) : 16;
        float xc[16], gt[16];
#pragma unroll
        for (int i = 0; i < 16; ++i) { xc[i] = bflo(xrn[i]); gt[i] = bflo(gtn[i]); }
        if (t0 + 16 < T) { const int nn = (T - t0 - 16) < 16 ? (T - t0 - 16) : 16;
#pragma unroll
            for (int i = 0; i < 16; ++i) { const int r = row0 + t0 + 16 + (i < nn ? i : nn - 1); xrn[i] = XR[(size_t)r * DLRU + ch]; gtn[i] = GT[(size_t)r * DLRU + ch]; } }
        __builtin_amdgcn_sched_barrier(0);
#pragma unroll
        for (int i = 0; i < 16; ++i) {
            const float xin = xc[i]; const float v = ((x0 * cw0 + x1 * cw1) + x2 * cw2) + xin * cw3 + cb;
            if (i < ns) { x0 = x1; x1 = x2; x2 = xin; }
            xc[i] = v;
            *(LAS bf16_t*)(xcb + i * LRU_XS + lane * 2) = (bf16_t)f2bf(v);
        }
        __builtin_amdgcn_wave_barrier();
        const bf16x8 a0 = *(const LAS bf16x8*)(xcb + cq * LRU_XS + (8 * g) * 2), a1 = *(const LAS bf16x8*)(xcb + cq * LRU_XS + (32 + 8 * g) * 2);
#pragma unroll
        for (int m = 0; m < 2; ++m)
#pragma unroll
            for (int ct = 0; ct < 4; ++ct) {
                f32x4 acc = __builtin_amdgcn_mfma_f32_16x16x32_bf16(a0, wf[m][ct][0], (f32x4){0.f, 0.f, 0.f, 0.f}, 0, 0, 0);
                acc = __builtin_amdgcn_mfma_f32_16x16x32_bf16(a1, wf[m][ct][1], acc, 0, 0, 0);
#pragma unroll
                for (int ii = 0; ii < 4; ++ii) G[(m * 16 + 4 * g + ii) * LRU_GS + 16 * ct + cq] = acc[ii];
            }
        __builtin_amdgcn_wave_barrier();
#pragma unroll
        for (int i = 0; i < 16; ++i) {
            if (i < ns) {
                const float ra = G[i * LRU_GS + lane] + ba, ri = G[(16 + i) * LRU_GS + lane] + bx;
                const float r = __builtin_amdgcn_rcpf(1.0f + __builtin_amdgcn_exp2f(-LOG2E * ra)), ig = __builtin_amdgcn_rcpf(1.0f + __builtin_amdgcn_exp2f(-LOG2E * ri));
                const float a = __builtin_amdgcn_exp2f(sp8 * r);
                const float u = __builtin_amdgcn_sqrtf(fmaxf(1.0f - a * a, 0.f)) * (ig * xc[i]);
                h = a * h + u; A = a * A;
                const float ge = gelu_as(gt[i]);
                if (samp) AR[(size_t)(row0 + t0 + i) * D + DATT + ch] = (bf16_t)f2bf(h * ge);
                else { R0[(size_t)(row0 + t0 + i) * DLRU + ch] = h * ge; R1[(size_t)(row0 + t0 + i) * DLRU + ch] = A * ge; }
            }
        }
        __builtin_amdgcn_wave_barrier();
    }
    if (samp) { P.out[O_HS + (size_t)b * 512 + ch] = h; float* co = P.out + O_CS + (size_t)b * 3 * 512 + ch; co[0] = x0; co[512] = x1; co[1024] = x2; }
    else {
        ((float*)(P.ws + WS_HE))[((size_t)(b * 32 + k)) * 512 + ch] = h; ((float*)(P.ws + WS_AE))[((size_t)(b * 32 + k)) * 512 + ch] = A;
        if (k == 31) { float* co = P.out + O_CP + (size_t)b * 3 * 512 + ch; co[0] = x0; co[512] = x1; co[1024] = x2; }
    }
}

__device__ __forceinline__ void phase_lru(const Params& P, LAS unsigned char* lds) {
    const int lane = threadIdx.x & 63, wave = __builtin_amdgcn_readfirstlane(threadIdx.x >> 6);
    const int gw = blockIdx.x * 8 + wave, nw = gridDim.x * 8;
#pragma unroll 1
    for (int pass = 0; pass < 2; ++pass) {
        if ((pass ^ (wave & 1)) == 0) {
            for (int u = gw; u < 2048 + 256; u += nw) { const bool samp = u >= 2048; const int v = samp ? u - 2048 : u; lru_unit(P, samp, samp ? (v >> 3) : (v >> 8), samp ? (v & 7) : ((v >> 5) & 7), v & 31, lane, lds + wave * LRU_WAVE); }
        } else quant_tables(P, gw, nw, MK_QHEAD, 2 * NEXP - MK_QTAIL);
    }
    __syncthreads();
}
__device__ __forceinline__ void phase_samp(const Params& P, LAS unsigned char* lds) {
    SampPre R;
    int u = blockIdx.x;
    if (u < 384 * 8) { const int bh = u >> 3; samp_prefetch(P, bh / NH, bh % NH, u & 7, R); }
    for (; u < 384 * 8; u += gridDim.x) {
        const int bh = u >> 3; const int un = (u + (int)gridDim.x < 384 * 8) ? u + (int)gridDim.x : u; const int nbh = un >> 3;
        samp_unit<false>(P, bh / NH, bh % NH, u & 7, lds, R, nbh / NH, nbh % NH, un & 7);
    }
    for (u = blockIdx.x; u < 384; u += gridDim.x) samp_unit<true>(P, u / NH, u % NH, 8, lds, R, 0, 0, 0);
}
__device__ __forceinline__ AttnId attn01_id(int u) {
    const int p = u / 1536, rem = u - p * 1536, bh = rem >> 4, rc = rem & 15; const int b = bh / NH, h = bh - b * NH;
    return AttnId{p, b, h, p == 0 ? 0 : (rc >> 2), p == 0 ? rc : (rc & 3)};
}
__device__ __forceinline__ void phase_attn01(const Params& P, LAS unsigned char* lds) {
    AttnKV R; int u = blockIdx.x;
    if (u < 3072) attn_fetch(P, attn01_id(u), R);
    for (; u < 3072; u += gridDim.x) {
        const int un = u + (int)gridDim.x; const bool hn = un < 3072;
        attn_unit<0>(P, attn01_id(u), R, hn, attn01_id(hn ? un : u), lds);
    }
}
__device__ __forceinline__ void phase_mix_b(const Params& P, LAS unsigned char* lds) {
    {
        const int gt = blockIdx.x * NTHREADS + threadIdx.x;
        for (int i = gt; i < 8 * 32 * 512; i += gridDim.x * NTHREADS) {
            const int ch = i & 511, k = (i >> 9) & 31, b = i >> 14;
            const float* HE = (const float*)(P.ws + WS_HE) + (size_t)b * 32 * 512 + ch; const float* AE = (const float*)(P.ws + WS_AE) + (size_t)b * 32 * 512 + ch;
            float he[31], ae[31];
#pragma unroll
            for (int kk = 0; kk < 31; ++kk) { he[kk] = kk < k ? HE[kk * 512] : 0.f; ae[kk] = kk < k ? AE[kk * 512] : 1.f; }
            float hin = 0.f;
#pragma unroll
            for (int kk = 0; kk < 31; ++kk) hin = kk < k ? he[kk] + ae[kk] * hin : hin;
            const float* R0 = (const float*)(P.ws + WS_R0) + (size_t)(b * 2048 + k * 64) * DLRU + ch; const float* R1 = (const float*)(P.ws + WS_R1) + (size_t)(b * 2048 + k * 64) * DLRU + ch;
            bf16_t* ar = (bf16_t*)(P.ws + WS_AR) + (size_t)(b * 2048 + k * 64) * D + DATT + ch;
#pragma unroll 1
            for (int t0 = 0; t0 < 64; t0 += 16) {
                float r0[16], r1[16];
#pragma unroll
                for (int t = 0; t < 16; ++t) { r0[t] = R0[(size_t)(t0 + t) * DLRU]; r1[t] = R1[(size_t)(t0 + t) * DLRU]; }
#pragma unroll
                for (int t = 0; t < 16; ++t) ar[(size_t)(t0 + t) * D] = (bf16_t)f2bf(r0[t] + r1[t] * hin);
            }
            if (k == 31) P.out[O_HP + (size_t)b * 512 + ch] = HE[31 * 512] + AE[31 * 512] * hin;
        }
    }
    { const int lane = threadIdx.x & 63, gw = blockIdx.x * 8 + (threadIdx.x >> 6);
      for (int u = gw; u < NTOK_S * NH; u += gridDim.x * 8) { const int row = u / NH, h = u - row * NH; samp_merge_unit(P, row >> 3, row & 7, h, lane); } }
    {
        AttnKV R; int u = blockIdx.x;
        if (u < 1536) attn_fetch(P, AttnId{2, (u >> 4) / NH, (u >> 4) % NH, u & 15, 0}, R);
        for (; u < 1536; u += gridDim.x) {
            const int un = u + (int)gridDim.x; const bool hn = un < 1536; const int uu = hn ? un : u;
            attn_unit<1>(P, AttnId{2, (u >> 4) / NH, (u >> 4) % NH, u & 15, 0}, R, hn, AttnId{2, (uu >> 4) / NH, (uu >> 4) % NH, uu & 15, 0}, lds);
        }
    }
}

__device__ __forceinline__ void phase_ln1(const Params& P) {
    const int lane = threadIdx.x & 63, wave = threadIdx.x >> 6;
    const bf16_t* pre = (const bf16_t*)(P.ws + WS_PRE1); bf16_t* x1b = (bf16_t*)(P.ws + WS_X1B);
    const int rstep = gridDim.x * 8;
    float4 g8[8], b8[8];
#pragma unroll
    for (int j = 0; j < 8; ++j) { const int col = (j >> 2) * 1024 + lane * 16 + (j & 3) * 4; g8[j] = *(const float4*)(P.ln1_g + col); b8[j] = *(const float4*)(P.ln1_b + col); }
    u32x4 nx[4];
    { const int r0 = blockIdx.x * 8 + wave;
      if (r0 < NTOK) {
#pragma unroll
          for (int j = 0; j < 4; ++j) nx[j] = *(const u32x4*)(pre + (size_t)r0 * D + (j >> 1) * 1024 + lane * 16 + (j & 1) * 8); } }
#pragma unroll
    for (int j = 0; j < 4; ++j) asm volatile("" : "+v"(nx[j]));
    for (int row = blockIdx.x * 8 + wave; row < NTOK; row += rstep) {
        float4 v[8]; float s = 0.f;
        u32x4 cur[4];
#pragma unroll
        for (int j = 0; j < 4; ++j) cur[j] = nx[j];
        if (row + rstep < NTOK) {
#pragma unroll
            for (int j = 0; j < 4; ++j) nx[j] = *(const u32x4*)(pre + (size_t)(row + rstep) * D + (j >> 1) * 1024 + lane * 16 + (j & 1) * 8); }
#pragma unroll
        for (int j = 0; j < 8; j += 2) { const u32x4 pw = cur[j >> 1];
            v[j] = make_float4(bflo(pw.x), bfhi(pw.x), bflo(pw.y), bfhi(pw.y)); v[j + 1] = make_float4(bflo(pw.z), bfhi(pw.z), bflo(pw.w), bfhi(pw.w));
            s += (v[j].x + v[j].y) + (v[j].z + v[j].w) + (v[j + 1].x + v[j + 1].y) + (v[j + 1].z + v[j + 1].w); }
        const float mean = wave_sum(s) * (1.0f / D); float q = 0.f;
#pragma unroll
        for (int j = 0; j < 8; ++j) { const float a = v[j].x - mean, b = v[j].y - mean, c = v[j].z - mean, d = v[j].w - mean; q += (a * a + b * b) + (c * c + d * d); }
        const float rstd = rsqrtf(wave_sum(q) * (1.0f / D) + LN_EPS);
        float am = 0.f;
#pragma unroll
        for (int j = 0; j < 8; ++j) { const int col = (j >> 2) * 1024 + lane * 16 + (j & 3) * 4; const float4 g = g8[j], bb = b8[j];
            float4 o; o.x = (v[j].x - mean) * rstd * g.x + bb.x; o.y = (v[j].y - mean) * rstd * g.y + bb.y; o.z = (v[j].z - mean) * rstd * g.z + bb.z; o.w = (v[j].w - mean) * rstd * g.w + bb.w;
            v[j] = o; am = fmaxf(am, fmaxf(fmaxf(fabsf(o.x), fabsf(o.y)), fmaxf(fabsf(o.z), fabsf(o.w))));
            uint2 w; w.x = pack2(o.x, o.y); w.y = pack2(o.z, o.w); *(uint2*)(x1b + (size_t)row * D + col) = w; }
        am = wave_max(am); if (am == 0.f) am = 1.f;
        const float inv = 119.0f / am;
        unsigned char* xq = P.ws + WS_X1Q + (size_t)row * D;
        u32x4 wh, wl;
#pragma unroll
        for (int d = 0; d < 4; ++d) { unsigned dh = 0u, dl = 0u;
#pragma unroll
            for (int e = 0; e < 8; ++e) { const float4 t = v[d * 2 + (e >> 2)]; const float x = (e & 3) == 0 ? t.x : ((e & 3) == 1 ? t.y : ((e & 3) == 2 ? t.z : t.w));
                const int q = (int)rintf(x * inv); dl |= (unsigned)(q & 15) << (4 * e); dh |= (unsigned)(((q + 8) >> 4) & 15) << (4 * e); }
            wh[d] = dh; wl[d] = dl; }
        *(u32x4*)(xq + lane * 32) = wh; *(u32x4*)(xq + lane * 32 + 16) = wl;
        if (lane == 0) ((float*)(P.ws + WS_SX))[row] = am * (1.0f / 119.0f);
    }
}

__device__ __forceinline__ int mono(float v) { const int b = __float_as_int(v); return b ^ ((b >> 31) & 0x7fffffff); }
__device__ __forceinline__ float unmono(int k) { return __int_as_float(k ^ ((k >> 31) & 0x7fffffff)); }
#define MK_INSERT16(L, X) do { int _x = (X); _Pragma("unroll") for (int _j = 0; _j < 16; ++_j) { const int _hi = max(L[_j], _x); _x = min(L[_j], _x); L[_j] = _hi; } } while (0)

template <int N> __device__ __forceinline__ void bitonic_sort_desc(int (&v)[N]) {
#pragma unroll
    for (int k = 2; k <= N; k <<= 1)
#pragma unroll
        for (int j = k >> 1; j > 0; j >>= 1)
#pragma unroll
            for (int i = 0; i < N; ++i) { const int l = i ^ j;
                if (l > i) { const int a = v[i], b = v[l]; if ((i & k) == 0) { v[i] = max(a, b); v[l] = min(a, b); } else { v[i] = min(a, b); v[l] = max(a, b); } } }
}
template <int N> __device__ __forceinline__ void bitonic_merge_desc(int (&v)[N]) {
#pragma unroll
    for (int j = N >> 1; j > 0; j >>= 1)
#pragma unroll
        for (int i = 0; i < N; ++i) { const int l = i ^ j; if (l > i) { const int a = v[i], b = v[l]; v[i] = max(a, b); v[l] = min(a, b); } }
}
__device__ __forceinline__ void xlane_merge16(int (&v)[16], int off) {
    int c[16];
#pragma unroll
    for (int i = 0; i < 16; ++i) c[i] = max(v[i], __shfl_xor(v[15 - i], off));
#pragma unroll
    for (int i = 0; i < 16; ++i) v[i] = c[i];
    bitonic_merge_desc<16>(v);
}
__device__ __forceinline__ int sel4(int g, int a, int b, int c, int d) { return g == 0 ? a : (g == 1 ? b : (g == 2 ? c : d)); }
__device__ __forceinline__ float sel4f(int g, float a, float b, float c, float d) { return g == 0 ? a : (g == 1 ? b : (g == 2 ? c : d)); }
__device__ __forceinline__ constexpr int cand_a(int role, int i) {
    return role == 0 ? 0 : role == 1 ? (i < 8 ? 1 : (i < 13 ? 2 : 4)) : role == 2 ? (i < 4 ? 3 : (i < 6 ? 5 : (i < 8 ? 6 : (i < 10 ? 7 : 8 + (i - 10))))) : (i < 2 ? 14 + i : -1);
}
__device__ __forceinline__ constexpr int cand_b(int role, int i) {
    return role == 0 ? i : role == 1 ? (i < 8 ? i : (i < 13 ? i - 8 : i - 13)) : role == 2 ? (i < 4 ? i : (i < 6 ? i - 4 : (i < 8 ? i - 6 : (i < 10 ? i - 8 : 0)))) : 0;
}

__device__ __forceinline__ void route_unit(const Params& P, int h, int tg, LAS unsigned char* lds, LAS int* lst) {
    const int lane = threadIdx.x & 63, w = __builtin_amdgcn_readfirstlane(threadIdx.x >> 6);
    const int cq = lane & 15, g = lane >> 4;
    const int tok = tg * 128 + w * 16 + cq;
    const bf16_t* qrow = (const bf16_t*)(P.ws + WS_QP) + (size_t)tok * D + h * 256;
    int L0[16], L1[16];
#pragma unroll
    for (int p = 0; p < 2; ++p) {
        bf16x8 qf[4];
#pragma unroll
        for (int ks = 0; ks < 4; ++ks) qf[ks] = *(const bf16x8*)(qrow + p * 128 + 32 * ks + 8 * g);
        int v0[16], v1[16];
#pragma unroll
        for (int kt = 0; kt < 8; ++kt) {
            f32x4 acc = {0.f, 0.f, 0.f, 0.f};
#pragma unroll
            for (int ks = 0; ks < 4; ++ks) { const bf16x8 kf = *(const LAS bf16x8*)(lds + (p * 128 + 16 * kt + cq) * KVS + (32 * ks + 8 * g) * 2); acc = __builtin_amdgcn_mfma_f32_16x16x32_bf16(kf, qf[ks], acc, 0, 0, 0); }
#pragma unroll
            for (int ii = 0; ii < 4; ++ii) { const int key = (mono(acc[ii]) & ~127) | (16 * kt + 4 * g + ii); if (kt < 4) v0[kt * 4 + ii] = key; else v1[(kt - 4) * 4 + ii] = key; }
        }
        bitonic_sort_desc<16>(v0); bitonic_sort_desc<16>(v1);
#pragma unroll
        for (int i = 0; i < 16; ++i) v0[i] = max(v0[i], v1[15 - i]);
        bitonic_merge_desc<16>(v0);
        xlane_merge16(v0, 16); xlane_merge16(v0, 32);
#pragma unroll
        for (int i = 0; i < 16; ++i) { if (p == 0) L0[i] = v0[i]; else L1[i] = v0[i]; }
    }
    if (g == 0) {
#pragma unroll
        for (int i = 0; i < 16; ++i) lst[(cq * 2 + 0) * 16 + i] = L0[i];
    }
    if (g == 1) {
#pragma unroll
        for (int i = 0; i < 16; ++i) lst[(cq * 2 + 1) * 16 + i] = L1[i];
    }
    float f0[16], f1[16];
#pragma unroll
    for (int i = 0; i < 16; ++i) { f0[i] = unmono(L0[i] & ~127); f1[i] = unmono(L1[i] & ~127); }
    int c[16];
#pragma unroll
    for (int i = 0; i < 16; ++i) {
        constexpr int NEG = (int)0x80000000;
        const float va = sel4f(g, f0[cand_a(0, i)], f0[cand_a(1, i)], f0[cand_a(2, i)], f0[cand_a(3, i) < 0 ? 0 : cand_a(3, i)]);
        const float vb = sel4f(g, f1[cand_b(0, i)], f1[cand_b(1, i)], f1[cand_b(2, i)], f1[cand_b(3, i)]);
        const int id = sel4(g, (cand_a(0, i) << 4) | cand_b(0, i), (cand_a(1, i) << 4) | cand_b(1, i), (cand_a(2, i) << 4) | cand_b(2, i), ((cand_a(3, i) < 0 ? 0 : cand_a(3, i)) << 4) | cand_b(3, i));
        int key = (mono(va + vb) & ~255) | id;
        if (cand_a(3, i) < 0) key = (g == 3) ? NEG : key;
        c[i] = key;
    }
    bitonic_sort_desc<16>(c);
    xlane_merge16(c, 16); xlane_merge16(c, 32);
    const float mx = unmono(c[0] & ~255);
    float e[16]; float sum = 0.f;
#pragma unroll
    for (int i = 0; i < 16; ++i) { e[i] = exp2f((unmono(c[i] & ~255) - mx) * LOG2E); sum += e[i]; }
    const float inv = 1.0f / sum;
    __builtin_amdgcn_wave_barrier();
    int ei[4]; float gi[4];
#pragma unroll
    for (int j = 0; j < 4; ++j) {
        const int key = sel4(g, c[j], c[4 + j], c[8 + j], c[12 + j]);
        gi[j] = sel4f(g, e[j], e[4 + j], e[8 + j], e[12 + j]) * inv;
        const int a = (key >> 4) & 15, b = key & 15;
        const int i0 = lst[(cq * 2 + 0) * 16 + a] & 127, i1 = lst[(cq * 2 + 1) * 16 + b] & 127;
        ei[j] = i0 * 128 + i1;
    }
    int* EIDX = (int*)(P.ws + WS_EIDX); float* GW = (float*)(P.ws + WS_GW);
    *(int4*)(EIDX + (size_t)tok * 128 + h * 16 + 4 * g) = make_int4(ei[0], ei[1], ei[2], ei[3]);
    *(float4*)(GW + (size_t)tok * 128 + h * 16 + 4 * g) = make_float4(gi[0], gi[1], gi[2], gi[3]);
    __builtin_amdgcn_wave_barrier();
}
__device__ __forceinline__ void phase_route(const Params& P, LAS unsigned char* lds) {
    const int tid = threadIdx.x, wave = __builtin_amdgcn_readfirstlane(tid >> 6);
    const int h = blockIdx.x & 7, slot = blockIdx.x >> 3, nslot = gridDim.x >> 3;
    const bf16_t* sk = (const bf16_t*)(P.ws + WS_SKB) + (size_t)h * 2 * 128 * 128;
#pragma unroll
    for (int it = 0; it < 8; ++it) { const int row = it * 32 + (tid >> 4), ch = tid & 15; *(LAS u32x4*)(lds + row * KVS + ch * 16) = *(const u32x4*)(sk + (size_t)row * 128 + ch * 8); }
    __syncthreads();
    LAS int* lst = (LAS int*)(lds + 73728) + wave * 512;
    for (int tg = slot; tg < NTOK / 128; tg += nslot) route_unit(P, h, tg, lds, lst);
    { const int extra = (NTOK / 128) % nslot;
      if (extra != 0 && slot >= extra) quant_tables(P, ((slot - extra) * 8 + h) * 8 + wave, (nslot - extra) * 8 * 8, 2 * NEXP - MK_QTAIL, 2 * NEXP);
      else if (extra == 0) quant_tables(P, (int)blockIdx.x * 8 + wave, (int)gridDim.x * 8, 2 * NEXP - MK_QTAIL, 2 * NEXP); }
}

__device__ __forceinline__ float ubf(unsigned x, int k) { return (float)((x >> (8 * k)) & 0xffu); }
constexpr int XSLOT = 1152, XGRP = 4 * XSLOT, XNG = 4, XWAVE = XNG * XGRP;
__device__ __forceinline__ void dma_group(__amdgpu_buffer_rsrc_t tab, int e_lo, int e_hi, int g, LAS unsigned char* sb, int lane) {
#pragma unroll
    for (int j = 0; j < 4; ++j) {
        const int k = g * 4 + j; const int e = __builtin_amdgcn_readlane(k < 64 ? e_lo : e_hi, k & 63);
        const int so = e * TROW;
        __builtin_amdgcn_raw_ptr_buffer_load_lds(tab, (LAS void*)(sb + j * XSLOT), 16, lane * 16, so, 0, 0);
        if (lane < 8) __builtin_amdgcn_raw_ptr_buffer_load_lds(tab, (LAS void*)(sb + j * XSLOT + 1024), 16, 1024 + lane * 16, so, 0, 0);
    }
}
__device__ __forceinline__ void u_consume(const LAS unsigned char* sb, const u32x4& xh, const u32x4& xl, float a_lo, float a_hi, float b_lo, float b_hi, int g, int lane, float& w_lo, float& w_hi) {
    int d[4];
#pragma unroll
    for (int j = 0; j < 4; ++j) {
        const u32x4 nb = *(const LAS u32x4*)(sb + j * XSLOT + lane * 16); const unsigned sc = *(const LAS unsigned short*)(sb + j * XSLOT + 1024 + lane * 2);
        int tot = 0;
#pragma unroll
        for (int jj = 0; jj < 2; ++jj) {
            int th = __builtin_amdgcn_sdot8((int)nb[jj * 2], (int)xh[jj * 2], 0, false); th = __builtin_amdgcn_sdot8((int)nb[jj * 2 + 1], (int)xh[jj * 2 + 1], th, false);
            int tl = __builtin_amdgcn_sdot8((int)nb[jj * 2], (int)xl[jj * 2], 0, false); tl = __builtin_amdgcn_sdot8((int)nb[jj * 2 + 1], (int)xl[jj * 2 + 1], tl, false);
            tot += (16 * th + tl) * (int)((sc >> (8 * jj)) & 255u); }
        d[j] = tot;
    }
    const auto s02 = __builtin_amdgcn_permlane32_swap((unsigned)d[0], (unsigned)d[2], false, false);
    const auto s13 = __builtin_amdgcn_permlane32_swap((unsigned)d[1], (unsigned)d[3], false, false);
    const int r0 = (int)s02[0] + (int)s02[1], r1 = (int)s13[0] + (int)s13[1];
    const auto s01 = __builtin_amdgcn_permlane16_swap((unsigned)r0, (unsigned)r1, false, false);
    int r = (int)s01[0] + (int)s01[1];
    r += __builtin_amdgcn_update_dpp(0, r, 0x128, 0xf, 0xf, false);
    r += __builtin_amdgcn_update_dpp(0, r, 0x124, 0xf, 0xf, false);
    r += __builtin_amdgcn_update_dpp(0, r, 0x4E, 0xf, 0xf, false);
    r += __builtin_amdgcn_update_dpp(0, r, 0xB1, 0xf, 0xf, false);
    const int tot = __shfl(r, (lane & 3) * 16);
    const bool mine = ((lane >> 2) == (g & 15));
    const bool hi = g >= 16;
    const float wv = (hi ? b_hi : b_lo) * gelu_as((float)tot * (hi ? a_hi : a_lo));
    if (hi) w_hi = mine ? wv : w_hi; else w_lo = mine ? wv : w_lo;
}
__device__ __forceinline__ void v_consume(const LAS unsigned char* sb, int (&acc)[32], int (&bias)[2], float w_lo, float w_hi, float inv_sw, int g, int lane) {
    u32x4 nb[4]; int wq[2] = {0, 0};
#pragma unroll
    for (int j = 0; j < 4; ++j) {
        const int k = g * 4 + j; const float w = readlane_f(k < 64 ? w_lo : w_hi, k & 63) * inv_sw;
        nb[j] = *(const LAS u32x4*)(sb + j * XSLOT + lane * 16); const unsigned sc = *(const LAS unsigned short*)(sb + j * XSLOT + 1024 + lane * 2);
#pragma unroll
        for (int jj = 0; jj < 2; ++jj) { const int q = (int)rintf(w * (float)((sc >> (8 * jj)) & 255u)); wq[jj] |= (q & 255) << (8 * j); }
    }
    bias[0] = __builtin_amdgcn_sdot4(wq[0], 0x01010101, bias[0], false); bias[1] = __builtin_amdgcn_sdot4(wq[1], 0x01010101, bias[1], false);
#pragma unroll
    for (int i = 0; i < 4; ++i) {
        const unsigned r0 = nb[0][i], r1 = nb[1][i], r2 = nb[2][i], r3 = nb[3][i];
        const unsigned p01a = __builtin_amdgcn_perm(r1, r0, 0x05010400u), p01b = __builtin_amdgcn_perm(r1, r0, 0x07030602u);
        const unsigned p23a = __builtin_amdgcn_perm(r3, r2, 0x05010400u), p23b = __builtin_amdgcn_perm(r3, r2, 0x07030602u);
        const unsigned t0 = __builtin_amdgcn_perm(p23a, p01a, 0x05040100u), t1 = __builtin_amdgcn_perm(p23a, p01a, 0x07060302u);
        const unsigned t2 = __builtin_amdgcn_perm(p23b, p01b, 0x05040100u), t3 = __builtin_amdgcn_perm(p23b, p01b, 0x07060302u);
        const int wv = wq[i >> 1];
        acc[i * 8 + 0] = __builtin_amdgcn_sdot4((int)(t0 & 0x0F0F0F0Fu), wv, acc[i * 8 + 0], false); acc[i * 8 + 1] = __builtin_amdgcn_sdot4((int)((t0 >> 4) & 0x0F0F0F0Fu), wv, acc[i * 8 + 1], false);
        acc[i * 8 + 2] = __builtin_amdgcn_sdot4((int)(t1 & 0x0F0F0F0Fu), wv, acc[i * 8 + 2], false); acc[i * 8 + 3] = __builtin_amdgcn_sdot4((int)((t1 >> 4) & 0x0F0F0F0Fu), wv, acc[i * 8 + 3], false);
        acc[i * 8 + 4] = __builtin_amdgcn_sdot4((int)(t2 & 0x0F0F0F0Fu), wv, acc[i * 8 + 4], false); acc[i * 8 + 5] = __builtin_amdgcn_sdot4((int)((t2 >> 4) & 0x0F0F0F0Fu), wv, acc[i * 8 + 5], false);
        acc[i * 8 + 6] = __builtin_amdgcn_sdot4((int)(t3 & 0x0F0F0F0Fu), wv, acc[i * 8 + 6], false); acc[i * 8 + 7] = __builtin_amdgcn_sdot4((int)((t3 >> 4) & 0x0F0F0F0Fu), wv, acc[i * 8 + 7], false);
    }
}
__device__ __forceinline__ void wave_sort128(int& v0, int& v1, int lane) {
#pragma unroll
    for (int k = 2; k <= 128; k <<= 1) {
#pragma unroll
        for (int j = k >> 1; j > 0; j >>= 1) {
            if (j == 64) { const int lo = min(v0, v1), hi = max(v0, v1); v0 = lo; v1 = hi; }
            else {
                const int p0 = __shfl_xor(v0, j), p1 = __shfl_xor(v1, j);
                const bool lower = (lane & j) == 0;
                const bool asc0 = (lane & k) == 0, asc1 = ((64 + lane) & k) == 0;
                v0 = (lower == asc0) ? min(v0, p0) : max(v0, p0);
                v1 = (lower == asc1) ? min(v1, p1) : max(v1, p1);
            }
        }
    }
}
__device__ __forceinline__ void exp_epilogue(const Params& P, int row, int ln, const int (&acc)[32], const int (&bias)[2], float scale_w) {
    const bf16_t* x1b = (const bf16_t*)(P.ws + WS_X1B);
    float val[32]; float s = 0.f;
#pragma unroll
    for (int jj = 0; jj < 2; ++jj) {
        const int b8 = 8 * bias[jj];
#pragma unroll
        for (int hh = 0; hh < 2; ++hh) {
            const u32x4 xa = *(const u32x4*)(x1b + (size_t)row * D + jj * 1024 + ln * 16 + hh * 8);
#pragma unroll
            for (int i = 0; i < 4; ++i) { const int e0 = jj * 16 + hh * 8 + 2 * i;
                val[e0] = scale_w * (float)(acc[e0] - b8) + ALPHA * bflo(xa[i]); val[e0 + 1] = scale_w * (float)(acc[e0 + 1] - b8) + ALPHA * bfhi(xa[i]); s += val[e0] + val[e0 + 1]; }
        }
    }
    const float mean = wave_sum(s) * (1.0f / D); float q = 0.f;
#pragma unroll
    for (int i = 0; i < 32; ++i) { const float d0 = val[i] - mean; q += d0 * d0; }
    const float rstd = rsqrtf(wave_sum(q) * (1.0f / D) + LN_EPS);
    float* yo = P.out + (row < NTOK_P ? O_YP + (size_t)row * D : O_YS + (size_t)(row - NTOK_P) * D);
    const int lo16 = ln * 16;
    float4 gg[8], bb[8];
#pragma unroll
    for (int jj = 0; jj < 2; ++jj)
#pragma unroll
        for (int i = 0; i < 4; ++i) { const int col = jj * 1024 + lo16 + i * 4; gg[jj * 4 + i] = *(const float4*)(P.ln2_g + col); bb[jj * 4 + i] = *(const float4*)(P.ln2_b + col); }
#pragma unroll
    for (int jj = 0; jj < 2; ++jj)
#pragma unroll
        for (int i = 0; i < 4; ++i) {
            const int col = jj * 1024 + lo16 + i * 4;
            const float4 g0 = gg[jj * 4 + i], b0 = bb[jj * 4 + i];
            float4 o;
            o.x = (val[jj * 16 + i * 4 + 0] - mean) * rstd * g0.x + b0.x; o.y = (val[jj * 16 + i * 4 + 1] - mean) * rstd * g0.y + b0.y;
            o.z = (val[jj * 16 + i * 4 + 2] - mean) * rstd * g0.z + b0.z; o.w = (val[jj * 16 + i * 4 + 3] - mean) * rstd * g0.w + b0.w;
            *(float4*)(yo + col) = o;
        }
}
__device__ __forceinline__ void phase_experts(const Params& P, LAS unsigned char* lds) {
    const int lane = threadIdx.x & 63, wave = __builtin_amdgcn_readfirstlane(threadIdx.x >> 6);
    const int* EIDX = (const int*)(P.ws + WS_EIDX); const float* GW = (const float*)(P.ws + WS_GW);
    const __amdgpu_buffer_rsrc_t UQ = __builtin_amdgcn_make_buffer_rsrc((void*)(P.ws + WS_UB), 0, NEXP * TROW, 0x00020000);
    const __amdgpu_buffer_rsrc_t VQ = __builtin_amdgcn_make_buffer_rsrc((void*)(P.ws + WS_VB), 0, NEXP * TROW, 0x00020000);
    const float* SU = (const float*)(P.ws + WS_SU); const float* SV = (const float*)(P.ws + WS_SV); const float* SX = (const float*)(P.ws + WS_SX);
    LAS unsigned char* wb = lds + wave * XWAVE;
    constexpr int TPW = 8;
    const int row0 = blockIdx.x * 8 + wave, rstride = gridDim.x * 8;
    if (row0 + (TPW - 1) * rstride < NTOK_P) {
        u32x4 mxh[TPW], mxl[TPW]; int mel[TPW], meh[TPW]; float mal[TPW], mah[TPW], mbl[TPW], mbh[TPW];
#pragma unroll
        for (int i = 0; i < TPW; ++i) {
            const int row = row0 + i * rstride;
            mxh[i] = *(const u32x4*)(P.ws + WS_X1Q + (size_t)row * D + lane * 32); mxl[i] = *(const u32x4*)(P.ws + WS_X1Q + (size_t)row * D + lane * 32 + 16);
            int p0 = (EIDX[(size_t)row * 128 + lane] << 18) | min(262143, (int)(GW[(size_t)row * 128 + lane] * 262144.0f));
            int p1 = (EIDX[(size_t)row * 128 + 64 + lane] << 18) | min(262143, (int)(GW[(size_t)row * 128 + 64 + lane] * 262144.0f));
            wave_sort128(p0, p1, lane);
            mel[i] = (int)((unsigned)p0 >> 18); meh[i] = (int)((unsigned)p1 >> 18);
            const float gl = ((float)(p0 & 262143) + 0.5f) * (1.0f / 262144.0f), gh = ((float)(p1 & 262143) + 0.5f) * (1.0f / 262144.0f);
            const float sx = SX[row];
            mal[i] = SU[mel[i]] * sx; mah[i] = SU[meh[i]] * sx; mbl[i] = gl * SV[mel[i]]; mbh[i] = gh * SV[meh[i]];
        }
        asm volatile("s_waitcnt vmcnt(0)" ::: "memory");
        dma_group(UQ, mel[0], meh[0], 0, wb, lane); dma_group(UQ, mel[0], meh[0], 1, wb + XGRP, lane); dma_group(UQ, mel[0], meh[0], 2, wb + 2 * XGRP, lane);
        int sg = 0;
        float mwl[TPW], mwh[TPW];
#pragma unroll
        for (int j = 0; j < TPW; ++j) { mwl[j] = 0.f; mwh[j] = 0.f; }
        static_assert(TPW == 8, "the visit order below is written for 8 tokens per wave");
#pragma unroll 1
        for (int v = 0; v < 64; ++v) {
            const int ss = v >> 3, i = v & 7, i2 = (v + 1) & 7, s2 = (v + 1) >> 3;
            u32x4 xh = mxh[0], xl = mxl[0]; int e_lo = mel[0], e_hi = meh[0], n_lo = mel[0], n_hi = meh[0]; float a_lo = mal[0], a_hi = mah[0], b_lo = mbl[0], b_hi = mbh[0], w_lo = mwl[0], w_hi = mwh[0];
#pragma unroll
            for (int j = 1; j < TPW; ++j) { const bool m = (i == j), m2 = (i2 == j);
                xh[0] = m ? mxh[j][0] : xh[0]; xh[1] = m ? mxh[j][1] : xh[1]; xh[2] = m ? mxh[j][2] : xh[2]; xh[3] = m ? mxh[j][3] : xh[3];
                xl[0] = m ? mxl[j][0] : xl[0]; xl[1] = m ? mxl[j][1] : xl[1]; xl[2] = m ? mxl[j][2] : xl[2]; xl[3] = m ? mxl[j][3] : xl[3];
                e_lo = m ? mel[j] : e_lo; e_hi = m ? meh[j] : e_hi; a_lo = m ? mal[j] : a_lo; a_hi = m ? mah[j] : a_hi; b_lo = m ? mbl[j] : b_lo; b_hi = m ? mbh[j] : b_hi;
                w_lo = m ? mwl[j] : w_lo; w_hi = m ? mwh[j] : w_hi; n_lo = m2 ? mel[j] : n_lo; n_hi = m2 ? meh[j] : n_hi; }
#pragma unroll
            for (int gg = 0; gg < 4; ++gg) {
                const int sn = (sg + 3) & 3;
                if (gg == 0) dma_group(UQ, e_lo, e_hi, ss * 4 + 3, wb + sn * XGRP, lane);
                else if (v < 63) dma_group(UQ, n_lo, n_hi, s2 * 4 + gg - 1, wb + sn * XGRP, lane);
                else dma_group(VQ, n_lo, n_hi, gg - 1, wb + sn * XGRP, lane);
                asm volatile("s_waitcnt vmcnt(24)" ::: "memory");
                u_consume(wb + sg * XGRP, xh, xl, a_lo, a_hi, b_lo, b_hi, ss * 4 + gg, lane, w_lo, w_hi);
                sg = (sg + 1) & 3;
            }
#pragma unroll
            for (int j = 0; j < TPW; ++j) { const bool m = (i == j); mwl[j] = m ? w_lo : mwl[j]; mwh[j] = m ? w_hi : mwh[j]; }
        }
#pragma unroll 1
        for (int i = 0; i < TPW; ++i) {
            const int row = row0 + i * rstride;
            int e_lo = mel[0], e_hi = meh[0], n_lo = mel[0], n_hi = meh[0]; float w_lo = mwl[0], w_hi = mwh[0];
#pragma unroll
            for (int j = 1; j < TPW; ++j) { const bool m = (i == j); e_lo = m ? mel[j] : e_lo; e_hi = m ? meh[j] : e_hi; w_lo = m ? mwl[j] : w_lo; w_hi = m ? mwh[j] : w_hi; }
#pragma unroll
            for (int j = 0; j < TPW - 1; ++j) { const bool m = (i == j); n_lo = m ? mel[j + 1] : n_lo; n_hi = m ? meh[j + 1] : n_hi; }
            float wmax = wave_max(fmaxf(fabsf(w_lo), fabsf(w_hi))); if (wmax == 0.f) wmax = 1.f;
            const float scale_w = wmax * (255.0f / 127.0f), inv_sw = 1.0f / scale_w;
            int acc[32]; int bias[2] = {0, 0};
#pragma unroll
            for (int q = 0; q < 32; ++q) acc[q] = 0;
#pragma unroll 1
            for (int g = 0; g < 32; ++g) {
                const int sn = (sg + 3) & 3;
                if (g + 3 < 32) dma_group(VQ, e_lo, e_hi, g + 3, wb + sn * XGRP, lane);
                else dma_group(VQ, n_lo, n_hi, g + 3 - 32, wb + sn * XGRP, lane);
                asm volatile("s_waitcnt vmcnt(24)" ::: "memory");
                v_consume(wb + sg * XGRP, acc, bias, w_lo, w_hi, inv_sw, g, lane);
                sg = (sg + 1) & 3;
            }
            int ln = lane; asm volatile("" : "+v"(ln));
            exp_epilogue(P, row, ln, acc, bias, scale_w);
        }
        asm volatile("s_waitcnt vmcnt(0)" ::: "memory");
    }
    for (int row = row0 + ((row0 + (TPW - 1) * rstride < NTOK_P) ? TPW * rstride : 0); row < NTOK_P; row += rstride) {
        int ln = lane; asm volatile("" : "+v"(ln));
        const u32x4 xh = *(const u32x4*)(P.ws + WS_X1Q + (size_t)row * D + ln * 32), xl = *(const u32x4*)(P.ws + WS_X1Q + (size_t)row * D + ln * 32 + 16);
        const float sx = SX[row];
        const int e_lo = EIDX[(size_t)row * 128 + ln], e_hi = EIDX[(size_t)row * 128 + 64 + ln];
        const float g_lo = GW[(size_t)row * 128 + ln], g_hi = GW[(size_t)row * 128 + 64 + ln];
        const float a_lo = SU[e_lo] * sx, a_hi = SU[e_hi] * sx, b_lo = g_lo * SV[e_lo], b_hi = g_hi * SV[e_hi];
        float w_lo = 0.f, w_hi = 0.f;
        asm volatile("s_waitcnt vmcnt(0)" ::: "memory");
        dma_group(UQ, e_lo, e_hi, 0, wb, lane); dma_group(UQ, e_lo, e_hi, 1, wb + XGRP, lane); dma_group(UQ, e_lo, e_hi, 2, wb + 2 * XGRP, lane);
        int sg = 0;
#pragma unroll 1
        for (int g = 0; g < 32; ++g) {
            const int sn = (sg + 3) & 3;
            if (g + 3 < 32) dma_group(UQ, e_lo, e_hi, g + 3, wb + sn * XGRP, lane); else dma_group(VQ, e_lo, e_hi, g + 3 - 32, wb + sn * XGRP, lane);
            asm volatile("s_waitcnt vmcnt(24)" ::: "memory");
            u_consume(wb + sg * XGRP, xh, xl, a_lo, a_hi, b_lo, b_hi, g, lane, w_lo, w_hi);
            sg = (sg + 1) & 3;
        }
        float wmax = wave_max(fmaxf(fabsf(w_lo), fabsf(w_hi))); if (wmax == 0.f) wmax = 1.f;
        const float scale_w = wmax * (255.0f / 127.0f), inv_sw = 1.0f / scale_w;
        int acc[32]; int bias[2] = {0, 0};
#pragma unroll
        for (int i = 0; i < 32; ++i) acc[i] = 0;
#pragma unroll 1
        for (int g = 0; g < 32; ++g) {
            const int sn = (sg + 3) & 3;
            dma_group(VQ, e_lo, e_hi, (g + 3) & 31, wb + sn * XGRP, lane);
            asm volatile("s_waitcnt vmcnt(24)" ::: "memory");
            v_consume(wb + sg * XGRP, acc, bias, w_lo, w_hi, inv_sw, g, lane);
            sg = (sg + 1) & 3;
        }
        asm volatile("s_waitcnt vmcnt(0)" ::: "memory");
        exp_epilogue(P, row, ln, acc, bias, scale_w);
    }
    LAS int* cmax = (LAS int*)(lds + MISC_OFF + 64);
    __syncthreads();
    for (int ct = blockIdx.x; ct < NTOK_S; ct += gridDim.x) {
        const int row = NTOK_P + ct;
        int ln = lane; asm volatile("" : "+v"(ln));
        const u32x4 xh = *(const u32x4*)(P.ws + WS_X1Q + (size_t)row * D + ln * 32), xl = *(const u32x4*)(P.ws + WS_X1Q + (size_t)row * D + ln * 32 + 16);
        const float sx = SX[row];
        const int kk = 16 * wave + (ln & 15);
        const int e_loc = EIDX[(size_t)row * 128 + kk]; const float g_loc = GW[(size_t)row * 128 + kk];
        const float a_loc = SU[e_loc] * sx, b_loc = g_loc * SV[e_loc];
        float w_loc = 0.f, w_dummy = 0.f;
        asm volatile("s_waitcnt vmcnt(0)" ::: "memory");
#pragma unroll
        for (int g = 0; g < 4; ++g) dma_group(UQ, e_loc, e_loc, g, wb + g * XGRP, lane);
        asm volatile("s_waitcnt vmcnt(0)" ::: "memory");
#pragma unroll
        for (int g = 0; g < 4; ++g) u_consume(wb + g * XGRP, xh, xl, a_loc, a_loc, b_loc, b_loc, g, lane, w_loc, w_dummy);
#pragma unroll
        for (int g = 0; g < 4; ++g) dma_group(VQ, e_loc, e_loc, g, wb + g * XGRP, lane);
        const float wm = wave_max(ln < 16 ? fabsf(w_loc) : 0.f);
        if (lane == 0) cmax[wave] = __float_as_int(wm);
        __syncthreads();
        float wmax = 0.f;
#pragma unroll
        for (int ww = 0; ww < 8; ++ww) wmax = fmaxf(wmax, __int_as_float(cmax[ww]));
        if (wmax == 0.f) wmax = 1.f;
        const float scale_w = wmax * (255.0f / 127.0f), inv_sw = 1.0f / scale_w;
        int acc[32]; int bias[2] = {0, 0};
#pragma unroll
        for (int i = 0; i < 32; ++i) acc[i] = 0;
        asm volatile("s_waitcnt vmcnt(0)" ::: "memory");
#pragma unroll
        for (int g = 0; g < 4; ++g) v_consume(wb + g * XGRP, acc, bias, w_loc, w_loc, inv_sw, g, lane);
        __builtin_amdgcn_wave_barrier();
        {
            LAS int* pp = (LAS int*)wb + lane * 36;
#pragma unroll
            for (int i = 0; i < 8; ++i) *(LAS u32x4*)(pp + 4 * i) = (u32x4){(unsigned)acc[4 * i], (unsigned)acc[4 * i + 1], (unsigned)acc[4 * i + 2], (unsigned)acc[4 * i + 3]};
            pp[32] = bias[0]; pp[33] = bias[1];
        }
        __syncthreads();
        if (wave == 0) {
#pragma unroll
            for (int i = 0; i < 32; ++i) acc[i] = 0;
            bias[0] = 0; bias[1] = 0;
#pragma unroll 1
            for (int ww = 0; ww < 8; ++ww) {
                const LAS int* pp = (const LAS int*)(lds + ww * XWAVE) + lane * 36;
#pragma unroll
                for (int i = 0; i < 8; ++i) { const u32x4 t = *(const LAS u32x4*)(pp + 4 * i); acc[4 * i] += (int)t[0]; acc[4 * i + 1] += (int)t[1]; acc[4 * i + 2] += (int)t[2]; acc[4 * i + 3] += (int)t[3]; }
                bias[0] += pp[32]; bias[1] += pp[33];
            }
            exp_epilogue(P, row, ln, acc, bias, scale_w);
        }
        __syncthreads();
    }
}

constexpr int NPHASE = 11;
__global__ void __launch_bounds__(NTHREADS, 2) fwd(Params P) {
    extern __shared__ __attribute__((aligned(16))) unsigned char lds_raw[];
    LAS unsigned char* lds = (LAS unsigned char*)lds_raw;
    volatile LAS unsigned* misc = (volatile LAS unsigned*)(lds + MISC_OFF);
    const int lo = P.ph_lo, hi = P.ph_hi;
    XcdBarrier bar; bar.bar = (unsigned*)(P.ws + WS_CTL); bar.x = 0; bar.st = nullptr;
    if (hi - lo > 1) {
        if (threadIdx.x == 0) { misc[0] = 0u; misc[1] = 0u; misc[2] = 0u; misc[3] = 0u; }
        __syncthreads();
        bar = xcd_barrier_post((unsigned*)(P.ws + WS_CTL), misc);
    }
#ifndef MK_REPMASK
#define MK_REPMASK 0
#endif
#ifndef MK_PHASE_MASK
#define MK_PHASE_MASK 0x7ff
#endif
#define IN(k) (((MK_PHASE_MASK >> (k)) & 1) && lo <= (k) && (k) < hi)
#define SEAM(k) do { if (IN(k) && IN((k) + 1)) xcd_barrier(bar); } while (0)
    if (IN(0)) { phase_prologue(P, lds); }
    SEAM(0);
    if (IN(1)) {
        pg8::Gemm g{(const pg8::bf16_t*)(P.ws + WS_XB), (const pg8::bf16_t*)(P.ws + WS_WINT), NTOK, DIN, D};
        pg8::StaticOrder S; S.init(NTOK, DIN, (int)gridDim.x, (int)blockIdx.x);
        EpiProj E{P.out, (bf16_t*)(P.ws + WS_XR), (bf16_t*)(P.ws + WS_GATE), (bf16_t*)(P.ws + WS_QB), (bf16_t*)(P.ws + WS_KB), (bf16_t*)(P.ws + WS_VB16)};
        pg8::gemm_phase<EpiProj, pg8::StaticOrder, false>(lds, g, S, E, nullptr);
        { const int nwg = (NTOK / 256) * (DIN / 256), full = nwg % (int)gridDim.x;
          if (full != 0 && (int)blockIdx.x >= full) quant_tables(P, ((int)blockIdx.x - full) * 8 + (int)(threadIdx.x >> 6), ((int)gridDim.x - full) * 8, 0, MK_QHEAD);
          else if (full == 0) quant_tables(P, (int)blockIdx.x * 8 + (int)(threadIdx.x >> 6), (int)gridDim.x * 8, 0, MK_QHEAD); }
    }
    SEAM(1);
    if (IN(2)) { phase_lru(P, lds); }
    if (IN(3)) { phase_samp(P, lds); }
    if (IN(4)) { phase_attn01(P, lds); }
    SEAM(4);
    if (IN(5)) { phase_mix_b(P, lds); }
    SEAM(5);
    if (IN(6)) {
        sample_rows_gemm<0>(P, (const bf16_t*)(P.ws + WS_AR), (const bf16_t*)(P.ws + WS_WOT), lds);
        pg8::Gemm g{(const pg8::bf16_t*)(P.ws + WS_AR), (const pg8::bf16_t*)(P.ws + WS_WOT), NTOK_P, D, D};
        pg8::StaticOrder S; S.init(NTOK_P, D, (int)gridDim.x, (int)blockIdx.x);
        EpiOut E{(const bf16_t*)(P.ws + WS_XB), (bf16_t*)(P.ws + WS_PRE1)};
        pg8::gemm_phase<EpiOut, pg8::StaticOrder, false>(lds, g, S, E, nullptr);
    }
    SEAM(6);
    if (IN(7)) { phase_ln1(P); }
    SEAM(7);
    if (IN(8)) {
        sample_rows_gemm<1>(P, (const bf16_t*)(P.ws + WS_X1B), (const bf16_t*)(P.ws + WS_WQT), lds);
        pg8::Gemm g{(const pg8::bf16_t*)(P.ws + WS_X1B), (const pg8::bf16_t*)(P.ws + WS_WQT), NTOK_P, D, D};
        pg8::StaticOrder S; S.init(NTOK_P, D, (int)gridDim.x, (int)blockIdx.x);
        EpiBf16Plain E{(bf16_t*)(P.ws + WS_QP), D};
        pg8::gemm_phase<EpiBf16Plain, pg8::StaticOrder, false>(lds, g, S, E, nullptr);
    }
    SEAM(8);
    if (IN(9)) { phase_route(P, lds); }
    SEAM(9);
    if (IN(10)) { phase_experts(P, lds); }
#undef IN
#undef SEAM
}
}

extern "C" void kernel_launch(void* const* d_in, const int* in_sizes, int n_in, void* d_out, int out_size, void* d_ws, size_t ws_size, hipStream_t stream) {
    using namespace mk;
    static int grid = 0;
    if (grid == 0) {
        if (n_in != 23 || (size_t)out_size != O_END || ws_size < WS_END) { fprintf(stderr, "kernel_launch: unexpected shapes: n_in %d out %d ws %zu (need %zu)\n", n_in, out_size, ws_size, (size_t)WS_END); grid = -1; return; }
        int dev = 0, cus = 0, per_cu = 0;
        if (hipGetDevice(&dev) != hipSuccess || hipDeviceGetAttribute(&cus, hipDeviceAttributeMultiprocessorCount, dev) != hipSuccess) { grid = -1; return; }
        if (hipFuncSetAttribute((const void*)fwd, hipFuncAttributeMaxDynamicSharedMemorySize, LDS_BYTES) != hipSuccess) { fprintf(stderr, "kernel_launch: hipFuncSetAttribute failed\n"); grid = -1; return; }
        if (hipOccupancyMaxActiveBlocksPerMultiprocessor(&per_cu, (const void*)fwd, NTHREADS, LDS_BYTES) != hipSuccess || per_cu < 1) { fprintf(stderr, "kernel_launch: occupancy query says %d\n", per_cu); }
        (void)hipGetLastError();
        grid = cus;
    }
    if (grid < 0) return;
    (void)hipMemsetAsync((char*)d_ws + WS_CTL, 0, 65536, stream);
    Params p{};
    p.x_prompt = (const float*)d_in[0]; p.x_sample = (const float*)d_in[1]; p.cache_k = (const float*)d_in[2]; p.cache_v = (const float*)d_in[3];
    p.state_conv = (const float*)d_in[4]; p.state_h = (const float*)d_in[5]; p.w_in = (const float*)d_in[6]; p.conv_w = (const float*)d_in[7]; p.conv_b = (const float*)d_in[8];
    p.lru_w_a = (const float*)d_in[9]; p.lru_b_a = (const float*)d_in[10]; p.lru_w_x = (const float*)d_in[11]; p.lru_b_x = (const float*)d_in[12]; p.lru_lambda = (const float*)d_in[13];
    p.w_out = (const float*)d_in[14]; p.ln1_g = (const float*)d_in[15]; p.ln1_b = (const float*)d_in[16]; p.w_query = (const float*)d_in[17]; p.sub_keys = (const float*)d_in[18];
    p.peer_u = (const float*)d_in[19]; p.peer_v = (const float*)d_in[20]; p.ln2_g = (const float*)d_in[21]; p.ln2_b = (const float*)d_in[22];
    p.out = (float*)d_out; p.ws = (unsigned char*)d_ws;
#if MK_N_LAUNCHES == 1
    p.ph_lo = 0; p.ph_hi = NPHASE;
    hipLaunchKernelGGL(fwd, dim3(grid), dim3(NTHREADS), LDS_BYTES, stream, p);
#else
    for (int k = 0; k < NPHASE; ++k) { p.ph_lo = k; p.ph_hi = k + 1; hipLaunchKernelGGL(fwd, dim3(grid), dim3(NTHREADS), LDS_BYTES, stream, p);
#ifdef MK_EXTRA_PHASE
        if (k == MK_EXTRA_PHASE) hipLaunchKernelGGL(fwd, dim3(grid), dim3(NTHREADS), LDS_BYTES, stream, p);
#endif
    }
#endif
    const hipError_t le = hipPeekAtLastError();
    if (le != hipSuccess) fprintf(stderr, "kernel_launch: launch failed: %s\n", hipGetErrorName(le));
}
```

```cpp
#include <hip/hip_runtime.h>
#include <cstdio>
#include <cstdint>
namespace pg8 {
#define PG8_LAS __attribute__((address_space(3)))
typedef unsigned short bf16_t;
typedef short bf16x8 __attribute__((ext_vector_type(8)));
typedef float f32x4 __attribute__((ext_vector_type(4)));
typedef unsigned u32x4 __attribute__((ext_vector_type(4)));
constexpr int BM = 256, BK = 64, HALF = 128, HTB = HALF * BK * 2  , STAGE_BYTES = 8 * HTB, NXCD = 8, WGM = 8;

__host__ __device__ __forceinline__ int lds_byte(int r, int c) { const int st = (r >> 4) * 2 + (c >> 5), rr = r & 15, cc = c & 31, ob = rr * 64 + cc * 2; return st * 1024 + (ob ^ (((ob >> 9) & 1) << 5)); }
__host__ __device__ __forceinline__ void stage_rc(int b, int& R, int& C) { const int st = b / 1024, sb = b % 1024, swz = sb ^ (((sb >> 9) & 1) << 5); R = (st >> 1) * 16 + swz / 64; C = (st & 1) * 32 + (swz % 64) / 2; }
__host__ __device__ __forceinline__ int perm32(int rho) { const int n = rho >> 4, i = rho & 15; return 8 * (i >> 2) + 4 * n + (i & 3); }

struct Unit { int pm, pn; };
struct Gemm { const bf16_t* A; const bf16_t* Bt; int M, N, K; };

struct StaticOrder {
    int nM, nN, nwg, G, c;
    __host__ __device__ void init(int M, int N, int G_, int c_) { nM = M / BM; nN = N / BM; nwg = nM * nN; G = G_; c = c_; }
    __host__ __device__ bool next(int i, Unit& u) const {
        const long L = (long)i * G + c; if (L >= nwg) return false;
        int wgid = (int)L; { const int q = nwg / NXCD, r = nwg % NXCD, xcd = wgid % NXCD, off = wgid / NXCD; wgid = (xcd < r ? xcd * (q + 1) : r * (q + 1) + (xcd - r) * q) + off; }
        const int nig = WGM * nN, gid = wgid / nig, fm = gid * WGM, gsz = (nM - fm) < WGM ? (nM - fm) : WGM;
        u.pm = fm + ((wgid % nig) % gsz); u.pn = (wgid % nig) / gsz; return true;
    }
    __device__ __forceinline__ void a_ready(const Unit&) const {}
    __device__ __forceinline__ void done(const Unit&) const {}
};
struct CountedOrder : StaticOrder {
    const unsigned* ready; unsigned need; unsigned* tmo;
    __device__ __forceinline__ void a_ready(const Unit& u) const {
        if (threadIdx.x < 64) {
            const unsigned long long t0 = __builtin_amdgcn_s_memrealtime(); unsigned polls = 0;
            while ((unsigned)__builtin_amdgcn_readfirstlane(__hip_atomic_load(ready + 64 * u.pm, __ATOMIC_RELAXED, __HIP_MEMORY_SCOPE_AGENT)) < need) {
                if ((++polls & 255u) == 0u && __builtin_amdgcn_readfirstlane(__hip_atomic_load(tmo, __ATOMIC_RELAXED, __HIP_MEMORY_SCOPE_AGENT)) != 0u) break;
                if (__builtin_amdgcn_s_memrealtime() - t0 > 2000000ull) {
                    if (threadIdx.x == 0) { unsigned expect = 0u; __hip_atomic_compare_exchange_strong(tmo + 1, &expect, 0x600u | (unsigned)(u.pm & 0xff), __ATOMIC_RELAXED, __ATOMIC_RELAXED, __HIP_MEMORY_SCOPE_AGENT); __hip_atomic_store(tmo, 1u, __ATOMIC_RELAXED, __HIP_MEMORY_SCOPE_AGENT); }
                    break; }
                __builtin_amdgcn_s_sleep(2); }
            __builtin_amdgcn_fence(__ATOMIC_ACQUIRE, "agent");
            asm volatile("s_waitcnt vmcnt(0)" ::: "memory");
        }
#if !defined(BROKEN_HOOK_NO_BARRIER)
        asm volatile("" ::: "memory"); __builtin_amdgcn_s_barrier(); asm volatile("" ::: "memory");
#endif
    }
};

__device__ __forceinline__ unsigned cvt_pk_bf16(float lo, float hi) { unsigned r; asm volatile("v_cvt_pk_bf16_f32 %0, %1, %2" : "=v"(r) : "v"(lo), "v"(hi)); return r; }
typedef float f32x2 __attribute__((ext_vector_type(2)));
__device__ __forceinline__ f32x2 gelu_pk(f32x2 v) {
    const f32x2 av = __builtin_elementwise_abs(v), d = av * 0.2316418882f + 1.0f;
    f32x2 t; t.x = __builtin_amdgcn_rcpf(d.x); t.y = __builtin_amdgcn_rcpf(d.y);
    f32x2 q = t * 0.5307027145f + (-0.7265760135f); q = q * t + 0.7107068705f; q = q * t + (-0.142248368f); q = q * t + 0.127414796f; q = q * t;
    const f32x2 s = (v * v) * (-0.72134752044f);
    f32x2 e; e.x = __builtin_amdgcn_exp2f(s.x); e.y = __builtin_amdgcn_exp2f(s.y);
    const f32x2 m = v * (q * e), r = v - m;
    f32x2 o; o.x = v.x < 0.f ? m.x : r.x; o.y = v.y < 0.f ? m.y : r.y; return o;
}

struct EpiF32 {
    static constexpr bool PERM = false, AFTER_DRAIN = false;
    float* C; int ldc; const float* bias;
    __device__ __forceinline__ void operator()(const f32x4 (&acc)[2][2][4][2], const Unit& u, int wr, int wc, int fr, int fq) const {
        const int row0 = u.pm * BM + wr * 64 + fr, col0 = u.pn * BM + wc * 32 + 4 * fq;
        f32x4 bv[2][2];
#pragma unroll
        for (int bj = 0; bj < 2; ++bj)
#pragma unroll
            for (int n = 0; n < 2; ++n) bv[bj][n] = bias ? *(const f32x4*)(bias + col0 + bj * HALF + n * 16) : (f32x4){0.f, 0.f, 0.f, 0.f};
#pragma unroll
        for (int ai = 0; ai < 2; ++ai)
#pragma unroll
            for (int m = 0; m < 4; ++m) { float* rowp = C + (size_t)(row0 + ai * HALF + m * 16) * ldc + col0;
#pragma unroll
                for (int bj = 0; bj < 2; ++bj)
#pragma unroll
                    for (int n = 0; n < 2; ++n) *(f32x4*)(rowp + bj * HALF + n * 16) = acc[ai][bj][m][n] + bv[bj][n]; }
    }
};
template <int ACT  > struct EpiBf16 {
    static constexpr bool PERM = true, AFTER_DRAIN = false;
    bf16_t* O; int ldc; const float* bias; int split_cols; size_t split_stride;
    __device__ __forceinline__ void operator()(const f32x4 (&acc)[2][2][4][2], const Unit& u, int wr, int wc, int fr, int fq) const {
        const int row0 = u.pm * BM + wr * 64 + fr; int colt = u.pn * BM; bf16_t* base = O;
        if (split_cols) { const int t = colt / split_cols; base += (size_t)t * split_stride; colt -= t * split_cols; }
        const int col0 = colt + wc * 32 + 8 * fq, bcol0 = u.pn * BM + wc * 32 + 8 * fq;
        f32x4 bv[2][2];
#pragma unroll
        for (int bj = 0; bj < 2; ++bj)
#pragma unroll
            for (int n = 0; n < 2; ++n) bv[bj][n] = bias ? *(const f32x4*)(bias + bcol0 + bj * HALF + 4 * n) : (f32x4){0.f, 0.f, 0.f, 0.f};
#pragma unroll
        for (int ai = 0; ai < 2; ++ai)
#pragma unroll
            for (int m = 0; m < 4; ++m) { bf16_t* rowp = base + (size_t)(row0 + ai * HALF + m * 16) * ldc + col0;
#pragma unroll
                for (int bj = 0; bj < 2; ++bj) { f32x4 v0 = acc[ai][bj][m][0] + bv[bj][0], v1 = acc[ai][bj][m][1] + bv[bj][1];
                    if (ACT == 1) { f32x2 a = gelu_pk((f32x2){v0[0], v0[1]}), b = gelu_pk((f32x2){v0[2], v0[3]}), c = gelu_pk((f32x2){v1[0], v1[1]}), d = gelu_pk((f32x2){v1[2], v1[3]});
                        v0 = (f32x4){a.x, a.y, b.x, b.y}; v1 = (f32x4){c.x, c.y, d.x, d.y}; }
                    if (ACT == 2) {
#pragma unroll
                        for (int j = 0; j < 4; ++j) { v0[j] = 0.5f * v0[j] * (1.0f + erff(v0[j] * 0.70710678f)); v1[j] = 0.5f * v1[j] * (1.0f + erff(v1[j] * 0.70710678f)); } }
                    u32x4 w; w.x = cvt_pk_bf16(v0[0], v0[1]); w.y = cvt_pk_bf16(v0[2], v0[3]); w.z = cvt_pk_bf16(v1[0], v1[1]); w.w = cvt_pk_bf16(v1[2], v1[3]);
                    *(u32x4*)(rowp + bj * HALF) = w; } }
    }
};

struct PanelStats {
    unsigned* xbuf;
    unsigned* cnt;
    unsigned* tmo;
    int ntn; float eps;
    unsigned code;
    __device__ __forceinline__ bool run(const f32x4 (&v)[2][2][4][2], const Unit& u, int wr, int wc, int fr, int fq, PG8_LAS unsigned char* lds, int wid, int lane) const {
        typedef float f32x2v __attribute__((ext_vector_type(2)));
        PG8_LAS f32x2v* P = (PG8_LAS f32x2v*)lds;
        PG8_LAS f32x2v* S = (PG8_LAS f32x2v*)(lds + 8192);
        PG8_LAS unsigned* flag = (PG8_LAS unsigned*)(lds + 8192 + 2048);
#pragma unroll
        for (int ai = 0; ai < 2; ++ai)
#pragma unroll
            for (int m = 0; m < 4; ++m) {
                float s = 0.f;
#pragma unroll
                for (int bj = 0; bj < 2; ++bj)
#pragma unroll
                    for (int n = 0; n < 2; ++n) { const f32x4 x = v[ai][bj][m][n]; s += (x[0] + x[1]) + (x[2] + x[3]); }
                s += __shfl_xor(s, 16); s += __shfl_xor(s, 32);
                const float mw = s * (1.0f / 64.0f); float q = 0.f;
#pragma unroll
                for (int bj = 0; bj < 2; ++bj)
#pragma unroll
                    for (int n = 0; n < 2; ++n) { const f32x4 d = v[ai][bj][m][n] - mw; q += (d[0] * d[0] + d[1] * d[1]) + (d[2] * d[2] + d[3] * d[3]); }
                q += __shfl_xor(q, 16); q += __shfl_xor(q, 32);
                if (fq == 0) P[(ai * HALF + wr * 64 + m * 16 + fr) * 4 + wc] = (f32x2v){mw, q};
            }
        asm volatile("s_waitcnt lgkmcnt(0)" ::: "memory"); __builtin_amdgcn_s_barrier(); asm volatile("" ::: "memory");
#if defined(BROKEN_NO_WAIT)
        if (blockIdx.x >= 64) { const long long t0 = clock64(); while (clock64() - t0 < 60000) __builtin_amdgcn_s_sleep(8); }
#endif
        const int row = wid * 32 + (lane & 31);
        if (lane < 32) {
            const f32x2v a = P[row * 4 + 0], b = P[row * 4 + 1], c = P[row * 4 + 2], d = P[row * 4 + 3];
            const float mt = (a.x + b.x + c.x + d.x) * 0.25f;
            const float da = a.x - mt, db = b.x - mt, dc = c.x - mt, dd = d.x - mt;
            const float m2 = (a.y + b.y) + (c.y + d.y) + 64.0f * ((da * da + db * db) + (dc * dc + dd * dd));
            unsigned long long* slot = (unsigned long long*)xbuf + ((size_t)(u.pm * BM + row) * 4 + u.pn);
            __hip_atomic_store(slot, ((unsigned long long)__float_as_uint(m2) << 32) | __float_as_uint(mt), __ATOMIC_RELAXED, __HIP_MEMORY_SCOPE_AGENT);
        }
        asm volatile("s_waitcnt vmcnt(0)" ::: "memory");
        if (lane == 0) __hip_atomic_fetch_add(cnt + 64 * u.pm, 1u, __ATOMIC_RELAXED, __HIP_MEMORY_SCOPE_AGENT);
        if (wid == 0) {
            bool dead = false; const unsigned long long t0 = __builtin_amdgcn_s_memrealtime(); const unsigned want = 8u * (unsigned)ntn;
            for (;;) {
#if defined(BROKEN_NO_WAIT)
                break;
#endif
                if ((unsigned)__builtin_amdgcn_readfirstlane(__hip_atomic_load(cnt + 64 * u.pm, __ATOMIC_RELAXED, __HIP_MEMORY_SCOPE_AGENT)) >= want) break;
                if (__builtin_amdgcn_s_memrealtime() - t0 > 2000000ull) {
                    if (lane == 0) { unsigned expect = 0u; __hip_atomic_compare_exchange_strong(tmo + 1, &expect, code | (unsigned)(u.pm & 0xff), __ATOMIC_RELAXED, __ATOMIC_RELAXED, __HIP_MEMORY_SCOPE_AGENT);
                                     __hip_atomic_store(tmo, 1u, __ATOMIC_RELAXED, __HIP_MEMORY_SCOPE_AGENT); }
                    dead = true; break; }
                __builtin_amdgcn_s_sleep(2);
            }
            __builtin_amdgcn_fence(__ATOMIC_ACQUIRE, "agent");
            if (lane == 0) flag[0] = dead ? 1u : 0u;
        }
        asm volatile("s_waitcnt vmcnt(0) lgkmcnt(0)" ::: "memory"); __builtin_amdgcn_s_barrier(); asm volatile("" ::: "memory");
        const bool bad = flag[0] != 0u;
        if (lane < 32) {
            const unsigned long long* slot = (const unsigned long long*)xbuf + (size_t)(u.pm * BM + row) * 4; float mt[4], m2[4]; float ms = 0.f;
#pragma unroll
            for (int t = 0; t < 4; ++t) { if (t < ntn) { const unsigned long long w = __hip_atomic_load(slot + t, __ATOMIC_RELAXED, __HIP_MEMORY_SCOPE_AGENT); mt[t] = __uint_as_float((unsigned)w); m2[t] = __uint_as_float((unsigned)(w >> 32)); } else { mt[t] = 0.f; m2[t] = 0.f; } ms += mt[t]; }
            const float mean = ms / (float)ntn; float q = 0.f;
#pragma unroll
            for (int t = 0; t < 4; ++t) if (t < ntn) { const float dm = mt[t] - mean; q += m2[t] + 256.0f * dm * dm; }
            S[row] = (f32x2v){mean, 1.0f / sqrtf(q / (256.0f * (float)ntn) + eps)};
        }
        asm volatile("s_waitcnt lgkmcnt(0)" ::: "memory"); __builtin_amdgcn_s_barrier(); asm volatile("" ::: "memory");
        return bad;
    }
};
struct EpiLnRes {
    static constexpr bool PERM = false, AFTER_DRAIN = true;
    const float* base; float* out; int ldc; const float* bias; PanelStats st; unsigned poison;
    __device__ __forceinline__ void refuse(size_t i0, size_t stride, int M, int N) const { const float q = __builtin_nanf(""); for (size_t i = i0; i < (size_t)M * N; i += stride) out[(i / N) * ldc + i % N] = q;
        if (i0 == 0) { unsigned expect = 0u; __hip_atomic_compare_exchange_strong(st.tmo + 1, &expect, 0x7f0u, __ATOMIC_RELAXED, __ATOMIC_RELAXED, __HIP_MEMORY_SCOPE_AGENT); __hip_atomic_store(st.tmo, 1u, __ATOMIC_RELAXED, __HIP_MEMORY_SCOPE_AGENT); } }
    __device__ __forceinline__ void fused(f32x4 (&acc)[2][2][4][2], const Unit& u, int wr, int wc, int fr, int fq, PG8_LAS unsigned char* lds, int wid, int lane) const {
        typedef float f32x2v __attribute__((ext_vector_type(2)));
        const PG8_LAS f32x2v* S = (const PG8_LAS f32x2v*)(lds + 8192);
        const int col0 = u.pn * BM + wc * 32 + 4 * fq;
#pragma unroll
        for (int bj = 0; bj < 2; ++bj)
#pragma unroll
            for (int n = 0; n < 2; ++n) { const f32x4 bv = bias ? *(const f32x4*)(bias + col0 + bj * HALF + n * 16) : (f32x4){0.f, 0.f, 0.f, 0.f};
#pragma unroll
                for (int ai = 0; ai < 2; ++ai)
#pragma unroll
                    for (int m = 0; m < 4; ++m) acc[ai][bj][m][n] += bv; }
        const bool bad = st.run(acc, u, wr, wc, fr, fq, lds, wid, lane) || poison != 0u;
        const float qnan = __builtin_nanf("");
#pragma unroll
        for (int ai = 0; ai < 2; ++ai)
#pragma unroll
            for (int m = 0; m < 4; ++m) { const int r = ai * HALF + wr * 64 + m * 16 + fr; const f32x2v sr = S[r]; const size_t off = (size_t)(u.pm * BM + r) * ldc + col0;
#pragma unroll
                for (int bj = 0; bj < 2; ++bj)
#pragma unroll
                    for (int n = 0; n < 2; ++n) { const f32x4 bs = *(const f32x4*)(base + off + bj * HALF + n * 16); f32x4 o = bs + (acc[ai][bj][m][n] - sr.x) * sr.y;
                        if (bad) o = (f32x4){qnan, qnan, qnan, qnan}; *(f32x4*)(out + off + bj * HALF + n * 16) = o; }
                asm volatile("" ::: "memory"); }
    }
};
struct EpiLnResLn {
    static constexpr bool PERM = false, AFTER_DRAIN = true;
    const float* base; float* out; bf16_t* xn; int ldc; const float* bias; PanelStats st1, st2; unsigned poison;
    __device__ __forceinline__ void refuse(size_t i0, size_t stride, int M, int N) const { const float q = __builtin_nanf(""); for (size_t i = i0; i < (size_t)M * N; i += stride) { const size_t o = (i / N) * ldc + i % N; out[o] = q; xn[o] = (bf16_t)0x7fc0u; }
        if (i0 == 0) { unsigned expect = 0u; __hip_atomic_compare_exchange_strong(st1.tmo + 1, &expect, 0x7f0u, __ATOMIC_RELAXED, __ATOMIC_RELAXED, __HIP_MEMORY_SCOPE_AGENT); __hip_atomic_store(st1.tmo, 1u, __ATOMIC_RELAXED, __HIP_MEMORY_SCOPE_AGENT); } }
    __device__ __forceinline__ void fused(f32x4 (&acc)[2][2][4][2], const Unit& u, int wr, int wc, int fr, int fq, PG8_LAS unsigned char* lds, int wid, int lane) const {
        typedef float f32x2v __attribute__((ext_vector_type(2))); typedef unsigned u32x2v __attribute__((ext_vector_type(2)));
        const PG8_LAS f32x2v* S = (const PG8_LAS f32x2v*)(lds + 8192);
        const int col0 = u.pn * BM + wc * 32 + 4 * fq;
#pragma unroll
        for (int bj = 0; bj < 2; ++bj)
#pragma unroll
            for (int n = 0; n < 2; ++n) { const f32x4 bv = bias ? *(const f32x4*)(bias + col0 + bj * HALF + n * 16) : (f32x4){0.f, 0.f, 0.f, 0.f};
#pragma unroll
                for (int ai = 0; ai < 2; ++ai)
#pragma unroll
                    for (int m = 0; m < 4; ++m) acc[ai][bj][m][n] += bv; }
        bool bad = st1.run(acc, u, wr, wc, fr, fq, lds, wid, lane) || poison != 0u;
        const float qnan = __builtin_nanf("");
#pragma unroll
        for (int ai = 0; ai < 2; ++ai)
#pragma unroll
            for (int m = 0; m < 4; ++m) { const int r = ai * HALF + wr * 64 + m * 16 + fr; const f32x2v sr = S[r]; const size_t off = (size_t)(u.pm * BM + r) * ldc + col0;
#pragma unroll
                for (int bj = 0; bj < 2; ++bj)
#pragma unroll
                    for (int n = 0; n < 2; ++n) { const f32x4 bs = *(const f32x4*)(base + off + bj * HALF + n * 16); acc[ai][bj][m][n] = bs + (acc[ai][bj][m][n] - sr.x) * sr.y; }
                asm volatile("" : "+v"(acc[ai][0][m][0]), "+v"(acc[ai][0][m][1]), "+v"(acc[ai][1][m][0]), "+v"(acc[ai][1][m][1]));
                if (m & 1) asm volatile("" ::: "memory"); }
        const bool bad1 = bad;
        bad = st2.run(acc, u, wr, wc, fr, fq, lds, wid, lane) || bad;
#pragma unroll
        for (int ai = 0; ai < 2; ++ai)
#pragma unroll
            for (int m = 0; m < 4; ++m) { const int r = ai * HALF + wr * 64 + m * 16 + fr; const f32x2v sr = S[r]; const size_t off = (size_t)(u.pm * BM + r) * ldc + col0;
#pragma unroll
                for (int bj = 0; bj < 2; ++bj)
#pragma unroll
                    for (int n = 0; n < 2; ++n) { const f32x4 x1 = acc[ai][bj][m][n]; *(f32x4*)(out + off + bj * HALF + n * 16) = bad1 ? (f32x4){qnan, qnan, qnan, qnan} : x1;
                        const f32x4 o = (x1 - sr.x) * sr.y; u32x2v w; w.x = cvt_pk_bf16(o[0], o[1]); w.y = cvt_pk_bf16(o[2], o[3]);
                        if (bad) { w.x = 0x7fc07fc0u; w.y = 0x7fc07fc0u; } *(u32x2v*)(xn + off + bj * HALF + n * 16) = w; }
                asm volatile("" ::: "memory"); }
    }
};

template <class Epi, class Sched, bool STAMP = false>
__device__ __forceinline__ void gemm_phase(PG8_LAS unsigned char* lds, const Gemm g, const Sched& S, const Epi& E, unsigned long long* stamps) {
    const int tid = threadIdx.x, wid = __builtin_amdgcn_readfirstlane(tid >> 6), lane = tid & 63, wr = wid >> 2, wc = wid & 3, fr = lane & 15, fq = lane >> 4;
    const int K = g.K, nt = K / BK;
    int ts_lo = 0, ts_hi = 0, nts = 0; const unsigned long long rt_entry = STAMP ? (unsigned long long)wall_clock64() : 0ull;
#define PG8_STAMP() do { if (STAMP && wid == 0 && nts < 64) { const unsigned long long _c = (unsigned long long)clock64(); \
        ts_lo = (lane == nts) ? (int)(unsigned)_c : ts_lo; ts_hi = (lane == nts) ? (int)(unsigned)(_c >> 32) : ts_hi; ++nts; } } while (0)
    PG8_STAMP();
    unsigned voffA[2], voffB[2];
#pragma unroll
    for (int i = 0; i < 2; ++i) { int R, C; stage_rc(tid * 16 + i * 8192, R, C); const int Rb = Epi::PERM ? ((R & ~31) + perm32(R & 31)) : R;
        voffA[i] = (unsigned)(R * K + C) * 2u; voffB[i] = (unsigned)(Rb * K + C) * 2u; }
    const size_t kstep = (size_t)(BK * 2);
    const size_t hstep = (size_t)HALF * K * 2;
    const size_t tstep = 2 * hstep;
    const unsigned ldsw = (unsigned)wid * 1024u;
    const int aoff = lds_byte(wr * 64 + fr, fq * 8), boff = lds_byte(wc * 32 + fr, fq * 8);
#define PG8_SA(b, h) (((b) * 2 + (h)) * HTB)
#define PG8_SB(b, h) ((4 + (b) * 2 + (h)) * HTB)
#define PG8_STAGE(bufoff, gbase, voff) do { _Pragma("unroll") for (int _i = 0; _i < 2; ++_i) \
        __builtin_amdgcn_global_load_lds((const unsigned*)((const char*)(gbase) + (voff)[_i]), (PG8_LAS unsigned*)(lds + (bufoff) + ldsw + _i * 8192), 16, 0, 0); } while (0)
#define PG8_LDA(dst, b, h) do { _Pragma("unroll") for (int m = 0; m < 4; ++m) _Pragma("unroll") for (int k = 0; k < 2; ++k) dst[m][k] = *(const PG8_LAS bf16x8*)(lds + PG8_SA(b, h) + aoff + m * 2048 + k * 1024); } while (0)
#define PG8_LDB(dst, b, h) do { _Pragma("unroll") for (int n = 0; n < 2; ++n) _Pragma("unroll") for (int k = 0; k < 2; ++k) dst[n][k] = *(const PG8_LAS bf16x8*)(lds + PG8_SB(b, h) + boff + n * 2048 + k * 1024); } while (0)
#define PG8_MMA(ai, bj, At, Bt) do { __builtin_amdgcn_s_setprio(1); _Pragma("unroll") for (int m = 0; m < 4; ++m) _Pragma("unroll") for (int n = 0; n < 2; ++n) _Pragma("unroll") for (int k = 0; k < 2; ++k) \
        acc[ai][bj][m][n] = __builtin_amdgcn_mfma_f32_16x16x32_bf16(Bt[n][k], At[m][k], acc[ai][bj][m][n], 0, 0, 0); __builtin_amdgcn_s_setprio(0); } while (0)
#define PG8_WAIT_V(n) asm volatile("s_waitcnt vmcnt(" #n ")" ::: "memory")
#define PG8_WAIT_L(n) asm volatile("s_waitcnt lgkmcnt(" #n ")" ::: "memory")
#define PG8_BAR __builtin_amdgcn_s_barrier()
#define PG8_SCHED __builtin_amdgcn_sched_barrier(0)
    Unit cur, nxt; int ui = 0;
    if (!S.next(0, cur)) return;
    f32x4 acc[2][2][4][2];
#pragma unroll
    for (int a = 0; a < 2; ++a)
#pragma unroll
        for (int b = 0; b < 2; ++b)
#pragma unroll
            for (int m = 0; m < 4; ++m)
#pragma unroll
                for (int n = 0; n < 2; ++n) acc[a][b][m][n] = (f32x4){0.f, 0.f, 0.f, 0.f};
    bf16x8 At[4][2], B0[2][2], B1[2][2];
    const char* cA = (const char*)g.A + (size_t)cur.pm * tstep; const char* cB = (const char*)g.Bt + (size_t)cur.pn * tstep;
    S.a_ready(cur);
    PG8_STAGE(PG8_SB(0, 0), cB, voffB); PG8_STAGE(PG8_SA(0, 0), cA, voffA); PG8_STAGE(PG8_SB(0, 1), cB + hstep, voffB); PG8_STAGE(PG8_SA(0, 1), cA + hstep, voffA);
    if (wr == 1) PG8_BAR;
    PG8_WAIT_V(4); PG8_BAR;
    PG8_STAGE(PG8_SB(1, 0), cB + kstep, voffB); PG8_STAGE(PG8_SA(1, 0), cA + kstep, voffA); PG8_STAGE(PG8_SB(1, 1), cB + hstep + kstep, voffB);
    PG8_WAIT_V(6); PG8_BAR;
    PG8_STAMP();
    for (;;) {
        const bool has_next = S.next(ui + 1, nxt);
        const char* nA = has_next ? (const char*)g.A + (size_t)nxt.pm * tstep : cA; const char* nB = has_next ? (const char*)g.Bt + (size_t)nxt.pn * tstep : cB;
        for (int t = 0; t < nt; t += 2) {
            const bool last = (t == nt - 2);
            const char* a1 = cA + (size_t)(t + 1) * kstep;
            const char* a2 = last ? nA : cA + (size_t)(t + 2) * kstep; const char* b2 = last ? nB : cB + (size_t)(t + 2) * kstep;
            const char* a3 = a2 + kstep; const char* b3 = b2 + kstep;
            if (last && has_next) S.a_ready(nxt);
            PG8_LDB(B0, 0, 0); PG8_SCHED; PG8_LDA(At, 0, 0); PG8_STAGE(PG8_SA(1, 1), a1 + hstep, voffA);
            PG8_WAIT_L(8); PG8_BAR; PG8_WAIT_L(0); PG8_MMA(0, 0, At, B0); PG8_BAR; PG8_SCHED;
            PG8_LDB(B1, 0, 1); PG8_STAGE(PG8_SB(0, 0), b2, voffB);
            PG8_BAR; PG8_WAIT_L(0); PG8_MMA(0, 1, At, B1); PG8_BAR;
            PG8_LDA(At, 0, 1); PG8_STAGE(PG8_SA(0, 0), a2, voffA);
            PG8_BAR; PG8_WAIT_L(0); PG8_MMA(1, 0, At, B0); PG8_BAR; PG8_SCHED;
            PG8_STAGE(PG8_SB(0, 1), b2 + hstep, voffB);
            PG8_WAIT_V(6); PG8_BAR; PG8_MMA(1, 1, At, B1); PG8_BAR;
            PG8_LDB(B0, 1, 0); PG8_SCHED; PG8_LDA(At, 1, 0); PG8_STAGE(PG8_SA(0, 1), a2 + hstep, voffA);
            PG8_WAIT_L(8); PG8_BAR; PG8_WAIT_L(0); PG8_MMA(0, 0, At, B0); PG8_BAR; PG8_SCHED;
            PG8_LDB(B1, 1, 1); PG8_STAGE(PG8_SB(1, 0), b3, voffB);
            PG8_BAR; PG8_WAIT_L(0); PG8_MMA(0, 1, At, B1); PG8_BAR;
            PG8_LDA(At, 1, 1); PG8_STAGE(PG8_SA(1, 0), a3, voffA);
            PG8_BAR; PG8_WAIT_L(0); PG8_MMA(1, 0, At, B0); PG8_BAR; PG8_SCHED;
            PG8_STAGE(PG8_SB(1, 1), b3 + hstep, voffB);
            PG8_WAIT_V(6); PG8_BAR; PG8_MMA(1, 1, At, B1); PG8_BAR;
        }
        PG8_STAMP();
        if constexpr (!Epi::AFTER_DRAIN) { E(acc, cur, wr, wc, fr, fq); S.done(cur); }
        PG8_STAMP();
        if (!has_next) break;
#pragma unroll
        for (int a = 0; a < 2; ++a)
#pragma unroll
            for (int b = 0; b < 2; ++b)
#pragma unroll
                for (int m = 0; m < 4; ++m)
#pragma unroll
                    for (int n = 0; n < 2; ++n) acc[a][b][m][n] = (f32x4){0.f, 0.f, 0.f, 0.f};
        cur = nxt; cA = nA; cB = nB; ++ui;
    }
    PG8_WAIT_V(0);
    if (wr == 0) PG8_BAR;
    PG8_BAR;
    if constexpr (Epi::AFTER_DRAIN) { E.fused(acc, cur, wr, wc, fr, fq, lds, wid, lane); S.done(cur); }
    PG8_STAMP();
    if (STAMP && wid == 0) { stamps[lane] = lane < nts ? (((unsigned long long)(unsigned)ts_hi << 32) | (unsigned)ts_lo) : 0ull;
        if (lane == 62) stamps[62] = rt_entry; if (lane == 63) stamps[63] = (unsigned long long)wall_clock64(); }
#undef PG8_STAMP
#undef PG8_SA
#undef PG8_SB
#undef PG8_STAGE
#undef PG8_LDA
#undef PG8_LDB
#undef PG8_MMA
#undef PG8_WAIT_V
#undef PG8_WAIT_L
#undef PG8_BAR
#undef PG8_SCHED
}
}
#define XB_TMO      128
#define XB_XCNT(j)  (256  + 64 * (j))
#define XB_XSUB(j)  (1280 + 64 * (j))
#define XB_XGEN(j)  (2304 + 64 * (j))
#define XB_TOP      3328
#define XB_TOPGEN   3392
#define XCD_BAR_WORDS 3456
#define XB_SPIN_CAP (1u << 18)
#define LAS __attribute__((address_space(3)))

__device__ __forceinline__ unsigned xb_ld(unsigned* p)              { return __hip_atomic_load(p, __ATOMIC_RELAXED, __HIP_MEMORY_SCOPE_AGENT); }
__device__ __forceinline__ unsigned xb_add(unsigned* p, unsigned v) { return __hip_atomic_fetch_add(p, v, __ATOMIC_RELAXED, __HIP_MEMORY_SCOPE_AGENT); }
__device__ __forceinline__ unsigned xb_xcc_id() { return (unsigned)__builtin_amdgcn_s_getreg((3 << 11) | 20) & 0xFu; }
#define XB_SPIN(cond, bar) do { unsigned _sp = 0; while (cond) { __builtin_amdgcn_s_sleep(1); \
    if ((++_sp & 255u) == 0u) { if (xb_ld(&(bar)[XB_TMO])) break; if (_sp > XB_SPIN_CAP) { atomicAdd(&(bar)[XB_TMO], 1u); break; } } } } while (0)

struct XcdBarrier {
    unsigned* bar; unsigned x;
    volatile LAS unsigned* st;
};

__device__ __forceinline__ XcdBarrier xcd_barrier_post(unsigned* bar, volatile LAS unsigned* st) {
    XcdBarrier b; b.bar = bar; b.x = xb_xcc_id(); b.st = st;
    if (threadIdx.x == 0) (void)xb_add(&bar[XB_XCNT(b.x)], 1u);
    return b;
}
__device__ __forceinline__ void xcd_barrier_complete(unsigned* bar, unsigned x, unsigned& nloc, unsigned& nx) {
    const unsigned G = gridDim.x * gridDim.y * gridDim.z;
    unsigned sum, cnt, mine, sp = 0u;
    for (;;) {
        sum = 0u; cnt = 0u; mine = 0u;
#pragma unroll
        for (unsigned j = 0; j < 16; ++j) { const unsigned c = xb_ld(&bar[XB_XCNT(j)]); sum += c; cnt += (c > 0u) ? 1u : 0u; mine = (j == x) ? c : mine; }
        if (sum == G) break;
        __builtin_amdgcn_s_sleep(1);
        if ((++sp & 255u) == 0u) { if (xb_ld(&bar[XB_TMO])) break; if (sp > XB_SPIN_CAP) { atomicAdd(&bar[XB_TMO], 1u); break; } }
    }
    nloc = mine > 0u ? mine : 1u; nx = cnt > 0u ? cnt : 1u;
}

__device__ __forceinline__ void xcd_barrier(const XcdBarrier& b) {
    asm volatile("s_waitcnt vmcnt(0)" ::: "memory");
    __syncthreads();
    if (threadIdx.x == 0) {
        unsigned* bar = b.bar;
        __builtin_amdgcn_s_waitcnt(0);
        unsigned nloc = b.st[0], nx = b.st[1];
        if (nloc == 0u) { xcd_barrier_complete(bar, b.x, nloc, nx); b.st[0] = nloc; b.st[1] = nx; }
        const unsigned old = xb_add(&bar[XB_XSUB(b.x)], 1u);
        const unsigned gen = old / nloc;
        if (old + 1u == (gen + 1u) * nloc) {
            __builtin_amdgcn_fence(__ATOMIC_RELEASE, "agent");
            asm volatile("s_waitcnt vmcnt(0)" ::: "memory");
            const unsigned og = xb_add(&bar[XB_TOP], 1u);
            const unsigned tg = og / nx;
            if (og + 1u == (tg + 1u) * nx) xb_add(&bar[XB_TOPGEN], 1u);
            else XB_SPIN(xb_ld(&bar[XB_TOPGEN]) == tg, bar);
            __builtin_amdgcn_fence(__ATOMIC_ACQUIRE, "agent");
            xb_add(&bar[XB_XGEN(b.x)], 1u);
            asm volatile("s_waitcnt vmcnt(0)" ::: "memory");
        } else {
            XB_SPIN(xb_ld(&bar[XB_XGEN(b.x)]) == gen, bar);
            __builtin_amdgcn_fence(__ATOMIC_ACQUIRE, "agent");
            asm volatile("s_waitcnt vmcnt(0)" ::: "memory");
        }
    }
    __syncthreads();
}


#ifndef MK_N_LAUNCHES
#define MK_N_LAUNCHES 1
#endif
#ifndef MK_QTAIL
#define MK_QTAIL 7680
#endif
#ifndef MK_QHEAD
#define MK_QHEAD 12288
#endif
namespace mk {
typedef unsigned short bf16_t;
typedef float f32x4 __attribute__((ext_vector_type(4)));
typedef short bf16x8 __attribute__((ext_vector_type(8)));
typedef short s16x4 __attribute__((ext_vector_type(4)));
typedef unsigned u32x4 __attribute__((ext_vector_type(4)));
typedef unsigned u32x2 __attribute__((ext_vector_type(2)));
typedef float f32x2 __attribute__((ext_vector_type(2)));
constexpr int D = 2048, NTOK_P = 16384, NTOK_S = 256, NTOK = 16640;
constexpr int DIN = 5632, DATT = 1536, DLRU = 512, NH = 12, HD = 128;
constexpr int NEXP = 16384;
constexpr float ALPHA = 1.189207115002721f;
constexpr float LN_EPS = 1e-5f;
constexpr float ATT_SCALE = 0.08838834764831845f;
constexpr float LOG2E = 1.4426950408889634f;
constexpr size_t O_YP = 0, O_YS = 33554432, O_KP = 34078720, O_VP = 59244544, O_CP = 84410368, O_HP = 84422656,
                 O_KS = 84426752, O_VS = 185090048, O_CS = 285753344, O_HS = 285802496, O_END = 285818880;
constexpr size_t WS_CTL = 0;
constexpr size_t WS_XB = 65536;
constexpr size_t WS_WINT = WS_XB + (size_t)NTOK * D * 2;
constexpr size_t WS_WOT = WS_WINT + (size_t)DIN * D * 2;
constexpr size_t WS_WQT = WS_WOT + (size_t)D * D * 2;
constexpr size_t WS_UB = WS_WQT + (size_t)D * D * 2;
constexpr size_t WS_VB = WS_UB + (size_t)NEXP * D * 2;
constexpr size_t WS_QF = WS_VB + (size_t)NEXP * D * 2;
constexpr size_t WS_XR = WS_QF + (size_t)NTOK * DATT * 4;
constexpr size_t WS_GATE = WS_XR + (size_t)NTOK * DLRU * 4;
constexpr size_t WS_AR = WS_GATE + (size_t)NTOK * DLRU * 4;
constexpr size_t WS_PRE1 = WS_AR + (size_t)NTOK * D * 2;
constexpr size_t WS_X1F = WS_PRE1 + (size_t)NTOK * D * 4;
constexpr size_t WS_X1B = WS_X1F + (size_t)NTOK * D * 4;
constexpr size_t WS_QP = WS_X1B + (size_t)NTOK * D * 2;
constexpr size_t WS_EIDX = WS_QP + (size_t)NTOK * D * 4;
constexpr size_t WS_GW = WS_EIDX + (size_t)NTOK * 128 * 4;
constexpr size_t WS_SU = WS_GW + (size_t)NTOK * 128 * 4;
constexpr size_t WS_SV = WS_SU + (size_t)NEXP * 4;
constexpr size_t WS_SX = WS_SV + (size_t)NEXP * 4;
constexpr size_t WS_X1Q = WS_SX + (size_t)NTOK * 4;
constexpr size_t WS_SKB = WS_X1Q + (size_t)NTOK * D;
constexpr size_t WS_QB = WS_SKB + (size_t)8 * 2 * 128 * 128 * 2;
constexpr size_t WS_KB = WS_QB + (size_t)NTOK * DATT * 2;
constexpr size_t WS_VB16 = WS_KB + (size_t)NTOK_P * DATT * 2;
constexpr size_t WS_PO = WS_VB16 + (size_t)NTOK_P * DATT * 2;
constexpr size_t WS_PM = WS_PO + (size_t)2 * NTOK_P * DATT * 2;
constexpr size_t WS_PL = WS_PM + (size_t)2 * NTOK_P * NH * 4;
constexpr size_t WS_R0 = WS_PL + (size_t)2 * NTOK_P * NH * 4;
constexpr size_t WS_R1 = WS_R0 + (size_t)NTOK_P * DLRU * 4;
constexpr size_t WS_HE = WS_R1 + (size_t)NTOK_P * DLRU * 4;
constexpr size_t WS_AE = WS_HE + (size_t)8 * 32 * 512 * 4;
constexpr size_t WS_LW = WS_AE + (size_t)8 * 32 * 512 * 4;
constexpr size_t WS_PS = WS_LW + (size_t)2 * 8 * 64 * 64 * 2;
constexpr size_t WS_END = WS_PS + (size_t)32 * 12 * 9 * 8 * 130 * 4;

constexpr int NTHREADS = 512;
constexpr int LDS_BYTES = 148480;
constexpr int MISC_OFF = 147456;

struct Params {
    const float* x_prompt; const float* x_sample; const float* cache_k; const float* cache_v; const float* state_conv; const float* state_h;
    const float* w_in; const float* conv_w; const float* conv_b; const float* lru_w_a; const float* lru_b_a; const float* lru_w_x; const float* lru_b_x;
    const float* lru_lambda; const float* w_out; const float* ln1_g; const float* ln1_b; const float* w_query; const float* sub_keys;
    const float* peer_u; const float* peer_v; const float* ln2_g; const float* ln2_b;
    float* out; unsigned char* ws; int ph_lo, ph_hi;
};

__device__ __forceinline__ unsigned f2bf(float f) { unsigned u = __float_as_uint(f); u += 0x7fffu + ((u >> 16) & 1u); return u >> 16; }
__device__ __forceinline__ unsigned pack2(float a, float b) { return f2bf(a) | (f2bf(b) << 16); }
__device__ __forceinline__ float bflo(unsigned w) { return __uint_as_float(w << 16); }
__device__ __forceinline__ float bfhi(unsigned w) { return __uint_as_float(w & 0xffff0000u); }
__device__ __forceinline__ float4 ntload4(const float* p) { const f32x4 v = __builtin_nontemporal_load((const f32x4*)p); return make_float4(v[0], v[1], v[2], v[3]); }
__device__ __forceinline__ void ntstore4(float* p, float4 v) { __builtin_nontemporal_store((f32x4){v.x, v.y, v.z, v.w}, (f32x4*)p); }
__device__ __forceinline__ float wave_sum(float v) {
#pragma unroll
    for (int o = 32; o >= 1; o >>= 1) v += __shfl_xor(v, o);
    return v;
}
__device__ __forceinline__ float wave_max(float v) {
#pragma unroll
    for (int o = 32; o >= 1; o >>= 1) v = fmaxf(v, __shfl_xor(v, o));
    return v;
}
__device__ __forceinline__ float gelu_exact(float v) { return 0.5f * v * (1.0f + erff(v * 0.7071067811865476f)); }
__device__ __forceinline__ float gelu_as(float v) {
    const float av = fabsf(v), t = __builtin_amdgcn_rcpf(av * 0.2316418882f + 1.0f);
    float q = t * 0.5307027145f + (-0.7265760135f); q = q * t + 0.7107068705f; q = q * t + (-0.142248368f); q = q * t + 0.127414796f; q = q * t;
    const float e = __builtin_amdgcn_exp2f((v * v) * (-0.72134752044f));
    const float m = v * (q * e);
    return v < 0.f ? m : v - m;
}
__device__ __forceinline__ float sigmoidf(float v) { return 1.0f / (1.0f + expf(-v)); }
__device__ __forceinline__ float readlane_f(float v, int l) { return __int_as_float(__builtin_amdgcn_readlane(__float_as_int(v), l)); }

__device__ __forceinline__ void convert_flat(const float* src, bf16_t* dst, size_t n8, size_t gtid, size_t gstride) {
    for (size_t i = gtid; i < n8; i += gstride) {
        const float4 a = ((const float4*)src)[2 * i], b = ((const float4*)src)[2 * i + 1];
        uint4 w; w.x = pack2(a.x, a.y); w.y = pack2(a.z, a.w); w.z = pack2(b.x, b.y); w.w = pack2(b.z, b.w);
        ((uint4*)dst)[i] = w;
    }
}
__device__ __forceinline__ void transpose_convert(const float* src, bf16_t* dst, int K, int N, LAS float* tile) {
    const int tid = threadIdx.x, ntn = N / 64, ntiles = (K / 64) * ntn;
    for (int tl = blockIdx.x; tl < ntiles; tl += gridDim.x) {
        const int kt = tl / ntn, nt = tl - kt * ntn;
#pragma unroll
        for (int i = 0; i < 8; ++i) { const int r = (tid >> 6) + 8 * i, c = tid & 63; tile[r * 65 + c] = src[(size_t)(kt * 64 + r) * N + nt * 64 + c]; }
        __syncthreads();
#pragma unroll
        for (int i = 0; i < 4; ++i) { const int n = (tid >> 5) + 16 * i, k0 = 2 * (tid & 31);
            const unsigned v = pack2(tile[k0 * 65 + n], tile[(k0 + 1) * 65 + n]);
            *(unsigned*)(dst + (size_t)(nt * 64 + n) * K + kt * 64 + k0) = v; }
        __syncthreads();
    }
}
constexpr int TROW = 1152;
__device__ __forceinline__ void quant_row_load(const Params& P, int it, int lane, float4 (&v)[8]) {
    const bool isv = it >= NEXP; const int row = isv ? it - NEXP : it;
    const float* src = (isv ? P.peer_v : P.peer_u) + (size_t)row * D;
#pragma unroll
    for (int j = 0; j < 2; ++j)
#pragma unroll
        for (int i = 0; i < 4; ++i) v[j * 4 + i] = *(const float4*)(src + j * 1024 + lane * 16 + i * 4);
}
__device__ __forceinline__ void quant_row_store(const Params& P, int it, int lane, const float4 (&v)[8]) {
    const bool isv = it >= NEXP; const int row = isv ? it - NEXP : it;
    float cm[2];
#pragma unroll
    for (int j = 0; j < 2; ++j) { float am = 0.f;
#pragma unroll
        for (int i = 0; i < 4; ++i) { const float4 t = v[j * 4 + i]; am = fmaxf(am, fmaxf(fmaxf(fabsf(t.x), fabsf(t.y)), fmaxf(fabsf(t.z), fabsf(t.w)))); }
        cm[j] = am; }
    float rm = wave_max(fmaxf(cm[0], cm[1])); if (rm == 0.f) rm = 1.f;
    unsigned char* dst = P.ws + (isv ? WS_VB : WS_UB) + (size_t)row * TROW;
    u32x4 w; unsigned sqp = 0u;
#pragma unroll
    for (int j = 0; j < 2; ++j) {
        int sq = (int)ceilf(cm[j] / rm * 255.0f); sq = sq < 1 ? 1 : (sq > 255 ? 255 : sq);
        sqp |= (unsigned)sq << (8 * j);
        const float inv = (255.0f * 7.0f) / (rm * (float)sq);
#pragma unroll
        for (int hh = 0; hh < 2; ++hh) { unsigned dw = 0u;
#pragma unroll
            for (int e = 0; e < 8; ++e) { const float4 t = v[j * 4 + hh * 2 + (e >> 2)]; const float x = (e & 3) == 0 ? t.x : ((e & 3) == 1 ? t.y : ((e & 3) == 2 ? t.z : t.w));
                int n = (int)rintf(x * inv); n = n < -7 ? -7 : (n > 7 ? 7 : n); dw |= (unsigned)(isv ? n + 8 : (n & 15)) << (4 * e); }
            w[j * 2 + hh] = dw; }
    }
    *(u32x4*)(dst + lane * 16) = w;
    *(unsigned short*)(dst + 1024 + lane * 2) = (unsigned short)sqp;
    if (lane == 0) ((float*)(P.ws + (isv ? WS_SV : WS_SU)))[row] = rm * (1.0f / (255.0f * 7.0f));
}
__device__ __forceinline__ void quant_tables(const Params& P, int gw, int nw, int lo, int hi) {
    const int lane = threadIdx.x & 63;
    float4 va[8], vb[8];
    int it = lo + gw;
    if (it < hi) quant_row_load(P, it, lane, va);
#pragma unroll 1
    for (; it < hi; it += 2 * nw) {
        if (it + nw < hi) quant_row_load(P, it + nw, lane, vb);
        quant_row_store(P, it, lane, va);
        if (it + nw < hi) {
            if (it + 2 * nw < hi) quant_row_load(P, it + 2 * nw, lane, va);
            quant_row_store(P, it + nw, lane, vb);
        }
    }
}
__device__ __forceinline__ void phase_prologue(const Params& P, LAS unsigned char* lds) {
    const size_t gtid = (size_t)blockIdx.x * NTHREADS + threadIdx.x, gstride = (size_t)gridDim.x * NTHREADS;
    unsigned char* ws = P.ws;
    convert_flat(P.x_prompt, (bf16_t*)(ws + WS_XB), (size_t)NTOK_P * D / 8, gtid, gstride);
    convert_flat(P.x_sample, (bf16_t*)(ws + WS_XB) + (size_t)NTOK_P * D, (size_t)NTOK_S * D / 8, gtid, gstride);
    convert_flat(P.sub_keys, (bf16_t*)(ws + WS_SKB), (size_t)8 * 2 * 128 * 128 / 8, gtid, gstride);
    for (size_t i = gtid; i < (size_t)2 * 8 * 64 * 64; i += gstride) {
        const int c = (int)(i & 63), d = (int)((i >> 6) & 63), n = (int)((i >> 12) & 7), m = (int)(i >> 15);
        ((bf16_t*)(ws + WS_LW))[i] = (bf16_t)f2bf((m ? P.lru_w_x : P.lru_w_a)[(n * 64 + c) * 64 + d]); }
    transpose_convert(P.w_in, (bf16_t*)(ws + WS_WINT), D, DIN, (LAS float*)lds);
    transpose_convert(P.w_out, (bf16_t*)(ws + WS_WOT), D, D, (LAS float*)lds);
    transpose_convert(P.w_query, (bf16_t*)(ws + WS_WQT), D, D, (LAS float*)lds);
}

struct EpiProj {
    static constexpr bool PERM = true, AFTER_DRAIN = false;
    float* out; bf16_t* XR; bf16_t* GATE; bf16_t* QB; bf16_t* KB; bf16_t* VB16;
    __device__ __forceinline__ void operator()(const f32x4 (&acc)[2][2][4][2], const pg8::Unit& u, int wr, int wc, int fr, int fq) const {
        const int pn = u.pn; const int coff = wc * 32 + 8 * fq;
#pragma unroll
        for (int ai = 0; ai < 2; ++ai)
#pragma unroll
            for (int m = 0; m < 4; ++m) {
                const int row = u.pm * 256 + ai * 128 + wr * 64 + m * 16 + fr;
                const bool prompt = row < NTOK_P;
                float* rowp = nullptr; bf16_t* rowb = nullptr; float bsc = 1.0f;
                if (pn < 6) { rowb = QB + (size_t)row * DATT + pn * 256; bsc = ATT_SCALE * LOG2E; }
                else if (pn < 18) {
                    const int isv = pn >= 12; const int c0 = (pn - (isv ? 12 : 6)) * 256;
                    if (prompt) { rowp = out + (isv ? O_VP : O_KP) + (size_t)row * DATT + c0; rowb = (isv ? VB16 : KB) + (size_t)row * DATT + c0; }
                    else { const int rr = row - NTOK_P, b = rr >> 3, t = rr & 7; rowp = out + (isv ? O_VS : O_KS) + ((size_t)b * 2048 + 2040 + t) * DATT + c0; }
                } else if (pn < 20) rowb = XR + (size_t)row * DLRU + (pn - 18) * 256;
                else rowb = GATE + (size_t)row * DLRU + (pn - 20) * 256;
#pragma unroll
                for (int bj = 0; bj < 2; ++bj) {
                    const f32x4 v0 = acc[ai][bj][m][0], v1 = acc[ai][bj][m][1];
                    if (rowp) { *(f32x4*)(rowp + coff + bj * 128) = v0; *(f32x4*)(rowp + coff + bj * 128 + 4) = v1; }
                    if (rowb) { u32x4 w; w.x = pg8::cvt_pk_bf16(v0[0] * bsc, v0[1] * bsc); w.y = pg8::cvt_pk_bf16(v0[2] * bsc, v0[3] * bsc); w.z = pg8::cvt_pk_bf16(v1[0] * bsc, v1[1] * bsc); w.w = pg8::cvt_pk_bf16(v1[2] * bsc, v1[3] * bsc);
                        *(u32x4*)(rowb + coff + bj * 128) = w; }
                }
            }
    }
};
struct EpiOut {
    static constexpr bool PERM = true, AFTER_DRAIN = false;
    const bf16_t* xb; bf16_t* pre;
    __device__ __forceinline__ void operator()(const f32x4 (&acc)[2][2][4][2], const pg8::Unit& u, int wr, int wc, int fr, int fq) const {
        const int col0 = u.pn * 256 + wc * 32 + 8 * fq;
        u32x4 xv[2][4][2];
#pragma unroll
        for (int ai = 0; ai < 2; ++ai)
#pragma unroll
            for (int m = 0; m < 4; ++m) { const int row = u.pm * 256 + ai * 128 + wr * 64 + m * 16 + fr;
#pragma unroll
                for (int bj = 0; bj < 2; ++bj) xv[ai][m][bj] = *(const u32x4*)(xb + (size_t)row * D + col0 + bj * 128); }
#pragma unroll
        for (int ai = 0; ai < 2; ++ai)
#pragma unroll
            for (int m = 0; m < 4; ++m) {
                const int row = u.pm * 256 + ai * 128 + wr * 64 + m * 16 + fr;
                bf16_t* pr = pre + (size_t)row * D + col0;
#pragma unroll
                for (int bj = 0; bj < 2; ++bj) {
                    const u32x4 x = xv[ai][m][bj]; const f32x4 v0 = acc[ai][bj][m][0], v1 = acc[ai][bj][m][1];
                    u32x4 w;
                    w.x = pg8::cvt_pk_bf16(ALPHA * bflo(x.x) + v0[0], ALPHA * bfhi(x.x) + v0[1]); w.y = pg8::cvt_pk_bf16(ALPHA * bflo(x.y) + v0[2], ALPHA * bfhi(x.y) + v0[3]);
                    w.z = pg8::cvt_pk_bf16(ALPHA * bflo(x.z) + v1[0], ALPHA * bfhi(x.z) + v1[1]); w.w = pg8::cvt_pk_bf16(ALPHA * bflo(x.w) + v1[2], ALPHA * bfhi(x.w) + v1[3]);
                    *(u32x4*)(pr + bj * 128) = w;
                }
            }
    }
};
struct EpiPlain {
    static constexpr bool PERM = false, AFTER_DRAIN = false;
    float* C; int ldc;
    __device__ __forceinline__ void operator()(const f32x4 (&acc)[2][2][4][2], const pg8::Unit& u, int wr, int wc, int fr, int fq) const {
        const int col0 = u.pn * 256 + wc * 32 + 4 * fq;
#pragma unroll
        for (int ai = 0; ai < 2; ++ai)
#pragma unroll
            for (int m = 0; m < 4; ++m) {
                const int row = u.pm * 256 + ai * 128 + wr * 64 + m * 16 + fr;
                float* pr = C + (size_t)row * ldc + col0;
#pragma unroll
                for (int bj = 0; bj < 2; ++bj)
#pragma unroll
                    for (int n = 0; n < 2; ++n) *(f32x4*)(pr + bj * 128 + n * 16) = acc[ai][bj][m][n];
            }
    }
};

struct EpiBf16Plain {
    static constexpr bool PERM = true, AFTER_DRAIN = false;
    bf16_t* C; int ldc;
    __device__ __forceinline__ void operator()(const f32x4 (&acc)[2][2][4][2], const pg8::Unit& u, int wr, int wc, int fr, int fq) const {
        const int col0 = u.pn * 256 + wc * 32 + 8 * fq;
#pragma unroll
        for (int ai = 0; ai < 2; ++ai)
#pragma unroll
            for (int m = 0; m < 4; ++m) {
                const int row = u.pm * 256 + ai * 128 + wr * 64 + m * 16 + fr;
                bf16_t* pr = C + (size_t)row * ldc + col0;
#pragma unroll
                for (int bj = 0; bj < 2; ++bj) { const f32x4 v0 = acc[ai][bj][m][0], v1 = acc[ai][bj][m][1]; u32x4 w;
                    w.x = pg8::cvt_pk_bf16(v0[0], v0[1]); w.y = pg8::cvt_pk_bf16(v0[2], v0[3]); w.z = pg8::cvt_pk_bf16(v1[0], v1[1]); w.w = pg8::cvt_pk_bf16(v1[2], v1[3]);
                    *(u32x4*)(pr + bj * 128) = w; }
            }
    }
};

template <int MODE>
__device__ __forceinline__ void sample_rows_gemm(const Params& P, const bf16_t* A, const bf16_t* Wt, LAS unsigned char* lds) {
    const int tid = threadIdx.x, lane = tid & 63, w = __builtin_amdgcn_readfirstlane(tid >> 6);
    const int c = lane & 15, g = lane >> 4;
    for (int tile = blockIdx.x; tile < 256; tile += gridDim.x) {
        const int tg = tile & 7, cg = tile >> 3;
        const int k0 = 256 * w;
        const bf16_t* wp = Wt + (size_t)(64 * cg + c) * D + k0 + 8 * g;
        const bf16_t* xp = A + (size_t)(NTOK_P + 32 * tg + c) * D + k0 + 8 * g;
        f32x4 acc[4][2];
#pragma unroll
        for (int ct = 0; ct < 4; ++ct) { acc[ct][0] = (f32x4){0.f, 0.f, 0.f, 0.f}; acc[ct][1] = (f32x4){0.f, 0.f, 0.f, 0.f}; }
        bf16x8 wf[8][4], xf[8][2];
#pragma unroll
        for (int ks = 0; ks < 8; ++ks) {
#pragma unroll
            for (int tt = 0; tt < 2; ++tt) xf[ks][tt] = *(const bf16x8*)(xp + (size_t)(16 * tt) * D + 32 * ks);
#pragma unroll
            for (int ct = 0; ct < 4; ++ct) wf[ks][ct] = *(const bf16x8*)(wp + (size_t)(16 * ct) * D + 32 * ks);
        }
        __builtin_amdgcn_sched_barrier(0);
#pragma unroll
        for (int ks = 0; ks < 8; ++ks)
#pragma unroll
            for (int ct = 0; ct < 4; ++ct)
#pragma unroll
                for (int tt = 0; tt < 2; ++tt) acc[ct][tt] = __builtin_amdgcn_mfma_f32_16x16x32_bf16(wf[ks][ct], xf[ks][tt], acc[ct][tt], 0, 0, 0);
        LAS float* part = (LAS float*)lds;
#pragma unroll
        for (int ct = 0; ct < 4; ++ct)
#pragma unroll
            for (int tt = 0; tt < 2; ++tt) *(LAS f32x4*)(part + ((w * 32 + 16 * tt + c) * 64 + 16 * ct + 4 * g)) = acc[ct][tt];
        __syncthreads();
        {
            const int tok = tid >> 4, c4 = (tid & 15) * 4;
            f32x4 sum = {0.f, 0.f, 0.f, 0.f};
#pragma unroll
            for (int ww = 0; ww < 8; ++ww) sum += *(const LAS f32x4*)(part + ((ww * 32 + tok) * 64 + c4));
            const int row = NTOK_P + 32 * tg + tok, col = 64 * cg + c4;
            if (MODE == 0) { const f32x4 xv = *(const f32x4*)(P.x_sample + (size_t)(row - NTOK_P) * D + col); const f32x4 r = xv * ALPHA + sum; u32x2 wv; wv.x = pg8::cvt_pk_bf16(r[0], r[1]); wv.y = pg8::cvt_pk_bf16(r[2], r[3]); *(u32x2*)((bf16_t*)(P.ws + WS_PRE1) + (size_t)row * D + col) = wv; }
            else { u32x2 wv; wv.x = pg8::cvt_pk_bf16(sum[0], sum[1]); wv.y = pg8::cvt_pk_bf16(sum[2], sum[3]); *(u32x2*)((bf16_t*)(P.ws + WS_QP) + (size_t)row * D + col) = wv; }
        }
        __syncthreads();
    }
}

constexpr int KVS = 288, VOFF = 73728;
struct AttnKV { u32x4 k[8], v[8]; };
struct AttnId { int p, b, h, r, c; };
__device__ __forceinline__ void attn_fetch(const Params& P, const AttnId& u, AttnKV& R) {
    const int tid = threadIdx.x; const int dil = 1 << (2 * u.p);
    const bf16_t* Kb = (const bf16_t*)(P.ws + WS_KB); const bf16_t* Vb = (const bf16_t*)(P.ws + WS_VB16);
    const size_t tok0 = (size_t)u.b * 2048; const int j0 = 128 * u.c - 128, rho0 = (u.c == 0) ? 128 : 0;
#pragma unroll
    for (int it = 0; it < 8; ++it) {
        const int rho = it * 32 + (tid >> 4), ch = tid & 15;
        if (rho >= rho0) {
            const size_t tok = tok0 + (size_t)((j0 + rho) * dil + u.r);
            R.k[it] = *(const u32x4*)(Kb + tok * DATT + u.h * HD + ch * 8);
            R.v[it] = *(const u32x4*)(Vb + tok * DATT + u.h * HD + ch * 8);
        }
    }
}
__device__ __forceinline__ void attn_commit(const AttnId& u, const AttnKV& R, LAS unsigned char* lds) {
    const int tid = threadIdx.x; const int rho0 = (u.c == 0) ? 128 : 0;
#pragma unroll
    for (int it = 0; it < 8; ++it) {
        const int rho = it * 32 + (tid >> 4), ch = tid & 15;
        if (rho >= rho0) { *(LAS u32x4*)(lds + rho * KVS + ch * 16) = R.k[it]; *(LAS u32x4*)(lds + VOFF + rho * KVS + ch * 16) = R.v[it]; }
    }
}
template <int MODE>
__device__ __forceinline__ void attn_unit(const Params& P, const AttnId& uid, AttnKV& R, bool has_next, const AttnId& nid, LAS unsigned char* lds) {
    const int tid = threadIdx.x, lane = tid & 63, w = __builtin_amdgcn_readfirstlane(tid >> 6);
    const int p = uid.p, b = uid.b, h = uid.h, r = uid.r, c = uid.c;
    const int dil = 1 << (2 * p);
    const bf16_t* Qb = (const bf16_t*)(P.ws + WS_QB);
    const size_t tok0 = (size_t)b * 2048;
    attn_commit(uid, R, lds);
    const int cq = lane & 15, g = lane >> 4;
    const int iq = 128 * c + 16 * w + cq;
    const size_t qtok = tok0 + (size_t)(iq * dil + r);
    bf16x8 qf[4];
#pragma unroll
    for (int ks = 0; ks < 4; ++ks) qf[ks] = *(const bf16x8*)(Qb + qtok * DATT + h * HD + 32 * ks + 8 * g);
    __syncthreads();
#pragma unroll
    for (int ks = 0; ks < 4; ++ks) asm volatile("" : "+v"(qf[ks]));
    if (has_next) attn_fetch(P, nid, R);
    const int ktmin = (8 - w - 8 * c) > 0 ? (8 - w - 8 * c) : 0;
    const float slope2 = exp2f(-8.0f * (float)(h + 1) / 12.0f) * LOG2E * (float)dil;
    f32x4 s[9]; float m = -INFINITY;
#pragma unroll
    for (int kt = 0; kt < 9; ++kt) {
        if (kt >= ktmin) {
            f32x4 acc = {0.f, 0.f, 0.f, 0.f};
#pragma unroll
            for (int ks = 0; ks < 4; ++ks) { const bf16x8 kf = *(const LAS bf16x8*)(lds + (16 * w + 16 * kt + cq) * KVS + (32 * ks + 8 * g) * 2); acc = __builtin_amdgcn_mfma_f32_16x16x32_bf16(kf, qf[ks], acc, 0, 0, 0); }
#pragma unroll
            for (int ii = 0; ii < 4; ++ii) { const int dist = cq + 128 - 16 * kt - 4 * g - ii; float v = acc[ii] - slope2 * (float)dist;
                if (kt == 0 && dist > 128) v = -INFINITY; if (kt == 8 && dist < 0) v = -INFINITY; acc[ii] = v; m = fmaxf(m, v); }
            s[kt] = acc;
        } else s[kt] = (f32x4){-INFINITY, -INFINITY, -INFINITY, -INFINITY};
    }
    m = fmaxf(m, __shfl_xor(m, 16)); m = fmaxf(m, __shfl_xor(m, 32));
    float l = 0.f;
#pragma unroll
    for (int kt = 0; kt < 9; ++kt)
#pragma unroll
        for (int ii = 0; ii < 4; ++ii) { const float pp = exp2f(s[kt][ii] - m); s[kt][ii] = pp; l += pp; }
    l += __shfl_xor(l, 16); l += __shfl_xor(l, 32);
    f32x4 o[8];
#pragma unroll
    for (int dt = 0; dt < 8; ++dt) o[dt] = (f32x4){0.f, 0.f, 0.f, 0.f};
#pragma unroll
    for (int kk = 0; kk < 5; ++kk) {
        const int T0 = 2 * kk, T1 = 2 * kk + 1;
        if (T1 >= ktmin || T0 == 8) {
            u32x4 pw; pw.x = pg8::cvt_pk_bf16(s[T0][0], s[T0][1]); pw.y = pg8::cvt_pk_bf16(s[T0][2], s[T0][3]);
            if (T1 <= 8) { pw.z = pg8::cvt_pk_bf16(s[T1 <= 8 ? T1 : 8][0], s[T1 <= 8 ? T1 : 8][1]); pw.w = pg8::cvt_pk_bf16(s[T1 <= 8 ? T1 : 8][2], s[T1 <= 8 ? T1 : 8][3]); } else { pw.z = 0u; pw.w = 0u; }
            const bf16x8 pf = __builtin_bit_cast(bf16x8, pw);
            const int rT0 = (T0 >= ktmin) ? T0 : 8, rT1 = (T1 <= 8 && T1 >= ktmin) ? T1 : 8;
            const int a0 = VOFF + (16 * w + 16 * rT0 + 4 * g + (cq >> 2)) * KVS + 8 * (cq & 3);
            const int a1 = VOFF + (16 * w + 16 * rT1 + 4 * g + (cq >> 2)) * KVS + 8 * (cq & 3);
#pragma unroll
            for (int dt = 0; dt < 8; ++dt) {
                const s16x4 v0 = __builtin_amdgcn_ds_read_tr16_b64_v4i16((LAS s16x4*)(lds + a0 + dt * 32));
                const s16x4 v1 = __builtin_amdgcn_ds_read_tr16_b64_v4i16((LAS s16x4*)(lds + a1 + dt * 32));
                const bf16x8 vf = {v0[0], v0[1], v0[2], v0[3], v1[0], v1[1], v1[2], v1[3]};
                o[dt] = __builtin_amdgcn_mfma_f32_16x16x32_bf16(vf, pf, o[dt], 0, 0, 0);
            }
        }
    }
    const float inv = 1.0f / l;
    if (MODE == 0) {
        bf16_t* po = (bf16_t*)(P.ws + WS_PO) + ((size_t)p * NTOK_P + qtok) * DATT + h * HD + 4 * g;
#pragma unroll
        for (int dt = 0; dt < 8; ++dt) { u32x2 wv; wv.x = pg8::cvt_pk_bf16(o[dt][0] * inv, o[dt][1] * inv); wv.y = pg8::cvt_pk_bf16(o[dt][2] * inv, o[dt][3] * inv); *(u32x2*)(po + 16 * dt) = wv; }
        if (g == 0) { ((float*)(P.ws + WS_PM))[((size_t)p * NTOK_P + qtok) * NH + h] = m; ((float*)(P.ws + WS_PL))[((size_t)p * NTOK_P + qtok) * NH + h] = l; }
    } else {
        const float* PM = (const float*)(P.ws + WS_PM); const float* PL = (const float*)(P.ws + WS_PL);
        const float m0 = PM[qtok * NH + h], l0 = PL[qtok * NH + h], m1 = PM[((size_t)NTOK_P + qtok) * NH + h], l1 = PL[((size_t)NTOK_P + qtok) * NH + h];
        const float M = fmaxf(m, fmaxf(m0, m1));
        const float w2 = exp2f(m - M), w0 = exp2f(m0 - M) * l0, w1 = exp2f(m1 - M) * l1;
        const float rden = 1.0f / (w2 * l + w0 + w1);
        const bf16_t* p0 = (const bf16_t*)(P.ws + WS_PO) + qtok * DATT + h * HD + 4 * g;
        const bf16_t* p1 = p0 + (size_t)NTOK_P * DATT;
        bf16_t* ar = (bf16_t*)(P.ws + WS_AR) + qtok * D + h * HD + 4 * g;
        u32x2 q0[8], q1[8];
#pragma unroll
        for (int dt = 0; dt < 8; ++dt) { q0[dt] = *(const u32x2*)(p0 + 16 * dt); q1[dt] = *(const u32x2*)(p1 + 16 * dt); }
#pragma unroll
        for (int dt = 0; dt < 8; ++dt) {
            const u32x2 x0 = q0[dt], x1 = q1[dt];
            const float r0 = (w2 * o[dt][0] + w0 * bflo(x0.x) + w1 * bflo(x1.x)) * rden, r1 = (w2 * o[dt][1] + w0 * bfhi(x0.x) + w1 * bfhi(x1.x)) * rden;
            const float r2 = (w2 * o[dt][2] + w0 * bflo(x0.y) + w1 * bflo(x1.y)) * rden, r3 = (w2 * o[dt][3] + w0 * bfhi(x0.y) + w1 * bfhi(x1.y)) * rden;
            u32x2 wv; wv.x = pg8::cvt_pk_bf16(r0, r1); wv.y = pg8::cvt_pk_bf16(r2, r3); *(u32x2*)(ar + 16 * dt) = wv;
        }
    }
    __syncthreads();
}

struct SampPre { f32x4 k[4], v[4]; };
__device__ __forceinline__ void samp_prefetch(const Params& P, int b, int h, int k, SampPre& R) {
    const int tid = threadIdx.x;
    const size_t so = ((size_t)(b * 2048 + 256 * k + (tid >> 5))) * DATT + h * HD + (tid & 31) * 4;
#pragma unroll
    for (int it = 0; it < 4; ++it) { R.k[it] = *(const f32x4*)(P.cache_k + so + (size_t)it * 16 * DATT); R.v[it] = *(const f32x4*)(P.cache_v + so + (size_t)it * 16 * DATT); }
}
__device__ __forceinline__ void samp_load4(const float* ck, const float* cv, int s0, f32x4 (&kk)[4], f32x4 (&vv)[4]) {
#pragma unroll
    for (int j = 0; j < 4; ++j) { kk[j] = *(const f32x4*)(ck + (size_t)(s0 + j) * 16 * DATT); vv[j] = *(const f32x4*)(cv + (size_t)(s0 + j) * 16 * DATT); }
}
__device__ __forceinline__ void samp_put4(float* ok, float* ov, float* ok0, float* ov0, LAS unsigned char* lk, int s0, const f32x4 (&kk)[4], const f32x4 (&vv)[4]) {
#pragma unroll
    for (int j = 0; j < 4; ++j) {
        const int it = s0 + j; const f32x4 kf = kk[j], vf = vv[j];
        if (it == 0) { *(f32x4*)ok0 = kf; *(f32x4*)ov0 = vf; } else { *(f32x4*)(ok + (size_t)it * 16 * DATT) = kf; *(f32x4*)(ov + (size_t)it * 16 * DATT) = vf; }
        u32x2 kw, vw; kw.x = pg8::cvt_pk_bf16(kf[0], kf[1]); kw.y = pg8::cvt_pk_bf16(kf[2], kf[3]); vw.x = pg8::cvt_pk_bf16(vf[0], vf[1]); vw.y = pg8::cvt_pk_bf16(vf[2], vf[3]);
        *(LAS u32x2*)(lk + it * 16 * KVS) = kw; *(LAS u32x2*)(lk + VOFF + it * 16 * KVS) = vw;
    }
}
template <bool LAST>
__device__ __forceinline__ void samp_unit(const Params& P, int b, int h, int k, LAS unsigned char* lds, SampPre& R, int nb, int nh, int nk) {
    const int tid = threadIdx.x, lane = tid & 63, w = __builtin_amdgcn_readfirstlane(tid >> 6);
    const int cq = lane & 15, g = lane >> 4;
    const int t = cq & 7;
    bf16x8 qf[4];
    { const bf16_t* Qb = (const bf16_t*)(P.ws + WS_QB) + ((size_t)(NTOK_P + b * 8 + t)) * DATT + h * HD + 8 * g;
#pragma unroll
      for (int ks = 0; ks < 4; ++ks) qf[ks] = *(const bf16x8*)(Qb + 32 * ks); }
    if (!LAST) {
        const int r5 = tid >> 5, ch4 = tid & 31;
        const size_t so = ((size_t)(b * 2048 + 256 * k + r5)) * DATT + h * HD + ch4 * 4;
        const float* ck = P.cache_k + so; const float* cv = P.cache_v + so;
        float* ok = P.out + O_KS + so - (size_t)8 * DATT; float* ov = P.out + O_VS + so - (size_t)8 * DATT;
        const bool first_ok = (256 * k + r5) >= 8;
        float* junk = (float*)(P.ws + WS_QF) + lane * 4;
        float* ok0 = first_ok ? ok : junk; float* ov0 = first_ok ? ov : junk + 256;
        LAS unsigned char* lk = lds + r5 * KVS + ch4 * 8;
        f32x4 ka[4], va[4], kb[4], vb[4];
        samp_load4(ck, cv, 4, ka, va);
        __builtin_amdgcn_sched_barrier(0);
        samp_put4(ok, ov, ok0, ov0, lk, 0, R.k, R.v);
        samp_load4(ck, cv, 8, kb, vb);
        __builtin_amdgcn_sched_barrier(0);
        samp_put4(ok, ov, ok0, ov0, lk, 4, ka, va);
#pragma unroll
        for (int ks = 0; ks < 4; ++ks) asm volatile("" : "+v"(qf[ks]));
        samp_load4(ck, cv, 12, ka, va);
        samp_prefetch(P, nb, nh, nk, R);
        __builtin_amdgcn_sched_barrier(0);
        samp_put4(ok, ov, ok0, ov0, lk, 8, kb, vb);
        samp_put4(ok, ov, ok0, ov0, lk, 12, ka, va);
    } else {
        const int rho = tid >> 5, ch4 = tid & 31;
        u32x2 kw = {0u, 0u}, vw = {0u, 0u};
        if (rho < 8) { const size_t so = ((size_t)(b * 2048 + 2040 + rho)) * DATT + h * HD + ch4 * 4; const float4 kf = *(const float4*)(P.out + O_KS + so), vf = *(const float4*)(P.out + O_VS + so);
            kw.x = pg8::cvt_pk_bf16(kf.x, kf.y); kw.y = pg8::cvt_pk_bf16(kf.z, kf.w); vw.x = pg8::cvt_pk_bf16(vf.x, vf.y); vw.y = pg8::cvt_pk_bf16(vf.z, vf.w); }
        *(LAS u32x2*)(lds + rho * KVS + ch4 * 8) = kw; *(LAS u32x2*)(lds + VOFF + rho * KVS + ch4 * 8) = vw;
        *(LAS u32x2*)(lds + (16 + rho) * KVS + ch4 * 8) = (u32x2){0u, 0u}; *(LAS u32x2*)(lds + VOFF + (16 + rho) * KVS + ch4 * 8) = (u32x2){0u, 0u};
#pragma unroll
        for (int ks = 0; ks < 4; ++ks) asm volatile("" : "+v"(qf[ks]));
    }
    __syncthreads();
    const float slope2 = exp2f(-8.0f * (float)(h + 1) / 12.0f) * LOG2E;
    const bool active = (k < 8) || (w == 0);
    f32x4 s[2]; float m = -INFINITY;
#pragma unroll
    for (int j = 0; j < 2; ++j) {
        f32x4 acc = {0.f, 0.f, 0.f, 0.f};
        if (active) {
#pragma unroll
            for (int ks = 0; ks < 4; ++ks) { const bf16x8 kf = *(const LAS bf16x8*)(lds + (32 * w + 16 * j + cq) * KVS + (32 * ks + 8 * g) * 2); acc = __builtin_amdgcn_mfma_f32_16x16x32_bf16(kf, qf[ks], acc, 0, 0, 0); }
        }
#pragma unroll
        for (int ii = 0; ii < 4; ++ii) {
            const int c = 256 * k + 32 * w + 16 * j + 4 * g + ii, dist = 2048 + t - c;
            int mult = (dist <= 128 ? 1 : 0) + (((dist & 3) == 0 && dist <= 512) ? 1 : 0) + (((dist & 15) == 0 && dist <= 2048) ? 1 : 0);
            if (dist < 0 || !active || c > 2055) mult = 0;
            const float v = mult ? acc[ii] - slope2 * (float)dist : -INFINITY;
            acc[ii] = v; m = fmaxf(m, v);
            s[j][ii] = (float)mult;
            s[j][ii] = v;
        }
    }
    m = fmaxf(m, __shfl_xor(m, 16)); m = fmaxf(m, __shfl_xor(m, 32));
    const float mref = (m == -INFINITY) ? 0.f : m;
    float l = 0.f;
#pragma unroll
    for (int j = 0; j < 2; ++j)
#pragma unroll
        for (int ii = 0; ii < 4; ++ii) {
            const int c = 256 * k + 32 * w + 16 * j + 4 * g + ii, dist = 2048 + t - c;
            const int mult = (dist <= 128 ? 1 : 0) + (((dist & 3) == 0 && dist <= 512) ? 1 : 0) + (((dist & 15) == 0 && dist <= 2048) ? 1 : 0);
            const float pp = (float)mult * exp2f(s[j][ii] - mref); s[j][ii] = pp; l += pp; }
    l += __shfl_xor(l, 16); l += __shfl_xor(l, 32);
    f32x4 o[8];
    {
        u32x4 pw; pw.x = pg8::cvt_pk_bf16(s[0][0], s[0][1]); pw.y = pg8::cvt_pk_bf16(s[0][2], s[0][3]); pw.z = pg8::cvt_pk_bf16(s[1][0], s[1][1]); pw.w = pg8::cvt_pk_bf16(s[1][2], s[1][3]);
        const bf16x8 pf = __builtin_bit_cast(bf16x8, pw);
        const int rw = active ? w : 0;
        const int a0 = VOFF + (32 * rw + 4 * g + (cq >> 2)) * KVS + 8 * (cq & 3), a1 = a0 + 16 * KVS;
#pragma unroll
        for (int dt = 0; dt < 8; ++dt) {
            const s16x4 v0 = __builtin_amdgcn_ds_read_tr16_b64_v4i16((LAS s16x4*)(lds + a0 + dt * 32));
            const s16x4 v1 = __builtin_amdgcn_ds_read_tr16_b64_v4i16((LAS s16x4*)(lds + a1 + dt * 32));
            const bf16x8 vf = {v0[0], v0[1], v0[2], v0[3], v1[0], v1[1], v1[2], v1[3]};
            o[dt] = __builtin_amdgcn_mfma_f32_16x16x32_bf16(vf, pf, (f32x4){0.f, 0.f, 0.f, 0.f}, 0, 0, 0);
        }
    }
    __syncthreads();
    LAS float* OL = (LAS float*)lds;
    LAS float* ML = (LAS float*)(lds + 32768);
    if (cq < 8) {
#pragma unroll
        for (int dt = 0; dt < 8; ++dt) *(LAS f32x4*)(OL + (w * 8 + cq) * 128 + 16 * dt + 4 * g) = o[dt];
        if (g == 0) { ML[(w * 8 + cq) * 2 + 0] = m; ML[(w * 8 + cq) * 2 + 1] = l; }
    }
    __syncthreads();
    {
        const int q = w; float M = -INFINITY;
#pragma unroll
        for (int ww = 0; ww < 8; ++ww) M = fmaxf(M, ML[(ww * 8 + q) * 2]);
        const float Mr = (M == -INFINITY) ? 0.f : M;
        float L = 0.f, o0 = 0.f, o1 = 0.f;
#pragma unroll
        for (int ww = 0; ww < 8; ++ww) { const float f = exp2f(ML[(ww * 8 + q) * 2] - Mr); L += f * ML[(ww * 8 + q) * 2 + 1];
            o0 += f * OL[(ww * 8 + q) * 128 + 2 * lane]; o1 += f * OL[(ww * 8 + q) * 128 + 2 * lane + 1]; }
        float* ps = (float*)(P.ws + WS_PS) + ((((size_t)(b * NH + h)) * 9 + k) * 8 + q) * 130;
        if (lane == 0) { ps[0] = M; ps[1] = L; }
        *(float2*)(ps + 2 + 2 * lane) = make_float2(o0, o1);
    }
    __syncthreads();
}
__device__ __forceinline__ void samp_merge_unit(const Params& P, int b, int t, int h, int lane) {
    const float* ps = (const float*)(P.ws + WS_PS) + ((size_t)(b * NH + h)) * 9 * 8 * 130 + (size_t)t * 130;
    float M = -INFINITY;
#pragma unroll
    for (int k = 0; k < 9; ++k) M = fmaxf(M, ps[(size_t)k * 8 * 130]);
    float L = 0.f, o0 = 0.f, o1 = 0.f;
#pragma unroll
    for (int k = 0; k < 9; ++k) { const float* pk = ps + (size_t)k * 8 * 130; const float f = exp2f(pk[0] - M); L += f * pk[1]; const float2 ov = *(const float2*)(pk + 2 + 2 * lane); o0 += f * ov.x; o1 += f * ov.y; }
    const float inv = 1.0f / L;
    bf16_t* ar = (bf16_t*)(P.ws + WS_AR) + ((size_t)(NTOK_P + b * 8 + t)) * D + h * HD;
    *(unsigned*)(ar + 2 * lane) = pack2(o0 * inv, o1 * inv);
}

constexpr int LRU_XS = 144, LRU_GS = 68, LRU_WAVE = 16 * LRU_XS + 2 * 16 * LRU_GS * 4;
__device__ __forceinline__ void lru_unit(const Params& P, bool samp, int b, int n, int k, int lane, LAS unsigned char* wl) {
    const int T = samp ? 8 : 64; const int row0 = samp ? NTOK_P + b * 8 : b * 2048 + k * 64; const int ch = n * 64 + lane;
    const int cq = lane & 15, g = lane >> 4;
    bf16x8 wf[2][4][2];
    { const bf16_t* lw = (const bf16_t*)(P.ws + WS_LW);
#pragma unroll
      for (int m = 0; m < 2; ++m)
#pragma unroll
        for (int ct = 0; ct < 4; ++ct)
#pragma unroll
            for (int ks = 0; ks < 2; ++ks) wf[m][ct][ks] = *(const bf16x8*)(lw + ((size_t)((m * 8 + n) * 64 + 16 * ct + cq)) * 64 + 32 * ks + 8 * g); }
    const float ba = P.lru_b_a[ch], bx = P.lru_b_x[ch], lam = P.lru_lambda[ch];
    const float sp8 = -8.0f * LOG2E * log1pf(expf(-lam));
    const float cw0 = P.conv_w[ch], cw1 = P.conv_w[512 + ch], cw2 = P.conv_w[1024 + ch], cw3 = P.conv_w[1536 + ch], cb = P.conv_b[ch];
    const bf16_t* XR = (const bf16_t*)(P.ws + WS_XR); const bf16_t* GT = (const bf16_t*)(P.ws + WS_GATE);
    float* R0 = (float*)(P.ws + WS_R0); float* R1 = (float*)(P.ws + WS_R1); bf16_t* AR = (bf16_t*)(P.ws + WS_AR);
    LAS unsigned char* xcb = wl; LAS float* G = (LAS float*)(wl + 16 * LRU_XS);
    float x0 = 0.f, x1 = 0.f, x2 = 0.f, h = 0.f, A = 1.f;
    if (samp) { x0 = P.state_conv[(b * 3 + 0) * 512 + ch]; x1 = P.state_conv[(b * 3 + 1) * 512 + ch]; x2 = P.state_conv[(b * 3 + 2) * 512 + ch]; h = P.state_h[b * 512 + ch]; }
    else if (k > 0) { x0 = bflo(XR[(size_t)(row0 - 3) * DLRU + ch]); x1 = bflo(XR[(size_t)(row0 - 2) * DLRU + ch]); x2 = bflo(XR[(size_t)(row0 - 1) * DLRU + ch]); }
    unsigned xrn[16], gtn[16];
    { const int ns0 = T < 16 ? T : 16;
#pragma unroll
      for (int i = 0; i < 16; ++i) { const int r = row0 + (i < ns0 ? i : ns0 - 1); xrn[i] = XR[(size_t)r * DLRU + ch]; gtn[i] = GT[(size_t)r * DLRU + ch]; } }
    __builtin_amdgcn_sched_barrier(0);
#pragma unroll
    for (int i = 0; i < 16; ++i) { asm volatile("" : "+v"(xrn[i])); asm volatile("" : "+v"(gtn[i])); }
#pragma unroll 1
    for (int t0 = 0; t0 < T; t0 += 16) {
        const int ns = (T - t0) < 16 ? (T - t0) : 16;
        float xc[16], gt[16];
#pragma unroll
        for (int i = 0; i < 16; ++i) { xc[i] = bflo(xrn[i]); gt[i] = bflo(gtn[i]); }
        if (t0 + 16 < T) { const int nn = (T - t0 - 16) < 16 ? (T - t0 - 16) : 16;
#pragma unroll
            for (int i = 0; i < 16; ++i) { const int r = row0 + t0 + 16 + (i < nn ? i : nn - 1); xrn[i] = XR[(size_t)r * DLRU + ch]; gtn[i] = GT[(size_t)r * DLRU + ch]; } }
        __builtin_amdgcn_sched_barrier(0);
#pragma unroll
        for (int i = 0; i < 16; ++i) {
            const float xin = xc[i]; const float v = ((x0 * cw0 + x1 * cw1) + x2 * cw2) + xin * cw3 + cb;
            if (i < ns) { x0 = x1; x1 = x2; x2 = xin; }
            xc[i] = v;
            *(LAS bf16_t*)(xcb + i * LRU_XS + lane * 2) = (bf16_t)f2bf(v);
        }
        __builtin_amdgcn_wave_barrier();
        const bf16x8 a0 = *(const LAS bf16x8*)(xcb + cq * LRU_XS + (8 * g) * 2), a1 = *(const LAS bf16x8*)(xcb + cq * LRU_XS + (32 + 8 * g) * 2);
#pragma unroll
        for (int m = 0; m < 2; ++m)
#pragma unroll
            for (int ct = 0; ct < 4; ++ct) {
                f32x4 acc = __builtin_amdgcn_mfma_f32_16x16x32_bf16(a0, wf[m][ct][0], (f32x4){0.f, 0.f, 0.f, 0.f}, 0, 0, 0);
                acc = __builtin_amdgcn_mfma_f32_16x16x32_bf16(a1, wf[m][ct][1], acc, 0, 0, 0);
#pragma unroll
                for (int ii = 0; ii < 4; ++ii) G[(m * 16 + 4 * g + ii) * LRU_GS + 16 * ct + cq] = acc[ii];
            }
        __builtin_amdgcn_wave_barrier();
#pragma unroll
        for (int i = 0; i < 16; ++i) {
            if (i < ns) {
                const float ra = G[i * LRU_GS + lane] + ba, ri = G[(16 + i) * LRU_GS + lane] + bx;
                const float r = __builtin_amdgcn_rcpf(1.0f + __builtin_amdgcn_exp2f(-LOG2E * ra)), ig = __builtin_amdgcn_rcpf(1.0f + __builtin_amdgcn_exp2f(-LOG2E * ri));
                const float a = __builtin_amdgcn_exp2f(sp8 * r);
                const float u = __builtin_amdgcn_sqrtf(fmaxf(1.0f - a * a, 0.f)) * (ig * xc[i]);
                h = a * h + u; A = a * A;
                const float ge = gelu_as(gt[i]);
                if (samp) AR[(size_t)(row0 + t0 + i) * D + DATT + ch] = (bf16_t)f2bf(h * ge);
                else { R0[(size_t)(row0 + t0 + i) * DLRU + ch] = h * ge; R1[(size_t)(row0 + t0 + i) * DLRU + ch] = A * ge; }
            }
        }
        __builtin_amdgcn_wave_barrier();
    }
    if (samp) { P.out[O_HS + (size_t)b * 512 + ch] = h; float* co = P.out + O_CS + (size_t)b * 3 * 512 + ch; co[0] = x0; co[512] = x1; co[1024] = x2; }
    else {
        ((float*)(P.ws + WS_HE))[((size_t)(b * 32 + k)) * 512 + ch] = h; ((float*)(P.ws + WS_AE))[((size_t)(b * 32 + k)) * 512 + ch] = A;
        if (k == 31) { float* co = P.out + O_CP + (size_t)b * 3 * 512 + ch; co[0] = x0; co[512] = x1; co[1024] = x2; }
    }
}

__device__ __forceinline__ void phase_lru(const Params& P, LAS unsigned char* lds) {
    const int lane = threadIdx.x & 63, wave = __builtin_amdgcn_readfirstlane(threadIdx.x >> 6);
    const int gw = blockIdx.x * 8 + wave, nw = gridDim.x * 8;
#pragma unroll 1
    for (int pass = 0; pass < 2; ++pass) {
        if ((pass ^ (wave & 1)) == 0) {
            for (int u = gw; u < 2048 + 256; u += nw) { const bool samp = u >= 2048; const int v = samp ? u - 2048 : u; lru_unit(P, samp, samp ? (v >> 3) : (v >> 8), samp ? (v & 7) : ((v >> 5) & 7), v & 31, lane, lds + wave * LRU_WAVE); }
        } else quant_tables(P, gw, nw, MK_QHEAD, 2 * NEXP - MK_QTAIL);
    }
    __syncthreads();
}
__device__ __forceinline__ void phase_samp(const Params& P, LAS unsigned char* lds) {
    SampPre R;
    int u = blockIdx.x;
    if (u < 384 * 8) { const int bh = u >> 3; samp_prefetch(P, bh / NH, bh % NH, u & 7, R); }
    for (; u < 384 * 8; u += gridDim.x) {
        const int bh = u >> 3; const int un = (u + (int)gridDim.x < 384 * 8) ? u + (int)gridDim.x : u; const int nbh = un >> 3;
        samp_unit<false>(P, bh / NH, bh % NH, u & 7, lds, R, nbh / NH, nbh % NH, un & 7);
    }
    for (u = blockIdx.x; u < 384; u += gridDim.x) samp_unit<true>(P, u / NH, u % NH, 8, lds, R, 0, 0, 0);
}
__device__ __forceinline__ AttnId attn01_id(int u) {
    const int p = u / 1536, rem = u - p * 1536, bh = rem >> 4, rc = rem & 15; const int b = bh / NH, h = bh - b * NH;
    return AttnId{p, b, h, p == 0 ? 0 : (rc >> 2), p == 0 ? rc : (rc & 3)};
}
__device__ __forceinline__ void phase_attn01(const Params& P, LAS unsigned char* lds) {
    AttnKV R; int u = blockIdx.x;
    if (u < 3072) attn_fetch(P, attn01_id(u), R);
    for (; u < 3072; u += gridDim.x) {
        const int un = u + (int)gridDim.x; const bool hn = un < 3072;
        attn_unit<0>(P, attn01_id(u), R, hn, attn01_id(hn ? un : u), lds);
    }
}
__device__ __forceinline__ void phase_mix_b(const Params& P, LAS unsigned char* lds) {
    {
        const int gt = blockIdx.x * NTHREADS + threadIdx.x;
        for (int i = gt; i < 8 * 32 * 512; i += gridDim.x * NTHREADS) {
            const int ch = i & 511, k = (i >> 9) & 31, b = i >> 14;
            const float* HE = (const float*)(P.ws + WS_HE) + (size_t)b * 32 * 512 + ch; const float* AE = (const float*)(P.ws + WS_AE) + (size_t)b * 32 * 512 + ch;
            float he[31], ae[31];
#pragma unroll
            for (int kk = 0; kk < 31; ++kk) { he[kk] = kk < k ? HE[kk * 512] : 0.f; ae[kk] = kk < k ? AE[kk * 512] : 1.f; }
            float hin = 0.f;
#pragma unroll
            for (int kk = 0; kk < 31; ++kk) hin = kk < k ? he[kk] + ae[kk] * hin : hin;
            const float* R0 = (const float*)(P.ws + WS_R0) + (size_t)(b * 2048 + k * 64) * DLRU + ch; const float* R1 = (const float*)(P.ws + WS_R1) + (size_t)(b * 2048 + k * 64) * DLRU + ch;
            bf16_t* ar = (bf16_t*)(P.ws + WS_AR) + (size_t)(b * 2048 + k * 64) * D + DATT + ch;
#pragma unroll 1
            for (int t0 = 0; t0 < 64; t0 += 16) {
                float r0[16], r1[16];
#pragma unroll
                for (int t = 0; t < 16; ++t) { r0[t] = R0[(size_t)(t0 + t) * DLRU]; r1[t] = R1[(size_t)(t0 + t) * DLRU]; }
#pragma unroll
                for (int t = 0; t < 16; ++t) ar[(size_t)(t0 + t) * D] = (bf16_t)f2bf(r0[t] + r1[t] * hin);
            }
            if (k == 31) P.out[O_HP + (size_t)b * 512 + ch] = HE[31 * 512] + AE[31 * 512] * hin;
        }
    }
    { const int lane = threadIdx.x & 63, gw = blockIdx.x * 8 + (threadIdx.x >> 6);
      for (int u = gw; u < NTOK_S * NH; u += gridDim.x * 8) { const int row = u / NH, h = u - row * NH; samp_merge_unit(P, row >> 3, row & 7, h, lane); } }
    {
        AttnKV R; int u = blockIdx.x;
        if (u < 1536) attn_fetch(P, AttnId{2, (u >> 4) / NH, (u >> 4) % NH, u & 15, 0}, R);
        for (; u < 1536; u += gridDim.x) {
            const int un = u + (int)gridDim.x; const bool hn = un < 1536; const int uu = hn ? un : u;
            attn_unit<1>(P, AttnId{2, (u >> 4) / NH, (u >> 4) % NH, u & 15, 0}, R, hn, AttnId{2, (uu >> 4) / NH, (uu >> 4) % NH, uu & 15, 0}, lds);
        }
    }
}

__device__ __forceinline__ void phase_ln1(const Params& P) {
    const int lane = threadIdx.x & 63, wave = threadIdx.x >> 6;
    const bf16_t* pre = (const bf16_t*)(P.ws + WS_PRE1); bf16_t* x1b = (bf16_t*)(P.ws + WS_X1B);
    const int rstep = gridDim.x * 8;
    float4 g8[8], b8[8];
#pragma unroll
    for (int j = 0; j < 8; ++j) { const int col = (j >> 2) * 1024 + lane * 16 + (j & 3) * 4; g8[j] = *(const float4*)(P.ln1_g + col); b8[j] = *(const float4*)(P.ln1_b + col); }
    u32x4 nx[4];
    { const int r0 = blockIdx.x * 8 + wave;
      if (r0 < NTOK) {
#pragma unroll
          for (int j = 0; j < 4; ++j) nx[j] = *(const u32x4*)(pre + (size_t)r0 * D + (j >> 1) * 1024 + lane * 16 + (j & 1) * 8); } }
#pragma unroll
    for (int j = 0; j < 4; ++j) asm volatile("" : "+v"(nx[j]));
    for (int row = blockIdx.x * 8 + wave; row < NTOK; row += rstep) {
        float4 v[8]; float s = 0.f;
        u32x4 cur[4];
#pragma unroll
        for (int j = 0; j < 4; ++j) cur[j] = nx[j];
        if (row + rstep < NTOK) {
#pragma unroll
            for (int j = 0; j < 4; ++j) nx[j] = *(const u32x4*)(pre + (size_t)(row + rstep) * D + (j >> 1) * 1024 + lane * 16 + (j & 1) * 8); }
#pragma unroll
        for (int j = 0; j < 8; j += 2) { const u32x4 pw = cur[j >> 1];
            v[j] = make_float4(bflo(pw.x), bfhi(pw.x), bflo(pw.y), bfhi(pw.y)); v[j + 1] = make_float4(bflo(pw.z), bfhi(pw.z), bflo(pw.w), bfhi(pw.w));
            s += (v[j].x + v[j].y) + (v[j].z + v[j].w) + (v[j + 1].x + v[j + 1].y) + (v[j + 1].z + v[j + 1].w); }
        const float mean = wave_sum(s) * (1.0f / D); float q = 0.f;
#pragma unroll
        for (int j = 0; j < 8; ++j) { const float a = v[j].x - mean, b = v[j].y - mean, c = v[j].z - mean, d = v[j].w - mean; q += (a * a + b * b) + (c * c + d * d); }
        const float rstd = rsqrtf(wave_sum(q) * (1.0f / D) + LN_EPS);
        float am = 0.f;
#pragma unroll
        for (int j = 0; j < 8; ++j) { const int col = (j >> 2) * 1024 + lane * 16 + (j & 3) * 4; const float4 g = g8[j], bb = b8[j];
            float4 o; o.x = (v[j].x - mean) * rstd * g.x + bb.x; o.y = (v[j].y - mean) * rstd * g.y + bb.y; o.z = (v[j].z - mean) * rstd * g.z + bb.z; o.w = (v[j].w - mean) * rstd * g.w + bb.w;
            v[j] = o; am = fmaxf(am, fmaxf(fmaxf(fabsf(o.x), fabsf(o.y)), fmaxf(fabsf(o.z), fabsf(o.w))));
            uint2 w; w.x = pack2(o.x, o.y); w.y = pack2(o.z, o.w); *(uint2*)(x1b + (size_t)row * D + col) = w; }
        am = wave_max(am); if (am == 0.f) am = 1.f;
        const float inv = 119.0f / am;
        unsigned char* xq = P.ws + WS_X1Q + (size_t)row * D;
        u32x4 wh, wl;
#pragma unroll
        for (int d = 0; d < 4; ++d) { unsigned dh = 0u, dl = 0u;
#pragma unroll
            for (int e = 0; e < 8; ++e) { const float4 t = v[d * 2 + (e >> 2)]; const float x = (e & 3) == 0 ? t.x : ((e & 3) == 1 ? t.y : ((e & 3) == 2 ? t.z : t.w));
                const int q = (int)rintf(x * inv); dl |= (unsigned)(q & 15) << (4 * e); dh |= (unsigned)(((q + 8) >> 4) & 15) << (4 * e); }
            wh[d] = dh; wl[d] = dl; }
        *(u32x4*)(xq + lane * 32) = wh; *(u32x4*)(xq + lane * 32 + 16) = wl;
        if (lane == 0) ((float*)(P.ws + WS_SX))[row] = am * (1.0f / 119.0f);
    }
}

__device__ __forceinline__ int mono(float v) { const int b = __float_as_int(v); return b ^ ((b >> 31) & 0x7fffffff); }
__device__ __forceinline__ float unmono(int k) { return __int_as_float(k ^ ((k >> 31) & 0x7fffffff)); }
#define MK_INSERT16(L, X) do { int _x = (X); _Pragma("unroll") for (int _j = 0; _j < 16; ++_j) { const int _hi = max(L[_j], _x); _x = min(L[_j], _x); L[_j] = _hi; } } while (0)

template <int N> __device__ __forceinline__ void bitonic_sort_desc(int (&v)[N]) {
#pragma unroll
    for (int k = 2; k <= N; k <<= 1)
#pragma unroll
        for (int j = k >> 1; j > 0; j >>= 1)
#pragma unroll
            for (int i = 0; i < N; ++i) { const int l = i ^ j;
                if (l > i) { const int a = v[i], b = v[l]; if ((i & k) == 0) { v[i] = max(a, b); v[l] = min(a, b); } else { v[i] = min(a, b); v[l] = max(a, b); } } }
}
template <int N> __device__ __forceinline__ void bitonic_merge_desc(int (&v)[N]) {
#pragma unroll
    for (int j = N >> 1; j > 0; j >>= 1)
#pragma unroll
        for (int i = 0; i < N; ++i) { const int l = i ^ j; if (l > i) { const int a = v[i], b = v[l]; v[i] = max(a, b); v[l] = min(a, b); } }
}
__device__ __forceinline__ void xlane_merge16(int (&v)[16], int off) {
    int c[16];
#pragma unroll
    for (int i = 0; i < 16; ++i) c[i] = max(v[i], __shfl_xor(v[15 - i], off));
#pragma unroll
    for (int i = 0; i < 16; ++i) v[i] = c[i];
    bitonic_merge_desc<16>(v);
}
__device__ __forceinline__ int sel4(int g, int a, int b, int c, int d) { return g == 0 ? a : (g == 1 ? b : (g == 2 ? c : d)); }
__device__ __forceinline__ float sel4f(int g, float a, float b, float c, float d) { return g == 0 ? a : (g == 1 ? b : (g == 2 ? c : d)); }
__device__ __forceinline__ constexpr int cand_a(int role, int i) {
    return role == 0 ? 0 : role == 1 ? (i < 8 ? 1 : (i < 13 ? 2 : 4)) : role == 2 ? (i < 4 ? 3 : (i < 6 ? 5 : (i < 8 ? 6 : (i < 10 ? 7 : 8 + (i - 10))))) : (i < 2 ? 14 + i : -1);
}
__device__ __forceinline__ constexpr int cand_b(int role, int i) {
    return role == 0 ? i : role == 1 ? (i < 8 ? i : (i < 13 ? i - 8 : i - 13)) : role == 2 ? (i < 4 ? i : (i < 6 ? i - 4 : (i < 8 ? i - 6 : (i < 10 ? i - 8 : 0)))) : 0;
}

__device__ __forceinline__ void route_unit(const Params& P, int h, int tg, LAS unsigned char* lds, LAS int* lst) {
    const int lane = threadIdx.x & 63, w = __builtin_amdgcn_readfirstlane(threadIdx.x >> 6);
    const int cq = lane & 15, g = lane >> 4;
    const int tok = tg * 128 + w * 16 + cq;
    const bf16_t* qrow = (const bf16_t*)(P.ws + WS_QP) + (size_t)tok * D + h * 256;
    int L0[16], L1[16];
#pragma unroll
    for (int p = 0; p < 2; ++p) {
        bf16x8 qf[4];
#pragma unroll
        for (int ks = 0; ks < 4; ++ks) qf[ks] = *(const bf16x8*)(qrow + p * 128 + 32 * ks + 8 * g);
        int v0[16], v1[16];
#pragma unroll
        for (int kt = 0; kt < 8; ++kt) {
            f32x4 acc = {0.f, 0.f, 0.f, 0.f};
#pragma unroll
            for (int ks = 0; ks < 4; ++ks) { const bf16x8 kf = *(const LAS bf16x8*)(lds + (p * 128 + 16 * kt + cq) * KVS + (32 * ks + 8 * g) * 2); acc = __builtin_amdgcn_mfma_f32_16x16x32_bf16(kf, qf[ks], acc, 0, 0, 0); }
#pragma unroll
            for (int ii = 0; ii < 4; ++ii) { const int key = (mono(acc[ii]) & ~127) | (16 * kt + 4 * g + ii); if (kt < 4) v0[kt * 4 + ii] = key; else v1[(kt - 4) * 4 + ii] = key; }
        }
        bitonic_sort_desc<16>(v0); bitonic_sort_desc<16>(v1);
#pragma unroll
        for (int i = 0; i < 16; ++i) v0[i] = max(v0[i], v1[15 - i]);
        bitonic_merge_desc<16>(v0);
        xlane_merge16(v0, 16); xlane_merge16(v0, 32);
#pragma unroll
        for (int i = 0; i < 16; ++i) { if (p == 0) L0[i] = v0[i]; else L1[i] = v0[i]; }
    }
    if (g == 0) {
#pragma unroll
        for (int i = 0; i < 16; ++i) lst[(cq * 2 + 0) * 16 + i] = L0[i];
    }
    if (g == 1) {
#pragma unroll
        for (int i = 0; i < 16; ++i) lst[(cq * 2 + 1) * 16 + i] = L1[i];
    }
    float f0[16], f1[16];
#pragma unroll
    for (int i = 0; i < 16; ++i) { f0[i] = unmono(L0[i] & ~127); f1[i] = unmono(L1[i] & ~127); }
    int c[16];
#pragma unroll
    for (int i = 0; i < 16; ++i) {
        constexpr int NEG = (int)0x80000000;
        const float va = sel4f(g, f0[cand_a(0, i)], f0[cand_a(1, i)], f0[cand_a(2, i)], f0[cand_a(3, i) < 0 ? 0 : cand_a(3, i)]);
        const float vb = sel4f(g, f1[cand_b(0, i)], f1[cand_b(1, i)], f1[cand_b(2, i)], f1[cand_b(3, i)]);
        const int id = sel4(g, (cand_a(0, i) << 4) | cand_b(0, i), (cand_a(1, i) << 4) | cand_b(1, i), (cand_a(2, i) << 4) | cand_b(2, i), ((cand_a(3, i) < 0 ? 0 : cand_a(3, i)) << 4) | cand_b(3, i));
        int key = (mono(va + vb) & ~255) | id;
        if (cand_a(3, i) < 0) key = (g == 3) ? NEG : key;
        c[i] = key;
    }
    bitonic_sort_desc<16>(c);
    xlane_merge16(c, 16); xlane_merge16(c, 32);
    const float mx = unmono(c[0] & ~255);
    float e[16]; float sum = 0.f;
#pragma unroll
    for (int i = 0; i < 16; ++i) { e[i] = exp2f((unmono(c[i] & ~255) - mx) * LOG2E); sum += e[i]; }
    const float inv = 1.0f / sum;
    __builtin_amdgcn_wave_barrier();
    int ei[4]; float gi[4];
#pragma unroll
    for (int j = 0; j < 4; ++j) {
        const int key = sel4(g, c[j], c[4 + j], c[8 + j], c[12 + j]);
        gi[j] = sel4f(g, e[j], e[4 + j], e[8 + j], e[12 + j]) * inv;
        const int a = (key >> 4) & 15, b = key & 15;
        const int i0 = lst[(cq * 2 + 0) * 16 + a] & 127, i1 = lst[(cq * 2 + 1) * 16 + b] & 127;
        ei[j] = i0 * 128 + i1;
    }
    int* EIDX = (int*)(P.ws + WS_EIDX); float* GW = (float*)(P.ws + WS_GW);
    *(int4*)(EIDX + (size_t)tok * 128 + h * 16 + 4 * g) = make_int4(ei[0], ei[1], ei[2], ei[3]);
    *(float4*)(GW + (size_t)tok * 128 + h * 16 + 4 * g) = make_float4(gi[0], gi[1], gi[2], gi[3]);
    __builtin_amdgcn_wave_barrier();
}
__device__ __forceinline__ void phase_route(const Params& P, LAS unsigned char* lds) {
    const int tid = threadIdx.x, wave = __builtin_amdgcn_readfirstlane(tid >> 6);
    const int h = blockIdx.x & 7, slot = blockIdx.x >> 3, nslot = gridDim.x >> 3;
    const bf16_t* sk = (const bf16_t*)(P.ws + WS_SKB) + (size_t)h * 2 * 128 * 128;
#pragma unroll
    for (int it = 0; it < 8; ++it) { const int row = it * 32 + (tid >> 4), ch = tid & 15; *(LAS u32x4*)(lds + row * KVS + ch * 16) = *(const u32x4*)(sk + (size_t)row * 128 + ch * 8); }
    __syncthreads();
    LAS int* lst = (LAS int*)(lds + 73728) + wave * 512;
    for (int tg = slot; tg < NTOK / 128; tg += nslot) route_unit(P, h, tg, lds, lst);
    { const int extra = (NTOK / 128) % nslot;
      if (extra != 0 && slot >= extra) quant_tables(P, ((slot - extra) * 8 + h) * 8 + wave, (nslot - extra) * 8 * 8, 2 * NEXP - MK_QTAIL, 2 * NEXP);
      else if (extra == 0) quant_tables(P, (int)blockIdx.x * 8 + wave, (int)gridDim.x * 8, 2 * NEXP - MK_QTAIL, 2 * NEXP); }
}

__device__ __forceinline__ float ubf(unsigned x, int k) { return (float)((x >> (8 * k)) & 0xffu); }
constexpr int XSLOT = 1152, XGRP = 4 * XSLOT, XNG = 4, XWAVE = XNG * XGRP;
__device__ __forceinline__ void dma_group(__amdgpu_buffer_rsrc_t tab, int e_lo, int e_hi, int g, LAS unsigned char* sb, int lane) {
#pragma unroll
    for (int j = 0; j < 4; ++j) {
        const int k = g * 4 + j; const int e = __builtin_amdgcn_readlane(k < 64 ? e_lo : e_hi, k & 63);
        const int so = e * TROW;
        __builtin_amdgcn_raw_ptr_buffer_load_lds(tab, (LAS void*)(sb + j * XSLOT), 16, lane * 16, so, 0, 0);
        if (lane < 8) __builtin_amdgcn_raw_ptr_buffer_load_lds(tab, (LAS void*)(sb + j * XSLOT + 1024), 16, 1024 + lane * 16, so, 0, 0);
    }
}
__device__ __forceinline__ void u_consume(const LAS unsigned char* sb, const u32x4& xh, const u32x4& xl, float a_lo, float a_hi, float b_lo, float b_hi, int g, int lane, float& w_lo, float& w_hi) {
    int d[4];
#pragma unroll
    for (int j = 0; j < 4; ++j) {
        const u32x4 nb = *(const LAS u32x4*)(sb + j * XSLOT + lane * 16); const unsigned sc = *(const LAS unsigned short*)(sb + j * XSLOT + 1024 + lane * 2);
        int tot = 0;
#pragma unroll
        for (int jj = 0; jj < 2; ++jj) {
            int th = __builtin_amdgcn_sdot8((int)nb[jj * 2], (int)xh[jj * 2], 0, false); th = __builtin_amdgcn_sdot8((int)nb[jj * 2 + 1], (int)xh[jj * 2 + 1], th, false);
            int tl = __builtin_amdgcn_sdot8((int)nb[jj * 2], (int)xl[jj * 2], 0, false); tl = __builtin_amdgcn_sdot8((int)nb[jj * 2 + 1], (int)xl[jj * 2 + 1], tl, false);
            tot += (16 * th + tl) * (int)((sc >> (8 * jj)) & 255u); }
        d[j] = tot;
    }
    const auto s02 = __builtin_amdgcn_permlane32_swap((unsigned)d[0], (unsigned)d[2], false, false);
    const auto s13 = __builtin_amdgcn_permlane32_swap((unsigned)d[1], (unsigned)d[3], false, false);
    const int r0 = (int)s02[0] + (int)s02[1], r1 = (int)s13[0] + (int)s13[1];
    const auto s01 = __builtin_amdgcn_permlane16_swap((unsigned)r0, (unsigned)r1, false, false);
    int r = (int)s01[0] + (int)s01[1];
    r += __builtin_amdgcn_update_dpp(0, r, 0x128, 0xf, 0xf, false);
    r += __builtin_amdgcn_update_dpp(0, r, 0x124, 0xf, 0xf, false);
    r += __builtin_amdgcn_update_dpp(0, r, 0x4E, 0xf, 0xf, false);
    r += __builtin_amdgcn_update_dpp(0, r, 0xB1, 0xf, 0xf, false);
    const int tot = __shfl(r, (lane & 3) * 16);
    const bool mine = ((lane >> 2) == (g & 15));
    const bool hi = g >= 16;
    const float wv = (hi ? b_hi : b_lo) * gelu_as((float)tot * (hi ? a_hi : a_lo));
    if (hi) w_hi = mine ? wv : w_hi; else w_lo = mine ? wv : w_lo;
}
__device__ __forceinline__ void v_consume(const LAS unsigned char* sb, int (&acc)[32], int (&bias)[2], float w_lo, float w_hi, float inv_sw, int g, int lane) {
    u32x4 nb[4]; int wq[2] = {0, 0};
#pragma unroll
    for (int j = 0; j < 4; ++j) {
        const int k = g * 4 + j; const float w = readlane_f(k < 64 ? w_lo : w_hi, k & 63) * inv_sw;
        nb[j] = *(const LAS u32x4*)(sb + j * XSLOT + lane * 16); const unsigned sc = *(const LAS unsigned short*)(sb + j * XSLOT + 1024 + lane * 2);
#pragma unroll
        for (int jj = 0; jj < 2; ++jj) { const int q = (int)rintf(w * (float)((sc >> (8 * jj)) & 255u)); wq[jj] |= (q & 255) << (8 * j); }
    }
    bias[0] = __builtin_amdgcn_sdot4(wq[0], 0x01010101, bias[0], false); bias[1] = __builtin_amdgcn_sdot4(wq[1], 0x01010101, bias[1], false);
#pragma unroll
    for (int i = 0; i < 4; ++i) {
        const unsigned r0 = nb[0][i], r1 = nb[1][i], r2 = nb[2][i], r3 = nb[3][i];
        const unsigned p01a = __builtin_amdgcn_perm(r1, r0, 0x05010400u), p01b = __builtin_amdgcn_perm(r1, r0, 0x07030602u);
        const unsigned p23a = __builtin_amdgcn_perm(r3, r2, 0x05010400u), p23b = __builtin_amdgcn_perm(r3, r2, 0x07030602u);
        const unsigned t0 = __builtin_amdgcn_perm(p23a, p01a, 0x05040100u), t1 = __builtin_amdgcn_perm(p23a, p01a, 0x07060302u);
        const unsigned t2 = __builtin_amdgcn_perm(p23b, p01b, 0x05040100u), t3 = __builtin_amdgcn_perm(p23b, p01b, 0x07060302u);
        const int wv = wq[i >> 1];
        acc[i * 8 + 0] = __builtin_amdgcn_sdot4((int)(t0 & 0x0F0F0F0Fu), wv, acc[i * 8 + 0], false); acc[i * 8 + 1] = __builtin_amdgcn_sdot4((int)((t0 >> 4) & 0x0F0F0F0Fu), wv, acc[i * 8 + 1], false);
        acc[i * 8 + 2] = __builtin_amdgcn_sdot4((int)(t1 & 0x0F0F0F0Fu), wv, acc[i * 8 + 2], false); acc[i * 8 + 3] = __builtin_amdgcn_sdot4((int)((t1 >> 4) & 0x0F0F0F0Fu), wv, acc[i * 8 + 3], false);
        acc[i * 8 + 4] = __builtin_amdgcn_sdot4((int)(t2 & 0x0F0F0F0Fu), wv, acc[i * 8 + 4], false); acc[i * 8 + 5] = __builtin_amdgcn_sdot4((int)((t2 >> 4) & 0x0F0F0F0Fu), wv, acc[i * 8 + 5], false);
        acc[i * 8 + 6] = __builtin_amdgcn_sdot4((int)(t3 & 0x0F0F0F0Fu), wv, acc[i * 8 + 6], false); acc[i * 8 + 7] = __builtin_amdgcn_sdot4((int)((t3 >> 4) & 0x0F0F0F0Fu), wv, acc[i * 8 + 7], false);
    }
}
__device__ __forceinline__ void wave_sort128(int& v0, int& v1, int lane) {
#pragma unroll
    for (int k = 2; k <= 128; k <<= 1) {
#pragma unroll
        for (int j = k >> 1; j > 0; j >>= 1) {
            if (j == 64) { const int lo = min(v0, v1), hi = max(v0, v1); v0 = lo; v1 = hi; }
            else {
                const int p0 = __shfl_xor(v0, j), p1 = __shfl_xor(v1, j);
                const bool lower = (lane & j) == 0;
                const bool asc0 = (lane & k) == 0, asc1 = ((64 + lane) & k) == 0;
                v0 = (lower == asc0) ? min(v0, p0) : max(v0, p0);
                v1 = (lower == asc1) ? min(v1, p1) : max(v1, p1);
            }
        }
    }
}
__device__ __forceinline__ void exp_epilogue(const Params& P, int row, int ln, const int (&acc)[32], const int (&bias)[2], float scale_w) {
    const bf16_t* x1b = (const bf16_t*)(P.ws + WS_X1B);
    float val[32]; float s = 0.f;
#pragma unroll
    for (int jj = 0; jj < 2; ++jj) {
        const int b8 = 8 * bias[jj];
#pragma unroll
        for (int hh = 0; hh < 2; ++hh) {
            const u32x4 xa = *(const u32x4*)(x1b + (size_t)row * D + jj * 1024 + ln * 16 + hh * 8);
#pragma unroll
            for (int i = 0; i < 4; ++i) { const int e0 = jj * 16 + hh * 8 + 2 * i;
                val[e0] = scale_w * (float)(acc[e0] - b8) + ALPHA * bflo(xa[i]); val[e0 + 1] = scale_w * (float)(acc[e0 + 1] - b8) + ALPHA * bfhi(xa[i]); s += val[e0] + val[e0 + 1]; }
        }
    }
    const float mean = wave_sum(s) * (1.0f / D); float q = 0.f;
#pragma unroll
    for (int i = 0; i < 32; ++i) { const float d0 = val[i] - mean; q += d0 * d0; }
    const float rstd = rsqrtf(wave_sum(q) * (1.0f / D) + LN_EPS);
    float* yo = P.out + (row < NTOK_P ? O_YP + (size_t)row * D : O_YS + (size_t)(row - NTOK_P) * D);
    const int lo16 = ln * 16;
    float4 gg[8], bb[8];
#pragma unroll
    for (int jj = 0; jj < 2; ++jj)
#pragma unroll
        for (int i = 0; i < 4; ++i) { const int col = jj * 1024 + lo16 + i * 4; gg[jj * 4 + i] = *(const float4*)(P.ln2_g + col); bb[jj * 4 + i] = *(const float4*)(P.ln2_b + col); }
#pragma unroll
    for (int jj = 0; jj < 2; ++jj)
#pragma unroll
        for (int i = 0; i < 4; ++i) {
            const int col = jj * 1024 + lo16 + i * 4;
            const float4 g0 = gg[jj * 4 + i], b0 = bb[jj * 4 + i];
            float4 o;
            o.x = (val[jj * 16 + i * 4 + 0] - mean) * rstd * g0.x + b0.x; o.y = (val[jj * 16 + i * 4 + 1] - mean) * rstd * g0.y + b0.y;
            o.z = (val[jj * 16 + i * 4 + 2] - mean) * rstd * g0.z + b0.z; o.w = (val[jj * 16 + i * 4 + 3] - mean) * rstd * g0.w + b0.w;
            *(float4*)(yo + col) = o;
        }
}
__device__ __forceinline__ void phase_experts(const Params& P, LAS unsigned char* lds) {
    const int lane = threadIdx.x & 63, wave = __builtin_amdgcn_readfirstlane(threadIdx.x >> 6);
    const int* EIDX = (const int*)(P.ws + WS_EIDX); const float* GW = (const float*)(P.ws + WS_GW);
    const __amdgpu_buffer_rsrc_t UQ = __builtin_amdgcn_make_buffer_rsrc((void*)(P.ws + WS_UB), 0, NEXP * TROW, 0x00020000);
    const __amdgpu_buffer_rsrc_t VQ = __builtin_amdgcn_make_buffer_rsrc((void*)(P.ws + WS_VB), 0, NEXP * TROW, 0x00020000);
    const float* SU = (const float*)(P.ws + WS_SU); const float* SV = (const float*)(P.ws + WS_SV); const float* SX = (const float*)(P.ws + WS_SX);
    LAS unsigned char* wb = lds + wave * XWAVE;
    constexpr int TPW = 8;
    const int row0 = blockIdx.x * 8 + wave, rstride = gridDim.x * 8;
    if (row0 + (TPW - 1) * rstride < NTOK_P) {
        u32x4 mxh[TPW], mxl[TPW]; int mel[TPW], meh[TPW]; float mal[TPW], mah[TPW], mbl[TPW], mbh[TPW];
#pragma unroll
        for (int i = 0; i < TPW; ++i) {
            const int row = row0 + i * rstride;
            mxh[i] = *(const u32x4*)(P.ws + WS_X1Q + (size_t)row * D + lane * 32); mxl[i] = *(const u32x4*)(P.ws + WS_X1Q + (size_t)row * D + lane * 32 + 16);
            int p0 = (EIDX[(size_t)row * 128 + lane] << 18) | min(262143, (int)(GW[(size_t)row * 128 + lane] * 262144.0f));
            int p1 = (EIDX[(size_t)row * 128 + 64 + lane] << 18) | min(262143, (int)(GW[(size_t)row * 128 + 64 + lane] * 262144.0f));
            wave_sort128(p0, p1, lane);
            mel[i] = (int)((unsigned)p0 >> 18); meh[i] = (int)((unsigned)p1 >> 18);
            const float gl = ((float)(p0 & 262143) + 0.5f) * (1.0f / 262144.0f), gh = ((float)(p1 & 262143) + 0.5f) * (1.0f / 262144.0f);
            const float sx = SX[row];
            mal[i] = SU[mel[i]] * sx; mah[i] = SU[meh[i]] * sx; mbl[i] = gl * SV[mel[i]]; mbh[i] = gh * SV[meh[i]];
        }
        asm volatile("s_waitcnt vmcnt(0)" ::: "memory");
        dma_group(UQ, mel[0], meh[0], 0, wb, lane); dma_group(UQ, mel[0], meh[0], 1, wb + XGRP, lane); dma_group(UQ, mel[0], meh[0], 2, wb + 2 * XGRP, lane);
        int sg = 0;
        float mwl[TPW], mwh[TPW];
#pragma unroll
        for (int j = 0; j < TPW; ++j) { mwl[j] = 0.f; mwh[j] = 0.f; }
        static_assert(TPW == 8, "the visit order below is written for 8 tokens per wave");
#pragma unroll 1
        for (int v = 0; v < 64; ++v) {
            const int ss = v >> 3, i = v & 7, i2 = (v + 1) & 7, s2 = (v + 1) >> 3;
            u32x4 xh = mxh[0], xl = mxl[0]; int e_lo = mel[0], e_hi = meh[0], n_lo = mel[0], n_hi = meh[0]; float a_lo = mal[0], a_hi = mah[0], b_lo = mbl[0], b_hi = mbh[0], w_lo = mwl[0], w_hi = mwh[0];
#pragma unroll
            for (int j = 1; j < TPW; ++j) { const bool m = (i == j), m2 = (i2 == j);
                xh[0] = m ? mxh[j][0] : xh[0]; xh[1] = m ? mxh[j][1] : xh[1]; xh[2] = m ? mxh[j][2] : xh[2]; xh[3] = m ? mxh[j][3] : xh[3];
                xl[0] = m ? mxl[j][0] : xl[0]; xl[1] = m ? mxl[j][1] : xl[1]; xl[2] = m ? mxl[j][2] : xl[2]; xl[3] = m ? mxl[j][3] : xl[3];
                e_lo = m ? mel[j] : e_lo; e_hi = m ? meh[j] : e_hi; a_lo = m ? mal[j] : a_lo; a_hi = m ? mah[j] : a_hi; b_lo = m ? mbl[j] : b_lo; b_hi = m ? mbh[j] : b_hi;
                w_lo = m ? mwl[j] : w_lo; w_hi = m ? mwh[j] : w_hi; n_lo = m2 ? mel[j] : n_lo; n_hi = m2 ? meh[j] : n_hi; }
#pragma unroll
            for (int gg = 0; gg < 4; ++gg) {
                const int sn = (sg + 3) & 3;
                if (gg == 0) dma_group(UQ, e_lo, e_hi, ss * 4 + 3, wb + sn * XGRP, lane);
                else if (v < 63) dma_group(UQ, n_lo, n_hi, s2 * 4 + gg - 1, wb + sn * XGRP, lane);
                else dma_group(VQ, n_lo, n_hi, gg - 1, wb + sn * XGRP, lane);
                asm volatile("s_waitcnt vmcnt(24)" ::: "memory");
                u_consume(wb + sg * XGRP, xh, xl, a_lo, a_hi, b_lo, b_hi, ss * 4 + gg, lane, w_lo, w_hi);
                sg = (sg + 1) & 3;
            }
#pragma unroll
            for (int j = 0; j < TPW; ++j) { const bool m = (i == j); mwl[j] = m ? w_lo : mwl[j]; mwh[j] = m ? w_hi : mwh[j]; }
        }
#pragma unroll 1
        for (int i = 0; i < TPW; ++i) {
            const int row = row0 + i * rstride;
            int e_lo = mel[0], e_hi = meh[0], n_lo = mel[0], n_hi = meh[0]; float w_lo = mwl[0], w_hi = mwh[0];
#pragma unroll
            for (int j = 1; j < TPW; ++j) { const bool m = (i == j); e_lo = m ? mel[j] : e_lo; e_hi = m ? meh[j] : e_hi; w_lo = m ? mwl[j] : w_lo; w_hi = m ? mwh[j] : w_hi; }
#pragma unroll
            for (int j = 0; j < TPW - 1; ++j) { const bool m = (i == j); n_lo = m ? mel[j + 1] : n_lo; n_hi = m ? meh[j + 1] : n_hi; }
            float wmax = wave_max(fmaxf(fabsf(w_lo), fabsf(w_hi))); if (wmax == 0.f) wmax = 1.f;
            const float scale_w = wmax * (255.0f / 127.0f), inv_sw = 1.0f / scale_w;
            int acc[32]; int bias[2] = {0, 0};
#pragma unroll
            for (int q = 0; q < 32; ++q) acc[q] = 0;
#pragma unroll 1
            for (int g = 0; g < 32; ++g) {
                const int sn = (sg + 3) & 3;
                if (g + 3 < 32) dma_group(VQ, e_lo, e_hi, g + 3, wb + sn * XGRP, lane);
                else dma_group(VQ, n_lo, n_hi, g + 3 - 32, wb + sn * XGRP, lane);
                asm volatile("s_waitcnt vmcnt(24)" ::: "memory");
                v_consume(wb + sg * XGRP, acc, bias, w_lo, w_hi, inv_sw, g, lane);
                sg = (sg + 1) & 3;
            }
            int ln = lane; asm volatile("" : "+v"(ln));
            exp_epilogue(P, row, ln, acc, bias, scale_w);
        }
        asm volatile("s_waitcnt vmcnt(0)" ::: "memory");
    }
    for (int row = row0 + ((row0 + (TPW - 1) * rstride < NTOK_P) ? TPW * rstride : 0); row < NTOK_P; row += rstride) {
        int ln = lane; asm volatile("" : "+v"(ln));
        const u32x4 xh = *(const u32x4*)(P.ws + WS_X1Q + (size_t)row * D + ln * 32), xl = *(const u32x4*)(P.ws + WS_X1Q + (size_t)row * D + ln * 32 + 16);
        const float sx = SX[row];
        const int e_lo = EIDX[(size_t)row * 128 + ln], e_hi = EIDX[(size_t)row * 128 + 64 + ln];
        const float g_lo = GW[(size_t)row * 128 + ln], g_hi = GW[(size_t)row * 128 + 64 + ln];
        const float a_lo = SU[e_lo] * sx, a_hi = SU[e_hi] * sx, b_lo = g_lo * SV[e_lo], b_hi = g_hi * SV[e_hi];
        float w_lo = 0.f, w_hi = 0.f;
        asm volatile("s_waitcnt vmcnt(0)" ::: "memory");
        dma_group(UQ, e_lo, e_hi, 0, wb, lane); dma_group(UQ, e_lo, e_hi, 1, wb + XGRP, lane); dma_group(UQ, e_lo, e_hi, 2, wb + 2 * XGRP, lane);
        int sg = 0;
#pragma unroll 1
        for (int g = 0; g < 32; ++g) {
            const int sn = (sg + 3) & 3;
            if (g + 3 < 32) dma_group(UQ, e_lo, e_hi, g + 3, wb + sn * XGRP, lane); else dma_group(VQ, e_lo, e_hi, g + 3 - 32, wb + sn * XGRP, lane);
            asm volatile("s_waitcnt vmcnt(24)" ::: "memory");
            u_consume(wb + sg * XGRP, xh, xl, a_lo, a_hi, b_lo, b_hi, g, lane, w_lo, w_hi);
            sg = (sg + 1) & 3;
        }
        float wmax = wave_max(fmaxf(fabsf(w_lo), fabsf(w_hi))); if (wmax == 0.f) wmax = 1.f;
        const float scale_w = wmax * (255.0f / 127.0f), inv_sw = 1.0f / scale_w;
        int acc[32]; int bias[2] = {0, 0};
#pragma unroll
        for (int i = 0; i < 32; ++i) acc[i] = 0;
#pragma unroll 1
        for (int g = 0; g < 32; ++g) {
            const int sn = (sg + 3) & 3;
            dma_group(VQ, e_lo, e_hi, (g + 3) & 31, wb + sn * XGRP, lane);
            asm volatile("s_waitcnt vmcnt(24)" ::: "memory");
            v_consume(wb + sg * XGRP, acc, bias, w_lo, w_hi, inv_sw, g, lane);
            sg = (sg + 1) & 3;
        }
        asm volatile("s_waitcnt vmcnt(0)" ::: "memory");
        exp_epilogue(P, row, ln, acc, bias, scale_w);
    }
    LAS int* cmax = (LAS int*)(lds + MISC_OFF + 64);
    __syncthreads();
    for (int ct = blockIdx.x; ct < NTOK_S; ct += gridDim.x) {
        const int row = NTOK_P + ct;
        int ln = lane; asm volatile("" : "+v"(ln));
        const u32x4 xh = *(const u32x4*)(P.ws + WS_X1Q + (size_t)row * D + ln * 32), xl = *(const u32x4*)(P.ws + WS_X1Q + (size_t)row * D + ln * 32 + 16);
        const float sx = SX[row];
        const int kk = 16 * wave + (ln & 15);
        const int e_loc = EIDX[(size_t)row * 128 + kk]; const float g_loc = GW[(size_t)row * 128 + kk];
        const float a_loc = SU[e_loc] * sx, b_loc = g_loc * SV[e_loc];
        float w_loc = 0.f, w_dummy = 0.f;
        asm volatile("s_waitcnt vmcnt(0)" ::: "memory");
#pragma unroll
        for (int g = 0; g < 4; ++g) dma_group(UQ, e_loc, e_loc, g, wb + g * XGRP, lane);
        asm volatile("s_waitcnt vmcnt(0)" ::: "memory");
#pragma unroll
        for (int g = 0; g < 4; ++g) u_consume(wb + g * XGRP, xh, xl, a_loc, a_loc, b_loc, b_loc, g, lane, w_loc, w_dummy);
#pragma unroll
        for (int g = 0; g < 4; ++g) dma_group(VQ, e_loc, e_loc, g, wb + g * XGRP, lane);
        const float wm = wave_max(ln < 16 ? fabsf(w_loc) : 0.f);
        if (lane == 0) cmax[wave] = __float_as_int(wm);
        __syncthreads();
        float wmax = 0.f;
#pragma unroll
        for (int ww = 0; ww < 8; ++ww) wmax = fmaxf(wmax, __int_as_float(cmax[ww]));
        if (wmax == 0.f) wmax = 1.f;
        const float scale_w = wmax * (255.0f / 127.0f), inv_sw = 1.0f / scale_w;
        int acc[32]; int bias[2] = {0, 0};
#pragma unroll
        for (int i = 0; i < 32; ++i) acc[i] = 0;
        asm volatile("s_waitcnt vmcnt(0)" ::: "memory");
#pragma unroll
        for (int g = 0; g < 4; ++g) v_consume(wb + g * XGRP, acc, bias, w_loc, w_loc, inv_sw, g, lane);
        __builtin_amdgcn_wave_barrier();
        {
            LAS int* pp = (LAS int*)wb + lane * 36;
#pragma unroll
            for (int i = 0; i < 8; ++i) *(LAS u32x4*)(pp + 4 * i) = (u32x4){(unsigned)acc[4 * i], (unsigned)acc[4 * i + 1], (unsigned)acc[4 * i + 2], (unsigned)acc[4 * i + 3]};
            pp[32] = bias[0]; pp[33] = bias[1];
        }
        __syncthreads();
        if (wave == 0) {
#pragma unroll
            for (int i = 0; i < 32; ++i) acc[i] = 0;
            bias[0] = 0; bias[1] = 0;
#pragma unroll 1
            for (int ww = 0; ww < 8; ++ww) {
                const LAS int* pp = (const LAS int*)(lds + ww * XWAVE) + lane * 36;
#pragma unroll
                for (int i = 0; i < 8; ++i) { const u32x4 t = *(const LAS u32x4*)(pp + 4 * i); acc[4 * i] += (int)t[0]; acc[4 * i + 1] += (int)t[1]; acc[4 * i + 2] += (int)t[2]; acc[4 * i + 3] += (int)t[3]; }
                bias[0] += pp[32]; bias[1] += pp[33];
            }
            exp_epilogue(P, row, ln, acc, bias, scale_w);
        }
        __syncthreads();
    }
}

constexpr int NPHASE = 11;
__global__ void __launch_bounds__(NTHREADS, 2) fwd(Params P) {
    extern __shared__ __attribute__((aligned(16))) unsigned char lds_raw[];
    LAS unsigned char* lds = (LAS unsigned char*)lds_raw;
    volatile LAS unsigned* misc = (volatile LAS unsigned*)(lds + MISC_OFF);
    const int lo = P.ph_lo, hi = P.ph_hi;
    XcdBarrier bar; bar.bar = (unsigned*)(P.ws + WS_CTL); bar.x = 0; bar.st = nullptr;
    if (hi - lo > 1) {
        if (threadIdx.x == 0) { misc[0] = 0u; misc[1] = 0u; misc[2] = 0u; misc[3] = 0u; }
        __syncthreads();
        bar = xcd_barrier_post((unsigned*)(P.ws + WS_CTL), misc);
    }
#ifndef MK_REPMASK
#define MK_REPMASK 0
#endif
#ifndef MK_PHASE_MASK
#define MK_PHASE_MASK 0x7ff
#endif
#define IN(k) (((MK_PHASE_MASK >> (k)) & 1) && lo <= (k) && (k) < hi)
#define SEAM(k) do { if (IN(k) && IN((k) + 1)) xcd_barrier(bar); } while (0)
    if (IN(0)) { phase_prologue(P, lds); }
    SEAM(0);
    if (IN(1)) {
        pg8::Gemm g{(const pg8::bf16_t*)(P.ws + WS_XB), (const pg8::bf16_t*)(P.ws + WS_WINT), NTOK, DIN, D};
        pg8::StaticOrder S; S.init(NTOK, DIN, (int)gridDim.x, (int)blockIdx.x);
        EpiProj E{P.out, (bf16_t*)(P.ws + WS_XR), (bf16_t*)(P.ws + WS_GATE), (bf16_t*)(P.ws + WS_QB), (bf16_t*)(P.ws + WS_KB), (bf16_t*)(P.ws + WS_VB16)};
        pg8::gemm_phase<EpiProj, pg8::StaticOrder, false>(lds, g, S, E, nullptr);
        { const int nwg = (NTOK / 256) * (DIN / 256), full = nwg % (int)gridDim.x;
          if (full != 0 && (int)blockIdx.x >= full) quant_tables(P, ((int)blockIdx.x - full) * 8 + (int)(threadIdx.x >> 6), ((int)gridDim.x - full) * 8, 0, MK_QHEAD);
          else if (full == 0) quant_tables(P, (int)blockIdx.x * 8 + (int)(threadIdx.x >> 6), (int)gridDim.x * 8, 0, MK_QHEAD); }
    }
    SEAM(1);
    {
        const bool copy_first = ((blockIdx.x >> 3) & 1) != 0;
        if (IN(3) && copy_first) phase_samp(P, lds);
        if (IN(2)) phase_lru(P, lds);
        if (IN(4)) phase_attn01(P, lds);
        if (IN(3) && !copy_first) phase_samp(P, lds);
    }
    SEAM(4);
    if (IN(5)) { phase_mix_b(P, lds); }
    SEAM(5);
    if (IN(6)) {
        sample_rows_gemm<0>(P, (const bf16_t*)(P.ws + WS_AR), (const bf16_t*)(P.ws + WS_WOT), lds);
        pg8::Gemm g{(const pg8::bf16_t*)(P.ws + WS_AR), (const pg8::bf16_t*)(P.ws + WS_WOT), NTOK_P, D, D};
        pg8::StaticOrder S; S.init(NTOK_P, D, (int)gridDim.x, (int)blockIdx.x);
        EpiOut E{(const bf16_t*)(P.ws + WS_XB), (bf16_t*)(P.ws + WS_PRE1)};
        pg8::gemm_phase<EpiOut, pg8::StaticOrder, false>(lds, g, S, E, nullptr);
    }
    SEAM(6);
    if (IN(7)) { phase_ln1(P); }
    SEAM(7);
    if (IN(8)) {
        sample_rows_gemm<1>(P, (const bf16_t*)(P.ws + WS_X1B), (const bf16_t*)(P.ws + WS_WQT), lds);
        pg8::Gemm g{(const pg8::bf16_t*)(P.ws + WS_X1B), (const pg8::bf16_t*)(P.ws + WS_WQT), NTOK_P, D, D};
        pg8::StaticOrder S; S.init(NTOK_P, D, (int)gridDim.x, (int)blockIdx.x);
        EpiBf16Plain E{(bf16_t*)(P.ws + WS_QP), D};
        pg8::gemm_phase<EpiBf16Plain, pg8::StaticOrder, false>(lds, g, S, E, nullptr);
    }
    SEAM(8);
    if (IN(9)) { phase_route(P, lds); }
    SEAM(9);
    if (IN(10)) { phase_experts(P, lds); }
#undef IN
#undef SEAM
}
}

extern "C" void kernel_launch(void* const* d_in, const int* in_sizes, int n_in, void* d_out, int out_size, void* d_ws, size_t ws_size, hipStream_t stream) {
    using namespace mk;
    static int grid = 0;
    if (grid == 0) {
        if (n_in != 23 || (size_t)out_size != O_END || ws_size < WS_END) { fprintf(stderr, "kernel_launch: unexpected shapes: n_in %d out %d ws %zu (need %zu)\n", n_in, out_size, ws_size, (size_t)WS_END); grid = -1; return; }
        int dev = 0, cus = 0, per_cu = 0;
        if (hipGetDevice(&dev) != hipSuccess || hipDeviceGetAttribute(&cus, hipDeviceAttributeMultiprocessorCount, dev) != hipSuccess) { grid = -1; return; }
        if (hipFuncSetAttribute((const void*)fwd, hipFuncAttributeMaxDynamicSharedMemorySize, LDS_BYTES) != hipSuccess) { fprintf(stderr, "kernel_launch: hipFuncSetAttribute failed\n"); grid = -1; return; }
        if (hipOccupancyMaxActiveBlocksPerMultiprocessor(&per_cu, (const void*)fwd, NTHREADS, LDS_BYTES) != hipSuccess || per_cu < 1) { fprintf(stderr, "kernel_launch: occupancy query says %d\n", per_cu); }
        (void)hipGetLastError();
        grid = cus;
    }
    if (grid < 0) return;
    (void)hipMemsetAsync((char*)d_ws + WS_CTL, 0, 65536, stream);
    Params p{};
    p.x_prompt = (const float*)d_in[0]; p.x_sample = (const float*)d_in[1]; p.cache_k = (const float*)d_in[2]; p.cache_v = (const float*)d_in[3];
    p.state_conv = (const float*)d_in[4]; p.state_h = (const float*)d_in[5]; p.w_in = (const float*)d_in[6]; p.conv_w = (const float*)d_in[7]; p.conv_b = (const float*)d_in[8];
    p.lru_w_a = (const float*)d_in[9]; p.lru_b_a = (const float*)d_in[10]; p.lru_w_x = (const float*)d_in[11]; p.lru_b_x = (const float*)d_in[12]; p.lru_lambda = (const float*)d_in[13];
    p.w_out = (const float*)d_in[14]; p.ln1_g = (const float*)d_in[15]; p.ln1_b = (const float*)d_in[16]; p.w_query = (const float*)d_in[17]; p.sub_keys = (const float*)d_in[18];
    p.peer_u = (const float*)d_in[19]; p.peer_v = (const float*)d_in[20]; p.ln2_g = (const float*)d_in[21]; p.ln2_b = (const float*)d_in[22];
    p.out = (float*)d_out; p.ws = (unsigned char*)d_ws;
#if MK_N_LAUNCHES == 1
    p.ph_lo = 0; p.ph_hi = NPHASE;
    hipLaunchKernelGGL(fwd, dim3(grid), dim3(NTHREADS), LDS_BYTES, stream, p);
#else
    for (int k = 0; k < NPHASE; ++k) { p.ph_lo = k; p.ph_hi = k + 1; hipLaunchKernelGGL(fwd, dim3(grid), dim3(NTHREADS), LDS_BYTES, stream, p);
#ifdef MK_EXTRA_PHASE
        if (k == MK_EXTRA_PHASE) hipLaunchKernelGGL(fwd, dim3(grid), dim3(NTHREADS), LDS_BYTES, stream, p);
#endif
    }
#endif
    const hipError_t le = hipPeekAtLastError();
    if (le != hipSuccess) fprintf(stderr, "kernel_launch: launch failed: %s\n", hipGetErrorName(le));
}
```

```cpp
#include <hip/hip_runtime.h>
#include <cstdio>
#include <cstdint>
namespace pg8 {
#define PG8_LAS __attribute__((address_space(3)))
typedef unsigned short bf16_t;
typedef short bf16x8 __attribute__((ext_vector_type(8)));
typedef float f32x4 __attribute__((ext_vector_type(4)));
typedef unsigned u32x4 __attribute__((ext_vector_type(4)));
constexpr int BM = 256, BK = 64, HALF = 128, HTB = HALF * BK * 2  , STAGE_BYTES = 8 * HTB, NXCD = 8, WGM = 8;

__host__ __device__ __forceinline__ int lds_byte(int r, int c) { const int st = (r >> 4) * 2 + (c >> 5), rr = r & 15, cc = c & 31, ob = rr * 64 + cc * 2; return st * 1024 + (ob ^ (((ob >> 9) & 1) << 5)); }
__host__ __device__ __forceinline__ void stage_rc(int b, int& R, int& C) { const int st = b / 1024, sb = b % 1024, swz = sb ^ (((sb >> 9) & 1) << 5); R = (st >> 1) * 16 + swz / 64; C = (st & 1) * 32 + (swz % 64) / 2; }
__host__ __device__ __forceinline__ int perm32(int rho) { const int n = rho >> 4, i = rho & 15; return 8 * (i >> 2) + 4 * n + (i & 3); }

struct Unit { int pm, pn; };
struct Gemm { const bf16_t* A; const bf16_t* Bt; int M, N, K; };

struct StaticOrder {
    int nM, nN, nwg, G, c;
    __host__ __device__ void init(int M, int N, int G_, int c_) { nM = M / BM; nN = N / BM; nwg = nM * nN; G = G_; c = c_; }
    __host__ __device__ bool next(int i, Unit& u) const {
        const long L = (long)i * G + c; if (L >= nwg) return false;
        int wgid = (int)L; { const int q = nwg / NXCD, r = nwg % NXCD, xcd = wgid % NXCD, off = wgid / NXCD; wgid = (xcd < r ? xcd * (q + 1) : r * (q + 1) + (xcd - r) * q) + off; }
        const int nig = WGM * nN, gid = wgid / nig, fm = gid * WGM, gsz = (nM - fm) < WGM ? (nM - fm) : WGM;
        u.pm = fm + ((wgid % nig) % gsz); u.pn = (wgid % nig) / gsz; return true;
    }
    __device__ __forceinline__ void a_ready(const Unit&) const {}
    __device__ __forceinline__ void done(const Unit&) const {}
};
struct CountedOrder : StaticOrder {
    const unsigned* ready; unsigned need; unsigned* tmo;
    __device__ __forceinline__ void a_ready(const Unit& u) const {
        if (threadIdx.x < 64) {
            const unsigned long long t0 = __builtin_amdgcn_s_memrealtime(); unsigned polls = 0;
            while ((unsigned)__builtin_amdgcn_readfirstlane(__hip_atomic_load(ready + 64 * u.pm, __ATOMIC_RELAXED, __HIP_MEMORY_SCOPE_AGENT)) < need) {
                if ((++polls & 255u) == 0u && __builtin_amdgcn_readfirstlane(__hip_atomic_load(tmo, __ATOMIC_RELAXED, __HIP_MEMORY_SCOPE_AGENT)) != 0u) break;
                if (__builtin_amdgcn_s_memrealtime() - t0 > 2000000ull) {
                    if (threadIdx.x == 0) { unsigned expect = 0u; __hip_atomic_compare_exchange_strong(tmo + 1, &expect, 0x600u | (unsigned)(u.pm & 0xff), __ATOMIC_RELAXED, __ATOMIC_RELAXED, __HIP_MEMORY_SCOPE_AGENT); __hip_atomic_store(tmo, 1u, __ATOMIC_RELAXED, __HIP_MEMORY_SCOPE_AGENT); }
                    break; }
                __builtin_amdgcn_s_sleep(2); }
            __builtin_amdgcn_fence(__ATOMIC_ACQUIRE, "agent");
            asm volatile("s_waitcnt vmcnt(0)" ::: "memory");
        }
#if !defined(BROKEN_HOOK_NO_BARRIER)
        asm volatile("" ::: "memory"); __builtin_amdgcn_s_barrier(); asm volatile("" ::: "memory");
#endif
    }
};

__device__ __forceinline__ unsigned cvt_pk_bf16(float lo, float hi) { unsigned r; asm volatile("v_cvt_pk_bf16_f32 %0, %1, %2" : "=v"(r) : "v"(lo), "v"(hi)); return r; }
typedef float f32x2 __attribute__((ext_vector_type(2)));
__device__ __forceinline__ f32x2 gelu_pk(f32x2 v) {
    const f32x2 av = __builtin_elementwise_abs(v), d = av * 0.2316418882f + 1.0f;
    f32x2 t; t.x = __builtin_amdgcn_rcpf(d.x); t.y = __builtin_amdgcn_rcpf(d.y);
    f32x2 q = t * 0.5307027145f + (-0.7265760135f); q = q * t + 0.7107068705f; q = q * t + (-0.142248368f); q = q * t + 0.127414796f; q = q * t;
    const f32x2 s = (v * v) * (-0.72134752044f);
    f32x2 e; e.x = __builtin_amdgcn_exp2f(s.x); e.y = __builtin_amdgcn_exp2f(s.y);
    const f32x2 m = v * (q * e), r = v - m;
    f32x2 o; o.x = v.x < 0.f ? m.x : r.x; o.y = v.y < 0.f ? m.y : r.y; return o;
}

struct EpiF32 {
    static constexpr bool PERM = false, AFTER_DRAIN = false;
    float* C; int ldc; const float* bias;
    __device__ __forceinline__ void operator()(const f32x4 (&acc)[2][2][4][2], const Unit& u, int wr, int wc, int fr, int fq) const {
        const int row0 = u.pm * BM + wr * 64 + fr, col0 = u.pn * BM + wc * 32 + 4 * fq;
        f32x4 bv[2][2];
#pragma unroll
        for (int bj = 0; bj < 2; ++bj)
#pragma unroll
            for (int n = 0; n < 2; ++n) bv[bj][n] = bias ? *(const f32x4*)(bias + col0 + bj * HALF + n * 16) : (f32x4){0.f, 0.f, 0.f, 0.f};
#pragma unroll
        for (int ai = 0; ai < 2; ++ai)
#pragma unroll
            for (int m = 0; m < 4; ++m) { float* rowp = C + (size_t)(row0 + ai * HALF + m * 16) * ldc + col0;
#pragma unroll
                for (int bj = 0; bj < 2; ++bj)
#pragma unroll
                    for (int n = 0; n < 2; ++n) *(f32x4*)(rowp + bj * HALF + n * 16) = acc[ai][bj][m][n] + bv[bj][n]; }
    }
};
template <int ACT  > struct EpiBf16 {
    static constexpr bool PERM = true, AFTER_DRAIN = false;
    bf16_t* O; int ldc; const float* bias; int split_cols; size_t split_stride;
    __device__ __forceinline__ void operator()(const f32x4 (&acc)[2][2][4][2], const Unit& u, int wr, int wc, int fr, int fq) const {
        const int row0 = u.pm * BM + wr * 64 + fr; int colt = u.pn * BM; bf16_t* base = O;
        if (split_cols) { const int t = colt / split_cols; base += (size_t)t * split_stride; colt -= t * split_cols; }
        const int col0 = colt + wc * 32 + 8 * fq, bcol0 = u.pn * BM + wc * 32 + 8 * fq;
        f32x4 bv[2][2];
#pragma unroll
        for (int bj = 0; bj < 2; ++bj)
#pragma unroll
            for (int n = 0; n < 2; ++n) bv[bj][n] = bias ? *(const f32x4*)(bias + bcol0 + bj * HALF + 4 * n) : (f32x4){0.f, 0.f, 0.f, 0.f};
#pragma unroll
        for (int ai = 0; ai < 2; ++ai)
#pragma unroll
            for (int m = 0; m < 4; ++m) { bf16_t* rowp = base + (size_t)(row0 + ai * HALF + m * 16) * ldc + col0;
#pragma unroll
                for (int bj = 0; bj < 2; ++bj) { f32x4 v0 = acc[ai][bj][m][0] + bv[bj][0], v1 = acc[ai][bj][m][1] + bv[bj][1];
                    if (ACT == 1) { f32x2 a = gelu_pk((f32x2){v0[0], v0[1]}), b = gelu_pk((f32x2){v0[2], v0[3]}), c = gelu_pk((f32x2){v1[0], v1[1]}), d = gelu_pk((f32x2){v1[2], v1[3]});
                        v0 = (f32x4){a.x, a.y, b.x, b.y}; v1 = (f32x4){c.x, c.y, d.x, d.y}; }
                    if (ACT == 2) {
#pragma unroll
                        for (int j = 0; j < 4; ++j) { v0[j] = 0.5f * v0[j] * (1.0f + erff(v0[j] * 0.70710678f)); v1[j] = 0.5f * v1[j] * (1.0f + erff(v1[j] * 0.70710678f)); } }
                    u32x4 w; w.x = cvt_pk_bf16(v0[0], v0[1]); w.y = cvt_pk_bf16(v0[2], v0[3]); w.z = cvt_pk_bf16(v1[0], v1[1]); w.w = cvt_pk_bf16(v1[2], v1[3]);
                    *(u32x4*)(rowp + bj * HALF) = w; } }
    }
};

struct PanelStats {
    unsigned* xbuf;
    unsigned* cnt;
    unsigned* tmo;
    int ntn; float eps;
    unsigned code;
    __device__ __forceinline__ bool run(const f32x4 (&v)[2][2][4][2], const Unit& u, int wr, int wc, int fr, int fq, PG8_LAS unsigned char* lds, int wid, int lane) const {
        typedef float f32x2v __attribute__((ext_vector_type(2)));
        PG8_LAS f32x2v* P = (PG8_LAS f32x2v*)lds;
        PG8_LAS f32x2v* S = (PG8_LAS f32x2v*)(lds + 8192);
        PG8_LAS unsigned* flag = (PG8_LAS unsigned*)(lds + 8192 + 2048);
#pragma unroll
        for (int ai = 0; ai < 2; ++ai)
#pragma unroll
            for (int m = 0; m < 4; ++m) {
                float s = 0.f;
#pragma unroll
                for (int bj = 0; bj < 2; ++bj)
#pragma unroll
                    for (int n = 0; n < 2; ++n) { const f32x4 x = v[ai][bj][m][n]; s += (x[0] + x[1]) + (x[2] + x[3]); }
                s += __shfl_xor(s, 16); s += __shfl_xor(s, 32);
                const float mw = s * (1.0f / 64.0f); float q = 0.f;
#pragma unroll
                for (int bj = 0; bj < 2; ++bj)
#pragma unroll
                    for (int n = 0; n < 2; ++n) { const f32x4 d = v[ai][bj][m][n] - mw; q += (d[0] * d[0] + d[1] * d[1]) + (d[2] * d[2] + d[3] * d[3]); }
                q += __shfl_xor(q, 16); q += __shfl_xor(q, 32);
                if (fq == 0) P[(ai * HALF + wr * 64 + m * 16 + fr) * 4 + wc] = (f32x2v){mw, q};
            }
        asm volatile("s_waitcnt lgkmcnt(0)" ::: "memory"); __builtin_amdgcn_s_barrier(); asm volatile("" ::: "memory");
#if defined(BROKEN_NO_WAIT)
        if (blockIdx.x >= 64) { const long long t0 = clock64(); while (clock64() - t0 < 60000) __builtin_amdgcn_s_sleep(8); }
#endif
        const int row = wid * 32 + (lane & 31);
        if (lane < 32) {
            const f32x2v a = P[row * 4 + 0], b = P[row * 4 + 1], c = P[row * 4 + 2], d = P[row * 4 + 3];
            const float mt = (a.x + b.x + c.x + d.x) * 0.25f;
            const float da = a.x - mt, db = b.x - mt, dc = c.x - mt, dd = d.x - mt;
            const float m2 = (a.y + b.y) + (c.y + d.y) + 64.0f * ((da * da + db * db) + (dc * dc + dd * dd));
            unsigned long long* slot = (unsigned long long*)xbuf + ((size_t)(u.pm * BM + row) * 4 + u.pn);
            __hip_atomic_store(slot, ((unsigned long long)__float_as_uint(m2) << 32) | __float_as_uint(mt), __ATOMIC_RELAXED, __HIP_MEMORY_SCOPE_AGENT);
        }
        asm volatile("s_waitcnt vmcnt(0)" ::: "memory");
        if (lane == 0) __hip_atomic_fetch_add(cnt + 64 * u.pm, 1u, __ATOMIC_RELAXED, __HIP_MEMORY_SCOPE_AGENT);
        if (wid == 0) {
            bool dead = false; const unsigned long long t0 = __builtin_amdgcn_s_memrealtime(); const unsigned want = 8u * (unsigned)ntn;
            for (;;) {
#if defined(BROKEN_NO_WAIT)
                break;
#endif
                if ((unsigned)__builtin_amdgcn_readfirstlane(__hip_atomic_load(cnt + 64 * u.pm, __ATOMIC_RELAXED, __HIP_MEMORY_SCOPE_AGENT)) >= want) break;
                if (__builtin_amdgcn_s_memrealtime() - t0 > 2000000ull) {
                    if (lane == 0) { unsigned expect = 0u; __hip_atomic_compare_exchange_strong(tmo + 1, &expect, code | (unsigned)(u.pm & 0xff), __ATOMIC_RELAXED, __ATOMIC_RELAXED, __HIP_MEMORY_SCOPE_AGENT);
                                     __hip_atomic_store(tmo, 1u, __ATOMIC_RELAXED, __HIP_MEMORY_SCOPE_AGENT); }
                    dead = true; break; }
                __builtin_amdgcn_s_sleep(2);
            }
            __builtin_amdgcn_fence(__ATOMIC_ACQUIRE, "agent");
            if (lane == 0) flag[0] = dead ? 1u : 0u;
        }
        asm volatile("s_waitcnt vmcnt(0) lgkmcnt(0)" ::: "memory"); __builtin_amdgcn_s_barrier(); asm volatile("" ::: "memory");
        const bool bad = flag[0] != 0u;
        if (lane < 32) {
            const unsigned long long* slot = (const unsigned long long*)xbuf + (size_t)(u.pm * BM + row) * 4; float mt[4], m2[4]; float ms = 0.f;
#pragma unroll
            for (int t = 0; t < 4; ++t) { if (t < ntn) { const unsigned long long w = __hip_atomic_load(slot + t, __ATOMIC_RELAXED, __HIP_MEMORY_SCOPE_AGENT); mt[t] = __uint_as_float((unsigned)w); m2[t] = __uint_as_float((unsigned)(w >> 32)); } else { mt[t] = 0.f; m2[t] = 0.f; } ms += mt[t]; }
            const float mean = ms / (float)ntn; float q = 0.f;
#pragma unroll
            for (int t = 0; t < 4; ++t) if (t < ntn) { const float dm = mt[t] - mean; q += m2[t] + 256.0f * dm * dm; }
            S[row] = (f32x2v){mean, 1.0f / sqrtf(q / (256.0f * (float)ntn) + eps)};
        }
        asm volatile("s_waitcnt lgkmcnt(0)" ::: "memory"); __builtin_amdgcn_s_barrier(); asm volatile("" ::: "memory");
        return bad;
    }
};
struct EpiLnRes {
    static constexpr bool PERM = false, AFTER_DRAIN = true;
    const float* base; float* out; int ldc; const float* bias; PanelStats st; unsigned poison;
    __device__ __forceinline__ void refuse(size_t i0, size_t stride, int M, int N) const { const float q = __builtin_nanf(""); for (size_t i = i0; i < (size_t)M * N; i += stride) out[(i / N) * ldc + i % N] = q;
        if (i0 == 0) { unsigned expect = 0u; __hip_atomic_compare_exchange_strong(st.tmo + 1, &expect, 0x7f0u, __ATOMIC_RELAXED, __ATOMIC_RELAXED, __HIP_MEMORY_SCOPE_AGENT); __hip_atomic_store(st.tmo, 1u, __ATOMIC_RELAXED, __HIP_MEMORY_SCOPE_AGENT); } }
    __device__ __forceinline__ void fused(f32x4 (&acc)[2][2][4][2], const Unit& u, int wr, int wc, int fr, int fq, PG8_LAS unsigned char* lds, int wid, int lane) const {
        typedef float f32x2v __attribute__((ext_vector_type(2)));
        const PG8_LAS f32x2v* S = (const PG8_LAS f32x2v*)(lds + 8192);
        const int col0 = u.pn * BM + wc * 32 + 4 * fq;
#pragma unroll
        for (int bj = 0; bj < 2; ++bj)
#pragma unroll
            for (int n = 0; n < 2; ++n) { const f32x4 bv = bias ? *(const f32x4*)(bias + col0 + bj * HALF + n * 16) : (f32x4){0.f, 0.f, 0.f, 0.f};
#pragma unroll
                for (int ai = 0; ai < 2; ++ai)
#pragma unroll
                    for (int m = 0; m < 4; ++m) acc[ai][bj][m][n] += bv; }
        const bool bad = st.run(acc, u, wr, wc, fr, fq, lds, wid, lane) || poison != 0u;
        const float qnan = __builtin_nanf("");
#pragma unroll
        for (int ai = 0; ai < 2; ++ai)
#pragma unroll
            for (int m = 0; m < 4; ++m) { const int r = ai * HALF + wr * 64 + m * 16 + fr; const f32x2v sr = S[r]; const size_t off = (size_t)(u.pm * BM + r) * ldc + col0;
#pragma unroll
                for (int bj = 0; bj < 2; ++bj)
#pragma unroll
                    for (int n = 0; n < 2; ++n) { const f32x4 bs = *(const f32x4*)(base + off + bj * HALF + n * 16); f32x4 o = bs + (acc[ai][bj][m][n] - sr.x) * sr.y;
                        if (bad) o = (f32x4){qnan, qnan, qnan, qnan}; *(f32x4*)(out + off + bj * HALF + n * 16) = o; }
                asm volatile("" ::: "memory"); }
    }
};
struct EpiLnResLn {
    static constexpr bool PERM = false, AFTER_DRAIN = true;
    const float* base; float* out; bf16_t* xn; int ldc; const float* bias; PanelStats st1, st2; unsigned poison;
    __device__ __forceinline__ void refuse(size_t i0, size_t stride, int M, int N) const { const float q = __builtin_nanf(""); for (size_t i = i0; i < (size_t)M * N; i += stride) { const size_t o = (i / N) * ldc + i % N; out[o] = q; xn[o] = (bf16_t)0x7fc0u; }
        if (i0 == 0) { unsigned expect = 0u; __hip_atomic_compare_exchange_strong(st1.tmo + 1, &expect, 0x7f0u, __ATOMIC_RELAXED, __ATOMIC_RELAXED, __HIP_MEMORY_SCOPE_AGENT); __hip_atomic_store(st1.tmo, 1u, __ATOMIC_RELAXED, __HIP_MEMORY_SCOPE_AGENT); } }
    __device__ __forceinline__ void fused(f32x4 (&acc)[2][2][4][2], const Unit& u, int wr, int wc, int fr, int fq, PG8_LAS unsigned char* lds, int wid, int lane) const {
        typedef float f32x2v __attribute__((ext_vector_type(2))); typedef unsigned u32x2v __attribute__((ext_vector_type(2)));
        const PG8_LAS f32x2v* S = (const PG8_LAS f32x2v*)(lds + 8192);
        const int col0 = u.pn * BM + wc * 32 + 4 * fq;
#pragma unroll
        for (int bj = 0; bj < 2; ++bj)
#pragma unroll
            for (int n = 0; n < 2; ++n) { const f32x4 bv = bias ? *(const f32x4*)(bias + col0 + bj * HALF + n * 16) : (f32x4){0.f, 0.f, 0.f, 0.f};
#pragma unroll
                for (int ai = 0; ai < 2; ++ai)
#pragma unroll
                    for (int m = 0; m < 4; ++m) acc[ai][bj][m][n] += bv; }
        bool bad = st1.run(acc, u, wr, wc, fr, fq, lds, wid, lane) || poison != 0u;
        const float qnan = __builtin_nanf("");
#pragma unroll
        for (int ai = 0; ai < 2; ++ai)
#pragma unroll
            for (int m = 0; m < 4; ++m) { const int r = ai * HALF + wr * 64 + m * 16 + fr; const f32x2v sr = S[r]; const size_t off = (size_t)(u.pm * BM + r) * ldc + col0;
#pragma unroll
                for (int bj = 0; bj < 2; ++bj)
#pragma unroll
                    for (int n = 0; n < 2; ++n) { const f32x4 bs = *(const f32x4*)(base + off + bj * HALF + n * 16); acc[ai][bj][m][n] = bs + (acc[ai][bj][m][n] - sr.x) * sr.y; }
                asm volatile("" : "+v"(acc[ai][0][m][0]), "+v"(acc[ai][0][m][1]), "+v"(acc[ai][1][m][0]), "+v"(acc[ai][1][m][1]));
                if (m & 1) asm volatile("" ::: "memory"); }
        const bool bad1 = bad;
        bad = st2.run(acc, u, wr, wc, fr, fq, lds, wid, lane) || bad;
#pragma unroll
        for (int ai = 0; ai < 2; ++ai)
#pragma unroll
            for (int m = 0; m < 4; ++m) { const int r = ai * HALF + wr * 64 + m * 16 + fr; const f32x2v sr = S[r]; const size_t off = (size_t)(u.pm * BM + r) * ldc + col0;
#pragma unroll
                for (int bj = 0; bj < 2; ++bj)
#pragma unroll
                    for (int n = 0; n < 2; ++n) { const f32x4 x1 = acc[ai][bj][m][n]; *(f32x4*)(out + off + bj * HALF + n * 16) = bad1 ? (f32x4){qnan, qnan, qnan, qnan} : x1;
                        const f32x4 o = (x1 - sr.x) * sr.y; u32x2v w; w.x = cvt_pk_bf16(o[0], o[1]); w.y = cvt_pk_bf16(o[2], o[3]);
                        if (bad) { w.x = 0x7fc07fc0u; w.y = 0x7fc07fc0u; } *(u32x2v*)(xn + off + bj * HALF + n * 16) = w; }
                asm volatile("" ::: "memory"); }
    }
};

template <class Epi, class Sched, bool STAMP = false>
__device__ __forceinline__ void gemm_phase(PG8_LAS unsigned char* lds, const Gemm g, const Sched& S, const Epi& E, unsigned long long* stamps) {
    const int tid = threadIdx.x, wid = __builtin_amdgcn_readfirstlane(tid >> 6), lane = tid & 63, wr = wid >> 2, wc = wid & 3, fr = lane & 15, fq = lane >> 4;
    const int K = g.K, nt = K / BK;
    int ts_lo = 0, ts_hi = 0, nts = 0; const unsigned long long rt_entry = STAMP ? (unsigned long long)wall_clock64() : 0ull;
#define PG8_STAMP() do { if (STAMP && wid == 0 && nts < 64) { const unsigned long long _c = (unsigned long long)clock64(); \
        ts_lo = (lane == nts) ? (int)(unsigned)_c : ts_lo; ts_hi = (lane == nts) ? (int)(unsigned)(_c >> 32) : ts_hi; ++nts; } } while (0)
    PG8_STAMP();
    unsigned voffA[2], voffB[2];
#pragma unroll
    for (int i = 0; i < 2; ++i) { int R, C; stage_rc(tid * 16 + i * 8192, R, C); const int Rb = Epi::PERM ? ((R & ~31) + perm32(R & 31)) : R;
        voffA[i] = (unsigned)(R * K + C) * 2u; voffB[i] = (unsigned)(Rb * K + C) * 2u; }
    const size_t kstep = (size_t)(BK * 2);
    const size_t hstep = (size_t)HALF * K * 2;
    const size_t tstep = 2 * hstep;
    const unsigned ldsw = (unsigned)wid * 1024u;
    const int aoff = lds_byte(wr * 64 + fr, fq * 8), boff = lds_byte(wc * 32 + fr, fq * 8);
#define PG8_SA(b, h) (((b) * 2 + (h)) * HTB)
#define PG8_SB(b, h) ((4 + (b) * 2 + (h)) * HTB)
#define PG8_STAGE(bufoff, gbase, voff) do { _Pragma("unroll") for (int _i = 0; _i < 2; ++_i) \
        __builtin_amdgcn_global_load_lds((const unsigned*)((const char*)(gbase) + (voff)[_i]), (PG8_LAS unsigned*)(lds + (bufoff) + ldsw + _i * 8192), 16, 0, 0); } while (0)
#define PG8_LDA(dst, b, h) do { _Pragma("unroll") for (int m = 0; m < 4; ++m) _Pragma("unroll") for (int k = 0; k < 2; ++k) dst[m][k] = *(const PG8_LAS bf16x8*)(lds + PG8_SA(b, h) + aoff + m * 2048 + k * 1024); } while (0)
#define PG8_LDB(dst, b, h) do { _Pragma("unroll") for (int n = 0; n < 2; ++n) _Pragma("unroll") for (int k = 0; k < 2; ++k) dst[n][k] = *(const PG8_LAS bf16x8*)(lds + PG8_SB(b, h) + boff + n * 2048 + k * 1024); } while (0)
#define PG8_MMA(ai, bj, At, Bt) do { __builtin_amdgcn_s_setprio(1); _Pragma("unroll") for (int m = 0; m < 4; ++m) _Pragma("unroll") for (int n = 0; n < 2; ++n) _Pragma("unroll") for (int k = 0; k < 2; ++k) \
        acc[ai][bj][m][n] = __builtin_amdgcn_mfma_f32_16x16x32_bf16(Bt[n][k], At[m][k], acc[ai][bj][m][n], 0, 0, 0); __builtin_amdgcn_s_setprio(0); } while (0)
#define PG8_WAIT_V(n) asm volatile("s_waitcnt vmcnt(" #n ")" ::: "memory")
#define PG8_WAIT_L(n) asm volatile("s_waitcnt lgkmcnt(" #n ")" ::: "memory")
#define PG8_BAR __builtin_amdgcn_s_barrier()
#define PG8_SCHED __builtin_amdgcn_sched_barrier(0)
    Unit cur, nxt; int ui = 0;
    if (!S.next(0, cur)) return;
    f32x4 acc[2][2][4][2];
#pragma unroll
    for (int a = 0; a < 2; ++a)
#pragma unroll
        for (int b = 0; b < 2; ++b)
#pragma unroll
            for (int m = 0; m < 4; ++m)
#pragma unroll
                for (int n = 0; n < 2; ++n) acc[a][b][m][n] = (f32x4){0.f, 0.f, 0.f, 0.f};
    bf16x8 At[4][2], B0[2][2], B1[2][2];
    const char* cA = (const char*)g.A + (size_t)cur.pm * tstep; const char* cB = (const char*)g.Bt + (size_t)cur.pn * tstep;
    S.a_ready(cur);
    PG8_STAGE(PG8_SB(0, 0), cB, voffB); PG8_STAGE(PG8_SA(0, 0), cA, voffA); PG8_STAGE(PG8_SB(0, 1), cB + hstep, voffB); PG8_STAGE(PG8_SA(0, 1), cA + hstep, voffA);
    if (wr == 1) PG8_BAR;
    PG8_WAIT_V(4); PG8_BAR;
    PG8_STAGE(PG8_SB(1, 0), cB + kstep, voffB); PG8_STAGE(PG8_SA(1, 0), cA + kstep, voffA); PG8_STAGE(PG8_SB(1, 1), cB + hstep + kstep, voffB);
    PG8_WAIT_V(6); PG8_BAR;
    PG8_STAMP();
    for (;;) {
        const bool has_next = S.next(ui + 1, nxt);
        const char* nA = has_next ? (const char*)g.A + (size_t)nxt.pm * tstep : cA; const char* nB = has_next ? (const char*)g.Bt + (size_t)nxt.pn * tstep : cB;
        for (int t = 0; t < nt; t += 2) {
            const bool last = (t == nt - 2);
            const char* a1 = cA + (size_t)(t + 1) * kstep;
            const char* a2 = last ? nA : cA + (size_t)(t + 2) * kstep; const char* b2 = last ? nB : cB + (size_t)(t + 2) * kstep;
            const char* a3 = a2 + kstep; const char* b3 = b2 + kstep;
            if (last && has_next) S.a_ready(nxt);
            PG8_LDB(B0, 0, 0); PG8_SCHED; PG8_LDA(At, 0, 0); PG8_STAGE(PG8_SA(1, 1), a1 + hstep, voffA);
            PG8_WAIT_L(8); PG8_BAR; PG8_WAIT_L(0); PG8_MMA(0, 0, At, B0); PG8_BAR; PG8_SCHED;
            PG8_LDB(B1, 0, 1); PG8_STAGE(PG8_SB(0, 0), b2, voffB);
            PG8_BAR; PG8_WAIT_L(0); PG8_MMA(0, 1, At, B1); PG8_BAR;
            PG8_LDA(At, 0, 1); PG8_STAGE(PG8_SA(0, 0), a2, voffA);
            PG8_BAR; PG8_WAIT_L(0); PG8_MMA(1, 0, At, B0); PG8_BAR; PG8_SCHED;
            PG8_STAGE(PG8_SB(0, 1), b2 + hstep, voffB);
            PG8_WAIT_V(6); PG8_BAR; PG8_MMA(1, 1, At, B1); PG8_BAR;
            PG8_LDB(B0, 1, 0); PG8_SCHED; PG8_LDA(At, 1, 0); PG8_STAGE(PG8_SA(0, 1), a2 + hstep, voffA);
            PG8_WAIT_L(8); PG8_BAR; PG8_WAIT_L(0); PG8_MMA(0, 0, At, B0); PG8_BAR; PG8_SCHED;
            PG8_LDB(B1, 1, 1); PG8_STAGE(PG8_SB(1, 0), b3, voffB);
            PG8_BAR; PG8_WAIT_L(0); PG8_MMA(0, 1, At, B1); PG8_BAR;
            PG8_LDA(At, 1, 1); PG8_STAGE(PG8_SA(1, 0), a3, voffA);
            PG8_BAR; PG8_WAIT_L(0); PG8_MMA(1, 0, At, B0); PG8_BAR; PG8_SCHED;
            PG8_STAGE(PG8_SB(1, 1), b3 + hstep, voffB);
            PG8_WAIT_V(6); PG8_BAR; PG8_MMA(1, 1, At, B1); PG8_BAR;
        }
        PG8_STAMP();
        if constexpr (!Epi::AFTER_DRAIN) { E(acc, cur, wr, wc, fr, fq); S.done(cur); }
        PG8_STAMP();
        if (!has_next) break;
#pragma unroll
        for (int a = 0; a < 2; ++a)
#pragma unroll
            for (int b = 0; b < 2; ++b)
#pragma unroll
                for (int m = 0; m < 4; ++m)
#pragma unroll
                    for (int n = 0; n < 2; ++n) acc[a][b][m][n] = (f32x4){0.f, 0.f, 0.f, 0.f};
        cur = nxt; cA = nA; cB = nB; ++ui;
    }
    PG8_WAIT_V(0);
    if (wr == 0) PG8_BAR;
    PG8_BAR;
    if constexpr (Epi::AFTER_DRAIN) { E.fused(acc, cur, wr, wc, fr, fq, lds, wid, lane); S.done(cur); }
    PG8_STAMP();
    if (STAMP && wid == 0) { stamps[lane] = lane < nts ? (((unsigned long long)(unsigned)ts_hi << 32) | (unsigned)ts_lo) : 0ull;
        if (lane == 62) stamps[62] = rt_entry; if (lane == 63) stamps[63] = (unsigned long long)wall_clock64(); }
#undef PG8_STAMP
#undef PG8_SA
#undef PG8_SB
#undef PG8_STAGE
#undef PG8_LDA
#undef PG8_LDB
#undef PG8_MMA
#undef PG8_WAIT_V
#undef PG8_WAIT_L
#undef PG8_BAR
#undef PG8_SCHED
}
}
#define XB_TMO      128
#define XB_XCNT(j)  (256  + 64 * (j))
#define XB_XSUB(j)  (1280 + 64 * (j))
#define XB_XGEN(j)  (2304 + 64 * (j))
#define XB_TOP      3328
#define XB_TOPGEN   3392
#define XCD_BAR_WORDS 3456
#define XB_SPIN_CAP (1u << 18)
#define LAS __attribute__((address_space(3)))

__device__ __forceinline__ unsigned xb_ld(unsigned* p)              { return __hip_atomic_load(p, __ATOMIC_RELAXED, __HIP_MEMORY_SCOPE_AGENT); }
__device__ __forceinline__ unsigned xb_add(unsigned* p, unsigned v) { return __hip_atomic_fetch_add(p, v, __ATOMIC_RELAXED, __HIP_MEMORY_SCOPE_AGENT); }
__device__ __forceinline__ unsigned xb_xcc_id() { return (unsigned)__builtin_amdgcn_s_getreg((3 << 11) | 20) & 0xFu; }
#define XB_SPIN(cond, bar) do { unsigned _sp = 0; while (cond) { __builtin_amdgcn_s_sleep(1); \
    if ((++_sp & 255u) == 0u) { if (xb_ld(&(bar)[XB_TMO])) break; if (_sp > XB_SPIN_CAP) { atomicAdd(&(bar)[XB_TMO], 1u); break; } } } } while (0)

struct XcdBarrier {
    unsigned* bar; unsigned x;
    volatile LAS unsigned* st;
};

__device__ __forceinline__ XcdBarrier xcd_barrier_post(unsigned* bar, volatile LAS unsigned* st) {
    XcdBarrier b; b.bar = bar; b.x = xb_xcc_id(); b.st = st;
    if (threadIdx.x == 0) (void)xb_add(&bar[XB_XCNT(b.x)], 1u);
    return b;
}
__device__ __forceinline__ void xcd_barrier_complete(unsigned* bar, unsigned x, unsigned& nloc, unsigned& nx) {
    const unsigned G = gridDim.x * gridDim.y * gridDim.z;
    unsigned sum, cnt, mine, sp = 0u;
    for (;;) {
        sum = 0u; cnt = 0u; mine = 0u;
#pragma unroll
        for (unsigned j = 0; j < 16; ++j) { const unsigned c = xb_ld(&bar[XB_XCNT(j)]); sum += c; cnt += (c > 0u) ? 1u : 0u; mine = (j == x) ? c : mine; }
        if (sum == G) break;
        __builtin_amdgcn_s_sleep(1);
        if ((++sp & 255u) == 0u) { if (xb_ld(&bar[XB_TMO])) break; if (sp > XB_SPIN_CAP) { atomicAdd(&bar[XB_TMO], 1u); break; } }
    }
    nloc = mine > 0u ? mine : 1u; nx = cnt > 0u ? cnt : 1u;
}

__device__ __forceinline__ void xcd_barrier(const XcdBarrier& b) {
    asm volatile("s_waitcnt vmcnt(0)" ::: "memory");
    __syncthreads();
    if (threadIdx.x == 0) {
        unsigned* bar = b.bar;
        __builtin_amdgcn_s_waitcnt(0);
        unsigned nloc = b.st[0], nx = b.st[1];
        if (nloc == 0u) { xcd_barrier_complete(bar, b.x, nloc, nx); b.st[0] = nloc; b.st[1] = nx; }
        const unsigned old = xb_add(&bar[XB_XSUB(b.x)], 1u);
        const unsigned gen = old / nloc;
        if (old + 1u == (gen + 1u) * nloc) {
            __builtin_amdgcn_fence(__ATOMIC_RELEASE, "agent");
            asm volatile("s_waitcnt vmcnt(0)" ::: "memory");
            const unsigned og = xb_add(&bar[XB_TOP], 1u);
            const unsigned tg = og / nx;
            if (og + 1u == (tg + 1u) * nx) xb_add(&bar[XB_TOPGEN], 1u);
            else XB_SPIN(xb_ld(&bar[XB_TOPGEN]) == tg, bar);
            __builtin_amdgcn_fence(__ATOMIC_ACQUIRE, "agent");
            xb_add(&bar[XB_XGEN(b.x)], 1u);
            asm volatile("s_waitcnt vmcnt(0)" ::: "memory");
        } else {
            XB_SPIN(xb_ld(&bar[XB_XGEN(b.x)]) == gen, bar);
            __builtin_amdgcn_fence(__ATOMIC_ACQUIRE, "agent");
            asm volatile("s_waitcnt vmcnt(0)" ::: "memory");
        }
    }
    __syncthreads();
}


#ifndef MK_N_LAUNCHES
#define MK_N_LAUNCHES 1
#endif
#ifndef MK_QTAIL
#define MK_QTAIL 7680
#endif
#ifndef MK_QHEAD
#define MK_QHEAD 12288
#endif
namespace mk {
typedef unsigned short bf16_t;
typedef float f32x4 __attribute__((ext_vector_type(4)));
typedef short bf16x8 __attribute__((ext_vector_type(8)));
typedef short s16x4 __attribute__((ext_vector_type(4)));
typedef unsigned u32x4 __attribute__((ext_vector_type(4)));
typedef unsigned u32x2 __attribute__((ext_vector_type(2)));
typedef float f32x2 __attribute__((ext_vector_type(2)));
constexpr int D = 2048, NTOK_P = 16384, NTOK_S = 256, NTOK = 16640;
constexpr int DIN = 5632, DATT = 1536, DLRU = 512, NH = 12, HD = 128;
constexpr int NEXP = 16384;
constexpr float ALPHA = 1.189207115002721f;
constexpr float LN_EPS = 1e-5f;
constexpr float ATT_SCALE = 0.08838834764831845f;
constexpr float LOG2E = 1.4426950408889634f;
constexpr size_t O_YP = 0, O_YS = 33554432, O_KP = 34078720, O_VP = 59244544, O_CP = 84410368, O_HP = 84422656,
                 O_KS = 84426752, O_VS = 185090048, O_CS = 285753344, O_HS = 285802496, O_END = 285818880;
constexpr size_t WS_CTL = 0;
constexpr size_t WS_XB = 65536;
constexpr size_t WS_WINT = WS_XB + (size_t)NTOK * D * 2;
constexpr size_t WS_WOT = WS_WINT + (size_t)DIN * D * 2;
constexpr size_t WS_WQT = WS_WOT + (size_t)D * D * 2;
constexpr size_t WS_UB = WS_WQT + (size_t)D * D * 2;
constexpr size_t WS_VB = WS_UB + (size_t)NEXP * D * 2;
constexpr size_t WS_QF = WS_VB + (size_t)NEXP * D * 2;
constexpr size_t WS_XR = WS_QF + (size_t)NTOK * DATT * 4;
constexpr size_t WS_GATE = WS_XR + (size_t)NTOK * DLRU * 4;
constexpr size_t WS_AR = WS_GATE + (size_t)NTOK * DLRU * 4;
constexpr size_t WS_PRE1 = WS_AR + (size_t)NTOK * D * 2;
constexpr size_t WS_X1F = WS_PRE1 + (size_t)NTOK * D * 4;
constexpr size_t WS_X1B = WS_X1F + (size_t)NTOK * D * 4;
constexpr size_t WS_QP = WS_X1B + (size_t)NTOK * D * 2;
constexpr size_t WS_EIDX = WS_QP + (size_t)NTOK * D * 4;
constexpr size_t WS_GW = WS_EIDX + (size_t)NTOK * 128 * 4;
constexpr size_t WS_SU = WS_GW + (size_t)NTOK * 128 * 4;
constexpr size_t WS_SV = WS_SU + (size_t)NEXP * 4;
constexpr size_t WS_SX = WS_SV + (size_t)NEXP * 4;
constexpr size_t WS_X1Q = WS_SX + (size_t)NTOK * 4;
constexpr size_t WS_SKB = WS_X1Q + (size_t)NTOK * D;
constexpr size_t WS_QB = WS_SKB + (size_t)8 * 2 * 128 * 128 * 2;
constexpr size_t WS_KB = WS_QB + (size_t)NTOK * DATT * 2;
constexpr size_t WS_VB16 = WS_KB + (size_t)NTOK_P * DATT * 2;
constexpr size_t WS_PO = WS_VB16 + (size_t)NTOK_P * DATT * 2;
constexpr size_t WS_PM = WS_PO + (size_t)2 * NTOK_P * DATT * 2;
constexpr size_t WS_PL = WS_PM + (size_t)2 * NTOK_P * NH * 4;
constexpr size_t WS_R0 = WS_PL + (size_t)2 * NTOK_P * NH * 4;
constexpr size_t WS_R1 = WS_R0 + (size_t)NTOK_P * DLRU * 4;
constexpr size_t WS_HE = WS_R1 + (size_t)NTOK_P * DLRU * 4;
constexpr size_t WS_AE = WS_HE + (size_t)8 * 32 * 512 * 4;
constexpr size_t WS_LW = WS_AE + (size_t)8 * 32 * 512 * 4;
constexpr size_t WS_PS = WS_LW + (size_t)2 * 8 * 64 * 64 * 2;
constexpr size_t WS_END = WS_PS + (size_t)32 * 12 * 9 * 8 * 130 * 4;

constexpr int NTHREADS = 512;
constexpr int LDS_BYTES = 148480;
constexpr int MISC_OFF = 147456;

struct Params {
    const float* x_prompt; const float* x_sample; const float* cache_k; const float* cache_v; const float* state_conv; const float* state_h;
    const float* w_in; const float* conv_w; const float* conv_b; const float* lru_w_a; const float* lru_b_a; const float* lru_w_x; const float* lru_b_x;
    const float* lru_lambda; const float* w_out; const float* ln1_g; const float* ln1_b; const float* w_query; const float* sub_keys;
    const float* peer_u; const float* peer_v; const float* ln2_g; const float* ln2_b;
    float* out; unsigned char* ws; int ph_lo, ph_hi;
};

__device__ __forceinline__ unsigned f2bf(float f) { unsigned u = __float_as_uint(f); u += 0x7fffu + ((u >> 16) & 1u); return u >> 16; }
__device__ __forceinline__ unsigned pack2(float a, float b) { return f2bf(a) | (f2bf(b) << 16); }
__device__ __forceinline__ float bflo(unsigned w) { return __uint_as_float(w << 16); }
__device__ __forceinline__ float bfhi(unsigned w) { return __uint_as_float(w & 0xffff0000u); }
__device__ __forceinline__ float4 ntload4(const float* p) { const f32x4 v = __builtin_nontemporal_load((const f32x4*)p); return make_float4(v[0], v[1], v[2], v[3]); }
__device__ __forceinline__ void ntstore4(float* p, float4 v) { __builtin_nontemporal_store((f32x4){v.x, v.y, v.z, v.w}, (f32x4*)p); }
__device__ __forceinline__ float wave_sum(float v) {
#pragma unroll
    for (int o = 32; o >= 1; o >>= 1) v += __shfl_xor(v, o);
    return v;
}
__device__ __forceinline__ float wave_max(float v) {
#pragma unroll
    for (int o = 32; o >= 1; o >>= 1) v = fmaxf(v, __shfl_xor(v, o));
    return v;
}
__device__ __forceinline__ float gelu_exact(float v) { return 0.5f * v * (1.0f + erff(v * 0.7071067811865476f)); }
__device__ __forceinline__ float gelu_as(float v) {
    const float av = fabsf(v), t = __builtin_amdgcn_rcpf(av * 0.2316418882f + 1.0f);
    float q = t * 0.5307027145f + (-0.7265760135f); q = q * t + 0.7107068705f; q = q * t + (-0.142248368f); q = q * t + 0.127414796f; q = q * t;
    const float e = __builtin_amdgcn_exp2f((v * v) * (-0.72134752044f));
    const float m = v * (q * e);
    return v < 0.f ? m : v - m;
}
__device__ __forceinline__ float sigmoidf(float v) { return 1.0f / (1.0f + expf(-v)); }
__device__ __forceinline__ float readlane_f(float v, int l) { return __int_as_float(__builtin_amdgcn_readlane(__float_as_int(v), l)); }

__device__ __forceinline__ void convert_flat(const float* src, bf16_t* dst, size_t n8, size_t gtid, size_t gstride) {
    for (size_t i = gtid; i < n8; i += gstride) {
        const float4 a = ((const float4*)src)[2 * i], b = ((const float4*)src)[2 * i + 1];
        uint4 w; w.x = pack2(a.x, a.y); w.y = pack2(a.z, a.w); w.z = pack2(b.x, b.y); w.w = pack2(b.z, b.w);
        ((uint4*)dst)[i] = w;
    }
}
__device__ __forceinline__ void transpose_convert(const float* src, bf16_t* dst, int K, int N, LAS float* tile) {
    const int tid = threadIdx.x, ntn = N / 64, ntiles = (K / 64) * ntn;
    for (int tl = blockIdx.x; tl < ntiles; tl += gridDim.x) {
        const int kt = tl / ntn, nt = tl - kt * ntn;
#pragma unroll
        for (int i = 0; i < 8; ++i) { const int r = (tid >> 6) + 8 * i, c = tid & 63; tile[r * 65 + c] = src[(size_t)(kt * 64 + r) * N + nt * 64 + c]; }
        __syncthreads();
#pragma unroll
        for (int i = 0; i < 4; ++i) { const int n = (tid >> 5) + 16 * i, k0 = 2 * (tid & 31);
            const unsigned v = pack2(tile[k0 * 65 + n], tile[(k0 + 1) * 65 + n]);
            *(unsigned*)(dst + (size_t)(nt * 64 + n) * K + kt * 64 + k0) = v; }
        __syncthreads();
    }
}
constexpr int TROW = 1152;
__device__ __forceinline__ void quant_row_load(const Params& P, int it, int lane, float4 (&v)[8]) {
    const bool isv = it >= NEXP; const int row = isv ? it - NEXP : it;
    const float* src = (isv ? P.peer_v : P.peer_u) + (size_t)row * D;
#pragma unroll
    for (int j = 0; j < 2; ++j)
#pragma unroll
        for (int i = 0; i < 4; ++i) v[j * 4 + i] = *(const float4*)(src + j * 1024 + lane * 16 + i * 4);
}
__device__ __forceinline__ void quant_row_store(const Params& P, int it, int lane, const float4 (&v)[8]) {
    const bool isv = it >= NEXP; const int row = isv ? it - NEXP : it;
    float cm[2];
#pragma unroll
    for (int j = 0; j < 2; ++j) { float am = 0.f;
#pragma unroll
        for (int i = 0; i < 4; ++i) { const float4 t = v[j * 4 + i]; am = fmaxf(am, fmaxf(fmaxf(fabsf(t.x), fabsf(t.y)), fmaxf(fabsf(t.z), fabsf(t.w)))); }
        cm[j] = am; }
    float rm = wave_max(fmaxf(cm[0], cm[1])); if (rm == 0.f) rm = 1.f;
    unsigned char* dst = P.ws + (isv ? WS_VB : WS_UB) + (size_t)row * TROW;
    u32x4 w; unsigned sqp = 0u;
#pragma unroll
    for (int j = 0; j < 2; ++j) {
        int sq = (int)ceilf(cm[j] / rm * 255.0f); sq = sq < 1 ? 1 : (sq > 255 ? 255 : sq);
        sqp |= (unsigned)sq << (8 * j);
        const float inv = (255.0f * 7.0f) / (rm * (float)sq);
#pragma unroll
        for (int hh = 0; hh < 2; ++hh) { unsigned dw = 0u;
#pragma unroll
            for (int e = 0; e < 8; ++e) { const float4 t = v[j * 4 + hh * 2 + (e >> 2)]; const float x = (e & 3) == 0 ? t.x : ((e & 3) == 1 ? t.y : ((e & 3) == 2 ? t.z : t.w));
                int n = (int)rintf(x * inv); n = n < -7 ? -7 : (n > 7 ? 7 : n); dw |= (unsigned)(isv ? n + 8 : (n & 15)) << (4 * e); }
            w[j * 2 + hh] = dw; }
    }
    *(u32x4*)(dst + lane * 16) = w;
    *(unsigned short*)(dst + 1024 + lane * 2) = (unsigned short)sqp;
    if (lane == 0) ((float*)(P.ws + (isv ? WS_SV : WS_SU)))[row] = rm * (1.0f / (255.0f * 7.0f));
}
__device__ __forceinline__ void quant_tables(const Params& P, int gw, int nw, int lo, int hi) {
    const int lane = threadIdx.x & 63;
    float4 va[8], vb[8];
    int it = lo + gw;
    if (it < hi) quant_row_load(P, it, lane, va);
#pragma unroll 1
    for (; it < hi; it += 2 * nw) {
        if (it + nw < hi) quant_row_load(P, it + nw, lane, vb);
        quant_row_store(P, it, lane, va);
        if (it + nw < hi) {
            if (it + 2 * nw < hi) quant_row_load(P, it + 2 * nw, lane, va);
            quant_row_store(P, it + nw, lane, vb);
        }
    }
}
__device__ __forceinline__ void phase_prologue(const Params& P, LAS unsigned char* lds) {
    const size_t gtid = (size_t)blockIdx.x * NTHREADS + threadIdx.x, gstride = (size_t)gridDim.x * NTHREADS;
    unsigned char* ws = P.ws;
    convert_flat(P.x_prompt, (bf16_t*)(ws + WS_XB), (size_t)NTOK_P * D / 8, gtid, gstride);
    convert_flat(P.x_sample, (bf16_t*)(ws + WS_XB) + (size_t)NTOK_P * D, (size_t)NTOK_S * D / 8, gtid, gstride);
    convert_flat(P.sub_keys, (bf16_t*)(ws + WS_SKB), (size_t)8 * 2 * 128 * 128 / 8, gtid, gstride);
    for (size_t i = gtid; i < (size_t)2 * 8 * 64 * 64; i += gstride) {
        const int c = (int)(i & 63), d = (int)((i >> 6) & 63), n = (int)((i >> 12) & 7), m = (int)(i >> 15);
        ((bf16_t*)(ws + WS_LW))[i] = (bf16_t)f2bf((m ? P.lru_w_x : P.lru_w_a)[(n * 64 + c) * 64 + d]); }
    transpose_convert(P.w_in, (bf16_t*)(ws + WS_WINT), D, DIN, (LAS float*)lds);
    transpose_convert(P.w_out, (bf16_t*)(ws + WS_WOT), D, D, (LAS float*)lds);
    transpose_convert(P.w_query, (bf16_t*)(ws + WS_WQT), D, D, (LAS float*)lds);
}

struct EpiProj {
    static constexpr bool PERM = true, AFTER_DRAIN = false;
    float* out; bf16_t* XR; bf16_t* GATE; bf16_t* QB; bf16_t* KB; bf16_t* VB16;
    __device__ __forceinline__ void operator()(const f32x4 (&acc)[2][2][4][2], const pg8::Unit& u, int wr, int wc, int fr, int fq) const {
        const int pn = u.pn; const int coff = wc * 32 + 8 * fq;
#pragma unroll
        for (int ai = 0; ai < 2; ++ai)
#pragma unroll
            for (int m = 0; m < 4; ++m) {
                const int row = u.pm * 256 + ai * 128 + wr * 64 + m * 16 + fr;
                const bool prompt = row < NTOK_P;
                float* rowp = nullptr; bf16_t* rowb = nullptr; float bsc = 1.0f;
                if (pn < 6) { rowb = QB + (size_t)row * DATT + pn * 256; bsc = ATT_SCALE * LOG2E; }
                else if (pn < 18) {
                    const int isv = pn >= 12; const int c0 = (pn - (isv ? 12 : 6)) * 256;
                    if (prompt) { rowp = out + (isv ? O_VP : O_KP) + (size_t)row * DATT + c0; rowb = (isv ? VB16 : KB) + (size_t)row * DATT + c0; }
                    else { const int rr = row - NTOK_P, b = rr >> 3, t = rr & 7; rowp = out + (isv ? O_VS : O_KS) + ((size_t)b * 2048 + 2040 + t) * DATT + c0; }
                } else if (pn < 20) rowb = XR + (size_t)row * DLRU + (pn - 18) * 256;
                else rowb = GATE + (size_t)row * DLRU + (pn - 20) * 256;
#pragma unroll
                for (int bj = 0; bj < 2; ++bj) {
                    const f32x4 v0 = acc[ai][bj][m][0], v1 = acc[ai][bj][m][1];
                    if (rowp) { *(f32x4*)(rowp + coff + bj * 128) = v0; *(f32x4*)(rowp + coff + bj * 128 + 4) = v1; }
                    if (rowb) { u32x4 w; w.x = pg8::cvt_pk_bf16(v0[0] * bsc, v0[1] * bsc); w.y = pg8::cvt_pk_bf16(v0[2] * bsc, v0[3] * bsc); w.z = pg8::cvt_pk_bf16(v1[0] * bsc, v1[1] * bsc); w.w = pg8::cvt_pk_bf16(v1[2] * bsc, v1[3] * bsc);
                        *(u32x4*)(rowb + coff + bj * 128) = w; }
                }
            }
    }
};
struct EpiOut {
    static constexpr bool PERM = true, AFTER_DRAIN = false;
    const bf16_t* xb; bf16_t* pre;
    __device__ __forceinline__ void operator()(const f32x4 (&acc)[2][2][4][2], const pg8::Unit& u, int wr, int wc, int fr, int fq) const {
        const int col0 = u.pn * 256 + wc * 32 + 8 * fq;
        u32x4 xv[2][4][2];
#pragma unroll
        for (int ai = 0; ai < 2; ++ai)
#pragma unroll
            for (int m = 0; m < 4; ++m) { const int row = u.pm * 256 + ai * 128 + wr * 64 + m * 16 + fr;
#pragma unroll
                for (int bj = 0; bj < 2; ++bj) xv[ai][m][bj] = *(const u32x4*)(xb + (size_t)row * D + col0 + bj * 128); }
#pragma unroll
        for (int ai = 0; ai < 2; ++ai)
#pragma unroll
            for (int m = 0; m < 4; ++m) {
                const int row = u.pm * 256 + ai * 128 + wr * 64 + m * 16 + fr;
                bf16_t* pr = pre + (size_t)row * D + col0;
#pragma unroll
                for (int bj = 0; bj < 2; ++bj) {
                    const u32x4 x = xv[ai][m][bj]; const f32x4 v0 = acc[ai][bj][m][0], v1 = acc[ai][bj][m][1];
                    u32x4 w;
                    w.x = pg8::cvt_pk_bf16(ALPHA * bflo(x.x) + v0[0], ALPHA * bfhi(x.x) + v0[1]); w.y = pg8::cvt_pk_bf16(ALPHA * bflo(x.y) + v0[2], ALPHA * bfhi(x.y) + v0[3]);
                    w.z = pg8::cvt_pk_bf16(ALPHA * bflo(x.z) + v1[0], ALPHA * bfhi(x.z) + v1[1]); w.w = pg8::cvt_pk_bf16(ALPHA * bflo(x.w) + v1[2], ALPHA * bfhi(x.w) + v1[3]);
                    *(u32x4*)(pr + bj * 128) = w;
                }
            }
    }
};
struct EpiPlain {
    static constexpr bool PERM = false, AFTER_DRAIN = false;
    float* C; int ldc;
    __device__ __forceinline__ void operator()(const f32x4 (&acc)[2][2][4][2], const pg8::Unit& u, int wr, int wc, int fr, int fq) const {
        const int col0 = u.pn * 256 + wc * 32 + 4 * fq;
#pragma unroll
        for (int ai = 0; ai < 2; ++ai)
#pragma unroll
            for (int m = 0; m < 4; ++m) {
                const int row = u.pm * 256 + ai * 128 + wr * 64 + m * 16 + fr;
                float* pr = C + (size_t)row * ldc + col0;
#pragma unroll
                for (int bj = 0; bj < 2; ++bj)
#pragma unroll
                    for (int n = 0; n < 2; ++n) *(f32x4*)(pr + bj * 128 + n * 16) = acc[ai][bj][m][n];
            }
    }
};

struct EpiBf16Plain {
    static constexpr bool PERM = true, AFTER_DRAIN = false;
    bf16_t* C; int ldc;
    __device__ __forceinline__ void operator()(const f32x4 (&acc)[2][2][4][2], const pg8::Unit& u, int wr, int wc, int fr, int fq) const {
        const int col0 = u.pn * 256 + wc * 32 + 8 * fq;
#pragma unroll
        for (int ai = 0; ai < 2; ++ai)
#pragma unroll
            for (int m = 0; m < 4; ++m) {
                const int row = u.pm * 256 + ai * 128 + wr * 64 + m * 16 + fr;
                bf16_t* pr = C + (size_t)row * ldc + col0;
#pragma unroll
                for (int bj = 0; bj < 2; ++bj) { const f32x4 v0 = acc[ai][bj][m][0], v1 = acc[ai][bj][m][1]; u32x4 w;
                    w.x = pg8::cvt_pk_bf16(v0[0], v0[1]); w.y = pg8::cvt_pk_bf16(v0[2], v0[3]); w.z = pg8::cvt_pk_bf16(v1[0], v1[1]); w.w = pg8::cvt_pk_bf16(v1[2], v1[3]);
                    *(u32x4*)(pr + bj * 128) = w; }
            }
    }
};

template <int MODE>
__device__ __forceinline__ void sample_rows_gemm(const Params& P, const bf16_t* A, const bf16_t* Wt, LAS unsigned char* lds) {
    const int tid = threadIdx.x, lane = tid & 63, w = __builtin_amdgcn_readfirstlane(tid >> 6);
    const int c = lane & 15, g = lane >> 4;
    for (int tile = blockIdx.x; tile < 256; tile += gridDim.x) {
        const int tg = tile & 7, cg = tile >> 3;
        const int k0 = 256 * w;
        const bf16_t* wp = Wt + (size_t)(64 * cg + c) * D + k0 + 8 * g;
        const bf16_t* xp = A + (size_t)(NTOK_P + 32 * tg + c) * D + k0 + 8 * g;
        f32x4 acc[4][2];
#pragma unroll
        for (int ct = 0; ct < 4; ++ct) { acc[ct][0] = (f32x4){0.f, 0.f, 0.f, 0.f}; acc[ct][1] = (f32x4){0.f, 0.f, 0.f, 0.f}; }
        bf16x8 wf[8][4], xf[8][2];
#pragma unroll
        for (int ks = 0; ks < 8; ++ks) {
#pragma unroll
            for (int tt = 0; tt < 2; ++tt) xf[ks][tt] = *(const bf16x8*)(xp + (size_t)(16 * tt) * D + 32 * ks);
#pragma unroll
            for (int ct = 0; ct < 4; ++ct) wf[ks][ct] = *(const bf16x8*)(wp + (size_t)(16 * ct) * D + 32 * ks);
        }
        __builtin_amdgcn_sched_barrier(0);
#pragma unroll
        for (int ks = 0; ks < 8; ++ks)
#pragma unroll
            for (int ct = 0; ct < 4; ++ct)
#pragma unroll
                for (int tt = 0; tt < 2; ++tt) acc[ct][tt] = __builtin_amdgcn_mfma_f32_16x16x32_bf16(wf[ks][ct], xf[ks][tt], acc[ct][tt], 0, 0, 0);
        LAS float* part = (LAS float*)lds;
#pragma unroll
        for (int ct = 0; ct < 4; ++ct)
#pragma unroll
            for (int tt = 0; tt < 2; ++tt) *(LAS f32x4*)(part + ((w * 32 + 16 * tt + c) * 64 + 16 * ct + 4 * g)) = acc[ct][tt];
        __syncthreads();
        {
            const int tok = tid >> 4, c4 = (tid & 15) * 4;
            f32x4 sum = {0.f, 0.f, 0.f, 0.f};
#pragma unroll
            for (int ww = 0; ww < 8; ++ww) sum += *(const LAS f32x4*)(part + ((ww * 32 + tok) * 64 + c4));
            const int row = NTOK_P + 32 * tg + tok, col = 64 * cg + c4;
            if (MODE == 0) { const f32x4 xv = *(const f32x4*)(P.x_sample + (size_t)(row - NTOK_P) * D + col); const f32x4 r = xv * ALPHA + sum; u32x2 wv; wv.x = pg8::cvt_pk_bf16(r[0], r[1]); wv.y = pg8::cvt_pk_bf16(r[2], r[3]); *(u32x2*)((bf16_t*)(P.ws + WS_PRE1) + (size_t)row * D + col) = wv; }
            else { u32x2 wv; wv.x = pg8::cvt_pk_bf16(sum[0], sum[1]); wv.y = pg8::cvt_pk_bf16(sum[2], sum[3]); *(u32x2*)((bf16_t*)(P.ws + WS_QP) + (size_t)row * D + col) = wv; }
        }
        __syncthreads();
    }
}

constexpr int KVS = 288, VOFF = 73728;
struct AttnKV { u32x4 k[8], v[8]; };
struct AttnId { int p, b, h, r, c, reuse; };
__device__ __forceinline__ void attn_fetch(const Params& P, const AttnId& u, AttnKV& R) {
    const int tid = threadIdx.x; const int dil = 1 << (2 * u.p);
    const bf16_t* Kb = (const bf16_t*)(P.ws + WS_KB); const bf16_t* Vb = (const bf16_t*)(P.ws + WS_VB16);
    const size_t tok0 = (size_t)u.b * 2048; const int j0 = 128 * u.c - 128, rho0 = (u.c == 0 || u.reuse) ? 128 : 0;
#pragma unroll
    for (int it = 0; it < 8; ++it) {
        const int rho = it * 32 + (tid >> 4), ch = tid & 15;
        if (rho >= rho0) {
            const size_t tok = tok0 + (size_t)((j0 + rho) * dil + u.r);
            R.k[it] = *(const u32x4*)(Kb + tok * DATT + u.h * HD + ch * 8);
            R.v[it] = *(const u32x4*)(Vb + tok * DATT + u.h * HD + ch * 8);
        }
    }
}
__device__ __forceinline__ void attn_commit(const AttnId& u, const AttnKV& R, LAS unsigned char* lds) {
    const int tid = threadIdx.x; const int rho0 = (u.c == 0 || u.reuse) ? 128 : 0;
    const int poff = (u.c & 1) ? 0 : 128;
#pragma unroll
    for (int it = 0; it < 8; ++it) {
        const int rho = it * 32 + (tid >> 4), ch = tid & 15;
        if (rho >= rho0) { const int pr = (rho + poff) & 255; *(LAS u32x4*)(lds + pr * KVS + ch * 16) = R.k[it]; *(LAS u32x4*)(lds + VOFF + pr * KVS + ch * 16) = R.v[it]; }
    }
}
template <int MODE>
__device__ __forceinline__ void attn_unit(const Params& P, const AttnId& uid, AttnKV& R, bool has_next, const AttnId& nid, LAS unsigned char* lds) {
    const int tid = threadIdx.x, lane = tid & 63, w = __builtin_amdgcn_readfirstlane(tid >> 6);
    const int p = uid.p, b = uid.b, h = uid.h, r = uid.r, c = uid.c;
    const int dil = 1 << (2 * p);
    const int poff = (c & 1) ? 0 : 128;
    const bf16_t* Qb = (const bf16_t*)(P.ws + WS_QB);
    const size_t tok0 = (size_t)b * 2048;
    attn_commit(uid, R, lds);
    const int cq = lane & 15, g = lane >> 4;
    const int iq = 128 * c + 16 * w + cq;
    const size_t qtok = tok0 + (size_t)(iq * dil + r);
    bf16x8 qf[4];
#pragma unroll
    for (int ks = 0; ks < 4; ++ks) qf[ks] = *(const bf16x8*)(Qb + qtok * DATT + h * HD + 32 * ks + 8 * g);
    __syncthreads();
#pragma unroll
    for (int ks = 0; ks < 4; ++ks) asm volatile("" : "+v"(qf[ks]));
    if (has_next) attn_fetch(P, nid, R);
    const int ktmin = (8 - w - 8 * c) > 0 ? (8 - w - 8 * c) : 0;
    const float slope2 = exp2f(-8.0f * (float)(h + 1) / 12.0f) * LOG2E * (float)dil;
    f32x4 s[9]; float m = -INFINITY;
#pragma unroll
    for (int kt = 0; kt < 9; ++kt) {
        if (kt >= ktmin) {
            f32x4 acc = {0.f, 0.f, 0.f, 0.f};
#pragma unroll
            for (int ks = 0; ks < 4; ++ks) { const bf16x8 kf = *(const LAS bf16x8*)(lds + (((16 * w + 16 * kt + poff) & 255) + cq) * KVS + (32 * ks + 8 * g) * 2); acc = __builtin_amdgcn_mfma_f32_16x16x32_bf16(kf, qf[ks], acc, 0, 0, 0); }
#pragma unroll
            for (int ii = 0; ii < 4; ++ii) { const int dist = cq + 128 - 16 * kt - 4 * g - ii; float v = acc[ii] - slope2 * (float)dist;
                if (kt == 0 && dist > 128) v = -INFINITY; if (kt == 8 && dist < 0) v = -INFINITY; acc[ii] = v; m = fmaxf(m, v); }
            s[kt] = acc;
        } else s[kt] = (f32x4){-INFINITY, -INFINITY, -INFINITY, -INFINITY};
    }
    m = fmaxf(m, __shfl_xor(m, 16)); m = fmaxf(m, __shfl_xor(m, 32));
    float l = 0.f;
#pragma unroll
    for (int kt = 0; kt < 9; ++kt)
#pragma unroll
        for (int ii = 0; ii < 4; ++ii) { const float pp = exp2f(s[kt][ii] - m); s[kt][ii] = pp; l += pp; }
    l += __shfl_xor(l, 16); l += __shfl_xor(l, 32);
    f32x4 o[8];
#pragma unroll
    for (int dt = 0; dt < 8; ++dt) o[dt] = (f32x4){0.f, 0.f, 0.f, 0.f};
#pragma unroll
    for (int kk = 0; kk < 5; ++kk) {
        const int T0 = 2 * kk, T1 = 2 * kk + 1;
        if (T1 >= ktmin || T0 == 8) {
            u32x4 pw; pw.x = pg8::cvt_pk_bf16(s[T0][0], s[T0][1]); pw.y = pg8::cvt_pk_bf16(s[T0][2], s[T0][3]);
            if (T1 <= 8) { pw.z = pg8::cvt_pk_bf16(s[T1 <= 8 ? T1 : 8][0], s[T1 <= 8 ? T1 : 8][1]); pw.w = pg8::cvt_pk_bf16(s[T1 <= 8 ? T1 : 8][2], s[T1 <= 8 ? T1 : 8][3]); } else { pw.z = 0u; pw.w = 0u; }
            const bf16x8 pf = __builtin_bit_cast(bf16x8, pw);
            const int rT0 = (T0 >= ktmin) ? T0 : 8, rT1 = (T1 <= 8 && T1 >= ktmin) ? T1 : 8;
            const int a0 = VOFF + (((16 * w + 16 * rT0 + poff) & 255) + 4 * g + (cq >> 2)) * KVS + 8 * (cq & 3);
            const int a1 = VOFF + (((16 * w + 16 * rT1 + poff) & 255) + 4 * g + (cq >> 2)) * KVS + 8 * (cq & 3);
#pragma unroll
            for (int dt = 0; dt < 8; ++dt) {
                const s16x4 v0 = __builtin_amdgcn_ds_read_tr16_b64_v4i16((LAS s16x4*)(lds + a0 + dt * 32));
                const s16x4 v1 = __builtin_amdgcn_ds_read_tr16_b64_v4i16((LAS s16x4*)(lds + a1 + dt * 32));
                const bf16x8 vf = {v0[0], v0[1], v0[2], v0[3], v1[0], v1[1], v1[2], v1[3]};
                o[dt] = __builtin_amdgcn_mfma_f32_16x16x32_bf16(vf, pf, o[dt], 0, 0, 0);
            }
        }
    }
    const float inv = 1.0f / l;
    if (MODE == 0) {
        bf16_t* po = (bf16_t*)(P.ws + WS_PO) + ((size_t)p * NTOK_P + qtok) * DATT + h * HD + 4 * g;
#pragma unroll
        for (int dt = 0; dt < 8; ++dt) { u32x2 wv; wv.x = pg8::cvt_pk_bf16(o[dt][0] * inv, o[dt][1] * inv); wv.y = pg8::cvt_pk_bf16(o[dt][2] * inv, o[dt][3] * inv); *(u32x2*)(po + 16 * dt) = wv; }
        if (g == 0) { ((float*)(P.ws + WS_PM))[((size_t)p * NTOK_P + qtok) * NH + h] = m; ((float*)(P.ws + WS_PL))[((size_t)p * NTOK_P + qtok) * NH + h] = l; }
    } else {
        const float* PM = (const float*)(P.ws + WS_PM); const float* PL = (const float*)(P.ws + WS_PL);
        const float m0 = PM[qtok * NH + h], l0 = PL[qtok * NH + h], m1 = PM[((size_t)NTOK_P + qtok) * NH + h], l1 = PL[((size_t)NTOK_P + qtok) * NH + h];
        const float M = fmaxf(m, fmaxf(m0, m1));
        const float w2 = exp2f(m - M), w0 = exp2f(m0 - M) * l0, w1 = exp2f(m1 - M) * l1;
        const float rden = 1.0f / (w2 * l + w0 + w1);
        const bf16_t* p0 = (const bf16_t*)(P.ws + WS_PO) + qtok * DATT + h * HD + 4 * g;
        const bf16_t* p1 = p0 + (size_t)NTOK_P * DATT;
        bf16_t* ar = (bf16_t*)(P.ws + WS_AR) + qtok * D + h * HD + 4 * g;
        u32x2 q0[8], q1[8];
#pragma unroll
        for (int dt = 0; dt < 8; ++dt) { q0[dt] = *(const u32x2*)(p0 + 16 * dt); q1[dt] = *(const u32x2*)(p1 + 16 * dt); }
#pragma unroll
        for (int dt = 0; dt < 8; ++dt) {
            const u32x2 x0 = q0[dt], x1 = q1[dt];
            const float r0 = (w2 * o[dt][0] + w0 * bflo(x0.x) + w1 * bflo(x1.x)) * rden, r1 = (w2 * o[dt][1] + w0 * bfhi(x0.x) + w1 * bfhi(x1.x)) * rden;
            const float r2 = (w2 * o[dt][2] + w0 * bflo(x0.y) + w1 * bflo(x1.y)) * rden, r3 = (w2 * o[dt][3] + w0 * bfhi(x0.y) + w1 * bfhi(x1.y)) * rden;
            u32x2 wv; wv.x = pg8::cvt_pk_bf16(r0, r1); wv.y = pg8::cvt_pk_bf16(r2, r3); *(u32x2*)(ar + 16 * dt) = wv;
        }
    }
    __syncthreads();
}

struct SampPre { f32x4 k[4], v[4]; };
__device__ __forceinline__ void samp_prefetch(const Params& P, int b, int h, int k, SampPre& R) {
    const int tid = threadIdx.x;
    const size_t so = ((size_t)(b * 2048 + 256 * k + (tid >> 5))) * DATT + h * HD + (tid & 31) * 4;
#pragma unroll
    for (int it = 0; it < 4; ++it) { R.k[it] = *(const f32x4*)(P.cache_k + so + (size_t)it * 16 * DATT); R.v[it] = *(const f32x4*)(P.cache_v + so + (size_t)it * 16 * DATT); }
}
__device__ __forceinline__ void samp_load4(const float* ck, const float* cv, int s0, f32x4 (&kk)[4], f32x4 (&vv)[4]) {
#pragma unroll
    for (int j = 0; j < 4; ++j) { kk[j] = *(const f32x4*)(ck + (size_t)(s0 + j) * 16 * DATT); vv[j] = *(const f32x4*)(cv + (size_t)(s0 + j) * 16 * DATT); }
}
__device__ __forceinline__ void samp_put4(float* ok, float* ov, float* ok0, float* ov0, LAS unsigned char* lk, int s0, const f32x4 (&kk)[4], const f32x4 (&vv)[4]) {
#pragma unroll
    for (int j = 0; j < 4; ++j) {
        const int it = s0 + j; const f32x4 kf = kk[j], vf = vv[j];
        if (it == 0) { *(f32x4*)ok0 = kf; *(f32x4*)ov0 = vf; } else { *(f32x4*)(ok + (size_t)it * 16 * DATT) = kf; *(f32x4*)(ov + (size_t)it * 16 * DATT) = vf; }
        u32x2 kw, vw; kw.x = pg8::cvt_pk_bf16(kf[0], kf[1]); kw.y = pg8::cvt_pk_bf16(kf[2], kf[3]); vw.x = pg8::cvt_pk_bf16(vf[0], vf[1]); vw.y = pg8::cvt_pk_bf16(vf[2], vf[3]);
        *(LAS u32x2*)(lk + it * 16 * KVS) = kw; *(LAS u32x2*)(lk + VOFF + it * 16 * KVS) = vw;
    }
}
template <bool LAST>
__device__ __forceinline__ void samp_unit(const Params& P, int b, int h, int k, LAS unsigned char* lds, SampPre& R, int nb, int nh, int nk) {
    const int tid = threadIdx.x, lane = tid & 63, w = __builtin_amdgcn_readfirstlane(tid >> 6);
    const int cq = lane & 15, g = lane >> 4;
    const int t = cq & 7;
    bf16x8 qf[4];
    { const bf16_t* Qb = (const bf16_t*)(P.ws + WS_QB) + ((size_t)(NTOK_P + b * 8 + t)) * DATT + h * HD + 8 * g;
#pragma unroll
      for (int ks = 0; ks < 4; ++ks) qf[ks] = *(const bf16x8*)(Qb + 32 * ks); }
    if (!LAST) {
        const int r5 = tid >> 5, ch4 = tid & 31;
        const size_t so = ((size_t)(b * 2048 + 256 * k + r5)) * DATT + h * HD + ch4 * 4;
        const float* ck = P.cache_k + so; const float* cv = P.cache_v + so;
        float* ok = P.out + O_KS + so - (size_t)8 * DATT; float* ov = P.out + O_VS + so - (size_t)8 * DATT;
        const bool first_ok = (256 * k + r5) >= 8;
        float* junk = (float*)(P.ws + WS_QF) + lane * 4;
        float* ok0 = first_ok ? ok : junk; float* ov0 = first_ok ? ov : junk + 256;
        LAS unsigned char* lk = lds + r5 * KVS + ch4 * 8;
        f32x4 ka[4], va[4], kb[4], vb[4];
        samp_load4(ck, cv, 4, ka, va);
        __builtin_amdgcn_sched_barrier(0);
        samp_put4(ok, ov, ok0, ov0, lk, 0, R.k, R.v);
        samp_load4(ck, cv, 8, kb, vb);
        __builtin_amdgcn_sched_barrier(0);
        samp_put4(ok, ov, ok0, ov0, lk, 4, ka, va);
#pragma unroll
        for (int ks = 0; ks < 4; ++ks) asm volatile("" : "+v"(qf[ks]));
        samp_load4(ck, cv, 12, ka, va);
        samp_prefetch(P, nb, nh, nk, R);
        __builtin_amdgcn_sched_barrier(0);
        samp_put4(ok, ov, ok0, ov0, lk, 8, kb, vb);
        samp_put4(ok, ov, ok0, ov0, lk, 12, ka, va);
    } else {
        const int rho = tid >> 5, ch4 = tid & 31;
        u32x2 kw = {0u, 0u}, vw = {0u, 0u};
        if (rho < 8) { const size_t so = ((size_t)(b * 2048 + 2040 + rho)) * DATT + h * HD + ch4 * 4; const float4 kf = *(const float4*)(P.out + O_KS + so), vf = *(const float4*)(P.out + O_VS + so);
            kw.x = pg8::cvt_pk_bf16(kf.x, kf.y); kw.y = pg8::cvt_pk_bf16(kf.z, kf.w); vw.x = pg8::cvt_pk_bf16(vf.x, vf.y); vw.y = pg8::cvt_pk_bf16(vf.z, vf.w); }
        *(LAS u32x2*)(lds + rho * KVS + ch4 * 8) = kw; *(LAS u32x2*)(lds + VOFF + rho * KVS + ch4 * 8) = vw;
        *(LAS u32x2*)(lds + (16 + rho) * KVS + ch4 * 8) = (u32x2){0u, 0u}; *(LAS u32x2*)(lds + VOFF + (16 + rho) * KVS + ch4 * 8) = (u32x2){0u, 0u};
#pragma unroll
        for (int ks = 0; ks < 4; ++ks) asm volatile("" : "+v"(qf[ks]));
    }
    __syncthreads();
    const float slope2 = exp2f(-8.0f * (float)(h + 1) / 12.0f) * LOG2E;
    const bool active = (k < 8) || (w == 0);
    f32x4 s[2]; float m = -INFINITY;
#pragma unroll
    for (int j = 0; j < 2; ++j) {
        f32x4 acc = {0.f, 0.f, 0.f, 0.f};
        if (active) {
#pragma unroll
            for (int ks = 0; ks < 4; ++ks) { const bf16x8 kf = *(const LAS bf16x8*)(lds + (32 * w + 16 * j + cq) * KVS + (32 * ks + 8 * g) * 2); acc = __builtin_amdgcn_mfma_f32_16x16x32_bf16(kf, qf[ks], acc, 0, 0, 0); }
        }
#pragma unroll
        for (int ii = 0; ii < 4; ++ii) {
            const int c = 256 * k + 32 * w + 16 * j + 4 * g + ii, dist = 2048 + t - c;
            int mult = (dist <= 128 ? 1 : 0) + (((dist & 3) == 0 && dist <= 512) ? 1 : 0) + (((dist & 15) == 0 && dist <= 2048) ? 1 : 0);
            if (dist < 0 || !active || c > 2055) mult = 0;
            const float v = mult ? acc[ii] - slope2 * (float)dist : -INFINITY;
            acc[ii] = v; m = fmaxf(m, v);
            s[j][ii] = (float)mult;
            s[j][ii] = v;
        }
    }
    m = fmaxf(m, __shfl_xor(m, 16)); m = fmaxf(m, __shfl_xor(m, 32));
    const float mref = (m == -INFINITY) ? 0.f : m;
    float l = 0.f;
#pragma unroll
    for (int j = 0; j < 2; ++j)
#pragma unroll
        for (int ii = 0; ii < 4; ++ii) {
            const int c = 256 * k + 32 * w + 16 * j + 4 * g + ii, dist = 2048 + t - c;
            const int mult = (dist <= 128 ? 1 : 0) + (((dist & 3) == 0 && dist <= 512) ? 1 : 0) + (((dist & 15) == 0 && dist <= 2048) ? 1 : 0);
            const float pp = (float)mult * exp2f(s[j][ii] - mref); s[j][ii] = pp; l += pp; }
    l += __shfl_xor(l, 16); l += __shfl_xor(l, 32);
    f32x4 o[8];
    {
        u32x4 pw; pw.x = pg8::cvt_pk_bf16(s[0][0], s[0][1]); pw.y = pg8::cvt_pk_bf16(s[0][2], s[0][3]); pw.z = pg8::cvt_pk_bf16(s[1][0], s[1][1]); pw.w = pg8::cvt_pk_bf16(s[1][2], s[1][3]);
        const bf16x8 pf = __builtin_bit_cast(bf16x8, pw);
        const int rw = active ? w : 0;
        const int a0 = VOFF + (32 * rw + 4 * g + (cq >> 2)) * KVS + 8 * (cq & 3), a1 = a0 + 16 * KVS;
#pragma unroll
        for (int dt = 0; dt < 8; ++dt) {
            const s16x4 v0 = __builtin_amdgcn_ds_read_tr16_b64_v4i16((LAS s16x4*)(lds + a0 + dt * 32));
            const s16x4 v1 = __builtin_amdgcn_ds_read_tr16_b64_v4i16((LAS s16x4*)(lds + a1 + dt * 32));
            const bf16x8 vf = {v0[0], v0[1], v0[2], v0[3], v1[0], v1[1], v1[2], v1[3]};
            o[dt] = __builtin_amdgcn_mfma_f32_16x16x32_bf16(vf, pf, (f32x4){0.f, 0.f, 0.f, 0.f}, 0, 0, 0);
        }
    }
    __syncthreads();
    LAS float* OL = (LAS float*)lds;
    LAS float* ML = (LAS float*)(lds + 32768);
    if (cq < 8) {
#pragma unroll
        for (int dt = 0; dt < 8; ++dt) *(LAS f32x4*)(OL + (w * 8 + cq) * 128 + 16 * dt + 4 * g) = o[dt];
        if (g == 0) { ML[(w * 8 + cq) * 2 + 0] = m; ML[(w * 8 + cq) * 2 + 1] = l; }
    }
    __syncthreads();
    {
        const int q = w; float M = -INFINITY;
#pragma unroll
        for (int ww = 0; ww < 8; ++ww) M = fmaxf(M, ML[(ww * 8 + q) * 2]);
        const float Mr = (M == -INFINITY) ? 0.f : M;
        float L = 0.f, o0 = 0.f, o1 = 0.f;
#pragma unroll
        for (int ww = 0; ww < 8; ++ww) { const float f = exp2f(ML[(ww * 8 + q) * 2] - Mr); L += f * ML[(ww * 8 + q) * 2 + 1];
            o0 += f * OL[(ww * 8 + q) * 128 + 2 * lane]; o1 += f * OL[(ww * 8 + q) * 128 + 2 * lane + 1]; }
        float* ps = (float*)(P.ws + WS_PS) + ((((size_t)(b * NH + h)) * 9 + k) * 8 + q) * 130;
        if (lane == 0) { ps[0] = M; ps[1] = L; }
        *(float2*)(ps + 2 + 2 * lane) = make_float2(o0, o1);
    }
    __syncthreads();
}
__device__ __forceinline__ void samp_merge_unit(const Params& P, int b, int t, int h, int lane) {
    const float* ps = (const float*)(P.ws + WS_PS) + ((size_t)(b * NH + h)) * 9 * 8 * 130 + (size_t)t * 130;
    float M = -INFINITY;
#pragma unroll
    for (int k = 0; k < 9; ++k) M = fmaxf(M, ps[(size_t)k * 8 * 130]);
    float L = 0.f, o0 = 0.f, o1 = 0.f;
#pragma unroll
    for (int k = 0; k < 9; ++k) { const float* pk = ps + (size_t)k * 8 * 130; const float f = exp2f(pk[0] - M); L += f * pk[1]; const float2 ov = *(const float2*)(pk + 2 + 2 * lane); o0 += f * ov.x; o1 += f * ov.y; }
    const float inv = 1.0f / L;
    bf16_t* ar = (bf16_t*)(P.ws + WS_AR) + ((size_t)(NTOK_P + b * 8 + t)) * D + h * HD;
    *(unsigned*)(ar + 2 * lane) = pack2(o0 * inv, o1 * inv);
}

constexpr int LRU_XS = 144, LRU_GS = 68, LRU_WAVE = 16 * LRU_XS + 2 * 16 * LRU_GS * 4;
__device__ __forceinline__ void lru_unit(const Params& P, bool samp, int b, int n, int k, int lane, LAS unsigned char* wl) {
    const int T = samp ? 8 : 64; const int row0 = samp ? NTOK_P + b * 8 : b * 2048 + k * 64; const int ch = n * 64 + lane;
    const int cq = lane & 15, g = lane >> 4;
    bf16x8 wf[2][4][2];
    { const bf16_t* lw = (const bf16_t*)(P.ws + WS_LW);
#pragma unroll
      for (int m = 0; m < 2; ++m)
#pragma unroll
        for (int ct = 0; ct < 4; ++ct)
#pragma unroll
            for (int ks = 0; ks < 2; ++ks) wf[m][ct][ks] = *(const bf16x8*)(lw + ((size_t)((m * 8 + n) * 64 + 16 * ct + cq)) * 64 + 32 * ks + 8 * g); }
    const float ba = P.lru_b_a[ch], bx = P.lru_b_x[ch], lam = P.lru_lambda[ch];
    const float sp8 = -8.0f * LOG2E * log1pf(expf(-lam));
    const float cw0 = P.conv_w[ch], cw1 = P.conv_w[512 + ch], cw2 = P.conv_w[1024 + ch], cw3 = P.conv_w[1536 + ch], cb = P.conv_b[ch];
    const bf16_t* XR = (const bf16_t*)(P.ws + WS_XR); const bf16_t* GT = (const bf16_t*)(P.ws + WS_GATE);
    float* R0 = (float*)(P.ws + WS_R0); float* R1 = (float*)(P.ws + WS_R1); bf16_t* AR = (bf16_t*)(P.ws + WS_AR);
    LAS unsigned char* xcb = wl; LAS float* G = (LAS float*)(wl + 16 * LRU_XS);
    float x0 = 0.f, x1 = 0.f, x2 = 0.f, h = 0.f, A = 1.f;
    if (samp) { x0 = P.state_conv[(b * 3 + 0) * 512 + ch]; x1 = P.state_conv[(b * 3 + 1) * 512 + ch]; x2 = P.state_conv[(b * 3 + 2) * 512 + ch]; h = P.state_h[b * 512 + ch]; }
    else if (k > 0) { x0 = bflo(XR[(size_t)(row0 - 3) * DLRU + ch]); x1 = bflo(XR[(size_t)(row0 - 2) * DLRU + ch]); x2 = bflo(XR[(size_t)(row0 - 1) * DLRU + ch]); }
    unsigned xrn[16], gtn[16];
    { const int ns0 = T < 16 ? T : 16;
#pragma unroll
      for (int i = 0; i < 16; ++i) { const int r = row0 + (i < ns0 ? i : ns0 - 1); xrn[i] = XR[(size_t)r * DLRU + ch]; gtn[i] = GT[(size_t)r * DLRU + ch]; } }
    __builtin_amdgcn_sched_barrier(0);
#pragma unroll
    for (int i = 0; i < 16; ++i) { asm volatile("" : "+v"(xrn[i])); asm volatile("" : "+v"(gtn[i])); }
#pragma unroll 1
    for (int t0 = 0; t0 < T; t0 += 16) {
        const int ns = (T - t0) < 16 ? (T - t0) : 16;
        float xc[16], gt[16];
#pragma unroll
        for (int i = 0; i < 16; ++i) { xc[i] = bflo(xrn[i]); gt[i] = bflo(gtn[i]); }
        if (t0 + 16 < T) { const int nn = (T - t0 - 16) < 16 ? (T - t0 - 16) : 16;
#pragma unroll
            for (int i = 0; i < 16; ++i) { const int r = row0 + t0 + 16 + (i < nn ? i : nn - 1); xrn[i] = XR[(size_t)r * DLRU + ch]; gtn[i] = GT[(size_t)r * DLRU + ch]; } }
        __builtin_amdgcn_sched_barrier(0);
#pragma unroll
        for (int i = 0; i < 16; ++i) {
            const float xin = xc[i]; const float v = ((x0 * cw0 + x1 * cw1) + x2 * cw2) + xin * cw3 + cb;
            if (i < ns) { x0 = x1; x1 = x2; x2 = xin; }
            xc[i] = v;
            *(LAS bf16_t*)(xcb + i * LRU_XS + lane * 2) = (bf16_t)f2bf(v);
        }
        __builtin_amdgcn_wave_barrier();
        const bf16x8 a0 = *(const LAS bf16x8*)(xcb + cq * LRU_XS + (8 * g) * 2), a1 = *(const LAS bf16x8*)(xcb + cq * LRU_XS + (32 + 8 * g) * 2);
#pragma unroll
        for (int m = 0; m < 2; ++m)
#pragma unroll
            for (int ct = 0; ct < 4; ++ct) {
                f32x4 acc = __builtin_amdgcn_mfma_f32_16x16x32_bf16(a0, wf[m][ct][0], (f32x4){0.f, 0.f, 0.f, 0.f}, 0, 0, 0);
                acc = __builtin_amdgcn_mfma_f32_16x16x32_bf16(a1, wf[m][ct][1], acc, 0, 0, 0);
#pragma unroll
                for (int ii = 0; ii < 4; ++ii) G[(m * 16 + 4 * g + ii) * LRU_GS + 16 * ct + cq] = acc[ii];
            }
        __builtin_amdgcn_wave_barrier();
#pragma unroll
        for (int i = 0; i < 16; ++i) {
            if (i < ns) {
                const float ra = G[i * LRU_GS + lane] + ba, ri = G[(16 + i) * LRU_GS + lane] + bx;
                const float r = __builtin_amdgcn_rcpf(1.0f + __builtin_amdgcn_exp2f(-LOG2E * ra)), ig = __builtin_amdgcn_rcpf(1.0f + __builtin_amdgcn_exp2f(-LOG2E * ri));
                const float a = __builtin_amdgcn_exp2f(sp8 * r);
                const float u = __builtin_amdgcn_sqrtf(fmaxf(1.0f - a * a, 0.f)) * (ig * xc[i]);
                h = a * h + u; A = a * A;
                const float ge = gelu_as(gt[i]);
                if (samp) AR[(size_t)(row0 + t0 + i) * D + DATT + ch] = (bf16_t)f2bf(h * ge);
                else { R0[(size_t)(row0 + t0 + i) * DLRU + ch] = h * ge; R1[(size_t)(row0 + t0 + i) * DLRU + ch] = A * ge; }
            }
        }
        __builtin_amdgcn_wave_barrier();
    }
    if (samp) { P.out[O_HS + (size_t)b * 512 + ch] = h; float* co = P.out + O_CS + (size_t)b * 3 * 512 + ch; co[0] = x0; co[512] = x1; co[1024] = x2; }
    else {
        ((float*)(P.ws + WS_HE))[((size_t)(b * 32 + k)) * 512 + ch] = h; ((float*)(P.ws + WS_AE))[((size_t)(b * 32 + k)) * 512 + ch] = A;
        if (k == 31) { float* co = P.out + O_CP + (size_t)b * 3 * 512 + ch; co[0] = x0; co[512] = x1; co[1024] = x2; }
    }
}

__device__ __forceinline__ void phase_lru(const Params& P, LAS unsigned char* lds) {
    const int lane = threadIdx.x & 63, wave = __builtin_amdgcn_readfirstlane(threadIdx.x >> 6);
    const int gw = blockIdx.x * 8 + wave, nw = gridDim.x * 8;
#pragma unroll 1
    for (int pass = 0; pass < 2; ++pass) {
        if ((pass ^ (wave & 1)) == 0) {
            for (int u = gw; u < 2048 + 256; u += nw) { const bool samp = u >= 2048; const int v = samp ? u - 2048 : u; lru_unit(P, samp, samp ? (v >> 3) : (v >> 8), samp ? (v & 7) : ((v >> 5) & 7), v & 31, lane, lds + wave * LRU_WAVE); }
        } else quant_tables(P, gw, nw, MK_QHEAD, 2 * NEXP - MK_QTAIL);
    }
    __syncthreads();
}
__device__ __forceinline__ void phase_samp(const Params& P, LAS unsigned char* lds) {
    SampPre R;
    int u = blockIdx.x;
    if (u < 384 * 8) { const int bh = u >> 3; samp_prefetch(P, bh / NH, bh % NH, u & 7, R); }
    for (; u < 384 * 8; u += gridDim.x) {
        const int bh = u >> 3; const int un = (u + (int)gridDim.x < 384 * 8) ? u + (int)gridDim.x : u; const int nbh = un >> 3;
        samp_unit<false>(P, bh / NH, bh % NH, u & 7, lds, R, nbh / NH, nbh % NH, un & 7);
    }
    for (u = blockIdx.x; u < 384; u += gridDim.x) samp_unit<true>(P, u / NH, u % NH, 8, lds, R, 0, 0, 0);
}
__device__ __forceinline__ AttnId attn01_id(int u) {
    const int p = u / 1536, rem = u - p * 1536, bh = rem >> 4, rc = rem & 15; const int b = bh / NH, h = bh - b * NH;
    return AttnId{p, b, h, p == 0 ? 0 : (rc >> 2), p == 0 ? rc : (rc & 3)};
}
__device__ __forceinline__ void phase_attn01(const Params& P, LAS unsigned char* lds) {
    AttnKV R;
    const int per = (3072 + (int)gridDim.x - 1) / (int)gridDim.x;
    int u = (int)blockIdx.x * per; const int ue = (u + per < 3072) ? u + per : 3072;
    AttnId cur = attn01_id(u < 3072 ? u : 0);
    if (u < ue) attn_fetch(P, cur, R);
    for (; u < ue; ++u) {
        const bool hn = u + 1 < ue;
        AttnId nxt = attn01_id(hn ? u + 1 : u);
        nxt.reuse = (hn && nxt.p == cur.p && nxt.b == cur.b && nxt.h == cur.h && nxt.r == cur.r && nxt.c == cur.c + 1) ? 1 : 0;
        attn_unit<0>(P, cur, R, hn, nxt, lds);
        cur = nxt;
    }
}
__device__ __forceinline__ void phase_mix_b(const Params& P, LAS unsigned char* lds) {
    {
        const int gt = blockIdx.x * NTHREADS + threadIdx.x;
        for (int i = gt; i < 8 * 32 * 512; i += gridDim.x * NTHREADS) {
            const int ch = i & 511, k = (i >> 9) & 31, b = i >> 14;
            const float* HE = (const float*)(P.ws + WS_HE) + (size_t)b * 32 * 512 + ch; const float* AE = (const float*)(P.ws + WS_AE) + (size_t)b * 32 * 512 + ch;
            float he[31], ae[31];
#pragma unroll
            for (int kk = 0; kk < 31; ++kk) { he[kk] = kk < k ? HE[kk * 512] : 0.f; ae[kk] = kk < k ? AE[kk * 512] : 1.f; }
            float hin = 0.f;
#pragma unroll
            for (int kk = 0; kk < 31; ++kk) hin = kk < k ? he[kk] + ae[kk] * hin : hin;
            const float* R0 = (const float*)(P.ws + WS_R0) + (size_t)(b * 2048 + k * 64) * DLRU + ch; const float* R1 = (const float*)(P.ws + WS_R1) + (size_t)(b * 2048 + k * 64) * DLRU + ch;
            bf16_t* ar = (bf16_t*)(P.ws + WS_AR) + (size_t)(b * 2048 + k * 64) * D + DATT + ch;
#pragma unroll 1
            for (int t0 = 0; t0 < 64; t0 += 16) {
                float r0[16], r1[16];
#pragma unroll
                for (int t = 0; t < 16; ++t) { r0[t] = R0[(size_t)(t0 + t) * DLRU]; r1[t] = R1[(size_t)(t0 + t) * DLRU]; }
#pragma unroll
                for (int t = 0; t < 16; ++t) ar[(size_t)(t0 + t) * D] = (bf16_t)f2bf(r0[t] + r1[t] * hin);
            }
            if (k == 31) P.out[O_HP + (size_t)b * 512 + ch] = HE[31 * 512] + AE[31 * 512] * hin;
        }
    }
    { const int lane = threadIdx.x & 63, gw = blockIdx.x * 8 + (threadIdx.x >> 6);
      for (int u = gw; u < NTOK_S * NH; u += gridDim.x * 8) { const int row = u / NH, h = u - row * NH; samp_merge_unit(P, row >> 3, row & 7, h, lane); } }
    {
        AttnKV R; int u = blockIdx.x;
        if (u < 1536) attn_fetch(P, AttnId{2, (u >> 4) / NH, (u >> 4) % NH, u & 15, 0}, R);
        for (; u < 1536; u += gridDim.x) {
            const int un = u + (int)gridDim.x; const bool hn = un < 1536; const int uu = hn ? un : u;
            attn_unit<1>(P, AttnId{2, (u >> 4) / NH, (u >> 4) % NH, u & 15, 0}, R, hn, AttnId{2, (uu >> 4) / NH, (uu >> 4) % NH, uu & 15, 0}, lds);
        }
    }
}

__device__ __forceinline__ void phase_ln1(const Params& P) {
    const int lane = threadIdx.x & 63, wave = threadIdx.x >> 6;
    const bf16_t* pre = (const bf16_t*)(P.ws + WS_PRE1); bf16_t* x1b = (bf16_t*)(P.ws + WS_X1B);
    const int rstep = gridDim.x * 8;
    float4 g8[8], b8[8];
#pragma unroll
    for (int j = 0; j < 8; ++j) { const int col = (j >> 2) * 1024 + lane * 16 + (j & 3) * 4; g8[j] = *(const float4*)(P.ln1_g + col); b8[j] = *(const float4*)(P.ln1_b + col); }
    u32x4 nx[4];
    { const int r0 = blockIdx.x * 8 + wave;
      if (r0 < NTOK) {
#pragma unroll
          for (int j = 0; j < 4; ++j) nx[j] = *(const u32x4*)(pre + (size_t)r0 * D + (j >> 1) * 1024 + lane * 16 + (j & 1) * 8); } }
#pragma unroll
    for (int j = 0; j < 4; ++j) asm volatile("" : "+v"(nx[j]));
    for (int row = blockIdx.x * 8 + wave; row < NTOK; row += rstep) {
        float4 v[8]; float s = 0.f;
        u32x4 cur[4];
#pragma unroll
        for (int j = 0; j < 4; ++j) cur[j] = nx[j];
        if (row + rstep < NTOK) {
#pragma unroll
            for (int j = 0; j < 4; ++j) nx[j] = *(const u32x4*)(pre + (size_t)(row + rstep) * D + (j >> 1) * 1024 + lane * 16 + (j & 1) * 8); }
#pragma unroll
        for (int j = 0; j < 8; j += 2) { const u32x4 pw = cur[j >> 1];
            v[j] = make_float4(bflo(pw.x), bfhi(pw.x), bflo(pw.y), bfhi(pw.y)); v[j + 1] = make_float4(bflo(pw.z), bfhi(pw.z), bflo(pw.w), bfhi(pw.w));
            s += (v[j].x + v[j].y) + (v[j].z + v[j].w) + (v[j + 1].x + v[j + 1].y) + (v[j + 1].z + v[j + 1].w); }
        const float mean = wave_sum(s) * (1.0f / D); float q = 0.f;
#pragma unroll
        for (int j = 0; j < 8; ++j) { const float a = v[j].x - mean, b = v[j].y - mean, c = v[j].z - mean, d = v[j].w - mean; q += (a * a + b * b) + (c * c + d * d); }
        const float rstd = rsqrtf(wave_sum(q) * (1.0f / D) + LN_EPS);
        float am = 0.f;
#pragma unroll
        for (int j = 0; j < 8; ++j) { const int col = (j >> 2) * 1024 + lane * 16 + (j & 3) * 4; const float4 g = g8[j], bb = b8[j];
            float4 o; o.x = (v[j].x - mean) * rstd * g.x + bb.x; o.y = (v[j].y - mean) * rstd * g.y + bb.y; o.z = (v[j].z - mean) * rstd * g.z + bb.z; o.w = (v[j].w - mean) * rstd * g.w + bb.w;
            v[j] = o; am = fmaxf(am, fmaxf(fmaxf(fabsf(o.x), fabsf(o.y)), fmaxf(fabsf(o.z), fabsf(o.w))));
            uint2 w; w.x = pack2(o.x, o.y); w.y = pack2(o.z, o.w); *(uint2*)(x1b + (size_t)row * D + col) = w; }
        am = wave_max(am); if (am == 0.f) am = 1.f;
        const float inv = 119.0f / am;
        unsigned char* xq = P.ws + WS_X1Q + (size_t)row * D;
        u32x4 wh, wl;
#pragma unroll
        for (int d = 0; d < 4; ++d) { unsigned dh = 0u, dl = 0u;
#pragma unroll
            for (int e = 0; e < 8; ++e) { const float4 t = v[d * 2 + (e >> 2)]; const float x = (e & 3) == 0 ? t.x : ((e & 3) == 1 ? t.y : ((e & 3) == 2 ? t.z : t.w));
                const int q = (int)rintf(x * inv); dl |= (unsigned)(q & 15) << (4 * e); dh |= (unsigned)(((q + 8) >> 4) & 15) << (4 * e); }
            wh[d] = dh; wl[d] = dl; }
        *(u32x4*)(xq + lane * 32) = wh; *(u32x4*)(xq + lane * 32 + 16) = wl;
        if (lane == 0) ((float*)(P.ws + WS_SX))[row] = am * (1.0f / 119.0f);
    }
}

__device__ __forceinline__ int mono(float v) { const int b = __float_as_int(v); return b ^ ((b >> 31) & 0x7fffffff); }
__device__ __forceinline__ float unmono(int k) { return __int_as_float(k ^ ((k >> 31) & 0x7fffffff)); }
#define MK_INSERT16(L, X) do { int _x = (X); _Pragma("unroll") for (int _j = 0; _j < 16; ++_j) { const int _hi = max(L[_j], _x); _x = min(L[_j], _x); L[_j] = _hi; } } while (0)

template <int N> __device__ __forceinline__ void bitonic_sort_desc(int (&v)[N]) {
#pragma unroll
    for (int k = 2; k <= N; k <<= 1)
#pragma unroll
        for (int j = k >> 1; j > 0; j >>= 1)
#pragma unroll
            for (int i = 0; i < N; ++i) { const int l = i ^ j;
                if (l > i) { const int a = v[i], b = v[l]; if ((i & k) == 0) { v[i] = max(a, b); v[l] = min(a, b); } else { v[i] = min(a, b); v[l] = max(a, b); } } }
}
template <int N> __device__ __forceinline__ void bitonic_merge_desc(int (&v)[N]) {
#pragma unroll
    for (int j = N >> 1; j > 0; j >>= 1)
#pragma unroll
        for (int i = 0; i < N; ++i) { const int l = i ^ j; if (l > i) { const int a = v[i], b = v[l]; v[i] = max(a, b); v[l] = min(a, b); } }
}
__device__ __forceinline__ void xlane_merge16(int (&v)[16], int off) {
    int c[16];
#pragma unroll
    for (int i = 0; i < 16; ++i) c[i] = max(v[i], __shfl_xor(v[15 - i], off));
#pragma unroll
    for (int i = 0; i < 16; ++i) v[i] = c[i];
    bitonic_merge_desc<16>(v);
}
__device__ __forceinline__ int sel4(int g, int a, int b, int c, int d) { return g == 0 ? a : (g == 1 ? b : (g == 2 ? c : d)); }
__device__ __forceinline__ float sel4f(int g, float a, float b, float c, float d) { return g == 0 ? a : (g == 1 ? b : (g == 2 ? c : d)); }
__device__ __forceinline__ constexpr int cand_a(int role, int i) {
    return role == 0 ? 0 : role == 1 ? (i < 8 ? 1 : (i < 13 ? 2 : 4)) : role == 2 ? (i < 4 ? 3 : (i < 6 ? 5 : (i < 8 ? 6 : (i < 10 ? 7 : 8 + (i - 10))))) : (i < 2 ? 14 + i : -1);
}
__device__ __forceinline__ constexpr int cand_b(int role, int i) {
    return role == 0 ? i : role == 1 ? (i < 8 ? i : (i < 13 ? i - 8 : i - 13)) : role == 2 ? (i < 4 ? i : (i < 6 ? i - 4 : (i < 8 ? i - 6 : (i < 10 ? i - 8 : 0)))) : 0;
}

__device__ __forceinline__ void route_unit(const Params& P, int h, int tg, LAS unsigned char* lds, LAS int* lst) {
    const int lane = threadIdx.x & 63, w = __builtin_amdgcn_readfirstlane(threadIdx.x >> 6);
    const int cq = lane & 15, g = lane >> 4;
    const int tok = tg * 128 + w * 16 + cq;
    const bf16_t* qrow = (const bf16_t*)(P.ws + WS_QP) + (size_t)tok * D + h * 256;
    int L0[16], L1[16];
#pragma unroll
    for (int p = 0; p < 2; ++p) {
        bf16x8 qf[4];
#pragma unroll
        for (int ks = 0; ks < 4; ++ks) qf[ks] = *(const bf16x8*)(qrow + p * 128 + 32 * ks + 8 * g);
        int v0[16], v1[16];
#pragma unroll
        for (int kt = 0; kt < 8; ++kt) {
            f32x4 acc = {0.f, 0.f, 0.f, 0.f};
#pragma unroll
            for (int ks = 0; ks < 4; ++ks) { const bf16x8 kf = *(const LAS bf16x8*)(lds + (p * 128 + 16 * kt + cq) * KVS + (32 * ks + 8 * g) * 2); acc = __builtin_amdgcn_mfma_f32_16x16x32_bf16(kf, qf[ks], acc, 0, 0, 0); }
#pragma unroll
            for (int ii = 0; ii < 4; ++ii) { const int key = (mono(acc[ii]) & ~127) | (16 * kt + 4 * g + ii); if (kt < 4) v0[kt * 4 + ii] = key; else v1[(kt - 4) * 4 + ii] = key; }
        }
        bitonic_sort_desc<16>(v0); bitonic_sort_desc<16>(v1);
#pragma unroll
        for (int i = 0; i < 16; ++i) v0[i] = max(v0[i], v1[15 - i]);
        bitonic_merge_desc<16>(v0);
        xlane_merge16(v0, 16); xlane_merge16(v0, 32);
#pragma unroll
        for (int i = 0; i < 16; ++i) { if (p == 0) L0[i] = v0[i]; else L1[i] = v0[i]; }
    }
    if (g == 0) {
#pragma unroll
        for (int i = 0; i < 16; ++i) lst[(cq * 2 + 0) * 16 + i] = L0[i];
    }
    if (g == 1) {
#pragma unroll
        for (int i = 0; i < 16; ++i) lst[(cq * 2 + 1) * 16 + i] = L1[i];
    }
    float f0[16], f1[16];
#pragma unroll
    for (int i = 0; i < 16; ++i) { f0[i] = unmono(L0[i] & ~127); f1[i] = unmono(L1[i] & ~127); }
    int c[16];
#pragma unroll
    for (int i = 0; i < 16; ++i) {
        constexpr int NEG = (int)0x80000000;
        const float va = sel4f(g, f0[cand_a(0, i)], f0[cand_a(1, i)], f0[cand_a(2, i)], f0[cand_a(3, i) < 0 ? 0 : cand_a(3, i)]);
        const float vb = sel4f(g, f1[cand_b(0, i)], f1[cand_b(1, i)], f1[cand_b(2, i)], f1[cand_b(3, i)]);
        const int id = sel4(g, (cand_a(0, i) << 4) | cand_b(0, i), (cand_a(1, i) << 4) | cand_b(1, i), (cand_a(2, i) << 4) | cand_b(2, i), ((cand_a(3, i) < 0 ? 0 : cand_a(3, i)) << 4) | cand_b(3, i));
        int key = (mono(va + vb) & ~255) | id;
        if (cand_a(3, i) < 0) key = (g == 3) ? NEG : key;
        c[i] = key;
    }
    bitonic_sort_desc<16>(c);
    xlane_merge16(c, 16); xlane_merge16(c, 32);
    const float mx = unmono(c[0] & ~255);
    float e[16]; float sum = 0.f;
#pragma unroll
    for (int i = 0; i < 16; ++i) { e[i] = exp2f((unmono(c[i] & ~255) - mx) * LOG2E); sum += e[i]; }
    const float inv = 1.0f / sum;
    __builtin_amdgcn_wave_barrier();
    int ei[4]; float gi[4];
#pragma unroll
    for (int j = 0; j < 4; ++j) {
        const int key = sel4(g, c[j], c[4 + j], c[8 + j], c[12 + j]);
        gi[j] = sel4f(g, e[j], e[4 + j], e[8 + j], e[12 + j]) * inv;
        const int a = (key >> 4) & 15, b = key & 15;
        const int i0 = lst[(cq * 2 + 0) * 16 + a] & 127, i1 = lst[(cq * 2 + 1) * 16 + b] & 127;
        ei[j] = i0 * 128 + i1;
    }
    int* EIDX = (int*)(P.ws + WS_EIDX); float* GW = (float*)(P.ws + WS_GW);
    *(int4*)(EIDX + (size_t)tok * 128 + h * 16 + 4 * g) = make_int4(ei[0], ei[1], ei[2], ei[3]);
    *(float4*)(GW + (size_t)tok * 128 + h * 16 + 4 * g) = make_float4(gi[0], gi[1], gi[2], gi[3]);
    __builtin_amdgcn_wave_barrier();
}
__device__ __forceinline__ void phase_route(const Params& P, LAS unsigned char* lds) {
    const int tid = threadIdx.x, wave = __builtin_amdgcn_readfirstlane(tid >> 6);
    const int h = blockIdx.x & 7, slot = blockIdx.x >> 3, nslot = gridDim.x >> 3;
    const bf16_t* sk = (const bf16_t*)(P.ws + WS_SKB) + (size_t)h * 2 * 128 * 128;
#pragma unroll
    for (int it = 0; it < 8; ++it) { const int row = it * 32 + (tid >> 4), ch = tid & 15; *(LAS u32x4*)(lds + row * KVS + ch * 16) = *(const u32x4*)(sk + (size_t)row * 128 + ch * 8); }
    __syncthreads();
    LAS int* lst = (LAS int*)(lds + 73728) + wave * 512;
    for (int tg = slot; tg < NTOK / 128; tg += nslot) route_unit(P, h, tg, lds, lst);
    { const int extra = (NTOK / 128) % nslot;
      if (extra != 0 && slot >= extra) quant_tables(P, ((slot - extra) * 8 + h) * 8 + wave, (nslot - extra) * 8 * 8, 2 * NEXP - MK_QTAIL, 2 * NEXP);
      else if (extra == 0) quant_tables(P, (int)blockIdx.x * 8 + wave, (int)gridDim.x * 8, 2 * NEXP - MK_QTAIL, 2 * NEXP); }
}

__device__ __forceinline__ float ubf(unsigned x, int k) { return (float)((x >> (8 * k)) & 0xffu); }
constexpr int XSLOT = 1152, XGRP = 4 * XSLOT, XNG = 4, XWAVE = XNG * XGRP;
__device__ __forceinline__ void dma_group(__amdgpu_buffer_rsrc_t tab, int e_lo, int e_hi, int g, LAS unsigned char* sb, int lane) {
#pragma unroll
    for (int j = 0; j < 4; ++j) {
        const int k = g * 4 + j; const int e = __builtin_amdgcn_readlane(k < 64 ? e_lo : e_hi, k & 63);
        const int so = e * TROW;
        __builtin_amdgcn_raw_ptr_buffer_load_lds(tab, (LAS void*)(sb + j * XSLOT), 16, lane * 16, so, 0, 0);
        if (lane < 8) __builtin_amdgcn_raw_ptr_buffer_load_lds(tab, (LAS void*)(sb + j * XSLOT + 1024), 16, 1024 + lane * 16, so, 0, 0);
    }
}
__device__ __forceinline__ void u_consume(const LAS unsigned char* sb, const u32x4& xh, const u32x4& xl, float a_lo, float a_hi, float b_lo, float b_hi, int g, int lane, float& w_lo, float& w_hi) {
    int d[4];
#pragma unroll
    for (int j = 0; j < 4; ++j) {
        const u32x4 nb = *(const LAS u32x4*)(sb + j * XSLOT + lane * 16); const unsigned sc = *(const LAS unsigned short*)(sb + j * XSLOT + 1024 + lane * 2);
        int tot = 0;
#pragma unroll
        for (int jj = 0; jj < 2; ++jj) {
            int th = __builtin_amdgcn_sdot8((int)nb[jj * 2], (int)xh[jj * 2], 0, false); th = __builtin_amdgcn_sdot8((int)nb[jj * 2 + 1], (int)xh[jj * 2 + 1], th, false);
            int tl = __builtin_amdgcn_sdot8((int)nb[jj * 2], (int)xl[jj * 2], 0, false); tl = __builtin_amdgcn_sdot8((int)nb[jj * 2 + 1], (int)xl[jj * 2 + 1], tl, false);
            tot += (16 * th + tl) * (int)((sc >> (8 * jj)) & 255u); }
        d[j] = tot;
    }
    const auto s02 = __builtin_amdgcn_permlane32_swap((unsigned)d[0], (unsigned)d[2], false, false);
    const auto s13 = __builtin_amdgcn_permlane32_swap((unsigned)d[1], (unsigned)d[3], false, false);
    const int r0 = (int)s02[0] + (int)s02[1], r1 = (int)s13[0] + (int)s13[1];
    const auto s01 = __builtin_amdgcn_permlane16_swap((unsigned)r0, (unsigned)r1, false, false);
    int r = (int)s01[0] + (int)s01[1];
    r += __builtin_amdgcn_update_dpp(0, r, 0x128, 0xf, 0xf, false);
    r += __builtin_amdgcn_update_dpp(0, r, 0x124, 0xf, 0xf, false);
    r += __builtin_amdgcn_update_dpp(0, r, 0x4E, 0xf, 0xf, false);
    r += __builtin_amdgcn_update_dpp(0, r, 0xB1, 0xf, 0xf, false);
    const int tot = __shfl(r, (lane & 3) * 16);
    const bool mine = ((lane >> 2) == (g & 15));
    const bool hi = g >= 16;
    const float wv = (hi ? b_hi : b_lo) * gelu_as((float)tot * (hi ? a_hi : a_lo));
    if (hi) w_hi = mine ? wv : w_hi; else w_lo = mine ? wv : w_lo;
}
__device__ __forceinline__ void v_consume(const LAS unsigned char* sb, int (&acc)[32], int (&bias)[2], float w_lo, float w_hi, float inv_sw, int g, int lane) {
    u32x4 nb[4]; int wq[2] = {0, 0};
#pragma unroll
    for (int j = 0; j < 4; ++j) {
        const int k = g * 4 + j; const float w = readlane_f(k < 64 ? w_lo : w_hi, k & 63) * inv_sw;
        nb[j] = *(const LAS u32x4*)(sb + j * XSLOT + lane * 16); const unsigned sc = *(const LAS unsigned short*)(sb + j * XSLOT + 1024 + lane * 2);
#pragma unroll
        for (int jj = 0; jj < 2; ++jj) { const int q = (int)rintf(w * (float)((sc >> (8 * jj)) & 255u)); wq[jj] |= (q & 255) << (8 * j); }
    }
    bias[0] = __builtin_amdgcn_sdot4(wq[0], 0x01010101, bias[0], false); bias[1] = __builtin_amdgcn_sdot4(wq[1], 0x01010101, bias[1], false);
#pragma unroll
    for (int i = 0; i < 4; ++i) {
        const unsigned r0 = nb[0][i], r1 = nb[1][i], r2 = nb[2][i], r3 = nb[3][i];
        const unsigned p01a = __builtin_amdgcn_perm(r1, r0, 0x05010400u), p01b = __builtin_amdgcn_perm(r1, r0, 0x07030602u);
        const unsigned p23a = __builtin_amdgcn_perm(r3, r2, 0x05010400u), p23b = __builtin_amdgcn_perm(r3, r2, 0x07030602u);
        const unsigned t0 = __builtin_amdgcn_perm(p23a, p01a, 0x05040100u), t1 = __builtin_amdgcn_perm(p23a, p01a, 0x07060302u);
        const unsigned t2 = __builtin_amdgcn_perm(p23b, p01b, 0x05040100u), t3 = __builtin_amdgcn_perm(p23b, p01b, 0x07060302u);
        const int wv = wq[i >> 1];
        acc[i * 8 + 0] = __builtin_amdgcn_sdot4((int)(t0 & 0x0F0F0F0Fu), wv, acc[i * 8 + 0], false); acc[i * 8 + 1] = __builtin_amdgcn_sdot4((int)((t0 >> 4) & 0x0F0F0F0Fu), wv, acc[i * 8 + 1], false);
        acc[i * 8 + 2] = __builtin_amdgcn_sdot4((int)(t1 & 0x0F0F0F0Fu), wv, acc[i * 8 + 2], false); acc[i * 8 + 3] = __builtin_amdgcn_sdot4((int)((t1 >> 4) & 0x0F0F0F0Fu), wv, acc[i * 8 + 3], false);
        acc[i * 8 + 4] = __builtin_amdgcn_sdot4((int)(t2 & 0x0F0F0F0Fu), wv, acc[i * 8 + 4], false); acc[i * 8 + 5] = __builtin_amdgcn_sdot4((int)((t2 >> 4) & 0x0F0F0F0Fu), wv, acc[i * 8 + 5], false);
        acc[i * 8 + 6] = __builtin_amdgcn_sdot4((int)(t3 & 0x0F0F0F0Fu), wv, acc[i * 8 + 6], false); acc[i * 8 + 7] = __builtin_amdgcn_sdot4((int)((t3 >> 4) & 0x0F0F0F0Fu), wv, acc[i * 8 + 7], false);
    }
}
__device__ __forceinline__ void wave_sort128(int& v0, int& v1, int lane) {
#pragma unroll
    for (int k = 2; k <= 128; k <<= 1) {
#pragma unroll
        for (int j = k >> 1; j > 0; j >>= 1) {
            if (j == 64) { const int lo = min(v0, v1), hi = max(v0, v1); v0 = lo; v1 = hi; }
            else {
                const int p0 = __shfl_xor(v0, j), p1 = __shfl_xor(v1, j);
                const bool lower = (lane & j) == 0;
                const bool asc0 = (lane & k) == 0, asc1 = ((64 + lane) & k) == 0;
                v0 = (lower == asc0) ? min(v0, p0) : max(v0, p0);
                v1 = (lower == asc1) ? min(v1, p1) : max(v1, p1);
            }
        }
    }
}
__device__ __forceinline__ void exp_epilogue(const Params& P, int row, int ln, const int (&acc)[32], const int (&bias)[2], float scale_w) {
    const bf16_t* x1b = (const bf16_t*)(P.ws + WS_X1B);
    float val[32]; float s = 0.f;
#pragma unroll
    for (int jj = 0; jj < 2; ++jj) {
        const int b8 = 8 * bias[jj];
#pragma unroll
        for (int hh = 0; hh < 2; ++hh) {
            const u32x4 xa = *(const u32x4*)(x1b + (size_t)row * D + jj * 1024 + ln * 16 + hh * 8);
#pragma unroll
            for (int i = 0; i < 4; ++i) { const int e0 = jj * 16 + hh * 8 + 2 * i;
                val[e0] = scale_w * (float)(acc[e0] - b8) + ALPHA * bflo(xa[i]); val[e0 + 1] = scale_w * (float)(acc[e0 + 1] - b8) + ALPHA * bfhi(xa[i]); s += val[e0] + val[e0 + 1]; }
        }
    }
    const float mean = wave_sum(s) * (1.0f / D); float q = 0.f;
#pragma unroll
    for (int i = 0; i < 32; ++i) { const float d0 = val[i] - mean; q += d0 * d0; }
    const float rstd = rsqrtf(wave_sum(q) * (1.0f / D) + LN_EPS);
    float* yo = P.out + (row < NTOK_P ? O_YP + (size_t)row * D : O_YS + (size_t)(row - NTOK_P) * D);
    const int lo16 = ln * 16;
    float4 gg[8], bb[8];
#pragma unroll
    for (int jj = 0; jj < 2; ++jj)
#pragma unroll
        for (int i = 0; i < 4; ++i) { const int col = jj * 1024 + lo16 + i * 4; gg[jj * 4 + i] = *(const float4*)(P.ln2_g + col); bb[jj * 4 + i] = *(const float4*)(P.ln2_b + col); }
#pragma unroll
    for (int jj = 0; jj < 2; ++jj)
#pragma unroll
        for (int i = 0; i < 4; ++i) {
            const int col = jj * 1024 + lo16 + i * 4;
            const float4 g0 = gg[jj * 4 + i], b0 = bb[jj * 4 + i];
            float4 o;
            o.x = (val[jj * 16 + i * 4 + 0] - mean) * rstd * g0.x + b0.x; o.y = (val[jj * 16 + i * 4 + 1] - mean) * rstd * g0.y + b0.y;
            o.z = (val[jj * 16 + i * 4 + 2] - mean) * rstd * g0.z + b0.z; o.w = (val[jj * 16 + i * 4 + 3] - mean) * rstd * g0.w + b0.w;
            *(float4*)(yo + col) = o;
        }
}
__device__ __forceinline__ void phase_experts(const Params& P, LAS unsigned char* lds) {
    const int lane = threadIdx.x & 63, wave = __builtin_amdgcn_readfirstlane(threadIdx.x >> 6);
    const int* EIDX = (const int*)(P.ws + WS_EIDX); const float* GW = (const float*)(P.ws + WS_GW);
    const __amdgpu_buffer_rsrc_t UQ = __builtin_amdgcn_make_buffer_rsrc((void*)(P.ws + WS_UB), 0, NEXP * TROW, 0x00020000);
    const __amdgpu_buffer_rsrc_t VQ = __builtin_amdgcn_make_buffer_rsrc((void*)(P.ws + WS_VB), 0, NEXP * TROW, 0x00020000);
    const float* SU = (const float*)(P.ws + WS_SU); const float* SV = (const float*)(P.ws + WS_SV); const float* SX = (const float*)(P.ws + WS_SX);
    LAS unsigned char* wb = lds + wave * XWAVE;
    constexpr int TPW = 8;
    const int row0 = blockIdx.x * 8 + wave, rstride = gridDim.x * 8;
    if (row0 + (TPW - 1) * rstride < NTOK_P) {
        u32x4 mxh[TPW], mxl[TPW]; int mel[TPW], meh[TPW]; float mal[TPW], mah[TPW], mbl[TPW], mbh[TPW];
#pragma unroll
        for (int i = 0; i < TPW; ++i) {
            const int row = row0 + i * rstride;
            mxh[i] = *(const u32x4*)(P.ws + WS_X1Q + (size_t)row * D + lane * 32); mxl[i] = *(const u32x4*)(P.ws + WS_X1Q + (size_t)row * D + lane * 32 + 16);
            int p0 = (EIDX[(size_t)row * 128 + lane] << 18) | min(262143, (int)(GW[(size_t)row * 128 + lane] * 262144.0f));
            int p1 = (EIDX[(size_t)row * 128 + 64 + lane] << 18) | min(262143, (int)(GW[(size_t)row * 128 + 64 + lane] * 262144.0f));
            wave_sort128(p0, p1, lane);
            mel[i] = (int)((unsigned)p0 >> 18); meh[i] = (int)((unsigned)p1 >> 18);
            const float gl = ((float)(p0 & 262143) + 0.5f) * (1.0f / 262144.0f), gh = ((float)(p1 & 262143) + 0.5f) * (1.0f / 262144.0f);
            const float sx = SX[row];
            mal[i] = SU[mel[i]] * sx; mah[i] = SU[meh[i]] * sx; mbl[i] = gl * SV[mel[i]]; mbh[i] = gh * SV[meh[i]];
        }
        asm volatile("s_waitcnt vmcnt(0)" ::: "memory");
        dma_group(UQ, mel[0], meh[0], 0, wb, lane); dma_group(UQ, mel[0], meh[0], 1, wb + XGRP, lane); dma_group(UQ, mel[0], meh[0], 2, wb + 2 * XGRP, lane);
        int sg = 0;
        float mwl[TPW], mwh[TPW];
#pragma unroll
        for (int j = 0; j < TPW; ++j) { mwl[j] = 0.f; mwh[j] = 0.f; }
        static_assert(TPW == 8, "the visit order below is written for 8 tokens per wave");
#pragma unroll 1
        for (int v = 0; v < 64; ++v) {
            const int ss = v >> 3, i = v & 7, i2 = (v + 1) & 7, s2 = (v + 1) >> 3;
            u32x4 xh = mxh[0], xl = mxl[0]; int e_lo = mel[0], e_hi = meh[0], n_lo = mel[0], n_hi = meh[0]; float a_lo = mal[0], a_hi = mah[0], b_lo = mbl[0], b_hi = mbh[0], w_lo = mwl[0], w_hi = mwh[0];
#pragma unroll
            for (int j = 1; j < TPW; ++j) { const bool m = (i == j), m2 = (i2 == j);
                xh[0] = m ? mxh[j][0] : xh[0]; xh[1] = m ? mxh[j][1] : xh[1]; xh[2] = m ? mxh[j][2] : xh[2]; xh[3] = m ? mxh[j][3] : xh[3];
                xl[0] = m ? mxl[j][0] : xl[0]; xl[1] = m ? mxl[j][1] : xl[1]; xl[2] = m ? mxl[j][2] : xl[2]; xl[3] = m ? mxl[j][3] : xl[3];
                e_lo = m ? mel[j] : e_lo; e_hi = m ? meh[j] : e_hi; a_lo = m ? mal[j] : a_lo; a_hi = m ? mah[j] : a_hi; b_lo = m ? mbl[j] : b_lo; b_hi = m ? mbh[j] : b_hi;
                w_lo = m ? mwl[j] : w_lo; w_hi = m ? mwh[j] : w_hi; n_lo = m2 ? mel[j] : n_lo; n_hi = m2 ? meh[j] : n_hi; }
#pragma unroll
            for (int gg = 0; gg < 4; ++gg) {
                const int sn = (sg + 3) & 3;
                if (gg == 0) dma_group(UQ, e_lo, e_hi, ss * 4 + 3, wb + sn * XGRP, lane);
                else if (v < 63) dma_group(UQ, n_lo, n_hi, s2 * 4 + gg - 1, wb + sn * XGRP, lane);
                else dma_group(VQ, n_lo, n_hi, gg - 1, wb + sn * XGRP, lane);
                asm volatile("s_waitcnt vmcnt(24)" ::: "memory");
                u_consume(wb + sg * XGRP, xh, xl, a_lo, a_hi, b_lo, b_hi, ss * 4 + gg, lane, w_lo, w_hi);
                sg = (sg + 1) & 3;
            }
#pragma unroll
            for (int j = 0; j < TPW; ++j) { const bool m = (i == j); mwl[j] = m ? w_lo : mwl[j]; mwh[j] = m ? w_hi : mwh[j]; }
        }
#pragma unroll 1
        for (int i = 0; i < TPW; ++i) {
            const int row = row0 + i * rstride;
            int e_lo = mel[0], e_hi = meh[0], n_lo = mel[0], n_hi = meh[0]; float w_lo = mwl[0], w_hi = mwh[0];
#pragma unroll
            for (int j = 1; j < TPW; ++j) { const bool m = (i == j); e_lo = m ? mel[j] : e_lo; e_hi = m ? meh[j] : e_hi; w_lo = m ? mwl[j] : w_lo; w_hi = m ? mwh[j] : w_hi; }
#pragma unroll
            for (int j = 0; j < TPW - 1; ++j) { const bool m = (i == j); n_lo = m ? mel[j + 1] : n_lo; n_hi = m ? meh[j + 1] : n_hi; }
            float wmax = wave_max(fmaxf(fabsf(w_lo), fabsf(w_hi))); if (wmax == 0.f) wmax = 1.f;
            const float scale_w = wmax * (255.0f / 127.0f), inv_sw = 1.0f / scale_w;
            int acc[32]; int bias[2] = {0, 0};
#pragma unroll
            for (int q = 0; q < 32; ++q) acc[q] = 0;
#pragma unroll 1
            for (int g = 0; g < 32; ++g) {
                const int sn = (sg + 3) & 3;
                if (g + 3 < 32) dma_group(VQ, e_lo, e_hi, g + 3, wb + sn * XGRP, lane);
                else dma_group(VQ, n_lo, n_hi, g + 3 - 32, wb + sn * XGRP, lane);
                asm volatile("s_waitcnt vmcnt(24)" ::: "memory");
                v_consume(wb + sg * XGRP, acc, bias, w_lo, w_hi, inv_sw, g, lane);
                sg = (sg + 1) & 3;
            }
            int ln = lane; asm volatile("" : "+v"(ln));
            exp_epilogue(P, row, ln, acc, bias, scale_w);
        }
        asm volatile("s_waitcnt vmcnt(0)" ::: "memory");
    }
    for (int row = row0 + ((row0 + (TPW - 1) * rstride < NTOK_P) ? TPW * rstride : 0); row < NTOK_P; row += rstride) {
        int ln = lane; asm volatile("" : "+v"(ln));
        const u32x4 xh = *(const u32x4*)(P.ws + WS_X1Q + (size_t)row * D + ln * 32), xl = *(const u32x4*)(P.ws + WS_X1Q + (size_t)row * D + ln * 32 + 16);
        const float sx = SX[row];
        const int e_lo = EIDX[(size_t)row * 128 + ln], e_hi = EIDX[(size_t)row * 128 + 64 + ln];
        const float g_lo = GW[(size_t)row * 128 + ln], g_hi = GW[(size_t)row * 128 + 64 + ln];
        const float a_lo = SU[e_lo] * sx, a_hi = SU[e_hi] * sx, b_lo = g_lo * SV[e_lo], b_hi = g_hi * SV[e_hi];
        float w_lo = 0.f, w_hi = 0.f;
        asm volatile("s_waitcnt vmcnt(0)" ::: "memory");
        dma_group(UQ, e_lo, e_hi, 0, wb, lane); dma_group(UQ, e_lo, e_hi, 1, wb + XGRP, lane); dma_group(UQ, e_lo, e_hi, 2, wb + 2 * XGRP, lane);
        int sg = 0;
#pragma unroll 1
        for (int g = 0; g < 32; ++g) {
            const int sn = (sg + 3) & 3;
            if (g + 3 < 32) dma_group(UQ, e_lo, e_hi, g + 3, wb + sn * XGRP, lane); else dma_group(VQ, e_lo, e_hi, g + 3 - 32, wb + sn * XGRP, lane);
            asm volatile("s_waitcnt vmcnt(24)" ::: "memory");
            u_consume(wb + sg * XGRP, xh, xl, a_lo, a_hi, b_lo, b_hi, g, lane, w_lo, w_hi);
            sg = (sg + 1) & 3;
        }
        float wmax = wave_max(fmaxf(fabsf(w_lo), fabsf(w_hi))); if (wmax == 0.f) wmax = 1.f;
        const float scale_w = wmax * (255.0f / 127.0f), inv_sw = 1.0f / scale_w;
        int acc[32]; int bias[2] = {0, 0};
#pragma unroll
        for (int i = 0; i < 32; ++i) acc[i] = 0;
#pragma unroll 1
        for (int g = 0; g < 32; ++g) {
            const int sn = (sg + 3) & 3;
            dma_group(VQ, e_lo, e_hi, (g + 3) & 31, wb + sn * XGRP, lane);
            asm volatile("s_waitcnt vmcnt(24)" ::: "memory");
            v_consume(wb + sg * XGRP, acc, bias, w_lo, w_hi, inv_sw, g, lane);
            sg = (sg + 1) & 3;
        }
        asm volatile("s_waitcnt vmcnt(0)" ::: "memory");
        exp_epilogue(P, row, ln, acc, bias, scale_w);
    }
    LAS int* cmax = (LAS int*)(lds + MISC_OFF + 64);
    __syncthreads();
    for (int ct = blockIdx.x; ct < NTOK_S; ct += gridDim.x) {
        const int row = NTOK_P + ct;
        int ln = lane; asm volatile("" : "+v"(ln));
        const u32x4 xh = *(const u32x4*)(P.ws + WS_X1Q + (size_t)row * D + ln * 32), xl = *(const u32x4*)(P.ws + WS_X1Q + (size_t)row * D + ln * 32 + 16);
        const float sx = SX[row];
        const int kk = 16 * wave + (ln & 15);
        const int e_loc = EIDX[(size_t)row * 128 + kk]; const float g_loc = GW[(size_t)row * 128 + kk];
        const float a_loc = SU[e_loc] * sx, b_loc = g_loc * SV[e_loc];
        float w_loc = 0.f, w_dummy = 0.f;
        asm volatile("s_waitcnt vmcnt(0)" ::: "memory");
#pragma unroll
        for (int g = 0; g < 4; ++g) dma_group(UQ, e_loc, e_loc, g, wb + g * XGRP, lane);
        asm volatile("s_waitcnt vmcnt(0)" ::: "memory");
#pragma unroll
        for (int g = 0; g < 4; ++g) u_consume(wb + g * XGRP, xh, xl, a_loc, a_loc, b_loc, b_loc, g, lane, w_loc, w_dummy);
#pragma unroll
        for (int g = 0; g < 4; ++g) dma_group(VQ, e_loc, e_loc, g, wb + g * XGRP, lane);
        const float wm = wave_max(ln < 16 ? fabsf(w_loc) : 0.f);
        if (lane == 0) cmax[wave] = __float_as_int(wm);
        __syncthreads();
        float wmax = 0.f;
#pragma unroll
        for (int ww = 0; ww < 8; ++ww) wmax = fmaxf(wmax, __int_as_float(cmax[ww]));
        if (wmax == 0.f) wmax = 1.f;
        const float scale_w = wmax * (255.0f / 127.0f), inv_sw = 1.0f / scale_w;
        int acc[32]; int bias[2] = {0, 0};
#pragma unroll
        for (int i = 0; i < 32; ++i) acc[i] = 0;
        asm volatile("s_waitcnt vmcnt(0)" ::: "memory");
#pragma unroll
        for (int g = 0; g < 4; ++g) v_consume(wb + g * XGRP, acc, bias, w_loc, w_loc, inv_sw, g, lane);
        __builtin_amdgcn_wave_barrier();
        {
            LAS int* pp = (LAS int*)wb + lane * 36;
#pragma unroll
            for (int i = 0; i < 8; ++i) *(LAS u32x4*)(pp + 4 * i) = (u32x4){(unsigned)acc[4 * i], (unsigned)acc[4 * i + 1], (unsigned)acc[4 * i + 2], (unsigned)acc[4 * i + 3]};
            pp[32] = bias[0]; pp[33] = bias[1];
        }
        __syncthreads();
        if (wave == 0) {
#pragma unroll
            for (int i = 0; i < 32; ++i) acc[i] = 0;
            bias[0] = 0; bias[1] = 0;
#pragma unroll 1
            for (int ww = 0; ww < 8; ++ww) {
                const LAS int* pp = (const LAS int*)(lds + ww * XWAVE) + lane * 36;
#pragma unroll
                for (int i = 0; i < 8; ++i) { const u32x4 t = *(const LAS u32x4*)(pp + 4 * i); acc[4 * i] += (int)t[0]; acc[4 * i + 1] += (int)t[1]; acc[4 * i + 2] += (int)t[2]; acc[4 * i + 3] += (int)t[3]; }
                bias[0] += pp[32]; bias[1] += pp[33];
            }
            exp_epilogue(P, row, ln, acc, bias, scale_w);
        }
        __syncthreads();
    }
}

constexpr int NPHASE = 11;
__global__ void __launch_bounds__(NTHREADS, 2) fwd(Params P) {
    extern __shared__ __attribute__((aligned(16))) unsigned char lds_raw[];
    LAS unsigned char* lds = (LAS unsigned char*)lds_raw;
    volatile LAS unsigned* misc = (volatile LAS unsigned*)(lds + MISC_OFF);
    const int lo = P.ph_lo, hi = P.ph_hi;
    XcdBarrier bar; bar.bar = (unsigned*)(P.ws + WS_CTL); bar.x = 0; bar.st = nullptr;
    if (hi - lo > 1) {
        if (threadIdx.x == 0) { misc[0] = 0u; misc[1] = 0u; misc[2] = 0u; misc[3] = 0u; }
        __syncthreads();
        bar = xcd_barrier_post((unsigned*)(P.ws + WS_CTL), misc);
    }
#ifndef MK_REPMASK
#define MK_REPMASK 0
#endif
#ifndef MK_PHASE_MASK
#define MK_PHASE_MASK 0x7ff
#endif
#define IN(k) (((MK_PHASE_MASK >> (k)) & 1) && lo <= (k) && (k) < hi)
#define SEAM(k) do { if (IN(k) && IN((k) + 1)) xcd_barrier(bar); } while (0)
    if (IN(0)) { phase_prologue(P, lds); }
    SEAM(0);
    if (IN(1)) {
        pg8::Gemm g{(const pg8::bf16_t*)(P.ws + WS_XB), (const pg8::bf16_t*)(P.ws + WS_WINT), NTOK, DIN, D};
        pg8::StaticOrder S; S.init(NTOK, DIN, (int)gridDim.x, (int)blockIdx.x);
        EpiProj E{P.out, (bf16_t*)(P.ws + WS_XR), (bf16_t*)(P.ws + WS_GATE), (bf16_t*)(P.ws + WS_QB), (bf16_t*)(P.ws + WS_KB), (bf16_t*)(P.ws + WS_VB16)};
        pg8::gemm_phase<EpiProj, pg8::StaticOrder, false>(lds, g, S, E, nullptr);
        { const int nwg = (NTOK / 256) * (DIN / 256), full = nwg % (int)gridDim.x;
          if (full != 0 && (int)blockIdx.x >= full) quant_tables(P, ((int)blockIdx.x - full) * 8 + (int)(threadIdx.x >> 6), ((int)gridDim.x - full) * 8, 0, MK_QHEAD);
          else if (full == 0) quant_tables(P, (int)blockIdx.x * 8 + (int)(threadIdx.x >> 6), (int)gridDim.x * 8, 0, MK_QHEAD); }
    }
    SEAM(1);
    {
        const bool copy_first = ((blockIdx.x >> 3) & 1) != 0;
        if (IN(3) && copy_first) phase_samp(P, lds);
        if (IN(2)) phase_lru(P, lds);
        if (IN(4)) phase_attn01(P, lds);
        if (IN(3) && !copy_first) phase_samp(P, lds);
    }
    SEAM(4);
    if (IN(5)) { phase_mix_b(P, lds); }
    SEAM(5);
    if (IN(6)) {
        sample_rows_gemm<0>(P, (const bf16_t*)(P.ws + WS_AR), (const bf16_t*)(P.ws + WS_WOT), lds);
        pg8::Gemm g{(const pg8::bf16_t*)(P.ws + WS_AR), (const pg8::bf16_t*)(P.ws + WS_WOT), NTOK_P, D, D};
        pg8::StaticOrder S; S.init(NTOK_P, D, (int)gridDim.x, (int)blockIdx.x);
        EpiOut E{(const bf16_t*)(P.ws + WS_XB), (bf16_t*)(P.ws + WS_PRE1)};
        pg8::gemm_phase<EpiOut, pg8::StaticOrder, false>(lds, g, S, E, nullptr);
    }
    SEAM(6);
    if (IN(7)) { phase_ln1(P); }
    SEAM(7);
    if (IN(8)) {
        sample_rows_gemm<1>(P, (const bf16_t*)(P.ws + WS_X1B), (const bf16_t*)(P.ws + WS_WQT), lds);
        pg8::Gemm g{(const pg8::bf16_t*)(P.ws + WS_X1B), (const pg8::bf16_t*)(P.ws + WS_WQT), NTOK_P, D, D};
        pg8::StaticOrder S; S.init(NTOK_P, D, (int)gridDim.x, (int)blockIdx.x);
        EpiBf16Plain E{(bf16_t*)(P.ws + WS_QP), D};
        pg8::gemm_phase<EpiBf16Plain, pg8::StaticOrder, false>(lds, g, S, E, nullptr);
    }
    SEAM(8);
    if (IN(9)) { phase_route(P, lds); }
    SEAM(9);
    if (IN(10)) { phase_experts(P, lds); }
#undef IN
#undef SEAM
}
}

extern "C" void kernel_launch(void* const* d_in, const int* in_sizes, int n_in, void* d_out, int out_size, void* d_ws, size_t ws_size, hipStream_t stream) {
    using namespace mk;
    static int grid = 0;
    if (grid == 0) {
        if (n_in != 23 || (size_t)out_size != O_END || ws_size < WS_END) { fprintf(stderr, "kernel_launch: unexpected shapes: n_in %d out %d ws %zu (need %zu)\n", n_in, out_size, ws_size, (size_t)WS_END); grid = -1; return; }
        int dev = 0, cus = 0, per_cu = 0;
        if (hipGetDevice(&dev) != hipSuccess || hipDeviceGetAttribute(&cus, hipDeviceAttributeMultiprocessorCount, dev) != hipSuccess) { grid = -1; return; }
        if (hipFuncSetAttribute((const void*)fwd, hipFuncAttributeMaxDynamicSharedMemorySize, LDS_BYTES) != hipSuccess) { fprintf(stderr, "kernel_launch: hipFuncSetAttribute failed\n"); grid = -1; return; }
        if (hipOccupancyMaxActiveBlocksPerMultiprocessor(&per_cu, (const void*)fwd, NTHREADS, LDS_BYTES) != hipSuccess || per_cu < 1) { fprintf(stderr, "kernel_launch: occupancy query says %d\n", per_cu); }
        (void)hipGetLastError();
        grid = cus;
    }
    if (grid < 0) return;
    (void)hipMemsetAsync((char*)d_ws + WS_CTL, 0, 65536, stream);
    Params p{};
    p.x_prompt = (const float*)d_in[0]; p.x_sample = (const float*)d_in[1]; p.cache_k = (const float*)d_in[2]; p.cache_v = (const float*)d_in[3];
    p.state_conv = (const float*)d_in[4]; p.state_h = (const float*)d_in[5]; p.w_in = (const float*)d_in[6]; p.conv_w = (const float*)d_in[7]; p.conv_b = (const float*)d_in[8];
    p.lru_w_a = (const float*)d_in[9]; p.lru_b_a = (const float*)d_in[10]; p.lru_w_x = (const float*)d_in[11]; p.lru_b_x = (const float*)d_in[12]; p.lru_lambda = (const float*)d_in[13];
    p.w_out = (const float*)d_in[14]; p.ln1_g = (const float*)d_in[15]; p.ln1_b = (const float*)d_in[16]; p.w_query = (const float*)d_in[17]; p.sub_keys = (const float*)d_in[18];
    p.peer_u = (const float*)d_in[19]; p.peer_v = (const float*)d_in[20]; p.ln2_g = (const float*)d_in[21]; p.ln2_b = (const float*)d_in[22];
    p.out = (float*)d_out; p.ws = (unsigned char*)d_ws;
#if MK_N_LAUNCHES == 1
    p.ph_lo = 0; p.ph_hi = NPHASE;
    hipLaunchKernelGGL(fwd, dim3(grid), dim3(NTHREADS), LDS_BYTES, stream, p);
#else
    for (int k = 0; k < NPHASE; ++k) { p.ph_lo = k; p.ph_hi = k + 1; hipLaunchKernelGGL(fwd, dim3(grid), dim3(NTHREADS), LDS_BYTES, stream, p);
#ifdef MK_EXTRA_PHASE
        if (k == MK_EXTRA_PHASE) hipLaunchKernelGGL(fwd, dim3(grid), dim3(NTHREADS), LDS_BYTES, stream, p);
#endif
    }
#endif
    const hipError_t le = hipPeekAtLastError();
    if (le != hipSuccess) fprintf(stderr, "kernel_launch: launch failed: %s\n", hipGetErrorName(le));
}
```

```cpp
#include <hip/hip_runtime.h>
#include <cstdio>
#include <cstdint>
namespace pg8 {
#define PG8_LAS __attribute__((address_space(3)))
typedef unsigned short bf16_t;
typedef short bf16x8 __attribute__((ext_vector_type(8)));
typedef float f32x4 __attribute__((ext_vector_type(4)));
typedef unsigned u32x4 __attribute__((ext_vector_type(4)));
constexpr int BM = 256, BK = 64, HALF = 128, HTB = HALF * BK * 2  , STAGE_BYTES = 8 * HTB, NXCD = 8, WGM = 8;

__host__ __device__ __forceinline__ int lds_byte(int r, int c) { const int st = (r >> 4) * 2 + (c >> 5), rr = r & 15, cc = c & 31, ob = rr * 64 + cc * 2; return st * 1024 + (ob ^ (((ob >> 9) & 1) << 5)); }
__host__ __device__ __forceinline__ void stage_rc(int b, int& R, int& C) { const int st = b / 1024, sb = b % 1024, swz = sb ^ (((sb >> 9) & 1) << 5); R = (st >> 1) * 16 + swz / 64; C = (st & 1) * 32 + (swz % 64) / 2; }
__host__ __device__ __forceinline__ int perm32(int rho) { const int n = rho >> 4, i = rho & 15; return 8 * (i >> 2) + 4 * n + (i & 3); }

struct Unit { int pm, pn; };
struct Gemm { const bf16_t* A; const bf16_t* Bt; int M, N, K; };

struct StaticOrder {
    int nM, nN, nwg, G, c;
    __host__ __device__ void init(int M, int N, int G_, int c_) { nM = M / BM; nN = N / BM; nwg = nM * nN; G = G_; c = c_; }
    __host__ __device__ bool next(int i, Unit& u) const {
        const long L = (long)i * G + c; if (L >= nwg) return false;
        int wgid = (int)L; { const int q = nwg / NXCD, r = nwg % NXCD, xcd = wgid % NXCD, off = wgid / NXCD; wgid = (xcd < r ? xcd * (q + 1) : r * (q + 1) + (xcd - r) * q) + off; }
        const int nig = WGM * nN, gid = wgid / nig, fm = gid * WGM, gsz = (nM - fm) < WGM ? (nM - fm) : WGM;
        u.pm = fm + ((wgid % nig) % gsz); u.pn = (wgid % nig) / gsz; return true;
    }
    __device__ __forceinline__ void a_ready(const Unit&) const {}
    __device__ __forceinline__ void done(const Unit&) const {}
};
struct CountedOrder : StaticOrder {
    const unsigned* ready; unsigned need; unsigned* tmo;
    __device__ __forceinline__ void a_ready(const Unit& u) const {
        if (threadIdx.x < 64) {
            const unsigned long long t0 = __builtin_amdgcn_s_memrealtime(); unsigned polls = 0;
            while ((unsigned)__builtin_amdgcn_readfirstlane(__hip_atomic_load(ready + 64 * u.pm, __ATOMIC_RELAXED, __HIP_MEMORY_SCOPE_AGENT)) < need) {
                if ((++polls & 255u) == 0u && __builtin_amdgcn_readfirstlane(__hip_atomic_load(tmo, __ATOMIC_RELAXED, __HIP_MEMORY_SCOPE_AGENT)) != 0u) break;
                if (__builtin_amdgcn_s_memrealtime() - t0 > 2000000ull) {
                    if (threadIdx.x == 0) { unsigned expect = 0u; __hip_atomic_compare_exchange_strong(tmo + 1, &expect, 0x600u | (unsigned)(u.pm & 0xff), __ATOMIC_RELAXED, __ATOMIC_RELAXED, __HIP_MEMORY_SCOPE_AGENT); __hip_atomic_store(tmo, 1u, __ATOMIC_RELAXED, __HIP_MEMORY_SCOPE_AGENT); }
                    break; }
                __builtin_amdgcn_s_sleep(2); }
            __builtin_amdgcn_fence(__ATOMIC_ACQUIRE, "agent");
            asm volatile("s_waitcnt vmcnt(0)" ::: "memory");
        }
#if !defined(BROKEN_HOOK_NO_BARRIER)
        asm volatile("" ::: "memory"); __builtin_amdgcn_s_barrier(); asm volatile("" ::: "memory");
#endif
    }
};

__device__ __forceinline__ unsigned cvt_pk_bf16(float lo, float hi) { unsigned r; asm volatile("v_cvt_pk_bf16_f32 %0, %1, %2" : "=v"(r) : "v"(lo), "v"(hi)); return r; }
typedef float f32x2 __attribute__((ext_vector_type(2)));
__device__ __forceinline__ f32x2 gelu_pk(f32x2 v) {
    const f32x2 av = __builtin_elementwise_abs(v), d = av * 0.2316418882f + 1.0f;
    f32x2 t; t.x = __builtin_amdgcn_rcpf(d.x); t.y = __builtin_amdgcn_rcpf(d.y);
    f32x2 q = t * 0.5307027145f + (-0.7265760135f); q = q * t + 0.7107068705f; q = q * t + (-0.142248368f); q = q * t + 0.127414796f; q = q * t;
    const f32x2 s = (v * v) * (-0.72134752044f);
    f32x2 e; e.x = __builtin_amdgcn_exp2f(s.x); e.y = __builtin_amdgcn_exp2f(s.y);
    const f32x2 m = v * (q * e), r = v - m;
    f32x2 o; o.x = v.x < 0.f ? m.x : r.x; o.y = v.y < 0.f ? m.y : r.y; return o;
}

struct EpiF32 {
    static constexpr bool PERM = false, AFTER_DRAIN = false;
    float* C; int ldc; const float* bias;
    __device__ __forceinline__ void operator()(const f32x4 (&acc)[2][2][4][2], const Unit& u, int wr, int wc, int fr, int fq) const {
        const int row0 = u.pm * BM + wr * 64 + fr, col0 = u.pn * BM + wc * 32 + 4 * fq;
        f32x4 bv[2][2];
#pragma unroll
        for (int bj = 0; bj < 2; ++bj)
#pragma unroll
            for (int n = 0; n < 2; ++n) bv[bj][n] = bias ? *(const f32x4*)(bias + col0 + bj * HALF + n * 16) : (f32x4){0.f, 0.f, 0.f, 0.f};
#pragma unroll
        for (int ai = 0; ai < 2; ++ai)
#pragma unroll
            for (int m = 0; m < 4; ++m) { float* rowp = C + (size_t)(row0 + ai * HALF + m * 16) * ldc + col0;
#pragma unroll
                for (int bj = 0; bj < 2; ++bj)
#pragma unroll
                    for (int n = 0; n < 2; ++n) *(f32x4*)(rowp + bj * HALF + n * 16) = acc[ai][bj][m][n] + bv[bj][n]; }
    }
};
template <int ACT  > struct EpiBf16 {
    static constexpr bool PERM = true, AFTER_DRAIN = false;
    bf16_t* O; int ldc; const float* bias; int split_cols; size_t split_stride;
    __device__ __forceinline__ void operator()(const f32x4 (&acc)[2][2][4][2], const Unit& u, int wr, int wc, int fr, int fq) const {
        const int row0 = u.pm * BM + wr * 64 + fr; int colt = u.pn * BM; bf16_t* base = O;
        if (split_cols) { const int t = colt / split_cols; base += (size_t)t * split_stride; colt -= t * split_cols; }
        const int col0 = colt + wc * 32 + 8 * fq, bcol0 = u.pn * BM + wc * 32 + 8 * fq;
        f32x4 bv[2][2];
#pragma unroll
        for (int bj = 0; bj < 2; ++bj)
#pragma unroll
            for (int n = 0; n < 2; ++n) bv[bj][n] = bias ? *(const f32x4*)(bias + bcol0 + bj * HALF + 4 * n) : (f32x4){0.f, 0.f, 0.f, 0.f};
#pragma unroll
        for (int ai = 0; ai < 2; ++ai)
#pragma unroll
            for (int m = 0; m < 4; ++m) { bf16_t* rowp = base + (size_t)(row0 + ai * HALF + m * 16) * ldc + col0;
#pragma unroll
                for (int bj = 0; bj < 2; ++bj) { f32x4 v0 = acc[ai][bj][m][0] + bv[bj][0], v1 = acc[ai][bj][m][1] + bv[bj][1];
                    if (ACT == 1) { f32x2 a = gelu_pk((f32x2){v0[0], v0[1]}), b = gelu_pk((f32x2){v0[2], v0[3]}), c = gelu_pk((f32x2){v1[0], v1[1]}), d = gelu_pk((f32x2){v1[2], v1[3]});
                        v0 = (f32x4){a.x, a.y, b.x, b.y}; v1 = (f32x4){c.x, c.y, d.x, d.y}; }
                    if (ACT == 2) {
#pragma unroll
                        for (int j = 0; j < 4; ++j) { v0[j] = 0.5f * v0[j] * (1.0f + erff(v0[j] * 0.70710678f)); v1[j] = 0.5f * v1[j] * (1.0f + erff(v1[j] * 0.70710678f)); } }
                    u32x4 w; w.x = cvt_pk_bf16(v0[0], v0[1]); w.y = cvt_pk_bf16(v0[2], v0[3]); w.z = cvt_pk_bf16(v1[0], v1[1]); w.w = cvt_pk_bf16(v1[2], v1[3]);
                    *(u32x4*)(rowp + bj * HALF) = w; } }
    }
};

struct PanelStats {
    unsigned* xbuf;
    unsigned* cnt;
    unsigned* tmo;
    int ntn; float eps;
    unsigned code;
    __device__ __forceinline__ bool run(const f32x4 (&v)[2][2][4][2], const Unit& u, int wr, int wc, int fr, int fq, PG8_LAS unsigned char* lds, int wid, int lane) const {
        typedef float f32x2v __attribute__((ext_vector_type(2)));
        PG8_LAS f32x2v* P = (PG8_LAS f32x2v*)lds;
        PG8_LAS f32x2v* S = (PG8_LAS f32x2v*)(lds + 8192);
        PG8_LAS unsigned* flag = (PG8_LAS unsigned*)(lds + 8192 + 2048);
#pragma unroll
        for (int ai = 0; ai < 2; ++ai)
#pragma unroll
            for (int m = 0; m < 4; ++m) {
                float s = 0.f;
#pragma unroll
                for (int bj = 0; bj < 2; ++bj)
#pragma unroll
                    for (int n = 0; n < 2; ++n) { const f32x4 x = v[ai][bj][m][n]; s += (x[0] + x[1]) + (x[2] + x[3]); }
                s += __shfl_xor(s, 16); s += __shfl_xor(s, 32);
                const float mw = s * (1.0f / 64.0f); float q = 0.f;
#pragma unroll
                for (int bj = 0; bj < 2; ++bj)
#pragma unroll
                    for (int n = 0; n < 2; ++n) { const f32x4 d = v[ai][bj][m][n] - mw; q += (d[0] * d[0] + d[1] * d[1]) + (d[2] * d[2] + d[3] * d[3]); }
                q += __shfl_xor(q, 16); q += __shfl_xor(q, 32);
                if (fq == 0) P[(ai * HALF + wr * 64 + m * 16 + fr) * 4 + wc] = (f32x2v){mw, q};
            }
        asm volatile("s_waitcnt lgkmcnt(0)" ::: "memory"); __builtin_amdgcn_s_barrier(); asm volatile("" ::: "memory");
#if defined(BROKEN_NO_WAIT)
        if (blockIdx.x >= 64) { const long long t0 = clock64(); while (clock64() - t0 < 60000) __builtin_amdgcn_s_sleep(8); }
#endif
        const int row = wid * 32 + (lane & 31);
        if (lane < 32) {
            const f32x2v a = P[row * 4 + 0], b = P[row * 4 + 1], c = P[row * 4 + 2], d = P[row * 4 + 3];
            const float mt = (a.x + b.x + c.x + d.x) * 0.25f;
            const float da = a.x - mt, db = b.x - mt, dc = c.x - mt, dd = d.x - mt;
            const float m2 = (a.y + b.y) + (c.y + d.y) + 64.0f * ((da * da + db * db) + (dc * dc + dd * dd));
            unsigned long long* slot = (unsigned long long*)xbuf + ((size_t)(u.pm * BM + row) * 4 + u.pn);
            __hip_atomic_store(slot, ((unsigned long long)__float_as_uint(m2) << 32) | __float_as_uint(mt), __ATOMIC_RELAXED, __HIP_MEMORY_SCOPE_AGENT);
        }
        asm volatile("s_waitcnt vmcnt(0)" ::: "memory");
        if (lane == 0) __hip_atomic_fetch_add(cnt + 64 * u.pm, 1u, __ATOMIC_RELAXED, __HIP_MEMORY_SCOPE_AGENT);
        if (wid == 0) {
            bool dead = false; const unsigned long long t0 = __builtin_amdgcn_s_memrealtime(); const unsigned want = 8u * (unsigned)ntn;
            for (;;) {
#if defined(BROKEN_NO_WAIT)
                break;
#endif
                if ((unsigned)__builtin_amdgcn_readfirstlane(__hip_atomic_load(cnt + 64 * u.pm, __ATOMIC_RELAXED, __HIP_MEMORY_SCOPE_AGENT)) >= want) break;
                if (__builtin_amdgcn_s_memrealtime() - t0 > 2000000ull) {
                    if (lane == 0) { unsigned expect = 0u; __hip_atomic_compare_exchange_strong(tmo + 1, &expect, code | (unsigned)(u.pm & 0xff), __ATOMIC_RELAXED, __ATOMIC_RELAXED, __HIP_MEMORY_SCOPE_AGENT);
                                     __hip_atomic_store(tmo, 1u, __ATOMIC_RELAXED, __HIP_MEMORY_SCOPE_AGENT); }
                    dead = true; break; }
                __builtin_amdgcn_s_sleep(2);
            }
            __builtin_amdgcn_fence(__ATOMIC_ACQUIRE, "agent");
            if (lane == 0) flag[0] = dead ? 1u : 0u;
        }
        asm volatile("s_waitcnt vmcnt(0) lgkmcnt(0)" ::: "memory"); __builtin_amdgcn_s_barrier(); asm volatile("" ::: "memory");
        const bool bad = flag[0] != 0u;
        if (lane < 32) {
            const unsigned long long* slot = (const unsigned long long*)xbuf + (size_t)(u.pm * BM + row) * 4; float mt[4], m2[4]; float ms = 0.f;
#pragma unroll
            for (int t = 0; t < 4; ++t) { if (t < ntn) { const unsigned long long w = __hip_atomic_load(slot + t, __ATOMIC_RELAXED, __HIP_MEMORY_SCOPE_AGENT); mt[t] = __uint_as_float((unsigned)w); m2[t] = __uint_as_float((unsigned)(w >> 32)); } else { mt[t] = 0.f; m2[t] = 0.f; } ms += mt[t]; }
            const float mean = ms / (float)ntn; float q = 0.f;
#pragma unroll
            for (int t = 0; t < 4; ++t) if (t < ntn) { const float dm = mt[t] - mean; q += m2[t] + 256.0f * dm * dm; }
            S[row] = (f32x2v){mean, 1.0f / sqrtf(q / (256.0f * (float)ntn) + eps)};
        }
        asm volatile("s_waitcnt lgkmcnt(0)" ::: "memory"); __builtin_amdgcn_s_barrier(); asm volatile("" ::: "memory");
        return bad;
    }
};
struct EpiLnRes {
    static constexpr bool PERM = false, AFTER_DRAIN = true;
    const float* base; float* out; int ldc; const float* bias; PanelStats st; unsigned poison;
    __device__ __forceinline__ void refuse(size_t i0, size_t stride, int M, int N) const { const float q = __builtin_nanf(""); for (size_t i = i0; i < (size_t)M * N; i += stride) out[(i / N) * ldc + i % N] = q;
        if (i0 == 0) { unsigned expect = 0u; __hip_atomic_compare_exchange_strong(st.tmo + 1, &expect, 0x7f0u, __ATOMIC_RELAXED, __ATOMIC_RELAXED, __HIP_MEMORY_SCOPE_AGENT); __hip_atomic_store(st.tmo, 1u, __ATOMIC_RELAXED, __HIP_MEMORY_SCOPE_AGENT); } }
    __device__ __forceinline__ void fused(f32x4 (&acc)[2][2][4][2], const Unit& u, int wr, int wc, int fr, int fq, PG8_LAS unsigned char* lds, int wid, int lane) const {
        typedef float f32x2v __attribute__((ext_vector_type(2)));
        const PG8_LAS f32x2v* S = (const PG8_LAS f32x2v*)(lds + 8192);
        const int col0 = u.pn * BM + wc * 32 + 4 * fq;
#pragma unroll
        for (int bj = 0; bj < 2; ++bj)
#pragma unroll
            for (int n = 0; n < 2; ++n) { const f32x4 bv = bias ? *(const f32x4*)(bias + col0 + bj * HALF + n * 16) : (f32x4){0.f, 0.f, 0.f, 0.f};
#pragma unroll
                for (int ai = 0; ai < 2; ++ai)
#pragma unroll
                    for (int m = 0; m < 4; ++m) acc[ai][bj][m][n] += bv; }
        const bool bad = st.run(acc, u, wr, wc, fr, fq, lds, wid, lane) || poison != 0u;
        const float qnan = __builtin_nanf("");
#pragma unroll
        for (int ai = 0; ai < 2; ++ai)
#pragma unroll
            for (int m = 0; m < 4; ++m) { const int r = ai * HALF + wr * 64 + m * 16 + fr; const f32x2v sr = S[r]; const size_t off = (size_t)(u.pm * BM + r) * ldc + col0;
#pragma unroll
                for (int bj = 0; bj < 2; ++bj)
#pragma unroll
                    for (int n = 0; n < 2; ++n) { const f32x4 bs = *(const f32x4*)(base + off + bj * HALF + n * 16); f32x4 o = bs + (acc[ai][bj][m][n] - sr.x) * sr.y;
                        if (bad) o = (f32x4){qnan, qnan, qnan, qnan}; *(f32x4*)(out + off + bj * HALF + n * 16) = o; }
                asm volatile("" ::: "memory"); }
    }
};
struct EpiLnResLn {
    static constexpr bool PERM = false, AFTER_DRAIN = true;
    const float* base; float* out; bf16_t* xn; int ldc; const float* bias; PanelStats st1, st2; unsigned poison;
    __device__ __forceinline__ void refuse(size_t i0, size_t stride, int M, int N) const { const float q = __builtin_nanf(""); for (size_t i = i0; i < (size_t)M * N; i += stride) { const size_t o = (i / N) * ldc + i % N; out[o] = q; xn[o] = (bf16_t)0x7fc0u; }
        if (i0 == 0) { unsigned expect = 0u; __hip_atomic_compare_exchange_strong(st1.tmo + 1, &expect, 0x7f0u, __ATOMIC_RELAXED, __ATOMIC_RELAXED, __HIP_MEMORY_SCOPE_AGENT); __hip_atomic_store(st1.tmo, 1u, __ATOMIC_RELAXED, __HIP_MEMORY_SCOPE_AGENT); } }
    __device__ __forceinline__ void fused(f32x4 (&acc)[2][2][4][2], const Unit& u, int wr, int wc, int fr, int fq, PG8_LAS unsigned char* lds, int wid, int lane) const {
        typedef float f32x2v __attribute__((ext_vector_type(2))); typedef unsigned u32x2v __attribute__((ext_vector_type(2)));
        const PG8_LAS f32x2v* S = (const PG8_LAS f32x2v*)(lds + 8192);
        const int col0 = u.pn * BM + wc * 32 + 4 * fq;
#pragma unroll
        for (int bj = 0; bj < 2; ++bj)
#pragma unroll
            for (int n = 0; n < 2; ++n) { const f32x4 bv = bias ? *(const f32x4*)(bias + col0 + bj * HALF + n * 16) : (f32x4){0.f, 0.f, 0.f, 0.f};
#pragma unroll
                for (int ai = 0; ai < 2; ++ai)
#pragma unroll
                    for (int m = 0; m < 4; ++m) acc[ai][bj][m][n] += bv; }
        bool bad = st1.run(acc, u, wr, wc, fr, fq, lds, wid, lane) || poison != 0u;
        const float qnan = __builtin_nanf("");
#pragma unroll
        for (int ai = 0; ai < 2; ++ai)
#pragma unroll
            for (int m = 0; m < 4; ++m) { const int r = ai * HALF + wr * 64 + m * 16 + fr; const f32x2v sr = S[r]; const size_t off = (size_t)(u.pm * BM + r) * ldc + col0;
#pragma unroll
                for (int bj = 0; bj < 2; ++bj)
#pragma unroll
                    for (int n = 0; n < 2; ++n) { const f32x4 bs = *(const f32x4*)(base + off + bj * HALF + n * 16); acc[ai][bj][m][n] = bs + (acc[ai][bj][m][n] - sr.x) * sr.y; }
                asm volatile("" : "+v"(acc[ai][0][m][0]), "+v"(acc[ai][0][m][1]), "+v"(acc[ai][1][m][0]), "+v"(acc[ai][1][m][1]));
                if (m & 1) asm volatile("" ::: "memory"); }
        const bool bad1 = bad;
        bad = st2.run(acc, u, wr, wc, fr, fq, lds, wid, lane) || bad;
#pragma unroll
        for (int ai = 0; ai < 2; ++ai)
#pragma unroll
            for (int m = 0; m < 4; ++m) { const int r = ai * HALF + wr * 64 + m * 16 + fr; const f32x2v sr = S[r]; const size_t off = (size_t)(u.pm * BM + r) * ldc + col0;
#pragma unroll
                for (int bj = 0; bj < 2; ++bj)
#pragma unroll
                    for (int n = 0; n < 2; ++n) { const f32x4 x1 = acc[ai][bj][m][n]; *(f32x4*)(out + off + bj * HALF + n * 16) = bad1 ? (f32x4){qnan, qnan, qnan, qnan} : x1;
                        const f32x4 o = (x1 - sr.x) * sr.y; u32x2v w; w.x = cvt_pk_bf16(o[0], o[1]); w.y = cvt_pk_bf16(o[2], o[3]);
                        if (bad) { w.x = 0x7fc07fc0u; w.y = 0x7fc07fc0u; } *(u32x2v*)(xn + off + bj * HALF + n * 16) = w; }
                asm volatile("" ::: "memory"); }
    }
};

template <class Epi, class Sched, bool STAMP = false>
__device__ __forceinline__ void gemm_phase(PG8_LAS unsigned char* lds, const Gemm g, const Sched& S, const Epi& E, unsigned long long* stamps) {
    const int tid = threadIdx.x, wid = __builtin_amdgcn_readfirstlane(tid >> 6), lane = tid & 63, wr = wid >> 2, wc = wid & 3, fr = lane & 15, fq = lane >> 4;
    const int K = g.K, nt = K / BK;
    int ts_lo = 0, ts_hi = 0, nts = 0; const unsigned long long rt_entry = STAMP ? (unsigned long long)wall_clock64() : 0ull;
#define PG8_STAMP() do { if (STAMP && wid == 0 && nts < 64) { const unsigned long long _c = (unsigned long long)clock64(); \
        ts_lo = (lane == nts) ? (int)(unsigned)_c : ts_lo; ts_hi = (lane == nts) ? (int)(unsigned)(_c >> 32) : ts_hi; ++nts; } } while (0)
    PG8_STAMP();
    unsigned voffA[2], voffB[2];
#pragma unroll
    for (int i = 0; i < 2; ++i) { int R, C; stage_rc(tid * 16 + i * 8192, R, C); const int Rb = Epi::PERM ? ((R & ~31) + perm32(R & 31)) : R;
        voffA[i] = (unsigned)(R * K + C) * 2u; voffB[i] = (unsigned)(Rb * K + C) * 2u; }
    const size_t kstep = (size_t)(BK * 2);
    const size_t hstep = (size_t)HALF * K * 2;
    const size_t tstep = 2 * hstep;
    const unsigned ldsw = (unsigned)wid * 1024u;
    const int aoff = lds_byte(wr * 64 + fr, fq * 8), boff = lds_byte(wc * 32 + fr, fq * 8);
#define PG8_SA(b, h) (((b) * 2 + (h)) * HTB)
#define PG8_SB(b, h) ((4 + (b) * 2 + (h)) * HTB)
#define PG8_STAGE(bufoff, gbase, voff) do { _Pragma("unroll") for (int _i = 0; _i < 2; ++_i) \
        __builtin_amdgcn_global_load_lds((const unsigned*)((const char*)(gbase) + (voff)[_i]), (PG8_LAS unsigned*)(lds + (bufoff) + ldsw + _i * 8192), 16, 0, 0); } while (0)
#define PG8_LDA(dst, b, h) do { _Pragma("unroll") for (int m = 0; m < 4; ++m) _Pragma("unroll") for (int k = 0; k < 2; ++k) dst[m][k] = *(const PG8_LAS bf16x8*)(lds + PG8_SA(b, h) + aoff + m * 2048 + k * 1024); } while (0)
#define PG8_LDB(dst, b, h) do { _Pragma("unroll") for (int n = 0; n < 2; ++n) _Pragma("unroll") for (int k = 0; k < 2; ++k) dst[n][k] = *(const PG8_LAS bf16x8*)(lds + PG8_SB(b, h) + boff + n * 2048 + k * 1024); } while (0)
#define PG8_MMA(ai, bj, At, Bt) do { __builtin_amdgcn_s_setprio(1); _Pragma("unroll") for (int m = 0; m < 4; ++m) _Pragma("unroll") for (int n = 0; n < 2; ++n) _Pragma("unroll") for (int k = 0; k < 2; ++k) \
        acc[ai][bj][m][n] = __builtin_amdgcn_mfma_f32_16x16x32_bf16(Bt[n][k], At[m][k], acc[ai][bj][m][n], 0, 0, 0); __builtin_amdgcn_s_setprio(0); } while (0)
#define PG8_WAIT_V(n) asm volatile("s_waitcnt vmcnt(" #n ")" ::: "memory")
#define PG8_WAIT_L(n) asm volatile("s_waitcnt lgkmcnt(" #n ")" ::: "memory")
#define PG8_BAR __builtin_amdgcn_s_barrier()
#define PG8_SCHED __builtin_amdgcn_sched_barrier(0)
    Unit cur, nxt; int ui = 0;
    if (!S.next(0, cur)) return;
    f32x4 acc[2][2][4][2];
#pragma unroll
    for (int a = 0; a < 2; ++a)
#pragma unroll
        for (int b = 0; b < 2; ++b)
#pragma unroll
            for (int m = 0; m < 4; ++m)
#pragma unroll
                for (int n = 0; n < 2; ++n) acc[a][b][m][n] = (f32x4){0.f, 0.f, 0.f, 0.f};
    bf16x8 At[4][2], B0[2][2], B1[2][2];
    const char* cA = (const char*)g.A + (size_t)cur.pm * tstep; const char* cB = (const char*)g.Bt + (size_t)cur.pn * tstep;
    S.a_ready(cur);
    PG8_STAGE(PG8_SB(0, 0), cB, voffB); PG8_STAGE(PG8_SA(0, 0), cA, voffA); PG8_STAGE(PG8_SB(0, 1), cB + hstep, voffB); PG8_STAGE(PG8_SA(0, 1), cA + hstep, voffA);
    if (wr == 1) PG8_BAR;
    PG8_WAIT_V(4); PG8_BAR;
    PG8_STAGE(PG8_SB(1, 0), cB + kstep, voffB); PG8_STAGE(PG8_SA(1, 0), cA + kstep, voffA); PG8_STAGE(PG8_SB(1, 1), cB + hstep + kstep, voffB);
    PG8_WAIT_V(6); PG8_BAR;
    PG8_STAMP();
    for (;;) {
        const bool has_next = S.next(ui + 1, nxt);
        const char* nA = has_next ? (const char*)g.A + (size_t)nxt.pm * tstep : cA; const char* nB = has_next ? (const char*)g.Bt + (size_t)nxt.pn * tstep : cB;
        for (int t = 0; t < nt; t += 2) {
            const bool last = (t == nt - 2);
            const char* a1 = cA + (size_t)(t + 1) * kstep;
            const char* a2 = last ? nA : cA + (size_t)(t + 2) * kstep; const char* b2 = last ? nB : cB + (size_t)(t + 2) * kstep;
            const char* a3 = a2 + kstep; const char* b3 = b2 + kstep;
            if (last && has_next) S.a_ready(nxt);
            PG8_LDB(B0, 0, 0); PG8_SCHED; PG8_LDA(At, 0, 0); PG8_STAGE(PG8_SA(1, 1), a1 + hstep, voffA);
            PG8_WAIT_L(8); PG8_BAR; PG8_WAIT_L(0); PG8_MMA(0, 0, At, B0); PG8_BAR; PG8_SCHED;
            PG8_LDB(B1, 0, 1); PG8_STAGE(PG8_SB(0, 0), b2, voffB);
            PG8_BAR; PG8_WAIT_L(0); PG8_MMA(0, 1, At, B1); PG8_BAR;
            PG8_LDA(At, 0, 1); PG8_STAGE(PG8_SA(0, 0), a2, voffA);
            PG8_BAR; PG8_WAIT_L(0); PG8_MMA(1, 0, At, B0); PG8_BAR; PG8_SCHED;
            PG8_STAGE(PG8_SB(0, 1), b2 + hstep, voffB);
            PG8_WAIT_V(6); PG8_BAR; PG8_MMA(1, 1, At, B1); PG8_BAR;
            PG8_LDB(B0, 1, 0); PG8_SCHED; PG8_LDA(At, 1, 0); PG8_STAGE(PG8_SA(0, 1), a2 + hstep, voffA);
            PG8_WAIT_L(8); PG8_BAR; PG8_WAIT_L(0); PG8_MMA(0, 0, At, B0); PG8_BAR; PG8_SCHED;
            PG8_LDB(B1, 1, 1); PG8_STAGE(PG8_SB(1, 0), b3, voffB);
            PG8_BAR; PG8_WAIT_L(0); PG8_MMA(0, 1, At, B1); PG8_BAR;
            PG8_LDA(At, 1, 1); PG8_STAGE(PG8_SA(1, 0), a3, voffA);
            PG8_BAR; PG8_WAIT_L(0); PG8_MMA(1, 0, At, B0); PG8_BAR; PG8_SCHED;
            PG8_STAGE(PG8_SB(1, 1), b3 + hstep, voffB);
            PG8_WAIT_V(6); PG8_BAR; PG8_MMA(1, 1, At, B1); PG8_BAR;
        }
        PG8_STAMP();
        if constexpr (!Epi::AFTER_DRAIN) { E(acc, cur, wr, wc, fr, fq); S.done(cur); }
        PG8_STAMP();
        if (!has_next) break;
#pragma unroll
        for (int a = 0; a < 2; ++a)
#pragma unroll
            for (int b = 0; b < 2; ++b)
#pragma unroll
                for (int m = 0; m < 4; ++m)
#pragma unroll
                    for (int n = 0; n < 2; ++n) acc[a][b][m][n] = (f32x4){0.f, 0.f, 0.f, 0.f};
        cur = nxt; cA = nA; cB = nB; ++ui;
    }
    PG8_WAIT_V(0);
    if (wr == 0) PG8_BAR;
    PG8_BAR;
    if constexpr (Epi::AFTER_DRAIN) { E.fused(acc, cur, wr, wc, fr, fq, lds, wid, lane); S.done(cur); }
    PG8_STAMP();
    if (STAMP && wid == 0) { stamps[lane] = lane < nts ? (((unsigned long long)(unsigned)ts_hi << 32) | (unsigned)ts_lo) : 0ull;
        if (lane == 62) stamps[62] = rt_entry; if (lane == 63) stamps[63] = (unsigned long long)wall_clock64(); }
#undef PG8_STAMP
#undef PG8_SA
#undef PG8_SB
#undef PG8_STAGE
#undef PG8_LDA
#undef PG8_LDB
#undef PG8_MMA
#undef PG8_WAIT_V
#undef PG8_WAIT_L
#undef PG8_BAR
#undef PG8_SCHED
}
}
#define XB_TMO      128
#define XB_XCNT(j)  (256  + 64 * (j))
#define XB_XSUB(j)  (1280 + 64 * (j))
#define XB_XGEN(j)  (2304 + 64 * (j))
#define XB_TOP      3328
#define XB_TOPGEN   3392
#define XCD_BAR_WORDS 3456
#define XB_SPIN_CAP (1u << 18)
#define LAS __attribute__((address_space(3)))

__device__ __forceinline__ unsigned xb_ld(unsigned* p)              { return __hip_atomic_load(p, __ATOMIC_RELAXED, __HIP_MEMORY_SCOPE_AGENT); }
__device__ __forceinline__ unsigned xb_add(unsigned* p, unsigned v) { return __hip_atomic_fetch_add(p, v, __ATOMIC_RELAXED, __HIP_MEMORY_SCOPE_AGENT); }
__device__ __forceinline__ unsigned xb_xcc_id() { return (unsigned)__builtin_amdgcn_s_getreg((3 << 11) | 20) & 0xFu; }
#define XB_SPIN(cond, bar) do { unsigned _sp = 0; while (cond) { __builtin_amdgcn_s_sleep(1); \
    if ((++_sp & 255u) == 0u) { if (xb_ld(&(bar)[XB_TMO])) break; if (_sp > XB_SPIN_CAP) { atomicAdd(&(bar)[XB_TMO], 1u); break; } } } } while (0)

struct XcdBarrier {
    unsigned* bar; unsigned x;
    volatile LAS unsigned* st;
};

__device__ __forceinline__ XcdBarrier xcd_barrier_post(unsigned* bar, volatile LAS unsigned* st) {
    XcdBarrier b; b.bar = bar; b.x = xb_xcc_id(); b.st = st;
    if (threadIdx.x == 0) (void)xb_add(&bar[XB_XCNT(b.x)], 1u);
    return b;
}
__device__ __forceinline__ void xcd_barrier_complete(unsigned* bar, unsigned x, unsigned& nloc, unsigned& nx) {
    const unsigned G = gridDim.x * gridDim.y * gridDim.z;
    unsigned sum, cnt, mine, sp = 0u;
    for (;;) {
        sum = 0u; cnt = 0u; mine = 0u;
#pragma unroll
        for (unsigned j = 0; j < 16; ++j) { const unsigned c = xb_ld(&bar[XB_XCNT(j)]); sum += c; cnt += (c > 0u) ? 1u : 0u; mine = (j == x) ? c : mine; }
        if (sum == G) break;
        __builtin_amdgcn_s_sleep(1);
        if ((++sp & 255u) == 0u) { if (xb_ld(&bar[XB_TMO])) break; if (sp > XB_SPIN_CAP) { atomicAdd(&bar[XB_TMO], 1u); break; } }
    }
    nloc = mine > 0u ? mine : 1u; nx = cnt > 0u ? cnt : 1u;
}

__device__ __forceinline__ void xcd_barrier(const XcdBarrier& b) {
    asm volatile("s_waitcnt vmcnt(0)" ::: "memory");
    __syncthreads();
    if (threadIdx.x == 0) {
        unsigned* bar = b.bar;
        __builtin_amdgcn_s_waitcnt(0);
        unsigned nloc = b.st[0], nx = b.st[1];
        if (nloc == 0u) { xcd_barrier_complete(bar, b.x, nloc, nx); b.st[0] = nloc; b.st[1] = nx; }
        const unsigned old = xb_add(&bar[XB_XSUB(b.x)], 1u);
        const unsigned gen = old / nloc;
        if (old + 1u == (gen + 1u) * nloc) {
            __builtin_amdgcn_fence(__ATOMIC_RELEASE, "agent");
            asm volatile("s_waitcnt vmcnt(0)" ::: "memory");
            const unsigned og = xb_add(&bar[XB_TOP], 1u);
            const unsigned tg = og / nx;
            if (og + 1u == (tg + 1u) * nx) xb_add(&bar[XB_TOPGEN], 1u);
            else XB_SPIN(xb_ld(&bar[XB_TOPGEN]) == tg, bar);
            __builtin_amdgcn_fence(__ATOMIC_ACQUIRE, "agent");
            xb_add(&bar[XB_XGEN(b.x)], 1u);
            asm volatile("s_waitcnt vmcnt(0)" ::: "memory");
        } else {
            XB_SPIN(xb_ld(&bar[XB_XGEN(b.x)]) == gen, bar);
            __builtin_amdgcn_fence(__ATOMIC_ACQUIRE, "agent");
            asm volatile("s_waitcnt vmcnt(0)" ::: "memory");
        }
    }
    __syncthreads();
}


#ifndef MK_N_LAUNCHES
#define MK_N_LAUNCHES 1
#endif
#ifndef MK_QTAIL
#define MK_QTAIL 7680
#endif
#ifndef MK_QHEAD
#define MK_QHEAD 12288
#endif
namespace mk {
typedef unsigned short bf16_t;
typedef float f32x4 __attribute__((ext_vector_type(4)));
typedef short bf16x8 __attribute__((ext_vector_type(8)));
typedef short s16x4 __attribute__((ext_vector_type(4)));
typedef unsigned u32x4 __attribute__((ext_vector_type(4)));
typedef unsigned u32x2 __attribute__((ext_vector_type(2)));
typedef float f32x2 __attribute__((ext_vector_type(2)));
constexpr int D = 2048, NTOK_P = 16384, NTOK_S = 256, NTOK = 16640;
constexpr int DIN = 5632, DATT = 1536, DLRU = 512, NH = 12, HD = 128;
constexpr int NEXP = 16384;
constexpr float ALPHA = 1.189207115002721f;
constexpr float LN_EPS = 1e-5f;
constexpr float ATT_SCALE = 0.08838834764831845f;
constexpr float LOG2E = 1.4426950408889634f;
constexpr size_t O_YP = 0, O_YS = 33554432, O_KP = 34078720, O_VP = 59244544, O_CP = 84410368, O_HP = 84422656,
                 O_KS = 84426752, O_VS = 185090048, O_CS = 285753344, O_HS = 285802496, O_END = 285818880;
constexpr size_t WS_CTL = 0;
constexpr size_t WS_XB = 65536;
constexpr size_t WS_WINT = WS_XB + (size_t)NTOK * D * 2;
constexpr size_t WS_WOT = WS_WINT + (size_t)DIN * D * 2;
constexpr size_t WS_WQT = WS_WOT + (size_t)D * D * 2;
constexpr size_t WS_UB = WS_WQT + (size_t)D * D * 2;
constexpr size_t WS_VB = WS_UB + (size_t)NEXP * D * 2;
constexpr size_t WS_QF = WS_VB + (size_t)NEXP * D * 2;
constexpr size_t WS_XR = WS_QF + (size_t)NTOK * DATT * 4;
constexpr size_t WS_GATE = WS_XR + (size_t)NTOK * DLRU * 4;
constexpr size_t WS_AR = WS_GATE + (size_t)NTOK * DLRU * 4;
constexpr size_t WS_PRE1 = WS_AR + (size_t)NTOK * D * 2;
constexpr size_t WS_X1F = WS_PRE1 + (size_t)NTOK * D * 4;
constexpr size_t WS_X1B = WS_X1F + (size_t)NTOK * D * 4;
constexpr size_t WS_QP = WS_X1B + (size_t)NTOK * D * 2;
constexpr size_t WS_EIDX = WS_QP + (size_t)NTOK * D * 4;
constexpr size_t WS_GW = WS_EIDX + (size_t)NTOK * 128 * 4;
constexpr size_t WS_SU = WS_GW + (size_t)NTOK * 128 * 4;
constexpr size_t WS_SV = WS_SU + (size_t)NEXP * 4;
constexpr size_t WS_SX = WS_SV + (size_t)NEXP * 4;
constexpr size_t WS_X1Q = WS_SX + (size_t)NTOK * 4;
constexpr size_t WS_SKB = WS_X1Q + (size_t)NTOK * D;
constexpr size_t WS_QB = WS_SKB + (size_t)8 * 2 * 128 * 128 * 2;
constexpr size_t WS_KB = WS_QB + (size_t)NTOK * DATT * 2;
constexpr size_t WS_VB16 = WS_KB + (size_t)NTOK_P * DATT * 2;
constexpr size_t WS_PO = WS_VB16 + (size_t)NTOK_P * DATT * 2;
constexpr size_t WS_PM = WS_PO + (size_t)2 * NTOK_P * DATT * 2;
constexpr size_t WS_PL = WS_PM + (size_t)2 * NTOK_P * NH * 4;
constexpr size_t WS_R0 = WS_PL + (size_t)2 * NTOK_P * NH * 4;
constexpr size_t WS_R1 = WS_R0 + (size_t)NTOK_P * DLRU * 4;
constexpr size_t WS_HE = WS_R1 + (size_t)NTOK_P * DLRU * 4;
constexpr size_t WS_AE = WS_HE + (size_t)8 * 32 * 512 * 4;
constexpr size_t WS_LW = WS_AE + (size_t)8 * 32 * 512 * 4;
constexpr size_t WS_PS = WS_LW + (size_t)2 * 8 * 64 * 64 * 2;
constexpr size_t WS_END = WS_PS + (size_t)32 * 12 * 9 * 8 * 130 * 4;

constexpr int NTHREADS = 512;
constexpr int LDS_BYTES = 148480;
constexpr int MISC_OFF = 147456;

struct Params {
    const float* x_prompt; const float* x_sample; const float* cache_k; const float* cache_v; const float* state_conv; const float* state_h;
    const float* w_in; const float* conv_w; const float* conv_b; const float* lru_w_a; const float* lru_b_a; const float* lru_w_x; const float* lru_b_x;
    const float* lru_lambda; const float* w_out; const float* ln1_g; const float* ln1_b; const float* w_query; const float* sub_keys;
    const float* peer_u; const float* peer_v; const float* ln2_g; const float* ln2_b;
    float* out; unsigned char* ws; int ph_lo, ph_hi;
};

__device__ __forceinline__ unsigned f2bf(float f) { unsigned u = __float_as_uint(f); u += 0x7fffu + ((u >> 16) & 1u); return u >> 16; }
__device__ __forceinline__ unsigned pack2(float a, float b) { return f2bf(a) | (f2bf(b) << 16); }
__device__ __forceinline__ float bflo(unsigned w) { return __uint_as_float(w << 16); }
__device__ __forceinline__ float bfhi(unsigned w) { return __uint_as_float(w & 0xffff0000u); }
__device__ __forceinline__ float4 ntload4(const float* p) { const f32x4 v = __builtin_nontemporal_load((const f32x4*)p); return make_float4(v[0], v[1], v[2], v[3]); }
__device__ __forceinline__ void ntstore4(float* p, float4 v) { __builtin_nontemporal_store((f32x4){v.x, v.y, v.z, v.w}, (f32x4*)p); }
__device__ __forceinline__ float wave_sum(float v) {
#pragma unroll
    for (int o = 32; o >= 1; o >>= 1) v += __shfl_xor(v, o);
    return v;
}
__device__ __forceinline__ float wave_max(float v) {
#pragma unroll
    for (int o = 32; o >= 1; o >>= 1) v = fmaxf(v, __shfl_xor(v, o));
    return v;
}
__device__ __forceinline__ float gelu_exact(float v) { return 0.5f * v * (1.0f + erff(v * 0.7071067811865476f)); }
__device__ __forceinline__ float gelu_as(float v) {
    const float av = fabsf(v), t = __builtin_amdgcn_rcpf(av * 0.2316418882f + 1.0f);
    float q = t * 0.5307027145f + (-0.7265760135f); q = q * t + 0.7107068705f; q = q * t + (-0.142248368f); q = q * t + 0.127414796f; q = q * t;
    const float e = __builtin_amdgcn_exp2f((v * v) * (-0.72134752044f));
    const float m = v * (q * e);
    return v < 0.f ? m : v - m;
}
__device__ __forceinline__ float sigmoidf(float v) { return 1.0f / (1.0f + expf(-v)); }
__device__ __forceinline__ float readlane_f(float v, int l) { return __int_as_float(__builtin_amdgcn_readlane(__float_as_int(v), l)); }

__device__ __forceinline__ void convert_flat(const float* src, bf16_t* dst, size_t n8, size_t gtid, size_t gstride) {
    for (size_t i = gtid; i < n8; i += gstride) {
        const float4 a = ((const float4*)src)[2 * i], b = ((const float4*)src)[2 * i + 1];
        uint4 w; w.x = pack2(a.x, a.y); w.y = pack2(a.z, a.w); w.z = pack2(b.x, b.y); w.w = pack2(b.z, b.w);
        ((uint4*)dst)[i] = w;
    }
}
__device__ __forceinline__ void transpose_convert(const float* src, bf16_t* dst, int K, int N, LAS float* tile) {
    const int tid = threadIdx.x, ntn = N / 64, ntiles = (K / 64) * ntn;
    for (int tl = blockIdx.x; tl < ntiles; tl += gridDim.x) {
        const int kt = tl / ntn, nt = tl - kt * ntn;
#pragma unroll
        for (int i = 0; i < 8; ++i) { const int r = (tid >> 6) + 8 * i, c = tid & 63; tile[r * 65 + c] = src[(size_t)(kt * 64 + r) * N + nt * 64 + c]; }
        __syncthreads();
#pragma unroll
        for (int i = 0; i < 4; ++i) { const int n = (tid >> 5) + 16 * i, k0 = 2 * (tid & 31);
            const unsigned v = pack2(tile[k0 * 65 + n], tile[(k0 + 1) * 65 + n]);
            *(unsigned*)(dst + (size_t)(nt * 64 + n) * K + kt * 64 + k0) = v; }
        __syncthreads();
    }
}
constexpr int TROW = 1152;
__device__ __forceinline__ void quant_row_load(const Params& P, int it, int lane, float4 (&v)[8]) {
    const bool isv = it >= NEXP; const int row = isv ? it - NEXP : it;
    const float* src = (isv ? P.peer_v : P.peer_u) + (size_t)row * D;
#pragma unroll
    for (int j = 0; j < 2; ++j)
#pragma unroll
        for (int i = 0; i < 4; ++i) v[j * 4 + i] = *(const float4*)(src + j * 1024 + lane * 16 + i * 4);
}
__device__ __forceinline__ void quant_row_store(const Params& P, int it, int lane, const float4 (&v)[8]) {
    const bool isv = it >= NEXP; const int row = isv ? it - NEXP : it;
    float cm[2];
#pragma unroll
    for (int j = 0; j < 2; ++j) { float am = 0.f;
#pragma unroll
        for (int i = 0; i < 4; ++i) { const float4 t = v[j * 4 + i]; am = fmaxf(am, fmaxf(fmaxf(fabsf(t.x), fabsf(t.y)), fmaxf(fabsf(t.z), fabsf(t.w)))); }
        cm[j] = am; }
    float rm = wave_max(fmaxf(cm[0], cm[1])); if (rm == 0.f) rm = 1.f;
    unsigned char* dst = P.ws + (isv ? WS_VB : WS_UB) + (size_t)row * TROW;
    u32x4 w; unsigned sqp = 0u;
#pragma unroll
    for (int j = 0; j < 2; ++j) {
        int sq = (int)ceilf(cm[j] / rm * 255.0f); sq = sq < 1 ? 1 : (sq > 255 ? 255 : sq);
        sqp |= (unsigned)sq << (8 * j);
        const float inv = (255.0f * 7.0f) / (rm * (float)sq);
#pragma unroll
        for (int hh = 0; hh < 2; ++hh) { unsigned dw = 0u;
#pragma unroll
            for (int e = 0; e < 8; ++e) { const float4 t = v[j * 4 + hh * 2 + (e >> 2)]; const float x = (e & 3) == 0 ? t.x : ((e & 3) == 1 ? t.y : ((e & 3) == 2 ? t.z : t.w));
                int n = (int)rintf(x * inv); n = n < -7 ? -7 : (n > 7 ? 7 : n); dw |= (unsigned)(isv ? n + 8 : (n & 15)) << (4 * e); }
            w[j * 2 + hh] = dw; }
    }
    *(u32x4*)(dst + lane * 16) = w;
    *(unsigned short*)(dst + 1024 + lane * 2) = (unsigned short)sqp;
    if (lane == 0) ((float*)(P.ws + (isv ? WS_SV : WS_SU)))[row] = rm * (1.0f / (255.0f * 7.0f));
}
__device__ __forceinline__ void quant_tables(const Params& P, int gw, int nw, int lo, int hi) {
    const int lane = threadIdx.x & 63;
    float4 va[8], vb[8];
    int it = lo + gw;
    if (it < hi) quant_row_load(P, it, lane, va);
#pragma unroll 1
    for (; it < hi; it += 2 * nw) {
        if (it + nw < hi) quant_row_load(P, it + nw, lane, vb);
        quant_row_store(P, it, lane, va);
        if (it + nw < hi) {
            if (it + 2 * nw < hi) quant_row_load(P, it + 2 * nw, lane, va);
            quant_row_store(P, it + nw, lane, vb);
        }
    }
}
__device__ __forceinline__ void phase_prologue(const Params& P, LAS unsigned char* lds) {
    const size_t gtid = (size_t)blockIdx.x * NTHREADS + threadIdx.x, gstride = (size_t)gridDim.x * NTHREADS;
    unsigned char* ws = P.ws;
    convert_flat(P.x_prompt, (bf16_t*)(ws + WS_XB), (size_t)NTOK_P * D / 8, gtid, gstride);
    convert_flat(P.x_sample, (bf16_t*)(ws + WS_XB) + (size_t)NTOK_P * D, (size_t)NTOK_S * D / 8, gtid, gstride);
    convert_flat(P.sub_keys, (bf16_t*)(ws + WS_SKB), (size_t)8 * 2 * 128 * 128 / 8, gtid, gstride);
    for (size_t i = gtid; i < (size_t)2 * 8 * 64 * 64; i += gstride) {
        const int c = (int)(i & 63), d = (int)((i >> 6) & 63), n = (int)((i >> 12) & 7), m = (int)(i >> 15);
        ((bf16_t*)(ws + WS_LW))[i] = (bf16_t)f2bf((m ? P.lru_w_x : P.lru_w_a)[(n * 64 + c) * 64 + d]); }
    transpose_convert(P.w_in, (bf16_t*)(ws + WS_WINT), D, DIN, (LAS float*)lds);
    transpose_convert(P.w_out, (bf16_t*)(ws + WS_WOT), D, D, (LAS float*)lds);
    transpose_convert(P.w_query, (bf16_t*)(ws + WS_WQT), D, D, (LAS float*)lds);
}

struct EpiProj {
    static constexpr bool PERM = true, AFTER_DRAIN = false;
    float* out; bf16_t* XR; bf16_t* GATE; bf16_t* QB; bf16_t* KB; bf16_t* VB16;
    __device__ __forceinline__ void operator()(const f32x4 (&acc)[2][2][4][2], const pg8::Unit& u, int wr, int wc, int fr, int fq) const {
        const int pn = u.pn; const int coff = wc * 32 + 8 * fq;
#pragma unroll
        for (int ai = 0; ai < 2; ++ai)
#pragma unroll
            for (int m = 0; m < 4; ++m) {
                const int row = u.pm * 256 + ai * 128 + wr * 64 + m * 16 + fr;
                const bool prompt = row < NTOK_P;
                float* rowp = nullptr; bf16_t* rowb = nullptr; float bsc = 1.0f;
                if (pn < 6) { rowb = QB + (size_t)row * DATT + pn * 256; bsc = ATT_SCALE * LOG2E; }
                else if (pn < 18) {
                    const int isv = pn >= 12; const int c0 = (pn - (isv ? 12 : 6)) * 256;
                    if (prompt) { rowp = out + (isv ? O_VP : O_KP) + (size_t)row * DATT + c0; rowb = (isv ? VB16 : KB) + (size_t)row * DATT + c0; }
                    else { const int rr = row - NTOK_P, b = rr >> 3, t = rr & 7; rowp = out + (isv ? O_VS : O_KS) + ((size_t)b * 2048 + 2040 + t) * DATT + c0; }
                } else if (pn < 20) rowb = XR + (size_t)row * DLRU + (pn - 18) * 256;
                else rowb = GATE + (size_t)row * DLRU + (pn - 20) * 256;
#pragma unroll
                for (int bj = 0; bj < 2; ++bj) {
                    const f32x4 v0 = acc[ai][bj][m][0], v1 = acc[ai][bj][m][1];
                    if (rowp) { *(f32x4*)(rowp + coff + bj * 128) = v0; *(f32x4*)(rowp + coff + bj * 128 + 4) = v1; }
                    if (rowb) { u32x4 w; w.x = pg8::cvt_pk_bf16(v0[0] * bsc, v0[1] * bsc); w.y = pg8::cvt_pk_bf16(v0[2] * bsc, v0[3] * bsc); w.z = pg8::cvt_pk_bf16(v1[0] * bsc, v1[1] * bsc); w.w = pg8::cvt_pk_bf16(v1[2] * bsc, v1[3] * bsc);
                        *(u32x4*)(rowb + coff + bj * 128) = w; }
                }
            }
    }
};
struct EpiOut {
    static constexpr bool PERM = true, AFTER_DRAIN = false;
    const bf16_t* xb; bf16_t* pre;
    __device__ __forceinline__ void operator()(const f32x4 (&acc)[2][2][4][2], const pg8::Unit& u, int wr, int wc, int fr, int fq) const {
        const int col0 = u.pn * 256 + wc * 32 + 8 * fq;
        u32x4 xv[2][4][2];
#pragma unroll
        for (int ai = 0; ai < 2; ++ai)
#pragma unroll
            for (int m = 0; m < 4; ++m) { const int row = u.pm * 256 + ai * 128 + wr * 64 + m * 16 + fr;
#pragma unroll
                for (int bj = 0; bj < 2; ++bj) xv[ai][m][bj] = *(const u32x4*)(xb + (size_t)row * D + col0 + bj * 128); }
#pragma unroll
        for (int ai = 0; ai < 2; ++ai)
#pragma unroll
            for (int m = 0; m < 4; ++m) {
                const int row = u.pm * 256 + ai * 128 + wr * 64 + m * 16 + fr;
                bf16_t* pr = pre + (size_t)row * D + col0;
#pragma unroll
                for (int bj = 0; bj < 2; ++bj) {
                    const u32x4 x = xv[ai][m][bj]; const f32x4 v0 = acc[ai][bj][m][0], v1 = acc[ai][bj][m][1];
                    u32x4 w;
                    w.x = pg8::cvt_pk_bf16(ALPHA * bflo(x.x) + v0[0], ALPHA * bfhi(x.x) + v0[1]); w.y = pg8::cvt_pk_bf16(ALPHA * bflo(x.y) + v0[2], ALPHA * bfhi(x.y) + v0[3]);
                    w.z = pg8::cvt_pk_bf16(ALPHA * bflo(x.z) + v1[0], ALPHA * bfhi(x.z) + v1[1]); w.w = pg8::cvt_pk_bf16(ALPHA * bflo(x.w) + v1[2], ALPHA * bfhi(x.w) + v1[3]);
                    *(u32x4*)(pr + bj * 128) = w;
                }
            }
    }
};
struct EpiPlain {
    static constexpr bool PERM = false, AFTER_DRAIN = false;
    float* C; int ldc;
    __device__ __forceinline__ void operator()(const f32x4 (&acc)[2][2][4][2], const pg8::Unit& u, int wr, int wc, int fr, int fq) const {
        const int col0 = u.pn * 256 + wc * 32 + 4 * fq;
#pragma unroll
        for (int ai = 0; ai < 2; ++ai)
#pragma unroll
            for (int m = 0; m < 4; ++m) {
                const int row = u.pm * 256 + ai * 128 + wr * 64 + m * 16 + fr;
                float* pr = C + (size_t)row * ldc + col0;
#pragma unroll
                for (int bj = 0; bj < 2; ++bj)
#pragma unroll
                    for (int n = 0; n < 2; ++n) *(f32x4*)(pr + bj * 128 + n * 16) = acc[ai][bj][m][n];
            }
    }
};

struct EpiBf16Plain {
    static constexpr bool PERM = true, AFTER_DRAIN = false;
    bf16_t* C; int ldc;
    __device__ __forceinline__ void operator()(const f32x4 (&acc)[2][2][4][2], const pg8::Unit& u, int wr, int wc, int fr, int fq) const {
        const int col0 = u.pn * 256 + wc * 32 + 8 * fq;
#pragma unroll
        for (int ai = 0; ai < 2; ++ai)
#pragma unroll
            for (int m = 0; m < 4; ++m) {
                const int row = u.pm * 256 + ai * 128 + wr * 64 + m * 16 + fr;
                bf16_t* pr = C + (size_t)row * ldc + col0;
#pragma unroll
                for (int bj = 0; bj < 2; ++bj) { const f32x4 v0 = acc[ai][bj][m][0], v1 = acc[ai][bj][m][1]; u32x4 w;
                    w.x = pg8::cvt_pk_bf16(v0[0], v0[1]); w.y = pg8::cvt_pk_bf16(v0[2], v0[3]); w.z = pg8::cvt_pk_bf16(v1[0], v1[1]); w.w = pg8::cvt_pk_bf16(v1[2], v1[3]);
                    *(u32x4*)(pr + bj * 128) = w; }
            }
    }
};

template <int MODE>
__device__ __forceinline__ void sample_rows_gemm(const Params& P, const bf16_t* A, const bf16_t* Wt, LAS unsigned char* lds) {
    const int tid = threadIdx.x, lane = tid & 63, w = __builtin_amdgcn_readfirstlane(tid >> 6);
    const int c = lane & 15, g = lane >> 4;
    for (int tile = blockIdx.x; tile < 256; tile += gridDim.x) {
        const int tg = tile & 7, cg = tile >> 3;
        const int k0 = 256 * w;
        const bf16_t* wp = Wt + (size_t)(64 * cg + c) * D + k0 + 8 * g;
        const bf16_t* xp = A + (size_t)(NTOK_P + 32 * tg + c) * D + k0 + 8 * g;
        f32x4 acc[4][2];
#pragma unroll
        for (int ct = 0; ct < 4; ++ct) { acc[ct][0] = (f32x4){0.f, 0.f, 0.f, 0.f}; acc[ct][1] = (f32x4){0.f, 0.f, 0.f, 0.f}; }
        bf16x8 wf[8][4], xf[8][2];
#pragma unroll
        for (int ks = 0; ks < 8; ++ks) {
#pragma unroll
            for (int tt = 0; tt < 2; ++tt) xf[ks][tt] = *(const bf16x8*)(xp + (size_t)(16 * tt) * D + 32 * ks);
#pragma unroll
            for (int ct = 0; ct < 4; ++ct) wf[ks][ct] = *(const bf16x8*)(wp + (size_t)(16 * ct) * D + 32 * ks);
        }
        __builtin_amdgcn_sched_barrier(0);
#pragma unroll
        for (int ks = 0; ks < 8; ++ks)
#pragma unroll
            for (int ct = 0; ct < 4; ++ct)
#pragma unroll
                for (int tt = 0; tt < 2; ++tt) acc[ct][tt] = __builtin_amdgcn_mfma_f32_16x16x32_bf16(wf[ks][ct], xf[ks][tt], acc[ct][tt], 0, 0, 0);
        LAS float* part = (LAS float*)lds;
#pragma unroll
        for (int ct = 0; ct < 4; ++ct)
#pragma unroll
            for (int tt = 0; tt < 2; ++tt) *(LAS f32x4*)(part + ((w * 32 + 16 * tt + c) * 64 + 16 * ct + 4 * g)) = acc[ct][tt];
        __syncthreads();
        {
            const int tok = tid >> 4, c4 = (tid & 15) * 4;
            f32x4 sum = {0.f, 0.f, 0.f, 0.f};
#pragma unroll
            for (int ww = 0; ww < 8; ++ww) sum += *(const LAS f32x4*)(part + ((ww * 32 + tok) * 64 + c4));
            const int row = NTOK_P + 32 * tg + tok, col = 64 * cg + c4;
            if (MODE == 0) { const f32x4 xv = *(const f32x4*)(P.x_sample + (size_t)(row - NTOK_P) * D + col); const f32x4 r = xv * ALPHA + sum; u32x2 wv; wv.x = pg8::cvt_pk_bf16(r[0], r[1]); wv.y = pg8::cvt_pk_bf16(r[2], r[3]); *(u32x2*)((bf16_t*)(P.ws + WS_PRE1) + (size_t)row * D + col) = wv; }
            else { u32x2 wv; wv.x = pg8::cvt_pk_bf16(sum[0], sum[1]); wv.y = pg8::cvt_pk_bf16(sum[2], sum[3]); *(u32x2*)((bf16_t*)(P.ws + WS_QP) + (size_t)row * D + col) = wv; }
        }
        __syncthreads();
    }
}

constexpr int KVS = 288, VOFF = 73728;
struct AttnKV { u32x4 k[8], v[8]; };
struct AttnId { int p, b, h, r, c, reuse; };
__device__ __forceinline__ void attn_fetch(const Params& P, const AttnId& u, AttnKV& R) {
    const int tid = threadIdx.x; const int dil = 1 << (2 * u.p);
    const bf16_t* Kb = (const bf16_t*)(P.ws + WS_KB); const bf16_t* Vb = (const bf16_t*)(P.ws + WS_VB16);
    const size_t tok0 = (size_t)u.b * 2048; const int j0 = 128 * u.c - 128, rho0 = (u.c == 0 || u.reuse) ? 128 : 0;
#pragma unroll
    for (int it = 0; it < 8; ++it) {
        const int rho = it * 32 + (tid >> 4), ch = tid & 15;
        if (rho >= rho0) {
            const size_t tok = tok0 + (size_t)((j0 + rho) * dil + u.r);
            R.k[it] = *(const u32x4*)(Kb + tok * DATT + u.h * HD + ch * 8);
            R.v[it] = *(const u32x4*)(Vb + tok * DATT + u.h * HD + ch * 8);
        }
    }
}
__device__ __forceinline__ void attn_commit(const AttnId& u, const AttnKV& R, LAS unsigned char* lds) {
    const int tid = threadIdx.x; const int rho0 = (u.c == 0 || u.reuse) ? 128 : 0;
    const int poff = (u.c & 1) ? 0 : 128;
#pragma unroll
    for (int it = 0; it < 8; ++it) {
        const int rho = it * 32 + (tid >> 4), ch = tid & 15;
        if (rho >= rho0) { const int pr = (rho + poff) & 255; *(LAS u32x4*)(lds + pr * KVS + ch * 16) = R.k[it]; *(LAS u32x4*)(lds + VOFF + pr * KVS + ch * 16) = R.v[it]; }
    }
}
template <int MODE>
__device__ __forceinline__ void attn_unit(const Params& P, const AttnId& uid, AttnKV& R, bool has_next, const AttnId& nid, LAS unsigned char* lds) {
    const int tid = threadIdx.x, lane = tid & 63, w = __builtin_amdgcn_readfirstlane(tid >> 6);
    const int p = uid.p, b = uid.b, h = uid.h, r = uid.r, c = uid.c;
    const int dil = 1 << (2 * p);
    const int poff = (c & 1) ? 0 : 128;
    const bf16_t* Qb = (const bf16_t*)(P.ws + WS_QB);
    const size_t tok0 = (size_t)b * 2048;
    attn_commit(uid, R, lds);
    const int cq = lane & 15, g = lane >> 4;
    const int iq = 128 * c + 16 * w + cq;
    const size_t qtok = tok0 + (size_t)(iq * dil + r);
    bf16x8 qf[4];
#pragma unroll
    for (int ks = 0; ks < 4; ++ks) qf[ks] = *(const bf16x8*)(Qb + qtok * DATT + h * HD + 32 * ks + 8 * g);
    __syncthreads();
#pragma unroll
    for (int ks = 0; ks < 4; ++ks) asm volatile("" : "+v"(qf[ks]));
    if (has_next) attn_fetch(P, nid, R);
    const int ktmin = (8 - w - 8 * c) > 0 ? (8 - w - 8 * c) : 0;
    const float slope2 = exp2f(-8.0f * (float)(h + 1) / 12.0f) * LOG2E * (float)dil;
    f32x4 s[9]; float m = -INFINITY;
#pragma unroll
    for (int kt = 0; kt < 9; ++kt) {
        if (kt >= ktmin) {
            f32x4 acc = {0.f, 0.f, 0.f, 0.f};
#pragma unroll
            for (int ks = 0; ks < 4; ++ks) { const bf16x8 kf = *(const LAS bf16x8*)(lds + (((16 * w + 16 * kt + poff) & 255) + cq) * KVS + (32 * ks + 8 * g) * 2); acc = __builtin_amdgcn_mfma_f32_16x16x32_bf16(kf, qf[ks], acc, 0, 0, 0); }
#pragma unroll
            for (int ii = 0; ii < 4; ++ii) { const int dist = cq + 128 - 16 * kt - 4 * g - ii; float v = acc[ii] - slope2 * (float)dist;
                if (kt == 0 && dist > 128) v = -INFINITY; if (kt == 8 && dist < 0) v = -INFINITY; acc[ii] = v; m = fmaxf(m, v); }
            s[kt] = acc;
        } else s[kt] = (f32x4){-INFINITY, -INFINITY, -INFINITY, -INFINITY};
    }
    m = fmaxf(m, __shfl_xor(m, 16)); m = fmaxf(m, __shfl_xor(m, 32));
    float l = 0.f;
#pragma unroll
    for (int kt = 0; kt < 9; ++kt)
#pragma unroll
        for (int ii = 0; ii < 4; ++ii) { const float pp = exp2f(s[kt][ii] - m); s[kt][ii] = pp; l += pp; }
    l += __shfl_xor(l, 16); l += __shfl_xor(l, 32);
    f32x4 o[8];
#pragma unroll
    for (int dt = 0; dt < 8; ++dt) o[dt] = (f32x4){0.f, 0.f, 0.f, 0.f};
#pragma unroll
    for (int kk = 0; kk < 5; ++kk) {
        const int T0 = 2 * kk, T1 = 2 * kk + 1;
        if (T1 >= ktmin || T0 == 8) {
            u32x4 pw; pw.x = pg8::cvt_pk_bf16(s[T0][0], s[T0][1]); pw.y = pg8::cvt_pk_bf16(s[T0][2], s[T0][3]);
            if (T1 <= 8) { pw.z = pg8::cvt_pk_bf16(s[T1 <= 8 ? T1 : 8][0], s[T1 <= 8 ? T1 : 8][1]); pw.w = pg8::cvt_pk_bf16(s[T1 <= 8 ? T1 : 8][2], s[T1 <= 8 ? T1 : 8][3]); } else { pw.z = 0u; pw.w = 0u; }
            const bf16x8 pf = __builtin_bit_cast(bf16x8, pw);
            const int rT0 = (T0 >= ktmin) ? T0 : 8, rT1 = (T1 <= 8 && T1 >= ktmin) ? T1 : 8;
            const int a0 = VOFF + (((16 * w + 16 * rT0 + poff) & 255) + 4 * g + (cq >> 2)) * KVS + 8 * (cq & 3);
            const int a1 = VOFF + (((16 * w + 16 * rT1 + poff) & 255) + 4 * g + (cq >> 2)) * KVS + 8 * (cq & 3);
#pragma unroll
            for (int dt = 0; dt < 8; ++dt) {
                const s16x4 v0 = __builtin_amdgcn_ds_read_tr16_b64_v4i16((LAS s16x4*)(lds + a0 + dt * 32));
                const s16x4 v1 = __builtin_amdgcn_ds_read_tr16_b64_v4i16((LAS s16x4*)(lds + a1 + dt * 32));
                const bf16x8 vf = {v0[0], v0[1], v0[2], v0[3], v1[0], v1[1], v1[2], v1[3]};
                o[dt] = __builtin_amdgcn_mfma_f32_16x16x32_bf16(vf, pf, o[dt], 0, 0, 0);
            }
        }
    }
    const float inv = 1.0f / l;
    if (MODE == 0) {
        bf16_t* po = (bf16_t*)(P.ws + WS_PO) + ((size_t)p * NTOK_P + qtok) * DATT + h * HD + 4 * g;
#pragma unroll
        for (int dt = 0; dt < 8; ++dt) { u32x2 wv; wv.x = pg8::cvt_pk_bf16(o[dt][0] * inv, o[dt][1] * inv); wv.y = pg8::cvt_pk_bf16(o[dt][2] * inv, o[dt][3] * inv); *(u32x2*)(po + 16 * dt) = wv; }
        if (g == 0) { ((float*)(P.ws + WS_PM))[((size_t)p * NTOK_P + qtok) * NH + h] = m; ((float*)(P.ws + WS_PL))[((size_t)p * NTOK_P + qtok) * NH + h] = l; }
    } else {
        const float* PM = (const float*)(P.ws + WS_PM); const float* PL = (const float*)(P.ws + WS_PL);
        const float m0 = PM[qtok * NH + h], l0 = PL[qtok * NH + h], m1 = PM[((size_t)NTOK_P + qtok) * NH + h], l1 = PL[((size_t)NTOK_P + qtok) * NH + h];
        const float M = fmaxf(m, fmaxf(m0, m1));
        const float w2 = exp2f(m - M), w0 = exp2f(m0 - M) * l0, w1 = exp2f(m1 - M) * l1;
        const float rden = 1.0f / (w2 * l + w0 + w1);
        const bf16_t* p0 = (const bf16_t*)(P.ws + WS_PO) + qtok * DATT + h * HD + 4 * g;
        const bf16_t* p1 = p0 + (size_t)NTOK_P * DATT;
        bf16_t* ar = (bf16_t*)(P.ws + WS_AR) + qtok * D + h * HD + 4 * g;
        u32x2 q0[8], q1[8];
#pragma unroll
        for (int dt = 0; dt < 8; ++dt) { q0[dt] = *(const u32x2*)(p0 + 16 * dt); q1[dt] = *(const u32x2*)(p1 + 16 * dt); }
#pragma unroll
        for (int dt = 0; dt < 8; ++dt) {
            const u32x2 x0 = q0[dt], x1 = q1[dt];
            const float r0 = (w2 * o[dt][0] + w0 * bflo(x0.x) + w1 * bflo(x1.x)) * rden, r1 = (w2 * o[dt][1] + w0 * bfhi(x0.x) + w1 * bfhi(x1.x)) * rden;
            const float r2 = (w2 * o[dt][2] + w0 * bflo(x0.y) + w1 * bflo(x1.y)) * rden, r3 = (w2 * o[dt][3] + w0 * bfhi(x0.y) + w1 * bfhi(x1.y)) * rden;
            u32x2 wv; wv.x = pg8::cvt_pk_bf16(r0, r1); wv.y = pg8::cvt_pk_bf16(r2, r3); *(u32x2*)(ar + 16 * dt) = wv;
        }
    }
    __syncthreads();
}

struct SampPre { f32x4 k[4], v[4]; };
__device__ __forceinline__ void samp_prefetch(const Params& P, int b, int h, int k, SampPre& R) {
    const int tid = threadIdx.x;
    const size_t so = ((size_t)(b * 2048 + 256 * k + (tid >> 5))) * DATT + h * HD + (tid & 31) * 4;
#pragma unroll
    for (int it = 0; it < 4; ++it) { R.k[it] = *(const f32x4*)(P.cache_k + so + (size_t)it * 16 * DATT); R.v[it] = *(const f32x4*)(P.cache_v + so + (size_t)it * 16 * DATT); }
}
__device__ __forceinline__ void samp_load4(const float* ck, const float* cv, int s0, f32x4 (&kk)[4], f32x4 (&vv)[4]) {
#pragma unroll
    for (int j = 0; j < 4; ++j) { kk[j] = *(const f32x4*)(ck + (size_t)(s0 + j) * 16 * DATT); vv[j] = *(const f32x4*)(cv + (size_t)(s0 + j) * 16 * DATT); }
}
__device__ __forceinline__ void samp_put4(float* ok, float* ov, float* ok0, float* ov0, LAS unsigned char* lk, int s0, const f32x4 (&kk)[4], const f32x4 (&vv)[4]) {
#pragma unroll
    for (int j = 0; j < 4; ++j) {
        const int it = s0 + j; const f32x4 kf = kk[j], vf = vv[j];
        if (it == 0) { *(f32x4*)ok0 = kf; *(f32x4*)ov0 = vf; } else { *(f32x4*)(ok + (size_t)it * 16 * DATT) = kf; *(f32x4*)(ov + (size_t)it * 16 * DATT) = vf; }
        u32x2 kw, vw; kw.x = pg8::cvt_pk_bf16(kf[0], kf[1]); kw.y = pg8::cvt_pk_bf16(kf[2], kf[3]); vw.x = pg8::cvt_pk_bf16(vf[0], vf[1]); vw.y = pg8::cvt_pk_bf16(vf[2], vf[3]);
        *(LAS u32x2*)(lk + it * 16 * KVS) = kw; *(LAS u32x2*)(lk + VOFF + it * 16 * KVS) = vw;
    }
}
template <bool LAST>
__device__ __forceinline__ void samp_unit(const Params& P, int b, int h, int k, LAS unsigned char* lds, SampPre& R, int nb, int nh, int nk) {
    const int tid = threadIdx.x, lane = tid & 63, w = __builtin_amdgcn_readfirstlane(tid >> 6);
    const int cq = lane & 15, g = lane >> 4;
    const int t = cq & 7;
    bf16x8 qf[4];
    { const bf16_t* Qb = (const bf16_t*)(P.ws + WS_QB) + ((size_t)(NTOK_P + b * 8 + t)) * DATT + h * HD + 8 * g;
#pragma unroll
      for (int ks = 0; ks < 4; ++ks) qf[ks] = *(const bf16x8*)(Qb + 32 * ks); }
    if (!LAST) {
        const int r5 = tid >> 5, ch4 = tid & 31;
        const size_t so = ((size_t)(b * 2048 + 256 * k + r5)) * DATT + h * HD + ch4 * 4;
        const float* ck = P.cache_k + so; const float* cv = P.cache_v + so;
        float* ok = P.out + O_KS + so - (size_t)8 * DATT; float* ov = P.out + O_VS + so - (size_t)8 * DATT;
        const bool first_ok = (256 * k + r5) >= 8;
        float* junk = (float*)(P.ws + WS_QF) + lane * 4;
        float* ok0 = first_ok ? ok : junk; float* ov0 = first_ok ? ov : junk + 256;
        LAS unsigned char* lk = lds + r5 * KVS + ch4 * 8;
        f32x4 ka[4], va[4], kb[4], vb[4];
        samp_load4(ck, cv, 4, ka, va);
        __builtin_amdgcn_sched_barrier(0);
        samp_put4(ok, ov, ok0, ov0, lk, 0, R.k, R.v);
        samp_load4(ck, cv, 8, kb, vb);
        __builtin_amdgcn_sched_barrier(0);
        samp_put4(ok, ov, ok0, ov0, lk, 4, ka, va);
#pragma unroll
        for (int ks = 0; ks < 4; ++ks) asm volatile("" : "+v"(qf[ks]));
        samp_load4(ck, cv, 12, ka, va);
        samp_prefetch(P, nb, nh, nk, R);
        __builtin_amdgcn_sched_barrier(0);
        samp_put4(ok, ov, ok0, ov0, lk, 8, kb, vb);
        samp_put4(ok, ov, ok0, ov0, lk, 12, ka, va);
    } else {
        const int rho = tid >> 5, ch4 = tid & 31;
        u32x2 kw = {0u, 0u}, vw = {0u, 0u};
        if (rho < 8) { const size_t so = ((size_t)(b * 2048 + 2040 + rho)) * DATT + h * HD + ch4 * 4; const float4 kf = *(const float4*)(P.out + O_KS + so), vf = *(const float4*)(P.out + O_VS + so);
            kw.x = pg8::cvt_pk_bf16(kf.x, kf.y); kw.y = pg8::cvt_pk_bf16(kf.z, kf.w); vw.x = pg8::cvt_pk_bf16(vf.x, vf.y); vw.y = pg8::cvt_pk_bf16(vf.z, vf.w); }
        *(LAS u32x2*)(lds + rho * KVS + ch4 * 8) = kw; *(LAS u32x2*)(lds + VOFF + rho * KVS + ch4 * 8) = vw;
        *(LAS u32x2*)(lds + (16 + rho) * KVS + ch4 * 8) = (u32x2){0u, 0u}; *(LAS u32x2*)(lds + VOFF + (16 + rho) * KVS + ch4 * 8) = (u32x2){0u, 0u};
#pragma unroll
        for (int ks = 0; ks < 4; ++ks) asm volatile("" : "+v"(qf[ks]));
    }
    __syncthreads();
    const float slope2 = exp2f(-8.0f * (float)(h + 1) / 12.0f) * LOG2E;
    const bool active = (k < 8) || (w == 0);
    f32x4 s[2]; float m = -INFINITY;
#pragma unroll
    for (int j = 0; j < 2; ++j) {
        f32x4 acc = {0.f, 0.f, 0.f, 0.f};
        if (active) {
#pragma unroll
            for (int ks = 0; ks < 4; ++ks) { const bf16x8 kf = *(const LAS bf16x8*)(lds + (32 * w + 16 * j + cq) * KVS + (32 * ks + 8 * g) * 2); acc = __builtin_amdgcn_mfma_f32_16x16x32_bf16(kf, qf[ks], acc, 0, 0, 0); }
        }
#pragma unroll
        for (int ii = 0; ii < 4; ++ii) {
            const int c = 256 * k + 32 * w + 16 * j + 4 * g + ii, dist = 2048 + t - c;
            int mult = (dist <= 128 ? 1 : 0) + (((dist & 3) == 0 && dist <= 512) ? 1 : 0) + (((dist & 15) == 0 && dist <= 2048) ? 1 : 0);
            if (dist < 0 || !active || c > 2055) mult = 0;
            const float v = mult ? acc[ii] - slope2 * (float)dist : -INFINITY;
            acc[ii] = v; m = fmaxf(m, v);
            s[j][ii] = (float)mult;
            s[j][ii] = v;
        }
    }
    m = fmaxf(m, __shfl_xor(m, 16)); m = fmaxf(m, __shfl_xor(m, 32));
    const float mref = (m == -INFINITY) ? 0.f : m;
    float l = 0.f;
#pragma unroll
    for (int j = 0; j < 2; ++j)
#pragma unroll
        for (int ii = 0; ii < 4; ++ii) {
            const int c = 256 * k + 32 * w + 16 * j + 4 * g + ii, dist = 2048 + t - c;
            const int mult = (dist <= 128 ? 1 : 0) + (((dist & 3) == 0 && dist <= 512) ? 1 : 0) + (((dist & 15) == 0 && dist <= 2048) ? 1 : 0);
            const float pp = (float)mult * exp2f(s[j][ii] - mref); s[j][ii] = pp; l += pp; }
    l += __shfl_xor(l, 16); l += __shfl_xor(l, 32);
    f32x4 o[8];
    {
        u32x4 pw; pw.x = pg8::cvt_pk_bf16(s[0][0], s[0][1]); pw.y = pg8::cvt_pk_bf16(s[0][2], s[0][3]); pw.z = pg8::cvt_pk_bf16(s[1][0], s[1][1]); pw.w = pg8::cvt_pk_bf16(s[1][2], s[1][3]);
        const bf16x8 pf = __builtin_bit_cast(bf16x8, pw);
        const int rw = active ? w : 0;
        const int a0 = VOFF + (32 * rw + 4 * g + (cq >> 2)) * KVS + 8 * (cq & 3), a1 = a0 + 16 * KVS;
#pragma unroll
        for (int dt = 0; dt < 8; ++dt) {
            const s16x4 v0 = __builtin_amdgcn_ds_read_tr16_b64_v4i16((LAS s16x4*)(lds + a0 + dt * 32));
            const s16x4 v1 = __builtin_amdgcn_ds_read_tr16_b64_v4i16((LAS s16x4*)(lds + a1 + dt * 32));
            const bf16x8 vf = {v0[0], v0[1], v0[2], v0[3], v1[0], v1[1], v1[2], v1[3]};
            o[dt] = __builtin_amdgcn_mfma_f32_16x16x32_bf16(vf, pf, (f32x4){0.f, 0.f, 0.f, 0.f}, 0, 0, 0);
        }
    }
    __syncthreads();
    LAS float* OL = (LAS float*)lds;
    LAS float* ML = (LAS float*)(lds + 32768);
    if (cq < 8) {
#pragma unroll
        for (int dt = 0; dt < 8; ++dt) *(LAS f32x4*)(OL + (w * 8 + cq) * 128 + 16 * dt + 4 * g) = o[dt];
        if (g == 0) { ML[(w * 8 + cq) * 2 + 0] = m; ML[(w * 8 + cq) * 2 + 1] = l; }
    }
    __syncthreads();
    {
        const int q = w; float M = -INFINITY;
#pragma unroll
        for (int ww = 0; ww < 8; ++ww) M = fmaxf(M, ML[(ww * 8 + q) * 2]);
        const float Mr = (M == -INFINITY) ? 0.f : M;
        float L = 0.f, o0 = 0.f, o1 = 0.f;
#pragma unroll
        for (int ww = 0; ww < 8; ++ww) { const float f = exp2f(ML[(ww * 8 + q) * 2] - Mr); L += f * ML[(ww * 8 + q) * 2 + 1];
            o0 += f * OL[(ww * 8 + q) * 128 + 2 * lane]; o1 += f * OL[(ww * 8 + q) * 128 + 2 * lane + 1]; }
        float* ps = (float*)(P.ws + WS_PS) + ((((size_t)(b * NH + h)) * 9 + k) * 8 + q) * 130;
        if (lane == 0) { ps[0] = M; ps[1] = L; }
        *(float2*)(ps + 2 + 2 * lane) = make_float2(o0, o1);
    }
    __syncthreads();
}
__device__ __forceinline__ void samp_merge_unit(const Params& P, int b, int t, int h, int lane) {
    const float* ps = (const float*)(P.ws + WS_PS) + ((size_t)(b * NH + h)) * 9 * 8 * 130 + (size_t)t * 130;
    float M = -INFINITY;
#pragma unroll
    for (int k = 0; k < 9; ++k) M = fmaxf(M, ps[(size_t)k * 8 * 130]);
    float L = 0.f, o0 = 0.f, o1 = 0.f;
#pragma unroll
    for (int k = 0; k < 9; ++k) { const float* pk = ps + (size_t)k * 8 * 130; const float f = exp2f(pk[0] - M); L += f * pk[1]; const float2 ov = *(const float2*)(pk + 2 + 2 * lane); o0 += f * ov.x; o1 += f * ov.y; }
    const float inv = 1.0f / L;
    bf16_t* ar = (bf16_t*)(P.ws + WS_AR) + ((size_t)(NTOK_P + b * 8 + t)) * D + h * HD;
    *(unsigned*)(ar + 2 * lane) = pack2(o0 * inv, o1 * inv);
}

constexpr int LRU_XS = 144, LRU_GS = 68, LRU_WAVE = 16 * LRU_XS + 2 * 16 * LRU_GS * 4;
__device__ __forceinline__ void lru_unit(const Params& P, bool samp, int b, int n, int k, int lane, LAS unsigned char* wl) {
    const int T = samp ? 8 : 64; const int row0 = samp ? NTOK_P + b * 8 : b * 2048 + k * 64; const int ch = n * 64 + lane;
    const int cq = lane & 15, g = lane >> 4;
    bf16x8 wf[2][4][2];
    { const bf16_t* lw = (const bf16_t*)(P.ws + WS_LW);
#pragma unroll
      for (int m = 0; m < 2; ++m)
#pragma unroll
        for (int ct = 0; ct < 4; ++ct)
#pragma unroll
            for (int ks = 0; ks < 2; ++ks) wf[m][ct][ks] = *(const bf16x8*)(lw + ((size_t)((m * 8 + n) * 64 + 16 * ct + cq)) * 64 + 32 * ks + 8 * g); }
    const float ba = P.lru_b_a[ch], bx = P.lru_b_x[ch], lam = P.lru_lambda[ch];
    const float sp8 = -8.0f * LOG2E * log1pf(expf(-lam));
    const float cw0 = P.conv_w[ch], cw1 = P.conv_w[512 + ch], cw2 = P.conv_w[1024 + ch], cw3 = P.conv_w[1536 + ch], cb = P.conv_b[ch];
    const bf16_t* XR = (const bf16_t*)(P.ws + WS_XR); const bf16_t* GT = (const bf16_t*)(P.ws + WS_GATE);
    unsigned* RP = (unsigned*)(P.ws + WS_R0); bf16_t* AR = (bf16_t*)(P.ws + WS_AR);
    LAS unsigned char* xcb = wl; LAS float* G = (LAS float*)(wl + 16 * LRU_XS);
    float x0 = 0.f, x1 = 0.f, x2 = 0.f, h = 0.f, A = 1.f;
    if (samp) { x0 = P.state_conv[(b * 3 + 0) * 512 + ch]; x1 = P.state_conv[(b * 3 + 1) * 512 + ch]; x2 = P.state_conv[(b * 3 + 2) * 512 + ch]; h = P.state_h[b * 512 + ch]; }
    else if (k > 0) { x0 = bflo(XR[(size_t)(row0 - 3) * DLRU + ch]); x1 = bflo(XR[(size_t)(row0 - 2) * DLRU + ch]); x2 = bflo(XR[(size_t)(row0 - 1) * DLRU + ch]); }
    unsigned xrn[16], gtn[16];
    { const int ns0 = T < 16 ? T : 16;
#pragma unroll
      for (int i = 0; i < 16; ++i) { const int r = row0 + (i < ns0 ? i : ns0 - 1); xrn[i] = XR[(size_t)r * DLRU + ch]; gtn[i] = GT[(size_t)r * DLRU + ch]; } }
    __builtin_amdgcn_sched_barrier(0);
#pragma unroll
    for (int i = 0; i < 16; ++i) { asm volatile("" : "+v"(xrn[i])); asm volatile("" : "+v"(gtn[i])); }
#pragma unroll 1
    for (int t0 = 0; t0 < T; t0 += 16) {
        const int ns = (T - t0) < 16 ? (T - t0) : 16;
        float xc[16], gt[16];
#pragma unroll
        for (int i = 0; i < 16; ++i) { xc[i] = bflo(xrn[i]); gt[i] = bflo(gtn[i]); }
        if (t0 + 16 < T) { const int nn = (T - t0 - 16) < 16 ? (T - t0 - 16) : 16;
#pragma unroll
            for (int i = 0; i < 16; ++i) { const int r = row0 + t0 + 16 + (i < nn ? i : nn - 1); xrn[i] = XR[(size_t)r * DLRU + ch]; gtn[i] = GT[(size_t)r * DLRU + ch]; } }
        __builtin_amdgcn_sched_barrier(0);
#pragma unroll
        for (int i = 0; i < 16; ++i) {
            const float xin = xc[i]; const float v = ((x0 * cw0 + x1 * cw1) + x2 * cw2) + xin * cw3 + cb;
            if (i < ns) { x0 = x1; x1 = x2; x2 = xin; }
            xc[i] = v;
            *(LAS bf16_t*)(xcb + i * LRU_XS + lane * 2) = (bf16_t)f2bf(v);
        }
        __builtin_amdgcn_wave_barrier();
        const bf16x8 a0 = *(const LAS bf16x8*)(xcb + cq * LRU_XS + (8 * g) * 2), a1 = *(const LAS bf16x8*)(xcb + cq * LRU_XS + (32 + 8 * g) * 2);
#pragma unroll
        for (int m = 0; m < 2; ++m)
#pragma unroll
            for (int ct = 0; ct < 4; ++ct) {
                f32x4 acc = __builtin_amdgcn_mfma_f32_16x16x32_bf16(a0, wf[m][ct][0], (f32x4){0.f, 0.f, 0.f, 0.f}, 0, 0, 0);
                acc = __builtin_amdgcn_mfma_f32_16x16x32_bf16(a1, wf[m][ct][1], acc, 0, 0, 0);
#pragma unroll
                for (int ii = 0; ii < 4; ++ii) G[(m * 16 + 4 * g + ii) * LRU_GS + 16 * ct + cq] = acc[ii];
            }
        __builtin_amdgcn_wave_barrier();
#pragma unroll
        for (int i = 0; i < 16; ++i) {
            if (i < ns) {
                const float ra = G[i * LRU_GS + lane] + ba, ri = G[(16 + i) * LRU_GS + lane] + bx;
                const float r = __builtin_amdgcn_rcpf(1.0f + __builtin_amdgcn_exp2f(-LOG2E * ra)), ig = __builtin_amdgcn_rcpf(1.0f + __builtin_amdgcn_exp2f(-LOG2E * ri));
                const float a = __builtin_amdgcn_exp2f(sp8 * r);
                const float u = __builtin_amdgcn_sqrtf(fmaxf(1.0f - a * a, 0.f)) * (ig * xc[i]);
                h = a * h + u; A = a * A;
                const float ge = gelu_as(gt[i]);
                if (samp) AR[(size_t)(row0 + t0 + i) * D + DATT + ch] = (bf16_t)f2bf(h * ge);
                else RP[(size_t)(row0 + t0 + i) * DLRU + ch] = pack2(h * ge, A * ge);
            }
        }
        __builtin_amdgcn_wave_barrier();
    }
    if (samp) { P.out[O_HS + (size_t)b * 512 + ch] = h; float* co = P.out + O_CS + (size_t)b * 3 * 512 + ch; co[0] = x0; co[512] = x1; co[1024] = x2; }
    else {
        ((float*)(P.ws + WS_HE))[((size_t)(b * 32 + k)) * 512 + ch] = h; ((float*)(P.ws + WS_AE))[((size_t)(b * 32 + k)) * 512 + ch] = A;
        if (k == 31) { float* co = P.out + O_CP + (size_t)b * 3 * 512 + ch; co[0] = x0; co[512] = x1; co[1024] = x2; }
    }
}

__device__ __forceinline__ void phase_lru(const Params& P, LAS unsigned char* lds) {
    const int lane = threadIdx.x & 63, wave = __builtin_amdgcn_readfirstlane(threadIdx.x >> 6);
    const int gw = blockIdx.x * 8 + wave, nw = gridDim.x * 8;
#pragma unroll 1
    for (int pass = 0; pass < 2; ++pass) {
        if ((pass ^ (wave & 1)) == 0) {
            for (int u = gw; u < 2048 + 256; u += nw) { const bool samp = u >= 2048; const int v = samp ? u - 2048 : u; lru_unit(P, samp, samp ? (v >> 3) : (v >> 8), samp ? (v & 7) : ((v >> 5) & 7), v & 31, lane, lds + wave * LRU_WAVE); }
        } else quant_tables(P, gw, nw, MK_QHEAD, 2 * NEXP - MK_QTAIL);
    }
    __syncthreads();
}
__device__ __forceinline__ void phase_samp(const Params& P, LAS unsigned char* lds) {
    SampPre R;
    int u = blockIdx.x;
    if (u < 384 * 8) { const int bh = u >> 3; samp_prefetch(P, bh / NH, bh % NH, u & 7, R); }
    for (; u < 384 * 8; u += gridDim.x) {
        const int bh = u >> 3; const int un = (u + (int)gridDim.x < 384 * 8) ? u + (int)gridDim.x : u; const int nbh = un >> 3;
        samp_unit<false>(P, bh / NH, bh % NH, u & 7, lds, R, nbh / NH, nbh % NH, un & 7);
    }
    for (u = blockIdx.x; u < 384; u += gridDim.x) samp_unit<true>(P, u / NH, u % NH, 8, lds, R, 0, 0, 0);
}
__device__ __forceinline__ AttnId attn01_id(int u) {
    const int p = u / 1536, rem = u - p * 1536, bh = rem >> 4, rc = rem & 15; const int b = bh / NH, h = bh - b * NH;
    return AttnId{p, b, h, p == 0 ? 0 : (rc >> 2), p == 0 ? rc : (rc & 3)};
}
__device__ __forceinline__ void phase_attn01(const Params& P, LAS unsigned char* lds) {
    AttnKV R;
    const int per = (3072 + (int)gridDim.x - 1) / (int)gridDim.x;
    int u = (int)blockIdx.x * per; const int ue = (u + per < 3072) ? u + per : 3072;
    AttnId cur = attn01_id(u < 3072 ? u : 0);
    if (u < ue) attn_fetch(P, cur, R);
    for (; u < ue; ++u) {
        const bool hn = u + 1 < ue;
        AttnId nxt = attn01_id(hn ? u + 1 : u);
        nxt.reuse = (hn && nxt.p == cur.p && nxt.b == cur.b && nxt.h == cur.h && nxt.r == cur.r && nxt.c == cur.c + 1) ? 1 : 0;
        attn_unit<0>(P, cur, R, hn, nxt, lds);
        cur = nxt;
    }
}
__device__ __forceinline__ void phase_mix_b(const Params& P, LAS unsigned char* lds) {
    {
        const int gt = blockIdx.x * NTHREADS + threadIdx.x;
        for (int i = gt; i < 8 * 32 * 512; i += gridDim.x * NTHREADS) {
            const int ch = i & 511, k = (i >> 9) & 31, b = i >> 14;
            const float* HE = (const float*)(P.ws + WS_HE) + (size_t)b * 32 * 512 + ch; const float* AE = (const float*)(P.ws + WS_AE) + (size_t)b * 32 * 512 + ch;
            float he[31], ae[31];
#pragma unroll
            for (int kk = 0; kk < 31; ++kk) { he[kk] = kk < k ? HE[kk * 512] : 0.f; ae[kk] = kk < k ? AE[kk * 512] : 1.f; }
            float hin = 0.f;
#pragma unroll
            for (int kk = 0; kk < 31; ++kk) hin = kk < k ? he[kk] + ae[kk] * hin : hin;
            const unsigned* RP = (const unsigned*)(P.ws + WS_R0) + (size_t)(b * 2048 + k * 64) * DLRU + ch;
            bf16_t* ar = (bf16_t*)(P.ws + WS_AR) + (size_t)(b * 2048 + k * 64) * D + DATT + ch;
#pragma unroll 1
            for (int t0 = 0; t0 < 64; t0 += 16) {
                unsigned rp[16];
#pragma unroll
                for (int t = 0; t < 16; ++t) rp[t] = RP[(size_t)(t0 + t) * DLRU];
#pragma unroll
                for (int t = 0; t < 16; ++t) ar[(size_t)(t0 + t) * D] = (bf16_t)f2bf(bflo(rp[t]) + bfhi(rp[t]) * hin);
            }
            if (k == 31) P.out[O_HP + (size_t)b * 512 + ch] = HE[31 * 512] + AE[31 * 512] * hin;
        }
    }
    { const int lane = threadIdx.x & 63, gw = blockIdx.x * 8 + (threadIdx.x >> 6);
      for (int u = gw; u < NTOK_S * NH; u += gridDim.x * 8) { const int row = u / NH, h = u - row * NH; samp_merge_unit(P, row >> 3, row & 7, h, lane); } }
    {
        AttnKV R; int u = blockIdx.x;
        if (u < 1536) attn_fetch(P, AttnId{2, (u >> 4) / NH, (u >> 4) % NH, u & 15, 0}, R);
        for (; u < 1536; u += gridDim.x) {
            const int un = u + (int)gridDim.x; const bool hn = un < 1536; const int uu = hn ? un : u;
            attn_unit<1>(P, AttnId{2, (u >> 4) / NH, (u >> 4) % NH, u & 15, 0}, R, hn, AttnId{2, (uu >> 4) / NH, (uu >> 4) % NH, uu & 15, 0}, lds);
        }
    }
}

__device__ __forceinline__ void phase_ln1(const Params& P) {
    const int lane = threadIdx.x & 63, wave = threadIdx.x >> 6;
    const bf16_t* pre = (const bf16_t*)(P.ws + WS_PRE1); bf16_t* x1b = (bf16_t*)(P.ws + WS_X1B);
    const int rstep = gridDim.x * 8;
    float4 g8[8], b8[8];
#pragma unroll
    for (int j = 0; j < 8; ++j) { const int col = (j >> 2) * 1024 + lane * 16 + (j & 3) * 4; g8[j] = *(const float4*)(P.ln1_g + col); b8[j] = *(const float4*)(P.ln1_b + col); }
    u32x4 nx[4];
    { const int r0 = blockIdx.x * 8 + wave;
      if (r0 < NTOK) {
#pragma unroll
          for (int j = 0; j < 4; ++j) nx[j] = *(const u32x4*)(pre + (size_t)r0 * D + (j >> 1) * 1024 + lane * 16 + (j & 1) * 8); } }
#pragma unroll
    for (int j = 0; j < 4; ++j) asm volatile("" : "+v"(nx[j]));
    for (int row = blockIdx.x * 8 + wave; row < NTOK; row += rstep) {
        float4 v[8]; float s = 0.f;
        u32x4 cur[4];
#pragma unroll
        for (int j = 0; j < 4; ++j) cur[j] = nx[j];
        if (row + rstep < NTOK) {
#pragma unroll
            for (int j = 0; j < 4; ++j) nx[j] = *(const u32x4*)(pre + (size_t)(row + rstep) * D + (j >> 1) * 1024 + lane * 16 + (j & 1) * 8); }
#pragma unroll
        for (int j = 0; j < 8; j += 2) { const u32x4 pw = cur[j >> 1];
            v[j] = make_float4(bflo(pw.x), bfhi(pw.x), bflo(pw.y), bfhi(pw.y)); v[j + 1] = make_float4(bflo(pw.z), bfhi(pw.z), bflo(pw.w), bfhi(pw.w));
            s += (v[j].x + v[j].y) + (v[j].z + v[j].w) + (v[j + 1].x + v[j + 1].y) + (v[j + 1].z + v[j + 1].w); }
        const float mean = wave_sum(s) * (1.0f / D); float q = 0.f;
#pragma unroll
        for (int j = 0; j < 8; ++j) { const float a = v[j].x - mean, b = v[j].y - mean, c = v[j].z - mean, d = v[j].w - mean; q += (a * a + b * b) + (c * c + d * d); }
        const float rstd = rsqrtf(wave_sum(q) * (1.0f / D) + LN_EPS);
        float am = 0.f;
#pragma unroll
        for (int j = 0; j < 8; ++j) { const int col = (j >> 2) * 1024 + lane * 16 + (j & 3) * 4; const float4 g = g8[j], bb = b8[j];
            float4 o; o.x = (v[j].x - mean) * rstd * g.x + bb.x; o.y = (v[j].y - mean) * rstd * g.y + bb.y; o.z = (v[j].z - mean) * rstd * g.z + bb.z; o.w = (v[j].w - mean) * rstd * g.w + bb.w;
            v[j] = o; am = fmaxf(am, fmaxf(fmaxf(fabsf(o.x), fabsf(o.y)), fmaxf(fabsf(o.z), fabsf(o.w))));
            uint2 w; w.x = pack2(o.x, o.y); w.y = pack2(o.z, o.w); *(uint2*)(x1b + (size_t)row * D + col) = w; }
        am = wave_max(am); if (am == 0.f) am = 1.f;
        const float inv = 119.0f / am;
        unsigned char* xq = P.ws + WS_X1Q + (size_t)row * D;
        u32x4 wh, wl;
#pragma unroll
        for (int d = 0; d < 4; ++d) { unsigned dh = 0u, dl = 0u;
#pragma unroll
            for (int e = 0; e < 8; ++e) { const float4 t = v[d * 2 + (e >> 2)]; const float x = (e & 3) == 0 ? t.x : ((e & 3) == 1 ? t.y : ((e & 3) == 2 ? t.z : t.w));
                const int q = (int)rintf(x * inv); dl |= (unsigned)(q & 15) << (4 * e); dh |= (unsigned)(((q + 8) >> 4) & 15) << (4 * e); }
            wh[d] = dh; wl[d] = dl; }
        *(u32x4*)(xq + lane * 32) = wh; *(u32x4*)(xq + lane * 32 + 16) = wl;
        if (lane == 0) ((float*)(P.ws + WS_SX))[row] = am * (1.0f / 119.0f);
    }
}

__device__ __forceinline__ int mono(float v) { const int b = __float_as_int(v); return b ^ ((b >> 31) & 0x7fffffff); }
__device__ __forceinline__ float unmono(int k) { return __int_as_float(k ^ ((k >> 31) & 0x7fffffff)); }
#define MK_INSERT16(L, X) do { int _x = (X); _Pragma("unroll") for (int _j = 0; _j < 16; ++_j) { const int _hi = max(L[_j], _x); _x = min(L[_j], _x); L[_j] = _hi; } } while (0)

template <int N> __device__ __forceinline__ void bitonic_sort_desc(int (&v)[N]) {
#pragma unroll
    for (int k = 2; k <= N; k <<= 1)
#pragma unroll
        for (int j = k >> 1; j > 0; j >>= 1)
#pragma unroll
            for (int i = 0; i < N; ++i) { const int l = i ^ j;
                if (l > i) { const int a = v[i], b = v[l]; if ((i & k) == 0) { v[i] = max(a, b); v[l] = min(a, b); } else { v[i] = min(a, b); v[l] = max(a, b); } } }
}
template <int N> __device__ __forceinline__ void bitonic_merge_desc(int (&v)[N]) {
#pragma unroll
    for (int j = N >> 1; j > 0; j >>= 1)
#pragma unroll
        for (int i = 0; i < N; ++i) { const int l = i ^ j; if (l > i) { const int a = v[i], b = v[l]; v[i] = max(a, b); v[l] = min(a, b); } }
}
__device__ __forceinline__ void xlane_merge16(int (&v)[16], int off) {
    int c[16];
#pragma unroll
    for (int i = 0; i < 16; ++i) c[i] = max(v[i], __shfl_xor(v[15 - i], off));
#pragma unroll
    for (int i = 0; i < 16; ++i) v[i] = c[i];
    bitonic_merge_desc<16>(v);
}
__device__ __forceinline__ int sel4(int g, int a, int b, int c, int d) { return g == 0 ? a : (g == 1 ? b : (g == 2 ? c : d)); }
__device__ __forceinline__ float sel4f(int g, float a, float b, float c, float d) { return g == 0 ? a : (g == 1 ? b : (g == 2 ? c : d)); }
__device__ __forceinline__ constexpr int cand_a(int role, int i) {
    return role == 0 ? 0 : role == 1 ? (i < 8 ? 1 : (i < 13 ? 2 : 4)) : role == 2 ? (i < 4 ? 3 : (i < 6 ? 5 : (i < 8 ? 6 : (i < 10 ? 7 : 8 + (i - 10))))) : (i < 2 ? 14 + i : -1);
}
__device__ __forceinline__ constexpr int cand_b(int role, int i) {
    return role == 0 ? i : role == 1 ? (i < 8 ? i : (i < 13 ? i - 8 : i - 13)) : role == 2 ? (i < 4 ? i : (i < 6 ? i - 4 : (i < 8 ? i - 6 : (i < 10 ? i - 8 : 0)))) : 0;
}

__device__ __forceinline__ void route_unit(const Params& P, int h, int tg, LAS unsigned char* lds, LAS int* lst) {
    const int lane = threadIdx.x & 63, w = __builtin_amdgcn_readfirstlane(threadIdx.x >> 6);
    const int cq = lane & 15, g = lane >> 4;
    const int tok = tg * 128 + w * 16 + cq;
    const bf16_t* qrow = (const bf16_t*)(P.ws + WS_QP) + (size_t)tok * D + h * 256;
    int L0[16], L1[16];
#pragma unroll
    for (int p = 0; p < 2; ++p) {
        bf16x8 qf[4];
#pragma unroll
        for (int ks = 0; ks < 4; ++ks) qf[ks] = *(const bf16x8*)(qrow + p * 128 + 32 * ks + 8 * g);
        int v0[16], v1[16];
#pragma unroll
        for (int kt = 0; kt < 8; ++kt) {
            f32x4 acc = {0.f, 0.f, 0.f, 0.f};
#pragma unroll
            for (int ks = 0; ks < 4; ++ks) { const bf16x8 kf = *(const LAS bf16x8*)(lds + (p * 128 + 16 * kt + cq) * KVS + (32 * ks + 8 * g) * 2); acc = __builtin_amdgcn_mfma_f32_16x16x32_bf16(kf, qf[ks], acc, 0, 0, 0); }
#pragma unroll
            for (int ii = 0; ii < 4; ++ii) { const int key = (mono(acc[ii]) & ~127) | (16 * kt + 4 * g + ii); if (kt < 4) v0[kt * 4 + ii] = key; else v1[(kt - 4) * 4 + ii] = key; }
        }
        bitonic_sort_desc<16>(v0); bitonic_sort_desc<16>(v1);
#pragma unroll
        for (int i = 0; i < 16; ++i) v0[i] = max(v0[i], v1[15 - i]);
        bitonic_merge_desc<16>(v0);
        xlane_merge16(v0, 16); xlane_merge16(v0, 32);
#pragma unroll
        for (int i = 0; i < 16; ++i) { if (p == 0) L0[i] = v0[i]; else L1[i] = v0[i]; }
    }
    if (g == 0) {
#pragma unroll
        for (int i = 0; i < 16; ++i) lst[(cq * 2 + 0) * 16 + i] = L0[i];
    }
    if (g == 1) {
#pragma unroll
        for (int i = 0; i < 16; ++i) lst[(cq * 2 + 1) * 16 + i] = L1[i];
    }
    float f0[16], f1[16];
#pragma unroll
    for (int i = 0; i < 16; ++i) { f0[i] = unmono(L0[i] & ~127); f1[i] = unmono(L1[i] & ~127); }
    int c[16];
#pragma unroll
    for (int i = 0; i < 16; ++i) {
        constexpr int NEG = (int)0x80000000;
        const float va = sel4f(g, f0[cand_a(0, i)], f0[cand_a(1, i)], f0[cand_a(2, i)], f0[cand_a(3, i) < 0 ? 0 : cand_a(3, i)]);
        const float vb = sel4f(g, f1[cand_b(0, i)], f1[cand_b(1, i)], f1[cand_b(2, i)], f1[cand_b(3, i)]);
        const int id = sel4(g, (cand_a(0, i) << 4) | cand_b(0, i), (cand_a(1, i) << 4) | cand_b(1, i), (cand_a(2, i) << 4) | cand_b(2, i), ((cand_a(3, i) < 0 ? 0 : cand_a(3, i)) << 4) | cand_b(3, i));
        int key = (mono(va + vb) & ~255) | id;
        if (cand_a(3, i) < 0) key = (g == 3) ? NEG : key;
        c[i] = key;
    }
    bitonic_sort_desc<16>(c);
    xlane_merge16(c, 16); xlane_merge16(c, 32);
    const float mx = unmono(c[0] & ~255);
    float e[16]; float sum = 0.f;
#pragma unroll
    for (int i = 0; i < 16; ++i) { e[i] = exp2f((unmono(c[i] & ~255) - mx) * LOG2E); sum += e[i]; }
    const float inv = 1.0f / sum;
    __builtin_amdgcn_wave_barrier();
    int ei[4]; float gi[4];
#pragma unroll
    for (int j = 0; j < 4; ++j) {
        const int key = sel4(g, c[j], c[4 + j], c[8 + j], c[12 + j]);
        gi[j] = sel4f(g, e[j], e[4 + j], e[8 + j], e[12 + j]) * inv;
        const int a = (key >> 4) & 15, b = key & 15;
        const int i0 = lst[(cq * 2 + 0) * 16 + a] & 127, i1 = lst[(cq * 2 + 1) * 16 + b] & 127;
        ei[j] = i0 * 128 + i1;
    }
    int* EIDX = (int*)(P.ws + WS_EIDX); float* GW = (float*)(P.ws + WS_GW);
    *(int4*)(EIDX + (size_t)tok * 128 + h * 16 + 4 * g) = make_int4(ei[0], ei[1], ei[2], ei[3]);
    *(float4*)(GW + (size_t)tok * 128 + h * 16 + 4 * g) = make_float4(gi[0], gi[1], gi[2], gi[3]);
    __builtin_amdgcn_wave_barrier();
}
__device__ __forceinline__ void phase_route(const Params& P, LAS unsigned char* lds) {
    const int tid = threadIdx.x, wave = __builtin_amdgcn_readfirstlane(tid >> 6);
    const int h = blockIdx.x & 7, slot = blockIdx.x >> 3, nslot = gridDim.x >> 3;
    const bf16_t* sk = (const bf16_t*)(P.ws + WS_SKB) + (size_t)h * 2 * 128 * 128;
#pragma unroll
    for (int it = 0; it < 8; ++it) { const int row = it * 32 + (tid >> 4), ch = tid & 15; *(LAS u32x4*)(lds + row * KVS + ch * 16) = *(const u32x4*)(sk + (size_t)row * 128 + ch * 8); }
    __syncthreads();
    LAS int* lst = (LAS int*)(lds + 73728) + wave * 512;
    for (int tg = slot; tg < NTOK / 128; tg += nslot) route_unit(P, h, tg, lds, lst);
    { const int extra = (NTOK / 128) % nslot;
      if (extra != 0 && slot >= extra) quant_tables(P, ((slot - extra) * 8 + h) * 8 + wave, (nslot - extra) * 8 * 8, 2 * NEXP - MK_QTAIL, 2 * NEXP);
      else if (extra == 0) quant_tables(P, (int)blockIdx.x * 8 + wave, (int)gridDim.x * 8, 2 * NEXP - MK_QTAIL, 2 * NEXP); }
}

__device__ __forceinline__ float ubf(unsigned x, int k) { return (float)((x >> (8 * k)) & 0xffu); }
constexpr int XSLOT = 1152, XGRP = 4 * XSLOT, XNG = 4, XWAVE = XNG * XGRP;
__device__ __forceinline__ void dma_group(__amdgpu_buffer_rsrc_t tab, int e_lo, int e_hi, int g, LAS unsigned char* sb, int lane) {
#pragma unroll
    for (int j = 0; j < 4; ++j) {
        const int k = g * 4 + j; const int e = __builtin_amdgcn_readlane(k < 64 ? e_lo : e_hi, k & 63);
        const int so = e * TROW;
        __builtin_amdgcn_raw_ptr_buffer_load_lds(tab, (LAS void*)(sb + j * XSLOT), 16, lane * 16, so, 0, 0);
        if (lane < 8) __builtin_amdgcn_raw_ptr_buffer_load_lds(tab, (LAS void*)(sb + j * XSLOT + 1024), 16, 1024 + lane * 16, so, 0, 0);
    }
}
__device__ __forceinline__ void u_consume(const LAS unsigned char* sb, const u32x4& xh, const u32x4& xl, float a_lo, float a_hi, float b_lo, float b_hi, int g, int lane, float& w_lo, float& w_hi) {
    int d[4];
#pragma unroll
    for (int j = 0; j < 4; ++j) {
        const u32x4 nb = *(const LAS u32x4*)(sb + j * XSLOT + lane * 16); const unsigned sc = *(const LAS unsigned short*)(sb + j * XSLOT + 1024 + lane * 2);
        int tot = 0;
#pragma unroll
        for (int jj = 0; jj < 2; ++jj) {
            int th = __builtin_amdgcn_sdot8((int)nb[jj * 2], (int)xh[jj * 2], 0, false); th = __builtin_amdgcn_sdot8((int)nb[jj * 2 + 1], (int)xh[jj * 2 + 1], th, false);
            int tl = __builtin_amdgcn_sdot8((int)nb[jj * 2], (int)xl[jj * 2], 0, false); tl = __builtin_amdgcn_sdot8((int)nb[jj * 2 + 1], (int)xl[jj * 2 + 1], tl, false);
            tot += (16 * th + tl) * (int)((sc >> (8 * jj)) & 255u); }
        d[j] = tot;
    }
    const auto s02 = __builtin_amdgcn_permlane32_swap((unsigned)d[0], (unsigned)d[2], false, false);
    const auto s13 = __builtin_amdgcn_permlane32_swap((unsigned)d[1], (unsigned)d[3], false, false);
    const int r0 = (int)s02[0] + (int)s02[1], r1 = (int)s13[0] + (int)s13[1];
    const auto s01 = __builtin_amdgcn_permlane16_swap((unsigned)r0, (unsigned)r1, false, false);
    int r = (int)s01[0] + (int)s01[1];
    r += __builtin_amdgcn_update_dpp(0, r, 0x128, 0xf, 0xf, false);
    r += __builtin_amdgcn_update_dpp(0, r, 0x124, 0xf, 0xf, false);
    r += __builtin_amdgcn_update_dpp(0, r, 0x4E, 0xf, 0xf, false);
    r += __builtin_amdgcn_update_dpp(0, r, 0xB1, 0xf, 0xf, false);
    const int tot = __shfl(r, (lane & 3) * 16);
    const bool mine = ((lane >> 2) == (g & 15));
    const bool hi = g >= 16;
    const float wv = (hi ? b_hi : b_lo) * gelu_as((float)tot * (hi ? a_hi : a_lo));
    if (hi) w_hi = mine ? wv : w_hi; else w_lo = mine ? wv : w_lo;
}
__device__ __forceinline__ void v_consume(const LAS unsigned char* sb, int (&acc)[32], int (&bias)[2], float w_lo, float w_hi, float inv_sw, int g, int lane) {
    u32x4 nb[4]; int wq[2] = {0, 0};
#pragma unroll
    for (int j = 0; j < 4; ++j) {
        const int k = g * 4 + j; const float w = readlane_f(k < 64 ? w_lo : w_hi, k & 63) * inv_sw;
        nb[j] = *(const LAS u32x4*)(sb + j * XSLOT + lane * 16); const unsigned sc = *(const LAS unsigned short*)(sb + j * XSLOT + 1024 + lane * 2);
#pragma unroll
        for (int jj = 0; jj < 2; ++jj) { const int q = (int)rintf(w * (float)((sc >> (8 * jj)) & 255u)); wq[jj] |= (q & 255) << (8 * j); }
    }
    bias[0] = __builtin_amdgcn_sdot4(wq[0], 0x01010101, bias[0], false); bias[1] = __builtin_amdgcn_sdot4(wq[1], 0x01010101, bias[1], false);
#pragma unroll
    for (int i = 0; i < 4; ++i) {
        const unsigned r0 = nb[0][i], r1 = nb[1][i], r2 = nb[2][i], r3 = nb[3][i];
        const unsigned p01a = __builtin_amdgcn_perm(r1, r0, 0x05010400u), p01b = __builtin_amdgcn_perm(r1, r0, 0x07030602u);
        const unsigned p23a = __builtin_amdgcn_perm(r3, r2, 0x05010400u), p23b = __builtin_amdgcn_perm(r3, r2, 0x07030602u);
        const unsigned t0 = __builtin_amdgcn_perm(p23a, p01a, 0x05040100u), t1 = __builtin_amdgcn_perm(p23a, p01a, 0x07060302u);
        const unsigned t2 = __builtin_amdgcn_perm(p23b, p01b, 0x05040100u), t3 = __builtin_amdgcn_perm(p23b, p01b, 0x07060302u);
        const int wv = wq[i >> 1];
        acc[i * 8 + 0] = __builtin_amdgcn_sdot4((int)(t0 & 0x0F0F0F0Fu), wv, acc[i * 8 + 0], false); acc[i * 8 + 1] = __builtin_amdgcn_sdot4((int)((t0 >> 4) & 0x0F0F0F0Fu), wv, acc[i * 8 + 1], false);
        acc[i * 8 + 2] = __builtin_amdgcn_sdot4((int)(t1 & 0x0F0F0F0Fu), wv, acc[i * 8 + 2], false); acc[i * 8 + 3] = __builtin_amdgcn_sdot4((int)((t1 >> 4) & 0x0F0F0F0Fu), wv, acc[i * 8 + 3], false);
        acc[i * 8 + 4] = __builtin_amdgcn_sdot4((int)(t2 & 0x0F0F0F0Fu), wv, acc[i * 8 + 4], false); acc[i * 8 + 5] = __builtin_amdgcn_sdot4((int)((t2 >> 4) & 0x0F0F0F0Fu), wv, acc[i * 8 + 5], false);
        acc[i * 8 + 6] = __builtin_amdgcn_sdot4((int)(t3 & 0x0F0F0F0Fu), wv, acc[i * 8 + 6], false); acc[i * 8 + 7] = __builtin_amdgcn_sdot4((int)((t3 >> 4) & 0x0F0F0F0Fu), wv, acc[i * 8 + 7], false);
    }
}
__device__ __forceinline__ void wave_sort128(int& v0, int& v1, int lane) {
#pragma unroll
    for (int k = 2; k <= 128; k <<= 1) {
#pragma unroll
        for (int j = k >> 1; j > 0; j >>= 1) {
            if (j == 64) { const int lo = min(v0, v1), hi = max(v0, v1); v0 = lo; v1 = hi; }
            else {
                const int p0 = __shfl_xor(v0, j), p1 = __shfl_xor(v1, j);
                const bool lower = (lane & j) == 0;
                const bool asc0 = (lane & k) == 0, asc1 = ((64 + lane) & k) == 0;
                v0 = (lower == asc0) ? min(v0, p0) : max(v0, p0);
                v1 = (lower == asc1) ? min(v1, p1) : max(v1, p1);
            }
        }
    }
}
__device__ __forceinline__ void exp_epilogue(const Params& P, int row, int ln, const int (&acc)[32], const int (&bias)[2], float scale_w) {
    const bf16_t* x1b = (const bf16_t*)(P.ws + WS_X1B);
    float val[32]; float s = 0.f;
#pragma unroll
    for (int jj = 0; jj < 2; ++jj) {
        const int b8 = 8 * bias[jj];
#pragma unroll
        for (int hh = 0; hh < 2; ++hh) {
            const u32x4 xa = *(const u32x4*)(x1b + (size_t)row * D + jj * 1024 + ln * 16 + hh * 8);
#pragma unroll
            for (int i = 0; i < 4; ++i) { const int e0 = jj * 16 + hh * 8 + 2 * i;
                val[e0] = scale_w * (float)(acc[e0] - b8) + ALPHA * bflo(xa[i]); val[e0 + 1] = scale_w * (float)(acc[e0 + 1] - b8) + ALPHA * bfhi(xa[i]); s += val[e0] + val[e0 + 1]; }
        }
    }
    const float mean = wave_sum(s) * (1.0f / D); float q = 0.f;
#pragma unroll
    for (int i = 0; i < 32; ++i) { const float d0 = val[i] - mean; q += d0 * d0; }
    const float rstd = rsqrtf(wave_sum(q) * (1.0f / D) + LN_EPS);
    float* yo = P.out + (row < NTOK_P ? O_YP + (size_t)row * D : O_YS + (size_t)(row - NTOK_P) * D);
    const int lo16 = ln * 16;
    float4 gg[8], bb[8];
#pragma unroll
    for (int jj = 0; jj < 2; ++jj)
#pragma unroll
        for (int i = 0; i < 4; ++i) { const int col = jj * 1024 + lo16 + i * 4; gg[jj * 4 + i] = *(const float4*)(P.ln2_g + col); bb[jj * 4 + i] = *(const float4*)(P.ln2_b + col); }
#pragma unroll
    for (int jj = 0; jj < 2; ++jj)
#pragma unroll
        for (int i = 0; i < 4; ++i) {
            const int col = jj * 1024 + lo16 + i * 4;
            const float4 g0 = gg[jj * 4 + i], b0 = bb[jj * 4 + i];
            float4 o;
            o.x = (val[jj * 16 + i * 4 + 0] - mean) * rstd * g0.x + b0.x; o.y = (val[jj * 16 + i * 4 + 1] - mean) * rstd * g0.y + b0.y;
            o.z = (val[jj * 16 + i * 4 + 2] - mean) * rstd * g0.z + b0.z; o.w = (val[jj * 16 + i * 4 + 3] - mean) * rstd * g0.w + b0.w;
            *(float4*)(yo + col) = o;
        }
}
__device__ __forceinline__ void phase_experts(const Params& P, LAS unsigned char* lds) {
    const int lane = threadIdx.x & 63, wave = __builtin_amdgcn_readfirstlane(threadIdx.x >> 6);
    const int* EIDX = (const int*)(P.ws + WS_EIDX); const float* GW = (const float*)(P.ws + WS_GW);
    const __amdgpu_buffer_rsrc_t UQ = __builtin_amdgcn_make_buffer_rsrc((void*)(P.ws + WS_UB), 0, NEXP * TROW, 0x00020000);
    const __amdgpu_buffer_rsrc_t VQ = __builtin_amdgcn_make_buffer_rsrc((void*)(P.ws + WS_VB), 0, NEXP * TROW, 0x00020000);
    const float* SU = (const float*)(P.ws + WS_SU); const float* SV = (const float*)(P.ws + WS_SV); const float* SX = (const float*)(P.ws + WS_SX);
    LAS unsigned char* wb = lds + wave * XWAVE;
    constexpr int TPW = 8;
    const int row0 = blockIdx.x * 8 + wave, rstride = gridDim.x * 8;
    if (row0 + (TPW - 1) * rstride < NTOK_P) {
        u32x4 mxh[TPW], mxl[TPW]; int mel[TPW], meh[TPW]; float mal[TPW], mah[TPW], mbl[TPW], mbh[TPW];
#pragma unroll
        for (int i = 0; i < TPW; ++i) {
            const int row = row0 + i * rstride;
            mxh[i] = *(const u32x4*)(P.ws + WS_X1Q + (size_t)row * D + lane * 32); mxl[i] = *(const u32x4*)(P.ws + WS_X1Q + (size_t)row * D + lane * 32 + 16);
            int p0 = (EIDX[(size_t)row * 128 + lane] << 18) | min(262143, (int)(GW[(size_t)row * 128 + lane] * 262144.0f));
            int p1 = (EIDX[(size_t)row * 128 + 64 + lane] << 18) | min(262143, (int)(GW[(size_t)row * 128 + 64 + lane] * 262144.0f));
            wave_sort128(p0, p1, lane);
            mel[i] = (int)((unsigned)p0 >> 18); meh[i] = (int)((unsigned)p1 >> 18);
            const float gl = ((float)(p0 & 262143) + 0.5f) * (1.0f / 262144.0f), gh = ((float)(p1 & 262143) + 0.5f) * (1.0f / 262144.0f);
            const float sx = SX[row];
            mal[i] = SU[mel[i]] * sx; mah[i] = SU[meh[i]] * sx; mbl[i] = gl * SV[mel[i]]; mbh[i] = gh * SV[meh[i]];
        }
        asm volatile("s_waitcnt vmcnt(0)" ::: "memory");
        dma_group(UQ, mel[0], meh[0], 0, wb, lane); dma_group(UQ, mel[0], meh[0], 1, wb + XGRP, lane); dma_group(UQ, mel[0], meh[0], 2, wb + 2 * XGRP, lane);
        int sg = 0;
        float mwl[TPW], mwh[TPW];
#pragma unroll
        for (int j = 0; j < TPW; ++j) { mwl[j] = 0.f; mwh[j] = 0.f; }
        static_assert(TPW == 8, "the visit order below is written for 8 tokens per wave");
#pragma unroll 1
        for (int v = 0; v < 64; ++v) {
            const int ss = v >> 3, i = v & 7, i2 = (v + 1) & 7, s2 = (v + 1) >> 3;
            u32x4 xh = mxh[0], xl = mxl[0]; int e_lo = mel[0], e_hi = meh[0], n_lo = mel[0], n_hi = meh[0]; float a_lo = mal[0], a_hi = mah[0], b_lo = mbl[0], b_hi = mbh[0], w_lo = mwl[0], w_hi = mwh[0];
#pragma unroll
            for (int j = 1; j < TPW; ++j) { const bool m = (i == j), m2 = (i2 == j);
                xh[0] = m ? mxh[j][0] : xh[0]; xh[1] = m ? mxh[j][1] : xh[1]; xh[2] = m ? mxh[j][2] : xh[2]; xh[3] = m ? mxh[j][3] : xh[3];
                xl[0] = m ? mxl[j][0] : xl[0]; xl[1] = m ? mxl[j][1] : xl[1]; xl[2] = m ? mxl[j][2] : xl[2]; xl[3] = m ? mxl[j][3] : xl[3];
                e_lo = m ? mel[j] : e_lo; e_hi = m ? meh[j] : e_hi; a_lo = m ? mal[j] : a_lo; a_hi = m ? mah[j] : a_hi; b_lo = m ? mbl[j] : b_lo; b_hi = m ? mbh[j] : b_hi;
                w_lo = m ? mwl[j] : w_lo; w_hi = m ? mwh[j] : w_hi; n_lo = m2 ? mel[j] : n_lo; n_hi = m2 ? meh[j] : n_hi; }
#pragma unroll
            for (int gg = 0; gg < 4; ++gg) {
                const int sn = (sg + 3) & 3;
                if (gg == 0) dma_group(UQ, e_lo, e_hi, ss * 4 + 3, wb + sn * XGRP, lane);
                else if (v < 63) dma_group(UQ, n_lo, n_hi, s2 * 4 + gg - 1, wb + sn * XGRP, lane);
                else dma_group(VQ, n_lo, n_hi, gg - 1, wb + sn * XGRP, lane);
                asm volatile("s_waitcnt vmcnt(24)" ::: "memory");
                u_consume(wb + sg * XGRP, xh, xl, a_lo, a_hi, b_lo, b_hi, ss * 4 + gg, lane, w_lo, w_hi);
                sg = (sg + 1) & 3;
            }
#pragma unroll
            for (int j = 0; j < TPW; ++j) { const bool m = (i == j); mwl[j] = m ? w_lo : mwl[j]; mwh[j] = m ? w_hi : mwh[j]; }
        }
#pragma unroll 1
        for (int i = 0; i < TPW; ++i) {
            const int row = row0 + i * rstride;
            int e_lo = mel[0], e_hi = meh[0], n_lo = mel[0], n_hi = meh[0]; float w_lo = mwl[0], w_hi = mwh[0];
#pragma unroll
            for (int j = 1; j < TPW; ++j) { const bool m = (i == j); e_lo = m ? mel[j] : e_lo; e_hi = m ? meh[j] : e_hi; w_lo = m ? mwl[j] : w_lo; w_hi = m ? mwh[j] : w_hi; }
#pragma unroll
            for (int j = 0; j < TPW - 1; ++j) { const bool m = (i == j); n_lo = m ? mel[j + 1] : n_lo; n_hi = m ? meh[j + 1] : n_hi; }
            float wmax = wave_max(fmaxf(fabsf(w_lo), fabsf(w_hi))); if (wmax == 0.f) wmax = 1.f;
            const float scale_w = wmax * (255.0f / 127.0f), inv_sw = 1.0f / scale_w;
            int acc[32]; int bias[2] = {0, 0};
#pragma unroll
            for (int q = 0; q < 32; ++q) acc[q] = 0;
#pragma unroll 1
            for (int g = 0; g < 32; ++g) {
                const int sn = (sg + 3) & 3;
                if (g + 3 < 32) dma_group(VQ, e_lo, e_hi, g + 3, wb + sn * XGRP, lane);
                else dma_group(VQ, n_lo, n_hi, g + 3 - 32, wb + sn * XGRP, lane);
                asm volatile("s_waitcnt vmcnt(24)" ::: "memory");
                v_consume(wb + sg * XGRP, acc, bias, w_lo, w_hi, inv_sw, g, lane);
                sg = (sg + 1) & 3;
            }
            int ln = lane; asm volatile("" : "+v"(ln));
            exp_epilogue(P, row, ln, acc, bias, scale_w);
        }
        asm volatile("s_waitcnt vmcnt(0)" ::: "memory");
    }
    for (int row = row0 + ((row0 + (TPW - 1) * rstride < NTOK_P) ? TPW * rstride : 0); row < NTOK_P; row += rstride) {
        int ln = lane; asm volatile("" : "+v"(ln));
        const u32x4 xh = *(const u32x4*)(P.ws + WS_X1Q + (size_t)row * D + ln * 32), xl = *(const u32x4*)(P.ws + WS_X1Q + (size_t)row * D + ln * 32 + 16);
        const float sx = SX[row];
        const int e_lo = EIDX[(size_t)row * 128 + ln], e_hi = EIDX[(size_t)row * 128 + 64 + ln];
        const float g_lo = GW[(size_t)row * 128 + ln], g_hi = GW[(size_t)row * 128 + 64 + ln];
        const float a_lo = SU[e_lo] * sx, a_hi = SU[e_hi] * sx, b_lo = g_lo * SV[e_lo], b_hi = g_hi * SV[e_hi];
        float w_lo = 0.f, w_hi = 0.f;
        asm volatile("s_waitcnt vmcnt(0)" ::: "memory");
        dma_group(UQ, e_lo, e_hi, 0, wb, lane); dma_group(UQ, e_lo, e_hi, 1, wb + XGRP, lane); dma_group(UQ, e_lo, e_hi, 2, wb + 2 * XGRP, lane);
        int sg = 0;
#pragma unroll 1
        for (int g = 0; g < 32; ++g) {
            const int sn = (sg + 3) & 3;
            if (g + 3 < 32) dma_group(UQ, e_lo, e_hi, g + 3, wb + sn * XGRP, lane); else dma_group(VQ, e_lo, e_hi, g + 3 - 32, wb + sn * XGRP, lane);
            asm volatile("s_waitcnt vmcnt(24)" ::: "memory");
            u_consume(wb + sg * XGRP, xh, xl, a_lo, a_hi, b_lo, b_hi, g, lane, w_lo, w_hi);
            sg = (sg + 1) & 3;
        }
        float wmax = wave_max(fmaxf(fabsf(w_lo), fabsf(w_hi))); if (wmax == 0.f) wmax = 1.f;
        const float scale_w = wmax * (255.0f / 127.0f), inv_sw = 1.0f / scale_w;
        int acc[32]; int bias[2] = {0, 0};
#pragma unroll
        for (int i = 0; i < 32; ++i) acc[i] = 0;
#pragma unroll 1
        for (int g = 0; g < 32; ++g) {
            const int sn = (sg + 3) & 3;
            dma_group(VQ, e_lo, e_hi, (g + 3) & 31, wb + sn * XGRP, lane);
            asm volatile("s_waitcnt vmcnt(24)" ::: "memory");
            v_consume(wb + sg * XGRP, acc, bias, w_lo, w_hi, inv_sw, g, lane);
            sg = (sg + 1) & 3;
        }
        asm volatile("s_waitcnt vmcnt(0)" ::: "memory");
        exp_epilogue(P, row, ln, acc, bias, scale_w);
    }
    LAS int* cmax = (LAS int*)(lds + MISC_OFF + 64);
    __syncthreads();
    for (int ct = blockIdx.x; ct < NTOK_S; ct += gridDim.x) {
        const int row = NTOK_P + ct;
        int ln = lane; asm volatile("" : "+v"(ln));
        const u32x4 xh = *(const u32x4*)(P.ws + WS_X1Q + (size_t)row * D + ln * 32), xl = *(const u32x4*)(P.ws + WS_X1Q + (size_t)row * D + ln * 32 + 16);
        const float sx = SX[row];
        const int kk = 16 * wave + (ln & 15);
        const int e_loc = EIDX[(size_t)row * 128 + kk]; const float g_loc = GW[(size_t)row * 128 + kk];
        const float a_loc = SU[e_loc] * sx, b_loc = g_loc * SV[e_loc];
        float w_loc = 0.f, w_dummy = 0.f;
        asm volatile("s_waitcnt vmcnt(0)" ::: "memory");
#pragma unroll
        for (int g = 0; g < 4; ++g) dma_group(UQ, e_loc, e_loc, g, wb + g * XGRP, lane);
        asm volatile("s_waitcnt vmcnt(0)" ::: "memory");
#pragma unroll
        for (int g = 0; g < 4; ++g) u_consume(wb + g * XGRP, xh, xl, a_loc, a_loc, b_loc, b_loc, g, lane, w_loc, w_dummy);
#pragma unroll
        for (int g = 0; g < 4; ++g) dma_group(VQ, e_loc, e_loc, g, wb + g * XGRP, lane);
        const float wm = wave_max(ln < 16 ? fabsf(w_loc) : 0.f);
        if (lane == 0) cmax[wave] = __float_as_int(wm);
        __syncthreads();
        float wmax = 0.f;
#pragma unroll
        for (int ww = 0; ww < 8; ++ww) wmax = fmaxf(wmax, __int_as_float(cmax[ww]));
        if (wmax == 0.f) wmax = 1.f;
        const float scale_w = wmax * (255.0f / 127.0f), inv_sw = 1.0f / scale_w;
        int acc[32]; int bias[2] = {0, 0};
#pragma unroll
        for (int i = 0; i < 32; ++i) acc[i] = 0;
        asm volatile("s_waitcnt vmcnt(0)" ::: "memory");
#pragma unroll
        for (int g = 0; g < 4; ++g) v_consume(wb + g * XGRP, acc, bias, w_loc, w_loc, inv_sw, g, lane);
        __builtin_amdgcn_wave_barrier();
        {
            LAS int* pp = (LAS int*)wb + lane * 36;
#pragma unroll
            for (int i = 0; i < 8; ++i) *(LAS u32x4*)(pp + 4 * i) = (u32x4){(unsigned)acc[4 * i], (unsigned)acc[4 * i + 1], (unsigned)acc[4 * i + 2], (unsigned)acc[4 * i + 3]};
            pp[32] = bias[0]; pp[33] = bias[1];
        }
        __syncthreads();
        if (wave == 0) {
#pragma unroll
            for (int i = 0; i < 32; ++i) acc[i] = 0;
            bias[0] = 0; bias[1] = 0;
#pragma unroll 1
            for (int ww = 0; ww < 8; ++ww) {
                const LAS int* pp = (const LAS int*)(lds + ww * XWAVE) + lane * 36;
#pragma unroll
                for (int i = 0; i < 8; ++i) { const u32x4 t = *(const LAS u32x4*)(pp + 4 * i); acc[4 * i] += (int)t[0]; acc[4 * i + 1] += (int)t[1]; acc[4 * i + 2] += (int)t[2]; acc[4 * i + 3] += (int)t[3]; }
                bias[0] += pp[32]; bias[1] += pp[33];
            }
            exp_epilogue(P, row, ln, acc, bias, scale_w);
        }
        __syncthreads();
    }
}

constexpr int NPHASE = 11;
__global__ void __launch_bounds__(NTHREADS, 2) fwd(Params P) {
    extern __shared__ __attribute__((aligned(16))) unsigned char lds_raw[];
    LAS unsigned char* lds = (LAS unsigned char*)lds_raw;
    volatile LAS unsigned* misc = (volatile LAS unsigned*)(lds + MISC_OFF);
    const int lo = P.ph_lo, hi = P.ph_hi;
    XcdBarrier bar; bar.bar = (unsigned*)(P.ws + WS_CTL); bar.x = 0; bar.st = nullptr;
    if (hi - lo > 1) {
        if (threadIdx.x == 0) { misc[0] = 0u; misc[1] = 0u; misc[2] = 0u; misc[3] = 0u; }
        __syncthreads();
        bar = xcd_barrier_post((unsigned*)(P.ws + WS_CTL), misc);
    }
#ifndef MK_REPMASK
#define MK_REPMASK 0
#endif
#ifndef MK_PHASE_MASK
#define MK_PHASE_MASK 0x7ff
#endif
#define IN(k) (((MK_PHASE_MASK >> (k)) & 1) && lo <= (k) && (k) < hi)
#define SEAM(k) do { if (IN(k) && IN((k) + 1)) xcd_barrier(bar); } while (0)
    if (IN(0)) { phase_prologue(P, lds); }
    SEAM(0);
    if (IN(1)) {
        pg8::Gemm g{(const pg8::bf16_t*)(P.ws + WS_XB), (const pg8::bf16_t*)(P.ws + WS_WINT), NTOK, DIN, D};
        pg8::StaticOrder S; S.init(NTOK, DIN, (int)gridDim.x, (int)blockIdx.x);
        EpiProj E{P.out, (bf16_t*)(P.ws + WS_XR), (bf16_t*)(P.ws + WS_GATE), (bf16_t*)(P.ws + WS_QB), (bf16_t*)(P.ws + WS_KB), (bf16_t*)(P.ws + WS_VB16)};
        pg8::gemm_phase<EpiProj, pg8::StaticOrder, false>(lds, g, S, E, nullptr);
        { const int nwg = (NTOK / 256) * (DIN / 256), full = nwg % (int)gridDim.x;
          if (full != 0 && (int)blockIdx.x >= full) quant_tables(P, ((int)blockIdx.x - full) * 8 + (int)(threadIdx.x >> 6), ((int)gridDim.x - full) * 8, 0, MK_QHEAD);
          else if (full == 0) quant_tables(P, (int)blockIdx.x * 8 + (int)(threadIdx.x >> 6), (int)gridDim.x * 8, 0, MK_QHEAD); }
    }
    SEAM(1);
    {
        const bool copy_first = ((blockIdx.x >> 3) & 1) != 0;
        if (IN(3) && copy_first) phase_samp(P, lds);
        if (IN(2)) phase_lru(P, lds);
        if (IN(4)) phase_attn01(P, lds);
        if (IN(3) && !copy_first) phase_samp(P, lds);
    }
    SEAM(4);
    if (IN(5)) { phase_mix_b(P, lds); }
    SEAM(5);
    if (IN(6)) {
        sample_rows_gemm<0>(P, (const bf16_t*)(P.ws + WS_AR), (const bf16_t*)(P.ws + WS_WOT), lds);
        pg8::Gemm g{(const pg8::bf16_t*)(P.ws + WS_AR), (const pg8::bf16_t*)(P.ws + WS_WOT), NTOK_P, D, D};
        pg8::StaticOrder S; S.init(NTOK_P, D, (int)gridDim.x, (int)blockIdx.x);
        EpiOut E{(const bf16_t*)(P.ws + WS_XB), (bf16_t*)(P.ws + WS_PRE1)};
        pg8::gemm_phase<EpiOut, pg8::StaticOrder, false>(lds, g, S, E, nullptr);
    }
    SEAM(6);
    if (IN(7)) { phase_ln1(P); }
    SEAM(7);
    if (IN(8)) {
        sample_rows_gemm<1>(P, (const bf16_t*)(P.ws + WS_X1B), (const bf16_t*)(P.ws + WS_WQT), lds);
        pg8::Gemm g{(const pg8::bf16_t*)(P.ws + WS_X1B), (const pg8::bf16_t*)(P.ws + WS_WQT), NTOK_P, D, D};
        pg8::StaticOrder S; S.init(NTOK_P, D, (int)gridDim.x, (int)blockIdx.x);
        EpiBf16Plain E{(bf16_t*)(P.ws + WS_QP), D};
        pg8::gemm_phase<EpiBf16Plain, pg8::StaticOrder, false>(lds, g, S, E, nullptr);
    }
    SEAM(8);
    if (IN(9)) { phase_route(P, lds); }
    SEAM(9);
    if (IN(10)) { phase_experts(P, lds); }
#undef IN
#undef SEAM
}
}

extern "C" void kernel_launch(void* const* d_in, const int* in_sizes, int n_in, void* d_out, int out_size, void* d_ws, size_t ws_size, hipStream_t stream) {
    using namespace mk;
    static int grid = 0;
    if (grid == 0) {
        if (n_in != 23 || (size_t)out_size != O_END || ws_size < WS_END) { fprintf(stderr, "kernel_launch: unexpected shapes: n_in %d out %d ws %zu (need %zu)\n", n_in, out_size, ws_size, (size_t)WS_END); grid = -1; return; }
        int dev = 0, cus = 0, per_cu = 0;
        if (hipGetDevice(&dev) != hipSuccess || hipDeviceGetAttribute(&cus, hipDeviceAttributeMultiprocessorCount, dev) != hipSuccess) { grid = -1; return; }
        if (hipFuncSetAttribute((const void*)fwd, hipFuncAttributeMaxDynamicSharedMemorySize, LDS_BYTES) != hipSuccess) { fprintf(stderr, "kernel_launch: hipFuncSetAttribute failed\n"); grid = -1; return; }
        if (hipOccupancyMaxActiveBlocksPerMultiprocessor(&per_cu, (const void*)fwd, NTHREADS, LDS_BYTES) != hipSuccess || per_cu < 1) { fprintf(stderr, "kernel_launch: occupancy query says %d\n", per_cu); }
        (void)hipGetLastError();
        grid = cus;
    }
    if (grid < 0) return;
    (void)hipMemsetAsync((char*)d_ws + WS_CTL, 0, 65536, stream);
    Params p{};
    p.x_prompt = (const float*)d_in[0]; p.x_sample = (const float*)d_in[1]; p.cache_k = (const float*)d_in[2]; p.cache_v = (const float*)d_in[3];
    p.state_conv = (const float*)d_in[4]; p.state_h = (const float*)d_in[5]; p.w_in = (const float*)d_in[6]; p.conv_w = (const float*)d_in[7]; p.conv_b = (const float*)d_in[8];
    p.lru_w_a = (const float*)d_in[9]; p.lru_b_a = (const float*)d_in[10]; p.lru_w_x = (const float*)d_in[11]; p.lru_b_x = (const float*)d_in[12]; p.lru_lambda = (const float*)d_in[13];
    p.w_out = (const float*)d_in[14]; p.ln1_g = (const float*)d_in[15]; p.ln1_b = (const float*)d_in[16]; p.w_query = (const float*)d_in[17]; p.sub_keys = (const float*)d_in[18];
    p.peer_u = (const float*)d_in[19]; p.peer_v = (const float*)d_in[20]; p.ln2_g = (const float*)d_in[21]; p.ln2_b = (const float*)d_in[22];
    p.out = (float*)d_out; p.ws = (unsigned char*)d_ws;
#if MK_N_LAUNCHES == 1
    p.ph_lo = 0; p.ph_hi = NPHASE;
    hipLaunchKernelGGL(fwd, dim3(grid), dim3(NTHREADS), LDS_BYTES, stream, p);
#else
    for (int k = 0; k < NPHASE; ++k) { p.ph_lo = k; p.ph_hi = k + 1; hipLaunchKernelGGL(fwd, dim3(grid), dim3(NTHREADS), LDS_BYTES, stream, p);
#ifdef MK_EXTRA_PHASE
        if (k == MK_EXTRA_PHASE) hipLaunchKernelGGL(fwd, dim3(grid), dim3(NTHREADS), LDS_BYTES, stream, p);
#endif
    }
#endif
    const hipError_t le = hipPeekAtLastError();
    if (le != hipSuccess) fprintf(stderr, "kernel_launch: launch failed: %s\n", hipGetErrorName(le));
}
```

```cpp
#include <hip/hip_runtime.h>
#include <cstdio>
#include <cstdint>
namespace pg8 {
#define PG8_LAS __attribute__((address_space(3)))
typedef unsigned short bf16_t;
typedef short bf16x8 __attribute__((ext_vector_type(8)));
typedef float f32x4 __attribute__((ext_vector_type(4)));
typedef unsigned u32x4 __attribute__((ext_vector_type(4)));
constexpr int BM = 256, BK = 64, HALF = 128, HTB = HALF * BK * 2  , STAGE_BYTES = 8 * HTB, NXCD = 8, WGM = 8;

__host__ __device__ __forceinline__ int lds_byte(int r, int c) { const int st = (r >> 4) * 2 + (c >> 5), rr = r & 15, cc = c & 31, ob = rr * 64 + cc * 2; return st * 1024 + (ob ^ (((ob >> 9) & 1) << 5)); }
__host__ __device__ __forceinline__ void stage_rc(int b, int& R, int& C) { const int st = b / 1024, sb = b % 1024, swz = sb ^ (((sb >> 9) & 1) << 5); R = (st >> 1) * 16 + swz / 64; C = (st & 1) * 32 + (swz % 64) / 2; }
__host__ __device__ __forceinline__ int perm32(int rho) { const int n = rho >> 4, i = rho & 15; return 8 * (i >> 2) + 4 * n + (i & 3); }

struct Unit { int pm, pn; };
struct Gemm { const bf16_t* A; const bf16_t* Bt; int M, N, K; };

struct StaticOrder {
    int nM, nN, nwg, G, c;
    __host__ __device__ void init(int M, int N, int G_, int c_) { nM = M / BM; nN = N / BM; nwg = nM * nN; G = G_; c = c_; }
    __host__ __device__ bool next(int i, Unit& u) const {
        const long L = (long)i * G + c; if (L >= nwg) return false;
        int wgid = (int)L; { const int q = nwg / NXCD, r = nwg % NXCD, xcd = wgid % NXCD, off = wgid / NXCD; wgid = (xcd < r ? xcd * (q + 1) : r * (q + 1) + (xcd - r) * q) + off; }
        const int nig = WGM * nN, gid = wgid / nig, fm = gid * WGM, gsz = (nM - fm) < WGM ? (nM - fm) : WGM;
        u.pm = fm + ((wgid % nig) % gsz); u.pn = (wgid % nig) / gsz; return true;
    }
    __device__ __forceinline__ void a_ready(const Unit&) const {}
    __device__ __forceinline__ void done(const Unit&) const {}
};
struct CountedOrder : StaticOrder {
    const unsigned* ready; unsigned need; unsigned* tmo;
    __device__ __forceinline__ void a_ready(const Unit& u) const {
        if (threadIdx.x < 64) {
            const unsigned long long t0 = __builtin_amdgcn_s_memrealtime(); unsigned polls = 0;
            while ((unsigned)__builtin_amdgcn_readfirstlane(__hip_atomic_load(ready + 64 * u.pm, __ATOMIC_RELAXED, __HIP_MEMORY_SCOPE_AGENT)) < need) {
                if ((++polls & 255u) == 0u && __builtin_amdgcn_readfirstlane(__hip_atomic_load(tmo, __ATOMIC_RELAXED, __HIP_MEMORY_SCOPE_AGENT)) != 0u) break;
                if (__builtin_amdgcn_s_memrealtime() - t0 > 2000000ull) {
                    if (threadIdx.x == 0) { unsigned expect = 0u; __hip_atomic_compare_exchange_strong(tmo + 1, &expect, 0x600u | (unsigned)(u.pm & 0xff), __ATOMIC_RELAXED, __ATOMIC_RELAXED, __HIP_MEMORY_SCOPE_AGENT); __hip_atomic_store(tmo, 1u, __ATOMIC_RELAXED, __HIP_MEMORY_SCOPE_AGENT); }
                    break; }
                __builtin_amdgcn_s_sleep(2); }
            __builtin_amdgcn_fence(__ATOMIC_ACQUIRE, "agent");
            asm volatile("s_waitcnt vmcnt(0)" ::: "memory");
        }
#if !defined(BROKEN_HOOK_NO_BARRIER)
        asm volatile("" ::: "memory"); __builtin_amdgcn_s_barrier(); asm volatile("" ::: "memory");
#endif
    }
};

__device__ __forceinline__ unsigned cvt_pk_bf16(float lo, float hi) { unsigned r; asm volatile("v_cvt_pk_bf16_f32 %0, %1, %2" : "=v"(r) : "v"(lo), "v"(hi)); return r; }
typedef float f32x2 __attribute__((ext_vector_type(2)));
__device__ __forceinline__ f32x2 gelu_pk(f32x2 v) {
    const f32x2 av = __builtin_elementwise_abs(v), d = av * 0.2316418882f + 1.0f;
    f32x2 t; t.x = __builtin_amdgcn_rcpf(d.x); t.y = __builtin_amdgcn_rcpf(d.y);
    f32x2 q = t * 0.5307027145f + (-0.7265760135f); q = q * t + 0.7107068705f; q = q * t + (-0.142248368f); q = q * t + 0.127414796f; q = q * t;
    const f32x2 s = (v * v) * (-0.72134752044f);
    f32x2 e; e.x = __builtin_amdgcn_exp2f(s.x); e.y = __builtin_amdgcn_exp2f(s.y);
    const f32x2 m = v * (q * e), r = v - m;
    f32x2 o; o.x = v.x < 0.f ? m.x : r.x; o.y = v.y < 0.f ? m.y : r.y; return o;
}

struct EpiF32 {
    static constexpr bool PERM = false, AFTER_DRAIN = false;
    float* C; int ldc; const float* bias;
    __device__ __forceinline__ void operator()(const f32x4 (&acc)[2][2][4][2], const Unit& u, int wr, int wc, int fr, int fq) const {
        const int row0 = u.pm * BM + wr * 64 + fr, col0 = u.pn * BM + wc * 32 + 4 * fq;
        f32x4 bv[2][2];
#pragma unroll
        for (int bj = 0; bj < 2; ++bj)
#pragma unroll
            for (int n = 0; n < 2; ++n) bv[bj][n] = bias ? *(const f32x4*)(bias + col0 + bj * HALF + n * 16) : (f32x4){0.f, 0.f, 0.f, 0.f};
#pragma unroll
        for (int ai = 0; ai < 2; ++ai)
#pragma unroll
            for (int m = 0; m < 4; ++m) { float* rowp = C + (size_t)(row0 + ai * HALF + m * 16) * ldc + col0;
#pragma unroll
                for (int bj = 0; bj < 2; ++bj)
#pragma unroll
                    for (int n = 0; n < 2; ++n) *(f32x4*)(rowp + bj * HALF + n * 16) = acc[ai][bj][m][n] + bv[bj][n]; }
    }
};
template <int ACT  > struct EpiBf16 {
    static constexpr bool PERM = true, AFTER_DRAIN = false;
    bf16_t* O; int ldc; const float* bias; int split_cols; size_t split_stride;
    __device__ __forceinline__ void operator()(const f32x4 (&acc)[2][2][4][2], const Unit& u, int wr, int wc, int fr, int fq) const {
        const int row0 = u.pm * BM + wr * 64 + fr; int colt = u.pn * BM; bf16_t* base = O;
        if (split_cols) { const int t = colt / split_cols; base += (size_t)t * split_stride; colt -= t * split_cols; }
        const int col0 = colt + wc * 32 + 8 * fq, bcol0 = u.pn * BM + wc * 32 + 8 * fq;
        f32x4 bv[2][2];
#pragma unroll
        for (int bj = 0; bj < 2; ++bj)
#pragma unroll
            for (int n = 0; n < 2; ++n) bv[bj][n] = bias ? *(const f32x4*)(bias + bcol0 + bj * HALF + 4 * n) : (f32x4){0.f, 0.f, 0.f, 0.f};
#pragma unroll
        for (int ai = 0; ai < 2; ++ai)
#pragma unroll
            for (int m = 0; m < 4; ++m) { bf16_t* rowp = base + (size_t)(row0 + ai * HALF + m * 16) * ldc + col0;
#pragma unroll
                for (int bj = 0; bj < 2; ++bj) { f32x4 v0 = acc[ai][bj][m][0] + bv[bj][0], v1 = acc[ai][bj][m][1] + bv[bj][1];
                    if (ACT == 1) { f32x2 a = gelu_pk((f32x2){v0[0], v0[1]}), b = gelu_pk((f32x2){v0[2], v0[3]}), c = gelu_pk((f32x2){v1[0], v1[1]}), d = gelu_pk((f32x2){v1[2], v1[3]});
                        v0 = (f32x4){a.x, a.y, b.x, b.y}; v1 = (f32x4){c.x, c.y, d.x, d.y}; }
                    if (ACT == 2) {
#pragma unroll
                        for (int j = 0; j < 4; ++j) { v0[j] = 0.5f * v0[j] * (1.0f + erff(v0[j] * 0.70710678f)); v1[j] = 0.5f * v1[j] * (1.0f + erff(v1[j] * 0.70710678f)); } }
                    u32x4 w; w.x = cvt_pk_bf16(v0[0], v0[1]); w.y = cvt_pk_bf16(v0[2], v0[3]); w.z = cvt_pk_bf16(v1[0], v1[1]); w.w = cvt_pk_bf16(v1[2], v1[3]);
                    *(u32x4*)(rowp + bj * HALF) = w; } }
    }
};

struct PanelStats {
    unsigned* xbuf;
    unsigned* cnt;
    unsigned* tmo;
    int ntn; float eps;
    unsigned code;
    __device__ __forceinline__ bool run(const f32x4 (&v)[2][2][4][2], const Unit& u, int wr, int wc, int fr, int fq, PG8_LAS unsigned char* lds, int wid, int lane) const {
        typedef float f32x2v __attribute__((ext_vector_type(2)));
        PG8_LAS f32x2v* P = (PG8_LAS f32x2v*)lds;
        PG8_LAS f32x2v* S = (PG8_LAS f32x2v*)(lds + 8192);
        PG8_LAS unsigned* flag = (PG8_LAS unsigned*)(lds + 8192 + 2048);
#pragma unroll
        for (int ai = 0; ai < 2; ++ai)
#pragma unroll
            for (int m = 0; m < 4; ++m) {
                float s = 0.f;
#pragma unroll
                for (int bj = 0; bj < 2; ++bj)
#pragma unroll
                    for (int n = 0; n < 2; ++n) { const f32x4 x = v[ai][bj][m][n]; s += (x[0] + x[1]) + (x[2] + x[3]); }
                s += __shfl_xor(s, 16); s += __shfl_xor(s, 32);
                const float mw = s * (1.0f / 64.0f); float q = 0.f;
#pragma unroll
                for (int bj = 0; bj < 2; ++bj)
#pragma unroll
                    for (int n = 0; n < 2; ++n) { const f32x4 d = v[ai][bj][m][n] - mw; q += (d[0] * d[0] + d[1] * d[1]) + (d[2] * d[2] + d[3] * d[3]); }
                q += __shfl_xor(q, 16); q += __shfl_xor(q, 32);
                if (fq == 0) P[(ai * HALF + wr * 64 + m * 16 + fr) * 4 + wc] = (f32x2v){mw, q};
            }
        asm volatile("s_waitcnt lgkmcnt(0)" ::: "memory"); __builtin_amdgcn_s_barrier(); asm volatile("" ::: "memory");
#if defined(BROKEN_NO_WAIT)
        if (blockIdx.x >= 64) { const long long t0 = clock64(); while (clock64() - t0 < 60000) __builtin_amdgcn_s_sleep(8); }
#endif
        const int row = wid * 32 + (lane & 31);
        if (lane < 32) {
            const f32x2v a = P[row * 4 + 0], b = P[row * 4 + 1], c = P[row * 4 + 2], d = P[row * 4 + 3];
            const float mt = (a.x + b.x + c.x + d.x) * 0.25f;
            const float da = a.x - mt, db = b.x - mt, dc = c.x - mt, dd = d.x - mt;
            const float m2 = (a.y + b.y) + (c.y + d.y) + 64.0f * ((da * da + db * db) + (dc * dc + dd * dd));
            unsigned long long* slot = (unsigned long long*)xbuf + ((size_t)(u.pm * BM + row) * 4 + u.pn);
            __hip_atomic_store(slot, ((unsigned long long)__float_as_uint(m2) << 32) | __float_as_uint(mt), __ATOMIC_RELAXED, __HIP_MEMORY_SCOPE_AGENT);
        }
        asm volatile("s_waitcnt vmcnt(0)" ::: "memory");
        if (lane == 0) __hip_atomic_fetch_add(cnt + 64 * u.pm, 1u, __ATOMIC_RELAXED, __HIP_MEMORY_SCOPE_AGENT);
        if (wid == 0) {
            bool dead = false; const unsigned long long t0 = __builtin_amdgcn_s_memrealtime(); const unsigned want = 8u * (unsigned)ntn;
            for (;;) {
#if defined(BROKEN_NO_WAIT)
                break;
#endif
                if ((unsigned)__builtin_amdgcn_readfirstlane(__hip_atomic_load(cnt + 64 * u.pm, __ATOMIC_RELAXED, __HIP_MEMORY_SCOPE_AGENT)) >= want) break;
                if (__builtin_amdgcn_s_memrealtime() - t0 > 2000000ull) {
                    if (lane == 0) { unsigned expect = 0u; __hip_atomic_compare_exchange_strong(tmo + 1, &expect, code | (unsigned)(u.pm & 0xff), __ATOMIC_RELAXED, __ATOMIC_RELAXED, __HIP_MEMORY_SCOPE_AGENT);
                                     __hip_atomic_store(tmo, 1u, __ATOMIC_RELAXED, __HIP_MEMORY_SCOPE_AGENT); }
                    dead = true; break; }
                __builtin_amdgcn_s_sleep(2);
            }
            __builtin_amdgcn_fence(__ATOMIC_ACQUIRE, "agent");
            if (lane == 0) flag[0] = dead ? 1u : 0u;
        }
        asm volatile("s_waitcnt vmcnt(0) lgkmcnt(0)" ::: "memory"); __builtin_amdgcn_s_barrier(); asm volatile("" ::: "memory");
        const bool bad = flag[0] != 0u;
        if (lane < 32) {
            const unsigned long long* slot = (const unsigned long long*)xbuf + (size_t)(u.pm * BM + row) * 4; float mt[4], m2[4]; float ms = 0.f;
#pragma unroll
            for (int t = 0; t < 4; ++t) { if (t < ntn) { const unsigned long long w = __hip_atomic_load(slot + t, __ATOMIC_RELAXED, __HIP_MEMORY_SCOPE_AGENT); mt[t] = __uint_as_float((unsigned)w); m2[t] = __uint_as_float((unsigned)(w >> 32)); } else { mt[t] = 0.f; m2[t] = 0.f; } ms += mt[t]; }
            const float mean = ms / (float)ntn; float q = 0.f;
#pragma unroll
            for (int t = 0; t < 4; ++t) if (t < ntn) { const float dm = mt[t] - mean; q += m2[t] + 256.0f * dm * dm; }
            S[row] = (f32x2v){mean, 1.0f / sqrtf(q / (256.0f * (float)ntn) + eps)};
        }
        asm volatile("s_waitcnt lgkmcnt(0)" ::: "memory"); __builtin_amdgcn_s_barrier(); asm volatile("" ::: "memory");
        return bad;
    }
};
struct EpiLnRes {
    static constexpr bool PERM = false, AFTER_DRAIN = true;
    const float* base; float* out; int ldc; const float* bias; PanelStats st; unsigned poison;
    __device__ __forceinline__ void refuse(size_t i0, size_t stride, int M, int N) const { const float q = __builtin_nanf(""); for (size_t i = i0; i < (size_t)M * N; i += stride) out[(i / N) * ldc + i % N] = q;
        if (i0 == 0) { unsigned expect = 0u; __hip_atomic_compare_exchange_strong(st.tmo + 1, &expect, 0x7f0u, __ATOMIC_RELAXED, __ATOMIC_RELAXED, __HIP_MEMORY_SCOPE_AGENT); __hip_atomic_store(st.tmo, 1u, __ATOMIC_RELAXED, __HIP_MEMORY_SCOPE_AGENT); } }
    __device__ __forceinline__ void fused(f32x4 (&acc)[2][2][4][2], const Unit& u, int wr, int wc, int fr, int fq, PG8_LAS unsigned char* lds, int wid, int lane) const {
        typedef float f32x2v __attribute__((ext_vector_type(2)));
        const PG8_LAS f32x2v* S = (const PG8_LAS f32x2v*)(lds + 8192);
        const int col0 = u.pn * BM + wc * 32 + 4 * fq;
#pragma unroll
        for (int bj = 0; bj < 2; ++bj)
#pragma unroll
            for (int n = 0; n < 2; ++n) { const f32x4 bv = bias ? *(const f32x4*)(bias + col0 + bj * HALF + n * 16) : (f32x4){0.f, 0.f, 0.f, 0.f};
#pragma unroll
                for (int ai = 0; ai < 2; ++ai)
#pragma unroll
                    for (int m = 0; m < 4; ++m) acc[ai][bj][m][n] += bv; }
        const bool bad = st.run(acc, u, wr, wc, fr, fq, lds, wid, lane) || poison != 0u;
        const float qnan = __builtin_nanf("");
#pragma unroll
        for (int ai = 0; ai < 2; ++ai)
#pragma unroll
            for (int m = 0; m < 4; ++m) { const int r = ai * HALF + wr * 64 + m * 16 + fr; const f32x2v sr = S[r]; const size_t off = (size_t)(u.pm * BM + r) * ldc + col0;
#pragma unroll
                for (int bj = 0; bj < 2; ++bj)
#pragma unroll
                    for (int n = 0; n < 2; ++n) { const f32x4 bs = *(const f32x4*)(base + off + bj * HALF + n * 16); f32x4 o = bs + (acc[ai][bj][m][n] - sr.x) * sr.y;
                        if (bad) o = (f32x4){qnan, qnan, qnan, qnan}; *(f32x4*)(out + off + bj * HALF + n * 16) = o; }
                asm volatile("" ::: "memory"); }
    }
};
struct EpiLnResLn {
    static constexpr bool PERM = false, AFTER_DRAIN = true;
    const float* base; float* out; bf16_t* xn; int ldc; const float* bias; PanelStats st1, st2; unsigned poison;
    __device__ __forceinline__ void refuse(size_t i0, size_t stride, int M, int N) const { const float q = __builtin_nanf(""); for (size_t i = i0; i < (size_t)M * N; i += stride) { const size_t o = (i / N) * ldc + i % N; out[o] = q; xn[o] = (bf16_t)0x7fc0u; }
        if (i0 == 0) { unsigned expect = 0u; __hip_atomic_compare_exchange_strong(st1.tmo + 1, &expect, 0x7f0u, __ATOMIC_RELAXED, __ATOMIC_RELAXED, __HIP_MEMORY_SCOPE_AGENT); __hip_atomic_store(st1.tmo, 1u, __ATOMIC_RELAXED, __HIP_MEMORY_SCOPE_AGENT); } }
    __device__ __forceinline__ void fused(f32x4 (&acc)[2][2][4][2], const Unit& u, int wr, int wc, int fr, int fq, PG8_LAS unsigned char* lds, int wid, int lane) const {
        typedef float f32x2v __attribute__((ext_vector_type(2))); typedef unsigned u32x2v __attribute__((ext_vector_type(2)));
        const PG8_LAS f32x2v* S = (const PG8_LAS f32x2v*)(lds + 8192);
        const int col0 = u.pn * BM + wc * 32 + 4 * fq;
#pragma unroll
        for (int bj = 0; bj < 2; ++bj)
#pragma unroll
            for (int n = 0; n < 2; ++n) { const f32x4 bv = bias ? *(const f32x4*)(bias + col0 + bj * HALF + n * 16) : (f32x4){0.f, 0.f, 0.f, 0.f};
#pragma unroll
                for (int ai = 0; ai < 2; ++ai)
#pragma unroll
                    for (int m = 0; m < 4; ++m) acc[ai][bj][m][n] += bv; }
        bool bad = st1.run(acc, u, wr, wc, fr, fq, lds, wid, lane) || poison != 0u;
        const float qnan = __builtin_nanf("");
#pragma unroll
        for (int ai = 0; ai < 2; ++ai)
#pragma unroll
            for (int m = 0; m < 4; ++m) { const int r = ai * HALF + wr * 64 + m * 16 + fr; const f32x2v sr = S[r]; const size_t off = (size_t)(u.pm * BM + r) * ldc + col0;
#pragma unroll
                for (int bj = 0; bj < 2; ++bj)
#pragma unroll
                    for (int n = 0; n < 2; ++n) { const f32x4 bs = *(const f32x4*)(base + off + bj * HALF + n * 16); acc[ai][bj][m][n] = bs + (acc[ai][bj][m][n] - sr.x) * sr.y; }
                asm volatile("" : "+v"(acc[ai][0][m][0]), "+v"(acc[ai][0][m][1]), "+v"(acc[ai][1][m][0]), "+v"(acc[ai][1][m][1]));
                if (m & 1) asm volatile("" ::: "memory"); }
        const bool bad1 = bad;
        bad = st2.run(acc, u, wr, wc, fr, fq, lds, wid, lane) || bad;
#pragma unroll
        for (int ai = 0; ai < 2; ++ai)
#pragma unroll
            for (int m = 0; m < 4; ++m) { const int r = ai * HALF + wr * 64 + m * 16 + fr; const f32x2v sr = S[r]; const size_t off = (size_t)(u.pm * BM + r) * ldc + col0;
#pragma unroll
                for (int bj = 0; bj < 2; ++bj)
#pragma unroll
                    for (int n = 0; n < 2; ++n) { const f32x4 x1 = acc[ai][bj][m][n]; *(f32x4*)(out + off + bj * HALF + n * 16) = bad1 ? (f32x4){qnan, qnan, qnan, qnan} : x1;
                        const f32x4 o = (x1 - sr.x) * sr.y; u32x2v w; w.x = cvt_pk_bf16(o[0], o[1]); w.y = cvt_pk_bf16(o[2], o[3]);
                        if (bad) { w.x = 0x7fc07fc0u; w.y = 0x7fc07fc0u; } *(u32x2v*)(xn + off + bj * HALF + n * 16) = w; }
                asm volatile("" ::: "memory"); }
    }
};

template <class Epi, class Sched, bool STAMP = false>
__device__ __forceinline__ void gemm_phase(PG8_LAS unsigned char* lds, const Gemm g, const Sched& S, const Epi& E, unsigned long long* stamps) {
    const int tid = threadIdx.x, wid = __builtin_amdgcn_readfirstlane(tid >> 6), lane = tid & 63, wr = wid >> 2, wc = wid & 3, fr = lane & 15, fq = lane >> 4;
    const int K = g.K, nt = K / BK;
    int ts_lo = 0, ts_hi = 0, nts = 0; const unsigned long long rt_entry = STAMP ? (unsigned long long)wall_clock64() : 0ull;
#define PG8_STAMP() do { if (STAMP && wid == 0 && nts < 64) { const unsigned long long _c = (unsigned long long)clock64(); \
        ts_lo = (lane == nts) ? (int)(unsigned)_c : ts_lo; ts_hi = (lane == nts) ? (int)(unsigned)(_c >> 32) : ts_hi; ++nts; } } while (0)
    PG8_STAMP();
    unsigned voffA[2], voffB[2];
#pragma unroll
    for (int i = 0; i < 2; ++i) { int R, C; stage_rc(tid * 16 + i * 8192, R, C); const int Rb = Epi::PERM ? ((R & ~31) + perm32(R & 31)) : R;
        voffA[i] = (unsigned)(R * K + C) * 2u; voffB[i] = (unsigned)(Rb * K + C) * 2u; }
    const size_t kstep = (size_t)(BK * 2);
    const size_t hstep = (size_t)HALF * K * 2;
    const size_t tstep = 2 * hstep;
    const unsigned ldsw = (unsigned)wid * 1024u;
    const int aoff = lds_byte(wr * 64 + fr, fq * 8), boff = lds_byte(wc * 32 + fr, fq * 8);
#define PG8_SA(b, h) (((b) * 2 + (h)) * HTB)
#define PG8_SB(b, h) ((4 + (b) * 2 + (h)) * HTB)
#define PG8_STAGE(bufoff, gbase, voff) do { _Pragma("unroll") for (int _i = 0; _i < 2; ++_i) \
        __builtin_amdgcn_global_load_lds((const unsigned*)((const char*)(gbase) + (voff)[_i]), (PG8_LAS unsigned*)(lds + (bufoff) + ldsw + _i * 8192), 16, 0, 0); } while (0)
#define PG8_LDA(dst, b, h) do { _Pragma("unroll") for (int m = 0; m < 4; ++m) _Pragma("unroll") for (int k = 0; k < 2; ++k) dst[m][k] = *(const PG8_LAS bf16x8*)(lds + PG8_SA(b, h) + aoff + m * 2048 + k * 1024); } while (0)
#define PG8_LDB(dst, b, h) do { _Pragma("unroll") for (int n = 0; n < 2; ++n) _Pragma("unroll") for (int k = 0; k < 2; ++k) dst[n][k] = *(const PG8_LAS bf16x8*)(lds + PG8_SB(b, h) + boff + n * 2048 + k * 1024); } while (0)
#define PG8_MMA(ai, bj, At, Bt) do { __builtin_amdgcn_s_setprio(1); _Pragma("unroll") for (int m = 0; m < 4; ++m) _Pragma("unroll") for (int n = 0; n < 2; ++n) _Pragma("unroll") for (int k = 0; k < 2; ++k) \
        acc[ai][bj][m][n] = __builtin_amdgcn_mfma_f32_16x16x32_bf16(Bt[n][k], At[m][k], acc[ai][bj][m][n], 0, 0, 0); __builtin_amdgcn_s_setprio(0); } while (0)
#define PG8_WAIT_V(n) asm volatile("s_waitcnt vmcnt(" #n ")" ::: "memory")
#define PG8_WAIT_L(n) asm volatile("s_waitcnt lgkmcnt(" #n ")" ::: "memory")
#define PG8_BAR __builtin_amdgcn_s_barrier()
#define PG8_SCHED __builtin_amdgcn_sched_barrier(0)
    Unit cur, nxt; int ui = 0;
    if (!S.next(0, cur)) return;
    f32x4 acc[2][2][4][2];
#pragma unroll
    for (int a = 0; a < 2; ++a)
#pragma unroll
        for (int b = 0; b < 2; ++b)
#pragma unroll
            for (int m = 0; m < 4; ++m)
#pragma unroll
                for (int n = 0; n < 2; ++n) acc[a][b][m][n] = (f32x4){0.f, 0.f, 0.f, 0.f};
    bf16x8 At[4][2], B0[2][2], B1[2][2];
    const char* cA = (const char*)g.A + (size_t)cur.pm * tstep; const char* cB = (const char*)g.Bt + (size_t)cur.pn * tstep;
    S.a_ready(cur);
    PG8_STAGE(PG8_SB(0, 0), cB, voffB); PG8_STAGE(PG8_SA(0, 0), cA, voffA); PG8_STAGE(PG8_SB(0, 1), cB + hstep, voffB); PG8_STAGE(PG8_SA(0, 1), cA + hstep, voffA);
    if (wr == 1) PG8_BAR;
    PG8_WAIT_V(4); PG8_BAR;
    PG8_STAGE(PG8_SB(1, 0), cB + kstep, voffB); PG8_STAGE(PG8_SA(1, 0), cA + kstep, voffA); PG8_STAGE(PG8_SB(1, 1), cB + hstep + kstep, voffB);
    PG8_WAIT_V(6); PG8_BAR;
    PG8_STAMP();
    for (;;) {
        const bool has_next = S.next(ui + 1, nxt);
        const char* nA = has_next ? (const char*)g.A + (size_t)nxt.pm * tstep : cA; const char* nB = has_next ? (const char*)g.Bt + (size_t)nxt.pn * tstep : cB;
        for (int t = 0; t < nt; t += 2) {
            const bool last = (t == nt - 2);
            const char* a1 = cA + (size_t)(t + 1) * kstep;
            const char* a2 = last ? nA : cA + (size_t)(t + 2) * kstep; const char* b2 = last ? nB : cB + (size_t)(t + 2) * kstep;
            const char* a3 = a2 + kstep; const char* b3 = b2 + kstep;
            if (last && has_next) S.a_ready(nxt);
            PG8_LDB(B0, 0, 0); PG8_SCHED; PG8_LDA(At, 0, 0); PG8_STAGE(PG8_SA(1, 1), a1 + hstep, voffA);
            PG8_WAIT_L(8); PG8_BAR; PG8_WAIT_L(0); PG8_MMA(0, 0, At, B0); PG8_BAR; PG8_SCHED;
            PG8_LDB(B1, 0, 1); PG8_STAGE(PG8_SB(0, 0), b2, voffB);
            PG8_BAR; PG8_WAIT_L(0); PG8_MMA(0, 1, At, B1); PG8_BAR;
            PG8_LDA(At, 0, 1); PG8_STAGE(PG8_SA(0, 0), a2, voffA);
            PG8_BAR; PG8_WAIT_L(0); PG8_MMA(1, 0, At, B0); PG8_BAR; PG8_SCHED;
            PG8_STAGE(PG8_SB(0, 1), b2 + hstep, voffB);
            PG8_WAIT_V(6); PG8_BAR; PG8_MMA(1, 1, At, B1); PG8_BAR;
            PG8_LDB(B0, 1, 0); PG8_SCHED; PG8_LDA(At, 1, 0); PG8_STAGE(PG8_SA(0, 1), a2 + hstep, voffA);
            PG8_WAIT_L(8); PG8_BAR; PG8_WAIT_L(0); PG8_MMA(0, 0, At, B0); PG8_BAR; PG8_SCHED;
            PG8_LDB(B1, 1, 1); PG8_STAGE(PG8_SB(1, 0), b3, voffB);
            PG8_BAR; PG8_WAIT_L(0); PG8_MMA(0, 1, At, B1); PG8_BAR;
            PG8_LDA(At, 1, 1); PG8_STAGE(PG8_SA(1, 0), a3, voffA);
            PG8_BAR; PG8_WAIT_L(0); PG8_MMA(1, 0, At, B0); PG8_BAR; PG8_SCHED;
            PG8_STAGE(PG8_SB(1, 1), b3 + hstep, voffB);
            PG8_WAIT_V(6); PG8_BAR; PG8_MMA(1, 1, At, B1); PG8_BAR;
        }
        PG8_STAMP();
        if constexpr (!Epi::AFTER_DRAIN) { E(acc, cur, wr, wc, fr, fq); S.done(cur); }
        PG8_STAMP();
        if (!has_next) break;
#pragma unroll
        for (int a = 0; a < 2; ++a)
#pragma unroll
            for (int b = 0; b < 2; ++b)
#pragma unroll
                for (int m = 0; m < 4; ++m)
#pragma unroll
                    for (int n = 0; n < 2; ++n) acc[a][b][m][n] = (f32x4){0.f, 0.f, 0.f, 0.f};
        cur = nxt; cA = nA; cB = nB; ++ui;
    }
    PG8_WAIT_V(0);
    if (wr == 0) PG8_BAR;
    PG8_BAR;
    if constexpr (Epi::AFTER_DRAIN) { E.fused(acc, cur, wr, wc, fr, fq, lds, wid, lane); S.done(cur); }
    PG8_STAMP();
    if (STAMP && wid == 0) { stamps[lane] = lane < nts ? (((unsigned long long)(unsigned)ts_hi << 32) | (unsigned)ts_lo) : 0ull;
        if (lane == 62) stamps[62] = rt_entry; if (lane == 63) stamps[63] = (unsigned long long)wall_clock64(); }
#undef PG8_STAMP
#undef PG8_SA
#undef PG8_SB
#undef PG8_STAGE
#undef PG8_LDA
#undef PG8_LDB
#undef PG8_MMA
#undef PG8_WAIT_V
#undef PG8_WAIT_L
#undef PG8_BAR
#undef PG8_SCHED
}
}
#define XB_TMO      128
#define XB_XCNT(j)  (256  + 64 * (j))
#define XB_XSUB(j)  (1280 + 64 * (j))
#define XB_XGEN(j)  (2304 + 64 * (j))
#define XB_TOP      3328
#define XB_TOPGEN   3392
#define XCD_BAR_WORDS 3456
#define XB_SPIN_CAP (1u << 18)
#define LAS __attribute__((address_space(3)))

__device__ __forceinline__ unsigned xb_ld(unsigned* p)              { return __hip_atomic_load(p, __ATOMIC_RELAXED, __HIP_MEMORY_SCOPE_AGENT); }
__device__ __forceinline__ unsigned xb_add(unsigned* p, unsigned v) { return __hip_atomic_fetch_add(p, v, __ATOMIC_RELAXED, __HIP_MEMORY_SCOPE_AGENT); }
__device__ __forceinline__ unsigned xb_xcc_id() { return (unsigned)__builtin_amdgcn_s_getreg((3 << 11) | 20) & 0xFu; }
#define XB_SPIN(cond, bar) do { unsigned _sp = 0; while (cond) { __builtin_amdgcn_s_sleep(1); \
    if ((++_sp & 255u) == 0u) { if (xb_ld(&(bar)[XB_TMO])) break; if (_sp > XB_SPIN_CAP) { atomicAdd(&(bar)[XB_TMO], 1u); break; } } } } while (0)

struct XcdBarrier {
    unsigned* bar; unsigned x;
    volatile LAS unsigned* st;
};

__device__ __forceinline__ XcdBarrier xcd_barrier_post(unsigned* bar, volatile LAS unsigned* st) {
    XcdBarrier b; b.bar = bar; b.x = xb_xcc_id(); b.st = st;
    if (threadIdx.x == 0) (void)xb_add(&bar[XB_XCNT(b.x)], 1u);
    return b;
}
__device__ __forceinline__ void xcd_barrier_complete(unsigned* bar, unsigned x, unsigned& nloc, unsigned& nx) {
    const unsigned G = gridDim.x * gridDim.y * gridDim.z;
    unsigned sum, cnt, mine, sp = 0u;
    for (;;) {
        sum = 0u; cnt = 0u; mine = 0u;
#pragma unroll
        for (unsigned j = 0; j < 16; ++j) { const unsigned c = xb_ld(&bar[XB_XCNT(j)]); sum += c; cnt += (c > 0u) ? 1u : 0u; mine = (j == x) ? c : mine; }
        if (sum == G) break;
        __builtin_amdgcn_s_sleep(1);
        if ((++sp & 255u) == 0u) { if (xb_ld(&bar[XB_TMO])) break; if (sp > XB_SPIN_CAP) { atomicAdd(&bar[XB_TMO], 1u); break; } }
    }
    nloc = mine > 0u ? mine : 1u; nx = cnt > 0u ? cnt : 1u;
}

__device__ __forceinline__ void xcd_barrier(const XcdBarrier& b) {
    asm volatile("s_waitcnt vmcnt(0)" ::: "memory");
    __syncthreads();
    if (threadIdx.x == 0) {
        unsigned* bar = b.bar;
        __builtin_amdgcn_s_waitcnt(0);
        unsigned nloc = b.st[0], nx = b.st[1];
        if (nloc == 0u) { xcd_barrier_complete(bar, b.x, nloc, nx); b.st[0] = nloc; b.st[1] = nx; }
        const unsigned old = xb_add(&bar[XB_XSUB(b.x)], 1u);
        const unsigned gen = old / nloc;
        if (old + 1u == (gen + 1u) * nloc) {
            __builtin_amdgcn_fence(__ATOMIC_RELEASE, "agent");
            asm volatile("s_waitcnt vmcnt(0)" ::: "memory");
            const unsigned og = xb_add(&bar[XB_TOP], 1u);
            const unsigned tg = og / nx;
            if (og + 1u == (tg + 1u) * nx) xb_add(&bar[XB_TOPGEN], 1u);
            else XB_SPIN(xb_ld(&bar[XB_TOPGEN]) == tg, bar);
            __builtin_amdgcn_fence(__ATOMIC_ACQUIRE, "agent");
            xb_add(&bar[XB_XGEN(b.x)], 1u);
            asm volatile("s_waitcnt vmcnt(0)" ::: "memory");
        } else {
            XB_SPIN(xb_ld(&bar[XB_XGEN(b.x)]) == gen, bar);
            __builtin_amdgcn_fence(__ATOMIC_ACQUIRE, "agent");
            asm volatile("s_waitcnt vmcnt(0)" ::: "memory");
        }
    }
    __syncthreads();
}


#ifndef MK_N_LAUNCHES
#define MK_N_LAUNCHES 1
#endif
#ifndef MK_QTAIL
#define MK_QTAIL 7680
#endif
#ifndef MK_QHEAD
#define MK_QHEAD 12288
#endif
namespace mk {
typedef unsigned short bf16_t;
typedef float f32x4 __attribute__((ext_vector_type(4)));
typedef short bf16x8 __attribute__((ext_vector_type(8)));
typedef short s16x4 __attribute__((ext_vector_type(4)));
typedef unsigned u32x4 __attribute__((ext_vector_type(4)));
typedef unsigned u32x2 __attribute__((ext_vector_type(2)));
typedef float f32x2 __attribute__((ext_vector_type(2)));
constexpr int D = 2048, NTOK_P = 16384, NTOK_S = 256, NTOK = 16640;
constexpr int DIN = 5632, DATT = 1536, DLRU = 512, NH = 12, HD = 128;
constexpr int NEXP = 16384;
constexpr float ALPHA = 1.189207115002721f;
constexpr float LN_EPS = 1e-5f;
constexpr float ATT_SCALE = 0.08838834764831845f;
constexpr float LOG2E = 1.4426950408889634f;
constexpr size_t O_YP = 0, O_YS = 33554432, O_KP = 34078720, O_VP = 59244544, O_CP = 84410368, O_HP = 84422656,
                 O_KS = 84426752, O_VS = 185090048, O_CS = 285753344, O_HS = 285802496, O_END = 285818880;
constexpr size_t WS_CTL = 0;
constexpr size_t WS_XB = 65536;
constexpr size_t WS_WINT = WS_XB + (size_t)NTOK * D * 2;
constexpr size_t WS_WOT = WS_WINT + (size_t)DIN * D * 2;
constexpr size_t WS_WQT = WS_WOT + (size_t)D * D * 2;
constexpr size_t WS_UB = WS_WQT + (size_t)D * D * 2;
constexpr size_t WS_VB = WS_UB + (size_t)NEXP * D * 2;
constexpr size_t WS_QF = WS_VB + (size_t)NEXP * D * 2;
constexpr size_t WS_XR = WS_QF + (size_t)NTOK * DATT * 4;
constexpr size_t WS_GATE = WS_XR + (size_t)NTOK * DLRU * 4;
constexpr size_t WS_AR = WS_GATE + (size_t)NTOK * DLRU * 4;
constexpr size_t WS_PRE1 = WS_AR + (size_t)NTOK * D * 2;
constexpr size_t WS_X1F = WS_PRE1 + (size_t)NTOK * D * 4;
constexpr size_t WS_X1B = WS_X1F + (size_t)NTOK * D * 4;
constexpr size_t WS_QP = WS_X1B + (size_t)NTOK * D * 2;
constexpr size_t WS_EIDX = WS_QP + (size_t)NTOK * D * 4;
constexpr size_t WS_GW = WS_EIDX + (size_t)NTOK * 128 * 4;
constexpr size_t WS_SU = WS_GW + (size_t)NTOK * 128 * 4;
constexpr size_t WS_SV = WS_SU + (size_t)NEXP * 4;
constexpr size_t WS_SX = WS_SV + (size_t)NEXP * 4;
constexpr size_t WS_X1Q = WS_SX + (size_t)NTOK * 4;
constexpr size_t WS_SKB = WS_X1Q + (size_t)NTOK * D;
constexpr size_t WS_QB = WS_SKB + (size_t)8 * 2 * 128 * 128 * 2;
constexpr size_t WS_KB = WS_QB + (size_t)NTOK * DATT * 2;
constexpr size_t WS_VB16 = WS_KB + (size_t)NTOK_P * DATT * 2;
constexpr size_t WS_PO = WS_VB16 + (size_t)NTOK_P * DATT * 2;
constexpr size_t WS_PM = WS_PO + (size_t)2 * NTOK_P * DATT * 2;
constexpr size_t WS_PL = WS_PM + (size_t)2 * NTOK_P * NH * 4;
constexpr size_t WS_R0 = WS_PL + (size_t)2 * NTOK_P * NH * 4;
constexpr size_t WS_R1 = WS_R0 + (size_t)NTOK_P * DLRU * 4;
constexpr size_t WS_HE = WS_R1 + (size_t)NTOK_P * DLRU * 4;
constexpr size_t WS_AE = WS_HE + (size_t)8 * 32 * 512 * 4;
constexpr size_t WS_LW = WS_AE + (size_t)8 * 32 * 512 * 4;
constexpr size_t WS_PS = WS_LW + (size_t)2 * 8 * 64 * 64 * 2;
constexpr size_t WS_END = WS_PS + (size_t)32 * 12 * 9 * 8 * 130 * 4;

constexpr int NTHREADS = 512;
constexpr int LDS_BYTES = 148480;
constexpr int MISC_OFF = 147456;

struct Params {
    const float* x_prompt; const float* x_sample; const float* cache_k; const float* cache_v; const float* state_conv; const float* state_h;
    const float* w_in; const float* conv_w; const float* conv_b; const float* lru_w_a; const float* lru_b_a; const float* lru_w_x; const float* lru_b_x;
    const float* lru_lambda; const float* w_out; const float* ln1_g; const float* ln1_b; const float* w_query; const float* sub_keys;
    const float* peer_u; const float* peer_v; const float* ln2_g; const float* ln2_b;
    float* out; unsigned char* ws; int ph_lo, ph_hi;
};

__device__ __forceinline__ unsigned f2bf(float f) { unsigned u = __float_as_uint(f); u += 0x7fffu + ((u >> 16) & 1u); return u >> 16; }
__device__ __forceinline__ unsigned pack2(float a, float b) { return f2bf(a) | (f2bf(b) << 16); }
__device__ __forceinline__ float bflo(unsigned w) { return __uint_as_float(w << 16); }
__device__ __forceinline__ float bfhi(unsigned w) { return __uint_as_float(w & 0xffff0000u); }
__device__ __forceinline__ float4 ntload4(const float* p) { const f32x4 v = __builtin_nontemporal_load((const f32x4*)p); return make_float4(v[0], v[1], v[2], v[3]); }
__device__ __forceinline__ void ntstore4(float* p, float4 v) { __builtin_nontemporal_store((f32x4){v.x, v.y, v.z, v.w}, (f32x4*)p); }
__device__ __forceinline__ float wave_sum(float v) {
#pragma unroll
    for (int o = 32; o >= 1; o >>= 1) v += __shfl_xor(v, o);
    return v;
}
__device__ __forceinline__ float wave_max(float v) {
#pragma unroll
    for (int o = 32; o >= 1; o >>= 1) v = fmaxf(v, __shfl_xor(v, o));
    return v;
}
__device__ __forceinline__ float gelu_exact(float v) { return 0.5f * v * (1.0f + erff(v * 0.7071067811865476f)); }
__device__ __forceinline__ float gelu_as(float v) {
    const float av = fabsf(v), t = __builtin_amdgcn_rcpf(av * 0.2316418882f + 1.0f);
    float q = t * 0.5307027145f + (-0.7265760135f); q = q * t + 0.7107068705f; q = q * t + (-0.142248368f); q = q * t + 0.127414796f; q = q * t;
    const float e = __builtin_amdgcn_exp2f((v * v) * (-0.72134752044f));
    const float m = v * (q * e);
    return v < 0.f ? m : v - m;
}
__device__ __forceinline__ float sigmoidf(float v) { return 1.0f / (1.0f + expf(-v)); }
__device__ __forceinline__ float readlane_f(float v, int l) { return __int_as_float(__builtin_amdgcn_readlane(__float_as_int(v), l)); }

__device__ __forceinline__ void convert_flat(const float* src, bf16_t* dst, size_t n8, size_t gtid, size_t gstride) {
    for (size_t i = gtid; i < n8; i += gstride) {
        const float4 a = ((const float4*)src)[2 * i], b = ((const float4*)src)[2 * i + 1];
        uint4 w; w.x = pack2(a.x, a.y); w.y = pack2(a.z, a.w); w.z = pack2(b.x, b.y); w.w = pack2(b.z, b.w);
        ((uint4*)dst)[i] = w;
    }
}
__device__ __forceinline__ void transpose_convert(const float* src, bf16_t* dst, int K, int N, LAS float* tile) {
    const int tid = threadIdx.x, ntn = N / 64, ntiles = (K / 64) * ntn;
    for (int tl = blockIdx.x; tl < ntiles; tl += gridDim.x) {
        const int kt = tl / ntn, nt = tl - kt * ntn;
#pragma unroll
        for (int i = 0; i < 8; ++i) { const int r = (tid >> 6) + 8 * i, c = tid & 63; tile[r * 65 + c] = src[(size_t)(kt * 64 + r) * N + nt * 64 + c]; }
        __syncthreads();
#pragma unroll
        for (int i = 0; i < 4; ++i) { const int n = (tid >> 5) + 16 * i, k0 = 2 * (tid & 31);
            const unsigned v = pack2(tile[k0 * 65 + n], tile[(k0 + 1) * 65 + n]);
            *(unsigned*)(dst + (size_t)(nt * 64 + n) * K + kt * 64 + k0) = v; }
        __syncthreads();
    }
}
constexpr int TROW = 1152;
__device__ __forceinline__ void quant_row_load(const Params& P, int it, int lane, float4 (&v)[8]) {
    const bool isv = it >= NEXP; const int row = isv ? it - NEXP : it;
    const float* src = (isv ? P.peer_v : P.peer_u) + (size_t)row * D;
#pragma unroll
    for (int j = 0; j < 2; ++j)
#pragma unroll
        for (int i = 0; i < 4; ++i) v[j * 4 + i] = *(const float4*)(src + j * 1024 + lane * 16 + i * 4);
}
__device__ __forceinline__ void quant_row_store(const Params& P, int it, int lane, const float4 (&v)[8]) {
    const bool isv = it >= NEXP; const int row = isv ? it - NEXP : it;
    float cm[2];
#pragma unroll
    for (int j = 0; j < 2; ++j) { float am = 0.f;
#pragma unroll
        for (int i = 0; i < 4; ++i) { const float4 t = v[j * 4 + i]; am = fmaxf(am, fmaxf(fmaxf(fabsf(t.x), fabsf(t.y)), fmaxf(fabsf(t.z), fabsf(t.w)))); }
        cm[j] = am; }
    float rm = wave_max(fmaxf(cm[0], cm[1])); if (rm == 0.f) rm = 1.f;
    unsigned char* dst = P.ws + (isv ? WS_VB : WS_UB) + (size_t)row * TROW;
    u32x4 w; unsigned sqp = 0u;
#pragma unroll
    for (int j = 0; j < 2; ++j) {
        int sq = (int)ceilf(cm[j] / rm * 255.0f); sq = sq < 1 ? 1 : (sq > 255 ? 255 : sq);
        sqp |= (unsigned)sq << (8 * j);
        const float inv = (255.0f * 7.0f) / (rm * (float)sq);
#pragma unroll
        for (int hh = 0; hh < 2; ++hh) { unsigned dw = 0u;
#pragma unroll
            for (int e = 0; e < 8; ++e) { const float4 t = v[j * 4 + hh * 2 + (e >> 2)]; const float x = (e & 3) == 0 ? t.x : ((e & 3) == 1 ? t.y : ((e & 3) == 2 ? t.z : t.w));
                int n = (int)rintf(x * inv); n = n < -7 ? -7 : (n > 7 ? 7 : n); dw |= (unsigned)(isv ? n + 8 : (n & 15)) << (4 * e); }
            w[j * 2 + hh] = dw; }
    }
    *(u32x4*)(dst + lane * 16) = w;
    *(unsigned short*)(dst + 1024 + lane * 2) = (unsigned short)sqp;
    if (lane == 0) ((float*)(P.ws + (isv ? WS_SV : WS_SU)))[row] = rm * (1.0f / (255.0f * 7.0f));
}
__device__ __forceinline__ void quant_tables(const Params& P, int gw, int nw, int lo, int hi) {
    const int lane = threadIdx.x & 63;
    float4 va[8], vb[8];
    int it = lo + gw;
    if (it < hi) quant_row_load(P, it, lane, va);
#pragma unroll 1
    for (; it < hi; it += 2 * nw) {
        if (it + nw < hi) quant_row_load(P, it + nw, lane, vb);
        quant_row_store(P, it, lane, va);
        if (it + nw < hi) {
            if (it + 2 * nw < hi) quant_row_load(P, it + 2 * nw, lane, va);
            quant_row_store(P, it + nw, lane, vb);
        }
    }
}
__device__ __forceinline__ void phase_prologue(const Params& P, LAS unsigned char* lds) {
    const size_t gtid = (size_t)blockIdx.x * NTHREADS + threadIdx.x, gstride = (size_t)gridDim.x * NTHREADS;
    unsigned char* ws = P.ws;
    convert_flat(P.x_prompt, (bf16_t*)(ws + WS_XB), (size_t)NTOK_P * D / 8, gtid, gstride);
    convert_flat(P.x_sample, (bf16_t*)(ws + WS_XB) + (size_t)NTOK_P * D, (size_t)NTOK_S * D / 8, gtid, gstride);
    convert_flat(P.sub_keys, (bf16_t*)(ws + WS_SKB), (size_t)8 * 2 * 128 * 128 / 8, gtid, gstride);
    for (size_t i = gtid; i < (size_t)2 * 8 * 64 * 64; i += gstride) {
        const int c = (int)(i & 63), d = (int)((i >> 6) & 63), n = (int)((i >> 12) & 7), m = (int)(i >> 15);
        ((bf16_t*)(ws + WS_LW))[i] = (bf16_t)f2bf((m ? P.lru_w_x : P.lru_w_a)[(n * 64 + c) * 64 + d]); }
    transpose_convert(P.w_in, (bf16_t*)(ws + WS_WINT), D, DIN, (LAS float*)lds);
    transpose_convert(P.w_out, (bf16_t*)(ws + WS_WOT), D, D, (LAS float*)lds);
    transpose_convert(P.w_query, (bf16_t*)(ws + WS_WQT), D, D, (LAS float*)lds);
}

struct EpiProj {
    static constexpr bool PERM = true, AFTER_DRAIN = false;
    float* out; bf16_t* XR; bf16_t* GATE; bf16_t* QB; bf16_t* KB; bf16_t* VB16;
    __device__ __forceinline__ void operator()(const f32x4 (&acc)[2][2][4][2], const pg8::Unit& u, int wr, int wc, int fr, int fq) const {
        const int pn = u.pn; const int coff = wc * 32 + 8 * fq;
#pragma unroll
        for (int ai = 0; ai < 2; ++ai)
#pragma unroll
            for (int m = 0; m < 4; ++m) {
                const int row = u.pm * 256 + ai * 128 + wr * 64 + m * 16 + fr;
                const bool prompt = row < NTOK_P;
                float* rowp = nullptr; bf16_t* rowb = nullptr; float bsc = 1.0f;
                if (pn < 6) { rowb = QB + (size_t)row * DATT + pn * 256; bsc = ATT_SCALE * LOG2E; }
                else if (pn < 18) {
                    const int isv = pn >= 12; const int c0 = (pn - (isv ? 12 : 6)) * 256;
                    if (prompt) { rowp = out + (isv ? O_VP : O_KP) + (size_t)row * DATT + c0; rowb = (isv ? VB16 : KB) + (size_t)row * DATT + c0; }
                    else { const int rr = row - NTOK_P, b = rr >> 3, t = rr & 7; rowp = out + (isv ? O_VS : O_KS) + ((size_t)b * 2048 + 2040 + t) * DATT + c0; }
                } else if (pn < 20) rowb = XR + (size_t)row * DLRU + (pn - 18) * 256;
                else rowb = GATE + (size_t)row * DLRU + (pn - 20) * 256;
#pragma unroll
                for (int bj = 0; bj < 2; ++bj) {
                    const f32x4 v0 = acc[ai][bj][m][0], v1 = acc[ai][bj][m][1];
                    if (rowp) { *(f32x4*)(rowp + coff + bj * 128) = v0; *(f32x4*)(rowp + coff + bj * 128 + 4) = v1; }
                    if (rowb) { u32x4 w; w.x = pg8::cvt_pk_bf16(v0[0] * bsc, v0[1] * bsc); w.y = pg8::cvt_pk_bf16(v0[2] * bsc, v0[3] * bsc); w.z = pg8::cvt_pk_bf16(v1[0] * bsc, v1[1] * bsc); w.w = pg8::cvt_pk_bf16(v1[2] * bsc, v1[3] * bsc);
                        *(u32x4*)(rowb + coff + bj * 128) = w; }
                }
            }
    }
};
struct EpiOut {
    static constexpr bool PERM = true, AFTER_DRAIN = false;
    const bf16_t* xb; bf16_t* pre;
    __device__ __forceinline__ void operator()(const f32x4 (&acc)[2][2][4][2], const pg8::Unit& u, int wr, int wc, int fr, int fq) const {
        const int col0 = u.pn * 256 + wc * 32 + 8 * fq;
        u32x4 xv[2][4][2];
#pragma unroll
        for (int ai = 0; ai < 2; ++ai)
#pragma unroll
            for (int m = 0; m < 4; ++m) { const int row = u.pm * 256 + ai * 128 + wr * 64 + m * 16 + fr;
#pragma unroll
                for (int bj = 0; bj < 2; ++bj) xv[ai][m][bj] = *(const u32x4*)(xb + (size_t)row * D + col0 + bj * 128); }
#pragma unroll
        for (int ai = 0; ai < 2; ++ai)
#pragma unroll
            for (int m = 0; m < 4; ++m) {
                const int row = u.pm * 256 + ai * 128 + wr * 64 + m * 16 + fr;
                bf16_t* pr = pre + (size_t)row * D + col0;
#pragma unroll
                for (int bj = 0; bj < 2; ++bj) {
                    const u32x4 x = xv[ai][m][bj]; const f32x4 v0 = acc[ai][bj][m][0], v1 = acc[ai][bj][m][1];
                    u32x4 w;
                    w.x = pg8::cvt_pk_bf16(ALPHA * bflo(x.x) + v0[0], ALPHA * bfhi(x.x) + v0[1]); w.y = pg8::cvt_pk_bf16(ALPHA * bflo(x.y) + v0[2], ALPHA * bfhi(x.y) + v0[3]);
                    w.z = pg8::cvt_pk_bf16(ALPHA * bflo(x.z) + v1[0], ALPHA * bfhi(x.z) + v1[1]); w.w = pg8::cvt_pk_bf16(ALPHA * bflo(x.w) + v1[2], ALPHA * bfhi(x.w) + v1[3]);
                    *(u32x4*)(pr + bj * 128) = w;
                }
            }
    }
};
struct EpiPlain {
    static constexpr bool PERM = false, AFTER_DRAIN = false;
    float* C; int ldc;
    __device__ __forceinline__ void operator()(const f32x4 (&acc)[2][2][4][2], const pg8::Unit& u, int wr, int wc, int fr, int fq) const {
        const int col0 = u.pn * 256 + wc * 32 + 4 * fq;
#pragma unroll
        for (int ai = 0; ai < 2; ++ai)
#pragma unroll
            for (int m = 0; m < 4; ++m) {
                const int row = u.pm * 256 + ai * 128 + wr * 64 + m * 16 + fr;
                float* pr = C + (size_t)row * ldc + col0;
#pragma unroll
                for (int bj = 0; bj < 2; ++bj)
#pragma unroll
                    for (int n = 0; n < 2; ++n) *(f32x4*)(pr + bj * 128 + n * 16) = acc[ai][bj][m][n];
            }
    }
};

struct EpiBf16Plain {
    static constexpr bool PERM = true, AFTER_DRAIN = false;
    bf16_t* C; int ldc;
    __device__ __forceinline__ void operator()(const f32x4 (&acc)[2][2][4][2], const pg8::Unit& u, int wr, int wc, int fr, int fq) const {
        const int col0 = u.pn * 256 + wc * 32 + 8 * fq;
#pragma unroll
        for (int ai = 0; ai < 2; ++ai)
#pragma unroll
            for (int m = 0; m < 4; ++m) {
                const int row = u.pm * 256 + ai * 128 + wr * 64 + m * 16 + fr;
                bf16_t* pr = C + (size_t)row * ldc + col0;
#pragma unroll
                for (int bj = 0; bj < 2; ++bj) { const f32x4 v0 = acc[ai][bj][m][0], v1 = acc[ai][bj][m][1]; u32x4 w;
                    w.x = pg8::cvt_pk_bf16(v0[0], v0[1]); w.y = pg8::cvt_pk_bf16(v0[2], v0[3]); w.z = pg8::cvt_pk_bf16(v1[0], v1[1]); w.w = pg8::cvt_pk_bf16(v1[2], v1[3]);
                    *(u32x4*)(pr + bj * 128) = w; }
            }
    }
};

template <int MODE>
__device__ __forceinline__ void sample_rows_gemm(const Params& P, const bf16_t* A, const bf16_t* Wt, LAS unsigned char* lds) {
    const int tid = threadIdx.x, lane = tid & 63, w = __builtin_amdgcn_readfirstlane(tid >> 6);
    const int c = lane & 15, g = lane >> 4;
    for (int tile = blockIdx.x; tile < 256; tile += gridDim.x) {
        const int tg = tile & 7, cg = tile >> 3;
        const int k0 = 256 * w;
        const bf16_t* wp = Wt + (size_t)(64 * cg + c) * D + k0 + 8 * g;
        const bf16_t* xp = A + (size_t)(NTOK_P + 32 * tg + c) * D + k0 + 8 * g;
        f32x4 acc[4][2];
#pragma unroll
        for (int ct = 0; ct < 4; ++ct) { acc[ct][0] = (f32x4){0.f, 0.f, 0.f, 0.f}; acc[ct][1] = (f32x4){0.f, 0.f, 0.f, 0.f}; }
        bf16x8 wf[8][4], xf[8][2];
#pragma unroll
        for (int ks = 0; ks < 8; ++ks) {
#pragma unroll
            for (int tt = 0; tt < 2; ++tt) xf[ks][tt] = *(const bf16x8*)(xp + (size_t)(16 * tt) * D + 32 * ks);
#pragma unroll
            for (int ct = 0; ct < 4; ++ct) wf[ks][ct] = *(const bf16x8*)(wp + (size_t)(16 * ct) * D + 32 * ks);
        }
        __builtin_amdgcn_sched_barrier(0);
#pragma unroll
        for (int ks = 0; ks < 8; ++ks)
#pragma unroll
            for (int ct = 0; ct < 4; ++ct)
#pragma unroll
                for (int tt = 0; tt < 2; ++tt) acc[ct][tt] = __builtin_amdgcn_mfma_f32_16x16x32_bf16(wf[ks][ct], xf[ks][tt], acc[ct][tt], 0, 0, 0);
        LAS float* part = (LAS float*)lds;
#pragma unroll
        for (int ct = 0; ct < 4; ++ct)
#pragma unroll
            for (int tt = 0; tt < 2; ++tt) *(LAS f32x4*)(part + ((w * 32 + 16 * tt + c) * 64 + 16 * ct + 4 * g)) = acc[ct][tt];
        __syncthreads();
        {
            const int tok = tid >> 4, c4 = (tid & 15) * 4;
            f32x4 sum = {0.f, 0.f, 0.f, 0.f};
#pragma unroll
            for (int ww = 0; ww < 8; ++ww) sum += *(const LAS f32x4*)(part + ((ww * 32 + tok) * 64 + c4));
            const int row = NTOK_P + 32 * tg + tok, col = 64 * cg + c4;
            if (MODE == 0) { const f32x4 xv = *(const f32x4*)(P.x_sample + (size_t)(row - NTOK_P) * D + col); const f32x4 r = xv * ALPHA + sum; u32x2 wv; wv.x = pg8::cvt_pk_bf16(r[0], r[1]); wv.y = pg8::cvt_pk_bf16(r[2], r[3]); *(u32x2*)((bf16_t*)(P.ws + WS_PRE1) + (size_t)row * D + col) = wv; }
            else { u32x2 wv; wv.x = pg8::cvt_pk_bf16(sum[0], sum[1]); wv.y = pg8::cvt_pk_bf16(sum[2], sum[3]); *(u32x2*)((bf16_t*)(P.ws + WS_QP) + (size_t)row * D + col) = wv; }
        }
        __syncthreads();
    }
}

constexpr int KVS = 288, VOFF = 73728;
struct AttnKV { u32x4 k[8], v[8]; };
struct AttnId { int p, b, h, r, c, reuse; };
__device__ __forceinline__ void attn_fetch(const Params& P, const AttnId& u, AttnKV& R) {
    const int tid = threadIdx.x; const int dil = 1 << (2 * u.p);
    const bf16_t* Kb = (const bf16_t*)(P.ws + WS_KB); const bf16_t* Vb = (const bf16_t*)(P.ws + WS_VB16);
    const size_t tok0 = (size_t)u.b * 2048; const int j0 = 128 * u.c - 128, rho0 = (u.c == 0 || u.reuse) ? 128 : 0;
#pragma unroll
    for (int it = 0; it < 8; ++it) {
        const int rho = it * 32 + (tid >> 4), ch = tid & 15;
        if (rho >= rho0) {
            const size_t tok = tok0 + (size_t)((j0 + rho) * dil + u.r);
            R.k[it] = *(const u32x4*)(Kb + tok * DATT + u.h * HD + ch * 8);
            R.v[it] = *(const u32x4*)(Vb + tok * DATT + u.h * HD + ch * 8);
        }
    }
}
__device__ __forceinline__ void attn_commit(const AttnId& u, const AttnKV& R, LAS unsigned char* lds) {
    const int tid = threadIdx.x; const int rho0 = (u.c == 0 || u.reuse) ? 128 : 0;
    const int poff = (u.c & 1) ? 0 : 128;
#pragma unroll
    for (int it = 0; it < 8; ++it) {
        const int rho = it * 32 + (tid >> 4), ch = tid & 15;
        if (rho >= rho0) { const int pr = (rho + poff) & 255; *(LAS u32x4*)(lds + pr * KVS + ch * 16) = R.k[it]; *(LAS u32x4*)(lds + VOFF + pr * KVS + ch * 16) = R.v[it]; }
    }
}
template <int MODE>
__device__ __forceinline__ void attn_unit(const Params& P, const AttnId& uid, AttnKV& R, bool has_next, const AttnId& nid, LAS unsigned char* lds) {
    const int tid = threadIdx.x, lane = tid & 63, w = __builtin_amdgcn_readfirstlane(tid >> 6);
    const int p = uid.p, b = uid.b, h = uid.h, r = uid.r, c = uid.c;
    const int dil = 1 << (2 * p);
    const int poff = (c & 1) ? 0 : 128;
    const bf16_t* Qb = (const bf16_t*)(P.ws + WS_QB);
    const size_t tok0 = (size_t)b * 2048;
    attn_commit(uid, R, lds);
    const int cq = lane & 15, g = lane >> 4;
    const int iq = 128 * c + 16 * w + cq;
    const size_t qtok = tok0 + (size_t)(iq * dil + r);
    bf16x8 qf[4];
#pragma unroll
    for (int ks = 0; ks < 4; ++ks) qf[ks] = *(const bf16x8*)(Qb + qtok * DATT + h * HD + 32 * ks + 8 * g);
    __syncthreads();
#pragma unroll
    for (int ks = 0; ks < 4; ++ks) asm volatile("" : "+v"(qf[ks]));
    if (has_next) attn_fetch(P, nid, R);
    const int ktmin = (8 - w - 8 * c) > 0 ? (8 - w - 8 * c) : 0;
    const float slope2 = exp2f(-8.0f * (float)(h + 1) / 12.0f) * LOG2E * (float)dil;
    f32x4 s[9]; float m = -INFINITY;
#pragma unroll
    for (int kt = 0; kt < 9; ++kt) {
        if (kt >= ktmin) {
            f32x4 acc = {0.f, 0.f, 0.f, 0.f};
#pragma unroll
            for (int ks = 0; ks < 4; ++ks) { const bf16x8 kf = *(const LAS bf16x8*)(lds + (((16 * w + 16 * kt + poff) & 255) + cq) * KVS + (32 * ks + 8 * g) * 2); acc = __builtin_amdgcn_mfma_f32_16x16x32_bf16(kf, qf[ks], acc, 0, 0, 0); }
#pragma unroll
            for (int ii = 0; ii < 4; ++ii) { const int dist = cq + 128 - 16 * kt - 4 * g - ii; float v = acc[ii] - slope2 * (float)dist;
                if (kt == 0 && dist > 128) v = -INFINITY; if (kt == 8 && dist < 0) v = -INFINITY; acc[ii] = v; m = fmaxf(m, v); }
            s[kt] = acc;
        } else s[kt] = (f32x4){-INFINITY, -INFINITY, -INFINITY, -INFINITY};
    }
    m = fmaxf(m, __shfl_xor(m, 16)); m = fmaxf(m, __shfl_xor(m, 32));
    float l = 0.f;
#pragma unroll
    for (int kt = 0; kt < 9; ++kt)
#pragma unroll
        for (int ii = 0; ii < 4; ++ii) { const float pp = exp2f(s[kt][ii] - m); s[kt][ii] = pp; l += pp; }
    l += __shfl_xor(l, 16); l += __shfl_xor(l, 32);
    f32x4 o[8];
#pragma unroll
    for (int dt = 0; dt < 8; ++dt) o[dt] = (f32x4){0.f, 0.f, 0.f, 0.f};
#pragma unroll
    for (int kk = 0; kk < 5; ++kk) {
        const int T0 = 2 * kk, T1 = 2 * kk + 1;
        if (T1 >= ktmin || T0 == 8) {
            u32x4 pw; pw.x = pg8::cvt_pk_bf16(s[T0][0], s[T0][1]); pw.y = pg8::cvt_pk_bf16(s[T0][2], s[T0][3]);
            if (T1 <= 8) { pw.z = pg8::cvt_pk_bf16(s[T1 <= 8 ? T1 : 8][0], s[T1 <= 8 ? T1 : 8][1]); pw.w = pg8::cvt_pk_bf16(s[T1 <= 8 ? T1 : 8][2], s[T1 <= 8 ? T1 : 8][3]); } else { pw.z = 0u; pw.w = 0u; }
            const bf16x8 pf = __builtin_bit_cast(bf16x8, pw);
            const int rT0 = (T0 >= ktmin) ? T0 : 8, rT1 = (T1 <= 8 && T1 >= ktmin) ? T1 : 8;
            const int a0 = VOFF + (((16 * w + 16 * rT0 + poff) & 255) + 4 * g + (cq >> 2)) * KVS + 8 * (cq & 3);
            const int a1 = VOFF + (((16 * w + 16 * rT1 + poff) & 255) + 4 * g + (cq >> 2)) * KVS + 8 * (cq & 3);
#pragma unroll
            for (int dt = 0; dt < 8; ++dt) {
                const s16x4 v0 = __builtin_amdgcn_ds_read_tr16_b64_v4i16((LAS s16x4*)(lds + a0 + dt * 32));
                const s16x4 v1 = __builtin_amdgcn_ds_read_tr16_b64_v4i16((LAS s16x4*)(lds + a1 + dt * 32));
                const bf16x8 vf = {v0[0], v0[1], v0[2], v0[3], v1[0], v1[1], v1[2], v1[3]};
                o[dt] = __builtin_amdgcn_mfma_f32_16x16x32_bf16(vf, pf, o[dt], 0, 0, 0);
            }
        }
    }
    const float inv = 1.0f / l;
    if (MODE == 0) {
        bf16_t* po = (bf16_t*)(P.ws + WS_PO) + ((size_t)p * NTOK_P + qtok) * DATT + h * HD + 4 * g;
#pragma unroll
        for (int dt = 0; dt < 8; ++dt) { u32x2 wv; wv.x = pg8::cvt_pk_bf16(o[dt][0] * inv, o[dt][1] * inv); wv.y = pg8::cvt_pk_bf16(o[dt][2] * inv, o[dt][3] * inv); *(u32x2*)(po + 16 * dt) = wv; }
        if (g == 0) { ((float*)(P.ws + WS_PM))[((size_t)p * NTOK_P + qtok) * NH + h] = m; ((float*)(P.ws + WS_PL))[((size_t)p * NTOK_P + qtok) * NH + h] = l; }
    } else {
        const float* PM = (const float*)(P.ws + WS_PM); const float* PL = (const float*)(P.ws + WS_PL);
        const float m0 = PM[qtok * NH + h], l0 = PL[qtok * NH + h], m1 = PM[((size_t)NTOK_P + qtok) * NH + h], l1 = PL[((size_t)NTOK_P + qtok) * NH + h];
        const float M = fmaxf(m, fmaxf(m0, m1));
        const float w2 = exp2f(m - M), w0 = exp2f(m0 - M) * l0, w1 = exp2f(m1 - M) * l1;
        const float rden = 1.0f / (w2 * l + w0 + w1);
        const bf16_t* p0 = (const bf16_t*)(P.ws + WS_PO) + qtok * DATT + h * HD + 4 * g;
        const bf16_t* p1 = p0 + (size_t)NTOK_P * DATT;
        bf16_t* ar = (bf16_t*)(P.ws + WS_AR) + qtok * D + h * HD + 4 * g;
        u32x2 q0[8], q1[8];
#pragma unroll
        for (int dt = 0; dt < 8; ++dt) { q0[dt] = *(const u32x2*)(p0 + 16 * dt); q1[dt] = *(const u32x2*)(p1 + 16 * dt); }
#pragma unroll
        for (int dt = 0; dt < 8; ++dt) {
            const u32x2 x0 = q0[dt], x1 = q1[dt];
            const float r0 = (w2 * o[dt][0] + w0 * bflo(x0.x) + w1 * bflo(x1.x)) * rden, r1 = (w2 * o[dt][1] + w0 * bfhi(x0.x) + w1 * bfhi(x1.x)) * rden;
            const float r2 = (w2 * o[dt][2] + w0 * bflo(x0.y) + w1 * bflo(x1.y)) * rden, r3 = (w2 * o[dt][3] + w0 * bfhi(x0.y) + w1 * bfhi(x1.y)) * rden;
            u32x2 wv; wv.x = pg8::cvt_pk_bf16(r0, r1); wv.y = pg8::cvt_pk_bf16(r2, r3); *(u32x2*)(ar + 16 * dt) = wv;
        }
    }
    __syncthreads();
}

struct SampPre { f32x4 k[4], v[4]; };
__device__ __forceinline__ void samp_prefetch(const Params& P, int b, int h, int k, SampPre& R) {
    const int tid = threadIdx.x;
    const size_t so = ((size_t)(b * 2048 + 256 * k + (tid >> 5))) * DATT + h * HD + (tid & 31) * 4;
#pragma unroll
    for (int it = 0; it < 4; ++it) { R.k[it] = *(const f32x4*)(P.cache_k + so + (size_t)it * 16 * DATT); R.v[it] = *(const f32x4*)(P.cache_v + so + (size_t)it * 16 * DATT); }
}
__device__ __forceinline__ void samp_load4(const float* ck, const float* cv, int s0, f32x4 (&kk)[4], f32x4 (&vv)[4]) {
#pragma unroll
    for (int j = 0; j < 4; ++j) { kk[j] = *(const f32x4*)(ck + (size_t)(s0 + j) * 16 * DATT); vv[j] = *(const f32x4*)(cv + (size_t)(s0 + j) * 16 * DATT); }
}
__device__ __forceinline__ void samp_put4(float* ok, float* ov, float* ok0, float* ov0, LAS unsigned char* lk, int s0, const f32x4 (&kk)[4], const f32x4 (&vv)[4]) {
#pragma unroll
    for (int j = 0; j < 4; ++j) {
        const int it = s0 + j; const f32x4 kf = kk[j], vf = vv[j];
        if (it == 0) { *(f32x4*)ok0 = kf; *(f32x4*)ov0 = vf; } else { *(f32x4*)(ok + (size_t)it * 16 * DATT) = kf; *(f32x4*)(ov + (size_t)it * 16 * DATT) = vf; }
        u32x2 kw, vw; kw.x = pg8::cvt_pk_bf16(kf[0], kf[1]); kw.y = pg8::cvt_pk_bf16(kf[2], kf[3]); vw.x = pg8::cvt_pk_bf16(vf[0], vf[1]); vw.y = pg8::cvt_pk_bf16(vf[2], vf[3]);
        *(LAS u32x2*)(lk + it * 16 * KVS) = kw; *(LAS u32x2*)(lk + VOFF + it * 16 * KVS) = vw;
    }
}
template <bool LAST>
__device__ __forceinline__ void samp_unit(const Params& P, int b, int h, int k, LAS unsigned char* lds, SampPre& R, int nb, int nh, int nk) {
    const int tid = threadIdx.x, lane = tid & 63, w = __builtin_amdgcn_readfirstlane(tid >> 6);
    const int cq = lane & 15, g = lane >> 4;
    const int t = cq & 7;
    bf16x8 qf[4];
    { const bf16_t* Qb = (const bf16_t*)(P.ws + WS_QB) + ((size_t)(NTOK_P + b * 8 + t)) * DATT + h * HD + 8 * g;
#pragma unroll
      for (int ks = 0; ks < 4; ++ks) qf[ks] = *(const bf16x8*)(Qb + 32 * ks); }
    if (!LAST) {
        const int r5 = tid >> 5, ch4 = tid & 31;
        const size_t so = ((size_t)(b * 2048 + 256 * k + r5)) * DATT + h * HD + ch4 * 4;
        const float* ck = P.cache_k + so; const float* cv = P.cache_v + so;
        float* ok = P.out + O_KS + so - (size_t)8 * DATT; float* ov = P.out + O_VS + so - (size_t)8 * DATT;
        const bool first_ok = (256 * k + r5) >= 8;
        float* junk = (float*)(P.ws + WS_QF) + lane * 4;
        float* ok0 = first_ok ? ok : junk; float* ov0 = first_ok ? ov : junk + 256;
        LAS unsigned char* lk = lds + r5 * KVS + ch4 * 8;
        f32x4 ka[4], va[4], kb[4], vb[4];
        samp_load4(ck, cv, 4, ka, va);
        __builtin_amdgcn_sched_barrier(0);
        samp_put4(ok, ov, ok0, ov0, lk, 0, R.k, R.v);
        samp_load4(ck, cv, 8, kb, vb);
        __builtin_amdgcn_sched_barrier(0);
        samp_put4(ok, ov, ok0, ov0, lk, 4, ka, va);
#pragma unroll
        for (int ks = 0; ks < 4; ++ks) asm volatile("" : "+v"(qf[ks]));
        samp_load4(ck, cv, 12, ka, va);
        samp_prefetch(P, nb, nh, nk, R);
        __builtin_amdgcn_sched_barrier(0);
        samp_put4(ok, ov, ok0, ov0, lk, 8, kb, vb);
        samp_put4(ok, ov, ok0, ov0, lk, 12, ka, va);
    } else {
        const int rho = tid >> 5, ch4 = tid & 31;
        u32x2 kw = {0u, 0u}, vw = {0u, 0u};
        if (rho < 8) { const size_t so = ((size_t)(b * 2048 + 2040 + rho)) * DATT + h * HD + ch4 * 4; const float4 kf = *(const float4*)(P.out + O_KS + so), vf = *(const float4*)(P.out + O_VS + so);
            kw.x = pg8::cvt_pk_bf16(kf.x, kf.y); kw.y = pg8::cvt_pk_bf16(kf.z, kf.w); vw.x = pg8::cvt_pk_bf16(vf.x, vf.y); vw.y = pg8::cvt_pk_bf16(vf.z, vf.w); }
        *(LAS u32x2*)(lds + rho * KVS + ch4 * 8) = kw; *(LAS u32x2*)(lds + VOFF + rho * KVS + ch4 * 8) = vw;
        *(LAS u32x2*)(lds + (16 + rho) * KVS + ch4 * 8) = (u32x2){0u, 0u}; *(LAS u32x2*)(lds + VOFF + (16 + rho) * KVS + ch4 * 8) = (u32x2){0u, 0u};
#pragma unroll
        for (int ks = 0; ks < 4; ++ks) asm volatile("" : "+v"(qf[ks]));
    }
    __syncthreads();
    const float slope2 = exp2f(-8.0f * (float)(h + 1) / 12.0f) * LOG2E;
    const bool active = (k < 8) || (w == 0);
    f32x4 s[2]; float m = -INFINITY;
#pragma unroll
    for (int j = 0; j < 2; ++j) {
        f32x4 acc = {0.f, 0.f, 0.f, 0.f};
        if (active) {
#pragma unroll
            for (int ks = 0; ks < 4; ++ks) { const bf16x8 kf = *(const LAS bf16x8*)(lds + (32 * w + 16 * j + cq) * KVS + (32 * ks + 8 * g) * 2); acc = __builtin_amdgcn_mfma_f32_16x16x32_bf16(kf, qf[ks], acc, 0, 0, 0); }
        }
#pragma unroll
        for (int ii = 0; ii < 4; ++ii) {
            const int c = 256 * k + 32 * w + 16 * j + 4 * g + ii, dist = 2048 + t - c;
            int mult = (dist <= 128 ? 1 : 0) + (((dist & 3) == 0 && dist <= 512) ? 1 : 0) + (((dist & 15) == 0 && dist <= 2048) ? 1 : 0);
            if (dist < 0 || !active || c > 2055) mult = 0;
            const float v = mult ? acc[ii] - slope2 * (float)dist : -INFINITY;
            acc[ii] = v; m = fmaxf(m, v);
            s[j][ii] = (float)mult;
            s[j][ii] = v;
        }
    }
    m = fmaxf(m, __shfl_xor(m, 16)); m = fmaxf(m, __shfl_xor(m, 32));
    const float mref = (m == -INFINITY) ? 0.f : m;
    float l = 0.f;
#pragma unroll
    for (int j = 0; j < 2; ++j)
#pragma unroll
        for (int ii = 0; ii < 4; ++ii) {
            const int c = 256 * k + 32 * w + 16 * j + 4 * g + ii, dist = 2048 + t - c;
            const int mult = (dist <= 128 ? 1 : 0) + (((dist & 3) == 0 && dist <= 512) ? 1 : 0) + (((dist & 15) == 0 && dist <= 2048) ? 1 : 0);
            const float pp = (float)mult * exp2f(s[j][ii] - mref); s[j][ii] = pp; l += pp; }
    l += __shfl_xor(l, 16); l += __shfl_xor(l, 32);
    f32x4 o[8];
    {
        u32x4 pw; pw.x = pg8::cvt_pk_bf16(s[0][0], s[0][1]); pw.y = pg8::cvt_pk_bf16(s[0][2], s[0][3]); pw.z = pg8::cvt_pk_bf16(s[1][0], s[1][1]); pw.w = pg8::cvt_pk_bf16(s[1][2], s[1][3]);
        const bf16x8 pf = __builtin_bit_cast(bf16x8, pw);
        const int rw = active ? w : 0;
        const int a0 = VOFF + (32 * rw + 4 * g + (cq >> 2)) * KVS + 8 * (cq & 3), a1 = a0 + 16 * KVS;
#pragma unroll
        for (int dt = 0; dt < 8; ++dt) {
            const s16x4 v0 = __builtin_amdgcn_ds_read_tr16_b64_v4i16((LAS s16x4*)(lds + a0 + dt * 32));
            const s16x4 v1 = __builtin_amdgcn_ds_read_tr16_b64_v4i16((LAS s16x4*)(lds + a1 + dt * 32));
            const bf16x8 vf = {v0[0], v0[1], v0[2], v0[3], v1[0], v1[1], v1[2], v1[3]};
            o[dt] = __builtin_amdgcn_mfma_f32_16x16x32_bf16(vf, pf, (f32x4){0.f, 0.f, 0.f, 0.f}, 0, 0, 0);
        }
    }
    __syncthreads();
    LAS float* OL = (LAS float*)lds;
    LAS float* ML = (LAS float*)(lds + 32768);
    if (cq < 8) {
#pragma unroll
        for (int dt = 0; dt < 8; ++dt) *(LAS f32x4*)(OL + (w * 8 + cq) * 128 + 16 * dt + 4 * g) = o[dt];
        if (g == 0) { ML[(w * 8 + cq) * 2 + 0] = m; ML[(w * 8 + cq) * 2 + 1] = l; }
    }
    __syncthreads();
    {
        const int q = w; float M = -INFINITY;
#pragma unroll
        for (int ww = 0; ww < 8; ++ww) M = fmaxf(M, ML[(ww * 8 + q) * 2]);
        const float Mr = (M == -INFINITY) ? 0.f : M;
        float L = 0.f, o0 = 0.f, o1 = 0.f;
#pragma unroll
        for (int ww = 0; ww < 8; ++ww) { const float f = exp2f(ML[(ww * 8 + q) * 2] - Mr); L += f * ML[(ww * 8 + q) * 2 + 1];
            o0 += f * OL[(ww * 8 + q) * 128 + 2 * lane]; o1 += f * OL[(ww * 8 + q) * 128 + 2 * lane + 1]; }
        float* ps = (float*)(P.ws + WS_PS) + ((((size_t)(b * NH + h)) * 9 + k) * 8 + q) * 130;
        if (lane == 0) { ps[0] = M; ps[1] = L; }
        *(float2*)(ps + 2 + 2 * lane) = make_float2(o0, o1);
    }
    __syncthreads();
}
__device__ __forceinline__ void samp_merge_unit(const Params& P, int b, int t, int h, int lane) {
    const float* ps = (const float*)(P.ws + WS_PS) + ((size_t)(b * NH + h)) * 9 * 8 * 130 + (size_t)t * 130;
    float M = -INFINITY;
#pragma unroll
    for (int k = 0; k < 9; ++k) M = fmaxf(M, ps[(size_t)k * 8 * 130]);
    float L = 0.f, o0 = 0.f, o1 = 0.f;
#pragma unroll
    for (int k = 0; k < 9; ++k) { const float* pk = ps + (size_t)k * 8 * 130; const float f = exp2f(pk[0] - M); L += f * pk[1]; const float2 ov = *(const float2*)(pk + 2 + 2 * lane); o0 += f * ov.x; o1 += f * ov.y; }
    const float inv = 1.0f / L;
    bf16_t* ar = (bf16_t*)(P.ws + WS_AR) + ((size_t)(NTOK_P + b * 8 + t)) * D + h * HD;
    *(unsigned*)(ar + 2 * lane) = pack2(o0 * inv, o1 * inv);
}

constexpr int LRU_XS = 144, LRU_GS = 68, LRU_WAVE = 16 * LRU_XS + 2 * 16 * LRU_GS * 4;
__device__ __forceinline__ void lru_unit(const Params& P, bool samp, int b, int n, int k, int lane, LAS unsigned char* wl) {
    const int T = samp ? 8 : 64; const int row0 = samp ? NTOK_P + b * 8 : b * 2048 + k * 64; const int ch = n * 64 + lane;
    const int cq = lane & 15, g = lane >> 4;
    bf16x8 wf[2][4][2];
    { const bf16_t* lw = (const bf16_t*)(P.ws + WS_LW);
#pragma unroll
      for (int m = 0; m < 2; ++m)
#pragma unroll
        for (int ct = 0; ct < 4; ++ct)
#pragma unroll
            for (int ks = 0; ks < 2; ++ks) wf[m][ct][ks] = *(const bf16x8*)(lw + ((size_t)((m * 8 + n) * 64 + 16 * ct + cq)) * 64 + 32 * ks + 8 * g); }
    const float ba = P.lru_b_a[ch], bx = P.lru_b_x[ch], lam = P.lru_lambda[ch];
    const float sp8 = -8.0f * LOG2E * log1pf(expf(-lam));
    const float cw0 = P.conv_w[ch], cw1 = P.conv_w[512 + ch], cw2 = P.conv_w[1024 + ch], cw3 = P.conv_w[1536 + ch], cb = P.conv_b[ch];
    const bf16_t* XR = (const bf16_t*)(P.ws + WS_XR); const bf16_t* GT = (const bf16_t*)(P.ws + WS_GATE);
    unsigned* RP = (unsigned*)(P.ws + WS_R0); bf16_t* AR = (bf16_t*)(P.ws + WS_AR);
    LAS unsigned char* xcb = wl; LAS float* G = (LAS float*)(wl + 16 * LRU_XS);
    float x0 = 0.f, x1 = 0.f, x2 = 0.f, h = 0.f, A = 1.f;
    if (samp) { x0 = P.state_conv[(b * 3 + 0) * 512 + ch]; x1 = P.state_conv[(b * 3 + 1) * 512 + ch]; x2 = P.state_conv[(b * 3 + 2) * 512 + ch]; h = P.state_h[b * 512 + ch]; }
    else if (k > 0) { x0 = bflo(XR[(size_t)(row0 - 3) * DLRU + ch]); x1 = bflo(XR[(size_t)(row0 - 2) * DLRU + ch]); x2 = bflo(XR[(size_t)(row0 - 1) * DLRU + ch]); }
    unsigned xrn[16], gtn[16];
    { const int ns0 = T < 16 ? T : 16;
#pragma unroll
      for (int i = 0; i < 16; ++i) { const int r = row0 + (i < ns0 ? i : ns0 - 1); xrn[i] = XR[(size_t)r * DLRU + ch]; gtn[i] = GT[(size_t)r * DLRU + ch]; } }
    __builtin_amdgcn_sched_barrier(0);
#pragma unroll
    for (int i = 0; i < 16; ++i) { asm volatile("" : "+v"(xrn[i])); asm volatile("" : "+v"(gtn[i])); }
#pragma unroll 1
    for (int t0 = 0; t0 < T; t0 += 16) {
        const int ns = (T - t0) < 16 ? (T - t0) : 16;
        float xc[16], gt[16];
#pragma unroll
        for (int i = 0; i < 16; ++i) { xc[i] = bflo(xrn[i]); gt[i] = bflo(gtn[i]); }
        if (t0 + 16 < T) { const int nn = (T - t0 - 16) < 16 ? (T - t0 - 16) : 16;
#pragma unroll
            for (int i = 0; i < 16; ++i) { const int r = row0 + t0 + 16 + (i < nn ? i : nn - 1); xrn[i] = XR[(size_t)r * DLRU + ch]; gtn[i] = GT[(size_t)r * DLRU + ch]; } }
        __builtin_amdgcn_sched_barrier(0);
#pragma unroll
        for (int i = 0; i < 16; ++i) {
            const float xin = xc[i]; const float v = ((x0 * cw0 + x1 * cw1) + x2 * cw2) + xin * cw3 + cb;
            if (i < ns) { x0 = x1; x1 = x2; x2 = xin; }
            xc[i] = v;
            *(LAS bf16_t*)(xcb + i * LRU_XS + lane * 2) = (bf16_t)f2bf(v);
        }
        __builtin_amdgcn_wave_barrier();
        const bf16x8 a0 = *(const LAS bf16x8*)(xcb + cq * LRU_XS + (8 * g) * 2), a1 = *(const LAS bf16x8*)(xcb + cq * LRU_XS + (32 + 8 * g) * 2);
#pragma unroll
        for (int m = 0; m < 2; ++m)
#pragma unroll
            for (int ct = 0; ct < 4; ++ct) {
                f32x4 acc = __builtin_amdgcn_mfma_f32_16x16x32_bf16(a0, wf[m][ct][0], (f32x4){0.f, 0.f, 0.f, 0.f}, 0, 0, 0);
                acc = __builtin_amdgcn_mfma_f32_16x16x32_bf16(a1, wf[m][ct][1], acc, 0, 0, 0);
#pragma unroll
                for (int ii = 0; ii < 4; ++ii) G[(m * 16 + 4 * g + ii) * LRU_GS + 16 * ct + cq] = acc[ii];
            }
        __builtin_amdgcn_wave_barrier();
#pragma unroll
        for (int i = 0; i < 16; ++i) {
            if (i < ns) {
                const float ra = G[i * LRU_GS + lane] + ba, ri = G[(16 + i) * LRU_GS + lane] + bx;
                const float r = __builtin_amdgcn_rcpf(1.0f + __builtin_amdgcn_exp2f(-LOG2E * ra)), ig = __builtin_amdgcn_rcpf(1.0f + __builtin_amdgcn_exp2f(-LOG2E * ri));
                const float a = __builtin_amdgcn_exp2f(sp8 * r);
                const float u = __builtin_amdgcn_sqrtf(fmaxf(1.0f - a * a, 0.f)) * (ig * xc[i]);
                h = a * h + u; A = a * A;
                const float ge = gelu_as(gt[i]);
                if (samp) AR[(size_t)(row0 + t0 + i) * D + DATT + ch] = (bf16_t)f2bf(h * ge);
                else RP[(size_t)(row0 + t0 + i) * DLRU + ch] = pack2(h * ge, A * ge);
            }
        }
        __builtin_amdgcn_wave_barrier();
    }
    if (samp) { P.out[O_HS + (size_t)b * 512 + ch] = h; float* co = P.out + O_CS + (size_t)b * 3 * 512 + ch; co[0] = x0; co[512] = x1; co[1024] = x2; }
    else {
        ((float*)(P.ws + WS_HE))[((size_t)(b * 32 + k)) * 512 + ch] = h; ((float*)(P.ws + WS_AE))[((size_t)(b * 32 + k)) * 512 + ch] = A;
        if (k == 31) { float* co = P.out + O_CP + (size_t)b * 3 * 512 + ch; co[0] = x0; co[512] = x1; co[1024] = x2; }
    }
}

__device__ __forceinline__ void phase_lru(const Params& P, LAS unsigned char* lds) {
    const int lane = threadIdx.x & 63, wave = __builtin_amdgcn_readfirstlane(threadIdx.x >> 6);
    const int gw = blockIdx.x * 8 + wave, nw = gridDim.x * 8;
#pragma unroll 1
    for (int pass = 0; pass < 2; ++pass) {
        if ((pass ^ (wave & 1)) == 0) {
            for (int u = gw; u < 2048 + 256; u += nw) { const bool samp = u >= 2048; const int v = samp ? u - 2048 : u; lru_unit(P, samp, samp ? (v >> 3) : (v >> 8), samp ? (v & 7) : ((v >> 5) & 7), v & 31, lane, lds + wave * LRU_WAVE); }
        } else quant_tables(P, gw, nw, MK_QHEAD, 2 * NEXP - MK_QTAIL);
    }
    __syncthreads();
}
__device__ __forceinline__ void phase_samp(const Params& P, LAS unsigned char* lds) {
    SampPre R;
    int u = blockIdx.x;
    if (u < 384 * 8) { const int bh = u >> 3; samp_prefetch(P, bh / NH, bh % NH, u & 7, R); }
    for (; u < 384 * 8; u += gridDim.x) {
        const int bh = u >> 3; const int un = (u + (int)gridDim.x < 384 * 8) ? u + (int)gridDim.x : u; const int nbh = un >> 3;
        samp_unit<false>(P, bh / NH, bh % NH, u & 7, lds, R, nbh / NH, nbh % NH, un & 7);
    }
    for (u = blockIdx.x; u < 384; u += gridDim.x) samp_unit<true>(P, u / NH, u % NH, 8, lds, R, 0, 0, 0);
}
__device__ __forceinline__ AttnId attn01_id(int u) {
    const int p = u / 1536, rem = u - p * 1536, bh = rem >> 4, rc = rem & 15; const int b = bh / NH, h = bh - b * NH;
    return AttnId{p, b, h, p == 0 ? 0 : (rc >> 2), p == 0 ? rc : (rc & 3)};
}
__device__ __forceinline__ void phase_attn01(const Params& P, LAS unsigned char* lds) {
    AttnKV R;
    const int per = (1536 + (int)gridDim.x - 1) / (int)gridDim.x;
    const int u0 = (int)blockIdx.x * per; const int n0 = (u0 + per <= 1536) ? per : (u0 < 1536 ? 1536 - u0 : 0);
    AttnId cur = attn01_id(u0 < 1536 ? u0 : 0);
    if (n0 > 0) attn_fetch(P, cur, R);
    for (int j = 0; j < 2 * n0; ++j) {
        const bool hn = j + 1 < 2 * n0; const int jn = hn ? j + 1 : j;
        AttnId nxt = attn01_id(jn < n0 ? u0 + jn : 1536 + u0 + jn - n0);
        nxt.reuse = (hn && nxt.p == cur.p && nxt.b == cur.b && nxt.h == cur.h && nxt.r == cur.r && nxt.c == cur.c + 1) ? 1 : 0;
        attn_unit<0>(P, cur, R, hn, nxt, lds);
        cur = nxt;
    }
}
__device__ __forceinline__ void phase_mix_b(const Params& P, LAS unsigned char* lds) {
    {
        const int gt = blockIdx.x * NTHREADS + threadIdx.x;
        for (int i = gt; i < 8 * 32 * 512; i += gridDim.x * NTHREADS) {
            const int ch = i & 511, k = (i >> 9) & 31, b = i >> 14;
            const float* HE = (const float*)(P.ws + WS_HE) + (size_t)b * 32 * 512 + ch; const float* AE = (const float*)(P.ws + WS_AE) + (size_t)b * 32 * 512 + ch;
            float he[31], ae[31];
#pragma unroll
            for (int kk = 0; kk < 31; ++kk) { he[kk] = kk < k ? HE[kk * 512] : 0.f; ae[kk] = kk < k ? AE[kk * 512] : 1.f; }
            float hin = 0.f;
#pragma unroll
            for (int kk = 0; kk < 31; ++kk) hin = kk < k ? he[kk] + ae[kk] * hin : hin;
            const unsigned* RP = (const unsigned*)(P.ws + WS_R0) + (size_t)(b * 2048 + k * 64) * DLRU + ch;
            bf16_t* ar = (bf16_t*)(P.ws + WS_AR) + (size_t)(b * 2048 + k * 64) * D + DATT + ch;
#pragma unroll 1
            for (int t0 = 0; t0 < 64; t0 += 16) {
                unsigned rp[16];
#pragma unroll
                for (int t = 0; t < 16; ++t) rp[t] = RP[(size_t)(t0 + t) * DLRU];
#pragma unroll
                for (int t = 0; t < 16; ++t) ar[(size_t)(t0 + t) * D] = (bf16_t)f2bf(bflo(rp[t]) + bfhi(rp[t]) * hin);
            }
            if (k == 31) P.out[O_HP + (size_t)b * 512 + ch] = HE[31 * 512] + AE[31 * 512] * hin;
        }
    }
    { const int lane = threadIdx.x & 63, gw = blockIdx.x * 8 + (threadIdx.x >> 6);
      for (int u = gw; u < NTOK_S * NH; u += gridDim.x * 8) { const int row = u / NH, h = u - row * NH; samp_merge_unit(P, row >> 3, row & 7, h, lane); } }
    {
        AttnKV R; int u = blockIdx.x;
        if (u < 1536) attn_fetch(P, AttnId{2, (u >> 4) / NH, (u >> 4) % NH, u & 15, 0}, R);
        for (; u < 1536; u += gridDim.x) {
            const int un = u + (int)gridDim.x; const bool hn = un < 1536; const int uu = hn ? un : u;
            attn_unit<1>(P, AttnId{2, (u >> 4) / NH, (u >> 4) % NH, u & 15, 0}, R, hn, AttnId{2, (uu >> 4) / NH, (uu >> 4) % NH, uu & 15, 0}, lds);
        }
    }
}

__device__ __forceinline__ void phase_ln1(const Params& P) {
    const int lane = threadIdx.x & 63, wave = threadIdx.x >> 6;
    const bf16_t* pre = (const bf16_t*)(P.ws + WS_PRE1); bf16_t* x1b = (bf16_t*)(P.ws + WS_X1B);
    const int rstep = gridDim.x * 8;
    float4 g8[8], b8[8];
#pragma unroll
    for (int j = 0; j < 8; ++j) { const int col = (j >> 2) * 1024 + lane * 16 + (j & 3) * 4; g8[j] = *(const float4*)(P.ln1_g + col); b8[j] = *(const float4*)(P.ln1_b + col); }
    u32x4 nx[4];
    { const int r0 = blockIdx.x * 8 + wave;
      if (r0 < NTOK) {
#pragma unroll
          for (int j = 0; j < 4; ++j) nx[j] = *(const u32x4*)(pre + (size_t)r0 * D + (j >> 1) * 1024 + lane * 16 + (j & 1) * 8); } }
#pragma unroll
    for (int j = 0; j < 4; ++j) asm volatile("" : "+v"(nx[j]));
    for (int row = blockIdx.x * 8 + wave; row < NTOK; row += rstep) {
        float4 v[8]; float s = 0.f;
        u32x4 cur[4];
#pragma unroll
        for (int j = 0; j < 4; ++j) cur[j] = nx[j];
        if (row + rstep < NTOK) {
#pragma unroll
            for (int j = 0; j < 4; ++j) nx[j] = *(const u32x4*)(pre + (size_t)(row + rstep) * D + (j >> 1) * 1024 + lane * 16 + (j & 1) * 8); }
#pragma unroll
        for (int j = 0; j < 8; j += 2) { const u32x4 pw = cur[j >> 1];
            v[j] = make_float4(bflo(pw.x), bfhi(pw.x), bflo(pw.y), bfhi(pw.y)); v[j + 1] = make_float4(bflo(pw.z), bfhi(pw.z), bflo(pw.w), bfhi(pw.w));
            s += (v[j].x + v[j].y) + (v[j].z + v[j].w) + (v[j + 1].x + v[j + 1].y) + (v[j + 1].z + v[j + 1].w); }
        const float mean = wave_sum(s) * (1.0f / D); float q = 0.f;
#pragma unroll
        for (int j = 0; j < 8; ++j) { const float a = v[j].x - mean, b = v[j].y - mean, c = v[j].z - mean, d = v[j].w - mean; q += (a * a + b * b) + (c * c + d * d); }
        const float rstd = rsqrtf(wave_sum(q) * (1.0f / D) + LN_EPS);
        float am = 0.f;
#pragma unroll
        for (int j = 0; j < 8; ++j) { const int col = (j >> 2) * 1024 + lane * 16 + (j & 3) * 4; const float4 g = g8[j], bb = b8[j];
            float4 o; o.x = (v[j].x - mean) * rstd * g.x + bb.x; o.y = (v[j].y - mean) * rstd * g.y + bb.y; o.z = (v[j].z - mean) * rstd * g.z + bb.z; o.w = (v[j].w - mean) * rstd * g.w + bb.w;
            v[j] = o; am = fmaxf(am, fmaxf(fmaxf(fabsf(o.x), fabsf(o.y)), fmaxf(fabsf(o.z), fabsf(o.w))));
            uint2 w; w.x = pack2(o.x, o.y); w.y = pack2(o.z, o.w); *(uint2*)(x1b + (size_t)row * D + col) = w; }
        am = wave_max(am); if (am == 0.f) am = 1.f;
        const float inv = 119.0f / am;
        unsigned char* xq = P.ws + WS_X1Q + (size_t)row * D;
        u32x4 wh, wl;
#pragma unroll
        for (int d = 0; d < 4; ++d) { unsigned dh = 0u, dl = 0u;
#pragma unroll
            for (int e = 0; e < 8; ++e) { const float4 t = v[d * 2 + (e >> 2)]; const float x = (e & 3) == 0 ? t.x : ((e & 3) == 1 ? t.y : ((e & 3) == 2 ? t.z : t.w));
                const int q = (int)rintf(x * inv); dl |= (unsigned)(q & 15) << (4 * e); dh |= (unsigned)(((q + 8) >> 4) & 15) << (4 * e); }
            wh[d] = dh; wl[d] = dl; }
        *(u32x4*)(xq + lane * 32) = wh; *(u32x4*)(xq + lane * 32 + 16) = wl;
        if (lane == 0) ((float*)(P.ws + WS_SX))[row] = am * (1.0f / 119.0f);
    }
}

__device__ __forceinline__ int mono(float v) { const int b = __float_as_int(v); return b ^ ((b >> 31) & 0x7fffffff); }
__device__ __forceinline__ float unmono(int k) { return __int_as_float(k ^ ((k >> 31) & 0x7fffffff)); }
#define MK_INSERT16(L, X) do { int _x = (X); _Pragma("unroll") for (int _j = 0; _j < 16; ++_j) { const int _hi = max(L[_j], _x); _x = min(L[_j], _x); L[_j] = _hi; } } while (0)

template <int N> __device__ __forceinline__ void bitonic_sort_desc(int (&v)[N]) {
#pragma unroll
    for (int k = 2; k <= N; k <<= 1)
#pragma unroll
        for (int j = k >> 1; j > 0; j >>= 1)
#pragma unroll
            for (int i = 0; i < N; ++i) { const int l = i ^ j;
                if (l > i) { const int a = v[i], b = v[l]; if ((i & k) == 0) { v[i] = max(a, b); v[l] = min(a, b); } else { v[i] = min(a, b); v[l] = max(a, b); } } }
}
template <int N> __device__ __forceinline__ void bitonic_merge_desc(int (&v)[N]) {
#pragma unroll
    for (int j = N >> 1; j > 0; j >>= 1)
#pragma unroll
        for (int i = 0; i < N; ++i) { const int l = i ^ j; if (l > i) { const int a = v[i], b = v[l]; v[i] = max(a, b); v[l] = min(a, b); } }
}
__device__ __forceinline__ void xlane_merge16(int (&v)[16], int off) {
    int c[16];
#pragma unroll
    for (int i = 0; i < 16; ++i) c[i] = max(v[i], __shfl_xor(v[15 - i], off));
#pragma unroll
    for (int i = 0; i < 16; ++i) v[i] = c[i];
    bitonic_merge_desc<16>(v);
}
__device__ __forceinline__ int sel4(int g, int a, int b, int c, int d) { return g == 0 ? a : (g == 1 ? b : (g == 2 ? c : d)); }
__device__ __forceinline__ float sel4f(int g, float a, float b, float c, float d) { return g == 0 ? a : (g == 1 ? b : (g == 2 ? c : d)); }
__device__ __forceinline__ constexpr int cand_a(int role, int i) {
    return role == 0 ? 0 : role == 1 ? (i < 8 ? 1 : (i < 13 ? 2 : 4)) : role == 2 ? (i < 4 ? 3 : (i < 6 ? 5 : (i < 8 ? 6 : (i < 10 ? 7 : 8 + (i - 10))))) : (i < 2 ? 14 + i : -1);
}
__device__ __forceinline__ constexpr int cand_b(int role, int i) {
    return role == 0 ? i : role == 1 ? (i < 8 ? i : (i < 13 ? i - 8 : i - 13)) : role == 2 ? (i < 4 ? i : (i < 6 ? i - 4 : (i < 8 ? i - 6 : (i < 10 ? i - 8 : 0)))) : 0;
}

__device__ __forceinline__ void route_unit(const Params& P, int h, int tg, LAS unsigned char* lds, LAS int* lst) {
    const int lane = threadIdx.x & 63, w = __builtin_amdgcn_readfirstlane(threadIdx.x >> 6);
    const int cq = lane & 15, g = lane >> 4;
    const int tok = tg * 128 + w * 16 + cq;
    const bf16_t* qrow = (const bf16_t*)(P.ws + WS_QP) + (size_t)tok * D + h * 256;
    int L0[16], L1[16];
#pragma unroll
    for (int p = 0; p < 2; ++p) {
        bf16x8 qf[4];
#pragma unroll
        for (int ks = 0; ks < 4; ++ks) qf[ks] = *(const bf16x8*)(qrow + p * 128 + 32 * ks + 8 * g);
        int v0[16], v1[16];
#pragma unroll
        for (int kt = 0; kt < 8; ++kt) {
            f32x4 acc = {0.f, 0.f, 0.f, 0.f};
#pragma unroll
            for (int ks = 0; ks < 4; ++ks) { const bf16x8 kf = *(const LAS bf16x8*)(lds + (p * 128 + 16 * kt + cq) * KVS + (32 * ks + 8 * g) * 2); acc = __builtin_amdgcn_mfma_f32_16x16x32_bf16(kf, qf[ks], acc, 0, 0, 0); }
#pragma unroll
            for (int ii = 0; ii < 4; ++ii) { const int key = (mono(acc[ii]) & ~127) | (16 * kt + 4 * g + ii); if (kt < 4) v0[kt * 4 + ii] = key; else v1[(kt - 4) * 4 + ii] = key; }
        }
        bitonic_sort_desc<16>(v0); bitonic_sort_desc<16>(v1);
#pragma unroll
        for (int i = 0; i < 16; ++i) v0[i] = max(v0[i], v1[15 - i]);
        bitonic_merge_desc<16>(v0);
        xlane_merge16(v0, 16); xlane_merge16(v0, 32);
#pragma unroll
        for (int i = 0; i < 16; ++i) { if (p == 0) L0[i] = v0[i]; else L1[i] = v0[i]; }
    }
    if (g == 0) {
#pragma unroll
        for (int i = 0; i < 16; ++i) lst[(cq * 2 + 0) * 16 + i] = L0[i];
    }
    if (g == 1) {
#pragma unroll
        for (int i = 0; i < 16; ++i) lst[(cq * 2 + 1) * 16 + i] = L1[i];
    }
    float f0[16], f1[16];
#pragma unroll
    for (int i = 0; i < 16; ++i) { f0[i] = unmono(L0[i] & ~127); f1[i] = unmono(L1[i] & ~127); }
    int c[16];
#pragma unroll
    for (int i = 0; i < 16; ++i) {
        constexpr int NEG = (int)0x80000000;
        const float va = sel4f(g, f0[cand_a(0, i)], f0[cand_a(1, i)], f0[cand_a(2, i)], f0[cand_a(3, i) < 0 ? 0 : cand_a(3, i)]);
        const float vb = sel4f(g, f1[cand_b(0, i)], f1[cand_b(1, i)], f1[cand_b(2, i)], f1[cand_b(3, i)]);
        const int id = sel4(g, (cand_a(0, i) << 4) | cand_b(0, i), (cand_a(1, i) << 4) | cand_b(1, i), (cand_a(2, i) << 4) | cand_b(2, i), ((cand_a(3, i) < 0 ? 0 : cand_a(3, i)) << 4) | cand_b(3, i));
        int key = (mono(va + vb) & ~255) | id;
        if (cand_a(3, i) < 0) key = (g == 3) ? NEG : key;
        c[i] = key;
    }
    bitonic_sort_desc<16>(c);
    xlane_merge16(c, 16); xlane_merge16(c, 32);
    const float mx = unmono(c[0] & ~255);
    float e[16]; float sum = 0.f;
#pragma unroll
    for (int i = 0; i < 16; ++i) { e[i] = exp2f((unmono(c[i] & ~255) - mx) * LOG2E); sum += e[i]; }
    const float inv = 1.0f / sum;
    __builtin_amdgcn_wave_barrier();
    int ei[4]; float gi[4];
#pragma unroll
    for (int j = 0; j < 4; ++j) {
        const int key = sel4(g, c[j], c[4 + j], c[8 + j], c[12 + j]);
        gi[j] = sel4f(g, e[j], e[4 + j], e[8 + j], e[12 + j]) * inv;
        const int a = (key >> 4) & 15, b = key & 15;
        const int i0 = lst[(cq * 2 + 0) * 16 + a] & 127, i1 = lst[(cq * 2 + 1) * 16 + b] & 127;
        ei[j] = i0 * 128 + i1;
    }
    int* EIDX = (int*)(P.ws + WS_EIDX); float* GW = (float*)(P.ws + WS_GW);
    *(int4*)(EIDX + (size_t)tok * 128 + h * 16 + 4 * g) = make_int4(ei[0], ei[1], ei[2], ei[3]);
    *(float4*)(GW + (size_t)tok * 128 + h * 16 + 4 * g) = make_float4(gi[0], gi[1], gi[2], gi[3]);
    __builtin_amdgcn_wave_barrier();
}
__device__ __forceinline__ void phase_route(const Params& P, LAS unsigned char* lds) {
    const int tid = threadIdx.x, wave = __builtin_amdgcn_readfirstlane(tid >> 6);
    const int h = blockIdx.x & 7, slot = blockIdx.x >> 3, nslot = gridDim.x >> 3;
    const bf16_t* sk = (const bf16_t*)(P.ws + WS_SKB) + (size_t)h * 2 * 128 * 128;
#pragma unroll
    for (int it = 0; it < 8; ++it) { const int row = it * 32 + (tid >> 4), ch = tid & 15; *(LAS u32x4*)(lds + row * KVS + ch * 16) = *(const u32x4*)(sk + (size_t)row * 128 + ch * 8); }
    __syncthreads();
    LAS int* lst = (LAS int*)(lds + 73728) + wave * 512;
    for (int tg = slot; tg < NTOK / 128; tg += nslot) route_unit(P, h, tg, lds, lst);
    { const int extra = (NTOK / 128) % nslot;
      if (extra != 0 && slot >= extra) quant_tables(P, ((slot - extra) * 8 + h) * 8 + wave, (nslot - extra) * 8 * 8, 2 * NEXP - MK_QTAIL, 2 * NEXP);
      else if (extra == 0) quant_tables(P, (int)blockIdx.x * 8 + wave, (int)gridDim.x * 8, 2 * NEXP - MK_QTAIL, 2 * NEXP); }
}

__device__ __forceinline__ float ubf(unsigned x, int k) { return (float)((x >> (8 * k)) & 0xffu); }
constexpr int XSLOT = 1152, XGRP = 4 * XSLOT, XNG = 4, XWAVE = XNG * XGRP;
__device__ __forceinline__ void dma_group(__amdgpu_buffer_rsrc_t tab, int e_lo, int e_hi, int g, LAS unsigned char* sb, int lane) {
#pragma unroll
    for (int j = 0; j < 4; ++j) {
        const int k = g * 4 + j; const int e = __builtin_amdgcn_readlane(k < 64 ? e_lo : e_hi, k & 63);
        const int so = e * TROW;
        __builtin_amdgcn_raw_ptr_buffer_load_lds(tab, (LAS void*)(sb + j * XSLOT), 16, lane * 16, so, 0, 0);
        if (lane < 8) __builtin_amdgcn_raw_ptr_buffer_load_lds(tab, (LAS void*)(sb + j * XSLOT + 1024), 16, 1024 + lane * 16, so, 0, 0);
    }
}
__device__ __forceinline__ void u_consume(const LAS unsigned char* sb, const u32x4& xh, const u32x4& xl, float a_lo, float a_hi, float b_lo, float b_hi, int g, int lane, float& w_lo, float& w_hi) {
    int d[4];
#pragma unroll
    for (int j = 0; j < 4; ++j) {
        const u32x4 nb = *(const LAS u32x4*)(sb + j * XSLOT + lane * 16); const unsigned sc = *(const LAS unsigned short*)(sb + j * XSLOT + 1024 + lane * 2);
        int tot = 0;
#pragma unroll
        for (int jj = 0; jj < 2; ++jj) {
            int th = __builtin_amdgcn_sdot8((int)nb[jj * 2], (int)xh[jj * 2], 0, false); th = __builtin_amdgcn_sdot8((int)nb[jj * 2 + 1], (int)xh[jj * 2 + 1], th, false);
            int tl = __builtin_amdgcn_sdot8((int)nb[jj * 2], (int)xl[jj * 2], 0, false); tl = __builtin_amdgcn_sdot8((int)nb[jj * 2 + 1], (int)xl[jj * 2 + 1], tl, false);
            tot += (16 * th + tl) * (int)((sc >> (8 * jj)) & 255u); }
        d[j] = tot;
    }
    const auto s02 = __builtin_amdgcn_permlane32_swap((unsigned)d[0], (unsigned)d[2], false, false);
    const auto s13 = __builtin_amdgcn_permlane32_swap((unsigned)d[1], (unsigned)d[3], false, false);
    const int r0 = (int)s02[0] + (int)s02[1], r1 = (int)s13[0] + (int)s13[1];
    const auto s01 = __builtin_amdgcn_permlane16_swap((unsigned)r0, (unsigned)r1, false, false);
    int r = (int)s01[0] + (int)s01[1];
    r += __builtin_amdgcn_update_dpp(0, r, 0x128, 0xf, 0xf, false);
    r += __builtin_amdgcn_update_dpp(0, r, 0x124, 0xf, 0xf, false);
    r += __builtin_amdgcn_update_dpp(0, r, 0x4E, 0xf, 0xf, false);
    r += __builtin_amdgcn_update_dpp(0, r, 0xB1, 0xf, 0xf, false);
    const int tot = __shfl(r, (lane & 3) * 16);
    const bool mine = ((lane >> 2) == (g & 15));
    const bool hi = g >= 16;
    const float wv = (hi ? b_hi : b_lo) * gelu_as((float)tot * (hi ? a_hi : a_lo));
    if (hi) w_hi = mine ? wv : w_hi; else w_lo = mine ? wv : w_lo;
}
__device__ __forceinline__ void v_consume(const LAS unsigned char* sb, int (&acc)[32], int (&bias)[2], float w_lo, float w_hi, float inv_sw, int g, int lane) {
    u32x4 nb[4]; int wq[2] = {0, 0};
#pragma unroll
    for (int j = 0; j < 4; ++j) {
        const int k = g * 4 + j; const float w = readlane_f(k < 64 ? w_lo : w_hi, k & 63) * inv_sw;
        nb[j] = *(const LAS u32x4*)(sb + j * XSLOT + lane * 16); const unsigned sc = *(const LAS unsigned short*)(sb + j * XSLOT + 1024 + lane * 2);
#pragma unroll
        for (int jj = 0; jj < 2; ++jj) { const int q = (int)rintf(w * (float)((sc >> (8 * jj)) & 255u)); wq[jj] |= (q & 255) << (8 * j); }
    }
    bias[0] = __builtin_amdgcn_sdot4(wq[0], 0x01010101, bias[0], false); bias[1] = __builtin_amdgcn_sdot4(wq[1], 0x01010101, bias[1], false);
#pragma unroll
    for (int i = 0; i < 4; ++i) {
        const unsigned r0 = nb[0][i], r1 = nb[1][i], r2 = nb[2][i], r3 = nb[3][i];
        const unsigned p01a = __builtin_amdgcn_perm(r1, r0, 0x05010400u), p01b = __builtin_amdgcn_perm(r1, r0, 0x07030602u);
        const unsigned p23a = __builtin_amdgcn_perm(r3, r2, 0x05010400u), p23b = __builtin_amdgcn_perm(r3, r2, 0x07030602u);
        const unsigned t0 = __builtin_amdgcn_perm(p23a, p01a, 0x05040100u), t1 = __builtin_amdgcn_perm(p23a, p01a, 0x07060302u);
        const unsigned t2 = __builtin_amdgcn_perm(p23b, p01b, 0x05040100u), t3 = __builtin_amdgcn_perm(p23b, p01b, 0x07060302u);
        const int wv = wq[i >> 1];
        acc[i * 8 + 0] = __builtin_amdgcn_sdot4((int)(t0 & 0x0F0F0F0Fu), wv, acc[i * 8 + 0], false); acc[i * 8 + 1] = __builtin_amdgcn_sdot4((int)((t0 >> 4) & 0x0F0F0F0Fu), wv, acc[i * 8 + 1], false);
        acc[i * 8 + 2] = __builtin_amdgcn_sdot4((int)(t1 & 0x0F0F0F0Fu), wv, acc[i * 8 + 2], false); acc[i * 8 + 3] = __builtin_amdgcn_sdot4((int)((t1 >> 4) & 0x0F0F0F0Fu), wv, acc[i * 8 + 3], false);
        acc[i * 8 + 4] = __builtin_amdgcn_sdot4((int)(t2 & 0x0F0F0F0Fu), wv, acc[i * 8 + 4], false); acc[i * 8 + 5] = __builtin_amdgcn_sdot4((int)((t2 >> 4) & 0x0F0F0F0Fu), wv, acc[i * 8 + 5], false);
        acc[i * 8 + 6] = __builtin_amdgcn_sdot4((int)(t3 & 0x0F0F0F0Fu), wv, acc[i * 8 + 6], false); acc[i * 8 + 7] = __builtin_amdgcn_sdot4((int)((t3 >> 4) & 0x0F0F0F0Fu), wv, acc[i * 8 + 7], false);
    }
}
__device__ __forceinline__ void wave_sort128(int& v0, int& v1, int lane) {
#pragma unroll
    for (int k = 2; k <= 128; k <<= 1) {
#pragma unroll
        for (int j = k >> 1; j > 0; j >>= 1) {
            if (j == 64) { const int lo = min(v0, v1), hi = max(v0, v1); v0 = lo; v1 = hi; }
            else {
                const int p0 = __shfl_xor(v0, j), p1 = __shfl_xor(v1, j);
                const bool lower = (lane & j) == 0;
                const bool asc0 = (lane & k) == 0, asc1 = ((64 + lane) & k) == 0;
                v0 = (lower == asc0) ? min(v0, p0) : max(v0, p0);
                v1 = (lower == asc1) ? min(v1, p1) : max(v1, p1);
            }
        }
    }
}
__device__ __forceinline__ void exp_epilogue(const Params& P, int row, int ln, const int (&acc)[32], const int (&bias)[2], float scale_w) {
    const bf16_t* x1b = (const bf16_t*)(P.ws + WS_X1B);
    float val[32]; float s = 0.f;
#pragma unroll
    for (int jj = 0; jj < 2; ++jj) {
        const int b8 = 8 * bias[jj];
#pragma unroll
        for (int hh = 0; hh < 2; ++hh) {
            const u32x4 xa = *(const u32x4*)(x1b + (size_t)row * D + jj * 1024 + ln * 16 + hh * 8);
#pragma unroll
            for (int i = 0; i < 4; ++i) { const int e0 = jj * 16 + hh * 8 + 2 * i;
                val[e0] = scale_w * (float)(acc[e0] - b8) + ALPHA * bflo(xa[i]); val[e0 + 1] = scale_w * (float)(acc[e0 + 1] - b8) + ALPHA * bfhi(xa[i]); s += val[e0] + val[e0 + 1]; }
        }
    }
    const float mean = wave_sum(s) * (1.0f / D); float q = 0.f;
#pragma unroll
    for (int i = 0; i < 32; ++i) { const float d0 = val[i] - mean; q += d0 * d0; }
    const float rstd = rsqrtf(wave_sum(q) * (1.0f / D) + LN_EPS);
    float* yo = P.out + (row < NTOK_P ? O_YP + (size_t)row * D : O_YS + (size_t)(row - NTOK_P) * D);
    const int lo16 = ln * 16;
    float4 gg[8], bb[8];
#pragma unroll
    for (int jj = 0; jj < 2; ++jj)
#pragma unroll
        for (int i = 0; i < 4; ++i) { const int col = jj * 1024 + lo16 + i * 4; gg[jj * 4 + i] = *(const float4*)(P.ln2_g + col); bb[jj * 4 + i] = *(const float4*)(P.ln2_b + col); }
#pragma unroll
    for (int jj = 0; jj < 2; ++jj)
#pragma unroll
        for (int i = 0; i < 4; ++i) {
            const int col = jj * 1024 + lo16 + i * 4;
            const float4 g0 = gg[jj * 4 + i], b0 = bb[jj * 4 + i];
            float4 o;
            o.x = (val[jj * 16 + i * 4 + 0] - mean) * rstd * g0.x + b0.x; o.y = (val[jj * 16 + i * 4 + 1] - mean) * rstd * g0.y + b0.y;
            o.z = (val[jj * 16 + i * 4 + 2] - mean) * rstd * g0.z + b0.z; o.w = (val[jj * 16 + i * 4 + 3] - mean) * rstd * g0.w + b0.w;
            *(float4*)(yo + col) = o;
        }
}
__device__ __forceinline__ void phase_experts(const Params& P, LAS unsigned char* lds) {
    const int lane = threadIdx.x & 63, wave = __builtin_amdgcn_readfirstlane(threadIdx.x >> 6);
    const int* EIDX = (const int*)(P.ws + WS_EIDX); const float* GW = (const float*)(P.ws + WS_GW);
    const __amdgpu_buffer_rsrc_t UQ = __builtin_amdgcn_make_buffer_rsrc((void*)(P.ws + WS_UB), 0, NEXP * TROW, 0x00020000);
    const __amdgpu_buffer_rsrc_t VQ = __builtin_amdgcn_make_buffer_rsrc((void*)(P.ws + WS_VB), 0, NEXP * TROW, 0x00020000);
    const float* SU = (const float*)(P.ws + WS_SU); const float* SV = (const float*)(P.ws + WS_SV); const float* SX = (const float*)(P.ws + WS_SX);
    LAS unsigned char* wb = lds + wave * XWAVE;
    constexpr int TPW = 8;
    const int row0 = blockIdx.x * 8 + wave, rstride = gridDim.x * 8;
    if (row0 + (TPW - 1) * rstride < NTOK_P) {
        u32x4 mxh[TPW], mxl[TPW]; int mel[TPW], meh[TPW]; float mal[TPW], mah[TPW], mbl[TPW], mbh[TPW];
#pragma unroll
        for (int i = 0; i < TPW; ++i) {
            const int row = row0 + i * rstride;
            mxh[i] = *(const u32x4*)(P.ws + WS_X1Q + (size_t)row * D + lane * 32); mxl[i] = *(const u32x4*)(P.ws + WS_X1Q + (size_t)row * D + lane * 32 + 16);
            int p0 = (EIDX[(size_t)row * 128 + lane] << 18) | min(262143, (int)(GW[(size_t)row * 128 + lane] * 262144.0f));
            int p1 = (EIDX[(size_t)row * 128 + 64 + lane] << 18) | min(262143, (int)(GW[(size_t)row * 128 + 64 + lane] * 262144.0f));
            wave_sort128(p0, p1, lane);
            mel[i] = (int)((unsigned)p0 >> 18); meh[i] = (int)((unsigned)p1 >> 18);
            const float gl = ((float)(p0 & 262143) + 0.5f) * (1.0f / 262144.0f), gh = ((float)(p1 & 262143) + 0.5f) * (1.0f / 262144.0f);
            const float sx = SX[row];
            mal[i] = SU[mel[i]] * sx; mah[i] = SU[meh[i]] * sx; mbl[i] = gl * SV[mel[i]]; mbh[i] = gh * SV[meh[i]];
        }
        asm volatile("s_waitcnt vmcnt(0)" ::: "memory");
        dma_group(UQ, mel[0], meh[0], 0, wb, lane); dma_group(UQ, mel[0], meh[0], 1, wb + XGRP, lane); dma_group(UQ, mel[0], meh[0], 2, wb + 2 * XGRP, lane);
        int sg = 0;
        float mwl[TPW], mwh[TPW];
#pragma unroll
        for (int j = 0; j < TPW; ++j) { mwl[j] = 0.f; mwh[j] = 0.f; }
        static_assert(TPW == 8, "the visit order below is written for 8 tokens per wave");
#pragma unroll 1
        for (int v = 0; v < 64; ++v) {
            const int ss = v >> 3, i = v & 7, i2 = (v + 1) & 7, s2 = (v + 1) >> 3;
            u32x4 xh = mxh[0], xl = mxl[0]; int e_lo = mel[0], e_hi = meh[0], n_lo = mel[0], n_hi = meh[0]; float a_lo = mal[0], a_hi = mah[0], b_lo = mbl[0], b_hi = mbh[0], w_lo = mwl[0], w_hi = mwh[0];
#pragma unroll
            for (int j = 1; j < TPW; ++j) { const bool m = (i == j), m2 = (i2 == j);
                xh[0] = m ? mxh[j][0] : xh[0]; xh[1] = m ? mxh[j][1] : xh[1]; xh[2] = m ? mxh[j][2] : xh[2]; xh[3] = m ? mxh[j][3] : xh[3];
                xl[0] = m ? mxl[j][0] : xl[0]; xl[1] = m ? mxl[j][1] : xl[1]; xl[2] = m ? mxl[j][2] : xl[2]; xl[3] = m ? mxl[j][3] : xl[3];
                e_lo = m ? mel[j] : e_lo; e_hi = m ? meh[j] : e_hi; a_lo = m ? mal[j] : a_lo; a_hi = m ? mah[j] : a_hi; b_lo = m ? mbl[j] : b_lo; b_hi = m ? mbh[j] : b_hi;
                w_lo = m ? mwl[j] : w_lo; w_hi = m ? mwh[j] : w_hi; n_lo = m2 ? mel[j] : n_lo; n_hi = m2 ? meh[j] : n_hi; }
#pragma unroll
            for (int gg = 0; gg < 4; ++gg) {
                const int sn = (sg + 3) & 3;
                if (gg == 0) dma_group(UQ, e_lo, e_hi, ss * 4 + 3, wb + sn * XGRP, lane);
                else if (v < 63) dma_group(UQ, n_lo, n_hi, s2 * 4 + gg - 1, wb + sn * XGRP, lane);
                else dma_group(VQ, n_lo, n_hi, gg - 1, wb + sn * XGRP, lane);
                asm volatile("s_waitcnt vmcnt(24)" ::: "memory");
                u_consume(wb + sg * XGRP, xh, xl, a_lo, a_hi, b_lo, b_hi, ss * 4 + gg, lane, w_lo, w_hi);
                sg = (sg + 1) & 3;
            }
#pragma unroll
            for (int j = 0; j < TPW; ++j) { const bool m = (i == j); mwl[j] = m ? w_lo : mwl[j]; mwh[j] = m ? w_hi : mwh[j]; }
        }
#pragma unroll 1
        for (int i = 0; i < TPW; ++i) {
            const int row = row0 + i * rstride;
            int e_lo = mel[0], e_hi = meh[0], n_lo = mel[0], n_hi = meh[0]; float w_lo = mwl[0], w_hi = mwh[0];
#pragma unroll
            for (int j = 1; j < TPW; ++j) { const bool m = (i == j); e_lo = m ? mel[j] : e_lo; e_hi = m ? meh[j] : e_hi; w_lo = m ? mwl[j] : w_lo; w_hi = m ? mwh[j] : w_hi; }
#pragma unroll
            for (int j = 0; j < TPW - 1; ++j) { const bool m = (i == j); n_lo = m ? mel[j + 1] : n_lo; n_hi = m ? meh[j + 1] : n_hi; }
            float wmax = wave_max(fmaxf(fabsf(w_lo), fabsf(w_hi))); if (wmax == 0.f) wmax = 1.f;
            const float scale_w = wmax * (255.0f / 127.0f), inv_sw = 1.0f / scale_w;
            int acc[32]; int bias[2] = {0, 0};
#pragma unroll
            for (int q = 0; q < 32; ++q) acc[q] = 0;
#pragma unroll 1
            for (int g = 0; g < 32; ++g) {
                const int sn = (sg + 3) & 3;
                if (g + 3 < 32) dma_group(VQ, e_lo, e_hi, g + 3, wb + sn * XGRP, lane);
                else dma_group(VQ, n_lo, n_hi, g + 3 - 32, wb + sn * XGRP, lane);
                asm volatile("s_waitcnt vmcnt(24)" ::: "memory");
                v_consume(wb + sg * XGRP, acc, bias, w_lo, w_hi, inv_sw, g, lane);
                sg = (sg + 1) & 3;
            }
            int ln = lane; asm volatile("" : "+v"(ln));
            exp_epilogue(P, row, ln, acc, bias, scale_w);
        }
        asm volatile("s_waitcnt vmcnt(0)" ::: "memory");
    }
    for (int row = row0 + ((row0 + (TPW - 1) * rstride < NTOK_P) ? TPW * rstride : 0); row < NTOK_P; row += rstride) {
        int ln = lane; asm volatile("" : "+v"(ln));
        const u32x4 xh = *(const u32x4*)(P.ws + WS_X1Q + (size_t)row * D + ln * 32), xl = *(const u32x4*)(P.ws + WS_X1Q + (size_t)row * D + ln * 32 + 16);
        const float sx = SX[row];
        const int e_lo = EIDX[(size_t)row * 128 + ln], e_hi = EIDX[(size_t)row * 128 + 64 + ln];
        const float g_lo = GW[(size_t)row * 128 + ln], g_hi = GW[(size_t)row * 128 + 64 + ln];
        const float a_lo = SU[e_lo] * sx, a_hi = SU[e_hi] * sx, b_lo = g_lo * SV[e_lo], b_hi = g_hi * SV[e_hi];
        float w_lo = 0.f, w_hi = 0.f;
        asm volatile("s_waitcnt vmcnt(0)" ::: "memory");
        dma_group(UQ, e_lo, e_hi, 0, wb, lane); dma_group(UQ, e_lo, e_hi, 1, wb + XGRP, lane); dma_group(UQ, e_lo, e_hi, 2, wb + 2 * XGRP, lane);
        int sg = 0;
#pragma unroll 1
        for (int g = 0; g < 32; ++g) {
            const int sn = (sg + 3) & 3;
            if (g + 3 < 32) dma_group(UQ, e_lo, e_hi, g + 3, wb + sn * XGRP, lane); else dma_group(VQ, e_lo, e_hi, g + 3 - 32, wb + sn * XGRP, lane);
            asm volatile("s_waitcnt vmcnt(24)" ::: "memory");
            u_consume(wb + sg * XGRP, xh, xl, a_lo, a_hi, b_lo, b_hi, g, lane, w_lo, w_hi);
            sg = (sg + 1) & 3;
        }
        float wmax = wave_max(fmaxf(fabsf(w_lo), fabsf(w_hi))); if (wmax == 0.f) wmax = 1.f;
        const float scale_w = wmax * (255.0f / 127.0f), inv_sw = 1.0f / scale_w;
        int acc[32]; int bias[2] = {0, 0};
#pragma unroll
        for (int i = 0; i < 32; ++i) acc[i] = 0;
#pragma unroll 1
        for (int g = 0; g < 32; ++g) {
            const int sn = (sg + 3) & 3;
            dma_group(VQ, e_lo, e_hi, (g + 3) & 31, wb + sn * XGRP, lane);
            asm volatile("s_waitcnt vmcnt(24)" ::: "memory");
            v_consume(wb + sg * XGRP, acc, bias, w_lo, w_hi, inv_sw, g, lane);
            sg = (sg + 1) & 3;
        }
        asm volatile("s_waitcnt vmcnt(0)" ::: "memory");
        exp_epilogue(P, row, ln, acc, bias, scale_w);
    }
    LAS int* cmax = (LAS int*)(lds + MISC_OFF + 64);
    __syncthreads();
    for (int ct = blockIdx.x; ct < NTOK_S; ct += gridDim.x) {
        const int row = NTOK_P + ct;
        int ln = lane; asm volatile("" : "+v"(ln));
        const u32x4 xh = *(const u32x4*)(P.ws + WS_X1Q + (size_t)row * D + ln * 32), xl = *(const u32x4*)(P.ws + WS_X1Q + (size_t)row * D + ln * 32 + 16);
        const float sx = SX[row];
        const int kk = 16 * wave + (ln & 15);
        const int e_loc = EIDX[(size_t)row * 128 + kk]; const float g_loc = GW[(size_t)row * 128 + kk];
        const float a_loc = SU[e_loc] * sx, b_loc = g_loc * SV[e_loc];
        float w_loc = 0.f, w_dummy = 0.f;
        asm volatile("s_waitcnt vmcnt(0)" ::: "memory");
#pragma unroll
        for (int g = 0; g < 4; ++g) dma_group(UQ, e_loc, e_loc, g, wb + g * XGRP, lane);
        asm volatile("s_waitcnt vmcnt(0)" ::: "memory");
#pragma unroll
        for (int g = 0; g < 4; ++g) u_consume(wb + g * XGRP, xh, xl, a_loc, a_loc, b_loc, b_loc, g, lane, w_loc, w_dummy);
#pragma unroll
        for (int g = 0; g < 4; ++g) dma_group(VQ, e_loc, e_loc, g, wb + g * XGRP, lane);
        const float wm = wave_max(ln < 16 ? fabsf(w_loc) : 0.f);
        if (lane == 0) cmax[wave] = __float_as_int(wm);
        __syncthreads();
        float wmax = 0.f;
#pragma unroll
        for (int ww = 0; ww < 8; ++ww) wmax = fmaxf(wmax, __int_as_float(cmax[ww]));
        if (wmax == 0.f) wmax = 1.f;
        const float scale_w = wmax * (255.0f / 127.0f), inv_sw = 1.0f / scale_w;
        int acc[32]; int bias[2] = {0, 0};
#pragma unroll
        for (int i = 0; i < 32; ++i) acc[i] = 0;
        asm volatile("s_waitcnt vmcnt(0)" ::: "memory");
#pragma unroll
        for (int g = 0; g < 4; ++g) v_consume(wb + g * XGRP, acc, bias, w_loc, w_loc, inv_sw, g, lane);
        __builtin_amdgcn_wave_barrier();
        {
            LAS int* pp = (LAS int*)wb + lane * 36;
#pragma unroll
            for (int i = 0; i < 8; ++i) *(LAS u32x4*)(pp + 4 * i) = (u32x4){(unsigned)acc[4 * i], (unsigned)acc[4 * i + 1], (unsigned)acc[4 * i + 2], (unsigned)acc[4 * i + 3]};
            pp[32] = bias[0]; pp[33] = bias[1];
        }
        __syncthreads();
        if (wave == 0) {
#pragma unroll
            for (int i = 0; i < 32; ++i) acc[i] = 0;
            bias[0] = 0; bias[1] = 0;
#pragma unroll 1
            for (int ww = 0; ww < 8; ++ww) {
                const LAS int* pp = (const LAS int*)(lds + ww * XWAVE) + lane * 36;
#pragma unroll
                for (int i = 0; i < 8; ++i) { const u32x4 t = *(const LAS u32x4*)(pp + 4 * i); acc[4 * i] += (int)t[0]; acc[4 * i + 1] += (int)t[1]; acc[4 * i + 2] += (int)t[2]; acc[4 * i + 3] += (int)t[3]; }
                bias[0] += pp[32]; bias[1] += pp[33];
            }
            exp_epilogue(P, row, ln, acc, bias, scale_w);
        }
        __syncthreads();
    }
}

constexpr int NPHASE = 11;
__global__ void __launch_bounds__(NTHREADS, 2) fwd(Params P) {
    extern __shared__ __attribute__((aligned(16))) unsigned char lds_raw[];
    LAS unsigned char* lds = (LAS unsigned char*)lds_raw;
    volatile LAS unsigned* misc = (volatile LAS unsigned*)(lds + MISC_OFF);
    const int lo = P.ph_lo, hi = P.ph_hi;
    XcdBarrier bar; bar.bar = (unsigned*)(P.ws + WS_CTL); bar.x = 0; bar.st = nullptr;
    if (hi - lo > 1) {
        if (threadIdx.x == 0) { misc[0] = 0u; misc[1] = 0u; misc[2] = 0u; misc[3] = 0u; }
        __syncthreads();
        bar = xcd_barrier_post((unsigned*)(P.ws + WS_CTL), misc);
    }
#ifndef MK_REPMASK
#define MK_REPMASK 0
#endif
#ifndef MK_PHASE_MASK
#define MK_PHASE_MASK 0x7ff
#endif
#define IN(k) (((MK_PHASE_MASK >> (k)) & 1) && lo <= (k) && (k) < hi)
#define SEAM(k) do { if (IN(k) && IN((k) + 1)) xcd_barrier(bar); } while (0)
    if (IN(0)) { phase_prologue(P, lds); }
    SEAM(0);
    if (IN(1)) {
        pg8::Gemm g{(const pg8::bf16_t*)(P.ws + WS_XB), (const pg8::bf16_t*)(P.ws + WS_WINT), NTOK, DIN, D};
        pg8::StaticOrder S; S.init(NTOK, DIN, (int)gridDim.x, (int)blockIdx.x);
        EpiProj E{P.out, (bf16_t*)(P.ws + WS_XR), (bf16_t*)(P.ws + WS_GATE), (bf16_t*)(P.ws + WS_QB), (bf16_t*)(P.ws + WS_KB), (bf16_t*)(P.ws + WS_VB16)};
        pg8::gemm_phase<EpiProj, pg8::StaticOrder, false>(lds, g, S, E, nullptr);
        { const int nwg = (NTOK / 256) * (DIN / 256), full = nwg % (int)gridDim.x;
          if (full != 0 && (int)blockIdx.x >= full) quant_tables(P, ((int)blockIdx.x - full) * 8 + (int)(threadIdx.x >> 6), ((int)gridDim.x - full) * 8, 0, MK_QHEAD);
          else if (full == 0) quant_tables(P, (int)blockIdx.x * 8 + (int)(threadIdx.x >> 6), (int)gridDim.x * 8, 0, MK_QHEAD); }
    }
    SEAM(1);
    {
        const bool copy_first = ((blockIdx.x >> 3) & 1) != 0;
        if (IN(3) && copy_first) phase_samp(P, lds);
        if (IN(2)) phase_lru(P, lds);
        if (IN(4)) phase_attn01(P, lds);
        if (IN(3) && !copy_first) phase_samp(P, lds);
    }
    SEAM(4);
    if (IN(5)) { phase_mix_b(P, lds); }
    SEAM(5);
    if (IN(6)) {
        sample_rows_gemm<0>(P, (const bf16_t*)(P.ws + WS_AR), (const bf16_t*)(P.ws + WS_WOT), lds);
        pg8::Gemm g{(const pg8::bf16_t*)(P.ws + WS_AR), (const pg8::bf16_t*)(P.ws + WS_WOT), NTOK_P, D, D};
        pg8::StaticOrder S; S.init(NTOK_P, D, (int)gridDim.x, (int)blockIdx.x);
        EpiOut E{(const bf16_t*)(P.ws + WS_XB), (bf16_t*)(P.ws + WS_PRE1)};
        pg8::gemm_phase<EpiOut, pg8::StaticOrder, false>(lds, g, S, E, nullptr);
    }
    SEAM(6);
    if (IN(7)) { phase_ln1(P); }
    SEAM(7);
    if (IN(8)) {
        sample_rows_gemm<1>(P, (const bf16_t*)(P.ws + WS_X1B), (const bf16_t*)(P.ws + WS_WQT), lds);
        pg8::Gemm g{(const pg8::bf16_t*)(P.ws + WS_X1B), (const pg8::bf16_t*)(P.ws + WS_WQT), NTOK_P, D, D};
        pg8::StaticOrder S; S.init(NTOK_P, D, (int)gridDim.x, (int)blockIdx.x);
        EpiBf16Plain E{(bf16_t*)(P.ws + WS_QP), D};
        pg8::gemm_phase<EpiBf16Plain, pg8::StaticOrder, false>(lds, g, S, E, nullptr);
    }
    SEAM(8);
    if (IN(9)) { phase_route(P, lds); }
    SEAM(9);
    if (IN(10)) { phase_experts(P, lds); }
#undef IN
#undef SEAM
}
}

extern "C" void kernel_launch(void* const* d_in, const int* in_sizes, int n_in, void* d_out, int out_size, void* d_ws, size_t ws_size, hipStream_t stream) {
    using namespace mk;
    static int grid = 0;
    if (grid == 0) {
        if (n_in != 23 || (size_t)out_size != O_END || ws_size < WS_END) { fprintf(stderr, "kernel_launch: unexpected shapes: n_in %d out %d ws %zu (need %zu)\n", n_in, out_size, ws_size, (size_t)WS_END); grid = -1; return; }
        int dev = 0, cus = 0, per_cu = 0;
        if (hipGetDevice(&dev) != hipSuccess || hipDeviceGetAttribute(&cus, hipDeviceAttributeMultiprocessorCount, dev) != hipSuccess) { grid = -1; return; }
        if (hipFuncSetAttribute((const void*)fwd, hipFuncAttributeMaxDynamicSharedMemorySize, LDS_BYTES) != hipSuccess) { fprintf(stderr, "kernel_launch: hipFuncSetAttribute failed\n"); grid = -1; return; }
        if (hipOccupancyMaxActiveBlocksPerMultiprocessor(&per_cu, (const void*)fwd, NTHREADS, LDS_BYTES) != hipSuccess || per_cu < 1) { fprintf(stderr, "kernel_launch: occupancy query says %d\n", per_cu); }
        (void)hipGetLastError();
        grid = cus;
    }
    if (grid < 0) return;
    (void)hipMemsetAsync((char*)d_ws + WS_CTL, 0, 65536, stream);
    Params p{};
    p.x_prompt = (const float*)d_in[0]; p.x_sample = (const float*)d_in[1]; p.cache_k = (const float*)d_in[2]; p.cache_v = (const float*)d_in[3];
    p.state_conv = (const float*)d_in[4]; p.state_h = (const float*)d_in[5]; p.w_in = (const float*)d_in[6]; p.conv_w = (const float*)d_in[7]; p.conv_b = (const float*)d_in[8];
    p.lru_w_a = (const float*)d_in[9]; p.lru_b_a = (const float*)d_in[10]; p.lru_w_x = (const float*)d_in[11]; p.lru_b_x = (const float*)d_in[12]; p.lru_lambda = (const float*)d_in[13];
    p.w_out = (const float*)d_in[14]; p.ln1_g = (const float*)d_in[15]; p.ln1_b = (const float*)d_in[16]; p.w_query = (const float*)d_in[17]; p.sub_keys = (const float*)d_in[18];
    p.peer_u = (const float*)d_in[19]; p.peer_v = (const float*)d_in[20]; p.ln2_g = (const float*)d_in[21]; p.ln2_b = (const float*)d_in[22];
    p.out = (float*)d_out; p.ws = (unsigned char*)d_ws;
#if MK_N_LAUNCHES == 1
    p.ph_lo = 0; p.ph_hi = NPHASE;
    hipLaunchKernelGGL(fwd, dim3(grid), dim3(NTHREADS), LDS_BYTES, stream, p);
#else
    for (int k = 0; k < NPHASE; ++k) { p.ph_lo = k; p.ph_hi = k + 1; hipLaunchKernelGGL(fwd, dim3(grid), dim3(NTHREADS), LDS_BYTES, stream, p);
#ifdef MK_EXTRA_PHASE
        if (k == MK_EXTRA_PHASE) hipLaunchKernelGGL(fwd, dim3(grid), dim3(NTHREADS), LDS_BYTES, stream, p);
#endif
    }
#endif
    const hipError_t le = hipPeekAtLastError();
    if (le != hipSuccess) fprintf(stderr, "kernel_launch: launch failed: %s\n", hipGetErrorName(le));
}
```
